# Optimizing an MI355X kernel written in HIP

```python
import jax
import jax.numpy as jnp
from jax import lax
import numpy as np

D_MODEL = 1024
BATCH = 4
SEQ = 4096
DEPTH = 2

GRID_W = 64
CTX_LEN = 256
N_BRANCH = 4
BRANCH_W = D_MODEL // 4
HEAD_DIM = 64
MLA_HEADS = 4
MLA_NOPE = 64
MLA_ROPE = 32
MLA_V = 64
MLA_Q_RANK = 256
MLA_KV_RANK = 128
SWA_Q_HEADS = 4
SWA_KV_HEADS = 2
WINDOW = 128
SWA_BLOCK = 128
AXA_Q_HEADS = 4
AXA_KV_HEADS = 2
LRU_WIDTH = BRANCH_W
LRU_BLOCKS = 4
LRU_BLOCK = LRU_WIDTH // LRU_BLOCKS
LRU_C = 8.0
CONV_W = 4
CONV_LEFT = 2
Q_BLOCK = 128
ROPE_THETA = 10000.0
RMS_EPS = 1e-6
NEG_INF = -1e30

IN_SIZES = (MLA_Q_RANK, MLA_KV_RANK, MLA_ROPE,
            SWA_Q_HEADS * HEAD_DIM, SWA_KV_HEADS * HEAD_DIM, SWA_KV_HEADS * HEAD_DIM,
            AXA_Q_HEADS * HEAD_DIM, AXA_KV_HEADS * HEAD_DIM, AXA_KV_HEADS * HEAD_DIM,
            LRU_WIDTH,
            N_BRANCH * BRANCH_W,
            N_BRANCH * D_MODEL)
IN_COLS = sum(IN_SIZES)

kernel_name = 'hybrid_parallel_mla_swa_axial_rglru_dit'


def _rms_norm(x, gain):
    x32 = x.astype(jnp.float32)
    y = x32 * lax.rsqrt(jnp.mean(x32 * x32, axis=-1, keepdims=True) + RMS_EPS)
    return (y * gain.astype(jnp.float32)).astype(x.dtype)


def _split_in(z):
    idx, acc = [], 0
    for s in IN_SIZES[:-1]:
        acc += s
        idx.append(acc)
    return jnp.split(z, idx, axis=-1)


def _axial_rope(n, rot_dim):
    n_rows = n // GRID_W
    rows = jnp.repeat(jnp.arange(n_rows, dtype=jnp.float32), GRID_W)
    cols = jnp.tile(jnp.arange(GRID_W, dtype=jnp.float32), n_rows)
    quarter = rot_dim // 4
    freqs = ROPE_THETA ** (-jnp.arange(quarter, dtype=jnp.float32) / quarter)
    ang = jnp.concatenate([rows[:, None] * freqs, cols[:, None] * freqs], axis=-1)
    return jnp.cos(ang), jnp.sin(ang)


def _apply_rope(x, cos, sin):
    half = x.shape[-1] // 2
    cos = cos[None, :, None, :].astype(x.dtype)
    sin = sin[None, :, None, :].astype(x.dtype)
    x1, x2 = x[..., :half], x[..., half:]
    return jnp.concatenate([x1 * cos - x2 * sin, x2 * cos + x1 * sin], axis=-1)


def _rope_tail(x, cos, sin):
    r = 2 * cos.shape[-1]
    return jnp.concatenate([x[..., :-r], _apply_rope(x[..., -r:], cos, sin)], axis=-1)


def _short_conv(u, w, b):
    n = u.shape[1]
    up = jnp.pad(u, ((0, 0), (CONV_LEFT, CONV_W - 1 - CONV_LEFT), (0, 0)))
    y = b
    for j in range(CONV_W):
        y = y + up[:, j:j + n] * w[j]
    return y


def _softmax_with_sink(s, sink):
    m = jnp.maximum(jnp.max(s, axis=-1, keepdims=True), sink)
    p = jnp.exp(s - m)
    return p / (jnp.sum(p, axis=-1, keepdims=True) + jnp.exp(sink - m))


def _dense_attention(q, k, v):
    b, n, hkv, g, d = q.shape
    nb = n // Q_BLOCK
    scale = d ** -0.5
    qb = jnp.moveaxis(q.reshape(b, nb, Q_BLOCK, hkv, g, d), 1, 0)

    def block(qblk):
        s = jnp.einsum('bqhgd,bkhd->bhgqk', qblk, k).astype(jnp.float32) * scale
        p = jax.nn.softmax(s, axis=-1).astype(v.dtype)
        return jnp.einsum('bhgqk,bkhd->bqhgd', p, v)

    out = lax.map(block, qb)
    return jnp.moveaxis(out, 0, 1).reshape(b, n, -1)


def _window_attention(q, k, v, k_ctx, v_ctx, sink):
    b, n, hkv, g, d = q.shape
    w = SWA_BLOCK
    nb = n // w
    scale = d ** -0.5
    pad = ((0, 0), (w, w), (0, 0), (0, 0))
    kp = jnp.pad(k, pad).reshape(b, nb + 2, w, hkv, d)
    vp = jnp.pad(v, pad).reshape(b, nb + 2, w, hkv, v.shape[-1])
    kb = jnp.concatenate([kp[:, :-2], kp[:, 1:-1], kp[:, 2:]], axis=2)
    vb = jnp.concatenate([vp[:, :-2], vp[:, 1:-1], vp[:, 2:]], axis=2)
    qb = q.reshape(b, nb, w, hkv, g, d)
    s_loc = jnp.einsum('bnqhgd,bnkhd->bnhgqk', qb, kb).astype(jnp.float32) * scale
    s_ctx = jnp.einsum('bnqhgd,bkhd->bnhgqk', qb, k_ctx).astype(jnp.float32) * scale
    qi = jnp.arange(w)[:, None]
    ki = jnp.arange(3 * w)[None, :]
    key_pos = (jnp.arange(nb)[:, None, None] - 1) * w + ki[None]
    rel = ki - qi
    valid = ((rel >= w - WINDOW) & (rel <= w + WINDOW))[None] & (key_pos >= 0) & (key_pos < n)
    s_loc = jnp.where(valid[None, :, None, None], s_loc, NEG_INF)
    p = _softmax_with_sink(jnp.concatenate([s_loc, s_ctx], axis=-1),
                           sink[None, None, :, :, None, None])
    p_loc = p[..., :3 * w].astype(v.dtype)
    p_ctx = p[..., 3 * w:].astype(v.dtype)
    out = (jnp.einsum('bnhgqk,bnkhd->bnqhgd', p_loc, vb)
           + jnp.einsum('bnhgqk,bkhd->bnqhgd', p_ctx, v_ctx))
    return out.reshape(b, n, -1)


def _sink_attention(q, k, v, sink):
    b, n = q.shape[:2]
    scale = q.shape[-1] ** -0.5
    s = jnp.einsum('bqhgd,bkhd->bhgqk', q, k).astype(jnp.float32) * scale
    p = _softmax_with_sink(s, sink[None, :, :, None, None]).astype(v.dtype)
    return jnp.einsum('bhgqk,bkhd->bqhgd', p, v).reshape(b, n, -1)


def _scan_combine(left, right):
    a_l, b_l = left
    a_r, b_r = right
    return a_l * a_r, a_r * b_l + b_r


def _rglru_dir(u, w_r, b_r, w_i, b_i, lam, h0, reverse):
    u32 = u.astype(jnp.float32)
    shp = u32.shape
    ub = u32.reshape(shp[:-1] + (LRU_BLOCKS, LRU_BLOCK))
    r = jax.nn.sigmoid(jnp.einsum('bnki,kij->bnkj', ub, w_r.astype(jnp.float32)).reshape(shp)
                       + b_r.astype(jnp.float32))
    i = jax.nn.sigmoid(jnp.einsum('bnki,kij->bnkj', ub, w_i.astype(jnp.float32)).reshape(shp)
                       + b_i.astype(jnp.float32))
    log_a = -LRU_C * r * jax.nn.softplus(-lam.astype(jnp.float32))
    a = jnp.exp(log_a)
    bx = jnp.sqrt(-jnp.expm1(2.0 * log_a)) * (i * u32)
    a_cum, b_cum = lax.associative_scan(_scan_combine, (a, bx), axis=1, reverse=reverse)
    return a_cum * h0[:, None, :] + b_cum


def _rglru_branch(u_c, u_x, lp, want_ctx):
    bsz = u_x.shape[0]
    ys_x, ys_c = [], []
    for d, reverse in enumerate((False, True)):
        args = (lp['lru_w_r'][d], lp['lru_b_r'][d], lp['lru_w_i'][d], lp['lru_b_i'][d],
                lp['lru_lambda'][d])
        h_c = _rglru_dir(u_c, *args, jnp.zeros((bsz, LRU_WIDTH), jnp.float32), reverse)
        h_last = h_c[:, 0] if reverse else h_c[:, -1]
        ys_x.append(_rglru_dir(u_x, *args, h_last, reverse))
        ys_c.append(h_c)
    y_x = (ys_x[0] + ys_x[1]).astype(u_x.dtype)
    y_c = (ys_c[0] + ys_c[1]).astype(u_c.dtype) if want_ctx else None
    return y_x, y_c


def _project_stream(h, lp, rope, need_queries):
    b, n = h.shape[:2]
    (z_cq, z_ckv, z_kr, z_sq, z_sk, z_sv, z_aq, z_ak, z_av,
     z_lru, z_gate, z_merge) = _split_in(h @ lp['w_in'])
    out = {}
    ckv = _rms_norm(z_ckv, lp['mla_ckv_norm'])
    kv = (ckv @ lp['mla_w_ukv']).reshape(b, n, MLA_HEADS, MLA_NOPE + MLA_V)
    k_rope = jnp.broadcast_to(z_kr[:, :, None, :], (b, n, MLA_HEADS, MLA_ROPE))
    mla_k = _rms_norm(jnp.concatenate([kv[..., :MLA_NOPE], k_rope], axis=-1), lp['mla_k_norm'])
    out['mla_v'] = kv[..., MLA_NOPE:]
    swa_k = _rms_norm(z_sk.reshape(b, n, SWA_KV_HEADS, HEAD_DIM), lp['swa_k_norm'])
    out['swa_v'] = z_sv.reshape(b, n, SWA_KV_HEADS, HEAD_DIM)
    axa_k = _rms_norm(z_ak.reshape(b, n, AXA_KV_HEADS, HEAD_DIM), lp['axa_k_norm'])
    out['axa_v'] = z_av.reshape(b, n, AXA_KV_HEADS, HEAD_DIM)
    if rope is not None:
        mla_k = _rope_tail(mla_k, *rope['mla'])
        swa_k = _apply_rope(swa_k, *rope['head'])
        axa_k = _apply_rope(axa_k, *rope['head'])
    out['mla_k'] = mla_k
    out['swa_k'] = swa_k
    out['axa_k'] = axa_k
    out['lru_u'] = _short_conv(z_lru, lp['lru_conv_w'], lp['lru_conv_b'])
    if need_queries:
        cq = _rms_norm(z_cq, lp['mla_cq_norm'])
        mla_q = _rms_norm((cq @ lp['mla_w_uq']).reshape(b, n, MLA_HEADS, MLA_NOPE + MLA_ROPE),
                          lp['mla_q_norm'])
        swa_q = _rms_norm(z_sq.reshape(b, n, SWA_Q_HEADS, HEAD_DIM), lp['swa_q_norm'])
        axa_q = _rms_norm(z_aq.reshape(b, n, AXA_Q_HEADS, HEAD_DIM), lp['axa_q_norm'])
        if rope is not None:
            mla_q = _rope_tail(mla_q, *rope['mla'])
            swa_q = _apply_rope(swa_q, *rope['head'])
            axa_q = _apply_rope(axa_q, *rope['head'])
        out['mla_q'] = mla_q[:, :, :, None, :]
        out['swa_q'] = swa_q.reshape(b, n, SWA_KV_HEADS, SWA_Q_HEADS // SWA_KV_HEADS, HEAD_DIM)
        out['axa_q'] = axa_q.reshape(b, n, AXA_KV_HEADS, AXA_Q_HEADS // AXA_KV_HEADS, HEAD_DIM)
        out['gate'] = z_gate
        out['merge'] = z_merge
    return out


def _merge_branches(branches, z_gate, z_merge, lp):
    b, n = z_gate.shape[:2]
    y = jnp.stack(branches, axis=2) * jax.nn.silu(z_gate.reshape(b, n, N_BRANCH, BRANCH_W))
    proj = jnp.einsum('bnkw,kwd->bnkd', y, lp['w_branch'])
    mix = jnp.sum(jax.nn.sigmoid(z_merge.reshape(b, n, N_BRANCH, D_MODEL)) * proj, axis=2)
    return mix @ lp['w_out']


def _layer(x, ctx, mod_x, mod_c, lp, rope, update_ctx):
    shift_x, scale_x, gate_x = jnp.split(mod_x[:, None, :], 3, axis=-1)
    shift_c, scale_c, gate_c = jnp.split(mod_c, 3, axis=-1)
    hx = _rms_norm(x, lp['norm_w']) * (1 + scale_x) + shift_x
    hc = _rms_norm(ctx, lp['norm_w']) * (1 + scale_c) + shift_c
    px = _project_stream(hx, lp, rope, True)
    pc = _project_stream(hc, lp, None, update_ctx)
    sink = lp['swa_sink'].astype(jnp.float32).reshape(SWA_KV_HEADS, SWA_Q_HEADS // SWA_KV_HEADS)
    ya = _dense_attention(px['mla_q'], jnp.concatenate([pc['mla_k'], px['mla_k']], axis=1),
                          jnp.concatenate([pc['mla_v'], px['mla_v']], axis=1))
    yb = _window_attention(px['swa_q'], px['swa_k'], px['swa_v'], pc['swa_k'], pc['swa_v'], sink)
    yc = _dense_attention(px['axa_q'], jnp.concatenate([pc['axa_k'], px['axa_k']], axis=1),
                          jnp.concatenate([pc['axa_v'], px['axa_v']], axis=1))
    yd_x, yd_c = _rglru_branch(pc['lru_u'], px['lru_u'], lp, update_ctx)
    x = x + gate_x * _merge_branches((ya, yb, yc, yd_x), px['gate'], px['merge'], lp)
    if update_ctx:
        ya_c = _dense_attention(pc['mla_q'], pc['mla_k'], pc['mla_v'])
        yb_c = _sink_attention(pc['swa_q'], pc['swa_k'], pc['swa_v'], sink)
        yc_c = _dense_attention(pc['axa_q'], pc['axa_k'], pc['axa_v'])
        ctx = ctx + gate_c * _merge_branches((ya_c, yb_c, yc_c, yd_c), pc['gate'], pc['merge'], lp)
    return x, ctx


def setup_inputs(seed: int = 0) -> dict:
    key = jax.random.key(seed)
    ks = jax.random.split(key, 32)
    D = D_MODEL

    def nrm(k, shape, scale):
        return jax.random.normal(k, shape, jnp.float32) * scale

    def gain(k, shape):
        return 1.0 + 0.05 * jax.random.normal(k, shape, jnp.float32)

    a_target = jax.random.uniform(ks[25], (DEPTH, 2, LRU_WIDTH), jnp.float32, 0.9, 0.999)
    s_lam = a_target ** (1.0 / LRU_C)
    return {
        'x': nrm(ks[0], (BATCH, SEQ, D), 1.0),
        'c': nrm(ks[1], (BATCH, D), 1.0),
        'ctx': nrm(ks[2], (BATCH, CTX_LEN, D), 1.0),
        'c_ctx': nrm(ks[3], (D,), 1.0),
        'w_mod': nrm(ks[4], (DEPTH, D, 3 * D), 0.5 * D ** -0.5),
        'b_mod': nrm(ks[5], (DEPTH, 3 * D), 0.02),
        'norm_w': gain(ks[6], (DEPTH, D)),
        'w_in': nrm(ks[7], (DEPTH, D, IN_COLS), D ** -0.5),
        'mla_cq_norm': gain(ks[8], (DEPTH, MLA_Q_RANK)),
        'mla_ckv_norm': gain(ks[9], (DEPTH, MLA_KV_RANK)),
        'mla_w_uq': nrm(ks[10], (DEPTH, MLA_Q_RANK, MLA_HEADS * (MLA_NOPE + MLA_ROPE)), MLA_Q_RANK ** -0.5),
        'mla_w_ukv': nrm(ks[11], (DEPTH, MLA_KV_RANK, MLA_HEADS * (MLA_NOPE + MLA_V)), MLA_KV_RANK ** -0.5),
        'mla_q_norm': gain(ks[12], (DEPTH, MLA_NOPE + MLA_ROPE)),
        'mla_k_norm': gain(ks[13], (DEPTH, MLA_NOPE + MLA_ROPE)),
        'swa_q_norm': gain(ks[14], (DEPTH, HEAD_DIM)),
        'swa_k_norm': gain(ks[15], (DEPTH, HEAD_DIM)),
        'swa_sink': nrm(ks[16], (DEPTH, SWA_Q_HEADS), 0.5),
        'axa_q_norm': gain(ks[17], (DEPTH, HEAD_DIM)),
        'axa_k_norm': gain(ks[18], (DEPTH, HEAD_DIM)),
        'lru_conv_w': nrm(ks[19], (DEPTH, CONV_W, LRU_WIDTH), CONV_W ** -0.5),
        'lru_conv_b': nrm(ks[20], (DEPTH, LRU_WIDTH), 0.02),
        'lru_w_r': nrm(ks[21], (DEPTH, 2, LRU_BLOCKS, LRU_BLOCK, LRU_BLOCK), LRU_BLOCK ** -0.5),
        'lru_b_r': nrm(ks[22], (DEPTH, 2, LRU_WIDTH), 0.02),
        'lru_w_i': nrm(ks[23], (DEPTH, 2, LRU_BLOCKS, LRU_BLOCK, LRU_BLOCK), LRU_BLOCK ** -0.5),
        'lru_b_i': nrm(ks[24], (DEPTH, 2, LRU_WIDTH), 0.02),
        'lru_lambda': jnp.log(s_lam) - jnp.log1p(-s_lam),
        'w_branch': nrm(ks[26], (DEPTH, N_BRANCH, BRANCH_W, D), BRANCH_W ** -0.5),
        'w_out': nrm(ks[27], (DEPTH, D, D), D ** -0.5),
    }


def reference(x, c, ctx, c_ctx, w_mod, b_mod, norm_w, w_in, mla_cq_norm, mla_ckv_norm,
              mla_w_uq, mla_w_ukv, mla_q_norm, mla_k_norm, swa_q_norm, swa_k_norm, swa_sink,
              axa_q_norm, axa_k_norm, lru_conv_w, lru_conv_b, lru_w_r, lru_b_r, lru_w_i,
              lru_b_i, lru_lambda, w_branch, w_out):
    n = x.shape[1]
    rope = {'mla': _axial_rope(n, MLA_ROPE), 'head': _axial_rope(n, HEAD_DIM)}
    sc = jax.nn.silu(c)
    scc = jax.nn.silu(c_ctx)
    for l in range(DEPTH):
        lp = {
            'norm_w': norm_w[l], 'w_in': w_in[l],
            'mla_cq_norm': mla_cq_norm[l], 'mla_ckv_norm': mla_ckv_norm[l],
            'mla_w_uq': mla_w_uq[l], 'mla_w_ukv': mla_w_ukv[l],
            'mla_q_norm': mla_q_norm[l], 'mla_k_norm': mla_k_norm[l],
            'swa_q_norm': swa_q_norm[l], 'swa_k_norm': swa_k_norm[l], 'swa_sink': swa_sink[l],
            'axa_q_norm': axa_q_norm[l], 'axa_k_norm': axa_k_norm[l],
            'lru_conv_w': lru_conv_w[l], 'lru_conv_b': lru_conv_b[l],
            'lru_w_r': lru_w_r[l], 'lru_b_r': lru_b_r[l],
            'lru_w_i': lru_w_i[l], 'lru_b_i': lru_b_i[l], 'lru_lambda': lru_lambda[l],
            'w_branch': w_branch[l], 'w_out': w_out[l],
        }
        mod_x = sc @ w_mod[l] + b_mod[l]
        mod_c = scc @ w_mod[l] + b_mod[l]
        x, ctx = _layer(x, ctx, mod_x, mod_c, lp, rope, l < DEPTH - 1)
    return x
```

```cpp
#include <hip/hip_runtime.h>
#include <cstdio>
#include <cstdint>
#include <cmath>
__device__ __forceinline__ float bflo(unsigned w) { return __uint_as_float(w << 16); }
__device__ __forceinline__ float bfhi(unsigned w) { return __uint_as_float(w & 0xffff0000u); }
__device__ __forceinline__ float sigmoid_f(float v) { return __builtin_amdgcn_rcpf(1.0f + __builtin_amdgcn_exp2f(-1.4426950408889634f * v)); }
namespace pg8 {
#define PG8_LAS __attribute__((address_space(3)))
typedef unsigned short bf16_t;
typedef short bf16x8 __attribute__((ext_vector_type(8)));
typedef float f32x4 __attribute__((ext_vector_type(4)));
typedef unsigned u32x4 __attribute__((ext_vector_type(4)));
constexpr int BM = 256, BK = 64, HALF = 128, HTB = HALF * BK * 2  , STAGE_BYTES = 8 * HTB, NXCD = 8, WGM = 8;

__host__ __device__ __forceinline__ int lds_byte(int r, int c) { const int st = (r >> 4) * 2 + (c >> 5), rr = r & 15, cc = c & 31, ob = rr * 64 + cc * 2; return st * 1024 + (ob ^ (((ob >> 9) & 1) << 5)); }
__host__ __device__ __forceinline__ void stage_rc(int b, int& R, int& C) { const int st = b / 1024, sb = b % 1024, swz = sb ^ (((sb >> 9) & 1) << 5); R = (st >> 1) * 16 + swz / 64; C = (st & 1) * 32 + (swz % 64) / 2; }
__host__ __device__ __forceinline__ int perm32(int rho) { const int n = rho >> 4, i = rho & 15; return 8 * (i >> 2) + 4 * n + (i & 3); }

struct Unit { int pm, pn; };
struct Gemm { const bf16_t* A; const bf16_t* Bt; int M, N, K, lda; int a_shift, a_step; };

struct StaticOrder {
    int nM, nN, nwg, G, c;
    __host__ __device__ void init(int M, int N, int G_, int c_) { nM = M / BM; nN = N / BM; nwg = nM * nN; G = G_; c = c_; }
    __host__ __device__ bool next(int i, Unit& u) const {
        const long L = (long)i * G + c; if (L >= nwg) return false;
        int wgid = (int)L; { const int q = nwg / NXCD, r = nwg % NXCD, xcd = wgid % NXCD, off = wgid / NXCD; wgid = (xcd < r ? xcd * (q + 1) : r * (q + 1) + (xcd - r) * q) + off; }
        const int nig = WGM * nN, gid = wgid / nig, fm = gid * WGM, gsz = (nM - fm) < WGM ? (nM - fm) : WGM;
        u.pm = fm + ((wgid % nig) % gsz); u.pn = (wgid % nig) / gsz; return true;
    }
    __device__ __forceinline__ void a_ready(const Unit&) const {}
    __device__ __forceinline__ void done(const Unit&) const {}
};

__device__ __forceinline__ unsigned cvt_pk_bf16(float lo, float hi) { unsigned r; asm volatile("v_cvt_pk_bf16_f32 %0, %1, %2" : "=v"(r) : "v"(lo), "v"(hi)); return r; }
enum { EM_PLAIN = 0, EM_SILU2 = 1, EM_SIG = 2, EM_MUL = 3, EM_RES = 4 };
struct EpiU {
    static constexpr bool PERM = true, AFTER_DRAIN = false;
    int mode; int l; unsigned char* ws; const float* xin; float* xout; const float* cin0;
    size_t oA, oB; int ldc, ldc2, split_tile;
    __device__ __forceinline__ void operator()(const f32x4 (&acc)[2][2][4][2], const Unit& u, int wr, int wc, int fr, int fq) const {
        if (mode == EM_RES) {
            const int b = u.pm / 17, t0 = u.pm % 17;
            const float* src; float* dst; const float* gate; const float* modl = (const float*)(ws + oA) + (size_t)l * 5 * 3072;
            if (t0 == 0) { float* c1 = (float*)(ws + oB); src = ((l == 0) ? cin0 : (const float*)c1) + (size_t)b * 256 * 1024; dst = c1 + (size_t)b * 256 * 1024; gate = modl + 4 * 3072 + 2048; }
            else { const size_t o = ((size_t)b * 4096 + (size_t)(t0 - 1) * 256) * 1024; src = xin + o; dst = xout + o; gate = modl + b * 3072 + 2048; }
            const int col0 = u.pn * BM + wc * 32 + 8 * fq;
            const char* srcb = (const char*)src; char* dstb = (char*)dst; const char* gb = (const char*)(gate + col0);
            const unsigned off0 = (unsigned)((wr * 64 + fr) * 1024 + col0) * 4u;
#pragma unroll
            for (int ai = 0; ai < 2; ++ai)
#pragma unroll
                for (int m = 0; m < 4; ++m) { const unsigned off = off0 + (unsigned)(ai * HALF + m * 16) * 4096u;
#pragma unroll
                    for (int bj = 0; bj < 2; ++bj)
#pragma unroll
                        for (int n = 0; n < 2; ++n) { const unsigned cb = (unsigned)(bj * HALF + n * 4) * 4u; const f32x4 g = *(const f32x4*)(gb + cb); const f32x4 xo = *(const f32x4*)(srcb + (off + cb));
                            *(f32x4*)(dstb + (off + cb)) = xo + g * acc[ai][bj][m][n]; }
                    asm volatile("" ::: "memory"); }
            return;
        }
        const int row0 = u.pm * BM + wr * 64 + fr; int colt = u.pn * BM; bf16_t* base = (bf16_t*)(ws + oA); int ld = ldc; bool second = false;
        if (u.pn >= split_tile) { base = (bf16_t*)(ws + oB); ld = ldc2; colt -= split_tile * BM; second = true; }
        const bool do_silu = (mode == EM_SILU2) && second;
        const int col0 = colt + wc * 32 + 8 * fq;
#pragma unroll
        for (int ai = 0; ai < 2; ++ai)
#pragma unroll
            for (int m = 0; m < 4; ++m) { bf16_t* rowp = base + (size_t)(row0 + ai * HALF + m * 16) * ld + col0;
#pragma unroll
                for (int bj = 0; bj < 2; ++bj) { f32x4 v0 = acc[ai][bj][m][0], v1 = acc[ai][bj][m][1];
                    if (mode == EM_SIG) {
#pragma unroll
                        for (int e = 0; e < 4; ++e) { v0[e] = sigmoid_f(v0[e]); v1[e] = sigmoid_f(v1[e]); } }
                    if (do_silu) {
#pragma unroll
                        for (int e = 0; e < 4; ++e) { v0[e] = v0[e] * sigmoid_f(v0[e]); v1[e] = v1[e] * sigmoid_f(v1[e]); } }
                    if (mode == EM_MUL) { const u32x4 o = *(const u32x4*)(rowp + bj * HALF);
                        v0[0] *= bflo(o.x); v0[1] *= bfhi(o.x); v0[2] *= bflo(o.y); v0[3] *= bfhi(o.y); v1[0] *= bflo(o.z); v1[1] *= bfhi(o.z); v1[2] *= bflo(o.w); v1[3] *= bfhi(o.w); }
                    u32x4 w; w.x = cvt_pk_bf16(v0[0], v0[1]); w.y = cvt_pk_bf16(v0[2], v0[3]); w.z = cvt_pk_bf16(v1[0], v1[1]); w.w = cvt_pk_bf16(v1[2], v1[3]);
                    *(u32x4*)(rowp + bj * HALF) = w; }
                if (mode == EM_MUL) asm volatile("" ::: "memory"); }
    }
};
struct Order {
    int nM, nN, nwg, G, c, latent_only;
    __device__ void init(int nM_, int nN_, int G_, int c_, int lat) { nM = nM_; nN = nN_; nwg = nM * nN; G = G_; c = c_; latent_only = lat; }
    __device__ bool next(int i, Unit& u) const {
        const long L = (long)i * G + c; if (L >= nwg) return false;
        int wgid = (int)L; { const int q = nwg / NXCD, r = nwg % NXCD, xcd = wgid % NXCD, off = wgid / NXCD; wgid = (xcd < r ? xcd * (q + 1) : r * (q + 1) + (xcd - r) * q) + off; }
        const int nig = WGM * nN, gid = wgid / nig, fm = gid * WGM, gsz = (nM - fm) < WGM ? (nM - fm) : WGM;
        int pm = fm + ((wgid % nig) % gsz); u.pn = (wgid % nig) / gsz; if (latent_only) pm = pm + pm / 16 + 1; u.pm = pm; return true;
    }
    __device__ __forceinline__ void a_ready(const Unit&) const {}
    __device__ __forceinline__ void done(const Unit&) const {}
};
template <class Epi, class Sched, bool ALIGN_EPI = false, bool SP2 = false>
__device__ __forceinline__ void gemm_phase(PG8_LAS unsigned char* lds, const Gemm g, const Sched& S, const Epi& E, const int tid  ) {
    const int wid = __builtin_amdgcn_readfirstlane(tid >> 6), lane = tid & 63, wr = wid >> 2, wc = wid & 3, fr = lane & 15, fq = lane >> 4;
    const int K = g.K, nt = K / BK;
    unsigned voffA[2], voffB[2];
#pragma unroll
    for (int i = 0; i < 2; ++i) { int R, C; stage_rc(tid * 16 + i * 8192, R, C); const int Rb = Epi::PERM ? ((R & ~31) + perm32(R & 31)) : R;
        voffA[i] = (unsigned)(R * g.lda + C) * 2u; voffB[i] = (unsigned)(Rb * K + C) * 2u; }
    const size_t kstep = (size_t)(BK * 2);
    const size_t hstepA = (size_t)HALF * g.lda * 2, hstepB = (size_t)HALF * K * 2;
    const size_t tstepA = 2 * hstepA, tstepB = 2 * hstepB;
    const unsigned ldsw = (unsigned)wid * 1024u;
    const int aoff = lds_byte(wr * 64 + fr, fq * 8), boff = lds_byte(wc * 32 + fr, fq * 8);
#define PG8_SA(b, h) (((b) * 2 + (h)) * HTB)
#define PG8_SB(b, h) ((4 + (b) * 2 + (h)) * HTB)
#define PG8_STAGE(bufoff, gbase, voff) do { _Pragma("unroll") for (int _i = 0; _i < 2; ++_i) \
        __builtin_amdgcn_global_load_lds((const unsigned*)((const char*)(gbase) + (voff)[_i]), (PG8_LAS unsigned*)(lds + (bufoff) + ldsw + _i * 8192), 16, 0, 0); } while (0)
#define PG8_LDA(dst, b, h) do { _Pragma("unroll") for (int m = 0; m < 4; ++m) _Pragma("unroll") for (int k = 0; k < 2; ++k) dst[m][k] = *(const PG8_LAS bf16x8*)(lds + PG8_SA(b, h) + aoff + m * 2048 + k * 1024); } while (0)
#define PG8_LDB(dst, b, h) do { _Pragma("unroll") for (int n = 0; n < 2; ++n) _Pragma("unroll") for (int k = 0; k < 2; ++k) dst[n][k] = *(const PG8_LAS bf16x8*)(lds + PG8_SB(b, h) + boff + n * 2048 + k * 1024); } while (0)
#define PG8_MMA(ai, bj, At, Bt) do { __builtin_amdgcn_s_setprio(1); _Pragma("unroll") for (int m = 0; m < 4; ++m) _Pragma("unroll") for (int n = 0; n < 2; ++n) _Pragma("unroll") for (int k = 0; k < 2; ++k) \
        acc[ai][bj][m][n] = __builtin_amdgcn_mfma_f32_16x16x32_bf16(Bt[n][k], At[m][k], acc[ai][bj][m][n], 0, 0, 0); __builtin_amdgcn_s_setprio(0); } while (0)
#define PG8_WAIT_V(n) asm volatile("s_waitcnt vmcnt(" #n ")" ::: "memory")
#define PG8_WAIT_L(n) asm volatile("s_waitcnt lgkmcnt(" #n ")" ::: "memory")
#define PG8_BAR __builtin_amdgcn_s_barrier()
#define PG8_SCHED __builtin_amdgcn_sched_barrier(0)
    Unit cur, nxt; int ui = 0;
    if (!S.next(0, cur)) return;
    f32x4 acc[2][2][4][2];
#pragma unroll
    for (int a = 0; a < 2; ++a)
#pragma unroll
        for (int b = 0; b < 2; ++b)
#pragma unroll
            for (int m = 0; m < 4; ++m)
#pragma unroll
                for (int n = 0; n < 2; ++n) acc[a][b][m][n] = (f32x4){0.f, 0.f, 0.f, 0.f};
    bf16x8 At[4][2], B0[2][2], B1[2][2];
    const char* cA = (const char*)g.A + (size_t)cur.pm * tstepA + (size_t)(cur.pn >> g.a_shift) * (size_t)g.a_step; const char* cB = (const char*)g.Bt + (size_t)cur.pn * tstepB;
    S.a_ready(cur);
    if constexpr (SP2) {
        PG8_STAGE(PG8_SB(0, 0), cB, voffB); PG8_STAGE(PG8_SB(0, 1), cB + hstepB, voffB); PG8_STAGE(PG8_SA(0, 0), cA, voffA); PG8_STAGE(PG8_SA(0, 1), cA + hstepA, voffA);
        if (wr == 1) PG8_BAR;
        PG8_WAIT_V(2); PG8_BAR;
        PG8_STAGE(PG8_SB(1, 0), cB + kstep, voffB); PG8_STAGE(PG8_SA(1, 0), cA + kstep, voffA); PG8_STAGE(PG8_SB(1, 1), cB + hstepB + kstep, voffB);
        PG8_WAIT_V(6); PG8_BAR;
    } else {
        PG8_STAGE(PG8_SB(0, 0), cB, voffB); PG8_STAGE(PG8_SA(0, 0), cA, voffA); PG8_STAGE(PG8_SB(0, 1), cB + hstepB, voffB); PG8_STAGE(PG8_SA(0, 1), cA + hstepA, voffA);
        if (wr == 1) PG8_BAR;
        PG8_WAIT_V(4); PG8_BAR;
        PG8_STAGE(PG8_SB(1, 0), cB + kstep, voffB); PG8_STAGE(PG8_SA(1, 0), cA + kstep, voffA); PG8_STAGE(PG8_SB(1, 1), cB + hstepB + kstep, voffB);
        PG8_WAIT_V(6); PG8_BAR;
    }
    for (;;) {
        const bool has_next = S.next(ui + 1, nxt);
        const char* nA = has_next ? (const char*)g.A + (size_t)nxt.pm * tstepA + (size_t)(nxt.pn >> g.a_shift) * (size_t)g.a_step : cA; const char* nB = has_next ? (const char*)g.Bt + (size_t)nxt.pn * tstepB : cB;
        for (int t = 0; t < nt; t += 2) {
            const bool last = (t == nt - 2);
            const char* a1 = cA + (size_t)(t + 1) * kstep;
            const char* a2 = last ? nA : cA + (size_t)(t + 2) * kstep; const char* b2 = last ? nB : cB + (size_t)(t + 2) * kstep;
            const char* a3 = a2 + kstep; const char* b3 = b2 + kstep;
            if (last && has_next) S.a_ready(nxt);
            if constexpr (SP2) {
            PG8_LDB(B0, 0, 0); PG8_LDB(B1, 0, 1); PG8_SCHED; PG8_LDA(At, 0, 0); PG8_STAGE(PG8_SA(1, 1), a1 + hstepA, voffA);
            PG8_WAIT_V(8); PG8_WAIT_L(0); PG8_BAR; PG8_MMA(0, 0, At, B0); PG8_MMA(0, 1, At, B1); PG8_BAR; PG8_SCHED;
            PG8_LDA(At, 0, 1); PG8_STAGE(PG8_SB(0, 0), b2, voffB); PG8_STAGE(PG8_SB(0, 1), b2 + hstepB, voffB); PG8_STAGE(PG8_SA(0, 0), a2, voffA);
            PG8_WAIT_V(8); PG8_WAIT_L(0); PG8_BAR; PG8_MMA(1, 0, At, B0); PG8_MMA(1, 1, At, B1); PG8_BAR; PG8_SCHED;
            PG8_LDB(B0, 1, 0); PG8_LDB(B1, 1, 1); PG8_SCHED; PG8_LDA(At, 1, 0); PG8_STAGE(PG8_SA(0, 1), a2 + hstepA, voffA);
            PG8_WAIT_V(8); PG8_WAIT_L(0); PG8_BAR; PG8_MMA(0, 0, At, B0); PG8_MMA(0, 1, At, B1); PG8_BAR; PG8_SCHED;
            PG8_LDA(At, 1, 1); PG8_STAGE(PG8_SB(1, 0), b3, voffB); PG8_STAGE(PG8_SB(1, 1), b3 + hstepB, voffB); PG8_STAGE(PG8_SA(1, 0), a3, voffA);
            PG8_WAIT_V(8); PG8_WAIT_L(0); PG8_BAR; PG8_MMA(1, 0, At, B0); PG8_MMA(1, 1, At, B1); PG8_BAR; PG8_SCHED;
            } else {
            PG8_LDB(B0, 0, 0); PG8_SCHED; PG8_LDA(At, 0, 0); PG8_STAGE(PG8_SA(1, 1), a1 + hstepA, voffA);
            PG8_WAIT_L(8); PG8_BAR; PG8_WAIT_L(0); PG8_MMA(0, 0, At, B0); PG8_BAR; PG8_SCHED;
            PG8_LDB(B1, 0, 1); PG8_STAGE(PG8_SB(0, 0), b2, voffB);
            PG8_BAR; PG8_WAIT_L(0); PG8_MMA(0, 1, At, B1); PG8_BAR;
            PG8_LDA(At, 0, 1); PG8_STAGE(PG8_SA(0, 0), a2, voffA);
            PG8_BAR; PG8_WAIT_L(0); PG8_MMA(1, 0, At, B0); PG8_BAR; PG8_SCHED;
            PG8_STAGE(PG8_SB(0, 1), b2 + hstepB, voffB);
            PG8_WAIT_V(6); PG8_BAR; PG8_MMA(1, 1, At, B1); PG8_BAR;
            PG8_LDB(B0, 1, 0); PG8_SCHED; PG8_LDA(At, 1, 0); PG8_STAGE(PG8_SA(0, 1), a2 + hstepA, voffA);
            PG8_WAIT_L(8); PG8_BAR; PG8_WAIT_L(0); PG8_MMA(0, 0, At, B0); PG8_BAR; PG8_SCHED;
            PG8_LDB(B1, 1, 1); PG8_STAGE(PG8_SB(1, 0), b3, voffB);
            PG8_BAR; PG8_WAIT_L(0); PG8_MMA(0, 1, At, B1); PG8_BAR;
            PG8_LDA(At, 1, 1); PG8_STAGE(PG8_SA(1, 0), a3, voffA);
            PG8_BAR; PG8_WAIT_L(0); PG8_MMA(1, 0, At, B0); PG8_BAR; PG8_SCHED;
            PG8_STAGE(PG8_SB(1, 1), b3 + hstepB, voffB);
            PG8_WAIT_V(6); PG8_BAR; PG8_MMA(1, 1, At, B1); PG8_BAR;
            }
        }
        if constexpr (ALIGN_EPI) { if (wr == 0) PG8_BAR; }
        if constexpr (!Epi::AFTER_DRAIN) { E(acc, cur, wr, wc, fr, fq); S.done(cur); }
        if (!has_next) break;
#pragma unroll
        for (int a = 0; a < 2; ++a)
#pragma unroll
            for (int b = 0; b < 2; ++b)
#pragma unroll
                for (int m = 0; m < 4; ++m)
#pragma unroll
                    for (int n = 0; n < 2; ++n) acc[a][b][m][n] = (f32x4){0.f, 0.f, 0.f, 0.f};
        cur = nxt; cA = nA; cB = nB; ++ui;
        if constexpr (ALIGN_EPI) { if (wr == 1) PG8_BAR; }
    }
    PG8_WAIT_V(0);
    if constexpr (!ALIGN_EPI) { if (wr == 0) PG8_BAR; }
    PG8_BAR;
    if constexpr (Epi::AFTER_DRAIN) { E.fused(acc, cur, wr, wc, fr, fq, lds, wid, lane); S.done(cur); }
#undef PG8_SA
#undef PG8_SB
#undef PG8_STAGE
#undef PG8_LDA
#undef PG8_LDB
#undef PG8_MMA
#undef PG8_WAIT_V
#undef PG8_WAIT_L
#undef PG8_BAR
#undef PG8_SCHED
}
}
#define PG8_SP2 true
#define PG8_ALIGN true
#define GAS __attribute__((address_space(1)))
#define LAS __attribute__((address_space(3)))
typedef unsigned short bf16;
typedef unsigned v4u __attribute__((ext_vector_type(4)));
typedef float f32x4 __attribute__((ext_vector_type(4)));
typedef short bf16x8 __attribute__((ext_vector_type(8)));
typedef GAS unsigned gu32;
typedef GAS unsigned long long gu64;
#define RLX_AGENT __ATOMIC_RELAXED, __HIP_MEMORY_SCOPE_AGENT
#define LDS_WAIT() asm volatile("s_waitcnt lgkmcnt(0)" ::: "memory")
#define VM_WAIT() asm volatile("s_waitcnt vmcnt(0)" ::: "memory")
__device__ __forceinline__ unsigned long long rt() { return __builtin_amdgcn_s_memrealtime(); }
__device__ __forceinline__ unsigned f2bf(float f) { unsigned u = __builtin_bit_cast(unsigned, f); return (u + 0x7fffu + ((u >> 16) & 1u)) >> 16; }
__device__ __forceinline__ unsigned pk2(float lo, float hi) { return f2bf(lo) | (f2bf(hi) << 16); }
#define XB_TMO      128
#define XB_XCNT(j)  (256  + 64 * (j))
#define XB_XSUB(j)  (1280 + 64 * (j))
#define XB_XGEN(j)  (2304 + 64 * (j))
#define XB_TOP      3328
#define XB_TOPGEN   3392
#define XCD_BAR_WORDS 3456
#define XB_SPIN_CAP (1u << 18)

__device__ __forceinline__ unsigned xb_ld(unsigned* p)              { return __hip_atomic_load(p, __ATOMIC_RELAXED, __HIP_MEMORY_SCOPE_AGENT); }
__device__ __forceinline__ unsigned xb_add(unsigned* p, unsigned v) { return __hip_atomic_fetch_add(p, v, __ATOMIC_RELAXED, __HIP_MEMORY_SCOPE_AGENT); }
__device__ __forceinline__ unsigned xb_xcc_id() { return (unsigned)__builtin_amdgcn_s_getreg((3 << 11) | 20) & 0xFu; }
#define XB_SPIN(cond, bar) do { unsigned _sp = 0; while (cond) { __builtin_amdgcn_s_sleep(1); \
    if ((++_sp & 255u) == 0u) { if (xb_ld(&(bar)[XB_TMO])) break; if (_sp > XB_SPIN_CAP) { atomicAdd(&(bar)[XB_TMO], 1u); break; } } } } while (0)

struct XcdBarrier {
    unsigned* bar; unsigned x;
    volatile LAS unsigned* st;
};

__device__ __forceinline__ XcdBarrier xcd_barrier_post(unsigned* bar, volatile LAS unsigned* st) {
    XcdBarrier b; b.bar = bar; b.x = xb_xcc_id(); b.st = st;
    if (threadIdx.x == 0) (void)xb_add(&bar[XB_XCNT(b.x)], 1u);
    return b;
}
__device__ __forceinline__ void xcd_barrier_complete(unsigned* bar, unsigned x, unsigned& nloc, unsigned& nx) {
    const unsigned G = gridDim.x * gridDim.y * gridDim.z;
    unsigned sum, cnt, mine, sp = 0u;
    for (;;) {
        sum = 0u; cnt = 0u; mine = 0u;
#pragma unroll
        for (unsigned j = 0; j < 16; ++j) { const unsigned c = xb_ld(&bar[XB_XCNT(j)]); sum += c; cnt += (c > 0u) ? 1u : 0u; mine = (j == x) ? c : mine; }
        if (sum == G) break;
        __builtin_amdgcn_s_sleep(1);
        if ((++sp & 255u) == 0u) { if (xb_ld(&bar[XB_TMO])) break; if (sp > XB_SPIN_CAP) { atomicAdd(&bar[XB_TMO], 1u); break; } }
    }
    nloc = mine > 0u ? mine : 1u; nx = cnt > 0u ? cnt : 1u;
}

__device__ __forceinline__ void xcd_barrier(const XcdBarrier& b) {
    asm volatile("s_waitcnt vmcnt(0)" ::: "memory");
    __syncthreads();
    if (threadIdx.x == 0) {
        unsigned* bar = b.bar;
        __builtin_amdgcn_s_waitcnt(0);
        unsigned nloc = b.st[0], nx = b.st[1];
        if (nloc == 0u) { xcd_barrier_complete(bar, b.x, nloc, nx); b.st[0] = nloc; b.st[1] = nx; }
        const unsigned old = xb_add(&bar[XB_XSUB(b.x)], 1u);
        const unsigned gen = old / nloc;
        if (old + 1u == (gen + 1u) * nloc) {
            __builtin_amdgcn_fence(__ATOMIC_RELEASE, "agent");
            asm volatile("s_waitcnt vmcnt(0)" ::: "memory");
            const unsigned og = xb_add(&bar[XB_TOP], 1u);
            const unsigned tg = og / nx;
            if (og + 1u == (tg + 1u) * nx) xb_add(&bar[XB_TOPGEN], 1u);
            else XB_SPIN(xb_ld(&bar[XB_TOPGEN]) == tg, bar);
            __builtin_amdgcn_fence(__ATOMIC_ACQUIRE, "agent");
            xb_add(&bar[XB_XGEN(b.x)], 1u);
            asm volatile("s_waitcnt vmcnt(0)" ::: "memory");
        } else {
            XB_SPIN(xb_ld(&bar[XB_XGEN(b.x)]) == gen, bar);
            __builtin_amdgcn_fence(__ATOMIC_ACQUIRE, "agent");
            asm volatile("s_waitcnt vmcnt(0)" ::: "memory");
        }
    }
    __syncthreads();
}
constexpr int NB = 4, SEQ = 4096, CTXL = 256, TPB = SEQ + CTXL, NROWS = NB * TPB, DM = 1024, NLAYER = 2, IN_COLS = 6816;
constexpr int NWAVES = 8, NTHREADS = NWAVES * 64;
constexpr float RMS_EPS = 1e-6f;
constexpr float LOG2E = 1.4426950408889634f;
constexpr float QSCALE64 = 0.125f * LOG2E;
constexpr float QSCALE96 = 0.10206207261596575f * LOG2E;
constexpr int ZS_P = 1792, ZC_CQ = 0, ZC_CKV = 256, ZC_KR = 384, ZC_SQ = 512, ZC_SK = 768, ZC_SV = 896, ZC_AQ = 1024, ZC_AK = 1280, ZC_AV = 1408, ZC_LRU = 1536;
constexpr int N1 = 2816;
constexpr int W1ROWS = N1 + 4096;
constexpr size_t MiB = 1u << 20;
constexpr size_t WS_CTL = 0, CTL_ZERO_BYTES = 64 * 1024;
constexpr size_t WS_MOD = 1 * MiB;
constexpr size_t WS_RHC = 1 * MiB + 256 * 1024, WS_RHS = WS_RHC + 512 * 1024;
constexpr size_t WS_RMC = WS_RHS + 512 * 1024, WS_RMS = WS_RMC + 256 * 1024;
constexpr size_t WS_CTX1 = 3 * MiB;
constexpr size_t WS_W = 8 * MiB, W_LAYER = 18 * MiB;
constexpr size_t WO_W1 = 0, WO_WB = 13 * MiB + 512 * 1024, WO_WO = WO_WB + 2 * MiB, WO_UQ = WO_WO + 2 * MiB, WO_UKV = WO_UQ + 256 * 1024;
constexpr size_t WS_H = 44 * MiB;
constexpr size_t WS_G = 78 * MiB;
constexpr size_t WS_S = 112 * MiB;
constexpr size_t WS_ZS = 112 * MiB;
constexpr size_t WS_MQ = 172 * MiB;
constexpr size_t WS_MKV = 189 * MiB;
constexpr size_t WS_MK = 206 * MiB;
constexpr size_t WS_U = 219 * MiB;
constexpr size_t WS_HF = 236 * MiB;
constexpr size_t WS_END = 253 * MiB;
static_assert(WS_H + (size_t)NROWS * 1024 * 2 <= WS_G && WS_G + (size_t)NROWS * 1024 * 2 <= WS_S && WS_S + (size_t)NROWS * 4096 * 2 <= 248 * MiB, "ws map");
static_assert(WS_ZS + (size_t)NROWS * ZS_P * 2 <= WS_MQ && WS_MK + (size_t)NROWS * 384 * 2 <= WS_U, "ws map 2");
static_assert(WO_UKV + 512 * 256 * 2 <= W_LAYER, "weights");
constexpr int CW_BAR = 1024;

constexpr int RING_OFF = 0, RING_BYTES = 131072, LDSCTL_OFF = RING_BYTES, MISC_OFF = LDSCTL_OFF + 320, LDS_BYTES = 147456;

typedef unsigned short bf16;
typedef unsigned u32x2 __attribute__((ext_vector_type(2)));
__device__ __forceinline__ float bf2f(bf16 v) { return __uint_as_float((unsigned)v << 16); }
__device__ __forceinline__ float wave_sum(float v) {
#pragma unroll
    for (int o = 1; o < 64; o <<= 1) v += __shfl_xor(v, o);
    return v; }
__device__ __forceinline__ float wave_max(float v) {
#pragma unroll
    for (int o = 1; o < 64; o <<= 1) v = fmaxf(v, __shfl_xor(v, o));
    return v; }
__device__ __forceinline__ float grp16_sum(float v) {
#pragma unroll
    for (int o = 1; o < 16; o <<= 1) v += __shfl_xor(v, o);
    return v; }

struct Args { const float* in[28]; float* out; unsigned char* ws; int ph_lo, ph_hi; };
enum { I_X = 0, I_C, I_CTX, I_CCTX, I_WMOD, I_BMOD, I_NORMW, I_WIN, I_CQN, I_CKVN, I_WUQ, I_WUKV, I_MQN, I_MKN, I_SQN, I_SKN, I_SINK, I_AQN, I_AKN,
       I_CONVW, I_CONVB, I_LWR, I_LBR, I_LWI, I_LBI, I_LAM, I_WBR, I_WOUT };

struct Frame {
    LAS unsigned char* lds; const float* const __attribute__((address_space(4)))* kin; unsigned char* ws; float* out;
    int tid, lane, wave, G, vcu, gw, NGW, z;
    __device__ __forceinline__ const float* in(int i) const { return kin[i]; }
};

__device__ __forceinline__ void xpose_item(const float* W, int ldn, int k0, int n0, bf16* WT, int pd, int drow, LAS float* scr, int lane) {
#pragma unroll 8
    for (int i = 0; i < 32; ++i) { const int kk = 2 * i + (lane >> 5); scr[kk * 33 + (lane & 31)] = W[(size_t)(k0 + kk) * ldn + n0 + (lane & 31)]; }
    LDS_WAIT(); asm volatile("" ::: "memory");
    const int c = lane & 7;
#pragma unroll
    for (int j = 0; j < 4; ++j) { const int n = (lane >> 3) + 8 * j; const LAS float* s = scr + (8 * c) * 33 + n;
        v4u o; o.x = pk2(s[0 * 33], s[1 * 33]); o.y = pk2(s[2 * 33], s[3 * 33]); o.z = pk2(s[4 * 33], s[5 * 33]); o.w = pk2(s[6 * 33], s[7 * 33]);
        *(GAS v4u*)(WT + (size_t)(drow + n0 + n) * pd + k0 + 8 * c) = o; }
    LDS_WAIT(); asm volatile("" ::: "memory");
}
__device__ __forceinline__ void zero16(bf16* p, size_t n16, int gt, int ngt) {
    for (size_t i = gt; i < n16; i += ngt) ((GAS v4u*)p)[i] = (v4u){0u, 0u, 0u, 0u};
}
__device__ __forceinline__ void p0_prologue(Frame& F) {
    LAS float* scr = (LAS float*)(F.lds + RING_OFF + F.wave * 16384);
    constexpr int I_IN = 16 * 213, I_UQ = 4 * 12, I_UKV = 2 * 16, I_BR = 4 * 4 * 32, I_OUT = 16 * 32, I_LAYER = I_IN + I_UQ + I_UKV + I_BR + I_OUT;
    for (int it = F.gw; it < NLAYER * I_LAYER; it += F.NGW) {
        const int l = it / I_LAYER; int r = it % I_LAYER;
        unsigned char* wl = F.ws + WS_W + (size_t)l * W_LAYER;
        if (r < I_IN) { const int kb = r / 213, nb = r % 213, n0 = nb * 32;
            xpose_item(F.in(I_WIN) + (size_t)l * 1024 * IN_COLS, IN_COLS, kb * 64, n0, (bf16*)(wl + WO_W1), 1024, n0 >= 416 ? 96 : 0, scr, F.lane); continue; } r -= I_IN;
        if (r < I_UQ) { const int kb = r / 12, nb = r % 12;
            xpose_item(F.in(I_WUQ) + (size_t)l * 256 * 384, 384, kb * 64, nb * 32, (bf16*)(wl + WO_UQ), 256, 0, scr, F.lane); continue; } r -= I_UQ;
        if (r < I_UKV) { const int kb = r / 16, nb = r % 16;
            xpose_item(F.in(I_WUKV) + (size_t)l * 128 * 512, 512, kb * 64, nb * 32, (bf16*)(wl + WO_UKV), 256, 0, scr, F.lane); continue; } r -= I_UKV;
        if (r < I_BR) { const int k = r / 128, rr = r % 128, kb = rr / 32, nb = rr % 32;
            xpose_item(F.in(I_WBR) + ((size_t)l * 4 + k) * 256 * 1024, 1024, kb * 64, nb * 32, (bf16*)(wl + WO_WB) + (size_t)k * 1024 * 256, 256, 0, scr, F.lane); continue; } r -= I_BR;
        { const int kb = r / 32, nb = r % 32;
            xpose_item(F.in(I_WOUT) + (size_t)l * 1024 * 1024, 1024, kb * 64, nb * 32, (bf16*)(wl + WO_WO), 1024, 0, scr, F.lane); }
    }
    const int gt = F.vcu * NTHREADS + F.tid, ngt = F.G * NTHREADS;
    for (int l = 0; l < NLAYER; ++l) {
        unsigned char* wl = F.ws + WS_W + (size_t)l * W_LAYER;
        zero16((bf16*)(wl + WO_W1) + (size_t)416 * 1024, 96 * 1024 * 2 / 16, gt, ngt);
        zero16((bf16*)(wl + WO_UQ) + (size_t)384 * 256, 128 * 256 * 2 / 16, gt, ngt);
        for (int i = gt; i < 512 * 16; i += ngt) { const int n = i >> 4, c = i & 15; ((GAS v4u*)((bf16*)(wl + WO_UKV) + (size_t)n * 256 + 128))[c] = (v4u){0u, 0u, 0u, 0u}; }
    }
    { float* rhc = (float*)(F.ws + WS_RHC); float* rhs = (float*)(F.ws + WS_RHS); float* rmc = (float*)(F.ws + WS_RMC); float* rms = (float*)(F.ws + WS_RMS);
      for (int i = gt; i < 4096 * 32; i += ngt) { const int t = i >> 5, p = i & 31; const float fr = powf(10000.0f, -(float)(p & 15) / 16.0f);
          const float pos = (float)((p < 16) ? (t >> 6) : (t & 63)); const float ang = pos * fr; rhc[i] = cosf(ang); rhs[i] = sinf(ang); }
      for (int i = gt; i < 4096 * 16; i += ngt) { const int t = i >> 4, p = i & 15; const float fr = powf(10000.0f, -(float)(p & 7) / 8.0f);
          const float pos = (float)((p < 8) ? (t >> 6) : (t & 63)); const float ang = pos * fr; rmc[i] = cosf(ang); rms[i] = sinf(ang); } }
    { LAS float* sc = (LAS float*)(F.lds + RING_OFF);
      LAS float* red = sc + 5 * 1024;
      __syncthreads();
      for (int i = F.tid; i < 5 * 1024; i += NTHREADS) { const float v = (i < 4096) ? F.in(I_C)[i] : F.in(I_CCTX)[i - 4096]; sc[i] = v / (1.0f + expf(-v)); }
      __syncthreads();
      float* modv = (float*)(F.ws + WS_MOD);
      for (int it = F.vcu; it < NLAYER * 96; it += F.G) {
          const int l = it / 96, n0 = (it % 96) * 32, nn = F.tid & 31, kc = F.tid >> 5;
          const float* w = F.in(I_WMOD) + (size_t)l * 1024 * 3072 + n0 + nn;
          float acc[5] = {0.f, 0.f, 0.f, 0.f, 0.f};
          for (int k = kc * 64; k < kc * 64 + 64; ++k) { const float wv = w[(size_t)k * 3072];
#pragma unroll
              for (int r = 0; r < 5; ++r) acc[r] += sc[r * 1024 + k] * wv; }
#pragma unroll
          for (int r = 0; r < 5; ++r) red[(kc * 5 + r) * 32 + nn] = acc[r];
          __syncthreads();
          if (F.tid < 160) { const int r = F.tid >> 5; float s = 0.f;
              for (int q = 0; q < 16; ++q) s += red[(q * 5 + r) * 32 + nn];
              modv[((size_t)l * 5 + r) * 3072 + n0 + nn] = s + F.in(I_BMOD)[l * 3072 + n0 + nn]; }
          __syncthreads();
      } }
}

__device__ __forceinline__ void ph_hnorm(Frame& F, int l) {
    const float* xs = (l == 0) ? F.in(I_X) : F.out; const float* cs = (l == 0) ? F.in(I_CTX) : (const float*)(F.ws + WS_CTX1);
    const float* nw = F.in(I_NORMW) + l * 1024; const float* modl = (const float*)(F.ws + WS_MOD) + (size_t)l * 5 * 3072;
    bf16* H = (bf16*)(F.ws + WS_H);
    for (int row = F.gw; row < NROWS; row += F.NGW) {
        const int b = row / TPB, j = row % TPB; const float* src; int mr;
        if (j < CTXL) { src = cs + ((size_t)b * CTXL + j) * 1024; mr = 4; } else { src = xs + ((size_t)b * SEQ + (j - CTXL)) * 1024; mr = b; }
        const GAS f32x4* xr = (const GAS f32x4*)src + F.lane;
        f32x4 v[4]; float ss = 0.f;
#pragma unroll
        for (int q = 0; q < 4; ++q) { v[q] = xr[64 * q]; ss += (v[q].x * v[q].x + v[q].y * v[q].y) + (v[q].z * v[q].z + v[q].w * v[q].w); }
        const float rstd = 1.0f / sqrtf(wave_sum(ss) * (1.0f / 1024.0f) + RMS_EPS);
        const float* mrow = modl + mr * 3072;
        GAS unsigned long long* o8 = (GAS unsigned long long*)(H + (size_t)row * 1024) + F.lane;
#pragma unroll
        for (int q = 0; q < 4; ++q) { const int c = 4 * F.lane + 256 * q;
            const f32x4 g = *(const f32x4*)(nw + c), sh = *(const f32x4*)(mrow + c), sc = *(const f32x4*)(mrow + 1024 + c);
            const f32x4 h = v[q] * rstd * g * (sc + 1.0f) + sh;
            o8[64 * q] = (unsigned long long)pk2(h.x, h.y) | ((unsigned long long)pk2(h.z, h.w) << 32); }
    }
}

__device__ __forceinline__ void head_norm_rope(bf16* hp, const float* gain, bool rope, const float* rc, const float* rs, float scale, int lane) {
    const int p0 = (lane & 15) * 2;
    const unsigned w1 = *(const unsigned*)(hp + p0), w2 = *(const unsigned*)(hp + 32 + p0);
    float a0 = bflo(w1), a1 = bfhi(w1), b0 = bflo(w2), b1 = bfhi(w2);
    const float ss = grp16_sum(a0 * a0 + a1 * a1 + b0 * b0 + b1 * b1);
    const float rstd = 1.0f / sqrtf(ss * (1.0f / 64.0f) + RMS_EPS);
    a0 *= rstd * gain[p0]; a1 *= rstd * gain[p0 + 1]; b0 *= rstd * gain[32 + p0]; b1 *= rstd * gain[33 + p0];
    if (rope) { const float c0 = rc[p0], c1 = rc[p0 + 1], s0 = rs[p0], s1 = rs[p0 + 1];
        const float x0 = a0 * c0 - b0 * s0, y0 = b0 * c0 + a0 * s0, x1 = a1 * c1 - b1 * s1, y1 = b1 * c1 + a1 * s1; a0 = x0; b0 = y0; a1 = x1; b1 = y1; }
    *(unsigned*)(hp + p0) = pk2(a0 * scale, a1 * scale); *(unsigned*)(hp + 32 + p0) = pk2(b0 * scale, b1 * scale);
}
__device__ __forceinline__ void ph_post1(Frame& F, int l) {
    bf16* ZS = (bf16*)(F.ws + WS_ZS);
    const float* rhc = (const float*)(F.ws + WS_RHC); const float* rhs = (const float*)(F.ws + WS_RHS);
    for (int row = F.gw; row < NROWS; row += F.NGW) {
        const int j = row % TPB; const bool lat = j >= CTXL; const int pos = lat ? j - CTXL : 0;
        bf16* z = ZS + (size_t)row * ZS_P; const int lane = F.lane;
        { u32x2 w = *(const u32x2*)(z + ZC_CQ + 4 * lane); float v0 = bflo(w.x), v1 = bfhi(w.x), v2 = bflo(w.y), v3 = bfhi(w.y);
          const float rstd = 1.0f / sqrtf(wave_sum(v0 * v0 + v1 * v1 + v2 * v2 + v3 * v3) * (1.0f / 256.0f) + RMS_EPS);
          const float* g = F.in(I_CQN) + l * 256 + 4 * lane;
          w.x = pk2(v0 * rstd * g[0], v1 * rstd * g[1]); w.y = pk2(v2 * rstd * g[2], v3 * rstd * g[3]); *(u32x2*)(z + ZC_CQ + 4 * lane) = w; }
        { unsigned w = *(const unsigned*)(z + ZC_CKV + 2 * lane); float v0 = bflo(w), v1 = bfhi(w);
          const float rstd = 1.0f / sqrtf(wave_sum(v0 * v0 + v1 * v1) * (1.0f / 128.0f) + RMS_EPS);
          const float* g = F.in(I_CKVN) + l * 128 + 2 * lane;
          *(unsigned*)(z + ZC_CKV + 2 * lane) = pk2(v0 * rstd * g[0], v1 * rstd * g[1]); }
        const int hg = lane >> 4; const float* rc = rhc + pos * 32; const float* rs = rhs + pos * 32;
        head_norm_rope(z + ZC_SQ + hg * 64, F.in(I_SQN) + l * 64, lat, rc, rs, QSCALE64, lane);
        head_norm_rope(z + ZC_AQ + hg * 64, F.in(I_AQN) + l * 64, lat, rc, rs, QSCALE64, lane);
        head_norm_rope(z + ((hg < 2) ? (ZC_SK + hg * 64) : (ZC_AK + (hg - 2) * 64)), ((hg < 2) ? F.in(I_SKN) : F.in(I_AKN)) + l * 64, lat, rc, rs, 1.0f, lane);
    }
}
__device__ __forceinline__ void ph_post2(Frame& F, int l) {
    const bf16* ZS = (const bf16*)(F.ws + WS_ZS); bf16* MQ = (bf16*)(F.ws + WS_MQ); const bf16* MKV = (const bf16*)(F.ws + WS_MKV); bf16* MK = (bf16*)(F.ws + WS_MK);
    const float* rmc = (const float*)(F.ws + WS_RMC); const float* rms = (const float*)(F.ws + WS_RMS);
    const float* gq = F.in(I_MQN) + l * 96; const float* gk = F.in(I_MKN) + l * 96;
    for (int row = F.gw; row < NROWS; row += F.NGW) {
        const int j = row % TPB; const bool lat = j >= CTXL; const int pos = lat ? j - CTXL : 0; const int lane = F.lane;
        const float* rc = rmc + pos * 16; const float* rs = rms + pos * 16;
        const bf16* z = ZS + (size_t)row * ZS_P;
#pragma unroll 1
        for (int h = 0; h < 4; ++h) {
#pragma unroll
            for (int qk = 0; qk < 2; ++qk) {
                float v0 = 0.f, v1 = 0.f; const int p = lane - 32;
                if (qk == 0) { bf16* q = MQ + (size_t)row * 512 + h * 96;
                    if (lane < 32) { const unsigned w = *(const unsigned*)(q + 2 * lane); v0 = bflo(w); v1 = bfhi(w); }
                    else if (lane < 48) { v0 = bf2f(q[64 + p]); v1 = bf2f(q[80 + p]); } }
                else { if (lane < 32) { const unsigned w = *(const unsigned*)(MKV + (size_t)row * 512 + h * 128 + 2 * lane); v0 = bflo(w); v1 = bfhi(w); }
                    else if (lane < 48) { v0 = bf2f(z[ZC_KR + p]); v1 = bf2f(z[ZC_KR + 16 + p]); } }
                const float rstd = 1.0f / sqrtf(wave_sum(v0 * v0 + v1 * v1) * (1.0f / 96.0f) + RMS_EPS);
                const float* g = qk == 0 ? gq : gk; const float scale = qk == 0 ? QSCALE96 : 1.0f;
                bf16* o = qk == 0 ? (MQ + (size_t)row * 512 + h * 96) : (MK + (size_t)row * 384 + h * 96);
                if (lane < 32) { *(unsigned*)(o + 2 * lane) = pk2(v0 * rstd * g[2 * lane] * scale, v1 * rstd * g[2 * lane + 1] * scale); }
                else if (lane < 48) { float y1 = v0 * rstd * g[64 + p], y2 = v1 * rstd * g[80 + p];
                    if (lat) { const float c = rc[p], s = rs[p]; const float t1 = y1 * c - y2 * s, t2 = y2 * c + y1 * s; y1 = t1; y2 = t2; }
                    o[64 + p] = (bf16)f2bf(y1 * scale); o[80 + p] = (bf16)f2bf(y2 * scale); }
            }
        }
    }
}

template <int DQK>
__device__ __forceinline__ void attn_row_naive(const bf16* q, const bf16* Kb, int kp, const bf16* Vb, int vp, int n1, int lo2, int hi2, bool has_sink, float sink2, bf16* y, int lane) {
    float qf[DQK];
#pragma unroll
    for (int c = 0; c < DQK / 8; ++c) { const v4u w = *(const v4u*)(q + 8 * c);
        qf[8 * c + 0] = bflo(w.x); qf[8 * c + 1] = bfhi(w.x); qf[8 * c + 2] = bflo(w.y); qf[8 * c + 3] = bfhi(w.y); qf[8 * c + 4] = bflo(w.z); qf[8 * c + 5] = bfhi(w.z); qf[8 * c + 6] = bflo(w.w); qf[8 * c + 7] = bfhi(w.w); }
    float m = -INFINITY, l = 0.f; float acc[64];
#pragma unroll
    for (int d = 0; d < 64; ++d) acc[d] = 0.f;
    for (int seg = 0; seg < 2; ++seg) {
        const int k0 = seg == 0 ? 0 : lo2, k1 = seg == 0 ? n1 : hi2;
        for (int key = k0 + lane; key < k1; key += 64) {
            const bf16* kr = Kb + (size_t)key * kp; float s = 0.f;
#pragma unroll
            for (int c = 0; c < DQK / 8; ++c) { const v4u w = *(const v4u*)(kr + 8 * c);
                s += qf[8 * c + 0] * bflo(w.x) + qf[8 * c + 1] * bfhi(w.x) + qf[8 * c + 2] * bflo(w.y) + qf[8 * c + 3] * bfhi(w.y) + qf[8 * c + 4] * bflo(w.z) + qf[8 * c + 5] * bfhi(w.z) + qf[8 * c + 6] * bflo(w.w) + qf[8 * c + 7] * bfhi(w.w); }
            if (s > m) { const float f = exp2f(m - s); l *= f;
#pragma unroll
                for (int d = 0; d < 64; ++d) acc[d] *= f;
                m = s; }
            const float p = exp2f(s - m); l += p;
            const bf16* vr = Vb + (size_t)key * vp;
#pragma unroll
            for (int c = 0; c < 8; ++c) { const v4u w = *(const v4u*)(vr + 8 * c);
                acc[8 * c + 0] += p * bflo(w.x); acc[8 * c + 1] += p * bfhi(w.x); acc[8 * c + 2] += p * bflo(w.y); acc[8 * c + 3] += p * bfhi(w.y); acc[8 * c + 4] += p * bflo(w.z); acc[8 * c + 5] += p * bfhi(w.z); acc[8 * c + 6] += p * bflo(w.w); acc[8 * c + 7] += p * bfhi(w.w); }
        }
    }
    float M = wave_max(m); if (has_sink) M = fmaxf(M, sink2);
    const float f = (m == -INFINITY) ? 0.f : exp2f(m - M);
    float L = wave_sum(l * f); if (has_sink) L += exp2f(sink2 - M);
    float mine = 0.f;
#pragma unroll
    for (int d = 0; d < 64; ++d) { const float t = wave_sum(acc[d] * f); if (lane == d) mine = t; }
    y[lane] = (bf16)f2bf(mine / L * bf2f(y[lane]));
}
__device__ __forceinline__ void ph_attn_naive(Frame& F, int l) {
    const bf16* ZS = (const bf16*)(F.ws + WS_ZS); const bf16* MQ = (const bf16*)(F.ws + WS_MQ); const bf16* MKV = (const bf16*)(F.ws + WS_MKV); const bf16* MK = (const bf16*)(F.ws + WS_MK);
    bf16* Y = (bf16*)(F.ws + WS_G);
    const long nitems = (long)NROWS * 12;
    for (long it = F.gw; it < nitems; it += F.NGW) {
        const int hb = (int)(it % 12); const int row = (int)(it / 12);
        const int b = row / TPB, j = row % TPB; const bool lat = j >= CTXL;
        if (!lat && l == NLAYER - 1) continue;
        const size_t r0 = (size_t)b * TPB;
        const int br = hb >> 2, h = hb & 3;
        bf16* y = Y + (size_t)row * 1024 + br * 256 + h * 64;
        if (br == 0) {
            attn_row_naive<96>(MQ + (size_t)row * 512 + h * 96, MK + r0 * 384 + h * 96, 384, MKV + r0 * 512 + h * 128 + 64, 512, CTXL, CTXL, lat ? TPB : CTXL, false, 0.f, y, F.lane);
        } else if (br == 1) {
            const int t = j - CTXL; int lo = CTXL, hi = CTXL;
            if (lat) { lo = CTXL + (t - 128 < 0 ? 0 : t - 128); hi = CTXL + (t + 128 > SEQ - 1 ? SEQ - 1 : t + 128) + 1; }
            attn_row_naive<64>(ZS + (size_t)row * ZS_P + ZC_SQ + h * 64, ZS + r0 * ZS_P + ZC_SK + (h >> 1) * 64, ZS_P, ZS + r0 * ZS_P + ZC_SV + (h >> 1) * 64, ZS_P, CTXL, lo, hi, true, F.in(I_SINK)[l * 4 + h] * LOG2E, y, F.lane);
        } else {
            attn_row_naive<64>(ZS + (size_t)row * ZS_P + ZC_AQ + h * 64, ZS + r0 * ZS_P + ZC_AK + (h >> 1) * 64, ZS_P, ZS + r0 * ZS_P + ZC_AV + (h >> 1) * 64, ZS_P, CTXL, CTXL, lat ? TPB : CTXL, false, 0.f, y, F.lane);
        }
    }
}

__device__ __forceinline__ void ph_lru_conv(Frame& F, int l) {
    const bf16* ZS = (const bf16*)(F.ws + WS_ZS); float* U = (float*)(F.ws + WS_U);
    const float* cw = F.in(I_CONVW) + l * 4 * 256; const float* cb = F.in(I_CONVB) + l * 256;
    const int gt = F.vcu * NTHREADS + F.tid, ngt = F.G * NTHREADS;
    for (int idx = gt; idx < NROWS * 256; idx += ngt) {
        const int row = idx >> 8, c = idx & 255, b = row / TPB, j = row % TPB;
        int s0, len, jj; if (j < CTXL) { s0 = b * TPB; len = CTXL; jj = j; } else { s0 = b * TPB + CTXL; len = SEQ; jj = j - CTXL; }
        float acc = cb[c];
#pragma unroll
        for (int i = 0; i < 4; ++i) { const int t = jj + i - 2; if (t >= 0 && t < len) acc += cw[i * 256 + c] * bf2f(ZS[(size_t)(s0 + t) * ZS_P + ZC_LRU + c]); }
        U[idx] = acc;
    }
}
__device__ __forceinline__ void ph_lru_scan(Frame& F, int l, int dir) {
    const float* U = (const float*)(F.ws + WS_U); float* HF = (float*)(F.ws + WS_HF); bf16* Y = (bf16*)(F.ws + WS_G);
    const int g = blockIdx.x * NTHREADS + F.tid;
    if (g < NB * 256) {
    const int b = g >> 8, c = g & 255, k = c >> 6, jc = c & 63;
    const float* wr = F.in(I_LWR) + ((((size_t)l * 2 + dir) * 4 + k) * 64) * 64 + jc;
    const float* wi = F.in(I_LWI) + ((((size_t)l * 2 + dir) * 4 + k) * 64) * 64 + jc;
    float wrr[64], wii[64];
#pragma unroll
    for (int i = 0; i < 64; ++i) { wrr[i] = wr[i * 64]; wii[i] = wi[i * 64]; }
    const float br = F.in(I_LBR)[(l * 2 + dir) * 256 + c], bi = F.in(I_LBI)[(l * 2 + dir) * 256 + c];
    const float lam = F.in(I_LAM)[(l * 2 + dir) * 256 + c];
    const float sp = log1pf(expf(-lam));
    float h = 0.f;
    for (int s = 0; s < TPB; ++s) {
        const int j = dir == 0 ? s : (s < CTXL ? CTXL - 1 - s : TPB + CTXL - 1 - s);
        const size_t row = (size_t)b * TPB + j;
        const float* ub = U + row * 256 + k * 64;
        float rp = br, ip = bi;
#pragma unroll
        for (int i = 0; i < 64; ++i) { const float uv = ub[i]; rp += uv * wrr[i]; ip += uv * wii[i]; }
        const float r = 1.0f / (1.0f + expf(-rp)), ig = 1.0f / (1.0f + expf(-ip));
        const float la = -8.0f * r * sp; const float a = expf(la);
        const float bx = sqrtf(-expm1f(2.0f * la)) * (ig * ub[jc]);
        h = a * h + bx;
        if (dir == 0) HF[row * 256 + c] = h;
        else { bf16* y = Y + row * 1024 + 768 + c; *y = (bf16)f2bf((HF[row * 256 + c] + h) * bf2f(*y)); }
    }
    }
}
__device__ __forceinline__ void ph_mixsum(Frame& F) {
    const bf16* S = (const bf16*)(F.ws + WS_S); bf16* MIX = (bf16*)(F.ws + WS_H);
    const int gt = F.vcu * NTHREADS + F.tid, ngt = F.G * NTHREADS;
    for (int idx = gt; idx < NROWS * 128; idx += ngt) {
        const int row = idx >> 7, c8 = (idx & 127) * 8; float s[8] = {0.f, 0.f, 0.f, 0.f, 0.f, 0.f, 0.f, 0.f};
#pragma unroll
        for (int k = 0; k < 4; ++k) { const v4u w = *(const GAS v4u*)(S + (size_t)row * 4096 + k * 1024 + c8);
            s[0] += bflo(w.x); s[1] += bfhi(w.x); s[2] += bflo(w.y); s[3] += bfhi(w.y); s[4] += bflo(w.z); s[5] += bfhi(w.z); s[6] += bflo(w.w); s[7] += bfhi(w.w); }
        v4u o; o.x = pk2(s[0], s[1]); o.y = pk2(s[2], s[3]); o.z = pk2(s[4], s[5]); o.w = pk2(s[6], s[7]);
        *(GAS v4u*)(MIX + (size_t)row * 1024 + c8) = o;
    }
}
constexpr int NPL = 13;
enum { PH_H = 0, PH_G1, PH_POST1, PH_G2, PH_POST2, PH_ATT, PH_LRUC, PH_LRUF, PH_LRUB, PH_SG, PH_PG, PH_MIX, PH_OG };
constexpr int NPHASES = 1 + NLAYER * NPL;
#ifndef PHMASK
#define PHMASK 16383
#endif
#ifndef MK_ONE_LAUNCH
#define MK_ONE_LAUNCH 1
#endif

__global__ void __launch_bounds__(NTHREADS, 2) fwd_kernel(Args args) {
    extern __shared__ __attribute__((aligned(16))) unsigned char lds_raw[];
    { LAS unsigned char* l0 = (LAS unsigned char*)lds_raw;
      for (int u = threadIdx.x; u < (LDS_BYTES - LDSCTL_OFF) / 4; u += NTHREADS) ((LAS unsigned*)(l0 + LDSCTL_OFF))[u] = 0u;
      __syncthreads();
      if (args.ph_hi - args.ph_lo > 1) (void)xcd_barrier_post((unsigned*)((gu32*)(args.ws + WS_CTL) + CW_BAR), (volatile LAS unsigned*)(l0 + MISC_OFF) + 8); }

    for (int ph = args.ph_lo; ph < args.ph_hi; ++ph) {
        int z; asm volatile("s_mov_b32 %0, 0" : "=s"(z));
        Frame F;
        F.lds = (LAS unsigned char*)lds_raw + z; F.kin = (const float* const __attribute__((address_space(4)))*)((const __attribute__((address_space(4))) char*)__builtin_amdgcn_kernarg_segment_ptr() + z); F.ws = args.ws + z; F.out = args.out + z; F.z = z;
        F.tid = threadIdx.x + z; F.lane = F.tid & 63; F.wave = __builtin_amdgcn_readfirstlane(F.tid >> 6);
        F.G = gridDim.x + z; { const int bx = blockIdx.x + z; F.vcu = (F.G % 8 == 0) ? (bx % 8) * (F.G / 8) + bx / 8 : bx; }
        F.gw = F.vcu * NWAVES + F.wave; F.NGW = F.G * NWAVES;
        bool is_gemm = false;
        pg8::Gemm g{nullptr, nullptr, NROWS, 256, 1024, 1024, 31, 0};
        pg8::Order S; S.init(1, 1, F.G, (int)blockIdx.x + z, 0);
        pg8::EpiU E{pg8::EM_PLAIN, 0, F.ws, nullptr, nullptr, nullptr, 0, 0, 0, 0, 1 << 20};
        if (ph == 0) { if (PHMASK & 8192) p0_prologue(F); }
        else {
            const int l = (ph - 1) / NPL, p = (ph - 1) % NPL;
            unsigned char* wl = F.ws + WS_W + (size_t)l * W_LAYER;
            const bool last = (l == NLAYER - 1);
            const int nMc = last ? 64 : NROWS / 256, lat = last ? 1 : 0;
            E.l = l;
            if (p == PH_H && (PHMASK & 1)) { ph_hnorm(F, l); }
            else if (p == PH_G1 && (PHMASK & 2)) {
                is_gemm = true; g.A = (const bf16*)(F.ws + WS_H); g.Bt = (const bf16*)(wl + WO_W1); g.N = N1; g.K = 1024; g.lda = 1024;
                S.init(NROWS / 256, N1 / 256, F.G, (int)blockIdx.x + z, 0);
                E.mode = pg8::EM_SILU2; E.oA = WS_ZS; E.ldc = ZS_P; E.oB = WS_G; E.ldc2 = 1024; E.split_tile = 7;
            }
            else if (p == PH_POST1 && (PHMASK & 4)) { ph_post1(F, l); }
            else if (p == PH_G2 && (PHMASK & 8)) {
                is_gemm = true; g.A = (const bf16*)(F.ws + WS_ZS); g.Bt = (const bf16*)(wl + WO_UQ); g.N = 1024; g.K = 256; g.lda = ZS_P; g.a_shift = 1; g.a_step = 512;
                S.init(NROWS / 256, 4, F.G, (int)blockIdx.x + z, 0);
                E.mode = pg8::EM_PLAIN; E.oA = WS_MQ; E.ldc = 512; E.oB = WS_MKV; E.ldc2 = 512; E.split_tile = 2;
            }
            else if (p == PH_POST2 && (PHMASK & 16)) { ph_post2(F, l); }
            else if (p == PH_ATT && (PHMASK & 32)) { ph_attn_naive(F, l); }
            else if (p == PH_LRUC && (PHMASK & 64)) { ph_lru_conv(F, l); }
            else if (p == PH_LRUF && (PHMASK & 128)) { ph_lru_scan(F, l, 0); }
            else if (p == PH_LRUB && (PHMASK & 256)) { ph_lru_scan(F, l, 1); }
            else if (p == PH_SG && (PHMASK & 512)) {
                is_gemm = true; g.A = (const bf16*)(F.ws + WS_H); g.Bt = (const bf16*)(wl + WO_W1) + (size_t)N1 * 1024; g.N = 4096; g.K = 1024; g.lda = 1024;
                S.init(nMc, 16, F.G, (int)blockIdx.x + z, lat);
                E.mode = pg8::EM_SIG; E.oA = WS_S; E.ldc = 4096;
            }
            else if (p == PH_PG && (PHMASK & 1024)) {
                is_gemm = true; g.A = (const bf16*)(F.ws + WS_G); g.Bt = (const bf16*)(wl + WO_WB); g.N = 4096; g.K = 256; g.lda = 1024; g.a_shift = 2; g.a_step = 512;
                S.init(nMc, 16, F.G, (int)blockIdx.x + z, lat);
                E.mode = pg8::EM_MUL; E.oA = WS_S; E.ldc = 4096;
            }
            else if (p == PH_MIX && (PHMASK & 2048)) { ph_mixsum(F); }
            else if (p == PH_OG && (PHMASK & 4096)) {
                is_gemm = true; g.A = (const bf16*)(F.ws + WS_H); g.Bt = (const bf16*)(wl + WO_WO); g.N = 1024; g.K = 1024; g.lda = 1024;
                S.init(nMc, 4, F.G, (int)blockIdx.x + z, lat);
                E.mode = pg8::EM_RES; E.xin = (l == 0) ? F.in(I_X) : (const float*)F.out; E.xout = F.out; E.cin0 = F.in(I_CTX); E.oA = WS_MOD; E.oB = WS_CTX1;
            }
        }
        if (is_gemm) pg8::gemm_phase<pg8::EpiU, pg8::Order, true, true>(F.lds + RING_OFF, g, S, E, F.tid);
        if (ph + 1 < args.ph_hi) {
            int z2; asm volatile("s_mov_b32 %0, 0" : "=s"(z2));
            XcdBarrier bar; bar.bar = (unsigned*)((gu32*)(args.ws + z2 + WS_CTL) + CW_BAR); bar.x = xb_xcc_id(); bar.st = (volatile LAS unsigned*)((LAS unsigned char*)lds_raw + z2 + MISC_OFF) + 8;
            xcd_barrier(bar);
        }
    }
}

extern "C" void kernel_launch(void* const* d_in, const int* in_sizes, int n_in, void* d_out, int out_size, void* d_ws, size_t ws_size, hipStream_t stream) {
    static int grid = 0;
    if (grid == 0) {
        if (n_in != 28 || out_size != NB * SEQ * DM || ws_size < WS_END) { fprintf(stderr, "kernel_launch: unexpected shapes (n_in %d out %d ws %zu); nothing launched\n", n_in, out_size, ws_size); grid = -1; return; }
        int dev = 0, cus = 0, per_cu = 0;
        if (hipGetDevice(&dev) != hipSuccess || hipDeviceGetAttribute(&cus, hipDeviceAttributeMultiprocessorCount, dev) != hipSuccess) { grid = -1; return; }
        if (hipFuncSetAttribute((const void*)fwd_kernel, hipFuncAttributeMaxDynamicSharedMemorySize, LDS_BYTES) != hipSuccess) { fprintf(stderr, "kernel_launch: hipFuncSetAttribute failed\n"); grid = -1; return; }
        if (hipOccupancyMaxActiveBlocksPerMultiprocessor(&per_cu, (const void*)fwd_kernel, NTHREADS, LDS_BYTES) != hipSuccess || per_cu < 1) { fprintf(stderr, "kernel_launch: occupancy query says %d\n", per_cu); (void)hipGetLastError(); grid = -1; return; }
        grid = cus;
    }
    if (grid < 0) return;
    (void)hipMemsetAsync((char*)d_ws + WS_CTL, 0, CTL_ZERO_BYTES, stream);
    Args a{};
    for (int i = 0; i < 28; ++i) a.in[i] = (const float*)d_in[i];
    a.out = (float*)d_out; a.ws = (unsigned char*)d_ws;
#if MK_ONE_LAUNCH
    a.ph_lo = 0; a.ph_hi = NPHASES;
    hipLaunchKernelGGL(fwd_kernel, dim3(grid), dim3(NTHREADS), LDS_BYTES, stream, a);
#else
    for (int ph = 0; ph < NPHASES; ++ph) { a.ph_lo = ph; a.ph_hi = ph + 1; hipLaunchKernelGGL(fwd_kernel, dim3(grid), dim3(NTHREADS), LDS_BYTES, stream, a); }
#endif
}
```

```cpp
#include <hip/hip_runtime.h>
#include <cstdio>
#include <cstdint>
#include <cmath>
__device__ __forceinline__ float bflo(unsigned w) { return __uint_as_float(w << 16); }
__device__ __forceinline__ float bfhi(unsigned w) { return __uint_as_float(w & 0xffff0000u); }
__device__ __forceinline__ float sigmoid_f(float v) { return __builtin_amdgcn_rcpf(1.0f + __builtin_amdgcn_exp2f(-1.4426950408889634f * v)); }
namespace pg8 {
#define PG8_LAS __attribute__((address_space(3)))
typedef unsigned short bf16_t;
typedef short bf16x8 __attribute__((ext_vector_type(8)));
typedef float f32x4 __attribute__((ext_vector_type(4)));
typedef unsigned u32x4 __attribute__((ext_vector_type(4)));
constexpr int BM = 256, BK = 64, HALF = 128, HTB = HALF * BK * 2  , STAGE_BYTES = 8 * HTB, NXCD = 8, WGM = 8;

__host__ __device__ __forceinline__ int lds_byte(int r, int c) { const int st = (r >> 4) * 2 + (c >> 5), rr = r & 15, cc = c & 31, ob = rr * 64 + cc * 2; return st * 1024 + (ob ^ (((ob >> 9) & 1) << 5)); }
__host__ __device__ __forceinline__ void stage_rc(int b, int& R, int& C) { const int st = b / 1024, sb = b % 1024, swz = sb ^ (((sb >> 9) & 1) << 5); R = (st >> 1) * 16 + swz / 64; C = (st & 1) * 32 + (swz % 64) / 2; }
__host__ __device__ __forceinline__ int perm32(int rho) { const int n = rho >> 4, i = rho & 15; return 8 * (i >> 2) + 4 * n + (i & 3); }

struct Unit { int pm, pn; };
struct Gemm { const bf16_t* A; const bf16_t* Bt; int M, N, K, lda; int a_shift, a_step; };

struct StaticOrder {
    int nM, nN, nwg, G, c;
    __host__ __device__ void init(int M, int N, int G_, int c_) { nM = M / BM; nN = N / BM; nwg = nM * nN; G = G_; c = c_; }
    __host__ __device__ bool next(int i, Unit& u) const {
        const long L = (long)i * G + c; if (L >= nwg) return false;
        int wgid = (int)L; { const int q = nwg / NXCD, r = nwg % NXCD, xcd = wgid % NXCD, off = wgid / NXCD; wgid = (xcd < r ? xcd * (q + 1) : r * (q + 1) + (xcd - r) * q) + off; }
        const int nig = WGM * nN, gid = wgid / nig, fm = gid * WGM, gsz = (nM - fm) < WGM ? (nM - fm) : WGM;
        u.pm = fm + ((wgid % nig) % gsz); u.pn = (wgid % nig) / gsz; return true;
    }
    __device__ __forceinline__ void a_ready(const Unit&) const {}
    __device__ __forceinline__ void done(const Unit&) const {}
};

__device__ __forceinline__ unsigned cvt_pk_bf16(float lo, float hi) { unsigned r; asm volatile("v_cvt_pk_bf16_f32 %0, %1, %2" : "=v"(r) : "v"(lo), "v"(hi)); return r; }
enum { EM_PLAIN = 0, EM_SILU2 = 1, EM_SIG = 2, EM_MUL = 3, EM_RES = 4 };
struct EpiU {
    static constexpr bool PERM = true, AFTER_DRAIN = false;
    int mode; int l; unsigned char* ws; const float* xin; float* xout; const float* cin0;
    size_t oA, oB; int ldc, ldc2, split_tile;
    __device__ __forceinline__ void operator()(const f32x4 (&acc)[2][2][4][2], const Unit& u, int wr, int wc, int fr, int fq) const {
        if (mode == EM_RES) {
            const int b = u.pm / 17, t0 = u.pm % 17;
            const float* src; float* dst; const float* gate; const float* modl = (const float*)(ws + oA) + (size_t)l * 5 * 3072;
            if (t0 == 0) { float* c1 = (float*)(ws + oB); src = ((l == 0) ? cin0 : (const float*)c1) + (size_t)b * 256 * 1024; dst = c1 + (size_t)b * 256 * 1024; gate = modl + 4 * 3072 + 2048; }
            else { const size_t o = ((size_t)b * 4096 + (size_t)(t0 - 1) * 256) * 1024; src = xin + o; dst = xout + o; gate = modl + b * 3072 + 2048; }
            const int col0 = u.pn * BM + wc * 32 + 8 * fq;
            const char* srcb = (const char*)src; char* dstb = (char*)dst; const char* gb = (const char*)(gate + col0);
            const unsigned off0 = (unsigned)((wr * 64 + fr) * 1024 + col0) * 4u;
#pragma unroll
            for (int ai = 0; ai < 2; ++ai)
#pragma unroll
                for (int m = 0; m < 4; ++m) { const unsigned off = off0 + (unsigned)(ai * HALF + m * 16) * 4096u;
#pragma unroll
                    for (int bj = 0; bj < 2; ++bj)
#pragma unroll
                        for (int n = 0; n < 2; ++n) { const unsigned cb = (unsigned)(bj * HALF + n * 4) * 4u; const f32x4 g = *(const f32x4*)(gb + cb); const f32x4 xo = *(const f32x4*)(srcb + (off + cb));
                            *(f32x4*)(dstb + (off + cb)) = xo + g * acc[ai][bj][m][n]; }
                    asm volatile("" ::: "memory"); }
            return;
        }
        const int row0 = u.pm * BM + wr * 64 + fr; int colt = u.pn * BM; bf16_t* base = (bf16_t*)(ws + oA); int ld = ldc; bool second = false;
        if (u.pn >= split_tile) { base = (bf16_t*)(ws + oB); ld = ldc2; colt -= split_tile * BM; second = true; }
        const bool do_silu = (mode == EM_SILU2) && second;
        const int col0 = colt + wc * 32 + 8 * fq;
#pragma unroll
        for (int ai = 0; ai < 2; ++ai)
#pragma unroll
            for (int m = 0; m < 4; ++m) { bf16_t* rowp = base + (size_t)(row0 + ai * HALF + m * 16) * ld + col0;
#pragma unroll
                for (int bj = 0; bj < 2; ++bj) { f32x4 v0 = acc[ai][bj][m][0], v1 = acc[ai][bj][m][1];
                    if (mode == EM_SIG) {
#pragma unroll
                        for (int e = 0; e < 4; ++e) { v0[e] = sigmoid_f(v0[e]); v1[e] = sigmoid_f(v1[e]); } }
                    if (do_silu) {
#pragma unroll
                        for (int e = 0; e < 4; ++e) { v0[e] = v0[e] * sigmoid_f(v0[e]); v1[e] = v1[e] * sigmoid_f(v1[e]); } }
                    if (mode == EM_MUL) { const u32x4 o = *(const u32x4*)(rowp + bj * HALF);
                        v0[0] *= bflo(o.x); v0[1] *= bfhi(o.x); v0[2] *= bflo(o.y); v0[3] *= bfhi(o.y); v1[0] *= bflo(o.z); v1[1] *= bfhi(o.z); v1[2] *= bflo(o.w); v1[3] *= bfhi(o.w); }
                    u32x4 w; w.x = cvt_pk_bf16(v0[0], v0[1]); w.y = cvt_pk_bf16(v0[2], v0[3]); w.z = cvt_pk_bf16(v1[0], v1[1]); w.w = cvt_pk_bf16(v1[2], v1[3]);
                    *(u32x4*)(rowp + bj * HALF) = w; }
                if (mode == EM_MUL) asm volatile("" ::: "memory"); }
    }
};
struct Order {
    int nM, nN, nwg, G, c, latent_only;
    __device__ void init(int nM_, int nN_, int G_, int c_, int lat) { nM = nM_; nN = nN_; nwg = nM * nN; G = G_; c = c_; latent_only = lat; }
    __device__ bool next(int i, Unit& u) const {
        const long L = (long)i * G + c; if (L >= nwg) return false;
        int wgid = (int)L; { const int q = nwg / NXCD, r = nwg % NXCD, xcd = wgid % NXCD, off = wgid / NXCD; wgid = (xcd < r ? xcd * (q + 1) : r * (q + 1) + (xcd - r) * q) + off; }
        const int nig = WGM * nN, gid = wgid / nig, fm = gid * WGM, gsz = (nM - fm) < WGM ? (nM - fm) : WGM;
        int pm = fm + ((wgid % nig) % gsz); u.pn = (wgid % nig) / gsz; if (latent_only) pm = pm + pm / 16 + 1; u.pm = pm; return true;
    }
    __device__ __forceinline__ void a_ready(const Unit&) const {}
    __device__ __forceinline__ void done(const Unit&) const {}
};
template <class Epi, class Sched, bool ALIGN_EPI = false, bool SP2 = false>
__device__ __forceinline__ void gemm_phase(PG8_LAS unsigned char* lds, const Gemm g, const Sched& S, const Epi& E, const int tid  ) {
    const int wid = __builtin_amdgcn_readfirstlane(tid >> 6), lane = tid & 63, wr = wid >> 2, wc = wid & 3, fr = lane & 15, fq = lane >> 4;
    const int K = g.K, nt = K / BK;
    unsigned voffA[2], voffB[2];
#pragma unroll
    for (int i = 0; i < 2; ++i) { int R, C; stage_rc(tid * 16 + i * 8192, R, C); const int Rb = Epi::PERM ? ((R & ~31) + perm32(R & 31)) : R;
        voffA[i] = (unsigned)(R * g.lda + C) * 2u; voffB[i] = (unsigned)(Rb * K + C) * 2u; }
    const size_t kstep = (size_t)(BK * 2);
    const size_t hstepA = (size_t)HALF * g.lda * 2, hstepB = (size_t)HALF * K * 2;
    const size_t tstepA = 2 * hstepA, tstepB = 2 * hstepB;
    const unsigned ldsw = (unsigned)wid * 1024u;
    const int aoff = lds_byte(wr * 64 + fr, fq * 8), boff = lds_byte(wc * 32 + fr, fq * 8);
#define PG8_SA(b, h) (((b) * 2 + (h)) * HTB)
#define PG8_SB(b, h) ((4 + (b) * 2 + (h)) * HTB)
#define PG8_STAGE(bufoff, gbase, voff) do { _Pragma("unroll") for (int _i = 0; _i < 2; ++_i) \
        __builtin_amdgcn_global_load_lds((const unsigned*)((const char*)(gbase) + (voff)[_i]), (PG8_LAS unsigned*)(lds + (bufoff) + ldsw + _i * 8192), 16, 0, 0); } while (0)
#define PG8_LDA(dst, b, h) do { _Pragma("unroll") for (int m = 0; m < 4; ++m) _Pragma("unroll") for (int k = 0; k < 2; ++k) dst[m][k] = *(const PG8_LAS bf16x8*)(lds + PG8_SA(b, h) + aoff + m * 2048 + k * 1024); } while (0)
#define PG8_LDB(dst, b, h) do { _Pragma("unroll") for (int n = 0; n < 2; ++n) _Pragma("unroll") for (int k = 0; k < 2; ++k) dst[n][k] = *(const PG8_LAS bf16x8*)(lds + PG8_SB(b, h) + boff + n * 2048 + k * 1024); } while (0)
#define PG8_MMA(ai, bj, At, Bt) do { __builtin_amdgcn_s_setprio(1); _Pragma("unroll") for (int m = 0; m < 4; ++m) _Pragma("unroll") for (int n = 0; n < 2; ++n) _Pragma("unroll") for (int k = 0; k < 2; ++k) \
        acc[ai][bj][m][n] = __builtin_amdgcn_mfma_f32_16x16x32_bf16(Bt[n][k], At[m][k], acc[ai][bj][m][n], 0, 0, 0); __builtin_amdgcn_s_setprio(0); } while (0)
#define PG8_WAIT_V(n) asm volatile("s_waitcnt vmcnt(" #n ")" ::: "memory")
#define PG8_WAIT_L(n) asm volatile("s_waitcnt lgkmcnt(" #n ")" ::: "memory")
#define PG8_BAR __builtin_amdgcn_s_barrier()
#define PG8_SCHED __builtin_amdgcn_sched_barrier(0)
    Unit cur, nxt; int ui = 0;
    if (!S.next(0, cur)) return;
    f32x4 acc[2][2][4][2];
#pragma unroll
    for (int a = 0; a < 2; ++a)
#pragma unroll
        for (int b = 0; b < 2; ++b)
#pragma unroll
            for (int m = 0; m < 4; ++m)
#pragma unroll
                for (int n = 0; n < 2; ++n) acc[a][b][m][n] = (f32x4){0.f, 0.f, 0.f, 0.f};
    bf16x8 At[4][2], B0[2][2], B1[2][2];
    const char* cA = (const char*)g.A + (size_t)cur.pm * tstepA + (size_t)(cur.pn >> g.a_shift) * (size_t)g.a_step; const char* cB = (const char*)g.Bt + (size_t)cur.pn * tstepB;
    S.a_ready(cur);
    if constexpr (SP2) {
        PG8_STAGE(PG8_SB(0, 0), cB, voffB); PG8_STAGE(PG8_SB(0, 1), cB + hstepB, voffB); PG8_STAGE(PG8_SA(0, 0), cA, voffA); PG8_STAGE(PG8_SA(0, 1), cA + hstepA, voffA);
        if (wr == 1) PG8_BAR;
        PG8_WAIT_V(2); PG8_BAR;
        PG8_STAGE(PG8_SB(1, 0), cB + kstep, voffB); PG8_STAGE(PG8_SA(1, 0), cA + kstep, voffA); PG8_STAGE(PG8_SB(1, 1), cB + hstepB + kstep, voffB);
        PG8_WAIT_V(6); PG8_BAR;
    } else {
        PG8_STAGE(PG8_SB(0, 0), cB, voffB); PG8_STAGE(PG8_SA(0, 0), cA, voffA); PG8_STAGE(PG8_SB(0, 1), cB + hstepB, voffB); PG8_STAGE(PG8_SA(0, 1), cA + hstepA, voffA);
        if (wr == 1) PG8_BAR;
        PG8_WAIT_V(4); PG8_BAR;
        PG8_STAGE(PG8_SB(1, 0), cB + kstep, voffB); PG8_STAGE(PG8_SA(1, 0), cA + kstep, voffA); PG8_STAGE(PG8_SB(1, 1), cB + hstepB + kstep, voffB);
        PG8_WAIT_V(6); PG8_BAR;
    }
    for (;;) {
        const bool has_next = S.next(ui + 1, nxt);
        const char* nA = has_next ? (const char*)g.A + (size_t)nxt.pm * tstepA + (size_t)(nxt.pn >> g.a_shift) * (size_t)g.a_step : cA; const char* nB = has_next ? (const char*)g.Bt + (size_t)nxt.pn * tstepB : cB;
        for (int t = 0; t < nt; t += 2) {
            const bool last = (t == nt - 2);
            const char* a1 = cA + (size_t)(t + 1) * kstep;
            const char* a2 = last ? nA : cA + (size_t)(t + 2) * kstep; const char* b2 = last ? nB : cB + (size_t)(t + 2) * kstep;
            const char* a3 = a2 + kstep; const char* b3 = b2 + kstep;
            if (last && has_next) S.a_ready(nxt);
            if constexpr (SP2) {
            PG8_LDB(B0, 0, 0); PG8_LDB(B1, 0, 1); PG8_SCHED; PG8_LDA(At, 0, 0); PG8_STAGE(PG8_SA(1, 1), a1 + hstepA, voffA);
            PG8_WAIT_V(8); PG8_WAIT_L(0); PG8_BAR; PG8_MMA(0, 0, At, B0); PG8_MMA(0, 1, At, B1); PG8_BAR; PG8_SCHED;
            PG8_LDA(At, 0, 1); PG8_STAGE(PG8_SB(0, 0), b2, voffB); PG8_STAGE(PG8_SB(0, 1), b2 + hstepB, voffB); PG8_STAGE(PG8_SA(0, 0), a2, voffA);
            PG8_WAIT_V(8); PG8_WAIT_L(0); PG8_BAR; PG8_MMA(1, 0, At, B0); PG8_MMA(1, 1, At, B1); PG8_BAR; PG8_SCHED;
            PG8_LDB(B0, 1, 0); PG8_LDB(B1, 1, 1); PG8_SCHED; PG8_LDA(At, 1, 0); PG8_STAGE(PG8_SA(0, 1), a2 + hstepA, voffA);
            PG8_WAIT_V(8); PG8_WAIT_L(0); PG8_BAR; PG8_MMA(0, 0, At, B0); PG8_MMA(0, 1, At, B1); PG8_BAR; PG8_SCHED;
            PG8_LDA(At, 1, 1); PG8_STAGE(PG8_SB(1, 0), b3, voffB); PG8_STAGE(PG8_SB(1, 1), b3 + hstepB, voffB); PG8_STAGE(PG8_SA(1, 0), a3, voffA);
            PG8_WAIT_V(8); PG8_WAIT_L(0); PG8_BAR; PG8_MMA(1, 0, At, B0); PG8_MMA(1, 1, At, B1); PG8_BAR; PG8_SCHED;
            } else {
            PG8_LDB(B0, 0, 0); PG8_SCHED; PG8_LDA(At, 0, 0); PG8_STAGE(PG8_SA(1, 1), a1 + hstepA, voffA);
            PG8_WAIT_L(8); PG8_BAR; PG8_WAIT_L(0); PG8_MMA(0, 0, At, B0); PG8_BAR; PG8_SCHED;
            PG8_LDB(B1, 0, 1); PG8_STAGE(PG8_SB(0, 0), b2, voffB);
            PG8_BAR; PG8_WAIT_L(0); PG8_MMA(0, 1, At, B1); PG8_BAR;
            PG8_LDA(At, 0, 1); PG8_STAGE(PG8_SA(0, 0), a2, voffA);
            PG8_BAR; PG8_WAIT_L(0); PG8_MMA(1, 0, At, B0); PG8_BAR; PG8_SCHED;
            PG8_STAGE(PG8_SB(0, 1), b2 + hstepB, voffB);
            PG8_WAIT_V(6); PG8_BAR; PG8_MMA(1, 1, At, B1); PG8_BAR;
            PG8_LDB(B0, 1, 0); PG8_SCHED; PG8_LDA(At, 1, 0); PG8_STAGE(PG8_SA(0, 1), a2 + hstepA, voffA);
            PG8_WAIT_L(8); PG8_BAR; PG8_WAIT_L(0); PG8_MMA(0, 0, At, B0); PG8_BAR; PG8_SCHED;
            PG8_LDB(B1, 1, 1); PG8_STAGE(PG8_SB(1, 0), b3, voffB);
            PG8_BAR; PG8_WAIT_L(0); PG8_MMA(0, 1, At, B1); PG8_BAR;
            PG8_LDA(At, 1, 1); PG8_STAGE(PG8_SA(1, 0), a3, voffA);
            PG8_BAR; PG8_WAIT_L(0); PG8_MMA(1, 0, At, B0); PG8_BAR; PG8_SCHED;
            PG8_STAGE(PG8_SB(1, 1), b3 + hstepB, voffB);
            PG8_WAIT_V(6); PG8_BAR; PG8_MMA(1, 1, At, B1); PG8_BAR;
            }
        }
        if constexpr (ALIGN_EPI) { if (wr == 0) PG8_BAR; }
        if constexpr (!Epi::AFTER_DRAIN) { E(acc, cur, wr, wc, fr, fq); S.done(cur); }
        if (!has_next) break;
#pragma unroll
        for (int a = 0; a < 2; ++a)
#pragma unroll
            for (int b = 0; b < 2; ++b)
#pragma unroll
                for (int m = 0; m < 4; ++m)
#pragma unroll
                    for (int n = 0; n < 2; ++n) acc[a][b][m][n] = (f32x4){0.f, 0.f, 0.f, 0.f};
        cur = nxt; cA = nA; cB = nB; ++ui;
        if constexpr (ALIGN_EPI) { if (wr == 1) PG8_BAR; }
    }
    PG8_WAIT_V(0);
    if constexpr (!ALIGN_EPI) { if (wr == 0) PG8_BAR; }
    PG8_BAR;
    if constexpr (Epi::AFTER_DRAIN) { E.fused(acc, cur, wr, wc, fr, fq, lds, wid, lane); S.done(cur); }
#undef PG8_SA
#undef PG8_SB
#undef PG8_STAGE
#undef PG8_LDA
#undef PG8_LDB
#undef PG8_MMA
#undef PG8_WAIT_V
#undef PG8_WAIT_L
#undef PG8_BAR
#undef PG8_SCHED
}
}
#define PG8_SP2 true
#define PG8_ALIGN true
#define GAS __attribute__((address_space(1)))
#define LAS __attribute__((address_space(3)))
typedef unsigned short bf16;
typedef unsigned v4u __attribute__((ext_vector_type(4)));
typedef float f32x4 __attribute__((ext_vector_type(4)));
typedef short bf16x8 __attribute__((ext_vector_type(8)));
typedef GAS unsigned gu32;
typedef GAS unsigned long long gu64;
#define RLX_AGENT __ATOMIC_RELAXED, __HIP_MEMORY_SCOPE_AGENT
#define LDS_WAIT() asm volatile("s_waitcnt lgkmcnt(0)" ::: "memory")
#define VM_WAIT() asm volatile("s_waitcnt vmcnt(0)" ::: "memory")
__device__ __forceinline__ unsigned long long rt() { return __builtin_amdgcn_s_memrealtime(); }
__device__ __forceinline__ unsigned f2bf(float f) { unsigned u = __builtin_bit_cast(unsigned, f); return (u + 0x7fffu + ((u >> 16) & 1u)) >> 16; }
__device__ __forceinline__ unsigned pk2(float lo, float hi) { return f2bf(lo) | (f2bf(hi) << 16); }
#define XB_TMO      128
#define XB_XCNT(j)  (256  + 64 * (j))
#define XB_XSUB(j)  (1280 + 64 * (j))
#define XB_XGEN(j)  (2304 + 64 * (j))
#define XB_TOP      3328
#define XB_TOPGEN   3392
#define XCD_BAR_WORDS 3456
#define XB_SPIN_CAP (1u << 18)

__device__ __forceinline__ unsigned xb_ld(unsigned* p)              { return __hip_atomic_load(p, __ATOMIC_RELAXED, __HIP_MEMORY_SCOPE_AGENT); }
__device__ __forceinline__ unsigned xb_add(unsigned* p, unsigned v) { return __hip_atomic_fetch_add(p, v, __ATOMIC_RELAXED, __HIP_MEMORY_SCOPE_AGENT); }
__device__ __forceinline__ unsigned xb_xcc_id() { return (unsigned)__builtin_amdgcn_s_getreg((3 << 11) | 20) & 0xFu; }
#define XB_SPIN(cond, bar) do { unsigned _sp = 0; while (cond) { __builtin_amdgcn_s_sleep(1); \
    if ((++_sp & 255u) == 0u) { if (xb_ld(&(bar)[XB_TMO])) break; if (_sp > XB_SPIN_CAP) { atomicAdd(&(bar)[XB_TMO], 1u); break; } } } } while (0)

struct XcdBarrier {
    unsigned* bar; unsigned x;
    volatile LAS unsigned* st;
};

__device__ __forceinline__ XcdBarrier xcd_barrier_post(unsigned* bar, volatile LAS unsigned* st) {
    XcdBarrier b; b.bar = bar; b.x = xb_xcc_id(); b.st = st;
    if (threadIdx.x == 0) (void)xb_add(&bar[XB_XCNT(b.x)], 1u);
    return b;
}
__device__ __forceinline__ void xcd_barrier_complete(unsigned* bar, unsigned x, unsigned& nloc, unsigned& nx) {
    const unsigned G = gridDim.x * gridDim.y * gridDim.z;
    unsigned sum, cnt, mine, sp = 0u;
    for (;;) {
        sum = 0u; cnt = 0u; mine = 0u;
#pragma unroll
        for (unsigned j = 0; j < 16; ++j) { const unsigned c = xb_ld(&bar[XB_XCNT(j)]); sum += c; cnt += (c > 0u) ? 1u : 0u; mine = (j == x) ? c : mine; }
        if (sum == G) break;
        __builtin_amdgcn_s_sleep(1);
        if ((++sp & 255u) == 0u) { if (xb_ld(&bar[XB_TMO])) break; if (sp > XB_SPIN_CAP) { atomicAdd(&bar[XB_TMO], 1u); break; } }
    }
    nloc = mine > 0u ? mine : 1u; nx = cnt > 0u ? cnt : 1u;
}

__device__ __forceinline__ void xcd_barrier(const XcdBarrier& b) {
    asm volatile("s_waitcnt vmcnt(0)" ::: "memory");
    __syncthreads();
    if (threadIdx.x == 0) {
        unsigned* bar = b.bar;
        __builtin_amdgcn_s_waitcnt(0);
        unsigned nloc = b.st[0], nx = b.st[1];
        if (nloc == 0u) { xcd_barrier_complete(bar, b.x, nloc, nx); b.st[0] = nloc; b.st[1] = nx; }
        const unsigned old = xb_add(&bar[XB_XSUB(b.x)], 1u);
        const unsigned gen = old / nloc;
        if (old + 1u == (gen + 1u) * nloc) {
            __builtin_amdgcn_fence(__ATOMIC_RELEASE, "agent");
            asm volatile("s_waitcnt vmcnt(0)" ::: "memory");
            const unsigned og = xb_add(&bar[XB_TOP], 1u);
            const unsigned tg = og / nx;
            if (og + 1u == (tg + 1u) * nx) xb_add(&bar[XB_TOPGEN], 1u);
            else XB_SPIN(xb_ld(&bar[XB_TOPGEN]) == tg, bar);
            __builtin_amdgcn_fence(__ATOMIC_ACQUIRE, "agent");
            xb_add(&bar[XB_XGEN(b.x)], 1u);
            asm volatile("s_waitcnt vmcnt(0)" ::: "memory");
        } else {
            XB_SPIN(xb_ld(&bar[XB_XGEN(b.x)]) == gen, bar);
            __builtin_amdgcn_fence(__ATOMIC_ACQUIRE, "agent");
            asm volatile("s_waitcnt vmcnt(0)" ::: "memory");
        }
    }
    __syncthreads();
}
constexpr int NB = 4, SEQ = 4096, CTXL = 256, TPB = SEQ + CTXL, NROWS = NB * TPB, DM = 1024, NLAYER = 2, IN_COLS = 6816;
constexpr int NWAVES = 8, NTHREADS = NWAVES * 64;
constexpr float RMS_EPS = 1e-6f;
constexpr float LOG2E = 1.4426950408889634f;
constexpr float QSCALE64 = 0.125f * LOG2E;
constexpr float QSCALE96 = 0.10206207261596575f * LOG2E;
constexpr int ZS_P = 1792, ZC_CQ = 0, ZC_CKV = 256, ZC_KR = 384, ZC_SQ = 512, ZC_SK = 768, ZC_SV = 896, ZC_AQ = 1024, ZC_AK = 1280, ZC_AV = 1408, ZC_LRU = 1536;
constexpr int N1 = 2816;
constexpr int W1ROWS = N1 + 4096;
constexpr size_t MiB = 1u << 20;
constexpr size_t WS_CTL = 0, CTL_ZERO_BYTES = 64 * 1024;
constexpr size_t WS_MOD = 1 * MiB;
constexpr size_t WS_RHC = 1 * MiB + 256 * 1024, WS_RHS = WS_RHC + 512 * 1024;
constexpr size_t WS_RMC = WS_RHS + 512 * 1024, WS_RMS = WS_RMC + 256 * 1024;
constexpr size_t WS_CTX1 = 3 * MiB;
constexpr size_t WS_W = 8 * MiB, W_LAYER = 18 * MiB;
constexpr size_t WO_W1 = 0, WO_WB = 13 * MiB + 512 * 1024, WO_WO = WO_WB + 2 * MiB, WO_UQ = WO_WO + 2 * MiB, WO_UKV = WO_UQ + 256 * 1024;
constexpr size_t WS_H = 44 * MiB;
constexpr size_t WS_G = 78 * MiB;
constexpr size_t WS_S = 112 * MiB;
constexpr size_t WS_ZS = 112 * MiB;
constexpr size_t WS_MQ = 172 * MiB;
constexpr size_t WS_MKV = 189 * MiB;
constexpr size_t WS_MK = 206 * MiB;
constexpr size_t WS_U = 219 * MiB;
constexpr size_t WS_HF = 236 * MiB;
constexpr size_t WS_SP = 2 * MiB + 768 * 1024;
constexpr size_t WS_LWT = 254 * MiB + 512 * 1024;
constexpr size_t WS_END = 255 * MiB;
static_assert(WS_H + (size_t)NROWS * 1024 * 2 <= WS_G && WS_G + (size_t)NROWS * 1024 * 2 <= WS_S && WS_S + (size_t)NROWS * 4096 * 2 <= 248 * MiB, "ws map");
static_assert(WS_ZS + (size_t)NROWS * ZS_P * 2 <= WS_MQ && WS_MK + (size_t)NROWS * 384 * 2 <= WS_U, "ws map 2");
static_assert(WO_UKV + 512 * 256 * 2 <= W_LAYER, "weights");
constexpr int CW_BAR = 1024;

constexpr int RING_OFF = 0, RING_BYTES = 131072, LDSCTL_OFF = RING_BYTES, MISC_OFF = LDSCTL_OFF + 320, LDS_BYTES = 147456;

typedef unsigned short bf16;
typedef unsigned u32x2 __attribute__((ext_vector_type(2)));
typedef float f32x2v __attribute__((ext_vector_type(2)));
__device__ __forceinline__ float bf2f(bf16 v) { return __uint_as_float((unsigned)v << 16); }
__device__ __forceinline__ float wave_sum(float v) {
#pragma unroll
    for (int o = 1; o < 64; o <<= 1) v += __shfl_xor(v, o);
    return v; }
__device__ __forceinline__ float wave_max(float v) {
#pragma unroll
    for (int o = 1; o < 64; o <<= 1) v = fmaxf(v, __shfl_xor(v, o));
    return v; }
__device__ __forceinline__ float grp16_sum(float v) {
#pragma unroll
    for (int o = 1; o < 16; o <<= 1) v += __shfl_xor(v, o);
    return v; }

struct Args { const float* in[28]; float* out; unsigned char* ws; int ph_lo, ph_hi; };
enum { I_X = 0, I_C, I_CTX, I_CCTX, I_WMOD, I_BMOD, I_NORMW, I_WIN, I_CQN, I_CKVN, I_WUQ, I_WUKV, I_MQN, I_MKN, I_SQN, I_SKN, I_SINK, I_AQN, I_AKN,
       I_CONVW, I_CONVB, I_LWR, I_LBR, I_LWI, I_LBI, I_LAM, I_WBR, I_WOUT };

struct Frame {
    LAS unsigned char* lds; const float* const __attribute__((address_space(4)))* kin; unsigned char* ws; float* out;
    int tid, lane, wave, G, vcu, gw, NGW, z;
    __device__ __forceinline__ const float* in(int i) const { return kin[i]; }
};

__device__ __forceinline__ void xpose_item(const float* W, int ldn, int k0, int n0, bf16* WT, int pd, int drow, LAS float* scr, int lane) {
#pragma unroll 8
    for (int i = 0; i < 32; ++i) { const int kk = 2 * i + (lane >> 5); scr[kk * 33 + (lane & 31)] = W[(size_t)(k0 + kk) * ldn + n0 + (lane & 31)]; }
    LDS_WAIT(); asm volatile("" ::: "memory");
    const int c = lane & 7;
#pragma unroll
    for (int j = 0; j < 4; ++j) { const int n = (lane >> 3) + 8 * j; const LAS float* s = scr + (8 * c) * 33 + n;
        v4u o; o.x = pk2(s[0 * 33], s[1 * 33]); o.y = pk2(s[2 * 33], s[3 * 33]); o.z = pk2(s[4 * 33], s[5 * 33]); o.w = pk2(s[6 * 33], s[7 * 33]);
        *(GAS v4u*)(WT + (size_t)(drow + n0 + n) * pd + k0 + 8 * c) = o; }
    LDS_WAIT(); asm volatile("" ::: "memory");
}
__device__ __forceinline__ void zero16(bf16* p, size_t n16, int gt, int ngt) {
    for (size_t i = gt; i < n16; i += ngt) ((GAS v4u*)p)[i] = (v4u){0u, 0u, 0u, 0u};
}
__device__ __forceinline__ void p0_prologue(Frame& F) {
    LAS float* scr = (LAS float*)(F.lds + RING_OFF + F.wave * 16384);
    constexpr int I_IN = 16 * 213, I_UQ = 4 * 12, I_UKV = 2 * 16, I_BR = 4 * 4 * 32, I_OUT = 16 * 32, I_LAYER = I_IN + I_UQ + I_UKV + I_BR + I_OUT;
    for (int it = F.gw; it < NLAYER * I_LAYER; it += F.NGW) {
        const int l = it / I_LAYER; int r = it % I_LAYER;
        unsigned char* wl = F.ws + WS_W + (size_t)l * W_LAYER;
        if (r < I_IN) { const int kb = r / 213, nb = r % 213, n0 = nb * 32;
            xpose_item(F.in(I_WIN) + (size_t)l * 1024 * IN_COLS, IN_COLS, kb * 64, n0, (bf16*)(wl + WO_W1), 1024, n0 >= 416 ? 96 : 0, scr, F.lane); continue; } r -= I_IN;
        if (r < I_UQ) { const int kb = r / 12, nb = r % 12;
            xpose_item(F.in(I_WUQ) + (size_t)l * 256 * 384, 384, kb * 64, nb * 32, (bf16*)(wl + WO_UQ), 256, 0, scr, F.lane); continue; } r -= I_UQ;
        if (r < I_UKV) { const int kb = r / 16, nb = r % 16;
            xpose_item(F.in(I_WUKV) + (size_t)l * 128 * 512, 512, kb * 64, nb * 32, (bf16*)(wl + WO_UKV), 256, 0, scr, F.lane); continue; } r -= I_UKV;
        if (r < I_BR) { const int k = r / 128, rr = r % 128, kb = rr / 32, nb = rr % 32;
            xpose_item(F.in(I_WBR) + ((size_t)l * 4 + k) * 256 * 1024, 1024, kb * 64, nb * 32, (bf16*)(wl + WO_WB) + (size_t)k * 1024 * 256, 256, 0, scr, F.lane); continue; } r -= I_BR;
        { const int kb = r / 32, nb = r % 32;
            xpose_item(F.in(I_WOUT) + (size_t)l * 1024 * 1024, 1024, kb * 64, nb * 32, (bf16*)(wl + WO_WO), 1024, 0, scr, F.lane); }
    }
    const int gt = F.vcu * NTHREADS + F.tid, ngt = F.G * NTHREADS;
    for (int l = 0; l < NLAYER; ++l) {
        unsigned char* wl = F.ws + WS_W + (size_t)l * W_LAYER;
        zero16((bf16*)(wl + WO_W1) + (size_t)416 * 1024, 96 * 1024 * 2 / 16, gt, ngt);
        zero16((bf16*)(wl + WO_UQ) + (size_t)384 * 256, 128 * 256 * 2 / 16, gt, ngt);
        for (int i = gt; i < 512 * 16; i += ngt) { const int n = i >> 4, c = i & 15; ((GAS v4u*)((bf16*)(wl + WO_UKV) + (size_t)n * 256 + 128))[c] = (v4u){0u, 0u, 0u, 0u}; }
    }
    { float* rhc = (float*)(F.ws + WS_RHC); float* rhs = (float*)(F.ws + WS_RHS); float* rmc = (float*)(F.ws + WS_RMC); float* rms = (float*)(F.ws + WS_RMS);
      for (int i = gt; i < 4096 * 32; i += ngt) { const int t = i >> 5, p = i & 31; const float fr = powf(10000.0f, -(float)(p & 15) / 16.0f);
          const float pos = (float)((p < 16) ? (t >> 6) : (t & 63)); const float ang = pos * fr; rhc[i] = cosf(ang); rhs[i] = sinf(ang); }
      for (int i = gt; i < 4096 * 16; i += ngt) { const int t = i >> 4, p = i & 15; const float fr = powf(10000.0f, -(float)(p & 7) / 8.0f);
          const float pos = (float)((p < 8) ? (t >> 6) : (t & 63)); const float ang = pos * fr; rmc[i] = cosf(ang); rms[i] = sinf(ang); } }
    { float* sp = (float*)(F.ws + WS_SP); for (int i = gt; i < NLAYER * 2 * 256; i += ngt) sp[i] = 8.0f * LOG2E * log1pf(expf(-F.in(I_LAM)[i])); }
    { float* lwt = (float*)(F.ws + WS_LWT);
      for (int o = gt; o < NLAYER * 2 * 2 * 256 * 64; o += ngt) { const int i = o & 63, c = (o >> 6) & 255, gate = (o >> 14) & 1, ld = o >> 15, k = c >> 6, j = c & 63;
          lwt[o] = (gate == 0 ? F.in(I_LWR) : F.in(I_LWI))[(((size_t)ld * 4 + k) * 64 + i) * 64 + j]; } }
    { LAS float* sc = (LAS float*)(F.lds + RING_OFF);
      LAS float* red = sc + 5 * 1024;
      __syncthreads();
      for (int i = F.tid; i < 5 * 1024; i += NTHREADS) { const float v = (i < 4096) ? F.in(I_C)[i] : F.in(I_CCTX)[i - 4096]; sc[i] = v / (1.0f + expf(-v)); }
      __syncthreads();
      float* modv = (float*)(F.ws + WS_MOD);
      for (int it = F.vcu; it < NLAYER * 96; it += F.G) {
          const int l = it / 96, n0 = (it % 96) * 32, nn = F.tid & 31, kc = F.tid >> 5;
          const float* w = F.in(I_WMOD) + (size_t)l * 1024 * 3072 + n0 + nn;
          float acc[5] = {0.f, 0.f, 0.f, 0.f, 0.f};
          for (int k = kc * 64; k < kc * 64 + 64; ++k) { const float wv = w[(size_t)k * 3072];
#pragma unroll
              for (int r = 0; r < 5; ++r) acc[r] += sc[r * 1024 + k] * wv; }
#pragma unroll
          for (int r = 0; r < 5; ++r) red[(kc * 5 + r) * 32 + nn] = acc[r];
          __syncthreads();
          if (F.tid < 160) { const int r = F.tid >> 5; float s = 0.f;
              for (int q = 0; q < 16; ++q) s += red[(q * 5 + r) * 32 + nn];
              modv[((size_t)l * 5 + r) * 3072 + n0 + nn] = s + F.in(I_BMOD)[l * 3072 + n0 + nn]; }
          __syncthreads();
      } }
}

__device__ __forceinline__ void ph_hnorm(Frame& F, int l) {
    const float* xs = (l == 0) ? F.in(I_X) : F.out; const float* cs = (l == 0) ? F.in(I_CTX) : (const float*)(F.ws + WS_CTX1);
    const float* nw = F.in(I_NORMW) + l * 1024; const float* modl = (const float*)(F.ws + WS_MOD) + (size_t)l * 5 * 3072;
    bf16* H = (bf16*)(F.ws + WS_H);
    for (int row = F.gw; row < NROWS; row += F.NGW) {
        const int b = row / TPB, j = row % TPB; const float* src; int mr;
        if (j < CTXL) { src = cs + ((size_t)b * CTXL + j) * 1024; mr = 4; } else { src = xs + ((size_t)b * SEQ + (j - CTXL)) * 1024; mr = b; }
        const GAS f32x4* xr = (const GAS f32x4*)src + F.lane;
        f32x4 v[4]; float ss = 0.f;
#pragma unroll
        for (int q = 0; q < 4; ++q) { v[q] = xr[64 * q]; ss += (v[q].x * v[q].x + v[q].y * v[q].y) + (v[q].z * v[q].z + v[q].w * v[q].w); }
        const float rstd = 1.0f / sqrtf(wave_sum(ss) * (1.0f / 1024.0f) + RMS_EPS);
        const float* mrow = modl + mr * 3072;
        GAS unsigned long long* o8 = (GAS unsigned long long*)(H + (size_t)row * 1024) + F.lane;
#pragma unroll
        for (int q = 0; q < 4; ++q) { const int c = 4 * F.lane + 256 * q;
            const f32x4 g = *(const f32x4*)(nw + c), sh = *(const f32x4*)(mrow + c), sc = *(const f32x4*)(mrow + 1024 + c);
            const f32x4 h = v[q] * rstd * g * (sc + 1.0f) + sh;
            o8[64 * q] = (unsigned long long)pk2(h.x, h.y) | ((unsigned long long)pk2(h.z, h.w) << 32); }
    }
}

__device__ __forceinline__ void head_norm_rope(bf16* hp, const float* gain, bool rope, const float* rc, const float* rs, float scale, int lane) {
    const int p0 = (lane & 15) * 2;
    const unsigned w1 = *(const unsigned*)(hp + p0), w2 = *(const unsigned*)(hp + 32 + p0);
    float a0 = bflo(w1), a1 = bfhi(w1), b0 = bflo(w2), b1 = bfhi(w2);
    const float ss = grp16_sum(a0 * a0 + a1 * a1 + b0 * b0 + b1 * b1);
    const float rstd = 1.0f / sqrtf(ss * (1.0f / 64.0f) + RMS_EPS);
    a0 *= rstd * gain[p0]; a1 *= rstd * gain[p0 + 1]; b0 *= rstd * gain[32 + p0]; b1 *= rstd * gain[33 + p0];
    if (rope) { const float c0 = rc[p0], c1 = rc[p0 + 1], s0 = rs[p0], s1 = rs[p0 + 1];
        const float x0 = a0 * c0 - b0 * s0, y0 = b0 * c0 + a0 * s0, x1 = a1 * c1 - b1 * s1, y1 = b1 * c1 + a1 * s1; a0 = x0; b0 = y0; a1 = x1; b1 = y1; }
    *(unsigned*)(hp + p0) = pk2(a0 * scale, a1 * scale); *(unsigned*)(hp + 32 + p0) = pk2(b0 * scale, b1 * scale);
}
__device__ __forceinline__ void ph_post1(Frame& F, int l) {
    bf16* ZS = (bf16*)(F.ws + WS_ZS);
    const float* rhc = (const float*)(F.ws + WS_RHC); const float* rhs = (const float*)(F.ws + WS_RHS);
    for (int row = F.gw; row < NROWS; row += F.NGW) {
        const int j = row % TPB; const bool lat = j >= CTXL; const int pos = lat ? j - CTXL : 0;
        bf16* z = ZS + (size_t)row * ZS_P; const int lane = F.lane;
        { u32x2 w = *(const u32x2*)(z + ZC_CQ + 4 * lane); float v0 = bflo(w.x), v1 = bfhi(w.x), v2 = bflo(w.y), v3 = bfhi(w.y);
          const float rstd = 1.0f / sqrtf(wave_sum(v0 * v0 + v1 * v1 + v2 * v2 + v3 * v3) * (1.0f / 256.0f) + RMS_EPS);
          const float* g = F.in(I_CQN) + l * 256 + 4 * lane;
          w.x = pk2(v0 * rstd * g[0], v1 * rstd * g[1]); w.y = pk2(v2 * rstd * g[2], v3 * rstd * g[3]); *(u32x2*)(z + ZC_CQ + 4 * lane) = w; }
        { unsigned w = *(const unsigned*)(z + ZC_CKV + 2 * lane); float v0 = bflo(w), v1 = bfhi(w);
          const float rstd = 1.0f / sqrtf(wave_sum(v0 * v0 + v1 * v1) * (1.0f / 128.0f) + RMS_EPS);
          const float* g = F.in(I_CKVN) + l * 128 + 2 * lane;
          *(unsigned*)(z + ZC_CKV + 2 * lane) = pk2(v0 * rstd * g[0], v1 * rstd * g[1]); }
        const int hg = lane >> 4; const float* rc = rhc + pos * 32; const float* rs = rhs + pos * 32;
        head_norm_rope(z + ZC_SQ + hg * 64, F.in(I_SQN) + l * 64, lat, rc, rs, QSCALE64, lane);
        head_norm_rope(z + ZC_AQ + hg * 64, F.in(I_AQN) + l * 64, lat, rc, rs, QSCALE64, lane);
        head_norm_rope(z + ((hg < 2) ? (ZC_SK + hg * 64) : (ZC_AK + (hg - 2) * 64)), ((hg < 2) ? F.in(I_SKN) : F.in(I_AKN)) + l * 64, lat, rc, rs, 1.0f, lane);
    }
}
__device__ __forceinline__ void ph_post2(Frame& F, int l) {
    const bf16* ZS = (const bf16*)(F.ws + WS_ZS); bf16* MQ = (bf16*)(F.ws + WS_MQ); const bf16* MKV = (const bf16*)(F.ws + WS_MKV); bf16* MK = (bf16*)(F.ws + WS_MK);
    const float* rmc = (const float*)(F.ws + WS_RMC); const float* rms = (const float*)(F.ws + WS_RMS);
    const float* gq = F.in(I_MQN) + l * 96; const float* gk = F.in(I_MKN) + l * 96;
    for (int row = F.gw; row < NROWS; row += F.NGW) {
        const int j = row % TPB; const bool lat = j >= CTXL; const int pos = lat ? j - CTXL : 0; const int lane = F.lane;
        const float* rc = rmc + pos * 16; const float* rs = rms + pos * 16;
        const bf16* z = ZS + (size_t)row * ZS_P;
#pragma unroll 1
        for (int h = 0; h < 4; ++h) {
#pragma unroll
            for (int qk = 0; qk < 2; ++qk) {
                float v0 = 0.f, v1 = 0.f; const int p = lane - 32;
                if (qk == 0) { bf16* q = MQ + (size_t)row * 512 + h * 96;
                    if (lane < 32) { const unsigned w = *(const unsigned*)(q + 2 * lane); v0 = bflo(w); v1 = bfhi(w); }
                    else if (lane < 48) { v0 = bf2f(q[64 + p]); v1 = bf2f(q[80 + p]); } }
                else { if (lane < 32) { const unsigned w = *(const unsigned*)(MKV + (size_t)row * 512 + h * 128 + 2 * lane); v0 = bflo(w); v1 = bfhi(w); }
                    else if (lane < 48) { v0 = bf2f(z[ZC_KR + p]); v1 = bf2f(z[ZC_KR + 16 + p]); } }
                const float rstd = 1.0f / sqrtf(wave_sum(v0 * v0 + v1 * v1) * (1.0f / 96.0f) + RMS_EPS);
                const float* g = qk == 0 ? gq : gk; const float scale = qk == 0 ? QSCALE96 : 1.0f;
                bf16* o = qk == 0 ? (MQ + (size_t)row * 512 + h * 96) : (MK + (size_t)row * 384 + h * 96);
                if (lane < 32) { *(unsigned*)(o + 2 * lane) = pk2(v0 * rstd * g[2 * lane] * scale, v1 * rstd * g[2 * lane + 1] * scale); }
                else if (lane < 48) { float y1 = v0 * rstd * g[64 + p], y2 = v1 * rstd * g[80 + p];
                    if (lat) { const float c = rc[p], s = rs[p]; const float t1 = y1 * c - y2 * s, t2 = y2 * c + y1 * s; y1 = t1; y2 = t2; }
                    o[64 + p] = (bf16)f2bf(y1 * scale); o[80 + p] = (bf16)f2bf(y2 * scale); }
            }
        }
    }
}

template <int DQK>
__device__ __forceinline__ void attn_row_naive(const bf16* q, const bf16* Kb, int kp, const bf16* Vb, int vp, int n1, int lo2, int hi2, bool has_sink, float sink2, bf16* y, int lane) {
    float qf[DQK];
#pragma unroll
    for (int c = 0; c < DQK / 8; ++c) { const v4u w = *(const v4u*)(q + 8 * c);
        qf[8 * c + 0] = bflo(w.x); qf[8 * c + 1] = bfhi(w.x); qf[8 * c + 2] = bflo(w.y); qf[8 * c + 3] = bfhi(w.y); qf[8 * c + 4] = bflo(w.z); qf[8 * c + 5] = bfhi(w.z); qf[8 * c + 6] = bflo(w.w); qf[8 * c + 7] = bfhi(w.w); }
    float m = -INFINITY, l = 0.f; float acc[64];
#pragma unroll
    for (int d = 0; d < 64; ++d) acc[d] = 0.f;
    for (int seg = 0; seg < 2; ++seg) {
        const int k0 = seg == 0 ? 0 : lo2, k1 = seg == 0 ? n1 : hi2;
        for (int key = k0 + lane; key < k1; key += 64) {
            const bf16* kr = Kb + (size_t)key * kp; float s = 0.f;
#pragma unroll
            for (int c = 0; c < DQK / 8; ++c) { const v4u w = *(const v4u*)(kr + 8 * c);
                s += qf[8 * c + 0] * bflo(w.x) + qf[8 * c + 1] * bfhi(w.x) + qf[8 * c + 2] * bflo(w.y) + qf[8 * c + 3] * bfhi(w.y) + qf[8 * c + 4] * bflo(w.z) + qf[8 * c + 5] * bfhi(w.z) + qf[8 * c + 6] * bflo(w.w) + qf[8 * c + 7] * bfhi(w.w); }
            if (s > m) { const float f = exp2f(m - s); l *= f;
#pragma unroll
                for (int d = 0; d < 64; ++d) acc[d] *= f;
                m = s; }
            const float p = exp2f(s - m); l += p;
            const bf16* vr = Vb + (size_t)key * vp;
#pragma unroll
            for (int c = 0; c < 8; ++c) { const v4u w = *(const v4u*)(vr + 8 * c);
                acc[8 * c + 0] += p * bflo(w.x); acc[8 * c + 1] += p * bfhi(w.x); acc[8 * c + 2] += p * bflo(w.y); acc[8 * c + 3] += p * bfhi(w.y); acc[8 * c + 4] += p * bflo(w.z); acc[8 * c + 5] += p * bfhi(w.z); acc[8 * c + 6] += p * bflo(w.w); acc[8 * c + 7] += p * bfhi(w.w); }
        }
    }
    float M = wave_max(m); if (has_sink) M = fmaxf(M, sink2);
    const float f = (m == -INFINITY) ? 0.f : exp2f(m - M);
    float L = wave_sum(l * f); if (has_sink) L += exp2f(sink2 - M);
    float mine = 0.f;
#pragma unroll
    for (int d = 0; d < 64; ++d) { const float t = wave_sum(acc[d] * f); if (lane == d) mine = t; }
    y[lane] = (bf16)f2bf(mine / L * bf2f(y[lane]));
}
__device__ __forceinline__ void ph_attn_naive(Frame& F, int l) {
    const bf16* ZS = (const bf16*)(F.ws + WS_ZS); const bf16* MQ = (const bf16*)(F.ws + WS_MQ); const bf16* MKV = (const bf16*)(F.ws + WS_MKV); const bf16* MK = (const bf16*)(F.ws + WS_MK);
    bf16* Y = (bf16*)(F.ws + WS_G);
    const long nitems = (long)NROWS * 12;
    for (long it = F.gw; it < nitems; it += F.NGW) {
        const int hb = (int)(it % 12); const int row = (int)(it / 12);
        const int b = row / TPB, j = row % TPB; const bool lat = j >= CTXL;
        if (!lat && l == NLAYER - 1) continue;
        const size_t r0 = (size_t)b * TPB;
        const int br = hb >> 2, h = hb & 3;
        bf16* y = Y + (size_t)row * 1024 + br * 256 + h * 64;
        if (br == 0) {
            attn_row_naive<96>(MQ + (size_t)row * 512 + h * 96, MK + r0 * 384 + h * 96, 384, MKV + r0 * 512 + h * 128 + 64, 512, CTXL, CTXL, lat ? TPB : CTXL, false, 0.f, y, F.lane);
        } else if (br == 1) {
            const int t = j - CTXL; int lo = CTXL, hi = CTXL;
            if (lat) { lo = CTXL + (t - 128 < 0 ? 0 : t - 128); hi = CTXL + (t + 128 > SEQ - 1 ? SEQ - 1 : t + 128) + 1; }
            attn_row_naive<64>(ZS + (size_t)row * ZS_P + ZC_SQ + h * 64, ZS + r0 * ZS_P + ZC_SK + (h >> 1) * 64, ZS_P, ZS + r0 * ZS_P + ZC_SV + (h >> 1) * 64, ZS_P, CTXL, lo, hi, true, F.in(I_SINK)[l * 4 + h] * LOG2E, y, F.lane);
        } else {
            attn_row_naive<64>(ZS + (size_t)row * ZS_P + ZC_AQ + h * 64, ZS + r0 * ZS_P + ZC_AK + (h >> 1) * 64, ZS_P, ZS + r0 * ZS_P + ZC_AV + (h >> 1) * 64, ZS_P, CTXL, CTXL, lat ? TPB : CTXL, false, 0.f, y, F.lane);
        }
    }
}

__device__ __forceinline__ void ph_lru_conv(Frame& F, int l) {
    const bf16* ZS = (const bf16*)(F.ws + WS_ZS); float* U = (float*)(F.ws + WS_U);
    const float* cw = F.in(I_CONVW) + l * 4 * 256; const float* cb = F.in(I_CONVB) + l * 256;
    const int gt = F.vcu * NTHREADS + F.tid, ngt = F.G * NTHREADS;
    for (int idx = gt; idx < NROWS * 256; idx += ngt) {
        const int row = idx >> 8, c = idx & 255, b = row / TPB, j = row % TPB;
        int s0, len, jj; if (j < CTXL) { s0 = b * TPB; len = CTXL; jj = j; } else { s0 = b * TPB + CTXL; len = SEQ; jj = j - CTXL; }
        float acc = cb[c];
#pragma unroll
        for (int i = 0; i < 4; ++i) { const int t = jj + i - 2; if (t >= 0 && t < len) acc += cw[i * 256 + c] * bf2f(ZS[(size_t)(s0 + t) * ZS_P + ZC_LRU + c]); }
        U[idx] = acc;
    }
}
__device__ __forceinline__ void ph_lru_scan(Frame& F, int l, int dir) {
    const float* U = (const float*)(F.ws + WS_U); float* HF = (float*)(F.ws + WS_HF); bf16* Y = (bf16*)(F.ws + WS_G);
    const int g = blockIdx.x * NTHREADS + F.tid;
    if (g < NB * 256) {
    const int b = g >> 8, c = g & 255, k = c >> 6, jc = c & 63;
    const float* wr = F.in(I_LWR) + ((((size_t)l * 2 + dir) * 4 + k) * 64) * 64 + jc;
    const float* wi = F.in(I_LWI) + ((((size_t)l * 2 + dir) * 4 + k) * 64) * 64 + jc;
    float wrr[64], wii[64];
#pragma unroll
    for (int i = 0; i < 64; ++i) { wrr[i] = wr[i * 64]; wii[i] = wi[i * 64]; }
    const float br = F.in(I_LBR)[(l * 2 + dir) * 256 + c], bi = F.in(I_LBI)[(l * 2 + dir) * 256 + c];
    const float lam = F.in(I_LAM)[(l * 2 + dir) * 256 + c];
    const float sp = log1pf(expf(-lam));
    float h = 0.f;
    for (int s = 0; s < TPB; ++s) {
        const int j = dir == 0 ? s : (s < CTXL ? CTXL - 1 - s : TPB + CTXL - 1 - s);
        const size_t row = (size_t)b * TPB + j;
        const float* ub = U + row * 256 + k * 64;
        float rp = br, ip = bi;
#pragma unroll
        for (int i = 0; i < 64; ++i) { const float uv = ub[i]; rp += uv * wrr[i]; ip += uv * wii[i]; }
        const float r = 1.0f / (1.0f + expf(-rp)), ig = 1.0f / (1.0f + expf(-ip));
        const float la = -8.0f * r * sp; const float a = expf(la);
        const float bx = sqrtf(-expm1f(2.0f * la)) * (ig * ub[jc]);
        h = a * h + bx;
        if (dir == 0) HF[row * 256 + c] = h;
        else { bf16* y = Y + row * 1024 + 768 + c; *y = (bf16)f2bf((HF[row * 256 + c] + h) * bf2f(*y)); }
    }
    }
}
__device__ __forceinline__ void ph_mixsum(Frame& F) {
    const bf16* S = (const bf16*)(F.ws + WS_S); bf16* MIX = (bf16*)(F.ws + WS_H);
    const int gt = F.vcu * NTHREADS + F.tid, ngt = F.G * NTHREADS;
    for (int idx = gt; idx < NROWS * 128; idx += ngt) {
        const int row = idx >> 7, c8 = (idx & 127) * 8; float s[8] = {0.f, 0.f, 0.f, 0.f, 0.f, 0.f, 0.f, 0.f};
#pragma unroll
        for (int k = 0; k < 4; ++k) { const v4u w = *(const GAS v4u*)(S + (size_t)row * 4096 + k * 1024 + c8);
            s[0] += bflo(w.x); s[1] += bfhi(w.x); s[2] += bflo(w.y); s[3] += bfhi(w.y); s[4] += bflo(w.z); s[5] += bfhi(w.z); s[6] += bflo(w.w); s[7] += bfhi(w.w); }
        v4u o; o.x = pk2(s[0], s[1]); o.y = pk2(s[2], s[3]); o.z = pk2(s[4], s[5]); o.w = pk2(s[6], s[7]);
        *(GAS v4u*)(MIX + (size_t)row * 1024 + c8) = o;
    }
}
namespace att {
typedef short bf16x8 __attribute__((ext_vector_type(8)));
typedef short s16x4 __attribute__((ext_vector_type(4)));
typedef short v4i16_t __attribute__((ext_vector_type(4)));
typedef float f32x16 __attribute__((ext_vector_type(16)));
typedef unsigned u32x4 __attribute__((ext_vector_type(4)));
typedef __attribute__((address_space(3))) const char* lds_cptr;
typedef float f32x2_t __attribute__((ext_vector_type(2))); typedef __bf16 bf16x2_t __attribute__((ext_vector_type(2)));
__device__ __forceinline__ int crow(int r, int hi) { return (r & 3) + 8 * (r >> 2) + 4 * hi; }
__device__ __forceinline__ void glds16(const void* gsrc, unsigned lds_dst) { unsigned keep;
    asm volatile("s_mov_b32 %0, m0\n\ts_mov_b32 m0, %2\n\ts_nop 0\n\tglobal_load_lds_dwordx4 %1, off\n\ts_mov_b32 m0, %0" : "=&s"(keep) : "v"(gsrc), "s"(lds_dst) : "memory"); }
__device__ __forceinline__ unsigned cvtpk(float lo, float hi) { f32x2_t v = {lo, hi}; bf16x2_t b = __builtin_convertvector(v, bf16x2_t); return __builtin_bit_cast(unsigned, b); }
__device__ __forceinline__ s16x4 vtr(lds_cptr p) { return __builtin_bit_cast(s16x4, __builtin_amdgcn_ds_read_tr16_b64_v4i16((__attribute__((address_space(3))) v4i16_t*)p)); }
__device__ __forceinline__ float halfswap_max(float m) { auto rr = __builtin_amdgcn_permlane32_swap(__float_as_uint(m), __float_as_uint(m), false, false); return fmaxf(__uint_as_float(rr[0]), __uint_as_float(rr[1])); }
__device__ __forceinline__ float halfswap_sum(float m) { auto rr = __builtin_amdgcn_permlane32_swap(__float_as_uint(m), __float_as_uint(m), false, false); return __uint_as_float(rr[0]) + __uint_as_float(rr[1]); }

template <int DQK> struct Cfg {
    static constexpr int KCH = DQK / 8, KSLOT = KCH * 1024, NKI = (KCH + 7) / 8, NI = NKI + 1;
    static constexpr int LDS_K = 0, LDS_V = 3 * KSLOT, LDS_WS = LDS_V + 3 * 8192, LDS_OST = LDS_WS + 8 * 256, BYTES = LDS_OST + 8 * 4096;
};
#define ATT_WAIT_BAR(N) asm volatile("s_waitcnt vmcnt(" #N ") lgkmcnt(0)\n\ts_barrier" ::: "memory")

struct UnitDesc {
    const unsigned short* Q; int qp;
    const unsigned short* K; int kp;
    const unsigned short* V; int vp;
    unsigned short* Y;
    int NT;
    int lat_row0;
    int qpos0, spos0;
    int has_sink; float sink2;
};

template <int DQK, bool SWA>
__device__ __forceinline__ void attn_unit(LAS unsigned char* ldsb, const UnitDesc& U, const int tid) {
    using C = Cfg<DQK>;
    const int lane = tid & 63, r32 = lane & 31, hi = lane >> 5; const int wid = __builtin_amdgcn_readfirstlane(tid >> 6);
    const unsigned lds0 = (unsigned)(uintptr_t)ldsb;
    LAS float* wsf = (LAS float*)(ldsb + C::LDS_WS) + wid * 64;
    const int kp = U.kp, vp = U.vp;
    const int kc1 = (C::NKI == 2 && wid < 4) ? wid + 8 : wid;
    const unsigned short* ksrc0 = U.K + (size_t)lane * kp + wid * 8;
    const unsigned short* ksrc1 = U.K + (size_t)lane * kp + kc1 * 8;
    const unsigned short* vsrc = U.V + (size_t)(16 * (wid & 3) + (lane >> 2)) * vp + (wid >> 2) * 32 + (lane & 3) * 8;
    const unsigned kdst0 = lds0 + C::LDS_K + wid * 1024, kdst1 = lds0 + C::LDS_K + kc1 * 1024, vdst = lds0 + C::LDS_V + wid * 1024;
    const int NT = U.NT;
#define ATT_KROW(t) (SWA ? ((t) < 4 ? 64 * (t) : U.lat_row0 + 64 * ((t) - 4)) : 64 * (t))
#define ATT_DMA(t, slot) do { const size_t ro_ = (size_t)ATT_KROW(t); \
        glds16(ksrc0 + ro_ * kp, (unsigned)__builtin_amdgcn_readfirstlane(kdst0 + (slot) * C::KSLOT)); \
        if (C::NKI == 2) glds16(ksrc1 + ro_ * kp, (unsigned)__builtin_amdgcn_readfirstlane(kdst1 + (slot) * C::KSLOT)); \
        glds16(vsrc + ro_ * vp, (unsigned)__builtin_amdgcn_readfirstlane(vdst + (slot) * 8192)); } while (0)
    ATT_DMA(0, 0);
    if (NT > 1) ATT_DMA(1, 1);
    bf16x8 qr[DQK / 16];
    { const unsigned short* qw = U.Q + (size_t)(wid * 32 + r32) * U.qp + hi * 8;
#pragma unroll
      for (int d0 = 0; d0 < DQK / 16; ++d0) qr[d0] = *(const bf16x8*)(qw + d0 * 16); }
    float m = -INFINITY, l = 0.f;
    f32x16 o[2]; o[0] = f32x16{}; o[1] = f32x16{};
    if (NT > 1) { if (C::NI == 2) ATT_WAIT_BAR(2); else ATT_WAIT_BAR(3); } else ATT_WAIT_BAR(0);
    const int qpos = U.qpos0 + wid * 32 + r32;
    int slot = 0;
    for (int t = 0; t < NT; ++t) {
        if (t + 2 < NT) { const int s2 = (slot >= 1) ? slot - 1 : 2; ATT_DMA(t + 2, s2); }
        f32x16 p0 = f32x16{}, p1 = f32x16{};
        { const lds_cptr kb = (lds_cptr)(ldsb + C::LDS_K) + slot * C::KSLOT + hi * 1024 + r32 * 16;
#pragma unroll
          for (int d0 = 0; d0 < DQK / 16; ++d0) {
              const bf16x8 b0 = *(const __attribute__((address_space(3))) bf16x8*)(kb + d0 * 2048);
              const bf16x8 b1 = *(const __attribute__((address_space(3))) bf16x8*)(kb + d0 * 2048 + 512);
              p0 = __builtin_amdgcn_mfma_f32_32x32x16_bf16(b0, qr[d0], p0, 0, 0, 0);
              p1 = __builtin_amdgcn_mfma_f32_32x32x16_bf16(b1, qr[d0], p1, 0, 0, 0); } }
        if (SWA) { if (t >= 4 && U.qpos0 >= 0) { const int sb = U.spos0 + 64 * (t - 4) + 4 * hi;
#pragma unroll
            for (int r = 0; r < 16; ++r) { const int dd = qpos - (sb + (r & 3) + 8 * (r >> 2));
                if (dd > 128 || dd < -128) p0[r] = -INFINITY;
                if (dd - 32 > 128 || dd - 32 < -128) p1[r] = -INFINITY; } } }
        float rm = fmaxf(p0[0], p1[0]);
#pragma unroll
        for (int r = 1; r < 16; ++r) rm = fmaxf(rm, fmaxf(p0[r], p1[r]));
        rm = halfswap_max(rm);
        if (__any(rm > m)) {
            const float mn = fmaxf(m, rm); const float alpha = __builtin_amdgcn_exp2f(m - mn);
            l *= alpha; m = mn;
            if (hi == 0) wsf[r32] = alpha;
            asm volatile("s_waitcnt lgkmcnt(0)" ::: "memory");
#pragma unroll
            for (int r = 0; r < 16; ++r) { const float f = wsf[crow(r, hi)]; o[0][r] *= f; o[1][r] *= f; }
        }
        float ls = 0.f;
#pragma unroll
        for (int r = 0; r < 16; ++r) { p0[r] = __builtin_amdgcn_exp2f(p0[r] - m); p1[r] = __builtin_amdgcn_exp2f(p1[r] - m); ls += p0[r] + p1[r]; }
        l += ls;
        u32x4 pw[4];
        pw[0] = (u32x4){cvtpk(p0[0], p0[1]), cvtpk(p0[2], p0[3]), cvtpk(p0[4], p0[5]), cvtpk(p0[6], p0[7])};
        pw[1] = (u32x4){cvtpk(p0[8], p0[9]), cvtpk(p0[10], p0[11]), cvtpk(p0[12], p0[13]), cvtpk(p0[14], p0[15])};
        pw[2] = (u32x4){cvtpk(p1[0], p1[1]), cvtpk(p1[2], p1[3]), cvtpk(p1[4], p1[5]), cvtpk(p1[6], p1[7])};
        pw[3] = (u32x4){cvtpk(p1[8], p1[9]), cvtpk(p1[10], p1[11]), cvtpk(p1[12], p1[13]), cvtpk(p1[14], p1[15])};
        { const lds_cptr vb = (lds_cptr)(ldsb + C::LDS_V) + slot * 8192 + ((lane >> 4) & 1) * 32 + (lane & 3) * 8 + (4 * hi + ((lane & 15) >> 2)) * 64;
#pragma unroll
          for (int d0 = 0; d0 < 2; ++d0)
#pragma unroll
              for (int ks = 0; ks < 4; ++ks) {
                  const s16x4 lo = vtr(vb + d0 * 4096 + ks * 1024), hh = vtr(vb + d0 * 4096 + ks * 1024 + 512);
                  const bf16x8 vf = (bf16x8){lo[0], lo[1], lo[2], lo[3], hh[0], hh[1], hh[2], hh[3]};
                  o[d0] = __builtin_amdgcn_mfma_f32_32x32x16_bf16(__builtin_bit_cast(bf16x8, pw[ks]), vf, o[d0], 0, 0, 0); } }
        if (t + 1 < NT) { if (t + 2 < NT) { if (C::NI == 2) ATT_WAIT_BAR(2); else ATT_WAIT_BAR(3); } else ATT_WAIT_BAR(0); }
        slot = (slot == 2) ? 0 : slot + 1;
    }
    l = halfswap_sum(l);
    if (U.has_sink) l += __builtin_amdgcn_exp2f(U.sink2 - m);
    if (hi == 0) wsf[32 + r32] = l;
    asm volatile("s_waitcnt lgkmcnt(0)" ::: "memory");
    { LAS unsigned short* stg = (LAS unsigned short*)(ldsb + C::LDS_OST) + wid * 2048;
#pragma unroll
      for (int r = 0; r < 16; ++r) { const int orow = crow(r, hi); const float rl = __builtin_amdgcn_rcpf(wsf[32 + orow]);
          stg[orow * 64 + r32] = (unsigned short)f2bf(o[0][r] * rl); stg[orow * 64 + 32 + r32] = (unsigned short)f2bf(o[1][r] * rl); }
      asm volatile("s_waitcnt lgkmcnt(0)" ::: "memory");
      unsigned short* yw = U.Y + (size_t)(wid * 32) * 1024;
#pragma unroll
      for (int i = 0; i < 4; ++i) { const int row = i * 8 + (lane >> 3), ch = lane & 7;
          const u32x4 ov = *(const LAS u32x4*)(stg + row * 64 + ch * 8);
          u32x4* gp = (u32x4*)(yw + (size_t)row * 1024 + ch * 8); const u32x4 g = *gp;
          u32x4 w; w.x = pk2(bflo(ov.x) * bflo(g.x), bfhi(ov.x) * bfhi(g.x)); w.y = pk2(bflo(ov.y) * bflo(g.y), bfhi(ov.y) * bfhi(g.y));
          w.z = pk2(bflo(ov.z) * bflo(g.z), bfhi(ov.z) * bfhi(g.z)); w.w = pk2(bflo(ov.w) * bflo(g.w), bfhi(ov.w) * bfhi(g.w));
          *gp = w; } }
    asm volatile("s_waitcnt vmcnt(0) lgkmcnt(0)\n\ts_barrier" ::: "memory");
#undef ATT_KROW
#undef ATT_DMA
}
}

__device__ __forceinline__ void ph_attn(Frame& F, int l) {
    unsigned short* ZS = (unsigned short*)(F.ws + WS_ZS); unsigned short* MQ = (unsigned short*)(F.ws + WS_MQ); unsigned short* MKV = (unsigned short*)(F.ws + WS_MKV); unsigned short* MK = (unsigned short*)(F.ws + WS_MK);
    unsigned short* Y = (unsigned short*)(F.ws + WS_G);
    LAS unsigned char* lds = F.lds + RING_OFF;
    const int u = F.vcu;
    const bool ctxq = (l == 0);
    for (int uu = u; uu < 256; uu += F.G) { const int bh = uu >> 4, qb = uu & 15, b = bh >> 2, h = bh & 3; const size_t r0 = (size_t)b * TPB, rq = r0 + CTXL + qb * 256;
        att::UnitDesc U{MQ + rq * 512 + h * 96, 512, MK + r0 * 384 + h * 96, 384, MKV + r0 * 512 + h * 128 + 64, 512, Y + rq * 1024 + h * 64, TPB / 64, 0, -1, 0, 0, 0.f};
        att::attn_unit<96, false>(lds, U, F.tid); }
    for (int uu = u; uu < 256; uu += F.G) { const int qb = uu & 15, g = (uu >> 4) & 1, kvh = (uu >> 5) & 1, b = uu >> 6, qh = kvh * 2 + g; const size_t r0 = (size_t)b * TPB, rq = r0 + CTXL + qb * 256;
        att::UnitDesc U{ZS + rq * ZS_P + ZC_AQ + qh * 64, ZS_P, ZS + r0 * ZS_P + ZC_AK + kvh * 64, ZS_P, ZS + r0 * ZS_P + ZC_AV + kvh * 64, ZS_P, Y + rq * 1024 + 512 + qh * 64, TPB / 64, 0, -1, 0, 0, 0.f};
        att::attn_unit<64, false>(lds, U, F.tid); }
    for (int uu = u; uu < 256; uu += F.G) { const int qb = uu & 15, g = (uu >> 4) & 1, kvh = (uu >> 5) & 1, b = uu >> 6, qh = kvh * 2 + g; const size_t r0 = (size_t)b * TPB, rq = r0 + CTXL + qb * 256;
        const int q0 = qb * 256, s0 = (q0 - 128 < 0) ? 0 : q0 - 128, s1 = (q0 + 384 > SEQ) ? SEQ : q0 + 384;
        att::UnitDesc U{ZS + rq * ZS_P + ZC_SQ + qh * 64, ZS_P, ZS + r0 * ZS_P + ZC_SK + kvh * 64, ZS_P, ZS + r0 * ZS_P + ZC_SV + kvh * 64, ZS_P, Y + rq * 1024 + 256 + qh * 64, 4 + (s1 - s0) / 64, CTXL + s0, q0, s0, 1, F.in(I_SINK)[l * 4 + qh] * LOG2E};
        att::attn_unit<64, true>(lds, U, F.tid); }
    if (ctxq) for (int uu = u; uu < 48; uu += F.G) { const int br = uu >> 4, b = (uu >> 2) & 3, h = uu & 3; const size_t r0 = (size_t)b * TPB;
        if (br == 0) { att::UnitDesc U{MQ + r0 * 512 + h * 96, 512, MK + r0 * 384 + h * 96, 384, MKV + r0 * 512 + h * 128 + 64, 512, Y + r0 * 1024 + h * 64, 4, 0, -1, 0, 0, 0.f};
            att::attn_unit<96, false>(lds, U, F.tid); }
        else if (br == 1) { att::UnitDesc U{ZS + r0 * ZS_P + ZC_SQ + h * 64, ZS_P, ZS + r0 * ZS_P + ZC_SK + (h >> 1) * 64, ZS_P, ZS + r0 * ZS_P + ZC_SV + (h >> 1) * 64, ZS_P, Y + r0 * 1024 + 256 + h * 64, 4, CTXL, -1, 0, 1, F.in(I_SINK)[l * 4 + h] * LOG2E};
            att::attn_unit<64, true>(lds, U, F.tid); }
        else { att::UnitDesc U{ZS + r0 * ZS_P + ZC_AQ + h * 64, ZS_P, ZS + r0 * ZS_P + ZC_AK + (h >> 1) * 64, ZS_P, ZS + r0 * ZS_P + ZC_AV + (h >> 1) * 64, ZS_P, Y + r0 * 1024 + 512 + h * 64, 4, 0, -1, 0, 0, 0.f};
            att::attn_unit<64, false>(lds, U, F.tid); } }
}
constexpr size_t WS_SUM = 253 * MiB;
constexpr size_t WS_HL = WS_U, WS_CP = WS_HF;
constexpr int NCHUNK = TPB / 64;
__device__ __forceinline__ void ph_lru1(Frame& F, int l) {
    const unsigned short* ZS = (const unsigned short*)(F.ws + WS_ZS); unsigned short* HL = (unsigned short*)(F.ws + WS_HL); unsigned short* CP = (unsigned short*)(F.ws + WS_CP);
    f32x2v* SUM = (f32x2v*)(F.ws + WS_SUM);
    LAS float* u = (LAS float*)(F.lds + RING_OFF);
    const float* cw = F.in(I_CONVW) + l * 4 * 256; const float* cb = F.in(I_CONVB) + l * 256;
    const int tid = F.tid, d = tid >> 8, c = tid & 255, k = c >> 6, jc = c & 63;
    for (int unit = F.vcu; unit < NB * NCHUNK; unit += F.G) {
        const int b = unit / NCHUNK, ci = unit % NCHUNK;
        int s0row, len, t0; if (ci < 4) { s0row = b * TPB; len = CTXL; t0 = ci * 64; } else { s0row = b * TPB + CTXL; len = SEQ; t0 = (ci - 4) * 64; }
        for (int idx = tid; idx < 64 * 256; idx += NTHREADS) { const int t = idx >> 8, cc = idx & 255; float acc = cb[cc];
#pragma unroll
            for (int i = 0; i < 4; ++i) { const int tt = t0 + t + i - 2; if (tt >= 0 && tt < len) acc += cw[i * 256 + cc] * bf2f(ZS[(size_t)(s0row + tt) * ZS_P + ZC_LRU + cc]); }
            u[idx] = acc; }
        __syncthreads();
        {
            const float* wt = (const float*)(F.ws + WS_LWT) + ((((size_t)l * 2 + d) * 2) * 256 + c) * 64;
            float wrr[64], wii[64];
#pragma unroll
            for (int i = 0; i < 64; i += 4) { const f32x4 a4 = *(const f32x4*)(wt + i), b4 = *(const f32x4*)(wt + 256 * 64 + i);
                wrr[i] = a4.x; wrr[i + 1] = a4.y; wrr[i + 2] = a4.z; wrr[i + 3] = a4.w; wii[i] = b4.x; wii[i + 1] = b4.y; wii[i + 2] = b4.z; wii[i + 3] = b4.w; }
            const float br = F.in(I_LBR)[(l * 2 + d) * 256 + c], bi = F.in(I_LBI)[(l * 2 + d) * 256 + c];
            const float sp8 = ((const float*)(F.ws + WS_SP))[(l * 2 + d) * 256 + c];
            float h = 0.f, P = 1.f;
#pragma unroll 1
            for (int s = 0; s < 64; ++s) {
                const int t = d == 0 ? s : 63 - s;
                const LAS float* ub = u + t * 256 + k * 64;
                float rp = br, ip = bi;
#pragma unroll
                for (int i = 0; i < 64; i += 4) { const f32x4 uv = *(const LAS f32x4*)(ub + i);
                    rp += uv.x * wrr[i] + uv.y * wrr[i + 1] + uv.z * wrr[i + 2] + uv.w * wrr[i + 3]; ip += uv.x * wii[i] + uv.y * wii[i + 1] + uv.z * wii[i + 2] + uv.w * wii[i + 3]; }
                const float r = sigmoid_f(rp), ig = sigmoid_f(ip);
                const float a = __builtin_amdgcn_exp2f(-r * sp8);
                const float bx = __builtin_amdgcn_sqrtf(1.0f - a * a) * (ig * ub[jc]);
                h = a * h + bx; P *= a;
                const size_t o = ((size_t)(s0row + t0 + t) * 2 + d) * 256 + c;
                HL[o] = (unsigned short)f2bf(h); CP[o] = (unsigned short)f2bf(P);
            }
            SUM[((size_t)(b * NCHUNK + ci) * 2 + d) * 256 + c] = (f32x2v){P, h};
        }
        __syncthreads();
    }
}
__device__ __forceinline__ void ph_lru2(Frame& F, int l) {
    const unsigned short* HL = (const unsigned short*)(F.ws + WS_HL); const unsigned short* CP = (const unsigned short*)(F.ws + WS_CP);
    const f32x2v* SUM = (const f32x2v*)(F.ws + WS_SUM); unsigned short* Y = (unsigned short*)(F.ws + WS_G);
    const int tid = F.tid, hf = tid >> 8, c = tid & 255; const bool last = (l == NLAYER - 1);
    for (int unit = F.vcu; unit < NB * NCHUNK; unit += F.G) {
        const int b = unit / NCHUNK, ci = unit % NCHUNK;
        if (last && ci < 4) continue;
        const f32x2v* sb = SUM + (size_t)b * NCHUNK * 2 * 256 + c;
        float cf = 0.f, cbk = 0.f;
        for (int j = 0; j < ci; ++j) { const f32x2v s = sb[(size_t)(j * 2 + 0) * 256]; cf = s.x * cf + s.y; }
        if (ci < 4) { for (int j = 3; j > ci; --j) { const f32x2v s = sb[(size_t)(j * 2 + 1) * 256]; cbk = s.x * cbk + s.y; } }
        else { for (int j = 3; j >= 0; --j) { const f32x2v s = sb[(size_t)(j * 2 + 1) * 256]; cbk = s.x * cbk + s.y; }
               for (int j = NCHUNK - 1; j > ci; --j) { const f32x2v s = sb[(size_t)(j * 2 + 1) * 256]; cbk = s.x * cbk + s.y; } }
        const size_t row0 = (size_t)b * TPB + ci * 64 + hf * 32;
        for (int t = 0; t < 32; ++t) { const size_t row = row0 + t; const size_t o = (row * 2) * 256 + c;
            const float v = bf2f(HL[o]) + bf2f(CP[o]) * cf + bf2f(HL[o + 256]) + bf2f(CP[o + 256]) * cbk;
            unsigned short* y = Y + row * 1024 + 768 + c; *y = (unsigned short)f2bf(v * bf2f(*y)); }
    }
}
constexpr int NPL = 10;
enum { PH_H = 0, PH_G1, PH_POST1, PH_G2, PH_POST2, PH_ATT, PH_SG, PH_PG, PH_MIX, PH_OG };
constexpr int NPHASES = 1 + NLAYER * NPL;
#ifndef NAIVE_ATT
#define NAIVE_ATT 0
#endif
#ifndef PHMASK
#define PHMASK 16383
#endif
#ifndef MK_ONE_LAUNCH
#define MK_ONE_LAUNCH 1
#endif

__global__ void __launch_bounds__(NTHREADS, 2) fwd_kernel(Args args) {
    extern __shared__ __attribute__((aligned(16))) unsigned char lds_raw[];
    { LAS unsigned char* l0 = (LAS unsigned char*)lds_raw;
      for (int u = threadIdx.x; u < (LDS_BYTES - LDSCTL_OFF) / 4; u += NTHREADS) ((LAS unsigned*)(l0 + LDSCTL_OFF))[u] = 0u;
      __syncthreads();
      if (args.ph_hi - args.ph_lo > 1) (void)xcd_barrier_post((unsigned*)((gu32*)(args.ws + WS_CTL) + CW_BAR), (volatile LAS unsigned*)(l0 + MISC_OFF) + 8); }

    for (int ph = args.ph_lo; ph < args.ph_hi; ++ph) {
        int z; asm volatile("s_mov_b32 %0, 0" : "=s"(z));
        Frame F;
        F.lds = (LAS unsigned char*)lds_raw + z; F.kin = (const float* const __attribute__((address_space(4)))*)((const __attribute__((address_space(4))) char*)__builtin_amdgcn_kernarg_segment_ptr() + z); F.ws = args.ws + z; F.out = args.out + z; F.z = z;
        F.tid = threadIdx.x + z; F.lane = F.tid & 63; F.wave = __builtin_amdgcn_readfirstlane(F.tid >> 6);
        F.G = gridDim.x + z; { const int bx = blockIdx.x + z; F.vcu = (F.G % 8 == 0) ? (bx % 8) * (F.G / 8) + bx / 8 : bx; }
        F.gw = F.vcu * NWAVES + F.wave; F.NGW = F.G * NWAVES;
        bool is_gemm = false;
        pg8::Gemm g{nullptr, nullptr, NROWS, 256, 1024, 1024, 31, 0};
        pg8::Order S; S.init(1, 1, F.G, (int)blockIdx.x + z, 0);
        pg8::EpiU E{pg8::EM_PLAIN, 0, F.ws, nullptr, nullptr, nullptr, 0, 0, 0, 0, 1 << 20};
        if (ph == 0) { if (PHMASK & 8192) p0_prologue(F); }
        else {
            const int l = (ph - 1) / NPL, p = (ph - 1) % NPL;
            unsigned char* wl = F.ws + WS_W + (size_t)l * W_LAYER;
            const bool last = (l == NLAYER - 1);
            const int nMc = last ? 64 : NROWS / 256, lat = last ? 1 : 0;
            E.l = l;
            if (p == PH_H && (PHMASK & 1)) { ph_hnorm(F, l); }
            else if (p == PH_G1 && (PHMASK & 2)) {
                is_gemm = true; g.A = (const bf16*)(F.ws + WS_H); g.Bt = (const bf16*)(wl + WO_W1); g.N = N1; g.K = 1024; g.lda = 1024;
                S.init(NROWS / 256, N1 / 256, F.G, (int)blockIdx.x + z, 0);
                E.mode = pg8::EM_SILU2; E.oA = WS_ZS; E.ldc = ZS_P; E.oB = WS_G; E.ldc2 = 1024; E.split_tile = 7;
            }
            else if (p == PH_POST1 && (PHMASK & 4)) { ph_lru1(F, l); ph_post1(F, l); }
            else if (p == PH_G2 && (PHMASK & 8)) {
                is_gemm = true; g.A = (const bf16*)(F.ws + WS_ZS); g.Bt = (const bf16*)(wl + WO_UQ); g.N = 1024; g.K = 256; g.lda = ZS_P; g.a_shift = 1; g.a_step = 512;
                S.init(NROWS / 256, 4, F.G, (int)blockIdx.x + z, 0);
                E.mode = pg8::EM_PLAIN; E.oA = WS_MQ; E.ldc = 512; E.oB = WS_MKV; E.ldc2 = 512; E.split_tile = 2;
            }
            else if (p == PH_POST2 && (PHMASK & 16)) { ph_post2(F, l); }
            else if (p == PH_ATT && (PHMASK & 32)) {
#if NAIVE_ATT
                ph_attn_naive(F, l);
#else
                ph_attn(F, l);
#endif
                ph_lru2(F, l); }
            else if (p == PH_SG && (PHMASK & 512)) {
                is_gemm = true; g.A = (const bf16*)(F.ws + WS_H); g.Bt = (const bf16*)(wl + WO_W1) + (size_t)N1 * 1024; g.N = 4096; g.K = 1024; g.lda = 1024;
                S.init(nMc, 16, F.G, (int)blockIdx.x + z, lat);
                E.mode = pg8::EM_SIG; E.oA = WS_S; E.ldc = 4096;
            }
            else if (p == PH_PG && (PHMASK & 1024)) {
                is_gemm = true; g.A = (const bf16*)(F.ws + WS_G); g.Bt = (const bf16*)(wl + WO_WB); g.N = 4096; g.K = 256; g.lda = 1024; g.a_shift = 2; g.a_step = 512;
                S.init(nMc, 16, F.G, (int)blockIdx.x + z, lat);
                E.mode = pg8::EM_MUL; E.oA = WS_S; E.ldc = 4096;
            }
            else if (p == PH_MIX && (PHMASK & 2048)) { ph_mixsum(F); }
            else if (p == PH_OG && (PHMASK & 4096)) {
                is_gemm = true; g.A = (const bf16*)(F.ws + WS_H); g.Bt = (const bf16*)(wl + WO_WO); g.N = 1024; g.K = 1024; g.lda = 1024;
                S.init(nMc, 4, F.G, (int)blockIdx.x + z, lat);
                E.mode = pg8::EM_RES; E.xin = (l == 0) ? F.in(I_X) : (const float*)F.out; E.xout = F.out; E.cin0 = F.in(I_CTX); E.oA = WS_MOD; E.oB = WS_CTX1;
            }
        }
        if (is_gemm) pg8::gemm_phase<pg8::EpiU, pg8::Order, true, true>(F.lds + RING_OFF, g, S, E, F.tid);
        if (ph + 1 < args.ph_hi) {
            int z2; asm volatile("s_mov_b32 %0, 0" : "=s"(z2));
            XcdBarrier bar; bar.bar = (unsigned*)((gu32*)(args.ws + z2 + WS_CTL) + CW_BAR); bar.x = xb_xcc_id(); bar.st = (volatile LAS unsigned*)((LAS unsigned char*)lds_raw + z2 + MISC_OFF) + 8;
            xcd_barrier(bar);
        }
    }
}

extern "C" void kernel_launch(void* const* d_in, const int* in_sizes, int n_in, void* d_out, int out_size, void* d_ws, size_t ws_size, hipStream_t stream) {
    static int grid = 0;
    if (grid == 0) {
        if (n_in != 28 || out_size != NB * SEQ * DM || ws_size < WS_END) { fprintf(stderr, "kernel_launch: unexpected shapes (n_in %d out %d ws %zu); nothing launched\n", n_in, out_size, ws_size); grid = -1; return; }
        int dev = 0, cus = 0, per_cu = 0;
        if (hipGetDevice(&dev) != hipSuccess || hipDeviceGetAttribute(&cus, hipDeviceAttributeMultiprocessorCount, dev) != hipSuccess) { grid = -1; return; }
        if (hipFuncSetAttribute((const void*)fwd_kernel, hipFuncAttributeMaxDynamicSharedMemorySize, LDS_BYTES) != hipSuccess) { fprintf(stderr, "kernel_launch: hipFuncSetAttribute failed\n"); grid = -1; return; }
        if (hipOccupancyMaxActiveBlocksPerMultiprocessor(&per_cu, (const void*)fwd_kernel, NTHREADS, LDS_BYTES) != hipSuccess || per_cu < 1) { fprintf(stderr, "kernel_launch: occupancy query says %d\n", per_cu); (void)hipGetLastError(); grid = -1; return; }
        grid = cus;
    }
    if (grid < 0) return;
    (void)hipMemsetAsync((char*)d_ws + WS_CTL, 0, CTL_ZERO_BYTES, stream);
    Args a{};
    for (int i = 0; i < 28; ++i) a.in[i] = (const float*)d_in[i];
    a.out = (float*)d_out; a.ws = (unsigned char*)d_ws;
#if MK_ONE_LAUNCH
    a.ph_lo = 0; a.ph_hi = NPHASES;
    hipLaunchKernelGGL(fwd_kernel, dim3(grid), dim3(NTHREADS), LDS_BYTES, stream, a);
#else
    for (int ph = 0; ph < NPHASES; ++ph) { a.ph_lo = ph; a.ph_hi = ph + 1; hipLaunchKernelGGL(fwd_kernel, dim3(grid), dim3(NTHREADS), LDS_BYTES, stream, a); }
#endif
}
```

```cpp
#include <hip/hip_runtime.h>
#include <cstdio>
#include <cstdint>
#include <cmath>
__device__ __forceinline__ float bflo(unsigned w) { return __uint_as_float(w << 16); }
__device__ __forceinline__ float bfhi(unsigned w) { return __uint_as_float(w & 0xffff0000u); }
__device__ __forceinline__ float sigmoid_f(float v) { return __builtin_amdgcn_rcpf(1.0f + __builtin_amdgcn_exp2f(-1.4426950408889634f * v)); }
namespace pg8 {
#define PG8_LAS __attribute__((address_space(3)))
typedef unsigned short bf16_t;
typedef short bf16x8 __attribute__((ext_vector_type(8)));
typedef float f32x4 __attribute__((ext_vector_type(4)));
typedef unsigned u32x4 __attribute__((ext_vector_type(4)));
constexpr int BM = 256, BK = 64, HALF = 128, HTB = HALF * BK * 2  , STAGE_BYTES = 8 * HTB, NXCD = 8, WGM = 8;

__host__ __device__ __forceinline__ int lds_byte(int r, int c) { const int st = (r >> 4) * 2 + (c >> 5), rr = r & 15, cc = c & 31, ob = rr * 64 + cc * 2; return st * 1024 + (ob ^ (((ob >> 9) & 1) << 5)); }
__host__ __device__ __forceinline__ void stage_rc(int b, int& R, int& C) { const int st = b / 1024, sb = b % 1024, swz = sb ^ (((sb >> 9) & 1) << 5); R = (st >> 1) * 16 + swz / 64; C = (st & 1) * 32 + (swz % 64) / 2; }
__host__ __device__ __forceinline__ int perm32(int rho) { const int n = rho >> 4, i = rho & 15; return 8 * (i >> 2) + 4 * n + (i & 3); }

struct Unit { int pm, pn; };
struct Gemm { const bf16_t* A; const bf16_t* Bt; int M, N, K, lda; int a_shift, a_step; };

struct StaticOrder {
    int nM, nN, nwg, G, c;
    __host__ __device__ void init(int M, int N, int G_, int c_) { nM = M / BM; nN = N / BM; nwg = nM * nN; G = G_; c = c_; }
    __host__ __device__ bool next(int i, Unit& u) const {
        const long L = (long)i * G + c; if (L >= nwg) return false;
        int wgid = (int)L; { const int q = nwg / NXCD, r = nwg % NXCD, xcd = wgid % NXCD, off = wgid / NXCD; wgid = (xcd < r ? xcd * (q + 1) : r * (q + 1) + (xcd - r) * q) + off; }
        const int nig = WGM * nN, gid = wgid / nig, fm = gid * WGM, gsz = (nM - fm) < WGM ? (nM - fm) : WGM;
        u.pm = fm + ((wgid % nig) % gsz); u.pn = (wgid % nig) / gsz; return true;
    }
    __device__ __forceinline__ void a_ready(const Unit&) const {}
    __device__ __forceinline__ void done(const Unit&) const {}
};

__device__ __forceinline__ unsigned cvt_pk_bf16(float lo, float hi) { unsigned r; asm volatile("v_cvt_pk_bf16_f32 %0, %1, %2" : "=v"(r) : "v"(lo), "v"(hi)); return r; }
enum { EM_PLAIN = 0, EM_SILU2 = 1, EM_SIG = 2, EM_MUL = 3, EM_RES = 4 };
struct EpiU {
    static constexpr bool PERM = true, AFTER_DRAIN = false;
    int mode; int l; unsigned char* ws; const float* xin; float* xout; const float* cin0;
    size_t oA, oB; int ldc, ldc2, split_tile;
    __device__ __forceinline__ void operator()(const f32x4 (&acc)[2][2][4][2], const Unit& u, int wr, int wc, int fr, int fq) const {
        if (mode == EM_RES) {
            const int b = u.pm / 17, t0 = u.pm % 17;
            const float* src; float* dst; const float* gate; const float* modl = (const float*)(ws + oA) + (size_t)l * 5 * 3072;
            if (t0 == 0) { float* c1 = (float*)(ws + oB); src = ((l == 0) ? cin0 : (const float*)c1) + (size_t)b * 256 * 1024; dst = c1 + (size_t)b * 256 * 1024; gate = modl + 4 * 3072 + 2048; }
            else { const size_t o = ((size_t)b * 4096 + (size_t)(t0 - 1) * 256) * 1024; src = xin + o; dst = xout + o; gate = modl + b * 3072 + 2048; }
            const int col0 = u.pn * BM + wc * 32 + 8 * fq;
            const char* srcb = (const char*)src; char* dstb = (char*)dst; const char* gb = (const char*)(gate + col0);
            const unsigned off0 = (unsigned)((wr * 64 + fr) * 1024 + col0) * 4u;
#pragma unroll
            for (int ai = 0; ai < 2; ++ai)
#pragma unroll
                for (int m = 0; m < 4; ++m) { const unsigned off = off0 + (unsigned)(ai * HALF + m * 16) * 4096u;
#pragma unroll
                    for (int bj = 0; bj < 2; ++bj)
#pragma unroll
                        for (int n = 0; n < 2; ++n) { const unsigned cb = (unsigned)(bj * HALF + n * 4) * 4u; const f32x4 g = *(const f32x4*)(gb + cb); const f32x4 xo = *(const f32x4*)(srcb + (off + cb));
                            *(f32x4*)(dstb + (off + cb)) = xo + g * acc[ai][bj][m][n]; }
                    asm volatile("" ::: "memory"); }
            return;
        }
        const int row0 = u.pm * BM + wr * 64 + fr; int colt = u.pn * BM; bf16_t* base = (bf16_t*)(ws + oA); int ld = ldc; bool second = false;
        if (u.pn >= split_tile) { base = (bf16_t*)(ws + oB); ld = ldc2; colt -= split_tile * BM; second = true; }
        const bool do_silu = (mode == EM_SILU2) && second;
        const int col0 = colt + wc * 32 + 8 * fq;
#pragma unroll
        for (int ai = 0; ai < 2; ++ai)
#pragma unroll
            for (int m = 0; m < 4; ++m) { bf16_t* rowp = base + (size_t)(row0 + ai * HALF + m * 16) * ld + col0;
#pragma unroll
                for (int bj = 0; bj < 2; ++bj) { f32x4 v0 = acc[ai][bj][m][0], v1 = acc[ai][bj][m][1];
                    if (mode == EM_SIG) {
#pragma unroll
                        for (int e = 0; e < 4; ++e) { v0[e] = sigmoid_f(v0[e]); v1[e] = sigmoid_f(v1[e]); } }
                    if (do_silu) {
#pragma unroll
                        for (int e = 0; e < 4; ++e) { v0[e] = v0[e] * sigmoid_f(v0[e]); v1[e] = v1[e] * sigmoid_f(v1[e]); } }
                    if (mode == EM_MUL) { const u32x4 o = *(const u32x4*)(rowp + bj * HALF);
                        v0[0] *= bflo(o.x); v0[1] *= bfhi(o.x); v0[2] *= bflo(o.y); v0[3] *= bfhi(o.y); v1[0] *= bflo(o.z); v1[1] *= bfhi(o.z); v1[2] *= bflo(o.w); v1[3] *= bfhi(o.w); }
                    u32x4 w; w.x = cvt_pk_bf16(v0[0], v0[1]); w.y = cvt_pk_bf16(v0[2], v0[3]); w.z = cvt_pk_bf16(v1[0], v1[1]); w.w = cvt_pk_bf16(v1[2], v1[3]);
                    *(u32x4*)(rowp + bj * HALF) = w; }
                if (mode == EM_MUL) asm volatile("" ::: "memory"); }
    }
};
struct Order {
    int nM, nN, nwg, G, c, latent_only;
    __device__ void init(int nM_, int nN_, int G_, int c_, int lat) { nM = nM_; nN = nN_; nwg = nM * nN; G = G_; c = c_; latent_only = lat; }
    __device__ bool next(int i, Unit& u) const {
        const long L = (long)i * G + c; if (L >= nwg) return false;
        int wgid = (int)L; { const int q = nwg / NXCD, r = nwg % NXCD, xcd = wgid % NXCD, off = wgid / NXCD; wgid = (xcd < r ? xcd * (q + 1) : r * (q + 1) + (xcd - r) * q) + off; }
        const int nig = WGM * nN, gid = wgid / nig, fm = gid * WGM, gsz = (nM - fm) < WGM ? (nM - fm) : WGM;
        int pm = fm + ((wgid % nig) % gsz); u.pn = (wgid % nig) / gsz; if (latent_only) pm = pm + pm / 16 + 1; u.pm = pm; return true;
    }
    __device__ __forceinline__ void a_ready(const Unit&) const {}
    __device__ __forceinline__ void done(const Unit&) const {}
};
template <class Epi, class Sched, bool ALIGN_EPI = false, bool SP2 = false>
__device__ __forceinline__ void gemm_phase(PG8_LAS unsigned char* lds, const Gemm g, const Sched& S, const Epi& E, const int tid  ) {
    const int wid = __builtin_amdgcn_readfirstlane(tid >> 6), lane = tid & 63, wr = wid >> 2, wc = wid & 3, fr = lane & 15, fq = lane >> 4;
    const int K = g.K, nt = K / BK;
    unsigned voffA[2], voffB[2];
#pragma unroll
    for (int i = 0; i < 2; ++i) { int R, C; stage_rc(tid * 16 + i * 8192, R, C); const int Rb = Epi::PERM ? ((R & ~31) + perm32(R & 31)) : R;
        voffA[i] = (unsigned)(R * g.lda + C) * 2u; voffB[i] = (unsigned)(Rb * K + C) * 2u; }
    const size_t kstep = (size_t)(BK * 2);
    const size_t hstepA = (size_t)HALF * g.lda * 2, hstepB = (size_t)HALF * K * 2;
    const size_t tstepA = 2 * hstepA, tstepB = 2 * hstepB;
    const unsigned ldsw = (unsigned)wid * 1024u;
    const int aoff = lds_byte(wr * 64 + fr, fq * 8), boff = lds_byte(wc * 32 + fr, fq * 8);
#define PG8_SA(b, h) (((b) * 2 + (h)) * HTB)
#define PG8_SB(b, h) ((4 + (b) * 2 + (h)) * HTB)
#define PG8_STAGE(bufoff, gbase, voff) do { _Pragma("unroll") for (int _i = 0; _i < 2; ++_i) \
        __builtin_amdgcn_global_load_lds((const unsigned*)((const char*)(gbase) + (voff)[_i]), (PG8_LAS unsigned*)(lds + (bufoff) + ldsw + _i * 8192), 16, 0, 0); } while (0)
#define PG8_LDA(dst, b, h) do { _Pragma("unroll") for (int m = 0; m < 4; ++m) _Pragma("unroll") for (int k = 0; k < 2; ++k) dst[m][k] = *(const PG8_LAS bf16x8*)(lds + PG8_SA(b, h) + aoff + m * 2048 + k * 1024); } while (0)
#define PG8_LDB(dst, b, h) do { _Pragma("unroll") for (int n = 0; n < 2; ++n) _Pragma("unroll") for (int k = 0; k < 2; ++k) dst[n][k] = *(const PG8_LAS bf16x8*)(lds + PG8_SB(b, h) + boff + n * 2048 + k * 1024); } while (0)
#define PG8_MMA(ai, bj, At, Bt) do { __builtin_amdgcn_s_setprio(1); _Pragma("unroll") for (int m = 0; m < 4; ++m) _Pragma("unroll") for (int n = 0; n < 2; ++n) _Pragma("unroll") for (int k = 0; k < 2; ++k) \
        acc[ai][bj][m][n] = __builtin_amdgcn_mfma_f32_16x16x32_bf16(Bt[n][k], At[m][k], acc[ai][bj][m][n], 0, 0, 0); __builtin_amdgcn_s_setprio(0); } while (0)
#define PG8_WAIT_V(n) asm volatile("s_waitcnt vmcnt(" #n ")" ::: "memory")
#define PG8_WAIT_L(n) asm volatile("s_waitcnt lgkmcnt(" #n ")" ::: "memory")
#define PG8_BAR __builtin_amdgcn_s_barrier()
#define PG8_SCHED __builtin_amdgcn_sched_barrier(0)
    Unit cur, nxt; int ui = 0;
    if (!S.next(0, cur)) return;
    f32x4 acc[2][2][4][2];
#pragma unroll
    for (int a = 0; a < 2; ++a)
#pragma unroll
        for (int b = 0; b < 2; ++b)
#pragma unroll
            for (int m = 0; m < 4; ++m)
#pragma unroll
                for (int n = 0; n < 2; ++n) acc[a][b][m][n] = (f32x4){0.f, 0.f, 0.f, 0.f};
    bf16x8 At[4][2], B0[2][2], B1[2][2];
    const char* cA = (const char*)g.A + (size_t)cur.pm * tstepA + (size_t)(cur.pn >> g.a_shift) * (size_t)g.a_step; const char* cB = (const char*)g.Bt + (size_t)cur.pn * tstepB;
    S.a_ready(cur);
    if constexpr (SP2) {
        PG8_STAGE(PG8_SB(0, 0), cB, voffB); PG8_STAGE(PG8_SB(0, 1), cB + hstepB, voffB); PG8_STAGE(PG8_SA(0, 0), cA, voffA); PG8_STAGE(PG8_SA(0, 1), cA + hstepA, voffA);
        if (wr == 1) PG8_BAR;
        PG8_WAIT_V(2); PG8_BAR;
        PG8_STAGE(PG8_SB(1, 0), cB + kstep, voffB); PG8_STAGE(PG8_SA(1, 0), cA + kstep, voffA); PG8_STAGE(PG8_SB(1, 1), cB + hstepB + kstep, voffB);
        PG8_WAIT_V(6); PG8_BAR;
    } else {
        PG8_STAGE(PG8_SB(0, 0), cB, voffB); PG8_STAGE(PG8_SA(0, 0), cA, voffA); PG8_STAGE(PG8_SB(0, 1), cB + hstepB, voffB); PG8_STAGE(PG8_SA(0, 1), cA + hstepA, voffA);
        if (wr == 1) PG8_BAR;
        PG8_WAIT_V(4); PG8_BAR;
        PG8_STAGE(PG8_SB(1, 0), cB + kstep, voffB); PG8_STAGE(PG8_SA(1, 0), cA + kstep, voffA); PG8_STAGE(PG8_SB(1, 1), cB + hstepB + kstep, voffB);
        PG8_WAIT_V(6); PG8_BAR;
    }
    for (;;) {
        const bool has_next = S.next(ui + 1, nxt);
        const char* nA = has_next ? (const char*)g.A + (size_t)nxt.pm * tstepA + (size_t)(nxt.pn >> g.a_shift) * (size_t)g.a_step : cA; const char* nB = has_next ? (const char*)g.Bt + (size_t)nxt.pn * tstepB : cB;
        for (int t = 0; t < nt; t += 2) {
            const bool last = (t == nt - 2);
            const char* a1 = cA + (size_t)(t + 1) * kstep;
            const char* a2 = last ? nA : cA + (size_t)(t + 2) * kstep; const char* b2 = last ? nB : cB + (size_t)(t + 2) * kstep;
            const char* a3 = a2 + kstep; const char* b3 = b2 + kstep;
            if (last && has_next) S.a_ready(nxt);
            if constexpr (SP2) {
            PG8_LDB(B0, 0, 0); PG8_LDB(B1, 0, 1); PG8_SCHED; PG8_LDA(At, 0, 0); PG8_STAGE(PG8_SA(1, 1), a1 + hstepA, voffA);
            PG8_WAIT_V(8); PG8_WAIT_L(0); PG8_BAR; PG8_MMA(0, 0, At, B0); PG8_MMA(0, 1, At, B1); PG8_BAR; PG8_SCHED;
            PG8_LDA(At, 0, 1); PG8_STAGE(PG8_SB(0, 0), b2, voffB); PG8_STAGE(PG8_SB(0, 1), b2 + hstepB, voffB); PG8_STAGE(PG8_SA(0, 0), a2, voffA);
            PG8_WAIT_V(8); PG8_WAIT_L(0); PG8_BAR; PG8_MMA(1, 0, At, B0); PG8_MMA(1, 1, At, B1); PG8_BAR; PG8_SCHED;
            PG8_LDB(B0, 1, 0); PG8_LDB(B1, 1, 1); PG8_SCHED; PG8_LDA(At, 1, 0); PG8_STAGE(PG8_SA(0, 1), a2 + hstepA, voffA);
            PG8_WAIT_V(8); PG8_WAIT_L(0); PG8_BAR; PG8_MMA(0, 0, At, B0); PG8_MMA(0, 1, At, B1); PG8_BAR; PG8_SCHED;
            PG8_LDA(At, 1, 1); PG8_STAGE(PG8_SB(1, 0), b3, voffB); PG8_STAGE(PG8_SB(1, 1), b3 + hstepB, voffB); PG8_STAGE(PG8_SA(1, 0), a3, voffA);
            PG8_WAIT_V(8); PG8_WAIT_L(0); PG8_BAR; PG8_MMA(1, 0, At, B0); PG8_MMA(1, 1, At, B1); PG8_BAR; PG8_SCHED;
            } else {
            PG8_LDB(B0, 0, 0); PG8_SCHED; PG8_LDA(At, 0, 0); PG8_STAGE(PG8_SA(1, 1), a1 + hstepA, voffA);
            PG8_WAIT_L(8); PG8_BAR; PG8_WAIT_L(0); PG8_MMA(0, 0, At, B0); PG8_BAR; PG8_SCHED;
            PG8_LDB(B1, 0, 1); PG8_STAGE(PG8_SB(0, 0), b2, voffB);
            PG8_BAR; PG8_WAIT_L(0); PG8_MMA(0, 1, At, B1); PG8_BAR;
            PG8_LDA(At, 0, 1); PG8_STAGE(PG8_SA(0, 0), a2, voffA);
            PG8_BAR; PG8_WAIT_L(0); PG8_MMA(1, 0, At, B0); PG8_BAR; PG8_SCHED;
            PG8_STAGE(PG8_SB(0, 1), b2 + hstepB, voffB);
            PG8_WAIT_V(6); PG8_BAR; PG8_MMA(1, 1, At, B1); PG8_BAR;
            PG8_LDB(B0, 1, 0); PG8_SCHED; PG8_LDA(At, 1, 0); PG8_STAGE(PG8_SA(0, 1), a2 + hstepA, voffA);
            PG8_WAIT_L(8); PG8_BAR; PG8_WAIT_L(0); PG8_MMA(0, 0, At, B0); PG8_BAR; PG8_SCHED;
            PG8_LDB(B1, 1, 1); PG8_STAGE(PG8_SB(1, 0), b3, voffB);
            PG8_BAR; PG8_WAIT_L(0); PG8_MMA(0, 1, At, B1); PG8_BAR;
            PG8_LDA(At, 1, 1); PG8_STAGE(PG8_SA(1, 0), a3, voffA);
            PG8_BAR; PG8_WAIT_L(0); PG8_MMA(1, 0, At, B0); PG8_BAR; PG8_SCHED;
            PG8_STAGE(PG8_SB(1, 1), b3 + hstepB, voffB);
            PG8_WAIT_V(6); PG8_BAR; PG8_MMA(1, 1, At, B1); PG8_BAR;
            }
        }
        if constexpr (ALIGN_EPI) { if (wr == 0) PG8_BAR; }
        if constexpr (!Epi::AFTER_DRAIN) { E(acc, cur, wr, wc, fr, fq); S.done(cur); }
        if (!has_next) break;
#pragma unroll
        for (int a = 0; a < 2; ++a)
#pragma unroll
            for (int b = 0; b < 2; ++b)
#pragma unroll
                for (int m = 0; m < 4; ++m)
#pragma unroll
                    for (int n = 0; n < 2; ++n) acc[a][b][m][n] = (f32x4){0.f, 0.f, 0.f, 0.f};
        cur = nxt; cA = nA; cB = nB; ++ui;
        if constexpr (ALIGN_EPI) { if (wr == 1) PG8_BAR; }
    }
    PG8_WAIT_V(0);
    if constexpr (!ALIGN_EPI) { if (wr == 0) PG8_BAR; }
    PG8_BAR;
    if constexpr (Epi::AFTER_DRAIN) { E.fused(acc, cur, wr, wc, fr, fq, lds, wid, lane); S.done(cur); }
#undef PG8_SA
#undef PG8_SB
#undef PG8_STAGE
#undef PG8_LDA
#undef PG8_LDB
#undef PG8_MMA
#undef PG8_WAIT_V
#undef PG8_WAIT_L
#undef PG8_BAR
#undef PG8_SCHED
}
}
#define PG8_SP2 true
#define PG8_ALIGN true
#define GAS __attribute__((address_space(1)))
#define LAS __attribute__((address_space(3)))
typedef unsigned short bf16;
typedef unsigned v4u __attribute__((ext_vector_type(4)));
typedef float f32x4 __attribute__((ext_vector_type(4)));
typedef short bf16x8 __attribute__((ext_vector_type(8)));
typedef GAS unsigned gu32;
typedef GAS unsigned long long gu64;
#define RLX_AGENT __ATOMIC_RELAXED, __HIP_MEMORY_SCOPE_AGENT
#define LDS_WAIT() asm volatile("s_waitcnt lgkmcnt(0)" ::: "memory")
#define VM_WAIT() asm volatile("s_waitcnt vmcnt(0)" ::: "memory")
__device__ __forceinline__ unsigned long long rt() { return __builtin_amdgcn_s_memrealtime(); }
__device__ __forceinline__ unsigned f2bf(float f) { unsigned u = __builtin_bit_cast(unsigned, f); return (u + 0x7fffu + ((u >> 16) & 1u)) >> 16; }
__device__ __forceinline__ unsigned pk2(float lo, float hi) { return f2bf(lo) | (f2bf(hi) << 16); }
#define XB_TMO      128
#define XB_XCNT(j)  (256  + 64 * (j))
#define XB_XSUB(j)  (1280 + 64 * (j))
#define XB_XGEN(j)  (2304 + 64 * (j))
#define XB_TOP      3328
#define XB_TOPGEN   3392
#define XCD_BAR_WORDS 3456
#define XB_SPIN_CAP (1u << 18)

__device__ __forceinline__ unsigned xb_ld(unsigned* p)              { return __hip_atomic_load(p, __ATOMIC_RELAXED, __HIP_MEMORY_SCOPE_AGENT); }
__device__ __forceinline__ unsigned xb_add(unsigned* p, unsigned v) { return __hip_atomic_fetch_add(p, v, __ATOMIC_RELAXED, __HIP_MEMORY_SCOPE_AGENT); }
__device__ __forceinline__ unsigned xb_xcc_id() { return (unsigned)__builtin_amdgcn_s_getreg((3 << 11) | 20) & 0xFu; }
#define XB_SPIN(cond, bar) do { unsigned _sp = 0; while (cond) { __builtin_amdgcn_s_sleep(1); \
    if ((++_sp & 255u) == 0u) { if (xb_ld(&(bar)[XB_TMO])) break; if (_sp > XB_SPIN_CAP) { atomicAdd(&(bar)[XB_TMO], 1u); break; } } } } while (0)

struct XcdBarrier {
    unsigned* bar; unsigned x;
    volatile LAS unsigned* st;
};

__device__ __forceinline__ XcdBarrier xcd_barrier_post(unsigned* bar, volatile LAS unsigned* st) {
    XcdBarrier b; b.bar = bar; b.x = xb_xcc_id(); b.st = st;
    if (threadIdx.x == 0) (void)xb_add(&bar[XB_XCNT(b.x)], 1u);
    return b;
}
__device__ __forceinline__ void xcd_barrier_complete(unsigned* bar, unsigned x, unsigned& nloc, unsigned& nx) {
    const unsigned G = gridDim.x * gridDim.y * gridDim.z;
    unsigned sum, cnt, mine, sp = 0u;
    for (;;) {
        sum = 0u; cnt = 0u; mine = 0u;
#pragma unroll
        for (unsigned j = 0; j < 16; ++j) { const unsigned c = xb_ld(&bar[XB_XCNT(j)]); sum += c; cnt += (c > 0u) ? 1u : 0u; mine = (j == x) ? c : mine; }
        if (sum == G) break;
        __builtin_amdgcn_s_sleep(1);
        if ((++sp & 255u) == 0u) { if (xb_ld(&bar[XB_TMO])) break; if (sp > XB_SPIN_CAP) { atomicAdd(&bar[XB_TMO], 1u); break; } }
    }
    nloc = mine > 0u ? mine : 1u; nx = cnt > 0u ? cnt : 1u;
}

__device__ __forceinline__ void xcd_barrier(const XcdBarrier& b) {
    asm volatile("s_waitcnt vmcnt(0)" ::: "memory");
    __syncthreads();
    if (threadIdx.x == 0) {
        unsigned* bar = b.bar;
        __builtin_amdgcn_s_waitcnt(0);
        unsigned nloc = b.st[0], nx = b.st[1];
        if (nloc == 0u) { xcd_barrier_complete(bar, b.x, nloc, nx); b.st[0] = nloc; b.st[1] = nx; }
        const unsigned old = xb_add(&bar[XB_XSUB(b.x)], 1u);
        const unsigned gen = old / nloc;
        if (old + 1u == (gen + 1u) * nloc) {
            __builtin_amdgcn_fence(__ATOMIC_RELEASE, "agent");
            asm volatile("s_waitcnt vmcnt(0)" ::: "memory");
            const unsigned og = xb_add(&bar[XB_TOP], 1u);
            const unsigned tg = og / nx;
            if (og + 1u == (tg + 1u) * nx) xb_add(&bar[XB_TOPGEN], 1u);
            else XB_SPIN(xb_ld(&bar[XB_TOPGEN]) == tg, bar);
            __builtin_amdgcn_fence(__ATOMIC_ACQUIRE, "agent");
            xb_add(&bar[XB_XGEN(b.x)], 1u);
            asm volatile("s_waitcnt vmcnt(0)" ::: "memory");
        } else {
            XB_SPIN(xb_ld(&bar[XB_XGEN(b.x)]) == gen, bar);
            __builtin_amdgcn_fence(__ATOMIC_ACQUIRE, "agent");
            asm volatile("s_waitcnt vmcnt(0)" ::: "memory");
        }
    }
    __syncthreads();
}
constexpr int NB = 4, SEQ = 4096, CTXL = 256, TPB = SEQ + CTXL, NROWS = NB * TPB, DM = 1024, NLAYER = 2, IN_COLS = 6816;
constexpr int NWAVES = 8, NTHREADS = NWAVES * 64;
constexpr float RMS_EPS = 1e-6f;
constexpr float LOG2E = 1.4426950408889634f;
constexpr float QSCALE64 = 0.125f * LOG2E;
constexpr float QSCALE96 = 0.10206207261596575f * LOG2E;
constexpr int ZS_P = 1792, ZC_CQ = 0, ZC_CKV = 256, ZC_KR = 384, ZC_SQ = 512, ZC_SK = 768, ZC_SV = 896, ZC_AQ = 1024, ZC_AK = 1280, ZC_AV = 1408, ZC_LRU = 1536;
constexpr int N1 = 2816;
constexpr int W1ROWS = N1 + 4096;
constexpr size_t MiB = 1u << 20;
constexpr size_t WS_CTL = 0, CTL_ZERO_BYTES = 64 * 1024;
constexpr size_t WS_MOD = 1 * MiB;
constexpr size_t WS_RHC = 1 * MiB + 256 * 1024, WS_RHS = WS_RHC + 512 * 1024;
constexpr size_t WS_RMC = WS_RHS + 512 * 1024, WS_RMS = WS_RMC + 256 * 1024;
constexpr size_t WS_CTX1 = 3 * MiB;
constexpr size_t WS_W = 8 * MiB, W_LAYER = 18 * MiB;
constexpr size_t WO_W1 = 0, WO_WB = 13 * MiB + 512 * 1024, WO_WO = WO_WB + 2 * MiB, WO_UQ = WO_WO + 2 * MiB, WO_UKV = WO_UQ + 256 * 1024;
constexpr size_t WS_H = 44 * MiB;
constexpr size_t WS_G = 78 * MiB;
constexpr size_t WS_S = 112 * MiB;
constexpr size_t WS_ZS = 112 * MiB;
constexpr size_t WS_MQ = 172 * MiB;
constexpr size_t WS_MKV = 189 * MiB;
constexpr size_t WS_MK = 206 * MiB;
constexpr size_t WS_U = 219 * MiB;
constexpr size_t WS_HF = 236 * MiB;
constexpr size_t WS_SP = 2 * MiB + 768 * 1024;
constexpr size_t WS_LWT = 254 * MiB + 512 * 1024;
constexpr size_t WS_END = 256 * MiB;
static_assert(WS_H + (size_t)NROWS * 1024 * 2 <= WS_G && WS_G + (size_t)NROWS * 1024 * 2 <= WS_S && WS_S + (size_t)NROWS * 4096 * 2 <= 248 * MiB, "ws map");
static_assert(WS_ZS + (size_t)NROWS * ZS_P * 2 <= WS_MQ && WS_MK + (size_t)NROWS * 384 * 2 <= WS_U, "ws map 2");
static_assert(WO_UKV + 512 * 256 * 2 <= W_LAYER, "weights");
constexpr int CW_BAR = 1024;

constexpr int RING_OFF = 0, RING_BYTES = 131072, LDSCTL_OFF = RING_BYTES, MISC_OFF = LDSCTL_OFF + 320, LDS_BYTES = 147456;

typedef unsigned short bf16;
typedef unsigned u32x2 __attribute__((ext_vector_type(2)));
typedef float f32x2v __attribute__((ext_vector_type(2)));
__device__ __forceinline__ float bf2f(bf16 v) { return __uint_as_float((unsigned)v << 16); }
__device__ __forceinline__ float wave_sum(float v) {
#pragma unroll
    for (int o = 1; o < 64; o <<= 1) v += __shfl_xor(v, o);
    return v; }
__device__ __forceinline__ float wave_max(float v) {
#pragma unroll
    for (int o = 1; o < 64; o <<= 1) v = fmaxf(v, __shfl_xor(v, o));
    return v; }
__device__ __forceinline__ float grp16_sum(float v) {
#pragma unroll
    for (int o = 1; o < 16; o <<= 1) v += __shfl_xor(v, o);
    return v; }

struct Args { const float* in[28]; float* out; unsigned char* ws; int ph_lo, ph_hi; };
enum { I_X = 0, I_C, I_CTX, I_CCTX, I_WMOD, I_BMOD, I_NORMW, I_WIN, I_CQN, I_CKVN, I_WUQ, I_WUKV, I_MQN, I_MKN, I_SQN, I_SKN, I_SINK, I_AQN, I_AKN,
       I_CONVW, I_CONVB, I_LWR, I_LBR, I_LWI, I_LBI, I_LAM, I_WBR, I_WOUT };

struct Frame {
    LAS unsigned char* lds; const float* const __attribute__((address_space(4)))* kin; unsigned char* ws; float* out;
    int tid, lane, wave, G, vcu, gw, NGW, z;
    __device__ __forceinline__ const float* in(int i) const { return kin[i]; }
};

__device__ __forceinline__ void xpose_item(const float* W, int ldn, int k0, int n0, bf16* WT, int pd, int drow, LAS float* scr, int lane) {
#pragma unroll 8
    for (int i = 0; i < 32; ++i) { const int kk = 2 * i + (lane >> 5); scr[kk * 33 + (lane & 31)] = W[(size_t)(k0 + kk) * ldn + n0 + (lane & 31)]; }
    LDS_WAIT(); asm volatile("" ::: "memory");
    const int c = lane & 7;
#pragma unroll
    for (int j = 0; j < 4; ++j) { const int n = (lane >> 3) + 8 * j; const LAS float* s = scr + (8 * c) * 33 + n;
        v4u o; o.x = pk2(s[0 * 33], s[1 * 33]); o.y = pk2(s[2 * 33], s[3 * 33]); o.z = pk2(s[4 * 33], s[5 * 33]); o.w = pk2(s[6 * 33], s[7 * 33]);
        *(GAS v4u*)(WT + (size_t)(drow + n0 + n) * pd + k0 + 8 * c) = o; }
    LDS_WAIT(); asm volatile("" ::: "memory");
}
__device__ __forceinline__ void zero16(bf16* p, size_t n16, int gt, int ngt) {
    for (size_t i = gt; i < n16; i += ngt) ((GAS v4u*)p)[i] = (v4u){0u, 0u, 0u, 0u};
}
__device__ __forceinline__ void p0_prologue(Frame& F) {
    LAS float* scr = (LAS float*)(F.lds + RING_OFF + F.wave * 16384);
    constexpr int I_IN = 16 * 213, I_UQ = 4 * 12, I_UKV = 2 * 16, I_BR = 4 * 4 * 32, I_OUT = 16 * 32, I_LAYER = I_IN + I_UQ + I_UKV + I_BR + I_OUT;
    for (int it = F.gw; it < NLAYER * I_LAYER; it += F.NGW) {
        const int l = it / I_LAYER; int r = it % I_LAYER;
        unsigned char* wl = F.ws + WS_W + (size_t)l * W_LAYER;
        if (r < I_IN) { const int kb = r / 213, nb = r % 213, n0 = nb * 32;
            xpose_item(F.in(I_WIN) + (size_t)l * 1024 * IN_COLS, IN_COLS, kb * 64, n0, (bf16*)(wl + WO_W1), 1024, n0 >= 416 ? 96 : 0, scr, F.lane); continue; } r -= I_IN;
        if (r < I_UQ) { const int kb = r / 12, nb = r % 12;
            xpose_item(F.in(I_WUQ) + (size_t)l * 256 * 384, 384, kb * 64, nb * 32, (bf16*)(wl + WO_UQ), 256, 0, scr, F.lane); continue; } r -= I_UQ;
        if (r < I_UKV) { const int kb = r / 16, nb = r % 16;
            xpose_item(F.in(I_WUKV) + (size_t)l * 128 * 512, 512, kb * 64, nb * 32, (bf16*)(wl + WO_UKV), 256, 0, scr, F.lane); continue; } r -= I_UKV;
        if (r < I_BR) { const int k = r / 128, rr = r % 128, kb = rr / 32, nb = rr % 32;
            xpose_item(F.in(I_WBR) + ((size_t)l * 4 + k) * 256 * 1024, 1024, kb * 64, nb * 32, (bf16*)(wl + WO_WB) + (size_t)k * 1024 * 256, 256, 0, scr, F.lane); continue; } r -= I_BR;
        { const int kb = r / 32, nb = r % 32;
            xpose_item(F.in(I_WOUT) + (size_t)l * 1024 * 1024, 1024, kb * 64, nb * 32, (bf16*)(wl + WO_WO), 1024, 0, scr, F.lane); }
    }
    const int gt = F.vcu * NTHREADS + F.tid, ngt = F.G * NTHREADS;
    for (int l = 0; l < NLAYER; ++l) {
        unsigned char* wl = F.ws + WS_W + (size_t)l * W_LAYER;
        zero16((bf16*)(wl + WO_W1) + (size_t)416 * 1024, 96 * 1024 * 2 / 16, gt, ngt);
        zero16((bf16*)(wl + WO_UQ) + (size_t)384 * 256, 128 * 256 * 2 / 16, gt, ngt);
        for (int i = gt; i < 512 * 16; i += ngt) { const int n = i >> 4, c = i & 15; ((GAS v4u*)((bf16*)(wl + WO_UKV) + (size_t)n * 256 + 128))[c] = (v4u){0u, 0u, 0u, 0u}; }
    }
    { float* rhc = (float*)(F.ws + WS_RHC); float* rhs = (float*)(F.ws + WS_RHS); float* rmc = (float*)(F.ws + WS_RMC); float* rms = (float*)(F.ws + WS_RMS);
      for (int i = gt; i < 4096 * 32; i += ngt) { const int t = i >> 5, p = i & 31; const float fr = powf(10000.0f, -(float)(p & 15) / 16.0f);
          const float pos = (float)((p < 16) ? (t >> 6) : (t & 63)); const float ang = pos * fr; rhc[i] = cosf(ang); rhs[i] = sinf(ang); }
      for (int i = gt; i < 4096 * 16; i += ngt) { const int t = i >> 4, p = i & 15; const float fr = powf(10000.0f, -(float)(p & 7) / 8.0f);
          const float pos = (float)((p < 8) ? (t >> 6) : (t & 63)); const float ang = pos * fr; rmc[i] = cosf(ang); rms[i] = sinf(ang); } }
    { float* sp = (float*)(F.ws + WS_SP); for (int i = gt; i < NLAYER * 2 * 256; i += ngt) sp[i] = 8.0f * LOG2E * log1pf(expf(-F.in(I_LAM)[i])); }
    { float* lwt = (float*)(F.ws + WS_LWT);
      for (int o = gt; o < NLAYER * 2 * 2 * 256 * 64; o += ngt) { const int i = o & 63, c = (o >> 6) & 255, gate = (o >> 14) & 1, ld = o >> 15, k = c >> 6, j = c & 63;
          lwt[o] = (gate == 0 ? F.in(I_LWR) : F.in(I_LWI))[(((size_t)ld * 4 + k) * 64 + i) * 64 + j]; } }
    { LAS float* sc = (LAS float*)(F.lds + RING_OFF);
      LAS float* red = sc + 5 * 1024;
      __syncthreads();
      for (int i = F.tid; i < 5 * 1024; i += NTHREADS) { const float v = (i < 4096) ? F.in(I_C)[i] : F.in(I_CCTX)[i - 4096]; sc[i] = v / (1.0f + expf(-v)); }
      __syncthreads();
      float* modv = (float*)(F.ws + WS_MOD);
      for (int it = F.vcu; it < NLAYER * 96; it += F.G) {
          const int l = it / 96, n0 = (it % 96) * 32, nn = F.tid & 31, kc = F.tid >> 5;
          const float* w = F.in(I_WMOD) + (size_t)l * 1024 * 3072 + n0 + nn;
          float acc[5] = {0.f, 0.f, 0.f, 0.f, 0.f};
          for (int k = kc * 64; k < kc * 64 + 64; ++k) { const float wv = w[(size_t)k * 3072];
#pragma unroll
              for (int r = 0; r < 5; ++r) acc[r] += sc[r * 1024 + k] * wv; }
#pragma unroll
          for (int r = 0; r < 5; ++r) red[(kc * 5 + r) * 32 + nn] = acc[r];
          __syncthreads();
          if (F.tid < 160) { const int r = F.tid >> 5; float s = 0.f;
              for (int q = 0; q < 16; ++q) s += red[(q * 5 + r) * 32 + nn];
              modv[((size_t)l * 5 + r) * 3072 + n0 + nn] = s + F.in(I_BMOD)[l * 3072 + n0 + nn]; }
          __syncthreads();
      } }
}

__device__ __forceinline__ void ph_hnorm(Frame& F, int l) {
    const float* xs = (l == 0) ? F.in(I_X) : F.out; const float* cs = (l == 0) ? F.in(I_CTX) : (const float*)(F.ws + WS_CTX1);
    const float* nw = F.in(I_NORMW) + l * 1024; const float* modl = (const float*)(F.ws + WS_MOD) + (size_t)l * 5 * 3072;
    bf16* H = (bf16*)(F.ws + WS_H);
    for (int row = F.gw; row < NROWS; row += F.NGW) {
        const int b = row / TPB, j = row % TPB; const float* src; int mr;
        if (j < CTXL) { src = cs + ((size_t)b * CTXL + j) * 1024; mr = 4; } else { src = xs + ((size_t)b * SEQ + (j - CTXL)) * 1024; mr = b; }
        const GAS f32x4* xr = (const GAS f32x4*)src + F.lane;
        f32x4 v[4]; float ss = 0.f;
#pragma unroll
        for (int q = 0; q < 4; ++q) { v[q] = xr[64 * q]; ss += (v[q].x * v[q].x + v[q].y * v[q].y) + (v[q].z * v[q].z + v[q].w * v[q].w); }
        const float rstd = 1.0f / sqrtf(wave_sum(ss) * (1.0f / 1024.0f) + RMS_EPS);
        const float* mrow = modl + mr * 3072;
        GAS unsigned long long* o8 = (GAS unsigned long long*)(H + (size_t)row * 1024) + F.lane;
#pragma unroll
        for (int q = 0; q < 4; ++q) { const int c = 4 * F.lane + 256 * q;
            const f32x4 g = *(const f32x4*)(nw + c), sh = *(const f32x4*)(mrow + c), sc = *(const f32x4*)(mrow + 1024 + c);
            const f32x4 h = v[q] * rstd * g * (sc + 1.0f) + sh;
            o8[64 * q] = (unsigned long long)pk2(h.x, h.y) | ((unsigned long long)pk2(h.z, h.w) << 32); }
    }
}

struct P1Regs { u32x2 cq; unsigned ckv, h[3][2]; float rc[2], rs[2]; };
__device__ __forceinline__ void post1_load(const bf16* z, const float* rc, const float* rs, bool lat, int lane, P1Regs& R) {
    const int hg = lane >> 4, p0 = (lane & 15) * 2;
    R.cq = *(const u32x2*)(z + ZC_CQ + 4 * lane); R.ckv = *(const unsigned*)(z + ZC_CKV + 2 * lane);
    const bf16* h0 = z + ZC_SQ + hg * 64 + p0; const bf16* h1 = z + ZC_AQ + hg * 64 + p0; const bf16* h2 = z + ((hg < 2) ? (ZC_SK + hg * 64) : (ZC_AK + (hg - 2) * 64)) + p0;
    R.h[0][0] = *(const unsigned*)h0; R.h[0][1] = *(const unsigned*)(h0 + 32); R.h[1][0] = *(const unsigned*)h1; R.h[1][1] = *(const unsigned*)(h1 + 32); R.h[2][0] = *(const unsigned*)h2; R.h[2][1] = *(const unsigned*)(h2 + 32);
    if (lat) { R.rc[0] = rc[p0]; R.rc[1] = rc[p0 + 1]; R.rs[0] = rs[p0]; R.rs[1] = rs[p0 + 1]; } else { R.rc[0] = 1.f; R.rc[1] = 1.f; R.rs[0] = 0.f; R.rs[1] = 0.f; }
}
__device__ __forceinline__ void post1_finish(bf16* z, int lane, const P1Regs& R, const float (&gcq)[4], const float (&gckv)[2], const float (&gh)[3][4]) {
    const int hg = lane >> 4, p0 = (lane & 15) * 2;
    { float v0 = bflo(R.cq.x), v1 = bfhi(R.cq.x), v2 = bflo(R.cq.y), v3 = bfhi(R.cq.y);
      const float rstd = 1.0f / sqrtf(wave_sum(v0 * v0 + v1 * v1 + v2 * v2 + v3 * v3) * (1.0f / 256.0f) + RMS_EPS);
      u32x2 w; w.x = pk2(v0 * rstd * gcq[0], v1 * rstd * gcq[1]); w.y = pk2(v2 * rstd * gcq[2], v3 * rstd * gcq[3]); *(u32x2*)(z + ZC_CQ + 4 * lane) = w; }
    { float v0 = bflo(R.ckv), v1 = bfhi(R.ckv);
      const float rstd = 1.0f / sqrtf(wave_sum(v0 * v0 + v1 * v1) * (1.0f / 128.0f) + RMS_EPS);
      *(unsigned*)(z + ZC_CKV + 2 * lane) = pk2(v0 * rstd * gckv[0], v1 * rstd * gckv[1]); }
#pragma unroll
    for (int q = 0; q < 3; ++q) {
        bf16* hp = z + ((q == 0) ? (ZC_SQ + hg * 64) : (q == 1) ? (ZC_AQ + hg * 64) : ((hg < 2) ? (ZC_SK + hg * 64) : (ZC_AK + (hg - 2) * 64))) + p0;
        float a0 = bflo(R.h[q][0]), a1 = bfhi(R.h[q][0]), b0 = bflo(R.h[q][1]), b1 = bfhi(R.h[q][1]);
        const float rstd = 1.0f / sqrtf(grp16_sum(a0 * a0 + a1 * a1 + b0 * b0 + b1 * b1) * (1.0f / 64.0f) + RMS_EPS);
        a0 *= rstd * gh[q][0]; a1 *= rstd * gh[q][1]; b0 *= rstd * gh[q][2]; b1 *= rstd * gh[q][3];
        const float x0 = a0 * R.rc[0] - b0 * R.rs[0], y0 = b0 * R.rc[0] + a0 * R.rs[0], x1 = a1 * R.rc[1] - b1 * R.rs[1], y1 = b1 * R.rc[1] + a1 * R.rs[1];
        const float sc = (q < 2) ? QSCALE64 : 1.0f;
        *(unsigned*)hp = pk2(x0 * sc, x1 * sc); *(unsigned*)(hp + 32) = pk2(y0 * sc, y1 * sc);
    }
}
__device__ __forceinline__ void ph_post1(Frame& F, int l) {
    bf16* ZS = (bf16*)(F.ws + WS_ZS);
    const float* rhc = (const float*)(F.ws + WS_RHC); const float* rhs = (const float*)(F.ws + WS_RHS);
    const int lane = F.lane, hg = lane >> 4, p0 = (lane & 15) * 2;
    float gcq[4], gckv[2], gh[3][4];
#pragma unroll
    for (int i = 0; i < 4; ++i) gcq[i] = F.in(I_CQN)[l * 256 + 4 * lane + i];
    gckv[0] = F.in(I_CKVN)[l * 128 + 2 * lane]; gckv[1] = F.in(I_CKVN)[l * 128 + 2 * lane + 1];
    { const float* g0 = F.in(I_SQN) + l * 64; const float* g1 = F.in(I_AQN) + l * 64; const float* g2 = ((hg < 2) ? F.in(I_SKN) : F.in(I_AKN)) + l * 64;
      gh[0][0] = g0[p0]; gh[0][1] = g0[p0 + 1]; gh[0][2] = g0[32 + p0]; gh[0][3] = g0[33 + p0];
      gh[1][0] = g1[p0]; gh[1][1] = g1[p0 + 1]; gh[1][2] = g1[32 + p0]; gh[1][3] = g1[33 + p0];
      gh[2][0] = g2[p0]; gh[2][1] = g2[p0 + 1]; gh[2][2] = g2[32 + p0]; gh[2][3] = g2[33 + p0]; }
    for (int row = F.gw; row < NROWS; row += 2 * F.NGW) {
        const int row2 = row + F.NGW; const bool has2 = row2 < NROWS;
        const int j = row % TPB; const bool lat = j >= CTXL; const int pos = lat ? j - CTXL : 0;
        const int j2 = has2 ? row2 % TPB : 0; const bool lat2 = j2 >= CTXL; const int pos2 = lat2 ? j2 - CTXL : 0;
        bf16* z = ZS + (size_t)row * ZS_P; bf16* z2 = ZS + (size_t)(has2 ? row2 : row) * ZS_P;
        P1Regs A, B;
        post1_load(z, rhc + pos * 32, rhs + pos * 32, lat, lane, A);
        if (has2) post1_load(z2, rhc + pos2 * 32, rhs + pos2 * 32, lat2, lane, B);
        post1_finish(z, lane, A, gcq, gckv, gh);
        if (has2) post1_finish(z2, lane, B, gcq, gckv, gh);
    }
}
struct P2Regs { u32x2 qn, kn; bf16 q1, q2, k1, k2; float c, s; };
__device__ __forceinline__ void post2_load(const bf16* zrow, const bf16* mq, const bf16* mkv, const float* rc, const float* rs, bool lat, int lane, P2Regs& R) {
    const int h = lane >> 4, j = lane & 15;
    R.qn = *(const u32x2*)(mq + h * 96 + 4 * j); R.q1 = mq[h * 96 + 64 + j]; R.q2 = mq[h * 96 + 80 + j];
    R.kn = *(const u32x2*)(mkv + h * 128 + 4 * j); R.k1 = zrow[ZC_KR + j]; R.k2 = zrow[ZC_KR + 16 + j];
    if (lat) { R.c = rc[j]; R.s = rs[j]; } else { R.c = 1.f; R.s = 0.f; }
}
__device__ __forceinline__ void post2_finish(bf16* mq, bf16* mk, int lane, const P2Regs& R, const float (&gq)[6], const float (&gk)[6]) {
    const int h = lane >> 4, j = lane & 15;
#pragma unroll
    for (int qk = 0; qk < 2; ++qk) {
        const u32x2 n = qk == 0 ? R.qn : R.kn; float v0 = bflo(n.x), v1 = bfhi(n.x), v2 = bflo(n.y), v3 = bfhi(n.y), r1 = bf2f(qk == 0 ? R.q1 : R.k1), r2 = bf2f(qk == 0 ? R.q2 : R.k2);
        const float rstd = 1.0f / sqrtf(grp16_sum(v0 * v0 + v1 * v1 + v2 * v2 + v3 * v3 + r1 * r1 + r2 * r2) * (1.0f / 96.0f) + RMS_EPS);
        const float (&g)[6] = qk == 0 ? gq : gk; const float sc = qk == 0 ? QSCALE96 : 1.0f;
        const float y1 = r1 * rstd * g[4], y2 = r2 * rstd * g[5];
        const float t1 = (y1 * R.c - y2 * R.s) * sc, t2 = (y2 * R.c + y1 * R.s) * sc;
        bf16* o = (qk == 0 ? mq : mk) + h * 96;
        u32x2 w; w.x = pk2(v0 * rstd * g[0] * sc, v1 * rstd * g[1] * sc); w.y = pk2(v2 * rstd * g[2] * sc, v3 * rstd * g[3] * sc);
        *(u32x2*)(o + 4 * j) = w; o[64 + j] = (bf16)f2bf(t1); o[80 + j] = (bf16)f2bf(t2);
    }
}
__device__ __forceinline__ void ph_post2(Frame& F, int l) {
    const bf16* ZS = (const bf16*)(F.ws + WS_ZS); bf16* MQ = (bf16*)(F.ws + WS_MQ); const bf16* MKV = (const bf16*)(F.ws + WS_MKV); bf16* MK = (bf16*)(F.ws + WS_MK);
    const float* rmc = (const float*)(F.ws + WS_RMC); const float* rms = (const float*)(F.ws + WS_RMS);
    const int lane = F.lane, jj = lane & 15;
    float gq[6], gk[6];
    { const float* a = F.in(I_MQN) + l * 96; const float* b = F.in(I_MKN) + l * 96;
#pragma unroll
      for (int i = 0; i < 4; ++i) { gq[i] = a[4 * jj + i]; gk[i] = b[4 * jj + i]; }
      gq[4] = a[64 + jj]; gq[5] = a[80 + jj]; gk[4] = b[64 + jj]; gk[5] = b[80 + jj]; }
    for (int row = F.gw; row < NROWS; row += 2 * F.NGW) {
        const int row2 = row + F.NGW; const bool has2 = row2 < NROWS; const size_t rb = has2 ? row2 : row;
        const int j = row % TPB; const bool lat = j >= CTXL; const int pos = lat ? j - CTXL : 0;
        const int j2 = (int)(rb % TPB); const bool lat2 = j2 >= CTXL; const int pos2 = lat2 ? j2 - CTXL : 0;
        P2Regs A, B;
        post2_load(ZS + (size_t)row * ZS_P, MQ + (size_t)row * 512, MKV + (size_t)row * 512, rmc + pos * 16, rms + pos * 16, lat, lane, A);
        if (has2) post2_load(ZS + rb * ZS_P, MQ + rb * 512, MKV + rb * 512, rmc + pos2 * 16, rms + pos2 * 16, lat2, lane, B);
        post2_finish(MQ + (size_t)row * 512, MK + (size_t)row * 384, lane, A, gq, gk);
        if (has2) post2_finish(MQ + rb * 512, MK + rb * 384, lane, B, gq, gk);
    }
}

template <int DQK>
__device__ __forceinline__ void attn_row_naive(const bf16* q, const bf16* Kb, int kp, const bf16* Vb, int vp, int n1, int lo2, int hi2, bool has_sink, float sink2, bf16* y, int lane) {
    float qf[DQK];
#pragma unroll
    for (int c = 0; c < DQK / 8; ++c) { const v4u w = *(const v4u*)(q + 8 * c);
        qf[8 * c + 0] = bflo(w.x); qf[8 * c + 1] = bfhi(w.x); qf[8 * c + 2] = bflo(w.y); qf[8 * c + 3] = bfhi(w.y); qf[8 * c + 4] = bflo(w.z); qf[8 * c + 5] = bfhi(w.z); qf[8 * c + 6] = bflo(w.w); qf[8 * c + 7] = bfhi(w.w); }
    float m = -INFINITY, l = 0.f; float acc[64];
#pragma unroll
    for (int d = 0; d < 64; ++d) acc[d] = 0.f;
    for (int seg = 0; seg < 2; ++seg) {
        const int k0 = seg == 0 ? 0 : lo2, k1 = seg == 0 ? n1 : hi2;
        for (int key = k0 + lane; key < k1; key += 64) {
            const bf16* kr = Kb + (size_t)key * kp; float s = 0.f;
#pragma unroll
            for (int c = 0; c < DQK / 8; ++c) { const v4u w = *(const v4u*)(kr + 8 * c);
                s += qf[8 * c + 0] * bflo(w.x) + qf[8 * c + 1] * bfhi(w.x) + qf[8 * c + 2] * bflo(w.y) + qf[8 * c + 3] * bfhi(w.y) + qf[8 * c + 4] * bflo(w.z) + qf[8 * c + 5] * bfhi(w.z) + qf[8 * c + 6] * bflo(w.w) + qf[8 * c + 7] * bfhi(w.w); }
            if (s > m) { const float f = exp2f(m - s); l *= f;
#pragma unroll
                for (int d = 0; d < 64; ++d) acc[d] *= f;
                m = s; }
            const float p = exp2f(s - m); l += p;
            const bf16* vr = Vb + (size_t)key * vp;
#pragma unroll
            for (int c = 0; c < 8; ++c) { const v4u w = *(const v4u*)(vr + 8 * c);
                acc[8 * c + 0] += p * bflo(w.x); acc[8 * c + 1] += p * bfhi(w.x); acc[8 * c + 2] += p * bflo(w.y); acc[8 * c + 3] += p * bfhi(w.y); acc[8 * c + 4] += p * bflo(w.z); acc[8 * c + 5] += p * bfhi(w.z); acc[8 * c + 6] += p * bflo(w.w); acc[8 * c + 7] += p * bfhi(w.w); }
        }
    }
    float M = wave_max(m); if (has_sink) M = fmaxf(M, sink2);
    const float f = (m == -INFINITY) ? 0.f : exp2f(m - M);
    float L = wave_sum(l * f); if (has_sink) L += exp2f(sink2 - M);
    float mine = 0.f;
#pragma unroll
    for (int d = 0; d < 64; ++d) { const float t = wave_sum(acc[d] * f); if (lane == d) mine = t; }
    y[lane] = (bf16)f2bf(mine / L * bf2f(y[lane]));
}
__device__ __forceinline__ void ph_attn_naive(Frame& F, int l) {
    const bf16* ZS = (const bf16*)(F.ws + WS_ZS); const bf16* MQ = (const bf16*)(F.ws + WS_MQ); const bf16* MKV = (const bf16*)(F.ws + WS_MKV); const bf16* MK = (const bf16*)(F.ws + WS_MK);
    bf16* Y = (bf16*)(F.ws + WS_G);
    const long nitems = (long)NROWS * 12;
    for (long it = F.gw; it < nitems; it += F.NGW) {
        const int hb = (int)(it % 12); const int row = (int)(it / 12);
        const int b = row / TPB, j = row % TPB; const bool lat = j >= CTXL;
        if (!lat && l == NLAYER - 1) continue;
        const size_t r0 = (size_t)b * TPB;
        const int br = hb >> 2, h = hb & 3;
        bf16* y = Y + (size_t)row * 1024 + br * 256 + h * 64;
        if (br == 0) {
            attn_row_naive<96>(MQ + (size_t)row * 512 + h * 96, MK + r0 * 384 + h * 96, 384, MKV + r0 * 512 + h * 128 + 64, 512, CTXL, CTXL, lat ? TPB : CTXL, false, 0.f, y, F.lane);
        } else if (br == 1) {
            const int t = j - CTXL; int lo = CTXL, hi = CTXL;
            if (lat) { lo = CTXL + (t - 128 < 0 ? 0 : t - 128); hi = CTXL + (t + 128 > SEQ - 1 ? SEQ - 1 : t + 128) + 1; }
            attn_row_naive<64>(ZS + (size_t)row * ZS_P + ZC_SQ + h * 64, ZS + r0 * ZS_P + ZC_SK + (h >> 1) * 64, ZS_P, ZS + r0 * ZS_P + ZC_SV + (h >> 1) * 64, ZS_P, CTXL, lo, hi, true, F.in(I_SINK)[l * 4 + h] * LOG2E, y, F.lane);
        } else {
            attn_row_naive<64>(ZS + (size_t)row * ZS_P + ZC_AQ + h * 64, ZS + r0 * ZS_P + ZC_AK + (h >> 1) * 64, ZS_P, ZS + r0 * ZS_P + ZC_AV + (h >> 1) * 64, ZS_P, CTXL, CTXL, lat ? TPB : CTXL, false, 0.f, y, F.lane);
        }
    }
}

__device__ __forceinline__ void ph_lru_conv(Frame& F, int l) {
    const bf16* ZS = (const bf16*)(F.ws + WS_ZS); float* U = (float*)(F.ws + WS_U);
    const float* cw = F.in(I_CONVW) + l * 4 * 256; const float* cb = F.in(I_CONVB) + l * 256;
    const int gt = F.vcu * NTHREADS + F.tid, ngt = F.G * NTHREADS;
    for (int idx = gt; idx < NROWS * 256; idx += ngt) {
        const int row = idx >> 8, c = idx & 255, b = row / TPB, j = row % TPB;
        int s0, len, jj; if (j < CTXL) { s0 = b * TPB; len = CTXL; jj = j; } else { s0 = b * TPB + CTXL; len = SEQ; jj = j - CTXL; }
        float acc = cb[c];
#pragma unroll
        for (int i = 0; i < 4; ++i) { const int t = jj + i - 2; if (t >= 0 && t < len) acc += cw[i * 256 + c] * bf2f(ZS[(size_t)(s0 + t) * ZS_P + ZC_LRU + c]); }
        U[idx] = acc;
    }
}
__device__ __forceinline__ void ph_lru_scan(Frame& F, int l, int dir) {
    const float* U = (const float*)(F.ws + WS_U); float* HF = (float*)(F.ws + WS_HF); bf16* Y = (bf16*)(F.ws + WS_G);
    const int g = blockIdx.x * NTHREADS + F.tid;
    if (g < NB * 256) {
    const int b = g >> 8, c = g & 255, k = c >> 6, jc = c & 63;
    const float* wr = F.in(I_LWR) + ((((size_t)l * 2 + dir) * 4 + k) * 64) * 64 + jc;
    const float* wi = F.in(I_LWI) + ((((size_t)l * 2 + dir) * 4 + k) * 64) * 64 + jc;
    float wrr[64], wii[64];
#pragma unroll
    for (int i = 0; i < 64; ++i) { wrr[i] = wr[i * 64]; wii[i] = wi[i * 64]; }
    const float br = F.in(I_LBR)[(l * 2 + dir) * 256 + c], bi = F.in(I_LBI)[(l * 2 + dir) * 256 + c];
    const float lam = F.in(I_LAM)[(l * 2 + dir) * 256 + c];
    const float sp = log1pf(expf(-lam));
    float h = 0.f;
    for (int s = 0; s < TPB; ++s) {
        const int j = dir == 0 ? s : (s < CTXL ? CTXL - 1 - s : TPB + CTXL - 1 - s);
        const size_t row = (size_t)b * TPB + j;
        const float* ub = U + row * 256 + k * 64;
        float rp = br, ip = bi;
#pragma unroll
        for (int i = 0; i < 64; ++i) { const float uv = ub[i]; rp += uv * wrr[i]; ip += uv * wii[i]; }
        const float r = 1.0f / (1.0f + expf(-rp)), ig = 1.0f / (1.0f + expf(-ip));
        const float la = -8.0f * r * sp; const float a = expf(la);
        const float bx = sqrtf(-expm1f(2.0f * la)) * (ig * ub[jc]);
        h = a * h + bx;
        if (dir == 0) HF[row * 256 + c] = h;
        else { bf16* y = Y + row * 1024 + 768 + c; *y = (bf16)f2bf((HF[row * 256 + c] + h) * bf2f(*y)); }
    }
    }
}
__device__ __forceinline__ void ph_mixsum(Frame& F) {
    const bf16* S = (const bf16*)(F.ws + WS_S); bf16* MIX = (bf16*)(F.ws + WS_H);
    const int gt = F.vcu * NTHREADS + F.tid, ngt = F.G * NTHREADS;
    for (int idx = gt; idx < NROWS * 128; idx += ngt) {
        const int row = idx >> 7, c8 = (idx & 127) * 8; float s[8] = {0.f, 0.f, 0.f, 0.f, 0.f, 0.f, 0.f, 0.f};
#pragma unroll
        for (int k = 0; k < 4; ++k) { const v4u w = *(const GAS v4u*)(S + (size_t)row * 4096 + k * 1024 + c8);
            s[0] += bflo(w.x); s[1] += bfhi(w.x); s[2] += bflo(w.y); s[3] += bfhi(w.y); s[4] += bflo(w.z); s[5] += bfhi(w.z); s[6] += bflo(w.w); s[7] += bfhi(w.w); }
        v4u o; o.x = pk2(s[0], s[1]); o.y = pk2(s[2], s[3]); o.z = pk2(s[4], s[5]); o.w = pk2(s[6], s[7]);
        *(GAS v4u*)(MIX + (size_t)row * 1024 + c8) = o;
    }
}
namespace att {
typedef short bf16x8 __attribute__((ext_vector_type(8)));
typedef short s16x4 __attribute__((ext_vector_type(4)));
typedef short v4i16_t __attribute__((ext_vector_type(4)));
typedef float f32x16 __attribute__((ext_vector_type(16)));
typedef unsigned u32x4 __attribute__((ext_vector_type(4)));
typedef __attribute__((address_space(3))) const char* lds_cptr;
typedef float f32x2_t __attribute__((ext_vector_type(2))); typedef __bf16 bf16x2_t __attribute__((ext_vector_type(2)));
__device__ __forceinline__ int crow(int r, int hi) { return (r & 3) + 8 * (r >> 2) + 4 * hi; }
__device__ __forceinline__ void glds16(const void* gsrc, unsigned lds_dst) { unsigned keep;
    asm volatile("s_mov_b32 %0, m0\n\ts_mov_b32 m0, %2\n\ts_nop 0\n\tglobal_load_lds_dwordx4 %1, off\n\ts_mov_b32 m0, %0" : "=&s"(keep) : "v"(gsrc), "s"(lds_dst) : "memory"); }
__device__ __forceinline__ unsigned cvtpk(float lo, float hi) { f32x2_t v = {lo, hi}; bf16x2_t b = __builtin_convertvector(v, bf16x2_t); return __builtin_bit_cast(unsigned, b); }
__device__ __forceinline__ s16x4 vtr(lds_cptr p) { return __builtin_bit_cast(s16x4, __builtin_amdgcn_ds_read_tr16_b64_v4i16((__attribute__((address_space(3))) v4i16_t*)p)); }
__device__ __forceinline__ float halfswap_max(float m) { auto rr = __builtin_amdgcn_permlane32_swap(__float_as_uint(m), __float_as_uint(m), false, false); return fmaxf(__uint_as_float(rr[0]), __uint_as_float(rr[1])); }
__device__ __forceinline__ float halfswap_sum(float m) { auto rr = __builtin_amdgcn_permlane32_swap(__float_as_uint(m), __float_as_uint(m), false, false); return __uint_as_float(rr[0]) + __uint_as_float(rr[1]); }

template <int DQK> struct Cfg {
    static constexpr int KCH = DQK / 8, KSLOT = KCH * 1024, NKI = (KCH + 7) / 8, NI = NKI + 1;
    static constexpr int LDS_K = 0, LDS_V = 3 * KSLOT, LDS_WS = LDS_V + 3 * 8192, LDS_OST = LDS_WS + 8 * 256, BYTES = LDS_OST + 8 * 4096;
};
#define ATT_WAIT_BAR(N) asm volatile("s_waitcnt vmcnt(" #N ") lgkmcnt(0)\n\ts_barrier" ::: "memory")

struct UnitDesc {
    const unsigned short* Q; int qp;
    const unsigned short* K; int kp;
    const unsigned short* V; int vp;
    unsigned short* Y;
    int NT;
    int lat_row0;
    int qpos0, spos0;
    int has_sink; float sink2;
};

template <int DQK, bool SWA>
__device__ __forceinline__ void attn_unit(LAS unsigned char* ldsb, const UnitDesc& U, const int tid) {
    using C = Cfg<DQK>;
    const int lane = tid & 63, r32 = lane & 31, hi = lane >> 5; const int wid = __builtin_amdgcn_readfirstlane(tid >> 6);
    const unsigned lds0 = (unsigned)(uintptr_t)ldsb;
    LAS float* wsf = (LAS float*)(ldsb + C::LDS_WS) + wid * 64;
    const int kp = U.kp, vp = U.vp;
    const int kc1 = (C::NKI == 2 && wid < 4) ? wid + 8 : wid;
    const unsigned short* ksrc0 = U.K + (size_t)lane * kp + wid * 8;
    const unsigned short* ksrc1 = U.K + (size_t)lane * kp + kc1 * 8;
    const unsigned short* vsrc = U.V + (size_t)(16 * (wid & 3) + (lane >> 2)) * vp + (wid >> 2) * 32 + (lane & 3) * 8;
    const unsigned kdst0 = lds0 + C::LDS_K + wid * 1024, kdst1 = lds0 + C::LDS_K + kc1 * 1024, vdst = lds0 + C::LDS_V + wid * 1024;
    const int NT = U.NT;
#define ATT_KROW(t) (SWA ? ((t) < 4 ? 64 * (t) : U.lat_row0 + 64 * ((t) - 4)) : 64 * (t))
#define ATT_DMA(t, slot) do { const size_t ro_ = (size_t)ATT_KROW(t); \
        glds16(ksrc0 + ro_ * kp, (unsigned)__builtin_amdgcn_readfirstlane(kdst0 + (slot) * C::KSLOT)); \
        if (C::NKI == 2) glds16(ksrc1 + ro_ * kp, (unsigned)__builtin_amdgcn_readfirstlane(kdst1 + (slot) * C::KSLOT)); \
        glds16(vsrc + ro_ * vp, (unsigned)__builtin_amdgcn_readfirstlane(vdst + (slot) * 8192)); } while (0)
    ATT_DMA(0, 0);
    if (NT > 1) ATT_DMA(1, 1);
    bf16x8 qr[DQK / 16];
    { const unsigned short* qw = U.Q + (size_t)(wid * 32 + r32) * U.qp + hi * 8;
#pragma unroll
      for (int d0 = 0; d0 < DQK / 16; ++d0) qr[d0] = *(const bf16x8*)(qw + d0 * 16); }
    float m = -INFINITY, l = 0.f;
    f32x16 o[2]; o[0] = f32x16{}; o[1] = f32x16{};
    if (NT > 1) { if (C::NI == 2) ATT_WAIT_BAR(2); else ATT_WAIT_BAR(3); } else ATT_WAIT_BAR(0);
    const int qpos = U.qpos0 + wid * 32 + r32;
    int slot = 0;
    for (int t = 0; t < NT; ++t) {
        if (t + 2 < NT) { const int s2 = (slot >= 1) ? slot - 1 : 2; ATT_DMA(t + 2, s2); }
        f32x16 p0 = f32x16{}, p1 = f32x16{};
        { const lds_cptr kb = (lds_cptr)(ldsb + C::LDS_K) + slot * C::KSLOT + hi * 1024 + r32 * 16;
#pragma unroll
          for (int d0 = 0; d0 < DQK / 16; ++d0) {
              const bf16x8 b0 = *(const __attribute__((address_space(3))) bf16x8*)(kb + d0 * 2048);
              const bf16x8 b1 = *(const __attribute__((address_space(3))) bf16x8*)(kb + d0 * 2048 + 512);
              p0 = __builtin_amdgcn_mfma_f32_32x32x16_bf16(b0, qr[d0], p0, 0, 0, 0);
              p1 = __builtin_amdgcn_mfma_f32_32x32x16_bf16(b1, qr[d0], p1, 0, 0, 0); } }
        if (SWA) { if (t >= 4 && U.qpos0 >= 0) { const int sb = U.spos0 + 64 * (t - 4) + 4 * hi;
#pragma unroll
            for (int r = 0; r < 16; ++r) { const int dd = qpos - (sb + (r & 3) + 8 * (r >> 2));
                if (dd > 128 || dd < -128) p0[r] = -INFINITY;
                if (dd - 32 > 128 || dd - 32 < -128) p1[r] = -INFINITY; } } }
        float rm = fmaxf(p0[0], p1[0]);
#pragma unroll
        for (int r = 1; r < 16; ++r) rm = fmaxf(rm, fmaxf(p0[r], p1[r]));
        rm = halfswap_max(rm);
        if (__any(rm > m)) {
            const float mn = fmaxf(m, rm); const float alpha = __builtin_amdgcn_exp2f(m - mn);
            l *= alpha; m = mn;
            if (hi == 0) wsf[r32] = alpha;
            asm volatile("s_waitcnt lgkmcnt(0)" ::: "memory");
#pragma unroll
            for (int r = 0; r < 16; ++r) { const float f = wsf[crow(r, hi)]; o[0][r] *= f; o[1][r] *= f; }
        }
        float ls = 0.f;
#pragma unroll
        for (int r = 0; r < 16; ++r) { p0[r] = __builtin_amdgcn_exp2f(p0[r] - m); p1[r] = __builtin_amdgcn_exp2f(p1[r] - m); ls += p0[r] + p1[r]; }
        l += ls;
        u32x4 pw[4];
        pw[0] = (u32x4){cvtpk(p0[0], p0[1]), cvtpk(p0[2], p0[3]), cvtpk(p0[4], p0[5]), cvtpk(p0[6], p0[7])};
        pw[1] = (u32x4){cvtpk(p0[8], p0[9]), cvtpk(p0[10], p0[11]), cvtpk(p0[12], p0[13]), cvtpk(p0[14], p0[15])};
        pw[2] = (u32x4){cvtpk(p1[0], p1[1]), cvtpk(p1[2], p1[3]), cvtpk(p1[4], p1[5]), cvtpk(p1[6], p1[7])};
        pw[3] = (u32x4){cvtpk(p1[8], p1[9]), cvtpk(p1[10], p1[11]), cvtpk(p1[12], p1[13]), cvtpk(p1[14], p1[15])};
        { const lds_cptr vb = (lds_cptr)(ldsb + C::LDS_V) + slot * 8192 + ((lane >> 4) & 1) * 32 + (lane & 3) * 8 + (4 * hi + ((lane & 15) >> 2)) * 64;
#pragma unroll
          for (int d0 = 0; d0 < 2; ++d0)
#pragma unroll
              for (int ks = 0; ks < 4; ++ks) {
                  const s16x4 lo = vtr(vb + d0 * 4096 + ks * 1024), hh = vtr(vb + d0 * 4096 + ks * 1024 + 512);
                  const bf16x8 vf = (bf16x8){lo[0], lo[1], lo[2], lo[3], hh[0], hh[1], hh[2], hh[3]};
                  o[d0] = __builtin_amdgcn_mfma_f32_32x32x16_bf16(__builtin_bit_cast(bf16x8, pw[ks]), vf, o[d0], 0, 0, 0); } }
        if (t + 1 < NT) { if (t + 2 < NT) { if (C::NI == 2) ATT_WAIT_BAR(2); else ATT_WAIT_BAR(3); } else ATT_WAIT_BAR(0); }
        slot = (slot == 2) ? 0 : slot + 1;
    }
    l = halfswap_sum(l);
    if (U.has_sink) l += __builtin_amdgcn_exp2f(U.sink2 - m);
    if (hi == 0) wsf[32 + r32] = l;
    asm volatile("s_waitcnt lgkmcnt(0)" ::: "memory");
    { LAS unsigned short* stg = (LAS unsigned short*)(ldsb + C::LDS_OST) + wid * 2048;
#pragma unroll
      for (int r = 0; r < 16; ++r) { const int orow = crow(r, hi); const float rl = __builtin_amdgcn_rcpf(wsf[32 + orow]);
          stg[orow * 64 + r32] = (unsigned short)f2bf(o[0][r] * rl); stg[orow * 64 + 32 + r32] = (unsigned short)f2bf(o[1][r] * rl); }
      asm volatile("s_waitcnt lgkmcnt(0)" ::: "memory");
      unsigned short* yw = U.Y + (size_t)(wid * 32) * 1024;
#pragma unroll
      for (int i = 0; i < 4; ++i) { const int row = i * 8 + (lane >> 3), ch = lane & 7;
          const u32x4 ov = *(const LAS u32x4*)(stg + row * 64 + ch * 8);
          u32x4* gp = (u32x4*)(yw + (size_t)row * 1024 + ch * 8); const u32x4 g = *gp;
          u32x4 w; w.x = pk2(bflo(ov.x) * bflo(g.x), bfhi(ov.x) * bfhi(g.x)); w.y = pk2(bflo(ov.y) * bflo(g.y), bfhi(ov.y) * bfhi(g.y));
          w.z = pk2(bflo(ov.z) * bflo(g.z), bfhi(ov.z) * bfhi(g.z)); w.w = pk2(bflo(ov.w) * bflo(g.w), bfhi(ov.w) * bfhi(g.w));
          *gp = w; } }
    asm volatile("s_waitcnt vmcnt(0) lgkmcnt(0)\n\ts_barrier" ::: "memory");
#undef ATT_KROW
#undef ATT_DMA
}
}

__device__ __forceinline__ void ph_attn(Frame& F, int l) {
    unsigned short* ZS = (unsigned short*)(F.ws + WS_ZS); unsigned short* MQ = (unsigned short*)(F.ws + WS_MQ); unsigned short* MKV = (unsigned short*)(F.ws + WS_MKV); unsigned short* MK = (unsigned short*)(F.ws + WS_MK);
    unsigned short* Y = (unsigned short*)(F.ws + WS_G);
    LAS unsigned char* lds = F.lds + RING_OFF;
    const int u = F.vcu;
    const bool ctxq = (l == 0);
    for (int uu = u; uu < 256; uu += F.G) { const int bh = uu >> 4, qb = uu & 15, b = bh >> 2, h = bh & 3; const size_t r0 = (size_t)b * TPB, rq = r0 + CTXL + qb * 256;
        att::UnitDesc U{MQ + rq * 512 + h * 96, 512, MK + r0 * 384 + h * 96, 384, MKV + r0 * 512 + h * 128 + 64, 512, Y + rq * 1024 + h * 64, TPB / 64, 0, -1, 0, 0, 0.f};
        att::attn_unit<96, false>(lds, U, F.tid); }
    for (int uu = u; uu < 256; uu += F.G) { const int qb = uu & 15, g = (uu >> 4) & 1, kvh = (uu >> 5) & 1, b = uu >> 6, qh = kvh * 2 + g; const size_t r0 = (size_t)b * TPB, rq = r0 + CTXL + qb * 256;
        att::UnitDesc U{ZS + rq * ZS_P + ZC_AQ + qh * 64, ZS_P, ZS + r0 * ZS_P + ZC_AK + kvh * 64, ZS_P, ZS + r0 * ZS_P + ZC_AV + kvh * 64, ZS_P, Y + rq * 1024 + 512 + qh * 64, TPB / 64, 0, -1, 0, 0, 0.f};
        att::attn_unit<64, false>(lds, U, F.tid); }
    for (int uu = u; uu < 256; uu += F.G) { const int qb = uu & 15, g = (uu >> 4) & 1, kvh = (uu >> 5) & 1, b = uu >> 6, qh = kvh * 2 + g; const size_t r0 = (size_t)b * TPB, rq = r0 + CTXL + qb * 256;
        const int q0 = qb * 256, s0 = (q0 - 128 < 0) ? 0 : q0 - 128, s1 = (q0 + 384 > SEQ) ? SEQ : q0 + 384;
        att::UnitDesc U{ZS + rq * ZS_P + ZC_SQ + qh * 64, ZS_P, ZS + r0 * ZS_P + ZC_SK + kvh * 64, ZS_P, ZS + r0 * ZS_P + ZC_SV + kvh * 64, ZS_P, Y + rq * 1024 + 256 + qh * 64, 4 + (s1 - s0) / 64, CTXL + s0, q0, s0, 1, F.in(I_SINK)[l * 4 + qh] * LOG2E};
        att::attn_unit<64, true>(lds, U, F.tid); }
    if (ctxq) for (int uu = u; uu < 48; uu += F.G) { const int br = uu >> 4, b = (uu >> 2) & 3, h = uu & 3; const size_t r0 = (size_t)b * TPB;
        if (br == 0) { att::UnitDesc U{MQ + r0 * 512 + h * 96, 512, MK + r0 * 384 + h * 96, 384, MKV + r0 * 512 + h * 128 + 64, 512, Y + r0 * 1024 + h * 64, 4, 0, -1, 0, 0, 0.f};
            att::attn_unit<96, false>(lds, U, F.tid); }
        else if (br == 1) { att::UnitDesc U{ZS + r0 * ZS_P + ZC_SQ + h * 64, ZS_P, ZS + r0 * ZS_P + ZC_SK + (h >> 1) * 64, ZS_P, ZS + r0 * ZS_P + ZC_SV + (h >> 1) * 64, ZS_P, Y + r0 * 1024 + 256 + h * 64, 4, CTXL, -1, 0, 1, F.in(I_SINK)[l * 4 + h] * LOG2E};
            att::attn_unit<64, true>(lds, U, F.tid); }
        else { att::UnitDesc U{ZS + r0 * ZS_P + ZC_AQ + h * 64, ZS_P, ZS + r0 * ZS_P + ZC_AK + (h >> 1) * 64, ZS_P, ZS + r0 * ZS_P + ZC_AV + (h >> 1) * 64, ZS_P, Y + r0 * 1024 + 512 + h * 64, 4, 0, -1, 0, 0, 0.f};
            att::attn_unit<64, false>(lds, U, F.tid); } }
}
constexpr size_t WS_SUM = 253 * MiB;
constexpr size_t WS_HL = WS_U, WS_CP = WS_HF;
constexpr int NCHUNK = TPB / 64;
__device__ __forceinline__ float swap_lo(float x) { auto rr = __builtin_amdgcn_permlane32_swap(__float_as_uint(x), __float_as_uint(x), false, false); return __uint_as_float(rr[0]); }
__device__ __forceinline__ float swap_hi(float x) { auto rr = __builtin_amdgcn_permlane32_swap(__float_as_uint(x), __float_as_uint(x), false, false); return __uint_as_float(rr[1]); }
__device__ __forceinline__ void ph_lru1(Frame& F, int l) {
    typedef short bf16x8 __attribute__((ext_vector_type(8))); typedef float f32x16 __attribute__((ext_vector_type(16)));
    const unsigned short* ZS = (const unsigned short*)(F.ws + WS_ZS); unsigned short* HL = (unsigned short*)(F.ws + WS_HL); unsigned short* CP = (unsigned short*)(F.ws + WS_CP);
    f32x2v* SUM = (f32x2v*)(F.ws + WS_SUM);
    constexpr int UP = 264;
    LAS unsigned short* ul = (LAS unsigned short*)(F.lds + RING_OFF);
    const float* cw = F.in(I_CONVW) + l * 4 * 256; const float* cb = F.in(I_CONVB) + l * 256;
    const int tid = F.tid, lane = tid & 63, r32 = lane & 31, hi = lane >> 5, k = F.wave & 3, d = F.wave >> 2;
    for (int unit = F.vcu; unit < NB * NCHUNK; unit += F.G) {
        const int b = unit / NCHUNK, ci = unit % NCHUNK;
        int s0row, len, t0; if (ci < 4) { s0row = b * TPB; len = CTXL; t0 = ci * 64; } else { s0row = b * TPB + CTXL; len = SEQ; t0 = (ci - 4) * 64; }
        { const int cc = tid & 255, hh = tid >> 8; float zv[35];
#pragma unroll
          for (int i = 0; i < 35; ++i) { const int tt = t0 + hh * 32 + i - 2; const int tc = tt < 0 ? 0 : (tt >= len ? len - 1 : tt);
              const float v = bf2f(ZS[(size_t)(s0row + tc) * ZS_P + ZC_LRU + cc]); zv[i] = (tt >= 0 && tt < len) ? v : 0.f; }
          const float w0 = cw[cc], w1 = cw[256 + cc], w2 = cw[512 + cc], w3 = cw[768 + cc], bb = cb[cc];
#pragma unroll
          for (int t = 0; t < 32; ++t) ul[(hh * 32 + t) * UP + cc] = (unsigned short)f2bf(bb + w0 * zv[t] + w1 * zv[t + 1] + w2 * zv[t + 2] + w3 * zv[t + 3]); }
        __syncthreads();
#pragma unroll 1
        for (int tn = 0; tn < 2; ++tn) {
            const int c = k * 64 + 32 * tn + r32;
            bf16x8 wf[2][4];
            const float brv = F.in(I_LBR)[(l * 2 + d) * 256 + c], biv = F.in(I_LBI)[(l * 2 + d) * 256 + c], spv = ((const float*)(F.ws + WS_SP))[(l * 2 + d) * 256 + c];
#pragma unroll
            for (int gate = 0; gate < 2; ++gate)
#pragma unroll
                for (int ks = 0; ks < 4; ++ks) { const float* src = (const float*)(F.ws + WS_LWT) + ((((size_t)l * 2 + d) * 2 + gate) * 256 + c) * 64 + 16 * ks + 8 * hi;
                    const f32x4 a = *(const f32x4*)src, b2 = *(const f32x4*)(src + 4);
                    v4u w; w.x = pk2(a.x, a.y); w.y = pk2(a.z, a.w); w.z = pk2(b2.x, b2.y); w.w = pk2(b2.z, b2.w); wf[gate][ks] = __builtin_bit_cast(bf16x8, w); }
            f32x16 A[2], X[2];
            A[0] = f32x16{}; A[1] = f32x16{}; X[0] = f32x16{}; X[1] = f32x16{};
#pragma unroll
            for (int tm = 0; tm < 2; ++tm)
#pragma unroll
                for (int ks = 0; ks < 4; ++ks) { const bf16x8 af = *(const LAS bf16x8*)(ul + (32 * tm + r32) * UP + k * 64 + 16 * ks + 8 * hi);
                    A[tm] = __builtin_amdgcn_mfma_f32_32x32x16_bf16(af, wf[0][ks], A[tm], 0, 0, 0); X[tm] = __builtin_amdgcn_mfma_f32_32x32x16_bf16(af, wf[1][ks], X[tm], 0, 0, 0); }
#pragma unroll
            for (int tm = 0; tm < 2; ++tm)
#pragma unroll
                for (int r = 0; r < 16; ++r) { const int tok = 32 * tm + (r & 3) + 8 * (r >> 2) + 4 * hi; const float uu = bf2f(ul[tok * UP + c]);
                    const float rr = sigmoid_f(A[tm][r] + brv), ii = sigmoid_f(X[tm][r] + biv);
                    const float a = __builtin_amdgcn_exp2f(-rr * spv); A[tm][r] = a; X[tm][r] = __builtin_amdgcn_sqrtf(1.0f - a * a) * (ii * uu);
                    if ((r & 3) == 3) asm volatile("" ::: "memory"); }
#pragma unroll
            for (int tm = 0; tm < 2; ++tm)
#pragma unroll
                for (int rg = 0; rg < 4; ++rg) { const int r0 = 4 * rg;
                    if (d == 0) {
#pragma unroll
                        for (int e2 = 1; e2 < 4; ++e2) { X[tm][r0 + e2] = A[tm][r0 + e2] * X[tm][r0 + e2 - 1] + X[tm][r0 + e2]; A[tm][r0 + e2] = A[tm][r0 + e2] * A[tm][r0 + e2 - 1]; } }
                    else {
#pragma unroll
                        for (int e2 = 2; e2 >= 0; --e2) { X[tm][r0 + e2] = A[tm][r0 + e2] * X[tm][r0 + e2 + 1] + X[tm][r0 + e2]; A[tm][r0 + e2] = A[tm][r0 + e2] * A[tm][r0 + e2 + 1]; } } }
            float enH[8], enP[8]; float EH = 0.f, EP = 1.f;
            if (d == 0) {
#pragma unroll
                for (int q = 0; q < 8; ++q) { const int tm = q >> 2, re = 4 * (q & 3) + 3; const float ce = A[tm][re], he = X[tm][re];
                    const float aH = swap_lo(ce * EH + he), aP = swap_lo(EP * ce);
                    const float E1H = hi ? aH : EH, E1P = hi ? aP : EP;
                    enH[q] = E1H; enP[q] = E1P;
                    EH = swap_hi(ce * E1H + he); EP = swap_hi(E1P * ce); }
            } else {
#pragma unroll
                for (int q = 7; q >= 0; --q) { const int tm = q >> 2, re = 4 * (q & 3); const float ce = A[tm][re], he = X[tm][re];
                    const float aH = swap_hi(ce * EH + he), aP = swap_hi(EP * ce);
                    const float E1H = hi ? EH : aH, E1P = hi ? EP : aP;
                    enH[q] = E1H; enP[q] = E1P;
                    EH = swap_lo(ce * E1H + he); EP = swap_lo(E1P * ce); }
            }
            { const unsigned ob = (unsigned)((((s0row + t0 + 4 * hi) * 2 + d) * 256 + c) * 2);
#pragma unroll
              for (int tm = 0; tm < 2; ++tm)
#pragma unroll
                for (int rg = 0; rg < 4; ++rg) { const int q = 4 * tm + rg;
#pragma unroll
                    for (int e2 = 0; e2 < 4; ++e2) { const int r = 4 * rg + e2; const unsigned o = ob + (unsigned)(32 * tm + 8 * rg + e2) * 1024u;
                        *(unsigned short*)((char*)HL + o) = (unsigned short)f2bf(X[tm][r] + A[tm][r] * enH[q]); *(unsigned short*)((char*)CP + o) = (unsigned short)f2bf(A[tm][r] * enP[q]); }
                    asm volatile("" ::: "memory"); } }
            if (hi == 0) SUM[((size_t)(b * NCHUNK + ci) * 2 + d) * 256 + c] = (f32x2v){EP, EH};
        }
        __syncthreads();
    }
}
constexpr size_t WS_CARRY = 255 * MiB;
__device__ __forceinline__ void ph_lru_carry(Frame& F) {
    if (F.vcu < 4) {
        const int g = F.vcu * NTHREADS + F.tid, b = g >> 9, d = (g >> 8) & 1, c = g & 255;
        const f32x2v* sb = (const f32x2v*)(F.ws + WS_SUM) + ((size_t)b * NCHUNK * 2 + d) * 256 + c;
        float* cr = (float*)(F.ws + WS_CARRY) + ((size_t)b * NCHUNK * 2 + d) * 256 + c;
        float h = 0.f;
#pragma unroll 1
        for (int p0 = 0; p0 < NCHUNK; p0 += 17) {
            f32x2v s[17];
#pragma unroll
            for (int i = 0; i < 17; ++i) { const int p = p0 + i, j = (d == 0) ? p : (p < 4 ? 3 - p : NCHUNK + 3 - p); s[i] = sb[(size_t)j * 512]; }
#pragma unroll
            for (int i = 0; i < 17; ++i) { const int p = p0 + i, j = (d == 0) ? p : (p < 4 ? 3 - p : NCHUNK + 3 - p); cr[(size_t)j * 512] = h; h = s[i].x * h + s[i].y; }
        }
    }
}
__device__ __forceinline__ void ph_lru2(Frame& F, int l) {
    const unsigned short* HL = (const unsigned short*)(F.ws + WS_HL); const unsigned short* CP = (const unsigned short*)(F.ws + WS_CP);
    const float* CARRY = (const float*)(F.ws + WS_CARRY); unsigned short* Y = (unsigned short*)(F.ws + WS_G);
    const int tid = F.tid, cg = tid & 31, tq = tid >> 5; const bool last = (l == NLAYER - 1);
    for (int unit = F.vcu; unit < NB * NCHUNK; unit += F.G) {
        const int b = unit / NCHUNK, ci = unit % NCHUNK;
        if (last && ci < 4) continue;
        const float* cp0 = CARRY + ((size_t)(b * NCHUNK + ci) * 2) * 256 + cg * 8;
        const f32x4 cfa = *(const f32x4*)cp0, cfb = *(const f32x4*)(cp0 + 4), cba = *(const f32x4*)(cp0 + 256), cbb = *(const f32x4*)(cp0 + 260);
        const float cf[8] = {cfa.x, cfa.y, cfa.z, cfa.w, cfb.x, cfb.y, cfb.z, cfb.w}, cbk[8] = {cba.x, cba.y, cba.z, cba.w, cbb.x, cbb.y, cbb.z, cbb.w};
        v4u hf[4], pf[4], hb[4], pb[4], gg[4];
#pragma unroll
        for (int i = 0; i < 4; ++i) { const size_t row = (size_t)b * TPB + ci * 64 + tq + 16 * i; const size_t o = (row * 2) * 256 + cg * 8;
            hf[i] = *(const v4u*)(HL + o); pf[i] = *(const v4u*)(CP + o); hb[i] = *(const v4u*)(HL + o + 256); pb[i] = *(const v4u*)(CP + o + 256); gg[i] = *(const v4u*)(Y + row * 1024 + 768 + cg * 8); }
#pragma unroll
        for (int i = 0; i < 4; ++i) { const size_t row = (size_t)b * TPB + ci * 64 + tq + 16 * i;
            unsigned w[4];
#pragma unroll
            for (int e = 0; e < 4; ++e) { const unsigned a = hf[i][e], p = pf[i][e], a2 = hb[i][e], p2 = pb[i][e], g = gg[i][e];
                const float v0 = (bflo(a) + bflo(p) * cf[2 * e] + bflo(a2) + bflo(p2) * cbk[2 * e]) * bflo(g);
                const float v1 = (bfhi(a) + bfhi(p) * cf[2 * e + 1] + bfhi(a2) + bfhi(p2) * cbk[2 * e + 1]) * bfhi(g);
                w[e] = pk2(v0, v1); }
            *(v4u*)(Y + row * 1024 + 768 + cg * 8) = (v4u){w[0], w[1], w[2], w[3]}; }
    }
}
constexpr int NPL = 10;
enum { PH_H = 0, PH_G1, PH_POST1, PH_G2, PH_POST2, PH_ATT, PH_SG, PH_PG, PH_MIX, PH_OG };
constexpr int NPHASES = 1 + NLAYER * NPL;
#ifndef NAIVE_ATT
#define NAIVE_ATT 0
#endif
#ifndef PROBE_MASK
#define PROBE_MASK 0
#endif
#ifndef PROBE_LAYERS
#define PROBE_LAYERS 3
#endif
#ifndef PHMASK
#define PHMASK 16383
#endif
#ifndef MK_ONE_LAUNCH
#define MK_ONE_LAUNCH 1
#endif

__global__ void __launch_bounds__(NTHREADS, 2) fwd_kernel(Args args) {
    extern __shared__ __attribute__((aligned(16))) unsigned char lds_raw[];
    { LAS unsigned char* l0 = (LAS unsigned char*)lds_raw;
      for (int u = threadIdx.x; u < (LDS_BYTES - LDSCTL_OFF) / 4; u += NTHREADS) ((LAS unsigned*)(l0 + LDSCTL_OFF))[u] = 0u;
      __syncthreads();
      if (args.ph_hi - args.ph_lo > 1) (void)xcd_barrier_post((unsigned*)((gu32*)(args.ws + WS_CTL) + CW_BAR), (volatile LAS unsigned*)(l0 + MISC_OFF) + 8); }

    unsigned long long tacc = 0ull;
    for (int ph = args.ph_lo; ph < args.ph_hi; ++ph) {
        unsigned long long tph0 = 0ull; bool probed = false;
        if (PROBE_MASK) { const int pl = (ph == 0) ? 0 : (ph - 1) / NPL, pp = (ph == 0) ? 10 : (ph - 1) % NPL; probed = ((PROBE_MASK >> pp) & 1) && ((PROBE_LAYERS >> pl) & 1); if (probed) tph0 = __builtin_amdgcn_s_memrealtime(); }
        int z; asm volatile("s_mov_b32 %0, 0" : "=s"(z));
        Frame F;
        F.lds = (LAS unsigned char*)lds_raw + z; F.kin = (const float* const __attribute__((address_space(4)))*)((const __attribute__((address_space(4))) char*)__builtin_amdgcn_kernarg_segment_ptr() + z); F.ws = args.ws + z; F.out = args.out + z; F.z = z;
        F.tid = threadIdx.x + z; F.lane = F.tid & 63; F.wave = __builtin_amdgcn_readfirstlane(F.tid >> 6);
        F.G = gridDim.x + z; { const int bx = blockIdx.x + z; F.vcu = (F.G % 8 == 0) ? (bx % 8) * (F.G / 8) + bx / 8 : bx; }
        F.gw = F.vcu * NWAVES + F.wave; F.NGW = F.G * NWAVES;
        bool is_gemm = false;
        pg8::Gemm g{nullptr, nullptr, NROWS, 256, 1024, 1024, 31, 0};
        pg8::Order S; S.init(1, 1, F.G, (int)blockIdx.x + z, 0);
        pg8::EpiU E{pg8::EM_PLAIN, 0, F.ws, nullptr, nullptr, nullptr, 0, 0, 0, 0, 1 << 20};
        if (ph == 0) { if (PHMASK & 8192) p0_prologue(F); }
        else {
            const int l = (ph - 1) / NPL, p = (ph - 1) % NPL;
            unsigned char* wl = F.ws + WS_W + (size_t)l * W_LAYER;
            const bool last = (l == NLAYER - 1);
            const int nMc = last ? 64 : NROWS / 256, lat = last ? 1 : 0;
            E.l = l;
            if (p == PH_H && (PHMASK & 1)) { ph_hnorm(F, l); }
            else if (p == PH_G1 && (PHMASK & 2)) {
                is_gemm = true; g.A = (const bf16*)(F.ws + WS_H); g.Bt = (const bf16*)(wl + WO_W1); g.N = N1; g.K = 1024; g.lda = 1024;
                S.init(NROWS / 256, N1 / 256, F.G, (int)blockIdx.x + z, 0);
                E.mode = pg8::EM_SILU2; E.oA = WS_ZS; E.ldc = ZS_P; E.oB = WS_G; E.ldc2 = 1024; E.split_tile = 7;
            }
            else if (p == PH_POST1 && (PHMASK & 4)) { ph_lru1(F, l); ph_post1(F, l); }
            else if (p == PH_G2 && (PHMASK & 8)) {
                is_gemm = true; g.A = (const bf16*)(F.ws + WS_ZS); g.Bt = (const bf16*)(wl + WO_UQ); g.N = 1024; g.K = 256; g.lda = ZS_P; g.a_shift = 1; g.a_step = 512;
                S.init(NROWS / 256, 4, F.G, (int)blockIdx.x + z, 0);
                E.mode = pg8::EM_PLAIN; E.oA = WS_MQ; E.ldc = 512; E.oB = WS_MKV; E.ldc2 = 512; E.split_tile = 2;
            }
            else if (p == PH_POST2 && (PHMASK & 16)) { ph_lru_carry(F); ph_post2(F, l); }
            else if (p == PH_ATT && (PHMASK & 32)) {
#if NAIVE_ATT
                ph_attn_naive(F, l);
#else
                ph_attn(F, l);
#endif
                ph_lru2(F, l); }
            else if (p == PH_SG && (PHMASK & 512)) {
                is_gemm = true; g.A = (const bf16*)(F.ws + WS_H); g.Bt = (const bf16*)(wl + WO_W1) + (size_t)N1 * 1024; g.N = 4096; g.K = 1024; g.lda = 1024;
                S.init(nMc, 16, F.G, (int)blockIdx.x + z, lat);
                E.mode = pg8::EM_SIG; E.oA = WS_S; E.ldc = 4096;
            }
            else if (p == PH_PG && (PHMASK & 1024)) {
                is_gemm = true; g.A = (const bf16*)(F.ws + WS_G); g.Bt = (const bf16*)(wl + WO_WB); g.N = 4096; g.K = 256; g.lda = 1024; g.a_shift = 2; g.a_step = 512;
                S.init(nMc, 16, F.G, (int)blockIdx.x + z, lat);
                E.mode = pg8::EM_MUL; E.oA = WS_S; E.ldc = 4096;
            }
            else if (p == PH_MIX && (PHMASK & 2048)) { ph_mixsum(F); }
            else if (p == PH_OG && (PHMASK & 4096)) {
                is_gemm = true; g.A = (const bf16*)(F.ws + WS_H); g.Bt = (const bf16*)(wl + WO_WO); g.N = 1024; g.K = 1024; g.lda = 1024;
                S.init(nMc, 4, F.G, (int)blockIdx.x + z, lat);
                E.mode = pg8::EM_RES; E.xin = (l == 0) ? F.in(I_X) : (const float*)F.out; E.xout = F.out; E.cin0 = F.in(I_CTX); E.oA = WS_MOD; E.oB = WS_CTX1;
            }
        }
        if (is_gemm) pg8::gemm_phase<pg8::EpiU, pg8::Order, true, true>(F.lds + RING_OFF, g, S, E, F.tid);
        if (ph + 1 < args.ph_hi) {
            int z2; asm volatile("s_mov_b32 %0, 0" : "=s"(z2));
            XcdBarrier bar; bar.bar = (unsigned*)((gu32*)(args.ws + z2 + WS_CTL) + CW_BAR); bar.x = xb_xcc_id(); bar.st = (volatile LAS unsigned*)((LAS unsigned char*)lds_raw + z2 + MISC_OFF) + 8;
            xcd_barrier(bar);
        }
        if (PROBE_MASK) { if (probed) tacc += __builtin_amdgcn_s_memrealtime() - tph0; }
    }
    if (PROBE_MASK) { const unsigned long long t0 = __builtin_amdgcn_s_memrealtime(); while (__builtin_amdgcn_s_memrealtime() - t0 < tacc) __builtin_amdgcn_s_sleep(8); }
}

extern "C" void kernel_launch(void* const* d_in, const int* in_sizes, int n_in, void* d_out, int out_size, void* d_ws, size_t ws_size, hipStream_t stream) {
    static int grid = 0;
    if (grid == 0) {
        if (n_in != 28 || out_size != NB * SEQ * DM || ws_size < WS_END) { fprintf(stderr, "kernel_launch: unexpected shapes (n_in %d out %d ws %zu); nothing launched\n", n_in, out_size, ws_size); grid = -1; return; }
        int dev = 0, cus = 0, per_cu = 0;
        if (hipGetDevice(&dev) != hipSuccess || hipDeviceGetAttribute(&cus, hipDeviceAttributeMultiprocessorCount, dev) != hipSuccess) { grid = -1; return; }
        if (hipFuncSetAttribute((const void*)fwd_kernel, hipFuncAttributeMaxDynamicSharedMemorySize, LDS_BYTES) != hipSuccess) { fprintf(stderr, "kernel_launch: hipFuncSetAttribute failed\n"); grid = -1; return; }
        if (hipOccupancyMaxActiveBlocksPerMultiprocessor(&per_cu, (const void*)fwd_kernel, NTHREADS, LDS_BYTES) != hipSuccess || per_cu < 1) { fprintf(stderr, "kernel_launch: occupancy query says %d\n", per_cu); (void)hipGetLastError(); grid = -1; return; }
        grid = cus;
    }
    if (grid < 0) return;
    (void)hipMemsetAsync((char*)d_ws + WS_CTL, 0, CTL_ZERO_BYTES, stream);
    Args a{};
    for (int i = 0; i < 28; ++i) a.in[i] = (const float*)d_in[i];
    a.out = (float*)d_out; a.ws = (unsigned char*)d_ws;
#if MK_ONE_LAUNCH
    a.ph_lo = 0; a.ph_hi = NPHASES;
    hipLaunchKernelGGL(fwd_kernel, dim3(grid), dim3(NTHREADS), LDS_BYTES, stream, a);
#else
    for (int ph = 0; ph < NPHASES; ++ph) { a.ph_lo = ph; a.ph_hi = ph + 1; hipLaunchKernelGGL(fwd_kernel, dim3(grid), dim3(NTHREADS), LDS_BYTES, stream, a); }
#endif
}
```

```cpp
#include <hip/hip_runtime.h>
#include <cstdio>
#include <cstdint>
#include <cmath>
__device__ __forceinline__ float bflo(unsigned w) { return __uint_as_float(w << 16); }
__device__ __forceinline__ float bfhi(unsigned w) { return __uint_as_float(w & 0xffff0000u); }
__device__ __forceinline__ float sigmoid_f(float v) { return __builtin_amdgcn_rcpf(1.0f + __builtin_amdgcn_exp2f(-1.4426950408889634f * v)); }
namespace pg8 {
#define PG8_LAS __attribute__((address_space(3)))
typedef unsigned short bf16_t;
typedef short bf16x8 __attribute__((ext_vector_type(8)));
typedef float f32x4 __attribute__((ext_vector_type(4)));
typedef unsigned u32x4 __attribute__((ext_vector_type(4)));
constexpr int BM = 256, BK = 64, HALF = 128, HTB = HALF * BK * 2  , STAGE_BYTES = 8 * HTB, NXCD = 8, WGM = 8;

__host__ __device__ __forceinline__ int lds_byte(int r, int c) { const int st = (r >> 4) * 2 + (c >> 5), rr = r & 15, cc = c & 31, ob = rr * 64 + cc * 2; return st * 1024 + (ob ^ (((ob >> 9) & 1) << 5)); }
__host__ __device__ __forceinline__ void stage_rc(int b, int& R, int& C) { const int st = b / 1024, sb = b % 1024, swz = sb ^ (((sb >> 9) & 1) << 5); R = (st >> 1) * 16 + swz / 64; C = (st & 1) * 32 + (swz % 64) / 2; }
__host__ __device__ __forceinline__ int perm32(int rho) { const int n = rho >> 4, i = rho & 15; return 8 * (i >> 2) + 4 * n + (i & 3); }

struct Unit { int pm, pn; };
struct Gemm { const bf16_t* A; const bf16_t* Bt; int M, N, K, lda; int a_shift, a_step; };

struct StaticOrder {
    int nM, nN, nwg, G, c;
    __host__ __device__ void init(int M, int N, int G_, int c_) { nM = M / BM; nN = N / BM; nwg = nM * nN; G = G_; c = c_; }
    __host__ __device__ bool next(int i, Unit& u) const {
        const long L = (long)i * G + c; if (L >= nwg) return false;
        int wgid = (int)L; { const int q = nwg / NXCD, r = nwg % NXCD, xcd = wgid % NXCD, off = wgid / NXCD; wgid = (xcd < r ? xcd * (q + 1) : r * (q + 1) + (xcd - r) * q) + off; }
        const int nig = WGM * nN, gid = wgid / nig, fm = gid * WGM, gsz = (nM - fm) < WGM ? (nM - fm) : WGM;
        u.pm = fm + ((wgid % nig) % gsz); u.pn = (wgid % nig) / gsz; return true;
    }
    __device__ __forceinline__ void a_ready(const Unit&) const {}
    __device__ __forceinline__ void done(const Unit&) const {}
};

__device__ __forceinline__ unsigned cvt_pk_bf16(float lo, float hi) { unsigned r; asm volatile("v_cvt_pk_bf16_f32 %0, %1, %2" : "=v"(r) : "v"(lo), "v"(hi)); return r; }
enum { EM_PLAIN = 0, EM_SILU2 = 1, EM_SIG = 2, EM_MUL = 3, EM_RES = 4 };
struct EpiU {
    static constexpr bool PERM = true, AFTER_DRAIN = false;
    int mode; int l; unsigned char* ws; const float* xin; float* xout; const float* cin0;
    size_t oA, oB; int ldc, ldc2, split_tile;
    __device__ __forceinline__ void operator()(const f32x4 (&acc)[2][2][4][2], const Unit& u, int wr, int wc, int fr, int fq) const {
        if (mode == EM_RES) {
            const int b = u.pm / 17, t0 = u.pm % 17;
            const float* src; float* dst; const float* gate; const float* modl = (const float*)(ws + oA) + (size_t)l * 5 * 3072;
            if (t0 == 0) { float* c1 = (float*)(ws + oB); src = ((l == 0) ? cin0 : (const float*)c1) + (size_t)b * 256 * 1024; dst = c1 + (size_t)b * 256 * 1024; gate = modl + 4 * 3072 + 2048; }
            else { const size_t o = ((size_t)b * 4096 + (size_t)(t0 - 1) * 256) * 1024; src = xin + o; dst = xout + o; gate = modl + b * 3072 + 2048; }
            const int col0 = u.pn * BM + wc * 32 + 8 * fq;
            const char* srcb = (const char*)src; char* dstb = (char*)dst; const char* gb = (const char*)(gate + col0);
            const unsigned off0 = (unsigned)((wr * 64 + fr) * 1024 + col0) * 4u;
#pragma unroll
            for (int ai = 0; ai < 2; ++ai) {
                f32x4 xo[4][2][2];
#pragma unroll
                for (int m = 0; m < 4; ++m) { const unsigned off = off0 + (unsigned)(ai * HALF + m * 16) * 4096u;
#pragma unroll
                    for (int bj = 0; bj < 2; ++bj)
#pragma unroll
                        for (int n = 0; n < 2; ++n) xo[m][bj][n] = *(const f32x4*)(srcb + (off + (unsigned)(bj * HALF + n * 4) * 4u)); }
#pragma unroll
                for (int m = 0; m < 4; ++m) { const unsigned off = off0 + (unsigned)(ai * HALF + m * 16) * 4096u;
#pragma unroll
                    for (int bj = 0; bj < 2; ++bj)
#pragma unroll
                        for (int n = 0; n < 2; ++n) { const unsigned cb = (unsigned)(bj * HALF + n * 4) * 4u; const f32x4 g = *(const f32x4*)(gb + cb);
                            *(f32x4*)(dstb + (off + cb)) = xo[m][bj][n] + g * acc[ai][bj][m][n]; } }
                asm volatile("" ::: "memory"); }
            return;
        }
        const int row0 = u.pm * BM + wr * 64 + fr; int colt = u.pn * BM; bf16_t* base = (bf16_t*)(ws + oA); int ld = ldc; bool second = false;
        if (u.pn >= split_tile) { base = (bf16_t*)(ws + oB); ld = ldc2; colt -= split_tile * BM; second = true; }
        const bool do_silu = (mode == EM_SILU2) && second;
        const int col0 = colt + wc * 32 + 8 * fq;
        if (mode == EM_MUL) {
            const int kk = u.pn >> 2, jt = u.pn & 3; const bool isctx = (u.pm % 17) == 0;
            bf16_t* mixb = (bf16_t*)(ws + oB); const int mcol0 = jt * BM + wc * 32 + 8 * fq;
            const bool rmw = !isctx && kk > 0;
#pragma unroll
            for (int am = 0; am < 4; ++am) { const int ai = am >> 1, mh = (am & 1) * 2;
                u32x4 old[2][2], prev[2][2];
#pragma unroll
                for (int m2 = 0; m2 < 2; ++m2)
#pragma unroll
                    for (int bj = 0; bj < 2; ++bj) old[m2][bj] = *(const u32x4*)(base + (size_t)(row0 + ai * HALF + (mh + m2) * 16) * ld + col0 + bj * HALF);
                if (rmw) {
#pragma unroll
                    for (int m2 = 0; m2 < 2; ++m2)
#pragma unroll
                        for (int bj = 0; bj < 2; ++bj) prev[m2][bj] = *(const u32x4*)(mixb + (size_t)(row0 + ai * HALF + (mh + m2) * 16) * 1024 + mcol0 + bj * HALF); }
#pragma unroll
                for (int m2 = 0; m2 < 2; ++m2)
#pragma unroll
                    for (int bj = 0; bj < 2; ++bj) { const int m = mh + m2; const f32x4 v0 = acc[ai][bj][m][0], v1 = acc[ai][bj][m][1]; const u32x4 o = old[m2][bj];
                        float t[8] = {v0[0] * bflo(o.x), v0[1] * bfhi(o.x), v0[2] * bflo(o.y), v0[3] * bfhi(o.y), v1[0] * bflo(o.z), v1[1] * bfhi(o.z), v1[2] * bflo(o.w), v1[3] * bfhi(o.w)};
                        if (rmw) { const u32x4 q = prev[m2][bj]; t[0] += bflo(q.x); t[1] += bfhi(q.x); t[2] += bflo(q.y); t[3] += bfhi(q.y); t[4] += bflo(q.z); t[5] += bfhi(q.z); t[6] += bflo(q.w); t[7] += bfhi(q.w); }
                        u32x4 w; w.x = cvt_pk_bf16(t[0], t[1]); w.y = cvt_pk_bf16(t[2], t[3]); w.z = cvt_pk_bf16(t[4], t[5]); w.w = cvt_pk_bf16(t[6], t[7]);
                        if (isctx) *(u32x4*)(base + (size_t)(row0 + ai * HALF + m * 16) * ld + col0 + bj * HALF) = w;
                        else *(u32x4*)(mixb + (size_t)(row0 + ai * HALF + m * 16) * 1024 + mcol0 + bj * HALF) = w; }
                asm volatile("" ::: "memory"); }
            return;
        }
#pragma unroll
        for (int ai = 0; ai < 2; ++ai)
#pragma unroll
            for (int m = 0; m < 4; ++m) { bf16_t* rowp = base + (size_t)(row0 + ai * HALF + m * 16) * ld + col0;
#pragma unroll
                for (int bj = 0; bj < 2; ++bj) { f32x4 v0 = acc[ai][bj][m][0], v1 = acc[ai][bj][m][1];
                    if (mode == EM_SIG) {
#pragma unroll
                        for (int e = 0; e < 4; ++e) { v0[e] = sigmoid_f(v0[e]); v1[e] = sigmoid_f(v1[e]); } }
                    if (do_silu) {
#pragma unroll
                        for (int e = 0; e < 4; ++e) { v0[e] = v0[e] * sigmoid_f(v0[e]); v1[e] = v1[e] * sigmoid_f(v1[e]); } }
                    u32x4 w; w.x = cvt_pk_bf16(v0[0], v0[1]); w.y = cvt_pk_bf16(v0[2], v0[3]); w.z = cvt_pk_bf16(v1[0], v1[1]); w.w = cvt_pk_bf16(v1[2], v1[3]);
                    *(u32x4*)(rowp + bj * HALF) = w; } }
    }
};
struct Order {
    int nM, nN, nwg, G, c, latent_only, grouped, vc, nctx;
    __device__ void init(int nM_, int nN_, int G_, int c_, int lat) { nM = nM_; nN = nN_; nwg = nM * nN; G = G_; c = c_; latent_only = lat; grouped = 0; vc = 0; nctx = 0; }
    __device__ void init_grouped(int G_, int vc_, int with_ctx) { init(64, 4, G_, vc_, 1); grouped = 1; vc = vc_; nctx = with_ctx ? 64 : 0; }
    __device__ bool next(int i, Unit& u) const {
        if (grouped) {
            const int gi = i >> 2, grp = vc + gi * G;
            if (grp < 256) { const int pm = grp >> 2; u.pm = pm + pm / 16 + 1; u.pn = 4 * (i & 3) + (grp & 3); return true; }
            const int done = ((256 - vc + G - 1) / G) * 4;
            const int x = vc + (i - done) * G;
            if (i >= done && x < nctx) { const int g = x >> 2, k = x & 3; u.pm = (g >> 2) * 17; u.pn = 4 * k + (g & 3); return true; }
            return false;
        }
        const long L = (long)i * G + c; if (L >= nwg) return false;
        int wgid = (int)L; { const int q = nwg / NXCD, r = nwg % NXCD, xcd = wgid % NXCD, off = wgid / NXCD; wgid = (xcd < r ? xcd * (q + 1) : r * (q + 1) + (xcd - r) * q) + off; }
        const int nig = WGM * nN, gid = wgid / nig, fm = gid * WGM, gsz = (nM - fm) < WGM ? (nM - fm) : WGM;
        int pm = fm + ((wgid % nig) % gsz); u.pn = (wgid % nig) / gsz; if (latent_only) pm = pm + pm / 16 + 1; u.pm = pm; return true;
    }
    __device__ __forceinline__ void a_ready(const Unit&) const {}
    __device__ __forceinline__ void done(const Unit&) const {}
};
template <class Epi, class Sched, bool ALIGN_EPI = false, bool SP2 = false>
__device__ __forceinline__ void gemm_phase(PG8_LAS unsigned char* lds, const Gemm g, const Sched& S, const Epi& E, const int tid  ) {
    const int wid = __builtin_amdgcn_readfirstlane(tid >> 6), lane = tid & 63, wr = wid >> 2, wc = wid & 3, fr = lane & 15, fq = lane >> 4;
    const int K = g.K, nt = K / BK;
    unsigned voffA[2], voffB[2];
#pragma unroll
    for (int i = 0; i < 2; ++i) { int R, C; stage_rc(tid * 16 + i * 8192, R, C); const int Rb = Epi::PERM ? ((R & ~31) + perm32(R & 31)) : R;
        voffA[i] = (unsigned)(R * g.lda + C) * 2u; voffB[i] = (unsigned)(Rb * K + C) * 2u; }
    const size_t kstep = (size_t)(BK * 2);
    const size_t hstepA = (size_t)HALF * g.lda * 2, hstepB = (size_t)HALF * K * 2;
    const size_t tstepA = 2 * hstepA, tstepB = 2 * hstepB;
    const unsigned ldsw = (unsigned)wid * 1024u;
    const int aoff = lds_byte(wr * 64 + fr, fq * 8), boff = lds_byte(wc * 32 + fr, fq * 8);
#define PG8_SA(b, h) (((b) * 2 + (h)) * HTB)
#define PG8_SB(b, h) ((4 + (b) * 2 + (h)) * HTB)
#define PG8_STAGE(bufoff, gbase, voff) do { _Pragma("unroll") for (int _i = 0; _i < 2; ++_i) \
        __builtin_amdgcn_global_load_lds((const unsigned*)((const char*)(gbase) + (voff)[_i]), (PG8_LAS unsigned*)(lds + (bufoff) + ldsw + _i * 8192), 16, 0, 0); } while (0)
#define PG8_LDA(dst, b, h) do { _Pragma("unroll") for (int m = 0; m < 4; ++m) _Pragma("unroll") for (int k = 0; k < 2; ++k) dst[m][k] = *(const PG8_LAS bf16x8*)(lds + PG8_SA(b, h) + aoff + m * 2048 + k * 1024); } while (0)
#define PG8_LDB(dst, b, h) do { _Pragma("unroll") for (int n = 0; n < 2; ++n) _Pragma("unroll") for (int k = 0; k < 2; ++k) dst[n][k] = *(const PG8_LAS bf16x8*)(lds + PG8_SB(b, h) + boff + n * 2048 + k * 1024); } while (0)
#define PG8_MMA(ai, bj, At, Bt) do { __builtin_amdgcn_s_setprio(1); _Pragma("unroll") for (int m = 0; m < 4; ++m) _Pragma("unroll") for (int n = 0; n < 2; ++n) _Pragma("unroll") for (int k = 0; k < 2; ++k) \
        acc[ai][bj][m][n] = __builtin_amdgcn_mfma_f32_16x16x32_bf16(Bt[n][k], At[m][k], acc[ai][bj][m][n], 0, 0, 0); __builtin_amdgcn_s_setprio(0); } while (0)
#define PG8_WAIT_V(n) asm volatile("s_waitcnt vmcnt(" #n ")" ::: "memory")
#define PG8_WAIT_L(n) asm volatile("s_waitcnt lgkmcnt(" #n ")" ::: "memory")
#define PG8_BAR __builtin_amdgcn_s_barrier()
#define PG8_SCHED __builtin_amdgcn_sched_barrier(0)
    Unit cur, nxt; int ui = 0;
    if (!S.next(0, cur)) return;
    f32x4 acc[2][2][4][2];
#pragma unroll
    for (int a = 0; a < 2; ++a)
#pragma unroll
        for (int b = 0; b < 2; ++b)
#pragma unroll
            for (int m = 0; m < 4; ++m)
#pragma unroll
                for (int n = 0; n < 2; ++n) acc[a][b][m][n] = (f32x4){0.f, 0.f, 0.f, 0.f};
    bf16x8 At[4][2], B0[2][2], B1[2][2];
    const char* cA = (const char*)g.A + (size_t)cur.pm * tstepA + (size_t)(cur.pn >> g.a_shift) * (size_t)g.a_step; const char* cB = (const char*)g.Bt + (size_t)cur.pn * tstepB;
    S.a_ready(cur);
    if constexpr (SP2) {
        PG8_STAGE(PG8_SB(0, 0), cB, voffB); PG8_STAGE(PG8_SB(0, 1), cB + hstepB, voffB); PG8_STAGE(PG8_SA(0, 0), cA, voffA); PG8_STAGE(PG8_SA(0, 1), cA + hstepA, voffA);
        if (wr == 1) PG8_BAR;
        PG8_WAIT_V(2); PG8_BAR;
        PG8_STAGE(PG8_SB(1, 0), cB + kstep, voffB); PG8_STAGE(PG8_SA(1, 0), cA + kstep, voffA); PG8_STAGE(PG8_SB(1, 1), cB + hstepB + kstep, voffB);
        PG8_WAIT_V(6); PG8_BAR;
    } else {
        PG8_STAGE(PG8_SB(0, 0), cB, voffB); PG8_STAGE(PG8_SA(0, 0), cA, voffA); PG8_STAGE(PG8_SB(0, 1), cB + hstepB, voffB); PG8_STAGE(PG8_SA(0, 1), cA + hstepA, voffA);
        if (wr == 1) PG8_BAR;
        PG8_WAIT_V(4); PG8_BAR;
        PG8_STAGE(PG8_SB(1, 0), cB + kstep, voffB); PG8_STAGE(PG8_SA(1, 0), cA + kstep, voffA); PG8_STAGE(PG8_SB(1, 1), cB + hstepB + kstep, voffB);
        PG8_WAIT_V(6); PG8_BAR;
    }
    for (;;) {
        const bool has_next = S.next(ui + 1, nxt);
        const char* nA = has_next ? (const char*)g.A + (size_t)nxt.pm * tstepA + (size_t)(nxt.pn >> g.a_shift) * (size_t)g.a_step : cA; const char* nB = has_next ? (const char*)g.Bt + (size_t)nxt.pn * tstepB : cB;
        for (int t = 0; t < nt; t += 2) {
            const bool last = (t == nt - 2);
            const char* a1 = cA + (size_t)(t + 1) * kstep;
            const char* a2 = last ? nA : cA + (size_t)(t + 2) * kstep; const char* b2 = last ? nB : cB + (size_t)(t + 2) * kstep;
            const char* a3 = a2 + kstep; const char* b3 = b2 + kstep;
            if (last && has_next) S.a_ready(nxt);
            if constexpr (SP2) {
            PG8_LDB(B0, 0, 0); PG8_LDB(B1, 0, 1); PG8_SCHED; PG8_LDA(At, 0, 0); PG8_STAGE(PG8_SA(1, 1), a1 + hstepA, voffA);
            PG8_WAIT_V(8); PG8_WAIT_L(0); PG8_BAR; PG8_MMA(0, 0, At, B0); PG8_MMA(0, 1, At, B1); PG8_BAR; PG8_SCHED;
            PG8_LDA(At, 0, 1); PG8_STAGE(PG8_SB(0, 0), b2, voffB); PG8_STAGE(PG8_SB(0, 1), b2 + hstepB, voffB); PG8_STAGE(PG8_SA(0, 0), a2, voffA);
            PG8_WAIT_V(8); PG8_WAIT_L(0); PG8_BAR; PG8_MMA(1, 0, At, B0); PG8_MMA(1, 1, At, B1); PG8_BAR; PG8_SCHED;
            PG8_LDB(B0, 1, 0); PG8_LDB(B1, 1, 1); PG8_SCHED; PG8_LDA(At, 1, 0); PG8_STAGE(PG8_SA(0, 1), a2 + hstepA, voffA);
            PG8_WAIT_V(8); PG8_WAIT_L(0); PG8_BAR; PG8_MMA(0, 0, At, B0); PG8_MMA(0, 1, At, B1); PG8_BAR; PG8_SCHED;
            PG8_LDA(At, 1, 1); PG8_STAGE(PG8_SB(1, 0), b3, voffB); PG8_STAGE(PG8_SB(1, 1), b3 + hstepB, voffB); PG8_STAGE(PG8_SA(1, 0), a3, voffA);
            PG8_WAIT_V(8); PG8_WAIT_L(0); PG8_BAR; PG8_MMA(1, 0, At, B0); PG8_MMA(1, 1, At, B1); PG8_BAR; PG8_SCHED;
            } else {
            PG8_LDB(B0, 0, 0); PG8_SCHED; PG8_LDA(At, 0, 0); PG8_STAGE(PG8_SA(1, 1), a1 + hstepA, voffA);
            PG8_WAIT_L(8); PG8_BAR; PG8_WAIT_L(0); PG8_MMA(0, 0, At, B0); PG8_BAR; PG8_SCHED;
            PG8_LDB(B1, 0, 1); PG8_STAGE(PG8_SB(0, 0), b2, voffB);
            PG8_BAR; PG8_WAIT_L(0); PG8_MMA(0, 1, At, B1); PG8_BAR;
            PG8_LDA(At, 0, 1); PG8_STAGE(PG8_SA(0, 0), a2, voffA);
            PG8_BAR; PG8_WAIT_L(0); PG8_MMA(1, 0, At, B0); PG8_BAR; PG8_SCHED;
            PG8_STAGE(PG8_SB(0, 1), b2 + hstepB, voffB);
            PG8_WAIT_V(6); PG8_BAR; PG8_MMA(1, 1, At, B1); PG8_BAR;
            PG8_LDB(B0, 1, 0); PG8_SCHED; PG8_LDA(At, 1, 0); PG8_STAGE(PG8_SA(0, 1), a2 + hstepA, voffA);
            PG8_WAIT_L(8); PG8_BAR; PG8_WAIT_L(0); PG8_MMA(0, 0, At, B0); PG8_BAR; PG8_SCHED;
            PG8_LDB(B1, 1, 1); PG8_STAGE(PG8_SB(1, 0), b3, voffB);
            PG8_BAR; PG8_WAIT_L(0); PG8_MMA(0, 1, At, B1); PG8_BAR;
            PG8_LDA(At, 1, 1); PG8_STAGE(PG8_SA(1, 0), a3, voffA);
            PG8_BAR; PG8_WAIT_L(0); PG8_MMA(1, 0, At, B0); PG8_BAR; PG8_SCHED;
            PG8_STAGE(PG8_SB(1, 1), b3 + hstepB, voffB);
            PG8_WAIT_V(6); PG8_BAR; PG8_MMA(1, 1, At, B1); PG8_BAR;
            }
        }
        if constexpr (ALIGN_EPI) { if (wr == 0) PG8_BAR; }
        if constexpr (!Epi::AFTER_DRAIN) { E(acc, cur, wr, wc, fr, fq); S.done(cur); }
        if (!has_next) break;
#pragma unroll
        for (int a = 0; a < 2; ++a)
#pragma unroll
            for (int b = 0; b < 2; ++b)
#pragma unroll
                for (int m = 0; m < 4; ++m)
#pragma unroll
                    for (int n = 0; n < 2; ++n) acc[a][b][m][n] = (f32x4){0.f, 0.f, 0.f, 0.f};
        cur = nxt; cA = nA; cB = nB; ++ui;
        if constexpr (ALIGN_EPI) { if (wr == 1) PG8_BAR; }
    }
    PG8_WAIT_V(0);
    if constexpr (!ALIGN_EPI) { if (wr == 0) PG8_BAR; }
    PG8_BAR;
    if constexpr (Epi::AFTER_DRAIN) { E.fused(acc, cur, wr, wc, fr, fq, lds, wid, lane); S.done(cur); }
#undef PG8_SA
#undef PG8_SB
#undef PG8_STAGE
#undef PG8_LDA
#undef PG8_LDB
#undef PG8_MMA
#undef PG8_WAIT_V
#undef PG8_WAIT_L
#undef PG8_BAR
#undef PG8_SCHED
}
}
#define PG8_SP2 true
#define PG8_ALIGN true
#define GAS __attribute__((address_space(1)))
#define LAS __attribute__((address_space(3)))
typedef unsigned short bf16;
typedef unsigned v4u __attribute__((ext_vector_type(4)));
typedef float f32x4 __attribute__((ext_vector_type(4)));
typedef short bf16x8 __attribute__((ext_vector_type(8)));
typedef GAS unsigned gu32;
typedef GAS unsigned long long gu64;
#define RLX_AGENT __ATOMIC_RELAXED, __HIP_MEMORY_SCOPE_AGENT
#define LDS_WAIT() asm volatile("s_waitcnt lgkmcnt(0)" ::: "memory")
#define VM_WAIT() asm volatile("s_waitcnt vmcnt(0)" ::: "memory")
__device__ __forceinline__ unsigned long long rt() { return __builtin_amdgcn_s_memrealtime(); }
__device__ __forceinline__ unsigned f2bf(float f) { unsigned u = __builtin_bit_cast(unsigned, f); return (u + 0x7fffu + ((u >> 16) & 1u)) >> 16; }
__device__ __forceinline__ unsigned pk2(float lo, float hi) { return f2bf(lo) | (f2bf(hi) << 16); }
#define XB_TMO      128
#define XB_XCNT(j)  (256  + 64 * (j))
#define XB_XSUB(j)  (1280 + 64 * (j))
#define XB_XGEN(j)  (2304 + 64 * (j))
#define XB_TOP      3328
#define XB_TOPGEN   3392
#define XCD_BAR_WORDS 3456
#define XB_SPIN_CAP (1u << 18)

__device__ __forceinline__ unsigned xb_ld(unsigned* p)              { return __hip_atomic_load(p, __ATOMIC_RELAXED, __HIP_MEMORY_SCOPE_AGENT); }
__device__ __forceinline__ unsigned xb_add(unsigned* p, unsigned v) { return __hip_atomic_fetch_add(p, v, __ATOMIC_RELAXED, __HIP_MEMORY_SCOPE_AGENT); }
__device__ __forceinline__ unsigned xb_xcc_id() { return (unsigned)__builtin_amdgcn_s_getreg((3 << 11) | 20) & 0xFu; }
#define XB_SPIN(cond, bar) do { unsigned _sp = 0; while (cond) { __builtin_amdgcn_s_sleep(1); \
    if ((++_sp & 255u) == 0u) { if (xb_ld(&(bar)[XB_TMO])) break; if (_sp > XB_SPIN_CAP) { atomicAdd(&(bar)[XB_TMO], 1u); break; } } } } while (0)

struct XcdBarrier {
    unsigned* bar; unsigned x;
    volatile LAS unsigned* st;
};

__device__ __forceinline__ XcdBarrier xcd_barrier_post(unsigned* bar, volatile LAS unsigned* st) {
    XcdBarrier b; b.bar = bar; b.x = xb_xcc_id(); b.st = st;
    if (threadIdx.x == 0) (void)xb_add(&bar[XB_XCNT(b.x)], 1u);
    return b;
}
__device__ __forceinline__ void xcd_barrier_complete(unsigned* bar, unsigned x, unsigned& nloc, unsigned& nx) {
    const unsigned G = gridDim.x * gridDim.y * gridDim.z;
    unsigned sum, cnt, mine, sp = 0u;
    for (;;) {
        sum = 0u; cnt = 0u; mine = 0u;
#pragma unroll
        for (unsigned j = 0; j < 16; ++j) { const unsigned c = xb_ld(&bar[XB_XCNT(j)]); sum += c; cnt += (c > 0u) ? 1u : 0u; mine = (j == x) ? c : mine; }
        if (sum == G) break;
        __builtin_amdgcn_s_sleep(1);
        if ((++sp & 255u) == 0u) { if (xb_ld(&bar[XB_TMO])) break; if (sp > XB_SPIN_CAP) { atomicAdd(&bar[XB_TMO], 1u); break; } }
    }
    nloc = mine > 0u ? mine : 1u; nx = cnt > 0u ? cnt : 1u;
}

__device__ __forceinline__ void xcd_barrier(const XcdBarrier& b) {
    asm volatile("s_waitcnt vmcnt(0)" ::: "memory");
    __syncthreads();
    if (threadIdx.x == 0) {
        unsigned* bar = b.bar;
        __builtin_amdgcn_s_waitcnt(0);
        unsigned nloc = b.st[0], nx = b.st[1];
        if (nloc == 0u) { xcd_barrier_complete(bar, b.x, nloc, nx); b.st[0] = nloc; b.st[1] = nx; }
        const unsigned old = xb_add(&bar[XB_XSUB(b.x)], 1u);
        const unsigned gen = old / nloc;
        if (old + 1u == (gen + 1u) * nloc) {
            __builtin_amdgcn_fence(__ATOMIC_RELEASE, "agent");
            asm volatile("s_waitcnt vmcnt(0)" ::: "memory");
            const unsigned og = xb_add(&bar[XB_TOP], 1u);
            const unsigned tg = og / nx;
            if (og + 1u == (tg + 1u) * nx) xb_add(&bar[XB_TOPGEN], 1u);
            else XB_SPIN(xb_ld(&bar[XB_TOPGEN]) == tg, bar);
            __builtin_amdgcn_fence(__ATOMIC_ACQUIRE, "agent");
            xb_add(&bar[XB_XGEN(b.x)], 1u);
            asm volatile("s_waitcnt vmcnt(0)" ::: "memory");
        } else {
            XB_SPIN(xb_ld(&bar[XB_XGEN(b.x)]) == gen, bar);
            __builtin_amdgcn_fence(__ATOMIC_ACQUIRE, "agent");
            asm volatile("s_waitcnt vmcnt(0)" ::: "memory");
        }
    }
    __syncthreads();
}
constexpr int NB = 4, SEQ = 4096, CTXL = 256, TPB = SEQ + CTXL, NROWS = NB * TPB, DM = 1024, NLAYER = 2, IN_COLS = 6816;
constexpr int NWAVES = 8, NTHREADS = NWAVES * 64;
constexpr float RMS_EPS = 1e-6f;
constexpr float LOG2E = 1.4426950408889634f;
constexpr float QSCALE64 = 0.125f * LOG2E;
constexpr float QSCALE96 = 0.10206207261596575f * LOG2E;
constexpr int ZS_P = 1792, ZC_CQ = 0, ZC_CKV = 256, ZC_KR = 384, ZC_SQ = 512, ZC_SK = 768, ZC_SV = 896, ZC_AQ = 1024, ZC_AK = 1280, ZC_AV = 1408, ZC_LRU = 1536;
constexpr int N1 = 2816;
constexpr int W1ROWS = N1 + 4096;
constexpr size_t MiB = 1u << 20;
constexpr size_t WS_CTL = 0, CTL_ZERO_BYTES = 64 * 1024;
constexpr size_t WS_MOD = 1 * MiB;
constexpr size_t WS_RHC = 1 * MiB + 256 * 1024, WS_RHS = WS_RHC + 512 * 1024;
constexpr size_t WS_RMC = WS_RHS + 512 * 1024, WS_RMS = WS_RMC + 256 * 1024;
constexpr size_t WS_CTX1 = 3 * MiB;
constexpr size_t WS_W = 8 * MiB, W_LAYER = 18 * MiB;
constexpr size_t WO_W1 = 0, WO_WB = 13 * MiB + 512 * 1024, WO_WO = WO_WB + 2 * MiB, WO_UQ = WO_WO + 2 * MiB, WO_UKV = WO_UQ + 256 * 1024;
constexpr size_t WS_H = 44 * MiB;
constexpr size_t WS_G = 78 * MiB;
constexpr size_t WS_S = 112 * MiB;
constexpr size_t WS_ZS = 112 * MiB;
constexpr size_t WS_MQ = 172 * MiB;
constexpr size_t WS_MKV = 189 * MiB;
constexpr size_t WS_MK = 206 * MiB;
constexpr size_t WS_U = 219 * MiB;
constexpr size_t WS_HF = 236 * MiB;
constexpr size_t WS_SP = 2 * MiB + 768 * 1024;
constexpr size_t WS_LWT = 254 * MiB + 512 * 1024;
constexpr size_t WS_END = 256 * MiB;
static_assert(WS_H + (size_t)NROWS * 1024 * 2 <= WS_G && WS_G + (size_t)NROWS * 1024 * 2 <= WS_S && WS_S + (size_t)NROWS * 4096 * 2 <= 248 * MiB, "ws map");
static_assert(WS_ZS + (size_t)NROWS * ZS_P * 2 <= WS_MQ && WS_MK + (size_t)NROWS * 384 * 2 <= WS_U, "ws map 2");
static_assert(WO_UKV + 512 * 256 * 2 <= W_LAYER, "weights");
constexpr int CW_BAR = 1024;

constexpr int RING_OFF = 0, RING_BYTES = 131072, LDSCTL_OFF = RING_BYTES, MISC_OFF = LDSCTL_OFF + 320, LDS_BYTES = 147456;

typedef unsigned short bf16;
typedef unsigned u32x2 __attribute__((ext_vector_type(2)));
typedef float f32x2v __attribute__((ext_vector_type(2)));
__device__ __forceinline__ float bf2f(bf16 v) { return __uint_as_float((unsigned)v << 16); }
__device__ __forceinline__ float wave_sum(float v) {
#pragma unroll
    for (int o = 1; o < 64; o <<= 1) v += __shfl_xor(v, o);
    return v; }
__device__ __forceinline__ float wave_max(float v) {
#pragma unroll
    for (int o = 1; o < 64; o <<= 1) v = fmaxf(v, __shfl_xor(v, o));
    return v; }
__device__ __forceinline__ float grp16_sum(float v) {
#pragma unroll
    for (int o = 1; o < 16; o <<= 1) v += __shfl_xor(v, o);
    return v; }

struct Args { const float* in[28]; float* out; unsigned char* ws; int ph_lo, ph_hi; };
enum { I_X = 0, I_C, I_CTX, I_CCTX, I_WMOD, I_BMOD, I_NORMW, I_WIN, I_CQN, I_CKVN, I_WUQ, I_WUKV, I_MQN, I_MKN, I_SQN, I_SKN, I_SINK, I_AQN, I_AKN,
       I_CONVW, I_CONVB, I_LWR, I_LBR, I_LWI, I_LBI, I_LAM, I_WBR, I_WOUT };

struct Frame {
    LAS unsigned char* lds; const float* const __attribute__((address_space(4)))* kin; unsigned char* ws; float* out;
    int tid, lane, wave, G, vcu, gw, NGW, z;
    __device__ __forceinline__ const float* in(int i) const { return kin[i]; }
};

__device__ __forceinline__ void xpose_item(const float* W, int ldn, int k0, int n0, bf16* WT, int pd, int drow, LAS float* scr, int lane) {
#pragma unroll 8
    for (int i = 0; i < 32; ++i) { const int kk = 2 * i + (lane >> 5); scr[kk * 33 + (lane & 31)] = W[(size_t)(k0 + kk) * ldn + n0 + (lane & 31)]; }
    LDS_WAIT(); asm volatile("" ::: "memory");
    const int c = lane & 7;
#pragma unroll
    for (int j = 0; j < 4; ++j) { const int n = (lane >> 3) + 8 * j; const LAS float* s = scr + (8 * c) * 33 + n;
        v4u o; o.x = pk2(s[0 * 33], s[1 * 33]); o.y = pk2(s[2 * 33], s[3 * 33]); o.z = pk2(s[4 * 33], s[5 * 33]); o.w = pk2(s[6 * 33], s[7 * 33]);
        *(GAS v4u*)(WT + (size_t)(drow + n0 + n) * pd + k0 + 8 * c) = o; }
    LDS_WAIT(); asm volatile("" ::: "memory");
}
__device__ __forceinline__ void zero16(bf16* p, size_t n16, int gt, int ngt) {
    for (size_t i = gt; i < n16; i += ngt) ((GAS v4u*)p)[i] = (v4u){0u, 0u, 0u, 0u};
}
__device__ __forceinline__ void p0_prologue(Frame& F) {
    LAS float* scr = (LAS float*)(F.lds + RING_OFF + F.wave * 16384);
    constexpr int I_IN = 16 * 213, I_UQ = 4 * 12, I_UKV = 2 * 16, I_BR = 4 * 4 * 32, I_OUT = 16 * 32, I_LAYER = I_IN + I_UQ + I_UKV + I_BR + I_OUT;
    for (int it = F.gw; it < NLAYER * I_LAYER; it += F.NGW) {
        const int l = it / I_LAYER; int r = it % I_LAYER;
        unsigned char* wl = F.ws + WS_W + (size_t)l * W_LAYER;
        if (r < I_IN) { const int kb = r / 213, nb = r % 213, n0 = nb * 32;
            xpose_item(F.in(I_WIN) + (size_t)l * 1024 * IN_COLS, IN_COLS, kb * 64, n0, (bf16*)(wl + WO_W1), 1024, n0 >= 416 ? 96 : 0, scr, F.lane); continue; } r -= I_IN;
        if (r < I_UQ) { const int kb = r / 12, nb = r % 12;
            xpose_item(F.in(I_WUQ) + (size_t)l * 256 * 384, 384, kb * 64, nb * 32, (bf16*)(wl + WO_UQ), 256, 0, scr, F.lane); continue; } r -= I_UQ;
        if (r < I_UKV) { const int kb = r / 16, nb = r % 16;
            xpose_item(F.in(I_WUKV) + (size_t)l * 128 * 512, 512, kb * 64, nb * 32, (bf16*)(wl + WO_UKV), 256, 0, scr, F.lane); continue; } r -= I_UKV;
        if (r < I_BR) { const int k = r / 128, rr = r % 128, kb = rr / 32, nb = rr % 32;
            xpose_item(F.in(I_WBR) + ((size_t)l * 4 + k) * 256 * 1024, 1024, kb * 64, nb * 32, (bf16*)(wl + WO_WB) + (size_t)k * 1024 * 256, 256, 0, scr, F.lane); continue; } r -= I_BR;
        { const int kb = r / 32, nb = r % 32;
            xpose_item(F.in(I_WOUT) + (size_t)l * 1024 * 1024, 1024, kb * 64, nb * 32, (bf16*)(wl + WO_WO), 1024, 0, scr, F.lane); }
    }
    const int gt = F.vcu * NTHREADS + F.tid, ngt = F.G * NTHREADS;
    for (int l = 0; l < NLAYER; ++l) {
        unsigned char* wl = F.ws + WS_W + (size_t)l * W_LAYER;
        zero16((bf16*)(wl + WO_W1) + (size_t)416 * 1024, 96 * 1024 * 2 / 16, gt, ngt);
        zero16((bf16*)(wl + WO_UQ) + (size_t)384 * 256, 128 * 256 * 2 / 16, gt, ngt);
        for (int i = gt; i < 512 * 16; i += ngt) { const int n = i >> 4, c = i & 15; ((GAS v4u*)((bf16*)(wl + WO_UKV) + (size_t)n * 256 + 128))[c] = (v4u){0u, 0u, 0u, 0u}; }
    }
    { float* rhc = (float*)(F.ws + WS_RHC); float* rhs = (float*)(F.ws + WS_RHS); float* rmc = (float*)(F.ws + WS_RMC); float* rms = (float*)(F.ws + WS_RMS);
      for (int i = gt; i < 4096 * 32; i += ngt) { const int t = i >> 5, p = i & 31; const float fr = powf(10000.0f, -(float)(p & 15) / 16.0f);
          const float pos = (float)((p < 16) ? (t >> 6) : (t & 63)); const float ang = pos * fr; rhc[i] = cosf(ang); rhs[i] = sinf(ang); }
      for (int i = gt; i < 4096 * 16; i += ngt) { const int t = i >> 4, p = i & 15; const float fr = powf(10000.0f, -(float)(p & 7) / 8.0f);
          const float pos = (float)((p < 8) ? (t >> 6) : (t & 63)); const float ang = pos * fr; rmc[i] = cosf(ang); rms[i] = sinf(ang); } }
    { float* sp = (float*)(F.ws + WS_SP); for (int i = gt; i < NLAYER * 2 * 256; i += ngt) sp[i] = 8.0f * LOG2E * log1pf(expf(-F.in(I_LAM)[i])); }
    { float* lwt = (float*)(F.ws + WS_LWT);
      for (int o = gt; o < NLAYER * 2 * 2 * 256 * 64; o += ngt) { const int i = o & 63, c = (o >> 6) & 255, gate = (o >> 14) & 1, ld = o >> 15, k = c >> 6, j = c & 63;
          lwt[o] = (gate == 0 ? F.in(I_LWR) : F.in(I_LWI))[(((size_t)ld * 4 + k) * 64 + i) * 64 + j]; } }
    { LAS float* sc = (LAS float*)(F.lds + RING_OFF);
      LAS float* red = sc + 5 * 1024;
      __syncthreads();
      for (int i = F.tid; i < 5 * 1024; i += NTHREADS) { const float v = (i < 4096) ? F.in(I_C)[i] : F.in(I_CCTX)[i - 4096]; sc[i] = v / (1.0f + expf(-v)); }
      __syncthreads();
      float* modv = (float*)(F.ws + WS_MOD);
      for (int it = F.vcu; it < NLAYER * 96; it += F.G) {
          const int l = it / 96, n0 = (it % 96) * 32, nn = F.tid & 31, kc = F.tid >> 5;
          const float* w = F.in(I_WMOD) + (size_t)l * 1024 * 3072 + n0 + nn;
          float acc[5] = {0.f, 0.f, 0.f, 0.f, 0.f};
          for (int k = kc * 64; k < kc * 64 + 64; ++k) { const float wv = w[(size_t)k * 3072];
#pragma unroll
              for (int r = 0; r < 5; ++r) acc[r] += sc[r * 1024 + k] * wv; }
#pragma unroll
          for (int r = 0; r < 5; ++r) red[(kc * 5 + r) * 32 + nn] = acc[r];
          __syncthreads();
          if (F.tid < 160) { const int r = F.tid >> 5; float s = 0.f;
              for (int q = 0; q < 16; ++q) s += red[(q * 5 + r) * 32 + nn];
              modv[((size_t)l * 5 + r) * 3072 + n0 + nn] = s + F.in(I_BMOD)[l * 3072 + n0 + nn]; }
          __syncthreads();
      } }
}

__device__ __forceinline__ void ph_hnorm(Frame& F, int l) {
    const float* xs = (l == 0) ? F.in(I_X) : F.out; const float* cs = (l == 0) ? F.in(I_CTX) : (const float*)(F.ws + WS_CTX1);
    const float* nw = F.in(I_NORMW) + l * 1024; const float* modl = (const float*)(F.ws + WS_MOD) + (size_t)l * 5 * 3072;
    bf16* H = (bf16*)(F.ws + WS_H);
    for (int row = F.gw; row < NROWS; row += F.NGW) {
        const int b = row / TPB, j = row % TPB; const float* src; int mr;
        if (j < CTXL) { src = cs + ((size_t)b * CTXL + j) * 1024; mr = 4; } else { src = xs + ((size_t)b * SEQ + (j - CTXL)) * 1024; mr = b; }
        const GAS f32x4* xr = (const GAS f32x4*)src + F.lane;
        f32x4 v[4]; float ss = 0.f;
#pragma unroll
        for (int q = 0; q < 4; ++q) { v[q] = xr[64 * q]; ss += (v[q].x * v[q].x + v[q].y * v[q].y) + (v[q].z * v[q].z + v[q].w * v[q].w); }
        const float rstd = 1.0f / sqrtf(wave_sum(ss) * (1.0f / 1024.0f) + RMS_EPS);
        const float* mrow = modl + mr * 3072;
        GAS unsigned long long* o8 = (GAS unsigned long long*)(H + (size_t)row * 1024) + F.lane;
#pragma unroll
        for (int q = 0; q < 4; ++q) { const int c = 4 * F.lane + 256 * q;
            const f32x4 g = *(const f32x4*)(nw + c), sh = *(const f32x4*)(mrow + c), sc = *(const f32x4*)(mrow + 1024 + c);
            const f32x4 h = v[q] * rstd * g * (sc + 1.0f) + sh;
            o8[64 * q] = (unsigned long long)pk2(h.x, h.y) | ((unsigned long long)pk2(h.z, h.w) << 32); }
    }
}

struct P1Regs { u32x2 cq; unsigned ckv, h[3][2]; float rc[2], rs[2]; };
__device__ __forceinline__ void post1_load(const bf16* z, const float* rc, const float* rs, bool lat, int lane, P1Regs& R) {
    const int hg = lane >> 4, p0 = (lane & 15) * 2;
    R.cq = *(const u32x2*)(z + ZC_CQ + 4 * lane); R.ckv = *(const unsigned*)(z + ZC_CKV + 2 * lane);
    const bf16* h0 = z + ZC_SQ + hg * 64 + p0; const bf16* h1 = z + ZC_AQ + hg * 64 + p0; const bf16* h2 = z + ((hg < 2) ? (ZC_SK + hg * 64) : (ZC_AK + (hg - 2) * 64)) + p0;
    R.h[0][0] = *(const unsigned*)h0; R.h[0][1] = *(const unsigned*)(h0 + 32); R.h[1][0] = *(const unsigned*)h1; R.h[1][1] = *(const unsigned*)(h1 + 32); R.h[2][0] = *(const unsigned*)h2; R.h[2][1] = *(const unsigned*)(h2 + 32);
    if (lat) { R.rc[0] = rc[p0]; R.rc[1] = rc[p0 + 1]; R.rs[0] = rs[p0]; R.rs[1] = rs[p0 + 1]; } else { R.rc[0] = 1.f; R.rc[1] = 1.f; R.rs[0] = 0.f; R.rs[1] = 0.f; }
}
__device__ __forceinline__ void post1_finish(bf16* z, int lane, const P1Regs& R, const float (&gcq)[4], const float (&gckv)[2], const float (&gh)[3][4]) {
    const int hg = lane >> 4, p0 = (lane & 15) * 2;
    { float v0 = bflo(R.cq.x), v1 = bfhi(R.cq.x), v2 = bflo(R.cq.y), v3 = bfhi(R.cq.y);
      const float rstd = 1.0f / sqrtf(wave_sum(v0 * v0 + v1 * v1 + v2 * v2 + v3 * v3) * (1.0f / 256.0f) + RMS_EPS);
      u32x2 w; w.x = pk2(v0 * rstd * gcq[0], v1 * rstd * gcq[1]); w.y = pk2(v2 * rstd * gcq[2], v3 * rstd * gcq[3]); *(u32x2*)(z + ZC_CQ + 4 * lane) = w; }
    { float v0 = bflo(R.ckv), v1 = bfhi(R.ckv);
      const float rstd = 1.0f / sqrtf(wave_sum(v0 * v0 + v1 * v1) * (1.0f / 128.0f) + RMS_EPS);
      *(unsigned*)(z + ZC_CKV + 2 * lane) = pk2(v0 * rstd * gckv[0], v1 * rstd * gckv[1]); }
#pragma unroll
    for (int q = 0; q < 3; ++q) {
        bf16* hp = z + ((q == 0) ? (ZC_SQ + hg * 64) : (q == 1) ? (ZC_AQ + hg * 64) : ((hg < 2) ? (ZC_SK + hg * 64) : (ZC_AK + (hg - 2) * 64))) + p0;
        float a0 = bflo(R.h[q][0]), a1 = bfhi(R.h[q][0]), b0 = bflo(R.h[q][1]), b1 = bfhi(R.h[q][1]);
        const float rstd = 1.0f / sqrtf(grp16_sum(a0 * a0 + a1 * a1 + b0 * b0 + b1 * b1) * (1.0f / 64.0f) + RMS_EPS);
        a0 *= rstd * gh[q][0]; a1 *= rstd * gh[q][1]; b0 *= rstd * gh[q][2]; b1 *= rstd * gh[q][3];
        const float x0 = a0 * R.rc[0] - b0 * R.rs[0], y0 = b0 * R.rc[0] + a0 * R.rs[0], x1 = a1 * R.rc[1] - b1 * R.rs[1], y1 = b1 * R.rc[1] + a1 * R.rs[1];
        const float sc = (q < 2) ? QSCALE64 : 1.0f;
        *(unsigned*)hp = pk2(x0 * sc, x1 * sc); *(unsigned*)(hp + 32) = pk2(y0 * sc, y1 * sc);
    }
}
__device__ __forceinline__ void ph_post1(Frame& F, int l) {
    bf16* ZS = (bf16*)(F.ws + WS_ZS);
    const float* rhc = (const float*)(F.ws + WS_RHC); const float* rhs = (const float*)(F.ws + WS_RHS);
    const int lane = F.lane, hg = lane >> 4, p0 = (lane & 15) * 2;
    float gcq[4], gckv[2], gh[3][4];
#pragma unroll
    for (int i = 0; i < 4; ++i) gcq[i] = F.in(I_CQN)[l * 256 + 4 * lane + i];
    gckv[0] = F.in(I_CKVN)[l * 128 + 2 * lane]; gckv[1] = F.in(I_CKVN)[l * 128 + 2 * lane + 1];
    { const float* g0 = F.in(I_SQN) + l * 64; const float* g1 = F.in(I_AQN) + l * 64; const float* g2 = ((hg < 2) ? F.in(I_SKN) : F.in(I_AKN)) + l * 64;
      gh[0][0] = g0[p0]; gh[0][1] = g0[p0 + 1]; gh[0][2] = g0[32 + p0]; gh[0][3] = g0[33 + p0];
      gh[1][0] = g1[p0]; gh[1][1] = g1[p0 + 1]; gh[1][2] = g1[32 + p0]; gh[1][3] = g1[33 + p0];
      gh[2][0] = g2[p0]; gh[2][1] = g2[p0 + 1]; gh[2][2] = g2[32 + p0]; gh[2][3] = g2[33 + p0]; }
    for (int row = F.gw; row < NROWS; row += 2 * F.NGW) {
        const int row2 = row + F.NGW; const bool has2 = row2 < NROWS;
        const int j = row % TPB; const bool lat = j >= CTXL; const int pos = lat ? j - CTXL : 0;
        const int j2 = has2 ? row2 % TPB : 0; const bool lat2 = j2 >= CTXL; const int pos2 = lat2 ? j2 - CTXL : 0;
        bf16* z = ZS + (size_t)row * ZS_P; bf16* z2 = ZS + (size_t)(has2 ? row2 : row) * ZS_P;
        P1Regs A, B;
        post1_load(z, rhc + pos * 32, rhs + pos * 32, lat, lane, A);
        if (has2) post1_load(z2, rhc + pos2 * 32, rhs + pos2 * 32, lat2, lane, B);
        post1_finish(z, lane, A, gcq, gckv, gh);
        if (has2) post1_finish(z2, lane, B, gcq, gckv, gh);
    }
}
struct P2Regs { u32x2 qn, kn; bf16 q1, q2, k1, k2; float c, s; };
__device__ __forceinline__ void post2_load(const bf16* zrow, const bf16* mq, const bf16* mkv, const float* rc, const float* rs, bool lat, int lane, P2Regs& R) {
    const int h = lane >> 4, j = lane & 15;
    R.qn = *(const u32x2*)(mq + h * 96 + 4 * j); R.q1 = mq[h * 96 + 64 + j]; R.q2 = mq[h * 96 + 80 + j];
    R.kn = *(const u32x2*)(mkv + h * 128 + 4 * j); R.k1 = zrow[ZC_KR + j]; R.k2 = zrow[ZC_KR + 16 + j];
    if (lat) { R.c = rc[j]; R.s = rs[j]; } else { R.c = 1.f; R.s = 0.f; }
}
__device__ __forceinline__ void post2_finish(bf16* mq, bf16* mk, int lane, const P2Regs& R, const float (&gq)[6], const float (&gk)[6]) {
    const int h = lane >> 4, j = lane & 15;
#pragma unroll
    for (int qk = 0; qk < 2; ++qk) {
        const u32x2 n = qk == 0 ? R.qn : R.kn; float v0 = bflo(n.x), v1 = bfhi(n.x), v2 = bflo(n.y), v3 = bfhi(n.y), r1 = bf2f(qk == 0 ? R.q1 : R.k1), r2 = bf2f(qk == 0 ? R.q2 : R.k2);
        const float rstd = 1.0f / sqrtf(grp16_sum(v0 * v0 + v1 * v1 + v2 * v2 + v3 * v3 + r1 * r1 + r2 * r2) * (1.0f / 96.0f) + RMS_EPS);
        const float (&g)[6] = qk == 0 ? gq : gk; const float sc = qk == 0 ? QSCALE96 : 1.0f;
        const float y1 = r1 * rstd * g[4], y2 = r2 * rstd * g[5];
        const float t1 = (y1 * R.c - y2 * R.s) * sc, t2 = (y2 * R.c + y1 * R.s) * sc;
        bf16* o = (qk == 0 ? mq : mk) + h * 96;
        u32x2 w; w.x = pk2(v0 * rstd * g[0] * sc, v1 * rstd * g[1] * sc); w.y = pk2(v2 * rstd * g[2] * sc, v3 * rstd * g[3] * sc);
        *(u32x2*)(o + 4 * j) = w; o[64 + j] = (bf16)f2bf(t1); o[80 + j] = (bf16)f2bf(t2);
    }
}
__device__ __forceinline__ void ph_post2(Frame& F, int l) {
    const bf16* ZS = (const bf16*)(F.ws + WS_ZS); bf16* MQ = (bf16*)(F.ws + WS_MQ); const bf16* MKV = (const bf16*)(F.ws + WS_MKV); bf16* MK = (bf16*)(F.ws + WS_MK);
    const float* rmc = (const float*)(F.ws + WS_RMC); const float* rms = (const float*)(F.ws + WS_RMS);
    const int lane = F.lane, jj = lane & 15;
    float gq[6], gk[6];
    { const float* a = F.in(I_MQN) + l * 96; const float* b = F.in(I_MKN) + l * 96;
#pragma unroll
      for (int i = 0; i < 4; ++i) { gq[i] = a[4 * jj + i]; gk[i] = b[4 * jj + i]; }
      gq[4] = a[64 + jj]; gq[5] = a[80 + jj]; gk[4] = b[64 + jj]; gk[5] = b[80 + jj]; }
    for (int row = F.gw; row < NROWS; row += 2 * F.NGW) {
        const int row2 = row + F.NGW; const bool has2 = row2 < NROWS; const size_t rb = has2 ? row2 : row;
        const int j = row % TPB; const bool lat = j >= CTXL; const int pos = lat ? j - CTXL : 0;
        const int j2 = (int)(rb % TPB); const bool lat2 = j2 >= CTXL; const int pos2 = lat2 ? j2 - CTXL : 0;
        P2Regs A, B;
        post2_load(ZS + (size_t)row * ZS_P, MQ + (size_t)row * 512, MKV + (size_t)row * 512, rmc + pos * 16, rms + pos * 16, lat, lane, A);
        if (has2) post2_load(ZS + rb * ZS_P, MQ + rb * 512, MKV + rb * 512, rmc + pos2 * 16, rms + pos2 * 16, lat2, lane, B);
        post2_finish(MQ + (size_t)row * 512, MK + (size_t)row * 384, lane, A, gq, gk);
        if (has2) post2_finish(MQ + rb * 512, MK + rb * 384, lane, B, gq, gk);
    }
}

template <int DQK>
__device__ __forceinline__ void attn_row_naive(const bf16* q, const bf16* Kb, int kp, const bf16* Vb, int vp, int n1, int lo2, int hi2, bool has_sink, float sink2, bf16* y, int lane) {
    float qf[DQK];
#pragma unroll
    for (int c = 0; c < DQK / 8; ++c) { const v4u w = *(const v4u*)(q + 8 * c);
        qf[8 * c + 0] = bflo(w.x); qf[8 * c + 1] = bfhi(w.x); qf[8 * c + 2] = bflo(w.y); qf[8 * c + 3] = bfhi(w.y); qf[8 * c + 4] = bflo(w.z); qf[8 * c + 5] = bfhi(w.z); qf[8 * c + 6] = bflo(w.w); qf[8 * c + 7] = bfhi(w.w); }
    float m = -INFINITY, l = 0.f; float acc[64];
#pragma unroll
    for (int d = 0; d < 64; ++d) acc[d] = 0.f;
    for (int seg = 0; seg < 2; ++seg) {
        const int k0 = seg == 0 ? 0 : lo2, k1 = seg == 0 ? n1 : hi2;
        for (int key = k0 + lane; key < k1; key += 64) {
            const bf16* kr = Kb + (size_t)key * kp; float s = 0.f;
#pragma unroll
            for (int c = 0; c < DQK / 8; ++c) { const v4u w = *(const v4u*)(kr + 8 * c);
                s += qf[8 * c + 0] * bflo(w.x) + qf[8 * c + 1] * bfhi(w.x) + qf[8 * c + 2] * bflo(w.y) + qf[8 * c + 3] * bfhi(w.y) + qf[8 * c + 4] * bflo(w.z) + qf[8 * c + 5] * bfhi(w.z) + qf[8 * c + 6] * bflo(w.w) + qf[8 * c + 7] * bfhi(w.w); }
            if (s > m) { const float f = exp2f(m - s); l *= f;
#pragma unroll
                for (int d = 0; d < 64; ++d) acc[d] *= f;
                m = s; }
            const float p = exp2f(s - m); l += p;
            const bf16* vr = Vb + (size_t)key * vp;
#pragma unroll
            for (int c = 0; c < 8; ++c) { const v4u w = *(const v4u*)(vr + 8 * c);
                acc[8 * c + 0] += p * bflo(w.x); acc[8 * c + 1] += p * bfhi(w.x); acc[8 * c + 2] += p * bflo(w.y); acc[8 * c + 3] += p * bfhi(w.y); acc[8 * c + 4] += p * bflo(w.z); acc[8 * c + 5] += p * bfhi(w.z); acc[8 * c + 6] += p * bflo(w.w); acc[8 * c + 7] += p * bfhi(w.w); }
        }
    }
    float M = wave_max(m); if (has_sink) M = fmaxf(M, sink2);
    const float f = (m == -INFINITY) ? 0.f : exp2f(m - M);
    float L = wave_sum(l * f); if (has_sink) L += exp2f(sink2 - M);
    float mine = 0.f;
#pragma unroll
    for (int d = 0; d < 64; ++d) { const float t = wave_sum(acc[d] * f); if (lane == d) mine = t; }
    y[lane] = (bf16)f2bf(mine / L * bf2f(y[lane]));
}
__device__ __forceinline__ void ph_attn_naive(Frame& F, int l) {
    const bf16* ZS = (const bf16*)(F.ws + WS_ZS); const bf16* MQ = (const bf16*)(F.ws + WS_MQ); const bf16* MKV = (const bf16*)(F.ws + WS_MKV); const bf16* MK = (const bf16*)(F.ws + WS_MK);
    bf16* Y = (bf16*)(F.ws + WS_G);
    const long nitems = (long)NROWS * 12;
    for (long it = F.gw; it < nitems; it += F.NGW) {
        const int hb = (int)(it % 12); const int row = (int)(it / 12);
        const int b = row / TPB, j = row % TPB; const bool lat = j >= CTXL;
        if (!lat && l == NLAYER - 1) continue;
        const size_t r0 = (size_t)b * TPB;
        const int br = hb >> 2, h = hb & 3;
        bf16* y = Y + (size_t)row * 1024 + br * 256 + h * 64;
        if (br == 0) {
            attn_row_naive<96>(MQ + (size_t)row * 512 + h * 96, MK + r0 * 384 + h * 96, 384, MKV + r0 * 512 + h * 128 + 64, 512, CTXL, CTXL, lat ? TPB : CTXL, false, 0.f, y, F.lane);
        } else if (br == 1) {
            const int t = j - CTXL; int lo = CTXL, hi = CTXL;
            if (lat) { lo = CTXL + (t - 128 < 0 ? 0 : t - 128); hi = CTXL + (t + 128 > SEQ - 1 ? SEQ - 1 : t + 128) + 1; }
            attn_row_naive<64>(ZS + (size_t)row * ZS_P + ZC_SQ + h * 64, ZS + r0 * ZS_P + ZC_SK + (h >> 1) * 64, ZS_P, ZS + r0 * ZS_P + ZC_SV + (h >> 1) * 64, ZS_P, CTXL, lo, hi, true, F.in(I_SINK)[l * 4 + h] * LOG2E, y, F.lane);
        } else {
            attn_row_naive<64>(ZS + (size_t)row * ZS_P + ZC_AQ + h * 64, ZS + r0 * ZS_P + ZC_AK + (h >> 1) * 64, ZS_P, ZS + r0 * ZS_P + ZC_AV + (h >> 1) * 64, ZS_P, CTXL, CTXL, lat ? TPB : CTXL, false, 0.f, y, F.lane);
        }
    }
}

__device__ __forceinline__ void ph_lru_conv(Frame& F, int l) {
    const bf16* ZS = (const bf16*)(F.ws + WS_ZS); float* U = (float*)(F.ws + WS_U);
    const float* cw = F.in(I_CONVW) + l * 4 * 256; const float* cb = F.in(I_CONVB) + l * 256;
    const int gt = F.vcu * NTHREADS + F.tid, ngt = F.G * NTHREADS;
    for (int idx = gt; idx < NROWS * 256; idx += ngt) {
        const int row = idx >> 8, c = idx & 255, b = row / TPB, j = row % TPB;
        int s0, len, jj; if (j < CTXL) { s0 = b * TPB; len = CTXL; jj = j; } else { s0 = b * TPB + CTXL; len = SEQ; jj = j - CTXL; }
        float acc = cb[c];
#pragma unroll
        for (int i = 0; i < 4; ++i) { const int t = jj + i - 2; if (t >= 0 && t < len) acc += cw[i * 256 + c] * bf2f(ZS[(size_t)(s0 + t) * ZS_P + ZC_LRU + c]); }
        U[idx] = acc;
    }
}
__device__ __forceinline__ void ph_lru_scan(Frame& F, int l, int dir) {
    const float* U = (const float*)(F.ws + WS_U); float* HF = (float*)(F.ws + WS_HF); bf16* Y = (bf16*)(F.ws + WS_G);
    const int g = blockIdx.x * NTHREADS + F.tid;
    if (g < NB * 256) {
    const int b = g >> 8, c = g & 255, k = c >> 6, jc = c & 63;
    const float* wr = F.in(I_LWR) + ((((size_t)l * 2 + dir) * 4 + k) * 64) * 64 + jc;
    const float* wi = F.in(I_LWI) + ((((size_t)l * 2 + dir) * 4 + k) * 64) * 64 + jc;
    float wrr[64], wii[64];
#pragma unroll
    for (int i = 0; i < 64; ++i) { wrr[i] = wr[i * 64]; wii[i] = wi[i * 64]; }
    const float br = F.in(I_LBR)[(l * 2 + dir) * 256 + c], bi = F.in(I_LBI)[(l * 2 + dir) * 256 + c];
    const float lam = F.in(I_LAM)[(l * 2 + dir) * 256 + c];
    const float sp = log1pf(expf(-lam));
    float h = 0.f;
    for (int s = 0; s < TPB; ++s) {
        const int j = dir == 0 ? s : (s < CTXL ? CTXL - 1 - s : TPB + CTXL - 1 - s);
        const size_t row = (size_t)b * TPB + j;
        const float* ub = U + row * 256 + k * 64;
        float rp = br, ip = bi;
#pragma unroll
        for (int i = 0; i < 64; ++i) { const float uv = ub[i]; rp += uv * wrr[i]; ip += uv * wii[i]; }
        const float r = 1.0f / (1.0f + expf(-rp)), ig = 1.0f / (1.0f + expf(-ip));
        const float la = -8.0f * r * sp; const float a = expf(la);
        const float bx = sqrtf(-expm1f(2.0f * la)) * (ig * ub[jc]);
        h = a * h + bx;
        if (dir == 0) HF[row * 256 + c] = h;
        else { bf16* y = Y + row * 1024 + 768 + c; *y = (bf16)f2bf((HF[row * 256 + c] + h) * bf2f(*y)); }
    }
    }
}
__device__ __forceinline__ void ph_mixsum_ctx(Frame& F) {
    const bf16* S = (const bf16*)(F.ws + WS_S); bf16* MIX = (bf16*)(F.ws + WS_H);
    const int gt = F.vcu * NTHREADS + F.tid, ngt = F.G * NTHREADS;
    for (int idx = gt; idx < NB * CTXL * 128; idx += ngt) {
        const int r = idx >> 7, c8 = (idx & 127) * 8; const size_t row = (size_t)(r >> 8) * TPB + (r & 255); float s[8] = {0.f, 0.f, 0.f, 0.f, 0.f, 0.f, 0.f, 0.f};
#pragma unroll
        for (int k = 0; k < 4; ++k) { const v4u w = *(const GAS v4u*)(S + row * 4096 + k * 1024 + c8);
            s[0] += bflo(w.x); s[1] += bfhi(w.x); s[2] += bflo(w.y); s[3] += bfhi(w.y); s[4] += bflo(w.z); s[5] += bfhi(w.z); s[6] += bflo(w.w); s[7] += bfhi(w.w); }
        v4u o; o.x = pk2(s[0], s[1]); o.y = pk2(s[2], s[3]); o.z = pk2(s[4], s[5]); o.w = pk2(s[6], s[7]);
        *(GAS v4u*)(MIX + row * 1024 + c8) = o;
    }
}
namespace att {
typedef short bf16x8 __attribute__((ext_vector_type(8)));
typedef short s16x4 __attribute__((ext_vector_type(4)));
typedef short v4i16_t __attribute__((ext_vector_type(4)));
typedef float f32x16 __attribute__((ext_vector_type(16)));
typedef unsigned u32x4 __attribute__((ext_vector_type(4)));
typedef __attribute__((address_space(3))) const char* lds_cptr;
typedef float f32x2_t __attribute__((ext_vector_type(2))); typedef __bf16 bf16x2_t __attribute__((ext_vector_type(2)));
__device__ __forceinline__ int crow(int r, int hi) { return (r & 3) + 8 * (r >> 2) + 4 * hi; }
__device__ __forceinline__ void glds16(const void* gsrc, unsigned lds_dst) { unsigned keep;
    asm volatile("s_mov_b32 %0, m0\n\ts_mov_b32 m0, %2\n\ts_nop 0\n\tglobal_load_lds_dwordx4 %1, off\n\ts_mov_b32 m0, %0" : "=&s"(keep) : "v"(gsrc), "s"(lds_dst) : "memory"); }
__device__ __forceinline__ unsigned cvtpk(float lo, float hi) { f32x2_t v = {lo, hi}; bf16x2_t b = __builtin_convertvector(v, bf16x2_t); return __builtin_bit_cast(unsigned, b); }
__device__ __forceinline__ s16x4 vtr(lds_cptr p) { return __builtin_bit_cast(s16x4, __builtin_amdgcn_ds_read_tr16_b64_v4i16((__attribute__((address_space(3))) v4i16_t*)p)); }
__device__ __forceinline__ float halfswap_max(float m) { auto rr = __builtin_amdgcn_permlane32_swap(__float_as_uint(m), __float_as_uint(m), false, false); return fmaxf(__uint_as_float(rr[0]), __uint_as_float(rr[1])); }
__device__ __forceinline__ float halfswap_sum(float m) { auto rr = __builtin_amdgcn_permlane32_swap(__float_as_uint(m), __float_as_uint(m), false, false); return __uint_as_float(rr[0]) + __uint_as_float(rr[1]); }

template <int DQK> struct Cfg {
    static constexpr int KCH = DQK / 8, KSLOT = KCH * 1024, NKI = (KCH + 7) / 8, NI = NKI + 1;
    static constexpr int LDS_K = 0, LDS_V = 3 * KSLOT, LDS_WS = LDS_V + 3 * 8192, LDS_OST = LDS_WS + 8 * 256, BYTES = LDS_OST + 8 * 4096;
};
#define ATT_WAIT_BAR(N) asm volatile("s_waitcnt vmcnt(" #N ") lgkmcnt(0)\n\ts_barrier" ::: "memory")

struct UnitDesc {
    const unsigned short* Q; int qp;
    const unsigned short* K; int kp;
    const unsigned short* V; int vp;
    unsigned short* Y;
    int NT;
    int lat_row0;
    int qpos0, spos0;
    int has_sink; float sink2;
};

constexpr float ATT_THR = 6.0f;
template <int DQK, bool SWA>
__device__ __forceinline__ void attn_unit(LAS unsigned char* ldsb, const UnitDesc& U, const int tid) {
    using C = Cfg<DQK>;
    const int lane = tid & 63, r32 = lane & 31, hi = lane >> 5; const int wid = __builtin_amdgcn_readfirstlane(tid >> 6);
    const unsigned lds0 = (unsigned)(uintptr_t)ldsb;
    LAS float* wsf = (LAS float*)(ldsb + C::LDS_WS) + wid * 64;
    const int kp = U.kp, vp = U.vp;
    const int kc1 = (C::NKI == 2 && wid < 4) ? wid + 8 : wid;
    const unsigned short* ksrc0 = U.K + (size_t)lane * kp + wid * 8;
    const unsigned short* ksrc1 = U.K + (size_t)lane * kp + kc1 * 8;
    const unsigned short* vsrc = U.V + (size_t)(16 * (wid & 3) + (lane >> 2)) * vp + (wid >> 2) * 32 + (lane & 3) * 8;
    const unsigned kdst0 = lds0 + C::LDS_K + wid * 1024, kdst1 = lds0 + C::LDS_K + kc1 * 1024, vdst = lds0 + C::LDS_V + wid * 1024;
    const int NT = U.NT;
#define ATT_KROW(t) (SWA ? ((t) < 4 ? 64 * (t) : U.lat_row0 + 64 * ((t) - 4)) : 64 * (t))
#define ATT_DMA_K(t, slot) do { const size_t ro_ = (size_t)ATT_KROW(t); \
        glds16(ksrc0 + ro_ * kp, (unsigned)__builtin_amdgcn_readfirstlane(kdst0 + (slot) * C::KSLOT)); \
        if (C::NKI == 2) glds16(ksrc1 + ro_ * kp, (unsigned)__builtin_amdgcn_readfirstlane(kdst1 + (slot) * C::KSLOT)); } while (0)
#define ATT_DMA_V(t, slot) do { const size_t ro_ = (size_t)ATT_KROW(t); glds16(vsrc + ro_ * vp, (unsigned)__builtin_amdgcn_readfirstlane(vdst + (slot) * 8192)); } while (0)
#define ATT_KLOAD(kslot) do { if (!SWA) { const lds_cptr kb_ = (lds_cptr)(ldsb + C::LDS_K) + (kslot) * C::KSLOT + hi * 1024 + r32 * 16; \
        _Pragma("unroll") for (int d0 = 0; d0 < DQK / 16; ++d0) { kf[2 * d0] = *(const __attribute__((address_space(3))) bf16x8*)(kb_ + d0 * 2048); kf[2 * d0 + 1] = *(const __attribute__((address_space(3))) bf16x8*)(kb_ + d0 * 2048 + 512); } } } while (0)
#define ATT_QKM(P0, P1, CINIT, kslot) do { { const float ci_ = (CINIT); _Pragma("unroll") for (int r = 0; r < 16; ++r) { P0[r] = ci_; P1[r] = ci_; } } \
        const lds_cptr kq_ = (lds_cptr)(ldsb + C::LDS_K) + (kslot) * C::KSLOT + hi * 1024 + r32 * 16; \
        _Pragma("unroll") for (int d0 = 0; d0 < DQK / 16; ++d0) { \
            const bf16x8 b0_ = SWA ? *(const __attribute__((address_space(3))) bf16x8*)(kq_ + d0 * 2048) : kf[2 * d0]; const bf16x8 b1_ = SWA ? *(const __attribute__((address_space(3))) bf16x8*)(kq_ + d0 * 2048 + 512) : kf[2 * d0 + 1]; \
            P0 = __builtin_amdgcn_mfma_f32_32x32x16_bf16(b0_, qr[d0], P0, 0, 0, 0); P1 = __builtin_amdgcn_mfma_f32_32x32x16_bf16(b1_, qr[d0], P1, 0, 0, 0); } } while (0)
#define ATT_VLOAD(vslot) do { if (!SWA) { const lds_cptr vb_ = (lds_cptr)(ldsb + C::LDS_V) + (vslot) * 8192 + ((lane >> 4) & 1) * 32 + (lane & 3) * 8 + (4 * hi + ((lane & 15) >> 2)) * 64; \
        _Pragma("unroll") for (int i = 0; i < 8; ++i) { vl[i] = vtr(vb_ + (i >> 2) * 4096 + (i & 3) * 1024); vh[i] = vtr(vb_ + (i >> 2) * 4096 + (i & 3) * 1024 + 512); } } } while (0)
#define ATT_MX3(a, b, c) __builtin_fmaxf(__builtin_fmaxf((a), (b)), (c))
#define ATT_SMPV(P0, P1, N0, N1, HASNEXT, t, vslot) do { \
        if (SWA) { const bool mk_ = ((t) >= 4) && (U.qpos0 >= 0); const int sb_ = U.spos0 + 64 * ((t) - 4) + 4 * hi; \
            _Pragma("unroll") for (int r = 0; r < 16; ++r) { const int dd_ = qpos - (sb_ + (r & 3) + 8 * (r >> 2)); \
                P0[r] = (mk_ && (dd_ > 128 || dd_ < -128)) ? -INFINITY : P0[r]; P1[r] = (mk_ && (dd_ - 32 > 128 || dd_ - 32 < -128)) ? -INFINITY : P1[r]; } } \
        float ra_ = ATT_MX3(P0[0], P0[1], P1[0]), rb_ = ATT_MX3(P0[2], P0[3], P1[1]); ra_ = ATT_MX3(ra_, P1[2], P1[3]); \
        _Pragma("unroll") for (int r = 4; r < 16; r += 4) { ra_ = ATT_MX3(ra_, P0[r], P0[r + 1]); rb_ = ATT_MX3(rb_, P0[r + 2], P0[r + 3]); ra_ = ATT_MX3(ra_, P1[r], P1[r + 1]); rb_ = ATT_MX3(rb_, P1[r + 2], P1[r + 3]); } \
        float rm_ = halfswap_max(__builtin_fmaxf(ra_, rb_)); \
        if (__builtin_expect(__any(rm_ > ATT_THR), 0)) { \
            const float dl_ = __builtin_fmaxf(rm_, 0.f); m += dl_; const float alpha_ = __builtin_amdgcn_exp2f(-dl_); l *= alpha_; \
            _Pragma("unroll") for (int r = 0; r < 16; ++r) { P0[r] -= dl_; P1[r] -= dl_; } \
            if (HASNEXT) { _Pragma("unroll") for (int r = 0; r < 16; ++r) { N0[r] -= dl_; N1[r] -= dl_; } } \
            if (hi == 0) wsf[r32] = alpha_; \
            asm volatile("s_waitcnt lgkmcnt(0)" ::: "memory"); \
            _Pragma("unroll") for (int r = 0; r < 16; ++r) { const float f_ = wsf[crow(r, hi)]; o[0][r] *= f_; o[1][r] *= f_; } } \
        float ls_ = 0.f; \
        _Pragma("unroll") for (int r = 0; r < 16; ++r) { P0[r] = __builtin_amdgcn_exp2f(P0[r]); P1[r] = __builtin_amdgcn_exp2f(P1[r]); ls_ += P0[r] + P1[r]; } \
        l += ls_; \
        u32x4 pw_[4]; \
        pw_[0] = (u32x4){cvtpk(P0[0], P0[1]), cvtpk(P0[2], P0[3]), cvtpk(P0[4], P0[5]), cvtpk(P0[6], P0[7])}; \
        pw_[1] = (u32x4){cvtpk(P0[8], P0[9]), cvtpk(P0[10], P0[11]), cvtpk(P0[12], P0[13]), cvtpk(P0[14], P0[15])}; \
        pw_[2] = (u32x4){cvtpk(P1[0], P1[1]), cvtpk(P1[2], P1[3]), cvtpk(P1[4], P1[5]), cvtpk(P1[6], P1[7])}; \
        pw_[3] = (u32x4){cvtpk(P1[8], P1[9]), cvtpk(P1[10], P1[11]), cvtpk(P1[12], P1[13]), cvtpk(P1[14], P1[15])}; \
        const lds_cptr vq_ = (lds_cptr)(ldsb + C::LDS_V) + (vslot) * 8192 + ((lane >> 4) & 1) * 32 + (lane & 3) * 8 + (4 * hi + ((lane & 15) >> 2)) * 64; \
        _Pragma("unroll") for (int d0 = 0; d0 < 2; ++d0) \
            _Pragma("unroll") for (int ks = 0; ks < 4; ++ks) { \
                const s16x4 lo_ = SWA ? vtr(vq_ + d0 * 4096 + ks * 1024) : vl[4 * d0 + ks], hh_ = SWA ? vtr(vq_ + d0 * 4096 + ks * 1024 + 512) : vh[4 * d0 + ks]; \
                const bf16x8 vf_ = (bf16x8){lo_[0], lo_[1], lo_[2], lo_[3], hh_[0], hh_[1], hh_[2], hh_[3]}; \
                o[d0] = __builtin_amdgcn_mfma_f32_32x32x16_bf16(__builtin_bit_cast(bf16x8, pw_[ks]), vf_, o[d0], 0, 0, 0); } } while (0)
#define ATT_STEP(C0, C1, N0, N1, t) do { \
        const int k3_ = (ks1 == 0) ? 2 : ks1 - 1, v2_ = (vs0 == 0) ? 2 : vs0 - 1; \
        if ((t) + 3 < NT) ATT_DMA_K((t) + 3, k3_); \
        if ((t) + 2 < NT) ATT_DMA_V((t) + 2, v2_); \
        ATT_KLOAD(ks1); \
        if (!SWA) __builtin_amdgcn_sched_barrier(0);        \
        ATT_QKM(N0, N1, -m, ks1); \
        ATT_VLOAD(vs0); \
        if (!SWA) __builtin_amdgcn_sched_barrier(0); \
        ATT_SMPV(C0, C1, N0, N1, true, t, vs0); \
        if ((t) + 3 < NT) { if (C::NI == 2) ATT_WAIT_BAR(2); else ATT_WAIT_BAR(3); } else ATT_WAIT_BAR(0); \
        ks1 = (ks1 == 2) ? 0 : ks1 + 1; vs0 = (vs0 == 2) ? 0 : vs0 + 1; } while (0)
    ATT_DMA_K(0, 0);
    ATT_DMA_K(1, 1); ATT_DMA_V(0, 0);
    ATT_DMA_K(2, 2); ATT_DMA_V(1, 1);
    bf16x8 qr[DQK / 16];
    { const unsigned short* qw = U.Q + (size_t)(wid * 32 + r32) * U.qp + hi * 8;
#pragma unroll
      for (int d0 = 0; d0 < DQK / 16; ++d0) qr[d0] = *(const bf16x8*)(qw + d0 * 16); }
    float m = 0.f, l = 0.f;
    f32x16 o[2]; o[0] = f32x16{}; o[1] = f32x16{};
    const int qpos = U.qpos0 + wid * 32 + r32;
    f32x16 pa0, pa1, pb0, pb1;
    bf16x8 kf[DQK / 8]; s16x4 vl[8], vh[8];
    if (C::NI == 2) ATT_WAIT_BAR(4); else ATT_WAIT_BAR(6);
    ATT_KLOAD(0); ATT_QKM(pa0, pa1, 0.f, 0);
    {
      float ra = ATT_MX3(pa0[0], pa0[1], pa1[0]), rb = ATT_MX3(pa0[2], pa0[3], pa1[1]); ra = ATT_MX3(ra, pa1[2], pa1[3]);
#pragma unroll
      for (int r = 4; r < 16; r += 4) { ra = ATT_MX3(ra, pa0[r], pa0[r + 1]); rb = ATT_MX3(rb, pa0[r + 2], pa0[r + 3]); ra = ATT_MX3(ra, pa1[r], pa1[r + 1]); rb = ATT_MX3(rb, pa1[r + 2], pa1[r + 3]); }
      m = halfswap_max(__builtin_fmaxf(ra, rb));
#pragma unroll
      for (int r = 0; r < 16; ++r) { pa0[r] -= m; pa1[r] -= m; } }
    if (C::NI == 2) ATT_WAIT_BAR(2); else ATT_WAIT_BAR(3);
    int ks1 = 1, vs0 = 0;
    int t = 0;
    if (SWA) { for (; t + 1 < NT; ++t) { ATT_STEP(pa0, pa1, pb0, pb1, t); pa0 = pb0; pa1 = pb1; } ATT_SMPV(pa0, pa1, pa0, pa1, false, NT - 1, vs0); }
    else {
    for (; t + 2 < NT; t += 2) { ATT_STEP(pa0, pa1, pb0, pb1, t); ATT_STEP(pb0, pb1, pa0, pa1, t + 1); }
    if (t + 1 < NT) { ATT_STEP(pa0, pa1, pb0, pb1, t); ATT_VLOAD(vs0); ATT_SMPV(pb0, pb1, pb0, pb1, false, NT - 1, vs0); }
    else { ATT_VLOAD(vs0); ATT_SMPV(pa0, pa1, pa0, pa1, false, NT - 1, vs0); }
    }
    l = halfswap_sum(l);
    if (U.has_sink) l += __builtin_amdgcn_exp2f(U.sink2 - m);
    if (hi == 0) wsf[32 + r32] = l;
    asm volatile("s_waitcnt lgkmcnt(0)" ::: "memory");
    { LAS unsigned short* stg = (LAS unsigned short*)(ldsb + C::LDS_OST) + wid * 2048;
#pragma unroll
      for (int r = 0; r < 16; ++r) { const int orow = crow(r, hi); const float rl = __builtin_amdgcn_rcpf(wsf[32 + orow]);
          stg[orow * 64 + r32] = (unsigned short)f2bf(o[0][r] * rl); stg[orow * 64 + 32 + r32] = (unsigned short)f2bf(o[1][r] * rl); }
      asm volatile("s_waitcnt lgkmcnt(0)" ::: "memory");
      unsigned short* yw = U.Y + (size_t)(wid * 32) * 1024;
#pragma unroll
      for (int i = 0; i < 4; ++i) { const int row = i * 8 + (lane >> 3), ch = lane & 7;
          const u32x4 ov = *(const LAS u32x4*)(stg + row * 64 + ch * 8);
          u32x4* gp = (u32x4*)(yw + (size_t)row * 1024 + ch * 8); const u32x4 g = *gp;
          u32x4 w; w.x = pk2(bflo(ov.x) * bflo(g.x), bfhi(ov.x) * bfhi(g.x)); w.y = pk2(bflo(ov.y) * bflo(g.y), bfhi(ov.y) * bfhi(g.y));
          w.z = pk2(bflo(ov.z) * bflo(g.z), bfhi(ov.z) * bfhi(g.z)); w.w = pk2(bflo(ov.w) * bflo(g.w), bfhi(ov.w) * bfhi(g.w));
          *gp = w; } }
    asm volatile("s_waitcnt vmcnt(0) lgkmcnt(0)\n\ts_barrier" ::: "memory");
#undef ATT_KROW
#undef ATT_DMA_K
#undef ATT_DMA_V
#undef ATT_KLOAD
#undef ATT_QKM
#undef ATT_VLOAD
#undef ATT_STEP
#undef ATT_SMPV
#undef ATT_MX3
}
}

__device__ __forceinline__ void ph_attn(Frame& F, int l) {
    unsigned short* ZS = (unsigned short*)(F.ws + WS_ZS); unsigned short* MQ = (unsigned short*)(F.ws + WS_MQ); unsigned short* MKV = (unsigned short*)(F.ws + WS_MKV); unsigned short* MK = (unsigned short*)(F.ws + WS_MK);
    unsigned short* Y = (unsigned short*)(F.ws + WS_G);
    LAS unsigned char* lds = F.lds + RING_OFF;
    const int u = F.vcu;
    const bool ctxq = (l == 0);
    for (int uu = u; uu < 256; uu += F.G) { const int bh = uu >> 4, qb = uu & 15, b = bh >> 2, h = bh & 3; const size_t r0 = (size_t)b * TPB, rq = r0 + CTXL + qb * 256;
        att::UnitDesc U{MQ + rq * 512 + h * 96, 512, MK + r0 * 384 + h * 96, 384, MKV + r0 * 512 + h * 128 + 64, 512, Y + rq * 1024 + h * 64, TPB / 64, 0, -1, 0, 0, 0.f};
        att::attn_unit<96, false>(lds, U, F.tid); }
    for (int uu = u; uu < 256; uu += F.G) { const int qb = uu & 15, g = (uu >> 4) & 1, kvh = (uu >> 5) & 1, b = uu >> 6, qh = kvh * 2 + g; const size_t r0 = (size_t)b * TPB, rq = r0 + CTXL + qb * 256;
        att::UnitDesc U{ZS + rq * ZS_P + ZC_AQ + qh * 64, ZS_P, ZS + r0 * ZS_P + ZC_AK + kvh * 64, ZS_P, ZS + r0 * ZS_P + ZC_AV + kvh * 64, ZS_P, Y + rq * 1024 + 512 + qh * 64, TPB / 64, 0, -1, 0, 0, 0.f};
        att::attn_unit<64, false>(lds, U, F.tid); }
    for (int uu = u; uu < 256; uu += F.G) { const int qb = uu & 15, g = (uu >> 4) & 1, kvh = (uu >> 5) & 1, b = uu >> 6, qh = kvh * 2 + g; const size_t r0 = (size_t)b * TPB, rq = r0 + CTXL + qb * 256;
        const int q0 = qb * 256, s0 = (q0 - 128 < 0) ? 0 : q0 - 128, s1 = (q0 + 384 > SEQ) ? SEQ : q0 + 384;
        att::UnitDesc U{ZS + rq * ZS_P + ZC_SQ + qh * 64, ZS_P, ZS + r0 * ZS_P + ZC_SK + kvh * 64, ZS_P, ZS + r0 * ZS_P + ZC_SV + kvh * 64, ZS_P, Y + rq * 1024 + 256 + qh * 64, 4 + (s1 - s0) / 64, CTXL + s0, q0, s0, 1, F.in(I_SINK)[l * 4 + qh] * LOG2E};
        att::attn_unit<64, true>(lds, U, F.tid); }
    if (ctxq) for (int uu = u; uu < 48; uu += F.G) { const int br = uu >> 4, b = (uu >> 2) & 3, h = uu & 3; const size_t r0 = (size_t)b * TPB;
        if (br == 0) { att::UnitDesc U{MQ + r0 * 512 + h * 96, 512, MK + r0 * 384 + h * 96, 384, MKV + r0 * 512 + h * 128 + 64, 512, Y + r0 * 1024 + h * 64, 4, 0, -1, 0, 0, 0.f};
            att::attn_unit<96, false>(lds, U, F.tid); }
        else if (br == 1) { att::UnitDesc U{ZS + r0 * ZS_P + ZC_SQ + h * 64, ZS_P, ZS + r0 * ZS_P + ZC_SK + (h >> 1) * 64, ZS_P, ZS + r0 * ZS_P + ZC_SV + (h >> 1) * 64, ZS_P, Y + r0 * 1024 + 256 + h * 64, 4, CTXL, -1, 0, 1, F.in(I_SINK)[l * 4 + h] * LOG2E};
            att::attn_unit<64, true>(lds, U, F.tid); }
        else { att::UnitDesc U{ZS + r0 * ZS_P + ZC_AQ + h * 64, ZS_P, ZS + r0 * ZS_P + ZC_AK + (h >> 1) * 64, ZS_P, ZS + r0 * ZS_P + ZC_AV + (h >> 1) * 64, ZS_P, Y + r0 * 1024 + 512 + h * 64, 4, 0, -1, 0, 0, 0.f};
            att::attn_unit<64, false>(lds, U, F.tid); } }
}
constexpr size_t WS_SUM = 253 * MiB;
constexpr size_t WS_HL = WS_U, WS_CP = WS_HF;
constexpr int NCHUNK = TPB / 64;
__device__ __forceinline__ float swap_lo(float x) { auto rr = __builtin_amdgcn_permlane32_swap(__float_as_uint(x), __float_as_uint(x), false, false); return __uint_as_float(rr[0]); }
__device__ __forceinline__ float swap_hi(float x) { auto rr = __builtin_amdgcn_permlane32_swap(__float_as_uint(x), __float_as_uint(x), false, false); return __uint_as_float(rr[1]); }
__device__ __forceinline__ void ph_lru1(Frame& F, int l) {
    typedef short bf16x8 __attribute__((ext_vector_type(8))); typedef float f32x16 __attribute__((ext_vector_type(16)));
    const unsigned short* ZS = (const unsigned short*)(F.ws + WS_ZS); unsigned short* HL = (unsigned short*)(F.ws + WS_HL); unsigned short* CP = (unsigned short*)(F.ws + WS_CP);
    f32x2v* SUM = (f32x2v*)(F.ws + WS_SUM);
    constexpr int UP = 264;
    LAS unsigned short* ul = (LAS unsigned short*)(F.lds + RING_OFF);
    const float* cw = F.in(I_CONVW) + l * 4 * 256; const float* cb = F.in(I_CONVB) + l * 256;
    const int tid = F.tid, lane = tid & 63, r32 = lane & 31, hi = lane >> 5, k = F.wave & 3, d = F.wave >> 2;
    for (int unit = F.vcu; unit < NB * NCHUNK; unit += F.G) {
        const int b = unit / NCHUNK, ci = unit % NCHUNK;
        int s0row, len, t0; if (ci < 4) { s0row = b * TPB; len = CTXL; t0 = ci * 64; } else { s0row = b * TPB + CTXL; len = SEQ; t0 = (ci - 4) * 64; }
        { const int cc = tid & 255, hh = tid >> 8; float zv[35];
#pragma unroll
          for (int i = 0; i < 35; ++i) { const int tt = t0 + hh * 32 + i - 2; const int tc = tt < 0 ? 0 : (tt >= len ? len - 1 : tt);
              const float v = bf2f(ZS[(size_t)(s0row + tc) * ZS_P + ZC_LRU + cc]); zv[i] = (tt >= 0 && tt < len) ? v : 0.f; }
          const float w0 = cw[cc], w1 = cw[256 + cc], w2 = cw[512 + cc], w3 = cw[768 + cc], bb = cb[cc];
#pragma unroll
          for (int t = 0; t < 32; ++t) ul[(hh * 32 + t) * UP + cc] = (unsigned short)f2bf(bb + w0 * zv[t] + w1 * zv[t + 1] + w2 * zv[t + 2] + w3 * zv[t + 3]); }
        __syncthreads();
#pragma unroll 1
        for (int tn = 0; tn < 2; ++tn) {
            const int c = k * 64 + 32 * tn + r32;
            bf16x8 wf[2][4];
            const float brv = F.in(I_LBR)[(l * 2 + d) * 256 + c], biv = F.in(I_LBI)[(l * 2 + d) * 256 + c], spv = ((const float*)(F.ws + WS_SP))[(l * 2 + d) * 256 + c];
#pragma unroll
            for (int gate = 0; gate < 2; ++gate)
#pragma unroll
                for (int ks = 0; ks < 4; ++ks) { const float* src = (const float*)(F.ws + WS_LWT) + ((((size_t)l * 2 + d) * 2 + gate) * 256 + c) * 64 + 16 * ks + 8 * hi;
                    const f32x4 a = *(const f32x4*)src, b2 = *(const f32x4*)(src + 4);
                    v4u w; w.x = pk2(a.x, a.y); w.y = pk2(a.z, a.w); w.z = pk2(b2.x, b2.y); w.w = pk2(b2.z, b2.w); wf[gate][ks] = __builtin_bit_cast(bf16x8, w); }
            f32x16 A[2], X[2];
            A[0] = f32x16{}; A[1] = f32x16{}; X[0] = f32x16{}; X[1] = f32x16{};
#pragma unroll
            for (int tm = 0; tm < 2; ++tm)
#pragma unroll
                for (int ks = 0; ks < 4; ++ks) { const bf16x8 af = *(const LAS bf16x8*)(ul + (32 * tm + r32) * UP + k * 64 + 16 * ks + 8 * hi);
                    A[tm] = __builtin_amdgcn_mfma_f32_32x32x16_bf16(af, wf[0][ks], A[tm], 0, 0, 0); X[tm] = __builtin_amdgcn_mfma_f32_32x32x16_bf16(af, wf[1][ks], X[tm], 0, 0, 0); }
#pragma unroll
            for (int tm = 0; tm < 2; ++tm)
#pragma unroll
                for (int r = 0; r < 16; ++r) { const int tok = 32 * tm + (r & 3) + 8 * (r >> 2) + 4 * hi; const float uu = bf2f(ul[tok * UP + c]);
                    const float rr = sigmoid_f(A[tm][r] + brv), ii = sigmoid_f(X[tm][r] + biv);
                    const float a = __builtin_amdgcn_exp2f(-rr * spv); A[tm][r] = a; X[tm][r] = __builtin_amdgcn_sqrtf(1.0f - a * a) * (ii * uu);
                    if ((r & 3) == 3) asm volatile("" ::: "memory"); }
#pragma unroll
            for (int tm = 0; tm < 2; ++tm)
#pragma unroll
                for (int rg = 0; rg < 4; ++rg) { const int r0 = 4 * rg;
                    if (d == 0) {
#pragma unroll
                        for (int e2 = 1; e2 < 4; ++e2) { X[tm][r0 + e2] = A[tm][r0 + e2] * X[tm][r0 + e2 - 1] + X[tm][r0 + e2]; A[tm][r0 + e2] = A[tm][r0 + e2] * A[tm][r0 + e2 - 1]; } }
                    else {
#pragma unroll
                        for (int e2 = 2; e2 >= 0; --e2) { X[tm][r0 + e2] = A[tm][r0 + e2] * X[tm][r0 + e2 + 1] + X[tm][r0 + e2]; A[tm][r0 + e2] = A[tm][r0 + e2] * A[tm][r0 + e2 + 1]; } } }
            float enH[8], enP[8]; float EH = 0.f, EP = 1.f;
            if (d == 0) {
#pragma unroll
                for (int q = 0; q < 8; ++q) { const int tm = q >> 2, re = 4 * (q & 3) + 3; const float ce = A[tm][re], he = X[tm][re];
                    const float aH = swap_lo(ce * EH + he), aP = swap_lo(EP * ce);
                    const float E1H = hi ? aH : EH, E1P = hi ? aP : EP;
                    enH[q] = E1H; enP[q] = E1P;
                    EH = swap_hi(ce * E1H + he); EP = swap_hi(E1P * ce); }
            } else {
#pragma unroll
                for (int q = 7; q >= 0; --q) { const int tm = q >> 2, re = 4 * (q & 3); const float ce = A[tm][re], he = X[tm][re];
                    const float aH = swap_hi(ce * EH + he), aP = swap_hi(EP * ce);
                    const float E1H = hi ? EH : aH, E1P = hi ? EP : aP;
                    enH[q] = E1H; enP[q] = E1P;
                    EH = swap_lo(ce * E1H + he); EP = swap_lo(E1P * ce); }
            }
            { const unsigned ob = (unsigned)((((s0row + t0 + 4 * hi) * 2 + d) * 256 + c) * 2);
#pragma unroll
              for (int tm = 0; tm < 2; ++tm)
#pragma unroll
                for (int rg = 0; rg < 4; ++rg) { const int q = 4 * tm + rg;
#pragma unroll
                    for (int e2 = 0; e2 < 4; ++e2) { const int r = 4 * rg + e2; const unsigned o = ob + (unsigned)(32 * tm + 8 * rg + e2) * 1024u;
                        *(unsigned short*)((char*)HL + o) = (unsigned short)f2bf(X[tm][r] + A[tm][r] * enH[q]); *(unsigned short*)((char*)CP + o) = (unsigned short)f2bf(A[tm][r] * enP[q]); }
                    asm volatile("" ::: "memory"); } }
            if (hi == 0) SUM[((size_t)(b * NCHUNK + ci) * 2 + d) * 256 + c] = (f32x2v){EP, EH};
        }
        __syncthreads();
    }
}
constexpr size_t WS_CARRY = 255 * MiB;
__device__ __forceinline__ void ph_lru_carry(Frame& F) {
    if (F.vcu < 4) {
        const int g = F.vcu * NTHREADS + F.tid, b = g >> 9, d = (g >> 8) & 1, c = g & 255;
        const f32x2v* sb = (const f32x2v*)(F.ws + WS_SUM) + ((size_t)b * NCHUNK * 2 + d) * 256 + c;
        float* cr = (float*)(F.ws + WS_CARRY) + ((size_t)b * NCHUNK * 2 + d) * 256 + c;
        float h = 0.f;
#pragma unroll 1
        for (int p0 = 0; p0 < NCHUNK; p0 += 17) {
            f32x2v s[17];
#pragma unroll
            for (int i = 0; i < 17; ++i) { const int p = p0 + i, j = (d == 0) ? p : (p < 4 ? 3 - p : NCHUNK + 3 - p); s[i] = sb[(size_t)j * 512]; }
#pragma unroll
            for (int i = 0; i < 17; ++i) { const int p = p0 + i, j = (d == 0) ? p : (p < 4 ? 3 - p : NCHUNK + 3 - p); cr[(size_t)j * 512] = h; h = s[i].x * h + s[i].y; }
        }
    }
}
__device__ __forceinline__ void ph_lru2(Frame& F, int l) {
    const unsigned short* HL = (const unsigned short*)(F.ws + WS_HL); const unsigned short* CP = (const unsigned short*)(F.ws + WS_CP);
    const float* CARRY = (const float*)(F.ws + WS_CARRY); unsigned short* Y = (unsigned short*)(F.ws + WS_G);
    const int tid = F.tid, cg = tid & 31, tq = tid >> 5; const bool last = (l == NLAYER - 1);
    for (int unit = F.vcu; unit < NB * NCHUNK; unit += F.G) {
        const int b = unit / NCHUNK, ci = unit % NCHUNK;
        if (last && ci < 4) continue;
        const float* cp0 = CARRY + ((size_t)(b * NCHUNK + ci) * 2) * 256 + cg * 8;
        const f32x4 cfa = *(const f32x4*)cp0, cfb = *(const f32x4*)(cp0 + 4), cba = *(const f32x4*)(cp0 + 256), cbb = *(const f32x4*)(cp0 + 260);
        const float cf[8] = {cfa.x, cfa.y, cfa.z, cfa.w, cfb.x, cfb.y, cfb.z, cfb.w}, cbk[8] = {cba.x, cba.y, cba.z, cba.w, cbb.x, cbb.y, cbb.z, cbb.w};
        v4u hf[4], pf[4], hb[4], pb[4], gg[4];
#pragma unroll
        for (int i = 0; i < 4; ++i) { const size_t row = (size_t)b * TPB + ci * 64 + tq + 16 * i; const size_t o = (row * 2) * 256 + cg * 8;
            hf[i] = *(const v4u*)(HL + o); pf[i] = *(const v4u*)(CP + o); hb[i] = *(const v4u*)(HL + o + 256); pb[i] = *(const v4u*)(CP + o + 256); gg[i] = *(const v4u*)(Y + row * 1024 + 768 + cg * 8); }
#pragma unroll
        for (int i = 0; i < 4; ++i) { const size_t row = (size_t)b * TPB + ci * 64 + tq + 16 * i;
            unsigned w[4];
#pragma unroll
            for (int e = 0; e < 4; ++e) { const unsigned a = hf[i][e], p = pf[i][e], a2 = hb[i][e], p2 = pb[i][e], g = gg[i][e];
                const float v0 = (bflo(a) + bflo(p) * cf[2 * e] + bflo(a2) + bflo(p2) * cbk[2 * e]) * bflo(g);
                const float v1 = (bfhi(a) + bfhi(p) * cf[2 * e + 1] + bfhi(a2) + bfhi(p2) * cbk[2 * e + 1]) * bfhi(g);
                w[e] = pk2(v0, v1); }
            *(v4u*)(Y + row * 1024 + 768 + cg * 8) = (v4u){w[0], w[1], w[2], w[3]}; }
    }
}
namespace pgx {
typedef short bf16x8 __attribute__((ext_vector_type(8)));
typedef float f32x4 __attribute__((ext_vector_type(4)));
typedef unsigned u32x4 __attribute__((ext_vector_type(4)));
typedef unsigned u32x2 __attribute__((ext_vector_type(2)));
constexpr int LP = 72;
constexpr int OPB = 128 * LP * 2;
__device__ __forceinline__ void pgx_unit(LAS unsigned char* lds, const unsigned short* Y, const unsigned short* Wb, const unsigned short* S, unsigned short* MIX, int row0, int n0, int tid) {
    const int lane = tid & 63, wid = __builtin_amdgcn_readfirstlane(tid >> 6), wm = wid & 3, wn = wid >> 2, fr = lane & 15, fq = lane >> 4;
    const int sr0 = tid >> 3, sk = (tid & 7) * 8;
    const unsigned short* ysrc = Y + (size_t)(row0 + sr0) * 1024 + sk;
    const unsigned short* wsrc = Wb + (size_t)(n0 + sr0) * 256 + sk;
    const int ldst = (sr0 * LP + sk) * 2;
    f32x4 acc[2][4], mix[2][4];
#pragma unroll
    for (int a = 0; a < 2; ++a)
#pragma unroll
        for (int b = 0; b < 4; ++b) { acc[a][b] = (f32x4){0.f, 0.f, 0.f, 0.f}; mix[a][b] = (f32x4){0.f, 0.f, 0.f, 0.f}; }
    u32x4 st[4][4];
    const unsigned short* yA = ysrc; const unsigned short* yB = ysrc + 64 * 1024;
    const unsigned short* wA = wsrc; const unsigned short* wB = wsrc + 64 * 256;
    const unsigned short* sp0 = S + (size_t)(row0 + 32 * wm + fr) * 4096 + n0 + 64 * wn + 4 * fq; const unsigned short* sp1 = sp0 + (size_t)16 * 4096;
#define PGX_LOADQ(set_, yo_, wp0_, wp1_, wo_) do { st[set_][0] = *(const u32x4*)(yA + (yo_)); st[set_][1] = *(const u32x4*)(yB + (yo_)); st[set_][2] = *(const u32x4*)((wp0_) + (wo_)); st[set_][3] = *(const u32x4*)((wp1_) + (wo_)); } while (0)
#define PGX_STORE(buf_, set_) do { LAS unsigned char* b_ = lds + (buf_) * 2 * OPB + ldst; \
        *(LAS u32x4*)b_ = st[set_][0]; *(LAS u32x4*)(b_ + 64 * LP * 2) = st[set_][1]; *(LAS u32x4*)(b_ + OPB) = st[set_][2]; *(LAS u32x4*)(b_ + OPB + 64 * LP * 2) = st[set_][3]; } while (0)
    u32x2 sga[2][4];
    PGX_LOADQ(0, 0, wA, wB, 0); PGX_LOADQ(1, 64, wA, wB, 64); PGX_LOADQ(2, 128, wA, wB, 128);
    PGX_STORE(0, 0);
    __syncthreads();
#define PGX_COMPUTE(h_) do { const LAS unsigned char* yb = lds + ((h_) & 1) * 2 * OPB + ((32 * wm + fr) * LP + 8 * fq) * 2; const LAS unsigned char* wb = lds + ((h_) & 1) * 2 * OPB + OPB + ((64 * wn + fr) * LP + 8 * fq) * 2; \
          _Pragma("unroll") for (int ks = 0; ks < 2; ++ks) { \
              bf16x8 yf[2], wf[4]; \
              _Pragma("unroll") for (int tt = 0; tt < 2; ++tt) yf[tt] = *(const LAS bf16x8*)(yb + (16 * tt * LP + 32 * ks) * 2); \
              _Pragma("unroll") for (int nt = 0; nt < 4; ++nt) wf[nt] = *(const LAS bf16x8*)(wb + (16 * nt * LP + 32 * ks) * 2); \
              _Pragma("unroll") for (int tt = 0; tt < 2; ++tt) \
                  _Pragma("unroll") for (int nt = 0; nt < 4; ++nt) acc[tt][nt] = __builtin_amdgcn_mfma_f32_16x16x32_bf16(wf[nt], yf[tt], acc[tt][nt], 0, 0, 0); } } while (0)
#pragma unroll 1
    for (int kk = 0; kk < 4; ++kk) {
        const bool more = kk < 3;
        const unsigned short* wnA = more ? wA + (size_t)1024 * 256 : wsrc; const unsigned short* wnB = more ? wB + (size_t)1024 * 256 : wsrc + 64 * 256;
        const int yo = more ? 256 : -768;
#pragma unroll
        for (int nt = 0; nt < 4; ++nt) { sga[0][nt] = *(const u32x2*)(sp0 + 16 * nt); sga[1][nt] = *(const u32x2*)(sp1 + 16 * nt); }
        PGX_LOADQ(3, 192, wA, wB, 192); PGX_COMPUTE(0); PGX_STORE(1, 1); __syncthreads();
        PGX_LOADQ(0, yo, wnA, wnB, 0); PGX_COMPUTE(1); PGX_STORE(0, 2); __syncthreads();
        PGX_LOADQ(1, yo + 64, wnA, wnB, 64); PGX_COMPUTE(2); PGX_STORE(1, 3); __syncthreads();
        PGX_LOADQ(2, yo + 128, wnA, wnB, 128); PGX_COMPUTE(3);
#pragma unroll
        for (int tt = 0; tt < 2; ++tt)
#pragma unroll
            for (int nt = 0; nt < 4; ++nt) { const u32x2 g = sga[tt][nt]; const f32x4 a = acc[tt][nt];
                mix[tt][nt] += (f32x4){a[0] * bflo(g.x), a[1] * bfhi(g.x), a[2] * bflo(g.y), a[3] * bfhi(g.y)}; acc[tt][nt] = (f32x4){0.f, 0.f, 0.f, 0.f}; }
        if (more) PGX_STORE(0, 0);
        __syncthreads();
        yA += 256; yB += 256; wA = wnA; wB = wnB; sp0 += 1024; sp1 += 1024;
    }
#pragma unroll
    for (int tt = 0; tt < 2; ++tt)
#pragma unroll
        for (int nt = 0; nt < 4; ++nt) { const f32x4 v = mix[tt][nt]; u32x2 w; w.x = pk2(v[0], v[1]); w.y = pk2(v[2], v[3]);
            *(u32x2*)(MIX + (size_t)(row0 + 32 * wm + 16 * tt + fr) * 1024 + n0 + 64 * wn + 16 * nt + 4 * fq) = w; }
#undef PGX_LOADQ
#undef PGX_STORE
#undef PGX_COMPUTE
}
}
__device__ __forceinline__ void ph_pgx(Frame& F, int l) {
    const unsigned short* Y = (const unsigned short*)(F.ws + WS_G); const unsigned short* S = (const unsigned short*)(F.ws + WS_S); unsigned short* MIX = (unsigned short*)(F.ws + WS_H);
    const unsigned short* Wb = (const unsigned short*)(F.ws + WS_W + (size_t)l * W_LAYER + WO_WB);
    const bool last = (l == NLAYER - 1);
    const int nrt = last ? 128 : NROWS / 128;
    for (int u = F.vcu; u < nrt * 8; u += F.G) {
        int rt = u >> 3; const int ct = u & 7;
        if (last) rt = rt + 2 * (rt / 32) + 2;
        pgx::pgx_unit(F.lds + RING_OFF, Y, Wb, S, MIX, rt * 128, ct * 128, F.tid);
    }
}
constexpr int NPL = 10;
enum { PH_H = 0, PH_G1, PH_POST1, PH_G2, PH_POST2, PH_ATT, PH_SG, PH_PG, PH_MIX, PH_OG };
constexpr int NPHASES = 1 + NLAYER * NPL;
#ifndef NAIVE_ATT
#define NAIVE_ATT 0
#endif
#ifndef PROBE_MASK
#define PROBE_MASK 0
#endif
#ifndef PROBE_LAYERS
#define PROBE_LAYERS 3
#endif
#ifndef PHMASK
#define PHMASK 16383
#endif
#ifndef MK_ONE_LAUNCH
#define MK_ONE_LAUNCH 1
#endif

__global__ void __launch_bounds__(NTHREADS, 2) fwd_kernel(Args args) {
    extern __shared__ __attribute__((aligned(16))) unsigned char lds_raw[];
    { LAS unsigned char* l0 = (LAS unsigned char*)lds_raw;
      for (int u = threadIdx.x; u < (LDS_BYTES - LDSCTL_OFF) / 4; u += NTHREADS) ((LAS unsigned*)(l0 + LDSCTL_OFF))[u] = 0u;
      __syncthreads();
      if (args.ph_hi - args.ph_lo > 1) (void)xcd_barrier_post((unsigned*)((gu32*)(args.ws + WS_CTL) + CW_BAR), (volatile LAS unsigned*)(l0 + MISC_OFF) + 8); }

    unsigned long long tacc = 0ull;
    for (int ph = args.ph_lo; ph < args.ph_hi; ++ph) {
        unsigned long long tph0 = 0ull; bool probed = false;
        if (PROBE_MASK) { const int pl = (ph == 0) ? 0 : (ph - 1) / NPL, pp = (ph == 0) ? 10 : (ph - 1) % NPL; probed = ((PROBE_MASK >> pp) & 1) && ((PROBE_LAYERS >> pl) & 1); if (probed) tph0 = __builtin_amdgcn_s_memrealtime(); }
        int z; asm volatile("s_mov_b32 %0, 0" : "=s"(z));
        Frame F;
        F.lds = (LAS unsigned char*)lds_raw + z; F.kin = (const float* const __attribute__((address_space(4)))*)((const __attribute__((address_space(4))) char*)__builtin_amdgcn_kernarg_segment_ptr() + z); F.ws = args.ws + z; F.out = args.out + z; F.z = z;
        F.tid = threadIdx.x + z; F.lane = F.tid & 63; F.wave = __builtin_amdgcn_readfirstlane(F.tid >> 6);
        F.G = gridDim.x + z; { const int bx = blockIdx.x + z; F.vcu = (F.G % 8 == 0) ? (bx % 8) * (F.G / 8) + bx / 8 : bx; }
        F.gw = F.vcu * NWAVES + F.wave; F.NGW = F.G * NWAVES;
        bool is_gemm = false;
        pg8::Gemm g{nullptr, nullptr, NROWS, 256, 1024, 1024, 31, 0};
        pg8::Order S; S.init(1, 1, F.G, (int)blockIdx.x + z, 0);
        pg8::EpiU E{pg8::EM_PLAIN, 0, F.ws, nullptr, nullptr, nullptr, 0, 0, 0, 0, 1 << 20};
        if (ph == 0) { if (PHMASK & 8192) p0_prologue(F); }
        else {
            const int l = (ph - 1) / NPL, p = (ph - 1) % NPL;
            unsigned char* wl = F.ws + WS_W + (size_t)l * W_LAYER;
            const bool last = (l == NLAYER - 1);
            const int nMc = last ? 64 : NROWS / 256, lat = last ? 1 : 0;
            E.l = l;
            if (p == PH_H && (PHMASK & 1)) { ph_hnorm(F, l); }
            else if (p == PH_G1 && (PHMASK & 2)) {
                is_gemm = true; g.A = (const bf16*)(F.ws + WS_H); g.Bt = (const bf16*)(wl + WO_W1); g.N = N1; g.K = 1024; g.lda = 1024;
                S.init(NROWS / 256, N1 / 256, F.G, (int)blockIdx.x + z, 0);
                E.mode = pg8::EM_SILU2; E.oA = WS_ZS; E.ldc = ZS_P; E.oB = WS_G; E.ldc2 = 1024; E.split_tile = 7;
            }
            else if (p == PH_POST1 && (PHMASK & 4)) { ph_lru1(F, l); ph_post1(F, l); }
            else if (p == PH_G2 && (PHMASK & 8)) {
                is_gemm = true; g.A = (const bf16*)(F.ws + WS_ZS); g.Bt = (const bf16*)(wl + WO_UQ); g.N = 1024; g.K = 256; g.lda = ZS_P; g.a_shift = 1; g.a_step = 512;
                S.init(NROWS / 256, 4, F.G, (int)blockIdx.x + z, 0);
                E.mode = pg8::EM_PLAIN; E.oA = WS_MQ; E.ldc = 512; E.oB = WS_MKV; E.ldc2 = 512; E.split_tile = 2;
            }
            else if (p == PH_POST2 && (PHMASK & 16)) { ph_lru_carry(F); ph_post2(F, l); }
            else if (p == PH_ATT && (PHMASK & 32)) {
#if NAIVE_ATT
                ph_attn_naive(F, l);
#else
                ph_attn(F, l);
#endif
                ph_lru2(F, l); }
            else if (p == PH_SG && (PHMASK & 512)) {
                is_gemm = true; g.A = (const bf16*)(F.ws + WS_H); g.Bt = (const bf16*)(wl + WO_W1) + (size_t)N1 * 1024; g.N = 4096; g.K = 1024; g.lda = 1024;
                S.init(nMc, 16, F.G, (int)blockIdx.x + z, lat);
                E.mode = pg8::EM_SIG; E.oA = WS_S; E.ldc = 4096;
            }
            else if (p == PH_PG && (PHMASK & 1024)) { ph_pgx(F, l); }
            else if (p == PH_MIX) { }
            else if (p == PH_OG && (PHMASK & 4096)) {
                is_gemm = true; g.A = (const bf16*)(F.ws + WS_H); g.Bt = (const bf16*)(wl + WO_WO); g.N = 1024; g.K = 1024; g.lda = 1024;
                S.init(nMc, 4, F.G, (int)blockIdx.x + z, lat);
                E.mode = pg8::EM_RES; E.xin = (l == 0) ? F.in(I_X) : (const float*)F.out; E.xout = F.out; E.cin0 = F.in(I_CTX); E.oA = WS_MOD; E.oB = WS_CTX1;
            }
        }
        if (is_gemm) pg8::gemm_phase<pg8::EpiU, pg8::Order, true, true>(F.lds + RING_OFF, g, S, E, F.tid);
        const bool empty_phase = (ph > 0) && ((ph - 1) % NPL == PH_MIX);
        if (ph + 1 < args.ph_hi && !empty_phase) {
            int z2; asm volatile("s_mov_b32 %0, 0" : "=s"(z2));
            XcdBarrier bar; bar.bar = (unsigned*)((gu32*)(args.ws + z2 + WS_CTL) + CW_BAR); bar.x = xb_xcc_id(); bar.st = (volatile LAS unsigned*)((LAS unsigned char*)lds_raw + z2 + MISC_OFF) + 8;
            xcd_barrier(bar);
        }
        if (PROBE_MASK) { if (probed) tacc += __builtin_amdgcn_s_memrealtime() - tph0; }
    }
#ifdef EXTRA_BARRIERS
    for (int xb = 0; xb < EXTRA_BARRIERS; ++xb) { int z3; asm volatile("s_mov_b32 %0, 0" : "=s"(z3));
        XcdBarrier bar; bar.bar = (unsigned*)((gu32*)(args.ws + z3 + WS_CTL) + CW_BAR); bar.x = xb_xcc_id(); bar.st = (volatile LAS unsigned*)((LAS unsigned char*)lds_raw + z3 + MISC_OFF) + 8;
        xcd_barrier(bar); }
#endif
    if (PROBE_MASK) { const unsigned long long t0 = __builtin_amdgcn_s_memrealtime(); while (__builtin_amdgcn_s_memrealtime() - t0 < tacc) __builtin_amdgcn_s_sleep(8); }
}

extern "C" void kernel_launch(void* const* d_in, const int* in_sizes, int n_in, void* d_out, int out_size, void* d_ws, size_t ws_size, hipStream_t stream) {
    static int grid = 0;
    if (grid == 0) {
        if (n_in != 28 || out_size != NB * SEQ * DM || ws_size < WS_END) { fprintf(stderr, "kernel_launch: unexpected shapes (n_in %d out %d ws %zu); nothing launched\n", n_in, out_size, ws_size); grid = -1; return; }
        int dev = 0, cus = 0, per_cu = 0;
        if (hipGetDevice(&dev) != hipSuccess || hipDeviceGetAttribute(&cus, hipDeviceAttributeMultiprocessorCount, dev) != hipSuccess) { grid = -1; return; }
        if (hipFuncSetAttribute((const void*)fwd_kernel, hipFuncAttributeMaxDynamicSharedMemorySize, LDS_BYTES) != hipSuccess) { fprintf(stderr, "kernel_launch: hipFuncSetAttribute failed\n"); grid = -1; return; }
        if (hipOccupancyMaxActiveBlocksPerMultiprocessor(&per_cu, (const void*)fwd_kernel, NTHREADS, LDS_BYTES) != hipSuccess || per_cu < 1) { fprintf(stderr, "kernel_launch: occupancy query says %d\n", per_cu); (void)hipGetLastError(); grid = -1; return; }
        grid = cus;
    }
    if (grid < 0) return;
    (void)hipMemsetAsync((char*)d_ws + WS_CTL, 0, CTL_ZERO_BYTES, stream);
    Args a{};
    for (int i = 0; i < 28; ++i) a.in[i] = (const float*)d_in[i];
    a.out = (float*)d_out; a.ws = (unsigned char*)d_ws;
#if MK_ONE_LAUNCH
    a.ph_lo = 0; a.ph_hi = NPHASES;
    hipLaunchKernelGGL(fwd_kernel, dim3(grid), dim3(NTHREADS), LDS_BYTES, stream, a);
#else
    for (int ph = 0; ph < NPHASES; ++ph) { a.ph_lo = ph; a.ph_hi = ph + 1; hipLaunchKernelGGL(fwd_kernel, dim3(grid), dim3(NTHREADS), LDS_BYTES, stream, a); }
#endif
}
```

```cpp
#include <hip/hip_runtime.h>
#include <cstdio>
#include <cstdint>
#include <cmath>
__device__ __forceinline__ float bflo(unsigned w) { return __uint_as_float(w << 16); }
__device__ __forceinline__ float bfhi(unsigned w) { return __uint_as_float(w & 0xffff0000u); }
__device__ __forceinline__ float sigmoid_f(float v) { return __builtin_amdgcn_rcpf(1.0f + __builtin_amdgcn_exp2f(-1.4426950408889634f * v)); }
namespace pg8 {
#define PG8_LAS __attribute__((address_space(3)))
typedef unsigned short bf16_t;
typedef short bf16x8 __attribute__((ext_vector_type(8)));
typedef float f32x4 __attribute__((ext_vector_type(4)));
typedef unsigned u32x4 __attribute__((ext_vector_type(4)));
constexpr int BM = 256, BK = 64, HALF = 128, HTB = HALF * BK * 2  , STAGE_BYTES = 8 * HTB, NXCD = 8, WGM = 8;

__host__ __device__ __forceinline__ int lds_byte(int r, int c) { const int st = (r >> 4) * 2 + (c >> 5), rr = r & 15, cc = c & 31, ob = rr * 64 + cc * 2; return st * 1024 + (ob ^ (((ob >> 9) & 1) << 5)); }
__host__ __device__ __forceinline__ void stage_rc(int b, int& R, int& C) { const int st = b / 1024, sb = b % 1024, swz = sb ^ (((sb >> 9) & 1) << 5); R = (st >> 1) * 16 + swz / 64; C = (st & 1) * 32 + (swz % 64) / 2; }
__host__ __device__ __forceinline__ int perm32(int rho) { const int n = rho >> 4, i = rho & 15; return 8 * (i >> 2) + 4 * n + (i & 3); }

struct Unit { int pm, pn; };
struct Gemm { const bf16_t* A; const bf16_t* Bt; int M, N, K, lda; int a_shift, a_step; };

struct StaticOrder {
    int nM, nN, nwg, G, c;
    __host__ __device__ void init(int M, int N, int G_, int c_) { nM = M / BM; nN = N / BM; nwg = nM * nN; G = G_; c = c_; }
    __host__ __device__ bool next(int i, Unit& u) const {
        const long L = (long)i * G + c; if (L >= nwg) return false;
        int wgid = (int)L; { const int q = nwg / NXCD, r = nwg % NXCD, xcd = wgid % NXCD, off = wgid / NXCD; wgid = (xcd < r ? xcd * (q + 1) : r * (q + 1) + (xcd - r) * q) + off; }
        const int nig = WGM * nN, gid = wgid / nig, fm = gid * WGM, gsz = (nM - fm) < WGM ? (nM - fm) : WGM;
        u.pm = fm + ((wgid % nig) % gsz); u.pn = (wgid % nig) / gsz; return true;
    }
    __device__ __forceinline__ void a_ready(const Unit&) const {}
    __device__ __forceinline__ void done(const Unit&) const {}
};

__device__ __forceinline__ unsigned cvt_pk_bf16(float lo, float hi) { unsigned r; asm volatile("v_cvt_pk_bf16_f32 %0, %1, %2" : "=v"(r) : "v"(lo), "v"(hi)); return r; }
enum { EM_PLAIN = 0, EM_SILU2 = 1, EM_SIG = 2, EM_MUL = 3, EM_RES = 4 };
struct EpiU {
    static constexpr bool PERM = true, AFTER_DRAIN = false;
    int mode; int l; unsigned char* ws; const float* xin; float* xout; const float* cin0;
    size_t oA, oB; int ldc, ldc2, split_tile;
    __device__ __forceinline__ void operator()(const f32x4 (&acc)[2][2][4][2], const Unit& u, int wr, int wc, int fr, int fq) const {
        if (mode == EM_RES) {
            const int b = u.pm / 17, t0 = u.pm % 17;
            const float* src; float* dst; const float* gate; const float* modl = (const float*)(ws + oA) + (size_t)l * 5 * 3072;
            if (t0 == 0) { float* c1 = (float*)(ws + oB); src = ((l == 0) ? cin0 : (const float*)c1) + (size_t)b * 256 * 1024; dst = c1 + (size_t)b * 256 * 1024; gate = modl + 4 * 3072 + 2048; }
            else { const size_t o = ((size_t)b * 4096 + (size_t)(t0 - 1) * 256) * 1024; src = xin + o; dst = xout + o; gate = modl + b * 3072 + 2048; }
            const int col0 = u.pn * BM + wc * 32 + 8 * fq;
            const char* srcb = (const char*)src; char* dstb = (char*)dst; const char* gb = (const char*)(gate + col0);
            const unsigned off0 = (unsigned)((wr * 64 + fr) * 1024 + col0) * 4u;
#pragma unroll
            for (int ai = 0; ai < 2; ++ai) {
                f32x4 xo[4][2][2];
#pragma unroll
                for (int m = 0; m < 4; ++m) { const unsigned off = off0 + (unsigned)(ai * HALF + m * 16) * 4096u;
#pragma unroll
                    for (int bj = 0; bj < 2; ++bj)
#pragma unroll
                        for (int n = 0; n < 2; ++n) xo[m][bj][n] = *(const f32x4*)(srcb + (off + (unsigned)(bj * HALF + n * 4) * 4u)); }
#pragma unroll
                for (int m = 0; m < 4; ++m) { const unsigned off = off0 + (unsigned)(ai * HALF + m * 16) * 4096u;
#pragma unroll
                    for (int bj = 0; bj < 2; ++bj)
#pragma unroll
                        for (int n = 0; n < 2; ++n) { const unsigned cb = (unsigned)(bj * HALF + n * 4) * 4u; const f32x4 g = *(const f32x4*)(gb + cb);
                            *(f32x4*)(dstb + (off + cb)) = xo[m][bj][n] + g * acc[ai][bj][m][n]; } }
                asm volatile("" ::: "memory"); }
            return;
        }
        const int row0 = u.pm * BM + wr * 64 + fr; int colt = u.pn * BM; bf16_t* base = (bf16_t*)(ws + oA); int ld = ldc; bool second = false;
        if (u.pn >= split_tile) { base = (bf16_t*)(ws + oB); ld = ldc2; colt -= split_tile * BM; second = true; }
        const bool do_silu = (mode == EM_SILU2) && second;
        const int col0 = colt + wc * 32 + 8 * fq;
        if (mode == EM_MUL) {
            const int kk = u.pn >> 2, jt = u.pn & 3; const bool isctx = (u.pm % 17) == 0;
            bf16_t* mixb = (bf16_t*)(ws + oB); const int mcol0 = jt * BM + wc * 32 + 8 * fq;
            const bool rmw = !isctx && kk > 0;
#pragma unroll
            for (int am = 0; am < 4; ++am) { const int ai = am >> 1, mh = (am & 1) * 2;
                u32x4 old[2][2], prev[2][2];
#pragma unroll
                for (int m2 = 0; m2 < 2; ++m2)
#pragma unroll
                    for (int bj = 0; bj < 2; ++bj) old[m2][bj] = *(const u32x4*)(base + (size_t)(row0 + ai * HALF + (mh + m2) * 16) * ld + col0 + bj * HALF);
                if (rmw) {
#pragma unroll
                    for (int m2 = 0; m2 < 2; ++m2)
#pragma unroll
                        for (int bj = 0; bj < 2; ++bj) prev[m2][bj] = *(const u32x4*)(mixb + (size_t)(row0 + ai * HALF + (mh + m2) * 16) * 1024 + mcol0 + bj * HALF); }
#pragma unroll
                for (int m2 = 0; m2 < 2; ++m2)
#pragma unroll
                    for (int bj = 0; bj < 2; ++bj) { const int m = mh + m2; const f32x4 v0 = acc[ai][bj][m][0], v1 = acc[ai][bj][m][1]; const u32x4 o = old[m2][bj];
                        float t[8] = {v0[0] * bflo(o.x), v0[1] * bfhi(o.x), v0[2] * bflo(o.y), v0[3] * bfhi(o.y), v1[0] * bflo(o.z), v1[1] * bfhi(o.z), v1[2] * bflo(o.w), v1[3] * bfhi(o.w)};
                        if (rmw) { const u32x4 q = prev[m2][bj]; t[0] += bflo(q.x); t[1] += bfhi(q.x); t[2] += bflo(q.y); t[3] += bfhi(q.y); t[4] += bflo(q.z); t[5] += bfhi(q.z); t[6] += bflo(q.w); t[7] += bfhi(q.w); }
                        u32x4 w; w.x = cvt_pk_bf16(t[0], t[1]); w.y = cvt_pk_bf16(t[2], t[3]); w.z = cvt_pk_bf16(t[4], t[5]); w.w = cvt_pk_bf16(t[6], t[7]);
                        if (isctx) *(u32x4*)(base + (size_t)(row0 + ai * HALF + m * 16) * ld + col0 + bj * HALF) = w;
                        else *(u32x4*)(mixb + (size_t)(row0 + ai * HALF + m * 16) * 1024 + mcol0 + bj * HALF) = w; }
                asm volatile("" ::: "memory"); }
            return;
        }
#pragma unroll
        for (int ai = 0; ai < 2; ++ai)
#pragma unroll
            for (int m = 0; m < 4; ++m) { bf16_t* rowp = base + (size_t)(row0 + ai * HALF + m * 16) * ld + col0;
#pragma unroll
                for (int bj = 0; bj < 2; ++bj) { f32x4 v0 = acc[ai][bj][m][0], v1 = acc[ai][bj][m][1];
                    if (mode == EM_SIG) {
#pragma unroll
                        for (int e = 0; e < 4; ++e) { v0[e] = sigmoid_f(v0[e]); v1[e] = sigmoid_f(v1[e]); } }
                    if (do_silu) {
#pragma unroll
                        for (int e = 0; e < 4; ++e) { v0[e] = v0[e] * sigmoid_f(v0[e]); v1[e] = v1[e] * sigmoid_f(v1[e]); } }
                    u32x4 w; w.x = cvt_pk_bf16(v0[0], v0[1]); w.y = cvt_pk_bf16(v0[2], v0[3]); w.z = cvt_pk_bf16(v1[0], v1[1]); w.w = cvt_pk_bf16(v1[2], v1[3]);
                    *(u32x4*)(rowp + bj * HALF) = w; } }
    }
};
struct Order {
    int nM, nN, nwg, G, c, latent_only, grouped, vc, nctx;
    __device__ void init(int nM_, int nN_, int G_, int c_, int lat) { nM = nM_; nN = nN_; nwg = nM * nN; G = G_; c = c_; latent_only = lat; grouped = 0; vc = 0; nctx = 0; }
    __device__ void init_grouped(int G_, int vc_, int with_ctx) { init(64, 4, G_, vc_, 1); grouped = 1; vc = vc_; nctx = with_ctx ? 64 : 0; }
    __device__ bool next(int i, Unit& u) const {
        if (grouped) {
            const int gi = i >> 2, grp = vc + gi * G;
            if (grp < 256) { const int pm = grp >> 2; u.pm = pm + pm / 16 + 1; u.pn = 4 * (i & 3) + (grp & 3); return true; }
            const int done = ((256 - vc + G - 1) / G) * 4;
            const int x = vc + (i - done) * G;
            if (i >= done && x < nctx) { const int g = x >> 2, k = x & 3; u.pm = (g >> 2) * 17; u.pn = 4 * k + (g & 3); return true; }
            return false;
        }
        const long L = (long)i * G + c; if (L >= nwg) return false;
        int wgid = (int)L; { const int q = nwg / NXCD, r = nwg % NXCD, xcd = wgid % NXCD, off = wgid / NXCD; wgid = (xcd < r ? xcd * (q + 1) : r * (q + 1) + (xcd - r) * q) + off; }
        const int nig = WGM * nN, gid = wgid / nig, fm = gid * WGM, gsz = (nM - fm) < WGM ? (nM - fm) : WGM;
        int pm = fm + ((wgid % nig) % gsz); u.pn = (wgid % nig) / gsz; if (latent_only) pm = pm + pm / 16 + 1; u.pm = pm; return true;
    }
    __device__ __forceinline__ void a_ready(const Unit&) const {}
    __device__ __forceinline__ void done(const Unit&) const {}
};
template <class Epi, class Sched, bool ALIGN_EPI = false, bool SP2 = false>
__device__ __forceinline__ void gemm_phase(PG8_LAS unsigned char* lds, const Gemm g, const Sched& S, const Epi& E, const int tid  ) {
    const int wid = __builtin_amdgcn_readfirstlane(tid >> 6), lane = tid & 63, wr = wid >> 2, wc = wid & 3, fr = lane & 15, fq = lane >> 4;
    const int K = g.K, nt = K / BK;
    unsigned voffA[2], voffB[2];
#pragma unroll
    for (int i = 0; i < 2; ++i) { int R, C; stage_rc(tid * 16 + i * 8192, R, C); const int Rb = Epi::PERM ? ((R & ~31) + perm32(R & 31)) : R;
        voffA[i] = (unsigned)(R * g.lda + C) * 2u; voffB[i] = (unsigned)(Rb * K + C) * 2u; }
    const size_t kstep = (size_t)(BK * 2);
    const size_t hstepA = (size_t)HALF * g.lda * 2, hstepB = (size_t)HALF * K * 2;
    const size_t tstepA = 2 * hstepA, tstepB = 2 * hstepB;
    const unsigned ldsw = (unsigned)wid * 1024u;
    const int aoff = lds_byte(wr * 64 + fr, fq * 8), boff = lds_byte(wc * 32 + fr, fq * 8);
#define PG8_SA(b, h) (((b) * 2 + (h)) * HTB)
#define PG8_SB(b, h) ((4 + (b) * 2 + (h)) * HTB)
#define PG8_STAGE(bufoff, gbase, voff) do { _Pragma("unroll") for (int _i = 0; _i < 2; ++_i) \
        __builtin_amdgcn_global_load_lds((const unsigned*)((const char*)(gbase) + (voff)[_i]), (PG8_LAS unsigned*)(lds + (bufoff) + ldsw + _i * 8192), 16, 0, 0); } while (0)
#define PG8_LDA(dst, b, h) do { _Pragma("unroll") for (int m = 0; m < 4; ++m) _Pragma("unroll") for (int k = 0; k < 2; ++k) dst[m][k] = *(const PG8_LAS bf16x8*)(lds + PG8_SA(b, h) + aoff + m * 2048 + k * 1024); } while (0)
#define PG8_LDB(dst, b, h) do { _Pragma("unroll") for (int n = 0; n < 2; ++n) _Pragma("unroll") for (int k = 0; k < 2; ++k) dst[n][k] = *(const PG8_LAS bf16x8*)(lds + PG8_SB(b, h) + boff + n * 2048 + k * 1024); } while (0)
#define PG8_MMA(ai, bj, At, Bt) do { __builtin_amdgcn_s_setprio(1); _Pragma("unroll") for (int m = 0; m < 4; ++m) _Pragma("unroll") for (int n = 0; n < 2; ++n) _Pragma("unroll") for (int k = 0; k < 2; ++k) \
        acc[ai][bj][m][n] = __builtin_amdgcn_mfma_f32_16x16x32_bf16(Bt[n][k], At[m][k], acc[ai][bj][m][n], 0, 0, 0); __builtin_amdgcn_s_setprio(0); } while (0)
#define PG8_WAIT_V(n) asm volatile("s_waitcnt vmcnt(" #n ")" ::: "memory")
#define PG8_WAIT_L(n) asm volatile("s_waitcnt lgkmcnt(" #n ")" ::: "memory")
#define PG8_BAR __builtin_amdgcn_s_barrier()
#define PG8_SCHED __builtin_amdgcn_sched_barrier(0)
    Unit cur, nxt; int ui = 0;
    if (!S.next(0, cur)) return;
    f32x4 acc[2][2][4][2];
#pragma unroll
    for (int a = 0; a < 2; ++a)
#pragma unroll
        for (int b = 0; b < 2; ++b)
#pragma unroll
            for (int m = 0; m < 4; ++m)
#pragma unroll
                for (int n = 0; n < 2; ++n) acc[a][b][m][n] = (f32x4){0.f, 0.f, 0.f, 0.f};
    bf16x8 At[4][2], B0[2][2], B1[2][2];
    const char* cA = (const char*)g.A + (size_t)cur.pm * tstepA + (size_t)(cur.pn >> g.a_shift) * (size_t)g.a_step; const char* cB = (const char*)g.Bt + (size_t)cur.pn * tstepB;
    S.a_ready(cur);
    if constexpr (SP2) {
        PG8_STAGE(PG8_SB(0, 0), cB, voffB); PG8_STAGE(PG8_SB(0, 1), cB + hstepB, voffB); PG8_STAGE(PG8_SA(0, 0), cA, voffA); PG8_STAGE(PG8_SA(0, 1), cA + hstepA, voffA);
        if (wr == 1) PG8_BAR;
        PG8_WAIT_V(2); PG8_BAR;
        PG8_STAGE(PG8_SB(1, 0), cB + kstep, voffB); PG8_STAGE(PG8_SA(1, 0), cA + kstep, voffA); PG8_STAGE(PG8_SB(1, 1), cB + hstepB + kstep, voffB);
        PG8_WAIT_V(6); PG8_BAR;
    } else {
        PG8_STAGE(PG8_SB(0, 0), cB, voffB); PG8_STAGE(PG8_SA(0, 0), cA, voffA); PG8_STAGE(PG8_SB(0, 1), cB + hstepB, voffB); PG8_STAGE(PG8_SA(0, 1), cA + hstepA, voffA);
        if (wr == 1) PG8_BAR;
        PG8_WAIT_V(4); PG8_BAR;
        PG8_STAGE(PG8_SB(1, 0), cB + kstep, voffB); PG8_STAGE(PG8_SA(1, 0), cA + kstep, voffA); PG8_STAGE(PG8_SB(1, 1), cB + hstepB + kstep, voffB);
        PG8_WAIT_V(6); PG8_BAR;
    }
    for (;;) {
        const bool has_next = S.next(ui + 1, nxt);
        const char* nA = has_next ? (const char*)g.A + (size_t)nxt.pm * tstepA + (size_t)(nxt.pn >> g.a_shift) * (size_t)g.a_step : cA; const char* nB = has_next ? (const char*)g.Bt + (size_t)nxt.pn * tstepB : cB;
        for (int t = 0; t < nt; t += 2) {
            const bool last = (t == nt - 2);
            const char* a1 = cA + (size_t)(t + 1) * kstep;
            const char* a2 = last ? nA : cA + (size_t)(t + 2) * kstep; const char* b2 = last ? nB : cB + (size_t)(t + 2) * kstep;
            const char* a3 = a2 + kstep; const char* b3 = b2 + kstep;
            if (last && has_next) S.a_ready(nxt);
            if constexpr (SP2) {
            PG8_LDB(B0, 0, 0); PG8_LDB(B1, 0, 1); PG8_SCHED; PG8_LDA(At, 0, 0); PG8_STAGE(PG8_SA(1, 1), a1 + hstepA, voffA);
            PG8_WAIT_V(8); PG8_WAIT_L(0); PG8_BAR; PG8_MMA(0, 0, At, B0); PG8_MMA(0, 1, At, B1); PG8_BAR; PG8_SCHED;
            PG8_LDA(At, 0, 1); PG8_STAGE(PG8_SB(0, 0), b2, voffB); PG8_STAGE(PG8_SB(0, 1), b2 + hstepB, voffB); PG8_STAGE(PG8_SA(0, 0), a2, voffA);
            PG8_WAIT_V(8); PG8_WAIT_L(0); PG8_BAR; PG8_MMA(1, 0, At, B0); PG8_MMA(1, 1, At, B1); PG8_BAR; PG8_SCHED;
            PG8_LDB(B0, 1, 0); PG8_LDB(B1, 1, 1); PG8_SCHED; PG8_LDA(At, 1, 0); PG8_STAGE(PG8_SA(0, 1), a2 + hstepA, voffA);
            PG8_WAIT_V(8); PG8_WAIT_L(0); PG8_BAR; PG8_MMA(0, 0, At, B0); PG8_MMA(0, 1, At, B1); PG8_BAR; PG8_SCHED;
            PG8_LDA(At, 1, 1); PG8_STAGE(PG8_SB(1, 0), b3, voffB); PG8_STAGE(PG8_SB(1, 1), b3 + hstepB, voffB); PG8_STAGE(PG8_SA(1, 0), a3, voffA);
            PG8_WAIT_V(8); PG8_WAIT_L(0); PG8_BAR; PG8_MMA(1, 0, At, B0); PG8_MMA(1, 1, At, B1); PG8_BAR; PG8_SCHED;
            } else {
            PG8_LDB(B0, 0, 0); PG8_SCHED; PG8_LDA(At, 0, 0); PG8_STAGE(PG8_SA(1, 1), a1 + hstepA, voffA);
            PG8_WAIT_L(8); PG8_BAR; PG8_WAIT_L(0); PG8_MMA(0, 0, At, B0); PG8_BAR; PG8_SCHED;
            PG8_LDB(B1, 0, 1); PG8_STAGE(PG8_SB(0, 0), b2, voffB);
            PG8_BAR; PG8_WAIT_L(0); PG8_MMA(0, 1, At, B1); PG8_BAR;
            PG8_LDA(At, 0, 1); PG8_STAGE(PG8_SA(0, 0), a2, voffA);
            PG8_BAR; PG8_WAIT_L(0); PG8_MMA(1, 0, At, B0); PG8_BAR; PG8_SCHED;
            PG8_STAGE(PG8_SB(0, 1), b2 + hstepB, voffB);
            PG8_WAIT_V(6); PG8_BAR; PG8_MMA(1, 1, At, B1); PG8_BAR;
            PG8_LDB(B0, 1, 0); PG8_SCHED; PG8_LDA(At, 1, 0); PG8_STAGE(PG8_SA(0, 1), a2 + hstepA, voffA);
            PG8_WAIT_L(8); PG8_BAR; PG8_WAIT_L(0); PG8_MMA(0, 0, At, B0); PG8_BAR; PG8_SCHED;
            PG8_LDB(B1, 1, 1); PG8_STAGE(PG8_SB(1, 0), b3, voffB);
            PG8_BAR; PG8_WAIT_L(0); PG8_MMA(0, 1, At, B1); PG8_BAR;
            PG8_LDA(At, 1, 1); PG8_STAGE(PG8_SA(1, 0), a3, voffA);
            PG8_BAR; PG8_WAIT_L(0); PG8_MMA(1, 0, At, B0); PG8_BAR; PG8_SCHED;
            PG8_STAGE(PG8_SB(1, 1), b3 + hstepB, voffB);
            PG8_WAIT_V(6); PG8_BAR; PG8_MMA(1, 1, At, B1); PG8_BAR;
            }
        }
        if constexpr (ALIGN_EPI) { if (wr == 0) PG8_BAR; }
        if constexpr (!Epi::AFTER_DRAIN) { E(acc, cur, wr, wc, fr, fq); S.done(cur); }
        if (!has_next) break;
#pragma unroll
        for (int a = 0; a < 2; ++a)
#pragma unroll
            for (int b = 0; b < 2; ++b)
#pragma unroll
                for (int m = 0; m < 4; ++m)
#pragma unroll
                    for (int n = 0; n < 2; ++n) acc[a][b][m][n] = (f32x4){0.f, 0.f, 0.f, 0.f};
        cur = nxt; cA = nA; cB = nB; ++ui;
        if constexpr (ALIGN_EPI) { if (wr == 1) PG8_BAR; }
    }
    PG8_WAIT_V(0);
    if constexpr (!ALIGN_EPI) { if (wr == 0) PG8_BAR; }
    PG8_BAR;
    if constexpr (Epi::AFTER_DRAIN) { E.fused(acc, cur, wr, wc, fr, fq, lds, wid, lane); S.done(cur); }
#undef PG8_SA
#undef PG8_SB
#undef PG8_STAGE
#undef PG8_LDA
#undef PG8_LDB
#undef PG8_MMA
#undef PG8_WAIT_V
#undef PG8_WAIT_L
#undef PG8_BAR
#undef PG8_SCHED
}
}
#define PG8_SP2 true
#define PG8_ALIGN true
#define GAS __attribute__((address_space(1)))
#define LAS __attribute__((address_space(3)))
typedef unsigned short bf16;
typedef unsigned v4u __attribute__((ext_vector_type(4)));
typedef float f32x4 __attribute__((ext_vector_type(4)));
typedef short bf16x8 __attribute__((ext_vector_type(8)));
typedef GAS unsigned gu32;
typedef GAS unsigned long long gu64;
#define RLX_AGENT __ATOMIC_RELAXED, __HIP_MEMORY_SCOPE_AGENT
#define LDS_WAIT() asm volatile("s_waitcnt lgkmcnt(0)" ::: "memory")
#define VM_WAIT() asm volatile("s_waitcnt vmcnt(0)" ::: "memory")
__device__ __forceinline__ unsigned long long rt() { return __builtin_amdgcn_s_memrealtime(); }
__device__ __forceinline__ unsigned f2bf(float f) { unsigned u = __builtin_bit_cast(unsigned, f); return (u + 0x7fffu + ((u >> 16) & 1u)) >> 16; }
__device__ __forceinline__ unsigned pk2(float lo, float hi) { return f2bf(lo) | (f2bf(hi) << 16); }
#define XB_TMO      128
#define XB_XCNT(j)  (256  + 64 * (j))
#define XB_XSUB(j)  (1280 + 64 * (j))
#define XB_XGEN(j)  (2304 + 64 * (j))
#define XB_TOP      3328
#define XB_TOPGEN   3392
#define XCD_BAR_WORDS 3456
#define XB_SPIN_CAP (1u << 18)

__device__ __forceinline__ unsigned xb_ld(unsigned* p)              { return __hip_atomic_load(p, __ATOMIC_RELAXED, __HIP_MEMORY_SCOPE_AGENT); }
__device__ __forceinline__ unsigned xb_add(unsigned* p, unsigned v) { return __hip_atomic_fetch_add(p, v, __ATOMIC_RELAXED, __HIP_MEMORY_SCOPE_AGENT); }
__device__ __forceinline__ unsigned xb_xcc_id() { return (unsigned)__builtin_amdgcn_s_getreg((3 << 11) | 20) & 0xFu; }
#define XB_SPIN(cond, bar) do { unsigned _sp = 0; while (cond) { __builtin_amdgcn_s_sleep(1); \
    if ((++_sp & 255u) == 0u) { if (xb_ld(&(bar)[XB_TMO])) break; if (_sp > XB_SPIN_CAP) { atomicAdd(&(bar)[XB_TMO], 1u); break; } } } } while (0)

struct XcdBarrier {
    unsigned* bar; unsigned x;
    volatile LAS unsigned* st;
};

__device__ __forceinline__ XcdBarrier xcd_barrier_post(unsigned* bar, volatile LAS unsigned* st) {
    XcdBarrier b; b.bar = bar; b.x = xb_xcc_id(); b.st = st;
    if (threadIdx.x == 0) (void)xb_add(&bar[XB_XCNT(b.x)], 1u);
    return b;
}
__device__ __forceinline__ void xcd_barrier_complete(unsigned* bar, unsigned x, unsigned& nloc, unsigned& nx) {
    const unsigned G = gridDim.x * gridDim.y * gridDim.z;
    unsigned sum, cnt, mine, sp = 0u;
    for (;;) {
        sum = 0u; cnt = 0u; mine = 0u;
#pragma unroll
        for (unsigned j = 0; j < 16; ++j) { const unsigned c = xb_ld(&bar[XB_XCNT(j)]); sum += c; cnt += (c > 0u) ? 1u : 0u; mine = (j == x) ? c : mine; }
        if (sum == G) break;
        __builtin_amdgcn_s_sleep(1);
        if ((++sp & 255u) == 0u) { if (xb_ld(&bar[XB_TMO])) break; if (sp > XB_SPIN_CAP) { atomicAdd(&bar[XB_TMO], 1u); break; } }
    }
    nloc = mine > 0u ? mine : 1u; nx = cnt > 0u ? cnt : 1u;
}

__device__ __forceinline__ void xcd_barrier(const XcdBarrier& b) {
    asm volatile("s_waitcnt vmcnt(0)" ::: "memory");
    __syncthreads();
    if (threadIdx.x == 0) {
        unsigned* bar = b.bar;
        __builtin_amdgcn_s_waitcnt(0);
        unsigned nloc = b.st[0], nx = b.st[1];
        if (nloc == 0u) { xcd_barrier_complete(bar, b.x, nloc, nx); b.st[0] = nloc; b.st[1] = nx; }
        const unsigned old = xb_add(&bar[XB_XSUB(b.x)], 1u);
        const unsigned gen = old / nloc;
        if (old + 1u == (gen + 1u) * nloc) {
            __builtin_amdgcn_fence(__ATOMIC_RELEASE, "agent");
            asm volatile("s_waitcnt vmcnt(0)" ::: "memory");
            const unsigned og = xb_add(&bar[XB_TOP], 1u);
            const unsigned tg = og / nx;
            if (og + 1u == (tg + 1u) * nx) xb_add(&bar[XB_TOPGEN], 1u);
            else XB_SPIN(xb_ld(&bar[XB_TOPGEN]) == tg, bar);
            __builtin_amdgcn_fence(__ATOMIC_ACQUIRE, "agent");
            xb_add(&bar[XB_XGEN(b.x)], 1u);
            asm volatile("s_waitcnt vmcnt(0)" ::: "memory");
        } else {
            XB_SPIN(xb_ld(&bar[XB_XGEN(b.x)]) == gen, bar);
            __builtin_amdgcn_fence(__ATOMIC_ACQUIRE, "agent");
            asm volatile("s_waitcnt vmcnt(0)" ::: "memory");
        }
    }
    __syncthreads();
}
constexpr int NB = 4, SEQ = 4096, CTXL = 256, TPB = SEQ + CTXL, NROWS = NB * TPB, DM = 1024, NLAYER = 2, IN_COLS = 6816;
constexpr int NWAVES = 8, NTHREADS = NWAVES * 64;
constexpr float RMS_EPS = 1e-6f;
constexpr float LOG2E = 1.4426950408889634f;
constexpr float QSCALE64 = 0.125f * LOG2E;
constexpr float QSCALE96 = 0.10206207261596575f * LOG2E;
constexpr int ZS_P = 1792, ZC_CQ = 0, ZC_CKV = 256, ZC_KR = 384, ZC_SQ = 512, ZC_SK = 768, ZC_SV = 896, ZC_AQ = 1024, ZC_AK = 1280, ZC_AV = 1408, ZC_LRU = 1536;
constexpr int N1 = 2816;
constexpr int W1ROWS = N1 + 4096;
constexpr size_t MiB = 1u << 20;
constexpr size_t WS_CTL = 0, CTL_ZERO_BYTES = 64 * 1024;
constexpr size_t WS_MOD = 1 * MiB;
constexpr size_t WS_RHC = 1 * MiB + 256 * 1024, WS_RHS = WS_RHC + 512 * 1024;
constexpr size_t WS_RMC = WS_RHS + 512 * 1024, WS_RMS = WS_RMC + 256 * 1024;
constexpr size_t WS_CTX1 = 3 * MiB;
constexpr size_t WS_W = 8 * MiB, W_LAYER = 18 * MiB;
constexpr size_t WO_W1 = 0, WO_WB = 13 * MiB + 512 * 1024, WO_WO = WO_WB + 2 * MiB, WO_UQ = WO_WO + 2 * MiB, WO_UKV = WO_UQ + 256 * 1024;
constexpr size_t WS_H = 44 * MiB;
constexpr size_t WS_G = 78 * MiB;
constexpr size_t WS_S = 112 * MiB;
constexpr size_t WS_ZS = 112 * MiB;
constexpr size_t WS_MQ = 172 * MiB;
constexpr size_t WS_MKV = 189 * MiB;
constexpr size_t WS_MK = 206 * MiB;
constexpr size_t WS_U = 219 * MiB;
constexpr size_t WS_HF = 236 * MiB;
constexpr size_t WS_SP = 2 * MiB + 768 * 1024;
constexpr size_t WS_LWT = 254 * MiB + 512 * 1024;
constexpr size_t WS_END = 256 * MiB;
static_assert(WS_H + (size_t)NROWS * 1024 * 2 <= WS_G && WS_G + (size_t)NROWS * 1024 * 2 <= WS_S && WS_S + (size_t)NROWS * 4096 * 2 <= 248 * MiB, "ws map");
static_assert(WS_ZS + (size_t)NROWS * ZS_P * 2 <= WS_MQ && WS_MK + (size_t)NROWS * 384 * 2 <= WS_U, "ws map 2");
static_assert(WO_UKV + 512 * 256 * 2 <= W_LAYER, "weights");
constexpr int CW_BAR = 1024;

constexpr int RING_OFF = 0, RING_BYTES = 131072, LDSCTL_OFF = RING_BYTES, MISC_OFF = LDSCTL_OFF + 320, LDS_BYTES = 147456;

typedef unsigned short bf16;
typedef unsigned u32x2 __attribute__((ext_vector_type(2)));
typedef float f32x2v __attribute__((ext_vector_type(2)));
__device__ __forceinline__ float bf2f(bf16 v) { return __uint_as_float((unsigned)v << 16); }
__device__ __forceinline__ float wave_sum(float v) {
#pragma unroll
    for (int o = 1; o < 64; o <<= 1) v += __shfl_xor(v, o);
    return v; }
__device__ __forceinline__ float wave_max(float v) {
#pragma unroll
    for (int o = 1; o < 64; o <<= 1) v = fmaxf(v, __shfl_xor(v, o));
    return v; }
__device__ __forceinline__ float grp16_sum(float v) {
#pragma unroll
    for (int o = 1; o < 16; o <<= 1) v += __shfl_xor(v, o);
    return v; }

struct Args { const float* in[28]; float* out; unsigned char* ws; int ph_lo, ph_hi; };
enum { I_X = 0, I_C, I_CTX, I_CCTX, I_WMOD, I_BMOD, I_NORMW, I_WIN, I_CQN, I_CKVN, I_WUQ, I_WUKV, I_MQN, I_MKN, I_SQN, I_SKN, I_SINK, I_AQN, I_AKN,
       I_CONVW, I_CONVB, I_LWR, I_LBR, I_LWI, I_LBI, I_LAM, I_WBR, I_WOUT };

struct Frame {
    LAS unsigned char* lds; const float* const __attribute__((address_space(4)))* kin; unsigned char* ws; float* out;
    int tid, lane, wave, G, vcu, gw, NGW, z;
    __device__ __forceinline__ const float* in(int i) const { return kin[i]; }
};

__device__ __forceinline__ void xpose_item(const float* W, int ldn, int k0, int n0, bf16* WT, int pd, int drow, LAS float* scr, int lane) {
#pragma unroll 8
    for (int i = 0; i < 32; ++i) { const int kk = 2 * i + (lane >> 5); scr[kk * 33 + (lane & 31)] = W[(size_t)(k0 + kk) * ldn + n0 + (lane & 31)]; }
    LDS_WAIT(); asm volatile("" ::: "memory");
    const int c = lane & 7;
#pragma unroll
    for (int j = 0; j < 4; ++j) { const int n = (lane >> 3) + 8 * j; const LAS float* s = scr + (8 * c) * 33 + n;
        v4u o; o.x = pk2(s[0 * 33], s[1 * 33]); o.y = pk2(s[2 * 33], s[3 * 33]); o.z = pk2(s[4 * 33], s[5 * 33]); o.w = pk2(s[6 * 33], s[7 * 33]);
        *(GAS v4u*)(WT + (size_t)(drow + n0 + n) * pd + k0 + 8 * c) = o; }
    LDS_WAIT(); asm volatile("" ::: "memory");
}
__device__ __forceinline__ void zero16(bf16* p, size_t n16, int gt, int ngt) {
    for (size_t i = gt; i < n16; i += ngt) ((GAS v4u*)p)[i] = (v4u){0u, 0u, 0u, 0u};
}
__device__ __forceinline__ void p0_prologue(Frame& F) {
    LAS float* scr = (LAS float*)(F.lds + RING_OFF + F.wave * 16384);
    constexpr int I_IN = 16 * 213, I_UQ = 4 * 12, I_UKV = 2 * 16, I_BR = 4 * 4 * 32, I_OUT = 16 * 32, I_LAYER = I_IN + I_UQ + I_UKV + I_BR + I_OUT;
    for (int it = F.gw; it < NLAYER * I_LAYER; it += F.NGW) {
        const int l = it / I_LAYER; int r = it % I_LAYER;
        unsigned char* wl = F.ws + WS_W + (size_t)l * W_LAYER;
        if (r < I_IN) { const int kb = r / 213, nb = r % 213, n0 = nb * 32;
            xpose_item(F.in(I_WIN) + (size_t)l * 1024 * IN_COLS, IN_COLS, kb * 64, n0, (bf16*)(wl + WO_W1), 1024, n0 >= 416 ? 96 : 0, scr, F.lane); continue; } r -= I_IN;
        if (r < I_UQ) { const int kb = r / 12, nb = r % 12;
            xpose_item(F.in(I_WUQ) + (size_t)l * 256 * 384, 384, kb * 64, nb * 32, (bf16*)(wl + WO_UQ), 256, 0, scr, F.lane); continue; } r -= I_UQ;
        if (r < I_UKV) { const int kb = r / 16, nb = r % 16;
            xpose_item(F.in(I_WUKV) + (size_t)l * 128 * 512, 512, kb * 64, nb * 32, (bf16*)(wl + WO_UKV), 256, 0, scr, F.lane); continue; } r -= I_UKV;
        if (r < I_BR) { const int k = r / 128, rr = r % 128, kb = rr / 32, nb = rr % 32;
            xpose_item(F.in(I_WBR) + ((size_t)l * 4 + k) * 256 * 1024, 1024, kb * 64, nb * 32, (bf16*)(wl + WO_WB) + (size_t)k * 1024 * 256, 256, 0, scr, F.lane); continue; } r -= I_BR;
        { const int kb = r / 32, nb = r % 32;
            xpose_item(F.in(I_WOUT) + (size_t)l * 1024 * 1024, 1024, kb * 64, nb * 32, (bf16*)(wl + WO_WO), 1024, 0, scr, F.lane); }
    }
    const int gt = F.vcu * NTHREADS + F.tid, ngt = F.G * NTHREADS;
    for (int l = 0; l < NLAYER; ++l) {
        unsigned char* wl = F.ws + WS_W + (size_t)l * W_LAYER;
        zero16((bf16*)(wl + WO_W1) + (size_t)416 * 1024, 96 * 1024 * 2 / 16, gt, ngt);
        zero16((bf16*)(wl + WO_UQ) + (size_t)384 * 256, 128 * 256 * 2 / 16, gt, ngt);
        for (int i = gt; i < 512 * 16; i += ngt) { const int n = i >> 4, c = i & 15; ((GAS v4u*)((bf16*)(wl + WO_UKV) + (size_t)n * 256 + 128))[c] = (v4u){0u, 0u, 0u, 0u}; }
    }
    { float* rhc = (float*)(F.ws + WS_RHC); float* rhs = (float*)(F.ws + WS_RHS); float* rmc = (float*)(F.ws + WS_RMC); float* rms = (float*)(F.ws + WS_RMS);
      for (int i = gt; i < 4096 * 32; i += ngt) { const int t = i >> 5, p = i & 31; const float fr = powf(10000.0f, -(float)(p & 15) / 16.0f);
          const float pos = (float)((p < 16) ? (t >> 6) : (t & 63)); const float ang = pos * fr; rhc[i] = cosf(ang); rhs[i] = sinf(ang); }
      for (int i = gt; i < 4096 * 16; i += ngt) { const int t = i >> 4, p = i & 15; const float fr = powf(10000.0f, -(float)(p & 7) / 8.0f);
          const float pos = (float)((p < 8) ? (t >> 6) : (t & 63)); const float ang = pos * fr; rmc[i] = cosf(ang); rms[i] = sinf(ang); } }
    { float* sp = (float*)(F.ws + WS_SP); for (int i = gt; i < NLAYER * 2 * 256; i += ngt) sp[i] = 8.0f * LOG2E * log1pf(expf(-F.in(I_LAM)[i])); }
    { float* lwt = (float*)(F.ws + WS_LWT);
      for (int o = gt; o < NLAYER * 2 * 2 * 256 * 64; o += ngt) { const int i = o & 63, c = (o >> 6) & 255, gate = (o >> 14) & 1, ld = o >> 15, k = c >> 6, j = c & 63;
          lwt[o] = (gate == 0 ? F.in(I_LWR) : F.in(I_LWI))[(((size_t)ld * 4 + k) * 64 + i) * 64 + j]; } }
    { LAS float* sc = (LAS float*)(F.lds + RING_OFF);
      LAS float* red = sc + 5 * 1024;
      __syncthreads();
      for (int i = F.tid; i < 5 * 1024; i += NTHREADS) { const float v = (i < 4096) ? F.in(I_C)[i] : F.in(I_CCTX)[i - 4096]; sc[i] = v / (1.0f + expf(-v)); }
      __syncthreads();
      float* modv = (float*)(F.ws + WS_MOD);
      for (int it = F.vcu; it < NLAYER * 96; it += F.G) {
          const int l = it / 96, n0 = (it % 96) * 32, nn = F.tid & 31, kc = F.tid >> 5;
          const float* w = F.in(I_WMOD) + (size_t)l * 1024 * 3072 + n0 + nn;
          float acc[5] = {0.f, 0.f, 0.f, 0.f, 0.f};
          for (int k = kc * 64; k < kc * 64 + 64; ++k) { const float wv = w[(size_t)k * 3072];
#pragma unroll
              for (int r = 0; r < 5; ++r) acc[r] += sc[r * 1024 + k] * wv; }
#pragma unroll
          for (int r = 0; r < 5; ++r) red[(kc * 5 + r) * 32 + nn] = acc[r];
          __syncthreads();
          if (F.tid < 160) { const int r = F.tid >> 5; float s = 0.f;
              for (int q = 0; q < 16; ++q) s += red[(q * 5 + r) * 32 + nn];
              modv[((size_t)l * 5 + r) * 3072 + n0 + nn] = s + F.in(I_BMOD)[l * 3072 + n0 + nn]; }
          __syncthreads();
      } }
}

__device__ __forceinline__ void ph_hnorm(Frame& F, int l) {
    const float* xs = (l == 0) ? F.in(I_X) : F.out; const float* cs = (l == 0) ? F.in(I_CTX) : (const float*)(F.ws + WS_CTX1);
    const float* nw = F.in(I_NORMW) + l * 1024; const float* modl = (const float*)(F.ws + WS_MOD) + (size_t)l * 5 * 3072;
    bf16* H = (bf16*)(F.ws + WS_H);
    for (int row = F.gw; row < NROWS; row += F.NGW) {
        const int b = row / TPB, j = row % TPB; const float* src; int mr;
        if (j < CTXL) { src = cs + ((size_t)b * CTXL + j) * 1024; mr = 4; } else { src = xs + ((size_t)b * SEQ + (j - CTXL)) * 1024; mr = b; }
        const GAS f32x4* xr = (const GAS f32x4*)src + F.lane;
        f32x4 v[4]; float ss = 0.f;
#pragma unroll
        for (int q = 0; q < 4; ++q) { v[q] = xr[64 * q]; ss += (v[q].x * v[q].x + v[q].y * v[q].y) + (v[q].z * v[q].z + v[q].w * v[q].w); }
        const float rstd = 1.0f / sqrtf(wave_sum(ss) * (1.0f / 1024.0f) + RMS_EPS);
        const float* mrow = modl + mr * 3072;
        GAS unsigned long long* o8 = (GAS unsigned long long*)(H + (size_t)row * 1024) + F.lane;
#pragma unroll
        for (int q = 0; q < 4; ++q) { const int c = 4 * F.lane + 256 * q;
            const f32x4 g = *(const f32x4*)(nw + c), sh = *(const f32x4*)(mrow + c), sc = *(const f32x4*)(mrow + 1024 + c);
            const f32x4 h = v[q] * rstd * g * (sc + 1.0f) + sh;
            o8[64 * q] = (unsigned long long)pk2(h.x, h.y) | ((unsigned long long)pk2(h.z, h.w) << 32); }
    }
}

struct P1Regs { u32x2 cq; unsigned ckv, h[3][2]; float rc[2], rs[2]; };
__device__ __forceinline__ void post1_load(const bf16* z, const float* rc, const float* rs, bool lat, int lane, P1Regs& R) {
    const int hg = lane >> 4, p0 = (lane & 15) * 2;
    R.cq = *(const u32x2*)(z + ZC_CQ + 4 * lane); R.ckv = *(const unsigned*)(z + ZC_CKV + 2 * lane);
    const bf16* h0 = z + ZC_SQ + hg * 64 + p0; const bf16* h1 = z + ZC_AQ + hg * 64 + p0; const bf16* h2 = z + ((hg < 2) ? (ZC_SK + hg * 64) : (ZC_AK + (hg - 2) * 64)) + p0;
    R.h[0][0] = *(const unsigned*)h0; R.h[0][1] = *(const unsigned*)(h0 + 32); R.h[1][0] = *(const unsigned*)h1; R.h[1][1] = *(const unsigned*)(h1 + 32); R.h[2][0] = *(const unsigned*)h2; R.h[2][1] = *(const unsigned*)(h2 + 32);
    if (lat) { R.rc[0] = rc[p0]; R.rc[1] = rc[p0 + 1]; R.rs[0] = rs[p0]; R.rs[1] = rs[p0 + 1]; } else { R.rc[0] = 1.f; R.rc[1] = 1.f; R.rs[0] = 0.f; R.rs[1] = 0.f; }
}
__device__ __forceinline__ void post1_finish(bf16* z, int lane, const P1Regs& R, const float (&gcq)[4], const float (&gckv)[2], const float (&gh)[3][4]) {
    const int hg = lane >> 4, p0 = (lane & 15) * 2;
    { float v0 = bflo(R.cq.x), v1 = bfhi(R.cq.x), v2 = bflo(R.cq.y), v3 = bfhi(R.cq.y);
      const float rstd = 1.0f / sqrtf(wave_sum(v0 * v0 + v1 * v1 + v2 * v2 + v3 * v3) * (1.0f / 256.0f) + RMS_EPS);
      u32x2 w; w.x = pk2(v0 * rstd * gcq[0], v1 * rstd * gcq[1]); w.y = pk2(v2 * rstd * gcq[2], v3 * rstd * gcq[3]); *(u32x2*)(z + ZC_CQ + 4 * lane) = w; }
    { float v0 = bflo(R.ckv), v1 = bfhi(R.ckv);
      const float rstd = 1.0f / sqrtf(wave_sum(v0 * v0 + v1 * v1) * (1.0f / 128.0f) + RMS_EPS);
      *(unsigned*)(z + ZC_CKV + 2 * lane) = pk2(v0 * rstd * gckv[0], v1 * rstd * gckv[1]); }
#pragma unroll
    for (int q = 0; q < 3; ++q) {
        bf16* hp = z + ((q == 0) ? (ZC_SQ + hg * 64) : (q == 1) ? (ZC_AQ + hg * 64) : ((hg < 2) ? (ZC_SK + hg * 64) : (ZC_AK + (hg - 2) * 64))) + p0;
        float a0 = bflo(R.h[q][0]), a1 = bfhi(R.h[q][0]), b0 = bflo(R.h[q][1]), b1 = bfhi(R.h[q][1]);
        const float rstd = 1.0f / sqrtf(grp16_sum(a0 * a0 + a1 * a1 + b0 * b0 + b1 * b1) * (1.0f / 64.0f) + RMS_EPS);
        a0 *= rstd * gh[q][0]; a1 *= rstd * gh[q][1]; b0 *= rstd * gh[q][2]; b1 *= rstd * gh[q][3];
        const float x0 = a0 * R.rc[0] - b0 * R.rs[0], y0 = b0 * R.rc[0] + a0 * R.rs[0], x1 = a1 * R.rc[1] - b1 * R.rs[1], y1 = b1 * R.rc[1] + a1 * R.rs[1];
        const float sc = (q < 2) ? QSCALE64 : 1.0f;
        *(unsigned*)hp = pk2(x0 * sc, x1 * sc); *(unsigned*)(hp + 32) = pk2(y0 * sc, y1 * sc);
    }
}
__device__ __forceinline__ void ph_post1(Frame& F, int l) {
    bf16* ZS = (bf16*)(F.ws + WS_ZS);
    const float* rhc = (const float*)(F.ws + WS_RHC); const float* rhs = (const float*)(F.ws + WS_RHS);
    const int lane = F.lane, hg = lane >> 4, p0 = (lane & 15) * 2;
    float gcq[4], gckv[2], gh[3][4];
#pragma unroll
    for (int i = 0; i < 4; ++i) gcq[i] = F.in(I_CQN)[l * 256 + 4 * lane + i];
    gckv[0] = F.in(I_CKVN)[l * 128 + 2 * lane]; gckv[1] = F.in(I_CKVN)[l * 128 + 2 * lane + 1];
    { const float* g0 = F.in(I_SQN) + l * 64; const float* g1 = F.in(I_AQN) + l * 64; const float* g2 = ((hg < 2) ? F.in(I_SKN) : F.in(I_AKN)) + l * 64;
      gh[0][0] = g0[p0]; gh[0][1] = g0[p0 + 1]; gh[0][2] = g0[32 + p0]; gh[0][3] = g0[33 + p0];
      gh[1][0] = g1[p0]; gh[1][1] = g1[p0 + 1]; gh[1][2] = g1[32 + p0]; gh[1][3] = g1[33 + p0];
      gh[2][0] = g2[p0]; gh[2][1] = g2[p0 + 1]; gh[2][2] = g2[32 + p0]; gh[2][3] = g2[33 + p0]; }
    for (int row = F.gw; row < NROWS; row += 2 * F.NGW) {
        const int row2 = row + F.NGW; const bool has2 = row2 < NROWS;
        const int j = row % TPB; const bool lat = j >= CTXL; const int pos = lat ? j - CTXL : 0;
        const int j2 = has2 ? row2 % TPB : 0; const bool lat2 = j2 >= CTXL; const int pos2 = lat2 ? j2 - CTXL : 0;
        bf16* z = ZS + (size_t)row * ZS_P; bf16* z2 = ZS + (size_t)(has2 ? row2 : row) * ZS_P;
        P1Regs A, B;
        post1_load(z, rhc + pos * 32, rhs + pos * 32, lat, lane, A);
        if (has2) post1_load(z2, rhc + pos2 * 32, rhs + pos2 * 32, lat2, lane, B);
        post1_finish(z, lane, A, gcq, gckv, gh);
        if (has2) post1_finish(z2, lane, B, gcq, gckv, gh);
    }
}
struct P2Regs { u32x2 qn, kn; bf16 q1, q2, k1, k2; float c, s; };
__device__ __forceinline__ void post2_load(const bf16* zrow, const bf16* mq, const bf16* mkv, const float* rc, const float* rs, bool lat, int lane, P2Regs& R) {
    const int h = lane >> 4, j = lane & 15;
    R.qn = *(const u32x2*)(mq + h * 96 + 4 * j); R.q1 = mq[h * 96 + 64 + j]; R.q2 = mq[h * 96 + 80 + j];
    R.kn = *(const u32x2*)(mkv + h * 128 + 4 * j); R.k1 = zrow[ZC_KR + j]; R.k2 = zrow[ZC_KR + 16 + j];
    if (lat) { R.c = rc[j]; R.s = rs[j]; } else { R.c = 1.f; R.s = 0.f; }
}
__device__ __forceinline__ void post2_finish(bf16* mq, bf16* mk, int lane, const P2Regs& R, const float (&gq)[6], const float (&gk)[6]) {
    const int h = lane >> 4, j = lane & 15;
#pragma unroll
    for (int qk = 0; qk < 2; ++qk) {
        const u32x2 n = qk == 0 ? R.qn : R.kn; float v0 = bflo(n.x), v1 = bfhi(n.x), v2 = bflo(n.y), v3 = bfhi(n.y), r1 = bf2f(qk == 0 ? R.q1 : R.k1), r2 = bf2f(qk == 0 ? R.q2 : R.k2);
        const float rstd = 1.0f / sqrtf(grp16_sum(v0 * v0 + v1 * v1 + v2 * v2 + v3 * v3 + r1 * r1 + r2 * r2) * (1.0f / 96.0f) + RMS_EPS);
        const float (&g)[6] = qk == 0 ? gq : gk; const float sc = qk == 0 ? QSCALE96 : 1.0f;
        const float y1 = r1 * rstd * g[4], y2 = r2 * rstd * g[5];
        const float t1 = (y1 * R.c - y2 * R.s) * sc, t2 = (y2 * R.c + y1 * R.s) * sc;
        bf16* o = (qk == 0 ? mq : mk) + h * 96;
        u32x2 w; w.x = pk2(v0 * rstd * g[0] * sc, v1 * rstd * g[1] * sc); w.y = pk2(v2 * rstd * g[2] * sc, v3 * rstd * g[3] * sc);
        *(u32x2*)(o + 4 * j) = w; o[64 + j] = (bf16)f2bf(t1); o[80 + j] = (bf16)f2bf(t2);
    }
}
__device__ __forceinline__ void ph_post2(Frame& F, int l) {
    const bf16* ZS = (const bf16*)(F.ws + WS_ZS); bf16* MQ = (bf16*)(F.ws + WS_MQ); const bf16* MKV = (const bf16*)(F.ws + WS_MKV); bf16* MK = (bf16*)(F.ws + WS_MK);
    const float* rmc = (const float*)(F.ws + WS_RMC); const float* rms = (const float*)(F.ws + WS_RMS);
    const int lane = F.lane, jj = lane & 15;
    float gq[6], gk[6];
    { const float* a = F.in(I_MQN) + l * 96; const float* b = F.in(I_MKN) + l * 96;
#pragma unroll
      for (int i = 0; i < 4; ++i) { gq[i] = a[4 * jj + i]; gk[i] = b[4 * jj + i]; }
      gq[4] = a[64 + jj]; gq[5] = a[80 + jj]; gk[4] = b[64 + jj]; gk[5] = b[80 + jj]; }
    for (int row = F.gw; row < NROWS; row += 2 * F.NGW) {
        const int row2 = row + F.NGW; const bool has2 = row2 < NROWS; const size_t rb = has2 ? row2 : row;
        const int j = row % TPB; const bool lat = j >= CTXL; const int pos = lat ? j - CTXL : 0;
        const int j2 = (int)(rb % TPB); const bool lat2 = j2 >= CTXL; const int pos2 = lat2 ? j2 - CTXL : 0;
        P2Regs A, B;
        post2_load(ZS + (size_t)row * ZS_P, MQ + (size_t)row * 512, MKV + (size_t)row * 512, rmc + pos * 16, rms + pos * 16, lat, lane, A);
        if (has2) post2_load(ZS + rb * ZS_P, MQ + rb * 512, MKV + rb * 512, rmc + pos2 * 16, rms + pos2 * 16, lat2, lane, B);
        post2_finish(MQ + (size_t)row * 512, MK + (size_t)row * 384, lane, A, gq, gk);
        if (has2) post2_finish(MQ + rb * 512, MK + rb * 384, lane, B, gq, gk);
    }
}

template <int DQK>
__device__ __forceinline__ void attn_row_naive(const bf16* q, const bf16* Kb, int kp, const bf16* Vb, int vp, int n1, int lo2, int hi2, bool has_sink, float sink2, bf16* y, int lane) {
    float qf[DQK];
#pragma unroll
    for (int c = 0; c < DQK / 8; ++c) { const v4u w = *(const v4u*)(q + 8 * c);
        qf[8 * c + 0] = bflo(w.x); qf[8 * c + 1] = bfhi(w.x); qf[8 * c + 2] = bflo(w.y); qf[8 * c + 3] = bfhi(w.y); qf[8 * c + 4] = bflo(w.z); qf[8 * c + 5] = bfhi(w.z); qf[8 * c + 6] = bflo(w.w); qf[8 * c + 7] = bfhi(w.w); }
    float m = -INFINITY, l = 0.f; float acc[64];
#pragma unroll
    for (int d = 0; d < 64; ++d) acc[d] = 0.f;
    for (int seg = 0; seg < 2; ++seg) {
        const int k0 = seg == 0 ? 0 : lo2, k1 = seg == 0 ? n1 : hi2;
        for (int key = k0 + lane; key < k1; key += 64) {
            const bf16* kr = Kb + (size_t)key * kp; float s = 0.f;
#pragma unroll
            for (int c = 0; c < DQK / 8; ++c) { const v4u w = *(const v4u*)(kr + 8 * c);
                s += qf[8 * c + 0] * bflo(w.x) + qf[8 * c + 1] * bfhi(w.x) + qf[8 * c + 2] * bflo(w.y) + qf[8 * c + 3] * bfhi(w.y) + qf[8 * c + 4] * bflo(w.z) + qf[8 * c + 5] * bfhi(w.z) + qf[8 * c + 6] * bflo(w.w) + qf[8 * c + 7] * bfhi(w.w); }
            if (s > m) { const float f = exp2f(m - s); l *= f;
#pragma unroll
                for (int d = 0; d < 64; ++d) acc[d] *= f;
                m = s; }
            const float p = exp2f(s - m); l += p;
            const bf16* vr = Vb + (size_t)key * vp;
#pragma unroll
            for (int c = 0; c < 8; ++c) { const v4u w = *(const v4u*)(vr + 8 * c);
                acc[8 * c + 0] += p * bflo(w.x); acc[8 * c + 1] += p * bfhi(w.x); acc[8 * c + 2] += p * bflo(w.y); acc[8 * c + 3] += p * bfhi(w.y); acc[8 * c + 4] += p * bflo(w.z); acc[8 * c + 5] += p * bfhi(w.z); acc[8 * c + 6] += p * bflo(w.w); acc[8 * c + 7] += p * bfhi(w.w); }
        }
    }
    float M = wave_max(m); if (has_sink) M = fmaxf(M, sink2);
    const float f = (m == -INFINITY) ? 0.f : exp2f(m - M);
    float L = wave_sum(l * f); if (has_sink) L += exp2f(sink2 - M);
    float mine = 0.f;
#pragma unroll
    for (int d = 0; d < 64; ++d) { const float t = wave_sum(acc[d] * f); if (lane == d) mine = t; }
    y[lane] = (bf16)f2bf(mine / L * bf2f(y[lane]));
}
__device__ __forceinline__ void ph_attn_naive(Frame& F, int l) {
    const bf16* ZS = (const bf16*)(F.ws + WS_ZS); const bf16* MQ = (const bf16*)(F.ws + WS_MQ); const bf16* MKV = (const bf16*)(F.ws + WS_MKV); const bf16* MK = (const bf16*)(F.ws + WS_MK);
    bf16* Y = (bf16*)(F.ws + WS_G);
    const long nitems = (long)NROWS * 12;
    for (long it = F.gw; it < nitems; it += F.NGW) {
        const int hb = (int)(it % 12); const int row = (int)(it / 12);
        const int b = row / TPB, j = row % TPB; const bool lat = j >= CTXL;
        if (!lat && l == NLAYER - 1) continue;
        const size_t r0 = (size_t)b * TPB;
        const int br = hb >> 2, h = hb & 3;
        bf16* y = Y + (size_t)row * 1024 + br * 256 + h * 64;
        if (br == 0) {
            attn_row_naive<96>(MQ + (size_t)row * 512 + h * 96, MK + r0 * 384 + h * 96, 384, MKV + r0 * 512 + h * 128 + 64, 512, CTXL, CTXL, lat ? TPB : CTXL, false, 0.f, y, F.lane);
        } else if (br == 1) {
            const int t = j - CTXL; int lo = CTXL, hi = CTXL;
            if (lat) { lo = CTXL + (t - 128 < 0 ? 0 : t - 128); hi = CTXL + (t + 128 > SEQ - 1 ? SEQ - 1 : t + 128) + 1; }
            attn_row_naive<64>(ZS + (size_t)row * ZS_P + ZC_SQ + h * 64, ZS + r0 * ZS_P + ZC_SK + (h >> 1) * 64, ZS_P, ZS + r0 * ZS_P + ZC_SV + (h >> 1) * 64, ZS_P, CTXL, lo, hi, true, F.in(I_SINK)[l * 4 + h] * LOG2E, y, F.lane);
        } else {
            attn_row_naive<64>(ZS + (size_t)row * ZS_P + ZC_AQ + h * 64, ZS + r0 * ZS_P + ZC_AK + (h >> 1) * 64, ZS_P, ZS + r0 * ZS_P + ZC_AV + (h >> 1) * 64, ZS_P, CTXL, CTXL, lat ? TPB : CTXL, false, 0.f, y, F.lane);
        }
    }
}

__device__ __forceinline__ void ph_lru_conv(Frame& F, int l) {
    const bf16* ZS = (const bf16*)(F.ws + WS_ZS); float* U = (float*)(F.ws + WS_U);
    const float* cw = F.in(I_CONVW) + l * 4 * 256; const float* cb = F.in(I_CONVB) + l * 256;
    const int gt = F.vcu * NTHREADS + F.tid, ngt = F.G * NTHREADS;
    for (int idx = gt; idx < NROWS * 256; idx += ngt) {
        const int row = idx >> 8, c = idx & 255, b = row / TPB, j = row % TPB;
        int s0, len, jj; if (j < CTXL) { s0 = b * TPB; len = CTXL; jj = j; } else { s0 = b * TPB + CTXL; len = SEQ; jj = j - CTXL; }
        float acc = cb[c];
#pragma unroll
        for (int i = 0; i < 4; ++i) { const int t = jj + i - 2; if (t >= 0 && t < len) acc += cw[i * 256 + c] * bf2f(ZS[(size_t)(s0 + t) * ZS_P + ZC_LRU + c]); }
        U[idx] = acc;
    }
}
__device__ __forceinline__ void ph_lru_scan(Frame& F, int l, int dir) {
    const float* U = (const float*)(F.ws + WS_U); float* HF = (float*)(F.ws + WS_HF); bf16* Y = (bf16*)(F.ws + WS_G);
    const int g = blockIdx.x * NTHREADS + F.tid;
    if (g < NB * 256) {
    const int b = g >> 8, c = g & 255, k = c >> 6, jc = c & 63;
    const float* wr = F.in(I_LWR) + ((((size_t)l * 2 + dir) * 4 + k) * 64) * 64 + jc;
    const float* wi = F.in(I_LWI) + ((((size_t)l * 2 + dir) * 4 + k) * 64) * 64 + jc;
    float wrr[64], wii[64];
#pragma unroll
    for (int i = 0; i < 64; ++i) { wrr[i] = wr[i * 64]; wii[i] = wi[i * 64]; }
    const float br = F.in(I_LBR)[(l * 2 + dir) * 256 + c], bi = F.in(I_LBI)[(l * 2 + dir) * 256 + c];
    const float lam = F.in(I_LAM)[(l * 2 + dir) * 256 + c];
    const float sp = log1pf(expf(-lam));
    float h = 0.f;
    for (int s = 0; s < TPB; ++s) {
        const int j = dir == 0 ? s : (s < CTXL ? CTXL - 1 - s : TPB + CTXL - 1 - s);
        const size_t row = (size_t)b * TPB + j;
        const float* ub = U + row * 256 + k * 64;
        float rp = br, ip = bi;
#pragma unroll
        for (int i = 0; i < 64; ++i) { const float uv = ub[i]; rp += uv * wrr[i]; ip += uv * wii[i]; }
        const float r = 1.0f / (1.0f + expf(-rp)), ig = 1.0f / (1.0f + expf(-ip));
        const float la = -8.0f * r * sp; const float a = expf(la);
        const float bx = sqrtf(-expm1f(2.0f * la)) * (ig * ub[jc]);
        h = a * h + bx;
        if (dir == 0) HF[row * 256 + c] = h;
        else { bf16* y = Y + row * 1024 + 768 + c; *y = (bf16)f2bf((HF[row * 256 + c] + h) * bf2f(*y)); }
    }
    }
}
__device__ __forceinline__ void ph_mixsum_ctx(Frame& F) {
    const bf16* S = (const bf16*)(F.ws + WS_S); bf16* MIX = (bf16*)(F.ws + WS_H);
    const int gt = F.vcu * NTHREADS + F.tid, ngt = F.G * NTHREADS;
    for (int idx = gt; idx < NB * CTXL * 128; idx += ngt) {
        const int r = idx >> 7, c8 = (idx & 127) * 8; const size_t row = (size_t)(r >> 8) * TPB + (r & 255); float s[8] = {0.f, 0.f, 0.f, 0.f, 0.f, 0.f, 0.f, 0.f};
#pragma unroll
        for (int k = 0; k < 4; ++k) { const v4u w = *(const GAS v4u*)(S + row * 4096 + k * 1024 + c8);
            s[0] += bflo(w.x); s[1] += bfhi(w.x); s[2] += bflo(w.y); s[3] += bfhi(w.y); s[4] += bflo(w.z); s[5] += bfhi(w.z); s[6] += bflo(w.w); s[7] += bfhi(w.w); }
        v4u o; o.x = pk2(s[0], s[1]); o.y = pk2(s[2], s[3]); o.z = pk2(s[4], s[5]); o.w = pk2(s[6], s[7]);
        *(GAS v4u*)(MIX + row * 1024 + c8) = o;
    }
}
namespace att {
typedef short bf16x8 __attribute__((ext_vector_type(8)));
typedef short s16x4 __attribute__((ext_vector_type(4)));
typedef short v4i16_t __attribute__((ext_vector_type(4)));
typedef float f32x16 __attribute__((ext_vector_type(16)));
typedef unsigned u32x4 __attribute__((ext_vector_type(4)));
typedef __attribute__((address_space(3))) const char* lds_cptr;
typedef float f32x2_t __attribute__((ext_vector_type(2))); typedef __bf16 bf16x2_t __attribute__((ext_vector_type(2)));
__device__ __forceinline__ int crow(int r, int hi) { return (r & 3) + 8 * (r >> 2) + 4 * hi; }
__device__ __forceinline__ void glds16(const void* gsrc, unsigned lds_dst) { unsigned keep;
    asm volatile("s_mov_b32 %0, m0\n\ts_mov_b32 m0, %2\n\ts_nop 0\n\tglobal_load_lds_dwordx4 %1, off\n\ts_mov_b32 m0, %0" : "=&s"(keep) : "v"(gsrc), "s"(lds_dst) : "memory"); }
__device__ __forceinline__ unsigned cvtpk(float lo, float hi) { f32x2_t v = {lo, hi}; bf16x2_t b = __builtin_convertvector(v, bf16x2_t); return __builtin_bit_cast(unsigned, b); }
__device__ __forceinline__ s16x4 vtr(lds_cptr p) { return __builtin_bit_cast(s16x4, __builtin_amdgcn_ds_read_tr16_b64_v4i16((__attribute__((address_space(3))) v4i16_t*)p)); }
__device__ __forceinline__ float halfswap_max(float m) { auto rr = __builtin_amdgcn_permlane32_swap(__float_as_uint(m), __float_as_uint(m), false, false); return fmaxf(__uint_as_float(rr[0]), __uint_as_float(rr[1])); }
__device__ __forceinline__ float halfswap_sum(float m) { auto rr = __builtin_amdgcn_permlane32_swap(__float_as_uint(m), __float_as_uint(m), false, false); return __uint_as_float(rr[0]) + __uint_as_float(rr[1]); }

template <int DQK> struct Cfg {
    static constexpr int KCH = DQK / 8, KSLOT = KCH * 1024, NKI = (KCH + 7) / 8, NI = NKI + 1;
    static constexpr int LDS_K = 0, LDS_V = 3 * KSLOT, LDS_WS = LDS_V + 3 * 8192, LDS_OST = LDS_WS + 8 * 256, BYTES = LDS_OST + 8 * 4096;
};
#define ATT_WAIT_BAR(N) asm volatile("s_waitcnt vmcnt(" #N ") lgkmcnt(0)\n\ts_barrier" ::: "memory")

struct UnitDesc {
    const unsigned short* Q; int qp;
    const unsigned short* K; int kp;
    const unsigned short* V; int vp;
    unsigned short* Y;
    int NT;
    int lat_row0;
    int qpos0, spos0;
    int has_sink; float sink2;
};

constexpr float ATT_THR = 6.0f;
template <int DQK, bool SWA>
__device__ __forceinline__ void attn_unit(LAS unsigned char* ldsb, const UnitDesc& U, const int tid) {
    using C = Cfg<DQK>;
    const int lane = tid & 63, r32 = lane & 31, hi = lane >> 5; const int wid = __builtin_amdgcn_readfirstlane(tid >> 6);
    const unsigned lds0 = (unsigned)(uintptr_t)ldsb;
    LAS float* wsf = (LAS float*)(ldsb + C::LDS_WS) + wid * 64;
    const int kp = U.kp, vp = U.vp;
    const int kc1 = (C::NKI == 2 && wid < 4) ? wid + 8 : wid;
    const unsigned short* ksrc0 = U.K + (size_t)lane * kp + wid * 8;
    const unsigned short* ksrc1 = U.K + (size_t)lane * kp + kc1 * 8;
    const unsigned short* vsrc = U.V + (size_t)(16 * (wid & 3) + (lane >> 2)) * vp + (wid >> 2) * 32 + (lane & 3) * 8;
    const unsigned kdst0 = lds0 + C::LDS_K + wid * 1024, kdst1 = lds0 + C::LDS_K + kc1 * 1024, vdst = lds0 + C::LDS_V + wid * 1024;
    const int NT = U.NT;
#define ATT_KROW(t) (SWA ? ((t) < 4 ? 64 * (t) : U.lat_row0 + 64 * ((t) - 4)) : 64 * (t))
#define ATT_DMA_K(t, slot) do { const size_t ro_ = (size_t)ATT_KROW(t); \
        glds16(ksrc0 + ro_ * kp, (unsigned)__builtin_amdgcn_readfirstlane(kdst0 + (slot) * C::KSLOT)); \
        if (C::NKI == 2) glds16(ksrc1 + ro_ * kp, (unsigned)__builtin_amdgcn_readfirstlane(kdst1 + (slot) * C::KSLOT)); } while (0)
#define ATT_DMA_V(t, slot) do { const size_t ro_ = (size_t)ATT_KROW(t); glds16(vsrc + ro_ * vp, (unsigned)__builtin_amdgcn_readfirstlane(vdst + (slot) * 8192)); } while (0)
#define ATT_KLOAD(kslot) do { if (!SWA) { const lds_cptr kb_ = (lds_cptr)(ldsb + C::LDS_K) + (kslot) * C::KSLOT + hi * 1024 + r32 * 16; \
        _Pragma("unroll") for (int d0 = 0; d0 < DQK / 16; ++d0) { kf[2 * d0] = *(const __attribute__((address_space(3))) bf16x8*)(kb_ + d0 * 2048); kf[2 * d0 + 1] = *(const __attribute__((address_space(3))) bf16x8*)(kb_ + d0 * 2048 + 512); } } } while (0)
#define ATT_QKM(P0, P1, CINIT, kslot) do { { const float ci_ = (CINIT); _Pragma("unroll") for (int r = 0; r < 16; ++r) { P0[r] = ci_; P1[r] = ci_; } } \
        const lds_cptr kq_ = (lds_cptr)(ldsb + C::LDS_K) + (kslot) * C::KSLOT + hi * 1024 + r32 * 16; \
        _Pragma("unroll") for (int d0 = 0; d0 < DQK / 16; ++d0) { \
            const bf16x8 b0_ = SWA ? *(const __attribute__((address_space(3))) bf16x8*)(kq_ + d0 * 2048) : kf[2 * d0]; const bf16x8 b1_ = SWA ? *(const __attribute__((address_space(3))) bf16x8*)(kq_ + d0 * 2048 + 512) : kf[2 * d0 + 1]; \
            P0 = __builtin_amdgcn_mfma_f32_32x32x16_bf16(b0_, qr[d0], P0, 0, 0, 0); P1 = __builtin_amdgcn_mfma_f32_32x32x16_bf16(b1_, qr[d0], P1, 0, 0, 0); } } while (0)
#define ATT_VLOAD(vslot) do { if (!SWA) { const lds_cptr vb_ = (lds_cptr)(ldsb + C::LDS_V) + (vslot) * 8192 + ((lane >> 4) & 1) * 32 + (lane & 3) * 8 + (4 * hi + ((lane & 15) >> 2)) * 64; \
        _Pragma("unroll") for (int i = 0; i < 8; ++i) { vl[i] = vtr(vb_ + (i >> 2) * 4096 + (i & 3) * 1024); vh[i] = vtr(vb_ + (i >> 2) * 4096 + (i & 3) * 1024 + 512); } } } while (0)
#define ATT_MX3(a, b, c) __builtin_fmaxf(__builtin_fmaxf((a), (b)), (c))
#define ATT_SMPV(P0, P1, N0, N1, HASNEXT, t, vslot) do { \
        if (SWA) { const bool mk_ = ((t) >= 4) && (U.qpos0 >= 0); const int sb_ = U.spos0 + 64 * ((t) - 4) + 4 * hi; \
            _Pragma("unroll") for (int r = 0; r < 16; ++r) { const int dd_ = qpos - (sb_ + (r & 3) + 8 * (r >> 2)); \
                P0[r] = (mk_ && (dd_ > 128 || dd_ < -128)) ? -INFINITY : P0[r]; P1[r] = (mk_ && (dd_ - 32 > 128 || dd_ - 32 < -128)) ? -INFINITY : P1[r]; } } \
        float ra_ = ATT_MX3(P0[0], P0[1], P1[0]), rb_ = ATT_MX3(P0[2], P0[3], P1[1]); ra_ = ATT_MX3(ra_, P1[2], P1[3]); \
        _Pragma("unroll") for (int r = 4; r < 16; r += 4) { ra_ = ATT_MX3(ra_, P0[r], P0[r + 1]); rb_ = ATT_MX3(rb_, P0[r + 2], P0[r + 3]); ra_ = ATT_MX3(ra_, P1[r], P1[r + 1]); rb_ = ATT_MX3(rb_, P1[r + 2], P1[r + 3]); } \
        float rm_ = halfswap_max(__builtin_fmaxf(ra_, rb_)); \
        if (__builtin_expect(__any(rm_ > ATT_THR), 0)) { \
            const float dl_ = __builtin_fmaxf(rm_, 0.f); m += dl_; const float alpha_ = __builtin_amdgcn_exp2f(-dl_); l *= alpha_; \
            _Pragma("unroll") for (int r = 0; r < 16; ++r) { P0[r] -= dl_; P1[r] -= dl_; } \
            if (HASNEXT) { _Pragma("unroll") for (int r = 0; r < 16; ++r) { N0[r] -= dl_; N1[r] -= dl_; } } \
            if (hi == 0) wsf[r32] = alpha_; \
            asm volatile("s_waitcnt lgkmcnt(0)" ::: "memory"); \
            _Pragma("unroll") for (int r = 0; r < 16; ++r) { const float f_ = wsf[crow(r, hi)]; o[0][r] *= f_; o[1][r] *= f_; } } \
        float ls_ = 0.f; \
        _Pragma("unroll") for (int r = 0; r < 16; ++r) { P0[r] = __builtin_amdgcn_exp2f(P0[r]); P1[r] = __builtin_amdgcn_exp2f(P1[r]); ls_ += P0[r] + P1[r]; } \
        l += ls_; \
        u32x4 pw_[4]; \
        pw_[0] = (u32x4){cvtpk(P0[0], P0[1]), cvtpk(P0[2], P0[3]), cvtpk(P0[4], P0[5]), cvtpk(P0[6], P0[7])}; \
        pw_[1] = (u32x4){cvtpk(P0[8], P0[9]), cvtpk(P0[10], P0[11]), cvtpk(P0[12], P0[13]), cvtpk(P0[14], P0[15])}; \
        pw_[2] = (u32x4){cvtpk(P1[0], P1[1]), cvtpk(P1[2], P1[3]), cvtpk(P1[4], P1[5]), cvtpk(P1[6], P1[7])}; \
        pw_[3] = (u32x4){cvtpk(P1[8], P1[9]), cvtpk(P1[10], P1[11]), cvtpk(P1[12], P1[13]), cvtpk(P1[14], P1[15])}; \
        const lds_cptr vq_ = (lds_cptr)(ldsb + C::LDS_V) + (vslot) * 8192 + ((lane >> 4) & 1) * 32 + (lane & 3) * 8 + (4 * hi + ((lane & 15) >> 2)) * 64; \
        _Pragma("unroll") for (int d0 = 0; d0 < 2; ++d0) \
            _Pragma("unroll") for (int ks = 0; ks < 4; ++ks) { \
                const s16x4 lo_ = SWA ? vtr(vq_ + d0 * 4096 + ks * 1024) : vl[4 * d0 + ks], hh_ = SWA ? vtr(vq_ + d0 * 4096 + ks * 1024 + 512) : vh[4 * d0 + ks]; \
                const bf16x8 vf_ = (bf16x8){lo_[0], lo_[1], lo_[2], lo_[3], hh_[0], hh_[1], hh_[2], hh_[3]}; \
                o[d0] = __builtin_amdgcn_mfma_f32_32x32x16_bf16(__builtin_bit_cast(bf16x8, pw_[ks]), vf_, o[d0], 0, 0, 0); } } while (0)
#define ATT_STEP(C0, C1, N0, N1, t) do { \
        const int k3_ = (ks1 == 0) ? 2 : ks1 - 1, v2_ = (vs0 == 0) ? 2 : vs0 - 1; \
        if ((t) + 3 < NT) ATT_DMA_K((t) + 3, k3_); \
        if ((t) + 2 < NT) ATT_DMA_V((t) + 2, v2_); \
        ATT_KLOAD(ks1); \
        if (!SWA) __builtin_amdgcn_sched_barrier(0);        \
        ATT_QKM(N0, N1, -m, ks1); \
        ATT_VLOAD(vs0); \
        if (!SWA) __builtin_amdgcn_sched_barrier(0); \
        ATT_SMPV(C0, C1, N0, N1, true, t, vs0); \
        if ((t) + 3 < NT) { if (C::NI == 2) ATT_WAIT_BAR(2); else ATT_WAIT_BAR(3); } else ATT_WAIT_BAR(0); \
        ks1 = (ks1 == 2) ? 0 : ks1 + 1; vs0 = (vs0 == 2) ? 0 : vs0 + 1; } while (0)
    ATT_DMA_K(0, 0);
    ATT_DMA_K(1, 1); ATT_DMA_V(0, 0);
    ATT_DMA_K(2, 2); ATT_DMA_V(1, 1);
    bf16x8 qr[DQK / 16];
    { const unsigned short* qw = U.Q + (size_t)(wid * 32 + r32) * U.qp + hi * 8;
#pragma unroll
      for (int d0 = 0; d0 < DQK / 16; ++d0) qr[d0] = *(const bf16x8*)(qw + d0 * 16); }
    float m = 0.f, l = 0.f;
    f32x16 o[2]; o[0] = f32x16{}; o[1] = f32x16{};
    const int qpos = U.qpos0 + wid * 32 + r32;
    f32x16 pa0, pa1, pb0, pb1;
    bf16x8 kf[DQK / 8]; s16x4 vl[8], vh[8];
    if (C::NI == 2) ATT_WAIT_BAR(4); else ATT_WAIT_BAR(6);
    ATT_KLOAD(0); ATT_QKM(pa0, pa1, 0.f, 0);
    {
      float ra = ATT_MX3(pa0[0], pa0[1], pa1[0]), rb = ATT_MX3(pa0[2], pa0[3], pa1[1]); ra = ATT_MX3(ra, pa1[2], pa1[3]);
#pragma unroll
      for (int r = 4; r < 16; r += 4) { ra = ATT_MX3(ra, pa0[r], pa0[r + 1]); rb = ATT_MX3(rb, pa0[r + 2], pa0[r + 3]); ra = ATT_MX3(ra, pa1[r], pa1[r + 1]); rb = ATT_MX3(rb, pa1[r + 2], pa1[r + 3]); }
      m = halfswap_max(__builtin_fmaxf(ra, rb));
#pragma unroll
      for (int r = 0; r < 16; ++r) { pa0[r] -= m; pa1[r] -= m; } }
    if (C::NI == 2) ATT_WAIT_BAR(2); else ATT_WAIT_BAR(3);
    int ks1 = 1, vs0 = 0;
    int t = 0;
    if (SWA) { for (; t + 1 < NT; ++t) { ATT_STEP(pa0, pa1, pb0, pb1, t); pa0 = pb0; pa1 = pb1; } ATT_SMPV(pa0, pa1, pa0, pa1, false, NT - 1, vs0); }
    else {
    for (; t + 2 < NT; t += 2) { ATT_STEP(pa0, pa1, pb0, pb1, t); ATT_STEP(pb0, pb1, pa0, pa1, t + 1); }
    if (t + 1 < NT) { ATT_STEP(pa0, pa1, pb0, pb1, t); ATT_VLOAD(vs0); ATT_SMPV(pb0, pb1, pb0, pb1, false, NT - 1, vs0); }
    else { ATT_VLOAD(vs0); ATT_SMPV(pa0, pa1, pa0, pa1, false, NT - 1, vs0); }
    }
    l = halfswap_sum(l);
    if (U.has_sink) l += __builtin_amdgcn_exp2f(U.sink2 - m);
    if (hi == 0) wsf[32 + r32] = l;
    asm volatile("s_waitcnt lgkmcnt(0)" ::: "memory");
    { LAS unsigned short* stg = (LAS unsigned short*)(ldsb + C::LDS_OST) + wid * 2048;
#pragma unroll
      for (int r = 0; r < 16; ++r) { const int orow = crow(r, hi); const float rl = __builtin_amdgcn_rcpf(wsf[32 + orow]);
          stg[orow * 64 + r32] = (unsigned short)f2bf(o[0][r] * rl); stg[orow * 64 + 32 + r32] = (unsigned short)f2bf(o[1][r] * rl); }
      asm volatile("s_waitcnt lgkmcnt(0)" ::: "memory");
      unsigned short* yw = U.Y + (size_t)(wid * 32) * 1024;
#pragma unroll
      for (int i = 0; i < 4; ++i) { const int row = i * 8 + (lane >> 3), ch = lane & 7;
          const u32x4 ov = *(const LAS u32x4*)(stg + row * 64 + ch * 8);
          u32x4* gp = (u32x4*)(yw + (size_t)row * 1024 + ch * 8); const u32x4 g = *gp;
          u32x4 w; w.x = pk2(bflo(ov.x) * bflo(g.x), bfhi(ov.x) * bfhi(g.x)); w.y = pk2(bflo(ov.y) * bflo(g.y), bfhi(ov.y) * bfhi(g.y));
          w.z = pk2(bflo(ov.z) * bflo(g.z), bfhi(ov.z) * bfhi(g.z)); w.w = pk2(bflo(ov.w) * bflo(g.w), bfhi(ov.w) * bfhi(g.w));
          *gp = w; } }
    asm volatile("s_waitcnt vmcnt(0) lgkmcnt(0)\n\ts_barrier" ::: "memory");
#undef ATT_KROW
#undef ATT_DMA_K
#undef ATT_DMA_V
#undef ATT_KLOAD
#undef ATT_QKM
#undef ATT_VLOAD
#undef ATT_STEP
#undef ATT_SMPV
#undef ATT_MX3
}
}

__device__ __forceinline__ void ph_attn(Frame& F, int l) {
    unsigned short* ZS = (unsigned short*)(F.ws + WS_ZS); unsigned short* MQ = (unsigned short*)(F.ws + WS_MQ); unsigned short* MKV = (unsigned short*)(F.ws + WS_MKV); unsigned short* MK = (unsigned short*)(F.ws + WS_MK);
    unsigned short* Y = (unsigned short*)(F.ws + WS_G);
    LAS unsigned char* lds = F.lds + RING_OFF;
    const int u = F.vcu;
    const bool ctxq = (l == 0);
    for (int uu = u; uu < 256; uu += F.G) { const int bh = uu >> 4, qb = uu & 15, b = bh >> 2, h = bh & 3; const size_t r0 = (size_t)b * TPB, rq = r0 + CTXL + qb * 256;
        att::UnitDesc U{MQ + rq * 512 + h * 96, 512, MK + r0 * 384 + h * 96, 384, MKV + r0 * 512 + h * 128 + 64, 512, Y + rq * 1024 + h * 64, TPB / 64, 0, -1, 0, 0, 0.f};
        att::attn_unit<96, false>(lds, U, F.tid); }
    for (int uu = u; uu < 256; uu += F.G) { const int qb = uu & 15, g = (uu >> 4) & 1, kvh = (uu >> 5) & 1, b = uu >> 6, qh = kvh * 2 + g; const size_t r0 = (size_t)b * TPB, rq = r0 + CTXL + qb * 256;
        att::UnitDesc U{ZS + rq * ZS_P + ZC_AQ + qh * 64, ZS_P, ZS + r0 * ZS_P + ZC_AK + kvh * 64, ZS_P, ZS + r0 * ZS_P + ZC_AV + kvh * 64, ZS_P, Y + rq * 1024 + 512 + qh * 64, TPB / 64, 0, -1, 0, 0, 0.f};
        att::attn_unit<64, false>(lds, U, F.tid); }
    for (int uu = u; uu < 256; uu += F.G) { const int qb = uu & 15, g = (uu >> 4) & 1, kvh = (uu >> 5) & 1, b = uu >> 6, qh = kvh * 2 + g; const size_t r0 = (size_t)b * TPB, rq = r0 + CTXL + qb * 256;
        const int q0 = qb * 256, s0 = (q0 - 128 < 0) ? 0 : q0 - 128, s1 = (q0 + 384 > SEQ) ? SEQ : q0 + 384;
        att::UnitDesc U{ZS + rq * ZS_P + ZC_SQ + qh * 64, ZS_P, ZS + r0 * ZS_P + ZC_SK + kvh * 64, ZS_P, ZS + r0 * ZS_P + ZC_SV + kvh * 64, ZS_P, Y + rq * 1024 + 256 + qh * 64, 4 + (s1 - s0) / 64, CTXL + s0, q0, s0, 1, F.in(I_SINK)[l * 4 + qh] * LOG2E};
        att::attn_unit<64, true>(lds, U, F.tid); }
    if (ctxq) for (int uu = u; uu < 48; uu += F.G) { const int br = uu >> 4, b = (uu >> 2) & 3, h = uu & 3; const size_t r0 = (size_t)b * TPB;
        if (br == 0) { att::UnitDesc U{MQ + r0 * 512 + h * 96, 512, MK + r0 * 384 + h * 96, 384, MKV + r0 * 512 + h * 128 + 64, 512, Y + r0 * 1024 + h * 64, 4, 0, -1, 0, 0, 0.f};
            att::attn_unit<96, false>(lds, U, F.tid); }
        else if (br == 1) { att::UnitDesc U{ZS + r0 * ZS_P + ZC_SQ + h * 64, ZS_P, ZS + r0 * ZS_P + ZC_SK + (h >> 1) * 64, ZS_P, ZS + r0 * ZS_P + ZC_SV + (h >> 1) * 64, ZS_P, Y + r0 * 1024 + 256 + h * 64, 4, CTXL, -1, 0, 1, F.in(I_SINK)[l * 4 + h] * LOG2E};
            att::attn_unit<64, true>(lds, U, F.tid); }
        else { att::UnitDesc U{ZS + r0 * ZS_P + ZC_AQ + h * 64, ZS_P, ZS + r0 * ZS_P + ZC_AK + (h >> 1) * 64, ZS_P, ZS + r0 * ZS_P + ZC_AV + (h >> 1) * 64, ZS_P, Y + r0 * 1024 + 512 + h * 64, 4, 0, -1, 0, 0, 0.f};
            att::attn_unit<64, false>(lds, U, F.tid); } }
}
constexpr size_t WS_SUM = 253 * MiB;
constexpr size_t WS_HL = WS_U, WS_CP = WS_HF;
constexpr int NCHUNK = TPB / 64;
__device__ __forceinline__ float swap_lo(float x) { auto rr = __builtin_amdgcn_permlane32_swap(__float_as_uint(x), __float_as_uint(x), false, false); return __uint_as_float(rr[0]); }
__device__ __forceinline__ float swap_hi(float x) { auto rr = __builtin_amdgcn_permlane32_swap(__float_as_uint(x), __float_as_uint(x), false, false); return __uint_as_float(rr[1]); }
__device__ __forceinline__ void ph_lru1(Frame& F, int l) {
    typedef short bf16x8 __attribute__((ext_vector_type(8))); typedef float f32x16 __attribute__((ext_vector_type(16)));
    const unsigned short* ZS = (const unsigned short*)(F.ws + WS_ZS); unsigned short* HL = (unsigned short*)(F.ws + WS_HL); unsigned short* CP = (unsigned short*)(F.ws + WS_CP);
    f32x2v* SUM = (f32x2v*)(F.ws + WS_SUM);
    constexpr int UP = 264;
    LAS unsigned short* ul = (LAS unsigned short*)(F.lds + RING_OFF);
    const float* cw = F.in(I_CONVW) + l * 4 * 256; const float* cb = F.in(I_CONVB) + l * 256;
    const int tid = F.tid, lane = tid & 63, r32 = lane & 31, hi = lane >> 5, k = F.wave & 3, d = F.wave >> 2;
    const int nfull = (NB * NCHUNK < F.G) ? NB * NCHUNK : F.G, nhalf = 2 * (NB * NCHUNK - nfull);
    for (int wi = F.vcu; wi < nfull + nhalf; wi += F.G) {
        const int unit = (wi < nfull) ? wi : nfull + ((wi - nfull) >> 1);
        const int tn_lo = (wi < nfull) ? 0 : ((wi - nfull) & 1), tn_hi = (wi < nfull) ? 2 : tn_lo + 1;
        const int b = unit / NCHUNK, ci = unit % NCHUNK;
        int s0row, len, t0; if (ci < 4) { s0row = b * TPB; len = CTXL; t0 = ci * 64; } else { s0row = b * TPB + CTXL; len = SEQ; t0 = (ci - 4) * 64; }
        { const int cc = tid & 255, hh = tid >> 8; float zv[35];
#pragma unroll
          for (int i = 0; i < 35; ++i) { const int tt = t0 + hh * 32 + i - 2; const int tc = tt < 0 ? 0 : (tt >= len ? len - 1 : tt);
              const float v = bf2f(ZS[(size_t)(s0row + tc) * ZS_P + ZC_LRU + cc]); zv[i] = (tt >= 0 && tt < len) ? v : 0.f; }
          const float w0 = cw[cc], w1 = cw[256 + cc], w2 = cw[512 + cc], w3 = cw[768 + cc], bb = cb[cc];
#pragma unroll
          for (int t = 0; t < 32; ++t) ul[(hh * 32 + t) * UP + cc] = (unsigned short)f2bf(bb + w0 * zv[t] + w1 * zv[t + 1] + w2 * zv[t + 2] + w3 * zv[t + 3]); }
        __syncthreads();
#pragma unroll 1
        for (int tn = tn_lo; tn < tn_hi; ++tn) {
            const int c = k * 64 + 32 * tn + r32;
            bf16x8 wf[2][4];
            const float brv = F.in(I_LBR)[(l * 2 + d) * 256 + c], biv = F.in(I_LBI)[(l * 2 + d) * 256 + c], spv = ((const float*)(F.ws + WS_SP))[(l * 2 + d) * 256 + c];
#pragma unroll
            for (int gate = 0; gate < 2; ++gate)
#pragma unroll
                for (int ks = 0; ks < 4; ++ks) { const float* src = (const float*)(F.ws + WS_LWT) + ((((size_t)l * 2 + d) * 2 + gate) * 256 + c) * 64 + 16 * ks + 8 * hi;
                    const f32x4 a = *(const f32x4*)src, b2 = *(const f32x4*)(src + 4);
                    v4u w; w.x = pk2(a.x, a.y); w.y = pk2(a.z, a.w); w.z = pk2(b2.x, b2.y); w.w = pk2(b2.z, b2.w); wf[gate][ks] = __builtin_bit_cast(bf16x8, w); }
            f32x16 A[2], X[2];
            A[0] = f32x16{}; A[1] = f32x16{}; X[0] = f32x16{}; X[1] = f32x16{};
#pragma unroll
            for (int tm = 0; tm < 2; ++tm)
#pragma unroll
                for (int ks = 0; ks < 4; ++ks) { const bf16x8 af = *(const LAS bf16x8*)(ul + (32 * tm + r32) * UP + k * 64 + 16 * ks + 8 * hi);
                    A[tm] = __builtin_amdgcn_mfma_f32_32x32x16_bf16(af, wf[0][ks], A[tm], 0, 0, 0); X[tm] = __builtin_amdgcn_mfma_f32_32x32x16_bf16(af, wf[1][ks], X[tm], 0, 0, 0); }
#pragma unroll
            for (int tm = 0; tm < 2; ++tm)
#pragma unroll
                for (int r = 0; r < 16; ++r) { const int tok = 32 * tm + (r & 3) + 8 * (r >> 2) + 4 * hi; const float uu = bf2f(ul[tok * UP + c]);
                    const float rr = sigmoid_f(A[tm][r] + brv), ii = sigmoid_f(X[tm][r] + biv);
                    const float a = __builtin_amdgcn_exp2f(-rr * spv); A[tm][r] = a; X[tm][r] = __builtin_amdgcn_sqrtf(1.0f - a * a) * (ii * uu);
                    if ((r & 3) == 3) asm volatile("" ::: "memory"); }
#pragma unroll
            for (int tm = 0; tm < 2; ++tm)
#pragma unroll
                for (int rg = 0; rg < 4; ++rg) { const int r0 = 4 * rg;
                    if (d == 0) {
#pragma unroll
                        for (int e2 = 1; e2 < 4; ++e2) { X[tm][r0 + e2] = A[tm][r0 + e2] * X[tm][r0 + e2 - 1] + X[tm][r0 + e2]; A[tm][r0 + e2] = A[tm][r0 + e2] * A[tm][r0 + e2 - 1]; } }
                    else {
#pragma unroll
                        for (int e2 = 2; e2 >= 0; --e2) { X[tm][r0 + e2] = A[tm][r0 + e2] * X[tm][r0 + e2 + 1] + X[tm][r0 + e2]; A[tm][r0 + e2] = A[tm][r0 + e2] * A[tm][r0 + e2 + 1]; } } }
            float enH[8], enP[8]; float EH = 0.f, EP = 1.f;
            if (d == 0) {
#pragma unroll
                for (int q = 0; q < 8; ++q) { const int tm = q >> 2, re = 4 * (q & 3) + 3; const float ce = A[tm][re], he = X[tm][re];
                    const float aH = swap_lo(ce * EH + he), aP = swap_lo(EP * ce);
                    const float E1H = hi ? aH : EH, E1P = hi ? aP : EP;
                    enH[q] = E1H; enP[q] = E1P;
                    EH = swap_hi(ce * E1H + he); EP = swap_hi(E1P * ce); }
            } else {
#pragma unroll
                for (int q = 7; q >= 0; --q) { const int tm = q >> 2, re = 4 * (q & 3); const float ce = A[tm][re], he = X[tm][re];
                    const float aH = swap_hi(ce * EH + he), aP = swap_hi(EP * ce);
                    const float E1H = hi ? EH : aH, E1P = hi ? EP : aP;
                    enH[q] = E1H; enP[q] = E1P;
                    EH = swap_lo(ce * E1H + he); EP = swap_lo(E1P * ce); }
            }
            { const unsigned ob = (unsigned)((((s0row + t0 + 4 * hi) * 2 + d) * 256 + c) * 2);
#pragma unroll
              for (int tm = 0; tm < 2; ++tm)
#pragma unroll
                for (int rg = 0; rg < 4; ++rg) { const int q = 4 * tm + rg;
#pragma unroll
                    for (int e2 = 0; e2 < 4; ++e2) { const int r = 4 * rg + e2; const unsigned o = ob + (unsigned)(32 * tm + 8 * rg + e2) * 1024u;
                        *(unsigned short*)((char*)HL + o) = (unsigned short)f2bf(X[tm][r] + A[tm][r] * enH[q]); *(unsigned short*)((char*)CP + o) = (unsigned short)f2bf(A[tm][r] * enP[q]); }
                    asm volatile("" ::: "memory"); } }
            if (hi == 0) SUM[((size_t)(b * NCHUNK + ci) * 2 + d) * 256 + c] = (f32x2v){EP, EH};
        }
        __syncthreads();
    }
}
constexpr size_t WS_CARRY = 255 * MiB;
__device__ __forceinline__ void ph_lru_carry(Frame& F) {
    if (F.vcu < 4) {
        const int g = F.vcu * NTHREADS + F.tid, b = g >> 9, d = (g >> 8) & 1, c = g & 255;
        const f32x2v* sb = (const f32x2v*)(F.ws + WS_SUM) + ((size_t)b * NCHUNK * 2 + d) * 256 + c;
        float* cr = (float*)(F.ws + WS_CARRY) + ((size_t)b * NCHUNK * 2 + d) * 256 + c;
        float h = 0.f;
#pragma unroll 1
        for (int p0 = 0; p0 < NCHUNK; p0 += 17) {
            f32x2v s[17];
#pragma unroll
            for (int i = 0; i < 17; ++i) { const int p = p0 + i, j = (d == 0) ? p : (p < 4 ? 3 - p : NCHUNK + 3 - p); s[i] = sb[(size_t)j * 512]; }
#pragma unroll
            for (int i = 0; i < 17; ++i) { const int p = p0 + i, j = (d == 0) ? p : (p < 4 ? 3 - p : NCHUNK + 3 - p); cr[(size_t)j * 512] = h; h = s[i].x * h + s[i].y; }
        }
    }
}
__device__ __forceinline__ void ph_lru2(Frame& F, int l) {
    const unsigned short* HL = (const unsigned short*)(F.ws + WS_HL); const unsigned short* CP = (const unsigned short*)(F.ws + WS_CP);
    const float* CARRY = (const float*)(F.ws + WS_CARRY); unsigned short* Y = (unsigned short*)(F.ws + WS_G);
    const int tid = F.tid, cg = tid & 31, tq = tid >> 5; const bool last = (l == NLAYER - 1);
    for (int unit = F.vcu; unit < NB * NCHUNK; unit += F.G) {
        const int b = unit / NCHUNK, ci = unit % NCHUNK;
        if (last && ci < 4) continue;
        const float* cp0 = CARRY + ((size_t)(b * NCHUNK + ci) * 2) * 256 + cg * 8;
        const f32x4 cfa = *(const f32x4*)cp0, cfb = *(const f32x4*)(cp0 + 4), cba = *(const f32x4*)(cp0 + 256), cbb = *(const f32x4*)(cp0 + 260);
        const float cf[8] = {cfa.x, cfa.y, cfa.z, cfa.w, cfb.x, cfb.y, cfb.z, cfb.w}, cbk[8] = {cba.x, cba.y, cba.z, cba.w, cbb.x, cbb.y, cbb.z, cbb.w};
        v4u hf[4], pf[4], hb[4], pb[4], gg[4];
#pragma unroll
        for (int i = 0; i < 4; ++i) { const size_t row = (size_t)b * TPB + ci * 64 + tq + 16 * i; const size_t o = (row * 2) * 256 + cg * 8;
            hf[i] = *(const v4u*)(HL + o); pf[i] = *(const v4u*)(CP + o); hb[i] = *(const v4u*)(HL + o + 256); pb[i] = *(const v4u*)(CP + o + 256); gg[i] = *(const v4u*)(Y + row * 1024 + 768 + cg * 8); }
#pragma unroll
        for (int i = 0; i < 4; ++i) { const size_t row = (size_t)b * TPB + ci * 64 + tq + 16 * i;
            unsigned w[4];
#pragma unroll
            for (int e = 0; e < 4; ++e) { const unsigned a = hf[i][e], p = pf[i][e], a2 = hb[i][e], p2 = pb[i][e], g = gg[i][e];
                const float v0 = (bflo(a) + bflo(p) * cf[2 * e] + bflo(a2) + bflo(p2) * cbk[2 * e]) * bflo(g);
                const float v1 = (bfhi(a) + bfhi(p) * cf[2 * e + 1] + bfhi(a2) + bfhi(p2) * cbk[2 * e + 1]) * bfhi(g);
                w[e] = pk2(v0, v1); }
            *(v4u*)(Y + row * 1024 + 768 + cg * 8) = (v4u){w[0], w[1], w[2], w[3]}; }
    }
}
namespace pgx {
typedef short bf16x8 __attribute__((ext_vector_type(8)));
typedef float f32x4 __attribute__((ext_vector_type(4)));
typedef unsigned u32x4 __attribute__((ext_vector_type(4)));
typedef unsigned u32x2 __attribute__((ext_vector_type(2)));
constexpr int LP = 72;
constexpr int OPB = 128 * LP * 2;
__device__ __forceinline__ void pgx_unit(LAS unsigned char* lds, const unsigned short* Y, const unsigned short* Wb, const unsigned short* S, unsigned short* MIX, int row0, int n0, int tid) {
    const int lane = tid & 63, wid = __builtin_amdgcn_readfirstlane(tid >> 6), wm = wid & 3, wn = wid >> 2, fr = lane & 15, fq = lane >> 4;
    const int sr0 = tid >> 3, sk = (tid & 7) * 8;
    const unsigned short* ysrc = Y + (size_t)(row0 + sr0) * 1024 + sk;
    const unsigned short* wsrc = Wb + (size_t)(n0 + sr0) * 256 + sk;
    const int ldst = (sr0 * LP + sk) * 2;
    f32x4 acc[2][4], mix[2][4];
#pragma unroll
    for (int a = 0; a < 2; ++a)
#pragma unroll
        for (int b = 0; b < 4; ++b) { acc[a][b] = (f32x4){0.f, 0.f, 0.f, 0.f}; mix[a][b] = (f32x4){0.f, 0.f, 0.f, 0.f}; }
    u32x4 st[4][4];
    const unsigned short* yA = ysrc; const unsigned short* yB = ysrc + 64 * 1024;
    const unsigned short* wA = wsrc; const unsigned short* wB = wsrc + 64 * 256;
    const unsigned short* sp0 = S + (size_t)(row0 + 32 * wm + fr) * 4096 + n0 + 64 * wn + 4 * fq; const unsigned short* sp1 = sp0 + (size_t)16 * 4096;
#define PGX_LOADQ(set_, yo_, wp0_, wp1_, wo_) do { st[set_][0] = *(const u32x4*)(yA + (yo_)); st[set_][1] = *(const u32x4*)(yB + (yo_)); st[set_][2] = *(const u32x4*)((wp0_) + (wo_)); st[set_][3] = *(const u32x4*)((wp1_) + (wo_)); } while (0)
#define PGX_STORE(buf_, set_) do { LAS unsigned char* b_ = lds + (buf_) * 2 * OPB + ldst; \
        *(LAS u32x4*)b_ = st[set_][0]; *(LAS u32x4*)(b_ + 64 * LP * 2) = st[set_][1]; *(LAS u32x4*)(b_ + OPB) = st[set_][2]; *(LAS u32x4*)(b_ + OPB + 64 * LP * 2) = st[set_][3]; } while (0)
    u32x2 sga[2][4];
    PGX_LOADQ(0, 0, wA, wB, 0); PGX_LOADQ(1, 64, wA, wB, 64); PGX_LOADQ(2, 128, wA, wB, 128);
    PGX_STORE(0, 0);
    __syncthreads();
#define PGX_COMPUTE(h_) do { const LAS unsigned char* yb = lds + ((h_) & 1) * 2 * OPB + ((32 * wm + fr) * LP + 8 * fq) * 2; const LAS unsigned char* wb = lds + ((h_) & 1) * 2 * OPB + OPB + ((64 * wn + fr) * LP + 8 * fq) * 2; \
          _Pragma("unroll") for (int ks = 0; ks < 2; ++ks) { \
              bf16x8 yf[2], wf[4]; \
              _Pragma("unroll") for (int tt = 0; tt < 2; ++tt) yf[tt] = *(const LAS bf16x8*)(yb + (16 * tt * LP + 32 * ks) * 2); \
              _Pragma("unroll") for (int nt = 0; nt < 4; ++nt) wf[nt] = *(const LAS bf16x8*)(wb + (16 * nt * LP + 32 * ks) * 2); \
              _Pragma("unroll") for (int tt = 0; tt < 2; ++tt) \
                  _Pragma("unroll") for (int nt = 0; nt < 4; ++nt) acc[tt][nt] = __builtin_amdgcn_mfma_f32_16x16x32_bf16(wf[nt], yf[tt], acc[tt][nt], 0, 0, 0); } } while (0)
#pragma unroll 1
    for (int kk = 0; kk < 4; ++kk) {
        const bool more = kk < 3;
        const unsigned short* wnA = more ? wA + (size_t)1024 * 256 : wsrc; const unsigned short* wnB = more ? wB + (size_t)1024 * 256 : wsrc + 64 * 256;
        const int yo = more ? 256 : -768;
#pragma unroll
        for (int nt = 0; nt < 4; ++nt) { sga[0][nt] = *(const u32x2*)(sp0 + 16 * nt); sga[1][nt] = *(const u32x2*)(sp1 + 16 * nt); }
        PGX_LOADQ(3, 192, wA, wB, 192); PGX_COMPUTE(0); PGX_STORE(1, 1); __syncthreads();
        PGX_LOADQ(0, yo, wnA, wnB, 0); PGX_COMPUTE(1); PGX_STORE(0, 2); __syncthreads();
        PGX_LOADQ(1, yo + 64, wnA, wnB, 64); PGX_COMPUTE(2); PGX_STORE(1, 3); __syncthreads();
        PGX_LOADQ(2, yo + 128, wnA, wnB, 128); PGX_COMPUTE(3);
#pragma unroll
        for (int tt = 0; tt < 2; ++tt)
#pragma unroll
            for (int nt = 0; nt < 4; ++nt) { const u32x2 g = sga[tt][nt]; const f32x4 a = acc[tt][nt];
                mix[tt][nt] += (f32x4){a[0] * bflo(g.x), a[1] * bfhi(g.x), a[2] * bflo(g.y), a[3] * bfhi(g.y)}; acc[tt][nt] = (f32x4){0.f, 0.f, 0.f, 0.f}; }
        if (more) PGX_STORE(0, 0);
        __syncthreads();
        yA += 256; yB += 256; wA = wnA; wB = wnB; sp0 += 1024; sp1 += 1024;
    }
#pragma unroll
    for (int tt = 0; tt < 2; ++tt)
#pragma unroll
        for (int nt = 0; nt < 4; ++nt) { const f32x4 v = mix[tt][nt]; u32x2 w; w.x = pk2(v[0], v[1]); w.y = pk2(v[2], v[3]);
            *(u32x2*)(MIX + (size_t)(row0 + 32 * wm + 16 * tt + fr) * 1024 + n0 + 64 * wn + 16 * nt + 4 * fq) = w; }
#undef PGX_LOADQ
#undef PGX_STORE
#undef PGX_COMPUTE
}
}
__device__ __forceinline__ void ph_pgx(Frame& F, int l) {
    const unsigned short* Y = (const unsigned short*)(F.ws + WS_G); const unsigned short* S = (const unsigned short*)(F.ws + WS_S); unsigned short* MIX = (unsigned short*)(F.ws + WS_H);
    const unsigned short* Wb = (const unsigned short*)(F.ws + WS_W + (size_t)l * W_LAYER + WO_WB);
    const bool last = (l == NLAYER - 1);
    const int nrt = last ? 128 : NROWS / 128;
    for (int u = F.vcu; u < nrt * 8; u += F.G) {
        int rt = u >> 3; const int ct = u & 7;
        if (last) rt = rt + 2 * (rt / 32) + 2;
        pgx::pgx_unit(F.lds + RING_OFF, Y, Wb, S, MIX, rt * 128, ct * 128, F.tid);
    }
}
constexpr int NPL = 10;
enum { PH_H = 0, PH_G1, PH_POST1, PH_G2, PH_POST2, PH_ATT, PH_SG, PH_PG, PH_MIX, PH_OG };
constexpr int NPHASES = 1 + NLAYER * NPL;
#ifndef NAIVE_ATT
#define NAIVE_ATT 0
#endif
#ifndef PROBE_MASK
#define PROBE_MASK 0
#endif
#ifndef PROBE_LAYERS
#define PROBE_LAYERS 3
#endif
#ifndef PHMASK
#define PHMASK 16383
#endif
#ifndef MK_ONE_LAUNCH
#define MK_ONE_LAUNCH 1
#endif

__global__ void __launch_bounds__(NTHREADS, 2) fwd_kernel(Args args) {
    extern __shared__ __attribute__((aligned(16))) unsigned char lds_raw[];
    { LAS unsigned char* l0 = (LAS unsigned char*)lds_raw;
      for (int u = threadIdx.x; u < (LDS_BYTES - LDSCTL_OFF) / 4; u += NTHREADS) ((LAS unsigned*)(l0 + LDSCTL_OFF))[u] = 0u;
      __syncthreads();
      if (args.ph_hi - args.ph_lo > 1) (void)xcd_barrier_post((unsigned*)((gu32*)(args.ws + WS_CTL) + CW_BAR), (volatile LAS unsigned*)(l0 + MISC_OFF) + 8); }

    unsigned long long tacc = 0ull;
    for (int ph = args.ph_lo; ph < args.ph_hi; ++ph) {
        unsigned long long tph0 = 0ull; bool probed = false;
        if (PROBE_MASK) { const int pl = (ph == 0) ? 0 : (ph - 1) / NPL, pp = (ph == 0) ? 10 : (ph - 1) % NPL; probed = ((PROBE_MASK >> pp) & 1) && ((PROBE_LAYERS >> pl) & 1); if (probed) tph0 = __builtin_amdgcn_s_memrealtime(); }
        int z; asm volatile("s_mov_b32 %0, 0" : "=s"(z));
        Frame F;
        F.lds = (LAS unsigned char*)lds_raw + z; F.kin = (const float* const __attribute__((address_space(4)))*)((const __attribute__((address_space(4))) char*)__builtin_amdgcn_kernarg_segment_ptr() + z); F.ws = args.ws + z; F.out = args.out + z; F.z = z;
        F.tid = threadIdx.x + z; F.lane = F.tid & 63; F.wave = __builtin_amdgcn_readfirstlane(F.tid >> 6);
        F.G = gridDim.x + z; { const int bx = blockIdx.x + z; F.vcu = (F.G % 8 == 0) ? (bx % 8) * (F.G / 8) + bx / 8 : bx; }
        F.gw = F.vcu * NWAVES + F.wave; F.NGW = F.G * NWAVES;
        bool is_gemm = false;
        pg8::Gemm g{nullptr, nullptr, NROWS, 256, 1024, 1024, 31, 0};
        pg8::Order S; S.init(1, 1, F.G, (int)blockIdx.x + z, 0);
        pg8::EpiU E{pg8::EM_PLAIN, 0, F.ws, nullptr, nullptr, nullptr, 0, 0, 0, 0, 1 << 20};
        if (ph == 0) { if (PHMASK & 8192) p0_prologue(F); }
        else {
            const int l = (ph - 1) / NPL, p = (ph - 1) % NPL;
            unsigned char* wl = F.ws + WS_W + (size_t)l * W_LAYER;
            const bool last = (l == NLAYER - 1);
            const int nMc = last ? 64 : NROWS / 256, lat = last ? 1 : 0;
            E.l = l;
            if (p == PH_H && (PHMASK & 1)) { ph_hnorm(F, l); }
            else if (p == PH_G1 && (PHMASK & 2)) {
                is_gemm = true; g.A = (const bf16*)(F.ws + WS_H); g.Bt = (const bf16*)(wl + WO_W1); g.N = N1; g.K = 1024; g.lda = 1024;
                S.init(NROWS / 256, N1 / 256, F.G, (int)blockIdx.x + z, 0);
                E.mode = pg8::EM_SILU2; E.oA = WS_ZS; E.ldc = ZS_P; E.oB = WS_G; E.ldc2 = 1024; E.split_tile = 7;
            }
            else if (p == PH_POST1 && (PHMASK & 4)) { ph_lru1(F, l); ph_post1(F, l); }
            else if (p == PH_G2 && (PHMASK & 8)) {
                is_gemm = true; g.A = (const bf16*)(F.ws + WS_ZS); g.Bt = (const bf16*)(wl + WO_UQ); g.N = 1024; g.K = 256; g.lda = ZS_P; g.a_shift = 1; g.a_step = 512;
                S.init(NROWS / 256, 4, F.G, (int)blockIdx.x + z, 0);
                E.mode = pg8::EM_PLAIN; E.oA = WS_MQ; E.ldc = 512; E.oB = WS_MKV; E.ldc2 = 512; E.split_tile = 2;
            }
            else if (p == PH_POST2 && (PHMASK & 16)) { ph_lru_carry(F); ph_post2(F, l); }
            else if (p == PH_ATT && (PHMASK & 32)) {
#if NAIVE_ATT
                ph_attn_naive(F, l);
#else
                ph_attn(F, l);
#endif
                ph_lru2(F, l); }
            else if (p == PH_SG && (PHMASK & 512)) {
                is_gemm = true; g.A = (const bf16*)(F.ws + WS_H); g.Bt = (const bf16*)(wl + WO_W1) + (size_t)N1 * 1024; g.N = 4096; g.K = 1024; g.lda = 1024;
                S.init(nMc, 16, F.G, (int)blockIdx.x + z, lat);
                E.mode = pg8::EM_SIG; E.oA = WS_S; E.ldc = 4096;
            }
            else if (p == PH_PG && (PHMASK & 1024)) { ph_pgx(F, l); }
            else if (p == PH_MIX) { }
            else if (p == PH_OG && (PHMASK & 4096)) {
                is_gemm = true; g.A = (const bf16*)(F.ws + WS_H); g.Bt = (const bf16*)(wl + WO_WO); g.N = 1024; g.K = 1024; g.lda = 1024;
                S.init(nMc, 4, F.G, (int)blockIdx.x + z, lat);
                E.mode = pg8::EM_RES; E.xin = (l == 0) ? F.in(I_X) : (const float*)F.out; E.xout = F.out; E.cin0 = F.in(I_CTX); E.oA = WS_MOD; E.oB = WS_CTX1;
            }
        }
        if (is_gemm) pg8::gemm_phase<pg8::EpiU, pg8::Order, true, true>(F.lds + RING_OFF, g, S, E, F.tid);
        const bool empty_phase = (ph > 0) && ((ph - 1) % NPL == PH_MIX);
        if (ph + 1 < args.ph_hi && !empty_phase) {
            int z2; asm volatile("s_mov_b32 %0, 0" : "=s"(z2));
            XcdBarrier bar; bar.bar = (unsigned*)((gu32*)(args.ws + z2 + WS_CTL) + CW_BAR); bar.x = xb_xcc_id(); bar.st = (volatile LAS unsigned*)((LAS unsigned char*)lds_raw + z2 + MISC_OFF) + 8;
            xcd_barrier(bar);
        }
        if (PROBE_MASK) { if (probed) tacc += __builtin_amdgcn_s_memrealtime() - tph0; }
    }
#ifdef EXTRA_BARRIERS
    for (int xb = 0; xb < EXTRA_BARRIERS; ++xb) { int z3; asm volatile("s_mov_b32 %0, 0" : "=s"(z3));
        XcdBarrier bar; bar.bar = (unsigned*)((gu32*)(args.ws + z3 + WS_CTL) + CW_BAR); bar.x = xb_xcc_id(); bar.st = (volatile LAS unsigned*)((LAS unsigned char*)lds_raw + z3 + MISC_OFF) + 8;
        xcd_barrier(bar); }
#endif
    if (PROBE_MASK) { const unsigned long long t0 = __builtin_amdgcn_s_memrealtime(); while (__builtin_amdgcn_s_memrealtime() - t0 < tacc) __builtin_amdgcn_s_sleep(8); }
}

extern "C" void kernel_launch(void* const* d_in, const int* in_sizes, int n_in, void* d_out, int out_size, void* d_ws, size_t ws_size, hipStream_t stream) {
    static int grid = 0;
    if (grid == 0) {
        if (n_in != 28 || out_size != NB * SEQ * DM || ws_size < WS_END) { fprintf(stderr, "kernel_launch: unexpected shapes (n_in %d out %d ws %zu); nothing launched\n", n_in, out_size, ws_size); grid = -1; return; }
        int dev = 0, cus = 0, per_cu = 0;
        if (hipGetDevice(&dev) != hipSuccess || hipDeviceGetAttribute(&cus, hipDeviceAttributeMultiprocessorCount, dev) != hipSuccess) { grid = -1; return; }
        if (hipFuncSetAttribute((const void*)fwd_kernel, hipFuncAttributeMaxDynamicSharedMemorySize, LDS_BYTES) != hipSuccess) { fprintf(stderr, "kernel_launch: hipFuncSetAttribute failed\n"); grid = -1; return; }
        if (hipOccupancyMaxActiveBlocksPerMultiprocessor(&per_cu, (const void*)fwd_kernel, NTHREADS, LDS_BYTES) != hipSuccess || per_cu < 1) { fprintf(stderr, "kernel_launch: occupancy query says %d\n", per_cu); (void)hipGetLastError(); grid = -1; return; }
        grid = cus;
    }
    if (grid < 0) return;
    (void)hipMemsetAsync((char*)d_ws + WS_CTL, 0, CTL_ZERO_BYTES, stream);
    Args a{};
    for (int i = 0; i < 28; ++i) a.in[i] = (const float*)d_in[i];
    a.out = (float*)d_out; a.ws = (unsigned char*)d_ws;
#if MK_ONE_LAUNCH
    a.ph_lo = 0; a.ph_hi = NPHASES;
    hipLaunchKernelGGL(fwd_kernel, dim3(grid), dim3(NTHREADS), LDS_BYTES, stream, a);
#else
    for (int ph = 0; ph < NPHASES; ++ph) { a.ph_lo = ph; a.ph_hi = ph + 1; hipLaunchKernelGGL(fwd_kernel, dim3(grid), dim3(NTHREADS), LDS_BYTES, stream, a); }
#endif
}
```

```cpp
#include <hip/hip_runtime.h>
#include <cstdio>
#include <cstdint>
#include <cmath>
__device__ __forceinline__ float bflo(unsigned w) { return __uint_as_float(w << 16); }
__device__ __forceinline__ float bfhi(unsigned w) { return __uint_as_float(w & 0xffff0000u); }
__device__ __forceinline__ float sigmoid_f(float v) { return __builtin_amdgcn_rcpf(1.0f + __builtin_amdgcn_exp2f(-1.4426950408889634f * v)); }
namespace pg8 {
#define PG8_LAS __attribute__((address_space(3)))
typedef unsigned short bf16_t;
typedef short bf16x8 __attribute__((ext_vector_type(8)));
typedef float f32x4 __attribute__((ext_vector_type(4)));
typedef unsigned u32x4 __attribute__((ext_vector_type(4)));
constexpr int BM = 256, BK = 64, HALF = 128, HTB = HALF * BK * 2  , STAGE_BYTES = 8 * HTB, NXCD = 8, WGM = 8;

__host__ __device__ __forceinline__ int lds_byte(int r, int c) { const int st = (r >> 4) * 2 + (c >> 5), rr = r & 15, cc = c & 31, ob = rr * 64 + cc * 2; return st * 1024 + (ob ^ (((ob >> 9) & 1) << 5)); }
__host__ __device__ __forceinline__ void stage_rc(int b, int& R, int& C) { const int st = b / 1024, sb = b % 1024, swz = sb ^ (((sb >> 9) & 1) << 5); R = (st >> 1) * 16 + swz / 64; C = (st & 1) * 32 + (swz % 64) / 2; }
__host__ __device__ __forceinline__ int perm32(int rho) { const int n = rho >> 4, i = rho & 15; return 8 * (i >> 2) + 4 * n + (i & 3); }

struct Unit { int pm, pn; };
struct Gemm { const bf16_t* A; const bf16_t* Bt; int M, N, K, lda; int a_shift, a_step; };

struct StaticOrder {
    int nM, nN, nwg, G, c;
    __host__ __device__ void init(int M, int N, int G_, int c_) { nM = M / BM; nN = N / BM; nwg = nM * nN; G = G_; c = c_; }
    __host__ __device__ bool next(int i, Unit& u) const {
        const long L = (long)i * G + c; if (L >= nwg) return false;
        int wgid = (int)L; { const int q = nwg / NXCD, r = nwg % NXCD, xcd = wgid % NXCD, off = wgid / NXCD; wgid = (xcd < r ? xcd * (q + 1) : r * (q + 1) + (xcd - r) * q) + off; }
        const int nig = WGM * nN, gid = wgid / nig, fm = gid * WGM, gsz = (nM - fm) < WGM ? (nM - fm) : WGM;
        u.pm = fm + ((wgid % nig) % gsz); u.pn = (wgid % nig) / gsz; return true;
    }
    __device__ __forceinline__ void a_ready(const Unit&) const {}
    __device__ __forceinline__ void done(const Unit&) const {}
};

__device__ __forceinline__ unsigned cvt_pk_bf16(float lo, float hi) { unsigned r; asm volatile("v_cvt_pk_bf16_f32 %0, %1, %2" : "=v"(r) : "v"(lo), "v"(hi)); return r; }
enum { EM_PLAIN = 0, EM_SILU2 = 1, EM_SIG = 2, EM_MUL = 3, EM_RES = 4 };
struct EpiU {
    static constexpr bool PERM = true, AFTER_DRAIN = false;
    int mode; int l; unsigned char* ws; const float* xin; float* xout; const float* cin0;
    size_t oA, oB; int ldc, ldc2, split_tile;
    __device__ __forceinline__ void operator()(const f32x4 (&acc)[2][2][4][2], const Unit& u, int wr, int wc, int fr, int fq) const {
        if (mode == EM_RES) {
            const int b = u.pm / 17, t0 = u.pm % 17;
            const float* src; float* dst; const float* gate; const float* modl = (const float*)(ws + oA) + (size_t)l * 5 * 3072;
            if (t0 == 0) { float* c1 = (float*)(ws + oB); src = ((l == 0) ? cin0 : (const float*)c1) + (size_t)b * 256 * 1024; dst = c1 + (size_t)b * 256 * 1024; gate = modl + 4 * 3072 + 2048; }
            else { const size_t o = ((size_t)b * 4096 + (size_t)(t0 - 1) * 256) * 1024; src = xin + o; dst = xout + o; gate = modl + b * 3072 + 2048; }
            const int col0 = u.pn * BM + wc * 32 + 8 * fq;
            const char* srcb = (const char*)src; char* dstb = (char*)dst; const char* gb = (const char*)(gate + col0);
            const unsigned off0 = (unsigned)((wr * 64 + fr) * 1024 + col0) * 4u;
#pragma unroll
            for (int ai = 0; ai < 2; ++ai) {
                f32x4 xo[4][2][2];
#pragma unroll
                for (int m = 0; m < 4; ++m) { const unsigned off = off0 + (unsigned)(ai * HALF + m * 16) * 4096u;
#pragma unroll
                    for (int bj = 0; bj < 2; ++bj)
#pragma unroll
                        for (int n = 0; n < 2; ++n) xo[m][bj][n] = *(const f32x4*)(srcb + (off + (unsigned)(bj * HALF + n * 4) * 4u)); }
#pragma unroll
                for (int m = 0; m < 4; ++m) { const unsigned off = off0 + (unsigned)(ai * HALF + m * 16) * 4096u;
#pragma unroll
                    for (int bj = 0; bj < 2; ++bj)
#pragma unroll
                        for (int n = 0; n < 2; ++n) { const unsigned cb = (unsigned)(bj * HALF + n * 4) * 4u; const f32x4 g = *(const f32x4*)(gb + cb);
                            *(f32x4*)(dstb + (off + cb)) = xo[m][bj][n] + g * acc[ai][bj][m][n]; } }
                asm volatile("" ::: "memory"); }
            return;
        }
        const int row0 = u.pm * BM + wr * 64 + fr; int colt = u.pn * BM; bf16_t* base = (bf16_t*)(ws + oA); int ld = ldc; bool second = false;
        if (u.pn >= split_tile) { base = (bf16_t*)(ws + oB); ld = ldc2; colt -= split_tile * BM; second = true; }
        const bool do_silu = (mode == EM_SILU2) && second;
        const int col0 = colt + wc * 32 + 8 * fq;
        if (mode == EM_MUL) {
            const int kk = u.pn >> 2, jt = u.pn & 3; const bool isctx = (u.pm % 17) == 0;
            bf16_t* mixb = (bf16_t*)(ws + oB); const int mcol0 = jt * BM + wc * 32 + 8 * fq;
            const bool rmw = !isctx && kk > 0;
#pragma unroll
            for (int am = 0; am < 4; ++am) { const int ai = am >> 1, mh = (am & 1) * 2;
                u32x4 old[2][2], prev[2][2];
#pragma unroll
                for (int m2 = 0; m2 < 2; ++m2)
#pragma unroll
                    for (int bj = 0; bj < 2; ++bj) old[m2][bj] = *(const u32x4*)(base + (size_t)(row0 + ai * HALF + (mh + m2) * 16) * ld + col0 + bj * HALF);
                if (rmw) {
#pragma unroll
                    for (int m2 = 0; m2 < 2; ++m2)
#pragma unroll
                        for (int bj = 0; bj < 2; ++bj) prev[m2][bj] = *(const u32x4*)(mixb + (size_t)(row0 + ai * HALF + (mh + m2) * 16) * 1024 + mcol0 + bj * HALF); }
#pragma unroll
                for (int m2 = 0; m2 < 2; ++m2)
#pragma unroll
                    for (int bj = 0; bj < 2; ++bj) { const int m = mh + m2; const f32x4 v0 = acc[ai][bj][m][0], v1 = acc[ai][bj][m][1]; const u32x4 o = old[m2][bj];
                        float t[8] = {v0[0] * bflo(o.x), v0[1] * bfhi(o.x), v0[2] * bflo(o.y), v0[3] * bfhi(o.y), v1[0] * bflo(o.z), v1[1] * bfhi(o.z), v1[2] * bflo(o.w), v1[3] * bfhi(o.w)};
                        if (rmw) { const u32x4 q = prev[m2][bj]; t[0] += bflo(q.x); t[1] += bfhi(q.x); t[2] += bflo(q.y); t[3] += bfhi(q.y); t[4] += bflo(q.z); t[5] += bfhi(q.z); t[6] += bflo(q.w); t[7] += bfhi(q.w); }
                        u32x4 w; w.x = cvt_pk_bf16(t[0], t[1]); w.y = cvt_pk_bf16(t[2], t[3]); w.z = cvt_pk_bf16(t[4], t[5]); w.w = cvt_pk_bf16(t[6], t[7]);
                        if (isctx) *(u32x4*)(base + (size_t)(row0 + ai * HALF + m * 16) * ld + col0 + bj * HALF) = w;
                        else *(u32x4*)(mixb + (size_t)(row0 + ai * HALF + m * 16) * 1024 + mcol0 + bj * HALF) = w; }
                asm volatile("" ::: "memory"); }
            return;
        }
#pragma unroll
        for (int ai = 0; ai < 2; ++ai)
#pragma unroll
            for (int m = 0; m < 4; ++m) { bf16_t* rowp = base + (size_t)(row0 + ai * HALF + m * 16) * ld + col0;
#pragma unroll
                for (int bj = 0; bj < 2; ++bj) { f32x4 v0 = acc[ai][bj][m][0], v1 = acc[ai][bj][m][1];
                    if (mode == EM_SIG) {
#pragma unroll
                        for (int e = 0; e < 4; ++e) { v0[e] = sigmoid_f(v0[e]); v1[e] = sigmoid_f(v1[e]); } }
                    if (do_silu) {
#pragma unroll
                        for (int e = 0; e < 4; ++e) { v0[e] = v0[e] * sigmoid_f(v0[e]); v1[e] = v1[e] * sigmoid_f(v1[e]); } }
                    u32x4 w; w.x = cvt_pk_bf16(v0[0], v0[1]); w.y = cvt_pk_bf16(v0[2], v0[3]); w.z = cvt_pk_bf16(v1[0], v1[1]); w.w = cvt_pk_bf16(v1[2], v1[3]);
                    *(u32x4*)(rowp + bj * HALF) = w; } }
    }
};
struct Order {
    int nM, nN, nwg, G, c, latent_only, grouped, vc, nctx;
    __device__ void init(int nM_, int nN_, int G_, int c_, int lat) { nM = nM_; nN = nN_; nwg = nM * nN; G = G_; c = c_; latent_only = lat; grouped = 0; vc = 0; nctx = 0; }
    __device__ void init_grouped(int G_, int vc_, int with_ctx) { init(64, 4, G_, vc_, 1); grouped = 1; vc = vc_; nctx = with_ctx ? 64 : 0; }
    __device__ bool next(int i, Unit& u) const {
        if (grouped) {
            const int gi = i >> 2, grp = vc + gi * G;
            if (grp < 256) { const int pm = grp >> 2; u.pm = pm + pm / 16 + 1; u.pn = 4 * (i & 3) + (grp & 3); return true; }
            const int done = ((256 - vc + G - 1) / G) * 4;
            const int x = vc + (i - done) * G;
            if (i >= done && x < nctx) { const int g = x >> 2, k = x & 3; u.pm = (g >> 2) * 17; u.pn = 4 * k + (g & 3); return true; }
            return false;
        }
        const long L = (long)i * G + c; if (L >= nwg) return false;
        int wgid = (int)L; { const int q = nwg / NXCD, r = nwg % NXCD, xcd = wgid % NXCD, off = wgid / NXCD; wgid = (xcd < r ? xcd * (q + 1) : r * (q + 1) + (xcd - r) * q) + off; }
        const int nig = WGM * nN, gid = wgid / nig, fm = gid * WGM, gsz = (nM - fm) < WGM ? (nM - fm) : WGM;
        int pm = fm + ((wgid % nig) % gsz); u.pn = (wgid % nig) / gsz; if (latent_only) pm = pm + pm / 16 + 1; u.pm = pm; return true;
    }
    __device__ __forceinline__ void a_ready(const Unit&) const {}
    __device__ __forceinline__ void done(const Unit&) const {}
};
template <class Epi, class Sched, bool ALIGN_EPI = false, bool SP2 = false>
__device__ __forceinline__ void gemm_phase(PG8_LAS unsigned char* lds, const Gemm g, const Sched& S, const Epi& E, const int tid  ) {
    const int wid = __builtin_amdgcn_readfirstlane(tid >> 6), lane = tid & 63, wr = wid >> 2, wc = wid & 3, fr = lane & 15, fq = lane >> 4;
    const int K = g.K, nt = K / BK;
    unsigned voffA[2], voffB[2];
#pragma unroll
    for (int i = 0; i < 2; ++i) { int R, C; stage_rc(tid * 16 + i * 8192, R, C); const int Rb = Epi::PERM ? ((R & ~31) + perm32(R & 31)) : R;
        voffA[i] = (unsigned)(R * g.lda + C) * 2u; voffB[i] = (unsigned)(Rb * K + C) * 2u; }
    const size_t kstep = (size_t)(BK * 2);
    const size_t hstepA = (size_t)HALF * g.lda * 2, hstepB = (size_t)HALF * K * 2;
    const size_t tstepA = 2 * hstepA, tstepB = 2 * hstepB;
    const unsigned ldsw = (unsigned)wid * 1024u;
    const int aoff = lds_byte(wr * 64 + fr, fq * 8), boff = lds_byte(wc * 32 + fr, fq * 8);
#define PG8_SA(b, h) (((b) * 2 + (h)) * HTB)
#define PG8_SB(b, h) ((4 + (b) * 2 + (h)) * HTB)
#define PG8_STAGE(bufoff, gbase, voff) do { _Pragma("unroll") for (int _i = 0; _i < 2; ++_i) \
        __builtin_amdgcn_global_load_lds((const unsigned*)((const char*)(gbase) + (voff)[_i]), (PG8_LAS unsigned*)(lds + (bufoff) + ldsw + _i * 8192), 16, 0, 0); } while (0)
#define PG8_LDA(dst, b, h) do { _Pragma("unroll") for (int m = 0; m < 4; ++m) _Pragma("unroll") for (int k = 0; k < 2; ++k) dst[m][k] = *(const PG8_LAS bf16x8*)(lds + PG8_SA(b, h) + aoff + m * 2048 + k * 1024); } while (0)
#define PG8_LDB(dst, b, h) do { _Pragma("unroll") for (int n = 0; n < 2; ++n) _Pragma("unroll") for (int k = 0; k < 2; ++k) dst[n][k] = *(const PG8_LAS bf16x8*)(lds + PG8_SB(b, h) + boff + n * 2048 + k * 1024); } while (0)
#define PG8_MMA(ai, bj, At, Bt) do { __builtin_amdgcn_s_setprio(1); _Pragma("unroll") for (int m = 0; m < 4; ++m) _Pragma("unroll") for (int n = 0; n < 2; ++n) _Pragma("unroll") for (int k = 0; k < 2; ++k) \
        acc[ai][bj][m][n] = __builtin_amdgcn_mfma_f32_16x16x32_bf16(Bt[n][k], At[m][k], acc[ai][bj][m][n], 0, 0, 0); __builtin_amdgcn_s_setprio(0); } while (0)
#define PG8_WAIT_V(n) asm volatile("s_waitcnt vmcnt(" #n ")" ::: "memory")
#define PG8_WAIT_L(n) asm volatile("s_waitcnt lgkmcnt(" #n ")" ::: "memory")
#define PG8_BAR __builtin_amdgcn_s_barrier()
#define PG8_SCHED __builtin_amdgcn_sched_barrier(0)
    Unit cur, nxt; int ui = 0;
    if (!S.next(0, cur)) return;
    f32x4 acc[2][2][4][2];
#pragma unroll
    for (int a = 0; a < 2; ++a)
#pragma unroll
        for (int b = 0; b < 2; ++b)
#pragma unroll
            for (int m = 0; m < 4; ++m)
#pragma unroll
                for (int n = 0; n < 2; ++n) acc[a][b][m][n] = (f32x4){0.f, 0.f, 0.f, 0.f};
    bf16x8 At[4][2], B0[2][2], B1[2][2];
    const char* cA = (const char*)g.A + (size_t)cur.pm * tstepA + (size_t)(cur.pn >> g.a_shift) * (size_t)g.a_step; const char* cB = (const char*)g.Bt + (size_t)cur.pn * tstepB;
    S.a_ready(cur);
    if constexpr (SP2) {
        PG8_STAGE(PG8_SB(0, 0), cB, voffB); PG8_STAGE(PG8_SB(0, 1), cB + hstepB, voffB); PG8_STAGE(PG8_SA(0, 0), cA, voffA); PG8_STAGE(PG8_SA(0, 1), cA + hstepA, voffA);
        if (wr == 1) PG8_BAR;
        PG8_WAIT_V(2); PG8_BAR;
        PG8_STAGE(PG8_SB(1, 0), cB + kstep, voffB); PG8_STAGE(PG8_SA(1, 0), cA + kstep, voffA); PG8_STAGE(PG8_SB(1, 1), cB + hstepB + kstep, voffB);
        PG8_WAIT_V(6); PG8_BAR;
    } else {
        PG8_STAGE(PG8_SB(0, 0), cB, voffB); PG8_STAGE(PG8_SA(0, 0), cA, voffA); PG8_STAGE(PG8_SB(0, 1), cB + hstepB, voffB); PG8_STAGE(PG8_SA(0, 1), cA + hstepA, voffA);
        if (wr == 1) PG8_BAR;
        PG8_WAIT_V(4); PG8_BAR;
        PG8_STAGE(PG8_SB(1, 0), cB + kstep, voffB); PG8_STAGE(PG8_SA(1, 0), cA + kstep, voffA); PG8_STAGE(PG8_SB(1, 1), cB + hstepB + kstep, voffB);
        PG8_WAIT_V(6); PG8_BAR;
    }
    for (;;) {
        const bool has_next = S.next(ui + 1, nxt);
        const char* nA = has_next ? (const char*)g.A + (size_t)nxt.pm * tstepA + (size_t)(nxt.pn >> g.a_shift) * (size_t)g.a_step : cA; const char* nB = has_next ? (const char*)g.Bt + (size_t)nxt.pn * tstepB : cB;
        for (int t = 0; t < nt; t += 2) {
            const bool last = (t == nt - 2);
            const char* a1 = cA + (size_t)(t + 1) * kstep;
            const char* a2 = last ? nA : cA + (size_t)(t + 2) * kstep; const char* b2 = last ? nB : cB + (size_t)(t + 2) * kstep;
            const char* a3 = a2 + kstep; const char* b3 = b2 + kstep;
            if (last && has_next) S.a_ready(nxt);
            if constexpr (SP2) {
            PG8_LDB(B0, 0, 0); PG8_LDB(B1, 0, 1); PG8_SCHED; PG8_LDA(At, 0, 0); PG8_STAGE(PG8_SA(1, 1), a1 + hstepA, voffA);
            PG8_WAIT_V(8); PG8_WAIT_L(0); PG8_BAR; PG8_MMA(0, 0, At, B0); PG8_MMA(0, 1, At, B1); PG8_BAR; PG8_SCHED;
            PG8_LDA(At, 0, 1); PG8_STAGE(PG8_SB(0, 0), b2, voffB); PG8_STAGE(PG8_SB(0, 1), b2 + hstepB, voffB); PG8_STAGE(PG8_SA(0, 0), a2, voffA);
            PG8_WAIT_V(8); PG8_WAIT_L(0); PG8_BAR; PG8_MMA(1, 0, At, B0); PG8_MMA(1, 1, At, B1); PG8_BAR; PG8_SCHED;
            PG8_LDB(B0, 1, 0); PG8_LDB(B1, 1, 1); PG8_SCHED; PG8_LDA(At, 1, 0); PG8_STAGE(PG8_SA(0, 1), a2 + hstepA, voffA);
            PG8_WAIT_V(8); PG8_WAIT_L(0); PG8_BAR; PG8_MMA(0, 0, At, B0); PG8_MMA(0, 1, At, B1); PG8_BAR; PG8_SCHED;
            PG8_LDA(At, 1, 1); PG8_STAGE(PG8_SB(1, 0), b3, voffB); PG8_STAGE(PG8_SB(1, 1), b3 + hstepB, voffB); PG8_STAGE(PG8_SA(1, 0), a3, voffA);
            PG8_WAIT_V(8); PG8_WAIT_L(0); PG8_BAR; PG8_MMA(1, 0, At, B0); PG8_MMA(1, 1, At, B1); PG8_BAR; PG8_SCHED;
            } else {
            PG8_LDB(B0, 0, 0); PG8_SCHED; PG8_LDA(At, 0, 0); PG8_STAGE(PG8_SA(1, 1), a1 + hstepA, voffA);
            PG8_WAIT_L(8); PG8_BAR; PG8_WAIT_L(0); PG8_MMA(0, 0, At, B0); PG8_BAR; PG8_SCHED;
            PG8_LDB(B1, 0, 1); PG8_STAGE(PG8_SB(0, 0), b2, voffB);
            PG8_BAR; PG8_WAIT_L(0); PG8_MMA(0, 1, At, B1); PG8_BAR;
            PG8_LDA(At, 0, 1); PG8_STAGE(PG8_SA(0, 0), a2, voffA);
            PG8_BAR; PG8_WAIT_L(0); PG8_MMA(1, 0, At, B0); PG8_BAR; PG8_SCHED;
            PG8_STAGE(PG8_SB(0, 1), b2 + hstepB, voffB);
            PG8_WAIT_V(6); PG8_BAR; PG8_MMA(1, 1, At, B1); PG8_BAR;
            PG8_LDB(B0, 1, 0); PG8_SCHED; PG8_LDA(At, 1, 0); PG8_STAGE(PG8_SA(0, 1), a2 + hstepA, voffA);
            PG8_WAIT_L(8); PG8_BAR; PG8_WAIT_L(0); PG8_MMA(0, 0, At, B0); PG8_BAR; PG8_SCHED;
            PG8_LDB(B1, 1, 1); PG8_STAGE(PG8_SB(1, 0), b3, voffB);
            PG8_BAR; PG8_WAIT_L(0); PG8_MMA(0, 1, At, B1); PG8_BAR;
            PG8_LDA(At, 1, 1); PG8_STAGE(PG8_SA(1, 0), a3, voffA);
            PG8_BAR; PG8_WAIT_L(0); PG8_MMA(1, 0, At, B0); PG8_BAR; PG8_SCHED;
            PG8_STAGE(PG8_SB(1, 1), b3 + hstepB, voffB);
            PG8_WAIT_V(6); PG8_BAR; PG8_MMA(1, 1, At, B1); PG8_BAR;
            }
        }
        if constexpr (ALIGN_EPI) { if (wr == 0) PG8_BAR; }
        if constexpr (!Epi::AFTER_DRAIN) { E(acc, cur, wr, wc, fr, fq); S.done(cur); }
        if (!has_next) break;
#pragma unroll
        for (int a = 0; a < 2; ++a)
#pragma unroll
            for (int b = 0; b < 2; ++b)
#pragma unroll
                for (int m = 0; m < 4; ++m)
#pragma unroll
                    for (int n = 0; n < 2; ++n) acc[a][b][m][n] = (f32x4){0.f, 0.f, 0.f, 0.f};
        cur = nxt; cA = nA; cB = nB; ++ui;
        if constexpr (ALIGN_EPI) { if (wr == 1) PG8_BAR; }
    }
    PG8_WAIT_V(0);
    if constexpr (!ALIGN_EPI) { if (wr == 0) PG8_BAR; }
    PG8_BAR;
    if constexpr (Epi::AFTER_DRAIN) { E.fused(acc, cur, wr, wc, fr, fq, lds, wid, lane); S.done(cur); }
#undef PG8_SA
#undef PG8_SB
#undef PG8_STAGE
#undef PG8_LDA
#undef PG8_LDB
#undef PG8_MMA
#undef PG8_WAIT_V
#undef PG8_WAIT_L
#undef PG8_BAR
#undef PG8_SCHED
}
}
#define PG8_SP2 true
#define PG8_ALIGN true
#define GAS __attribute__((address_space(1)))
#define LAS __attribute__((address_space(3)))
typedef unsigned short bf16;
typedef unsigned v4u __attribute__((ext_vector_type(4)));
typedef float f32x4 __attribute__((ext_vector_type(4)));
typedef short bf16x8 __attribute__((ext_vector_type(8)));
typedef GAS unsigned gu32;
typedef GAS unsigned long long gu64;
#define RLX_AGENT __ATOMIC_RELAXED, __HIP_MEMORY_SCOPE_AGENT
#define LDS_WAIT() asm volatile("s_waitcnt lgkmcnt(0)" ::: "memory")
#define VM_WAIT() asm volatile("s_waitcnt vmcnt(0)" ::: "memory")
__device__ __forceinline__ unsigned long long rt() { return __builtin_amdgcn_s_memrealtime(); }
__device__ __forceinline__ unsigned f2bf(float f) { unsigned u = __builtin_bit_cast(unsigned, f); return (u + 0x7fffu + ((u >> 16) & 1u)) >> 16; }
__device__ __forceinline__ unsigned pk2(float lo, float hi) { return f2bf(lo) | (f2bf(hi) << 16); }
#define XB_TMO      128
#define XB_XCNT(j)  (256  + 64 * (j))
#define XB_XSUB(j)  (1280 + 64 * (j))
#define XB_XGEN(j)  (2304 + 64 * (j))
#define XB_TOP      3328
#define XB_TOPGEN   3392
#define XCD_BAR_WORDS 3456
#define XB_SPIN_CAP (1u << 18)

__device__ __forceinline__ unsigned xb_ld(unsigned* p)              { return __hip_atomic_load(p, __ATOMIC_RELAXED, __HIP_MEMORY_SCOPE_AGENT); }
__device__ __forceinline__ unsigned xb_add(unsigned* p, unsigned v) { return __hip_atomic_fetch_add(p, v, __ATOMIC_RELAXED, __HIP_MEMORY_SCOPE_AGENT); }
__device__ __forceinline__ unsigned xb_xcc_id() { return (unsigned)__builtin_amdgcn_s_getreg((3 << 11) | 20) & 0xFu; }
#define XB_SPIN(cond, bar) do { unsigned _sp = 0; while (cond) { __builtin_amdgcn_s_sleep(1); \
    if ((++_sp & 255u) == 0u) { if (xb_ld(&(bar)[XB_TMO])) break; if (_sp > XB_SPIN_CAP) { atomicAdd(&(bar)[XB_TMO], 1u); break; } } } } while (0)

struct XcdBarrier {
    unsigned* bar; unsigned x;
    volatile LAS unsigned* st;
};

__device__ __forceinline__ XcdBarrier xcd_barrier_post(unsigned* bar, volatile LAS unsigned* st) {
    XcdBarrier b; b.bar = bar; b.x = xb_xcc_id(); b.st = st;
    if (threadIdx.x == 0) (void)xb_add(&bar[XB_XCNT(b.x)], 1u);
    return b;
}
__device__ __forceinline__ void xcd_barrier_complete(unsigned* bar, unsigned x, unsigned& nloc, unsigned& nx) {
    const unsigned G = gridDim.x * gridDim.y * gridDim.z;
    unsigned sum, cnt, mine, sp = 0u;
    for (;;) {
        sum = 0u; cnt = 0u; mine = 0u;
#pragma unroll
        for (unsigned j = 0; j < 16; ++j) { const unsigned c = xb_ld(&bar[XB_XCNT(j)]); sum += c; cnt += (c > 0u) ? 1u : 0u; mine = (j == x) ? c : mine; }
        if (sum == G) break;
        __builtin_amdgcn_s_sleep(1);
        if ((++sp & 255u) == 0u) { if (xb_ld(&bar[XB_TMO])) break; if (sp > XB_SPIN_CAP) { atomicAdd(&bar[XB_TMO], 1u); break; } }
    }
    nloc = mine > 0u ? mine : 1u; nx = cnt > 0u ? cnt : 1u;
}

__device__ __forceinline__ void xcd_barrier(const XcdBarrier& b) {
    asm volatile("s_waitcnt vmcnt(0)" ::: "memory");
    __syncthreads();
    if (threadIdx.x == 0) {
        unsigned* bar = b.bar;
        __builtin_amdgcn_s_waitcnt(0);
        unsigned nloc = b.st[0], nx = b.st[1];
        if (nloc == 0u) { xcd_barrier_complete(bar, b.x, nloc, nx); b.st[0] = nloc; b.st[1] = nx; }
        const unsigned old = xb_add(&bar[XB_XSUB(b.x)], 1u);
        const unsigned gen = old / nloc;
        if (old + 1u == (gen + 1u) * nloc) {
            __builtin_amdgcn_fence(__ATOMIC_RELEASE, "agent");
            asm volatile("s_waitcnt vmcnt(0)" ::: "memory");
            const unsigned og = xb_add(&bar[XB_TOP], 1u);
            const unsigned tg = og / nx;
            if (og + 1u == (tg + 1u) * nx) xb_add(&bar[XB_TOPGEN], 1u);
            else XB_SPIN(xb_ld(&bar[XB_TOPGEN]) == tg, bar);
            __builtin_amdgcn_fence(__ATOMIC_ACQUIRE, "agent");
            xb_add(&bar[XB_XGEN(b.x)], 1u);
            asm volatile("s_waitcnt vmcnt(0)" ::: "memory");
        } else {
            XB_SPIN(xb_ld(&bar[XB_XGEN(b.x)]) == gen, bar);
            __builtin_amdgcn_fence(__ATOMIC_ACQUIRE, "agent");
            asm volatile("s_waitcnt vmcnt(0)" ::: "memory");
        }
    }
    __syncthreads();
}
constexpr int NB = 4, SEQ = 4096, CTXL = 256, TPB = SEQ + CTXL, NROWS = NB * TPB, DM = 1024, NLAYER = 2, IN_COLS = 6816;
constexpr int NWAVES = 8, NTHREADS = NWAVES * 64;
constexpr float RMS_EPS = 1e-6f;
constexpr float LOG2E = 1.4426950408889634f;
constexpr float QSCALE64 = 0.125f * LOG2E;
constexpr float QSCALE96 = 0.10206207261596575f * LOG2E;
constexpr int ZS_P = 1792, ZC_CQ = 0, ZC_CKV = 256, ZC_KR = 384, ZC_SQ = 512, ZC_SK = 768, ZC_SV = 896, ZC_AQ = 1024, ZC_AK = 1280, ZC_AV = 1408, ZC_LRU = 1536;
constexpr int N1 = 2816;
constexpr int W1ROWS = N1 + 4096;
constexpr size_t MiB = 1u << 20;
constexpr size_t WS_CTL = 0, CTL_ZERO_BYTES = 64 * 1024;
constexpr size_t WS_MOD = 1 * MiB;
constexpr size_t WS_RHC = 1 * MiB + 256 * 1024, WS_RHS = WS_RHC + 512 * 1024;
constexpr size_t WS_RMC = WS_RHS + 512 * 1024, WS_RMS = WS_RMC + 256 * 1024;
constexpr size_t WS_CTX1 = 3 * MiB;
constexpr size_t WS_W = 8 * MiB, W_LAYER = 18 * MiB;
constexpr size_t WO_W1 = 0, WO_WB = 13 * MiB + 512 * 1024, WO_WO = WO_WB + 2 * MiB, WO_UQ = WO_WO + 2 * MiB, WO_UKV = WO_UQ + 256 * 1024;
constexpr size_t WS_H = 44 * MiB;
constexpr size_t WS_G = 78 * MiB;
constexpr size_t WS_S = 112 * MiB;
constexpr size_t WS_ZS = 112 * MiB;
constexpr size_t WS_MQ = 172 * MiB;
constexpr size_t WS_MKV = 189 * MiB;
constexpr size_t WS_MK = 206 * MiB;
constexpr size_t WS_U = 219 * MiB;
constexpr size_t WS_HF = 236 * MiB;
constexpr size_t WS_SP = 2 * MiB + 768 * 1024;
constexpr size_t WS_LWT = 254 * MiB + 512 * 1024;
constexpr size_t WS_END = 256 * MiB;
static_assert(WS_H + (size_t)NROWS * 1024 * 2 <= WS_G && WS_G + (size_t)NROWS * 1024 * 2 <= WS_S && WS_S + (size_t)NROWS * 4096 * 2 <= 248 * MiB, "ws map");
static_assert(WS_ZS + (size_t)NROWS * ZS_P * 2 <= WS_MQ && WS_MK + (size_t)NROWS * 384 * 2 <= WS_U, "ws map 2");
static_assert(WO_UKV + 512 * 256 * 2 <= W_LAYER, "weights");
constexpr int CW_BAR = 1024;

constexpr int RING_OFF = 0, RING_BYTES = 131072, LDSCTL_OFF = RING_BYTES, MISC_OFF = LDSCTL_OFF + 320, LDS_BYTES = 147456;

typedef unsigned short bf16;
typedef unsigned u32x2 __attribute__((ext_vector_type(2)));
typedef float f32x2v __attribute__((ext_vector_type(2)));
__device__ __forceinline__ float bf2f(bf16 v) { return __uint_as_float((unsigned)v << 16); }
__device__ __forceinline__ float wave_sum(float v) {
#pragma unroll
    for (int o = 1; o < 64; o <<= 1) v += __shfl_xor(v, o);
    return v; }
__device__ __forceinline__ float wave_max(float v) {
#pragma unroll
    for (int o = 1; o < 64; o <<= 1) v = fmaxf(v, __shfl_xor(v, o));
    return v; }
__device__ __forceinline__ float grp16_sum(float v) {
#pragma unroll
    for (int o = 1; o < 16; o <<= 1) v += __shfl_xor(v, o);
    return v; }

struct Args { const float* in[28]; float* out; unsigned char* ws; int ph_lo, ph_hi; };
enum { I_X = 0, I_C, I_CTX, I_CCTX, I_WMOD, I_BMOD, I_NORMW, I_WIN, I_CQN, I_CKVN, I_WUQ, I_WUKV, I_MQN, I_MKN, I_SQN, I_SKN, I_SINK, I_AQN, I_AKN,
       I_CONVW, I_CONVB, I_LWR, I_LBR, I_LWI, I_LBI, I_LAM, I_WBR, I_WOUT };

struct Frame {
    LAS unsigned char* lds; const float* const __attribute__((address_space(4)))* kin; unsigned char* ws; float* out;
    int tid, lane, wave, G, vcu, gw, NGW, z;
    __device__ __forceinline__ const float* in(int i) const { return kin[i]; }
};

__device__ __forceinline__ void xpose_item(const float* W, int ldn, int k0, int n0, bf16* WT, int pd, int drow, LAS float* scr, int lane) {
#pragma unroll 8
    for (int i = 0; i < 32; ++i) { const int kk = 2 * i + (lane >> 5); scr[kk * 33 + (lane & 31)] = W[(size_t)(k0 + kk) * ldn + n0 + (lane & 31)]; }
    LDS_WAIT(); asm volatile("" ::: "memory");
    const int c = lane & 7;
#pragma unroll
    for (int j = 0; j < 4; ++j) { const int n = (lane >> 3) + 8 * j; const LAS float* s = scr + (8 * c) * 33 + n;
        v4u o; o.x = pk2(s[0 * 33], s[1 * 33]); o.y = pk2(s[2 * 33], s[3 * 33]); o.z = pk2(s[4 * 33], s[5 * 33]); o.w = pk2(s[6 * 33], s[7 * 33]);
        *(GAS v4u*)(WT + (size_t)(drow + n0 + n) * pd + k0 + 8 * c) = o; }
    LDS_WAIT(); asm volatile("" ::: "memory");
}
__device__ __forceinline__ void zero16(bf16* p, size_t n16, int gt, int ngt) {
    for (size_t i = gt; i < n16; i += ngt) ((GAS v4u*)p)[i] = (v4u){0u, 0u, 0u, 0u};
}
__device__ __forceinline__ void weight_copies(Frame& F, int l, int gw, int NGW) {
    LAS float* scr = (LAS float*)(F.lds + RING_OFF + F.wave * 16384);
    constexpr int I_IN = 16 * 213, I_UQ = 4 * 12, I_UKV = 2 * 16, I_BR = 4 * 4 * 32, I_OUT = 16 * 32, I_LAYER = I_IN + I_UQ + I_UKV + I_BR + I_OUT;
    unsigned char* wl = F.ws + WS_W + (size_t)l * W_LAYER;
    for (int it = gw; it < I_LAYER; it += NGW) {
        int r = it;
        if (r < I_IN) { const int kb = r / 213, nb = r % 213, n0 = nb * 32;
            xpose_item(F.in(I_WIN) + (size_t)l * 1024 * IN_COLS, IN_COLS, kb * 64, n0, (bf16*)(wl + WO_W1), 1024, n0 >= 416 ? 96 : 0, scr, F.lane); continue; } r -= I_IN;
        if (r < I_UQ) { const int kb = r / 12, nb = r % 12;
            xpose_item(F.in(I_WUQ) + (size_t)l * 256 * 384, 384, kb * 64, nb * 32, (bf16*)(wl + WO_UQ), 256, 0, scr, F.lane); continue; } r -= I_UQ;
        if (r < I_UKV) { const int kb = r / 16, nb = r % 16;
            xpose_item(F.in(I_WUKV) + (size_t)l * 128 * 512, 512, kb * 64, nb * 32, (bf16*)(wl + WO_UKV), 256, 0, scr, F.lane); continue; } r -= I_UKV;
        if (r < I_BR) { const int k = r / 128, rr = r % 128, kb = rr / 32, nb = rr % 32;
            xpose_item(F.in(I_WBR) + ((size_t)l * 4 + k) * 256 * 1024, 1024, kb * 64, nb * 32, (bf16*)(wl + WO_WB) + (size_t)k * 1024 * 256, 256, 0, scr, F.lane); continue; } r -= I_BR;
        { const int kb = r / 32, nb = r % 32;
            xpose_item(F.in(I_WOUT) + (size_t)l * 1024 * 1024, 1024, kb * 64, nb * 32, (bf16*)(wl + WO_WO), 1024, 0, scr, F.lane); }
    }
}
__device__ __forceinline__ void p0_prologue(Frame& F) {
    weight_copies(F, 0, F.gw, F.NGW);
    const int gt = F.vcu * NTHREADS + F.tid, ngt = F.G * NTHREADS;
    for (int l = 0; l < NLAYER; ++l) {
        unsigned char* wl = F.ws + WS_W + (size_t)l * W_LAYER;
        zero16((bf16*)(wl + WO_W1) + (size_t)416 * 1024, 96 * 1024 * 2 / 16, gt, ngt);
        zero16((bf16*)(wl + WO_UQ) + (size_t)384 * 256, 128 * 256 * 2 / 16, gt, ngt);
        for (int i = gt; i < 512 * 16; i += ngt) { const int n = i >> 4, c = i & 15; ((GAS v4u*)((bf16*)(wl + WO_UKV) + (size_t)n * 256 + 128))[c] = (v4u){0u, 0u, 0u, 0u}; }
    }
    { float* rhc = (float*)(F.ws + WS_RHC); float* rhs = (float*)(F.ws + WS_RHS); float* rmc = (float*)(F.ws + WS_RMC); float* rms = (float*)(F.ws + WS_RMS);
      for (int i = gt; i < 4096 * 32; i += ngt) { const int t = i >> 5, p = i & 31; const float fr = powf(10000.0f, -(float)(p & 15) / 16.0f);
          const float pos = (float)((p < 16) ? (t >> 6) : (t & 63)); const float ang = pos * fr; rhc[i] = cosf(ang); rhs[i] = sinf(ang); }
      for (int i = gt; i < 4096 * 16; i += ngt) { const int t = i >> 4, p = i & 15; const float fr = powf(10000.0f, -(float)(p & 7) / 8.0f);
          const float pos = (float)((p < 8) ? (t >> 6) : (t & 63)); const float ang = pos * fr; rmc[i] = cosf(ang); rms[i] = sinf(ang); } }
    { float* sp = (float*)(F.ws + WS_SP); for (int i = gt; i < NLAYER * 2 * 256; i += ngt) sp[i] = 8.0f * LOG2E * log1pf(expf(-F.in(I_LAM)[i])); }
    { float* lwt = (float*)(F.ws + WS_LWT);
      for (int o = gt; o < NLAYER * 2 * 2 * 256 * 64; o += ngt) { const int i = o & 63, c = (o >> 6) & 255, gate = (o >> 14) & 1, ld = o >> 15, k = c >> 6, j = c & 63;
          lwt[o] = (gate == 0 ? F.in(I_LWR) : F.in(I_LWI))[(((size_t)ld * 4 + k) * 64 + i) * 64 + j]; } }
    { LAS float* sc = (LAS float*)(F.lds + RING_OFF);
      LAS float* red = sc + 5 * 1024;
      __syncthreads();
      for (int i = F.tid; i < 5 * 1024; i += NTHREADS) { const float v = (i < 4096) ? F.in(I_C)[i] : F.in(I_CCTX)[i - 4096]; sc[i] = v / (1.0f + expf(-v)); }
      __syncthreads();
      float* modv = (float*)(F.ws + WS_MOD);
      for (int it = F.vcu; it < NLAYER * 96; it += F.G) {
          const int l = it / 96, n0 = (it % 96) * 32, nn = F.tid & 31, kc = F.tid >> 5;
          const float* w = F.in(I_WMOD) + (size_t)l * 1024 * 3072 + n0 + nn;
          float acc[5] = {0.f, 0.f, 0.f, 0.f, 0.f};
          for (int k = kc * 64; k < kc * 64 + 64; ++k) { const float wv = w[(size_t)k * 3072];
#pragma unroll
              for (int r = 0; r < 5; ++r) acc[r] += sc[r * 1024 + k] * wv; }
#pragma unroll
          for (int r = 0; r < 5; ++r) red[(kc * 5 + r) * 32 + nn] = acc[r];
          __syncthreads();
          if (F.tid < 160) { const int r = F.tid >> 5; float s = 0.f;
              for (int q = 0; q < 16; ++q) s += red[(q * 5 + r) * 32 + nn];
              modv[((size_t)l * 5 + r) * 3072 + n0 + nn] = s + F.in(I_BMOD)[l * 3072 + n0 + nn]; }
          __syncthreads();
      } }
}

__device__ __forceinline__ void ph_hnorm(Frame& F, int l) {
    const float* xs = (l == 0) ? F.in(I_X) : F.out; const float* cs = (l == 0) ? F.in(I_CTX) : (const float*)(F.ws + WS_CTX1);
    const float* nw = F.in(I_NORMW) + l * 1024; const float* modl = (const float*)(F.ws + WS_MOD) + (size_t)l * 5 * 3072;
    bf16* H = (bf16*)(F.ws + WS_H);
    for (int row = F.gw; row < NROWS; row += F.NGW) {
        const int b = row / TPB, j = row % TPB; const float* src; int mr;
        if (j < CTXL) { src = cs + ((size_t)b * CTXL + j) * 1024; mr = 4; } else { src = xs + ((size_t)b * SEQ + (j - CTXL)) * 1024; mr = b; }
        const GAS f32x4* xr = (const GAS f32x4*)src + F.lane;
        f32x4 v[4]; float ss = 0.f;
#pragma unroll
        for (int q = 0; q < 4; ++q) { v[q] = xr[64 * q]; ss += (v[q].x * v[q].x + v[q].y * v[q].y) + (v[q].z * v[q].z + v[q].w * v[q].w); }
        const float rstd = 1.0f / sqrtf(wave_sum(ss) * (1.0f / 1024.0f) + RMS_EPS);
        const float* mrow = modl + mr * 3072;
        GAS unsigned long long* o8 = (GAS unsigned long long*)(H + (size_t)row * 1024) + F.lane;
#pragma unroll
        for (int q = 0; q < 4; ++q) { const int c = 4 * F.lane + 256 * q;
            const f32x4 g = *(const f32x4*)(nw + c), sh = *(const f32x4*)(mrow + c), sc = *(const f32x4*)(mrow + 1024 + c);
            const f32x4 h = v[q] * rstd * g * (sc + 1.0f) + sh;
            o8[64 * q] = (unsigned long long)pk2(h.x, h.y) | ((unsigned long long)pk2(h.z, h.w) << 32); }
    }
}

struct P1Regs { u32x2 cq; unsigned ckv, h[3][2]; float rc[2], rs[2]; };
__device__ __forceinline__ void post1_load(const bf16* z, const float* rc, const float* rs, bool lat, int lane, P1Regs& R) {
    const int hg = lane >> 4, p0 = (lane & 15) * 2;
    R.cq = *(const u32x2*)(z + ZC_CQ + 4 * lane); R.ckv = *(const unsigned*)(z + ZC_CKV + 2 * lane);
    const bf16* h0 = z + ZC_SQ + hg * 64 + p0; const bf16* h1 = z + ZC_AQ + hg * 64 + p0; const bf16* h2 = z + ((hg < 2) ? (ZC_SK + hg * 64) : (ZC_AK + (hg - 2) * 64)) + p0;
    R.h[0][0] = *(const unsigned*)h0; R.h[0][1] = *(const unsigned*)(h0 + 32); R.h[1][0] = *(const unsigned*)h1; R.h[1][1] = *(const unsigned*)(h1 + 32); R.h[2][0] = *(const unsigned*)h2; R.h[2][1] = *(const unsigned*)(h2 + 32);
    if (lat) { R.rc[0] = rc[p0]; R.rc[1] = rc[p0 + 1]; R.rs[0] = rs[p0]; R.rs[1] = rs[p0 + 1]; } else { R.rc[0] = 1.f; R.rc[1] = 1.f; R.rs[0] = 0.f; R.rs[1] = 0.f; }
}
__device__ __forceinline__ void post1_finish(bf16* z, int lane, const P1Regs& R, const float (&gcq)[4], const float (&gckv)[2], const float (&gh)[3][4]) {
    const int hg = lane >> 4, p0 = (lane & 15) * 2;
    { float v0 = bflo(R.cq.x), v1 = bfhi(R.cq.x), v2 = bflo(R.cq.y), v3 = bfhi(R.cq.y);
      const float rstd = 1.0f / sqrtf(wave_sum(v0 * v0 + v1 * v1 + v2 * v2 + v3 * v3) * (1.0f / 256.0f) + RMS_EPS);
      u32x2 w; w.x = pk2(v0 * rstd * gcq[0], v1 * rstd * gcq[1]); w.y = pk2(v2 * rstd * gcq[2], v3 * rstd * gcq[3]); *(u32x2*)(z + ZC_CQ + 4 * lane) = w; }
    { float v0 = bflo(R.ckv), v1 = bfhi(R.ckv);
      const float rstd = 1.0f / sqrtf(wave_sum(v0 * v0 + v1 * v1) * (1.0f / 128.0f) + RMS_EPS);
      *(unsigned*)(z + ZC_CKV + 2 * lane) = pk2(v0 * rstd * gckv[0], v1 * rstd * gckv[1]); }
#pragma unroll
    for (int q = 0; q < 3; ++q) {
        bf16* hp = z + ((q == 0) ? (ZC_SQ + hg * 64) : (q == 1) ? (ZC_AQ + hg * 64) : ((hg < 2) ? (ZC_SK + hg * 64) : (ZC_AK + (hg - 2) * 64))) + p0;
        float a0 = bflo(R.h[q][0]), a1 = bfhi(R.h[q][0]), b0 = bflo(R.h[q][1]), b1 = bfhi(R.h[q][1]);
        const float rstd = 1.0f / sqrtf(grp16_sum(a0 * a0 + a1 * a1 + b0 * b0 + b1 * b1) * (1.0f / 64.0f) + RMS_EPS);
        a0 *= rstd * gh[q][0]; a1 *= rstd * gh[q][1]; b0 *= rstd * gh[q][2]; b1 *= rstd * gh[q][3];
        const float x0 = a0 * R.rc[0] - b0 * R.rs[0], y0 = b0 * R.rc[0] + a0 * R.rs[0], x1 = a1 * R.rc[1] - b1 * R.rs[1], y1 = b1 * R.rc[1] + a1 * R.rs[1];
        const float sc = (q < 2) ? QSCALE64 : 1.0f;
        *(unsigned*)hp = pk2(x0 * sc, x1 * sc); *(unsigned*)(hp + 32) = pk2(y0 * sc, y1 * sc);
    }
}
__device__ __forceinline__ void ph_post1(Frame& F, int l) {
    bf16* ZS = (bf16*)(F.ws + WS_ZS);
    const float* rhc = (const float*)(F.ws + WS_RHC); const float* rhs = (const float*)(F.ws + WS_RHS);
    const int lane = F.lane, hg = lane >> 4, p0 = (lane & 15) * 2;
    float gcq[4], gckv[2], gh[3][4];
#pragma unroll
    for (int i = 0; i < 4; ++i) gcq[i] = F.in(I_CQN)[l * 256 + 4 * lane + i];
    gckv[0] = F.in(I_CKVN)[l * 128 + 2 * lane]; gckv[1] = F.in(I_CKVN)[l * 128 + 2 * lane + 1];
    { const float* g0 = F.in(I_SQN) + l * 64; const float* g1 = F.in(I_AQN) + l * 64; const float* g2 = ((hg < 2) ? F.in(I_SKN) : F.in(I_AKN)) + l * 64;
      gh[0][0] = g0[p0]; gh[0][1] = g0[p0 + 1]; gh[0][2] = g0[32 + p0]; gh[0][3] = g0[33 + p0];
      gh[1][0] = g1[p0]; gh[1][1] = g1[p0 + 1]; gh[1][2] = g1[32 + p0]; gh[1][3] = g1[33 + p0];
      gh[2][0] = g2[p0]; gh[2][1] = g2[p0 + 1]; gh[2][2] = g2[32 + p0]; gh[2][3] = g2[33 + p0]; }
    for (int row = F.gw; row < NROWS; row += 2 * F.NGW) {
        const int row2 = row + F.NGW; const bool has2 = row2 < NROWS;
        const int j = row % TPB; const bool lat = j >= CTXL; const int pos = lat ? j - CTXL : 0;
        const int j2 = has2 ? row2 % TPB : 0; const bool lat2 = j2 >= CTXL; const int pos2 = lat2 ? j2 - CTXL : 0;
        bf16* z = ZS + (size_t)row * ZS_P; bf16* z2 = ZS + (size_t)(has2 ? row2 : row) * ZS_P;
        P1Regs A, B;
        post1_load(z, rhc + pos * 32, rhs + pos * 32, lat, lane, A);
        if (has2) post1_load(z2, rhc + pos2 * 32, rhs + pos2 * 32, lat2, lane, B);
        post1_finish(z, lane, A, gcq, gckv, gh);
        if (has2) post1_finish(z2, lane, B, gcq, gckv, gh);
    }
}
struct P2Regs { u32x2 qn, kn; bf16 q1, q2, k1, k2; float c, s; };
__device__ __forceinline__ void post2_load(const bf16* zrow, const bf16* mq, const bf16* mkv, const float* rc, const float* rs, bool lat, int lane, P2Regs& R) {
    const int h = lane >> 4, j = lane & 15;
    R.qn = *(const u32x2*)(mq + h * 96 + 4 * j); R.q1 = mq[h * 96 + 64 + j]; R.q2 = mq[h * 96 + 80 + j];
    R.kn = *(const u32x2*)(mkv + h * 128 + 4 * j); R.k1 = zrow[ZC_KR + j]; R.k2 = zrow[ZC_KR + 16 + j];
    if (lat) { R.c = rc[j]; R.s = rs[j]; } else { R.c = 1.f; R.s = 0.f; }
}
__device__ __forceinline__ void post2_finish(bf16* mq, bf16* mk, int lane, const P2Regs& R, const float (&gq)[6], const float (&gk)[6]) {
    const int h = lane >> 4, j = lane & 15;
#pragma unroll
    for (int qk = 0; qk < 2; ++qk) {
        const u32x2 n = qk == 0 ? R.qn : R.kn; float v0 = bflo(n.x), v1 = bfhi(n.x), v2 = bflo(n.y), v3 = bfhi(n.y), r1 = bf2f(qk == 0 ? R.q1 : R.k1), r2 = bf2f(qk == 0 ? R.q2 : R.k2);
        const float rstd = 1.0f / sqrtf(grp16_sum(v0 * v0 + v1 * v1 + v2 * v2 + v3 * v3 + r1 * r1 + r2 * r2) * (1.0f / 96.0f) + RMS_EPS);
        const float (&g)[6] = qk == 0 ? gq : gk; const float sc = qk == 0 ? QSCALE96 : 1.0f;
        const float y1 = r1 * rstd * g[4], y2 = r2 * rstd * g[5];
        const float t1 = (y1 * R.c - y2 * R.s) * sc, t2 = (y2 * R.c + y1 * R.s) * sc;
        bf16* o = (qk == 0 ? mq : mk) + h * 96;
        u32x2 w; w.x = pk2(v0 * rstd * g[0] * sc, v1 * rstd * g[1] * sc); w.y = pk2(v2 * rstd * g[2] * sc, v3 * rstd * g[3] * sc);
        *(u32x2*)(o + 4 * j) = w; o[64 + j] = (bf16)f2bf(t1); o[80 + j] = (bf16)f2bf(t2);
    }
}
__device__ __forceinline__ void ph_post2(Frame& F, int l) {
    const bf16* ZS = (const bf16*)(F.ws + WS_ZS); bf16* MQ = (bf16*)(F.ws + WS_MQ); const bf16* MKV = (const bf16*)(F.ws + WS_MKV); bf16* MK = (bf16*)(F.ws + WS_MK);
    const float* rmc = (const float*)(F.ws + WS_RMC); const float* rms = (const float*)(F.ws + WS_RMS);
    const int lane = F.lane, jj = lane & 15;
    float gq[6], gk[6];
    { const float* a = F.in(I_MQN) + l * 96; const float* b = F.in(I_MKN) + l * 96;
#pragma unroll
      for (int i = 0; i < 4; ++i) { gq[i] = a[4 * jj + i]; gk[i] = b[4 * jj + i]; }
      gq[4] = a[64 + jj]; gq[5] = a[80 + jj]; gk[4] = b[64 + jj]; gk[5] = b[80 + jj]; }
    for (int row = F.gw; row < NROWS; row += 2 * F.NGW) {
        const int row2 = row + F.NGW; const bool has2 = row2 < NROWS; const size_t rb = has2 ? row2 : row;
        const int j = row % TPB; const bool lat = j >= CTXL; const int pos = lat ? j - CTXL : 0;
        const int j2 = (int)(rb % TPB); const bool lat2 = j2 >= CTXL; const int pos2 = lat2 ? j2 - CTXL : 0;
        P2Regs A, B;
        post2_load(ZS + (size_t)row * ZS_P, MQ + (size_t)row * 512, MKV + (size_t)row * 512, rmc + pos * 16, rms + pos * 16, lat, lane, A);
        if (has2) post2_load(ZS + rb * ZS_P, MQ + rb * 512, MKV + rb * 512, rmc + pos2 * 16, rms + pos2 * 16, lat2, lane, B);
        post2_finish(MQ + (size_t)row * 512, MK + (size_t)row * 384, lane, A, gq, gk);
        if (has2) post2_finish(MQ + rb * 512, MK + rb * 384, lane, B, gq, gk);
    }
}

template <int DQK>
__device__ __forceinline__ void attn_row_naive(const bf16* q, const bf16* Kb, int kp, const bf16* Vb, int vp, int n1, int lo2, int hi2, bool has_sink, float sink2, bf16* y, int lane) {
    float qf[DQK];
#pragma unroll
    for (int c = 0; c < DQK / 8; ++c) { const v4u w = *(const v4u*)(q + 8 * c);
        qf[8 * c + 0] = bflo(w.x); qf[8 * c + 1] = bfhi(w.x); qf[8 * c + 2] = bflo(w.y); qf[8 * c + 3] = bfhi(w.y); qf[8 * c + 4] = bflo(w.z); qf[8 * c + 5] = bfhi(w.z); qf[8 * c + 6] = bflo(w.w); qf[8 * c + 7] = bfhi(w.w); }
    float m = -INFINITY, l = 0.f; float acc[64];
#pragma unroll
    for (int d = 0; d < 64; ++d) acc[d] = 0.f;
    for (int seg = 0; seg < 2; ++seg) {
        const int k0 = seg == 0 ? 0 : lo2, k1 = seg == 0 ? n1 : hi2;
        for (int key = k0 + lane; key < k1; key += 64) {
            const bf16* kr = Kb + (size_t)key * kp; float s = 0.f;
#pragma unroll
            for (int c = 0; c < DQK / 8; ++c) { const v4u w = *(const v4u*)(kr + 8 * c);
                s += qf[8 * c + 0] * bflo(w.x) + qf[8 * c + 1] * bfhi(w.x) + qf[8 * c + 2] * bflo(w.y) + qf[8 * c + 3] * bfhi(w.y) + qf[8 * c + 4] * bflo(w.z) + qf[8 * c + 5] * bfhi(w.z) + qf[8 * c + 6] * bflo(w.w) + qf[8 * c + 7] * bfhi(w.w); }
            if (s > m) { const float f = exp2f(m - s); l *= f;
#pragma unroll
                for (int d = 0; d < 64; ++d) acc[d] *= f;
                m = s; }
            const float p = exp2f(s - m); l += p;
            const bf16* vr = Vb + (size_t)key * vp;
#pragma unroll
            for (int c = 0; c < 8; ++c) { const v4u w = *(const v4u*)(vr + 8 * c);
                acc[8 * c + 0] += p * bflo(w.x); acc[8 * c + 1] += p * bfhi(w.x); acc[8 * c + 2] += p * bflo(w.y); acc[8 * c + 3] += p * bfhi(w.y); acc[8 * c + 4] += p * bflo(w.z); acc[8 * c + 5] += p * bfhi(w.z); acc[8 * c + 6] += p * bflo(w.w); acc[8 * c + 7] += p * bfhi(w.w); }
        }
    }
    float M = wave_max(m); if (has_sink) M = fmaxf(M, sink2);
    const float f = (m == -INFINITY) ? 0.f : exp2f(m - M);
    float L = wave_sum(l * f); if (has_sink) L += exp2f(sink2 - M);
    float mine = 0.f;
#pragma unroll
    for (int d = 0; d < 64; ++d) { const float t = wave_sum(acc[d] * f); if (lane == d) mine = t; }
    y[lane] = (bf16)f2bf(mine / L * bf2f(y[lane]));
}
__device__ __forceinline__ void ph_attn_naive(Frame& F, int l) {
    const bf16* ZS = (const bf16*)(F.ws + WS_ZS); const bf16* MQ = (const bf16*)(F.ws + WS_MQ); const bf16* MKV = (const bf16*)(F.ws + WS_MKV); const bf16* MK = (const bf16*)(F.ws + WS_MK);
    bf16* Y = (bf16*)(F.ws + WS_G);
    const long nitems = (long)NROWS * 12;
    for (long it = F.gw; it < nitems; it += F.NGW) {
        const int hb = (int)(it % 12); const int row = (int)(it / 12);
        const int b = row / TPB, j = row % TPB; const bool lat = j >= CTXL;
        if (!lat && l == NLAYER - 1) continue;
        const size_t r0 = (size_t)b * TPB;
        const int br = hb >> 2, h = hb & 3;
        bf16* y = Y + (size_t)row * 1024 + br * 256 + h * 64;
        if (br == 0) {
            attn_row_naive<96>(MQ + (size_t)row * 512 + h * 96, MK + r0 * 384 + h * 96, 384, MKV + r0 * 512 + h * 128 + 64, 512, CTXL, CTXL, lat ? TPB : CTXL, false, 0.f, y, F.lane);
        } else if (br == 1) {
            const int t = j - CTXL; int lo = CTXL, hi = CTXL;
            if (lat) { lo = CTXL + (t - 128 < 0 ? 0 : t - 128); hi = CTXL + (t + 128 > SEQ - 1 ? SEQ - 1 : t + 128) + 1; }
            attn_row_naive<64>(ZS + (size_t)row * ZS_P + ZC_SQ + h * 64, ZS + r0 * ZS_P + ZC_SK + (h >> 1) * 64, ZS_P, ZS + r0 * ZS_P + ZC_SV + (h >> 1) * 64, ZS_P, CTXL, lo, hi, true, F.in(I_SINK)[l * 4 + h] * LOG2E, y, F.lane);
        } else {
            attn_row_naive<64>(ZS + (size_t)row * ZS_P + ZC_AQ + h * 64, ZS + r0 * ZS_P + ZC_AK + (h >> 1) * 64, ZS_P, ZS + r0 * ZS_P + ZC_AV + (h >> 1) * 64, ZS_P, CTXL, CTXL, lat ? TPB : CTXL, false, 0.f, y, F.lane);
        }
    }
}

__device__ __forceinline__ void ph_lru_conv(Frame& F, int l) {
    const bf16* ZS = (const bf16*)(F.ws + WS_ZS); float* U = (float*)(F.ws + WS_U);
    const float* cw = F.in(I_CONVW) + l * 4 * 256; const float* cb = F.in(I_CONVB) + l * 256;
    const int gt = F.vcu * NTHREADS + F.tid, ngt = F.G * NTHREADS;
    for (int idx = gt; idx < NROWS * 256; idx += ngt) {
        const int row = idx >> 8, c = idx & 255, b = row / TPB, j = row % TPB;
        int s0, len, jj; if (j < CTXL) { s0 = b * TPB; len = CTXL; jj = j; } else { s0 = b * TPB + CTXL; len = SEQ; jj = j - CTXL; }
        float acc = cb[c];
#pragma unroll
        for (int i = 0; i < 4; ++i) { const int t = jj + i - 2; if (t >= 0 && t < len) acc += cw[i * 256 + c] * bf2f(ZS[(size_t)(s0 + t) * ZS_P + ZC_LRU + c]); }
        U[idx] = acc;
    }
}
__device__ __forceinline__ void ph_lru_scan(Frame& F, int l, int dir) {
    const float* U = (const float*)(F.ws + WS_U); float* HF = (float*)(F.ws + WS_HF); bf16* Y = (bf16*)(F.ws + WS_G);
    const int g = blockIdx.x * NTHREADS + F.tid;
    if (g < NB * 256) {
    const int b = g >> 8, c = g & 255, k = c >> 6, jc = c & 63;
    const float* wr = F.in(I_LWR) + ((((size_t)l * 2 + dir) * 4 + k) * 64) * 64 + jc;
    const float* wi = F.in(I_LWI) + ((((size_t)l * 2 + dir) * 4 + k) * 64) * 64 + jc;
    float wrr[64], wii[64];
#pragma unroll
    for (int i = 0; i < 64; ++i) { wrr[i] = wr[i * 64]; wii[i] = wi[i * 64]; }
    const float br = F.in(I_LBR)[(l * 2 + dir) * 256 + c], bi = F.in(I_LBI)[(l * 2 + dir) * 256 + c];
    const float lam = F.in(I_LAM)[(l * 2 + dir) * 256 + c];
    const float sp = log1pf(expf(-lam));
    float h = 0.f;
    for (int s = 0; s < TPB; ++s) {
        const int j = dir == 0 ? s : (s < CTXL ? CTXL - 1 - s : TPB + CTXL - 1 - s);
        const size_t row = (size_t)b * TPB + j;
        const float* ub = U + row * 256 + k * 64;
        float rp = br, ip = bi;
#pragma unroll
        for (int i = 0; i < 64; ++i) { const float uv = ub[i]; rp += uv * wrr[i]; ip += uv * wii[i]; }
        const float r = 1.0f / (1.0f + expf(-rp)), ig = 1.0f / (1.0f + expf(-ip));
        const float la = -8.0f * r * sp; const float a = expf(la);
        const float bx = sqrtf(-expm1f(2.0f * la)) * (ig * ub[jc]);
        h = a * h + bx;
        if (dir == 0) HF[row * 256 + c] = h;
        else { bf16* y = Y + row * 1024 + 768 + c; *y = (bf16)f2bf((HF[row * 256 + c] + h) * bf2f(*y)); }
    }
    }
}
__device__ __forceinline__ void ph_mixsum_ctx(Frame& F) {
    const bf16* S = (const bf16*)(F.ws + WS_S); bf16* MIX = (bf16*)(F.ws + WS_H);
    const int gt = F.vcu * NTHREADS + F.tid, ngt = F.G * NTHREADS;
    for (int idx = gt; idx < NB * CTXL * 128; idx += ngt) {
        const int r = idx >> 7, c8 = (idx & 127) * 8; const size_t row = (size_t)(r >> 8) * TPB + (r & 255); float s[8] = {0.f, 0.f, 0.f, 0.f, 0.f, 0.f, 0.f, 0.f};
#pragma unroll
        for (int k = 0; k < 4; ++k) { const v4u w = *(const GAS v4u*)(S + row * 4096 + k * 1024 + c8);
            s[0] += bflo(w.x); s[1] += bfhi(w.x); s[2] += bflo(w.y); s[3] += bfhi(w.y); s[4] += bflo(w.z); s[5] += bfhi(w.z); s[6] += bflo(w.w); s[7] += bfhi(w.w); }
        v4u o; o.x = pk2(s[0], s[1]); o.y = pk2(s[2], s[3]); o.z = pk2(s[4], s[5]); o.w = pk2(s[6], s[7]);
        *(GAS v4u*)(MIX + row * 1024 + c8) = o;
    }
}
namespace att {
typedef short bf16x8 __attribute__((ext_vector_type(8)));
typedef short s16x4 __attribute__((ext_vector_type(4)));
typedef short v4i16_t __attribute__((ext_vector_type(4)));
typedef float f32x16 __attribute__((ext_vector_type(16)));
typedef unsigned u32x4 __attribute__((ext_vector_type(4)));
typedef __attribute__((address_space(3))) const char* lds_cptr;
typedef float f32x2_t __attribute__((ext_vector_type(2))); typedef __bf16 bf16x2_t __attribute__((ext_vector_type(2)));
__device__ __forceinline__ int crow(int r, int hi) { return (r & 3) + 8 * (r >> 2) + 4 * hi; }
__device__ __forceinline__ void glds16(const void* gsrc, unsigned lds_dst) { unsigned keep;
    asm volatile("s_mov_b32 %0, m0\n\ts_mov_b32 m0, %2\n\ts_nop 0\n\tglobal_load_lds_dwordx4 %1, off\n\ts_mov_b32 m0, %0" : "=&s"(keep) : "v"(gsrc), "s"(lds_dst) : "memory"); }
__device__ __forceinline__ unsigned cvtpk(float lo, float hi) { f32x2_t v = {lo, hi}; bf16x2_t b = __builtin_convertvector(v, bf16x2_t); return __builtin_bit_cast(unsigned, b); }
__device__ __forceinline__ s16x4 vtr(lds_cptr p) { return __builtin_bit_cast(s16x4, __builtin_amdgcn_ds_read_tr16_b64_v4i16((__attribute__((address_space(3))) v4i16_t*)p)); }
__device__ __forceinline__ float halfswap_max(float m) { auto rr = __builtin_amdgcn_permlane32_swap(__float_as_uint(m), __float_as_uint(m), false, false); return fmaxf(__uint_as_float(rr[0]), __uint_as_float(rr[1])); }
__device__ __forceinline__ float halfswap_sum(float m) { auto rr = __builtin_amdgcn_permlane32_swap(__float_as_uint(m), __float_as_uint(m), false, false); return __uint_as_float(rr[0]) + __uint_as_float(rr[1]); }

template <int DQK> struct Cfg {
    static constexpr int KCH = DQK / 8, KSLOT = KCH * 1024, NKI = (KCH + 7) / 8, NI = NKI + 1;
    static constexpr int LDS_K = 0, LDS_V = 3 * KSLOT, LDS_WS = LDS_V + 3 * 8192, LDS_OST = LDS_WS + 8 * 256, BYTES = LDS_OST + 8 * 4096;
};
#define ATT_WAIT_BAR(N) asm volatile("s_waitcnt vmcnt(" #N ") lgkmcnt(0)\n\ts_barrier" ::: "memory")

struct UnitDesc {
    const unsigned short* Q; int qp;
    const unsigned short* K; int kp;
    const unsigned short* V; int vp;
    unsigned short* Y;
    int NT;
    int lat_row0;
    int qpos0, spos0;
    int has_sink; float sink2;
};

constexpr float ATT_THR = 6.0f;
template <int DQK, bool SWA>
__device__ __forceinline__ void attn_unit(LAS unsigned char* ldsb, const UnitDesc& U, const int tid) {
    using C = Cfg<DQK>;
    const int lane = tid & 63, r32 = lane & 31, hi = lane >> 5; const int wid = __builtin_amdgcn_readfirstlane(tid >> 6);
    const unsigned lds0 = (unsigned)(uintptr_t)ldsb;
    LAS float* wsf = (LAS float*)(ldsb + C::LDS_WS) + wid * 64;
    const int kp = U.kp, vp = U.vp;
    const int kc1 = (C::NKI == 2 && wid < 4) ? wid + 8 : wid;
    const unsigned short* ksrc0 = U.K + (size_t)lane * kp + wid * 8;
    const unsigned short* ksrc1 = U.K + (size_t)lane * kp + kc1 * 8;
    const unsigned short* vsrc = U.V + (size_t)(16 * (wid & 3) + (lane >> 2)) * vp + (wid >> 2) * 32 + (lane & 3) * 8;
    const unsigned kdst0 = lds0 + C::LDS_K + wid * 1024, kdst1 = lds0 + C::LDS_K + kc1 * 1024, vdst = lds0 + C::LDS_V + wid * 1024;
    const int NT = U.NT;
#define ATT_KROW(t) (SWA ? ((t) < 4 ? 64 * (t) : U.lat_row0 + 64 * ((t) - 4)) : 64 * (t))
#define ATT_DMA_K(t, slot) do { const size_t ro_ = (size_t)ATT_KROW(t); \
        glds16(ksrc0 + ro_ * kp, (unsigned)__builtin_amdgcn_readfirstlane(kdst0 + (slot) * C::KSLOT)); \
        if (C::NKI == 2) glds16(ksrc1 + ro_ * kp, (unsigned)__builtin_amdgcn_readfirstlane(kdst1 + (slot) * C::KSLOT)); } while (0)
#define ATT_DMA_V(t, slot) do { const size_t ro_ = (size_t)ATT_KROW(t); glds16(vsrc + ro_ * vp, (unsigned)__builtin_amdgcn_readfirstlane(vdst + (slot) * 8192)); } while (0)
#define ATT_KLOAD(kslot) do { if (!SWA) { const lds_cptr kb_ = (lds_cptr)(ldsb + C::LDS_K) + (kslot) * C::KSLOT + hi * 1024 + r32 * 16; \
        _Pragma("unroll") for (int d0 = 0; d0 < DQK / 16; ++d0) { kf[2 * d0] = *(const __attribute__((address_space(3))) bf16x8*)(kb_ + d0 * 2048); kf[2 * d0 + 1] = *(const __attribute__((address_space(3))) bf16x8*)(kb_ + d0 * 2048 + 512); } } } while (0)
#define ATT_QKM(P0, P1, CINIT, kslot) do { { const float ci_ = (CINIT); _Pragma("unroll") for (int r = 0; r < 16; ++r) { P0[r] = ci_; P1[r] = ci_; } } \
        const lds_cptr kq_ = (lds_cptr)(ldsb + C::LDS_K) + (kslot) * C::KSLOT + hi * 1024 + r32 * 16; \
        _Pragma("unroll") for (int d0 = 0; d0 < DQK / 16; ++d0) { \
            const bf16x8 b0_ = SWA ? *(const __attribute__((address_space(3))) bf16x8*)(kq_ + d0 * 2048) : kf[2 * d0]; const bf16x8 b1_ = SWA ? *(const __attribute__((address_space(3))) bf16x8*)(kq_ + d0 * 2048 + 512) : kf[2 * d0 + 1]; \
            P0 = __builtin_amdgcn_mfma_f32_32x32x16_bf16(b0_, qr[d0], P0, 0, 0, 0); P1 = __builtin_amdgcn_mfma_f32_32x32x16_bf16(b1_, qr[d0], P1, 0, 0, 0); } } while (0)
#define ATT_VLOAD(vslot) do { if (!SWA) { const lds_cptr vb_ = (lds_cptr)(ldsb + C::LDS_V) + (vslot) * 8192 + ((lane >> 4) & 1) * 32 + (lane & 3) * 8 + (4 * hi + ((lane & 15) >> 2)) * 64; \
        _Pragma("unroll") for (int i = 0; i < 8; ++i) { vl[i] = vtr(vb_ + (i >> 2) * 4096 + (i & 3) * 1024); vh[i] = vtr(vb_ + (i >> 2) * 4096 + (i & 3) * 1024 + 512); } } } while (0)
#define ATT_MX3(a, b, c) __builtin_fmaxf(__builtin_fmaxf((a), (b)), (c))
#define ATT_SMPV(P0, P1, N0, N1, HASNEXT, t, vslot) do { \
        if (SWA) { const bool mk_ = ((t) >= 4) && (U.qpos0 >= 0); const int sb_ = U.spos0 + 64 * ((t) - 4) + 4 * hi; \
            _Pragma("unroll") for (int r = 0; r < 16; ++r) { const int dd_ = qpos - (sb_ + (r & 3) + 8 * (r >> 2)); \
                P0[r] = (mk_ && (dd_ > 128 || dd_ < -128)) ? -INFINITY : P0[r]; P1[r] = (mk_ && (dd_ - 32 > 128 || dd_ - 32 < -128)) ? -INFINITY : P1[r]; } } \
        float ra_ = ATT_MX3(P0[0], P0[1], P1[0]), rb_ = ATT_MX3(P0[2], P0[3], P1[1]); ra_ = ATT_MX3(ra_, P1[2], P1[3]); \
        _Pragma("unroll") for (int r = 4; r < 16; r += 4) { ra_ = ATT_MX3(ra_, P0[r], P0[r + 1]); rb_ = ATT_MX3(rb_, P0[r + 2], P0[r + 3]); ra_ = ATT_MX3(ra_, P1[r], P1[r + 1]); rb_ = ATT_MX3(rb_, P1[r + 2], P1[r + 3]); } \
        float rm_ = halfswap_max(__builtin_fmaxf(ra_, rb_)); \
        if (__builtin_expect(__any(rm_ > ATT_THR), 0)) { \
            const float dl_ = __builtin_fmaxf(rm_, 0.f); m += dl_; const float alpha_ = __builtin_amdgcn_exp2f(-dl_); l *= alpha_; \
            _Pragma("unroll") for (int r = 0; r < 16; ++r) { P0[r] -= dl_; P1[r] -= dl_; } \
            if (HASNEXT) { _Pragma("unroll") for (int r = 0; r < 16; ++r) { N0[r] -= dl_; N1[r] -= dl_; } } \
            if (hi == 0) wsf[r32] = alpha_; \
            asm volatile("s_waitcnt lgkmcnt(0)" ::: "memory"); \
            _Pragma("unroll") for (int r = 0; r < 16; ++r) { const float f_ = wsf[crow(r, hi)]; o[0][r] *= f_; o[1][r] *= f_; } } \
        float ls_ = 0.f; \
        _Pragma("unroll") for (int r = 0; r < 16; ++r) { P0[r] = __builtin_amdgcn_exp2f(P0[r]); P1[r] = __builtin_amdgcn_exp2f(P1[r]); ls_ += P0[r] + P1[r]; } \
        l += ls_; \
        u32x4 pw_[4]; \
        pw_[0] = (u32x4){cvtpk(P0[0], P0[1]), cvtpk(P0[2], P0[3]), cvtpk(P0[4], P0[5]), cvtpk(P0[6], P0[7])}; \
        pw_[1] = (u32x4){cvtpk(P0[8], P0[9]), cvtpk(P0[10], P0[11]), cvtpk(P0[12], P0[13]), cvtpk(P0[14], P0[15])}; \
        pw_[2] = (u32x4){cvtpk(P1[0], P1[1]), cvtpk(P1[2], P1[3]), cvtpk(P1[4], P1[5]), cvtpk(P1[6], P1[7])}; \
        pw_[3] = (u32x4){cvtpk(P1[8], P1[9]), cvtpk(P1[10], P1[11]), cvtpk(P1[12], P1[13]), cvtpk(P1[14], P1[15])}; \
        const lds_cptr vq_ = (lds_cptr)(ldsb + C::LDS_V) + (vslot) * 8192 + ((lane >> 4) & 1) * 32 + (lane & 3) * 8 + (4 * hi + ((lane & 15) >> 2)) * 64; \
        _Pragma("unroll") for (int d0 = 0; d0 < 2; ++d0) \
            _Pragma("unroll") for (int ks = 0; ks < 4; ++ks) { \
                const s16x4 lo_ = SWA ? vtr(vq_ + d0 * 4096 + ks * 1024) : vl[4 * d0 + ks], hh_ = SWA ? vtr(vq_ + d0 * 4096 + ks * 1024 + 512) : vh[4 * d0 + ks]; \
                const bf16x8 vf_ = (bf16x8){lo_[0], lo_[1], lo_[2], lo_[3], hh_[0], hh_[1], hh_[2], hh_[3]}; \
                o[d0] = __builtin_amdgcn_mfma_f32_32x32x16_bf16(__builtin_bit_cast(bf16x8, pw_[ks]), vf_, o[d0], 0, 0, 0); } } while (0)
#define ATT_STEP(C0, C1, N0, N1, t) do { \
        const int k3_ = (ks1 == 0) ? 2 : ks1 - 1, v2_ = (vs0 == 0) ? 2 : vs0 - 1; \
        if ((t) + 3 < NT) ATT_DMA_K((t) + 3, k3_); \
        if ((t) + 2 < NT) ATT_DMA_V((t) + 2, v2_); \
        ATT_KLOAD(ks1); \
        if (!SWA) __builtin_amdgcn_sched_barrier(0);        \
        ATT_QKM(N0, N1, -m, ks1); \
        ATT_VLOAD(vs0); \
        if (!SWA) __builtin_amdgcn_sched_barrier(0); \
        ATT_SMPV(C0, C1, N0, N1, true, t, vs0); \
        if ((t) + 3 < NT) { if (C::NI == 2) ATT_WAIT_BAR(2); else ATT_WAIT_BAR(3); } else ATT_WAIT_BAR(0); \
        ks1 = (ks1 == 2) ? 0 : ks1 + 1; vs0 = (vs0 == 2) ? 0 : vs0 + 1; } while (0)
    ATT_DMA_K(0, 0);
    ATT_DMA_K(1, 1); ATT_DMA_V(0, 0);
    ATT_DMA_K(2, 2); ATT_DMA_V(1, 1);
    bf16x8 qr[DQK / 16];
    { const unsigned short* qw = U.Q + (size_t)(wid * 32 + r32) * U.qp + hi * 8;
#pragma unroll
      for (int d0 = 0; d0 < DQK / 16; ++d0) qr[d0] = *(const bf16x8*)(qw + d0 * 16); }
    float m = 0.f, l = 0.f;
    f32x16 o[2]; o[0] = f32x16{}; o[1] = f32x16{};
    const int qpos = U.qpos0 + wid * 32 + r32;
    f32x16 pa0, pa1, pb0, pb1;
    bf16x8 kf[DQK / 8]; s16x4 vl[8], vh[8];
    if (C::NI == 2) ATT_WAIT_BAR(4); else ATT_WAIT_BAR(6);
    ATT_KLOAD(0); ATT_QKM(pa0, pa1, 0.f, 0);
    {
      float ra = ATT_MX3(pa0[0], pa0[1], pa1[0]), rb = ATT_MX3(pa0[2], pa0[3], pa1[1]); ra = ATT_MX3(ra, pa1[2], pa1[3]);
#pragma unroll
      for (int r = 4; r < 16; r += 4) { ra = ATT_MX3(ra, pa0[r], pa0[r + 1]); rb = ATT_MX3(rb, pa0[r + 2], pa0[r + 3]); ra = ATT_MX3(ra, pa1[r], pa1[r + 1]); rb = ATT_MX3(rb, pa1[r + 2], pa1[r + 3]); }
      m = halfswap_max(__builtin_fmaxf(ra, rb));
#pragma unroll
      for (int r = 0; r < 16; ++r) { pa0[r] -= m; pa1[r] -= m; } }
    if (C::NI == 2) ATT_WAIT_BAR(2); else ATT_WAIT_BAR(3);
    int ks1 = 1, vs0 = 0;
    int t = 0;
    if (SWA) { for (; t + 1 < NT; ++t) { ATT_STEP(pa0, pa1, pb0, pb1, t); pa0 = pb0; pa1 = pb1; } ATT_SMPV(pa0, pa1, pa0, pa1, false, NT - 1, vs0); }
    else {
    for (; t + 2 < NT; t += 2) { ATT_STEP(pa0, pa1, pb0, pb1, t); ATT_STEP(pb0, pb1, pa0, pa1, t + 1); }
    if (t + 1 < NT) { ATT_STEP(pa0, pa1, pb0, pb1, t); ATT_VLOAD(vs0); ATT_SMPV(pb0, pb1, pb0, pb1, false, NT - 1, vs0); }
    else { ATT_VLOAD(vs0); ATT_SMPV(pa0, pa1, pa0, pa1, false, NT - 1, vs0); }
    }
    l = halfswap_sum(l);
    if (U.has_sink) l += __builtin_amdgcn_exp2f(U.sink2 - m);
    if (hi == 0) wsf[32 + r32] = l;
    asm volatile("s_waitcnt lgkmcnt(0)" ::: "memory");
    { LAS unsigned short* stg = (LAS unsigned short*)(ldsb + C::LDS_OST) + wid * 2048;
#pragma unroll
      for (int r = 0; r < 16; ++r) { const int orow = crow(r, hi); const float rl = __builtin_amdgcn_rcpf(wsf[32 + orow]);
          stg[orow * 64 + r32] = (unsigned short)f2bf(o[0][r] * rl); stg[orow * 64 + 32 + r32] = (unsigned short)f2bf(o[1][r] * rl); }
      asm volatile("s_waitcnt lgkmcnt(0)" ::: "memory");
      unsigned short* yw = U.Y + (size_t)(wid * 32) * 1024;
#pragma unroll
      for (int i = 0; i < 4; ++i) { const int row = i * 8 + (lane >> 3), ch = lane & 7;
          const u32x4 ov = *(const LAS u32x4*)(stg + row * 64 + ch * 8);
          u32x4* gp = (u32x4*)(yw + (size_t)row * 1024 + ch * 8); const u32x4 g = *gp;
          u32x4 w; w.x = pk2(bflo(ov.x) * bflo(g.x), bfhi(ov.x) * bfhi(g.x)); w.y = pk2(bflo(ov.y) * bflo(g.y), bfhi(ov.y) * bfhi(g.y));
          w.z = pk2(bflo(ov.z) * bflo(g.z), bfhi(ov.z) * bfhi(g.z)); w.w = pk2(bflo(ov.w) * bflo(g.w), bfhi(ov.w) * bfhi(g.w));
          *gp = w; } }
    asm volatile("s_waitcnt vmcnt(0) lgkmcnt(0)\n\ts_barrier" ::: "memory");
#undef ATT_KROW
#undef ATT_DMA_K
#undef ATT_DMA_V
#undef ATT_KLOAD
#undef ATT_QKM
#undef ATT_VLOAD
#undef ATT_STEP
#undef ATT_SMPV
#undef ATT_MX3
}
}

__device__ __forceinline__ void ph_attn(Frame& F, int l) {
    unsigned short* ZS = (unsigned short*)(F.ws + WS_ZS); unsigned short* MQ = (unsigned short*)(F.ws + WS_MQ); unsigned short* MKV = (unsigned short*)(F.ws + WS_MKV); unsigned short* MK = (unsigned short*)(F.ws + WS_MK);
    unsigned short* Y = (unsigned short*)(F.ws + WS_G);
    LAS unsigned char* lds = F.lds + RING_OFF;
    const int u = F.vcu;
    const bool ctxq = (l == 0);
    for (int uu = u; uu < 256; uu += F.G) { const int bh = uu >> 4, qb = uu & 15, b = bh >> 2, h = bh & 3; const size_t r0 = (size_t)b * TPB, rq = r0 + CTXL + qb * 256;
        att::UnitDesc U{MQ + rq * 512 + h * 96, 512, MK + r0 * 384 + h * 96, 384, MKV + r0 * 512 + h * 128 + 64, 512, Y + rq * 1024 + h * 64, TPB / 64, 0, -1, 0, 0, 0.f};
        att::attn_unit<96, false>(lds, U, F.tid); }
    for (int uu = u; uu < 256; uu += F.G) { const int qb = uu & 15, g = (uu >> 4) & 1, kvh = (uu >> 5) & 1, b = uu >> 6, qh = kvh * 2 + g; const size_t r0 = (size_t)b * TPB, rq = r0 + CTXL + qb * 256;
        att::UnitDesc U{ZS + rq * ZS_P + ZC_AQ + qh * 64, ZS_P, ZS + r0 * ZS_P + ZC_AK + kvh * 64, ZS_P, ZS + r0 * ZS_P + ZC_AV + kvh * 64, ZS_P, Y + rq * 1024 + 512 + qh * 64, TPB / 64, 0, -1, 0, 0, 0.f};
        att::attn_unit<64, false>(lds, U, F.tid); }
    for (int uu = u; uu < 256; uu += F.G) { const int qb = uu & 15, g = (uu >> 4) & 1, kvh = (uu >> 5) & 1, b = uu >> 6, qh = kvh * 2 + g; const size_t r0 = (size_t)b * TPB, rq = r0 + CTXL + qb * 256;
        const int q0 = qb * 256, s0 = (q0 - 128 < 0) ? 0 : q0 - 128, s1 = (q0 + 384 > SEQ) ? SEQ : q0 + 384;
        att::UnitDesc U{ZS + rq * ZS_P + ZC_SQ + qh * 64, ZS_P, ZS + r0 * ZS_P + ZC_SK + kvh * 64, ZS_P, ZS + r0 * ZS_P + ZC_SV + kvh * 64, ZS_P, Y + rq * 1024 + 256 + qh * 64, 4 + (s1 - s0) / 64, CTXL + s0, q0, s0, 1, F.in(I_SINK)[l * 4 + qh] * LOG2E};
        att::attn_unit<64, true>(lds, U, F.tid); }
    if (ctxq) for (int uu = u; uu < 48; uu += F.G) { const int br = uu >> 4, b = (uu >> 2) & 3, h = uu & 3; const size_t r0 = (size_t)b * TPB;
        if (br == 0) { att::UnitDesc U{MQ + r0 * 512 + h * 96, 512, MK + r0 * 384 + h * 96, 384, MKV + r0 * 512 + h * 128 + 64, 512, Y + r0 * 1024 + h * 64, 4, 0, -1, 0, 0, 0.f};
            att::attn_unit<96, false>(lds, U, F.tid); }
        else if (br == 1) { att::UnitDesc U{ZS + r0 * ZS_P + ZC_SQ + h * 64, ZS_P, ZS + r0 * ZS_P + ZC_SK + (h >> 1) * 64, ZS_P, ZS + r0 * ZS_P + ZC_SV + (h >> 1) * 64, ZS_P, Y + r0 * 1024 + 256 + h * 64, 4, CTXL, -1, 0, 1, F.in(I_SINK)[l * 4 + h] * LOG2E};
            att::attn_unit<64, true>(lds, U, F.tid); }
        else { att::UnitDesc U{ZS + r0 * ZS_P + ZC_AQ + h * 64, ZS_P, ZS + r0 * ZS_P + ZC_AK + (h >> 1) * 64, ZS_P, ZS + r0 * ZS_P + ZC_AV + (h >> 1) * 64, ZS_P, Y + r0 * 1024 + 512 + h * 64, 4, 0, -1, 0, 0, 0.f};
            att::attn_unit<64, false>(lds, U, F.tid); } }
}
constexpr size_t WS_SUM = 253 * MiB;
constexpr size_t WS_HL = WS_U, WS_CP = WS_HF;
constexpr int NCHUNK = TPB / 64;
__device__ __forceinline__ float swap_lo(float x) { auto rr = __builtin_amdgcn_permlane32_swap(__float_as_uint(x), __float_as_uint(x), false, false); return __uint_as_float(rr[0]); }
__device__ __forceinline__ float swap_hi(float x) { auto rr = __builtin_amdgcn_permlane32_swap(__float_as_uint(x), __float_as_uint(x), false, false); return __uint_as_float(rr[1]); }
__device__ __forceinline__ void ph_lru1(Frame& F, int l) {
    typedef short bf16x8 __attribute__((ext_vector_type(8))); typedef float f32x16 __attribute__((ext_vector_type(16)));
    const unsigned short* ZS = (const unsigned short*)(F.ws + WS_ZS); unsigned short* HL = (unsigned short*)(F.ws + WS_HL); unsigned short* CP = (unsigned short*)(F.ws + WS_CP);
    f32x2v* SUM = (f32x2v*)(F.ws + WS_SUM);
    constexpr int UP = 264;
    LAS unsigned short* ul = (LAS unsigned short*)(F.lds + RING_OFF);
    const float* cw = F.in(I_CONVW) + l * 4 * 256; const float* cb = F.in(I_CONVB) + l * 256;
    const int tid = F.tid, lane = tid & 63, r32 = lane & 31, hi = lane >> 5, k = F.wave & 3, d = F.wave >> 2;
    const int nfull = (NB * NCHUNK < F.G) ? NB * NCHUNK : F.G, nhalf = 2 * (NB * NCHUNK - nfull);
    for (int wi = F.vcu; wi < nfull + nhalf; wi += F.G) {
        const int unit = (wi < nfull) ? wi : nfull + ((wi - nfull) >> 1);
        const int tn_lo = (wi < nfull) ? 0 : ((wi - nfull) & 1), tn_hi = (wi < nfull) ? 2 : tn_lo + 1;
        const int b = unit / NCHUNK, ci = unit % NCHUNK;
        int s0row, len, t0; if (ci < 4) { s0row = b * TPB; len = CTXL; t0 = ci * 64; } else { s0row = b * TPB + CTXL; len = SEQ; t0 = (ci - 4) * 64; }
        { const int cc = tid & 255, hh = tid >> 8; float zv[35];
#pragma unroll
          for (int i = 0; i < 35; ++i) { const int tt = t0 + hh * 32 + i - 2; const int tc = tt < 0 ? 0 : (tt >= len ? len - 1 : tt);
              const float v = bf2f(ZS[(size_t)(s0row + tc) * ZS_P + ZC_LRU + cc]); zv[i] = (tt >= 0 && tt < len) ? v : 0.f; }
          const float w0 = cw[cc], w1 = cw[256 + cc], w2 = cw[512 + cc], w3 = cw[768 + cc], bb = cb[cc];
#pragma unroll
          for (int t = 0; t < 32; ++t) ul[(hh * 32 + t) * UP + cc] = (unsigned short)f2bf(bb + w0 * zv[t] + w1 * zv[t + 1] + w2 * zv[t + 2] + w3 * zv[t + 3]); }
        __syncthreads();
#pragma unroll 1
        for (int tn = tn_lo; tn < tn_hi; ++tn) {
            const int c = k * 64 + 32 * tn + r32;
            bf16x8 wf[2][4];
            const float brv = F.in(I_LBR)[(l * 2 + d) * 256 + c], biv = F.in(I_LBI)[(l * 2 + d) * 256 + c], spv = ((const float*)(F.ws + WS_SP))[(l * 2 + d) * 256 + c];
#pragma unroll
            for (int gate = 0; gate < 2; ++gate)
#pragma unroll
                for (int ks = 0; ks < 4; ++ks) { const float* src = (const float*)(F.ws + WS_LWT) + ((((size_t)l * 2 + d) * 2 + gate) * 256 + c) * 64 + 16 * ks + 8 * hi;
                    const f32x4 a = *(const f32x4*)src, b2 = *(const f32x4*)(src + 4);
                    v4u w; w.x = pk2(a.x, a.y); w.y = pk2(a.z, a.w); w.z = pk2(b2.x, b2.y); w.w = pk2(b2.z, b2.w); wf[gate][ks] = __builtin_bit_cast(bf16x8, w); }
            f32x16 A[2], X[2];
            A[0] = f32x16{}; A[1] = f32x16{}; X[0] = f32x16{}; X[1] = f32x16{};
#pragma unroll
            for (int tm = 0; tm < 2; ++tm)
#pragma unroll
                for (int ks = 0; ks < 4; ++ks) { const bf16x8 af = *(const LAS bf16x8*)(ul + (32 * tm + r32) * UP + k * 64 + 16 * ks + 8 * hi);
                    A[tm] = __builtin_amdgcn_mfma_f32_32x32x16_bf16(af, wf[0][ks], A[tm], 0, 0, 0); X[tm] = __builtin_amdgcn_mfma_f32_32x32x16_bf16(af, wf[1][ks], X[tm], 0, 0, 0); }
#pragma unroll
            for (int tm = 0; tm < 2; ++tm)
#pragma unroll
                for (int r = 0; r < 16; ++r) { const int tok = 32 * tm + (r & 3) + 8 * (r >> 2) + 4 * hi; const float uu = bf2f(ul[tok * UP + c]);
                    const float rr = sigmoid_f(A[tm][r] + brv), ii = sigmoid_f(X[tm][r] + biv);
                    const float a = __builtin_amdgcn_exp2f(-rr * spv); A[tm][r] = a; X[tm][r] = __builtin_amdgcn_sqrtf(1.0f - a * a) * (ii * uu);
                    if ((r & 3) == 3) asm volatile("" ::: "memory"); }
#pragma unroll
            for (int tm = 0; tm < 2; ++tm)
#pragma unroll
                for (int rg = 0; rg < 4; ++rg) { const int r0 = 4 * rg;
                    if (d == 0) {
#pragma unroll
                        for (int e2 = 1; e2 < 4; ++e2) { X[tm][r0 + e2] = A[tm][r0 + e2] * X[tm][r0 + e2 - 1] + X[tm][r0 + e2]; A[tm][r0 + e2] = A[tm][r0 + e2] * A[tm][r0 + e2 - 1]; } }
                    else {
#pragma unroll
                        for (int e2 = 2; e2 >= 0; --e2) { X[tm][r0 + e2] = A[tm][r0 + e2] * X[tm][r0 + e2 + 1] + X[tm][r0 + e2]; A[tm][r0 + e2] = A[tm][r0 + e2] * A[tm][r0 + e2 + 1]; } } }
            float enH[8], enP[8]; float EH = 0.f, EP = 1.f;
            if (d == 0) {
#pragma unroll
                for (int q = 0; q < 8; ++q) { const int tm = q >> 2, re = 4 * (q & 3) + 3; const float ce = A[tm][re], he = X[tm][re];
                    const float aH = swap_lo(ce * EH + he), aP = swap_lo(EP * ce);
                    const float E1H = hi ? aH : EH, E1P = hi ? aP : EP;
                    enH[q] = E1H; enP[q] = E1P;
                    EH = swap_hi(ce * E1H + he); EP = swap_hi(E1P * ce); }
            } else {
#pragma unroll
                for (int q = 7; q >= 0; --q) { const int tm = q >> 2, re = 4 * (q & 3); const float ce = A[tm][re], he = X[tm][re];
                    const float aH = swap_hi(ce * EH + he), aP = swap_hi(EP * ce);
                    const float E1H = hi ? EH : aH, E1P = hi ? EP : aP;
                    enH[q] = E1H; enP[q] = E1P;
                    EH = swap_lo(ce * E1H + he); EP = swap_lo(E1P * ce); }
            }
            { const unsigned ob = (unsigned)((((s0row + t0 + 4 * hi) * 2 + d) * 256 + c) * 2);
#pragma unroll
              for (int tm = 0; tm < 2; ++tm)
#pragma unroll
                for (int rg = 0; rg < 4; ++rg) { const int q = 4 * tm + rg;
#pragma unroll
                    for (int e2 = 0; e2 < 4; ++e2) { const int r = 4 * rg + e2; const unsigned o = ob + (unsigned)(32 * tm + 8 * rg + e2) * 1024u;
                        *(unsigned short*)((char*)HL + o) = (unsigned short)f2bf(X[tm][r] + A[tm][r] * enH[q]); *(unsigned short*)((char*)CP + o) = (unsigned short)f2bf(A[tm][r] * enP[q]); }
                    asm volatile("" ::: "memory"); } }
            if (hi == 0) SUM[((size_t)(b * NCHUNK + ci) * 2 + d) * 256 + c] = (f32x2v){EP, EH};
        }
        __syncthreads();
    }
}
constexpr size_t WS_CARRY = 255 * MiB;
__device__ __forceinline__ void ph_lru_carry(Frame& F) {
    if (F.vcu < 4) {
        const int g = F.vcu * NTHREADS + F.tid, b = g >> 9, d = (g >> 8) & 1, c = g & 255;
        const f32x2v* sb = (const f32x2v*)(F.ws + WS_SUM) + ((size_t)b * NCHUNK * 2 + d) * 256 + c;
        float* cr = (float*)(F.ws + WS_CARRY) + ((size_t)b * NCHUNK * 2 + d) * 256 + c;
        float h = 0.f;
#pragma unroll 1
        for (int p0 = 0; p0 < NCHUNK; p0 += 17) {
            f32x2v s[17];
#pragma unroll
            for (int i = 0; i < 17; ++i) { const int p = p0 + i, j = (d == 0) ? p : (p < 4 ? 3 - p : NCHUNK + 3 - p); s[i] = sb[(size_t)j * 512]; }
#pragma unroll
            for (int i = 0; i < 17; ++i) { const int p = p0 + i, j = (d == 0) ? p : (p < 4 ? 3 - p : NCHUNK + 3 - p); cr[(size_t)j * 512] = h; h = s[i].x * h + s[i].y; }
        }
    }
}
__device__ __forceinline__ void ph_lru2(Frame& F, int l) {
    const unsigned short* HL = (const unsigned short*)(F.ws + WS_HL); const unsigned short* CP = (const unsigned short*)(F.ws + WS_CP);
    const float* CARRY = (const float*)(F.ws + WS_CARRY); unsigned short* Y = (unsigned short*)(F.ws + WS_G);
    const int tid = F.tid, cg = tid & 31, tq = tid >> 5; const bool last = (l == NLAYER - 1);
    for (int unit = F.vcu; unit < NB * NCHUNK; unit += F.G) {
        const int b = unit / NCHUNK, ci = unit % NCHUNK;
        if (last && ci < 4) continue;
        const float* cp0 = CARRY + ((size_t)(b * NCHUNK + ci) * 2) * 256 + cg * 8;
        const f32x4 cfa = *(const f32x4*)cp0, cfb = *(const f32x4*)(cp0 + 4), cba = *(const f32x4*)(cp0 + 256), cbb = *(const f32x4*)(cp0 + 260);
        const float cf[8] = {cfa.x, cfa.y, cfa.z, cfa.w, cfb.x, cfb.y, cfb.z, cfb.w}, cbk[8] = {cba.x, cba.y, cba.z, cba.w, cbb.x, cbb.y, cbb.z, cbb.w};
        v4u hf[4], pf[4], hb[4], pb[4], gg[4];
#pragma unroll
        for (int i = 0; i < 4; ++i) { const size_t row = (size_t)b * TPB + ci * 64 + tq + 16 * i; const size_t o = (row * 2) * 256 + cg * 8;
            hf[i] = *(const v4u*)(HL + o); pf[i] = *(const v4u*)(CP + o); hb[i] = *(const v4u*)(HL + o + 256); pb[i] = *(const v4u*)(CP + o + 256); gg[i] = *(const v4u*)(Y + row * 1024 + 768 + cg * 8); }
#pragma unroll
        for (int i = 0; i < 4; ++i) { const size_t row = (size_t)b * TPB + ci * 64 + tq + 16 * i;
            unsigned w[4];
#pragma unroll
            for (int e = 0; e < 4; ++e) { const unsigned a = hf[i][e], p = pf[i][e], a2 = hb[i][e], p2 = pb[i][e], g = gg[i][e];
                const float v0 = (bflo(a) + bflo(p) * cf[2 * e] + bflo(a2) + bflo(p2) * cbk[2 * e]) * bflo(g);
                const float v1 = (bfhi(a) + bfhi(p) * cf[2 * e + 1] + bfhi(a2) + bfhi(p2) * cbk[2 * e + 1]) * bfhi(g);
                w[e] = pk2(v0, v1); }
            *(v4u*)(Y + row * 1024 + 768 + cg * 8) = (v4u){w[0], w[1], w[2], w[3]}; }
    }
}
namespace pgx {
typedef short bf16x8 __attribute__((ext_vector_type(8)));
typedef float f32x4 __attribute__((ext_vector_type(4)));
typedef unsigned u32x4 __attribute__((ext_vector_type(4)));
typedef unsigned u32x2 __attribute__((ext_vector_type(2)));
constexpr int OPB = 16384;
__device__ __forceinline__ void pgx_unit(LAS unsigned char* lds, const unsigned short* Y, const unsigned short* Wb, const unsigned short* S, unsigned short* MIX, int row0, int n0, int tid) {
    const int lane = tid & 63, wid = __builtin_amdgcn_readfirstlane(tid >> 6), wm = wid & 3, wn = wid >> 2, fr = lane & 15, fq = lane >> 4;
    const int sr0 = tid >> 3, sk = (tid & 7) * 8;
    const unsigned short* ysrc = Y + (size_t)(row0 + sr0) * 1024 + sk;
    const unsigned short* wsrc = Wb + (size_t)(n0 + sr0) * 256 + sk;
    const int ldst = (tid & 7) * 2048 + (sr0 & ~15) * 16 + (((sr0 & 15) ^ (tid & 7)) << 4);
    f32x4 acc[2][4], mix[2][4];
#pragma unroll
    for (int a = 0; a < 2; ++a)
#pragma unroll
        for (int b = 0; b < 4; ++b) { acc[a][b] = (f32x4){0.f, 0.f, 0.f, 0.f}; mix[a][b] = (f32x4){0.f, 0.f, 0.f, 0.f}; }
    u32x4 st[4][4];
    const unsigned short* yA = ysrc; const unsigned short* yB = ysrc + 64 * 1024;
    const unsigned short* wA = wsrc; const unsigned short* wB = wsrc + 64 * 256;
    const unsigned short* sp0 = S + (size_t)(row0 + 32 * wm + fr) * 4096 + n0 + 64 * wn + 4 * fq; const unsigned short* sp1 = sp0 + (size_t)16 * 4096;
#define PGX_LOADQ(set_, yo_, wp0_, wp1_, wo_) do { st[set_][0] = *(const u32x4*)(yA + (yo_)); st[set_][1] = *(const u32x4*)(yB + (yo_)); st[set_][2] = *(const u32x4*)((wp0_) + (wo_)); st[set_][3] = *(const u32x4*)((wp1_) + (wo_)); } while (0)
#define PGX_STORE(buf_, set_) do { LAS unsigned char* b_ = lds + (buf_) * 2 * OPB + ldst; \
        *(LAS u32x4*)b_ = st[set_][0]; *(LAS u32x4*)(b_ + 1024) = st[set_][1]; *(LAS u32x4*)(b_ + OPB) = st[set_][2]; *(LAS u32x4*)(b_ + OPB + 1024) = st[set_][3]; } while (0)
    u32x2 sga[2][4];
    PGX_LOADQ(0, 0, wA, wB, 0); PGX_LOADQ(1, 64, wA, wB, 64); PGX_LOADQ(2, 128, wA, wB, 128);
    PGX_STORE(0, 0);
    __syncthreads();
#define PGX_COMPUTE(h_) do { const LAS unsigned char* yb = lds + ((h_) & 1) * 2 * OPB + 32 * wm * 16; const LAS unsigned char* wb = lds + ((h_) & 1) * 2 * OPB + OPB + 64 * wn * 16; \
          _Pragma("unroll") for (int ks = 0; ks < 2; ++ks) { const int fo_ = (4 * ks + fq) * 2048 + ((fr ^ (4 * ks + fq)) << 4); \
              bf16x8 yf[2], wf[4]; \
              _Pragma("unroll") for (int tt = 0; tt < 2; ++tt) yf[tt] = *(const LAS bf16x8*)(yb + fo_ + tt * 256); \
              _Pragma("unroll") for (int nt = 0; nt < 4; ++nt) wf[nt] = *(const LAS bf16x8*)(wb + fo_ + nt * 256); \
              _Pragma("unroll") for (int tt = 0; tt < 2; ++tt) \
                  _Pragma("unroll") for (int nt = 0; nt < 4; ++nt) acc[tt][nt] = __builtin_amdgcn_mfma_f32_16x16x32_bf16(wf[nt], yf[tt], acc[tt][nt], 0, 0, 0); } } while (0)
#pragma unroll 1
    for (int kk = 0; kk < 4; ++kk) {
        const bool more = kk < 3;
        const unsigned short* wnA = more ? wA + (size_t)1024 * 256 : wsrc; const unsigned short* wnB = more ? wB + (size_t)1024 * 256 : wsrc + 64 * 256;
        const int yo = more ? 256 : -768;
#pragma unroll
        for (int nt = 0; nt < 4; ++nt) { sga[0][nt] = *(const u32x2*)(sp0 + 16 * nt); sga[1][nt] = *(const u32x2*)(sp1 + 16 * nt); }
        PGX_LOADQ(3, 192, wA, wB, 192); PGX_COMPUTE(0); PGX_STORE(1, 1); __syncthreads();
        PGX_LOADQ(0, yo, wnA, wnB, 0); PGX_COMPUTE(1); PGX_STORE(0, 2); __syncthreads();
        PGX_LOADQ(1, yo + 64, wnA, wnB, 64); PGX_COMPUTE(2); PGX_STORE(1, 3); __syncthreads();
        PGX_LOADQ(2, yo + 128, wnA, wnB, 128); PGX_COMPUTE(3);
#pragma unroll
        for (int tt = 0; tt < 2; ++tt)
#pragma unroll
            for (int nt = 0; nt < 4; ++nt) { const u32x2 g = sga[tt][nt]; const f32x4 a = acc[tt][nt];
                mix[tt][nt] += (f32x4){a[0] * bflo(g.x), a[1] * bfhi(g.x), a[2] * bflo(g.y), a[3] * bfhi(g.y)}; acc[tt][nt] = (f32x4){0.f, 0.f, 0.f, 0.f}; }
        if (more) PGX_STORE(0, 0);
        __syncthreads();
        yA += 256; yB += 256; wA = wnA; wB = wnB; sp0 += 1024; sp1 += 1024;
    }
#pragma unroll
    for (int tt = 0; tt < 2; ++tt)
#pragma unroll
        for (int nt = 0; nt < 4; ++nt) { const f32x4 v = mix[tt][nt]; u32x2 w; w.x = pk2(v[0], v[1]); w.y = pk2(v[2], v[3]);
            *(u32x2*)(MIX + (size_t)(row0 + 32 * wm + 16 * tt + fr) * 1024 + n0 + 64 * wn + 16 * nt + 4 * fq) = w; }
#undef PGX_LOADQ
#undef PGX_STORE
#undef PGX_COMPUTE
}
}
__device__ __forceinline__ void ph_pgx(Frame& F, int l) {
    const unsigned short* Y = (const unsigned short*)(F.ws + WS_G); const unsigned short* S = (const unsigned short*)(F.ws + WS_S); unsigned short* MIX = (unsigned short*)(F.ws + WS_H);
    const unsigned short* Wb = (const unsigned short*)(F.ws + WS_W + (size_t)l * W_LAYER + WO_WB);
    const bool last = (l == NLAYER - 1);
    const int nrt = last ? 128 : NROWS / 128;
    for (int u = F.vcu; u < nrt * 8; u += F.G) {
        int rt = u >> 3; const int ct = u & 7;
        if (last) rt = rt + 2 * (rt / 32) + 2;
        pgx::pgx_unit(F.lds + RING_OFF, Y, Wb, S, MIX, rt * 128, ct * 128, F.tid);
    }
}
constexpr int NPL = 10;
enum { PH_H = 0, PH_G1, PH_POST1, PH_G2, PH_POST2, PH_ATT, PH_SG, PH_PG, PH_MIX, PH_OG };
constexpr int NPHASES = 1 + NLAYER * NPL;
#ifndef NAIVE_ATT
#define NAIVE_ATT 0
#endif
#ifndef PROBE_MASK
#define PROBE_MASK 0
#endif
#ifndef PROBE_LAYERS
#define PROBE_LAYERS 3
#endif
#ifndef PHMASK
#define PHMASK 16383
#endif
#ifndef MK_ONE_LAUNCH
#define MK_ONE_LAUNCH 1
#endif

__global__ void __launch_bounds__(NTHREADS, 2) fwd_kernel(Args args) {
    extern __shared__ __attribute__((aligned(16))) unsigned char lds_raw[];
    { LAS unsigned char* l0 = (LAS unsigned char*)lds_raw;
      for (int u = threadIdx.x; u < (LDS_BYTES - LDSCTL_OFF) / 4; u += NTHREADS) ((LAS unsigned*)(l0 + LDSCTL_OFF))[u] = 0u;
      __syncthreads();
      if (args.ph_hi - args.ph_lo > 1) (void)xcd_barrier_post((unsigned*)((gu32*)(args.ws + WS_CTL) + CW_BAR), (volatile LAS unsigned*)(l0 + MISC_OFF) + 8); }

    unsigned long long tacc = 0ull;
    for (int ph = args.ph_lo; ph < args.ph_hi; ++ph) {
        unsigned long long tph0 = 0ull; bool probed = false;
        if (PROBE_MASK) { const int pl = (ph == 0) ? 0 : (ph - 1) / NPL, pp = (ph == 0) ? 10 : (ph - 1) % NPL; probed = ((PROBE_MASK >> pp) & 1) && ((PROBE_LAYERS >> pl) & 1); if (probed) tph0 = __builtin_amdgcn_s_memrealtime(); }
        int z; asm volatile("s_mov_b32 %0, 0" : "=s"(z));
        Frame F;
        F.lds = (LAS unsigned char*)lds_raw + z; F.kin = (const float* const __attribute__((address_space(4)))*)((const __attribute__((address_space(4))) char*)__builtin_amdgcn_kernarg_segment_ptr() + z); F.ws = args.ws + z; F.out = args.out + z; F.z = z;
        F.tid = threadIdx.x + z; F.lane = F.tid & 63; F.wave = __builtin_amdgcn_readfirstlane(F.tid >> 6);
        F.G = gridDim.x + z; { const int bx = blockIdx.x + z; F.vcu = (F.G % 8 == 0) ? (bx % 8) * (F.G / 8) + bx / 8 : bx; }
        F.gw = F.vcu * NWAVES + F.wave; F.NGW = F.G * NWAVES;
        bool is_gemm = false;
        pg8::Gemm g{nullptr, nullptr, NROWS, 256, 1024, 1024, 31, 0};
        pg8::Order S; S.init(1, 1, F.G, (int)blockIdx.x + z, 0);
        pg8::EpiU E{pg8::EM_PLAIN, 0, F.ws, nullptr, nullptr, nullptr, 0, 0, 0, 0, 1 << 20};
        if (ph == 0) { if (PHMASK & 8192) p0_prologue(F); }
        else {
            const int l = (ph - 1) / NPL, p = (ph - 1) % NPL;
            unsigned char* wl = F.ws + WS_W + (size_t)l * W_LAYER;
            const bool last = (l == NLAYER - 1);
            const int nMc = last ? 64 : NROWS / 256, lat = last ? 1 : 0;
            E.l = l;
            if (p == PH_H && (PHMASK & 1)) { ph_hnorm(F, l); }
            else if (p == PH_G1 && (PHMASK & 2)) {
                is_gemm = true; g.A = (const bf16*)(F.ws + WS_H); g.Bt = (const bf16*)(wl + WO_W1); g.N = N1; g.K = 1024; g.lda = 1024;
                S.init(NROWS / 256, N1 / 256, F.G, (int)blockIdx.x + z, 0);
                E.mode = pg8::EM_SILU2; E.oA = WS_ZS; E.ldc = ZS_P; E.oB = WS_G; E.ldc2 = 1024; E.split_tile = 7;
            }
            else if (p == PH_POST1 && (PHMASK & 4)) { ph_lru1(F, l); ph_post1(F, l); }
            else if (p == PH_G2 && (PHMASK & 8)) {
                is_gemm = true; g.A = (const bf16*)(F.ws + WS_ZS); g.Bt = (const bf16*)(wl + WO_UQ); g.N = 1024; g.K = 256; g.lda = ZS_P; g.a_shift = 1; g.a_step = 512;
                S.init(NROWS / 256, 4, F.G, (int)blockIdx.x + z, 0);
                E.mode = pg8::EM_PLAIN; E.oA = WS_MQ; E.ldc = 512; E.oB = WS_MKV; E.ldc2 = 512; E.split_tile = 2;
            }
            else if (p == PH_POST2 && (PHMASK & 16)) { ph_lru_carry(F); ph_post2(F, l); }
            else if (p == PH_ATT && (PHMASK & 32)) {
#if NAIVE_ATT
                ph_attn_naive(F, l);
#else
                ph_attn(F, l);
#endif
                ph_lru2(F, l); }
            else if (p == PH_SG && (PHMASK & 512)) {
                is_gemm = true; g.A = (const bf16*)(F.ws + WS_H); g.Bt = (const bf16*)(wl + WO_W1) + (size_t)N1 * 1024; g.N = 4096; g.K = 1024; g.lda = 1024;
                S.init(nMc, 16, F.G, (int)blockIdx.x + z, lat);
                E.mode = pg8::EM_SIG; E.oA = WS_S; E.ldc = 4096;
            }
            else if (p == PH_PG && (PHMASK & 1024)) { ph_pgx(F, l); }
            else if (p == PH_MIX) { }
            else if (p == PH_OG && (PHMASK & 4096)) {
                is_gemm = true; g.A = (const bf16*)(F.ws + WS_H); g.Bt = (const bf16*)(wl + WO_WO); g.N = 1024; g.K = 1024; g.lda = 1024;
                S.init(nMc, 4, F.G, (int)blockIdx.x + z, lat);
                E.mode = pg8::EM_RES; E.xin = (l == 0) ? F.in(I_X) : (const float*)F.out; E.xout = F.out; E.cin0 = F.in(I_CTX); E.oA = WS_MOD; E.oB = WS_CTX1;
            }
        }
        if (is_gemm) pg8::gemm_phase<pg8::EpiU, pg8::Order, true, true>(F.lds + RING_OFF, g, S, E, F.tid);
        if (ph == 1 + PH_OG && NLAYER == 2) {
            pg8::Unit tmp; const int nbusy = (NROWS / 256) * 4 - F.G;
            if ((int)blockIdx.x + z >= nbusy && nbusy >= 0 && nbusy < F.G) { __syncthreads(); weight_copies(F, 1, ((int)blockIdx.x + z - nbusy) * NWAVES + F.wave, (F.G - nbusy) * NWAVES); }
            (void)tmp; }
        const bool empty_phase = (ph > 0) && ((ph - 1) % NPL == PH_MIX);
        if (ph + 1 < args.ph_hi && !empty_phase) {
            int z2; asm volatile("s_mov_b32 %0, 0" : "=s"(z2));
            XcdBarrier bar; bar.bar = (unsigned*)((gu32*)(args.ws + z2 + WS_CTL) + CW_BAR); bar.x = xb_xcc_id(); bar.st = (volatile LAS unsigned*)((LAS unsigned char*)lds_raw + z2 + MISC_OFF) + 8;
            xcd_barrier(bar);
        }
        if (PROBE_MASK) { if (probed) tacc += __builtin_amdgcn_s_memrealtime() - tph0; }
    }
#ifdef EXTRA_BARRIERS
    for (int xb = 0; xb < EXTRA_BARRIERS; ++xb) { int z3; asm volatile("s_mov_b32 %0, 0" : "=s"(z3));
        XcdBarrier bar; bar.bar = (unsigned*)((gu32*)(args.ws + z3 + WS_CTL) + CW_BAR); bar.x = xb_xcc_id(); bar.st = (volatile LAS unsigned*)((LAS unsigned char*)lds_raw + z3 + MISC_OFF) + 8;
        xcd_barrier(bar); }
#endif
    if (PROBE_MASK) { const unsigned long long t0 = __builtin_amdgcn_s_memrealtime(); while (__builtin_amdgcn_s_memrealtime() - t0 < tacc) __builtin_amdgcn_s_sleep(8); }
}

extern "C" void kernel_launch(void* const* d_in, const int* in_sizes, int n_in, void* d_out, int out_size, void* d_ws, size_t ws_size, hipStream_t stream) {
    static int grid = 0;
    if (grid == 0) {
        if (n_in != 28 || out_size != NB * SEQ * DM || ws_size < WS_END) { fprintf(stderr, "kernel_launch: unexpected shapes (n_in %d out %d ws %zu); nothing launched\n", n_in, out_size, ws_size); grid = -1; return; }
        int dev = 0, cus = 0, per_cu = 0;
        if (hipGetDevice(&dev) != hipSuccess || hipDeviceGetAttribute(&cus, hipDeviceAttributeMultiprocessorCount, dev) != hipSuccess) { grid = -1; return; }
        if (hipFuncSetAttribute((const void*)fwd_kernel, hipFuncAttributeMaxDynamicSharedMemorySize, LDS_BYTES) != hipSuccess) { fprintf(stderr, "kernel_launch: hipFuncSetAttribute failed\n"); grid = -1; return; }
        if (hipOccupancyMaxActiveBlocksPerMultiprocessor(&per_cu, (const void*)fwd_kernel, NTHREADS, LDS_BYTES) != hipSuccess || per_cu < 1) { fprintf(stderr, "kernel_launch: occupancy query says %d\n", per_cu); (void)hipGetLastError(); grid = -1; return; }
        grid = cus;
    }
    if (grid < 0) return;
    (void)hipMemsetAsync((char*)d_ws + WS_CTL, 0, CTL_ZERO_BYTES, stream);
    Args a{};
    for (int i = 0; i < 28; ++i) a.in[i] = (const float*)d_in[i];
    a.out = (float*)d_out; a.ws = (unsigned char*)d_ws;
#if MK_ONE_LAUNCH
    a.ph_lo = 0; a.ph_hi = NPHASES;
    hipLaunchKernelGGL(fwd_kernel, dim3(grid), dim3(NTHREADS), LDS_BYTES, stream, a);
#else
    for (int ph = 0; ph < NPHASES; ++ph) { a.ph_lo = ph; a.ph_hi = ph + 1; hipLaunchKernelGGL(fwd_kernel, dim3(grid), dim3(NTHREADS), LDS_BYTES, stream, a); }
#endif
}
```

```cpp
#include <hip/hip_runtime.h>
#include <cstdio>
#include <cstdint>
#include <cmath>
__device__ __forceinline__ float bflo(unsigned w) { return __uint_as_float(w << 16); }
__device__ __forceinline__ float bfhi(unsigned w) { return __uint_as_float(w & 0xffff0000u); }
__device__ __forceinline__ float sigmoid_f(float v) { return __builtin_amdgcn_rcpf(1.0f + __builtin_amdgcn_exp2f(-1.4426950408889634f * v)); }
namespace pg8 {
#define PG8_LAS __attribute__((address_space(3)))
typedef unsigned short bf16_t;
typedef short bf16x8 __attribute__((ext_vector_type(8)));
typedef float f32x4 __attribute__((ext_vector_type(4)));
typedef unsigned u32x4 __attribute__((ext_vector_type(4)));
constexpr int BM = 256, BK = 64, HALF = 128, HTB = HALF * BK * 2  , STAGE_BYTES = 8 * HTB, NXCD = 8, WGM = 8;

__host__ __device__ __forceinline__ int lds_byte(int r, int c) { const int st = (r >> 4) * 2 + (c >> 5), rr = r & 15, cc = c & 31, ob = rr * 64 + cc * 2; return st * 1024 + (ob ^ (((ob >> 9) & 1) << 5)); }
__host__ __device__ __forceinline__ void stage_rc(int b, int& R, int& C) { const int st = b / 1024, sb = b % 1024, swz = sb ^ (((sb >> 9) & 1) << 5); R = (st >> 1) * 16 + swz / 64; C = (st & 1) * 32 + (swz % 64) / 2; }
__host__ __device__ __forceinline__ int perm32(int rho) { const int n = rho >> 4, i = rho & 15; return 8 * (i >> 2) + 4 * n + (i & 3); }

struct Unit { int pm, pn; };
struct Gemm { const bf16_t* A; const bf16_t* Bt; int M, N, K, lda; int a_shift, a_step; };

struct StaticOrder {
    int nM, nN, nwg, G, c;
    __host__ __device__ void init(int M, int N, int G_, int c_) { nM = M / BM; nN = N / BM; nwg = nM * nN; G = G_; c = c_; }
    __host__ __device__ bool next(int i, Unit& u) const {
        const long L = (long)i * G + c; if (L >= nwg) return false;
        int wgid = (int)L; { const int q = nwg / NXCD, r = nwg % NXCD, xcd = wgid % NXCD, off = wgid / NXCD; wgid = (xcd < r ? xcd * (q + 1) : r * (q + 1) + (xcd - r) * q) + off; }
        const int nig = WGM * nN, gid = wgid / nig, fm = gid * WGM, gsz = (nM - fm) < WGM ? (nM - fm) : WGM;
        u.pm = fm + ((wgid % nig) % gsz); u.pn = (wgid % nig) / gsz; return true;
    }
    __device__ __forceinline__ void a_ready(const Unit&) const {}
    __device__ __forceinline__ void done(const Unit&) const {}
};

__device__ __forceinline__ unsigned cvt_pk_bf16(float lo, float hi) { unsigned r; asm volatile("v_cvt_pk_bf16_f32 %0, %1, %2" : "=v"(r) : "v"(lo), "v"(hi)); return r; }
enum { EM_PLAIN = 0, EM_SILU2 = 1, EM_SIG = 2, EM_MUL = 3, EM_RES = 4 };
struct EpiU {
    static constexpr bool PERM = true, AFTER_DRAIN = false;
    int mode; int l; unsigned char* ws; const float* xin; float* xout; const float* cin0;
    size_t oA, oB; int ldc, ldc2, split_tile;
    __device__ __forceinline__ void operator()(const f32x4 (&acc)[2][2][4][2], const Unit& u, int wr, int wc, int fr, int fq) const {
        if (mode == EM_RES) {
            const int b = u.pm / 17, t0 = u.pm % 17;
            const float* src; float* dst; const float* gate; const float* modl = (const float*)(ws + oA) + (size_t)l * 5 * 3072;
            if (t0 == 0) { float* c1 = (float*)(ws + oB); src = ((l == 0) ? cin0 : (const float*)c1) + (size_t)b * 256 * 1024; dst = c1 + (size_t)b * 256 * 1024; gate = modl + 4 * 3072 + 2048; }
            else { const size_t o = ((size_t)b * 4096 + (size_t)(t0 - 1) * 256) * 1024; src = xin + o; dst = xout + o; gate = modl + b * 3072 + 2048; }
            const int col0 = u.pn * BM + wc * 32 + 8 * fq;
            const char* srcb = (const char*)src; char* dstb = (char*)dst; const char* gb = (const char*)(gate + col0);
            const unsigned off0 = (unsigned)((wr * 64 + fr) * 1024 + col0) * 4u;
#pragma unroll
            for (int ai = 0; ai < 2; ++ai) {
                f32x4 xo[4][2][2];
#pragma unroll
                for (int m = 0; m < 4; ++m) { const unsigned off = off0 + (unsigned)(ai * HALF + m * 16) * 4096u;
#pragma unroll
                    for (int bj = 0; bj < 2; ++bj)
#pragma unroll
                        for (int n = 0; n < 2; ++n) xo[m][bj][n] = *(const f32x4*)(srcb + (off + (unsigned)(bj * HALF + n * 4) * 4u)); }
#pragma unroll
                for (int m = 0; m < 4; ++m) { const unsigned off = off0 + (unsigned)(ai * HALF + m * 16) * 4096u;
#pragma unroll
                    for (int bj = 0; bj < 2; ++bj)
#pragma unroll
                        for (int n = 0; n < 2; ++n) { const unsigned cb = (unsigned)(bj * HALF + n * 4) * 4u; const f32x4 g = *(const f32x4*)(gb + cb);
                            *(f32x4*)(dstb + (off + cb)) = xo[m][bj][n] + g * acc[ai][bj][m][n]; } }
                asm volatile("" ::: "memory"); }
            return;
        }
        const int row0 = u.pm * BM + wr * 64 + fr; int colt = u.pn * BM; bf16_t* base = (bf16_t*)(ws + oA); int ld = ldc; bool second = false;
        if (u.pn >= split_tile) { base = (bf16_t*)(ws + oB); ld = ldc2; colt -= split_tile * BM; second = true; }
        const bool do_silu = (mode == EM_SILU2) && second;
        const int col0 = colt + wc * 32 + 8 * fq;
        if (mode == EM_MUL) {
            const int kk = u.pn >> 2, jt = u.pn & 3; const bool isctx = (u.pm % 17) == 0;
            bf16_t* mixb = (bf16_t*)(ws + oB); const int mcol0 = jt * BM + wc * 32 + 8 * fq;
            const bool rmw = !isctx && kk > 0;
#pragma unroll
            for (int am = 0; am < 4; ++am) { const int ai = am >> 1, mh = (am & 1) * 2;
                u32x4 old[2][2], prev[2][2];
#pragma unroll
                for (int m2 = 0; m2 < 2; ++m2)
#pragma unroll
                    for (int bj = 0; bj < 2; ++bj) old[m2][bj] = *(const u32x4*)(base + (size_t)(row0 + ai * HALF + (mh + m2) * 16) * ld + col0 + bj * HALF);
                if (rmw) {
#pragma unroll
                    for (int m2 = 0; m2 < 2; ++m2)
#pragma unroll
                        for (int bj = 0; bj < 2; ++bj) prev[m2][bj] = *(const u32x4*)(mixb + (size_t)(row0 + ai * HALF + (mh + m2) * 16) * 1024 + mcol0 + bj * HALF); }
#pragma unroll
                for (int m2 = 0; m2 < 2; ++m2)
#pragma unroll
                    for (int bj = 0; bj < 2; ++bj) { const int m = mh + m2; const f32x4 v0 = acc[ai][bj][m][0], v1 = acc[ai][bj][m][1]; const u32x4 o = old[m2][bj];
                        float t[8] = {v0[0] * bflo(o.x), v0[1] * bfhi(o.x), v0[2] * bflo(o.y), v0[3] * bfhi(o.y), v1[0] * bflo(o.z), v1[1] * bfhi(o.z), v1[2] * bflo(o.w), v1[3] * bfhi(o.w)};
                        if (rmw) { const u32x4 q = prev[m2][bj]; t[0] += bflo(q.x); t[1] += bfhi(q.x); t[2] += bflo(q.y); t[3] += bfhi(q.y); t[4] += bflo(q.z); t[5] += bfhi(q.z); t[6] += bflo(q.w); t[7] += bfhi(q.w); }
                        u32x4 w; w.x = cvt_pk_bf16(t[0], t[1]); w.y = cvt_pk_bf16(t[2], t[3]); w.z = cvt_pk_bf16(t[4], t[5]); w.w = cvt_pk_bf16(t[6], t[7]);
                        if (isctx) *(u32x4*)(base + (size_t)(row0 + ai * HALF + m * 16) * ld + col0 + bj * HALF) = w;
                        else *(u32x4*)(mixb + (size_t)(row0 + ai * HALF + m * 16) * 1024 + mcol0 + bj * HALF) = w; }
                asm volatile("" ::: "memory"); }
            return;
        }
#pragma unroll
        for (int ai = 0; ai < 2; ++ai)
#pragma unroll
            for (int m = 0; m < 4; ++m) { bf16_t* rowp = base + (size_t)(row0 + ai * HALF + m * 16) * ld + col0;
#pragma unroll
                for (int bj = 0; bj < 2; ++bj) { f32x4 v0 = acc[ai][bj][m][0], v1 = acc[ai][bj][m][1];
                    if (mode == EM_SIG) {
#pragma unroll
                        for (int e = 0; e < 4; ++e) { v0[e] = sigmoid_f(v0[e]); v1[e] = sigmoid_f(v1[e]); } }
                    if (do_silu) {
#pragma unroll
                        for (int e = 0; e < 4; ++e) { v0[e] = v0[e] * sigmoid_f(v0[e]); v1[e] = v1[e] * sigmoid_f(v1[e]); } }
                    u32x4 w; w.x = cvt_pk_bf16(v0[0], v0[1]); w.y = cvt_pk_bf16(v0[2], v0[3]); w.z = cvt_pk_bf16(v1[0], v1[1]); w.w = cvt_pk_bf16(v1[2], v1[3]);
                    *(u32x4*)(rowp + bj * HALF) = w; } }
    }
};
struct Order {
    int nM, nN, nwg, G, c, latent_only, grouped, vc, nctx;
    __device__ void init(int nM_, int nN_, int G_, int c_, int lat) { nM = nM_; nN = nN_; nwg = nM * nN; G = G_; c = c_; latent_only = lat; grouped = 0; vc = 0; nctx = 0; }
    __device__ void init_grouped(int G_, int vc_, int with_ctx) { init(64, 4, G_, vc_, 1); grouped = 1; vc = vc_; nctx = with_ctx ? 64 : 0; }
    __device__ bool next(int i, Unit& u) const {
        if (grouped) {
            const int gi = i >> 2, grp = vc + gi * G;
            if (grp < 256) { const int pm = grp >> 2; u.pm = pm + pm / 16 + 1; u.pn = 4 * (i & 3) + (grp & 3); return true; }
            const int done = ((256 - vc + G - 1) / G) * 4;
            const int x = vc + (i - done) * G;
            if (i >= done && x < nctx) { const int g = x >> 2, k = x & 3; u.pm = (g >> 2) * 17; u.pn = 4 * k + (g & 3); return true; }
            return false;
        }
        const long L = (long)i * G + c; if (L >= nwg) return false;
        int wgid = (int)L; { const int q = nwg / NXCD, r = nwg % NXCD, xcd = wgid % NXCD, off = wgid / NXCD; wgid = (xcd < r ? xcd * (q + 1) : r * (q + 1) + (xcd - r) * q) + off; }
        const int nig = WGM * nN, gid = wgid / nig, fm = gid * WGM, gsz = (nM - fm) < WGM ? (nM - fm) : WGM;
        int pm = fm + ((wgid % nig) % gsz); u.pn = (wgid % nig) / gsz; if (latent_only) pm = pm + pm / 16 + 1; u.pm = pm; return true;
    }
    __device__ __forceinline__ void a_ready(const Unit&) const {}
    __device__ __forceinline__ void done(const Unit&) const {}
};
template <class Epi, class Sched, bool ALIGN_EPI = false, bool SP2 = false>
__device__ __forceinline__ void gemm_phase(PG8_LAS unsigned char* lds, const Gemm g, const Sched& S, const Epi& E, const int tid  ) {
    const int wid = __builtin_amdgcn_readfirstlane(tid >> 6), lane = tid & 63, wr = wid >> 2, wc = wid & 3, fr = lane & 15, fq = lane >> 4;
    const int K = g.K, nt = K / BK;
    unsigned voffA[2], voffB[2];
#pragma unroll
    for (int i = 0; i < 2; ++i) { int R, C; stage_rc(tid * 16 + i * 8192, R, C); const int Rb = Epi::PERM ? ((R & ~31) + perm32(R & 31)) : R;
        voffA[i] = (unsigned)(R * g.lda + C) * 2u; voffB[i] = (unsigned)(Rb * K + C) * 2u; }
    const size_t kstep = (size_t)(BK * 2);
    const size_t hstepA = (size_t)HALF * g.lda * 2, hstepB = (size_t)HALF * K * 2;
    const size_t tstepA = 2 * hstepA, tstepB = 2 * hstepB;
    const unsigned ldsw = (unsigned)wid * 1024u;
    const int aoff = lds_byte(wr * 64 + fr, fq * 8), boff = lds_byte(wc * 32 + fr, fq * 8);
#define PG8_SA(b, h) (((b) * 2 + (h)) * HTB)
#define PG8_SB(b, h) ((4 + (b) * 2 + (h)) * HTB)
#define PG8_STAGE(bufoff, gbase, voff) do { _Pragma("unroll") for (int _i = 0; _i < 2; ++_i) \
        __builtin_amdgcn_global_load_lds((const unsigned*)((const char*)(gbase) + (voff)[_i]), (PG8_LAS unsigned*)(lds + (bufoff) + ldsw + _i * 8192), 16, 0, 0); } while (0)
#define PG8_LDA(dst, b, h) do { _Pragma("unroll") for (int m = 0; m < 4; ++m) _Pragma("unroll") for (int k = 0; k < 2; ++k) dst[m][k] = *(const PG8_LAS bf16x8*)(lds + PG8_SA(b, h) + aoff + m * 2048 + k * 1024); } while (0)
#define PG8_LDB(dst, b, h) do { _Pragma("unroll") for (int n = 0; n < 2; ++n) _Pragma("unroll") for (int k = 0; k < 2; ++k) dst[n][k] = *(const PG8_LAS bf16x8*)(lds + PG8_SB(b, h) + boff + n * 2048 + k * 1024); } while (0)
#define PG8_MMA(ai, bj, At, Bt) do { __builtin_amdgcn_s_setprio(1); _Pragma("unroll") for (int m = 0; m < 4; ++m) _Pragma("unroll") for (int n = 0; n < 2; ++n) _Pragma("unroll") for (int k = 0; k < 2; ++k) \
        acc[ai][bj][m][n] = __builtin_amdgcn_mfma_f32_16x16x32_bf16(Bt[n][k], At[m][k], acc[ai][bj][m][n], 0, 0, 0); __builtin_amdgcn_s_setprio(0); } while (0)
#define PG8_WAIT_V(n) asm volatile("s_waitcnt vmcnt(" #n ")" ::: "memory")
#define PG8_WAIT_L(n) asm volatile("s_waitcnt lgkmcnt(" #n ")" ::: "memory")
#define PG8_BAR __builtin_amdgcn_s_barrier()
#define PG8_SCHED __builtin_amdgcn_sched_barrier(0)
    Unit cur, nxt; int ui = 0;
    if (!S.next(0, cur)) return;
    f32x4 acc[2][2][4][2];
#pragma unroll
    for (int a = 0; a < 2; ++a)
#pragma unroll
        for (int b = 0; b < 2; ++b)
#pragma unroll
            for (int m = 0; m < 4; ++m)
#pragma unroll
                for (int n = 0; n < 2; ++n) acc[a][b][m][n] = (f32x4){0.f, 0.f, 0.f, 0.f};
    bf16x8 At[4][2], B0[2][2], B1[2][2];
    const char* cA = (const char*)g.A + (size_t)cur.pm * tstepA + (size_t)(cur.pn >> g.a_shift) * (size_t)g.a_step; const char* cB = (const char*)g.Bt + (size_t)cur.pn * tstepB;
    S.a_ready(cur);
    if constexpr (SP2) {
        PG8_STAGE(PG8_SB(0, 0), cB, voffB); PG8_STAGE(PG8_SB(0, 1), cB + hstepB, voffB); PG8_STAGE(PG8_SA(0, 0), cA, voffA); PG8_STAGE(PG8_SA(0, 1), cA + hstepA, voffA);
        if (wr == 1) PG8_BAR;
        PG8_WAIT_V(2); PG8_BAR;
        PG8_STAGE(PG8_SB(1, 0), cB + kstep, voffB); PG8_STAGE(PG8_SA(1, 0), cA + kstep, voffA); PG8_STAGE(PG8_SB(1, 1), cB + hstepB + kstep, voffB);
        PG8_WAIT_V(6); PG8_BAR;
    } else {
        PG8_STAGE(PG8_SB(0, 0), cB, voffB); PG8_STAGE(PG8_SA(0, 0), cA, voffA); PG8_STAGE(PG8_SB(0, 1), cB + hstepB, voffB); PG8_STAGE(PG8_SA(0, 1), cA + hstepA, voffA);
        if (wr == 1) PG8_BAR;
        PG8_WAIT_V(4); PG8_BAR;
        PG8_STAGE(PG8_SB(1, 0), cB + kstep, voffB); PG8_STAGE(PG8_SA(1, 0), cA + kstep, voffA); PG8_STAGE(PG8_SB(1, 1), cB + hstepB + kstep, voffB);
        PG8_WAIT_V(6); PG8_BAR;
    }
    for (;;) {
        const bool has_next = S.next(ui + 1, nxt);
        const char* nA = has_next ? (const char*)g.A + (size_t)nxt.pm * tstepA + (size_t)(nxt.pn >> g.a_shift) * (size_t)g.a_step : cA; const char* nB = has_next ? (const char*)g.Bt + (size_t)nxt.pn * tstepB : cB;
        for (int t = 0; t < nt; t += 2) {
            const bool last = (t == nt - 2);
            const char* a1 = cA + (size_t)(t + 1) * kstep;
            const char* a2 = last ? nA : cA + (size_t)(t + 2) * kstep; const char* b2 = last ? nB : cB + (size_t)(t + 2) * kstep;
            const char* a3 = a2 + kstep; const char* b3 = b2 + kstep;
            if (last && has_next) S.a_ready(nxt);
            if constexpr (SP2) {
            PG8_LDB(B0, 0, 0); PG8_LDB(B1, 0, 1); PG8_SCHED; PG8_LDA(At, 0, 0); PG8_STAGE(PG8_SA(1, 1), a1 + hstepA, voffA);
            PG8_WAIT_V(8); PG8_WAIT_L(0); PG8_BAR; PG8_MMA(0, 0, At, B0); PG8_MMA(0, 1, At, B1); PG8_BAR; PG8_SCHED;
            PG8_LDA(At, 0, 1); PG8_STAGE(PG8_SB(0, 0), b2, voffB); PG8_STAGE(PG8_SB(0, 1), b2 + hstepB, voffB); PG8_STAGE(PG8_SA(0, 0), a2, voffA);
            PG8_WAIT_V(8); PG8_WAIT_L(0); PG8_BAR; PG8_MMA(1, 0, At, B0); PG8_MMA(1, 1, At, B1); PG8_BAR; PG8_SCHED;
            PG8_LDB(B0, 1, 0); PG8_LDB(B1, 1, 1); PG8_SCHED; PG8_LDA(At, 1, 0); PG8_STAGE(PG8_SA(0, 1), a2 + hstepA, voffA);
            PG8_WAIT_V(8); PG8_WAIT_L(0); PG8_BAR; PG8_MMA(0, 0, At, B0); PG8_MMA(0, 1, At, B1); PG8_BAR; PG8_SCHED;
            PG8_LDA(At, 1, 1); PG8_STAGE(PG8_SB(1, 0), b3, voffB); PG8_STAGE(PG8_SB(1, 1), b3 + hstepB, voffB); PG8_STAGE(PG8_SA(1, 0), a3, voffA);
            PG8_WAIT_V(8); PG8_WAIT_L(0); PG8_BAR; PG8_MMA(1, 0, At, B0); PG8_MMA(1, 1, At, B1); PG8_BAR; PG8_SCHED;
            } else {
            PG8_LDB(B0, 0, 0); PG8_SCHED; PG8_LDA(At, 0, 0); PG8_STAGE(PG8_SA(1, 1), a1 + hstepA, voffA);
            PG8_WAIT_L(8); PG8_BAR; PG8_WAIT_L(0); PG8_MMA(0, 0, At, B0); PG8_BAR; PG8_SCHED;
            PG8_LDB(B1, 0, 1); PG8_STAGE(PG8_SB(0, 0), b2, voffB);
            PG8_BAR; PG8_WAIT_L(0); PG8_MMA(0, 1, At, B1); PG8_BAR;
            PG8_LDA(At, 0, 1); PG8_STAGE(PG8_SA(0, 0), a2, voffA);
            PG8_BAR; PG8_WAIT_L(0); PG8_MMA(1, 0, At, B0); PG8_BAR; PG8_SCHED;
            PG8_STAGE(PG8_SB(0, 1), b2 + hstepB, voffB);
            PG8_WAIT_V(6); PG8_BAR; PG8_MMA(1, 1, At, B1); PG8_BAR;
            PG8_LDB(B0, 1, 0); PG8_SCHED; PG8_LDA(At, 1, 0); PG8_STAGE(PG8_SA(0, 1), a2 + hstepA, voffA);
            PG8_WAIT_L(8); PG8_BAR; PG8_WAIT_L(0); PG8_MMA(0, 0, At, B0); PG8_BAR; PG8_SCHED;
            PG8_LDB(B1, 1, 1); PG8_STAGE(PG8_SB(1, 0), b3, voffB);
            PG8_BAR; PG8_WAIT_L(0); PG8_MMA(0, 1, At, B1); PG8_BAR;
            PG8_LDA(At, 1, 1); PG8_STAGE(PG8_SA(1, 0), a3, voffA);
            PG8_BAR; PG8_WAIT_L(0); PG8_MMA(1, 0, At, B0); PG8_BAR; PG8_SCHED;
            PG8_STAGE(PG8_SB(1, 1), b3 + hstepB, voffB);
            PG8_WAIT_V(6); PG8_BAR; PG8_MMA(1, 1, At, B1); PG8_BAR;
            }
        }
        if constexpr (ALIGN_EPI) { if (wr == 0) PG8_BAR; }
        if constexpr (!Epi::AFTER_DRAIN) { E(acc, cur, wr, wc, fr, fq); S.done(cur); }
        if (!has_next) break;
#pragma unroll
        for (int a = 0; a < 2; ++a)
#pragma unroll
            for (int b = 0; b < 2; ++b)
#pragma unroll
                for (int m = 0; m < 4; ++m)
#pragma unroll
                    for (int n = 0; n < 2; ++n) acc[a][b][m][n] = (f32x4){0.f, 0.f, 0.f, 0.f};
        cur = nxt; cA = nA; cB = nB; ++ui;
        if constexpr (ALIGN_EPI) { if (wr == 1) PG8_BAR; }
    }
    PG8_WAIT_V(0);
    if constexpr (!ALIGN_EPI) { if (wr == 0) PG8_BAR; }
    PG8_BAR;
    if constexpr (Epi::AFTER_DRAIN) { E.fused(acc, cur, wr, wc, fr, fq, lds, wid, lane); S.done(cur); }
#undef PG8_SA
#undef PG8_SB
#undef PG8_STAGE
#undef PG8_LDA
#undef PG8_LDB
#undef PG8_MMA
#undef PG8_WAIT_V
#undef PG8_WAIT_L
#undef PG8_BAR
#undef PG8_SCHED
}
}
#define PG8_SP2 true
#define PG8_ALIGN true
#define GAS __attribute__((address_space(1)))
#define LAS __attribute__((address_space(3)))
typedef unsigned short bf16;
typedef unsigned v4u __attribute__((ext_vector_type(4)));
typedef float f32x4 __attribute__((ext_vector_type(4)));
typedef short bf16x8 __attribute__((ext_vector_type(8)));
typedef GAS unsigned gu32;
typedef GAS unsigned long long gu64;
#define RLX_AGENT __ATOMIC_RELAXED, __HIP_MEMORY_SCOPE_AGENT
#define LDS_WAIT() asm volatile("s_waitcnt lgkmcnt(0)" ::: "memory")
#define VM_WAIT() asm volatile("s_waitcnt vmcnt(0)" ::: "memory")
__device__ __forceinline__ unsigned long long rt() { return __builtin_amdgcn_s_memrealtime(); }
__device__ __forceinline__ unsigned f2bf(float f) { unsigned u = __builtin_bit_cast(unsigned, f); return (u + 0x7fffu + ((u >> 16) & 1u)) >> 16; }
__device__ __forceinline__ unsigned pk2(float lo, float hi) { return f2bf(lo) | (f2bf(hi) << 16); }
#define XB_TMO      128
#define XB_XCNT(j)  (256  + 64 * (j))
#define XB_XSUB(j)  (1280 + 64 * (j))
#define XB_XGEN(j)  (2304 + 64 * (j))
#define XB_TOP      3328
#define XB_TOPGEN   3392
#define XCD_BAR_WORDS 3456
#define XB_SPIN_CAP (1u << 18)

__device__ __forceinline__ unsigned xb_ld(unsigned* p)              { return __hip_atomic_load(p, __ATOMIC_RELAXED, __HIP_MEMORY_SCOPE_AGENT); }
__device__ __forceinline__ unsigned xb_add(unsigned* p, unsigned v) { return __hip_atomic_fetch_add(p, v, __ATOMIC_RELAXED, __HIP_MEMORY_SCOPE_AGENT); }
__device__ __forceinline__ unsigned xb_xcc_id() { return (unsigned)__builtin_amdgcn_s_getreg((3 << 11) | 20) & 0xFu; }
#define XB_SPIN(cond, bar) do { unsigned _sp = 0; while (cond) { __builtin_amdgcn_s_sleep(1); \
    if ((++_sp & 255u) == 0u) { if (xb_ld(&(bar)[XB_TMO])) break; if (_sp > XB_SPIN_CAP) { atomicAdd(&(bar)[XB_TMO], 1u); break; } } } } while (0)

struct XcdBarrier {
    unsigned* bar; unsigned x;
    volatile LAS unsigned* st;
};

__device__ __forceinline__ XcdBarrier xcd_barrier_post(unsigned* bar, volatile LAS unsigned* st) {
    XcdBarrier b; b.bar = bar; b.x = xb_xcc_id(); b.st = st;
    if (threadIdx.x == 0) (void)xb_add(&bar[XB_XCNT(b.x)], 1u);
    return b;
}
__device__ __forceinline__ void xcd_barrier_complete(unsigned* bar, unsigned x, unsigned& nloc, unsigned& nx) {
    const unsigned G = gridDim.x * gridDim.y * gridDim.z;
    unsigned sum, cnt, mine, sp = 0u;
    for (;;) {
        sum = 0u; cnt = 0u; mine = 0u;
#pragma unroll
        for (unsigned j = 0; j < 16; ++j) { const unsigned c = xb_ld(&bar[XB_XCNT(j)]); sum += c; cnt += (c > 0u) ? 1u : 0u; mine = (j == x) ? c : mine; }
        if (sum == G) break;
        __builtin_amdgcn_s_sleep(1);
        if ((++sp & 255u) == 0u) { if (xb_ld(&bar[XB_TMO])) break; if (sp > XB_SPIN_CAP) { atomicAdd(&bar[XB_TMO], 1u); break; } }
    }
    nloc = mine > 0u ? mine : 1u; nx = cnt > 0u ? cnt : 1u;
}

__device__ __forceinline__ void xcd_barrier(const XcdBarrier& b) {
    asm volatile("s_waitcnt vmcnt(0)" ::: "memory");
    __syncthreads();
    if (threadIdx.x == 0) {
        unsigned* bar = b.bar;
        __builtin_amdgcn_s_waitcnt(0);
        unsigned nloc = b.st[0], nx = b.st[1];
        if (nloc == 0u) { xcd_barrier_complete(bar, b.x, nloc, nx); b.st[0] = nloc; b.st[1] = nx; }
        const unsigned old = xb_add(&bar[XB_XSUB(b.x)], 1u);
        const unsigned gen = old / nloc;
        if (old + 1u == (gen + 1u) * nloc) {
            __builtin_amdgcn_fence(__ATOMIC_RELEASE, "agent");
            asm volatile("s_waitcnt vmcnt(0)" ::: "memory");
            const unsigned og = xb_add(&bar[XB_TOP], 1u);
            const unsigned tg = og / nx;
            if (og + 1u == (tg + 1u) * nx) xb_add(&bar[XB_TOPGEN], 1u);
            else XB_SPIN(xb_ld(&bar[XB_TOPGEN]) == tg, bar);
            __builtin_amdgcn_fence(__ATOMIC_ACQUIRE, "agent");
            xb_add(&bar[XB_XGEN(b.x)], 1u);
            asm volatile("s_waitcnt vmcnt(0)" ::: "memory");
        } else {
            XB_SPIN(xb_ld(&bar[XB_XGEN(b.x)]) == gen, bar);
            __builtin_amdgcn_fence(__ATOMIC_ACQUIRE, "agent");
            asm volatile("s_waitcnt vmcnt(0)" ::: "memory");
        }
    }
    __syncthreads();
}
constexpr int NB = 4, SEQ = 4096, CTXL = 256, TPB = SEQ + CTXL, NROWS = NB * TPB, DM = 1024, NLAYER = 2, IN_COLS = 6816;
constexpr int NWAVES = 8, NTHREADS = NWAVES * 64;
constexpr float RMS_EPS = 1e-6f;
constexpr float LOG2E = 1.4426950408889634f;
constexpr float QSCALE64 = 0.125f * LOG2E;
constexpr float QSCALE96 = 0.10206207261596575f * LOG2E;
constexpr int ZS_P = 1792, ZC_CQ = 0, ZC_CKV = 256, ZC_KR = 384, ZC_SQ = 512, ZC_SK = 768, ZC_SV = 896, ZC_AQ = 1024, ZC_AK = 1280, ZC_AV = 1408, ZC_LRU = 1536;
constexpr int N1 = 2816;
constexpr int W1ROWS = N1 + 4096;
constexpr size_t MiB = 1u << 20;
constexpr size_t WS_CTL = 0, CTL_ZERO_BYTES = 64 * 1024;
constexpr size_t WS_MOD = 1 * MiB;
constexpr size_t WS_RHC = 1 * MiB + 256 * 1024, WS_RHS = WS_RHC + 512 * 1024;
constexpr size_t WS_RMC = WS_RHS + 512 * 1024, WS_RMS = WS_RMC + 256 * 1024;
constexpr size_t WS_CTX1 = 3 * MiB;
constexpr size_t WS_W = 8 * MiB, W_LAYER = 18 * MiB;
constexpr size_t WO_W1 = 0, WO_WB = 13 * MiB + 512 * 1024, WO_WO = WO_WB + 2 * MiB, WO_UQ = WO_WO + 2 * MiB, WO_UKV = WO_UQ + 256 * 1024;
constexpr size_t WS_H = 44 * MiB;
constexpr size_t WS_G = 78 * MiB;
constexpr size_t WS_S = 112 * MiB;
constexpr size_t WS_ZS = 112 * MiB;
constexpr size_t WS_MQ = 172 * MiB;
constexpr size_t WS_MKV = 189 * MiB;
constexpr size_t WS_MK = 206 * MiB;
constexpr size_t WS_U = 219 * MiB;
constexpr size_t WS_HF = 236 * MiB;
constexpr size_t WS_SP = 2 * MiB + 768 * 1024;
constexpr size_t WS_LWT = 254 * MiB + 512 * 1024;
constexpr size_t WS_END = 256 * MiB;
static_assert(WS_H + (size_t)NROWS * 1024 * 2 <= WS_G && WS_G + (size_t)NROWS * 1024 * 2 <= WS_S && WS_S + (size_t)NROWS * 4096 * 2 <= 248 * MiB, "ws map");
static_assert(WS_ZS + (size_t)NROWS * ZS_P * 2 <= WS_MQ && WS_MK + (size_t)NROWS * 384 * 2 <= WS_U, "ws map 2");
static_assert(WO_UKV + 512 * 256 * 2 <= W_LAYER, "weights");
constexpr int CW_BAR = 1024;

constexpr int RING_OFF = 0, RING_BYTES = 131072, LDSCTL_OFF = RING_BYTES, MISC_OFF = LDSCTL_OFF + 320, LDS_BYTES = 147456;

typedef unsigned short bf16;
typedef unsigned u32x2 __attribute__((ext_vector_type(2)));
typedef float f32x2v __attribute__((ext_vector_type(2)));
__device__ __forceinline__ float bf2f(bf16 v) { return __uint_as_float((unsigned)v << 16); }
__device__ __forceinline__ float wave_sum(float v) {
#pragma unroll
    for (int o = 1; o < 64; o <<= 1) v += __shfl_xor(v, o);
    return v; }
__device__ __forceinline__ float wave_max(float v) {
#pragma unroll
    for (int o = 1; o < 64; o <<= 1) v = fmaxf(v, __shfl_xor(v, o));
    return v; }
__device__ __forceinline__ float grp16_sum(float v) {
#pragma unroll
    for (int o = 1; o < 16; o <<= 1) v += __shfl_xor(v, o);
    return v; }

struct Args { const float* in[28]; float* out; unsigned char* ws; int ph_lo, ph_hi; };
enum { I_X = 0, I_C, I_CTX, I_CCTX, I_WMOD, I_BMOD, I_NORMW, I_WIN, I_CQN, I_CKVN, I_WUQ, I_WUKV, I_MQN, I_MKN, I_SQN, I_SKN, I_SINK, I_AQN, I_AKN,
       I_CONVW, I_CONVB, I_LWR, I_LBR, I_LWI, I_LBI, I_LAM, I_WBR, I_WOUT };

struct Frame {
    LAS unsigned char* lds; const float* const __attribute__((address_space(4)))* kin; unsigned char* ws; float* out;
    int tid, lane, wave, G, vcu, gw, NGW, z;
    __device__ __forceinline__ const float* in(int i) const { return kin[i]; }
};

__device__ __forceinline__ void xpose_item(const float* W, int ldn, int k0, int n0, bf16* WT, int pd, int drow, LAS float* scr, int lane) {
#pragma unroll 8
    for (int i = 0; i < 32; ++i) { const int kk = 2 * i + (lane >> 5); scr[kk * 33 + (lane & 31)] = W[(size_t)(k0 + kk) * ldn + n0 + (lane & 31)]; }
    LDS_WAIT(); asm volatile("" ::: "memory");
    const int c = lane & 7;
#pragma unroll
    for (int j = 0; j < 4; ++j) { const int n = (lane >> 3) + 8 * j; const LAS float* s = scr + (8 * c) * 33 + n;
        v4u o; o.x = pk2(s[0 * 33], s[1 * 33]); o.y = pk2(s[2 * 33], s[3 * 33]); o.z = pk2(s[4 * 33], s[5 * 33]); o.w = pk2(s[6 * 33], s[7 * 33]);
        *(GAS v4u*)(WT + (size_t)(drow + n0 + n) * pd + k0 + 8 * c) = o; }
    LDS_WAIT(); asm volatile("" ::: "memory");
}
__device__ __forceinline__ void zero16(bf16* p, size_t n16, int gt, int ngt) {
    for (size_t i = gt; i < n16; i += ngt) ((GAS v4u*)p)[i] = (v4u){0u, 0u, 0u, 0u};
}
__device__ __forceinline__ void weight_copies(Frame& F, int l, int gw, int NGW) {
    LAS float* scr = (LAS float*)(F.lds + RING_OFF + F.wave * 16384);
    constexpr int I_IN = 16 * 213, I_UQ = 4 * 12, I_UKV = 2 * 16, I_BR = 4 * 4 * 32, I_OUT = 16 * 32, I_LAYER = I_IN + I_UQ + I_UKV + I_BR + I_OUT;
    unsigned char* wl = F.ws + WS_W + (size_t)l * W_LAYER;
    for (int it = gw; it < I_LAYER; it += NGW) {
        int r = it;
        if (r < I_IN) { const int kb = r / 213, nb = r % 213, n0 = nb * 32;
            xpose_item(F.in(I_WIN) + (size_t)l * 1024 * IN_COLS, IN_COLS, kb * 64, n0, (bf16*)(wl + WO_W1), 1024, n0 >= 416 ? 96 : 0, scr, F.lane); continue; } r -= I_IN;
        if (r < I_UQ) { const int kb = r / 12, nb = r % 12;
            xpose_item(F.in(I_WUQ) + (size_t)l * 256 * 384, 384, kb * 64, nb * 32, (bf16*)(wl + WO_UQ), 256, 0, scr, F.lane); continue; } r -= I_UQ;
        if (r < I_UKV) { const int kb = r / 16, nb = r % 16;
            xpose_item(F.in(I_WUKV) + (size_t)l * 128 * 512, 512, kb * 64, nb * 32, (bf16*)(wl + WO_UKV), 256, 0, scr, F.lane); continue; } r -= I_UKV;
        if (r < I_BR) { const int k = r / 128, rr = r % 128, kb = rr / 32, nb = rr % 32;
            xpose_item(F.in(I_WBR) + ((size_t)l * 4 + k) * 256 * 1024, 1024, kb * 64, nb * 32, (bf16*)(wl + WO_WB) + (size_t)k * 1024 * 256, 256, 0, scr, F.lane); continue; } r -= I_BR;
        { const int kb = r / 32, nb = r % 32;
            xpose_item(F.in(I_WOUT) + (size_t)l * 1024 * 1024, 1024, kb * 64, nb * 32, (bf16*)(wl + WO_WO), 1024, 0, scr, F.lane); }
    }
}
__device__ __forceinline__ void p0_prologue(Frame& F) {
    weight_copies(F, 0, F.gw, F.NGW);
    const int gt = F.vcu * NTHREADS + F.tid, ngt = F.G * NTHREADS;
    for (int l = 0; l < NLAYER; ++l) {
        unsigned char* wl = F.ws + WS_W + (size_t)l * W_LAYER;
        zero16((bf16*)(wl + WO_W1) + (size_t)416 * 1024, 96 * 1024 * 2 / 16, gt, ngt);
        zero16((bf16*)(wl + WO_UQ) + (size_t)384 * 256, 128 * 256 * 2 / 16, gt, ngt);
        for (int i = gt; i < 512 * 16; i += ngt) { const int n = i >> 4, c = i & 15; ((GAS v4u*)((bf16*)(wl + WO_UKV) + (size_t)n * 256 + 128))[c] = (v4u){0u, 0u, 0u, 0u}; }
    }
    { float* rhc = (float*)(F.ws + WS_RHC); float* rhs = (float*)(F.ws + WS_RHS); float* rmc = (float*)(F.ws + WS_RMC); float* rms = (float*)(F.ws + WS_RMS);
      for (int i = gt; i < 4096 * 32; i += ngt) { const int t = i >> 5, p = i & 31; const float fr = powf(10000.0f, -(float)(p & 15) / 16.0f);
          const float pos = (float)((p < 16) ? (t >> 6) : (t & 63)); const float ang = pos * fr; rhc[i] = cosf(ang); rhs[i] = sinf(ang); }
      for (int i = gt; i < 4096 * 16; i += ngt) { const int t = i >> 4, p = i & 15; const float fr = powf(10000.0f, -(float)(p & 7) / 8.0f);
          const float pos = (float)((p < 8) ? (t >> 6) : (t & 63)); const float ang = pos * fr; rmc[i] = cosf(ang); rms[i] = sinf(ang); } }
    { float* sp = (float*)(F.ws + WS_SP); for (int i = gt; i < NLAYER * 2 * 256; i += ngt) sp[i] = 8.0f * LOG2E * log1pf(expf(-F.in(I_LAM)[i])); }
    { float* lwt = (float*)(F.ws + WS_LWT);
      for (int o = gt; o < NLAYER * 2 * 2 * 256 * 64; o += ngt) { const int i = o & 63, c = (o >> 6) & 255, gate = (o >> 14) & 1, ld = o >> 15, k = c >> 6, j = c & 63;
          lwt[o] = (gate == 0 ? F.in(I_LWR) : F.in(I_LWI))[(((size_t)ld * 4 + k) * 64 + i) * 64 + j]; } }
    { LAS float* sc = (LAS float*)(F.lds + RING_OFF);
      LAS float* red = sc + 5 * 1024;
      __syncthreads();
      for (int i = F.tid; i < 5 * 1024; i += NTHREADS) { const float v = (i < 4096) ? F.in(I_C)[i] : F.in(I_CCTX)[i - 4096]; sc[i] = v / (1.0f + expf(-v)); }
      __syncthreads();
      float* modv = (float*)(F.ws + WS_MOD);
      for (int it = F.vcu; it < NLAYER * 96; it += F.G) {
          const int l = it / 96, n0 = (it % 96) * 32, nn = F.tid & 31, kc = F.tid >> 5;
          const float* w = F.in(I_WMOD) + (size_t)l * 1024 * 3072 + n0 + nn;
          float acc[5] = {0.f, 0.f, 0.f, 0.f, 0.f};
          for (int k = kc * 64; k < kc * 64 + 64; ++k) { const float wv = w[(size_t)k * 3072];
#pragma unroll
              for (int r = 0; r < 5; ++r) acc[r] += sc[r * 1024 + k] * wv; }
#pragma unroll
          for (int r = 0; r < 5; ++r) red[(kc * 5 + r) * 32 + nn] = acc[r];
          __syncthreads();
          if (F.tid < 160) { const int r = F.tid >> 5; float s = 0.f;
              for (int q = 0; q < 16; ++q) s += red[(q * 5 + r) * 32 + nn];
              modv[((size_t)l * 5 + r) * 3072 + n0 + nn] = s + F.in(I_BMOD)[l * 3072 + n0 + nn]; }
          __syncthreads();
      } }
}

__device__ __forceinline__ void ph_hnorm(Frame& F, int l) {
    const float* xs = (l == 0) ? F.in(I_X) : F.out; const float* cs = (l == 0) ? F.in(I_CTX) : (const float*)(F.ws + WS_CTX1);
    const float* nw = F.in(I_NORMW) + l * 1024; const float* modl = (const float*)(F.ws + WS_MOD) + (size_t)l * 5 * 3072;
    bf16* H = (bf16*)(F.ws + WS_H);
    for (int row = F.gw; row < NROWS; row += F.NGW) {
        const int b = row / TPB, j = row % TPB; const float* src; int mr;
        if (j < CTXL) { src = cs + ((size_t)b * CTXL + j) * 1024; mr = 4; } else { src = xs + ((size_t)b * SEQ + (j - CTXL)) * 1024; mr = b; }
        const GAS f32x4* xr = (const GAS f32x4*)src + F.lane;
        f32x4 v[4]; float ss = 0.f;
#pragma unroll
        for (int q = 0; q < 4; ++q) { v[q] = xr[64 * q]; ss += (v[q].x * v[q].x + v[q].y * v[q].y) + (v[q].z * v[q].z + v[q].w * v[q].w); }
        const float rstd = 1.0f / sqrtf(wave_sum(ss) * (1.0f / 1024.0f) + RMS_EPS);
        const float* mrow = modl + mr * 3072;
        GAS unsigned long long* o8 = (GAS unsigned long long*)(H + (size_t)row * 1024) + F.lane;
#pragma unroll
        for (int q = 0; q < 4; ++q) { const int c = 4 * F.lane + 256 * q;
            const f32x4 g = *(const f32x4*)(nw + c), sh = *(const f32x4*)(mrow + c), sc = *(const f32x4*)(mrow + 1024 + c);
            const f32x4 h = v[q] * rstd * g * (sc + 1.0f) + sh;
            o8[64 * q] = (unsigned long long)pk2(h.x, h.y) | ((unsigned long long)pk2(h.z, h.w) << 32); }
    }
}

struct P1Regs { u32x2 cq; unsigned ckv, h[3][2]; float rc[2], rs[2]; };
__device__ __forceinline__ void post1_load(const bf16* z, const float* rc, const float* rs, bool lat, int lane, P1Regs& R) {
    const int hg = lane >> 4, p0 = (lane & 15) * 2;
    R.cq = *(const u32x2*)(z + ZC_CQ + 4 * lane); R.ckv = *(const unsigned*)(z + ZC_CKV + 2 * lane);
    const bf16* h0 = z + ZC_SQ + hg * 64 + p0; const bf16* h1 = z + ZC_AQ + hg * 64 + p0; const bf16* h2 = z + ((hg < 2) ? (ZC_SK + hg * 64) : (ZC_AK + (hg - 2) * 64)) + p0;
    R.h[0][0] = *(const unsigned*)h0; R.h[0][1] = *(const unsigned*)(h0 + 32); R.h[1][0] = *(const unsigned*)h1; R.h[1][1] = *(const unsigned*)(h1 + 32); R.h[2][0] = *(const unsigned*)h2; R.h[2][1] = *(const unsigned*)(h2 + 32);
    if (lat) { R.rc[0] = rc[p0]; R.rc[1] = rc[p0 + 1]; R.rs[0] = rs[p0]; R.rs[1] = rs[p0 + 1]; } else { R.rc[0] = 1.f; R.rc[1] = 1.f; R.rs[0] = 0.f; R.rs[1] = 0.f; }
}
__device__ __forceinline__ void post1_finish(bf16* z, int lane, const P1Regs& R, const float (&gcq)[4], const float (&gckv)[2], const float (&gh)[3][4]) {
    const int hg = lane >> 4, p0 = (lane & 15) * 2;
    { float v0 = bflo(R.cq.x), v1 = bfhi(R.cq.x), v2 = bflo(R.cq.y), v3 = bfhi(R.cq.y);
      const float rstd = 1.0f / sqrtf(wave_sum(v0 * v0 + v1 * v1 + v2 * v2 + v3 * v3) * (1.0f / 256.0f) + RMS_EPS);
      u32x2 w; w.x = pk2(v0 * rstd * gcq[0], v1 * rstd * gcq[1]); w.y = pk2(v2 * rstd * gcq[2], v3 * rstd * gcq[3]); *(u32x2*)(z + ZC_CQ + 4 * lane) = w; }
    { float v0 = bflo(R.ckv), v1 = bfhi(R.ckv);
      const float rstd = 1.0f / sqrtf(wave_sum(v0 * v0 + v1 * v1) * (1.0f / 128.0f) + RMS_EPS);
      *(unsigned*)(z + ZC_CKV + 2 * lane) = pk2(v0 * rstd * gckv[0], v1 * rstd * gckv[1]); }
#pragma unroll
    for (int q = 0; q < 3; ++q) {
        bf16* hp = z + ((q == 0) ? (ZC_SQ + hg * 64) : (q == 1) ? (ZC_AQ + hg * 64) : ((hg < 2) ? (ZC_SK + hg * 64) : (ZC_AK + (hg - 2) * 64))) + p0;
        float a0 = bflo(R.h[q][0]), a1 = bfhi(R.h[q][0]), b0 = bflo(R.h[q][1]), b1 = bfhi(R.h[q][1]);
        const float rstd = 1.0f / sqrtf(grp16_sum(a0 * a0 + a1 * a1 + b0 * b0 + b1 * b1) * (1.0f / 64.0f) + RMS_EPS);
        a0 *= rstd * gh[q][0]; a1 *= rstd * gh[q][1]; b0 *= rstd * gh[q][2]; b1 *= rstd * gh[q][3];
        const float x0 = a0 * R.rc[0] - b0 * R.rs[0], y0 = b0 * R.rc[0] + a0 * R.rs[0], x1 = a1 * R.rc[1] - b1 * R.rs[1], y1 = b1 * R.rc[1] + a1 * R.rs[1];
        const float sc = (q < 2) ? QSCALE64 : 1.0f;
        *(unsigned*)hp = pk2(x0 * sc, x1 * sc); *(unsigned*)(hp + 32) = pk2(y0 * sc, y1 * sc);
    }
}
__device__ __forceinline__ void ph_post1(Frame& F, int l) {
    bf16* ZS = (bf16*)(F.ws + WS_ZS);
    const float* rhc = (const float*)(F.ws + WS_RHC); const float* rhs = (const float*)(F.ws + WS_RHS);
    const int lane = F.lane, hg = lane >> 4, p0 = (lane & 15) * 2;
    float gcq[4], gckv[2], gh[3][4];
#pragma unroll
    for (int i = 0; i < 4; ++i) gcq[i] = F.in(I_CQN)[l * 256 + 4 * lane + i];
    gckv[0] = F.in(I_CKVN)[l * 128 + 2 * lane]; gckv[1] = F.in(I_CKVN)[l * 128 + 2 * lane + 1];
    { const float* g0 = F.in(I_SQN) + l * 64; const float* g1 = F.in(I_AQN) + l * 64; const float* g2 = ((hg < 2) ? F.in(I_SKN) : F.in(I_AKN)) + l * 64;
      gh[0][0] = g0[p0]; gh[0][1] = g0[p0 + 1]; gh[0][2] = g0[32 + p0]; gh[0][3] = g0[33 + p0];
      gh[1][0] = g1[p0]; gh[1][1] = g1[p0 + 1]; gh[1][2] = g1[32 + p0]; gh[1][3] = g1[33 + p0];
      gh[2][0] = g2[p0]; gh[2][1] = g2[p0 + 1]; gh[2][2] = g2[32 + p0]; gh[2][3] = g2[33 + p0]; }
    for (int row = F.gw; row < NROWS; row += 2 * F.NGW) {
        const int row2 = row + F.NGW; const bool has2 = row2 < NROWS;
        const int j = row % TPB; const bool lat = j >= CTXL; const int pos = lat ? j - CTXL : 0;
        const int j2 = has2 ? row2 % TPB : 0; const bool lat2 = j2 >= CTXL; const int pos2 = lat2 ? j2 - CTXL : 0;
        bf16* z = ZS + (size_t)row * ZS_P; bf16* z2 = ZS + (size_t)(has2 ? row2 : row) * ZS_P;
        P1Regs A, B;
        post1_load(z, rhc + pos * 32, rhs + pos * 32, lat, lane, A);
        if (has2) post1_load(z2, rhc + pos2 * 32, rhs + pos2 * 32, lat2, lane, B);
        post1_finish(z, lane, A, gcq, gckv, gh);
        if (has2) post1_finish(z2, lane, B, gcq, gckv, gh);
    }
}
struct P2Regs { u32x2 qn, kn; bf16 q1, q2, k1, k2; float c, s; };
__device__ __forceinline__ void post2_load(const bf16* zrow, const bf16* mq, const bf16* mkv, const float* rc, const float* rs, bool lat, int lane, P2Regs& R) {
    const int h = lane >> 4, j = lane & 15;
    R.qn = *(const u32x2*)(mq + h * 96 + 4 * j); R.q1 = mq[h * 96 + 64 + j]; R.q2 = mq[h * 96 + 80 + j];
    R.kn = *(const u32x2*)(mkv + h * 128 + 4 * j); R.k1 = zrow[ZC_KR + j]; R.k2 = zrow[ZC_KR + 16 + j];
    if (lat) { R.c = rc[j]; R.s = rs[j]; } else { R.c = 1.f; R.s = 0.f; }
}
__device__ __forceinline__ void post2_finish(bf16* mq, bf16* mk, int lane, const P2Regs& R, const float (&gq)[6], const float (&gk)[6]) {
    const int h = lane >> 4, j = lane & 15;
#pragma unroll
    for (int qk = 0; qk < 2; ++qk) {
        const u32x2 n = qk == 0 ? R.qn : R.kn; float v0 = bflo(n.x), v1 = bfhi(n.x), v2 = bflo(n.y), v3 = bfhi(n.y), r1 = bf2f(qk == 0 ? R.q1 : R.k1), r2 = bf2f(qk == 0 ? R.q2 : R.k2);
        const float rstd = 1.0f / sqrtf(grp16_sum(v0 * v0 + v1 * v1 + v2 * v2 + v3 * v3 + r1 * r1 + r2 * r2) * (1.0f / 96.0f) + RMS_EPS);
        const float (&g)[6] = qk == 0 ? gq : gk; const float sc = qk == 0 ? QSCALE96 : 1.0f;
        const float y1 = r1 * rstd * g[4], y2 = r2 * rstd * g[5];
        const float t1 = (y1 * R.c - y2 * R.s) * sc, t2 = (y2 * R.c + y1 * R.s) * sc;
        bf16* o = (qk == 0 ? mq : mk) + h * 96;
        u32x2 w; w.x = pk2(v0 * rstd * g[0] * sc, v1 * rstd * g[1] * sc); w.y = pk2(v2 * rstd * g[2] * sc, v3 * rstd * g[3] * sc);
        *(u32x2*)(o + 4 * j) = w; o[64 + j] = (bf16)f2bf(t1); o[80 + j] = (bf16)f2bf(t2);
    }
}
__device__ __forceinline__ void ph_post2(Frame& F, int l) {
    const bf16* ZS = (const bf16*)(F.ws + WS_ZS); bf16* MQ = (bf16*)(F.ws + WS_MQ); const bf16* MKV = (const bf16*)(F.ws + WS_MKV); bf16* MK = (bf16*)(F.ws + WS_MK);
    const float* rmc = (const float*)(F.ws + WS_RMC); const float* rms = (const float*)(F.ws + WS_RMS);
    const int lane = F.lane, jj = lane & 15;
    float gq[6], gk[6];
    { const float* a = F.in(I_MQN) + l * 96; const float* b = F.in(I_MKN) + l * 96;
#pragma unroll
      for (int i = 0; i < 4; ++i) { gq[i] = a[4 * jj + i]; gk[i] = b[4 * jj + i]; }
      gq[4] = a[64 + jj]; gq[5] = a[80 + jj]; gk[4] = b[64 + jj]; gk[5] = b[80 + jj]; }
    for (int row = F.gw; row < NROWS; row += 2 * F.NGW) {
        const int row2 = row + F.NGW; const bool has2 = row2 < NROWS; const size_t rb = has2 ? row2 : row;
        const int j = row % TPB; const bool lat = j >= CTXL; const int pos = lat ? j - CTXL : 0;
        const int j2 = (int)(rb % TPB); const bool lat2 = j2 >= CTXL; const int pos2 = lat2 ? j2 - CTXL : 0;
        P2Regs A, B;
        post2_load(ZS + (size_t)row * ZS_P, MQ + (size_t)row * 512, MKV + (size_t)row * 512, rmc + pos * 16, rms + pos * 16, lat, lane, A);
        if (has2) post2_load(ZS + rb * ZS_P, MQ + rb * 512, MKV + rb * 512, rmc + pos2 * 16, rms + pos2 * 16, lat2, lane, B);
        post2_finish(MQ + (size_t)row * 512, MK + (size_t)row * 384, lane, A, gq, gk);
        if (has2) post2_finish(MQ + rb * 512, MK + rb * 384, lane, B, gq, gk);
    }
}

template <int DQK>
__device__ __forceinline__ void attn_row_naive(const bf16* q, const bf16* Kb, int kp, const bf16* Vb, int vp, int n1, int lo2, int hi2, bool has_sink, float sink2, bf16* y, int lane) {
    float qf[DQK];
#pragma unroll
    for (int c = 0; c < DQK / 8; ++c) { const v4u w = *(const v4u*)(q + 8 * c);
        qf[8 * c + 0] = bflo(w.x); qf[8 * c + 1] = bfhi(w.x); qf[8 * c + 2] = bflo(w.y); qf[8 * c + 3] = bfhi(w.y); qf[8 * c + 4] = bflo(w.z); qf[8 * c + 5] = bfhi(w.z); qf[8 * c + 6] = bflo(w.w); qf[8 * c + 7] = bfhi(w.w); }
    float m = -INFINITY, l = 0.f; float acc[64];
#pragma unroll
    for (int d = 0; d < 64; ++d) acc[d] = 0.f;
    for (int seg = 0; seg < 2; ++seg) {
        const int k0 = seg == 0 ? 0 : lo2, k1 = seg == 0 ? n1 : hi2;
        for (int key = k0 + lane; key < k1; key += 64) {
            const bf16* kr = Kb + (size_t)key * kp; float s = 0.f;
#pragma unroll
            for (int c = 0; c < DQK / 8; ++c) { const v4u w = *(const v4u*)(kr + 8 * c);
                s += qf[8 * c + 0] * bflo(w.x) + qf[8 * c + 1] * bfhi(w.x) + qf[8 * c + 2] * bflo(w.y) + qf[8 * c + 3] * bfhi(w.y) + qf[8 * c + 4] * bflo(w.z) + qf[8 * c + 5] * bfhi(w.z) + qf[8 * c + 6] * bflo(w.w) + qf[8 * c + 7] * bfhi(w.w); }
            if (s > m) { const float f = exp2f(m - s); l *= f;
#pragma unroll
                for (int d = 0; d < 64; ++d) acc[d] *= f;
                m = s; }
            const float p = exp2f(s - m); l += p;
            const bf16* vr = Vb + (size_t)key * vp;
#pragma unroll
            for (int c = 0; c < 8; ++c) { const v4u w = *(const v4u*)(vr + 8 * c);
                acc[8 * c + 0] += p * bflo(w.x); acc[8 * c + 1] += p * bfhi(w.x); acc[8 * c + 2] += p * bflo(w.y); acc[8 * c + 3] += p * bfhi(w.y); acc[8 * c + 4] += p * bflo(w.z); acc[8 * c + 5] += p * bfhi(w.z); acc[8 * c + 6] += p * bflo(w.w); acc[8 * c + 7] += p * bfhi(w.w); }
        }
    }
    float M = wave_max(m); if (has_sink) M = fmaxf(M, sink2);
    const float f = (m == -INFINITY) ? 0.f : exp2f(m - M);
    float L = wave_sum(l * f); if (has_sink) L += exp2f(sink2 - M);
    float mine = 0.f;
#pragma unroll
    for (int d = 0; d < 64; ++d) { const float t = wave_sum(acc[d] * f); if (lane == d) mine = t; }
    y[lane] = (bf16)f2bf(mine / L * bf2f(y[lane]));
}
__device__ __forceinline__ void ph_attn_naive(Frame& F, int l) {
    const bf16* ZS = (const bf16*)(F.ws + WS_ZS); const bf16* MQ = (const bf16*)(F.ws + WS_MQ); const bf16* MKV = (const bf16*)(F.ws + WS_MKV); const bf16* MK = (const bf16*)(F.ws + WS_MK);
    bf16* Y = (bf16*)(F.ws + WS_G);
    const long nitems = (long)NROWS * 12;
    for (long it = F.gw; it < nitems; it += F.NGW) {
        const int hb = (int)(it % 12); const int row = (int)(it / 12);
        const int b = row / TPB, j = row % TPB; const bool lat = j >= CTXL;
        if (!lat && l == NLAYER - 1) continue;
        const size_t r0 = (size_t)b * TPB;
        const int br = hb >> 2, h = hb & 3;
        bf16* y = Y + (size_t)row * 1024 + br * 256 + h * 64;
        if (br == 0) {
            attn_row_naive<96>(MQ + (size_t)row * 512 + h * 96, MK + r0 * 384 + h * 96, 384, MKV + r0 * 512 + h * 128 + 64, 512, CTXL, CTXL, lat ? TPB : CTXL, false, 0.f, y, F.lane);
        } else if (br == 1) {
            const int t = j - CTXL; int lo = CTXL, hi = CTXL;
            if (lat) { lo = CTXL + (t - 128 < 0 ? 0 : t - 128); hi = CTXL + (t + 128 > SEQ - 1 ? SEQ - 1 : t + 128) + 1; }
            attn_row_naive<64>(ZS + (size_t)row * ZS_P + ZC_SQ + h * 64, ZS + r0 * ZS_P + ZC_SK + (h >> 1) * 64, ZS_P, ZS + r0 * ZS_P + ZC_SV + (h >> 1) * 64, ZS_P, CTXL, lo, hi, true, F.in(I_SINK)[l * 4 + h] * LOG2E, y, F.lane);
        } else {
            attn_row_naive<64>(ZS + (size_t)row * ZS_P + ZC_AQ + h * 64, ZS + r0 * ZS_P + ZC_AK + (h >> 1) * 64, ZS_P, ZS + r0 * ZS_P + ZC_AV + (h >> 1) * 64, ZS_P, CTXL, CTXL, lat ? TPB : CTXL, false, 0.f, y, F.lane);
        }
    }
}

__device__ __forceinline__ void ph_lru_conv(Frame& F, int l) {
    const bf16* ZS = (const bf16*)(F.ws + WS_ZS); float* U = (float*)(F.ws + WS_U);
    const float* cw = F.in(I_CONVW) + l * 4 * 256; const float* cb = F.in(I_CONVB) + l * 256;
    const int gt = F.vcu * NTHREADS + F.tid, ngt = F.G * NTHREADS;
    for (int idx = gt; idx < NROWS * 256; idx += ngt) {
        const int row = idx >> 8, c = idx & 255, b = row / TPB, j = row % TPB;
        int s0, len, jj; if (j < CTXL) { s0 = b * TPB; len = CTXL; jj = j; } else { s0 = b * TPB + CTXL; len = SEQ; jj = j - CTXL; }
        float acc = cb[c];
#pragma unroll
        for (int i = 0; i < 4; ++i) { const int t = jj + i - 2; if (t >= 0 && t < len) acc += cw[i * 256 + c] * bf2f(ZS[(size_t)(s0 + t) * ZS_P + ZC_LRU + c]); }
        U[idx] = acc;
    }
}
__device__ __forceinline__ void ph_lru_scan(Frame& F, int l, int dir) {
    const float* U = (const float*)(F.ws + WS_U); float* HF = (float*)(F.ws + WS_HF); bf16* Y = (bf16*)(F.ws + WS_G);
    const int g = blockIdx.x * NTHREADS + F.tid;
    if (g < NB * 256) {
    const int b = g >> 8, c = g & 255, k = c >> 6, jc = c & 63;
    const float* wr = F.in(I_LWR) + ((((size_t)l * 2 + dir) * 4 + k) * 64) * 64 + jc;
    const float* wi = F.in(I_LWI) + ((((size_t)l * 2 + dir) * 4 + k) * 64) * 64 + jc;
    float wrr[64], wii[64];
#pragma unroll
    for (int i = 0; i < 64; ++i) { wrr[i] = wr[i * 64]; wii[i] = wi[i * 64]; }
    const float br = F.in(I_LBR)[(l * 2 + dir) * 256 + c], bi = F.in(I_LBI)[(l * 2 + dir) * 256 + c];
    const float lam = F.in(I_LAM)[(l * 2 + dir) * 256 + c];
    const float sp = log1pf(expf(-lam));
    float h = 0.f;
    for (int s = 0; s < TPB; ++s) {
        const int j = dir == 0 ? s : (s < CTXL ? CTXL - 1 - s : TPB + CTXL - 1 - s);
        const size_t row = (size_t)b * TPB + j;
        const float* ub = U + row * 256 + k * 64;
        float rp = br, ip = bi;
#pragma unroll
        for (int i = 0; i < 64; ++i) { const float uv = ub[i]; rp += uv * wrr[i]; ip += uv * wii[i]; }
        const float r = 1.0f / (1.0f + expf(-rp)), ig = 1.0f / (1.0f + expf(-ip));
        const float la = -8.0f * r * sp; const float a = expf(la);
        const float bx = sqrtf(-expm1f(2.0f * la)) * (ig * ub[jc]);
        h = a * h + bx;
        if (dir == 0) HF[row * 256 + c] = h;
        else { bf16* y = Y + row * 1024 + 768 + c; *y = (bf16)f2bf((HF[row * 256 + c] + h) * bf2f(*y)); }
    }
    }
}
__device__ __forceinline__ void ph_mixsum_ctx(Frame& F) {
    const bf16* S = (const bf16*)(F.ws + WS_S); bf16* MIX = (bf16*)(F.ws + WS_H);
    const int gt = F.vcu * NTHREADS + F.tid, ngt = F.G * NTHREADS;
    for (int idx = gt; idx < NB * CTXL * 128; idx += ngt) {
        const int r = idx >> 7, c8 = (idx & 127) * 8; const size_t row = (size_t)(r >> 8) * TPB + (r & 255); float s[8] = {0.f, 0.f, 0.f, 0.f, 0.f, 0.f, 0.f, 0.f};
#pragma unroll
        for (int k = 0; k < 4; ++k) { const v4u w = *(const GAS v4u*)(S + row * 4096 + k * 1024 + c8);
            s[0] += bflo(w.x); s[1] += bfhi(w.x); s[2] += bflo(w.y); s[3] += bfhi(w.y); s[4] += bflo(w.z); s[5] += bfhi(w.z); s[6] += bflo(w.w); s[7] += bfhi(w.w); }
        v4u o; o.x = pk2(s[0], s[1]); o.y = pk2(s[2], s[3]); o.z = pk2(s[4], s[5]); o.w = pk2(s[6], s[7]);
        *(GAS v4u*)(MIX + row * 1024 + c8) = o;
    }
}
namespace att {
typedef short bf16x8 __attribute__((ext_vector_type(8)));
typedef short s16x4 __attribute__((ext_vector_type(4)));
typedef short v4i16_t __attribute__((ext_vector_type(4)));
typedef float f32x16 __attribute__((ext_vector_type(16)));
typedef unsigned u32x4 __attribute__((ext_vector_type(4)));
typedef __attribute__((address_space(3))) const char* lds_cptr;
typedef float f32x2_t __attribute__((ext_vector_type(2))); typedef __bf16 bf16x2_t __attribute__((ext_vector_type(2)));
__device__ __forceinline__ int crow(int r, int hi) { return (r & 3) + 8 * (r >> 2) + 4 * hi; }
__device__ __forceinline__ void glds16(const void* gsrc, unsigned lds_dst) { unsigned keep;
    asm volatile("s_mov_b32 %0, m0\n\ts_mov_b32 m0, %2\n\ts_nop 0\n\tglobal_load_lds_dwordx4 %1, off\n\ts_mov_b32 m0, %0" : "=&s"(keep) : "v"(gsrc), "s"(lds_dst) : "memory"); }
__device__ __forceinline__ unsigned cvtpk(float lo, float hi) { f32x2_t v = {lo, hi}; bf16x2_t b = __builtin_convertvector(v, bf16x2_t); return __builtin_bit_cast(unsigned, b); }
__device__ __forceinline__ s16x4 vtr(lds_cptr p) { return __builtin_bit_cast(s16x4, __builtin_amdgcn_ds_read_tr16_b64_v4i16((__attribute__((address_space(3))) v4i16_t*)p)); }
__device__ __forceinline__ float halfswap_max(float m) { auto rr = __builtin_amdgcn_permlane32_swap(__float_as_uint(m), __float_as_uint(m), false, false); return fmaxf(__uint_as_float(rr[0]), __uint_as_float(rr[1])); }
__device__ __forceinline__ float halfswap_sum(float m) { auto rr = __builtin_amdgcn_permlane32_swap(__float_as_uint(m), __float_as_uint(m), false, false); return __uint_as_float(rr[0]) + __uint_as_float(rr[1]); }

template <int DQK> struct Cfg {
    static constexpr int KCH = DQK / 8, KSLOT = KCH * 1024, NKI = (KCH + 7) / 8, NI = NKI + 1;
    static constexpr int LDS_K = 0, LDS_V = 3 * KSLOT, LDS_WS = LDS_V + 3 * 8192, LDS_OST = LDS_WS + 8 * 256, BYTES = LDS_OST + 8 * 4096;
};
#define ATT_WAIT_BAR(N) asm volatile("s_waitcnt vmcnt(" #N ") lgkmcnt(0)\n\ts_barrier" ::: "memory")

struct UnitDesc {
    const unsigned short* Q; int qp;
    const unsigned short* K; int kp;
    const unsigned short* V; int vp;
    unsigned short* Y;
    int NT;
    int lat_row0;
    int qpos0, spos0;
    int has_sink; float sink2;
};

constexpr float ATT_THR = 6.0f;
template <int DQK, bool SWA>
__device__ __forceinline__ void attn_unit(LAS unsigned char* ldsb, const UnitDesc& U, const int tid) {
    using C = Cfg<DQK>;
    const int lane = tid & 63, r32 = lane & 31, hi = lane >> 5; const int wid = __builtin_amdgcn_readfirstlane(tid >> 6);
    const unsigned lds0 = (unsigned)(uintptr_t)ldsb;
    LAS float* wsf = (LAS float*)(ldsb + C::LDS_WS) + wid * 64;
    const int kp = U.kp, vp = U.vp;
    const int kc1 = (C::NKI == 2 && wid < 4) ? wid + 8 : wid;
    const unsigned short* ksrc0 = U.K + (size_t)lane * kp + wid * 8;
    const unsigned short* ksrc1 = U.K + (size_t)lane * kp + kc1 * 8;
    const unsigned short* vsrc = U.V + (size_t)(16 * (wid & 3) + (lane >> 2)) * vp + (wid >> 2) * 32 + (lane & 3) * 8;
    const unsigned kdst0 = lds0 + C::LDS_K + wid * 1024, kdst1 = lds0 + C::LDS_K + kc1 * 1024, vdst = lds0 + C::LDS_V + wid * 1024;
    const int NT = U.NT;
#define ATT_KROW(t) (SWA ? ((t) < 4 ? 64 * (t) : U.lat_row0 + 64 * ((t) - 4)) : 64 * (t))
#define ATT_DMA_K(t, slot) do { const size_t ro_ = (size_t)ATT_KROW(t); \
        glds16(ksrc0 + ro_ * kp, (unsigned)__builtin_amdgcn_readfirstlane(kdst0 + (slot) * C::KSLOT)); \
        if (C::NKI == 2) glds16(ksrc1 + ro_ * kp, (unsigned)__builtin_amdgcn_readfirstlane(kdst1 + (slot) * C::KSLOT)); } while (0)
#define ATT_DMA_V(t, slot) do { const size_t ro_ = (size_t)ATT_KROW(t); glds16(vsrc + ro_ * vp, (unsigned)__builtin_amdgcn_readfirstlane(vdst + (slot) * 8192)); } while (0)
#define ATT_KLOAD(kslot) do { if (!SWA) { const lds_cptr kb_ = (lds_cptr)(ldsb + C::LDS_K) + (kslot) * C::KSLOT + hi * 1024 + r32 * 16; \
        _Pragma("unroll") for (int d0 = 0; d0 < DQK / 16; ++d0) { kf[2 * d0] = *(const __attribute__((address_space(3))) bf16x8*)(kb_ + d0 * 2048); kf[2 * d0 + 1] = *(const __attribute__((address_space(3))) bf16x8*)(kb_ + d0 * 2048 + 512); } } } while (0)
#define ATT_QKM(P0, P1, CINIT, kslot) do { { const float ci_ = (CINIT); _Pragma("unroll") for (int r = 0; r < 16; ++r) { P0[r] = ci_; P1[r] = ci_; } } \
        const lds_cptr kq_ = (lds_cptr)(ldsb + C::LDS_K) + (kslot) * C::KSLOT + hi * 1024 + r32 * 16; \
        _Pragma("unroll") for (int d0 = 0; d0 < DQK / 16; ++d0) { \
            const bf16x8 b0_ = SWA ? *(const __attribute__((address_space(3))) bf16x8*)(kq_ + d0 * 2048) : kf[2 * d0]; const bf16x8 b1_ = SWA ? *(const __attribute__((address_space(3))) bf16x8*)(kq_ + d0 * 2048 + 512) : kf[2 * d0 + 1]; \
            P0 = __builtin_amdgcn_mfma_f32_32x32x16_bf16(b0_, qr[d0], P0, 0, 0, 0); P1 = __builtin_amdgcn_mfma_f32_32x32x16_bf16(b1_, qr[d0], P1, 0, 0, 0); } } while (0)
#define ATT_VLOAD(vslot) do { if (!SWA) { const lds_cptr vb_ = (lds_cptr)(ldsb + C::LDS_V) + (vslot) * 8192 + ((lane >> 4) & 1) * 32 + (lane & 3) * 8 + (4 * hi + ((lane & 15) >> 2)) * 64; \
        _Pragma("unroll") for (int i = 0; i < 8; ++i) { vl[i] = vtr(vb_ + (i >> 2) * 4096 + (i & 3) * 1024); vh[i] = vtr(vb_ + (i >> 2) * 4096 + (i & 3) * 1024 + 512); } } } while (0)
#define ATT_MX3(a, b, c) __builtin_fmaxf(__builtin_fmaxf((a), (b)), (c))
#define ATT_SMPV(P0, P1, N0, N1, HASNEXT, t, vslot) do { \
        if (SWA) { const bool mk_ = ((t) >= 4) && (U.qpos0 >= 0); const int sb_ = U.spos0 + 64 * ((t) - 4) + 4 * hi; \
            _Pragma("unroll") for (int r = 0; r < 16; ++r) { const int dd_ = qpos - (sb_ + (r & 3) + 8 * (r >> 2)); \
                P0[r] = (mk_ && (dd_ > 128 || dd_ < -128)) ? -INFINITY : P0[r]; P1[r] = (mk_ && (dd_ - 32 > 128 || dd_ - 32 < -128)) ? -INFINITY : P1[r]; } } \
        float ra_ = ATT_MX3(P0[0], P0[1], P1[0]), rb_ = ATT_MX3(P0[2], P0[3], P1[1]); ra_ = ATT_MX3(ra_, P1[2], P1[3]); \
        _Pragma("unroll") for (int r = 4; r < 16; r += 4) { ra_ = ATT_MX3(ra_, P0[r], P0[r + 1]); rb_ = ATT_MX3(rb_, P0[r + 2], P0[r + 3]); ra_ = ATT_MX3(ra_, P1[r], P1[r + 1]); rb_ = ATT_MX3(rb_, P1[r + 2], P1[r + 3]); } \
        float rm_ = halfswap_max(__builtin_fmaxf(ra_, rb_)); \
        if (__builtin_expect(__any(rm_ > ATT_THR), 0)) { \
            const float dl_ = __builtin_fmaxf(rm_, 0.f); m += dl_; const float alpha_ = __builtin_amdgcn_exp2f(-dl_); l *= alpha_; \
            _Pragma("unroll") for (int r = 0; r < 16; ++r) { P0[r] -= dl_; P1[r] -= dl_; } \
            if (HASNEXT) { _Pragma("unroll") for (int r = 0; r < 16; ++r) { N0[r] -= dl_; N1[r] -= dl_; } } \
            if (hi == 0) wsf[r32] = alpha_; \
            asm volatile("s_waitcnt lgkmcnt(0)" ::: "memory"); \
            _Pragma("unroll") for (int r = 0; r < 16; ++r) { const float f_ = wsf[crow(r, hi)]; o[0][r] *= f_; o[1][r] *= f_; } } \
        float ls_ = 0.f; \
        _Pragma("unroll") for (int r = 0; r < 16; ++r) { P0[r] = __builtin_amdgcn_exp2f(P0[r]); P1[r] = __builtin_amdgcn_exp2f(P1[r]); ls_ += P0[r] + P1[r]; } \
        l += ls_; \
        u32x4 pw_[4]; \
        pw_[0] = (u32x4){cvtpk(P0[0], P0[1]), cvtpk(P0[2], P0[3]), cvtpk(P0[4], P0[5]), cvtpk(P0[6], P0[7])}; \
        pw_[1] = (u32x4){cvtpk(P0[8], P0[9]), cvtpk(P0[10], P0[11]), cvtpk(P0[12], P0[13]), cvtpk(P0[14], P0[15])}; \
        pw_[2] = (u32x4){cvtpk(P1[0], P1[1]), cvtpk(P1[2], P1[3]), cvtpk(P1[4], P1[5]), cvtpk(P1[6], P1[7])}; \
        pw_[3] = (u32x4){cvtpk(P1[8], P1[9]), cvtpk(P1[10], P1[11]), cvtpk(P1[12], P1[13]), cvtpk(P1[14], P1[15])}; \
        const lds_cptr vq_ = (lds_cptr)(ldsb + C::LDS_V) + (vslot) * 8192 + ((lane >> 4) & 1) * 32 + (lane & 3) * 8 + (4 * hi + ((lane & 15) >> 2)) * 64; \
        _Pragma("unroll") for (int d0 = 0; d0 < 2; ++d0) \
            _Pragma("unroll") for (int ks = 0; ks < 4; ++ks) { \
                const s16x4 lo_ = SWA ? vtr(vq_ + d0 * 4096 + ks * 1024) : vl[4 * d0 + ks], hh_ = SWA ? vtr(vq_ + d0 * 4096 + ks * 1024 + 512) : vh[4 * d0 + ks]; \
                const bf16x8 vf_ = (bf16x8){lo_[0], lo_[1], lo_[2], lo_[3], hh_[0], hh_[1], hh_[2], hh_[3]}; \
                o[d0] = __builtin_amdgcn_mfma_f32_32x32x16_bf16(__builtin_bit_cast(bf16x8, pw_[ks]), vf_, o[d0], 0, 0, 0); } } while (0)
#define ATT_SKIP(j) (SWA && (j) >= 4 && U.qpos0 >= 0 && ((U.spos0 + 64 * ((j) - 4) > U.qpos0 + 32 * wid + 31 + 128) || (U.spos0 + 64 * ((j) - 4) + 63 < U.qpos0 + 32 * wid - 128)))
#define ATT_STEP(C0, C1, N0, N1, t) do { \
        const int k3_ = (ks1 == 0) ? 2 : ks1 - 1, v2_ = (vs0 == 0) ? 2 : vs0 - 1; \
        if ((t) + 3 < NT) ATT_DMA_K((t) + 3, k3_); \
        if ((t) + 2 < NT) ATT_DMA_V((t) + 2, v2_); \
        ATT_KLOAD(ks1); \
        if (!SWA) __builtin_amdgcn_sched_barrier(0);        \
        if (!SWA || !ATT_SKIP((t) + 1)) ATT_QKM(N0, N1, -m, ks1); \
        ATT_VLOAD(vs0); \
        if (!SWA) __builtin_amdgcn_sched_barrier(0); \
        if (!SWA || !ATT_SKIP(t)) ATT_SMPV(C0, C1, N0, N1, true, t, vs0); \
        if ((t) + 3 < NT) { if (C::NI == 2) ATT_WAIT_BAR(2); else ATT_WAIT_BAR(3); } else ATT_WAIT_BAR(0); \
        ks1 = (ks1 == 2) ? 0 : ks1 + 1; vs0 = (vs0 == 2) ? 0 : vs0 + 1; } while (0)
    ATT_DMA_K(0, 0);
    ATT_DMA_K(1, 1); ATT_DMA_V(0, 0);
    ATT_DMA_K(2, 2); ATT_DMA_V(1, 1);
    bf16x8 qr[DQK / 16];
    { const unsigned short* qw = U.Q + (size_t)(wid * 32 + r32) * U.qp + hi * 8;
#pragma unroll
      for (int d0 = 0; d0 < DQK / 16; ++d0) qr[d0] = *(const bf16x8*)(qw + d0 * 16); }
    float m = 0.f, l = 0.f;
    f32x16 o[2]; o[0] = f32x16{}; o[1] = f32x16{};
    const int qpos = U.qpos0 + wid * 32 + r32;
    f32x16 pa0, pa1, pb0, pb1;
    bf16x8 kf[DQK / 8]; s16x4 vl[8], vh[8];
    if (C::NI == 2) ATT_WAIT_BAR(4); else ATT_WAIT_BAR(6);
    ATT_KLOAD(0); ATT_QKM(pa0, pa1, 0.f, 0);
    {
      float ra = ATT_MX3(pa0[0], pa0[1], pa1[0]), rb = ATT_MX3(pa0[2], pa0[3], pa1[1]); ra = ATT_MX3(ra, pa1[2], pa1[3]);
#pragma unroll
      for (int r = 4; r < 16; r += 4) { ra = ATT_MX3(ra, pa0[r], pa0[r + 1]); rb = ATT_MX3(rb, pa0[r + 2], pa0[r + 3]); ra = ATT_MX3(ra, pa1[r], pa1[r + 1]); rb = ATT_MX3(rb, pa1[r + 2], pa1[r + 3]); }
      m = halfswap_max(__builtin_fmaxf(ra, rb));
#pragma unroll
      for (int r = 0; r < 16; ++r) { pa0[r] -= m; pa1[r] -= m; } }
    if (C::NI == 2) ATT_WAIT_BAR(2); else ATT_WAIT_BAR(3);
    int ks1 = 1, vs0 = 0;
    int t = 0;
    if (SWA) { for (; t + 1 < NT; ++t) { ATT_STEP(pa0, pa1, pb0, pb1, t); pa0 = pb0; pa1 = pb1; } if (!ATT_SKIP(NT - 1)) ATT_SMPV(pa0, pa1, pa0, pa1, false, NT - 1, vs0); }
    else {
    for (; t + 2 < NT; t += 2) { ATT_STEP(pa0, pa1, pb0, pb1, t); ATT_STEP(pb0, pb1, pa0, pa1, t + 1); }
    if (t + 1 < NT) { ATT_STEP(pa0, pa1, pb0, pb1, t); ATT_VLOAD(vs0); ATT_SMPV(pb0, pb1, pb0, pb1, false, NT - 1, vs0); }
    else { ATT_VLOAD(vs0); ATT_SMPV(pa0, pa1, pa0, pa1, false, NT - 1, vs0); }
    }
    l = halfswap_sum(l);
    if (U.has_sink) l += __builtin_amdgcn_exp2f(U.sink2 - m);
    if (hi == 0) wsf[32 + r32] = l;
    asm volatile("s_waitcnt lgkmcnt(0)" ::: "memory");
    { LAS unsigned short* stg = (LAS unsigned short*)(ldsb + C::LDS_OST) + wid * 2048;
#pragma unroll
      for (int r = 0; r < 16; ++r) { const int orow = crow(r, hi); const float rl = __builtin_amdgcn_rcpf(wsf[32 + orow]);
          stg[orow * 64 + r32] = (unsigned short)f2bf(o[0][r] * rl); stg[orow * 64 + 32 + r32] = (unsigned short)f2bf(o[1][r] * rl); }
      asm volatile("s_waitcnt lgkmcnt(0)" ::: "memory");
      unsigned short* yw = U.Y + (size_t)(wid * 32) * 1024;
#pragma unroll
      for (int i = 0; i < 4; ++i) { const int row = i * 8 + (lane >> 3), ch = lane & 7;
          const u32x4 ov = *(const LAS u32x4*)(stg + row * 64 + ch * 8);
          u32x4* gp = (u32x4*)(yw + (size_t)row * 1024 + ch * 8); const u32x4 g = *gp;
          u32x4 w; w.x = pk2(bflo(ov.x) * bflo(g.x), bfhi(ov.x) * bfhi(g.x)); w.y = pk2(bflo(ov.y) * bflo(g.y), bfhi(ov.y) * bfhi(g.y));
          w.z = pk2(bflo(ov.z) * bflo(g.z), bfhi(ov.z) * bfhi(g.z)); w.w = pk2(bflo(ov.w) * bflo(g.w), bfhi(ov.w) * bfhi(g.w));
          *gp = w; } }
    asm volatile("s_waitcnt vmcnt(0) lgkmcnt(0)\n\ts_barrier" ::: "memory");
#undef ATT_KROW
#undef ATT_DMA_K
#undef ATT_DMA_V
#undef ATT_KLOAD
#undef ATT_QKM
#undef ATT_VLOAD
#undef ATT_STEP
#undef ATT_SKIP
#undef ATT_SMPV
#undef ATT_MX3
}
}

__device__ __forceinline__ void ph_attn(Frame& F, int l) {
    unsigned short* ZS = (unsigned short*)(F.ws + WS_ZS); unsigned short* MQ = (unsigned short*)(F.ws + WS_MQ); unsigned short* MKV = (unsigned short*)(F.ws + WS_MKV); unsigned short* MK = (unsigned short*)(F.ws + WS_MK);
    unsigned short* Y = (unsigned short*)(F.ws + WS_G);
    LAS unsigned char* lds = F.lds + RING_OFF;
    const int u = F.vcu;
    const bool ctxq = (l == 0);
    for (int uu = u; uu < 256; uu += F.G) { const int bh = uu >> 4, qb = uu & 15, b = bh >> 2, h = bh & 3; const size_t r0 = (size_t)b * TPB, rq = r0 + CTXL + qb * 256;
        att::UnitDesc U{MQ + rq * 512 + h * 96, 512, MK + r0 * 384 + h * 96, 384, MKV + r0 * 512 + h * 128 + 64, 512, Y + rq * 1024 + h * 64, TPB / 64, 0, -1, 0, 0, 0.f};
        att::attn_unit<96, false>(lds, U, F.tid); }
    for (int uu = u; uu < 256; uu += F.G) { const int qb = uu & 15, g = (uu >> 4) & 1, kvh = (uu >> 5) & 1, b = uu >> 6, qh = kvh * 2 + g; const size_t r0 = (size_t)b * TPB, rq = r0 + CTXL + qb * 256;
        att::UnitDesc U{ZS + rq * ZS_P + ZC_AQ + qh * 64, ZS_P, ZS + r0 * ZS_P + ZC_AK + kvh * 64, ZS_P, ZS + r0 * ZS_P + ZC_AV + kvh * 64, ZS_P, Y + rq * 1024 + 512 + qh * 64, TPB / 64, 0, -1, 0, 0, 0.f};
        att::attn_unit<64, false>(lds, U, F.tid); }
    for (int uu = u; uu < 256; uu += F.G) { const int qb = uu & 15, g = (uu >> 4) & 1, kvh = (uu >> 5) & 1, b = uu >> 6, qh = kvh * 2 + g; const size_t r0 = (size_t)b * TPB, rq = r0 + CTXL + qb * 256;
        const int q0 = qb * 256, s0 = (q0 - 128 < 0) ? 0 : q0 - 128, s1 = (q0 + 384 > SEQ) ? SEQ : q0 + 384;
        att::UnitDesc U{ZS + rq * ZS_P + ZC_SQ + qh * 64, ZS_P, ZS + r0 * ZS_P + ZC_SK + kvh * 64, ZS_P, ZS + r0 * ZS_P + ZC_SV + kvh * 64, ZS_P, Y + rq * 1024 + 256 + qh * 64, 4 + (s1 - s0) / 64, CTXL + s0, q0, s0, 1, F.in(I_SINK)[l * 4 + qh] * LOG2E};
        att::attn_unit<64, true>(lds, U, F.tid); }
    if (ctxq) for (int uu = u; uu < 48; uu += F.G) { const int br = uu >> 4, b = (uu >> 2) & 3, h = uu & 3; const size_t r0 = (size_t)b * TPB;
        if (br == 0) { att::UnitDesc U{MQ + r0 * 512 + h * 96, 512, MK + r0 * 384 + h * 96, 384, MKV + r0 * 512 + h * 128 + 64, 512, Y + r0 * 1024 + h * 64, 4, 0, -1, 0, 0, 0.f};
            att::attn_unit<96, false>(lds, U, F.tid); }
        else if (br == 1) { att::UnitDesc U{ZS + r0 * ZS_P + ZC_SQ + h * 64, ZS_P, ZS + r0 * ZS_P + ZC_SK + (h >> 1) * 64, ZS_P, ZS + r0 * ZS_P + ZC_SV + (h >> 1) * 64, ZS_P, Y + r0 * 1024 + 256 + h * 64, 4, CTXL, -1, 0, 1, F.in(I_SINK)[l * 4 + h] * LOG2E};
            att::attn_unit<64, true>(lds, U, F.tid); }
        else { att::UnitDesc U{ZS + r0 * ZS_P + ZC_AQ + h * 64, ZS_P, ZS + r0 * ZS_P + ZC_AK + (h >> 1) * 64, ZS_P, ZS + r0 * ZS_P + ZC_AV + (h >> 1) * 64, ZS_P, Y + r0 * 1024 + 512 + h * 64, 4, 0, -1, 0, 0, 0.f};
            att::attn_unit<64, false>(lds, U, F.tid); } }
}
constexpr size_t WS_SUM = 253 * MiB;
constexpr size_t WS_HL = WS_U, WS_CP = WS_HF;
constexpr int NCHUNK = TPB / 64;
__device__ __forceinline__ float swap_lo(float x) { auto rr = __builtin_amdgcn_permlane32_swap(__float_as_uint(x), __float_as_uint(x), false, false); return __uint_as_float(rr[0]); }
__device__ __forceinline__ float swap_hi(float x) { auto rr = __builtin_amdgcn_permlane32_swap(__float_as_uint(x), __float_as_uint(x), false, false); return __uint_as_float(rr[1]); }
__device__ __forceinline__ void ph_lru1(Frame& F, int l) {
    typedef short bf16x8 __attribute__((ext_vector_type(8))); typedef float f32x16 __attribute__((ext_vector_type(16)));
    const unsigned short* ZS = (const unsigned short*)(F.ws + WS_ZS); unsigned short* HL = (unsigned short*)(F.ws + WS_HL); unsigned short* CP = (unsigned short*)(F.ws + WS_CP);
    f32x2v* SUM = (f32x2v*)(F.ws + WS_SUM);
    constexpr int UP = 264;
    LAS unsigned short* ul = (LAS unsigned short*)(F.lds + RING_OFF);
    const float* cw = F.in(I_CONVW) + l * 4 * 256; const float* cb = F.in(I_CONVB) + l * 256;
    const int tid = F.tid, lane = tid & 63, r32 = lane & 31, hi = lane >> 5, k = F.wave & 3, d = F.wave >> 2;
    const int nfull = (NB * NCHUNK < F.G) ? NB * NCHUNK : F.G, nhalf = 2 * (NB * NCHUNK - nfull);
    for (int wi = F.vcu; wi < nfull + nhalf; wi += F.G) {
        const int unit = (wi < nfull) ? wi : nfull + ((wi - nfull) >> 1);
        const int tn_lo = (wi < nfull) ? 0 : ((wi - nfull) & 1), tn_hi = (wi < nfull) ? 2 : tn_lo + 1;
        const int b = unit / NCHUNK, ci = unit % NCHUNK;
        int s0row, len, t0; if (ci < 4) { s0row = b * TPB; len = CTXL; t0 = ci * 64; } else { s0row = b * TPB + CTXL; len = SEQ; t0 = (ci - 4) * 64; }
        { const int cc = tid & 255, hh = tid >> 8; float zv[35];
#pragma unroll
          for (int i = 0; i < 35; ++i) { const int tt = t0 + hh * 32 + i - 2; const int tc = tt < 0 ? 0 : (tt >= len ? len - 1 : tt);
              const float v = bf2f(ZS[(size_t)(s0row + tc) * ZS_P + ZC_LRU + cc]); zv[i] = (tt >= 0 && tt < len) ? v : 0.f; }
          const float w0 = cw[cc], w1 = cw[256 + cc], w2 = cw[512 + cc], w3 = cw[768 + cc], bb = cb[cc];
#pragma unroll
          for (int t = 0; t < 32; ++t) ul[(hh * 32 + t) * UP + cc] = (unsigned short)f2bf(bb + w0 * zv[t] + w1 * zv[t + 1] + w2 * zv[t + 2] + w3 * zv[t + 3]); }
        __syncthreads();
#pragma unroll 1
        for (int tn = tn_lo; tn < tn_hi; ++tn) {
            const int c = k * 64 + 32 * tn + r32;
            bf16x8 wf[2][4];
            const float brv = F.in(I_LBR)[(l * 2 + d) * 256 + c], biv = F.in(I_LBI)[(l * 2 + d) * 256 + c], spv = ((const float*)(F.ws + WS_SP))[(l * 2 + d) * 256 + c];
#pragma unroll
            for (int gate = 0; gate < 2; ++gate)
#pragma unroll
                for (int ks = 0; ks < 4; ++ks) { const float* src = (const float*)(F.ws + WS_LWT) + ((((size_t)l * 2 + d) * 2 + gate) * 256 + c) * 64 + 16 * ks + 8 * hi;
                    const f32x4 a = *(const f32x4*)src, b2 = *(const f32x4*)(src + 4);
                    v4u w; w.x = pk2(a.x, a.y); w.y = pk2(a.z, a.w); w.z = pk2(b2.x, b2.y); w.w = pk2(b2.z, b2.w); wf[gate][ks] = __builtin_bit_cast(bf16x8, w); }
            f32x16 A[2], X[2];
            A[0] = f32x16{}; A[1] = f32x16{}; X[0] = f32x16{}; X[1] = f32x16{};
#pragma unroll
            for (int tm = 0; tm < 2; ++tm)
#pragma unroll
                for (int ks = 0; ks < 4; ++ks) { const bf16x8 af = *(const LAS bf16x8*)(ul + (32 * tm + r32) * UP + k * 64 + 16 * ks + 8 * hi);
                    A[tm] = __builtin_amdgcn_mfma_f32_32x32x16_bf16(af, wf[0][ks], A[tm], 0, 0, 0); X[tm] = __builtin_amdgcn_mfma_f32_32x32x16_bf16(af, wf[1][ks], X[tm], 0, 0, 0); }
#pragma unroll
            for (int tm = 0; tm < 2; ++tm)
#pragma unroll
                for (int r = 0; r < 16; ++r) { const int tok = 32 * tm + (r & 3) + 8 * (r >> 2) + 4 * hi; const float uu = bf2f(ul[tok * UP + c]);
                    const float rr = sigmoid_f(A[tm][r] + brv), ii = sigmoid_f(X[tm][r] + biv);
                    const float a = __builtin_amdgcn_exp2f(-rr * spv); A[tm][r] = a; X[tm][r] = __builtin_amdgcn_sqrtf(1.0f - a * a) * (ii * uu);
                    if ((r & 3) == 3) asm volatile("" ::: "memory"); }
#pragma unroll
            for (int tm = 0; tm < 2; ++tm)
#pragma unroll
                for (int rg = 0; rg < 4; ++rg) { const int r0 = 4 * rg;
                    if (d == 0) {
#pragma unroll
                        for (int e2 = 1; e2 < 4; ++e2) { X[tm][r0 + e2] = A[tm][r0 + e2] * X[tm][r0 + e2 - 1] + X[tm][r0 + e2]; A[tm][r0 + e2] = A[tm][r0 + e2] * A[tm][r0 + e2 - 1]; } }
                    else {
#pragma unroll
                        for (int e2 = 2; e2 >= 0; --e2) { X[tm][r0 + e2] = A[tm][r0 + e2] * X[tm][r0 + e2 + 1] + X[tm][r0 + e2]; A[tm][r0 + e2] = A[tm][r0 + e2] * A[tm][r0 + e2 + 1]; } } }
            float enH[8], enP[8]; float EH = 0.f, EP = 1.f;
            if (d == 0) {
#pragma unroll
                for (int q = 0; q < 8; ++q) { const int tm = q >> 2, re = 4 * (q & 3) + 3; const float ce = A[tm][re], he = X[tm][re];
                    const float aH = swap_lo(ce * EH + he), aP = swap_lo(EP * ce);
                    const float E1H = hi ? aH : EH, E1P = hi ? aP : EP;
                    enH[q] = E1H; enP[q] = E1P;
                    EH = swap_hi(ce * E1H + he); EP = swap_hi(E1P * ce); }
            } else {
#pragma unroll
                for (int q = 7; q >= 0; --q) { const int tm = q >> 2, re = 4 * (q & 3); const float ce = A[tm][re], he = X[tm][re];
                    const float aH = swap_hi(ce * EH + he), aP = swap_hi(EP * ce);
                    const float E1H = hi ? EH : aH, E1P = hi ? EP : aP;
                    enH[q] = E1H; enP[q] = E1P;
                    EH = swap_lo(ce * E1H + he); EP = swap_lo(E1P * ce); }
            }
            { const unsigned ob = (unsigned)((((s0row + t0 + 4 * hi) * 2 + d) * 256 + c) * 2);
#pragma unroll
              for (int tm = 0; tm < 2; ++tm)
#pragma unroll
                for (int rg = 0; rg < 4; ++rg) { const int q = 4 * tm + rg;
#pragma unroll
                    for (int e2 = 0; e2 < 4; ++e2) { const int r = 4 * rg + e2; const unsigned o = ob + (unsigned)(32 * tm + 8 * rg + e2) * 1024u;
                        *(unsigned short*)((char*)HL + o) = (unsigned short)f2bf(X[tm][r] + A[tm][r] * enH[q]); *(unsigned short*)((char*)CP + o) = (unsigned short)f2bf(A[tm][r] * enP[q]); }
                    asm volatile("" ::: "memory"); } }
            if (hi == 0) SUM[((size_t)(b * NCHUNK + ci) * 2 + d) * 256 + c] = (f32x2v){EP, EH};
        }
        __syncthreads();
    }
}
constexpr size_t WS_CARRY = 255 * MiB;
__device__ __forceinline__ void ph_lru_carry(Frame& F) {
    if (F.vcu < 4) {
        const int g = F.vcu * NTHREADS + F.tid, b = g >> 9, d = (g >> 8) & 1, c = g & 255;
        const f32x2v* sb = (const f32x2v*)(F.ws + WS_SUM) + ((size_t)b * NCHUNK * 2 + d) * 256 + c;
        float* cr = (float*)(F.ws + WS_CARRY) + ((size_t)b * NCHUNK * 2 + d) * 256 + c;
        float h = 0.f;
#pragma unroll 1
        for (int p0 = 0; p0 < NCHUNK; p0 += 17) {
            f32x2v s[17];
#pragma unroll
            for (int i = 0; i < 17; ++i) { const int p = p0 + i, j = (d == 0) ? p : (p < 4 ? 3 - p : NCHUNK + 3 - p); s[i] = sb[(size_t)j * 512]; }
#pragma unroll
            for (int i = 0; i < 17; ++i) { const int p = p0 + i, j = (d == 0) ? p : (p < 4 ? 3 - p : NCHUNK + 3 - p); cr[(size_t)j * 512] = h; h = s[i].x * h + s[i].y; }
        }
    }
}
__device__ __forceinline__ void ph_lru2(Frame& F, int l) {
    const unsigned short* HL = (const unsigned short*)(F.ws + WS_HL); const unsigned short* CP = (const unsigned short*)(F.ws + WS_CP);
    const float* CARRY = (const float*)(F.ws + WS_CARRY); unsigned short* Y = (unsigned short*)(F.ws + WS_G);
    const int tid = F.tid, cg = tid & 31, tq = tid >> 5; const bool last = (l == NLAYER - 1);
    for (int unit = F.vcu; unit < NB * NCHUNK; unit += F.G) {
        const int b = unit / NCHUNK, ci = unit % NCHUNK;
        if (last && ci < 4) continue;
        const float* cp0 = CARRY + ((size_t)(b * NCHUNK + ci) * 2) * 256 + cg * 8;
        const f32x4 cfa = *(const f32x4*)cp0, cfb = *(const f32x4*)(cp0 + 4), cba = *(const f32x4*)(cp0 + 256), cbb = *(const f32x4*)(cp0 + 260);
        const float cf[8] = {cfa.x, cfa.y, cfa.z, cfa.w, cfb.x, cfb.y, cfb.z, cfb.w}, cbk[8] = {cba.x, cba.y, cba.z, cba.w, cbb.x, cbb.y, cbb.z, cbb.w};
        v4u hf[4], pf[4], hb[4], pb[4], gg[4];
#pragma unroll
        for (int i = 0; i < 4; ++i) { const size_t row = (size_t)b * TPB + ci * 64 + tq + 16 * i; const size_t o = (row * 2) * 256 + cg * 8;
            hf[i] = *(const v4u*)(HL + o); pf[i] = *(const v4u*)(CP + o); hb[i] = *(const v4u*)(HL + o + 256); pb[i] = *(const v4u*)(CP + o + 256); gg[i] = *(const v4u*)(Y + row * 1024 + 768 + cg * 8); }
#pragma unroll
        for (int i = 0; i < 4; ++i) { const size_t row = (size_t)b * TPB + ci * 64 + tq + 16 * i;
            unsigned w[4];
#pragma unroll
            for (int e = 0; e < 4; ++e) { const unsigned a = hf[i][e], p = pf[i][e], a2 = hb[i][e], p2 = pb[i][e], g = gg[i][e];
                const float v0 = (bflo(a) + bflo(p) * cf[2 * e] + bflo(a2) + bflo(p2) * cbk[2 * e]) * bflo(g);
                const float v1 = (bfhi(a) + bfhi(p) * cf[2 * e + 1] + bfhi(a2) + bfhi(p2) * cbk[2 * e + 1]) * bfhi(g);
                w[e] = pk2(v0, v1); }
            *(v4u*)(Y + row * 1024 + 768 + cg * 8) = (v4u){w[0], w[1], w[2], w[3]}; }
    }
}
namespace pgx {
typedef short bf16x8 __attribute__((ext_vector_type(8)));
typedef float f32x4 __attribute__((ext_vector_type(4)));
typedef unsigned u32x4 __attribute__((ext_vector_type(4)));
typedef unsigned u32x2 __attribute__((ext_vector_type(2)));
constexpr int OPB = 16384;
template <int VAR> __device__ __forceinline__ void pgx_unit(LAS unsigned char* lds, const unsigned short* Y, const unsigned short* Wb, const unsigned short* S, unsigned short* MIX, int row0, int n0, int tid) {
    const int lane = tid & 63, wid = __builtin_amdgcn_readfirstlane(tid >> 6), wm = wid & 3, wn = wid >> 2, fr = lane & 15, fq = lane >> 4;
    const int sr0 = tid >> 3, sk = (tid & 7) * 8;
    const unsigned short* ysrc = Y + (size_t)(row0 + sr0) * 1024 + sk;
    const unsigned short* wsrc = Wb + (size_t)(n0 + sr0) * 256 + sk;
    const int ldst = (tid & 7) * 2048 + (sr0 & ~15) * 16 + (((sr0 & 15) ^ (tid & 7)) << 4);
    const int wrow = (sr0 & ~63) | (((sr0 >> 2) & 3) << 4) | (((sr0 >> 4) & 3) << 2) | (sr0 & 3);
    const int ldstw = (tid & 7) * 2048 + (wrow & ~15) * 16 + (((wrow & 15) ^ (tid & 7)) << 4);
    f32x4 acc[2][4], mix[2][4];
#pragma unroll
    for (int a = 0; a < 2; ++a)
#pragma unroll
        for (int b = 0; b < 4; ++b) { acc[a][b] = (f32x4){0.f, 0.f, 0.f, 0.f}; mix[a][b] = (f32x4){0.f, 0.f, 0.f, 0.f}; }
    u32x4 st[4][4];
    const unsigned short* yA = ysrc; const unsigned short* yB = ysrc + 64 * 1024;
    const unsigned short* wA = wsrc; const unsigned short* wB = wsrc + 64 * 256;
    const unsigned short* sp0 = S + (size_t)(row0 + 32 * wm + fr) * 4096 + n0 + 64 * wn + 16 * fq; const unsigned short* sp1 = sp0 + (size_t)16 * 4096;
#define PGX_LOADQ(set_, yo_, wp0_, wp1_, wo_) do { if (VAR == 2) { st[set_][0] = *(const u32x4*)(ysrc); st[set_][1] = *(const u32x4*)(ysrc + 64 * 1024); st[set_][2] = *(const u32x4*)(wsrc); st[set_][3] = *(const u32x4*)(wsrc + 64 * 256); } else if (VAR == 4) { st[set_][0] = st[set_][1] = st[set_][2] = st[set_][3] = (u32x4){1u,2u,3u,4u}; asm volatile("" : "+v"(st[set_][0]), "+v"(st[set_][1]), "+v"(st[set_][2]), "+v"(st[set_][3])); } else { st[set_][0] = *(const u32x4*)(yA + (yo_)); st[set_][1] = *(const u32x4*)(yB + (yo_)); st[set_][2] = *(const u32x4*)((wp0_) + (wo_)); st[set_][3] = *(const u32x4*)((wp1_) + (wo_)); } } while (0)
#define PGX_STORE(buf_, set_) do { LAS unsigned char* b_ = lds + (buf_) * 2 * OPB + ldst; \
        *(LAS u32x4*)b_ = st[set_][0]; *(LAS u32x4*)(b_ + 1024) = st[set_][1]; *(LAS u32x4*)(b_ - ldst + OPB + ldstw) = st[set_][2]; *(LAS u32x4*)(b_ - ldst + OPB + ldstw + 1024) = st[set_][3]; } while (0)
    u32x4 sga[2][2], sgb[2][2];
#define PGX_SLOAD(dst_, off_) do { if (VAR == 1 || VAR == 4) { dst_[0][0] = dst_[0][1] = dst_[1][0] = dst_[1][1] = (u32x4){0x3f803f80u, 0x3f803f80u, 0x3f803f80u, 0x3f803f80u}; } \
        else { dst_[0][0] = *(const u32x4*)(sp0 + (off_)); dst_[0][1] = *(const u32x4*)(sp0 + (off_) + 8); dst_[1][0] = *(const u32x4*)(sp1 + (off_)); dst_[1][1] = *(const u32x4*)(sp1 + (off_) + 8); } } while (0)
    PGX_SLOAD(sga, 0);
    PGX_LOADQ(0, 0, wA, wB, 0); PGX_LOADQ(1, 64, wA, wB, 64); PGX_LOADQ(2, 128, wA, wB, 128);
    PGX_STORE(0, 0);
    __syncthreads();
#define PGX_COMPUTE(h_) do { const LAS unsigned char* yb = lds + ((h_) & 1) * 2 * OPB + 32 * wm * 16; const LAS unsigned char* wb = lds + ((h_) & 1) * 2 * OPB + OPB + 64 * wn * 16; \
          _Pragma("unroll") for (int ks = 0; ks < 2; ++ks) { const int fo_ = (4 * ks + fq) * 2048 + ((fr ^ (4 * ks + fq)) << 4); \
              bf16x8 yf[2], wf[4]; \
              _Pragma("unroll") for (int tt = 0; tt < 2; ++tt) yf[tt] = *(const LAS bf16x8*)(yb + fo_ + tt * 256); \
              _Pragma("unroll") for (int nt = 0; nt < 4; ++nt) wf[nt] = *(const LAS bf16x8*)(wb + fo_ + nt * 256); \
              _Pragma("unroll") for (int tt = 0; tt < 2; ++tt) \
                  _Pragma("unroll") for (int nt = 0; nt < 4; ++nt) acc[tt][nt] = __builtin_amdgcn_mfma_f32_16x16x32_bf16(wf[nt], yf[tt], acc[tt][nt], 0, 0, 0); } } while (0)
#pragma unroll 1
    for (int kk = 0; kk < 4; ++kk) {
        const bool more = kk < 3;
        const unsigned short* wnA = more ? wA + (size_t)1024 * 256 : wsrc; const unsigned short* wnB = more ? wB + (size_t)1024 * 256 : wsrc + 64 * 256;
        const int yo = more ? 256 : -768;
        PGX_SLOAD(sgb, more ? 1024 : 0);
        PGX_LOADQ(3, 192, wA, wB, 192); PGX_COMPUTE(0); PGX_STORE(1, 1); __syncthreads();
        PGX_LOADQ(0, yo, wnA, wnB, 0); PGX_COMPUTE(1); PGX_STORE(0, 2); __syncthreads();
        PGX_LOADQ(1, yo + 64, wnA, wnB, 64); PGX_COMPUTE(2); PGX_STORE(1, 3); __syncthreads();
        PGX_LOADQ(2, yo + 128, wnA, wnB, 128); PGX_COMPUTE(3);
#pragma unroll
        for (int tt = 0; tt < 2; ++tt)
#pragma unroll
            for (int nt = 0; nt < 4; ++nt) { const u32x4 gv = sga[tt][nt >> 1]; const unsigned g0 = (nt & 1) ? gv.z : gv.x, g1 = (nt & 1) ? gv.w : gv.y; const f32x4 a = acc[tt][nt];
                mix[tt][nt] += (f32x4){a[0] * bflo(g0), a[1] * bfhi(g0), a[2] * bflo(g1), a[3] * bfhi(g1)}; acc[tt][nt] = (f32x4){0.f, 0.f, 0.f, 0.f}; }
#pragma unroll
        for (int tt = 0; tt < 2; ++tt) { sga[tt][0] = sgb[tt][0]; sga[tt][1] = sgb[tt][1]; }
        if (more) PGX_STORE(0, 0);
        __syncthreads();
        yA += 256; yB += 256; wA = wnA; wB = wnB; sp0 += 1024; sp1 += 1024;
    }
#pragma unroll
    for (int tt = 0; tt < 2; ++tt) { unsigned short* mp = MIX + (size_t)(row0 + 32 * wm + 16 * tt + fr) * 1024 + n0 + 64 * wn + 16 * fq;
        u32x4 w0, w1; w0.x = pk2(mix[tt][0][0], mix[tt][0][1]); w0.y = pk2(mix[tt][0][2], mix[tt][0][3]); w0.z = pk2(mix[tt][1][0], mix[tt][1][1]); w0.w = pk2(mix[tt][1][2], mix[tt][1][3]);
        w1.x = pk2(mix[tt][2][0], mix[tt][2][1]); w1.y = pk2(mix[tt][2][2], mix[tt][2][3]); w1.z = pk2(mix[tt][3][0], mix[tt][3][1]); w1.w = pk2(mix[tt][3][2], mix[tt][3][3]);
        *(u32x4*)mp = w0; *(u32x4*)(mp + 8) = w1; }
#undef PGX_LOADQ
#undef PGX_SLOAD
#undef PGX_STORE
#undef PGX_COMPUTE
}
}
template <int VAR> __device__ __forceinline__ void ph_pgx(Frame& F, int l) {
    const unsigned short* Y = (const unsigned short*)(F.ws + WS_G); const unsigned short* S = (const unsigned short*)(F.ws + WS_S); unsigned short* MIX = (VAR == 0) ? (unsigned short*)(F.ws + WS_H) : (unsigned short*)F.out;
    const unsigned short* Wb = (const unsigned short*)(F.ws + WS_W + (size_t)l * W_LAYER + WO_WB);
    const bool last = (l == NLAYER - 1);
    const int nrt = last ? 128 : NROWS / 128;
    for (int u = F.vcu; u < nrt * 8; u += F.G) {
        int rt = u >> 3; const int ct = u & 7;
        if (last) rt = rt + 2 * (rt / 32) + 2;
        pgx::pgx_unit<VAR>(F.lds + RING_OFF, Y, Wb, S, MIX, rt * 128, ct * 128, F.tid);
    }
}
constexpr int NPL = 10;
enum { PH_H = 0, PH_G1, PH_POST1, PH_G2, PH_POST2, PH_ATT, PH_SG, PH_PG, PH_MIX, PH_OG };
constexpr int NPHASES = 1 + NLAYER * NPL;
#ifndef NAIVE_ATT
#define NAIVE_ATT 0
#endif
#ifndef PROBE_MASK
#define PROBE_MASK 0
#endif
#ifndef PROBE_LAYERS
#define PROBE_LAYERS 3
#endif
#ifndef PHMASK
#define PHMASK 16383
#endif
#ifndef MK_ONE_LAUNCH
#define MK_ONE_LAUNCH 1
#endif

__global__ void __launch_bounds__(NTHREADS, 2) fwd_kernel(Args args) {
    extern __shared__ __attribute__((aligned(16))) unsigned char lds_raw[];
    { LAS unsigned char* l0 = (LAS unsigned char*)lds_raw;
      for (int u = threadIdx.x; u < (LDS_BYTES - LDSCTL_OFF) / 4; u += NTHREADS) ((LAS unsigned*)(l0 + LDSCTL_OFF))[u] = 0u;
      __syncthreads();
      if (args.ph_hi - args.ph_lo > 1) (void)xcd_barrier_post((unsigned*)((gu32*)(args.ws + WS_CTL) + CW_BAR), (volatile LAS unsigned*)(l0 + MISC_OFF) + 8); }

    unsigned long long tacc = 0ull;
    for (int ph = args.ph_lo; ph < args.ph_hi; ++ph) {
        unsigned long long tph0 = 0ull; bool probed = false;
        if (PROBE_MASK) { const int pl = (ph == 0) ? 0 : (ph - 1) / NPL, pp = (ph == 0) ? 10 : (ph - 1) % NPL; probed = ((PROBE_MASK >> pp) & 1) && ((PROBE_LAYERS >> pl) & 1); if (probed) tph0 = __builtin_amdgcn_s_memrealtime(); }
        int z; asm volatile("s_mov_b32 %0, 0" : "=s"(z));
        Frame F;
        F.lds = (LAS unsigned char*)lds_raw + z; F.kin = (const float* const __attribute__((address_space(4)))*)((const __attribute__((address_space(4))) char*)__builtin_amdgcn_kernarg_segment_ptr() + z); F.ws = args.ws + z; F.out = args.out + z; F.z = z;
        F.tid = threadIdx.x + z; F.lane = F.tid & 63; F.wave = __builtin_amdgcn_readfirstlane(F.tid >> 6);
        F.G = gridDim.x + z; { const int bx = blockIdx.x + z; F.vcu = (F.G % 8 == 0) ? (bx % 8) * (F.G / 8) + bx / 8 : bx; }
        F.gw = F.vcu * NWAVES + F.wave; F.NGW = F.G * NWAVES;
        bool is_gemm = false;
        pg8::Gemm g{nullptr, nullptr, NROWS, 256, 1024, 1024, 31, 0};
        pg8::Order S; S.init(1, 1, F.G, (int)blockIdx.x + z, 0);
        pg8::EpiU E{pg8::EM_PLAIN, 0, F.ws, nullptr, nullptr, nullptr, 0, 0, 0, 0, 1 << 20};
        if (ph == 0) { if (PHMASK & 8192) p0_prologue(F); }
        else {
            const int l = (ph - 1) / NPL, p = (ph - 1) % NPL;
            unsigned char* wl = F.ws + WS_W + (size_t)l * W_LAYER;
            const bool last = (l == NLAYER - 1);
            const int nMc = last ? 64 : NROWS / 256, lat = last ? 1 : 0;
            E.l = l;
            if (p == PH_H && (PHMASK & 1)) { ph_hnorm(F, l); }
            else if (p == PH_G1 && (PHMASK & 2)) {
                is_gemm = true; g.A = (const bf16*)(F.ws + WS_H); g.Bt = (const bf16*)(wl + WO_W1); g.N = N1; g.K = 1024; g.lda = 1024;
                S.init(NROWS / 256, N1 / 256, F.G, (int)blockIdx.x + z, 0);
                E.mode = pg8::EM_SILU2; E.oA = WS_ZS; E.ldc = ZS_P; E.oB = WS_G; E.ldc2 = 1024; E.split_tile = 7;
            }
            else if (p == PH_POST1 && (PHMASK & 4)) { ph_lru1(F, l); ph_post1(F, l); }
            else if (p == PH_G2 && (PHMASK & 8)) {
                is_gemm = true; g.A = (const bf16*)(F.ws + WS_ZS); g.Bt = (const bf16*)(wl + WO_UQ); g.N = 1024; g.K = 256; g.lda = ZS_P; g.a_shift = 1; g.a_step = 512;
                S.init(NROWS / 256, 4, F.G, (int)blockIdx.x + z, 0);
                E.mode = pg8::EM_PLAIN; E.oA = WS_MQ; E.ldc = 512; E.oB = WS_MKV; E.ldc2 = 512; E.split_tile = 2;
            }
            else if (p == PH_POST2 && (PHMASK & 16)) { ph_lru_carry(F); ph_post2(F, l); }
            else if (p == PH_ATT && (PHMASK & 32)) {
#if NAIVE_ATT
                ph_attn_naive(F, l);
#else
                ph_attn(F, l);
#endif
                ph_lru2(F, l); }
            else if (p == PH_SG && (PHMASK & 512)) {
                is_gemm = true; g.A = (const bf16*)(F.ws + WS_H); g.Bt = (const bf16*)(wl + WO_W1) + (size_t)N1 * 1024; g.N = 4096; g.K = 1024; g.lda = 1024;
                S.init(nMc, 16, F.G, (int)blockIdx.x + z, lat);
                E.mode = pg8::EM_SIG; E.oA = WS_S; E.ldc = 4096;
            }
            else if (p == PH_PG && (PHMASK & 1024)) { ph_pgx<0>(F, l);
#ifdef PGX_PROBE
                if (l == 0) { __syncthreads(); ph_pgx<PGX_PROBE>(F, l); }
#endif
            }
            else if (p == PH_MIX) { }
            else if (p == PH_OG && (PHMASK & 4096)) {
                is_gemm = true; g.A = (const bf16*)(F.ws + WS_H); g.Bt = (const bf16*)(wl + WO_WO); g.N = 1024; g.K = 1024; g.lda = 1024;
                S.init(nMc, 4, F.G, (int)blockIdx.x + z, lat);
                E.mode = pg8::EM_RES; E.xin = (l == 0) ? F.in(I_X) : (const float*)F.out; E.xout = F.out; E.cin0 = F.in(I_CTX); E.oA = WS_MOD; E.oB = WS_CTX1;
            }
        }
        if (is_gemm) pg8::gemm_phase<pg8::EpiU, pg8::Order, true, true>(F.lds + RING_OFF, g, S, E, F.tid);
        if (ph == 1 + PH_OG && NLAYER == 2) {
            pg8::Unit tmp; const int nbusy = (NROWS / 256) * 4 - F.G;
            if ((int)blockIdx.x + z >= nbusy && nbusy >= 0 && nbusy < F.G) { __syncthreads(); weight_copies(F, 1, ((int)blockIdx.x + z - nbusy) * NWAVES + F.wave, (F.G - nbusy) * NWAVES); }
            (void)tmp; }
        const bool empty_phase = (ph > 0) && ((ph - 1) % NPL == PH_MIX);
        if (ph + 1 < args.ph_hi && !empty_phase) {
            int z2; asm volatile("s_mov_b32 %0, 0" : "=s"(z2));
            XcdBarrier bar; bar.bar = (unsigned*)((gu32*)(args.ws + z2 + WS_CTL) + CW_BAR); bar.x = xb_xcc_id(); bar.st = (volatile LAS unsigned*)((LAS unsigned char*)lds_raw + z2 + MISC_OFF) + 8;
            xcd_barrier(bar);
        }
        if (PROBE_MASK) { if (probed) tacc += __builtin_amdgcn_s_memrealtime() - tph0; }
    }
#ifdef EXTRA_BARRIERS
    for (int xb = 0; xb < EXTRA_BARRIERS; ++xb) { int z3; asm volatile("s_mov_b32 %0, 0" : "=s"(z3));
        XcdBarrier bar; bar.bar = (unsigned*)((gu32*)(args.ws + z3 + WS_CTL) + CW_BAR); bar.x = xb_xcc_id(); bar.st = (volatile LAS unsigned*)((LAS unsigned char*)lds_raw + z3 + MISC_OFF) + 8;
        xcd_barrier(bar); }
#endif
    if (PROBE_MASK) { const unsigned long long t0 = __builtin_amdgcn_s_memrealtime(); while (__builtin_amdgcn_s_memrealtime() - t0 < tacc) __builtin_amdgcn_s_sleep(8); }
}

extern "C" void kernel_launch(void* const* d_in, const int* in_sizes, int n_in, void* d_out, int out_size, void* d_ws, size_t ws_size, hipStream_t stream) {
    static int grid = 0;
    if (grid == 0) {
        if (n_in != 28 || out_size != NB * SEQ * DM || ws_size < WS_END) { fprintf(stderr, "kernel_launch: unexpected shapes (n_in %d out %d ws %zu); nothing launched\n", n_in, out_size, ws_size); grid = -1; return; }
        int dev = 0, cus = 0, per_cu = 0;
        if (hipGetDevice(&dev) != hipSuccess || hipDeviceGetAttribute(&cus, hipDeviceAttributeMultiprocessorCount, dev) != hipSuccess) { grid = -1; return; }
        if (hipFuncSetAttribute((const void*)fwd_kernel, hipFuncAttributeMaxDynamicSharedMemorySize, LDS_BYTES) != hipSuccess) { fprintf(stderr, "kernel_launch: hipFuncSetAttribute failed\n"); grid = -1; return; }
        if (hipOccupancyMaxActiveBlocksPerMultiprocessor(&per_cu, (const void*)fwd_kernel, NTHREADS, LDS_BYTES) != hipSuccess || per_cu < 1) { fprintf(stderr, "kernel_launch: occupancy query says %d\n", per_cu); (void)hipGetLastError(); grid = -1; return; }
        grid = cus;
    }
    if (grid < 0) return;
    (void)hipMemsetAsync((char*)d_ws + WS_CTL, 0, CTL_ZERO_BYTES, stream);
    Args a{};
    for (int i = 0; i < 28; ++i) a.in[i] = (const float*)d_in[i];
    a.out = (float*)d_out; a.ws = (unsigned char*)d_ws;
#if MK_ONE_LAUNCH
    a.ph_lo = 0; a.ph_hi = NPHASES;
    hipLaunchKernelGGL(fwd_kernel, dim3(grid), dim3(NTHREADS), LDS_BYTES, stream, a);
#else
    for (int ph = 0; ph < NPHASES; ++ph) { a.ph_lo = ph; a.ph_hi = ph + 1; hipLaunchKernelGGL(fwd_kernel, dim3(grid), dim3(NTHREADS), LDS_BYTES, stream, a); }
#endif
}
```

```cpp
#include <hip/hip_runtime.h>
#include <cstdio>
#include <cstdint>
#include <cmath>
__device__ __forceinline__ float bflo(unsigned w) { return __uint_as_float(w << 16); }
__device__ __forceinline__ float bfhi(unsigned w) { return __uint_as_float(w & 0xffff0000u); }
__device__ __forceinline__ float sigmoid_f(float v) { return __builtin_amdgcn_rcpf(1.0f + __builtin_amdgcn_exp2f(-1.4426950408889634f * v)); }
namespace pg8 {
#define PG8_LAS __attribute__((address_space(3)))
typedef unsigned short bf16_t;
typedef short bf16x8 __attribute__((ext_vector_type(8)));
typedef float f32x4 __attribute__((ext_vector_type(4)));
typedef unsigned u32x4 __attribute__((ext_vector_type(4)));
constexpr int BM = 256, BK = 64, HALF = 128, HTB = HALF * BK * 2  , STAGE_BYTES = 8 * HTB, NXCD = 8, WGM = 8;

__host__ __device__ __forceinline__ int lds_byte(int r, int c) { const int st = (r >> 4) * 2 + (c >> 5), rr = r & 15, cc = c & 31, ob = rr * 64 + cc * 2; return st * 1024 + (ob ^ (((ob >> 9) & 1) << 5)); }
__host__ __device__ __forceinline__ void stage_rc(int b, int& R, int& C) { const int st = b / 1024, sb = b % 1024, swz = sb ^ (((sb >> 9) & 1) << 5); R = (st >> 1) * 16 + swz / 64; C = (st & 1) * 32 + (swz % 64) / 2; }
__host__ __device__ __forceinline__ int perm32(int rho) { const int n = rho >> 4, i = rho & 15; return 8 * (i >> 2) + 4 * n + (i & 3); }

struct Unit { int pm, pn; };
struct Gemm { const bf16_t* A; const bf16_t* Bt; int M, N, K, lda; int a_shift, a_step; };

struct StaticOrder {
    int nM, nN, nwg, G, c;
    __host__ __device__ void init(int M, int N, int G_, int c_) { nM = M / BM; nN = N / BM; nwg = nM * nN; G = G_; c = c_; }
    __host__ __device__ bool next(int i, Unit& u) const {
        const long L = (long)i * G + c; if (L >= nwg) return false;
        int wgid = (int)L; { const int q = nwg / NXCD, r = nwg % NXCD, xcd = wgid % NXCD, off = wgid / NXCD; wgid = (xcd < r ? xcd * (q + 1) : r * (q + 1) + (xcd - r) * q) + off; }
        const int nig = WGM * nN, gid = wgid / nig, fm = gid * WGM, gsz = (nM - fm) < WGM ? (nM - fm) : WGM;
        u.pm = fm + ((wgid % nig) % gsz); u.pn = (wgid % nig) / gsz; return true;
    }
    __device__ __forceinline__ void a_ready(const Unit&) const {}
    __device__ __forceinline__ void done(const Unit&) const {}
};

__device__ __forceinline__ unsigned cvt_pk_bf16(float lo, float hi) { unsigned r; asm volatile("v_cvt_pk_bf16_f32 %0, %1, %2" : "=v"(r) : "v"(lo), "v"(hi)); return r; }
enum { EM_PLAIN = 0, EM_SILU2 = 1, EM_SIG = 2, EM_MUL = 3, EM_RES = 4 };
struct EpiU {
    static constexpr bool PERM = true, AFTER_DRAIN = false;
    int mode; int l; unsigned char* ws; const float* xin; float* xout; const float* cin0;
    size_t oA, oB; int ldc, ldc2, split_tile;
    __device__ __forceinline__ void operator()(const f32x4 (&acc)[2][2][4][2], const Unit& u, int wr, int wc, int fr, int fq) const {
        if (mode == EM_RES) {
            const int b = u.pm / 17, t0 = u.pm % 17;
            const float* src; float* dst; const float* gate; const float* modl = (const float*)(ws + oA) + (size_t)l * 5 * 3072;
            if (t0 == 0) { float* c1 = (float*)(ws + oB); src = ((l == 0) ? cin0 : (const float*)c1) + (size_t)b * 256 * 1024; dst = c1 + (size_t)b * 256 * 1024; gate = modl + 4 * 3072 + 2048; }
            else { const size_t o = ((size_t)b * 4096 + (size_t)(t0 - 1) * 256) * 1024; src = xin + o; dst = xout + o; gate = modl + b * 3072 + 2048; }
            const int col0 = u.pn * BM + wc * 32 + 8 * fq;
            const char* srcb = (const char*)src; char* dstb = (char*)dst; const char* gb = (const char*)(gate + col0);
            const unsigned off0 = (unsigned)((wr * 64 + fr) * 1024 + col0) * 4u;
#pragma unroll
            for (int ai = 0; ai < 2; ++ai) {
                f32x4 xo[4][2][2];
#pragma unroll
                for (int m = 0; m < 4; ++m) { const unsigned off = off0 + (unsigned)(ai * HALF + m * 16) * 4096u;
#pragma unroll
                    for (int bj = 0; bj < 2; ++bj)
#pragma unroll
                        for (int n = 0; n < 2; ++n) xo[m][bj][n] = *(const f32x4*)(srcb + (off + (unsigned)(bj * HALF + n * 4) * 4u)); }
#pragma unroll
                for (int m = 0; m < 4; ++m) { const unsigned off = off0 + (unsigned)(ai * HALF + m * 16) * 4096u;
#pragma unroll
                    for (int bj = 0; bj < 2; ++bj)
#pragma unroll
                        for (int n = 0; n < 2; ++n) { const unsigned cb = (unsigned)(bj * HALF + n * 4) * 4u; const f32x4 g = *(const f32x4*)(gb + cb);
                            *(f32x4*)(dstb + (off + cb)) = xo[m][bj][n] + g * acc[ai][bj][m][n]; } }
                asm volatile("" ::: "memory"); }
            return;
        }
        const int row0 = u.pm * BM + wr * 64 + fr; int colt = u.pn * BM; bf16_t* base = (bf16_t*)(ws + oA); int ld = ldc; bool second = false;
        if (u.pn >= split_tile) { base = (bf16_t*)(ws + oB); ld = ldc2; colt -= split_tile * BM; second = true; }
        const bool do_silu = (mode == EM_SILU2) && second;
        const int col0 = colt + wc * 32 + 8 * fq;
        if (mode == EM_MUL) {
            const int kk = u.pn >> 2, jt = u.pn & 3; const bool isctx = (u.pm % 17) == 0;
            bf16_t* mixb = (bf16_t*)(ws + oB); const int mcol0 = jt * BM + wc * 32 + 8 * fq;
            const bool rmw = !isctx && kk > 0;
#pragma unroll
            for (int am = 0; am < 4; ++am) { const int ai = am >> 1, mh = (am & 1) * 2;
                u32x4 old[2][2], prev[2][2];
#pragma unroll
                for (int m2 = 0; m2 < 2; ++m2)
#pragma unroll
                    for (int bj = 0; bj < 2; ++bj) old[m2][bj] = *(const u32x4*)(base + (size_t)(row0 + ai * HALF + (mh + m2) * 16) * ld + col0 + bj * HALF);
                if (rmw) {
#pragma unroll
                    for (int m2 = 0; m2 < 2; ++m2)
#pragma unroll
                        for (int bj = 0; bj < 2; ++bj) prev[m2][bj] = *(const u32x4*)(mixb + (size_t)(row0 + ai * HALF + (mh + m2) * 16) * 1024 + mcol0 + bj * HALF); }
#pragma unroll
                for (int m2 = 0; m2 < 2; ++m2)
#pragma unroll
                    for (int bj = 0; bj < 2; ++bj) { const int m = mh + m2; const f32x4 v0 = acc[ai][bj][m][0], v1 = acc[ai][bj][m][1]; const u32x4 o = old[m2][bj];
                        float t[8] = {v0[0] * bflo(o.x), v0[1] * bfhi(o.x), v0[2] * bflo(o.y), v0[3] * bfhi(o.y), v1[0] * bflo(o.z), v1[1] * bfhi(o.z), v1[2] * bflo(o.w), v1[3] * bfhi(o.w)};
                        if (rmw) { const u32x4 q = prev[m2][bj]; t[0] += bflo(q.x); t[1] += bfhi(q.x); t[2] += bflo(q.y); t[3] += bfhi(q.y); t[4] += bflo(q.z); t[5] += bfhi(q.z); t[6] += bflo(q.w); t[7] += bfhi(q.w); }
                        u32x4 w; w.x = cvt_pk_bf16(t[0], t[1]); w.y = cvt_pk_bf16(t[2], t[3]); w.z = cvt_pk_bf16(t[4], t[5]); w.w = cvt_pk_bf16(t[6], t[7]);
                        if (isctx) *(u32x4*)(base + (size_t)(row0 + ai * HALF + m * 16) * ld + col0 + bj * HALF) = w;
                        else *(u32x4*)(mixb + (size_t)(row0 + ai * HALF + m * 16) * 1024 + mcol0 + bj * HALF) = w; }
                asm volatile("" ::: "memory"); }
            return;
        }
#pragma unroll
        for (int ai = 0; ai < 2; ++ai)
#pragma unroll
            for (int m = 0; m < 4; ++m) { bf16_t* rowp = base + (size_t)(row0 + ai * HALF + m * 16) * ld + col0;
#pragma unroll
                for (int bj = 0; bj < 2; ++bj) { f32x4 v0 = acc[ai][bj][m][0], v1 = acc[ai][bj][m][1];
                    if (mode == EM_SIG) {
#pragma unroll
                        for (int e = 0; e < 4; ++e) { v0[e] = sigmoid_f(v0[e]); v1[e] = sigmoid_f(v1[e]); } }
                    if (do_silu) {
#pragma unroll
                        for (int e = 0; e < 4; ++e) { v0[e] = v0[e] * sigmoid_f(v0[e]); v1[e] = v1[e] * sigmoid_f(v1[e]); } }
                    u32x4 w; w.x = cvt_pk_bf16(v0[0], v0[1]); w.y = cvt_pk_bf16(v0[2], v0[3]); w.z = cvt_pk_bf16(v1[0], v1[1]); w.w = cvt_pk_bf16(v1[2], v1[3]);
                    *(u32x4*)(rowp + bj * HALF) = w; } }
    }
};
struct Order {
    int nM, nN, nwg, G, c, latent_only, grouped, vc, nctx;
    __device__ void init(int nM_, int nN_, int G_, int c_, int lat) { nM = nM_; nN = nN_; nwg = nM * nN; G = G_; c = c_; latent_only = lat; grouped = 0; vc = 0; nctx = 0; }
    __device__ void init_grouped(int G_, int vc_, int with_ctx) { init(64, 4, G_, vc_, 1); grouped = 1; vc = vc_; nctx = with_ctx ? 64 : 0; }
    __device__ bool next(int i, Unit& u) const {
        if (grouped) {
            const int gi = i >> 2, grp = vc + gi * G;
            if (grp < 256) { const int pm = grp >> 2; u.pm = pm + pm / 16 + 1; u.pn = 4 * (i & 3) + (grp & 3); return true; }
            const int done = ((256 - vc + G - 1) / G) * 4;
            const int x = vc + (i - done) * G;
            if (i >= done && x < nctx) { const int g = x >> 2, k = x & 3; u.pm = (g >> 2) * 17; u.pn = 4 * k + (g & 3); return true; }
            return false;
        }
        const long L = (long)i * G + c; if (L >= nwg) return false;
        int wgid = (int)L; { const int q = nwg / NXCD, r = nwg % NXCD, xcd = wgid % NXCD, off = wgid / NXCD; wgid = (xcd < r ? xcd * (q + 1) : r * (q + 1) + (xcd - r) * q) + off; }
        const int nig = WGM * nN, gid = wgid / nig, fm = gid * WGM, gsz = (nM - fm) < WGM ? (nM - fm) : WGM;
        int pm = fm + ((wgid % nig) % gsz); u.pn = (wgid % nig) / gsz; if (latent_only) pm = pm + pm / 16 + 1; u.pm = pm; return true;
    }
    __device__ __forceinline__ void a_ready(const Unit&) const {}
    __device__ __forceinline__ void done(const Unit&) const {}
};
template <class Epi, class Sched, bool ALIGN_EPI = false, bool SP2 = false>
__device__ __forceinline__ void gemm_phase(PG8_LAS unsigned char* lds, const Gemm g, const Sched& S, const Epi& E, const int tid  ) {
    const int wid = __builtin_amdgcn_readfirstlane(tid >> 6), lane = tid & 63, wr = wid >> 2, wc = wid & 3, fr = lane & 15, fq = lane >> 4;
    const int K = g.K, nt = K / BK;
    unsigned voffA[2], voffB[2];
#pragma unroll
    for (int i = 0; i < 2; ++i) { int R, C; stage_rc(tid * 16 + i * 8192, R, C); const int Rb = Epi::PERM ? ((R & ~31) + perm32(R & 31)) : R;
        voffA[i] = (unsigned)(R * g.lda + C) * 2u; voffB[i] = (unsigned)(Rb * K + C) * 2u; }
    const size_t kstep = (size_t)(BK * 2);
    const size_t hstepA = (size_t)HALF * g.lda * 2, hstepB = (size_t)HALF * K * 2;
    const size_t tstepA = 2 * hstepA, tstepB = 2 * hstepB;
    const unsigned ldsw = (unsigned)wid * 1024u;
    const int aoff = lds_byte(wr * 64 + fr, fq * 8), boff = lds_byte(wc * 32 + fr, fq * 8);
#define PG8_SA(b, h) (((b) * 2 + (h)) * HTB)
#define PG8_SB(b, h) ((4 + (b) * 2 + (h)) * HTB)
#define PG8_STAGE(bufoff, gbase, voff) do { _Pragma("unroll") for (int _i = 0; _i < 2; ++_i) \
        __builtin_amdgcn_global_load_lds((const unsigned*)((const char*)(gbase) + (voff)[_i]), (PG8_LAS unsigned*)(lds + (bufoff) + ldsw + _i * 8192), 16, 0, 0); } while (0)
#define PG8_LDA(dst, b, h) do { _Pragma("unroll") for (int m = 0; m < 4; ++m) _Pragma("unroll") for (int k = 0; k < 2; ++k) dst[m][k] = *(const PG8_LAS bf16x8*)(lds + PG8_SA(b, h) + aoff + m * 2048 + k * 1024); } while (0)
#define PG8_LDB(dst, b, h) do { _Pragma("unroll") for (int n = 0; n < 2; ++n) _Pragma("unroll") for (int k = 0; k < 2; ++k) dst[n][k] = *(const PG8_LAS bf16x8*)(lds + PG8_SB(b, h) + boff + n * 2048 + k * 1024); } while (0)
#define PG8_MMA(ai, bj, At, Bt) do { __builtin_amdgcn_s_setprio(1); _Pragma("unroll") for (int m = 0; m < 4; ++m) _Pragma("unroll") for (int n = 0; n < 2; ++n) _Pragma("unroll") for (int k = 0; k < 2; ++k) \
        acc[ai][bj][m][n] = __builtin_amdgcn_mfma_f32_16x16x32_bf16(Bt[n][k], At[m][k], acc[ai][bj][m][n], 0, 0, 0); __builtin_amdgcn_s_setprio(0); } while (0)
#define PG8_WAIT_V(n) asm volatile("s_waitcnt vmcnt(" #n ")" ::: "memory")
#define PG8_WAIT_L(n) asm volatile("s_waitcnt lgkmcnt(" #n ")" ::: "memory")
#define PG8_BAR __builtin_amdgcn_s_barrier()
#define PG8_SCHED __builtin_amdgcn_sched_barrier(0)
    Unit cur, nxt; int ui = 0;
    if (!S.next(0, cur)) return;
    f32x4 acc[2][2][4][2];
#pragma unroll
    for (int a = 0; a < 2; ++a)
#pragma unroll
        for (int b = 0; b < 2; ++b)
#pragma unroll
            for (int m = 0; m < 4; ++m)
#pragma unroll
                for (int n = 0; n < 2; ++n) acc[a][b][m][n] = (f32x4){0.f, 0.f, 0.f, 0.f};
    bf16x8 At[4][2], B0[2][2], B1[2][2];
    const char* cA = (const char*)g.A + (size_t)cur.pm * tstepA + (size_t)(cur.pn >> g.a_shift) * (size_t)g.a_step; const char* cB = (const char*)g.Bt + (size_t)cur.pn * tstepB;
    S.a_ready(cur);
    if constexpr (SP2) {
        PG8_STAGE(PG8_SB(0, 0), cB, voffB); PG8_STAGE(PG8_SB(0, 1), cB + hstepB, voffB); PG8_STAGE(PG8_SA(0, 0), cA, voffA); PG8_STAGE(PG8_SA(0, 1), cA + hstepA, voffA);
        if (wr == 1) PG8_BAR;
        PG8_WAIT_V(2); PG8_BAR;
        PG8_STAGE(PG8_SB(1, 0), cB + kstep, voffB); PG8_STAGE(PG8_SA(1, 0), cA + kstep, voffA); PG8_STAGE(PG8_SB(1, 1), cB + hstepB + kstep, voffB);
        PG8_WAIT_V(6); PG8_BAR;
    } else {
        PG8_STAGE(PG8_SB(0, 0), cB, voffB); PG8_STAGE(PG8_SA(0, 0), cA, voffA); PG8_STAGE(PG8_SB(0, 1), cB + hstepB, voffB); PG8_STAGE(PG8_SA(0, 1), cA + hstepA, voffA);
        if (wr == 1) PG8_BAR;
        PG8_WAIT_V(4); PG8_BAR;
        PG8_STAGE(PG8_SB(1, 0), cB + kstep, voffB); PG8_STAGE(PG8_SA(1, 0), cA + kstep, voffA); PG8_STAGE(PG8_SB(1, 1), cB + hstepB + kstep, voffB);
        PG8_WAIT_V(6); PG8_BAR;
    }
    for (;;) {
        const bool has_next = S.next(ui + 1, nxt);
        const char* nA = has_next ? (const char*)g.A + (size_t)nxt.pm * tstepA + (size_t)(nxt.pn >> g.a_shift) * (size_t)g.a_step : cA; const char* nB = has_next ? (const char*)g.Bt + (size_t)nxt.pn * tstepB : cB;
        for (int t = 0; t < nt; t += 2) {
            const bool last = (t == nt - 2);
            const char* a1 = cA + (size_t)(t + 1) * kstep;
            const char* a2 = last ? nA : cA + (size_t)(t + 2) * kstep; const char* b2 = last ? nB : cB + (size_t)(t + 2) * kstep;
            const char* a3 = a2 + kstep; const char* b3 = b2 + kstep;
            if (last && has_next) S.a_ready(nxt);
            if constexpr (SP2) {
            PG8_LDB(B0, 0, 0); PG8_LDB(B1, 0, 1); PG8_SCHED; PG8_LDA(At, 0, 0); PG8_STAGE(PG8_SA(1, 1), a1 + hstepA, voffA);
            PG8_WAIT_V(8); PG8_WAIT_L(0); PG8_BAR; PG8_MMA(0, 0, At, B0); PG8_MMA(0, 1, At, B1); PG8_BAR; PG8_SCHED;
            PG8_LDA(At, 0, 1); PG8_STAGE(PG8_SB(0, 0), b2, voffB); PG8_STAGE(PG8_SB(0, 1), b2 + hstepB, voffB); PG8_STAGE(PG8_SA(0, 0), a2, voffA);
            PG8_WAIT_V(8); PG8_WAIT_L(0); PG8_BAR; PG8_MMA(1, 0, At, B0); PG8_MMA(1, 1, At, B1); PG8_BAR; PG8_SCHED;
            PG8_LDB(B0, 1, 0); PG8_LDB(B1, 1, 1); PG8_SCHED; PG8_LDA(At, 1, 0); PG8_STAGE(PG8_SA(0, 1), a2 + hstepA, voffA);
            PG8_WAIT_V(8); PG8_WAIT_L(0); PG8_BAR; PG8_MMA(0, 0, At, B0); PG8_MMA(0, 1, At, B1); PG8_BAR; PG8_SCHED;
            PG8_LDA(At, 1, 1); PG8_STAGE(PG8_SB(1, 0), b3, voffB); PG8_STAGE(PG8_SB(1, 1), b3 + hstepB, voffB); PG8_STAGE(PG8_SA(1, 0), a3, voffA);
            PG8_WAIT_V(8); PG8_WAIT_L(0); PG8_BAR; PG8_MMA(1, 0, At, B0); PG8_MMA(1, 1, At, B1); PG8_BAR; PG8_SCHED;
            } else {
            PG8_LDB(B0, 0, 0); PG8_SCHED; PG8_LDA(At, 0, 0); PG8_STAGE(PG8_SA(1, 1), a1 + hstepA, voffA);
            PG8_WAIT_L(8); PG8_BAR; PG8_WAIT_L(0); PG8_MMA(0, 0, At, B0); PG8_BAR; PG8_SCHED;
            PG8_LDB(B1, 0, 1); PG8_STAGE(PG8_SB(0, 0), b2, voffB);
            PG8_BAR; PG8_WAIT_L(0); PG8_MMA(0, 1, At, B1); PG8_BAR;
            PG8_LDA(At, 0, 1); PG8_STAGE(PG8_SA(0, 0), a2, voffA);
            PG8_BAR; PG8_WAIT_L(0); PG8_MMA(1, 0, At, B0); PG8_BAR; PG8_SCHED;
            PG8_STAGE(PG8_SB(0, 1), b2 + hstepB, voffB);
            PG8_WAIT_V(6); PG8_BAR; PG8_MMA(1, 1, At, B1); PG8_BAR;
            PG8_LDB(B0, 1, 0); PG8_SCHED; PG8_LDA(At, 1, 0); PG8_STAGE(PG8_SA(0, 1), a2 + hstepA, voffA);
            PG8_WAIT_L(8); PG8_BAR; PG8_WAIT_L(0); PG8_MMA(0, 0, At, B0); PG8_BAR; PG8_SCHED;
            PG8_LDB(B1, 1, 1); PG8_STAGE(PG8_SB(1, 0), b3, voffB);
            PG8_BAR; PG8_WAIT_L(0); PG8_MMA(0, 1, At, B1); PG8_BAR;
            PG8_LDA(At, 1, 1); PG8_STAGE(PG8_SA(1, 0), a3, voffA);
            PG8_BAR; PG8_WAIT_L(0); PG8_MMA(1, 0, At, B0); PG8_BAR; PG8_SCHED;
            PG8_STAGE(PG8_SB(1, 1), b3 + hstepB, voffB);
            PG8_WAIT_V(6); PG8_BAR; PG8_MMA(1, 1, At, B1); PG8_BAR;
            }
        }
        if constexpr (ALIGN_EPI) { if (wr == 0) PG8_BAR; }
        if constexpr (!Epi::AFTER_DRAIN) { E(acc, cur, wr, wc, fr, fq); S.done(cur); }
        if (!has_next) break;
#pragma unroll
        for (int a = 0; a < 2; ++a)
#pragma unroll
            for (int b = 0; b < 2; ++b)
#pragma unroll
                for (int m = 0; m < 4; ++m)
#pragma unroll
                    for (int n = 0; n < 2; ++n) acc[a][b][m][n] = (f32x4){0.f, 0.f, 0.f, 0.f};
        cur = nxt; cA = nA; cB = nB; ++ui;
        if constexpr (ALIGN_EPI) { if (wr == 1) PG8_BAR; }
    }
    PG8_WAIT_V(0);
    if constexpr (!ALIGN_EPI) { if (wr == 0) PG8_BAR; }
    PG8_BAR;
    if constexpr (Epi::AFTER_DRAIN) { E.fused(acc, cur, wr, wc, fr, fq, lds, wid, lane); S.done(cur); }
#undef PG8_SA
#undef PG8_SB
#undef PG8_STAGE
#undef PG8_LDA
#undef PG8_LDB
#undef PG8_MMA
#undef PG8_WAIT_V
#undef PG8_WAIT_L
#undef PG8_BAR
#undef PG8_SCHED
}
}
#define PG8_SP2 true
#define PG8_ALIGN true
#define GAS __attribute__((address_space(1)))
#define LAS __attribute__((address_space(3)))
typedef unsigned short bf16;
typedef unsigned v4u __attribute__((ext_vector_type(4)));
typedef float f32x4 __attribute__((ext_vector_type(4)));
typedef short bf16x8 __attribute__((ext_vector_type(8)));
typedef GAS unsigned gu32;
typedef GAS unsigned long long gu64;
#define RLX_AGENT __ATOMIC_RELAXED, __HIP_MEMORY_SCOPE_AGENT
#define LDS_WAIT() asm volatile("s_waitcnt lgkmcnt(0)" ::: "memory")
#define VM_WAIT() asm volatile("s_waitcnt vmcnt(0)" ::: "memory")
__device__ __forceinline__ unsigned long long rt() { return __builtin_amdgcn_s_memrealtime(); }
__device__ __forceinline__ unsigned f2bf(float f) { unsigned u = __builtin_bit_cast(unsigned, f); return (u + 0x7fffu + ((u >> 16) & 1u)) >> 16; }
__device__ __forceinline__ unsigned pk2(float lo, float hi) { return f2bf(lo) | (f2bf(hi) << 16); }
#define XB_TMO      128
#define XB_XCNT(j)  (256  + 64 * (j))
#define XB_XSUB(j)  (1280 + 64 * (j))
#define XB_XGEN(j)  (2304 + 64 * (j))
#define XB_TOP      3328
#define XB_TOPGEN   3392
#define XCD_BAR_WORDS 3456
#define XB_SPIN_CAP (1u << 18)

__device__ __forceinline__ unsigned xb_ld(unsigned* p)              { return __hip_atomic_load(p, __ATOMIC_RELAXED, __HIP_MEMORY_SCOPE_AGENT); }
__device__ __forceinline__ unsigned xb_add(unsigned* p, unsigned v) { return __hip_atomic_fetch_add(p, v, __ATOMIC_RELAXED, __HIP_MEMORY_SCOPE_AGENT); }
__device__ __forceinline__ unsigned xb_xcc_id() { return (unsigned)__builtin_amdgcn_s_getreg((3 << 11) | 20) & 0xFu; }
#define XB_SPIN(cond, bar) do { unsigned _sp = 0; while (cond) { __builtin_amdgcn_s_sleep(1); \
    if ((++_sp & 255u) == 0u) { if (xb_ld(&(bar)[XB_TMO])) break; if (_sp > XB_SPIN_CAP) { atomicAdd(&(bar)[XB_TMO], 1u); break; } } } } while (0)

struct XcdBarrier {
    unsigned* bar; unsigned x;
    volatile LAS unsigned* st;
};

__device__ __forceinline__ XcdBarrier xcd_barrier_post(unsigned* bar, volatile LAS unsigned* st) {
    XcdBarrier b; b.bar = bar; b.x = xb_xcc_id(); b.st = st;
    if (threadIdx.x == 0) (void)xb_add(&bar[XB_XCNT(b.x)], 1u);
    return b;
}
__device__ __forceinline__ void xcd_barrier_complete(unsigned* bar, unsigned x, unsigned& nloc, unsigned& nx) {
    const unsigned G = gridDim.x * gridDim.y * gridDim.z;
    unsigned sum, cnt, mine, sp = 0u;
    for (;;) {
        sum = 0u; cnt = 0u; mine = 0u;
#pragma unroll
        for (unsigned j = 0; j < 16; ++j) { const unsigned c = xb_ld(&bar[XB_XCNT(j)]); sum += c; cnt += (c > 0u) ? 1u : 0u; mine = (j == x) ? c : mine; }
        if (sum == G) break;
        __builtin_amdgcn_s_sleep(1);
        if ((++sp & 255u) == 0u) { if (xb_ld(&bar[XB_TMO])) break; if (sp > XB_SPIN_CAP) { atomicAdd(&bar[XB_TMO], 1u); break; } }
    }
    nloc = mine > 0u ? mine : 1u; nx = cnt > 0u ? cnt : 1u;
}

__device__ __forceinline__ void xcd_barrier(const XcdBarrier& b) {
    asm volatile("s_waitcnt vmcnt(0)" ::: "memory");
    __syncthreads();
    if (threadIdx.x == 0) {
        unsigned* bar = b.bar;
        __builtin_amdgcn_s_waitcnt(0);
        unsigned nloc = b.st[0], nx = b.st[1];
        if (nloc == 0u) { xcd_barrier_complete(bar, b.x, nloc, nx); b.st[0] = nloc; b.st[1] = nx; }
        const unsigned old = xb_add(&bar[XB_XSUB(b.x)], 1u);
        const unsigned gen = old / nloc;
        if (old + 1u == (gen + 1u) * nloc) {
            __builtin_amdgcn_fence(__ATOMIC_RELEASE, "agent");
            asm volatile("s_waitcnt vmcnt(0)" ::: "memory");
            const unsigned og = xb_add(&bar[XB_TOP], 1u);
            const unsigned tg = og / nx;
            if (og + 1u == (tg + 1u) * nx) xb_add(&bar[XB_TOPGEN], 1u);
            else XB_SPIN(xb_ld(&bar[XB_TOPGEN]) == tg, bar);
            __builtin_amdgcn_fence(__ATOMIC_ACQUIRE, "agent");
            xb_add(&bar[XB_XGEN(b.x)], 1u);
            asm volatile("s_waitcnt vmcnt(0)" ::: "memory");
        } else {
            XB_SPIN(xb_ld(&bar[XB_XGEN(b.x)]) == gen, bar);
            __builtin_amdgcn_fence(__ATOMIC_ACQUIRE, "agent");
            asm volatile("s_waitcnt vmcnt(0)" ::: "memory");
        }
    }
    __syncthreads();
}
constexpr int NB = 4, SEQ = 4096, CTXL = 256, TPB = SEQ + CTXL, NROWS = NB * TPB, DM = 1024, NLAYER = 2, IN_COLS = 6816;
constexpr int NWAVES = 8, NTHREADS = NWAVES * 64;
constexpr float RMS_EPS = 1e-6f;
constexpr float LOG2E = 1.4426950408889634f;
constexpr float QSCALE64 = 0.125f * LOG2E;
constexpr float QSCALE96 = 0.10206207261596575f * LOG2E;
constexpr int ZS_P = 1792, ZC_CQ = 0, ZC_CKV = 256, ZC_KR = 384, ZC_SQ = 512, ZC_SK = 768, ZC_SV = 896, ZC_AQ = 1024, ZC_AK = 1280, ZC_AV = 1408, ZC_LRU = 1536;
constexpr int N1 = 2816;
constexpr int W1ROWS = N1 + 4096;
constexpr size_t MiB = 1u << 20;
constexpr size_t WS_CTL = 0, CTL_ZERO_BYTES = 64 * 1024;
constexpr size_t WS_MOD = 1 * MiB;
constexpr size_t WS_RHC = 1 * MiB + 256 * 1024, WS_RHS = WS_RHC + 512 * 1024;
constexpr size_t WS_RMC = WS_RHS + 512 * 1024, WS_RMS = WS_RMC + 256 * 1024;
constexpr size_t WS_CTX1 = 3 * MiB;
constexpr size_t WS_W = 8 * MiB, W_LAYER = 18 * MiB;
constexpr size_t WO_W1 = 0, WO_WB = 13 * MiB + 512 * 1024, WO_WO = WO_WB + 2 * MiB, WO_UQ = WO_WO + 2 * MiB, WO_UKV = WO_UQ + 256 * 1024;
constexpr size_t WS_H = 44 * MiB;
constexpr size_t WS_G = 78 * MiB;
constexpr size_t WS_S = 112 * MiB;
constexpr size_t WS_ZS = 112 * MiB;
constexpr size_t WS_MQ = 172 * MiB;
constexpr size_t WS_MKV = 189 * MiB;
constexpr size_t WS_MK = 206 * MiB;
constexpr size_t WS_U = 219 * MiB;
constexpr size_t WS_HF = 236 * MiB;
constexpr size_t WS_SP = 2 * MiB + 768 * 1024;
constexpr size_t WS_LWT = 254 * MiB + 512 * 1024;
constexpr size_t WS_END = 256 * MiB;
static_assert(WS_H + (size_t)NROWS * 1024 * 2 <= WS_G && WS_G + (size_t)NROWS * 1024 * 2 <= WS_S && WS_S + (size_t)NROWS * 4096 * 2 <= 248 * MiB, "ws map");
static_assert(WS_ZS + (size_t)NROWS * ZS_P * 2 <= WS_MQ && WS_MK + (size_t)NROWS * 384 * 2 <= WS_U, "ws map 2");
static_assert(WO_UKV + 512 * 256 * 2 <= W_LAYER, "weights");
constexpr int CW_BAR = 1024;

constexpr int RING_OFF = 0, RING_BYTES = 131072, LDSCTL_OFF = RING_BYTES, MISC_OFF = LDSCTL_OFF + 320, LDS_BYTES = 147456;

typedef unsigned short bf16;
typedef unsigned u32x2 __attribute__((ext_vector_type(2)));
typedef float f32x2v __attribute__((ext_vector_type(2)));
__device__ __forceinline__ float bf2f(bf16 v) { return __uint_as_float((unsigned)v << 16); }
__device__ __forceinline__ float wave_sum(float v) {
#pragma unroll
    for (int o = 1; o < 64; o <<= 1) v += __shfl_xor(v, o);
    return v; }
__device__ __forceinline__ float wave_max(float v) {
#pragma unroll
    for (int o = 1; o < 64; o <<= 1) v = fmaxf(v, __shfl_xor(v, o));
    return v; }
__device__ __forceinline__ float grp16_sum(float v) {
#pragma unroll
    for (int o = 1; o < 16; o <<= 1) v += __shfl_xor(v, o);
    return v; }

struct Args { const float* in[28]; float* out; unsigned char* ws; int ph_lo, ph_hi; };
enum { I_X = 0, I_C, I_CTX, I_CCTX, I_WMOD, I_BMOD, I_NORMW, I_WIN, I_CQN, I_CKVN, I_WUQ, I_WUKV, I_MQN, I_MKN, I_SQN, I_SKN, I_SINK, I_AQN, I_AKN,
       I_CONVW, I_CONVB, I_LWR, I_LBR, I_LWI, I_LBI, I_LAM, I_WBR, I_WOUT };

struct Frame {
    LAS unsigned char* lds; const float* const __attribute__((address_space(4)))* kin; unsigned char* ws; float* out;
    int tid, lane, wave, G, vcu, gw, NGW, z;
    __device__ __forceinline__ const float* in(int i) const { return kin[i]; }
};

__device__ __forceinline__ void xpose_item(const float* W, int ldn, int k0, int n0, bf16* WT, int pd, int drow, LAS float* scr, int lane) {
#pragma unroll 8
    for (int i = 0; i < 32; ++i) { const int kk = 2 * i + (lane >> 5); scr[kk * 33 + (lane & 31)] = W[(size_t)(k0 + kk) * ldn + n0 + (lane & 31)]; }
    LDS_WAIT(); asm volatile("" ::: "memory");
    const int c = lane & 7;
#pragma unroll
    for (int j = 0; j < 4; ++j) { const int n = (lane >> 3) + 8 * j; const LAS float* s = scr + (8 * c) * 33 + n;
        v4u o; o.x = pk2(s[0 * 33], s[1 * 33]); o.y = pk2(s[2 * 33], s[3 * 33]); o.z = pk2(s[4 * 33], s[5 * 33]); o.w = pk2(s[6 * 33], s[7 * 33]);
        *(GAS v4u*)(WT + (size_t)(drow + n0 + n) * pd + k0 + 8 * c) = o; }
    LDS_WAIT(); asm volatile("" ::: "memory");
}
__device__ __forceinline__ void zero16(bf16* p, size_t n16, int gt, int ngt) {
    for (size_t i = gt; i < n16; i += ngt) ((GAS v4u*)p)[i] = (v4u){0u, 0u, 0u, 0u};
}
__device__ __forceinline__ void weight_copies(Frame& F, int l, int gw, int NGW) {
    LAS float* scr = (LAS float*)(F.lds + RING_OFF + F.wave * 16384);
    constexpr int I_IN = 16 * 213, I_UQ = 4 * 12, I_UKV = 2 * 16, I_BR = 4 * 4 * 32, I_OUT = 16 * 32, I_LAYER = I_IN + I_UQ + I_UKV + I_BR + I_OUT;
    unsigned char* wl = F.ws + WS_W + (size_t)l * W_LAYER;
    for (int it = gw; it < I_LAYER; it += NGW) {
        int r = it;
        if (r < I_IN) { const int kb = r / 213, nb = r % 213, n0 = nb * 32;
            xpose_item(F.in(I_WIN) + (size_t)l * 1024 * IN_COLS, IN_COLS, kb * 64, n0, (bf16*)(wl + WO_W1), 1024, n0 >= 416 ? 96 : 0, scr, F.lane); continue; } r -= I_IN;
        if (r < I_UQ) { const int kb = r / 12, nb = r % 12;
            xpose_item(F.in(I_WUQ) + (size_t)l * 256 * 384, 384, kb * 64, nb * 32, (bf16*)(wl + WO_UQ), 256, 0, scr, F.lane); continue; } r -= I_UQ;
        if (r < I_UKV) { const int kb = r / 16, nb = r % 16;
            xpose_item(F.in(I_WUKV) + (size_t)l * 128 * 512, 512, kb * 64, nb * 32, (bf16*)(wl + WO_UKV), 256, 0, scr, F.lane); continue; } r -= I_UKV;
        if (r < I_BR) { const int k = r / 128, rr = r % 128, kb = rr / 32, nb = rr % 32;
            xpose_item(F.in(I_WBR) + ((size_t)l * 4 + k) * 256 * 1024, 1024, kb * 64, nb * 32, (bf16*)(wl + WO_WB) + (size_t)k * 1024 * 256, 256, 0, scr, F.lane); continue; } r -= I_BR;
        { const int kb = r / 32, nb = r % 32;
            xpose_item(F.in(I_WOUT) + (size_t)l * 1024 * 1024, 1024, kb * 64, nb * 32, (bf16*)(wl + WO_WO), 1024, 0, scr, F.lane); }
    }
}
__device__ __forceinline__ void p0_prologue(Frame& F) {
    weight_copies(F, 0, F.gw, F.NGW);
    const int gt = F.vcu * NTHREADS + F.tid, ngt = F.G * NTHREADS;
    for (int l = 0; l < NLAYER; ++l) {
        unsigned char* wl = F.ws + WS_W + (size_t)l * W_LAYER;
        zero16((bf16*)(wl + WO_W1) + (size_t)416 * 1024, 96 * 1024 * 2 / 16, gt, ngt);
        zero16((bf16*)(wl + WO_UQ) + (size_t)384 * 256, 128 * 256 * 2 / 16, gt, ngt);
        for (int i = gt; i < 512 * 16; i += ngt) { const int n = i >> 4, c = i & 15; ((GAS v4u*)((bf16*)(wl + WO_UKV) + (size_t)n * 256 + 128))[c] = (v4u){0u, 0u, 0u, 0u}; }
    }
    { float* rhc = (float*)(F.ws + WS_RHC); float* rhs = (float*)(F.ws + WS_RHS); float* rmc = (float*)(F.ws + WS_RMC); float* rms = (float*)(F.ws + WS_RMS);
      for (int i = gt; i < 4096 * 32; i += ngt) { const int t = i >> 5, p = i & 31; const float fr = powf(10000.0f, -(float)(p & 15) / 16.0f);
          const float pos = (float)((p < 16) ? (t >> 6) : (t & 63)); const float ang = pos * fr; rhc[i] = cosf(ang); rhs[i] = sinf(ang); }
      for (int i = gt; i < 4096 * 16; i += ngt) { const int t = i >> 4, p = i & 15; const float fr = powf(10000.0f, -(float)(p & 7) / 8.0f);
          const float pos = (float)((p < 8) ? (t >> 6) : (t & 63)); const float ang = pos * fr; rmc[i] = cosf(ang); rms[i] = sinf(ang); } }
    { float* sp = (float*)(F.ws + WS_SP); for (int i = gt; i < NLAYER * 2 * 256; i += ngt) sp[i] = 8.0f * LOG2E * log1pf(expf(-F.in(I_LAM)[i])); }
    { float* lwt = (float*)(F.ws + WS_LWT);
      for (int o = gt; o < NLAYER * 2 * 2 * 256 * 64; o += ngt) { const int i = o & 63, c = (o >> 6) & 255, gate = (o >> 14) & 1, ld = o >> 15, k = c >> 6, j = c & 63;
          lwt[o] = (gate == 0 ? F.in(I_LWR) : F.in(I_LWI))[(((size_t)ld * 4 + k) * 64 + i) * 64 + j]; } }
    { LAS float* sc = (LAS float*)(F.lds + RING_OFF);
      LAS float* red = sc + 5 * 1024;
      __syncthreads();
      for (int i = F.tid; i < 5 * 1024; i += NTHREADS) { const float v = (i < 4096) ? F.in(I_C)[i] : F.in(I_CCTX)[i - 4096]; sc[i] = v / (1.0f + expf(-v)); }
      __syncthreads();
      float* modv = (float*)(F.ws + WS_MOD);
      for (int it = F.vcu; it < NLAYER * 96; it += F.G) {
          const int l = it / 96, n0 = (it % 96) * 32, nn = F.tid & 31, kc = F.tid >> 5;
          const float* w = F.in(I_WMOD) + (size_t)l * 1024 * 3072 + n0 + nn;
          float acc[5] = {0.f, 0.f, 0.f, 0.f, 0.f};
          for (int k = kc * 64; k < kc * 64 + 64; ++k) { const float wv = w[(size_t)k * 3072];
#pragma unroll
              for (int r = 0; r < 5; ++r) acc[r] += sc[r * 1024 + k] * wv; }
#pragma unroll
          for (int r = 0; r < 5; ++r) red[(kc * 5 + r) * 32 + nn] = acc[r];
          __syncthreads();
          if (F.tid < 160) { const int r = F.tid >> 5; float s = 0.f;
              for (int q = 0; q < 16; ++q) s += red[(q * 5 + r) * 32 + nn];
              modv[((size_t)l * 5 + r) * 3072 + n0 + nn] = s + F.in(I_BMOD)[l * 3072 + n0 + nn]; }
          __syncthreads();
      } }
}

__device__ __forceinline__ void ph_hnorm(Frame& F, int l) {
    const float* xs = (l == 0) ? F.in(I_X) : F.out; const float* cs = (l == 0) ? F.in(I_CTX) : (const float*)(F.ws + WS_CTX1);
    const float* nw = F.in(I_NORMW) + l * 1024; const float* modl = (const float*)(F.ws + WS_MOD) + (size_t)l * 5 * 3072;
    bf16* H = (bf16*)(F.ws + WS_H);
    for (int row = F.gw; row < NROWS; row += F.NGW) {
        const int b = row / TPB, j = row % TPB; const float* src; int mr;
        if (j < CTXL) { src = cs + ((size_t)b * CTXL + j) * 1024; mr = 4; } else { src = xs + ((size_t)b * SEQ + (j - CTXL)) * 1024; mr = b; }
        const GAS f32x4* xr = (const GAS f32x4*)src + F.lane;
        f32x4 v[4]; float ss = 0.f;
#pragma unroll
        for (int q = 0; q < 4; ++q) { v[q] = xr[64 * q]; ss += (v[q].x * v[q].x + v[q].y * v[q].y) + (v[q].z * v[q].z + v[q].w * v[q].w); }
        const float rstd = 1.0f / sqrtf(wave_sum(ss) * (1.0f / 1024.0f) + RMS_EPS);
        const float* mrow = modl + mr * 3072;
        GAS unsigned long long* o8 = (GAS unsigned long long*)(H + (size_t)row * 1024) + F.lane;
#pragma unroll
        for (int q = 0; q < 4; ++q) { const int c = 4 * F.lane + 256 * q;
            const f32x4 g = *(const f32x4*)(nw + c), sh = *(const f32x4*)(mrow + c), sc = *(const f32x4*)(mrow + 1024 + c);
            const f32x4 h = v[q] * rstd * g * (sc + 1.0f) + sh;
            o8[64 * q] = (unsigned long long)pk2(h.x, h.y) | ((unsigned long long)pk2(h.z, h.w) << 32); }
    }
}

struct P1Regs { u32x2 cq; unsigned ckv, h[3][2]; float rc[2], rs[2]; };
__device__ __forceinline__ void post1_load(const bf16* z, const float* rc, const float* rs, bool lat, int lane, P1Regs& R) {
    const int hg = lane >> 4, p0 = (lane & 15) * 2;
    R.cq = *(const u32x2*)(z + ZC_CQ + 4 * lane); R.ckv = *(const unsigned*)(z + ZC_CKV + 2 * lane);
    const bf16* h0 = z + ZC_SQ + hg * 64 + p0; const bf16* h1 = z + ZC_AQ + hg * 64 + p0; const bf16* h2 = z + ((hg < 2) ? (ZC_SK + hg * 64) : (ZC_AK + (hg - 2) * 64)) + p0;
    R.h[0][0] = *(const unsigned*)h0; R.h[0][1] = *(const unsigned*)(h0 + 32); R.h[1][0] = *(const unsigned*)h1; R.h[1][1] = *(const unsigned*)(h1 + 32); R.h[2][0] = *(const unsigned*)h2; R.h[2][1] = *(const unsigned*)(h2 + 32);
    if (lat) { R.rc[0] = rc[p0]; R.rc[1] = rc[p0 + 1]; R.rs[0] = rs[p0]; R.rs[1] = rs[p0 + 1]; } else { R.rc[0] = 1.f; R.rc[1] = 1.f; R.rs[0] = 0.f; R.rs[1] = 0.f; }
}
__device__ __forceinline__ void post1_finish(bf16* z, int lane, const P1Regs& R, const float (&gcq)[4], const float (&gckv)[2], const float (&gh)[3][4]) {
    const int hg = lane >> 4, p0 = (lane & 15) * 2;
    { float v0 = bflo(R.cq.x), v1 = bfhi(R.cq.x), v2 = bflo(R.cq.y), v3 = bfhi(R.cq.y);
      const float rstd = 1.0f / sqrtf(wave_sum(v0 * v0 + v1 * v1 + v2 * v2 + v3 * v3) * (1.0f / 256.0f) + RMS_EPS);
      u32x2 w; w.x = pk2(v0 * rstd * gcq[0], v1 * rstd * gcq[1]); w.y = pk2(v2 * rstd * gcq[2], v3 * rstd * gcq[3]); *(u32x2*)(z + ZC_CQ + 4 * lane) = w; }
    { float v0 = bflo(R.ckv), v1 = bfhi(R.ckv);
      const float rstd = 1.0f / sqrtf(wave_sum(v0 * v0 + v1 * v1) * (1.0f / 128.0f) + RMS_EPS);
      *(unsigned*)(z + ZC_CKV + 2 * lane) = pk2(v0 * rstd * gckv[0], v1 * rstd * gckv[1]); }
#pragma unroll
    for (int q = 0; q < 3; ++q) {
        bf16* hp = z + ((q == 0) ? (ZC_SQ + hg * 64) : (q == 1) ? (ZC_AQ + hg * 64) : ((hg < 2) ? (ZC_SK + hg * 64) : (ZC_AK + (hg - 2) * 64))) + p0;
        float a0 = bflo(R.h[q][0]), a1 = bfhi(R.h[q][0]), b0 = bflo(R.h[q][1]), b1 = bfhi(R.h[q][1]);
        const float rstd = 1.0f / sqrtf(grp16_sum(a0 * a0 + a1 * a1 + b0 * b0 + b1 * b1) * (1.0f / 64.0f) + RMS_EPS);
        a0 *= rstd * gh[q][0]; a1 *= rstd * gh[q][1]; b0 *= rstd * gh[q][2]; b1 *= rstd * gh[q][3];
        const float x0 = a0 * R.rc[0] - b0 * R.rs[0], y0 = b0 * R.rc[0] + a0 * R.rs[0], x1 = a1 * R.rc[1] - b1 * R.rs[1], y1 = b1 * R.rc[1] + a1 * R.rs[1];
        const float sc = (q < 2) ? QSCALE64 : 1.0f;
        *(unsigned*)hp = pk2(x0 * sc, x1 * sc); *(unsigned*)(hp + 32) = pk2(y0 * sc, y1 * sc);
    }
}
__device__ __forceinline__ void ph_post1(Frame& F, int l) {
    bf16* ZS = (bf16*)(F.ws + WS_ZS);
    const float* rhc = (const float*)(F.ws + WS_RHC); const float* rhs = (const float*)(F.ws + WS_RHS);
    const int lane = F.lane, hg = lane >> 4, p0 = (lane & 15) * 2;
    float gcq[4], gckv[2], gh[3][4];
#pragma unroll
    for (int i = 0; i < 4; ++i) gcq[i] = F.in(I_CQN)[l * 256 + 4 * lane + i];
    gckv[0] = F.in(I_CKVN)[l * 128 + 2 * lane]; gckv[1] = F.in(I_CKVN)[l * 128 + 2 * lane + 1];
    { const float* g0 = F.in(I_SQN) + l * 64; const float* g1 = F.in(I_AQN) + l * 64; const float* g2 = ((hg < 2) ? F.in(I_SKN) : F.in(I_AKN)) + l * 64;
      gh[0][0] = g0[p0]; gh[0][1] = g0[p0 + 1]; gh[0][2] = g0[32 + p0]; gh[0][3] = g0[33 + p0];
      gh[1][0] = g1[p0]; gh[1][1] = g1[p0 + 1]; gh[1][2] = g1[32 + p0]; gh[1][3] = g1[33 + p0];
      gh[2][0] = g2[p0]; gh[2][1] = g2[p0 + 1]; gh[2][2] = g2[32 + p0]; gh[2][3] = g2[33 + p0]; }
    for (int row = F.gw; row < NROWS; row += 2 * F.NGW) {
        const int row2 = row + F.NGW; const bool has2 = row2 < NROWS;
        const int j = row % TPB; const bool lat = j >= CTXL; const int pos = lat ? j - CTXL : 0;
        const int j2 = has2 ? row2 % TPB : 0; const bool lat2 = j2 >= CTXL; const int pos2 = lat2 ? j2 - CTXL : 0;
        bf16* z = ZS + (size_t)row * ZS_P; bf16* z2 = ZS + (size_t)(has2 ? row2 : row) * ZS_P;
        P1Regs A, B;
        post1_load(z, rhc + pos * 32, rhs + pos * 32, lat, lane, A);
        if (has2) post1_load(z2, rhc + pos2 * 32, rhs + pos2 * 32, lat2, lane, B);
        post1_finish(z, lane, A, gcq, gckv, gh);
        if (has2) post1_finish(z2, lane, B, gcq, gckv, gh);
    }
}
struct P2Regs { u32x2 qn, kn; bf16 q1, q2, k1, k2; float c, s; };
__device__ __forceinline__ void post2_load(const bf16* zrow, const bf16* mq, const bf16* mkv, const float* rc, const float* rs, bool lat, int lane, P2Regs& R) {
    const int h = lane >> 4, j = lane & 15;
    R.qn = *(const u32x2*)(mq + h * 96 + 4 * j); R.q1 = mq[h * 96 + 64 + j]; R.q2 = mq[h * 96 + 80 + j];
    R.kn = *(const u32x2*)(mkv + h * 128 + 4 * j); R.k1 = zrow[ZC_KR + j]; R.k2 = zrow[ZC_KR + 16 + j];
    if (lat) { R.c = rc[j]; R.s = rs[j]; } else { R.c = 1.f; R.s = 0.f; }
}
__device__ __forceinline__ void post2_finish(bf16* mq, bf16* mk, int lane, const P2Regs& R, const float (&gq)[6], const float (&gk)[6]) {
    const int h = lane >> 4, j = lane & 15;
#pragma unroll
    for (int qk = 0; qk < 2; ++qk) {
        const u32x2 n = qk == 0 ? R.qn : R.kn; float v0 = bflo(n.x), v1 = bfhi(n.x), v2 = bflo(n.y), v3 = bfhi(n.y), r1 = bf2f(qk == 0 ? R.q1 : R.k1), r2 = bf2f(qk == 0 ? R.q2 : R.k2);
        const float rstd = 1.0f / sqrtf(grp16_sum(v0 * v0 + v1 * v1 + v2 * v2 + v3 * v3 + r1 * r1 + r2 * r2) * (1.0f / 96.0f) + RMS_EPS);
        const float (&g)[6] = qk == 0 ? gq : gk; const float sc = qk == 0 ? QSCALE96 : 1.0f;
        const float y1 = r1 * rstd * g[4], y2 = r2 * rstd * g[5];
        const float t1 = (y1 * R.c - y2 * R.s) * sc, t2 = (y2 * R.c + y1 * R.s) * sc;
        bf16* o = (qk == 0 ? mq : mk) + h * 96;
        u32x2 w; w.x = pk2(v0 * rstd * g[0] * sc, v1 * rstd * g[1] * sc); w.y = pk2(v2 * rstd * g[2] * sc, v3 * rstd * g[3] * sc);
        *(u32x2*)(o + 4 * j) = w; o[64 + j] = (bf16)f2bf(t1); o[80 + j] = (bf16)f2bf(t2);
    }
}
__device__ __forceinline__ void ph_post2(Frame& F, int l) {
    const bf16* ZS = (const bf16*)(F.ws + WS_ZS); bf16* MQ = (bf16*)(F.ws + WS_MQ); const bf16* MKV = (const bf16*)(F.ws + WS_MKV); bf16* MK = (bf16*)(F.ws + WS_MK);
    const float* rmc = (const float*)(F.ws + WS_RMC); const float* rms = (const float*)(F.ws + WS_RMS);
    const int lane = F.lane, jj = lane & 15;
    float gq[6], gk[6];
    { const float* a = F.in(I_MQN) + l * 96; const float* b = F.in(I_MKN) + l * 96;
#pragma unroll
      for (int i = 0; i < 4; ++i) { gq[i] = a[4 * jj + i]; gk[i] = b[4 * jj + i]; }
      gq[4] = a[64 + jj]; gq[5] = a[80 + jj]; gk[4] = b[64 + jj]; gk[5] = b[80 + jj]; }
    for (int row = F.gw; row < NROWS; row += 2 * F.NGW) {
        const int row2 = row + F.NGW; const bool has2 = row2 < NROWS; const size_t rb = has2 ? row2 : row;
        const int j = row % TPB; const bool lat = j >= CTXL; const int pos = lat ? j - CTXL : 0;
        const int j2 = (int)(rb % TPB); const bool lat2 = j2 >= CTXL; const int pos2 = lat2 ? j2 - CTXL : 0;
        P2Regs A, B;
        post2_load(ZS + (size_t)row * ZS_P, MQ + (size_t)row * 512, MKV + (size_t)row * 512, rmc + pos * 16, rms + pos * 16, lat, lane, A);
        if (has2) post2_load(ZS + rb * ZS_P, MQ + rb * 512, MKV + rb * 512, rmc + pos2 * 16, rms + pos2 * 16, lat2, lane, B);
        post2_finish(MQ + (size_t)row * 512, MK + (size_t)row * 384, lane, A, gq, gk);
        if (has2) post2_finish(MQ + rb * 512, MK + rb * 384, lane, B, gq, gk);
    }
}

template <int DQK>
__device__ __forceinline__ void attn_row_naive(const bf16* q, const bf16* Kb, int kp, const bf16* Vb, int vp, int n1, int lo2, int hi2, bool has_sink, float sink2, bf16* y, int lane) {
    float qf[DQK];
#pragma unroll
    for (int c = 0; c < DQK / 8; ++c) { const v4u w = *(const v4u*)(q + 8 * c);
        qf[8 * c + 0] = bflo(w.x); qf[8 * c + 1] = bfhi(w.x); qf[8 * c + 2] = bflo(w.y); qf[8 * c + 3] = bfhi(w.y); qf[8 * c + 4] = bflo(w.z); qf[8 * c + 5] = bfhi(w.z); qf[8 * c + 6] = bflo(w.w); qf[8 * c + 7] = bfhi(w.w); }
    float m = -INFINITY, l = 0.f; float acc[64];
#pragma unroll
    for (int d = 0; d < 64; ++d) acc[d] = 0.f;
    for (int seg = 0; seg < 2; ++seg) {
        const int k0 = seg == 0 ? 0 : lo2, k1 = seg == 0 ? n1 : hi2;
        for (int key = k0 + lane; key < k1; key += 64) {
            const bf16* kr = Kb + (size_t)key * kp; float s = 0.f;
#pragma unroll
            for (int c = 0; c < DQK / 8; ++c) { const v4u w = *(const v4u*)(kr + 8 * c);
                s += qf[8 * c + 0] * bflo(w.x) + qf[8 * c + 1] * bfhi(w.x) + qf[8 * c + 2] * bflo(w.y) + qf[8 * c + 3] * bfhi(w.y) + qf[8 * c + 4] * bflo(w.z) + qf[8 * c + 5] * bfhi(w.z) + qf[8 * c + 6] * bflo(w.w) + qf[8 * c + 7] * bfhi(w.w); }
            if (s > m) { const float f = exp2f(m - s); l *= f;
#pragma unroll
                for (int d = 0; d < 64; ++d) acc[d] *= f;
                m = s; }
            const float p = exp2f(s - m); l += p;
            const bf16* vr = Vb + (size_t)key * vp;
#pragma unroll
            for (int c = 0; c < 8; ++c) { const v4u w = *(const v4u*)(vr + 8 * c);
                acc[8 * c + 0] += p * bflo(w.x); acc[8 * c + 1] += p * bfhi(w.x); acc[8 * c + 2] += p * bflo(w.y); acc[8 * c + 3] += p * bfhi(w.y); acc[8 * c + 4] += p * bflo(w.z); acc[8 * c + 5] += p * bfhi(w.z); acc[8 * c + 6] += p * bflo(w.w); acc[8 * c + 7] += p * bfhi(w.w); }
        }
    }
    float M = wave_max(m); if (has_sink) M = fmaxf(M, sink2);
    const float f = (m == -INFINITY) ? 0.f : exp2f(m - M);
    float L = wave_sum(l * f); if (has_sink) L += exp2f(sink2 - M);
    float mine = 0.f;
#pragma unroll
    for (int d = 0; d < 64; ++d) { const float t = wave_sum(acc[d] * f); if (lane == d) mine = t; }
    y[lane] = (bf16)f2bf(mine / L * bf2f(y[lane]));
}
__device__ __forceinline__ void ph_attn_naive(Frame& F, int l) {
    const bf16* ZS = (const bf16*)(F.ws + WS_ZS); const bf16* MQ = (const bf16*)(F.ws + WS_MQ); const bf16* MKV = (const bf16*)(F.ws + WS_MKV); const bf16* MK = (const bf16*)(F.ws + WS_MK);
    bf16* Y = (bf16*)(F.ws + WS_G);
    const long nitems = (long)NROWS * 12;
    for (long it = F.gw; it < nitems; it += F.NGW) {
        const int hb = (int)(it % 12); const int row = (int)(it / 12);
        const int b = row / TPB, j = row % TPB; const bool lat = j >= CTXL;
        if (!lat && l == NLAYER - 1) continue;
        const size_t r0 = (size_t)b * TPB;
        const int br = hb >> 2, h = hb & 3;
        bf16* y = Y + (size_t)row * 1024 + br * 256 + h * 64;
        if (br == 0) {
            attn_row_naive<96>(MQ + (size_t)row * 512 + h * 96, MK + r0 * 384 + h * 96, 384, MKV + r0 * 512 + h * 128 + 64, 512, CTXL, CTXL, lat ? TPB : CTXL, false, 0.f, y, F.lane);
        } else if (br == 1) {
            const int t = j - CTXL; int lo = CTXL, hi = CTXL;
            if (lat) { lo = CTXL + (t - 128 < 0 ? 0 : t - 128); hi = CTXL + (t + 128 > SEQ - 1 ? SEQ - 1 : t + 128) + 1; }
            attn_row_naive<64>(ZS + (size_t)row * ZS_P + ZC_SQ + h * 64, ZS + r0 * ZS_P + ZC_SK + (h >> 1) * 64, ZS_P, ZS + r0 * ZS_P + ZC_SV + (h >> 1) * 64, ZS_P, CTXL, lo, hi, true, F.in(I_SINK)[l * 4 + h] * LOG2E, y, F.lane);
        } else {
            attn_row_naive<64>(ZS + (size_t)row * ZS_P + ZC_AQ + h * 64, ZS + r0 * ZS_P + ZC_AK + (h >> 1) * 64, ZS_P, ZS + r0 * ZS_P + ZC_AV + (h >> 1) * 64, ZS_P, CTXL, CTXL, lat ? TPB : CTXL, false, 0.f, y, F.lane);
        }
    }
}

__device__ __forceinline__ void ph_lru_conv(Frame& F, int l) {
    const bf16* ZS = (const bf16*)(F.ws + WS_ZS); float* U = (float*)(F.ws + WS_U);
    const float* cw = F.in(I_CONVW) + l * 4 * 256; const float* cb = F.in(I_CONVB) + l * 256;
    const int gt = F.vcu * NTHREADS + F.tid, ngt = F.G * NTHREADS;
    for (int idx = gt; idx < NROWS * 256; idx += ngt) {
        const int row = idx >> 8, c = idx & 255, b = row / TPB, j = row % TPB;
        int s0, len, jj; if (j < CTXL) { s0 = b * TPB; len = CTXL; jj = j; } else { s0 = b * TPB + CTXL; len = SEQ; jj = j - CTXL; }
        float acc = cb[c];
#pragma unroll
        for (int i = 0; i < 4; ++i) { const int t = jj + i - 2; if (t >= 0 && t < len) acc += cw[i * 256 + c] * bf2f(ZS[(size_t)(s0 + t) * ZS_P + ZC_LRU + c]); }
        U[idx] = acc;
    }
}
__device__ __forceinline__ void ph_lru_scan(Frame& F, int l, int dir) {
    const float* U = (const float*)(F.ws + WS_U); float* HF = (float*)(F.ws + WS_HF); bf16* Y = (bf16*)(F.ws + WS_G);
    const int g = blockIdx.x * NTHREADS + F.tid;
    if (g < NB * 256) {
    const int b = g >> 8, c = g & 255, k = c >> 6, jc = c & 63;
    const float* wr = F.in(I_LWR) + ((((size_t)l * 2 + dir) * 4 + k) * 64) * 64 + jc;
    const float* wi = F.in(I_LWI) + ((((size_t)l * 2 + dir) * 4 + k) * 64) * 64 + jc;
    float wrr[64], wii[64];
#pragma unroll
    for (int i = 0; i < 64; ++i) { wrr[i] = wr[i * 64]; wii[i] = wi[i * 64]; }
    const float br = F.in(I_LBR)[(l * 2 + dir) * 256 + c], bi = F.in(I_LBI)[(l * 2 + dir) * 256 + c];
    const float lam = F.in(I_LAM)[(l * 2 + dir) * 256 + c];
    const float sp = log1pf(expf(-lam));
    float h = 0.f;
    for (int s = 0; s < TPB; ++s) {
        const int j = dir == 0 ? s : (s < CTXL ? CTXL - 1 - s : TPB + CTXL - 1 - s);
        const size_t row = (size_t)b * TPB + j;
        const float* ub = U + row * 256 + k * 64;
        float rp = br, ip = bi;
#pragma unroll
        for (int i = 0; i < 64; ++i) { const float uv = ub[i]; rp += uv * wrr[i]; ip += uv * wii[i]; }
        const float r = 1.0f / (1.0f + expf(-rp)), ig = 1.0f / (1.0f + expf(-ip));
        const float la = -8.0f * r * sp; const float a = expf(la);
        const float bx = sqrtf(-expm1f(2.0f * la)) * (ig * ub[jc]);
        h = a * h + bx;
        if (dir == 0) HF[row * 256 + c] = h;
        else { bf16* y = Y + row * 1024 + 768 + c; *y = (bf16)f2bf((HF[row * 256 + c] + h) * bf2f(*y)); }
    }
    }
}
__device__ __forceinline__ void ph_mixsum_ctx(Frame& F) {
    const bf16* S = (const bf16*)(F.ws + WS_S); bf16* MIX = (bf16*)(F.ws + WS_H);
    const int gt = F.vcu * NTHREADS + F.tid, ngt = F.G * NTHREADS;
    for (int idx = gt; idx < NB * CTXL * 128; idx += ngt) {
        const int r = idx >> 7, c8 = (idx & 127) * 8; const size_t row = (size_t)(r >> 8) * TPB + (r & 255); float s[8] = {0.f, 0.f, 0.f, 0.f, 0.f, 0.f, 0.f, 0.f};
#pragma unroll
        for (int k = 0; k < 4; ++k) { const v4u w = *(const GAS v4u*)(S + row * 4096 + k * 1024 + c8);
            s[0] += bflo(w.x); s[1] += bfhi(w.x); s[2] += bflo(w.y); s[3] += bfhi(w.y); s[4] += bflo(w.z); s[5] += bfhi(w.z); s[6] += bflo(w.w); s[7] += bfhi(w.w); }
        v4u o; o.x = pk2(s[0], s[1]); o.y = pk2(s[2], s[3]); o.z = pk2(s[4], s[5]); o.w = pk2(s[6], s[7]);
        *(GAS v4u*)(MIX + row * 1024 + c8) = o;
    }
}
namespace att {
typedef short bf16x8 __attribute__((ext_vector_type(8)));
typedef short s16x4 __attribute__((ext_vector_type(4)));
typedef short v4i16_t __attribute__((ext_vector_type(4)));
typedef float f32x16 __attribute__((ext_vector_type(16)));
typedef unsigned u32x4 __attribute__((ext_vector_type(4)));
typedef __attribute__((address_space(3))) const char* lds_cptr;
typedef float f32x2_t __attribute__((ext_vector_type(2))); typedef __bf16 bf16x2_t __attribute__((ext_vector_type(2)));
__device__ __forceinline__ int crow(int r, int hi) { return (r & 3) + 8 * (r >> 2) + 4 * hi; }
__device__ __forceinline__ void glds16(const void* gsrc, unsigned lds_dst) { unsigned keep;
    asm volatile("s_mov_b32 %0, m0\n\ts_mov_b32 m0, %2\n\ts_nop 0\n\tglobal_load_lds_dwordx4 %1, off\n\ts_mov_b32 m0, %0" : "=&s"(keep) : "v"(gsrc), "s"(lds_dst) : "memory"); }
__device__ __forceinline__ unsigned cvtpk(float lo, float hi) { f32x2_t v = {lo, hi}; bf16x2_t b = __builtin_convertvector(v, bf16x2_t); return __builtin_bit_cast(unsigned, b); }
__device__ __forceinline__ s16x4 vtr(lds_cptr p) { return __builtin_bit_cast(s16x4, __builtin_amdgcn_ds_read_tr16_b64_v4i16((__attribute__((address_space(3))) v4i16_t*)p)); }
__device__ __forceinline__ float halfswap_max(float m) { auto rr = __builtin_amdgcn_permlane32_swap(__float_as_uint(m), __float_as_uint(m), false, false); return fmaxf(__uint_as_float(rr[0]), __uint_as_float(rr[1])); }
__device__ __forceinline__ float halfswap_sum(float m) { auto rr = __builtin_amdgcn_permlane32_swap(__float_as_uint(m), __float_as_uint(m), false, false); return __uint_as_float(rr[0]) + __uint_as_float(rr[1]); }

template <int DQK> struct Cfg {
    static constexpr int KCH = DQK / 8, KSLOT = KCH * 1024, NKI = (KCH + 7) / 8, NI = NKI + 1;
    static constexpr int LDS_K = 0, LDS_V = 3 * KSLOT, LDS_WS = LDS_V + 3 * 8192, LDS_OST = LDS_WS + 8 * 256, BYTES = LDS_OST + 8 * 4096;
};
#define ATT_WAIT_BAR(N) asm volatile("s_waitcnt vmcnt(" #N ") lgkmcnt(0)\n\ts_barrier" ::: "memory")

struct UnitDesc {
    const unsigned short* Q; int qp;
    const unsigned short* K; int kp;
    const unsigned short* V; int vp;
    unsigned short* Y;
    int NT;
    int lat_row0;
    int qpos0, spos0;
    int has_sink; float sink2;
};

template <int DQK, bool SWA>
__device__ __forceinline__ void attn_unit(LAS unsigned char* ldsb, const UnitDesc& U, const int tid) {
    using C = Cfg<DQK>;
    const int lane = tid & 63, r32 = lane & 31, hi = lane >> 5; const int wid = __builtin_amdgcn_readfirstlane(tid >> 6);
    const unsigned lds0 = (unsigned)(uintptr_t)ldsb;
    LAS float* wsf = (LAS float*)(ldsb + C::LDS_WS) + wid * 64;
    const int kp = U.kp, vp = U.vp;
    const int kc1 = (C::NKI == 2 && wid < 4) ? wid + 8 : wid;
    const unsigned short* ksrc0 = U.K + (size_t)lane * kp + wid * 8;
    const unsigned short* ksrc1 = U.K + (size_t)lane * kp + kc1 * 8;
    const unsigned short* vsrc = U.V + (size_t)(16 * (wid & 3) + (lane >> 2)) * vp + (wid >> 2) * 32 + (lane & 3) * 8;
    const unsigned kdst0 = lds0 + C::LDS_K + wid * 1024, kdst1 = lds0 + C::LDS_K + kc1 * 1024, vdst = lds0 + C::LDS_V + wid * 1024;
    const int NT = U.NT;
#define ATT_KROW(t) (SWA ? ((t) < 4 ? 64 * (t) : U.lat_row0 + 64 * ((t) - 4)) : 64 * (t))
#define ATT_DMA_K(t, slot) do { const size_t ro_ = (size_t)ATT_KROW(t); \
        glds16(ksrc0 + ro_ * kp, (unsigned)__builtin_amdgcn_readfirstlane(kdst0 + (slot) * C::KSLOT)); \
        if (C::NKI == 2) glds16(ksrc1 + ro_ * kp, (unsigned)__builtin_amdgcn_readfirstlane(kdst1 + (slot) * C::KSLOT)); } while (0)
#define ATT_DMA_V(t, slot) do { const size_t ro_ = (size_t)ATT_KROW(t); glds16(vsrc + ro_ * vp, (unsigned)__builtin_amdgcn_readfirstlane(vdst + (slot) * 8192)); } while (0)
#define ATT_KLOAD(kslot) do { if (!SWA) { const lds_cptr kb_ = (lds_cptr)(ldsb + C::LDS_K) + (kslot) * C::KSLOT + hi * 1024 + r32 * 16; \
        _Pragma("unroll") for (int d0 = 0; d0 < DQK / 16; ++d0) { kf[2 * d0] = *(const __attribute__((address_space(3))) bf16x8*)(kb_ + d0 * 2048); kf[2 * d0 + 1] = *(const __attribute__((address_space(3))) bf16x8*)(kb_ + d0 * 2048 + 512); } } } while (0)
#define ATT_QKM(P0, P1, CINIT, kslot) do { P0 = f32x16{}; P1 = f32x16{}; \
        const lds_cptr kq_ = (lds_cptr)(ldsb + C::LDS_K) + (kslot) * C::KSLOT + hi * 1024 + r32 * 16; \
        _Pragma("unroll") for (int d0 = 0; d0 < DQK / 16; ++d0) { \
            const bf16x8 b0_ = SWA ? *(const __attribute__((address_space(3))) bf16x8*)(kq_ + d0 * 2048) : kf[2 * d0]; const bf16x8 b1_ = SWA ? *(const __attribute__((address_space(3))) bf16x8*)(kq_ + d0 * 2048 + 512) : kf[2 * d0 + 1]; \
            P0 = __builtin_amdgcn_mfma_f32_32x32x16_bf16(b0_, qr[d0], P0, 0, 0, 0); P1 = __builtin_amdgcn_mfma_f32_32x32x16_bf16(b1_, qr[d0], P1, 0, 0, 0); } } while (0)
#define ATT_VLOAD(vslot) do { if (!SWA) { const lds_cptr vb_ = (lds_cptr)(ldsb + C::LDS_V) + (vslot) * 8192 + ((lane >> 4) & 1) * 32 + (lane & 3) * 8 + (4 * hi + ((lane & 15) >> 2)) * 64; \
        _Pragma("unroll") for (int i = 0; i < 8; ++i) { vl[i] = vtr(vb_ + (i >> 2) * 4096 + (i & 3) * 1024); vh[i] = vtr(vb_ + (i >> 2) * 4096 + (i & 3) * 1024 + 512); } } } while (0)
#define ATT_MX3(a, b, c) __builtin_fmaxf(__builtin_fmaxf((a), (b)), (c))
#define ATT_SMPV(P0, P1, N0, N1, HASNEXT, t, vslot) do { \
        if (SWA) { const bool mk_ = ((t) >= 4) && (U.qpos0 >= 0); const int sb_ = U.spos0 + 64 * ((t) - 4) + 4 * hi; \
            _Pragma("unroll") for (int r = 0; r < 16; ++r) { const int dd_ = qpos - (sb_ + (r & 3) + 8 * (r >> 2)); \
                P0[r] = (mk_ && (dd_ > 128 || dd_ < -128)) ? -INFINITY : P0[r]; P1[r] = (mk_ && (dd_ - 32 > 128 || dd_ - 32 < -128)) ? -INFINITY : P1[r]; } } \
        float ls_ = 0.f; \
        _Pragma("unroll") for (int r = 0; r < 16; ++r) { P0[r] = __builtin_amdgcn_exp2f(P0[r]); P1[r] = __builtin_amdgcn_exp2f(P1[r]); ls_ += P0[r] + P1[r]; } \
        l += ls_; \
        if (!SWA && DQK != 64) { __builtin_amdgcn_sched_barrier(0); ATT_VLOAD(vslot); } \
        u32x4 pw_[4]; \
        pw_[0] = (u32x4){cvtpk(P0[0], P0[1]), cvtpk(P0[2], P0[3]), cvtpk(P0[4], P0[5]), cvtpk(P0[6], P0[7])}; \
        pw_[1] = (u32x4){cvtpk(P0[8], P0[9]), cvtpk(P0[10], P0[11]), cvtpk(P0[12], P0[13]), cvtpk(P0[14], P0[15])}; \
        pw_[2] = (u32x4){cvtpk(P1[0], P1[1]), cvtpk(P1[2], P1[3]), cvtpk(P1[4], P1[5]), cvtpk(P1[6], P1[7])}; \
        pw_[3] = (u32x4){cvtpk(P1[8], P1[9]), cvtpk(P1[10], P1[11]), cvtpk(P1[12], P1[13]), cvtpk(P1[14], P1[15])}; \
        const lds_cptr vq_ = (lds_cptr)(ldsb + C::LDS_V) + (vslot) * 8192 + ((lane >> 4) & 1) * 32 + (lane & 3) * 8 + (4 * hi + ((lane & 15) >> 2)) * 64; \
        _Pragma("unroll") for (int d0 = 0; d0 < 2; ++d0) \
            _Pragma("unroll") for (int ks = 0; ks < 4; ++ks) { \
                const s16x4 lo_ = SWA ? vtr(vq_ + d0 * 4096 + ks * 1024) : vl[4 * d0 + ks], hh_ = SWA ? vtr(vq_ + d0 * 4096 + ks * 1024 + 512) : vh[4 * d0 + ks]; \
                const bf16x8 vf_ = (bf16x8){lo_[0], lo_[1], lo_[2], lo_[3], hh_[0], hh_[1], hh_[2], hh_[3]}; \
                o[d0] = __builtin_amdgcn_mfma_f32_32x32x16_bf16(__builtin_bit_cast(bf16x8, pw_[ks]), vf_, o[d0], 0, 0, 0); } } while (0)
#define ATT_SKIP(j) (SWA && (j) >= 4 && U.qpos0 >= 0 && ((U.spos0 + 64 * ((j) - 4) > U.qpos0 + 32 * wid + 31 + 128) || (U.spos0 + 64 * ((j) - 4) + 63 < U.qpos0 + 32 * wid - 128)))
#define ATT_STEP(C0, C1, N0, N1, t) do { \
        const int k3_ = (ks1 == 0) ? 2 : ks1 - 1, v2_ = (vs0 == 0) ? 2 : vs0 - 1; \
        if ((t) + 3 < NT) ATT_DMA_K((t) + 3, k3_); \
        if ((t) + 2 < NT) ATT_DMA_V((t) + 2, v2_); \
        ATT_KLOAD(ks1); \
        if (!SWA) __builtin_amdgcn_sched_barrier(0);        \
        if (!SWA || !ATT_SKIP((t) + 1)) ATT_QKM(N0, N1, -m, ks1); \
        if (DQK == 64) ATT_VLOAD(vs0);        \
        if (!SWA) __builtin_amdgcn_sched_barrier(0); \
        if (!SWA || !ATT_SKIP(t)) ATT_SMPV(C0, C1, N0, N1, true, t, vs0); \
        if ((t) + 3 < NT) { if (C::NI == 2) ATT_WAIT_BAR(2); else ATT_WAIT_BAR(3); } else ATT_WAIT_BAR(0); \
        ks1 = (ks1 == 2) ? 0 : ks1 + 1; vs0 = (vs0 == 2) ? 0 : vs0 + 1; } while (0)
    ATT_DMA_K(0, 0);
    ATT_DMA_K(1, 1); ATT_DMA_V(0, 0);
    ATT_DMA_K(2, 2); ATT_DMA_V(1, 1);
    bf16x8 qr[DQK / 16];
    { const unsigned short* qw = U.Q + (size_t)(wid * 32 + r32) * U.qp + hi * 8;
#pragma unroll
      for (int d0 = 0; d0 < DQK / 16; ++d0) qr[d0] = *(const bf16x8*)(qw + d0 * 16); }
    const float m = 0.f; float l = 0.f;
    f32x16 o[2]; o[0] = f32x16{}; o[1] = f32x16{};
    const int qpos = U.qpos0 + wid * 32 + r32;
    f32x16 pa0, pa1, pb0, pb1;
    bf16x8 kf[DQK / 8]; s16x4 vl[8], vh[8];
    if (C::NI == 2) ATT_WAIT_BAR(4); else ATT_WAIT_BAR(6);
    ATT_KLOAD(0); ATT_QKM(pa0, pa1, 0.f, 0);
    if (C::NI == 2) ATT_WAIT_BAR(2); else ATT_WAIT_BAR(3);
    int ks1 = 1, vs0 = 0;
    int t = 0;
    if (SWA) { for (; t + 1 < NT; ++t) { ATT_STEP(pa0, pa1, pb0, pb1, t); pa0 = pb0; pa1 = pb1; } if (!ATT_SKIP(NT - 1)) ATT_SMPV(pa0, pa1, pa0, pa1, false, NT - 1, vs0); }
    else {
    for (; t + 2 < NT; t += 2) { ATT_STEP(pa0, pa1, pb0, pb1, t); ATT_STEP(pb0, pb1, pa0, pa1, t + 1); }
    if (t + 1 < NT) { ATT_STEP(pa0, pa1, pb0, pb1, t); if (DQK == 64) ATT_VLOAD(vs0); ATT_SMPV(pb0, pb1, pb0, pb1, false, NT - 1, vs0); }
    else { if (DQK == 64) ATT_VLOAD(vs0); ATT_SMPV(pa0, pa1, pa0, pa1, false, NT - 1, vs0); }
    }
    l = halfswap_sum(l);
    if (U.has_sink) l += __builtin_amdgcn_exp2f(U.sink2 - m);
    if (hi == 0) wsf[32 + r32] = l;
    asm volatile("s_waitcnt lgkmcnt(0)" ::: "memory");
    { LAS unsigned short* stg = (LAS unsigned short*)(ldsb + C::LDS_OST) + wid * 2048;
#pragma unroll
      for (int r = 0; r < 16; ++r) { const int orow = crow(r, hi); const float rl = __builtin_amdgcn_rcpf(wsf[32 + orow]);
          stg[orow * 64 + r32] = (unsigned short)f2bf(o[0][r] * rl); stg[orow * 64 + 32 + r32] = (unsigned short)f2bf(o[1][r] * rl); }
      asm volatile("s_waitcnt lgkmcnt(0)" ::: "memory");
      unsigned short* yw = U.Y + (size_t)(wid * 32) * 1024;
#pragma unroll
      for (int i = 0; i < 4; ++i) { const int row = i * 8 + (lane >> 3), ch = lane & 7;
          const u32x4 ov = *(const LAS u32x4*)(stg + row * 64 + ch * 8);
          u32x4* gp = (u32x4*)(yw + (size_t)row * 1024 + ch * 8); const u32x4 g = *gp;
          u32x4 w; w.x = pk2(bflo(ov.x) * bflo(g.x), bfhi(ov.x) * bfhi(g.x)); w.y = pk2(bflo(ov.y) * bflo(g.y), bfhi(ov.y) * bfhi(g.y));
          w.z = pk2(bflo(ov.z) * bflo(g.z), bfhi(ov.z) * bfhi(g.z)); w.w = pk2(bflo(ov.w) * bflo(g.w), bfhi(ov.w) * bfhi(g.w));
          *gp = w; } }
    asm volatile("s_waitcnt vmcnt(0) lgkmcnt(0)\n\ts_barrier" ::: "memory");
#undef ATT_KROW
#undef ATT_DMA_K
#undef ATT_DMA_V
#undef ATT_KLOAD
#undef ATT_QKM
#undef ATT_VLOAD
#undef ATT_STEP
#undef ATT_SKIP
#undef ATT_SMPV
#undef ATT_MX3
}
}

__device__ __forceinline__ void ph_attn(Frame& F, int l) {
    unsigned short* ZS = (unsigned short*)(F.ws + WS_ZS); unsigned short* MQ = (unsigned short*)(F.ws + WS_MQ); unsigned short* MKV = (unsigned short*)(F.ws + WS_MKV); unsigned short* MK = (unsigned short*)(F.ws + WS_MK);
    unsigned short* Y = (unsigned short*)(F.ws + WS_G);
    LAS unsigned char* lds = F.lds + RING_OFF;
    const int u = F.vcu;
    const bool ctxq = (l == 0);
    for (int uu = u; uu < 256; uu += F.G) { const int bh = uu >> 4, qb = uu & 15, b = bh >> 2, h = bh & 3; const size_t r0 = (size_t)b * TPB, rq = r0 + CTXL + qb * 256;
        att::UnitDesc U{MQ + rq * 512 + h * 96, 512, MK + r0 * 384 + h * 96, 384, MKV + r0 * 512 + h * 128 + 64, 512, Y + rq * 1024 + h * 64, TPB / 64, 0, -1, 0, 0, 0.f};
        att::attn_unit<96, false>(lds, U, F.tid); }
    for (int uu = u; uu < 256; uu += F.G) { const int qb = uu & 15, g = (uu >> 4) & 1, kvh = (uu >> 5) & 1, b = uu >> 6, qh = kvh * 2 + g; const size_t r0 = (size_t)b * TPB, rq = r0 + CTXL + qb * 256;
        att::UnitDesc U{ZS + rq * ZS_P + ZC_AQ + qh * 64, ZS_P, ZS + r0 * ZS_P + ZC_AK + kvh * 64, ZS_P, ZS + r0 * ZS_P + ZC_AV + kvh * 64, ZS_P, Y + rq * 1024 + 512 + qh * 64, TPB / 64, 0, -1, 0, 0, 0.f};
        att::attn_unit<64, false>(lds, U, F.tid); }
    for (int uu = u; uu < 256; uu += F.G) { const int qb = uu & 15, g = (uu >> 4) & 1, kvh = (uu >> 5) & 1, b = uu >> 6, qh = kvh * 2 + g; const size_t r0 = (size_t)b * TPB, rq = r0 + CTXL + qb * 256;
        const int q0 = qb * 256, s0 = (q0 - 128 < 0) ? 0 : q0 - 128, s1 = (q0 + 384 > SEQ) ? SEQ : q0 + 384;
        att::UnitDesc U{ZS + rq * ZS_P + ZC_SQ + qh * 64, ZS_P, ZS + r0 * ZS_P + ZC_SK + kvh * 64, ZS_P, ZS + r0 * ZS_P + ZC_SV + kvh * 64, ZS_P, Y + rq * 1024 + 256 + qh * 64, 4 + (s1 - s0) / 64, CTXL + s0, q0, s0, 1, F.in(I_SINK)[l * 4 + qh] * LOG2E};
        att::attn_unit<64, true>(lds, U, F.tid); }
    if (ctxq) for (int uu = u; uu < 48; uu += F.G) { const int br = uu >> 4, b = (uu >> 2) & 3, h = uu & 3; const size_t r0 = (size_t)b * TPB;
        if (br == 0) { att::UnitDesc U{MQ + r0 * 512 + h * 96, 512, MK + r0 * 384 + h * 96, 384, MKV + r0 * 512 + h * 128 + 64, 512, Y + r0 * 1024 + h * 64, 4, 0, -1, 0, 0, 0.f};
            att::attn_unit<96, false>(lds, U, F.tid); }
        else if (br == 1) { att::UnitDesc U{ZS + r0 * ZS_P + ZC_SQ + h * 64, ZS_P, ZS + r0 * ZS_P + ZC_SK + (h >> 1) * 64, ZS_P, ZS + r0 * ZS_P + ZC_SV + (h >> 1) * 64, ZS_P, Y + r0 * 1024 + 256 + h * 64, 4, CTXL, -1, 0, 1, F.in(I_SINK)[l * 4 + h] * LOG2E};
            att::attn_unit<64, true>(lds, U, F.tid); }
        else { att::UnitDesc U{ZS + r0 * ZS_P + ZC_AQ + h * 64, ZS_P, ZS + r0 * ZS_P + ZC_AK + (h >> 1) * 64, ZS_P, ZS + r0 * ZS_P + ZC_AV + (h >> 1) * 64, ZS_P, Y + r0 * 1024 + 512 + h * 64, 4, 0, -1, 0, 0, 0.f};
            att::attn_unit<64, false>(lds, U, F.tid); } }
}
constexpr size_t WS_SUM = 253 * MiB;
constexpr size_t WS_HL = WS_U, WS_CP = WS_HF;
constexpr int NCHUNK = TPB / 64;
__device__ __forceinline__ float swap_lo(float x) { auto rr = __builtin_amdgcn_permlane32_swap(__float_as_uint(x), __float_as_uint(x), false, false); return __uint_as_float(rr[0]); }
__device__ __forceinline__ float swap_hi(float x) { auto rr = __builtin_amdgcn_permlane32_swap(__float_as_uint(x), __float_as_uint(x), false, false); return __uint_as_float(rr[1]); }
__device__ __forceinline__ void ph_lru1(Frame& F, int l) {
    typedef short bf16x8 __attribute__((ext_vector_type(8))); typedef float f32x16 __attribute__((ext_vector_type(16)));
    const unsigned short* ZS = (const unsigned short*)(F.ws + WS_ZS); unsigned short* HL = (unsigned short*)(F.ws + WS_HL); unsigned short* CP = (unsigned short*)(F.ws + WS_CP);
    f32x2v* SUM = (f32x2v*)(F.ws + WS_SUM);
    constexpr int UP = 264;
    LAS unsigned short* ul = (LAS unsigned short*)(F.lds + RING_OFF);
    const float* cw = F.in(I_CONVW) + l * 4 * 256; const float* cb = F.in(I_CONVB) + l * 256;
    const int tid = F.tid, lane = tid & 63, r32 = lane & 31, hi = lane >> 5, k = F.wave & 3, d = F.wave >> 2;
    const int nfull = (NB * NCHUNK < F.G) ? NB * NCHUNK : F.G, nhalf = 2 * (NB * NCHUNK - nfull);
    for (int wi = F.vcu; wi < nfull + nhalf; wi += F.G) {
        const int unit = (wi < nfull) ? wi : nfull + ((wi - nfull) >> 1);
        const int tn_lo = (wi < nfull) ? 0 : ((wi - nfull) & 1), tn_hi = (wi < nfull) ? 2 : tn_lo + 1;
        const int b = unit / NCHUNK, ci = unit % NCHUNK;
        int s0row, len, t0; if (ci < 4) { s0row = b * TPB; len = CTXL; t0 = ci * 64; } else { s0row = b * TPB + CTXL; len = SEQ; t0 = (ci - 4) * 64; }
        { const int cc = tid & 255, hh = tid >> 8; float zv[35];
#pragma unroll
          for (int i = 0; i < 35; ++i) { const int tt = t0 + hh * 32 + i - 2; const int tc = tt < 0 ? 0 : (tt >= len ? len - 1 : tt);
              const float v = bf2f(ZS[(size_t)(s0row + tc) * ZS_P + ZC_LRU + cc]); zv[i] = (tt >= 0 && tt < len) ? v : 0.f; }
          const float w0 = cw[cc], w1 = cw[256 + cc], w2 = cw[512 + cc], w3 = cw[768 + cc], bb = cb[cc];
#pragma unroll
          for (int t = 0; t < 32; ++t) ul[(hh * 32 + t) * UP + cc] = (unsigned short)f2bf(bb + w0 * zv[t] + w1 * zv[t + 1] + w2 * zv[t + 2] + w3 * zv[t + 3]); }
        __syncthreads();
#pragma unroll 1
        for (int tn = tn_lo; tn < tn_hi; ++tn) {
            const int c = k * 64 + 32 * tn + r32;
            bf16x8 wf[2][4];
            const float brv = F.in(I_LBR)[(l * 2 + d) * 256 + c], biv = F.in(I_LBI)[(l * 2 + d) * 256 + c], spv = ((const float*)(F.ws + WS_SP))[(l * 2 + d) * 256 + c];
#pragma unroll
            for (int gate = 0; gate < 2; ++gate)
#pragma unroll
                for (int ks = 0; ks < 4; ++ks) { const float* src = (const float*)(F.ws + WS_LWT) + ((((size_t)l * 2 + d) * 2 + gate) * 256 + c) * 64 + 16 * ks + 8 * hi;
                    const f32x4 a = *(const f32x4*)src, b2 = *(const f32x4*)(src + 4);
                    v4u w; w.x = pk2(a.x, a.y); w.y = pk2(a.z, a.w); w.z = pk2(b2.x, b2.y); w.w = pk2(b2.z, b2.w); wf[gate][ks] = __builtin_bit_cast(bf16x8, w); }
            f32x16 A[2], X[2];
            A[0] = f32x16{}; A[1] = f32x16{}; X[0] = f32x16{}; X[1] = f32x16{};
#pragma unroll
            for (int tm = 0; tm < 2; ++tm)
#pragma unroll
                for (int ks = 0; ks < 4; ++ks) { const bf16x8 af = *(const LAS bf16x8*)(ul + (32 * tm + r32) * UP + k * 64 + 16 * ks + 8 * hi);
                    A[tm] = __builtin_amdgcn_mfma_f32_32x32x16_bf16(af, wf[0][ks], A[tm], 0, 0, 0); X[tm] = __builtin_amdgcn_mfma_f32_32x32x16_bf16(af, wf[1][ks], X[tm], 0, 0, 0); }
#pragma unroll
            for (int tm = 0; tm < 2; ++tm)
#pragma unroll
                for (int r = 0; r < 16; ++r) { const int tok = 32 * tm + (r & 3) + 8 * (r >> 2) + 4 * hi; const float uu = bf2f(ul[tok * UP + c]);
                    const float rr = sigmoid_f(A[tm][r] + brv), ii = sigmoid_f(X[tm][r] + biv);
                    const float a = __builtin_amdgcn_exp2f(-rr * spv); A[tm][r] = a; X[tm][r] = __builtin_amdgcn_sqrtf(1.0f - a * a) * (ii * uu);
                    if ((r & 3) == 3) asm volatile("" ::: "memory"); }
#pragma unroll
            for (int tm = 0; tm < 2; ++tm)
#pragma unroll
                for (int rg = 0; rg < 4; ++rg) { const int r0 = 4 * rg;
                    if (d == 0) {
#pragma unroll
                        for (int e2 = 1; e2 < 4; ++e2) { X[tm][r0 + e2] = A[tm][r0 + e2] * X[tm][r0 + e2 - 1] + X[tm][r0 + e2]; A[tm][r0 + e2] = A[tm][r0 + e2] * A[tm][r0 + e2 - 1]; } }
                    else {
#pragma unroll
                        for (int e2 = 2; e2 >= 0; --e2) { X[tm][r0 + e2] = A[tm][r0 + e2] * X[tm][r0 + e2 + 1] + X[tm][r0 + e2]; A[tm][r0 + e2] = A[tm][r0 + e2] * A[tm][r0 + e2 + 1]; } } }
            float enH[8], enP[8]; float EH = 0.f, EP = 1.f;
            if (d == 0) {
#pragma unroll
                for (int q = 0; q < 8; ++q) { const int tm = q >> 2, re = 4 * (q & 3) + 3; const float ce = A[tm][re], he = X[tm][re];
                    const float aH = swap_lo(ce * EH + he), aP = swap_lo(EP * ce);
                    const float E1H = hi ? aH : EH, E1P = hi ? aP : EP;
                    enH[q] = E1H; enP[q] = E1P;
                    EH = swap_hi(ce * E1H + he); EP = swap_hi(E1P * ce); }
            } else {
#pragma unroll
                for (int q = 7; q >= 0; --q) { const int tm = q >> 2, re = 4 * (q & 3); const float ce = A[tm][re], he = X[tm][re];
                    const float aH = swap_hi(ce * EH + he), aP = swap_hi(EP * ce);
                    const float E1H = hi ? EH : aH, E1P = hi ? EP : aP;
                    enH[q] = E1H; enP[q] = E1P;
                    EH = swap_lo(ce * E1H + he); EP = swap_lo(E1P * ce); }
            }
            { const unsigned ob = (unsigned)((((s0row + t0 + 4 * hi) * 2 + d) * 256 + c) * 2);
#pragma unroll
              for (int tm = 0; tm < 2; ++tm)
#pragma unroll
                for (int rg = 0; rg < 4; ++rg) { const int q = 4 * tm + rg;
#pragma unroll
                    for (int e2 = 0; e2 < 4; ++e2) { const int r = 4 * rg + e2; const unsigned o = ob + (unsigned)(32 * tm + 8 * rg + e2) * 1024u;
                        *(unsigned short*)((char*)HL + o) = (unsigned short)f2bf(X[tm][r] + A[tm][r] * enH[q]); *(unsigned short*)((char*)CP + o) = (unsigned short)f2bf(A[tm][r] * enP[q]); }
                    asm volatile("" ::: "memory"); } }
            if (hi == 0) SUM[((size_t)(b * NCHUNK + ci) * 2 + d) * 256 + c] = (f32x2v){EP, EH};
        }
        __syncthreads();
    }
}
constexpr size_t WS_CARRY = 255 * MiB;
__device__ __forceinline__ void ph_lru_carry(Frame& F) {
    if (F.vcu < 4) {
        const int g = F.vcu * NTHREADS + F.tid, b = g >> 9, d = (g >> 8) & 1, c = g & 255;
        const f32x2v* sb = (const f32x2v*)(F.ws + WS_SUM) + ((size_t)b * NCHUNK * 2 + d) * 256 + c;
        float* cr = (float*)(F.ws + WS_CARRY) + ((size_t)b * NCHUNK * 2 + d) * 256 + c;
        float h = 0.f;
#pragma unroll 1
        for (int p0 = 0; p0 < NCHUNK; p0 += 17) {
            f32x2v s[17];
#pragma unroll
            for (int i = 0; i < 17; ++i) { const int p = p0 + i, j = (d == 0) ? p : (p < 4 ? 3 - p : NCHUNK + 3 - p); s[i] = sb[(size_t)j * 512]; }
#pragma unroll
            for (int i = 0; i < 17; ++i) { const int p = p0 + i, j = (d == 0) ? p : (p < 4 ? 3 - p : NCHUNK + 3 - p); cr[(size_t)j * 512] = h; h = s[i].x * h + s[i].y; }
        }
    }
}
__device__ __forceinline__ void ph_lru2(Frame& F, int l) {
    const unsigned short* HL = (const unsigned short*)(F.ws + WS_HL); const unsigned short* CP = (const unsigned short*)(F.ws + WS_CP);
    const float* CARRY = (const float*)(F.ws + WS_CARRY); unsigned short* Y = (unsigned short*)(F.ws + WS_G);
    const int tid = F.tid, cg = tid & 31, tq = tid >> 5; const bool last = (l == NLAYER - 1);
    for (int unit = F.vcu; unit < NB * NCHUNK; unit += F.G) {
        const int b = unit / NCHUNK, ci = unit % NCHUNK;
        if (last && ci < 4) continue;
        const float* cp0 = CARRY + ((size_t)(b * NCHUNK + ci) * 2) * 256 + cg * 8;
        const f32x4 cfa = *(const f32x4*)cp0, cfb = *(const f32x4*)(cp0 + 4), cba = *(const f32x4*)(cp0 + 256), cbb = *(const f32x4*)(cp0 + 260);
        const float cf[8] = {cfa.x, cfa.y, cfa.z, cfa.w, cfb.x, cfb.y, cfb.z, cfb.w}, cbk[8] = {cba.x, cba.y, cba.z, cba.w, cbb.x, cbb.y, cbb.z, cbb.w};
        v4u hf[4], pf[4], hb[4], pb[4], gg[4];
#pragma unroll
        for (int i = 0; i < 4; ++i) { const size_t row = (size_t)b * TPB + ci * 64 + tq + 16 * i; const size_t o = (row * 2) * 256 + cg * 8;
            hf[i] = *(const v4u*)(HL + o); pf[i] = *(const v4u*)(CP + o); hb[i] = *(const v4u*)(HL + o + 256); pb[i] = *(const v4u*)(CP + o + 256); gg[i] = *(const v4u*)(Y + row * 1024 + 768 + cg * 8); }
#pragma unroll
        for (int i = 0; i < 4; ++i) { const size_t row = (size_t)b * TPB + ci * 64 + tq + 16 * i;
            unsigned w[4];
#pragma unroll
            for (int e = 0; e < 4; ++e) { const unsigned a = hf[i][e], p = pf[i][e], a2 = hb[i][e], p2 = pb[i][e], g = gg[i][e];
                const float v0 = (bflo(a) + bflo(p) * cf[2 * e] + bflo(a2) + bflo(p2) * cbk[2 * e]) * bflo(g);
                const float v1 = (bfhi(a) + bfhi(p) * cf[2 * e + 1] + bfhi(a2) + bfhi(p2) * cbk[2 * e + 1]) * bfhi(g);
                w[e] = pk2(v0, v1); }
            *(v4u*)(Y + row * 1024 + 768 + cg * 8) = (v4u){w[0], w[1], w[2], w[3]}; }
    }
}
namespace pgx {
typedef short bf16x8 __attribute__((ext_vector_type(8)));
typedef float f32x4 __attribute__((ext_vector_type(4)));
typedef unsigned u32x4 __attribute__((ext_vector_type(4)));
typedef unsigned u32x2 __attribute__((ext_vector_type(2)));
constexpr int OPB = 16384;
template <int VAR> __device__ __forceinline__ void pgx_unit(LAS unsigned char* lds, const unsigned short* Y, const unsigned short* Wb, const unsigned short* S, unsigned short* MIX, int row0, int n0, int tid) {
    const int lane = tid & 63, wid = __builtin_amdgcn_readfirstlane(tid >> 6), wm = wid & 3, wn = wid >> 2, fr = lane & 15, fq = lane >> 4;
    const int sr0 = tid >> 3, sk = (tid & 7) * 8;
    const unsigned short* ysrc = Y + (size_t)(row0 + sr0) * 1024 + sk;
    const unsigned short* wsrc = Wb + (size_t)(n0 + sr0) * 256 + sk;
    const int ldst = (tid & 7) * 2048 + (sr0 & ~15) * 16 + (((sr0 & 15) ^ (tid & 7)) << 4);
    const int wrow = (sr0 & ~63) | (((sr0 >> 2) & 3) << 4) | (((sr0 >> 4) & 3) << 2) | (sr0 & 3);
    const int ldstw = (tid & 7) * 2048 + (wrow & ~15) * 16 + (((wrow & 15) ^ (tid & 7)) << 4);
    f32x4 acc[2][4], mix[2][4];
#pragma unroll
    for (int a = 0; a < 2; ++a)
#pragma unroll
        for (int b = 0; b < 4; ++b) { acc[a][b] = (f32x4){0.f, 0.f, 0.f, 0.f}; mix[a][b] = (f32x4){0.f, 0.f, 0.f, 0.f}; }
    u32x4 st[4][4];
    const unsigned short* yA = ysrc; const unsigned short* yB = ysrc + 64 * 1024;
    const unsigned short* wA = wsrc; const unsigned short* wB = wsrc + 64 * 256;
    const unsigned short* sp0 = S + (size_t)(row0 + 32 * wm + fr) * 4096 + n0 + 64 * wn + 16 * fq; const unsigned short* sp1 = sp0 + (size_t)16 * 4096;
#define PGX_LOADQ(set_, yo_, wp0_, wp1_, wo_) do { if (VAR == 2) { st[set_][0] = *(const u32x4*)(ysrc); st[set_][1] = *(const u32x4*)(ysrc + 64 * 1024); st[set_][2] = *(const u32x4*)(wsrc); st[set_][3] = *(const u32x4*)(wsrc + 64 * 256); } else if (VAR == 4) { st[set_][0] = st[set_][1] = st[set_][2] = st[set_][3] = (u32x4){1u,2u,3u,4u}; asm volatile("" : "+v"(st[set_][0]), "+v"(st[set_][1]), "+v"(st[set_][2]), "+v"(st[set_][3])); } else { st[set_][0] = *(const u32x4*)(yA + (yo_)); st[set_][1] = *(const u32x4*)(yB + (yo_)); st[set_][2] = *(const u32x4*)((wp0_) + (wo_)); st[set_][3] = *(const u32x4*)((wp1_) + (wo_)); } } while (0)
#define PGX_STORE(buf_, set_) do { LAS unsigned char* b_ = lds + (buf_) * 2 * OPB + ldst; \
        *(LAS u32x4*)b_ = st[set_][0]; *(LAS u32x4*)(b_ + 1024) = st[set_][1]; *(LAS u32x4*)(b_ - ldst + OPB + ldstw) = st[set_][2]; *(LAS u32x4*)(b_ - ldst + OPB + ldstw + 1024) = st[set_][3]; } while (0)
    u32x4 sga[2][2], sgb[2][2];
#define PGX_SLOAD(dst_, off_) do { if (VAR == 1 || VAR == 4) { dst_[0][0] = dst_[0][1] = dst_[1][0] = dst_[1][1] = (u32x4){0x3f803f80u, 0x3f803f80u, 0x3f803f80u, 0x3f803f80u}; } \
        else { dst_[0][0] = *(const u32x4*)(sp0 + (off_)); dst_[0][1] = *(const u32x4*)(sp0 + (off_) + 8); dst_[1][0] = *(const u32x4*)(sp1 + (off_)); dst_[1][1] = *(const u32x4*)(sp1 + (off_) + 8); } } while (0)
    PGX_SLOAD(sga, 0);
    PGX_LOADQ(0, 0, wA, wB, 0); PGX_LOADQ(1, 64, wA, wB, 64); PGX_LOADQ(2, 128, wA, wB, 128);
    PGX_STORE(0, 0);
    __syncthreads();
#define PGX_COMPUTE(h_) do { const LAS unsigned char* yb = lds + ((h_) & 1) * 2 * OPB + 32 * wm * 16; const LAS unsigned char* wb = lds + ((h_) & 1) * 2 * OPB + OPB + 64 * wn * 16; \
          _Pragma("unroll") for (int ks = 0; ks < 2; ++ks) { const int fo_ = (4 * ks + fq) * 2048 + ((fr ^ (4 * ks + fq)) << 4); \
              bf16x8 yf[2], wf[4]; \
              _Pragma("unroll") for (int tt = 0; tt < 2; ++tt) yf[tt] = *(const LAS bf16x8*)(yb + fo_ + tt * 256); \
              _Pragma("unroll") for (int nt = 0; nt < 4; ++nt) wf[nt] = *(const LAS bf16x8*)(wb + fo_ + nt * 256); \
              _Pragma("unroll") for (int tt = 0; tt < 2; ++tt) \
                  _Pragma("unroll") for (int nt = 0; nt < 4; ++nt) acc[tt][nt] = __builtin_amdgcn_mfma_f32_16x16x32_bf16(wf[nt], yf[tt], acc[tt][nt], 0, 0, 0); } } while (0)
#pragma unroll 1
    for (int kk = 0; kk < 4; ++kk) {
        const bool more = kk < 3;
        const unsigned short* wnA = more ? wA + (size_t)1024 * 256 : wsrc; const unsigned short* wnB = more ? wB + (size_t)1024 * 256 : wsrc + 64 * 256;
        const int yo = more ? 256 : -768;
        PGX_SLOAD(sgb, more ? 1024 : 0);
        PGX_LOADQ(3, 192, wA, wB, 192); PGX_COMPUTE(0); PGX_STORE(1, 1); __syncthreads();
        PGX_LOADQ(0, yo, wnA, wnB, 0); PGX_COMPUTE(1); PGX_STORE(0, 2); __syncthreads();
        PGX_LOADQ(1, yo + 64, wnA, wnB, 64); PGX_COMPUTE(2); PGX_STORE(1, 3); __syncthreads();
        PGX_LOADQ(2, yo + 128, wnA, wnB, 128); PGX_COMPUTE(3);
#pragma unroll
        for (int tt = 0; tt < 2; ++tt)
#pragma unroll
            for (int nt = 0; nt < 4; ++nt) { const u32x4 gv = sga[tt][nt >> 1]; const unsigned g0 = (nt & 1) ? gv.z : gv.x, g1 = (nt & 1) ? gv.w : gv.y; const f32x4 a = acc[tt][nt];
                mix[tt][nt] += (f32x4){a[0] * bflo(g0), a[1] * bfhi(g0), a[2] * bflo(g1), a[3] * bfhi(g1)}; acc[tt][nt] = (f32x4){0.f, 0.f, 0.f, 0.f}; }
#pragma unroll
        for (int tt = 0; tt < 2; ++tt) { sga[tt][0] = sgb[tt][0]; sga[tt][1] = sgb[tt][1]; }
        if (more) PGX_STORE(0, 0);
        __syncthreads();
        yA += 256; yB += 256; wA = wnA; wB = wnB; sp0 += 1024; sp1 += 1024;
    }
#pragma unroll
    for (int tt = 0; tt < 2; ++tt) { unsigned short* mp = MIX + (size_t)(row0 + 32 * wm + 16 * tt + fr) * 1024 + n0 + 64 * wn + 16 * fq;
        u32x4 w0, w1; w0.x = pk2(mix[tt][0][0], mix[tt][0][1]); w0.y = pk2(mix[tt][0][2], mix[tt][0][3]); w0.z = pk2(mix[tt][1][0], mix[tt][1][1]); w0.w = pk2(mix[tt][1][2], mix[tt][1][3]);
        w1.x = pk2(mix[tt][2][0], mix[tt][2][1]); w1.y = pk2(mix[tt][2][2], mix[tt][2][3]); w1.z = pk2(mix[tt][3][0], mix[tt][3][1]); w1.w = pk2(mix[tt][3][2], mix[tt][3][3]);
        *(u32x4*)mp = w0; *(u32x4*)(mp + 8) = w1; }
#undef PGX_LOADQ
#undef PGX_SLOAD
#undef PGX_STORE
#undef PGX_COMPUTE
}
}
template <int VAR> __device__ __forceinline__ void ph_pgx(Frame& F, int l) {
    const unsigned short* Y = (const unsigned short*)(F.ws + WS_G); const unsigned short* S = (const unsigned short*)(F.ws + WS_S); unsigned short* MIX = (VAR == 0) ? (unsigned short*)(F.ws + WS_H) : (unsigned short*)F.out;
    const unsigned short* Wb = (const unsigned short*)(F.ws + WS_W + (size_t)l * W_LAYER + WO_WB);
    const bool last = (l == NLAYER - 1);
    const int nrt = last ? 128 : NROWS / 128;
    for (int u = F.vcu; u < nrt * 8; u += F.G) {
        int rt = u >> 3; const int ct = u & 7;
        if (last) rt = rt + 2 * (rt / 32) + 2;
        pgx::pgx_unit<VAR>(F.lds + RING_OFF, Y, Wb, S, MIX, rt * 128, ct * 128, F.tid);
    }
}
constexpr int NPL = 10;
enum { PH_H = 0, PH_G1, PH_POST1, PH_G2, PH_POST2, PH_ATT, PH_SG, PH_PG, PH_MIX, PH_OG };
constexpr int NPHASES = 1 + NLAYER * NPL;
#ifndef NAIVE_ATT
#define NAIVE_ATT 0
#endif
#ifndef PROBE_MASK
#define PROBE_MASK 0
#endif
#ifndef PROBE_LAYERS
#define PROBE_LAYERS 3
#endif
#ifndef PHMASK
#define PHMASK 16383
#endif
#ifndef MK_ONE_LAUNCH
#define MK_ONE_LAUNCH 1
#endif

__global__ void __launch_bounds__(NTHREADS, 2) fwd_kernel(Args args) {
    extern __shared__ __attribute__((aligned(16))) unsigned char lds_raw[];
    { LAS unsigned char* l0 = (LAS unsigned char*)lds_raw;
      for (int u = threadIdx.x; u < (LDS_BYTES - LDSCTL_OFF) / 4; u += NTHREADS) ((LAS unsigned*)(l0 + LDSCTL_OFF))[u] = 0u;
      __syncthreads();
      if (args.ph_hi - args.ph_lo > 1) (void)xcd_barrier_post((unsigned*)((gu32*)(args.ws + WS_CTL) + CW_BAR), (volatile LAS unsigned*)(l0 + MISC_OFF) + 8); }

    unsigned long long tacc = 0ull;
    for (int ph = args.ph_lo; ph < args.ph_hi; ++ph) {
        unsigned long long tph0 = 0ull; bool probed = false;
        if (PROBE_MASK) { const int pl = (ph == 0) ? 0 : (ph - 1) / NPL, pp = (ph == 0) ? 10 : (ph - 1) % NPL; probed = ((PROBE_MASK >> pp) & 1) && ((PROBE_LAYERS >> pl) & 1); if (probed) tph0 = __builtin_amdgcn_s_memrealtime(); }
        int z; asm volatile("s_mov_b32 %0, 0" : "=s"(z));
        Frame F;
        F.lds = (LAS unsigned char*)lds_raw + z; F.kin = (const float* const __attribute__((address_space(4)))*)((const __attribute__((address_space(4))) char*)__builtin_amdgcn_kernarg_segment_ptr() + z); F.ws = args.ws + z; F.out = args.out + z; F.z = z;
        F.tid = threadIdx.x + z; F.lane = F.tid & 63; F.wave = __builtin_amdgcn_readfirstlane(F.tid >> 6);
        F.G = gridDim.x + z; { const int bx = blockIdx.x + z; F.vcu = (F.G % 8 == 0) ? (bx % 8) * (F.G / 8) + bx / 8 : bx; }
        F.gw = F.vcu * NWAVES + F.wave; F.NGW = F.G * NWAVES;
        bool is_gemm = false;
        pg8::Gemm g{nullptr, nullptr, NROWS, 256, 1024, 1024, 31, 0};
        pg8::Order S; S.init(1, 1, F.G, (int)blockIdx.x + z, 0);
        pg8::EpiU E{pg8::EM_PLAIN, 0, F.ws, nullptr, nullptr, nullptr, 0, 0, 0, 0, 1 << 20};
        if (ph == 0) { if (PHMASK & 8192) p0_prologue(F); }
        else {
            const int l = (ph - 1) / NPL, p = (ph - 1) % NPL;
            unsigned char* wl = F.ws + WS_W + (size_t)l * W_LAYER;
            const bool last = (l == NLAYER - 1);
            const int nMc = last ? 64 : NROWS / 256, lat = last ? 1 : 0;
            E.l = l;
            if (p == PH_H && (PHMASK & 1)) { ph_hnorm(F, l); }
            else if (p == PH_G1 && (PHMASK & 2)) {
                is_gemm = true; g.A = (const bf16*)(F.ws + WS_H); g.Bt = (const bf16*)(wl + WO_W1); g.N = N1; g.K = 1024; g.lda = 1024;
                S.init(NROWS / 256, N1 / 256, F.G, (int)blockIdx.x + z, 0);
                E.mode = pg8::EM_SILU2; E.oA = WS_ZS; E.ldc = ZS_P; E.oB = WS_G; E.ldc2 = 1024; E.split_tile = 7;
            }
            else if (p == PH_POST1 && (PHMASK & 4)) { ph_lru1(F, l); ph_post1(F, l); }
            else if (p == PH_G2 && (PHMASK & 8)) {
                is_gemm = true; g.A = (const bf16*)(F.ws + WS_ZS); g.Bt = (const bf16*)(wl + WO_UQ); g.N = 1024; g.K = 256; g.lda = ZS_P; g.a_shift = 1; g.a_step = 512;
                S.init(NROWS / 256, 4, F.G, (int)blockIdx.x + z, 0);
                E.mode = pg8::EM_PLAIN; E.oA = WS_MQ; E.ldc = 512; E.oB = WS_MKV; E.ldc2 = 512; E.split_tile = 2;
            }
            else if (p == PH_POST2 && (PHMASK & 16)) { ph_lru_carry(F); ph_post2(F, l); }
            else if (p == PH_ATT && (PHMASK & 32)) {
#if NAIVE_ATT
                ph_attn_naive(F, l);
#else
                ph_attn(F, l);
#endif
                ph_lru2(F, l); }
            else if (p == PH_SG && (PHMASK & 512)) {
                is_gemm = true; g.A = (const bf16*)(F.ws + WS_H); g.Bt = (const bf16*)(wl + WO_W1) + (size_t)N1 * 1024; g.N = 4096; g.K = 1024; g.lda = 1024;
                S.init(nMc, 16, F.G, (int)blockIdx.x + z, lat);
                E.mode = pg8::EM_SIG; E.oA = WS_S; E.ldc = 4096;
            }
            else if (p == PH_PG && (PHMASK & 1024)) { ph_pgx<0>(F, l);
#ifdef PGX_PROBE
                if (l == 0) { __syncthreads(); ph_pgx<PGX_PROBE>(F, l); }
#endif
            }
            else if (p == PH_MIX) { }
            else if (p == PH_OG && (PHMASK & 4096)) {
                is_gemm = true; g.A = (const bf16*)(F.ws + WS_H); g.Bt = (const bf16*)(wl + WO_WO); g.N = 1024; g.K = 1024; g.lda = 1024;
                S.init(nMc, 4, F.G, (int)blockIdx.x + z, lat);
                E.mode = pg8::EM_RES; E.xin = (l == 0) ? F.in(I_X) : (const float*)F.out; E.xout = F.out; E.cin0 = F.in(I_CTX); E.oA = WS_MOD; E.oB = WS_CTX1;
            }
        }
        if (is_gemm) pg8::gemm_phase<pg8::EpiU, pg8::Order, true, true>(F.lds + RING_OFF, g, S, E, F.tid);
        if (ph == 1 + PH_OG && NLAYER == 2) {
            pg8::Unit tmp; const int nbusy = (NROWS / 256) * 4 - F.G;
            if ((int)blockIdx.x + z >= nbusy && nbusy >= 0 && nbusy < F.G) { __syncthreads(); weight_copies(F, 1, ((int)blockIdx.x + z - nbusy) * NWAVES + F.wave, (F.G - nbusy) * NWAVES); }
            (void)tmp; }
        const bool empty_phase = (ph > 0) && ((ph - 1) % NPL == PH_MIX);
        if (ph + 1 < args.ph_hi && !empty_phase) {
            int z2; asm volatile("s_mov_b32 %0, 0" : "=s"(z2));
            XcdBarrier bar; bar.bar = (unsigned*)((gu32*)(args.ws + z2 + WS_CTL) + CW_BAR); bar.x = xb_xcc_id(); bar.st = (volatile LAS unsigned*)((LAS unsigned char*)lds_raw + z2 + MISC_OFF) + 8;
            xcd_barrier(bar);
        }
        if (PROBE_MASK) { if (probed) tacc += __builtin_amdgcn_s_memrealtime() - tph0; }
    }
#ifdef EXTRA_BARRIERS
    for (int xb = 0; xb < EXTRA_BARRIERS; ++xb) { int z3; asm volatile("s_mov_b32 %0, 0" : "=s"(z3));
        XcdBarrier bar; bar.bar = (unsigned*)((gu32*)(args.ws + z3 + WS_CTL) + CW_BAR); bar.x = xb_xcc_id(); bar.st = (volatile LAS unsigned*)((LAS unsigned char*)lds_raw + z3 + MISC_OFF) + 8;
        xcd_barrier(bar); }
#endif
    if (PROBE_MASK) { const unsigned long long t0 = __builtin_amdgcn_s_memrealtime(); while (__builtin_amdgcn_s_memrealtime() - t0 < tacc) __builtin_amdgcn_s_sleep(8); }
}

extern "C" void kernel_launch(void* const* d_in, const int* in_sizes, int n_in, void* d_out, int out_size, void* d_ws, size_t ws_size, hipStream_t stream) {
    static int grid = 0;
    if (grid == 0) {
        if (n_in != 28 || out_size != NB * SEQ * DM || ws_size < WS_END) { fprintf(stderr, "kernel_launch: unexpected shapes (n_in %d out %d ws %zu); nothing launched\n", n_in, out_size, ws_size); grid = -1; return; }
        int dev = 0, cus = 0, per_cu = 0;
        if (hipGetDevice(&dev) != hipSuccess || hipDeviceGetAttribute(&cus, hipDeviceAttributeMultiprocessorCount, dev) != hipSuccess) { grid = -1; return; }
        if (hipFuncSetAttribute((const void*)fwd_kernel, hipFuncAttributeMaxDynamicSharedMemorySize, LDS_BYTES) != hipSuccess) { fprintf(stderr, "kernel_launch: hipFuncSetAttribute failed\n"); grid = -1; return; }
        if (hipOccupancyMaxActiveBlocksPerMultiprocessor(&per_cu, (const void*)fwd_kernel, NTHREADS, LDS_BYTES) != hipSuccess || per_cu < 1) { fprintf(stderr, "kernel_launch: occupancy query says %d\n", per_cu); (void)hipGetLastError(); grid = -1; return; }
        grid = cus;
    }
    if (grid < 0) return;
    (void)hipMemsetAsync((char*)d_ws + WS_CTL, 0, CTL_ZERO_BYTES, stream);
    Args a{};
    for (int i = 0; i < 28; ++i) a.in[i] = (const float*)d_in[i];
    a.out = (float*)d_out; a.ws = (unsigned char*)d_ws;
#if MK_ONE_LAUNCH
    a.ph_lo = 0; a.ph_hi = NPHASES;
    hipLaunchKernelGGL(fwd_kernel, dim3(grid), dim3(NTHREADS), LDS_BYTES, stream, a);
#else
    for (int ph = 0; ph < NPHASES; ++ph) { a.ph_lo = ph; a.ph_hi = ph + 1; hipLaunchKernelGGL(fwd_kernel, dim3(grid), dim3(NTHREADS), LDS_BYTES, stream, a); }
#endif
}
```

```cpp
#include <hip/hip_runtime.h>
#include <cstdio>
#include <cstdint>
#include <cmath>
__device__ __forceinline__ float bflo(unsigned w) { return __uint_as_float(w << 16); }
__device__ __forceinline__ float bfhi(unsigned w) { return __uint_as_float(w & 0xffff0000u); }
__device__ __forceinline__ float sigmoid_f(float v) { return __builtin_amdgcn_rcpf(1.0f + __builtin_amdgcn_exp2f(-1.4426950408889634f * v)); }
namespace pg8 {
#define PG8_LAS __attribute__((address_space(3)))
typedef unsigned short bf16_t;
typedef short bf16x8 __attribute__((ext_vector_type(8)));
typedef float f32x4 __attribute__((ext_vector_type(4)));
typedef unsigned u32x4 __attribute__((ext_vector_type(4)));
constexpr int BM = 256, BK = 64, HALF = 128, HTB = HALF * BK * 2  , STAGE_BYTES = 8 * HTB, NXCD = 8, WGM = 8;

__host__ __device__ __forceinline__ int lds_byte(int r, int c) { const int st = (r >> 4) * 2 + (c >> 5), rr = r & 15, cc = c & 31, ob = rr * 64 + cc * 2; return st * 1024 + (ob ^ (((ob >> 9) & 1) << 5)); }
__host__ __device__ __forceinline__ void stage_rc(int b, int& R, int& C) { const int st = b / 1024, sb = b % 1024, swz = sb ^ (((sb >> 9) & 1) << 5); R = (st >> 1) * 16 + swz / 64; C = (st & 1) * 32 + (swz % 64) / 2; }
__host__ __device__ __forceinline__ int perm32(int rho) { const int n = rho >> 4, i = rho & 15; return 8 * (i >> 2) + 4 * n + (i & 3); }

struct Unit { int pm, pn; };
struct Gemm { const bf16_t* A; const bf16_t* Bt; int M, N, K, lda; int a_shift, a_step; };

struct StaticOrder {
    int nM, nN, nwg, G, c;
    __host__ __device__ void init(int M, int N, int G_, int c_) { nM = M / BM; nN = N / BM; nwg = nM * nN; G = G_; c = c_; }
    __host__ __device__ bool next(int i, Unit& u) const {
        const long L = (long)i * G + c; if (L >= nwg) return false;
        int wgid = (int)L; { const int q = nwg / NXCD, r = nwg % NXCD, xcd = wgid % NXCD, off = wgid / NXCD; wgid = (xcd < r ? xcd * (q + 1) : r * (q + 1) + (xcd - r) * q) + off; }
        const int nig = WGM * nN, gid = wgid / nig, fm = gid * WGM, gsz = (nM - fm) < WGM ? (nM - fm) : WGM;
        u.pm = fm + ((wgid % nig) % gsz); u.pn = (wgid % nig) / gsz; return true;
    }
    __device__ __forceinline__ void a_ready(const Unit&) const {}
    __device__ __forceinline__ void done(const Unit&) const {}
};

__device__ __forceinline__ unsigned cvt_pk_bf16(float lo, float hi) { unsigned r; asm volatile("v_cvt_pk_bf16_f32 %0, %1, %2" : "=v"(r) : "v"(lo), "v"(hi)); return r; }
enum { EM_PLAIN = 0, EM_SILU2 = 1, EM_SIG = 2, EM_MUL = 3, EM_RES = 4 };
struct EpiU {
    static constexpr bool PERM = true, AFTER_DRAIN = false;
    int mode; int l; unsigned char* ws; const float* xin; float* xout; const float* cin0;
    size_t oA, oB; int ldc, ldc2, split_tile;
    __device__ __forceinline__ void operator()(const f32x4 (&acc)[2][2][4][2], const Unit& u, int wr, int wc, int fr, int fq) const {
        if (mode == EM_RES) {
            const int b = u.pm / 17, t0 = u.pm % 17;
            const float* src; float* dst; const float* gate; const float* modl = (const float*)(ws + oA) + (size_t)l * 5 * 3072;
            if (t0 == 0) { float* c1 = (float*)(ws + oB); src = ((l == 0) ? cin0 : (const float*)c1) + (size_t)b * 256 * 1024; dst = c1 + (size_t)b * 256 * 1024; gate = modl + 4 * 3072 + 2048; }
            else { const size_t o = ((size_t)b * 4096 + (size_t)(t0 - 1) * 256) * 1024; src = xin + o; dst = xout + o; gate = modl + b * 3072 + 2048; }
            const int col0 = u.pn * BM + wc * 32 + 8 * fq;
            const char* srcb = (const char*)src; char* dstb = (char*)dst; const char* gb = (const char*)(gate + col0);
            const unsigned off0 = (unsigned)((wr * 64 + fr) * 1024 + col0) * 4u;
#pragma unroll
            for (int ai = 0; ai < 2; ++ai) {
                f32x4 xo[4][2][2];
#pragma unroll
                for (int m = 0; m < 4; ++m) { const unsigned off = off0 + (unsigned)(ai * HALF + m * 16) * 4096u;
#pragma unroll
                    for (int bj = 0; bj < 2; ++bj)
#pragma unroll
                        for (int n = 0; n < 2; ++n) xo[m][bj][n] = *(const f32x4*)(srcb + (off + (unsigned)(bj * HALF + n * 4) * 4u)); }
#pragma unroll
                for (int m = 0; m < 4; ++m) { const unsigned off = off0 + (unsigned)(ai * HALF + m * 16) * 4096u;
#pragma unroll
                    for (int bj = 0; bj < 2; ++bj)
#pragma unroll
                        for (int n = 0; n < 2; ++n) { const unsigned cb = (unsigned)(bj * HALF + n * 4) * 4u; const f32x4 g = *(const f32x4*)(gb + cb);
                            *(f32x4*)(dstb + (off + cb)) = xo[m][bj][n] + g * acc[ai][bj][m][n]; } }
                asm volatile("" ::: "memory"); }
            return;
        }
        const int row0 = u.pm * BM + wr * 64 + fr; int colt = u.pn * BM; bf16_t* base = (bf16_t*)(ws + oA); int ld = ldc; bool second = false;
        if (u.pn >= split_tile) { base = (bf16_t*)(ws + oB); ld = ldc2; colt -= split_tile * BM; second = true; }
        const bool do_silu = (mode == EM_SILU2) && second;
        const int col0 = colt + wc * 32 + 8 * fq;
#pragma unroll
        for (int ai = 0; ai < 2; ++ai)
#pragma unroll
            for (int m = 0; m < 4; ++m) { bf16_t* rowp = base + (size_t)(row0 + ai * HALF + m * 16) * ld + col0;
#pragma unroll
                for (int bj = 0; bj < 2; ++bj) { f32x4 v0 = acc[ai][bj][m][0], v1 = acc[ai][bj][m][1];
                    if (mode == EM_SIG) {
#pragma unroll
                        for (int e = 0; e < 4; ++e) { v0[e] = sigmoid_f(v0[e]); v1[e] = sigmoid_f(v1[e]); } }
                    if (do_silu) {
#pragma unroll
                        for (int e = 0; e < 4; ++e) { v0[e] = v0[e] * sigmoid_f(v0[e]); v1[e] = v1[e] * sigmoid_f(v1[e]); } }
                    u32x4 w; w.x = cvt_pk_bf16(v0[0], v0[1]); w.y = cvt_pk_bf16(v0[2], v0[3]); w.z = cvt_pk_bf16(v1[0], v1[1]); w.w = cvt_pk_bf16(v1[2], v1[3]);
                    *(u32x4*)(rowp + bj * HALF) = w; } }
    }
};
struct Order {
    int nM, nN, nwg, G, c, latent_only, grouped, vc, nctx;
    __device__ void init(int nM_, int nN_, int G_, int c_, int lat) { nM = nM_; nN = nN_; nwg = nM * nN; G = G_; c = c_; latent_only = lat; grouped = 0; vc = 0; nctx = 0; }
    __device__ void init_grouped(int G_, int vc_, int with_ctx) { init(64, 4, G_, vc_, 1); grouped = 1; vc = vc_; nctx = with_ctx ? 64 : 0; }
    __device__ bool next(int i, Unit& u) const {
        if (grouped) {
            const int gi = i >> 2, grp = vc + gi * G;
            if (grp < 256) { const int pm = grp >> 2; u.pm = pm + pm / 16 + 1; u.pn = 4 * (i & 3) + (grp & 3); return true; }
            const int done = ((256 - vc + G - 1) / G) * 4;
            const int x = vc + (i - done) * G;
            if (i >= done && x < nctx) { const int g = x >> 2, k = x & 3; u.pm = (g >> 2) * 17; u.pn = 4 * k + (g & 3); return true; }
            return false;
        }
        const long L = (long)i * G + c; if (L >= nwg) return false;
        int wgid = (int)L; { const int q = nwg / NXCD, r = nwg % NXCD, xcd = wgid % NXCD, off = wgid / NXCD; wgid = (xcd < r ? xcd * (q + 1) : r * (q + 1) + (xcd - r) * q) + off; }
        const int nig = WGM * nN, gid = wgid / nig, fm = gid * WGM, gsz = (nM - fm) < WGM ? (nM - fm) : WGM;
        int pm = fm + ((wgid % nig) % gsz); u.pn = (wgid % nig) / gsz; if (latent_only == 1) pm = pm + pm / 16 + 1; else if (latent_only == 2) pm = pm * 17; u.pm = pm; return true;
    }
    __device__ __forceinline__ void a_ready(const Unit&) const {}
    __device__ __forceinline__ void done(const Unit&) const {}
};
template <class Epi, class Sched, bool ALIGN_EPI = false, bool SP2 = false>
__device__ __forceinline__ void gemm_phase(PG8_LAS unsigned char* lds, const Gemm g, const Sched& S, const Epi& E, const int tid  ) {
    const int wid = __builtin_amdgcn_readfirstlane(tid >> 6), lane = tid & 63, wr = wid >> 2, wc = wid & 3, fr = lane & 15, fq = lane >> 4;
    const int K = g.K, nt = K / BK;
    unsigned voffA[2], voffB[2];
#pragma unroll
    for (int i = 0; i < 2; ++i) { int R, C; stage_rc(tid * 16 + i * 8192, R, C); const int Rb = Epi::PERM ? ((R & ~31) + perm32(R & 31)) : R;
        voffA[i] = (unsigned)(R * g.lda + C) * 2u; voffB[i] = (unsigned)(Rb * K + C) * 2u; }
    const size_t kstep = (size_t)(BK * 2);
    const size_t hstepA = (size_t)HALF * g.lda * 2, hstepB = (size_t)HALF * K * 2;
    const size_t tstepA = 2 * hstepA, tstepB = 2 * hstepB;
    const unsigned ldsw = (unsigned)wid * 1024u;
    const int aoff = lds_byte(wr * 64 + fr, fq * 8), boff = lds_byte(wc * 32 + fr, fq * 8);
#define PG8_SA(b, h) (((b) * 2 + (h)) * HTB)
#define PG8_SB(b, h) ((4 + (b) * 2 + (h)) * HTB)
#define PG8_STAGE(bufoff, gbase, voff) do { _Pragma("unroll") for (int _i = 0; _i < 2; ++_i) \
        __builtin_amdgcn_global_load_lds((const unsigned*)((const char*)(gbase) + (voff)[_i]), (PG8_LAS unsigned*)(lds + (bufoff) + ldsw + _i * 8192), 16, 0, 0); } while (0)
#define PG8_LDA(dst, b, h) do { _Pragma("unroll") for (int m = 0; m < 4; ++m) _Pragma("unroll") for (int k = 0; k < 2; ++k) dst[m][k] = *(const PG8_LAS bf16x8*)(lds + PG8_SA(b, h) + aoff + m * 2048 + k * 1024); } while (0)
#define PG8_LDB(dst, b, h) do { _Pragma("unroll") for (int n = 0; n < 2; ++n) _Pragma("unroll") for (int k = 0; k < 2; ++k) dst[n][k] = *(const PG8_LAS bf16x8*)(lds + PG8_SB(b, h) + boff + n * 2048 + k * 1024); } while (0)
#define PG8_MMA(ai, bj, At, Bt) do { __builtin_amdgcn_s_setprio(1); _Pragma("unroll") for (int m = 0; m < 4; ++m) _Pragma("unroll") for (int n = 0; n < 2; ++n) _Pragma("unroll") for (int k = 0; k < 2; ++k) \
        acc[ai][bj][m][n] = __builtin_amdgcn_mfma_f32_16x16x32_bf16(Bt[n][k], At[m][k], acc[ai][bj][m][n], 0, 0, 0); __builtin_amdgcn_s_setprio(0); } while (0)
#define PG8_WAIT_V(n) asm volatile("s_waitcnt vmcnt(" #n ")" ::: "memory")
#define PG8_WAIT_L(n) asm volatile("s_waitcnt lgkmcnt(" #n ")" ::: "memory")
#define PG8_BAR __builtin_amdgcn_s_barrier()
#define PG8_SCHED __builtin_amdgcn_sched_barrier(0)
    Unit cur, nxt; int ui = 0;
    if (!S.next(0, cur)) return;
    f32x4 acc[2][2][4][2];
#pragma unroll
    for (int a = 0; a < 2; ++a)
#pragma unroll
        for (int b = 0; b < 2; ++b)
#pragma unroll
            for (int m = 0; m < 4; ++m)
#pragma unroll
                for (int n = 0; n < 2; ++n) acc[a][b][m][n] = (f32x4){0.f, 0.f, 0.f, 0.f};
    bf16x8 At[4][2], B0[2][2], B1[2][2];
    const char* cA = (const char*)g.A + (size_t)cur.pm * tstepA + (size_t)(cur.pn >> g.a_shift) * (size_t)g.a_step; const char* cB = (const char*)g.Bt + (size_t)cur.pn * tstepB;
    S.a_ready(cur);
    if constexpr (SP2) {
        PG8_STAGE(PG8_SB(0, 0), cB, voffB); PG8_STAGE(PG8_SB(0, 1), cB + hstepB, voffB); PG8_STAGE(PG8_SA(0, 0), cA, voffA); PG8_STAGE(PG8_SA(0, 1), cA + hstepA, voffA);
        if (wr == 1) PG8_BAR;
        PG8_WAIT_V(2); PG8_BAR;
        PG8_STAGE(PG8_SB(1, 0), cB + kstep, voffB); PG8_STAGE(PG8_SA(1, 0), cA + kstep, voffA); PG8_STAGE(PG8_SB(1, 1), cB + hstepB + kstep, voffB);
        PG8_WAIT_V(6); PG8_BAR;
    } else {
        PG8_STAGE(PG8_SB(0, 0), cB, voffB); PG8_STAGE(PG8_SA(0, 0), cA, voffA); PG8_STAGE(PG8_SB(0, 1), cB + hstepB, voffB); PG8_STAGE(PG8_SA(0, 1), cA + hstepA, voffA);
        if (wr == 1) PG8_BAR;
        PG8_WAIT_V(4); PG8_BAR;
        PG8_STAGE(PG8_SB(1, 0), cB + kstep, voffB); PG8_STAGE(PG8_SA(1, 0), cA + kstep, voffA); PG8_STAGE(PG8_SB(1, 1), cB + hstepB + kstep, voffB);
        PG8_WAIT_V(6); PG8_BAR;
    }
    for (;;) {
        const bool has_next = S.next(ui + 1, nxt);
        const char* nA = has_next ? (const char*)g.A + (size_t)nxt.pm * tstepA + (size_t)(nxt.pn >> g.a_shift) * (size_t)g.a_step : cA; const char* nB = has_next ? (const char*)g.Bt + (size_t)nxt.pn * tstepB : cB;
        for (int t = 0; t < nt; t += 2) {
            const bool last = (t == nt - 2);
            const char* a1 = cA + (size_t)(t + 1) * kstep;
            const char* a2 = last ? nA : cA + (size_t)(t + 2) * kstep; const char* b2 = last ? nB : cB + (size_t)(t + 2) * kstep;
            const char* a3 = a2 + kstep; const char* b3 = b2 + kstep;
            if (last && has_next) S.a_ready(nxt);
            if constexpr (SP2) {
            PG8_LDB(B0, 0, 0); PG8_LDB(B1, 0, 1); PG8_SCHED; PG8_LDA(At, 0, 0); PG8_STAGE(PG8_SA(1, 1), a1 + hstepA, voffA);
            PG8_WAIT_V(8); PG8_WAIT_L(0); PG8_BAR; PG8_MMA(0, 0, At, B0); PG8_MMA(0, 1, At, B1); PG8_BAR; PG8_SCHED;
            PG8_LDA(At, 0, 1); PG8_STAGE(PG8_SB(0, 0), b2, voffB); PG8_STAGE(PG8_SB(0, 1), b2 + hstepB, voffB); PG8_STAGE(PG8_SA(0, 0), a2, voffA);
            PG8_WAIT_V(8); PG8_WAIT_L(0); PG8_BAR; PG8_MMA(1, 0, At, B0); PG8_MMA(1, 1, At, B1); PG8_BAR; PG8_SCHED;
            PG8_LDB(B0, 1, 0); PG8_LDB(B1, 1, 1); PG8_SCHED; PG8_LDA(At, 1, 0); PG8_STAGE(PG8_SA(0, 1), a2 + hstepA, voffA);
            PG8_WAIT_V(8); PG8_WAIT_L(0); PG8_BAR; PG8_MMA(0, 0, At, B0); PG8_MMA(0, 1, At, B1); PG8_BAR; PG8_SCHED;
            PG8_LDA(At, 1, 1); PG8_STAGE(PG8_SB(1, 0), b3, voffB); PG8_STAGE(PG8_SB(1, 1), b3 + hstepB, voffB); PG8_STAGE(PG8_SA(1, 0), a3, voffA);
            PG8_WAIT_V(8); PG8_WAIT_L(0); PG8_BAR; PG8_MMA(1, 0, At, B0); PG8_MMA(1, 1, At, B1); PG8_BAR; PG8_SCHED;
            } else {
            PG8_LDB(B0, 0, 0); PG8_SCHED; PG8_LDA(At, 0, 0); PG8_STAGE(PG8_SA(1, 1), a1 + hstepA, voffA);
            PG8_WAIT_L(8); PG8_BAR; PG8_WAIT_L(0); PG8_MMA(0, 0, At, B0); PG8_BAR; PG8_SCHED;
            PG8_LDB(B1, 0, 1); PG8_STAGE(PG8_SB(0, 0), b2, voffB);
            PG8_BAR; PG8_WAIT_L(0); PG8_MMA(0, 1, At, B1); PG8_BAR;
            PG8_LDA(At, 0, 1); PG8_STAGE(PG8_SA(0, 0), a2, voffA);
            PG8_BAR; PG8_WAIT_L(0); PG8_MMA(1, 0, At, B0); PG8_BAR; PG8_SCHED;
            PG8_STAGE(PG8_SB(0, 1), b2 + hstepB, voffB);
            PG8_WAIT_V(6); PG8_BAR; PG8_MMA(1, 1, At, B1); PG8_BAR;
            PG8_LDB(B0, 1, 0); PG8_SCHED; PG8_LDA(At, 1, 0); PG8_STAGE(PG8_SA(0, 1), a2 + hstepA, voffA);
            PG8_WAIT_L(8); PG8_BAR; PG8_WAIT_L(0); PG8_MMA(0, 0, At, B0); PG8_BAR; PG8_SCHED;
            PG8_LDB(B1, 1, 1); PG8_STAGE(PG8_SB(1, 0), b3, voffB);
            PG8_BAR; PG8_WAIT_L(0); PG8_MMA(0, 1, At, B1); PG8_BAR;
            PG8_LDA(At, 1, 1); PG8_STAGE(PG8_SA(1, 0), a3, voffA);
            PG8_BAR; PG8_WAIT_L(0); PG8_MMA(1, 0, At, B0); PG8_BAR; PG8_SCHED;
            PG8_STAGE(PG8_SB(1, 1), b3 + hstepB, voffB);
            PG8_WAIT_V(6); PG8_BAR; PG8_MMA(1, 1, At, B1); PG8_BAR;
            }
        }
        if constexpr (ALIGN_EPI) { if (wr == 0) PG8_BAR; }
        if constexpr (!Epi::AFTER_DRAIN) { E(acc, cur, wr, wc, fr, fq); S.done(cur); }
        if (!has_next) break;
#pragma unroll
        for (int a = 0; a < 2; ++a)
#pragma unroll
            for (int b = 0; b < 2; ++b)
#pragma unroll
                for (int m = 0; m < 4; ++m)
#pragma unroll
                    for (int n = 0; n < 2; ++n) acc[a][b][m][n] = (f32x4){0.f, 0.f, 0.f, 0.f};
        cur = nxt; cA = nA; cB = nB; ++ui;
        if constexpr (ALIGN_EPI) { if (wr == 1) PG8_BAR; }
    }
    PG8_WAIT_V(0);
    if constexpr (!ALIGN_EPI) { if (wr == 0) PG8_BAR; }
    PG8_BAR;
    if constexpr (Epi::AFTER_DRAIN) { E.fused(acc, cur, wr, wc, fr, fq, lds, wid, lane); S.done(cur); }
#undef PG8_SA
#undef PG8_SB
#undef PG8_STAGE
#undef PG8_LDA
#undef PG8_LDB
#undef PG8_MMA
#undef PG8_WAIT_V
#undef PG8_WAIT_L
#undef PG8_BAR
#undef PG8_SCHED
}
}
#define PG8_SP2 true
#define PG8_ALIGN true
#define GAS __attribute__((address_space(1)))
#define LAS __attribute__((address_space(3)))
typedef unsigned short bf16;
typedef unsigned v4u __attribute__((ext_vector_type(4)));
typedef float f32x4 __attribute__((ext_vector_type(4)));
typedef short bf16x8 __attribute__((ext_vector_type(8)));
typedef GAS unsigned gu32;
typedef GAS unsigned long long gu64;
#define RLX_AGENT __ATOMIC_RELAXED, __HIP_MEMORY_SCOPE_AGENT
#define LDS_WAIT() asm volatile("s_waitcnt lgkmcnt(0)" ::: "memory")
#define VM_WAIT() asm volatile("s_waitcnt vmcnt(0)" ::: "memory")
__device__ __forceinline__ unsigned long long rt() { return __builtin_amdgcn_s_memrealtime(); }
__device__ __forceinline__ unsigned f2bf(float f) { unsigned u = __builtin_bit_cast(unsigned, f); return (u + 0x7fffu + ((u >> 16) & 1u)) >> 16; }
__device__ __forceinline__ unsigned pk2(float lo, float hi) { return f2bf(lo) | (f2bf(hi) << 16); }
#define XB_TMO      128
#define XB_XCNT(j)  (256  + 64 * (j))
#define XB_XSUB(j)  (1280 + 64 * (j))
#define XB_XGEN(j)  (2304 + 64 * (j))
#define XB_TOP      3328
#define XB_TOPGEN   3392
#define XCD_BAR_WORDS 3456
#define XB_SPIN_CAP (1u << 18)

__device__ __forceinline__ unsigned xb_ld(unsigned* p)              { return __hip_atomic_load(p, __ATOMIC_RELAXED, __HIP_MEMORY_SCOPE_AGENT); }
__device__ __forceinline__ unsigned xb_add(unsigned* p, unsigned v) { return __hip_atomic_fetch_add(p, v, __ATOMIC_RELAXED, __HIP_MEMORY_SCOPE_AGENT); }
__device__ __forceinline__ unsigned xb_xcc_id() { return (unsigned)__builtin_amdgcn_s_getreg((3 << 11) | 20) & 0xFu; }
#define XB_SPIN(cond, bar) do { unsigned _sp = 0; while (cond) { __builtin_amdgcn_s_sleep(1); \
    if ((++_sp & 255u) == 0u) { if (xb_ld(&(bar)[XB_TMO])) break; if (_sp > XB_SPIN_CAP) { atomicAdd(&(bar)[XB_TMO], 1u); break; } } } } while (0)

struct XcdBarrier {
    unsigned* bar; unsigned x;
    volatile LAS unsigned* st;
};

__device__ __forceinline__ XcdBarrier xcd_barrier_post(unsigned* bar, volatile LAS unsigned* st) {
    XcdBarrier b; b.bar = bar; b.x = xb_xcc_id(); b.st = st;
    if (threadIdx.x == 0) (void)xb_add(&bar[XB_XCNT(b.x)], 1u);
    return b;
}
__device__ __forceinline__ void xcd_barrier_complete(unsigned* bar, unsigned x, unsigned& nloc, unsigned& nx) {
    const unsigned G = gridDim.x * gridDim.y * gridDim.z;
    unsigned sum, cnt, mine, sp = 0u;
    for (;;) {
        sum = 0u; cnt = 0u; mine = 0u;
#pragma unroll
        for (unsigned j = 0; j < 16; ++j) { const unsigned c = xb_ld(&bar[XB_XCNT(j)]); sum += c; cnt += (c > 0u) ? 1u : 0u; mine = (j == x) ? c : mine; }
        if (sum == G) break;
        __builtin_amdgcn_s_sleep(1);
        if ((++sp & 255u) == 0u) { if (xb_ld(&bar[XB_TMO])) break; if (sp > XB_SPIN_CAP) { atomicAdd(&bar[XB_TMO], 1u); break; } }
    }
    nloc = mine > 0u ? mine : 1u; nx = cnt > 0u ? cnt : 1u;
}

__device__ __forceinline__ void xcd_barrier(const XcdBarrier& b) {
    asm volatile("s_waitcnt vmcnt(0)" ::: "memory");
    __syncthreads();
    if (threadIdx.x == 0) {
        unsigned* bar = b.bar;
        __builtin_amdgcn_s_waitcnt(0);
        unsigned nloc = b.st[0], nx = b.st[1];
        if (nloc == 0u) { xcd_barrier_complete(bar, b.x, nloc, nx); b.st[0] = nloc; b.st[1] = nx; }
        const unsigned old = xb_add(&bar[XB_XSUB(b.x)], 1u);
        const unsigned gen = old / nloc;
        if (old + 1u == (gen + 1u) * nloc) {
            __builtin_amdgcn_fence(__ATOMIC_RELEASE, "agent");
            asm volatile("s_waitcnt vmcnt(0)" ::: "memory");
            const unsigned og = xb_add(&bar[XB_TOP], 1u);
            const unsigned tg = og / nx;
            if (og + 1u == (tg + 1u) * nx) xb_add(&bar[XB_TOPGEN], 1u);
            else XB_SPIN(xb_ld(&bar[XB_TOPGEN]) == tg, bar);
            __builtin_amdgcn_fence(__ATOMIC_ACQUIRE, "agent");
            xb_add(&bar[XB_XGEN(b.x)], 1u);
            asm volatile("s_waitcnt vmcnt(0)" ::: "memory");
        } else {
            XB_SPIN(xb_ld(&bar[XB_XGEN(b.x)]) == gen, bar);
            __builtin_amdgcn_fence(__ATOMIC_ACQUIRE, "agent");
            asm volatile("s_waitcnt vmcnt(0)" ::: "memory");
        }
    }
    __syncthreads();
}
constexpr int NB = 4, SEQ = 4096, CTXL = 256, TPB = SEQ + CTXL, NROWS = NB * TPB, DM = 1024, NLAYER = 2, IN_COLS = 6816;
constexpr int NWAVES = 8, NTHREADS = NWAVES * 64;
constexpr float RMS_EPS = 1e-6f;
constexpr float LOG2E = 1.4426950408889634f;
constexpr float QSCALE64 = 0.125f * LOG2E;
constexpr float QSCALE96 = 0.10206207261596575f * LOG2E;
constexpr int ZS_P = 1792, ZC_CQ = 0, ZC_CKV = 256, ZC_KR = 384, ZC_SQ = 512, ZC_SK = 768, ZC_SV = 896, ZC_AQ = 1024, ZC_AK = 1280, ZC_AV = 1408, ZC_LRU = 1536;
constexpr int N1 = 2816;
constexpr int W1ROWS = N1 + 4096;
constexpr size_t MiB = 1u << 20;
constexpr size_t WS_CTL = 0, CTL_ZERO_BYTES = 64 * 1024;
constexpr size_t WS_MOD = 1 * MiB;
constexpr size_t WS_RHC = 1 * MiB + 256 * 1024, WS_RHS = WS_RHC + 512 * 1024;
constexpr size_t WS_RMC = WS_RHS + 512 * 1024, WS_RMS = WS_RMC + 256 * 1024;
constexpr size_t WS_CTX1 = 3 * MiB;
constexpr size_t WS_WOS = 3 * MiB;
constexpr size_t WS_W = 8 * MiB, W_LAYER = 18 * MiB;
constexpr size_t WO_W1 = 0, WO_WB = 13 * MiB + 512 * 1024, WO_WO = WO_WB + 2 * MiB, WO_UQ = WO_WO + 2 * MiB, WO_UKV = WO_UQ + 256 * 1024;
constexpr size_t WS_H = 44 * MiB;
constexpr size_t WS_G = 78 * MiB;
constexpr size_t WS_S = 112 * MiB;
constexpr size_t WS_ZS = 112 * MiB;
constexpr size_t WS_MQ = 172 * MiB;
constexpr size_t WS_MKV = 189 * MiB;
constexpr size_t WS_MK = 206 * MiB;
constexpr size_t WS_U = 219 * MiB;
constexpr size_t WS_HF = 236 * MiB;
constexpr size_t WS_SP = 2 * MiB + 768 * 1024;
constexpr size_t WS_LWT = 254 * MiB + 512 * 1024;
constexpr size_t WS_END = 256 * MiB;
static_assert(WS_H + (size_t)NROWS * 1024 * 2 <= WS_G && WS_G + (size_t)NROWS * 1024 * 2 <= WS_S && WS_S + (size_t)NROWS * 4096 * 2 <= 248 * MiB, "ws map");
static_assert(WS_ZS + (size_t)NROWS * ZS_P * 2 <= WS_MQ && WS_MK + (size_t)NROWS * 384 * 2 <= WS_U, "ws map 2");
static_assert(WO_UKV + 512 * 256 * 2 <= W_LAYER, "weights");
constexpr int CW_BAR = 1024;

constexpr int RING_OFF = 0, RING_BYTES = 131072, LDSCTL_OFF = RING_BYTES, MISC_OFF = LDSCTL_OFF + 320, LDS_BYTES = 147456;

typedef unsigned short bf16;
typedef unsigned u32x2 __attribute__((ext_vector_type(2)));
typedef float f32x2v __attribute__((ext_vector_type(2)));
__device__ __forceinline__ float bf2f(bf16 v) { return __uint_as_float((unsigned)v << 16); }
template <int O> __device__ __forceinline__ float xor_swz(float v) { return __int_as_float(__builtin_amdgcn_ds_swizzle(__float_as_int(v), (O << 10) | 0x1F)); }
__device__ __forceinline__ float wave_sum(float v) {
    v += xor_swz<1>(v); v += xor_swz<2>(v); v += xor_swz<4>(v); v += xor_swz<8>(v); v += xor_swz<16>(v);
    auto rr = __builtin_amdgcn_permlane32_swap(__float_as_uint(v), __float_as_uint(v), false, false); return __uint_as_float(rr[0]) + __uint_as_float(rr[1]); }
__device__ __forceinline__ float wave_max(float v) {
    v = fmaxf(v, xor_swz<1>(v)); v = fmaxf(v, xor_swz<2>(v)); v = fmaxf(v, xor_swz<4>(v)); v = fmaxf(v, xor_swz<8>(v)); v = fmaxf(v, xor_swz<16>(v));
    auto rr = __builtin_amdgcn_permlane32_swap(__float_as_uint(v), __float_as_uint(v), false, false); return fmaxf(__uint_as_float(rr[0]), __uint_as_float(rr[1])); }
__device__ __forceinline__ float grp16_sum(float v) {
    v += xor_swz<1>(v); v += xor_swz<2>(v); v += xor_swz<4>(v); v += xor_swz<8>(v); return v; }

struct Args { const float* in[28]; float* out; unsigned char* ws; int ph_lo, ph_hi; };
enum { I_X = 0, I_C, I_CTX, I_CCTX, I_WMOD, I_BMOD, I_NORMW, I_WIN, I_CQN, I_CKVN, I_WUQ, I_WUKV, I_MQN, I_MKN, I_SQN, I_SKN, I_SINK, I_AQN, I_AKN,
       I_CONVW, I_CONVB, I_LWR, I_LBR, I_LWI, I_LBI, I_LAM, I_WBR, I_WOUT };

struct Frame {
    LAS unsigned char* lds; const float* const __attribute__((address_space(4)))* kin; unsigned char* ws; float* out;
    int tid, lane, wave, G, vcu, gw, NGW, z;
    __device__ __forceinline__ const float* in(int i) const { return kin[i]; }
};

__device__ __forceinline__ void xpose_item(const float* W, int ldn, int k0, int n0, bf16* WT, int pd, int drow, LAS float* scr, int lane) {
    float v[32]; const float* wp = W + (size_t)(k0 + (lane >> 5)) * ldn + n0 + (lane & 31);
#pragma unroll
    for (int i = 0; i < 32; ++i) v[i] = wp[(size_t)(2 * i) * ldn];
#pragma unroll
    for (int i = 0; i < 32; ++i) scr[(2 * i + (lane >> 5)) * 33 + (lane & 31)] = v[i];
    LDS_WAIT(); asm volatile("" ::: "memory");
    const int c = lane & 7;
#pragma unroll
    for (int j = 0; j < 4; ++j) { const int n = (lane >> 3) + 8 * j; const LAS float* s = scr + (8 * c) * 33 + n;
        v4u o; o.x = pk2(s[0 * 33], s[1 * 33]); o.y = pk2(s[2 * 33], s[3 * 33]); o.z = pk2(s[4 * 33], s[5 * 33]); o.w = pk2(s[6 * 33], s[7 * 33]);
        *(GAS v4u*)(WT + (size_t)(drow + n0 + n) * pd + k0 + 8 * c) = o; }
    LDS_WAIT(); asm volatile("" ::: "memory");
}
__device__ __forceinline__ void zero16(bf16* p, size_t n16, int gt, int ngt) {
    for (size_t i = gt; i < n16; i += ngt) ((GAS v4u*)p)[i] = (v4u){0u, 0u, 0u, 0u};
}
__device__ __forceinline__ void weight_copies(Frame& F, int l, int gw, int NGW, int it_end = 1 << 30, int nsplit = 0) {
    LAS float* scr = (LAS float*)(F.lds + RING_OFF + F.wave * 16384);
    constexpr int I_IN = 16 * 213, I_UQ = 4 * 12, I_UKV = 2 * 16, I_BR = 4 * 4 * 32, I_OUT = 16 * 32, I_LAYER = I_IN + I_UQ + I_UKV + I_BR + I_OUT;
    unsigned char* wl = F.ws + WS_W + (size_t)l * W_LAYER;
    if (it_end > I_LAYER + nsplit) it_end = I_LAYER + nsplit;
    for (int it = gw; it < it_end; it += NGW) {
        int r = it;
        if (r < nsplit) { const int kb = r / 32, nb = r % 32, kq = kb >> 2;
            xpose_item(F.in(I_WOUT), 1024, kb * 64, nb * 32, (bf16*)(F.ws + WS_WOS) + (size_t)kq * (1024 * 256 - 256), 256, 0, scr, F.lane); continue; } r -= nsplit;
        if (r < I_IN) { const int kb = r / 213, nb = r % 213, n0 = nb * 32;
            xpose_item(F.in(I_WIN) + (size_t)l * 1024 * IN_COLS, IN_COLS, kb * 64, n0, (bf16*)(wl + WO_W1), 1024, n0 >= 416 ? 96 : 0, scr, F.lane); continue; } r -= I_IN;
        if (r < I_UQ) { const int kb = r / 12, nb = r % 12;
            xpose_item(F.in(I_WUQ) + (size_t)l * 256 * 384, 384, kb * 64, nb * 32, (bf16*)(wl + WO_UQ), 256, 0, scr, F.lane); continue; } r -= I_UQ;
        if (r < I_UKV) { const int kb = r / 16, nb = r % 16;
            xpose_item(F.in(I_WUKV) + (size_t)l * 128 * 512, 512, kb * 64, nb * 32, (bf16*)(wl + WO_UKV), 256, 0, scr, F.lane); continue; } r -= I_UKV;
        if (r < I_BR) { const int k = r / 128, rr = r % 128, kb = rr / 32, nb = rr % 32;
            xpose_item(F.in(I_WBR) + ((size_t)l * 4 + k) * 256 * 1024, 1024, kb * 64, nb * 32, (bf16*)(wl + WO_WB) + (size_t)k * 1024 * 256, 256, 0, scr, F.lane); continue; } r -= I_BR;
        { const int kb = r / 32, nb = r % 32;
            xpose_item(F.in(I_WOUT) + (size_t)l * 1024 * 1024, 1024, kb * 64, nb * 32, (bf16*)(wl + WO_WO), 1024, 0, scr, F.lane); }
    }
}
__device__ __forceinline__ void p0_prologue(Frame& F) {
    weight_copies(F, 0, F.gw, F.NGW, 1 << 30, 16 * 32);
    const int gt = F.vcu * NTHREADS + F.tid, ngt = F.G * NTHREADS;
    for (int l = 0; l < NLAYER; ++l) {
        unsigned char* wl = F.ws + WS_W + (size_t)l * W_LAYER;
        zero16((bf16*)(wl + WO_W1) + (size_t)416 * 1024, 96 * 1024 * 2 / 16, gt, ngt);
        zero16((bf16*)(wl + WO_UQ) + (size_t)384 * 256, 128 * 256 * 2 / 16, gt, ngt);
        for (int i = gt; i < 512 * 16; i += ngt) { const int n = i >> 4, c = i & 15; ((GAS v4u*)((bf16*)(wl + WO_UKV) + (size_t)n * 256 + 128))[c] = (v4u){0u, 0u, 0u, 0u}; }
    }
    { float* rhc = (float*)(F.ws + WS_RHC); float* rhs = (float*)(F.ws + WS_RHS); float* rmc = (float*)(F.ws + WS_RMC); float* rms = (float*)(F.ws + WS_RMS);
      for (int i = gt; i < 4096 * 32; i += ngt) { const int t = i >> 5, p = i & 31; const float fr = powf(10000.0f, -(float)(p & 15) / 16.0f);
          const float pos = (float)((p < 16) ? (t >> 6) : (t & 63)); const float ang = pos * fr; rhc[i] = cosf(ang); rhs[i] = sinf(ang); }
      for (int i = gt; i < 4096 * 16; i += ngt) { const int t = i >> 4, p = i & 15; const float fr = powf(10000.0f, -(float)(p & 7) / 8.0f);
          const float pos = (float)((p < 8) ? (t >> 6) : (t & 63)); const float ang = pos * fr; rmc[i] = cosf(ang); rms[i] = sinf(ang); } }
    { float* sp = (float*)(F.ws + WS_SP); for (int i = gt; i < NLAYER * 2 * 256; i += ngt) sp[i] = 8.0f * LOG2E * log1pf(expf(-F.in(I_LAM)[i])); }
    { float* lwt = (float*)(F.ws + WS_LWT);
      for (int o = gt; o < NLAYER * 2 * 2 * 256 * 64; o += ngt) { const int i = o & 63, c = (o >> 6) & 255, gate = (o >> 14) & 1, ld = o >> 15, k = c >> 6, j = c & 63;
          lwt[o] = (gate == 0 ? F.in(I_LWR) : F.in(I_LWI))[(((size_t)ld * 4 + k) * 64 + i) * 64 + j]; } }
    { LAS float* sc = (LAS float*)(F.lds + RING_OFF);
      LAS float* red = sc + 5 * 1024;
      __syncthreads();
      for (int i = F.tid; i < 5 * 1024; i += NTHREADS) { const float v = (i < 4096) ? F.in(I_C)[i] : F.in(I_CCTX)[i - 4096]; sc[i] = v / (1.0f + expf(-v)); }
      __syncthreads();
      float* modv = (float*)(F.ws + WS_MOD);
      for (int it = F.vcu; it < NLAYER * 96; it += F.G) {
          const int l = it / 96, n0 = (it % 96) * 32, nn = F.tid & 31, kc = F.tid >> 5;
          const float* w = F.in(I_WMOD) + (size_t)l * 1024 * 3072 + n0 + nn;
          float acc[5] = {0.f, 0.f, 0.f, 0.f, 0.f};
          for (int k = kc * 64; k < kc * 64 + 64; ++k) { const float wv = w[(size_t)k * 3072];
#pragma unroll
              for (int r = 0; r < 5; ++r) acc[r] += sc[r * 1024 + k] * wv; }
#pragma unroll
          for (int r = 0; r < 5; ++r) red[(kc * 5 + r) * 32 + nn] = acc[r];
          __syncthreads();
          if (F.tid < 160) { const int r = F.tid >> 5; float s = 0.f;
              for (int q = 0; q < 16; ++q) s += red[(q * 5 + r) * 32 + nn];
              modv[((size_t)l * 5 + r) * 3072 + n0 + nn] = s + F.in(I_BMOD)[l * 3072 + n0 + nn]; }
          __syncthreads();
      } }
}

__device__ __forceinline__ void ph_hnorm(Frame& F, int l) {
    const float* xs = (l == 0) ? F.in(I_X) : F.out; const float* cs = (l == 0) ? F.in(I_CTX) : (const float*)(F.ws + WS_CTX1);
    const float* nw = F.in(I_NORMW) + l * 1024; const float* modl = (const float*)(F.ws + WS_MOD) + (size_t)l * 5 * 3072;
    bf16* H = (bf16*)(F.ws + WS_H);
    for (int row = F.gw; row < NROWS; row += F.NGW) {
        const int b = row / TPB, j = row % TPB; const float* src; int mr;
        if (j < CTXL) { src = cs + ((size_t)b * CTXL + j) * 1024; mr = 4; } else { src = xs + ((size_t)b * SEQ + (j - CTXL)) * 1024; mr = b; }
        const GAS f32x4* xr = (const GAS f32x4*)src + F.lane;
        f32x4 v[4]; float ss = 0.f;
        if (l > 0 && j < CTXL) {
            const unsigned short* P = (const unsigned short*)(F.ws + WS_S) + (size_t)row * 4096 + 4 * F.lane;
            const float* gt = (const float*)(F.ws + WS_MOD) + 4 * 3072 + 2048 + 4 * F.lane;
            const GAS f32x4* c0 = (const GAS f32x4*)(F.in(I_CTX) + ((size_t)b * CTXL + j) * 1024) + F.lane;
#pragma unroll
            for (int q = 0; q < 4; ++q) { f32x4 a = {0.f, 0.f, 0.f, 0.f};
#pragma unroll
                for (int kq = 0; kq < 4; ++kq) { const u32x2 w = *(const u32x2*)(P + kq * 1024 + 256 * q); a.x += bflo(w.x); a.y += bfhi(w.x); a.z += bflo(w.y); a.w += bfhi(w.y); }
                v[q] = c0[64 * q] + *(const f32x4*)(gt + 256 * q) * a; }
        } else {
#pragma unroll
            for (int q = 0; q < 4; ++q) v[q] = xr[64 * q];
        }
#pragma unroll
        for (int q = 0; q < 4; ++q) ss += (v[q].x * v[q].x + v[q].y * v[q].y) + (v[q].z * v[q].z + v[q].w * v[q].w);
        const float rstd = 1.0f / sqrtf(wave_sum(ss) * (1.0f / 1024.0f) + RMS_EPS);
        const float* mrow = modl + mr * 3072;
        GAS unsigned long long* o8 = (GAS unsigned long long*)(H + (size_t)row * 1024) + F.lane;
#pragma unroll
        for (int q = 0; q < 4; ++q) { const int c = 4 * F.lane + 256 * q;
            const f32x4 g = *(const f32x4*)(nw + c), sh = *(const f32x4*)(mrow + c), sc = *(const f32x4*)(mrow + 1024 + c);
            const f32x4 h = v[q] * rstd * g * (sc + 1.0f) + sh;
            o8[64 * q] = (unsigned long long)pk2(h.x, h.y) | ((unsigned long long)pk2(h.z, h.w) << 32); }
    }
}

struct P1Regs { u32x2 cq; unsigned ckv, h[3][2]; float rc[2], rs[2]; };
__device__ __forceinline__ void post1_load(const bf16* z, const float* rc, const float* rs, bool lat, int lane, P1Regs& R) {
    const int hg = lane >> 4, p0 = (lane & 15) * 2;
    R.cq = *(const u32x2*)(z + ZC_CQ + 4 * lane); R.ckv = *(const unsigned*)(z + ZC_CKV + 2 * lane);
    const bf16* h0 = z + ZC_SQ + hg * 64 + p0; const bf16* h1 = z + ZC_AQ + hg * 64 + p0; const bf16* h2 = z + ((hg < 2) ? (ZC_SK + hg * 64) : (ZC_AK + (hg - 2) * 64)) + p0;
    R.h[0][0] = *(const unsigned*)h0; R.h[0][1] = *(const unsigned*)(h0 + 32); R.h[1][0] = *(const unsigned*)h1; R.h[1][1] = *(const unsigned*)(h1 + 32); R.h[2][0] = *(const unsigned*)h2; R.h[2][1] = *(const unsigned*)(h2 + 32);
    if (lat) { R.rc[0] = rc[p0]; R.rc[1] = rc[p0 + 1]; R.rs[0] = rs[p0]; R.rs[1] = rs[p0 + 1]; } else { R.rc[0] = 1.f; R.rc[1] = 1.f; R.rs[0] = 0.f; R.rs[1] = 0.f; }
}
__device__ __forceinline__ void post1_finish(bf16* z, int lane, const P1Regs& R, const float (&gcq)[4], const float (&gckv)[2], const float (&gh)[3][4]) {
    const int hg = lane >> 4, p0 = (lane & 15) * 2;
    { float v0 = bflo(R.cq.x), v1 = bfhi(R.cq.x), v2 = bflo(R.cq.y), v3 = bfhi(R.cq.y);
      const float rstd = 1.0f / sqrtf(wave_sum(v0 * v0 + v1 * v1 + v2 * v2 + v3 * v3) * (1.0f / 256.0f) + RMS_EPS);
      u32x2 w; w.x = pk2(v0 * rstd * gcq[0], v1 * rstd * gcq[1]); w.y = pk2(v2 * rstd * gcq[2], v3 * rstd * gcq[3]); *(u32x2*)(z + ZC_CQ + 4 * lane) = w; }
    { float v0 = bflo(R.ckv), v1 = bfhi(R.ckv);
      const float rstd = 1.0f / sqrtf(wave_sum(v0 * v0 + v1 * v1) * (1.0f / 128.0f) + RMS_EPS);
      *(unsigned*)(z + ZC_CKV + 2 * lane) = pk2(v0 * rstd * gckv[0], v1 * rstd * gckv[1]); }
#pragma unroll
    for (int q = 0; q < 3; ++q) {
        bf16* hp = z + ((q == 0) ? (ZC_SQ + hg * 64) : (q == 1) ? (ZC_AQ + hg * 64) : ((hg < 2) ? (ZC_SK + hg * 64) : (ZC_AK + (hg - 2) * 64))) + p0;
        float a0 = bflo(R.h[q][0]), a1 = bfhi(R.h[q][0]), b0 = bflo(R.h[q][1]), b1 = bfhi(R.h[q][1]);
        const float rstd = 1.0f / sqrtf(grp16_sum(a0 * a0 + a1 * a1 + b0 * b0 + b1 * b1) * (1.0f / 64.0f) + RMS_EPS);
        a0 *= rstd * gh[q][0]; a1 *= rstd * gh[q][1]; b0 *= rstd * gh[q][2]; b1 *= rstd * gh[q][3];
        const float x0 = a0 * R.rc[0] - b0 * R.rs[0], y0 = b0 * R.rc[0] + a0 * R.rs[0], x1 = a1 * R.rc[1] - b1 * R.rs[1], y1 = b1 * R.rc[1] + a1 * R.rs[1];
        const float sc = (q < 2) ? QSCALE64 : 1.0f;
        *(unsigned*)hp = pk2(x0 * sc, x1 * sc); *(unsigned*)(hp + 32) = pk2(y0 * sc, y1 * sc);
    }
}
__device__ __forceinline__ void ph_post1(Frame& F, int l) {
    bf16* ZS = (bf16*)(F.ws + WS_ZS);
    const float* rhc = (const float*)(F.ws + WS_RHC); const float* rhs = (const float*)(F.ws + WS_RHS);
    const int lane = F.lane, hg = lane >> 4, p0 = (lane & 15) * 2;
    float gcq[4], gckv[2], gh[3][4];
#pragma unroll
    for (int i = 0; i < 4; ++i) gcq[i] = F.in(I_CQN)[l * 256 + 4 * lane + i];
    gckv[0] = F.in(I_CKVN)[l * 128 + 2 * lane]; gckv[1] = F.in(I_CKVN)[l * 128 + 2 * lane + 1];
    { const float* g0 = F.in(I_SQN) + l * 64; const float* g1 = F.in(I_AQN) + l * 64; const float* g2 = ((hg < 2) ? F.in(I_SKN) : F.in(I_AKN)) + l * 64;
      gh[0][0] = g0[p0]; gh[0][1] = g0[p0 + 1]; gh[0][2] = g0[32 + p0]; gh[0][3] = g0[33 + p0];
      gh[1][0] = g1[p0]; gh[1][1] = g1[p0 + 1]; gh[1][2] = g1[32 + p0]; gh[1][3] = g1[33 + p0];
      gh[2][0] = g2[p0]; gh[2][1] = g2[p0 + 1]; gh[2][2] = g2[32 + p0]; gh[2][3] = g2[33 + p0]; }
    for (int row = F.gw; row < NROWS; row += 2 * F.NGW) {
        const int row2 = row + F.NGW; const bool has2 = row2 < NROWS;
        const int j = row % TPB; const bool lat = j >= CTXL; const int pos = lat ? j - CTXL : 0;
        const int j2 = has2 ? row2 % TPB : 0; const bool lat2 = j2 >= CTXL; const int pos2 = lat2 ? j2 - CTXL : 0;
        bf16* z = ZS + (size_t)row * ZS_P; bf16* z2 = ZS + (size_t)(has2 ? row2 : row) * ZS_P;
        P1Regs A, B;
        post1_load(z, rhc + pos * 32, rhs + pos * 32, lat, lane, A);
        if (has2) post1_load(z2, rhc + pos2 * 32, rhs + pos2 * 32, lat2, lane, B);
        post1_finish(z, lane, A, gcq, gckv, gh);
        if (has2) post1_finish(z2, lane, B, gcq, gckv, gh);
    }
}
struct P2Regs { u32x2 qn, kn; bf16 q1, q2, k1, k2; float c, s; };
__device__ __forceinline__ void post2_load(const bf16* zrow, const bf16* mq, const bf16* mkv, const float* rc, const float* rs, bool lat, int lane, P2Regs& R) {
    const int h = lane >> 4, j = lane & 15;
    R.qn = *(const u32x2*)(mq + h * 96 + 4 * j); R.q1 = mq[h * 96 + 64 + j]; R.q2 = mq[h * 96 + 80 + j];
    R.kn = *(const u32x2*)(mkv + h * 128 + 4 * j); R.k1 = zrow[ZC_KR + j]; R.k2 = zrow[ZC_KR + 16 + j];
    if (lat) { R.c = rc[j]; R.s = rs[j]; } else { R.c = 1.f; R.s = 0.f; }
}
__device__ __forceinline__ void post2_finish(bf16* mq, bf16* mk, int lane, const P2Regs& R, const float (&gq)[6], const float (&gk)[6]) {
    const int h = lane >> 4, j = lane & 15;
#pragma unroll
    for (int qk = 0; qk < 2; ++qk) {
        const u32x2 n = qk == 0 ? R.qn : R.kn; float v0 = bflo(n.x), v1 = bfhi(n.x), v2 = bflo(n.y), v3 = bfhi(n.y), r1 = bf2f(qk == 0 ? R.q1 : R.k1), r2 = bf2f(qk == 0 ? R.q2 : R.k2);
        const float rstd = 1.0f / sqrtf(grp16_sum(v0 * v0 + v1 * v1 + v2 * v2 + v3 * v3 + r1 * r1 + r2 * r2) * (1.0f / 96.0f) + RMS_EPS);
        const float (&g)[6] = qk == 0 ? gq : gk; const float sc = qk == 0 ? QSCALE96 : 1.0f;
        const float y1 = r1 * rstd * g[4], y2 = r2 * rstd * g[5];
        const float t1 = (y1 * R.c - y2 * R.s) * sc, t2 = (y2 * R.c + y1 * R.s) * sc;
        bf16* o = (qk == 0 ? mq : mk) + h * 96;
        u32x2 w; w.x = pk2(v0 * rstd * g[0] * sc, v1 * rstd * g[1] * sc); w.y = pk2(v2 * rstd * g[2] * sc, v3 * rstd * g[3] * sc);
        *(u32x2*)(o + 4 * j) = w; o[64 + j] = (bf16)f2bf(t1); o[80 + j] = (bf16)f2bf(t2);
    }
}
__device__ __forceinline__ void ph_post2(Frame& F, int l) {
    const bf16* ZS = (const bf16*)(F.ws + WS_ZS); bf16* MQ = (bf16*)(F.ws + WS_MQ); const bf16* MKV = (const bf16*)(F.ws + WS_MKV); bf16* MK = (bf16*)(F.ws + WS_MK);
    const float* rmc = (const float*)(F.ws + WS_RMC); const float* rms = (const float*)(F.ws + WS_RMS);
    const int lane = F.lane, jj = lane & 15;
    float gq[6], gk[6];
    { const float* a = F.in(I_MQN) + l * 96; const float* b = F.in(I_MKN) + l * 96;
#pragma unroll
      for (int i = 0; i < 4; ++i) { gq[i] = a[4 * jj + i]; gk[i] = b[4 * jj + i]; }
      gq[4] = a[64 + jj]; gq[5] = a[80 + jj]; gk[4] = b[64 + jj]; gk[5] = b[80 + jj]; }
    for (int row = F.gw; row < NROWS; row += 2 * F.NGW) {
        const int row2 = row + F.NGW; const bool has2 = row2 < NROWS; const size_t rb = has2 ? row2 : row;
        const int j = row % TPB; const bool lat = j >= CTXL; const int pos = lat ? j - CTXL : 0;
        const int j2 = (int)(rb % TPB); const bool lat2 = j2 >= CTXL; const int pos2 = lat2 ? j2 - CTXL : 0;
        P2Regs A, B;
        post2_load(ZS + (size_t)row * ZS_P, MQ + (size_t)row * 512, MKV + (size_t)row * 512, rmc + pos * 16, rms + pos * 16, lat, lane, A);
        if (has2) post2_load(ZS + rb * ZS_P, MQ + rb * 512, MKV + rb * 512, rmc + pos2 * 16, rms + pos2 * 16, lat2, lane, B);
        post2_finish(MQ + (size_t)row * 512, MK + (size_t)row * 384, lane, A, gq, gk);
        if (has2) post2_finish(MQ + rb * 512, MK + rb * 384, lane, B, gq, gk);
    }
}

template <int DQK>
__device__ __forceinline__ void attn_row_naive(const bf16* q, const bf16* Kb, int kp, const bf16* Vb, int vp, int n1, int lo2, int hi2, bool has_sink, float sink2, bf16* y, int lane) {
    float qf[DQK];
#pragma unroll
    for (int c = 0; c < DQK / 8; ++c) { const v4u w = *(const v4u*)(q + 8 * c);
        qf[8 * c + 0] = bflo(w.x); qf[8 * c + 1] = bfhi(w.x); qf[8 * c + 2] = bflo(w.y); qf[8 * c + 3] = bfhi(w.y); qf[8 * c + 4] = bflo(w.z); qf[8 * c + 5] = bfhi(w.z); qf[8 * c + 6] = bflo(w.w); qf[8 * c + 7] = bfhi(w.w); }
    float m = -INFINITY, l = 0.f; float acc[64];
#pragma unroll
    for (int d = 0; d < 64; ++d) acc[d] = 0.f;
    for (int seg = 0; seg < 2; ++seg) {
        const int k0 = seg == 0 ? 0 : lo2, k1 = seg == 0 ? n1 : hi2;
        for (int key = k0 + lane; key < k1; key += 64) {
            const bf16* kr = Kb + (size_t)key * kp; float s = 0.f;
#pragma unroll
            for (int c = 0; c < DQK / 8; ++c) { const v4u w = *(const v4u*)(kr + 8 * c);
                s += qf[8 * c + 0] * bflo(w.x) + qf[8 * c + 1] * bfhi(w.x) + qf[8 * c + 2] * bflo(w.y) + qf[8 * c + 3] * bfhi(w.y) + qf[8 * c + 4] * bflo(w.z) + qf[8 * c + 5] * bfhi(w.z) + qf[8 * c + 6] * bflo(w.w) + qf[8 * c + 7] * bfhi(w.w); }
            if (s > m) { const float f = exp2f(m - s); l *= f;
#pragma unroll
                for (int d = 0; d < 64; ++d) acc[d] *= f;
                m = s; }
            const float p = exp2f(s - m); l += p;
            const bf16* vr = Vb + (size_t)key * vp;
#pragma unroll
            for (int c = 0; c < 8; ++c) { const v4u w = *(const v4u*)(vr + 8 * c);
                acc[8 * c + 0] += p * bflo(w.x); acc[8 * c + 1] += p * bfhi(w.x); acc[8 * c + 2] += p * bflo(w.y); acc[8 * c + 3] += p * bfhi(w.y); acc[8 * c + 4] += p * bflo(w.z); acc[8 * c + 5] += p * bfhi(w.z); acc[8 * c + 6] += p * bflo(w.w); acc[8 * c + 7] += p * bfhi(w.w); }
        }
    }
    float M = wave_max(m); if (has_sink) M = fmaxf(M, sink2);
    const float f = (m == -INFINITY) ? 0.f : exp2f(m - M);
    float L = wave_sum(l * f); if (has_sink) L += exp2f(sink2 - M);
    float mine = 0.f;
#pragma unroll
    for (int d = 0; d < 64; ++d) { const float t = wave_sum(acc[d] * f); if (lane == d) mine = t; }
    y[lane] = (bf16)f2bf(mine / L * bf2f(y[lane]));
}
__device__ __forceinline__ void ph_attn_naive(Frame& F, int l) {
    const bf16* ZS = (const bf16*)(F.ws + WS_ZS); const bf16* MQ = (const bf16*)(F.ws + WS_MQ); const bf16* MKV = (const bf16*)(F.ws + WS_MKV); const bf16* MK = (const bf16*)(F.ws + WS_MK);
    bf16* Y = (bf16*)(F.ws + WS_G);
    const long nitems = (long)NROWS * 12;
    for (long it = F.gw; it < nitems; it += F.NGW) {
        const int hb = (int)(it % 12); const int row = (int)(it / 12);
        const int b = row / TPB, j = row % TPB; const bool lat = j >= CTXL;
        if (!lat && l == NLAYER - 1) continue;
        const size_t r0 = (size_t)b * TPB;
        const int br = hb >> 2, h = hb & 3;
        bf16* y = Y + (size_t)row * 1024 + br * 256 + h * 64;
        if (br == 0) {
            attn_row_naive<96>(MQ + (size_t)row * 512 + h * 96, MK + r0 * 384 + h * 96, 384, MKV + r0 * 512 + h * 128 + 64, 512, CTXL, CTXL, lat ? TPB : CTXL, false, 0.f, y, F.lane);
        } else if (br == 1) {
            const int t = j - CTXL; int lo = CTXL, hi = CTXL;
            if (lat) { lo = CTXL + (t - 128 < 0 ? 0 : t - 128); hi = CTXL + (t + 128 > SEQ - 1 ? SEQ - 1 : t + 128) + 1; }
            attn_row_naive<64>(ZS + (size_t)row * ZS_P + ZC_SQ + h * 64, ZS + r0 * ZS_P + ZC_SK + (h >> 1) * 64, ZS_P, ZS + r0 * ZS_P + ZC_SV + (h >> 1) * 64, ZS_P, CTXL, lo, hi, true, F.in(I_SINK)[l * 4 + h] * LOG2E, y, F.lane);
        } else {
            attn_row_naive<64>(ZS + (size_t)row * ZS_P + ZC_AQ + h * 64, ZS + r0 * ZS_P + ZC_AK + (h >> 1) * 64, ZS_P, ZS + r0 * ZS_P + ZC_AV + (h >> 1) * 64, ZS_P, CTXL, CTXL, lat ? TPB : CTXL, false, 0.f, y, F.lane);
        }
    }
}

__device__ __forceinline__ void ph_lru_conv(Frame& F, int l) {
    const bf16* ZS = (const bf16*)(F.ws + WS_ZS); float* U = (float*)(F.ws + WS_U);
    const float* cw = F.in(I_CONVW) + l * 4 * 256; const float* cb = F.in(I_CONVB) + l * 256;
    const int gt = F.vcu * NTHREADS + F.tid, ngt = F.G * NTHREADS;
    for (int idx = gt; idx < NROWS * 256; idx += ngt) {
        const int row = idx >> 8, c = idx & 255, b = row / TPB, j = row % TPB;
        int s0, len, jj; if (j < CTXL) { s0 = b * TPB; len = CTXL; jj = j; } else { s0 = b * TPB + CTXL; len = SEQ; jj = j - CTXL; }
        float acc = cb[c];
#pragma unroll
        for (int i = 0; i < 4; ++i) { const int t = jj + i - 2; if (t >= 0 && t < len) acc += cw[i * 256 + c] * bf2f(ZS[(size_t)(s0 + t) * ZS_P + ZC_LRU + c]); }
        U[idx] = acc;
    }
}
__device__ __forceinline__ void ph_lru_scan(Frame& F, int l, int dir) {
    const float* U = (const float*)(F.ws + WS_U); float* HF = (float*)(F.ws + WS_HF); bf16* Y = (bf16*)(F.ws + WS_G);
    const int g = blockIdx.x * NTHREADS + F.tid;
    if (g < NB * 256) {
    const int b = g >> 8, c = g & 255, k = c >> 6, jc = c & 63;
    const float* wr = F.in(I_LWR) + ((((size_t)l * 2 + dir) * 4 + k) * 64) * 64 + jc;
    const float* wi = F.in(I_LWI) + ((((size_t)l * 2 + dir) * 4 + k) * 64) * 64 + jc;
    float wrr[64], wii[64];
#pragma unroll
    for (int i = 0; i < 64; ++i) { wrr[i] = wr[i * 64]; wii[i] = wi[i * 64]; }
    const float br = F.in(I_LBR)[(l * 2 + dir) * 256 + c], bi = F.in(I_LBI)[(l * 2 + dir) * 256 + c];
    const float lam = F.in(I_LAM)[(l * 2 + dir) * 256 + c];
    const float sp = log1pf(expf(-lam));
    float h = 0.f;
    for (int s = 0; s < TPB; ++s) {
        const int j = dir == 0 ? s : (s < CTXL ? CTXL - 1 - s : TPB + CTXL - 1 - s);
        const size_t row = (size_t)b * TPB + j;
        const float* ub = U + row * 256 + k * 64;
        float rp = br, ip = bi;
#pragma unroll
        for (int i = 0; i < 64; ++i) { const float uv = ub[i]; rp += uv * wrr[i]; ip += uv * wii[i]; }
        const float r = 1.0f / (1.0f + expf(-rp)), ig = 1.0f / (1.0f + expf(-ip));
        const float la = -8.0f * r * sp; const float a = expf(la);
        const float bx = sqrtf(-expm1f(2.0f * la)) * (ig * ub[jc]);
        h = a * h + bx;
        if (dir == 0) HF[row * 256 + c] = h;
        else { bf16* y = Y + row * 1024 + 768 + c; *y = (bf16)f2bf((HF[row * 256 + c] + h) * bf2f(*y)); }
    }
    }
}
__device__ __forceinline__ void ph_mixsum_ctx(Frame& F) {
    const bf16* S = (const bf16*)(F.ws + WS_S); bf16* MIX = (bf16*)(F.ws + WS_H);
    const int gt = F.vcu * NTHREADS + F.tid, ngt = F.G * NTHREADS;
    for (int idx = gt; idx < NB * CTXL * 128; idx += ngt) {
        const int r = idx >> 7, c8 = (idx & 127) * 8; const size_t row = (size_t)(r >> 8) * TPB + (r & 255); float s[8] = {0.f, 0.f, 0.f, 0.f, 0.f, 0.f, 0.f, 0.f};
#pragma unroll
        for (int k = 0; k < 4; ++k) { const v4u w = *(const GAS v4u*)(S + row * 4096 + k * 1024 + c8);
            s[0] += bflo(w.x); s[1] += bfhi(w.x); s[2] += bflo(w.y); s[3] += bfhi(w.y); s[4] += bflo(w.z); s[5] += bfhi(w.z); s[6] += bflo(w.w); s[7] += bfhi(w.w); }
        v4u o; o.x = pk2(s[0], s[1]); o.y = pk2(s[2], s[3]); o.z = pk2(s[4], s[5]); o.w = pk2(s[6], s[7]);
        *(GAS v4u*)(MIX + row * 1024 + c8) = o;
    }
}
namespace att {
typedef short bf16x8 __attribute__((ext_vector_type(8)));
typedef short s16x4 __attribute__((ext_vector_type(4)));
typedef short v4i16_t __attribute__((ext_vector_type(4)));
typedef float f32x16 __attribute__((ext_vector_type(16)));
typedef unsigned u32x4 __attribute__((ext_vector_type(4)));
typedef __attribute__((address_space(3))) const char* lds_cptr;
typedef float f32x2_t __attribute__((ext_vector_type(2))); typedef __bf16 bf16x2_t __attribute__((ext_vector_type(2)));
__device__ __forceinline__ int crow(int r, int hi) { return (r & 3) + 8 * (r >> 2) + 4 * hi; }
__device__ __forceinline__ void glds16(const void* gsrc, unsigned lds_dst) { unsigned keep;
    asm volatile("s_mov_b32 %0, m0\n\ts_mov_b32 m0, %2\n\ts_nop 0\n\tglobal_load_lds_dwordx4 %1, off\n\ts_mov_b32 m0, %0" : "=&s"(keep) : "v"(gsrc), "s"(lds_dst) : "memory"); }
__device__ __forceinline__ unsigned cvtpk(float lo, float hi) { f32x2_t v = {lo, hi}; bf16x2_t b = __builtin_convertvector(v, bf16x2_t); return __builtin_bit_cast(unsigned, b); }
__device__ __forceinline__ s16x4 vtr(lds_cptr p) { return __builtin_bit_cast(s16x4, __builtin_amdgcn_ds_read_tr16_b64_v4i16((__attribute__((address_space(3))) v4i16_t*)p)); }
__device__ __forceinline__ float halfswap_max(float m) { auto rr = __builtin_amdgcn_permlane32_swap(__float_as_uint(m), __float_as_uint(m), false, false); return fmaxf(__uint_as_float(rr[0]), __uint_as_float(rr[1])); }
__device__ __forceinline__ float halfswap_sum(float m) { auto rr = __builtin_amdgcn_permlane32_swap(__float_as_uint(m), __float_as_uint(m), false, false); return __uint_as_float(rr[0]) + __uint_as_float(rr[1]); }

template <int DQK> struct Cfg {
    static constexpr int KCH = DQK / 8, KSLOT = KCH * 1024, NKI = (KCH + 7) / 8, NI = NKI + 1;
    static constexpr int LDS_K = 0, LDS_V = 3 * KSLOT, LDS_WS = LDS_V + 3 * 8192, LDS_OST = LDS_WS + 8 * 256, BYTES = LDS_OST + 8 * 4096;
};
#define ATT_WAIT_BAR(N) asm volatile("s_waitcnt vmcnt(" #N ") lgkmcnt(0)\n\ts_barrier" ::: "memory")

struct UnitDesc {
    const unsigned short* Q; int qp;
    const unsigned short* K; int kp;
    const unsigned short* V; int vp;
    unsigned short* Y;
    int NT;
    int lat_row0;
    int qpos0, spos0;
    int has_sink; float sink2;
};

template <int DQK, bool SWA>
__device__ __forceinline__ void attn_unit(LAS unsigned char* ldsb, const UnitDesc& U, const int tid) {
    using C = Cfg<DQK>;
    const int lane = tid & 63, r32 = lane & 31, hi = lane >> 5; const int wid = __builtin_amdgcn_readfirstlane(tid >> 6);
    const unsigned lds0 = (unsigned)(uintptr_t)ldsb;
    LAS float* wsf = (LAS float*)(ldsb + C::LDS_WS) + wid * 64;
    const int kp = U.kp, vp = U.vp;
    const int kc1 = (C::NKI == 2 && wid < 4) ? wid + 8 : wid;
    const unsigned short* ksrc0 = U.K + (size_t)lane * kp + wid * 8;
    const unsigned short* ksrc1 = U.K + (size_t)lane * kp + kc1 * 8;
    const unsigned short* vsrc = U.V + (size_t)(16 * (wid & 3) + (lane >> 2)) * vp + (wid >> 2) * 32 + (lane & 3) * 8;
    const unsigned kdst0 = lds0 + C::LDS_K + wid * 1024, kdst1 = lds0 + C::LDS_K + kc1 * 1024, vdst = lds0 + C::LDS_V + wid * 1024;
    const int NT = U.NT;
#define ATT_KROW(t) (SWA ? ((t) < 4 ? 64 * (t) : U.lat_row0 + 64 * ((t) - 4)) : 64 * (t))
#define ATT_DMA_K(t, slot) do { const size_t ro_ = (size_t)ATT_KROW(t); \
        glds16(ksrc0 + ro_ * kp, (unsigned)__builtin_amdgcn_readfirstlane(kdst0 + (slot) * C::KSLOT)); \
        if (C::NKI == 2) glds16(ksrc1 + ro_ * kp, (unsigned)__builtin_amdgcn_readfirstlane(kdst1 + (slot) * C::KSLOT)); } while (0)
#define ATT_DMA_V(t, slot) do { const size_t ro_ = (size_t)ATT_KROW(t); glds16(vsrc + ro_ * vp, (unsigned)__builtin_amdgcn_readfirstlane(vdst + (slot) * 8192)); } while (0)
#define ATT_KLOAD(kslot) do { if (!SWA) { const lds_cptr kb_ = (lds_cptr)(ldsb + C::LDS_K) + (kslot) * C::KSLOT + hi * 1024 + r32 * 16; \
        _Pragma("unroll") for (int d0 = 0; d0 < DQK / 16; ++d0) { kf[2 * d0] = *(const __attribute__((address_space(3))) bf16x8*)(kb_ + d0 * 2048); kf[2 * d0 + 1] = *(const __attribute__((address_space(3))) bf16x8*)(kb_ + d0 * 2048 + 512); } } } while (0)
#define ATT_QKM(P0, P1, CINIT, kslot) do { P0 = f32x16{}; P1 = f32x16{}; \
        const lds_cptr kq_ = (lds_cptr)(ldsb + C::LDS_K) + (kslot) * C::KSLOT + hi * 1024 + r32 * 16; \
        _Pragma("unroll") for (int d0 = 0; d0 < DQK / 16; ++d0) { \
            const bf16x8 b0_ = SWA ? *(const __attribute__((address_space(3))) bf16x8*)(kq_ + d0 * 2048) : kf[2 * d0]; const bf16x8 b1_ = SWA ? *(const __attribute__((address_space(3))) bf16x8*)(kq_ + d0 * 2048 + 512) : kf[2 * d0 + 1]; \
            P0 = __builtin_amdgcn_mfma_f32_32x32x16_bf16(b0_, qr[d0], P0, 0, 0, 0); P1 = __builtin_amdgcn_mfma_f32_32x32x16_bf16(b1_, qr[d0], P1, 0, 0, 0); } } while (0)
#define ATT_VLOAD(vslot) do { if (!SWA) { const lds_cptr vb_ = (lds_cptr)(ldsb + C::LDS_V) + (vslot) * 8192 + ((lane >> 4) & 1) * 32 + (lane & 3) * 8 + (4 * hi + ((lane & 15) >> 2)) * 64; \
        _Pragma("unroll") for (int i = 0; i < 8; ++i) { vl[i] = vtr(vb_ + (i >> 2) * 4096 + (i & 3) * 1024); vh[i] = vtr(vb_ + (i >> 2) * 4096 + (i & 3) * 1024 + 512); } } } while (0)
#define ATT_MX3(a, b, c) __builtin_fmaxf(__builtin_fmaxf((a), (b)), (c))
#define ATT_NEEDMASK(j) ((j) >= 4 && U.qpos0 >= 0 && !((U.spos0 + 64 * ((j) - 4) + 63 - (U.qpos0 + 32 * wid) <= 128) && ((U.qpos0 + 32 * wid + 31) - (U.spos0 + 64 * ((j) - 4)) <= 128)))
#define ATT_SMPV(P0, P1, N0, N1, HASNEXT, t, vslot) do { \
        if (SWA && ATT_NEEDMASK(t)) { const bool mk_ = true; const int sb_ = U.spos0 + 64 * ((t) - 4) + 4 * hi;        \
            _Pragma("unroll") for (int r = 0; r < 16; ++r) { const int dd_ = qpos - (sb_ + (r & 3) + 8 * (r >> 2)); \
                P0[r] = (mk_ && (dd_ > 128 || dd_ < -128)) ? -INFINITY : P0[r]; P1[r] = (mk_ && (dd_ - 32 > 128 || dd_ - 32 < -128)) ? -INFINITY : P1[r]; } } \
        float ls_ = 0.f; \
        _Pragma("unroll") for (int r = 0; r < 16; ++r) { P0[r] = __builtin_amdgcn_exp2f(P0[r]); P1[r] = __builtin_amdgcn_exp2f(P1[r]); ls_ += P0[r] + P1[r]; } \
        l += ls_; \
        if (!SWA && DQK != 64) { __builtin_amdgcn_sched_barrier(0); ATT_VLOAD(vslot); } \
        u32x4 pw_[4]; \
        pw_[0] = (u32x4){cvtpk(P0[0], P0[1]), cvtpk(P0[2], P0[3]), cvtpk(P0[4], P0[5]), cvtpk(P0[6], P0[7])}; \
        pw_[1] = (u32x4){cvtpk(P0[8], P0[9]), cvtpk(P0[10], P0[11]), cvtpk(P0[12], P0[13]), cvtpk(P0[14], P0[15])}; \
        pw_[2] = (u32x4){cvtpk(P1[0], P1[1]), cvtpk(P1[2], P1[3]), cvtpk(P1[4], P1[5]), cvtpk(P1[6], P1[7])}; \
        pw_[3] = (u32x4){cvtpk(P1[8], P1[9]), cvtpk(P1[10], P1[11]), cvtpk(P1[12], P1[13]), cvtpk(P1[14], P1[15])}; \
        const lds_cptr vq_ = (lds_cptr)(ldsb + C::LDS_V) + (vslot) * 8192 + ((lane >> 4) & 1) * 32 + (lane & 3) * 8 + (4 * hi + ((lane & 15) >> 2)) * 64; \
        _Pragma("unroll") for (int d0 = 0; d0 < 2; ++d0) \
            _Pragma("unroll") for (int ks = 0; ks < 4; ++ks) { \
                const s16x4 lo_ = SWA ? vtr(vq_ + d0 * 4096 + ks * 1024) : vl[4 * d0 + ks], hh_ = SWA ? vtr(vq_ + d0 * 4096 + ks * 1024 + 512) : vh[4 * d0 + ks]; \
                const bf16x8 vf_ = (bf16x8){lo_[0], lo_[1], lo_[2], lo_[3], hh_[0], hh_[1], hh_[2], hh_[3]}; \
                o[d0] = __builtin_amdgcn_mfma_f32_32x32x16_bf16(__builtin_bit_cast(bf16x8, pw_[ks]), vf_, o[d0], 0, 0, 0); } } while (0)
#define ATT_SKIP(j) (SWA && (j) >= 4 && U.qpos0 >= 0 && ((U.spos0 + 64 * ((j) - 4) > U.qpos0 + 32 * wid + 31 + 128) || (U.spos0 + 64 * ((j) - 4) + 63 < U.qpos0 + 32 * wid - 128)))
#define ATT_STEP(C0, C1, N0, N1, t) do { \
        const int k3_ = (ks1 == 0) ? 2 : ks1 - 1, v2_ = (vs0 == 0) ? 2 : vs0 - 1; \
        if ((t) + 3 < NT) ATT_DMA_K((t) + 3, k3_); \
        if ((t) + 2 < NT) ATT_DMA_V((t) + 2, v2_); \
        ATT_KLOAD(ks1); \
        if (!SWA) __builtin_amdgcn_sched_barrier(0);        \
        if (!SWA || !ATT_SKIP((t) + 1)) ATT_QKM(N0, N1, -m, ks1); \
        if (DQK == 64) ATT_VLOAD(vs0);        \
        if (!SWA) __builtin_amdgcn_sched_barrier(0); \
        if (!SWA || !ATT_SKIP(t)) ATT_SMPV(C0, C1, N0, N1, true, t, vs0); \
        if ((t) + 3 < NT) { if (C::NI == 2) ATT_WAIT_BAR(2); else ATT_WAIT_BAR(3); } else ATT_WAIT_BAR(0); \
        ks1 = (ks1 == 2) ? 0 : ks1 + 1; vs0 = (vs0 == 2) ? 0 : vs0 + 1; } while (0)
    ATT_DMA_K(0, 0);
    ATT_DMA_K(1, 1); ATT_DMA_V(0, 0);
    ATT_DMA_K(2, 2); ATT_DMA_V(1, 1);
    bf16x8 qr[DQK / 16];
    { const unsigned short* qw = U.Q + (size_t)(wid * 32 + r32) * U.qp + hi * 8;
#pragma unroll
      for (int d0 = 0; d0 < DQK / 16; ++d0) qr[d0] = *(const bf16x8*)(qw + d0 * 16); }
    const float m = 0.f; float l = 0.f;
    f32x16 o[2]; o[0] = f32x16{}; o[1] = f32x16{};
    const int qpos = U.qpos0 + wid * 32 + r32;
    f32x16 pa0, pa1, pb0, pb1;
    bf16x8 kf[DQK / 8]; s16x4 vl[8], vh[8];
    if (C::NI == 2) ATT_WAIT_BAR(4); else ATT_WAIT_BAR(6);
    ATT_KLOAD(0); ATT_QKM(pa0, pa1, 0.f, 0);
    if (C::NI == 2) ATT_WAIT_BAR(2); else ATT_WAIT_BAR(3);
    int ks1 = 1, vs0 = 0;
    int t = 0;
    if (SWA) { for (; t + 1 < NT; ++t) { ATT_STEP(pa0, pa1, pb0, pb1, t); pa0 = pb0; pa1 = pb1; } if (!ATT_SKIP(NT - 1)) ATT_SMPV(pa0, pa1, pa0, pa1, false, NT - 1, vs0); }
    else {
    for (; t + 2 < NT; t += 2) { ATT_STEP(pa0, pa1, pb0, pb1, t); ATT_STEP(pb0, pb1, pa0, pa1, t + 1); }
    if (t + 1 < NT) { ATT_STEP(pa0, pa1, pb0, pb1, t); if (DQK == 64) ATT_VLOAD(vs0); ATT_SMPV(pb0, pb1, pb0, pb1, false, NT - 1, vs0); }
    else { if (DQK == 64) ATT_VLOAD(vs0); ATT_SMPV(pa0, pa1, pa0, pa1, false, NT - 1, vs0); }
    }
    l = halfswap_sum(l);
    if (U.has_sink) l += __builtin_amdgcn_exp2f(U.sink2 - m);
    if (hi == 0) wsf[32 + r32] = l;
    asm volatile("s_waitcnt lgkmcnt(0)" ::: "memory");
    { LAS unsigned short* stg = (LAS unsigned short*)(ldsb + C::LDS_OST) + wid * 2048;
#pragma unroll
      for (int r = 0; r < 16; ++r) { const int orow = crow(r, hi); const float rl = __builtin_amdgcn_rcpf(wsf[32 + orow]);
          stg[orow * 64 + r32] = (unsigned short)f2bf(o[0][r] * rl); stg[orow * 64 + 32 + r32] = (unsigned short)f2bf(o[1][r] * rl); }
      asm volatile("s_waitcnt lgkmcnt(0)" ::: "memory");
      unsigned short* yw = U.Y + (size_t)(wid * 32) * 1024;
#pragma unroll
      for (int i = 0; i < 4; ++i) { const int row = i * 8 + (lane >> 3), ch = lane & 7;
          const u32x4 ov = *(const LAS u32x4*)(stg + row * 64 + ch * 8);
          u32x4* gp = (u32x4*)(yw + (size_t)row * 1024 + ch * 8); const u32x4 g = *gp;
          u32x4 w; w.x = pk2(bflo(ov.x) * bflo(g.x), bfhi(ov.x) * bfhi(g.x)); w.y = pk2(bflo(ov.y) * bflo(g.y), bfhi(ov.y) * bfhi(g.y));
          w.z = pk2(bflo(ov.z) * bflo(g.z), bfhi(ov.z) * bfhi(g.z)); w.w = pk2(bflo(ov.w) * bflo(g.w), bfhi(ov.w) * bfhi(g.w));
          *gp = w; } }
    asm volatile("s_waitcnt vmcnt(0) lgkmcnt(0)\n\ts_barrier" ::: "memory");
#undef ATT_KROW
#undef ATT_DMA_K
#undef ATT_DMA_V
#undef ATT_KLOAD
#undef ATT_QKM
#undef ATT_VLOAD
#undef ATT_STEP
#undef ATT_SKIP
#undef ATT_SMPV
#undef ATT_MX3
#undef ATT_NEEDMASK
}
}

__device__ __forceinline__ void ph_attn(Frame& F, int l) {
    unsigned short* ZS = (unsigned short*)(F.ws + WS_ZS); unsigned short* MQ = (unsigned short*)(F.ws + WS_MQ); unsigned short* MKV = (unsigned short*)(F.ws + WS_MKV); unsigned short* MK = (unsigned short*)(F.ws + WS_MK);
    unsigned short* Y = (unsigned short*)(F.ws + WS_G);
    LAS unsigned char* lds = F.lds + RING_OFF;
    const int u = F.vcu;
    const bool ctxq = (l == 0);
    for (int uu = u; uu < 256; uu += F.G) { const int bh = uu >> 4, qb = uu & 15, b = bh >> 2, h = bh & 3; const size_t r0 = (size_t)b * TPB, rq = r0 + CTXL + qb * 256;
        att::UnitDesc U{MQ + rq * 512 + h * 96, 512, MK + r0 * 384 + h * 96, 384, MKV + r0 * 512 + h * 128 + 64, 512, Y + rq * 1024 + h * 64, TPB / 64, 0, -1, 0, 0, 0.f};
        att::attn_unit<96, false>(lds, U, F.tid); }
    for (int uu = u; uu < 256; uu += F.G) { const int qb = uu & 15, g = (uu >> 4) & 1, kvh = (uu >> 5) & 1, b = uu >> 6, qh = kvh * 2 + g; const size_t r0 = (size_t)b * TPB, rq = r0 + CTXL + qb * 256;
        att::UnitDesc U{ZS + rq * ZS_P + ZC_AQ + qh * 64, ZS_P, ZS + r0 * ZS_P + ZC_AK + kvh * 64, ZS_P, ZS + r0 * ZS_P + ZC_AV + kvh * 64, ZS_P, Y + rq * 1024 + 512 + qh * 64, TPB / 64, 0, -1, 0, 0, 0.f};
        att::attn_unit<64, false>(lds, U, F.tid); }
    for (int uu = u; uu < 256; uu += F.G) { const int qb = uu & 15, g = (uu >> 4) & 1, kvh = (uu >> 5) & 1, b = uu >> 6, qh = kvh * 2 + g; const size_t r0 = (size_t)b * TPB, rq = r0 + CTXL + qb * 256;
        const int q0 = qb * 256, s0 = (q0 - 128 < 0) ? 0 : q0 - 128, s1 = (q0 + 384 > SEQ) ? SEQ : q0 + 384;
        att::UnitDesc U{ZS + rq * ZS_P + ZC_SQ + qh * 64, ZS_P, ZS + r0 * ZS_P + ZC_SK + kvh * 64, ZS_P, ZS + r0 * ZS_P + ZC_SV + kvh * 64, ZS_P, Y + rq * 1024 + 256 + qh * 64, 4 + (s1 - s0) / 64, CTXL + s0, q0, s0, 1, F.in(I_SINK)[l * 4 + qh] * LOG2E};
        att::attn_unit<64, true>(lds, U, F.tid); }
    if (ctxq) for (int uu = u; uu < 48; uu += F.G) { const int br = uu >> 4, b = (uu >> 2) & 3, h = uu & 3; const size_t r0 = (size_t)b * TPB;
        if (br == 0) { att::UnitDesc U{MQ + r0 * 512 + h * 96, 512, MK + r0 * 384 + h * 96, 384, MKV + r0 * 512 + h * 128 + 64, 512, Y + r0 * 1024 + h * 64, 4, 0, -1, 0, 0, 0.f};
            att::attn_unit<96, false>(lds, U, F.tid); }
        else if (br == 1) { att::UnitDesc U{ZS + r0 * ZS_P + ZC_SQ + h * 64, ZS_P, ZS + r0 * ZS_P + ZC_SK + (h >> 1) * 64, ZS_P, ZS + r0 * ZS_P + ZC_SV + (h >> 1) * 64, ZS_P, Y + r0 * 1024 + 256 + h * 64, 4, CTXL, -1, 0, 1, F.in(I_SINK)[l * 4 + h] * LOG2E};
            att::attn_unit<64, true>(lds, U, F.tid); }
        else { att::UnitDesc U{ZS + r0 * ZS_P + ZC_AQ + h * 64, ZS_P, ZS + r0 * ZS_P + ZC_AK + (h >> 1) * 64, ZS_P, ZS + r0 * ZS_P + ZC_AV + (h >> 1) * 64, ZS_P, Y + r0 * 1024 + 512 + h * 64, 4, 0, -1, 0, 0, 0.f};
            att::attn_unit<64, false>(lds, U, F.tid); } }
}
constexpr size_t WS_SUM = 253 * MiB;
constexpr size_t WS_HL = WS_U, WS_CP = WS_HF;
constexpr int NCHUNK = TPB / 64;
__device__ __forceinline__ float swap_lo(float x) { auto rr = __builtin_amdgcn_permlane32_swap(__float_as_uint(x), __float_as_uint(x), false, false); return __uint_as_float(rr[0]); }
__device__ __forceinline__ float swap_hi(float x) { auto rr = __builtin_amdgcn_permlane32_swap(__float_as_uint(x), __float_as_uint(x), false, false); return __uint_as_float(rr[1]); }
__device__ __forceinline__ void ph_lru1(Frame& F, int l) {
    typedef short bf16x8 __attribute__((ext_vector_type(8))); typedef float f32x16 __attribute__((ext_vector_type(16)));
    const unsigned short* ZS = (const unsigned short*)(F.ws + WS_ZS); unsigned short* HL = (unsigned short*)(F.ws + WS_HL); unsigned short* CP = (unsigned short*)(F.ws + WS_CP);
    f32x2v* SUM = (f32x2v*)(F.ws + WS_SUM);
    constexpr int UP = 264;
    LAS unsigned short* ul = (LAS unsigned short*)(F.lds + RING_OFF);
    const float* cw = F.in(I_CONVW) + l * 4 * 256; const float* cb = F.in(I_CONVB) + l * 256;
    const int tid = F.tid, lane = tid & 63, r32 = lane & 31, hi = lane >> 5, k = F.wave & 3, d = F.wave >> 2;
    const int nfull = (NB * NCHUNK < F.G) ? NB * NCHUNK : F.G, nhalf = 2 * (NB * NCHUNK - nfull);
    for (int wi = F.vcu; wi < nfull + nhalf; wi += F.G) {
        const int unit = (wi < nfull) ? wi : nfull + ((wi - nfull) >> 1);
        const int tn_lo = (wi < nfull) ? 0 : ((wi - nfull) & 1), tn_hi = (wi < nfull) ? 2 : tn_lo + 1;
        const int b = unit / NCHUNK, ci = unit % NCHUNK;
        int s0row, len, t0; if (ci < 4) { s0row = b * TPB; len = CTXL; t0 = ci * 64; } else { s0row = b * TPB + CTXL; len = SEQ; t0 = (ci - 4) * 64; }
        { const int cc = tid & 255, hh = tid >> 8; float zv[35];
#pragma unroll
          for (int i = 0; i < 35; ++i) { const int tt = t0 + hh * 32 + i - 2; const int tc = tt < 0 ? 0 : (tt >= len ? len - 1 : tt);
              const float v = bf2f(ZS[(size_t)(s0row + tc) * ZS_P + ZC_LRU + cc]); zv[i] = (tt >= 0 && tt < len) ? v : 0.f; }
          const float w0 = cw[cc], w1 = cw[256 + cc], w2 = cw[512 + cc], w3 = cw[768 + cc], bb = cb[cc];
#pragma unroll
          for (int t = 0; t < 32; ++t) ul[(hh * 32 + t) * UP + cc] = (unsigned short)f2bf(bb + w0 * zv[t] + w1 * zv[t + 1] + w2 * zv[t + 2] + w3 * zv[t + 3]); }
        __syncthreads();
#pragma unroll 1
        for (int tn = tn_lo; tn < tn_hi; ++tn) {
            const int c = k * 64 + 32 * tn + r32;
            bf16x8 wf[2][4];
            const float brv = F.in(I_LBR)[(l * 2 + d) * 256 + c], biv = F.in(I_LBI)[(l * 2 + d) * 256 + c], spv = ((const float*)(F.ws + WS_SP))[(l * 2 + d) * 256 + c];
#pragma unroll
            for (int gate = 0; gate < 2; ++gate)
#pragma unroll
                for (int ks = 0; ks < 4; ++ks) { const float* src = (const float*)(F.ws + WS_LWT) + ((((size_t)l * 2 + d) * 2 + gate) * 256 + c) * 64 + 16 * ks + 8 * hi;
                    const f32x4 a = *(const f32x4*)src, b2 = *(const f32x4*)(src + 4);
                    v4u w; w.x = pk2(a.x, a.y); w.y = pk2(a.z, a.w); w.z = pk2(b2.x, b2.y); w.w = pk2(b2.z, b2.w); wf[gate][ks] = __builtin_bit_cast(bf16x8, w); }
            f32x16 A[2], X[2];
            A[0] = f32x16{}; A[1] = f32x16{}; X[0] = f32x16{}; X[1] = f32x16{};
#pragma unroll
            for (int tm = 0; tm < 2; ++tm)
#pragma unroll
                for (int ks = 0; ks < 4; ++ks) { const bf16x8 af = *(const LAS bf16x8*)(ul + (32 * tm + r32) * UP + k * 64 + 16 * ks + 8 * hi);
                    A[tm] = __builtin_amdgcn_mfma_f32_32x32x16_bf16(af, wf[0][ks], A[tm], 0, 0, 0); X[tm] = __builtin_amdgcn_mfma_f32_32x32x16_bf16(af, wf[1][ks], X[tm], 0, 0, 0); }
#pragma unroll
            for (int tm = 0; tm < 2; ++tm)
#pragma unroll
                for (int r = 0; r < 16; ++r) { const int tok = 32 * tm + (r & 3) + 8 * (r >> 2) + 4 * hi; const float uu = bf2f(ul[tok * UP + c]);
                    const float rr = sigmoid_f(A[tm][r] + brv), ii = sigmoid_f(X[tm][r] + biv);
                    const float a = __builtin_amdgcn_exp2f(-rr * spv); A[tm][r] = a; X[tm][r] = __builtin_amdgcn_sqrtf(1.0f - a * a) * (ii * uu);
                    if ((r & 3) == 3) asm volatile("" ::: "memory"); }
#pragma unroll
            for (int tm = 0; tm < 2; ++tm)
#pragma unroll
                for (int rg = 0; rg < 4; ++rg) { const int r0 = 4 * rg;
                    if (d == 0) {
#pragma unroll
                        for (int e2 = 1; e2 < 4; ++e2) { X[tm][r0 + e2] = A[tm][r0 + e2] * X[tm][r0 + e2 - 1] + X[tm][r0 + e2]; A[tm][r0 + e2] = A[tm][r0 + e2] * A[tm][r0 + e2 - 1]; } }
                    else {
#pragma unroll
                        for (int e2 = 2; e2 >= 0; --e2) { X[tm][r0 + e2] = A[tm][r0 + e2] * X[tm][r0 + e2 + 1] + X[tm][r0 + e2]; A[tm][r0 + e2] = A[tm][r0 + e2] * A[tm][r0 + e2 + 1]; } } }
            float enH[8], enP[8]; float EH = 0.f, EP = 1.f;
            if (d == 0) {
#pragma unroll
                for (int q = 0; q < 8; ++q) { const int tm = q >> 2, re = 4 * (q & 3) + 3; const float ce = A[tm][re], he = X[tm][re];
                    const float aH = swap_lo(ce * EH + he), aP = swap_lo(EP * ce);
                    const float E1H = hi ? aH : EH, E1P = hi ? aP : EP;
                    enH[q] = E1H; enP[q] = E1P;
                    EH = swap_hi(ce * E1H + he); EP = swap_hi(E1P * ce); }
            } else {
#pragma unroll
                for (int q = 7; q >= 0; --q) { const int tm = q >> 2, re = 4 * (q & 3); const float ce = A[tm][re], he = X[tm][re];
                    const float aH = swap_hi(ce * EH + he), aP = swap_hi(EP * ce);
                    const float E1H = hi ? EH : aH, E1P = hi ? EP : aP;
                    enH[q] = E1H; enP[q] = E1P;
                    EH = swap_lo(ce * E1H + he); EP = swap_lo(E1P * ce); }
            }
            { const unsigned ob = (unsigned)((((s0row + t0 + 4 * hi) * 2 + d) * 256 + c) * 2);
#pragma unroll
              for (int tm = 0; tm < 2; ++tm)
#pragma unroll
                for (int rg = 0; rg < 4; ++rg) { const int q = 4 * tm + rg;
#pragma unroll
                    for (int e2 = 0; e2 < 4; ++e2) { const int r = 4 * rg + e2; const unsigned o = ob + (unsigned)(32 * tm + 8 * rg + e2) * 1024u;
                        *(unsigned short*)((char*)HL + o) = (unsigned short)f2bf(X[tm][r] + A[tm][r] * enH[q]); *(unsigned short*)((char*)CP + o) = (unsigned short)f2bf(A[tm][r] * enP[q]); }
                    asm volatile("" ::: "memory"); } }
            if (hi == 0) SUM[((size_t)(b * NCHUNK + ci) * 2 + d) * 256 + c] = (f32x2v){EP, EH};
        }
        __syncthreads();
    }
}
constexpr size_t WS_CARRY = 255 * MiB;
__device__ __forceinline__ void ph_lru_carry(Frame& F) {
    if (F.vcu < 4) {
        const int g = F.vcu * NTHREADS + F.tid, b = g >> 9, d = (g >> 8) & 1, c = g & 255;
        const f32x2v* sb = (const f32x2v*)(F.ws + WS_SUM) + ((size_t)b * NCHUNK * 2 + d) * 256 + c;
        float* cr = (float*)(F.ws + WS_CARRY) + ((size_t)b * NCHUNK * 2 + d) * 256 + c;
        float h = 0.f;
#pragma unroll 1
        for (int p0 = 0; p0 < NCHUNK; p0 += 17) {
            f32x2v s[17];
#pragma unroll
            for (int i = 0; i < 17; ++i) { const int p = p0 + i, j = (d == 0) ? p : (p < 4 ? 3 - p : NCHUNK + 3 - p); s[i] = sb[(size_t)j * 512]; }
#pragma unroll
            for (int i = 0; i < 17; ++i) { const int p = p0 + i, j = (d == 0) ? p : (p < 4 ? 3 - p : NCHUNK + 3 - p); cr[(size_t)j * 512] = h; h = s[i].x * h + s[i].y; }
        }
    }
}
__device__ __forceinline__ void ph_lru2(Frame& F, int l) {
    const unsigned short* HL = (const unsigned short*)(F.ws + WS_HL); const unsigned short* CP = (const unsigned short*)(F.ws + WS_CP);
    const float* CARRY = (const float*)(F.ws + WS_CARRY); unsigned short* Y = (unsigned short*)(F.ws + WS_G);
    const int tid = F.tid, cg = tid & 31, tq = tid >> 5; const bool last = (l == NLAYER - 1);
    for (int unit = F.vcu; unit < NB * NCHUNK; unit += F.G) {
        const int b = unit / NCHUNK, ci = unit % NCHUNK;
        if (last && ci < 4) continue;
        const float* cp0 = CARRY + ((size_t)(b * NCHUNK + ci) * 2) * 256 + cg * 8;
        const f32x4 cfa = *(const f32x4*)cp0, cfb = *(const f32x4*)(cp0 + 4), cba = *(const f32x4*)(cp0 + 256), cbb = *(const f32x4*)(cp0 + 260);
        const float cf[8] = {cfa.x, cfa.y, cfa.z, cfa.w, cfb.x, cfb.y, cfb.z, cfb.w}, cbk[8] = {cba.x, cba.y, cba.z, cba.w, cbb.x, cbb.y, cbb.z, cbb.w};
        v4u hf[4], pf[4], hb[4], pb[4], gg[4];
#pragma unroll
        for (int i = 0; i < 4; ++i) { const size_t row = (size_t)b * TPB + ci * 64 + tq + 16 * i; const size_t o = (row * 2) * 256 + cg * 8;
            hf[i] = *(const v4u*)(HL + o); pf[i] = *(const v4u*)(CP + o); hb[i] = *(const v4u*)(HL + o + 256); pb[i] = *(const v4u*)(CP + o + 256); gg[i] = *(const v4u*)(Y + row * 1024 + 768 + cg * 8); }
#pragma unroll
        for (int i = 0; i < 4; ++i) { const size_t row = (size_t)b * TPB + ci * 64 + tq + 16 * i;
            unsigned w[4];
#pragma unroll
            for (int e = 0; e < 4; ++e) { const unsigned a = hf[i][e], p = pf[i][e], a2 = hb[i][e], p2 = pb[i][e], g = gg[i][e];
                const float v0 = (bflo(a) + bflo(p) * cf[2 * e] + bflo(a2) + bflo(p2) * cbk[2 * e]) * bflo(g);
                const float v1 = (bfhi(a) + bfhi(p) * cf[2 * e + 1] + bfhi(a2) + bfhi(p2) * cbk[2 * e + 1]) * bfhi(g);
                w[e] = pk2(v0, v1); }
            *(v4u*)(Y + row * 1024 + 768 + cg * 8) = (v4u){w[0], w[1], w[2], w[3]}; }
    }
}
namespace pgx {
typedef short bf16x8 __attribute__((ext_vector_type(8)));
typedef float f32x4 __attribute__((ext_vector_type(4)));
typedef unsigned u32x4 __attribute__((ext_vector_type(4)));
typedef unsigned u32x2 __attribute__((ext_vector_type(2)));
constexpr int OPB = 16384;
template <int VAR> __device__ __forceinline__ void pgx_unit(LAS unsigned char* lds, const unsigned short* Y, const unsigned short* Wb, const unsigned short* S, unsigned short* MIX, int row0, int n0, int tid) {
    const int lane = tid & 63, wid = __builtin_amdgcn_readfirstlane(tid >> 6), wm = wid & 3, wn = wid >> 2, fr = lane & 15, fq = lane >> 4;
    const int sr0 = tid >> 3, sk = (tid & 7) * 8;
    const unsigned short* ysrc = Y + (size_t)(row0 + sr0) * 1024 + sk;
    const unsigned short* wsrc = Wb + (size_t)(n0 + sr0) * 256 + sk;
    const int ldst = (tid & 7) * 2048 + (sr0 & ~15) * 16 + (((sr0 & 15) ^ (tid & 7)) << 4);
    const int wrow = (sr0 & ~63) | (((sr0 >> 2) & 3) << 4) | (((sr0 >> 4) & 3) << 2) | (sr0 & 3);
    const int ldstw = (tid & 7) * 2048 + (wrow & ~15) * 16 + (((wrow & 15) ^ (tid & 7)) << 4);
    f32x4 acc[2][4], mix[2][4];
#pragma unroll
    for (int a = 0; a < 2; ++a)
#pragma unroll
        for (int b = 0; b < 4; ++b) { acc[a][b] = (f32x4){0.f, 0.f, 0.f, 0.f}; mix[a][b] = (f32x4){0.f, 0.f, 0.f, 0.f}; }
    u32x4 st[4][4];
    const unsigned short* yA = ysrc; const unsigned short* yB = ysrc + 64 * 1024;
    const unsigned short* wA = wsrc; const unsigned short* wB = wsrc + 64 * 256;
    const unsigned short* sp0 = S + (size_t)(row0 + 32 * wm + fr) * 4096 + n0 + 64 * wn + 16 * fq; const unsigned short* sp1 = sp0 + (size_t)16 * 4096;
#define PGX_LOADQ(set_, yo_, wp0_, wp1_, wo_) do { if (VAR == 2) { st[set_][0] = *(const u32x4*)(ysrc); st[set_][1] = *(const u32x4*)(ysrc + 64 * 1024); st[set_][2] = *(const u32x4*)(wsrc); st[set_][3] = *(const u32x4*)(wsrc + 64 * 256); } else if (VAR == 4) { st[set_][0] = st[set_][1] = st[set_][2] = st[set_][3] = (u32x4){1u,2u,3u,4u}; asm volatile("" : "+v"(st[set_][0]), "+v"(st[set_][1]), "+v"(st[set_][2]), "+v"(st[set_][3])); } else { st[set_][0] = *(const u32x4*)(yA + (yo_)); st[set_][1] = *(const u32x4*)(yB + (yo_)); st[set_][2] = *(const u32x4*)((wp0_) + (wo_)); st[set_][3] = *(const u32x4*)((wp1_) + (wo_)); } } while (0)
#define PGX_STORE(buf_, set_) do { LAS unsigned char* b_ = lds + (buf_) * 2 * OPB + ldst; \
        *(LAS u32x4*)b_ = st[set_][0]; *(LAS u32x4*)(b_ + 1024) = st[set_][1]; *(LAS u32x4*)(b_ - ldst + OPB + ldstw) = st[set_][2]; *(LAS u32x4*)(b_ - ldst + OPB + ldstw + 1024) = st[set_][3]; } while (0)
    u32x4 sga[2][2], sgb[2][2];
#define PGX_SLOAD(dst_, off_) do { if (VAR == 1 || VAR == 4) { dst_[0][0] = dst_[0][1] = dst_[1][0] = dst_[1][1] = (u32x4){0x3f803f80u, 0x3f803f80u, 0x3f803f80u, 0x3f803f80u}; } \
        else { dst_[0][0] = *(const u32x4*)(sp0 + (off_)); dst_[0][1] = *(const u32x4*)(sp0 + (off_) + 8); dst_[1][0] = *(const u32x4*)(sp1 + (off_)); dst_[1][1] = *(const u32x4*)(sp1 + (off_) + 8); } } while (0)
    PGX_SLOAD(sga, 0);
    PGX_LOADQ(0, 0, wA, wB, 0); PGX_LOADQ(1, 64, wA, wB, 64); PGX_LOADQ(2, 128, wA, wB, 128);
    PGX_STORE(0, 0);
    __syncthreads();
#define PGX_COMPUTE(h_) do { const LAS unsigned char* yb = lds + ((h_) & 1) * 2 * OPB + 32 * wm * 16; const LAS unsigned char* wb = lds + ((h_) & 1) * 2 * OPB + OPB + 64 * wn * 16; \
          _Pragma("unroll") for (int ks = 0; ks < 2; ++ks) { const int fo_ = (4 * ks + fq) * 2048 + ((fr ^ (4 * ks + fq)) << 4); \
              bf16x8 yf[2], wf[4]; \
              _Pragma("unroll") for (int tt = 0; tt < 2; ++tt) yf[tt] = *(const LAS bf16x8*)(yb + fo_ + tt * 256); \
              _Pragma("unroll") for (int nt = 0; nt < 4; ++nt) wf[nt] = *(const LAS bf16x8*)(wb + fo_ + nt * 256); \
              _Pragma("unroll") for (int tt = 0; tt < 2; ++tt) \
                  _Pragma("unroll") for (int nt = 0; nt < 4; ++nt) acc[tt][nt] = __builtin_amdgcn_mfma_f32_16x16x32_bf16(wf[nt], yf[tt], acc[tt][nt], 0, 0, 0); } } while (0)
#pragma unroll 1
    for (int kk = 0; kk < 4; ++kk) {
        const bool more = kk < 3;
        const unsigned short* wnA = more ? wA + (size_t)1024 * 256 : wsrc; const unsigned short* wnB = more ? wB + (size_t)1024 * 256 : wsrc + 64 * 256;
        const int yo = more ? 256 : -768;
        PGX_SLOAD(sgb, more ? 1024 : 0);
        PGX_LOADQ(3, 192, wA, wB, 192); PGX_COMPUTE(0); PGX_STORE(1, 1); __syncthreads();
        PGX_LOADQ(0, yo, wnA, wnB, 0); PGX_COMPUTE(1); PGX_STORE(0, 2); __syncthreads();
        PGX_LOADQ(1, yo + 64, wnA, wnB, 64); PGX_COMPUTE(2); PGX_STORE(1, 3); __syncthreads();
        PGX_LOADQ(2, yo + 128, wnA, wnB, 128); PGX_COMPUTE(3);
#pragma unroll
        for (int tt = 0; tt < 2; ++tt)
#pragma unroll
            for (int nt = 0; nt < 4; ++nt) { const u32x4 gv = sga[tt][nt >> 1]; const unsigned g0 = (nt & 1) ? gv.z : gv.x, g1 = (nt & 1) ? gv.w : gv.y; const f32x4 a = acc[tt][nt];
                mix[tt][nt] += (f32x4){a[0] * bflo(g0), a[1] * bfhi(g0), a[2] * bflo(g1), a[3] * bfhi(g1)}; acc[tt][nt] = (f32x4){0.f, 0.f, 0.f, 0.f}; }
#pragma unroll
        for (int tt = 0; tt < 2; ++tt) { sga[tt][0] = sgb[tt][0]; sga[tt][1] = sgb[tt][1]; }
        if (more) PGX_STORE(0, 0);
        __syncthreads();
        yA += 256; yB += 256; wA = wnA; wB = wnB; sp0 += 1024; sp1 += 1024;
    }
#pragma unroll
    for (int tt = 0; tt < 2; ++tt) { unsigned short* mp = MIX + (size_t)(row0 + 32 * wm + 16 * tt + fr) * 1024 + n0 + 64 * wn + 16 * fq;
        u32x4 w0, w1; w0.x = pk2(mix[tt][0][0], mix[tt][0][1]); w0.y = pk2(mix[tt][0][2], mix[tt][0][3]); w0.z = pk2(mix[tt][1][0], mix[tt][1][1]); w0.w = pk2(mix[tt][1][2], mix[tt][1][3]);
        w1.x = pk2(mix[tt][2][0], mix[tt][2][1]); w1.y = pk2(mix[tt][2][2], mix[tt][2][3]); w1.z = pk2(mix[tt][3][0], mix[tt][3][1]); w1.w = pk2(mix[tt][3][2], mix[tt][3][3]);
        *(u32x4*)mp = w0; *(u32x4*)(mp + 8) = w1; }
#undef PGX_LOADQ
#undef PGX_SLOAD
#undef PGX_STORE
#undef PGX_COMPUTE
}
}
template <int VAR> __device__ __forceinline__ void ph_pgx(Frame& F, int l) {
    const unsigned short* Y = (const unsigned short*)(F.ws + WS_G); const unsigned short* S = (const unsigned short*)(F.ws + WS_S); unsigned short* MIX = (VAR == 0) ? (unsigned short*)(F.ws + WS_H) : (unsigned short*)F.out;
    const unsigned short* Wb = (const unsigned short*)(F.ws + WS_W + (size_t)l * W_LAYER + WO_WB);
    const bool last = (l == NLAYER - 1);
    const int nrt = last ? 128 : NROWS / 128;
    for (int u = F.vcu; u < nrt * 8; u += F.G) {
        int rt = u >> 3; const int ct = u & 7;
        if (last) rt = rt + 2 * (rt / 32) + 2;
        pgx::pgx_unit<VAR>(F.lds + RING_OFF, Y, Wb, S, MIX, rt * 128, ct * 128, F.tid);
    }
}
constexpr int NPL = 10;
enum { PH_H = 0, PH_G1, PH_POST1, PH_G2, PH_POST2, PH_ATT, PH_SG, PH_PG, PH_MIX, PH_OG };
constexpr int NPHASES = 1 + NLAYER * NPL;
#ifndef NAIVE_ATT
#define NAIVE_ATT 0
#endif
#ifndef PROBE_MASK
#define PROBE_MASK 0
#endif
#ifndef PROBE_LAYERS
#define PROBE_LAYERS 3
#endif
#ifndef PHMASK
#define PHMASK 16383
#endif
#ifndef MK_ONE_LAUNCH
#define MK_ONE_LAUNCH 1
#endif

__global__ void __launch_bounds__(NTHREADS, 2) fwd_kernel(Args args) {
    extern __shared__ __attribute__((aligned(16))) unsigned char lds_raw[];
    { LAS unsigned char* l0 = (LAS unsigned char*)lds_raw;
      for (int u = threadIdx.x; u < (LDS_BYTES - LDSCTL_OFF) / 4; u += NTHREADS) ((LAS unsigned*)(l0 + LDSCTL_OFF))[u] = 0u;
      __syncthreads();
      if (args.ph_hi - args.ph_lo > 1) (void)xcd_barrier_post((unsigned*)((gu32*)(args.ws + WS_CTL) + CW_BAR), (volatile LAS unsigned*)(l0 + MISC_OFF) + 8); }

    unsigned long long tacc = 0ull;
    for (int ph = args.ph_lo; ph < args.ph_hi; ++ph) {
        unsigned long long tph0 = 0ull; bool probed = false;
        if (PROBE_MASK) { const int pl = (ph == 0) ? 0 : (ph - 1) / NPL, pp = (ph == 0) ? 10 : (ph - 1) % NPL; probed = ((PROBE_MASK >> pp) & 1) && ((PROBE_LAYERS >> pl) & 1); if (probed) tph0 = __builtin_amdgcn_s_memrealtime(); }
        int z; asm volatile("s_mov_b32 %0, 0" : "=s"(z));
        Frame F;
        F.lds = (LAS unsigned char*)lds_raw + z; F.kin = (const float* const __attribute__((address_space(4)))*)((const __attribute__((address_space(4))) char*)__builtin_amdgcn_kernarg_segment_ptr() + z); F.ws = args.ws + z; F.out = args.out + z; F.z = z;
        F.tid = threadIdx.x + z; F.lane = F.tid & 63; F.wave = __builtin_amdgcn_readfirstlane(F.tid >> 6);
        F.G = gridDim.x + z; { const int bx = blockIdx.x + z; F.vcu = (F.G % 8 == 0) ? (bx % 8) * (F.G / 8) + bx / 8 : bx; }
        F.gw = F.vcu * NWAVES + F.wave; F.NGW = F.G * NWAVES;
        bool is_gemm = false;
        pg8::Gemm g{nullptr, nullptr, NROWS, 256, 1024, 1024, 31, 0};
        pg8::Order S; S.init(1, 1, F.G, (int)blockIdx.x + z, 0);
        pg8::EpiU E{pg8::EM_PLAIN, 0, F.ws, nullptr, nullptr, nullptr, 0, 0, 0, 0, 1 << 20};
        if (ph == 0) { if (PHMASK & 8192) p0_prologue(F); }
        else {
            const int l = (ph - 1) / NPL, p = (ph - 1) % NPL;
            unsigned char* wl = F.ws + WS_W + (size_t)l * W_LAYER;
            const bool last = (l == NLAYER - 1);
            const int nMc = last ? 64 : NROWS / 256, lat = last ? 1 : 0;
            E.l = l;
            if (p == PH_H && (PHMASK & 1)) { ph_hnorm(F, l); }
            else if (p == PH_G1 && (PHMASK & 2)) {
                is_gemm = true; g.A = (const bf16*)(F.ws + WS_H); g.Bt = (const bf16*)(wl + WO_W1); g.N = N1; g.K = 1024; g.lda = 1024;
                S.init(NROWS / 256, N1 / 256, F.G, (int)blockIdx.x + z, 0);
                E.mode = pg8::EM_SILU2; E.oA = WS_ZS; E.ldc = ZS_P; E.oB = WS_G; E.ldc2 = 1024; E.split_tile = 7;
            }
            else if (p == PH_POST1 && (PHMASK & 4)) { ph_lru1(F, l); ph_post1(F, l); }
            else if (p == PH_G2 && (PHMASK & 8)) {
                is_gemm = true; g.A = (const bf16*)(F.ws + WS_ZS); g.Bt = (const bf16*)(wl + WO_UQ); g.N = 1024; g.K = 256; g.lda = ZS_P; g.a_shift = 1; g.a_step = 512;
                S.init(NROWS / 256, 4, F.G, (int)blockIdx.x + z, 0);
                E.mode = pg8::EM_PLAIN; E.oA = WS_MQ; E.ldc = 512; E.oB = WS_MKV; E.ldc2 = 512; E.split_tile = 2;
            }
            else if (p == PH_POST2 && (PHMASK & 16)) { ph_lru_carry(F); ph_post2(F, l); }
            else if (p == PH_ATT && (PHMASK & 32)) {
#if NAIVE_ATT
                ph_attn_naive(F, l);
#else
                ph_attn(F, l);
#endif
                ph_lru2(F, l); }
            else if (p == PH_SG && (PHMASK & 512)) {
                is_gemm = true; g.A = (const bf16*)(F.ws + WS_H); g.Bt = (const bf16*)(wl + WO_W1) + (size_t)N1 * 1024; g.N = 4096; g.K = 1024; g.lda = 1024;
                S.init(nMc, 16, F.G, (int)blockIdx.x + z, lat);
                E.mode = pg8::EM_SIG; E.oA = WS_S; E.ldc = 4096;
            }
            else if (p == PH_PG && (PHMASK & 1024)) { ph_pgx<0>(F, l);
#ifdef PGX_PROBE
                if (l == 0) { __syncthreads(); ph_pgx<PGX_PROBE>(F, l); }
#endif
            }
            else if (p == PH_MIX) {
                if (!last && (PHMASK & 2048)) {
                    is_gemm = true; g.A = (const bf16*)(F.ws + WS_H); g.Bt = (const bf16*)(F.ws + WS_WOS); g.N = 4096; g.K = 256; g.lda = 1024; g.a_shift = 2; g.a_step = 512;
                    S.init(4, 16, F.G, (int)blockIdx.x + z, 2);
                    E.mode = pg8::EM_PLAIN; E.oA = WS_S; E.ldc = 4096; }
            }
            else if (p == PH_OG && (PHMASK & 4096)) {
                is_gemm = true; g.A = (const bf16*)(F.ws + WS_H); g.Bt = (const bf16*)(wl + WO_WO); g.N = 1024; g.K = 1024; g.lda = 1024;
                S.init(64, 4, F.G, (int)blockIdx.x + z, 1);
                E.mode = pg8::EM_RES; E.xin = (l == 0) ? F.in(I_X) : (const float*)F.out; E.xout = F.out; E.cin0 = F.in(I_CTX); E.oA = WS_MOD; E.oB = WS_CTX1;
            }
        }
        if (is_gemm) pg8::gemm_phase<pg8::EpiU, pg8::Order, true, true>(F.lds + RING_OFF, g, S, E, F.tid);
        if (NLAYER == 2 && ph >= 1 + PH_SG && ph <= 1 + PH_OG) {
            int z4; asm volatile("s_mov_b32 %0, 0" : "=s"(z4));
            Frame C;
            C.lds = (LAS unsigned char*)lds_raw + z4; C.kin = (const float* const __attribute__((address_space(4)))*)((const __attribute__((address_space(4))) char*)__builtin_amdgcn_kernarg_segment_ptr() + z4); C.ws = args.ws + z4; C.out = args.out + z4; C.z = z4;
            C.tid = threadIdx.x + z4; C.lane = C.tid & 63; C.wave = __builtin_amdgcn_readfirstlane(C.tid >> 6);
            C.G = gridDim.x + z4; const int bx = blockIdx.x + z4; C.vcu = (C.G % 8 == 0) ? (bx % 8) * (C.G / 8) + bx / 8 : bx;
            C.gw = C.vcu * NWAVES + C.wave; C.NGW = C.G * NWAVES;
            const int p = ph - 1; int cidx = -1, cn = 1, clo = 0, chi = 0;
            if (p == PH_SG) { const int nb = ((NROWS / 256) * 16) % C.G; cidx = bx - nb; cn = C.G - nb; clo = 0; chi = 1536; }
            else if (p == PH_PG) { const int nb = ((NROWS / 128) * 8) % C.G; cidx = C.vcu - nb; cn = C.G - nb; clo = 1536; chi = 3072; }
            else if (p == PH_OG) { const int nb = (64 < C.G) ? 64 : 0; cidx = bx - nb; cn = C.G - nb; clo = 3072; chi = 1 << 30; }
            if (cidx >= 0 && chi > 0) { __syncthreads(); weight_copies(C, 1, clo + cidx * NWAVES + C.wave, cn * NWAVES, chi); }
        }
        const bool empty_phase = (ph > 0) && ((ph - 1) % NPL == PH_MIX);
        if (empty_phase) __syncthreads();
        if (ph + 1 < args.ph_hi && !empty_phase) {
            int z2; asm volatile("s_mov_b32 %0, 0" : "=s"(z2));
            XcdBarrier bar; bar.bar = (unsigned*)((gu32*)(args.ws + z2 + WS_CTL) + CW_BAR); bar.x = xb_xcc_id(); bar.st = (volatile LAS unsigned*)((LAS unsigned char*)lds_raw + z2 + MISC_OFF) + 8;
            xcd_barrier(bar);
        }
        if (PROBE_MASK) { if (probed) tacc += __builtin_amdgcn_s_memrealtime() - tph0; }
    }
#ifdef EXTRA_BARRIERS
    for (int xb = 0; xb < EXTRA_BARRIERS; ++xb) { int z3; asm volatile("s_mov_b32 %0, 0" : "=s"(z3));
        XcdBarrier bar; bar.bar = (unsigned*)((gu32*)(args.ws + z3 + WS_CTL) + CW_BAR); bar.x = xb_xcc_id(); bar.st = (volatile LAS unsigned*)((LAS unsigned char*)lds_raw + z3 + MISC_OFF) + 8;
        xcd_barrier(bar); }
#endif
    if (PROBE_MASK) { const unsigned long long t0 = __builtin_amdgcn_s_memrealtime(); while (__builtin_amdgcn_s_memrealtime() - t0 < tacc) __builtin_amdgcn_s_sleep(8); }
}

extern "C" void kernel_launch(void* const* d_in, const int* in_sizes, int n_in, void* d_out, int out_size, void* d_ws, size_t ws_size, hipStream_t stream) {
    static int grid = 0;
    if (grid == 0) {
        if (n_in != 28 || out_size != NB * SEQ * DM || ws_size < WS_END) { fprintf(stderr, "kernel_launch: unexpected shapes (n_in %d out %d ws %zu); nothing launched\n", n_in, out_size, ws_size); grid = -1; return; }
        int dev = 0, cus = 0, per_cu = 0;
        if (hipGetDevice(&dev) != hipSuccess || hipDeviceGetAttribute(&cus, hipDeviceAttributeMultiprocessorCount, dev) != hipSuccess) { grid = -1; return; }
        if (hipFuncSetAttribute((const void*)fwd_kernel, hipFuncAttributeMaxDynamicSharedMemorySize, LDS_BYTES) != hipSuccess) { fprintf(stderr, "kernel_launch: hipFuncSetAttribute failed\n"); grid = -1; return; }
        if (hipOccupancyMaxActiveBlocksPerMultiprocessor(&per_cu, (const void*)fwd_kernel, NTHREADS, LDS_BYTES) != hipSuccess || per_cu < 1) { fprintf(stderr, "kernel_launch: occupancy query says %d\n", per_cu); (void)hipGetLastError(); grid = -1; return; }
        grid = cus;
    }
    if (grid < 0) return;
    (void)hipMemsetAsync((char*)d_ws + WS_CTL, 0, CTL_ZERO_BYTES, stream);
    Args a{};
    for (int i = 0; i < 28; ++i) a.in[i] = (const float*)d_in[i];
    a.out = (float*)d_out; a.ws = (unsigned char*)d_ws;
#if MK_ONE_LAUNCH
    a.ph_lo = 0; a.ph_hi = NPHASES;
    hipLaunchKernelGGL(fwd_kernel, dim3(grid), dim3(NTHREADS), LDS_BYTES, stream, a);
#else
    for (int ph = 0; ph < NPHASES; ++ph) { a.ph_lo = ph; a.ph_hi = ph + 1; hipLaunchKernelGGL(fwd_kernel, dim3(grid), dim3(NTHREADS), LDS_BYTES, stream, a); }
#endif
}
```

```cpp
#include <hip/hip_runtime.h>
#include <cstdio>
#include <cstdint>
#include <cmath>
__device__ __forceinline__ float bflo(unsigned w) { return __uint_as_float(w << 16); }
__device__ __forceinline__ float bfhi(unsigned w) { return __uint_as_float(w & 0xffff0000u); }
__device__ __forceinline__ float sigmoid_f(float v) { return __builtin_amdgcn_rcpf(1.0f + __builtin_amdgcn_exp2f(-1.4426950408889634f * v)); }
namespace pg8 {
#define PG8_LAS __attribute__((address_space(3)))
typedef unsigned short bf16_t;
typedef short bf16x8 __attribute__((ext_vector_type(8)));
typedef float f32x4 __attribute__((ext_vector_type(4)));
typedef unsigned u32x4 __attribute__((ext_vector_type(4)));
constexpr int BM = 256, BK = 64, HALF = 128, HTB = HALF * BK * 2  , STAGE_BYTES = 8 * HTB, NXCD = 8, WGM = 8;

__host__ __device__ __forceinline__ int lds_byte(int r, int c) { const int st = (r >> 4) * 2 + (c >> 5), rr = r & 15, cc = c & 31, ob = rr * 64 + cc * 2; return st * 1024 + (ob ^ (((ob >> 9) & 1) << 5)); }
__host__ __device__ __forceinline__ void stage_rc(int b, int& R, int& C) { const int st = b / 1024, sb = b % 1024, swz = sb ^ (((sb >> 9) & 1) << 5); R = (st >> 1) * 16 + swz / 64; C = (st & 1) * 32 + (swz % 64) / 2; }
__host__ __device__ __forceinline__ int perm32(int rho) { const int n = rho >> 4, i = rho & 15; return 8 * (i >> 2) + 4 * n + (i & 3); }

struct Unit { int pm, pn; };
struct Gemm { const bf16_t* A; const bf16_t* Bt; int M, N, K, lda; int a_shift, a_step; };

struct StaticOrder {
    int nM, nN, nwg, G, c;
    __host__ __device__ void init(int M, int N, int G_, int c_) { nM = M / BM; nN = N / BM; nwg = nM * nN; G = G_; c = c_; }
    __host__ __device__ bool next(int i, Unit& u) const {
        const long L = (long)i * G + c; if (L >= nwg) return false;
        int wgid = (int)L; { const int q = nwg / NXCD, r = nwg % NXCD, xcd = wgid % NXCD, off = wgid / NXCD; wgid = (xcd < r ? xcd * (q + 1) : r * (q + 1) + (xcd - r) * q) + off; }
        const int nig = WGM * nN, gid = wgid / nig, fm = gid * WGM, gsz = (nM - fm) < WGM ? (nM - fm) : WGM;
        u.pm = fm + ((wgid % nig) % gsz); u.pn = (wgid % nig) / gsz; return true;
    }
    __device__ __forceinline__ void a_ready(const Unit&) const {}
    __device__ __forceinline__ void done(const Unit&) const {}
};

__device__ __forceinline__ unsigned cvt_pk_bf16(float lo, float hi) { unsigned r; asm volatile("v_cvt_pk_bf16_f32 %0, %1, %2" : "=v"(r) : "v"(lo), "v"(hi)); return r; }
enum { EM_PLAIN = 0, EM_SILU2 = 1, EM_SIG = 2, EM_MUL = 3, EM_RES = 4 };
struct EpiU {
    static constexpr bool PERM = true, AFTER_DRAIN = false;
    int mode; int l; unsigned char* ws; const float* xin; float* xout; const float* cin0;
    size_t oA, oB; int ldc, ldc2, split_tile;
    __device__ __forceinline__ void operator()(const f32x4 (&acc)[2][2][4][2], const Unit& u, int wr, int wc, int fr, int fq) const {
        if (mode == EM_RES) {
            const int b = u.pm / 17, t0 = u.pm % 17;
            const float* src; float* dst; const float* gate; const float* modl = (const float*)(ws + oA) + (size_t)l * 5 * 3072;
            if (t0 == 0) { float* c1 = (float*)(ws + oB); src = ((l == 0) ? cin0 : (const float*)c1) + (size_t)b * 256 * 1024; dst = c1 + (size_t)b * 256 * 1024; gate = modl + 4 * 3072 + 2048; }
            else { const size_t o = ((size_t)b * 4096 + (size_t)(t0 - 1) * 256) * 1024; src = xin + o; dst = xout + o; gate = modl + b * 3072 + 2048; }
            const int col0 = u.pn * BM + wc * 32 + 8 * fq;
            const char* srcb = (const char*)src; char* dstb = (char*)dst; const char* gb = (const char*)(gate + col0);
            const unsigned off0 = (unsigned)((wr * 64 + fr) * 1024 + col0) * 4u;
#pragma unroll
            for (int ai = 0; ai < 2; ++ai) {
                f32x4 xo[4][2][2];
#pragma unroll
                for (int m = 0; m < 4; ++m) { const unsigned off = off0 + (unsigned)(ai * HALF + m * 16) * 4096u;
#pragma unroll
                    for (int bj = 0; bj < 2; ++bj)
#pragma unroll
                        for (int n = 0; n < 2; ++n) xo[m][bj][n] = *(const f32x4*)(srcb + (off + (unsigned)(bj * HALF + n * 4) * 4u)); }
#pragma unroll
                for (int m = 0; m < 4; ++m) { const unsigned off = off0 + (unsigned)(ai * HALF + m * 16) * 4096u;
#pragma unroll
                    for (int bj = 0; bj < 2; ++bj)
#pragma unroll
                        for (int n = 0; n < 2; ++n) { const unsigned cb = (unsigned)(bj * HALF + n * 4) * 4u; const f32x4 g = *(const f32x4*)(gb + cb);
                            *(f32x4*)(dstb + (off + cb)) = xo[m][bj][n] + g * acc[ai][bj][m][n]; } }
                asm volatile("" ::: "memory"); }
            return;
        }
        const int row0 = u.pm * BM + wr * 64 + fr; int colt = u.pn * BM; bf16_t* base = (bf16_t*)(ws + oA); int ld = ldc; bool second = false;
        if (u.pn >= split_tile) { base = (bf16_t*)(ws + oB); ld = ldc2; colt -= split_tile * BM; second = true; }
        const bool do_silu = (mode == EM_SILU2) && second;
        const int col0 = colt + wc * 32 + 8 * fq;
#pragma unroll
        for (int ai = 0; ai < 2; ++ai)
#pragma unroll
            for (int m = 0; m < 4; ++m) { bf16_t* rowp = base + (size_t)(row0 + ai * HALF + m * 16) * ld + col0;
#pragma unroll
                for (int bj = 0; bj < 2; ++bj) { f32x4 v0 = acc[ai][bj][m][0], v1 = acc[ai][bj][m][1];
                    if (mode == EM_SIG) {
#pragma unroll
                        for (int e = 0; e < 4; ++e) { v0[e] = sigmoid_f(v0[e]); v1[e] = sigmoid_f(v1[e]); } }
                    if (do_silu) {
#pragma unroll
                        for (int e = 0; e < 4; ++e) { v0[e] = v0[e] * sigmoid_f(v0[e]); v1[e] = v1[e] * sigmoid_f(v1[e]); } }
                    u32x4 w; w.x = cvt_pk_bf16(v0[0], v0[1]); w.y = cvt_pk_bf16(v0[2], v0[3]); w.z = cvt_pk_bf16(v1[0], v1[1]); w.w = cvt_pk_bf16(v1[2], v1[3]);
                    *(u32x4*)(rowp + bj * HALF) = w; } }
    }
};
struct Order {
    int nM, nN, nwg, G, c, latent_only, grouped, vc, nctx;
    __device__ void init(int nM_, int nN_, int G_, int c_, int lat) { nM = nM_; nN = nN_; nwg = nM * nN; G = G_; c = c_; latent_only = lat; grouped = 0; vc = 0; nctx = 0; }
    __device__ void init_grouped(int G_, int vc_, int with_ctx) { init(64, 4, G_, vc_, 1); grouped = 1; vc = vc_; nctx = with_ctx ? 64 : 0; }
    __device__ bool next(int i, Unit& u) const {
        if (grouped) {
            const int gi = i >> 2, grp = vc + gi * G;
            if (grp < 256) { const int pm = grp >> 2; u.pm = pm + pm / 16 + 1; u.pn = 4 * (i & 3) + (grp & 3); return true; }
            const int done = ((256 - vc + G - 1) / G) * 4;
            const int x = vc + (i - done) * G;
            if (i >= done && x < nctx) { const int g = x >> 2, k = x & 3; u.pm = (g >> 2) * 17; u.pn = 4 * k + (g & 3); return true; }
            return false;
        }
        const long L = (long)i * G + c; if (L >= nwg) return false;
        int wgid = (int)L; { const int q = nwg / NXCD, r = nwg % NXCD, xcd = wgid % NXCD, off = wgid / NXCD; wgid = (xcd < r ? xcd * (q + 1) : r * (q + 1) + (xcd - r) * q) + off; }
        const int nig = WGM * nN, gid = wgid / nig, fm = gid * WGM, gsz = (nM - fm) < WGM ? (nM - fm) : WGM;
        int pm = fm + ((wgid % nig) % gsz); u.pn = (wgid % nig) / gsz; if (latent_only == 1) pm = pm + pm / 16 + 1; else if (latent_only == 2) pm = pm * 17; u.pm = pm; return true;
    }
    __device__ __forceinline__ void a_ready(const Unit&) const {}
    __device__ __forceinline__ void done(const Unit&) const {}
};
template <class Epi, class Sched, bool ALIGN_EPI = false, bool SP2 = false>
__device__ __forceinline__ void gemm_phase(PG8_LAS unsigned char* lds, const Gemm g, const Sched& S, const Epi& E, const int tid  ) {
    const int wid = __builtin_amdgcn_readfirstlane(tid >> 6), lane = tid & 63, wr = wid >> 2, wc = wid & 3, fr = lane & 15, fq = lane >> 4;
    const int K = g.K, nt = K / BK;
    unsigned voffA[2], voffB[2];
#pragma unroll
    for (int i = 0; i < 2; ++i) { int R, C; stage_rc(tid * 16 + i * 8192, R, C); const int Rb = Epi::PERM ? ((R & ~31) + perm32(R & 31)) : R;
        voffA[i] = (unsigned)(R * g.lda + C) * 2u; voffB[i] = (unsigned)(Rb * K + C) * 2u; }
    const size_t kstep = (size_t)(BK * 2);
    const size_t hstepA = (size_t)HALF * g.lda * 2, hstepB = (size_t)HALF * K * 2;
    const size_t tstepA = 2 * hstepA, tstepB = 2 * hstepB;
    const unsigned ldsw = (unsigned)wid * 1024u;
    const int aoff = lds_byte(wr * 64 + fr, fq * 8), boff = lds_byte(wc * 32 + fr, fq * 8);
#define PG8_SA(b, h) (((b) * 2 + (h)) * HTB)
#define PG8_SB(b, h) ((4 + (b) * 2 + (h)) * HTB)
#define PG8_STAGE(bufoff, gbase, voff) do { _Pragma("unroll") for (int _i = 0; _i < 2; ++_i) \
        __builtin_amdgcn_global_load_lds((const unsigned*)((const char*)(gbase) + (voff)[_i]), (PG8_LAS unsigned*)(lds + (bufoff) + ldsw + _i * 8192), 16, 0, 0); } while (0)
#define PG8_LDA(dst, b, h) do { _Pragma("unroll") for (int m = 0; m < 4; ++m) _Pragma("unroll") for (int k = 0; k < 2; ++k) dst[m][k] = *(const PG8_LAS bf16x8*)(lds + PG8_SA(b, h) + aoff + m * 2048 + k * 1024); } while (0)
#define PG8_LDB(dst, b, h) do { _Pragma("unroll") for (int n = 0; n < 2; ++n) _Pragma("unroll") for (int k = 0; k < 2; ++k) dst[n][k] = *(const PG8_LAS bf16x8*)(lds + PG8_SB(b, h) + boff + n * 2048 + k * 1024); } while (0)
#define PG8_MMA(ai, bj, At, Bt) do { __builtin_amdgcn_s_setprio(1); _Pragma("unroll") for (int m = 0; m < 4; ++m) _Pragma("unroll") for (int n = 0; n < 2; ++n) _Pragma("unroll") for (int k = 0; k < 2; ++k) \
        acc[ai][bj][m][n] = __builtin_amdgcn_mfma_f32_16x16x32_bf16(Bt[n][k], At[m][k], acc[ai][bj][m][n], 0, 0, 0); __builtin_amdgcn_s_setprio(0); } while (0)
#define PG8_WAIT_V(n) asm volatile("s_waitcnt vmcnt(" #n ")" ::: "memory")
#define PG8_WAIT_L(n) asm volatile("s_waitcnt lgkmcnt(" #n ")" ::: "memory")
#define PG8_BAR __builtin_amdgcn_s_barrier()
#define PG8_SCHED __builtin_amdgcn_sched_barrier(0)
    Unit cur, nxt; int ui = 0;
    if (!S.next(0, cur)) return;
    f32x4 acc[2][2][4][2];
#pragma unroll
    for (int a = 0; a < 2; ++a)
#pragma unroll
        for (int b = 0; b < 2; ++b)
#pragma unroll
            for (int m = 0; m < 4; ++m)
#pragma unroll
                for (int n = 0; n < 2; ++n) acc[a][b][m][n] = (f32x4){0.f, 0.f, 0.f, 0.f};
    bf16x8 At[4][2], B0[2][2], B1[2][2];
    const char* cA = (const char*)g.A + (size_t)cur.pm * tstepA + (size_t)(cur.pn >> g.a_shift) * (size_t)g.a_step; const char* cB = (const char*)g.Bt + (size_t)cur.pn * tstepB;
    S.a_ready(cur);
    if constexpr (SP2) {
        PG8_STAGE(PG8_SB(0, 0), cB, voffB); PG8_STAGE(PG8_SB(0, 1), cB + hstepB, voffB); PG8_STAGE(PG8_SA(0, 0), cA, voffA); PG8_STAGE(PG8_SA(0, 1), cA + hstepA, voffA);
        if (wr == 1) PG8_BAR;
        PG8_WAIT_V(2); PG8_BAR;
        PG8_STAGE(PG8_SB(1, 0), cB + kstep, voffB); PG8_STAGE(PG8_SA(1, 0), cA + kstep, voffA); PG8_STAGE(PG8_SB(1, 1), cB + hstepB + kstep, voffB);
        PG8_WAIT_V(6); PG8_BAR;
    } else {
        PG8_STAGE(PG8_SB(0, 0), cB, voffB); PG8_STAGE(PG8_SA(0, 0), cA, voffA); PG8_STAGE(PG8_SB(0, 1), cB + hstepB, voffB); PG8_STAGE(PG8_SA(0, 1), cA + hstepA, voffA);
        if (wr == 1) PG8_BAR;
        PG8_WAIT_V(4); PG8_BAR;
        PG8_STAGE(PG8_SB(1, 0), cB + kstep, voffB); PG8_STAGE(PG8_SA(1, 0), cA + kstep, voffA); PG8_STAGE(PG8_SB(1, 1), cB + hstepB + kstep, voffB);
        PG8_WAIT_V(6); PG8_BAR;
    }
    for (;;) {
        const bool has_next = S.next(ui + 1, nxt);
        const char* nA = has_next ? (const char*)g.A + (size_t)nxt.pm * tstepA + (size_t)(nxt.pn >> g.a_shift) * (size_t)g.a_step : cA; const char* nB = has_next ? (const char*)g.Bt + (size_t)nxt.pn * tstepB : cB;
        for (int t = 0; t < nt; t += 2) {
            const bool last = (t == nt - 2);
            const char* a1 = cA + (size_t)(t + 1) * kstep;
            const char* a2 = last ? nA : cA + (size_t)(t + 2) * kstep; const char* b2 = last ? nB : cB + (size_t)(t + 2) * kstep;
            const char* a3 = a2 + kstep; const char* b3 = b2 + kstep;
            if (last && has_next) S.a_ready(nxt);
            if constexpr (SP2) {
            PG8_LDB(B0, 0, 0); PG8_LDB(B1, 0, 1); PG8_SCHED; PG8_LDA(At, 0, 0); PG8_STAGE(PG8_SA(1, 1), a1 + hstepA, voffA);
            PG8_WAIT_V(8); PG8_WAIT_L(0); PG8_BAR; PG8_MMA(0, 0, At, B0); PG8_MMA(0, 1, At, B1); PG8_BAR; PG8_SCHED;
            PG8_LDA(At, 0, 1); PG8_STAGE(PG8_SB(0, 0), b2, voffB); PG8_STAGE(PG8_SB(0, 1), b2 + hstepB, voffB); PG8_STAGE(PG8_SA(0, 0), a2, voffA);
            PG8_WAIT_V(8); PG8_WAIT_L(0); PG8_BAR; PG8_MMA(1, 0, At, B0); PG8_MMA(1, 1, At, B1); PG8_BAR; PG8_SCHED;
            PG8_LDB(B0, 1, 0); PG8_LDB(B1, 1, 1); PG8_SCHED; PG8_LDA(At, 1, 0); PG8_STAGE(PG8_SA(0, 1), a2 + hstepA, voffA);
            PG8_WAIT_V(8); PG8_WAIT_L(0); PG8_BAR; PG8_MMA(0, 0, At, B0); PG8_MMA(0, 1, At, B1); PG8_BAR; PG8_SCHED;
            PG8_LDA(At, 1, 1); PG8_STAGE(PG8_SB(1, 0), b3, voffB); PG8_STAGE(PG8_SB(1, 1), b3 + hstepB, voffB); PG8_STAGE(PG8_SA(1, 0), a3, voffA);
            PG8_WAIT_V(8); PG8_WAIT_L(0); PG8_BAR; PG8_MMA(1, 0, At, B0); PG8_MMA(1, 1, At, B1); PG8_BAR; PG8_SCHED;
            } else {
            PG8_LDB(B0, 0, 0); PG8_SCHED; PG8_LDA(At, 0, 0); PG8_STAGE(PG8_SA(1, 1), a1 + hstepA, voffA);
            PG8_WAIT_L(8); PG8_BAR; PG8_WAIT_L(0); PG8_MMA(0, 0, At, B0); PG8_BAR; PG8_SCHED;
            PG8_LDB(B1, 0, 1); PG8_STAGE(PG8_SB(0, 0), b2, voffB);
            PG8_BAR; PG8_WAIT_L(0); PG8_MMA(0, 1, At, B1); PG8_BAR;
            PG8_LDA(At, 0, 1); PG8_STAGE(PG8_SA(0, 0), a2, voffA);
            PG8_BAR; PG8_WAIT_L(0); PG8_MMA(1, 0, At, B0); PG8_BAR; PG8_SCHED;
            PG8_STAGE(PG8_SB(0, 1), b2 + hstepB, voffB);
            PG8_WAIT_V(6); PG8_BAR; PG8_MMA(1, 1, At, B1); PG8_BAR;
            PG8_LDB(B0, 1, 0); PG8_SCHED; PG8_LDA(At, 1, 0); PG8_STAGE(PG8_SA(0, 1), a2 + hstepA, voffA);
            PG8_WAIT_L(8); PG8_BAR; PG8_WAIT_L(0); PG8_MMA(0, 0, At, B0); PG8_BAR; PG8_SCHED;
            PG8_LDB(B1, 1, 1); PG8_STAGE(PG8_SB(1, 0), b3, voffB);
            PG8_BAR; PG8_WAIT_L(0); PG8_MMA(0, 1, At, B1); PG8_BAR;
            PG8_LDA(At, 1, 1); PG8_STAGE(PG8_SA(1, 0), a3, voffA);
            PG8_BAR; PG8_WAIT_L(0); PG8_MMA(1, 0, At, B0); PG8_BAR; PG8_SCHED;
            PG8_STAGE(PG8_SB(1, 1), b3 + hstepB, voffB);
            PG8_WAIT_V(6); PG8_BAR; PG8_MMA(1, 1, At, B1); PG8_BAR;
            }
        }
        if constexpr (ALIGN_EPI) { if (wr == 0) PG8_BAR; }
        if constexpr (!Epi::AFTER_DRAIN) { E(acc, cur, wr, wc, fr, fq); S.done(cur); }
        if (!has_next) break;
#pragma unroll
        for (int a = 0; a < 2; ++a)
#pragma unroll
            for (int b = 0; b < 2; ++b)
#pragma unroll
                for (int m = 0; m < 4; ++m)
#pragma unroll
                    for (int n = 0; n < 2; ++n) acc[a][b][m][n] = (f32x4){0.f, 0.f, 0.f, 0.f};
        cur = nxt; cA = nA; cB = nB; ++ui;
        if constexpr (ALIGN_EPI) { if (wr == 1) PG8_BAR; }
    }
    PG8_WAIT_V(0);
    if constexpr (!ALIGN_EPI) { if (wr == 0) PG8_BAR; }
    PG8_BAR;
    if constexpr (Epi::AFTER_DRAIN) { E.fused(acc, cur, wr, wc, fr, fq, lds, wid, lane); S.done(cur); }
#undef PG8_SA
#undef PG8_SB
#undef PG8_STAGE
#undef PG8_LDA
#undef PG8_LDB
#undef PG8_MMA
#undef PG8_WAIT_V
#undef PG8_WAIT_L
#undef PG8_BAR
#undef PG8_SCHED
}
}
#define PG8_SP2 true
#define PG8_ALIGN true
#define GAS __attribute__((address_space(1)))
#define LAS __attribute__((address_space(3)))
typedef unsigned short bf16;
typedef unsigned v4u __attribute__((ext_vector_type(4)));
typedef float f32x4 __attribute__((ext_vector_type(4)));
typedef short bf16x8 __attribute__((ext_vector_type(8)));
typedef GAS unsigned gu32;
typedef GAS unsigned long long gu64;
#define RLX_AGENT __ATOMIC_RELAXED, __HIP_MEMORY_SCOPE_AGENT
#define LDS_WAIT() asm volatile("s_waitcnt lgkmcnt(0)" ::: "memory")
#define VM_WAIT() asm volatile("s_waitcnt vmcnt(0)" ::: "memory")
__device__ __forceinline__ unsigned long long rt() { return __builtin_amdgcn_s_memrealtime(); }
__device__ __forceinline__ unsigned f2bf(float f) { unsigned u = __builtin_bit_cast(unsigned, f); return (u + 0x7fffu + ((u >> 16) & 1u)) >> 16; }
__device__ __forceinline__ unsigned pk2(float lo, float hi) { return f2bf(lo) | (f2bf(hi) << 16); }
#define XB_TMO      128
#define XB_XCNT(j)  (256  + 64 * (j))
#define XB_XSUB(j)  (1280 + 64 * (j))
#define XB_XGEN(j)  (2304 + 64 * (j))
#define XB_TOP      3328
#define XB_TOPGEN   3392
#define XCD_BAR_WORDS 3456
#define XB_SPIN_CAP (1u << 18)

__device__ __forceinline__ unsigned xb_ld(unsigned* p)              { return __hip_atomic_load(p, __ATOMIC_RELAXED, __HIP_MEMORY_SCOPE_AGENT); }
__device__ __forceinline__ unsigned xb_add(unsigned* p, unsigned v) { return __hip_atomic_fetch_add(p, v, __ATOMIC_RELAXED, __HIP_MEMORY_SCOPE_AGENT); }
__device__ __forceinline__ unsigned xb_xcc_id() { return (unsigned)__builtin_amdgcn_s_getreg((3 << 11) | 20) & 0xFu; }
#define XB_SPIN(cond, bar) do { unsigned _sp = 0; while (cond) { __builtin_amdgcn_s_sleep(1); \
    if ((++_sp & 255u) == 0u) { if (xb_ld(&(bar)[XB_TMO])) break; if (_sp > XB_SPIN_CAP) { atomicAdd(&(bar)[XB_TMO], 1u); break; } } } } while (0)

struct XcdBarrier {
    unsigned* bar; unsigned x;
    volatile LAS unsigned* st;
};

__device__ __forceinline__ XcdBarrier xcd_barrier_post(unsigned* bar, volatile LAS unsigned* st) {
    XcdBarrier b; b.bar = bar; b.x = xb_xcc_id(); b.st = st;
    if (threadIdx.x == 0) (void)xb_add(&bar[XB_XCNT(b.x)], 1u);
    return b;
}
__device__ __forceinline__ void xcd_barrier_complete(unsigned* bar, unsigned x, unsigned& nloc, unsigned& nx) {
    const unsigned G = gridDim.x * gridDim.y * gridDim.z;
    unsigned sum, cnt, mine, sp = 0u;
    for (;;) {
        sum = 0u; cnt = 0u; mine = 0u;
#pragma unroll
        for (unsigned j = 0; j < 16; ++j) { const unsigned c = xb_ld(&bar[XB_XCNT(j)]); sum += c; cnt += (c > 0u) ? 1u : 0u; mine = (j == x) ? c : mine; }
        if (sum == G) break;
        __builtin_amdgcn_s_sleep(1);
        if ((++sp & 255u) == 0u) { if (xb_ld(&bar[XB_TMO])) break; if (sp > XB_SPIN_CAP) { atomicAdd(&bar[XB_TMO], 1u); break; } }
    }
    nloc = mine > 0u ? mine : 1u; nx = cnt > 0u ? cnt : 1u;
}

__device__ __forceinline__ void xcd_barrier(const XcdBarrier& b) {
    asm volatile("s_waitcnt vmcnt(0)" ::: "memory");
    __syncthreads();
    if (threadIdx.x == 0) {
        unsigned* bar = b.bar;
        __builtin_amdgcn_s_waitcnt(0);
        unsigned nloc = b.st[0], nx = b.st[1];
        if (nloc == 0u) { xcd_barrier_complete(bar, b.x, nloc, nx); b.st[0] = nloc; b.st[1] = nx; }
        const unsigned old = xb_add(&bar[XB_XSUB(b.x)], 1u);
        const unsigned gen = old / nloc;
        if (old + 1u == (gen + 1u) * nloc) {
            __builtin_amdgcn_fence(__ATOMIC_RELEASE, "agent");
            asm volatile("s_waitcnt vmcnt(0)" ::: "memory");
            const unsigned og = xb_add(&bar[XB_TOP], 1u);
            const unsigned tg = og / nx;
            if (og + 1u == (tg + 1u) * nx) xb_add(&bar[XB_TOPGEN], 1u);
            else XB_SPIN(xb_ld(&bar[XB_TOPGEN]) == tg, bar);
            __builtin_amdgcn_fence(__ATOMIC_ACQUIRE, "agent");
            xb_add(&bar[XB_XGEN(b.x)], 1u);
            asm volatile("s_waitcnt vmcnt(0)" ::: "memory");
        } else {
            XB_SPIN(xb_ld(&bar[XB_XGEN(b.x)]) == gen, bar);
            __builtin_amdgcn_fence(__ATOMIC_ACQUIRE, "agent");
            asm volatile("s_waitcnt vmcnt(0)" ::: "memory");
        }
    }
    __syncthreads();
}
constexpr int NB = 4, SEQ = 4096, CTXL = 256, TPB = SEQ + CTXL, NROWS = NB * TPB, DM = 1024, NLAYER = 2, IN_COLS = 6816;
constexpr int NWAVES = 8, NTHREADS = NWAVES * 64;
constexpr float RMS_EPS = 1e-6f;
constexpr float LOG2E = 1.4426950408889634f;
constexpr float QSCALE64 = 0.125f * LOG2E;
constexpr float QSCALE96 = 0.10206207261596575f * LOG2E;
constexpr int ZS_P = 1792, ZC_CQ = 0, ZC_CKV = 256, ZC_KR = 384, ZC_SQ = 512, ZC_SK = 768, ZC_SV = 896, ZC_AQ = 1024, ZC_AK = 1280, ZC_AV = 1408, ZC_LRU = 1536;
constexpr int N1 = 2816;
constexpr int W1ROWS = N1 + 4096;
constexpr size_t MiB = 1u << 20;
constexpr size_t WS_CTL = 0, CTL_ZERO_BYTES = 64 * 1024;
constexpr size_t WS_MOD = 1 * MiB;
constexpr size_t WS_RHC = 1 * MiB + 256 * 1024, WS_RHS = WS_RHC + 512 * 1024;
constexpr size_t WS_RMC = WS_RHS + 512 * 1024, WS_RMS = WS_RMC + 256 * 1024;
constexpr size_t WS_CTX1 = 3 * MiB;
constexpr size_t WS_WOS = 3 * MiB;
constexpr size_t WS_W = 8 * MiB, W_LAYER = 18 * MiB;
constexpr size_t WO_W1 = 0, WO_WB = 13 * MiB + 512 * 1024, WO_WO = WO_WB + 2 * MiB, WO_UQ = WO_WO + 2 * MiB, WO_UKV = WO_UQ + 256 * 1024;
constexpr size_t WS_H = 44 * MiB;
constexpr size_t WS_G = 78 * MiB;
constexpr size_t WS_S = 112 * MiB;
constexpr size_t WS_ZS = 112 * MiB;
constexpr size_t WS_MQ = 172 * MiB;
constexpr size_t WS_MKV = 189 * MiB;
constexpr size_t WS_MK = 206 * MiB;
constexpr size_t WS_U = 219 * MiB;
constexpr size_t WS_HF = 236 * MiB;
constexpr size_t WS_SP = 2 * MiB + 768 * 1024;
constexpr size_t WS_LWT = 254 * MiB + 512 * 1024;
constexpr size_t WS_END = 256 * MiB;
static_assert(WS_H + (size_t)NROWS * 1024 * 2 <= WS_G && WS_G + (size_t)NROWS * 1024 * 2 <= WS_S && WS_S + (size_t)NROWS * 4096 * 2 <= 248 * MiB, "ws map");
static_assert(WS_ZS + (size_t)NROWS * ZS_P * 2 <= WS_MQ && WS_MK + (size_t)NROWS * 384 * 2 <= WS_U, "ws map 2");
static_assert(WO_UKV + 512 * 256 * 2 <= W_LAYER, "weights");
constexpr int CW_BAR = 1024;
constexpr int CW_FLG = 8192;

constexpr int RING_OFF = 0, RING_BYTES = 131072, LDSCTL_OFF = RING_BYTES, MISC_OFF = LDSCTL_OFF + 320, LDS_BYTES = 147456;

typedef unsigned short bf16;
typedef unsigned u32x2 __attribute__((ext_vector_type(2)));
typedef float f32x2v __attribute__((ext_vector_type(2)));
__device__ __forceinline__ float bf2f(bf16 v) { return __uint_as_float((unsigned)v << 16); }
template <int O> __device__ __forceinline__ float xor_swz(float v) { return __int_as_float(__builtin_amdgcn_ds_swizzle(__float_as_int(v), (O << 10) | 0x1F)); }
__device__ __forceinline__ float wave_sum(float v) {
    v += xor_swz<1>(v); v += xor_swz<2>(v); v += xor_swz<4>(v); v += xor_swz<8>(v); v += xor_swz<16>(v);
    auto rr = __builtin_amdgcn_permlane32_swap(__float_as_uint(v), __float_as_uint(v), false, false); return __uint_as_float(rr[0]) + __uint_as_float(rr[1]); }
__device__ __forceinline__ float wave_max(float v) {
    v = fmaxf(v, xor_swz<1>(v)); v = fmaxf(v, xor_swz<2>(v)); v = fmaxf(v, xor_swz<4>(v)); v = fmaxf(v, xor_swz<8>(v)); v = fmaxf(v, xor_swz<16>(v));
    auto rr = __builtin_amdgcn_permlane32_swap(__float_as_uint(v), __float_as_uint(v), false, false); return fmaxf(__uint_as_float(rr[0]), __uint_as_float(rr[1])); }
__device__ __forceinline__ float grp16_sum(float v) {
    v += xor_swz<1>(v); v += xor_swz<2>(v); v += xor_swz<4>(v); v += xor_swz<8>(v); return v; }

struct Args { const float* in[28]; float* out; unsigned char* ws; int ph_lo, ph_hi; };
enum { I_X = 0, I_C, I_CTX, I_CCTX, I_WMOD, I_BMOD, I_NORMW, I_WIN, I_CQN, I_CKVN, I_WUQ, I_WUKV, I_MQN, I_MKN, I_SQN, I_SKN, I_SINK, I_AQN, I_AKN,
       I_CONVW, I_CONVB, I_LWR, I_LBR, I_LWI, I_LBI, I_LAM, I_WBR, I_WOUT };

struct Frame {
    LAS unsigned char* lds; const float* const __attribute__((address_space(4)))* kin; unsigned char* ws; float* out;
    int tid, lane, wave, G, vcu, gw, NGW, z;
    __device__ __forceinline__ const float* in(int i) const { return kin[i]; }
};

__device__ __forceinline__ void xpose_item(const float* W, int ldn, int k0, int n0, bf16* WT, int pd, int drow, LAS float* scr, int lane) {
    float v[32]; const float* wp = W + (size_t)(k0 + (lane >> 5)) * ldn + n0 + (lane & 31);
#pragma unroll
    for (int i = 0; i < 32; ++i) v[i] = wp[(size_t)(2 * i) * ldn];
#pragma unroll
    for (int i = 0; i < 32; ++i) scr[(2 * i + (lane >> 5)) * 33 + (lane & 31)] = v[i];
    LDS_WAIT(); asm volatile("" ::: "memory");
    const int c = lane & 7;
#pragma unroll
    for (int j = 0; j < 4; ++j) { const int n = (lane >> 3) + 8 * j; const LAS float* s = scr + (8 * c) * 33 + n;
        v4u o; o.x = pk2(s[0 * 33], s[1 * 33]); o.y = pk2(s[2 * 33], s[3 * 33]); o.z = pk2(s[4 * 33], s[5 * 33]); o.w = pk2(s[6 * 33], s[7 * 33]);
        *(GAS v4u*)(WT + (size_t)(drow + n0 + n) * pd + k0 + 8 * c) = o; }
    LDS_WAIT(); asm volatile("" ::: "memory");
}
__device__ __forceinline__ void zero16(bf16* p, size_t n16, int gt, int ngt) {
    for (size_t i = gt; i < n16; i += ngt) ((GAS v4u*)p)[i] = (v4u){0u, 0u, 0u, 0u};
}
constexpr int N1T = 2816 / 32;
constexpr int I_EARLY = 16 * N1T + 4 * 12 + 2 * 16, I_INL = 16 * (213 - N1T), I_BR = 4 * 4 * 32, I_OUT = 16 * 32, I_LAYER = I_EARLY + I_INL + I_BR + I_OUT, I_SPLIT = 16 * 32;
__device__ __forceinline__ void copy_item(Frame& F, int l, int r, LAS float* scr) {
    unsigned char* wl = F.ws + WS_W + (size_t)l * W_LAYER;
    if (r < 16 * N1T) { const int kb = r / N1T, nb = r % N1T, n0 = nb * 32;
        xpose_item(F.in(I_WIN) + (size_t)l * 1024 * IN_COLS, IN_COLS, kb * 64, n0, (bf16*)(wl + WO_W1), 1024, n0 >= 416 ? 96 : 0, scr, F.lane); return; } r -= 16 * N1T;
    if (r < 4 * 12) { const int kb = r / 12, nb = r % 12;
        xpose_item(F.in(I_WUQ) + (size_t)l * 256 * 384, 384, kb * 64, nb * 32, (bf16*)(wl + WO_UQ), 256, 0, scr, F.lane); return; } r -= 4 * 12;
    if (r < 2 * 16) { const int kb = r / 16, nb = r % 16;
        xpose_item(F.in(I_WUKV) + (size_t)l * 128 * 512, 512, kb * 64, nb * 32, (bf16*)(wl + WO_UKV), 256, 0, scr, F.lane); return; } r -= 2 * 16;
    if (r < I_INL) { const int kb = r / (213 - N1T), nb = N1T + r % (213 - N1T), n0 = nb * 32;
        xpose_item(F.in(I_WIN) + (size_t)l * 1024 * IN_COLS, IN_COLS, kb * 64, n0, (bf16*)(wl + WO_W1), 1024, 96, scr, F.lane); return; } r -= I_INL;
    if (r < I_BR) { const int k = r / 128, rr = r % 128, kb = rr / 32, nb = rr % 32;
        xpose_item(F.in(I_WBR) + ((size_t)l * 4 + k) * 256 * 1024, 1024, kb * 64, nb * 32, (bf16*)(wl + WO_WB) + (size_t)k * 1024 * 256, 256, 0, scr, F.lane); return; } r -= I_BR;
    if (r < I_OUT) { const int kb = r / 32, nb = r % 32;
        xpose_item(F.in(I_WOUT) + (size_t)l * 1024 * 1024, 1024, kb * 64, nb * 32, (bf16*)(wl + WO_WO), 1024, 0, scr, F.lane); return; } r -= I_OUT;
    if (r < I_SPLIT) { const int kb = r / 32, nb = r % 32, kq = kb >> 2;
        xpose_item(F.in(I_WOUT), 1024, kb * 64, nb * 32, (bf16*)(F.ws + WS_WOS) + (size_t)kq * (1024 * 256 - 256), 256, 0, scr, F.lane); }
}
__device__ __forceinline__ void weight_copies(Frame& F, int first, int stride, int loA, int nA, int loB, int nB) {
    LAS float* scr = (LAS float*)(F.lds + RING_OFF + F.wave * 16384);
#pragma unroll 1
    for (int v = first; v < nA + nB; v += stride) { const bool a = v < nA; copy_item(F, a ? 0 : NLAYER - 1, a ? loA + v : loB + v - nA, scr); }
}
constexpr int IC_G1 = 320;
__device__ __forceinline__ void p0_tables(Frame& F, int gt, int ngt) {
    { float* rhc = (float*)(F.ws + WS_RHC); float* rhs = (float*)(F.ws + WS_RHS); float* rmc = (float*)(F.ws + WS_RMC); float* rms = (float*)(F.ws + WS_RMS);
      constexpr float L2_10000 = 13.287712379549449f, INV_2PI = 0.15915494309189535f;
      for (int i = gt; i < 4096 * 32; i += ngt) { const int t = i >> 5, p = i & 31; const float fr = __builtin_amdgcn_exp2f(-(float)(p & 15) * (L2_10000 / 16.0f));
          const float pos = (float)((p < 16) ? (t >> 6) : (t & 63)); const float rev = pos * fr * INV_2PI; rhc[i] = __builtin_amdgcn_cosf(rev); rhs[i] = __builtin_amdgcn_sinf(rev); }
      for (int i = gt; i < 4096 * 16; i += ngt) { const int t = i >> 4, p = i & 15; const float fr = __builtin_amdgcn_exp2f(-(float)(p & 7) * (L2_10000 / 8.0f));
          const float pos = (float)((p < 8) ? (t >> 6) : (t & 63)); const float rev = pos * fr * INV_2PI; rmc[i] = __builtin_amdgcn_cosf(rev); rms[i] = __builtin_amdgcn_sinf(rev); } }
    { float* sp = (float*)(F.ws + WS_SP); for (int i = gt; i < NLAYER * 2 * 256; i += ngt) sp[i] = 8.0f * LOG2E * log1pf(expf(-F.in(I_LAM)[i])); }
    { float* lwt = (float*)(F.ws + WS_LWT);
      for (int o = gt; o < NLAYER * 2 * 2 * 256 * 64; o += ngt) { const int i = o & 63, c = (o >> 6) & 255, gate = (o >> 14) & 1, ld = o >> 15, k = c >> 6, j = c & 63;
          lwt[o] = (gate == 0 ? F.in(I_LWR) : F.in(I_LWI))[(((size_t)ld * 4 + k) * 64 + i) * 64 + j]; } }
}
__device__ __forceinline__ void p0_prologue(Frame& F) {
    weight_copies(F, F.gw, F.NGW, 0, I_EARLY, 0, 0);
    const int gt = F.vcu * NTHREADS + F.tid, ngt = F.G * NTHREADS;
    for (int l = 0; l < NLAYER; ++l) {
        unsigned char* wl = F.ws + WS_W + (size_t)l * W_LAYER;
        zero16((bf16*)(wl + WO_W1) + (size_t)416 * 1024, 96 * 1024 * 2 / 16, gt, ngt);
        zero16((bf16*)(wl + WO_UQ) + (size_t)384 * 256, 128 * 256 * 2 / 16, gt, ngt);
        for (int i = gt; i < 512 * 16; i += ngt) { const int n = i >> 4, c = i & 15; ((GAS v4u*)((bf16*)(wl + WO_UKV) + (size_t)n * 256 + 128))[c] = (v4u){0u, 0u, 0u, 0u}; }
    }
    { LAS float* sc = (LAS float*)(F.lds + RING_OFF);
      LAS float* red = sc + 5 * 1024;
      __syncthreads();
      for (int i = F.tid; i < 5 * 1024; i += NTHREADS) { const float v = (i < 4096) ? F.in(I_C)[i] : F.in(I_CCTX)[i - 4096]; sc[i] = v / (1.0f + expf(-v)); }
      __syncthreads();
      float* modv = (float*)(F.ws + WS_MOD);
      for (int it = F.vcu; it < NLAYER * 96; it += F.G) {
          const int l = it / 96, n0 = (it % 96) * 32, nn = F.tid & 31, kc = F.tid >> 5;
          const float* w = F.in(I_WMOD) + (size_t)l * 1024 * 3072 + n0 + nn;
          float acc[5] = {0.f, 0.f, 0.f, 0.f, 0.f};
#pragma unroll 1
          for (int k0 = kc * 64; k0 < kc * 64 + 64; k0 += 32) { float wv[32];
#pragma unroll
              for (int i = 0; i < 32; ++i) wv[i] = w[(size_t)(k0 + i) * 3072];
#pragma unroll
              for (int i = 0; i < 32; ++i)
#pragma unroll
                  for (int r = 0; r < 5; ++r) acc[r] += sc[r * 1024 + k0 + i] * wv[i]; }
#pragma unroll
          for (int r = 0; r < 5; ++r) red[(kc * 5 + r) * 32 + nn] = acc[r];
          __syncthreads();
          if (F.tid < 160) { const int r = F.tid >> 5; float s = 0.f;
              for (int q = 0; q < 16; ++q) s += red[(q * 5 + r) * 32 + nn];
              modv[((size_t)l * 5 + r) * 3072 + n0 + nn] = s + F.in(I_BMOD)[l * 3072 + n0 + nn]; }
          __syncthreads();
      } }
}

__device__ __forceinline__ void ph_hnorm(Frame& F, int l) {
    const float* xs = (l == 0) ? F.in(I_X) : F.out; const float* cs = (l == 0) ? F.in(I_CTX) : (const float*)(F.ws + WS_CTX1);
    const float* nw = F.in(I_NORMW) + l * 1024; const float* modl = (const float*)(F.ws + WS_MOD) + (size_t)l * 5 * 3072;
    bf16* H = (bf16*)(F.ws + WS_H);
    for (int row = F.gw; row < NROWS; row += F.NGW) {
        const int b = row / TPB, j = row % TPB; const float* src; int mr;
        if (j < CTXL) { src = cs + ((size_t)b * CTXL + j) * 1024; mr = 4; } else { src = xs + ((size_t)b * SEQ + (j - CTXL)) * 1024; mr = b; }
        const GAS f32x4* xr = (const GAS f32x4*)src + F.lane;
        f32x4 v[4]; float ss = 0.f;
        if (l > 0 && j < CTXL) {
            const unsigned short* P = (const unsigned short*)(F.ws + WS_S) + (size_t)row * 4096 + 4 * F.lane;
            const float* gt = (const float*)(F.ws + WS_MOD) + 4 * 3072 + 2048 + 4 * F.lane;
            const GAS f32x4* c0 = (const GAS f32x4*)(F.in(I_CTX) + ((size_t)b * CTXL + j) * 1024) + F.lane;
#pragma unroll
            for (int q = 0; q < 4; ++q) { f32x4 a = {0.f, 0.f, 0.f, 0.f};
#pragma unroll
                for (int kq = 0; kq < 4; ++kq) { const u32x2 w = *(const u32x2*)(P + kq * 1024 + 256 * q); a.x += bflo(w.x); a.y += bfhi(w.x); a.z += bflo(w.y); a.w += bfhi(w.y); }
                v[q] = c0[64 * q] + *(const f32x4*)(gt + 256 * q) * a; }
        } else {
#pragma unroll
            for (int q = 0; q < 4; ++q) v[q] = xr[64 * q];
        }
#pragma unroll
        for (int q = 0; q < 4; ++q) ss += (v[q].x * v[q].x + v[q].y * v[q].y) + (v[q].z * v[q].z + v[q].w * v[q].w);
        const float rstd = 1.0f / sqrtf(wave_sum(ss) * (1.0f / 1024.0f) + RMS_EPS);
        const float* mrow = modl + mr * 3072;
        GAS unsigned long long* o8 = (GAS unsigned long long*)(H + (size_t)row * 1024) + F.lane;
#pragma unroll
        for (int q = 0; q < 4; ++q) { const int c = 4 * F.lane + 256 * q;
            const f32x4 g = *(const f32x4*)(nw + c), sh = *(const f32x4*)(mrow + c), sc = *(const f32x4*)(mrow + 1024 + c);
            const f32x4 h = v[q] * rstd * g * (sc + 1.0f) + sh;
            o8[64 * q] = (unsigned long long)pk2(h.x, h.y) | ((unsigned long long)pk2(h.z, h.w) << 32); }
    }
}

struct P1Regs { u32x2 cq; unsigned ckv, h[3][2]; float rc[2], rs[2]; };
__device__ __forceinline__ void post1_load(const bf16* z, const float* rc, const float* rs, bool lat, int lane, P1Regs& R) {
    const int hg = lane >> 4, p0 = (lane & 15) * 2;
    R.cq = *(const u32x2*)(z + ZC_CQ + 4 * lane); R.ckv = *(const unsigned*)(z + ZC_CKV + 2 * lane);
    const bf16* h0 = z + ZC_SQ + hg * 64 + p0; const bf16* h1 = z + ZC_AQ + hg * 64 + p0; const bf16* h2 = z + ((hg < 2) ? (ZC_SK + hg * 64) : (ZC_AK + (hg - 2) * 64)) + p0;
    R.h[0][0] = *(const unsigned*)h0; R.h[0][1] = *(const unsigned*)(h0 + 32); R.h[1][0] = *(const unsigned*)h1; R.h[1][1] = *(const unsigned*)(h1 + 32); R.h[2][0] = *(const unsigned*)h2; R.h[2][1] = *(const unsigned*)(h2 + 32);
    if (lat) { R.rc[0] = rc[p0]; R.rc[1] = rc[p0 + 1]; R.rs[0] = rs[p0]; R.rs[1] = rs[p0 + 1]; } else { R.rc[0] = 1.f; R.rc[1] = 1.f; R.rs[0] = 0.f; R.rs[1] = 0.f; }
}
__device__ __forceinline__ void post1_finish(bf16* z, int lane, const P1Regs& R, const float (&gcq)[4], const float (&gckv)[2], const float (&gh)[3][4]) {
    const int hg = lane >> 4, p0 = (lane & 15) * 2;
    { float v0 = bflo(R.cq.x), v1 = bfhi(R.cq.x), v2 = bflo(R.cq.y), v3 = bfhi(R.cq.y);
      const float rstd = 1.0f / sqrtf(wave_sum(v0 * v0 + v1 * v1 + v2 * v2 + v3 * v3) * (1.0f / 256.0f) + RMS_EPS);
      u32x2 w; w.x = pk2(v0 * rstd * gcq[0], v1 * rstd * gcq[1]); w.y = pk2(v2 * rstd * gcq[2], v3 * rstd * gcq[3]); *(u32x2*)(z + ZC_CQ + 4 * lane) = w; }
    { float v0 = bflo(R.ckv), v1 = bfhi(R.ckv);
      const float rstd = 1.0f / sqrtf(wave_sum(v0 * v0 + v1 * v1) * (1.0f / 128.0f) + RMS_EPS);
      *(unsigned*)(z + ZC_CKV + 2 * lane) = pk2(v0 * rstd * gckv[0], v1 * rstd * gckv[1]); }
#pragma unroll
    for (int q = 0; q < 3; ++q) {
        bf16* hp = z + ((q == 0) ? (ZC_SQ + hg * 64) : (q == 1) ? (ZC_AQ + hg * 64) : ((hg < 2) ? (ZC_SK + hg * 64) : (ZC_AK + (hg - 2) * 64))) + p0;
        float a0 = bflo(R.h[q][0]), a1 = bfhi(R.h[q][0]), b0 = bflo(R.h[q][1]), b1 = bfhi(R.h[q][1]);
        const float rstd = 1.0f / sqrtf(grp16_sum(a0 * a0 + a1 * a1 + b0 * b0 + b1 * b1) * (1.0f / 64.0f) + RMS_EPS);
        a0 *= rstd * gh[q][0]; a1 *= rstd * gh[q][1]; b0 *= rstd * gh[q][2]; b1 *= rstd * gh[q][3];
        const float x0 = a0 * R.rc[0] - b0 * R.rs[0], y0 = b0 * R.rc[0] + a0 * R.rs[0], x1 = a1 * R.rc[1] - b1 * R.rs[1], y1 = b1 * R.rc[1] + a1 * R.rs[1];
        const float sc = (q < 2) ? QSCALE64 : 1.0f;
        *(unsigned*)hp = pk2(x0 * sc, x1 * sc); *(unsigned*)(hp + 32) = pk2(y0 * sc, y1 * sc);
    }
}
__device__ __forceinline__ void ph_post1(Frame& F, int l) {
    bf16* ZS = (bf16*)(F.ws + WS_ZS);
    const float* rhc = (const float*)(F.ws + WS_RHC); const float* rhs = (const float*)(F.ws + WS_RHS);
    const int lane = F.lane, hg = lane >> 4, p0 = (lane & 15) * 2;
    float gcq[4], gckv[2], gh[3][4];
#pragma unroll
    for (int i = 0; i < 4; ++i) gcq[i] = F.in(I_CQN)[l * 256 + 4 * lane + i];
    gckv[0] = F.in(I_CKVN)[l * 128 + 2 * lane]; gckv[1] = F.in(I_CKVN)[l * 128 + 2 * lane + 1];
    { const float* g0 = F.in(I_SQN) + l * 64; const float* g1 = F.in(I_AQN) + l * 64; const float* g2 = ((hg < 2) ? F.in(I_SKN) : F.in(I_AKN)) + l * 64;
      gh[0][0] = g0[p0]; gh[0][1] = g0[p0 + 1]; gh[0][2] = g0[32 + p0]; gh[0][3] = g0[33 + p0];
      gh[1][0] = g1[p0]; gh[1][1] = g1[p0 + 1]; gh[1][2] = g1[32 + p0]; gh[1][3] = g1[33 + p0];
      gh[2][0] = g2[p0]; gh[2][1] = g2[p0 + 1]; gh[2][2] = g2[32 + p0]; gh[2][3] = g2[33 + p0]; }
    for (int row = F.gw; row < NROWS; row += 2 * F.NGW) {
        const int row2 = row + F.NGW; const bool has2 = row2 < NROWS;
        const int j = row % TPB; const bool lat = j >= CTXL; const int pos = lat ? j - CTXL : 0;
        const int j2 = has2 ? row2 % TPB : 0; const bool lat2 = j2 >= CTXL; const int pos2 = lat2 ? j2 - CTXL : 0;
        bf16* z = ZS + (size_t)row * ZS_P; bf16* z2 = ZS + (size_t)(has2 ? row2 : row) * ZS_P;
        P1Regs A, B;
        post1_load(z, rhc + pos * 32, rhs + pos * 32, lat, lane, A);
        if (has2) post1_load(z2, rhc + pos2 * 32, rhs + pos2 * 32, lat2, lane, B);
        post1_finish(z, lane, A, gcq, gckv, gh);
        if (has2) post1_finish(z2, lane, B, gcq, gckv, gh);
    }
}
struct P2Regs { u32x2 qn, kn; bf16 q1, q2, k1, k2; float c, s; };
__device__ __forceinline__ void post2_load(const bf16* zrow, const bf16* mq, const bf16* mkv, const float* rc, const float* rs, bool lat, int lane, P2Regs& R) {
    const int h = lane >> 4, j = lane & 15;
    R.qn = *(const u32x2*)(mq + h * 96 + 4 * j); R.q1 = mq[h * 96 + 64 + j]; R.q2 = mq[h * 96 + 80 + j];
    R.kn = *(const u32x2*)(mkv + h * 128 + 4 * j); R.k1 = zrow[ZC_KR + j]; R.k2 = zrow[ZC_KR + 16 + j];
    if (lat) { R.c = rc[j]; R.s = rs[j]; } else { R.c = 1.f; R.s = 0.f; }
}
__device__ __forceinline__ void post2_finish(bf16* mq, bf16* mk, int lane, const P2Regs& R, const float (&gq)[6], const float (&gk)[6]) {
    const int h = lane >> 4, j = lane & 15;
#pragma unroll
    for (int qk = 0; qk < 2; ++qk) {
        const u32x2 n = qk == 0 ? R.qn : R.kn; float v0 = bflo(n.x), v1 = bfhi(n.x), v2 = bflo(n.y), v3 = bfhi(n.y), r1 = bf2f(qk == 0 ? R.q1 : R.k1), r2 = bf2f(qk == 0 ? R.q2 : R.k2);
        const float rstd = 1.0f / sqrtf(grp16_sum(v0 * v0 + v1 * v1 + v2 * v2 + v3 * v3 + r1 * r1 + r2 * r2) * (1.0f / 96.0f) + RMS_EPS);
        const float (&g)[6] = qk == 0 ? gq : gk; const float sc = qk == 0 ? QSCALE96 : 1.0f;
        const float y1 = r1 * rstd * g[4], y2 = r2 * rstd * g[5];
        const float t1 = (y1 * R.c - y2 * R.s) * sc, t2 = (y2 * R.c + y1 * R.s) * sc;
        bf16* o = (qk == 0 ? mq : mk) + h * 96;
        u32x2 w; w.x = pk2(v0 * rstd * g[0] * sc, v1 * rstd * g[1] * sc); w.y = pk2(v2 * rstd * g[2] * sc, v3 * rstd * g[3] * sc);
        *(u32x2*)(o + 4 * j) = w; o[64 + j] = (bf16)f2bf(t1); o[80 + j] = (bf16)f2bf(t2);
    }
}
__device__ __forceinline__ void ph_post2(Frame& F, int l) {
    const bf16* ZS = (const bf16*)(F.ws + WS_ZS); bf16* MQ = (bf16*)(F.ws + WS_MQ); const bf16* MKV = (const bf16*)(F.ws + WS_MKV); bf16* MK = (bf16*)(F.ws + WS_MK);
    const float* rmc = (const float*)(F.ws + WS_RMC); const float* rms = (const float*)(F.ws + WS_RMS);
    const int lane = F.lane, jj = lane & 15;
    float gq[6], gk[6];
    { const float* a = F.in(I_MQN) + l * 96; const float* b = F.in(I_MKN) + l * 96;
#pragma unroll
      for (int i = 0; i < 4; ++i) { gq[i] = a[4 * jj + i]; gk[i] = b[4 * jj + i]; }
      gq[4] = a[64 + jj]; gq[5] = a[80 + jj]; gk[4] = b[64 + jj]; gk[5] = b[80 + jj]; }
    for (int row = F.gw; row < NROWS; row += 2 * F.NGW) {
        const int row2 = row + F.NGW; const bool has2 = row2 < NROWS; const size_t rb = has2 ? row2 : row;
        const int j = row % TPB; const bool lat = j >= CTXL; const int pos = lat ? j - CTXL : 0;
        const int j2 = (int)(rb % TPB); const bool lat2 = j2 >= CTXL; const int pos2 = lat2 ? j2 - CTXL : 0;
        P2Regs A, B;
        post2_load(ZS + (size_t)row * ZS_P, MQ + (size_t)row * 512, MKV + (size_t)row * 512, rmc + pos * 16, rms + pos * 16, lat, lane, A);
        if (has2) post2_load(ZS + rb * ZS_P, MQ + rb * 512, MKV + rb * 512, rmc + pos2 * 16, rms + pos2 * 16, lat2, lane, B);
        post2_finish(MQ + (size_t)row * 512, MK + (size_t)row * 384, lane, A, gq, gk);
        if (has2) post2_finish(MQ + rb * 512, MK + rb * 384, lane, B, gq, gk);
    }
}

template <int DQK>
__device__ __forceinline__ void attn_row_naive(const bf16* q, const bf16* Kb, int kp, const bf16* Vb, int vp, int n1, int lo2, int hi2, bool has_sink, float sink2, bf16* y, int lane) {
    float qf[DQK];
#pragma unroll
    for (int c = 0; c < DQK / 8; ++c) { const v4u w = *(const v4u*)(q + 8 * c);
        qf[8 * c + 0] = bflo(w.x); qf[8 * c + 1] = bfhi(w.x); qf[8 * c + 2] = bflo(w.y); qf[8 * c + 3] = bfhi(w.y); qf[8 * c + 4] = bflo(w.z); qf[8 * c + 5] = bfhi(w.z); qf[8 * c + 6] = bflo(w.w); qf[8 * c + 7] = bfhi(w.w); }
    float m = -INFINITY, l = 0.f; float acc[64];
#pragma unroll
    for (int d = 0; d < 64; ++d) acc[d] = 0.f;
    for (int seg = 0; seg < 2; ++seg) {
        const int k0 = seg == 0 ? 0 : lo2, k1 = seg == 0 ? n1 : hi2;
        for (int key = k0 + lane; key < k1; key += 64) {
            const bf16* kr = Kb + (size_t)key * kp; float s = 0.f;
#pragma unroll
            for (int c = 0; c < DQK / 8; ++c) { const v4u w = *(const v4u*)(kr + 8 * c);
                s += qf[8 * c + 0] * bflo(w.x) + qf[8 * c + 1] * bfhi(w.x) + qf[8 * c + 2] * bflo(w.y) + qf[8 * c + 3] * bfhi(w.y) + qf[8 * c + 4] * bflo(w.z) + qf[8 * c + 5] * bfhi(w.z) + qf[8 * c + 6] * bflo(w.w) + qf[8 * c + 7] * bfhi(w.w); }
            if (s > m) { const float f = exp2f(m - s); l *= f;
#pragma unroll
                for (int d = 0; d < 64; ++d) acc[d] *= f;
                m = s; }
            const float p = exp2f(s - m); l += p;
            const bf16* vr = Vb + (size_t)key * vp;
#pragma unroll
            for (int c = 0; c < 8; ++c) { const v4u w = *(const v4u*)(vr + 8 * c);
                acc[8 * c + 0] += p * bflo(w.x); acc[8 * c + 1] += p * bfhi(w.x); acc[8 * c + 2] += p * bflo(w.y); acc[8 * c + 3] += p * bfhi(w.y); acc[8 * c + 4] += p * bflo(w.z); acc[8 * c + 5] += p * bfhi(w.z); acc[8 * c + 6] += p * bflo(w.w); acc[8 * c + 7] += p * bfhi(w.w); }
        }
    }
    float M = wave_max(m); if (has_sink) M = fmaxf(M, sink2);
    const float f = (m == -INFINITY) ? 0.f : exp2f(m - M);
    float L = wave_sum(l * f); if (has_sink) L += exp2f(sink2 - M);
    float mine = 0.f;
#pragma unroll
    for (int d = 0; d < 64; ++d) { const float t = wave_sum(acc[d] * f); if (lane == d) mine = t; }
    y[lane] = (bf16)f2bf(mine / L * bf2f(y[lane]));
}
__device__ __forceinline__ void ph_attn_naive(Frame& F, int l) {
    const bf16* ZS = (const bf16*)(F.ws + WS_ZS); const bf16* MQ = (const bf16*)(F.ws + WS_MQ); const bf16* MKV = (const bf16*)(F.ws + WS_MKV); const bf16* MK = (const bf16*)(F.ws + WS_MK);
    bf16* Y = (bf16*)(F.ws + WS_G);
    const long nitems = (long)NROWS * 12;
    for (long it = F.gw; it < nitems; it += F.NGW) {
        const int hb = (int)(it % 12); const int row = (int)(it / 12);
        const int b = row / TPB, j = row % TPB; const bool lat = j >= CTXL;
        if (!lat && l == NLAYER - 1) continue;
        const size_t r0 = (size_t)b * TPB;
        const int br = hb >> 2, h = hb & 3;
        bf16* y = Y + (size_t)row * 1024 + br * 256 + h * 64;
        if (br == 0) {
            attn_row_naive<96>(MQ + (size_t)row * 512 + h * 96, MK + r0 * 384 + h * 96, 384, MKV + r0 * 512 + h * 128 + 64, 512, CTXL, CTXL, lat ? TPB : CTXL, false, 0.f, y, F.lane);
        } else if (br == 1) {
            const int t = j - CTXL; int lo = CTXL, hi = CTXL;
            if (lat) { lo = CTXL + (t - 128 < 0 ? 0 : t - 128); hi = CTXL + (t + 128 > SEQ - 1 ? SEQ - 1 : t + 128) + 1; }
            attn_row_naive<64>(ZS + (size_t)row * ZS_P + ZC_SQ + h * 64, ZS + r0 * ZS_P + ZC_SK + (h >> 1) * 64, ZS_P, ZS + r0 * ZS_P + ZC_SV + (h >> 1) * 64, ZS_P, CTXL, lo, hi, true, F.in(I_SINK)[l * 4 + h] * LOG2E, y, F.lane);
        } else {
            attn_row_naive<64>(ZS + (size_t)row * ZS_P + ZC_AQ + h * 64, ZS + r0 * ZS_P + ZC_AK + (h >> 1) * 64, ZS_P, ZS + r0 * ZS_P + ZC_AV + (h >> 1) * 64, ZS_P, CTXL, CTXL, lat ? TPB : CTXL, false, 0.f, y, F.lane);
        }
    }
}

__device__ __forceinline__ void ph_lru_conv(Frame& F, int l) {
    const bf16* ZS = (const bf16*)(F.ws + WS_ZS); float* U = (float*)(F.ws + WS_U);
    const float* cw = F.in(I_CONVW) + l * 4 * 256; const float* cb = F.in(I_CONVB) + l * 256;
    const int gt = F.vcu * NTHREADS + F.tid, ngt = F.G * NTHREADS;
    for (int idx = gt; idx < NROWS * 256; idx += ngt) {
        const int row = idx >> 8, c = idx & 255, b = row / TPB, j = row % TPB;
        int s0, len, jj; if (j < CTXL) { s0 = b * TPB; len = CTXL; jj = j; } else { s0 = b * TPB + CTXL; len = SEQ; jj = j - CTXL; }
        float acc = cb[c];
#pragma unroll
        for (int i = 0; i < 4; ++i) { const int t = jj + i - 2; if (t >= 0 && t < len) acc += cw[i * 256 + c] * bf2f(ZS[(size_t)(s0 + t) * ZS_P + ZC_LRU + c]); }
        U[idx] = acc;
    }
}
__device__ __forceinline__ void ph_lru_scan(Frame& F, int l, int dir) {
    const float* U = (const float*)(F.ws + WS_U); float* HF = (float*)(F.ws + WS_HF); bf16* Y = (bf16*)(F.ws + WS_G);
    const int g = blockIdx.x * NTHREADS + F.tid;
    if (g < NB * 256) {
    const int b = g >> 8, c = g & 255, k = c >> 6, jc = c & 63;
    const float* wr = F.in(I_LWR) + ((((size_t)l * 2 + dir) * 4 + k) * 64) * 64 + jc;
    const float* wi = F.in(I_LWI) + ((((size_t)l * 2 + dir) * 4 + k) * 64) * 64 + jc;
    float wrr[64], wii[64];
#pragma unroll
    for (int i = 0; i < 64; ++i) { wrr[i] = wr[i * 64]; wii[i] = wi[i * 64]; }
    const float br = F.in(I_LBR)[(l * 2 + dir) * 256 + c], bi = F.in(I_LBI)[(l * 2 + dir) * 256 + c];
    const float lam = F.in(I_LAM)[(l * 2 + dir) * 256 + c];
    const float sp = log1pf(expf(-lam));
    float h = 0.f;
    for (int s = 0; s < TPB; ++s) {
        const int j = dir == 0 ? s : (s < CTXL ? CTXL - 1 - s : TPB + CTXL - 1 - s);
        const size_t row = (size_t)b * TPB + j;
        const float* ub = U + row * 256 + k * 64;
        float rp = br, ip = bi;
#pragma unroll
        for (int i = 0; i < 64; ++i) { const float uv = ub[i]; rp += uv * wrr[i]; ip += uv * wii[i]; }
        const float r = 1.0f / (1.0f + expf(-rp)), ig = 1.0f / (1.0f + expf(-ip));
        const float la = -8.0f * r * sp; const float a = expf(la);
        const float bx = sqrtf(-expm1f(2.0f * la)) * (ig * ub[jc]);
        h = a * h + bx;
        if (dir == 0) HF[row * 256 + c] = h;
        else { bf16* y = Y + row * 1024 + 768 + c; *y = (bf16)f2bf((HF[row * 256 + c] + h) * bf2f(*y)); }
    }
    }
}
__device__ __forceinline__ void ph_mixsum_ctx(Frame& F) {
    const bf16* S = (const bf16*)(F.ws + WS_S); bf16* MIX = (bf16*)(F.ws + WS_H);
    const int gt = F.vcu * NTHREADS + F.tid, ngt = F.G * NTHREADS;
    for (int idx = gt; idx < NB * CTXL * 128; idx += ngt) {
        const int r = idx >> 7, c8 = (idx & 127) * 8; const size_t row = (size_t)(r >> 8) * TPB + (r & 255); float s[8] = {0.f, 0.f, 0.f, 0.f, 0.f, 0.f, 0.f, 0.f};
#pragma unroll
        for (int k = 0; k < 4; ++k) { const v4u w = *(const GAS v4u*)(S + row * 4096 + k * 1024 + c8);
            s[0] += bflo(w.x); s[1] += bfhi(w.x); s[2] += bflo(w.y); s[3] += bfhi(w.y); s[4] += bflo(w.z); s[5] += bfhi(w.z); s[6] += bflo(w.w); s[7] += bfhi(w.w); }
        v4u o; o.x = pk2(s[0], s[1]); o.y = pk2(s[2], s[3]); o.z = pk2(s[4], s[5]); o.w = pk2(s[6], s[7]);
        *(GAS v4u*)(MIX + row * 1024 + c8) = o;
    }
}
namespace att {
typedef short bf16x8 __attribute__((ext_vector_type(8)));
typedef short s16x4 __attribute__((ext_vector_type(4)));
typedef short v4i16_t __attribute__((ext_vector_type(4)));
typedef float f32x16 __attribute__((ext_vector_type(16)));
typedef unsigned u32x4 __attribute__((ext_vector_type(4)));
typedef __attribute__((address_space(3))) const char* lds_cptr;
typedef float f32x2_t __attribute__((ext_vector_type(2))); typedef __bf16 bf16x2_t __attribute__((ext_vector_type(2)));
__device__ __forceinline__ int crow(int r, int hi) { return (r & 3) + 8 * (r >> 2) + 4 * hi; }
__device__ __forceinline__ void glds16(const void* gsrc, unsigned lds_dst) { unsigned keep;
    asm volatile("s_mov_b32 %0, m0\n\ts_mov_b32 m0, %2\n\ts_nop 0\n\tglobal_load_lds_dwordx4 %1, off\n\ts_mov_b32 m0, %0" : "=&s"(keep) : "v"(gsrc), "s"(lds_dst) : "memory"); }
__device__ __forceinline__ unsigned cvtpk(float lo, float hi) { f32x2_t v = {lo, hi}; bf16x2_t b = __builtin_convertvector(v, bf16x2_t); return __builtin_bit_cast(unsigned, b); }
__device__ __forceinline__ s16x4 vtr(lds_cptr p) { return __builtin_bit_cast(s16x4, __builtin_amdgcn_ds_read_tr16_b64_v4i16((__attribute__((address_space(3))) v4i16_t*)p)); }
__device__ __forceinline__ float halfswap_max(float m) { auto rr = __builtin_amdgcn_permlane32_swap(__float_as_uint(m), __float_as_uint(m), false, false); return fmaxf(__uint_as_float(rr[0]), __uint_as_float(rr[1])); }
__device__ __forceinline__ float halfswap_sum(float m) { auto rr = __builtin_amdgcn_permlane32_swap(__float_as_uint(m), __float_as_uint(m), false, false); return __uint_as_float(rr[0]) + __uint_as_float(rr[1]); }

template <int DQK> struct Cfg {
    static constexpr int KCH = DQK / 8, KSLOT = KCH * 1024, NKI = (KCH + 7) / 8, NI = NKI + 1;
    static constexpr int LDS_K = 0, LDS_V = 3 * KSLOT, LDS_WS = LDS_V + 3 * 8192, LDS_OST = LDS_WS + 8 * 256, BYTES = LDS_OST + 8 * 4096;
};
#define ATT_WAIT_BAR(N) asm volatile("s_waitcnt vmcnt(" #N ") lgkmcnt(0)\n\ts_barrier" ::: "memory")

struct UnitDesc {
    const unsigned short* Q; int qp;
    const unsigned short* K; int kp;
    const unsigned short* V; int vp;
    unsigned short* Y;
    int NT;
    int lat_row0;
    int qpos0, spos0;
    int has_sink; float sink2;
};

template <int DQK, bool SWA>
__device__ __forceinline__ void attn_unit(LAS unsigned char* ldsb, const UnitDesc& U, const int tid) {
    using C = Cfg<DQK>;
    const int lane = tid & 63, r32 = lane & 31, hi = lane >> 5; const int wid = __builtin_amdgcn_readfirstlane(tid >> 6);
    const unsigned lds0 = (unsigned)(uintptr_t)ldsb;
    LAS float* wsf = (LAS float*)(ldsb + C::LDS_WS) + wid * 64;
    const int kp = U.kp, vp = U.vp;
    const int kc1 = (C::NKI == 2 && wid < 4) ? wid + 8 : wid;
    const unsigned short* ksrc0 = U.K + (size_t)lane * kp + wid * 8;
    const unsigned short* ksrc1 = U.K + (size_t)lane * kp + kc1 * 8;
    const unsigned short* vsrc = U.V + (size_t)(16 * (wid & 3) + (lane >> 2)) * vp + (wid >> 2) * 32 + (lane & 3) * 8;
    const unsigned kdst0 = lds0 + C::LDS_K + wid * 1024, kdst1 = lds0 + C::LDS_K + kc1 * 1024, vdst = lds0 + C::LDS_V + wid * 1024;
    const int NT = U.NT;
#define ATT_KROW(t) (SWA ? ((t) < 4 ? 64 * (t) : U.lat_row0 + 64 * ((t) - 4)) : 64 * (t))
#define ATT_DMA_K(t, slot) do { const size_t ro_ = (size_t)ATT_KROW(t); \
        glds16(ksrc0 + ro_ * kp, (unsigned)__builtin_amdgcn_readfirstlane(kdst0 + (slot) * C::KSLOT)); \
        if (C::NKI == 2) glds16(ksrc1 + ro_ * kp, (unsigned)__builtin_amdgcn_readfirstlane(kdst1 + (slot) * C::KSLOT)); } while (0)
#define ATT_DMA_V(t, slot) do { const size_t ro_ = (size_t)ATT_KROW(t); glds16(vsrc + ro_ * vp, (unsigned)__builtin_amdgcn_readfirstlane(vdst + (slot) * 8192)); } while (0)
#define ATT_KLOAD(kslot) do { if (!SWA) { const lds_cptr kb_ = (lds_cptr)(ldsb + C::LDS_K) + (kslot) * C::KSLOT + hi * 1024 + r32 * 16; \
        _Pragma("unroll") for (int d0 = 0; d0 < DQK / 16; ++d0) { kf[2 * d0] = *(const __attribute__((address_space(3))) bf16x8*)(kb_ + d0 * 2048); kf[2 * d0 + 1] = *(const __attribute__((address_space(3))) bf16x8*)(kb_ + d0 * 2048 + 512); } } } while (0)
#define ATT_QKM(P0, P1, CINIT, kslot) do { P0 = f32x16{}; P1 = f32x16{}; \
        const lds_cptr kq_ = (lds_cptr)(ldsb + C::LDS_K) + (kslot) * C::KSLOT + hi * 1024 + r32 * 16; \
        _Pragma("unroll") for (int d0 = 0; d0 < DQK / 16; ++d0) { \
            const bf16x8 b0_ = SWA ? *(const __attribute__((address_space(3))) bf16x8*)(kq_ + d0 * 2048) : kf[2 * d0]; const bf16x8 b1_ = SWA ? *(const __attribute__((address_space(3))) bf16x8*)(kq_ + d0 * 2048 + 512) : kf[2 * d0 + 1]; \
            P0 = __builtin_amdgcn_mfma_f32_32x32x16_bf16(b0_, qr[d0], P0, 0, 0, 0); P1 = __builtin_amdgcn_mfma_f32_32x32x16_bf16(b1_, qr[d0], P1, 0, 0, 0); } } while (0)
#define ATT_VLOAD(vslot) do { if (!SWA) { const lds_cptr vb_ = (lds_cptr)(ldsb + C::LDS_V) + (vslot) * 8192 + ((lane >> 4) & 1) * 32 + (lane & 3) * 8 + (4 * hi + ((lane & 15) >> 2)) * 64; \
        _Pragma("unroll") for (int i = 0; i < 8; ++i) { vl[i] = vtr(vb_ + (i >> 2) * 4096 + (i & 3) * 1024); vh[i] = vtr(vb_ + (i >> 2) * 4096 + (i & 3) * 1024 + 512); } } } while (0)
#define ATT_MX3(a, b, c) __builtin_fmaxf(__builtin_fmaxf((a), (b)), (c))
#define ATT_NEEDMASK(j) ((j) >= 4 && U.qpos0 >= 0 && !((U.spos0 + 64 * ((j) - 4) + 63 - (U.qpos0 + 32 * wid) <= 128) && ((U.qpos0 + 32 * wid + 31) - (U.spos0 + 64 * ((j) - 4)) <= 128)))
#define ATT_SMPV(P0, P1, N0, N1, HASNEXT, t, vslot) do { \
        if (SWA && ATT_NEEDMASK(t)) { const bool mk_ = true; const int sb_ = U.spos0 + 64 * ((t) - 4) + 4 * hi;        \
            _Pragma("unroll") for (int r = 0; r < 16; ++r) { const int dd_ = qpos - (sb_ + (r & 3) + 8 * (r >> 2)); \
                P0[r] = (mk_ && (dd_ > 128 || dd_ < -128)) ? -INFINITY : P0[r]; P1[r] = (mk_ && (dd_ - 32 > 128 || dd_ - 32 < -128)) ? -INFINITY : P1[r]; } } \
        float ls_ = 0.f; \
        _Pragma("unroll") for (int r = 0; r < 16; ++r) { P0[r] = __builtin_amdgcn_exp2f(P0[r]); P1[r] = __builtin_amdgcn_exp2f(P1[r]); ls_ += P0[r] + P1[r]; } \
        l += ls_; \
        if (!SWA && DQK != 64) { __builtin_amdgcn_sched_barrier(0); ATT_VLOAD(vslot); } \
        u32x4 pw_[4]; \
        pw_[0] = (u32x4){cvtpk(P0[0], P0[1]), cvtpk(P0[2], P0[3]), cvtpk(P0[4], P0[5]), cvtpk(P0[6], P0[7])}; \
        pw_[1] = (u32x4){cvtpk(P0[8], P0[9]), cvtpk(P0[10], P0[11]), cvtpk(P0[12], P0[13]), cvtpk(P0[14], P0[15])}; \
        pw_[2] = (u32x4){cvtpk(P1[0], P1[1]), cvtpk(P1[2], P1[3]), cvtpk(P1[4], P1[5]), cvtpk(P1[6], P1[7])}; \
        pw_[3] = (u32x4){cvtpk(P1[8], P1[9]), cvtpk(P1[10], P1[11]), cvtpk(P1[12], P1[13]), cvtpk(P1[14], P1[15])}; \
        const lds_cptr vq_ = (lds_cptr)(ldsb + C::LDS_V) + (vslot) * 8192 + ((lane >> 4) & 1) * 32 + (lane & 3) * 8 + (4 * hi + ((lane & 15) >> 2)) * 64; \
        _Pragma("unroll") for (int d0 = 0; d0 < 2; ++d0) \
            _Pragma("unroll") for (int ks = 0; ks < 4; ++ks) { \
                const s16x4 lo_ = SWA ? vtr(vq_ + d0 * 4096 + ks * 1024) : vl[4 * d0 + ks], hh_ = SWA ? vtr(vq_ + d0 * 4096 + ks * 1024 + 512) : vh[4 * d0 + ks]; \
                const bf16x8 vf_ = (bf16x8){lo_[0], lo_[1], lo_[2], lo_[3], hh_[0], hh_[1], hh_[2], hh_[3]}; \
                o[d0] = __builtin_amdgcn_mfma_f32_32x32x16_bf16(__builtin_bit_cast(bf16x8, pw_[ks]), vf_, o[d0], 0, 0, 0); } } while (0)
#define ATT_SKIP(j) (SWA && (j) >= 4 && U.qpos0 >= 0 && ((U.spos0 + 64 * ((j) - 4) > U.qpos0 + 32 * wid + 31 + 128) || (U.spos0 + 64 * ((j) - 4) + 63 < U.qpos0 + 32 * wid - 128)))
#define ATT_STEP(C0, C1, N0, N1, t) do { \
        const int k3_ = (ks1 == 0) ? 2 : ks1 - 1, v2_ = (vs0 == 0) ? 2 : vs0 - 1; \
        if ((t) + 3 < NT) ATT_DMA_K((t) + 3, k3_); \
        if ((t) + 2 < NT) ATT_DMA_V((t) + 2, v2_); \
        ATT_KLOAD(ks1); \
        if (!SWA) __builtin_amdgcn_sched_barrier(0);        \
        if (!SWA || !ATT_SKIP((t) + 1)) ATT_QKM(N0, N1, -m, ks1); \
        if (DQK == 64) ATT_VLOAD(vs0);        \
        if (!SWA) __builtin_amdgcn_sched_barrier(0); \
        if (!SWA || !ATT_SKIP(t)) ATT_SMPV(C0, C1, N0, N1, true, t, vs0); \
        if ((t) + 3 < NT) { if (C::NI == 2) ATT_WAIT_BAR(2); else ATT_WAIT_BAR(3); } else ATT_WAIT_BAR(0); \
        ks1 = (ks1 == 2) ? 0 : ks1 + 1; vs0 = (vs0 == 2) ? 0 : vs0 + 1; } while (0)
    ATT_DMA_K(0, 0);
    ATT_DMA_K(1, 1); ATT_DMA_V(0, 0);
    ATT_DMA_K(2, 2); ATT_DMA_V(1, 1);
    bf16x8 qr[DQK / 16];
    { const unsigned short* qw = U.Q + (size_t)(wid * 32 + r32) * U.qp + hi * 8;
#pragma unroll
      for (int d0 = 0; d0 < DQK / 16; ++d0) qr[d0] = *(const bf16x8*)(qw + d0 * 16); }
    const float m = 0.f; float l = 0.f;
    f32x16 o[2]; o[0] = f32x16{}; o[1] = f32x16{};
    const int qpos = U.qpos0 + wid * 32 + r32;
    f32x16 pa0, pa1, pb0, pb1;
    bf16x8 kf[DQK / 8]; s16x4 vl[8], vh[8];
    if (C::NI == 2) ATT_WAIT_BAR(4); else ATT_WAIT_BAR(6);
    ATT_KLOAD(0); ATT_QKM(pa0, pa1, 0.f, 0);
    if (C::NI == 2) ATT_WAIT_BAR(2); else ATT_WAIT_BAR(3);
    int ks1 = 1, vs0 = 0;
    int t = 0;
    if (SWA) { for (; t + 1 < NT; ++t) { ATT_STEP(pa0, pa1, pb0, pb1, t); pa0 = pb0; pa1 = pb1; } if (!ATT_SKIP(NT - 1)) ATT_SMPV(pa0, pa1, pa0, pa1, false, NT - 1, vs0); }
    else {
    for (; t + 2 < NT; t += 2) { ATT_STEP(pa0, pa1, pb0, pb1, t); ATT_STEP(pb0, pb1, pa0, pa1, t + 1); }
    if (t + 1 < NT) { ATT_STEP(pa0, pa1, pb0, pb1, t); if (DQK == 64) ATT_VLOAD(vs0); ATT_SMPV(pb0, pb1, pb0, pb1, false, NT - 1, vs0); }
    else { if (DQK == 64) ATT_VLOAD(vs0); ATT_SMPV(pa0, pa1, pa0, pa1, false, NT - 1, vs0); }
    }
    l = halfswap_sum(l);
    if (U.has_sink) l += __builtin_amdgcn_exp2f(U.sink2 - m);
    if (hi == 0) wsf[32 + r32] = l;
    asm volatile("s_waitcnt lgkmcnt(0)" ::: "memory");
    { LAS unsigned short* stg = (LAS unsigned short*)(ldsb + C::LDS_OST) + wid * 2048;
#pragma unroll
      for (int r = 0; r < 16; ++r) { const int orow = crow(r, hi); const float rl = __builtin_amdgcn_rcpf(wsf[32 + orow]);
          stg[orow * 64 + r32] = (unsigned short)f2bf(o[0][r] * rl); stg[orow * 64 + 32 + r32] = (unsigned short)f2bf(o[1][r] * rl); }
      asm volatile("s_waitcnt lgkmcnt(0)" ::: "memory");
      unsigned short* yw = U.Y + (size_t)(wid * 32) * 1024;
#pragma unroll
      for (int i = 0; i < 4; ++i) { const int row = i * 8 + (lane >> 3), ch = lane & 7;
          const u32x4 ov = *(const LAS u32x4*)(stg + row * 64 + ch * 8);
          u32x4* gp = (u32x4*)(yw + (size_t)row * 1024 + ch * 8); const u32x4 g = *gp;
          u32x4 w; w.x = pk2(bflo(ov.x) * bflo(g.x), bfhi(ov.x) * bfhi(g.x)); w.y = pk2(bflo(ov.y) * bflo(g.y), bfhi(ov.y) * bfhi(g.y));
          w.z = pk2(bflo(ov.z) * bflo(g.z), bfhi(ov.z) * bfhi(g.z)); w.w = pk2(bflo(ov.w) * bflo(g.w), bfhi(ov.w) * bfhi(g.w));
          *gp = w; } }
    asm volatile("s_waitcnt vmcnt(0) lgkmcnt(0)\n\ts_barrier" ::: "memory");
#undef ATT_KROW
#undef ATT_DMA_K
#undef ATT_DMA_V
#undef ATT_KLOAD
#undef ATT_QKM
#undef ATT_VLOAD
#undef ATT_STEP
#undef ATT_SKIP
#undef ATT_SMPV
#undef ATT_MX3
#undef ATT_NEEDMASK
}
}

__device__ __forceinline__ void ph_attn(Frame& F, int l) {
    unsigned short* ZS = (unsigned short*)(F.ws + WS_ZS); unsigned short* MQ = (unsigned short*)(F.ws + WS_MQ); unsigned short* MKV = (unsigned short*)(F.ws + WS_MKV); unsigned short* MK = (unsigned short*)(F.ws + WS_MK);
    unsigned short* Y = (unsigned short*)(F.ws + WS_G);
    LAS unsigned char* lds = F.lds + RING_OFF;
    const int u = F.vcu;
    const bool ctxq = (l == 0);
    for (int uu = u; uu < 256; uu += F.G) { const int bh = uu >> 4, qb = uu & 15, b = bh >> 2, h = bh & 3; const size_t r0 = (size_t)b * TPB, rq = r0 + CTXL + qb * 256;
        att::UnitDesc U{MQ + rq * 512 + h * 96, 512, MK + r0 * 384 + h * 96, 384, MKV + r0 * 512 + h * 128 + 64, 512, Y + rq * 1024 + h * 64, TPB / 64, 0, -1, 0, 0, 0.f};
        att::attn_unit<96, false>(lds, U, F.tid); }
    for (int uu = u; uu < 256; uu += F.G) { const int qb = uu & 15, g = (uu >> 4) & 1, kvh = (uu >> 5) & 1, b = uu >> 6, qh = kvh * 2 + g; const size_t r0 = (size_t)b * TPB, rq = r0 + CTXL + qb * 256;
        att::UnitDesc U{ZS + rq * ZS_P + ZC_AQ + qh * 64, ZS_P, ZS + r0 * ZS_P + ZC_AK + kvh * 64, ZS_P, ZS + r0 * ZS_P + ZC_AV + kvh * 64, ZS_P, Y + rq * 1024 + 512 + qh * 64, TPB / 64, 0, -1, 0, 0, 0.f};
        att::attn_unit<64, false>(lds, U, F.tid); }
    for (int uu = u; uu < 256; uu += F.G) { const int qb = uu & 15, g = (uu >> 4) & 1, kvh = (uu >> 5) & 1, b = uu >> 6, qh = kvh * 2 + g; const size_t r0 = (size_t)b * TPB, rq = r0 + CTXL + qb * 256;
        const int q0 = qb * 256, s0 = (q0 - 128 < 0) ? 0 : q0 - 128, s1 = (q0 + 384 > SEQ) ? SEQ : q0 + 384;
        att::UnitDesc U{ZS + rq * ZS_P + ZC_SQ + qh * 64, ZS_P, ZS + r0 * ZS_P + ZC_SK + kvh * 64, ZS_P, ZS + r0 * ZS_P + ZC_SV + kvh * 64, ZS_P, Y + rq * 1024 + 256 + qh * 64, 4 + (s1 - s0) / 64, CTXL + s0, q0, s0, 1, F.in(I_SINK)[l * 4 + qh] * LOG2E};
        att::attn_unit<64, true>(lds, U, F.tid); }
    if (ctxq) for (int uu = u; uu < 48; uu += F.G) { const int br = uu >> 4, b = (uu >> 2) & 3, h = uu & 3; const size_t r0 = (size_t)b * TPB;
        if (br == 0) { att::UnitDesc U{MQ + r0 * 512 + h * 96, 512, MK + r0 * 384 + h * 96, 384, MKV + r0 * 512 + h * 128 + 64, 512, Y + r0 * 1024 + h * 64, 4, 0, -1, 0, 0, 0.f};
            att::attn_unit<96, false>(lds, U, F.tid); }
        else if (br == 1) { att::UnitDesc U{ZS + r0 * ZS_P + ZC_SQ + h * 64, ZS_P, ZS + r0 * ZS_P + ZC_SK + (h >> 1) * 64, ZS_P, ZS + r0 * ZS_P + ZC_SV + (h >> 1) * 64, ZS_P, Y + r0 * 1024 + 256 + h * 64, 4, CTXL, -1, 0, 1, F.in(I_SINK)[l * 4 + h] * LOG2E};
            att::attn_unit<64, true>(lds, U, F.tid); }
        else { att::UnitDesc U{ZS + r0 * ZS_P + ZC_AQ + h * 64, ZS_P, ZS + r0 * ZS_P + ZC_AK + (h >> 1) * 64, ZS_P, ZS + r0 * ZS_P + ZC_AV + (h >> 1) * 64, ZS_P, Y + r0 * 1024 + 512 + h * 64, 4, 0, -1, 0, 0, 0.f};
            att::attn_unit<64, false>(lds, U, F.tid); } }
}
constexpr size_t WS_SUM = 253 * MiB;
constexpr size_t WS_HL = WS_U, WS_CP = WS_HF;
constexpr int NCHUNK = TPB / 64;
__device__ __forceinline__ float swap_lo(float x) { auto rr = __builtin_amdgcn_permlane32_swap(__float_as_uint(x), __float_as_uint(x), false, false); return __uint_as_float(rr[0]); }
__device__ __forceinline__ float swap_hi(float x) { auto rr = __builtin_amdgcn_permlane32_swap(__float_as_uint(x), __float_as_uint(x), false, false); return __uint_as_float(rr[1]); }
__device__ __forceinline__ void ph_lru1(Frame& F, int l) {
    typedef short bf16x8 __attribute__((ext_vector_type(8))); typedef float f32x16 __attribute__((ext_vector_type(16)));
    const unsigned short* ZS = (const unsigned short*)(F.ws + WS_ZS); unsigned short* HL = (unsigned short*)(F.ws + WS_HL); unsigned short* CP = (unsigned short*)(F.ws + WS_CP);
    f32x2v* SUM = (f32x2v*)(F.ws + WS_SUM);
    constexpr int UP = 264;
    LAS unsigned short* ul = (LAS unsigned short*)(F.lds + RING_OFF);
    const float* cw = F.in(I_CONVW) + l * 4 * 256; const float* cb = F.in(I_CONVB) + l * 256;
    const int tid = F.tid, lane = tid & 63, r32 = lane & 31, hi = lane >> 5, k = F.wave & 3, d = F.wave >> 2;
    const int nfull = (NB * NCHUNK < F.G) ? NB * NCHUNK : F.G, nhalf = 2 * (NB * NCHUNK - nfull);
    for (int wi = F.vcu; wi < nfull + nhalf; wi += F.G) {
        const int unit = (wi < nfull) ? wi : nfull + ((wi - nfull) >> 1);
        const int tn_lo = (wi < nfull) ? 0 : ((wi - nfull) & 1), tn_hi = (wi < nfull) ? 2 : tn_lo + 1;
        const int b = unit / NCHUNK, ci = unit % NCHUNK;
        int s0row, len, t0; if (ci < 4) { s0row = b * TPB; len = CTXL; t0 = ci * 64; } else { s0row = b * TPB + CTXL; len = SEQ; t0 = (ci - 4) * 64; }
        { const int cc = tid & 255, hh = tid >> 8; float zv[35];
#pragma unroll
          for (int i = 0; i < 35; ++i) { const int tt = t0 + hh * 32 + i - 2; const int tc = tt < 0 ? 0 : (tt >= len ? len - 1 : tt);
              const float v = bf2f(ZS[(size_t)(s0row + tc) * ZS_P + ZC_LRU + cc]); zv[i] = (tt >= 0 && tt < len) ? v : 0.f; }
          const float w0 = cw[cc], w1 = cw[256 + cc], w2 = cw[512 + cc], w3 = cw[768 + cc], bb = cb[cc];
#pragma unroll
          for (int t = 0; t < 32; ++t) ul[(hh * 32 + t) * UP + cc] = (unsigned short)f2bf(bb + w0 * zv[t] + w1 * zv[t + 1] + w2 * zv[t + 2] + w3 * zv[t + 3]); }
        __syncthreads();
#pragma unroll 1
        for (int tn = tn_lo; tn < tn_hi; ++tn) {
            const int c = k * 64 + 32 * tn + r32;
            bf16x8 wf[2][4];
            const float brv = F.in(I_LBR)[(l * 2 + d) * 256 + c], biv = F.in(I_LBI)[(l * 2 + d) * 256 + c], spv = ((const float*)(F.ws + WS_SP))[(l * 2 + d) * 256 + c];
#pragma unroll
            for (int gate = 0; gate < 2; ++gate)
#pragma unroll
                for (int ks = 0; ks < 4; ++ks) { const float* src = (const float*)(F.ws + WS_LWT) + ((((size_t)l * 2 + d) * 2 + gate) * 256 + c) * 64 + 16 * ks + 8 * hi;
                    const f32x4 a = *(const f32x4*)src, b2 = *(const f32x4*)(src + 4);
                    v4u w; w.x = pk2(a.x, a.y); w.y = pk2(a.z, a.w); w.z = pk2(b2.x, b2.y); w.w = pk2(b2.z, b2.w); wf[gate][ks] = __builtin_bit_cast(bf16x8, w); }
            f32x16 A[2], X[2];
            A[0] = f32x16{}; A[1] = f32x16{}; X[0] = f32x16{}; X[1] = f32x16{};
#pragma unroll
            for (int tm = 0; tm < 2; ++tm)
#pragma unroll
                for (int ks = 0; ks < 4; ++ks) { const bf16x8 af = *(const LAS bf16x8*)(ul + (32 * tm + r32) * UP + k * 64 + 16 * ks + 8 * hi);
                    A[tm] = __builtin_amdgcn_mfma_f32_32x32x16_bf16(af, wf[0][ks], A[tm], 0, 0, 0); X[tm] = __builtin_amdgcn_mfma_f32_32x32x16_bf16(af, wf[1][ks], X[tm], 0, 0, 0); }
#pragma unroll
            for (int tm = 0; tm < 2; ++tm)
#pragma unroll
                for (int r = 0; r < 16; ++r) { const int tok = 32 * tm + (r & 3) + 8 * (r >> 2) + 4 * hi; const float uu = bf2f(ul[tok * UP + c]);
                    const float rr = sigmoid_f(A[tm][r] + brv), ii = sigmoid_f(X[tm][r] + biv);
                    const float a = __builtin_amdgcn_exp2f(-rr * spv); A[tm][r] = a; X[tm][r] = __builtin_amdgcn_sqrtf(1.0f - a * a) * (ii * uu);
                    if ((r & 3) == 3) asm volatile("" ::: "memory"); }
#pragma unroll
            for (int tm = 0; tm < 2; ++tm)
#pragma unroll
                for (int rg = 0; rg < 4; ++rg) { const int r0 = 4 * rg;
                    if (d == 0) {
#pragma unroll
                        for (int e2 = 1; e2 < 4; ++e2) { X[tm][r0 + e2] = A[tm][r0 + e2] * X[tm][r0 + e2 - 1] + X[tm][r0 + e2]; A[tm][r0 + e2] = A[tm][r0 + e2] * A[tm][r0 + e2 - 1]; } }
                    else {
#pragma unroll
                        for (int e2 = 2; e2 >= 0; --e2) { X[tm][r0 + e2] = A[tm][r0 + e2] * X[tm][r0 + e2 + 1] + X[tm][r0 + e2]; A[tm][r0 + e2] = A[tm][r0 + e2] * A[tm][r0 + e2 + 1]; } } }
            float enH[8], enP[8]; float EH = 0.f, EP = 1.f;
            if (d == 0) {
#pragma unroll
                for (int q = 0; q < 8; ++q) { const int tm = q >> 2, re = 4 * (q & 3) + 3; const float ce = A[tm][re], he = X[tm][re];
                    const float aH = swap_lo(ce * EH + he), aP = swap_lo(EP * ce);
                    const float E1H = hi ? aH : EH, E1P = hi ? aP : EP;
                    enH[q] = E1H; enP[q] = E1P;
                    EH = swap_hi(ce * E1H + he); EP = swap_hi(E1P * ce); }
            } else {
#pragma unroll
                for (int q = 7; q >= 0; --q) { const int tm = q >> 2, re = 4 * (q & 3); const float ce = A[tm][re], he = X[tm][re];
                    const float aH = swap_hi(ce * EH + he), aP = swap_hi(EP * ce);
                    const float E1H = hi ? EH : aH, E1P = hi ? EP : aP;
                    enH[q] = E1H; enP[q] = E1P;
                    EH = swap_lo(ce * E1H + he); EP = swap_lo(E1P * ce); }
            }
            { const unsigned ob = (unsigned)((((s0row + t0 + 4 * hi) * 2 + d) * 256 + c) * 2);
#pragma unroll
              for (int tm = 0; tm < 2; ++tm)
#pragma unroll
                for (int rg = 0; rg < 4; ++rg) { const int q = 4 * tm + rg;
#pragma unroll
                    for (int e2 = 0; e2 < 4; ++e2) { const int r = 4 * rg + e2; const unsigned o = ob + (unsigned)(32 * tm + 8 * rg + e2) * 1024u;
                        *(unsigned short*)((char*)HL + o) = (unsigned short)f2bf(X[tm][r] + A[tm][r] * enH[q]); *(unsigned short*)((char*)CP + o) = (unsigned short)f2bf(A[tm][r] * enP[q]); }
                    asm volatile("" ::: "memory"); } }
            if (hi == 0) SUM[((size_t)(b * NCHUNK + ci) * 2 + d) * 256 + c] = (f32x2v){EP, EH};
        }
        __syncthreads();
    }
}
constexpr size_t WS_CARRY = 255 * MiB;
__device__ __forceinline__ void ph_lru_carry(Frame& F) {
    if (F.vcu < 4) {
        const int g = F.vcu * NTHREADS + F.tid, b = g >> 9, d = (g >> 8) & 1, c = g & 255;
        const f32x2v* sb = (const f32x2v*)(F.ws + WS_SUM) + ((size_t)b * NCHUNK * 2 + d) * 256 + c;
        float* cr = (float*)(F.ws + WS_CARRY) + ((size_t)b * NCHUNK * 2 + d) * 256 + c;
        float h = 0.f;
#pragma unroll 1
        for (int p0 = 0; p0 < NCHUNK; p0 += 17) {
            f32x2v s[17];
#pragma unroll
            for (int i = 0; i < 17; ++i) { const int p = p0 + i, j = (d == 0) ? p : (p < 4 ? 3 - p : NCHUNK + 3 - p); s[i] = sb[(size_t)j * 512]; }
#pragma unroll
            for (int i = 0; i < 17; ++i) { const int p = p0 + i, j = (d == 0) ? p : (p < 4 ? 3 - p : NCHUNK + 3 - p); cr[(size_t)j * 512] = h; h = s[i].x * h + s[i].y; }
        }
    }
}
__device__ __forceinline__ void ph_lru2(Frame& F, int l) {
    const unsigned short* HL = (const unsigned short*)(F.ws + WS_HL); const unsigned short* CP = (const unsigned short*)(F.ws + WS_CP);
    const float* CARRY = (const float*)(F.ws + WS_CARRY); unsigned short* Y = (unsigned short*)(F.ws + WS_G);
    const int tid = F.tid, cg = tid & 31, tq = tid >> 5; const bool last = (l == NLAYER - 1);
    for (int unit = F.vcu; unit < NB * NCHUNK; unit += F.G) {
        const int b = unit / NCHUNK, ci = unit % NCHUNK;
        if (last && ci < 4) continue;
        const float* cp0 = CARRY + ((size_t)(b * NCHUNK + ci) * 2) * 256 + cg * 8;
        const f32x4 cfa = *(const f32x4*)cp0, cfb = *(const f32x4*)(cp0 + 4), cba = *(const f32x4*)(cp0 + 256), cbb = *(const f32x4*)(cp0 + 260);
        const float cf[8] = {cfa.x, cfa.y, cfa.z, cfa.w, cfb.x, cfb.y, cfb.z, cfb.w}, cbk[8] = {cba.x, cba.y, cba.z, cba.w, cbb.x, cbb.y, cbb.z, cbb.w};
        v4u hf[4], pf[4], hb[4], pb[4], gg[4];
#pragma unroll
        for (int i = 0; i < 4; ++i) { const size_t row = (size_t)b * TPB + ci * 64 + tq + 16 * i; const size_t o = (row * 2) * 256 + cg * 8;
            hf[i] = *(const v4u*)(HL + o); pf[i] = *(const v4u*)(CP + o); hb[i] = *(const v4u*)(HL + o + 256); pb[i] = *(const v4u*)(CP + o + 256); gg[i] = *(const v4u*)(Y + row * 1024 + 768 + cg * 8); }
#pragma unroll
        for (int i = 0; i < 4; ++i) { const size_t row = (size_t)b * TPB + ci * 64 + tq + 16 * i;
            unsigned w[4];
#pragma unroll
            for (int e = 0; e < 4; ++e) { const unsigned a = hf[i][e], p = pf[i][e], a2 = hb[i][e], p2 = pb[i][e], g = gg[i][e];
                const float v0 = (bflo(a) + bflo(p) * cf[2 * e] + bflo(a2) + bflo(p2) * cbk[2 * e]) * bflo(g);
                const float v1 = (bfhi(a) + bfhi(p) * cf[2 * e + 1] + bfhi(a2) + bfhi(p2) * cbk[2 * e + 1]) * bfhi(g);
                w[e] = pk2(v0, v1); }
            *(v4u*)(Y + row * 1024 + 768 + cg * 8) = (v4u){w[0], w[1], w[2], w[3]}; }
    }
}
namespace pgx {
typedef short bf16x8 __attribute__((ext_vector_type(8)));
typedef float f32x4 __attribute__((ext_vector_type(4)));
typedef unsigned u32x4 __attribute__((ext_vector_type(4)));
typedef unsigned u32x2 __attribute__((ext_vector_type(2)));
constexpr int OPB = 16384;
template <int VAR> __device__ __forceinline__ void pgx_unit(LAS unsigned char* lds, const unsigned short* Y, const unsigned short* Wb, const unsigned short* S, unsigned short* MIX, int row0, int n0, int tid) {
    const int lane = tid & 63, wid = __builtin_amdgcn_readfirstlane(tid >> 6), wm = wid & 3, wn = wid >> 2, fr = lane & 15, fq = lane >> 4;
    const int sr0 = tid >> 3, sk = (tid & 7) * 8;
    const unsigned short* ysrc = Y + (size_t)(row0 + sr0) * 1024 + sk;
    const unsigned short* wsrc = Wb + (size_t)(n0 + sr0) * 256 + sk;
    const int ldst = (tid & 7) * 2048 + (sr0 & ~15) * 16 + (((sr0 & 15) ^ (tid & 7)) << 4);
    const int wrow = (sr0 & ~63) | (((sr0 >> 2) & 3) << 4) | (((sr0 >> 4) & 3) << 2) | (sr0 & 3);
    const int ldstw = (tid & 7) * 2048 + (wrow & ~15) * 16 + (((wrow & 15) ^ (tid & 7)) << 4);
    f32x4 acc[2][4], mix[2][4];
#pragma unroll
    for (int a = 0; a < 2; ++a)
#pragma unroll
        for (int b = 0; b < 4; ++b) { acc[a][b] = (f32x4){0.f, 0.f, 0.f, 0.f}; mix[a][b] = (f32x4){0.f, 0.f, 0.f, 0.f}; }
    u32x4 st[4][4];
    const unsigned short* yA = ysrc; const unsigned short* yB = ysrc + 64 * 1024;
    const unsigned short* wA = wsrc; const unsigned short* wB = wsrc + 64 * 256;
    const unsigned short* sp0 = S + (size_t)(row0 + 32 * wm + fr) * 4096 + n0 + 64 * wn + 16 * fq; const unsigned short* sp1 = sp0 + (size_t)16 * 4096;
#define PGX_LOADQ(set_, yo_, wp0_, wp1_, wo_) do { if (VAR == 2) { st[set_][0] = *(const u32x4*)(ysrc); st[set_][1] = *(const u32x4*)(ysrc + 64 * 1024); st[set_][2] = *(const u32x4*)(wsrc); st[set_][3] = *(const u32x4*)(wsrc + 64 * 256); } else if (VAR == 4) { st[set_][0] = st[set_][1] = st[set_][2] = st[set_][3] = (u32x4){1u,2u,3u,4u}; asm volatile("" : "+v"(st[set_][0]), "+v"(st[set_][1]), "+v"(st[set_][2]), "+v"(st[set_][3])); } else { st[set_][0] = *(const u32x4*)(yA + (yo_)); st[set_][1] = *(const u32x4*)(yB + (yo_)); st[set_][2] = *(const u32x4*)((wp0_) + (wo_)); st[set_][3] = *(const u32x4*)((wp1_) + (wo_)); } } while (0)
#define PGX_STORE(buf_, set_) do { LAS unsigned char* b_ = lds + (buf_) * 2 * OPB + ldst; \
        *(LAS u32x4*)b_ = st[set_][0]; *(LAS u32x4*)(b_ + 1024) = st[set_][1]; *(LAS u32x4*)(b_ - ldst + OPB + ldstw) = st[set_][2]; *(LAS u32x4*)(b_ - ldst + OPB + ldstw + 1024) = st[set_][3]; } while (0)
    u32x4 sga[2][2], sgb[2][2];
#define PGX_SLOAD(dst_, off_) do { if (VAR == 1 || VAR == 4) { dst_[0][0] = dst_[0][1] = dst_[1][0] = dst_[1][1] = (u32x4){0x3f803f80u, 0x3f803f80u, 0x3f803f80u, 0x3f803f80u}; } \
        else { dst_[0][0] = *(const u32x4*)(sp0 + (off_)); dst_[0][1] = *(const u32x4*)(sp0 + (off_) + 8); dst_[1][0] = *(const u32x4*)(sp1 + (off_)); dst_[1][1] = *(const u32x4*)(sp1 + (off_) + 8); } } while (0)
    PGX_SLOAD(sga, 0);
    PGX_LOADQ(0, 0, wA, wB, 0); PGX_LOADQ(1, 64, wA, wB, 64); PGX_LOADQ(2, 128, wA, wB, 128);
    PGX_STORE(0, 0);
    __syncthreads();
#define PGX_COMPUTE(h_) do { const LAS unsigned char* yb = lds + ((h_) & 1) * 2 * OPB + 32 * wm * 16; const LAS unsigned char* wb = lds + ((h_) & 1) * 2 * OPB + OPB + 64 * wn * 16; \
          _Pragma("unroll") for (int ks = 0; ks < 2; ++ks) { const int fo_ = (4 * ks + fq) * 2048 + ((fr ^ (4 * ks + fq)) << 4); \
              bf16x8 yf[2], wf[4]; \
              _Pragma("unroll") for (int tt = 0; tt < 2; ++tt) yf[tt] = *(const LAS bf16x8*)(yb + fo_ + tt * 256); \
              _Pragma("unroll") for (int nt = 0; nt < 4; ++nt) wf[nt] = *(const LAS bf16x8*)(wb + fo_ + nt * 256); \
              _Pragma("unroll") for (int tt = 0; tt < 2; ++tt) \
                  _Pragma("unroll") for (int nt = 0; nt < 4; ++nt) acc[tt][nt] = __builtin_amdgcn_mfma_f32_16x16x32_bf16(wf[nt], yf[tt], acc[tt][nt], 0, 0, 0); } } while (0)
#pragma unroll 1
    for (int kk = 0; kk < 4; ++kk) {
        const bool more = kk < 3;
        const unsigned short* wnA = more ? wA + (size_t)1024 * 256 : wsrc; const unsigned short* wnB = more ? wB + (size_t)1024 * 256 : wsrc + 64 * 256;
        const int yo = more ? 256 : -768;
        PGX_SLOAD(sgb, more ? 1024 : 0);
        PGX_LOADQ(3, 192, wA, wB, 192); PGX_COMPUTE(0); PGX_STORE(1, 1); __syncthreads();
        PGX_LOADQ(0, yo, wnA, wnB, 0); PGX_COMPUTE(1); PGX_STORE(0, 2); __syncthreads();
        PGX_LOADQ(1, yo + 64, wnA, wnB, 64); PGX_COMPUTE(2); PGX_STORE(1, 3); __syncthreads();
        PGX_LOADQ(2, yo + 128, wnA, wnB, 128); PGX_COMPUTE(3);
#pragma unroll
        for (int tt = 0; tt < 2; ++tt)
#pragma unroll
            for (int nt = 0; nt < 4; ++nt) { const u32x4 gv = sga[tt][nt >> 1]; const unsigned g0 = (nt & 1) ? gv.z : gv.x, g1 = (nt & 1) ? gv.w : gv.y; const f32x4 a = acc[tt][nt];
                mix[tt][nt] += (f32x4){a[0] * bflo(g0), a[1] * bfhi(g0), a[2] * bflo(g1), a[3] * bfhi(g1)}; acc[tt][nt] = (f32x4){0.f, 0.f, 0.f, 0.f}; }
#pragma unroll
        for (int tt = 0; tt < 2; ++tt) { sga[tt][0] = sgb[tt][0]; sga[tt][1] = sgb[tt][1]; }
        if (more) PGX_STORE(0, 0);
        __syncthreads();
        yA += 256; yB += 256; wA = wnA; wB = wnB; sp0 += 1024; sp1 += 1024;
    }
#pragma unroll
    for (int tt = 0; tt < 2; ++tt) { unsigned short* mp = MIX + (size_t)(row0 + 32 * wm + 16 * tt + fr) * 1024 + n0 + 64 * wn + 16 * fq;
        u32x4 w0, w1; w0.x = pk2(mix[tt][0][0], mix[tt][0][1]); w0.y = pk2(mix[tt][0][2], mix[tt][0][3]); w0.z = pk2(mix[tt][1][0], mix[tt][1][1]); w0.w = pk2(mix[tt][1][2], mix[tt][1][3]);
        w1.x = pk2(mix[tt][2][0], mix[tt][2][1]); w1.y = pk2(mix[tt][2][2], mix[tt][2][3]); w1.z = pk2(mix[tt][3][0], mix[tt][3][1]); w1.w = pk2(mix[tt][3][2], mix[tt][3][3]);
        *(u32x4*)mp = w0; *(u32x4*)(mp + 8) = w1; }
#undef PGX_LOADQ
#undef PGX_SLOAD
#undef PGX_STORE
#undef PGX_COMPUTE
}
}
template <int VAR> __device__ __forceinline__ void ph_pgx(Frame& F, int l, int r_lo = 0, int r_hi = 1 << 20, bool signal = false) {
    const unsigned short* Y = (const unsigned short*)(F.ws + WS_G); const unsigned short* S = (const unsigned short*)(F.ws + WS_S); unsigned short* MIX = (VAR == 0) ? (unsigned short*)(F.ws + WS_H) : (unsigned short*)F.out;
    const unsigned short* Wb = (const unsigned short*)(F.ws + WS_W + (size_t)l * W_LAYER + WO_WB);
    const bool last = (l == NLAYER - 1);
    const int nrt = last ? 128 : NROWS / 128;
    for (int r = r_lo; r <= r_hi; ++r) {
        const int u = F.vcu + r * F.G; if (u >= nrt * 8) break;
        int rt = u >> 3; const int ct = u & 7;
        if (last) rt = rt + 2 * (rt / 32) + 2;
        pgx::pgx_unit<VAR>(F.lds + RING_OFF, Y, Wb, S, MIX, rt * 128, ct * 128, F.tid);
        if (signal) {
            asm volatile("s_waitcnt vmcnt(0)" ::: "memory"); __syncthreads();
            if (F.tid == 0) { __builtin_amdgcn_fence(__ATOMIC_RELEASE, "agent"); asm volatile("s_waitcnt vmcnt(0)" ::: "memory");
                (void)xb_add((unsigned*)((gu32*)(F.ws + WS_CTL) + CW_FLG) + (u >> 4), 1u); }
        }
    }
}
constexpr int NPL = 10;
enum { PH_H = 0, PH_G1, PH_POST1, PH_G2, PH_POST2, PH_ATT, PH_SG, PH_PG, PH_MIX, PH_OG };
constexpr int NPHASES = 1 + NLAYER * NPL;
#ifndef NAIVE_ATT
#define NAIVE_ATT 0
#endif
#ifndef PROBE_MASK
#define PROBE_MASK 0
#endif
#ifndef PROBE_LAYERS
#define PROBE_LAYERS 3
#endif
#ifndef MERGE_PGOG
#define MERGE_PGOG 0
#endif
#ifndef PHMASK
#define PHMASK 16383
#endif
#ifndef MK_ONE_LAUNCH
#define MK_ONE_LAUNCH 1
#endif

__global__ void __launch_bounds__(NTHREADS, 2) fwd_kernel(Args args) {
    extern __shared__ __attribute__((aligned(16))) unsigned char lds_raw[];
    { LAS unsigned char* l0 = (LAS unsigned char*)lds_raw;
      for (int u = threadIdx.x; u < (LDS_BYTES - LDSCTL_OFF) / 4; u += NTHREADS) ((LAS unsigned*)(l0 + LDSCTL_OFF))[u] = 0u;
      __syncthreads();
      if (args.ph_hi - args.ph_lo > 1) (void)xcd_barrier_post((unsigned*)((gu32*)(args.ws + WS_CTL) + CW_BAR), (volatile LAS unsigned*)(l0 + MISC_OFF) + 8); }

    unsigned long long tacc = 0ull;
    for (int ph = args.ph_lo; ph < args.ph_hi; ++ph) {
        unsigned long long tph0 = 0ull; bool probed = false;
        if (PROBE_MASK) { const int pl = (ph == 0) ? 0 : (ph - 1) / NPL, pp = (ph == 0) ? 10 : (ph - 1) % NPL; probed = ((PROBE_MASK >> pp) & 1) && ((PROBE_LAYERS >> pl) & 1); if (probed) tph0 = __builtin_amdgcn_s_memrealtime(); }
        int z; asm volatile("s_mov_b32 %0, 0" : "=s"(z));
        Frame F;
        F.lds = (LAS unsigned char*)lds_raw + z; F.kin = (const float* const __attribute__((address_space(4)))*)((const __attribute__((address_space(4))) char*)__builtin_amdgcn_kernarg_segment_ptr() + z); F.ws = args.ws + z; F.out = args.out + z; F.z = z;
        F.tid = threadIdx.x + z; F.lane = F.tid & 63; F.wave = __builtin_amdgcn_readfirstlane(F.tid >> 6);
        F.G = gridDim.x + z; { const int bx = blockIdx.x + z; F.vcu = (F.G % 8 == 0) ? (bx % 8) * (F.G / 8) + bx / 8 : bx; }
        F.gw = F.vcu * NWAVES + F.wave; F.NGW = F.G * NWAVES;
        bool is_gemm = false;
        pg8::Gemm g{nullptr, nullptr, NROWS, 256, 1024, 1024, 31, 0};
        pg8::Order S; S.init(1, 1, F.G, (int)blockIdx.x + z, 0);
        pg8::EpiU E{pg8::EM_PLAIN, 0, F.ws, nullptr, nullptr, nullptr, 0, 0, 0, 0, 1 << 20};
        if (ph == 0) { if (PHMASK & 8192) p0_prologue(F); }
        else {
            const int l = (ph - 1) / NPL, p = (ph - 1) % NPL;
            unsigned char* wl = F.ws + WS_W + (size_t)l * W_LAYER;
            const bool last = (l == NLAYER - 1);
            const int nMc = last ? 64 : NROWS / 256, lat = last ? 1 : 0;
            const bool merged = last && F.G == 256 && MERGE_PGOG;
            E.l = l;
            if (p == PH_H && (PHMASK & 1)) { ph_hnorm(F, l); }
            else if (p == PH_G1 && (PHMASK & 2)) {
                is_gemm = true; g.A = (const bf16*)(F.ws + WS_H); g.Bt = (const bf16*)(wl + WO_W1); g.N = N1; g.K = 1024; g.lda = 1024;
                S.init(NROWS / 256, N1 / 256, F.G, (int)blockIdx.x + z, 0);
                E.mode = pg8::EM_SILU2; E.oA = WS_ZS; E.ldc = ZS_P; E.oB = WS_G; E.ldc2 = 1024; E.split_tile = 7;
            }
            else if (p == PH_POST1 && (PHMASK & 4)) { ph_lru1(F, l); ph_post1(F, l); }
            else if (p == PH_G2 && (PHMASK & 8)) {
                is_gemm = true; g.A = (const bf16*)(F.ws + WS_ZS); g.Bt = (const bf16*)(wl + WO_UQ); g.N = 1024; g.K = 256; g.lda = ZS_P; g.a_shift = 1; g.a_step = 512;
                S.init(NROWS / 256, 4, F.G, (int)blockIdx.x + z, 0);
                E.mode = pg8::EM_PLAIN; E.oA = WS_MQ; E.ldc = 512; E.oB = WS_MKV; E.ldc2 = 512; E.split_tile = 2;
            }
            else if (p == PH_POST2 && (PHMASK & 16)) { ph_lru_carry(F); ph_post2(F, l); }
            else if (p == PH_ATT && (PHMASK & 32)) {
#if NAIVE_ATT
                ph_attn_naive(F, l);
#else
                ph_attn(F, l);
#endif
                ph_lru2(F, l); }
            else if (p == PH_SG && (PHMASK & 512)) {
                is_gemm = true; g.A = (const bf16*)(F.ws + WS_H); g.Bt = (const bf16*)(wl + WO_W1) + (size_t)N1 * 1024; g.N = 4096; g.K = 1024; g.lda = 1024;
                S.init(nMc, 16, F.G, (int)blockIdx.x + z, lat);
                E.mode = pg8::EM_SIG; E.oA = WS_S; E.ldc = 4096;
            }
            else if (p == PH_PG && (PHMASK & 1024)) {
                int r_hi = 1 << 20;
                if (merged) { pg8::Unit u0; pg8::Order S0; S0.init(64, 4, F.G, (int)blockIdx.x + z, 1); (void)S0.next(0, u0); r_hi = u0.pm / 17; }
                ph_pgx<0>(F, l, 0, r_hi, merged);
#ifdef PGX_PROBE
                if (l == 0) { __syncthreads(); ph_pgx<PGX_PROBE>(F, l); }
#endif
            }
            else if (p == PH_MIX) {
                if (!last && (PHMASK & 2048)) {
                    is_gemm = true; g.A = (const bf16*)(F.ws + WS_H); g.Bt = (const bf16*)(F.ws + WS_WOS); g.N = 4096; g.K = 256; g.lda = 1024; g.a_shift = 2; g.a_step = 512;
                    S.init(4, 16, F.G, (int)blockIdx.x + z, 2);
                    E.mode = pg8::EM_PLAIN; E.oA = WS_S; E.ldc = 4096; }
            }
            else if (p == PH_OG && (PHMASK & 4096)) {
                is_gemm = true; g.A = (const bf16*)(F.ws + WS_H); g.Bt = (const bf16*)(wl + WO_WO); g.N = 1024; g.K = 1024; g.lda = 1024;
                S.init(64, 4, F.G, (int)blockIdx.x + z, 1);
                E.mode = pg8::EM_RES; E.xin = (l == 0) ? F.in(I_X) : (const float*)F.out; E.xout = F.out; E.cin0 = F.in(I_CTX); E.oA = WS_MOD; E.oB = WS_CTX1;
                if (merged) {
                    pg8::Unit u0; (void)S.next(0, u0); const int q = (u0.pm / 17) * 16 + u0.pm % 17 - 1;
                    if (F.tid == 0) { unsigned* bar = (unsigned*)((gu32*)(F.ws + WS_CTL) + CW_BAR); unsigned* flg = (unsigned*)((gu32*)(F.ws + WS_CTL) + CW_FLG) + q;
                        XB_SPIN(xb_ld(flg) < 16u, bar); __builtin_amdgcn_fence(__ATOMIC_ACQUIRE, "agent"); asm volatile("s_waitcnt vmcnt(0)" ::: "memory"); }
                    __syncthreads(); }
            }
        }
        if (is_gemm) pg8::gemm_phase<pg8::EpiU, pg8::Order, true, true>(F.lds + RING_OFF, g, S, E, F.tid);
        if (NLAYER == 2 && ph >= 1 && ph <= 1 + PH_OG) {
            const int p = ph - 1;
            if (p == PH_G1 || p == PH_G2 || p == PH_SG || p == PH_PG || p == PH_OG) {
                int z4; asm volatile("s_mov_b32 %0, 0" : "=s"(z4));
                Frame C;
                C.lds = (LAS unsigned char*)lds_raw + z4; C.kin = (const float* const __attribute__((address_space(4)))*)((const __attribute__((address_space(4))) char*)__builtin_amdgcn_kernarg_segment_ptr() + z4); C.ws = args.ws + z4; C.out = args.out + z4; C.z = z4;
                C.tid = threadIdx.x + z4; C.lane = C.tid & 63; C.wave = __builtin_amdgcn_readfirstlane(C.tid >> 6);
                C.G = gridDim.x + z4; const int bx = blockIdx.x + z4; C.vcu = (C.G % 8 == 0) ? (bx % 8) * (C.G / 8) + bx / 8 : bx;
                C.gw = C.vcu * NWAVES + C.wave; C.NGW = C.G * NWAVES;
                int cidx = -1, cn = 1, loA = 0, nA = 0, loB = 0, nB = 0;
                if (p == PH_G1) { const int nb = ((NROWS / 256) * (N1 / 256)) % C.G; cidx = bx - nb; cn = C.G - nb; loA = I_EARLY; nA = IC_G1; }
                else if (p == PH_G2) { const int nb = ((NROWS / 256) * 4) % C.G; cidx = bx - nb; cn = C.G - nb; loA = I_EARLY + IC_G1; nA = I_INL - IC_G1; }
                else if (p == PH_SG) { const int nb = ((NROWS / 256) * 16) % C.G; cidx = bx - nb; cn = C.G - nb; loA = I_EARLY + I_INL; nA = I_BR; loB = 0; nB = 1536; }
                else if (p == PH_PG) { const int nb = ((NROWS / 128) * 8) % C.G; cidx = C.vcu - nb; cn = C.G - nb; loA = I_EARLY + I_INL + I_BR; nA = I_OUT + I_SPLIT; loB = 1536; nB = 1536; }
                else { const int nb = (64 < C.G) ? 64 : 0; cidx = bx - nb; cn = C.G - nb; loB = 3072; nB = I_LAYER - 3072; }
                if (cidx >= 0) { __syncthreads();
                    if (p == PH_G1) p0_tables(C, cidx * NTHREADS + C.tid, cn * NTHREADS);
                    weight_copies(C, cidx * NWAVES + C.wave, cn * NWAVES, loA, nA, loB, nB); }
            }
        }
        if (MERGE_PGOG && ph == 1 + (NLAYER - 1) * NPL + PH_OG && gridDim.x == 256) {
            int z5; asm volatile("s_mov_b32 %0, 0" : "=s"(z5));
            Frame C;
            C.lds = (LAS unsigned char*)lds_raw + z5; C.kin = (const float* const __attribute__((address_space(4)))*)((const __attribute__((address_space(4))) char*)__builtin_amdgcn_kernarg_segment_ptr() + z5); C.ws = args.ws + z5; C.out = args.out + z5; C.z = z5;
            C.tid = threadIdx.x + z5; C.lane = C.tid & 63; C.wave = __builtin_amdgcn_readfirstlane(C.tid >> 6);
            C.G = gridDim.x + z5; const int bx = blockIdx.x + z5; C.vcu = (C.G % 8 == 0) ? (bx % 8) * (C.G / 8) + bx / 8 : bx;
            C.gw = C.vcu * NWAVES + C.wave; C.NGW = C.G * NWAVES;
            pg8::Unit u0; pg8::Order S0; S0.init(64, 4, C.G, bx, 1); (void)S0.next(0, u0);
            __syncthreads(); ph_pgx<0>(C, NLAYER - 1, u0.pm / 17 + 1, 1 << 20, true);
        }
        const bool empty_phase = (ph > 0) && (((ph - 1) % NPL == PH_MIX) || (MERGE_PGOG && ph == 1 + (NLAYER - 1) * NPL + PH_PG && gridDim.x == 256));
        if (empty_phase) __syncthreads();
        if (ph + 1 < args.ph_hi && !empty_phase) {
            int z2; asm volatile("s_mov_b32 %0, 0" : "=s"(z2));
            XcdBarrier bar; bar.bar = (unsigned*)((gu32*)(args.ws + z2 + WS_CTL) + CW_BAR); bar.x = xb_xcc_id(); bar.st = (volatile LAS unsigned*)((LAS unsigned char*)lds_raw + z2 + MISC_OFF) + 8;
            xcd_barrier(bar);
        }
        if (PROBE_MASK) { if (probed) tacc += __builtin_amdgcn_s_memrealtime() - tph0; }
    }
#ifdef EXTRA_BARRIERS
    for (int xb = 0; xb < EXTRA_BARRIERS; ++xb) { int z3; asm volatile("s_mov_b32 %0, 0" : "=s"(z3));
        XcdBarrier bar; bar.bar = (unsigned*)((gu32*)(args.ws + z3 + WS_CTL) + CW_BAR); bar.x = xb_xcc_id(); bar.st = (volatile LAS unsigned*)((LAS unsigned char*)lds_raw + z3 + MISC_OFF) + 8;
        xcd_barrier(bar); }
#endif
    if (PROBE_MASK) { const unsigned long long t0 = __builtin_amdgcn_s_memrealtime(); while (__builtin_amdgcn_s_memrealtime() - t0 < tacc) __builtin_amdgcn_s_sleep(8); }
}

extern "C" void kernel_launch(void* const* d_in, const int* in_sizes, int n_in, void* d_out, int out_size, void* d_ws, size_t ws_size, hipStream_t stream) {
    static int grid = 0;
    if (grid == 0) {
        if (n_in != 28 || out_size != NB * SEQ * DM || ws_size < WS_END) { fprintf(stderr, "kernel_launch: unexpected shapes (n_in %d out %d ws %zu); nothing launched\n", n_in, out_size, ws_size); grid = -1; return; }
        int dev = 0, cus = 0, per_cu = 0;
        if (hipGetDevice(&dev) != hipSuccess || hipDeviceGetAttribute(&cus, hipDeviceAttributeMultiprocessorCount, dev) != hipSuccess) { grid = -1; return; }
        if (hipFuncSetAttribute((const void*)fwd_kernel, hipFuncAttributeMaxDynamicSharedMemorySize, LDS_BYTES) != hipSuccess) { fprintf(stderr, "kernel_launch: hipFuncSetAttribute failed\n"); grid = -1; return; }
        if (hipOccupancyMaxActiveBlocksPerMultiprocessor(&per_cu, (const void*)fwd_kernel, NTHREADS, LDS_BYTES) != hipSuccess || per_cu < 1) { fprintf(stderr, "kernel_launch: occupancy query says %d\n", per_cu); (void)hipGetLastError(); grid = -1; return; }
        grid = cus;
    }
    if (grid < 0) return;
    (void)hipMemsetAsync((char*)d_ws + WS_CTL, 0, CTL_ZERO_BYTES, stream);
    Args a{};
    for (int i = 0; i < 28; ++i) a.in[i] = (const float*)d_in[i];
    a.out = (float*)d_out; a.ws = (unsigned char*)d_ws;
#if MK_ONE_LAUNCH
    a.ph_lo = 0; a.ph_hi = NPHASES;
    hipLaunchKernelGGL(fwd_kernel, dim3(grid), dim3(NTHREADS), LDS_BYTES, stream, a);
#else
    for (int ph = 0; ph < NPHASES; ++ph) { a.ph_lo = ph; a.ph_hi = ph + 1; hipLaunchKernelGGL(fwd_kernel, dim3(grid), dim3(NTHREADS), LDS_BYTES, stream, a); }
#endif
}
```

```cpp
#include <hip/hip_runtime.h>
#include <cstdio>
#include <cstdint>
#include <cmath>
__device__ __forceinline__ float bflo(unsigned w) { return __uint_as_float(w << 16); }
__device__ __forceinline__ float bfhi(unsigned w) { return __uint_as_float(w & 0xffff0000u); }
__device__ __forceinline__ float sigmoid_f(float v) { return __builtin_amdgcn_rcpf(1.0f + __builtin_amdgcn_exp2f(-1.4426950408889634f * v)); }
namespace pg8 {
#define PG8_LAS __attribute__((address_space(3)))
typedef unsigned short bf16_t;
typedef short bf16x8 __attribute__((ext_vector_type(8)));
typedef float f32x4 __attribute__((ext_vector_type(4)));
typedef unsigned u32x4 __attribute__((ext_vector_type(4)));
constexpr int BM = 256, BK = 64, HALF = 128, HTB = HALF * BK * 2  , STAGE_BYTES = 8 * HTB, NXCD = 8, WGM = 8;

__host__ __device__ __forceinline__ int lds_byte(int r, int c) { const int st = (r >> 4) * 2 + (c >> 5), rr = r & 15, cc = c & 31, ob = rr * 64 + cc * 2; return st * 1024 + (ob ^ (((ob >> 9) & 1) << 5)); }
__host__ __device__ __forceinline__ void stage_rc(int b, int& R, int& C) { const int st = b / 1024, sb = b % 1024, swz = sb ^ (((sb >> 9) & 1) << 5); R = (st >> 1) * 16 + swz / 64; C = (st & 1) * 32 + (swz % 64) / 2; }
__host__ __device__ __forceinline__ int perm32(int rho) { const int n = rho >> 4, i = rho & 15; return 8 * (i >> 2) + 4 * n + (i & 3); }

struct Unit { int pm, pn; };
struct Gemm { const bf16_t* A; const bf16_t* Bt; int M, N, K, lda; int a_shift, a_step; };

struct StaticOrder {
    int nM, nN, nwg, G, c;
    __host__ __device__ void init(int M, int N, int G_, int c_) { nM = M / BM; nN = N / BM; nwg = nM * nN; G = G_; c = c_; }
    __host__ __device__ bool next(int i, Unit& u) const {
        const long L = (long)i * G + c; if (L >= nwg) return false;
        int wgid = (int)L; { const int q = nwg / NXCD, r = nwg % NXCD, xcd = wgid % NXCD, off = wgid / NXCD; wgid = (xcd < r ? xcd * (q + 1) : r * (q + 1) + (xcd - r) * q) + off; }
        const int nig = WGM * nN, gid = wgid / nig, fm = gid * WGM, gsz = (nM - fm) < WGM ? (nM - fm) : WGM;
        u.pm = fm + ((wgid % nig) % gsz); u.pn = (wgid % nig) / gsz; return true;
    }
    __device__ __forceinline__ void a_ready(const Unit&) const {}
    __device__ __forceinline__ void done(const Unit&) const {}
};

__device__ __forceinline__ unsigned cvt_pk_bf16(float lo, float hi) { unsigned r; asm volatile("v_cvt_pk_bf16_f32 %0, %1, %2" : "=v"(r) : "v"(lo), "v"(hi)); return r; }
enum { EM_PLAIN = 0, EM_SILU2 = 1, EM_SIG = 2, EM_MUL = 3, EM_RES = 4 };
struct EpiU {
    static constexpr bool PERM = true, AFTER_DRAIN = false;
    int mode; int l; unsigned char* ws; const float* xin; float* xout; const float* cin0;
    size_t oA, oB; int ldc, ldc2, split_tile;
    __device__ __forceinline__ void operator()(const f32x4 (&acc)[2][2][4][2], const Unit& u, int wr, int wc, int fr, int fq) const {
        if (mode == EM_RES) {
            const int b = u.pm / 17, t0 = u.pm % 17;
            const float* src; float* dst; const float* gate; const float* modl = (const float*)(ws + oA) + (size_t)l * 5 * 3072;
            if (t0 == 0) { float* c1 = (float*)(ws + oB); src = ((l == 0) ? cin0 : (const float*)c1) + (size_t)b * 256 * 1024; dst = c1 + (size_t)b * 256 * 1024; gate = modl + 4 * 3072 + 2048; }
            else { const size_t o = ((size_t)b * 4096 + (size_t)(t0 - 1) * 256) * 1024; src = xin + o; dst = xout + o; gate = modl + b * 3072 + 2048; }
            const int col0 = u.pn * BM + wc * 32 + 8 * fq;
            const char* srcb = (const char*)src; char* dstb = (char*)dst; const char* gb = (const char*)(gate + col0);
            const unsigned off0 = (unsigned)((wr * 64 + fr) * 1024 + col0) * 4u;
#pragma unroll
            for (int ai = 0; ai < 2; ++ai) {
                f32x4 xo[4][2][2];
#pragma unroll
                for (int m = 0; m < 4; ++m) { const unsigned off = off0 + (unsigned)(ai * HALF + m * 16) * 4096u;
#pragma unroll
                    for (int bj = 0; bj < 2; ++bj)
#pragma unroll
                        for (int n = 0; n < 2; ++n) xo[m][bj][n] = *(const f32x4*)(srcb + (off + (unsigned)(bj * HALF + n * 4) * 4u)); }
#pragma unroll
                for (int m = 0; m < 4; ++m) { const unsigned off = off0 + (unsigned)(ai * HALF + m * 16) * 4096u;
#pragma unroll
                    for (int bj = 0; bj < 2; ++bj)
#pragma unroll
                        for (int n = 0; n < 2; ++n) { const unsigned cb = (unsigned)(bj * HALF + n * 4) * 4u; const f32x4 g = *(const f32x4*)(gb + cb);
                            *(f32x4*)(dstb + (off + cb)) = xo[m][bj][n] + g * acc[ai][bj][m][n]; } }
                asm volatile("" ::: "memory"); }
            return;
        }
        const int row0 = u.pm * BM + wr * 64 + fr; int colt = u.pn * BM; bf16_t* base = (bf16_t*)(ws + oA); int ld = ldc; bool second = false;
        if (u.pn >= split_tile) { base = (bf16_t*)(ws + oB); ld = ldc2; colt -= split_tile * BM; second = true; }
        const bool do_silu = (mode == EM_SILU2) && second;
        const int col0 = colt + wc * 32 + 8 * fq;
#pragma unroll
        for (int ai = 0; ai < 2; ++ai)
#pragma unroll
            for (int m = 0; m < 4; ++m) { bf16_t* rowp = base + (size_t)(row0 + ai * HALF + m * 16) * ld + col0;
#pragma unroll
                for (int bj = 0; bj < 2; ++bj) { f32x4 v0 = acc[ai][bj][m][0], v1 = acc[ai][bj][m][1];
                    if (mode == EM_SIG) {
#pragma unroll
                        for (int e = 0; e < 4; ++e) { v0[e] = sigmoid_f(v0[e]); v1[e] = sigmoid_f(v1[e]); } }
                    if (do_silu) {
#pragma unroll
                        for (int e = 0; e < 4; ++e) { v0[e] = v0[e] * sigmoid_f(v0[e]); v1[e] = v1[e] * sigmoid_f(v1[e]); } }
                    u32x4 w; w.x = cvt_pk_bf16(v0[0], v0[1]); w.y = cvt_pk_bf16(v0[2], v0[3]); w.z = cvt_pk_bf16(v1[0], v1[1]); w.w = cvt_pk_bf16(v1[2], v1[3]);
                    *(u32x4*)(rowp + bj * HALF) = w; } }
    }
};
struct Order {
    int nM, nN, nwg, G, c, latent_only, grouped, vc, nctx;
    __device__ void init(int nM_, int nN_, int G_, int c_, int lat) { nM = nM_; nN = nN_; nwg = nM * nN; G = G_; c = c_; latent_only = lat; grouped = 0; vc = 0; nctx = 0; }
    __device__ void init_grouped(int G_, int vc_, int with_ctx) { init(64, 4, G_, vc_, 1); grouped = 1; vc = vc_; nctx = with_ctx ? 64 : 0; }
    __device__ bool next(int i, Unit& u) const {
        if (grouped) {
            const int gi = i >> 2, grp = vc + gi * G;
            if (grp < 256) { const int pm = grp >> 2; u.pm = pm + pm / 16 + 1; u.pn = 4 * (i & 3) + (grp & 3); return true; }
            const int done = ((256 - vc + G - 1) / G) * 4;
            const int x = vc + (i - done) * G;
            if (i >= done && x < nctx) { const int g = x >> 2, k = x & 3; u.pm = (g >> 2) * 17; u.pn = 4 * k + (g & 3); return true; }
            return false;
        }
        const long L = (long)i * G + c; if (L >= nwg) return false;
        int wgid = (int)L; { const int q = nwg / NXCD, r = nwg % NXCD, xcd = wgid % NXCD, off = wgid / NXCD; wgid = (xcd < r ? xcd * (q + 1) : r * (q + 1) + (xcd - r) * q) + off; }
        const int nig = WGM * nN, gid = wgid / nig, fm = gid * WGM, gsz = (nM - fm) < WGM ? (nM - fm) : WGM;
        int pm = fm + ((wgid % nig) % gsz); u.pn = (wgid % nig) / gsz; if (latent_only == 1) pm = pm + pm / 16 + 1; else if (latent_only == 2) pm = pm * 17; u.pm = pm; return true;
    }
    __device__ __forceinline__ void a_ready(const Unit&) const {}
    __device__ __forceinline__ void done(const Unit&) const {}
};
template <class Epi, class Sched, bool ALIGN_EPI = false, bool SP2 = false>
__device__ __forceinline__ void gemm_phase(PG8_LAS unsigned char* lds, const Gemm g, const Sched& S, const Epi& E, const int tid  ) {
    const int wid = __builtin_amdgcn_readfirstlane(tid >> 6), lane = tid & 63, wr = wid >> 2, wc = wid & 3, fr = lane & 15, fq = lane >> 4;
    const int K = g.K, nt = K / BK;
    unsigned voffA[2], voffB[2];
#pragma unroll
    for (int i = 0; i < 2; ++i) { int R, C; stage_rc(tid * 16 + i * 8192, R, C); const int Rb = Epi::PERM ? ((R & ~31) + perm32(R & 31)) : R;
        voffA[i] = (unsigned)(R * g.lda + C) * 2u; voffB[i] = (unsigned)(Rb * K + C) * 2u; }
    const size_t kstep = (size_t)(BK * 2);
    const size_t hstepA = (size_t)HALF * g.lda * 2, hstepB = (size_t)HALF * K * 2;
    const size_t tstepA = 2 * hstepA, tstepB = 2 * hstepB;
    const unsigned ldsw = (unsigned)wid * 1024u;
    const int aoff = lds_byte(wr * 64 + fr, fq * 8), boff = lds_byte(wc * 32 + fr, fq * 8);
#define PG8_SA(b, h) (((b) * 2 + (h)) * HTB)
#define PG8_SB(b, h) ((4 + (b) * 2 + (h)) * HTB)
#define PG8_STAGE(bufoff, gbase, voff) do { _Pragma("unroll") for (int _i = 0; _i < 2; ++_i) \
        __builtin_amdgcn_global_load_lds((const unsigned*)((const char*)(gbase) + (voff)[_i]), (PG8_LAS unsigned*)(lds + (bufoff) + ldsw + _i * 8192), 16, 0, 0); } while (0)
#define PG8_LDA(dst, b, h) do { _Pragma("unroll") for (int m = 0; m < 4; ++m) _Pragma("unroll") for (int k = 0; k < 2; ++k) dst[m][k] = *(const PG8_LAS bf16x8*)(lds + PG8_SA(b, h) + aoff + m * 2048 + k * 1024); } while (0)
#define PG8_LDB(dst, b, h) do { _Pragma("unroll") for (int n = 0; n < 2; ++n) _Pragma("unroll") for (int k = 0; k < 2; ++k) dst[n][k] = *(const PG8_LAS bf16x8*)(lds + PG8_SB(b, h) + boff + n * 2048 + k * 1024); } while (0)
#define PG8_MMA(ai, bj, At, Bt) do { __builtin_amdgcn_s_setprio(1); _Pragma("unroll") for (int m = 0; m < 4; ++m) _Pragma("unroll") for (int n = 0; n < 2; ++n) _Pragma("unroll") for (int k = 0; k < 2; ++k) \
        acc[ai][bj][m][n] = __builtin_amdgcn_mfma_f32_16x16x32_bf16(Bt[n][k], At[m][k], acc[ai][bj][m][n], 0, 0, 0); __builtin_amdgcn_s_setprio(0); } while (0)
#define PG8_WAIT_V(n) asm volatile("s_waitcnt vmcnt(" #n ")" ::: "memory")
#define PG8_WAIT_L(n) asm volatile("s_waitcnt lgkmcnt(" #n ")" ::: "memory")
#define PG8_BAR __builtin_amdgcn_s_barrier()
#define PG8_SCHED __builtin_amdgcn_sched_barrier(0)
    Unit cur, nxt; int ui = 0;
    if (!S.next(0, cur)) return;
    f32x4 acc[2][2][4][2];
#pragma unroll
    for (int a = 0; a < 2; ++a)
#pragma unroll
        for (int b = 0; b < 2; ++b)
#pragma unroll
            for (int m = 0; m < 4; ++m)
#pragma unroll
                for (int n = 0; n < 2; ++n) acc[a][b][m][n] = (f32x4){0.f, 0.f, 0.f, 0.f};
    bf16x8 At[4][2], B0[2][2], B1[2][2];
    const char* cA = (const char*)g.A + (size_t)cur.pm * tstepA + (size_t)(cur.pn >> g.a_shift) * (size_t)g.a_step; const char* cB = (const char*)g.Bt + (size_t)cur.pn * tstepB;
    S.a_ready(cur);
    if constexpr (SP2) {
        PG8_STAGE(PG8_SB(0, 0), cB, voffB); PG8_STAGE(PG8_SB(0, 1), cB + hstepB, voffB); PG8_STAGE(PG8_SA(0, 0), cA, voffA); PG8_STAGE(PG8_SA(0, 1), cA + hstepA, voffA);
        if (wr == 1) PG8_BAR;
        PG8_WAIT_V(2); PG8_BAR;
        PG8_STAGE(PG8_SB(1, 0), cB + kstep, voffB); PG8_STAGE(PG8_SA(1, 0), cA + kstep, voffA); PG8_STAGE(PG8_SB(1, 1), cB + hstepB + kstep, voffB);
        PG8_WAIT_V(6); PG8_BAR;
    } else {
        PG8_STAGE(PG8_SB(0, 0), cB, voffB); PG8_STAGE(PG8_SA(0, 0), cA, voffA); PG8_STAGE(PG8_SB(0, 1), cB + hstepB, voffB); PG8_STAGE(PG8_SA(0, 1), cA + hstepA, voffA);
        if (wr == 1) PG8_BAR;
        PG8_WAIT_V(4); PG8_BAR;
        PG8_STAGE(PG8_SB(1, 0), cB + kstep, voffB); PG8_STAGE(PG8_SA(1, 0), cA + kstep, voffA); PG8_STAGE(PG8_SB(1, 1), cB + hstepB + kstep, voffB);
        PG8_WAIT_V(6); PG8_BAR;
    }
    for (;;) {
        const bool has_next = S.next(ui + 1, nxt);
        const char* nA = has_next ? (const char*)g.A + (size_t)nxt.pm * tstepA + (size_t)(nxt.pn >> g.a_shift) * (size_t)g.a_step : cA; const char* nB = has_next ? (const char*)g.Bt + (size_t)nxt.pn * tstepB : cB;
        for (int t = 0; t < nt; t += 2) {
            const bool last = (t == nt - 2);
            const char* a1 = cA + (size_t)(t + 1) * kstep;
            const char* a2 = last ? nA : cA + (size_t)(t + 2) * kstep; const char* b2 = last ? nB : cB + (size_t)(t + 2) * kstep;
            const char* a3 = a2 + kstep; const char* b3 = b2 + kstep;
            if (last && has_next) S.a_ready(nxt);
            if constexpr (SP2) {
            PG8_LDB(B0, 0, 0); PG8_LDB(B1, 0, 1); PG8_SCHED; PG8_LDA(At, 0, 0); PG8_STAGE(PG8_SA(1, 1), a1 + hstepA, voffA);
            PG8_WAIT_V(8); PG8_WAIT_L(0); PG8_BAR; PG8_MMA(0, 0, At, B0); PG8_MMA(0, 1, At, B1); PG8_BAR; PG8_SCHED;
            PG8_LDA(At, 0, 1); PG8_STAGE(PG8_SB(0, 0), b2, voffB); PG8_STAGE(PG8_SB(0, 1), b2 + hstepB, voffB); PG8_STAGE(PG8_SA(0, 0), a2, voffA);
            PG8_WAIT_V(8); PG8_WAIT_L(0); PG8_BAR; PG8_MMA(1, 0, At, B0); PG8_MMA(1, 1, At, B1); PG8_BAR; PG8_SCHED;
            PG8_LDB(B0, 1, 0); PG8_LDB(B1, 1, 1); PG8_SCHED; PG8_LDA(At, 1, 0); PG8_STAGE(PG8_SA(0, 1), a2 + hstepA, voffA);
            PG8_WAIT_V(8); PG8_WAIT_L(0); PG8_BAR; PG8_MMA(0, 0, At, B0); PG8_MMA(0, 1, At, B1); PG8_BAR; PG8_SCHED;
            PG8_LDA(At, 1, 1); PG8_STAGE(PG8_SB(1, 0), b3, voffB); PG8_STAGE(PG8_SB(1, 1), b3 + hstepB, voffB); PG8_STAGE(PG8_SA(1, 0), a3, voffA);
            PG8_WAIT_V(8); PG8_WAIT_L(0); PG8_BAR; PG8_MMA(1, 0, At, B0); PG8_MMA(1, 1, At, B1); PG8_BAR; PG8_SCHED;
            } else {
            PG8_LDB(B0, 0, 0); PG8_SCHED; PG8_LDA(At, 0, 0); PG8_STAGE(PG8_SA(1, 1), a1 + hstepA, voffA);
            PG8_WAIT_L(8); PG8_BAR; PG8_WAIT_L(0); PG8_MMA(0, 0, At, B0); PG8_BAR; PG8_SCHED;
            PG8_LDB(B1, 0, 1); PG8_STAGE(PG8_SB(0, 0), b2, voffB);
            PG8_BAR; PG8_WAIT_L(0); PG8_MMA(0, 1, At, B1); PG8_BAR;
            PG8_LDA(At, 0, 1); PG8_STAGE(PG8_SA(0, 0), a2, voffA);
            PG8_BAR; PG8_WAIT_L(0); PG8_MMA(1, 0, At, B0); PG8_BAR; PG8_SCHED;
            PG8_STAGE(PG8_SB(0, 1), b2 + hstepB, voffB);
            PG8_WAIT_V(6); PG8_BAR; PG8_MMA(1, 1, At, B1); PG8_BAR;
            PG8_LDB(B0, 1, 0); PG8_SCHED; PG8_LDA(At, 1, 0); PG8_STAGE(PG8_SA(0, 1), a2 + hstepA, voffA);
            PG8_WAIT_L(8); PG8_BAR; PG8_WAIT_L(0); PG8_MMA(0, 0, At, B0); PG8_BAR; PG8_SCHED;
            PG8_LDB(B1, 1, 1); PG8_STAGE(PG8_SB(1, 0), b3, voffB);
            PG8_BAR; PG8_WAIT_L(0); PG8_MMA(0, 1, At, B1); PG8_BAR;
            PG8_LDA(At, 1, 1); PG8_STAGE(PG8_SA(1, 0), a3, voffA);
            PG8_BAR; PG8_WAIT_L(0); PG8_MMA(1, 0, At, B0); PG8_BAR; PG8_SCHED;
            PG8_STAGE(PG8_SB(1, 1), b3 + hstepB, voffB);
            PG8_WAIT_V(6); PG8_BAR; PG8_MMA(1, 1, At, B1); PG8_BAR;
            }
        }
        if constexpr (ALIGN_EPI) { if (wr == 0) PG8_BAR; }
        if constexpr (!Epi::AFTER_DRAIN) { E(acc, cur, wr, wc, fr, fq); S.done(cur); }
        if (!has_next) break;
#pragma unroll
        for (int a = 0; a < 2; ++a)
#pragma unroll
            for (int b = 0; b < 2; ++b)
#pragma unroll
                for (int m = 0; m < 4; ++m)
#pragma unroll
                    for (int n = 0; n < 2; ++n) acc[a][b][m][n] = (f32x4){0.f, 0.f, 0.f, 0.f};
        cur = nxt; cA = nA; cB = nB; ++ui;
        if constexpr (ALIGN_EPI) { if (wr == 1) PG8_BAR; }
    }
    PG8_WAIT_V(0);
    if constexpr (!ALIGN_EPI) { if (wr == 0) PG8_BAR; }
    PG8_BAR;
    if constexpr (Epi::AFTER_DRAIN) { E.fused(acc, cur, wr, wc, fr, fq, lds, wid, lane); S.done(cur); }
#undef PG8_SA
#undef PG8_SB
#undef PG8_STAGE
#undef PG8_LDA
#undef PG8_LDB
#undef PG8_MMA
#undef PG8_WAIT_V
#undef PG8_WAIT_L
#undef PG8_BAR
#undef PG8_SCHED
}
}
#define PG8_SP2 true
#define PG8_ALIGN true
#define GAS __attribute__((address_space(1)))
#define LAS __attribute__((address_space(3)))
typedef unsigned short bf16;
typedef unsigned v4u __attribute__((ext_vector_type(4)));
typedef float f32x4 __attribute__((ext_vector_type(4)));
typedef short bf16x8 __attribute__((ext_vector_type(8)));
typedef GAS unsigned gu32;
typedef GAS unsigned long long gu64;
#define RLX_AGENT __ATOMIC_RELAXED, __HIP_MEMORY_SCOPE_AGENT
#define LDS_WAIT() asm volatile("s_waitcnt lgkmcnt(0)" ::: "memory")
#define VM_WAIT() asm volatile("s_waitcnt vmcnt(0)" ::: "memory")
__device__ __forceinline__ unsigned long long rt() { return __builtin_amdgcn_s_memrealtime(); }
__device__ __forceinline__ unsigned f2bf(float f) { unsigned u = __builtin_bit_cast(unsigned, f); return (u + 0x7fffu + ((u >> 16) & 1u)) >> 16; }
__device__ __forceinline__ unsigned pk2(float lo, float hi) { return f2bf(lo) | (f2bf(hi) << 16); }
#define XB_TMO      128
#define XB_XCNT(j)  (256  + 64 * (j))
#define XB_XSUB(j)  (1280 + 64 * (j))
#define XB_XGEN(j)  (2304 + 64 * (j))
#define XB_TOP      3328
#define XB_TOPGEN   3392
#define XCD_BAR_WORDS 3456
#define XB_SPIN_CAP (1u << 18)

__device__ __forceinline__ unsigned xb_ld(unsigned* p)              { return __hip_atomic_load(p, __ATOMIC_RELAXED, __HIP_MEMORY_SCOPE_AGENT); }
__device__ __forceinline__ unsigned xb_add(unsigned* p, unsigned v) { return __hip_atomic_fetch_add(p, v, __ATOMIC_RELAXED, __HIP_MEMORY_SCOPE_AGENT); }
__device__ __forceinline__ unsigned xb_xcc_id() { return (unsigned)__builtin_amdgcn_s_getreg((3 << 11) | 20) & 0xFu; }
#define XB_SPIN(cond, bar) do { unsigned _sp = 0; while (cond) { __builtin_amdgcn_s_sleep(1); \
    if ((++_sp & 255u) == 0u) { if (xb_ld(&(bar)[XB_TMO])) break; if (_sp > XB_SPIN_CAP) { atomicAdd(&(bar)[XB_TMO], 1u); break; } } } } while (0)

struct XcdBarrier {
    unsigned* bar; unsigned x;
    volatile LAS unsigned* st;
};

__device__ __forceinline__ XcdBarrier xcd_barrier_post(unsigned* bar, volatile LAS unsigned* st) {
    XcdBarrier b; b.bar = bar; b.x = xb_xcc_id(); b.st = st;
    if (threadIdx.x == 0) (void)xb_add(&bar[XB_XCNT(b.x)], 1u);
    return b;
}
__device__ __forceinline__ void xcd_barrier_complete(unsigned* bar, unsigned x, unsigned& nloc, unsigned& nx) {
    const unsigned G = gridDim.x * gridDim.y * gridDim.z;
    unsigned sum, cnt, mine, sp = 0u;
    for (;;) {
        sum = 0u; cnt = 0u; mine = 0u;
#pragma unroll
        for (unsigned j = 0; j < 16; ++j) { const unsigned c = xb_ld(&bar[XB_XCNT(j)]); sum += c; cnt += (c > 0u) ? 1u : 0u; mine = (j == x) ? c : mine; }
        if (sum == G) break;
        __builtin_amdgcn_s_sleep(1);
        if ((++sp & 255u) == 0u) { if (xb_ld(&bar[XB_TMO])) break; if (sp > XB_SPIN_CAP) { atomicAdd(&bar[XB_TMO], 1u); break; } }
    }
    nloc = mine > 0u ? mine : 1u; nx = cnt > 0u ? cnt : 1u;
}

__device__ __forceinline__ void xcd_barrier(const XcdBarrier& b) {
    asm volatile("s_waitcnt vmcnt(0)" ::: "memory");
    __syncthreads();
    if (threadIdx.x == 0) {
        unsigned* bar = b.bar;
        __builtin_amdgcn_s_waitcnt(0);
        unsigned nloc = b.st[0], nx = b.st[1];
        if (nloc == 0u) { xcd_barrier_complete(bar, b.x, nloc, nx); b.st[0] = nloc; b.st[1] = nx; }
        const unsigned old = xb_add(&bar[XB_XSUB(b.x)], 1u);
        const unsigned gen = old / nloc;
        if (old + 1u == (gen + 1u) * nloc) {
            __builtin_amdgcn_fence(__ATOMIC_RELEASE, "agent");
            asm volatile("s_waitcnt vmcnt(0)" ::: "memory");
            const unsigned og = xb_add(&bar[XB_TOP], 1u);
            const unsigned tg = og / nx;
            if (og + 1u == (tg + 1u) * nx) xb_add(&bar[XB_TOPGEN], 1u);
            else XB_SPIN(xb_ld(&bar[XB_TOPGEN]) == tg, bar);
            __builtin_amdgcn_fence(__ATOMIC_ACQUIRE, "agent");
            xb_add(&bar[XB_XGEN(b.x)], 1u);
            asm volatile("s_waitcnt vmcnt(0)" ::: "memory");
        } else {
            XB_SPIN(xb_ld(&bar[XB_XGEN(b.x)]) == gen, bar);
            __builtin_amdgcn_fence(__ATOMIC_ACQUIRE, "agent");
            asm volatile("s_waitcnt vmcnt(0)" ::: "memory");
        }
    }
    __syncthreads();
}
constexpr int NB = 4, SEQ = 4096, CTXL = 256, TPB = SEQ + CTXL, NROWS = NB * TPB, DM = 1024, NLAYER = 2, IN_COLS = 6816;
constexpr int NWAVES = 8, NTHREADS = NWAVES * 64;
constexpr float RMS_EPS = 1e-6f;
constexpr float LOG2E = 1.4426950408889634f;
constexpr float QSCALE64 = 0.125f * LOG2E;
constexpr float QSCALE96 = 0.10206207261596575f * LOG2E;
constexpr int ZS_P = 1792, ZC_CQ = 0, ZC_CKV = 256, ZC_KR = 384, ZC_SQ = 512, ZC_SK = 768, ZC_SV = 896, ZC_AQ = 1024, ZC_AK = 1280, ZC_AV = 1408, ZC_LRU = 1536;
constexpr int N1 = 2816;
constexpr int W1ROWS = N1 + 4096;
constexpr size_t MiB = 1u << 20;
constexpr size_t WS_CTL = 0, CTL_ZERO_BYTES = 64 * 1024;
constexpr size_t WS_MOD = 1 * MiB;
constexpr size_t WS_RHC = 1 * MiB + 256 * 1024, WS_RHS = WS_RHC + 512 * 1024;
constexpr size_t WS_RMC = WS_RHS + 512 * 1024, WS_RMS = WS_RMC + 256 * 1024;
constexpr size_t WS_CTX1 = 3 * MiB;
constexpr size_t WS_WOS = 3 * MiB;
constexpr size_t WS_W = 8 * MiB, W_LAYER = 18 * MiB;
constexpr size_t WO_W1 = 0, WO_WB = 13 * MiB + 512 * 1024, WO_WO = WO_WB + 2 * MiB, WO_UQ = WO_WO + 2 * MiB, WO_UKV = WO_UQ + 256 * 1024;
constexpr size_t WS_H = 44 * MiB;
constexpr size_t WS_G = 78 * MiB;
constexpr size_t WS_S = 112 * MiB;
constexpr size_t WS_ZS = 112 * MiB;
constexpr size_t WS_MQ = 172 * MiB;
constexpr size_t WS_MKV = 189 * MiB;
constexpr size_t WS_MK = 206 * MiB;
constexpr size_t WS_U = 219 * MiB;
constexpr size_t WS_HF = 236 * MiB;
constexpr size_t WS_SP = 2 * MiB + 768 * 1024;
constexpr size_t WS_LWT = 254 * MiB + 512 * 1024;
constexpr size_t WS_END = 256 * MiB;
static_assert(WS_H + (size_t)NROWS * 1024 * 2 <= WS_G && WS_G + (size_t)NROWS * 1024 * 2 <= WS_S && WS_S + (size_t)NROWS * 4096 * 2 <= 248 * MiB, "ws map");
static_assert(WS_ZS + (size_t)NROWS * ZS_P * 2 <= WS_MQ && WS_MK + (size_t)NROWS * 384 * 2 <= WS_U, "ws map 2");
static_assert(WO_UKV + 512 * 256 * 2 <= W_LAYER, "weights");
constexpr int CW_BAR = 1024;
constexpr int CW_FLG = 8192;

constexpr int RING_OFF = 0, RING_BYTES = 131072, LDSCTL_OFF = RING_BYTES, MISC_OFF = LDSCTL_OFF + 320, LDS_BYTES = 147456;

typedef unsigned short bf16;
typedef unsigned u32x2 __attribute__((ext_vector_type(2)));
typedef float f32x2v __attribute__((ext_vector_type(2)));
__device__ __forceinline__ float bf2f(bf16 v) { return __uint_as_float((unsigned)v << 16); }
template <int O> __device__ __forceinline__ float xor_swz(float v) { return __int_as_float(__builtin_amdgcn_ds_swizzle(__float_as_int(v), (O << 10) | 0x1F)); }
__device__ __forceinline__ float wave_sum(float v) {
    v += xor_swz<1>(v); v += xor_swz<2>(v); v += xor_swz<4>(v); v += xor_swz<8>(v); v += xor_swz<16>(v);
    auto rr = __builtin_amdgcn_permlane32_swap(__float_as_uint(v), __float_as_uint(v), false, false); return __uint_as_float(rr[0]) + __uint_as_float(rr[1]); }
__device__ __forceinline__ float wave_max(float v) {
    v = fmaxf(v, xor_swz<1>(v)); v = fmaxf(v, xor_swz<2>(v)); v = fmaxf(v, xor_swz<4>(v)); v = fmaxf(v, xor_swz<8>(v)); v = fmaxf(v, xor_swz<16>(v));
    auto rr = __builtin_amdgcn_permlane32_swap(__float_as_uint(v), __float_as_uint(v), false, false); return fmaxf(__uint_as_float(rr[0]), __uint_as_float(rr[1])); }
__device__ __forceinline__ float grp16_sum(float v) {
    v += xor_swz<1>(v); v += xor_swz<2>(v); v += xor_swz<4>(v); v += xor_swz<8>(v); return v; }

struct Args { const float* in[28]; float* out; unsigned char* ws; int ph_lo, ph_hi; };
enum { I_X = 0, I_C, I_CTX, I_CCTX, I_WMOD, I_BMOD, I_NORMW, I_WIN, I_CQN, I_CKVN, I_WUQ, I_WUKV, I_MQN, I_MKN, I_SQN, I_SKN, I_SINK, I_AQN, I_AKN,
       I_CONVW, I_CONVB, I_LWR, I_LBR, I_LWI, I_LBI, I_LAM, I_WBR, I_WOUT };

struct Frame {
    LAS unsigned char* lds; const float* const __attribute__((address_space(4)))* kin; unsigned char* ws; float* out;
    int tid, lane, wave, G, vcu, gw, NGW, z;
    __device__ __forceinline__ const float* in(int i) const { return kin[i]; }
};

__device__ __forceinline__ void xpose_item(const float* W, int ldn, int k0, int n0, bf16* WT, int pd, int drow, LAS float* scr, int lane) {
    float v[32]; const float* wp = W + (size_t)(k0 + (lane >> 5)) * ldn + n0 + (lane & 31);
#pragma unroll
    for (int i = 0; i < 32; ++i) v[i] = wp[(size_t)(2 * i) * ldn];
#pragma unroll
    for (int i = 0; i < 32; ++i) scr[(2 * i + (lane >> 5)) * 33 + (lane & 31)] = v[i];
    LDS_WAIT(); asm volatile("" ::: "memory");
    const int c = lane & 7;
#pragma unroll
    for (int j = 0; j < 4; ++j) { const int n = (lane >> 3) + 8 * j; const LAS float* s = scr + (8 * c) * 33 + n;
        v4u o; o.x = pk2(s[0 * 33], s[1 * 33]); o.y = pk2(s[2 * 33], s[3 * 33]); o.z = pk2(s[4 * 33], s[5 * 33]); o.w = pk2(s[6 * 33], s[7 * 33]);
        *(GAS v4u*)(WT + (size_t)(drow + n0 + n) * pd + k0 + 8 * c) = o; }
    LDS_WAIT(); asm volatile("" ::: "memory");
}
__device__ __forceinline__ void zero16(bf16* p, size_t n16, int gt, int ngt) {
    for (size_t i = gt; i < n16; i += ngt) ((GAS v4u*)p)[i] = (v4u){0u, 0u, 0u, 0u};
}
constexpr int N1T = 2816 / 32;
constexpr int I_EARLY = 16 * N1T + 4 * 12 + 2 * 16, I_INL = 16 * (213 - N1T), I_BR = 4 * 4 * 32, I_OUT = 16 * 32, I_LAYER = I_EARLY + I_INL + I_BR + I_OUT, I_SPLIT = 16 * 32;
__device__ __forceinline__ void copy_item(Frame& F, int l, int r, LAS float* scr) {
    unsigned char* wl = F.ws + WS_W + (size_t)l * W_LAYER;
    if (r < 16 * N1T) { const int kb = r / N1T, nb = r % N1T, n0 = nb * 32;
        xpose_item(F.in(I_WIN) + (size_t)l * 1024 * IN_COLS, IN_COLS, kb * 64, n0, (bf16*)(wl + WO_W1), 1024, n0 >= 416 ? 96 : 0, scr, F.lane); return; } r -= 16 * N1T;
    if (r < 4 * 12) { const int kb = r / 12, nb = r % 12;
        xpose_item(F.in(I_WUQ) + (size_t)l * 256 * 384, 384, kb * 64, nb * 32, (bf16*)(wl + WO_UQ), 256, 0, scr, F.lane); return; } r -= 4 * 12;
    if (r < 2 * 16) { const int kb = r / 16, nb = r % 16;
        xpose_item(F.in(I_WUKV) + (size_t)l * 128 * 512, 512, kb * 64, nb * 32, (bf16*)(wl + WO_UKV), 256, 0, scr, F.lane); return; } r -= 2 * 16;
    if (r < I_INL) { const int kb = r / (213 - N1T), nb = N1T + r % (213 - N1T), n0 = nb * 32;
        xpose_item(F.in(I_WIN) + (size_t)l * 1024 * IN_COLS, IN_COLS, kb * 64, n0, (bf16*)(wl + WO_W1), 1024, 96, scr, F.lane); return; } r -= I_INL;
    if (r < I_BR) { const int k = r / 128, rr = r % 128, kb = rr / 32, nb = rr % 32;
        xpose_item(F.in(I_WBR) + ((size_t)l * 4 + k) * 256 * 1024, 1024, kb * 64, nb * 32, (bf16*)(wl + WO_WB) + (size_t)k * 1024 * 256, 256, 0, scr, F.lane); return; } r -= I_BR;
    if (r < I_OUT) { const int kb = r / 32, nb = r % 32;
        xpose_item(F.in(I_WOUT) + (size_t)l * 1024 * 1024, 1024, kb * 64, nb * 32, (bf16*)(wl + WO_WO), 1024, 0, scr, F.lane); return; } r -= I_OUT;
    if (r < I_SPLIT) { const int kb = r / 32, nb = r % 32, kq = kb >> 2;
        xpose_item(F.in(I_WOUT), 1024, kb * 64, nb * 32, (bf16*)(F.ws + WS_WOS) + (size_t)kq * (1024 * 256 - 256), 256, 0, scr, F.lane); }
}
__device__ __forceinline__ void weight_copies(Frame& F, int first, int stride, int loA, int nA, int loB, int nB) {
    LAS float* scr = (LAS float*)(F.lds + RING_OFF + F.wave * 16384);
#pragma unroll 1
    for (int v = first; v < nA + nB; v += stride) { const bool a = v < nA; copy_item(F, a ? 0 : NLAYER - 1, a ? loA + v : loB + v - nA, scr); }
}
constexpr int IC_G1 = 320;
__device__ __forceinline__ void p0_tables(Frame& F, int gt, int ngt) {
    { float* rhc = (float*)(F.ws + WS_RHC); float* rhs = (float*)(F.ws + WS_RHS); float* rmc = (float*)(F.ws + WS_RMC); float* rms = (float*)(F.ws + WS_RMS);
      constexpr float L2_10000 = 13.287712379549449f, INV_2PI = 0.15915494309189535f;
      for (int i = gt; i < 4096 * 32; i += ngt) { const int t = i >> 5, p = i & 31; const float fr = __builtin_amdgcn_exp2f(-(float)(p & 15) * (L2_10000 / 16.0f));
          const float pos = (float)((p < 16) ? (t >> 6) : (t & 63)); const float rev = pos * fr * INV_2PI; rhc[i] = __builtin_amdgcn_cosf(rev); rhs[i] = __builtin_amdgcn_sinf(rev); }
      for (int i = gt; i < 4096 * 16; i += ngt) { const int t = i >> 4, p = i & 15; const float fr = __builtin_amdgcn_exp2f(-(float)(p & 7) * (L2_10000 / 8.0f));
          const float pos = (float)((p < 8) ? (t >> 6) : (t & 63)); const float rev = pos * fr * INV_2PI; rmc[i] = __builtin_amdgcn_cosf(rev); rms[i] = __builtin_amdgcn_sinf(rev); } }
    { float* sp = (float*)(F.ws + WS_SP); for (int i = gt; i < NLAYER * 2 * 256; i += ngt) sp[i] = 8.0f * LOG2E * log1pf(expf(-F.in(I_LAM)[i])); }
    { float* lwt = (float*)(F.ws + WS_LWT);
      for (int o = gt; o < NLAYER * 2 * 2 * 256 * 64; o += ngt) { const int i = o & 63, c = (o >> 6) & 255, gate = (o >> 14) & 1, ld = o >> 15, k = c >> 6, j = c & 63;
          lwt[o] = (gate == 0 ? F.in(I_LWR) : F.in(I_LWI))[(((size_t)ld * 4 + k) * 64 + i) * 64 + j]; } }
}
__device__ __forceinline__ void p0_prologue(Frame& F) {
    weight_copies(F, F.gw, F.NGW, 0, I_EARLY, 0, 0);
    const int gt = F.vcu * NTHREADS + F.tid, ngt = F.G * NTHREADS;
    for (int l = 0; l < NLAYER; ++l) {
        unsigned char* wl = F.ws + WS_W + (size_t)l * W_LAYER;
        zero16((bf16*)(wl + WO_W1) + (size_t)416 * 1024, 96 * 1024 * 2 / 16, gt, ngt);
        zero16((bf16*)(wl + WO_UQ) + (size_t)384 * 256, 128 * 256 * 2 / 16, gt, ngt);
        for (int i = gt; i < 512 * 16; i += ngt) { const int n = i >> 4, c = i & 15; ((GAS v4u*)((bf16*)(wl + WO_UKV) + (size_t)n * 256 + 128))[c] = (v4u){0u, 0u, 0u, 0u}; }
    }
    { LAS float* sc = (LAS float*)(F.lds + RING_OFF);
      LAS float* red = sc + 5 * 1024;
      __syncthreads();
      for (int i = F.tid; i < 5 * 1024; i += NTHREADS) { const float v = (i < 4096) ? F.in(I_C)[i] : F.in(I_CCTX)[i - 4096]; sc[i] = v / (1.0f + expf(-v)); }
      __syncthreads();
      float* modv = (float*)(F.ws + WS_MOD);
      for (int it = F.vcu; it < NLAYER * 96; it += F.G) {
          const int l = it / 96, n0 = (it % 96) * 32, nn = F.tid & 31, kc = F.tid >> 5;
          const float* w = F.in(I_WMOD) + (size_t)l * 1024 * 3072 + n0 + nn;
          float acc[5] = {0.f, 0.f, 0.f, 0.f, 0.f};
#pragma unroll 1
          for (int k0 = kc * 64; k0 < kc * 64 + 64; k0 += 32) { float wv[32];
#pragma unroll
              for (int i = 0; i < 32; ++i) wv[i] = w[(size_t)(k0 + i) * 3072];
#pragma unroll
              for (int i = 0; i < 32; ++i)
#pragma unroll
                  for (int r = 0; r < 5; ++r) acc[r] += sc[r * 1024 + k0 + i] * wv[i]; }
#pragma unroll
          for (int r = 0; r < 5; ++r) red[(kc * 5 + r) * 32 + nn] = acc[r];
          __syncthreads();
          if (F.tid < 160) { const int r = F.tid >> 5; float s = 0.f;
              for (int q = 0; q < 16; ++q) s += red[(q * 5 + r) * 32 + nn];
              modv[((size_t)l * 5 + r) * 3072 + n0 + nn] = s + F.in(I_BMOD)[l * 3072 + n0 + nn]; }
          __syncthreads();
      } }
}

__device__ __forceinline__ void ph_hnorm(Frame& F, int l) {
    const float* xs = (l == 0) ? F.in(I_X) : F.out; const float* cs = (l == 0) ? F.in(I_CTX) : (const float*)(F.ws + WS_CTX1);
    const float* nw = F.in(I_NORMW) + l * 1024; const float* modl = (const float*)(F.ws + WS_MOD) + (size_t)l * 5 * 3072;
    bf16* H = (bf16*)(F.ws + WS_H);
    for (int row = F.gw; row < NROWS; row += F.NGW) {
        const int b = row / TPB, j = row % TPB; const float* src; int mr;
        if (j < CTXL) { src = cs + ((size_t)b * CTXL + j) * 1024; mr = 4; } else { src = xs + ((size_t)b * SEQ + (j - CTXL)) * 1024; mr = b; }
        const GAS f32x4* xr = (const GAS f32x4*)src + F.lane;
        f32x4 v[4]; float ss = 0.f;
        if (l > 0 && j < CTXL) {
            const unsigned short* P = (const unsigned short*)(F.ws + WS_S) + (size_t)row * 4096 + 4 * F.lane;
            const float* gt = (const float*)(F.ws + WS_MOD) + 4 * 3072 + 2048 + 4 * F.lane;
            const GAS f32x4* c0 = (const GAS f32x4*)(F.in(I_CTX) + ((size_t)b * CTXL + j) * 1024) + F.lane;
#pragma unroll
            for (int q = 0; q < 4; ++q) { f32x4 a = {0.f, 0.f, 0.f, 0.f};
#pragma unroll
                for (int kq = 0; kq < 4; ++kq) { const u32x2 w = *(const u32x2*)(P + kq * 1024 + 256 * q); a.x += bflo(w.x); a.y += bfhi(w.x); a.z += bflo(w.y); a.w += bfhi(w.y); }
                v[q] = c0[64 * q] + *(const f32x4*)(gt + 256 * q) * a; }
        } else {
#pragma unroll
            for (int q = 0; q < 4; ++q) v[q] = xr[64 * q];
        }
#pragma unroll
        for (int q = 0; q < 4; ++q) ss += (v[q].x * v[q].x + v[q].y * v[q].y) + (v[q].z * v[q].z + v[q].w * v[q].w);
        const float rstd = 1.0f / sqrtf(wave_sum(ss) * (1.0f / 1024.0f) + RMS_EPS);
        const float* mrow = modl + mr * 3072;
        GAS unsigned long long* o8 = (GAS unsigned long long*)(H + (size_t)row * 1024) + F.lane;
#pragma unroll
        for (int q = 0; q < 4; ++q) { const int c = 4 * F.lane + 256 * q;
            const f32x4 g = *(const f32x4*)(nw + c), sh = *(const f32x4*)(mrow + c), sc = *(const f32x4*)(mrow + 1024 + c);
            const f32x4 h = v[q] * rstd * g * (sc + 1.0f) + sh;
            o8[64 * q] = (unsigned long long)pk2(h.x, h.y) | ((unsigned long long)pk2(h.z, h.w) << 32); }
    }
}

struct P1Regs { u32x2 cq; unsigned ckv, h[3][2]; float rc[2], rs[2]; };
__device__ __forceinline__ void post1_load(const bf16* z, const float* rc, const float* rs, bool lat, int lane, P1Regs& R) {
    const int hg = lane >> 4, p0 = (lane & 15) * 2;
    R.cq = *(const u32x2*)(z + ZC_CQ + 4 * lane); R.ckv = *(const unsigned*)(z + ZC_CKV + 2 * lane);
    const bf16* h0 = z + ZC_SQ + hg * 64 + p0; const bf16* h1 = z + ZC_AQ + hg * 64 + p0; const bf16* h2 = z + ((hg < 2) ? (ZC_SK + hg * 64) : (ZC_AK + (hg - 2) * 64)) + p0;
    R.h[0][0] = *(const unsigned*)h0; R.h[0][1] = *(const unsigned*)(h0 + 32); R.h[1][0] = *(const unsigned*)h1; R.h[1][1] = *(const unsigned*)(h1 + 32); R.h[2][0] = *(const unsigned*)h2; R.h[2][1] = *(const unsigned*)(h2 + 32);
    if (lat) { R.rc[0] = rc[p0]; R.rc[1] = rc[p0 + 1]; R.rs[0] = rs[p0]; R.rs[1] = rs[p0 + 1]; } else { R.rc[0] = 1.f; R.rc[1] = 1.f; R.rs[0] = 0.f; R.rs[1] = 0.f; }
}
__device__ __forceinline__ void post1_finish(bf16* z, int lane, const P1Regs& R, const float (&gcq)[4], const float (&gckv)[2], const float (&gh)[3][4]) {
    const int hg = lane >> 4, p0 = (lane & 15) * 2;
    { float v0 = bflo(R.cq.x), v1 = bfhi(R.cq.x), v2 = bflo(R.cq.y), v3 = bfhi(R.cq.y);
      const float rstd = 1.0f / sqrtf(wave_sum(v0 * v0 + v1 * v1 + v2 * v2 + v3 * v3) * (1.0f / 256.0f) + RMS_EPS);
      u32x2 w; w.x = pk2(v0 * rstd * gcq[0], v1 * rstd * gcq[1]); w.y = pk2(v2 * rstd * gcq[2], v3 * rstd * gcq[3]); *(u32x2*)(z + ZC_CQ + 4 * lane) = w; }
    { float v0 = bflo(R.ckv), v1 = bfhi(R.ckv);
      const float rstd = 1.0f / sqrtf(wave_sum(v0 * v0 + v1 * v1) * (1.0f / 128.0f) + RMS_EPS);
      *(unsigned*)(z + ZC_CKV + 2 * lane) = pk2(v0 * rstd * gckv[0], v1 * rstd * gckv[1]); }
#pragma unroll
    for (int q = 0; q < 3; ++q) {
        bf16* hp = z + ((q == 0) ? (ZC_SQ + hg * 64) : (q == 1) ? (ZC_AQ + hg * 64) : ((hg < 2) ? (ZC_SK + hg * 64) : (ZC_AK + (hg - 2) * 64))) + p0;
        float a0 = bflo(R.h[q][0]), a1 = bfhi(R.h[q][0]), b0 = bflo(R.h[q][1]), b1 = bfhi(R.h[q][1]);
        const float rstd = 1.0f / sqrtf(grp16_sum(a0 * a0 + a1 * a1 + b0 * b0 + b1 * b1) * (1.0f / 64.0f) + RMS_EPS);
        a0 *= rstd * gh[q][0]; a1 *= rstd * gh[q][1]; b0 *= rstd * gh[q][2]; b1 *= rstd * gh[q][3];
        const float x0 = a0 * R.rc[0] - b0 * R.rs[0], y0 = b0 * R.rc[0] + a0 * R.rs[0], x1 = a1 * R.rc[1] - b1 * R.rs[1], y1 = b1 * R.rc[1] + a1 * R.rs[1];
        const float sc = (q < 2) ? QSCALE64 : 1.0f;
        *(unsigned*)hp = pk2(x0 * sc, x1 * sc); *(unsigned*)(hp + 32) = pk2(y0 * sc, y1 * sc);
    }
}
__device__ __forceinline__ void ph_post1(Frame& F, int l) {
    bf16* ZS = (bf16*)(F.ws + WS_ZS);
    const float* rhc = (const float*)(F.ws + WS_RHC); const float* rhs = (const float*)(F.ws + WS_RHS);
    const int lane = F.lane, hg = lane >> 4, p0 = (lane & 15) * 2;
    float gcq[4], gckv[2], gh[3][4];
#pragma unroll
    for (int i = 0; i < 4; ++i) gcq[i] = F.in(I_CQN)[l * 256 + 4 * lane + i];
    gckv[0] = F.in(I_CKVN)[l * 128 + 2 * lane]; gckv[1] = F.in(I_CKVN)[l * 128 + 2 * lane + 1];
    { const float* g0 = F.in(I_SQN) + l * 64; const float* g1 = F.in(I_AQN) + l * 64; const float* g2 = ((hg < 2) ? F.in(I_SKN) : F.in(I_AKN)) + l * 64;
      gh[0][0] = g0[p0]; gh[0][1] = g0[p0 + 1]; gh[0][2] = g0[32 + p0]; gh[0][3] = g0[33 + p0];
      gh[1][0] = g1[p0]; gh[1][1] = g1[p0 + 1]; gh[1][2] = g1[32 + p0]; gh[1][3] = g1[33 + p0];
      gh[2][0] = g2[p0]; gh[2][1] = g2[p0 + 1]; gh[2][2] = g2[32 + p0]; gh[2][3] = g2[33 + p0]; }
    for (int row = F.gw; row < NROWS; row += 2 * F.NGW) {
        const int row2 = row + F.NGW; const bool has2 = row2 < NROWS;
        const int j = row % TPB; const bool lat = j >= CTXL; const int pos = lat ? j - CTXL : 0;
        const int j2 = has2 ? row2 % TPB : 0; const bool lat2 = j2 >= CTXL; const int pos2 = lat2 ? j2 - CTXL : 0;
        bf16* z = ZS + (size_t)row * ZS_P; bf16* z2 = ZS + (size_t)(has2 ? row2 : row) * ZS_P;
        P1Regs A, B;
        post1_load(z, rhc + pos * 32, rhs + pos * 32, lat, lane, A);
        if (has2) post1_load(z2, rhc + pos2 * 32, rhs + pos2 * 32, lat2, lane, B);
        post1_finish(z, lane, A, gcq, gckv, gh);
        if (has2) post1_finish(z2, lane, B, gcq, gckv, gh);
    }
}
struct P2Regs { u32x2 qn, kn; bf16 q1, q2, k1, k2; float c, s; };
__device__ __forceinline__ void post2_load(const bf16* zrow, const bf16* mq, const bf16* mkv, const float* rc, const float* rs, bool lat, int lane, P2Regs& R) {
    const int h = lane >> 4, j = lane & 15;
    R.qn = *(const u32x2*)(mq + h * 96 + 4 * j); R.q1 = mq[h * 96 + 64 + j]; R.q2 = mq[h * 96 + 80 + j];
    R.kn = *(const u32x2*)(mkv + h * 128 + 4 * j); R.k1 = zrow[ZC_KR + j]; R.k2 = zrow[ZC_KR + 16 + j];
    if (lat) { R.c = rc[j]; R.s = rs[j]; } else { R.c = 1.f; R.s = 0.f; }
}
__device__ __forceinline__ void post2_finish(bf16* mq, bf16* mk, int lane, const P2Regs& R, const float (&gq)[6], const float (&gk)[6]) {
    const int h = lane >> 4, j = lane & 15;
#pragma unroll
    for (int qk = 0; qk < 2; ++qk) {
        const u32x2 n = qk == 0 ? R.qn : R.kn; float v0 = bflo(n.x), v1 = bfhi(n.x), v2 = bflo(n.y), v3 = bfhi(n.y), r1 = bf2f(qk == 0 ? R.q1 : R.k1), r2 = bf2f(qk == 0 ? R.q2 : R.k2);
        const float rstd = 1.0f / sqrtf(grp16_sum(v0 * v0 + v1 * v1 + v2 * v2 + v3 * v3 + r1 * r1 + r2 * r2) * (1.0f / 96.0f) + RMS_EPS);
        const float (&g)[6] = qk == 0 ? gq : gk; const float sc = qk == 0 ? QSCALE96 : 1.0f;
        const float y1 = r1 * rstd * g[4], y2 = r2 * rstd * g[5];
        const float t1 = (y1 * R.c - y2 * R.s) * sc, t2 = (y2 * R.c + y1 * R.s) * sc;
        bf16* o = (qk == 0 ? mq : mk) + h * 96;
        u32x2 w; w.x = pk2(v0 * rstd * g[0] * sc, v1 * rstd * g[1] * sc); w.y = pk2(v2 * rstd * g[2] * sc, v3 * rstd * g[3] * sc);
        *(u32x2*)(o + 4 * j) = w; o[64 + j] = (bf16)f2bf(t1); o[80 + j] = (bf16)f2bf(t2);
    }
}
__device__ __forceinline__ void ph_post2(Frame& F, int l) {
    const bf16* ZS = (const bf16*)(F.ws + WS_ZS); bf16* MQ = (bf16*)(F.ws + WS_MQ); const bf16* MKV = (const bf16*)(F.ws + WS_MKV); bf16* MK = (bf16*)(F.ws + WS_MK);
    const float* rmc = (const float*)(F.ws + WS_RMC); const float* rms = (const float*)(F.ws + WS_RMS);
    const int lane = F.lane, jj = lane & 15;
    float gq[6], gk[6];
    { const float* a = F.in(I_MQN) + l * 96; const float* b = F.in(I_MKN) + l * 96;
#pragma unroll
      for (int i = 0; i < 4; ++i) { gq[i] = a[4 * jj + i]; gk[i] = b[4 * jj + i]; }
      gq[4] = a[64 + jj]; gq[5] = a[80 + jj]; gk[4] = b[64 + jj]; gk[5] = b[80 + jj]; }
    for (int row = F.gw; row < NROWS; row += 2 * F.NGW) {
        const int row2 = row + F.NGW; const bool has2 = row2 < NROWS; const size_t rb = has2 ? row2 : row;
        const int j = row % TPB; const bool lat = j >= CTXL; const int pos = lat ? j - CTXL : 0;
        const int j2 = (int)(rb % TPB); const bool lat2 = j2 >= CTXL; const int pos2 = lat2 ? j2 - CTXL : 0;
        P2Regs A, B;
        post2_load(ZS + (size_t)row * ZS_P, MQ + (size_t)row * 512, MKV + (size_t)row * 512, rmc + pos * 16, rms + pos * 16, lat, lane, A);
        if (has2) post2_load(ZS + rb * ZS_P, MQ + rb * 512, MKV + rb * 512, rmc + pos2 * 16, rms + pos2 * 16, lat2, lane, B);
        post2_finish(MQ + (size_t)row * 512, MK + (size_t)row * 384, lane, A, gq, gk);
        if (has2) post2_finish(MQ + rb * 512, MK + rb * 384, lane, B, gq, gk);
    }
}

template <int DQK>
__device__ __forceinline__ void attn_row_naive(const bf16* q, const bf16* Kb, int kp, const bf16* Vb, int vp, int n1, int lo2, int hi2, bool has_sink, float sink2, bf16* y, int lane) {
    float qf[DQK];
#pragma unroll
    for (int c = 0; c < DQK / 8; ++c) { const v4u w = *(const v4u*)(q + 8 * c);
        qf[8 * c + 0] = bflo(w.x); qf[8 * c + 1] = bfhi(w.x); qf[8 * c + 2] = bflo(w.y); qf[8 * c + 3] = bfhi(w.y); qf[8 * c + 4] = bflo(w.z); qf[8 * c + 5] = bfhi(w.z); qf[8 * c + 6] = bflo(w.w); qf[8 * c + 7] = bfhi(w.w); }
    float m = -INFINITY, l = 0.f; float acc[64];
#pragma unroll
    for (int d = 0; d < 64; ++d) acc[d] = 0.f;
    for (int seg = 0; seg < 2; ++seg) {
        const int k0 = seg == 0 ? 0 : lo2, k1 = seg == 0 ? n1 : hi2;
        for (int key = k0 + lane; key < k1; key += 64) {
            const bf16* kr = Kb + (size_t)key * kp; float s = 0.f;
#pragma unroll
            for (int c = 0; c < DQK / 8; ++c) { const v4u w = *(const v4u*)(kr + 8 * c);
                s += qf[8 * c + 0] * bflo(w.x) + qf[8 * c + 1] * bfhi(w.x) + qf[8 * c + 2] * bflo(w.y) + qf[8 * c + 3] * bfhi(w.y) + qf[8 * c + 4] * bflo(w.z) + qf[8 * c + 5] * bfhi(w.z) + qf[8 * c + 6] * bflo(w.w) + qf[8 * c + 7] * bfhi(w.w); }
            if (s > m) { const float f = exp2f(m - s); l *= f;
#pragma unroll
                for (int d = 0; d < 64; ++d) acc[d] *= f;
                m = s; }
            const float p = exp2f(s - m); l += p;
            const bf16* vr = Vb + (size_t)key * vp;
#pragma unroll
            for (int c = 0; c < 8; ++c) { const v4u w = *(const v4u*)(vr + 8 * c);
                acc[8 * c + 0] += p * bflo(w.x); acc[8 * c + 1] += p * bfhi(w.x); acc[8 * c + 2] += p * bflo(w.y); acc[8 * c + 3] += p * bfhi(w.y); acc[8 * c + 4] += p * bflo(w.z); acc[8 * c + 5] += p * bfhi(w.z); acc[8 * c + 6] += p * bflo(w.w); acc[8 * c + 7] += p * bfhi(w.w); }
        }
    }
    float M = wave_max(m); if (has_sink) M = fmaxf(M, sink2);
    const float f = (m == -INFINITY) ? 0.f : exp2f(m - M);
    float L = wave_sum(l * f); if (has_sink) L += exp2f(sink2 - M);
    float mine = 0.f;
#pragma unroll
    for (int d = 0; d < 64; ++d) { const float t = wave_sum(acc[d] * f); if (lane == d) mine = t; }
    y[lane] = (bf16)f2bf(mine / L * bf2f(y[lane]));
}
__device__ __forceinline__ void ph_attn_naive(Frame& F, int l) {
    const bf16* ZS = (const bf16*)(F.ws + WS_ZS); const bf16* MQ = (const bf16*)(F.ws + WS_MQ); const bf16* MKV = (const bf16*)(F.ws + WS_MKV); const bf16* MK = (const bf16*)(F.ws + WS_MK);
    bf16* Y = (bf16*)(F.ws + WS_G);
    const long nitems = (long)NROWS * 12;
    for (long it = F.gw; it < nitems; it += F.NGW) {
        const int hb = (int)(it % 12); const int row = (int)(it / 12);
        const int b = row / TPB, j = row % TPB; const bool lat = j >= CTXL;
        if (!lat && l == NLAYER - 1) continue;
        const size_t r0 = (size_t)b * TPB;
        const int br = hb >> 2, h = hb & 3;
        bf16* y = Y + (size_t)row * 1024 + br * 256 + h * 64;
        if (br == 0) {
            attn_row_naive<96>(MQ + (size_t)row * 512 + h * 96, MK + r0 * 384 + h * 96, 384, MKV + r0 * 512 + h * 128 + 64, 512, CTXL, CTXL, lat ? TPB : CTXL, false, 0.f, y, F.lane);
        } else if (br == 1) {
            const int t = j - CTXL; int lo = CTXL, hi = CTXL;
            if (lat) { lo = CTXL + (t - 128 < 0 ? 0 : t - 128); hi = CTXL + (t + 128 > SEQ - 1 ? SEQ - 1 : t + 128) + 1; }
            attn_row_naive<64>(ZS + (size_t)row * ZS_P + ZC_SQ + h * 64, ZS + r0 * ZS_P + ZC_SK + (h >> 1) * 64, ZS_P, ZS + r0 * ZS_P + ZC_SV + (h >> 1) * 64, ZS_P, CTXL, lo, hi, true, F.in(I_SINK)[l * 4 + h] * LOG2E, y, F.lane);
        } else {
            attn_row_naive<64>(ZS + (size_t)row * ZS_P + ZC_AQ + h * 64, ZS + r0 * ZS_P + ZC_AK + (h >> 1) * 64, ZS_P, ZS + r0 * ZS_P + ZC_AV + (h >> 1) * 64, ZS_P, CTXL, CTXL, lat ? TPB : CTXL, false, 0.f, y, F.lane);
        }
    }
}

__device__ __forceinline__ void ph_lru_conv(Frame& F, int l) {
    const bf16* ZS = (const bf16*)(F.ws + WS_ZS); float* U = (float*)(F.ws + WS_U);
    const float* cw = F.in(I_CONVW) + l * 4 * 256; const float* cb = F.in(I_CONVB) + l * 256;
    const int gt = F.vcu * NTHREADS + F.tid, ngt = F.G * NTHREADS;
    for (int idx = gt; idx < NROWS * 256; idx += ngt) {
        const int row = idx >> 8, c = idx & 255, b = row / TPB, j = row % TPB;
        int s0, len, jj; if (j < CTXL) { s0 = b * TPB; len = CTXL; jj = j; } else { s0 = b * TPB + CTXL; len = SEQ; jj = j - CTXL; }
        float acc = cb[c];
#pragma unroll
        for (int i = 0; i < 4; ++i) { const int t = jj + i - 2; if (t >= 0 && t < len) acc += cw[i * 256 + c] * bf2f(ZS[(size_t)(s0 + t) * ZS_P + ZC_LRU + c]); }
        U[idx] = acc;
    }
}
__device__ __forceinline__ void ph_lru_scan(Frame& F, int l, int dir) {
    const float* U = (const float*)(F.ws + WS_U); float* HF = (float*)(F.ws + WS_HF); bf16* Y = (bf16*)(F.ws + WS_G);
    const int g = blockIdx.x * NTHREADS + F.tid;
    if (g < NB * 256) {
    const int b = g >> 8, c = g & 255, k = c >> 6, jc = c & 63;
    const float* wr = F.in(I_LWR) + ((((size_t)l * 2 + dir) * 4 + k) * 64) * 64 + jc;
    const float* wi = F.in(I_LWI) + ((((size_t)l * 2 + dir) * 4 + k) * 64) * 64 + jc;
    float wrr[64], wii[64];
#pragma unroll
    for (int i = 0; i < 64; ++i) { wrr[i] = wr[i * 64]; wii[i] = wi[i * 64]; }
    const float br = F.in(I_LBR)[(l * 2 + dir) * 256 + c], bi = F.in(I_LBI)[(l * 2 + dir) * 256 + c];
    const float lam = F.in(I_LAM)[(l * 2 + dir) * 256 + c];
    const float sp = log1pf(expf(-lam));
    float h = 0.f;
    for (int s = 0; s < TPB; ++s) {
        const int j = dir == 0 ? s : (s < CTXL ? CTXL - 1 - s : TPB + CTXL - 1 - s);
        const size_t row = (size_t)b * TPB + j;
        const float* ub = U + row * 256 + k * 64;
        float rp = br, ip = bi;
#pragma unroll
        for (int i = 0; i < 64; ++i) { const float uv = ub[i]; rp += uv * wrr[i]; ip += uv * wii[i]; }
        const float r = 1.0f / (1.0f + expf(-rp)), ig = 1.0f / (1.0f + expf(-ip));
        const float la = -8.0f * r * sp; const float a = expf(la);
        const float bx = sqrtf(-expm1f(2.0f * la)) * (ig * ub[jc]);
        h = a * h + bx;
        if (dir == 0) HF[row * 256 + c] = h;
        else { bf16* y = Y + row * 1024 + 768 + c; *y = (bf16)f2bf((HF[row * 256 + c] + h) * bf2f(*y)); }
    }
    }
}
__device__ __forceinline__ void ph_mixsum_ctx(Frame& F) {
    const bf16* S = (const bf16*)(F.ws + WS_S); bf16* MIX = (bf16*)(F.ws + WS_H);
    const int gt = F.vcu * NTHREADS + F.tid, ngt = F.G * NTHREADS;
    for (int idx = gt; idx < NB * CTXL * 128; idx += ngt) {
        const int r = idx >> 7, c8 = (idx & 127) * 8; const size_t row = (size_t)(r >> 8) * TPB + (r & 255); float s[8] = {0.f, 0.f, 0.f, 0.f, 0.f, 0.f, 0.f, 0.f};
#pragma unroll
        for (int k = 0; k < 4; ++k) { const v4u w = *(const GAS v4u*)(S + row * 4096 + k * 1024 + c8);
            s[0] += bflo(w.x); s[1] += bfhi(w.x); s[2] += bflo(w.y); s[3] += bfhi(w.y); s[4] += bflo(w.z); s[5] += bfhi(w.z); s[6] += bflo(w.w); s[7] += bfhi(w.w); }
        v4u o; o.x = pk2(s[0], s[1]); o.y = pk2(s[2], s[3]); o.z = pk2(s[4], s[5]); o.w = pk2(s[6], s[7]);
        *(GAS v4u*)(MIX + row * 1024 + c8) = o;
    }
}
namespace att {
typedef short bf16x8 __attribute__((ext_vector_type(8)));
typedef short s16x4 __attribute__((ext_vector_type(4)));
typedef short v4i16_t __attribute__((ext_vector_type(4)));
typedef float f32x16 __attribute__((ext_vector_type(16)));
typedef unsigned u32x4 __attribute__((ext_vector_type(4)));
typedef __attribute__((address_space(3))) const char* lds_cptr;
typedef float f32x2_t __attribute__((ext_vector_type(2))); typedef __bf16 bf16x2_t __attribute__((ext_vector_type(2)));
__device__ __forceinline__ int crow(int r, int hi) { return (r & 3) + 8 * (r >> 2) + 4 * hi; }
__device__ __forceinline__ void glds16(const void* gsrc, unsigned lds_dst) { unsigned keep;
    asm volatile("s_mov_b32 %0, m0\n\ts_mov_b32 m0, %2\n\ts_nop 0\n\tglobal_load_lds_dwordx4 %1, off\n\ts_mov_b32 m0, %0" : "=&s"(keep) : "v"(gsrc), "s"(lds_dst) : "memory"); }
__device__ __forceinline__ unsigned cvtpk(float lo, float hi) { f32x2_t v = {lo, hi}; bf16x2_t b = __builtin_convertvector(v, bf16x2_t); return __builtin_bit_cast(unsigned, b); }
__device__ __forceinline__ s16x4 vtr(lds_cptr p) { return __builtin_bit_cast(s16x4, __builtin_amdgcn_ds_read_tr16_b64_v4i16((__attribute__((address_space(3))) v4i16_t*)p)); }
__device__ __forceinline__ float halfswap_max(float m) { auto rr = __builtin_amdgcn_permlane32_swap(__float_as_uint(m), __float_as_uint(m), false, false); return fmaxf(__uint_as_float(rr[0]), __uint_as_float(rr[1])); }
__device__ __forceinline__ float halfswap_sum(float m) { auto rr = __builtin_amdgcn_permlane32_swap(__float_as_uint(m), __float_as_uint(m), false, false); return __uint_as_float(rr[0]) + __uint_as_float(rr[1]); }

template <int DQK> struct Cfg {
    static constexpr int KCH = DQK / 8, KSLOT = KCH * 1024, NKI = (KCH + 7) / 8, NI = NKI + 1;
    static constexpr int LDS_K = 0, LDS_V = 3 * KSLOT, LDS_WS = LDS_V + 3 * 8192, LDS_OST = LDS_WS + 8 * 256, BYTES = LDS_OST + 8 * 4096;
};
#define ATT_WAIT_BAR(N) asm volatile("s_waitcnt vmcnt(" #N ") lgkmcnt(0)\n\ts_barrier" ::: "memory")

struct UnitDesc {
    const unsigned short* Q; int qp;
    const unsigned short* K; int kp;
    const unsigned short* V; int vp;
    unsigned short* Y;
    int NT;
    int lat_row0;
    int qpos0, spos0;
    int has_sink; float sink2;
};

template <int DQK, bool SWA>
__device__ __forceinline__ void attn_unit(LAS unsigned char* ldsb, const UnitDesc& U, const int tid) {
    using C = Cfg<DQK>;
    const int lane = tid & 63, r32 = lane & 31, hi = lane >> 5; const int wid = __builtin_amdgcn_readfirstlane(tid >> 6);
    const unsigned lds0 = (unsigned)(uintptr_t)ldsb;
    LAS float* wsf = (LAS float*)(ldsb + C::LDS_WS) + wid * 64;
    const int kp = U.kp, vp = U.vp;
    const int kc1 = (C::NKI == 2 && wid < 4) ? wid + 8 : wid;
    const unsigned short* ksrc0 = U.K + (size_t)lane * kp + wid * 8;
    const unsigned short* ksrc1 = U.K + (size_t)lane * kp + kc1 * 8;
    const unsigned short* vsrc = U.V + (size_t)(16 * (wid & 3) + (lane >> 2)) * vp + (wid >> 2) * 32 + (lane & 3) * 8;
    const unsigned kdst0 = lds0 + C::LDS_K + wid * 1024, kdst1 = lds0 + C::LDS_K + kc1 * 1024, vdst = lds0 + C::LDS_V + wid * 1024;
    const int NT = U.NT;
#define ATT_KROW(t) (SWA ? ((t) < 4 ? 64 * (t) : U.lat_row0 + 64 * ((t) - 4)) : 64 * (t))
#define ATT_DMA_K(t, slot) do { const size_t ro_ = (size_t)ATT_KROW(t); \
        glds16(ksrc0 + ro_ * kp, (unsigned)__builtin_amdgcn_readfirstlane(kdst0 + (slot) * C::KSLOT)); \
        if (C::NKI == 2) glds16(ksrc1 + ro_ * kp, (unsigned)__builtin_amdgcn_readfirstlane(kdst1 + (slot) * C::KSLOT)); } while (0)
#define ATT_DMA_V(t, slot) do { const size_t ro_ = (size_t)ATT_KROW(t); glds16(vsrc + ro_ * vp, (unsigned)__builtin_amdgcn_readfirstlane(vdst + (slot) * 8192)); } while (0)
#define ATT_KLOAD(kslot) do { if (!SWA) { const lds_cptr kb_ = (lds_cptr)(ldsb + C::LDS_K) + (kslot) * C::KSLOT + hi * 1024 + r32 * 16; \
        _Pragma("unroll") for (int d0 = 0; d0 < DQK / 16; ++d0) { kf[2 * d0] = *(const __attribute__((address_space(3))) bf16x8*)(kb_ + d0 * 2048); kf[2 * d0 + 1] = *(const __attribute__((address_space(3))) bf16x8*)(kb_ + d0 * 2048 + 512); } } } while (0)
#define ATT_QKM(P0, P1, CINIT, kslot) do { P0 = f32x16{}; P1 = f32x16{}; \
        const lds_cptr kq_ = (lds_cptr)(ldsb + C::LDS_K) + (kslot) * C::KSLOT + hi * 1024 + r32 * 16; \
        _Pragma("unroll") for (int d0 = 0; d0 < DQK / 16; ++d0) { \
            const bf16x8 b0_ = SWA ? *(const __attribute__((address_space(3))) bf16x8*)(kq_ + d0 * 2048) : kf[2 * d0]; const bf16x8 b1_ = SWA ? *(const __attribute__((address_space(3))) bf16x8*)(kq_ + d0 * 2048 + 512) : kf[2 * d0 + 1]; \
            P0 = __builtin_amdgcn_mfma_f32_32x32x16_bf16(b0_, qr[d0], P0, 0, 0, 0); P1 = __builtin_amdgcn_mfma_f32_32x32x16_bf16(b1_, qr[d0], P1, 0, 0, 0); } } while (0)
#define ATT_VLOAD(vslot) do { if (!SWA) { const lds_cptr vb_ = (lds_cptr)(ldsb + C::LDS_V) + (vslot) * 8192 + ((lane >> 4) & 1) * 32 + (lane & 3) * 8 + (4 * hi + ((lane & 15) >> 2)) * 64; \
        _Pragma("unroll") for (int i = 0; i < 8; ++i) { vl[i] = vtr(vb_ + (i >> 2) * 4096 + (i & 3) * 1024); vh[i] = vtr(vb_ + (i >> 2) * 4096 + (i & 3) * 1024 + 512); } } } while (0)
#define ATT_MX3(a, b, c) __builtin_fmaxf(__builtin_fmaxf((a), (b)), (c))
#define ATT_NEEDMASK(j) ((j) >= 4 && U.qpos0 >= 0 && !((U.spos0 + 64 * ((j) - 4) + 63 - (U.qpos0 + 32 * wid) <= 128) && ((U.qpos0 + 32 * wid + 31) - (U.spos0 + 64 * ((j) - 4)) <= 128)))
#define ATT_SMPV(P0, P1, N0, N1, HASNEXT, t, vslot) do { \
        if (SWA && ATT_NEEDMASK(t)) { const bool mk_ = true; const int sb_ = U.spos0 + 64 * ((t) - 4) + 4 * hi;        \
            _Pragma("unroll") for (int r = 0; r < 16; ++r) { const int dd_ = qpos - (sb_ + (r & 3) + 8 * (r >> 2)); \
                P0[r] = (mk_ && (dd_ > 128 || dd_ < -128)) ? -INFINITY : P0[r]; P1[r] = (mk_ && (dd_ - 32 > 128 || dd_ - 32 < -128)) ? -INFINITY : P1[r]; } } \
        float ls_ = 0.f; \
        _Pragma("unroll") for (int r = 0; r < 16; ++r) { P0[r] = __builtin_amdgcn_exp2f(P0[r]); P1[r] = __builtin_amdgcn_exp2f(P1[r]); ls_ += P0[r] + P1[r]; } \
        l += ls_; \
        if (!SWA && DQK != 64) { __builtin_amdgcn_sched_barrier(0); ATT_VLOAD(vslot); } \
        u32x4 pw_[4]; \
        pw_[0] = (u32x4){cvtpk(P0[0], P0[1]), cvtpk(P0[2], P0[3]), cvtpk(P0[4], P0[5]), cvtpk(P0[6], P0[7])}; \
        pw_[1] = (u32x4){cvtpk(P0[8], P0[9]), cvtpk(P0[10], P0[11]), cvtpk(P0[12], P0[13]), cvtpk(P0[14], P0[15])}; \
        pw_[2] = (u32x4){cvtpk(P1[0], P1[1]), cvtpk(P1[2], P1[3]), cvtpk(P1[4], P1[5]), cvtpk(P1[6], P1[7])}; \
        pw_[3] = (u32x4){cvtpk(P1[8], P1[9]), cvtpk(P1[10], P1[11]), cvtpk(P1[12], P1[13]), cvtpk(P1[14], P1[15])}; \
        const lds_cptr vq_ = (lds_cptr)(ldsb + C::LDS_V) + (vslot) * 8192 + ((lane >> 4) & 1) * 32 + (lane & 3) * 8 + (4 * hi + ((lane & 15) >> 2)) * 64; \
        _Pragma("unroll") for (int d0 = 0; d0 < 2; ++d0) \
            _Pragma("unroll") for (int ks = 0; ks < 4; ++ks) { \
                const s16x4 lo_ = SWA ? vtr(vq_ + d0 * 4096 + ks * 1024) : vl[4 * d0 + ks], hh_ = SWA ? vtr(vq_ + d0 * 4096 + ks * 1024 + 512) : vh[4 * d0 + ks]; \
                const bf16x8 vf_ = (bf16x8){lo_[0], lo_[1], lo_[2], lo_[3], hh_[0], hh_[1], hh_[2], hh_[3]}; \
                o[d0] = __builtin_amdgcn_mfma_f32_32x32x16_bf16(__builtin_bit_cast(bf16x8, pw_[ks]), vf_, o[d0], 0, 0, 0); } } while (0)
#define ATT_SKIP(j) (SWA && (j) >= 4 && U.qpos0 >= 0 && ((U.spos0 + 64 * ((j) - 4) > U.qpos0 + 32 * wid + 31 + 128) || (U.spos0 + 64 * ((j) - 4) + 63 < U.qpos0 + 32 * wid - 128)))
#define ATT_STEP(C0, C1, N0, N1, t) do { \
        const int k3_ = (ks1 == 0) ? 2 : ks1 - 1, v2_ = (vs0 == 0) ? 2 : vs0 - 1; \
        if ((t) + 3 < NT) ATT_DMA_K((t) + 3, k3_); \
        if ((t) + 2 < NT) ATT_DMA_V((t) + 2, v2_); \
        ATT_KLOAD(ks1); \
        if (!SWA) __builtin_amdgcn_sched_barrier(0);        \
        if (!SWA || !ATT_SKIP((t) + 1)) ATT_QKM(N0, N1, -m, ks1); \
        if (DQK == 64) ATT_VLOAD(vs0);        \
        if (!SWA) __builtin_amdgcn_sched_barrier(0); \
        if (!SWA || !ATT_SKIP(t)) ATT_SMPV(C0, C1, N0, N1, true, t, vs0); \
        if ((t) + 3 < NT) { if (C::NI == 2) ATT_WAIT_BAR(2); else ATT_WAIT_BAR(3); } else ATT_WAIT_BAR(0); \
        ks1 = (ks1 == 2) ? 0 : ks1 + 1; vs0 = (vs0 == 2) ? 0 : vs0 + 1; } while (0)
    ATT_DMA_K(0, 0);
    ATT_DMA_K(1, 1); ATT_DMA_V(0, 0);
    ATT_DMA_K(2, 2); ATT_DMA_V(1, 1);
    bf16x8 qr[DQK / 16];
    { const unsigned short* qw = U.Q + (size_t)(wid * 32 + r32) * U.qp + hi * 8;
#pragma unroll
      for (int d0 = 0; d0 < DQK / 16; ++d0) qr[d0] = *(const bf16x8*)(qw + d0 * 16); }
    const float m = 0.f; float l = 0.f;
    f32x16 o[2]; o[0] = f32x16{}; o[1] = f32x16{};
    const int qpos = U.qpos0 + wid * 32 + r32;
    f32x16 pa0, pa1, pb0, pb1;
    bf16x8 kf[DQK / 8]; s16x4 vl[8], vh[8];
    if (C::NI == 2) ATT_WAIT_BAR(4); else ATT_WAIT_BAR(6);
    ATT_KLOAD(0); ATT_QKM(pa0, pa1, 0.f, 0);
    if (C::NI == 2) ATT_WAIT_BAR(2); else ATT_WAIT_BAR(3);
    int ks1 = 1, vs0 = 0;
    int t = 0;
    if (SWA) { for (; t + 1 < NT; ++t) { ATT_STEP(pa0, pa1, pb0, pb1, t); pa0 = pb0; pa1 = pb1; } if (!ATT_SKIP(NT - 1)) ATT_SMPV(pa0, pa1, pa0, pa1, false, NT - 1, vs0); }
    else {
    for (; t + 2 < NT; t += 2) { ATT_STEP(pa0, pa1, pb0, pb1, t); ATT_STEP(pb0, pb1, pa0, pa1, t + 1); }
    if (t + 1 < NT) { ATT_STEP(pa0, pa1, pb0, pb1, t); if (DQK == 64) ATT_VLOAD(vs0); ATT_SMPV(pb0, pb1, pb0, pb1, false, NT - 1, vs0); }
    else { if (DQK == 64) ATT_VLOAD(vs0); ATT_SMPV(pa0, pa1, pa0, pa1, false, NT - 1, vs0); }
    }
    l = halfswap_sum(l);
    if (U.has_sink) l += __builtin_amdgcn_exp2f(U.sink2 - m);
    if (hi == 0) wsf[32 + r32] = l;
    asm volatile("s_waitcnt lgkmcnt(0)" ::: "memory");
    { LAS unsigned short* stg = (LAS unsigned short*)(ldsb + C::LDS_OST) + wid * 2048;
#pragma unroll
      for (int r = 0; r < 16; ++r) { const int orow = crow(r, hi); const float rl = __builtin_amdgcn_rcpf(wsf[32 + orow]);
          stg[orow * 64 + r32] = (unsigned short)f2bf(o[0][r] * rl); stg[orow * 64 + 32 + r32] = (unsigned short)f2bf(o[1][r] * rl); }
      asm volatile("s_waitcnt lgkmcnt(0)" ::: "memory");
      unsigned short* yw = U.Y + (size_t)(wid * 32) * 1024;
#pragma unroll
      for (int i = 0; i < 4; ++i) { const int row = i * 8 + (lane >> 3), ch = lane & 7;
          const u32x4 ov = *(const LAS u32x4*)(stg + row * 64 + ch * 8);
          u32x4* gp = (u32x4*)(yw + (size_t)row * 1024 + ch * 8); const u32x4 g = *gp;
          u32x4 w; w.x = pk2(bflo(ov.x) * bflo(g.x), bfhi(ov.x) * bfhi(g.x)); w.y = pk2(bflo(ov.y) * bflo(g.y), bfhi(ov.y) * bfhi(g.y));
          w.z = pk2(bflo(ov.z) * bflo(g.z), bfhi(ov.z) * bfhi(g.z)); w.w = pk2(bflo(ov.w) * bflo(g.w), bfhi(ov.w) * bfhi(g.w));
          *gp = w; } }
    asm volatile("s_waitcnt vmcnt(0) lgkmcnt(0)\n\ts_barrier" ::: "memory");
#undef ATT_KROW
#undef ATT_DMA_K
#undef ATT_DMA_V
#undef ATT_KLOAD
#undef ATT_QKM
#undef ATT_VLOAD
#undef ATT_STEP
#undef ATT_SKIP
#undef ATT_SMPV
#undef ATT_MX3
#undef ATT_NEEDMASK
}

template <int DQK>
__device__ __forceinline__ void attn_unit_d(LAS unsigned char* ldsb, const UnitDesc& U, const int tid) {
    using C = Cfg<DQK>;
    constexpr int LDS_X = C::LDS_WS + 8 * 256;
    static_assert(LDS_X + 8 * 8192 <= RING_BYTES, "attention LDS");
    const int lane = tid & 63, r32 = lane & 31, hi = lane >> 5; const int wid = __builtin_amdgcn_readfirstlane(tid >> 6); const int rg = wid & 3, kh = wid >> 2;
    const unsigned lds0 = (unsigned)(uintptr_t)ldsb;
    const int kp = U.kp, vp = U.vp;
    const int kc1 = (C::NKI == 2 && wid < 4) ? wid + 8 : wid;
    const unsigned short* ksrc0 = U.K + (size_t)lane * kp + wid * 8;
    const unsigned short* ksrc1 = U.K + (size_t)lane * kp + kc1 * 8;
    const unsigned short* vsrc = U.V + (size_t)(16 * (wid & 3) + (lane >> 2)) * vp + (wid >> 2) * 32 + (lane & 3) * 8;
    const unsigned kdst0 = lds0 + C::LDS_K + wid * 1024, kdst1 = lds0 + C::LDS_K + kc1 * 1024, vdst = lds0 + C::LDS_V + wid * 1024;
    const int NT = U.NT;
#define ATD_DMA(t, slot) do { const size_t ro_ = (size_t)64 * (t); \
        glds16(ksrc0 + ro_ * kp, (unsigned)__builtin_amdgcn_readfirstlane(kdst0 + (slot) * C::KSLOT)); \
        if (C::NKI == 2) glds16(ksrc1 + ro_ * kp, (unsigned)__builtin_amdgcn_readfirstlane(kdst1 + (slot) * C::KSLOT)); \
        glds16(vsrc + ro_ * vp, (unsigned)__builtin_amdgcn_readfirstlane(vdst + (slot) * 8192)); } while (0)
    ATD_DMA(0, 0); ATD_DMA(1, 1);
    bf16x8 qr[2][DQK / 16];
    { const unsigned short* qw = U.Q + (size_t)(rg * 64 + r32) * U.qp + hi * 8;
#pragma unroll
      for (int qb = 0; qb < 2; ++qb)
#pragma unroll
          for (int d0 = 0; d0 < DQK / 16; ++d0) qr[qb][d0] = *(const bf16x8*)(qw + (size_t)(qb * 32) * U.qp + d0 * 16); }
    f32x16 o[2][2]; o[0][0] = f32x16{}; o[0][1] = f32x16{}; o[1][0] = f32x16{}; o[1][1] = f32x16{};
    float l0 = 0.f, l1 = 0.f, l0b = 0.f, l1b = 0.f; u32x4 pp[4]; pp[0] = pp[1] = pp[2] = pp[3] = (u32x4){0u, 0u, 0u, 0u};
    if (C::NI == 2) ATT_WAIT_BAR(2); else ATT_WAIT_BAR(3);
#pragma unroll
    for (int qb = 0; qb < 2; ++qb)
#pragma unroll
        for (int d0 = 0; d0 < DQK / 16; ++d0) asm volatile("" : "+v"(qr[qb][d0]));
    const lds_cptr kbase = (lds_cptr)(ldsb + C::LDS_K) + hi * 1024 + kh * 512 + r32 * 16;
    const lds_cptr vbase = (lds_cptr)(ldsb + C::LDS_V) + kh * 2048 + ((lane >> 4) & 1) * 32 + (lane & 3) * 8 + (4 * hi + ((lane & 15) >> 2)) * 64;
#define ATD_DOT(acc, w) acc = __builtin_amdgcn_fdot2_f32_bf16(__builtin_bit_cast(bf16x2_t, (w)), __builtin_bit_cast(bf16x2_t, 0x3f803f80u), acc, false)
#define ATD_SUM4(LA, LB, W) do { ATD_DOT(LA, W.x); ATD_DOT(LB, W.y); ATD_DOT(LA, W.z); ATD_DOT(LB, W.w); } while (0)
#define ATD_SMPV(S, PW0, PW1, OA, OB) do { \
        _Pragma("unroll") for (int r = 0; r < 16; ++r) S[r] = __builtin_amdgcn_exp2f(S[r]); \
        PW0 = (u32x4){cvtpk(S[0], S[1]), cvtpk(S[2], S[3]), cvtpk(S[4], S[5]), cvtpk(S[6], S[7])}; \
        PW1 = (u32x4){cvtpk(S[8], S[9]), cvtpk(S[10], S[11]), cvtpk(S[12], S[13]), cvtpk(S[14], S[15])}; \
        OA = __builtin_amdgcn_mfma_f32_32x32x16_bf16(__builtin_bit_cast(bf16x8, PW0), vf[0][0], OA, 0, 0, 0); OB = __builtin_amdgcn_mfma_f32_32x32x16_bf16(__builtin_bit_cast(bf16x8, PW0), vf[1][0], OB, 0, 0, 0); \
        OA = __builtin_amdgcn_mfma_f32_32x32x16_bf16(__builtin_bit_cast(bf16x8, PW1), vf[0][1], OA, 0, 0, 0); OB = __builtin_amdgcn_mfma_f32_32x32x16_bf16(__builtin_bit_cast(bf16x8, PW1), vf[1][1], OB, 0, 0, 0); } while (0)
    int s = 0;
#pragma unroll 1
    for (int t = 0; t < NT; ++t) {
        const int s2 = (s == 0) ? 2 : s - 1;
        if (t + 2 < NT) ATD_DMA(t + 2, s2);
        bf16x8 kf[DQK / 16], vf[2][2];
        { const lds_cptr kb_ = kbase + s * C::KSLOT;
#pragma unroll
          for (int d0 = 0; d0 < DQK / 16; ++d0) kf[d0] = *(const __attribute__((address_space(3))) bf16x8*)(kb_ + d0 * 2048); }
        { const lds_cptr vb_ = vbase + s * 8192;
#pragma unroll
          for (int d0 = 0; d0 < 2; ++d0)
#pragma unroll
              for (int ks = 0; ks < 2; ++ks) { const s16x4 lo_ = vtr(vb_ + d0 * 4096 + ks * 1024), hh_ = vtr(vb_ + d0 * 4096 + ks * 1024 + 512);
                  vf[d0][ks] = (bf16x8){lo_[0], lo_[1], lo_[2], lo_[3], hh_[0], hh_[1], hh_[2], hh_[3]}; } }
        f32x16 S0 = f32x16{}, S1 = f32x16{};
#pragma unroll
        for (int d0 = 0; d0 < DQK / 16; ++d0) S0 = __builtin_amdgcn_mfma_f32_32x32x16_bf16(kf[d0], qr[0][d0], S0, 0, 0, 0);
#pragma unroll
        for (int d0 = 0; d0 < DQK / 16; ++d0) S1 = __builtin_amdgcn_mfma_f32_32x32x16_bf16(kf[d0], qr[1][d0], S1, 0, 0, 0);
        ATD_SUM4(l0, l0b, pp[0]); ATD_SUM4(l0, l0b, pp[1]); ATD_SUM4(l1, l1b, pp[2]); ATD_SUM4(l1, l1b, pp[3]);
        __builtin_amdgcn_sched_barrier(0);
        ATD_SMPV(S0, pp[0], pp[1], o[0][0], o[0][1]);
        ATD_SMPV(S1, pp[2], pp[3], o[1][0], o[1][1]);
        if (t + 2 < NT) { if (C::NI == 2) ATT_WAIT_BAR(2); else ATT_WAIT_BAR(3); } else ATT_WAIT_BAR(0);
        s = (s == 2) ? 0 : s + 1;
    }
    LAS float* wl = (LAS float*)(ldsb + C::LDS_WS);
    LAS float* X = (LAS float*)(ldsb + LDS_X);
    ATD_SUM4(l0, l0b, pp[0]); ATD_SUM4(l0, l0b, pp[1]); ATD_SUM4(l1, l1b, pp[2]); ATD_SUM4(l1, l1b, pp[3]); l0 += l0b; l1 += l1b;
    const float lkeep = halfswap_sum(kh ? l1 : l0), lsend = halfswap_sum(kh ? l0 : l1);
    f32x16 ok0 = kh ? o[1][0] : o[0][0], ok1 = kh ? o[1][1] : o[0][1]; const f32x16 os0 = kh ? o[0][0] : o[1][0], os1 = kh ? o[0][1] : o[1][1];
    { LAS float* xs = X + wid * 2048 + lane;
#pragma unroll
      for (int r = 0; r < 16; ++r) { xs[r * 64] = os0[r]; xs[(16 + r) * 64] = os1[r]; }
      if (hi == 0) wl[wid * 64 + r32] = lsend; }
    asm volatile("s_waitcnt lgkmcnt(0)\n\ts_barrier" ::: "memory");
    { const LAS float* xr = X + (wid ^ 4) * 2048 + lane;
#pragma unroll
      for (int r = 0; r < 16; ++r) { ok0[r] += xr[r * 64]; ok1[r] += xr[(16 + r) * 64]; }
      const float lt = lkeep + wl[(wid ^ 4) * 64 + r32];
      if (hi == 0) wl[wid * 64 + 32 + r32] = lt; }
    asm volatile("s_waitcnt lgkmcnt(0)" ::: "memory");
    { LAS unsigned short* stg = (LAS unsigned short*)(ldsb + C::LDS_K) + wid * 2048;
      const LAS float* lt = wl + wid * 64 + 32;
#pragma unroll
      for (int r = 0; r < 16; ++r) { const int orow = crow(r, hi); const float rl = __builtin_amdgcn_rcpf(lt[orow]);
          stg[orow * 64 + r32] = (unsigned short)f2bf(ok0[r] * rl); stg[orow * 64 + 32 + r32] = (unsigned short)f2bf(ok1[r] * rl); }
      asm volatile("s_waitcnt lgkmcnt(0)" ::: "memory");
      unsigned short* yw = U.Y + (size_t)(rg * 64 + kh * 32) * 1024;
#pragma unroll
      for (int i = 0; i < 4; ++i) { const int row = i * 8 + (lane >> 3), ch = lane & 7;
          const u32x4 ov = *(const LAS u32x4*)(stg + row * 64 + ch * 8);
          u32x4* gp = (u32x4*)(yw + (size_t)row * 1024 + ch * 8); const u32x4 g = *gp;
          u32x4 w; w.x = pk2(bflo(ov.x) * bflo(g.x), bfhi(ov.x) * bfhi(g.x)); w.y = pk2(bflo(ov.y) * bflo(g.y), bfhi(ov.y) * bfhi(g.y));
          w.z = pk2(bflo(ov.z) * bflo(g.z), bfhi(ov.z) * bfhi(g.z)); w.w = pk2(bflo(ov.w) * bflo(g.w), bfhi(ov.w) * bfhi(g.w));
          *gp = w; } }
    asm volatile("s_waitcnt vmcnt(0) lgkmcnt(0)\n\ts_barrier" ::: "memory");
#undef ATD_DMA
#undef ATD_SMPV
#undef ATD_DOT
#undef ATD_SUM4
}
}

__device__ __forceinline__ void ph_attn(Frame& F, int l) {
    unsigned short* ZS = (unsigned short*)(F.ws + WS_ZS); unsigned short* MQ = (unsigned short*)(F.ws + WS_MQ); unsigned short* MKV = (unsigned short*)(F.ws + WS_MKV); unsigned short* MK = (unsigned short*)(F.ws + WS_MK);
    unsigned short* Y = (unsigned short*)(F.ws + WS_G);
    LAS unsigned char* lds = F.lds + RING_OFF;
    const int u = F.vcu;
    const bool ctxq = (l == 0);
    for (int uu = u; uu < 256; uu += F.G) { const int bh = uu >> 4, qb = uu & 15, b = bh >> 2, h = bh & 3; const size_t r0 = (size_t)b * TPB, rq = r0 + CTXL + qb * 256;
        att::UnitDesc U{MQ + rq * 512 + h * 96, 512, MK + r0 * 384 + h * 96, 384, MKV + r0 * 512 + h * 128 + 64, 512, Y + rq * 1024 + h * 64, TPB / 64, 0, -1, 0, 0, 0.f};
        att::attn_unit_d<96>(lds, U, F.tid); }
    for (int uu = u; uu < 256; uu += F.G) { const int qb = uu & 15, g = (uu >> 4) & 1, kvh = (uu >> 5) & 1, b = uu >> 6, qh = kvh * 2 + g; const size_t r0 = (size_t)b * TPB, rq = r0 + CTXL + qb * 256;
        att::UnitDesc U{ZS + rq * ZS_P + ZC_AQ + qh * 64, ZS_P, ZS + r0 * ZS_P + ZC_AK + kvh * 64, ZS_P, ZS + r0 * ZS_P + ZC_AV + kvh * 64, ZS_P, Y + rq * 1024 + 512 + qh * 64, TPB / 64, 0, -1, 0, 0, 0.f};
        att::attn_unit_d<64>(lds, U, F.tid); }
    for (int uu = u; uu < 256; uu += F.G) { const int qb = uu & 15, g = (uu >> 4) & 1, kvh = (uu >> 5) & 1, b = uu >> 6, qh = kvh * 2 + g; const size_t r0 = (size_t)b * TPB, rq = r0 + CTXL + qb * 256;
        const int q0 = qb * 256, s0 = (q0 - 128 < 0) ? 0 : q0 - 128, s1 = (q0 + 384 > SEQ) ? SEQ : q0 + 384;
        att::UnitDesc U{ZS + rq * ZS_P + ZC_SQ + qh * 64, ZS_P, ZS + r0 * ZS_P + ZC_SK + kvh * 64, ZS_P, ZS + r0 * ZS_P + ZC_SV + kvh * 64, ZS_P, Y + rq * 1024 + 256 + qh * 64, 4 + (s1 - s0) / 64, CTXL + s0, q0, s0, 1, F.in(I_SINK)[l * 4 + qh] * LOG2E};
        att::attn_unit<64, true>(lds, U, F.tid); }
    if (ctxq) for (int uu = u; uu < 48; uu += F.G) { const int br = uu >> 4, b = (uu >> 2) & 3, h = uu & 3; const size_t r0 = (size_t)b * TPB;
        if (br == 0) { att::UnitDesc U{MQ + r0 * 512 + h * 96, 512, MK + r0 * 384 + h * 96, 384, MKV + r0 * 512 + h * 128 + 64, 512, Y + r0 * 1024 + h * 64, 4, 0, -1, 0, 0, 0.f};
            att::attn_unit_d<96>(lds, U, F.tid); }
        else if (br == 1) { att::UnitDesc U{ZS + r0 * ZS_P + ZC_SQ + h * 64, ZS_P, ZS + r0 * ZS_P + ZC_SK + (h >> 1) * 64, ZS_P, ZS + r0 * ZS_P + ZC_SV + (h >> 1) * 64, ZS_P, Y + r0 * 1024 + 256 + h * 64, 4, CTXL, -1, 0, 1, F.in(I_SINK)[l * 4 + h] * LOG2E};
            att::attn_unit<64, true>(lds, U, F.tid); }
        else { att::UnitDesc U{ZS + r0 * ZS_P + ZC_AQ + h * 64, ZS_P, ZS + r0 * ZS_P + ZC_AK + (h >> 1) * 64, ZS_P, ZS + r0 * ZS_P + ZC_AV + (h >> 1) * 64, ZS_P, Y + r0 * 1024 + 512 + h * 64, 4, 0, -1, 0, 0, 0.f};
            att::attn_unit_d<64>(lds, U, F.tid); } }
}
constexpr size_t WS_SUM = 253 * MiB;
constexpr size_t WS_HL = WS_U, WS_CP = WS_HF;
constexpr int NCHUNK = TPB / 64;
__device__ __forceinline__ float swap_lo(float x) { auto rr = __builtin_amdgcn_permlane32_swap(__float_as_uint(x), __float_as_uint(x), false, false); return __uint_as_float(rr[0]); }
__device__ __forceinline__ float swap_hi(float x) { auto rr = __builtin_amdgcn_permlane32_swap(__float_as_uint(x), __float_as_uint(x), false, false); return __uint_as_float(rr[1]); }
__device__ __forceinline__ void ph_lru1(Frame& F, int l) {
    typedef short bf16x8 __attribute__((ext_vector_type(8))); typedef float f32x16 __attribute__((ext_vector_type(16)));
    const unsigned short* ZS = (const unsigned short*)(F.ws + WS_ZS); unsigned short* HL = (unsigned short*)(F.ws + WS_HL); unsigned short* CP = (unsigned short*)(F.ws + WS_CP);
    f32x2v* SUM = (f32x2v*)(F.ws + WS_SUM);
    constexpr int UP = 264;
    LAS unsigned short* ul = (LAS unsigned short*)(F.lds + RING_OFF);
    const float* cw = F.in(I_CONVW) + l * 4 * 256; const float* cb = F.in(I_CONVB) + l * 256;
    const int tid = F.tid, lane = tid & 63, r32 = lane & 31, hi = lane >> 5, k = F.wave & 3, d = F.wave >> 2;
    const int nfull = (NB * NCHUNK < F.G) ? NB * NCHUNK : F.G, nhalf = 2 * (NB * NCHUNK - nfull);
    for (int wi = F.vcu; wi < nfull + nhalf; wi += F.G) {
        const int unit = (wi < nfull) ? wi : nfull + ((wi - nfull) >> 1);
        const int tn_lo = (wi < nfull) ? 0 : ((wi - nfull) & 1), tn_hi = (wi < nfull) ? 2 : tn_lo + 1;
        const int b = unit / NCHUNK, ci = unit % NCHUNK;
        int s0row, len, t0; if (ci < 4) { s0row = b * TPB; len = CTXL; t0 = ci * 64; } else { s0row = b * TPB + CTXL; len = SEQ; t0 = (ci - 4) * 64; }
        { const int cc = tid & 255, hh = tid >> 8; float zv[35];
#pragma unroll
          for (int i = 0; i < 35; ++i) { const int tt = t0 + hh * 32 + i - 2; const int tc = tt < 0 ? 0 : (tt >= len ? len - 1 : tt);
              const float v = bf2f(ZS[(size_t)(s0row + tc) * ZS_P + ZC_LRU + cc]); zv[i] = (tt >= 0 && tt < len) ? v : 0.f; }
          const float w0 = cw[cc], w1 = cw[256 + cc], w2 = cw[512 + cc], w3 = cw[768 + cc], bb = cb[cc];
#pragma unroll
          for (int t = 0; t < 32; ++t) ul[(hh * 32 + t) * UP + cc] = (unsigned short)f2bf(bb + w0 * zv[t] + w1 * zv[t + 1] + w2 * zv[t + 2] + w3 * zv[t + 3]); }
        __syncthreads();
#pragma unroll 1
        for (int tn = tn_lo; tn < tn_hi; ++tn) {
            const int c = k * 64 + 32 * tn + r32;
            bf16x8 wf[2][4];
            const float brv = F.in(I_LBR)[(l * 2 + d) * 256 + c], biv = F.in(I_LBI)[(l * 2 + d) * 256 + c], spv = ((const float*)(F.ws + WS_SP))[(l * 2 + d) * 256 + c];
#pragma unroll
            for (int gate = 0; gate < 2; ++gate)
#pragma unroll
                for (int ks = 0; ks < 4; ++ks) { const float* src = (const float*)(F.ws + WS_LWT) + ((((size_t)l * 2 + d) * 2 + gate) * 256 + c) * 64 + 16 * ks + 8 * hi;
                    const f32x4 a = *(const f32x4*)src, b2 = *(const f32x4*)(src + 4);
                    v4u w; w.x = pk2(a.x, a.y); w.y = pk2(a.z, a.w); w.z = pk2(b2.x, b2.y); w.w = pk2(b2.z, b2.w); wf[gate][ks] = __builtin_bit_cast(bf16x8, w); }
            f32x16 A[2], X[2];
            A[0] = f32x16{}; A[1] = f32x16{}; X[0] = f32x16{}; X[1] = f32x16{};
#pragma unroll
            for (int tm = 0; tm < 2; ++tm)
#pragma unroll
                for (int ks = 0; ks < 4; ++ks) { const bf16x8 af = *(const LAS bf16x8*)(ul + (32 * tm + r32) * UP + k * 64 + 16 * ks + 8 * hi);
                    A[tm] = __builtin_amdgcn_mfma_f32_32x32x16_bf16(af, wf[0][ks], A[tm], 0, 0, 0); X[tm] = __builtin_amdgcn_mfma_f32_32x32x16_bf16(af, wf[1][ks], X[tm], 0, 0, 0); }
#pragma unroll
            for (int tm = 0; tm < 2; ++tm)
#pragma unroll
                for (int r = 0; r < 16; ++r) { const int tok = 32 * tm + (r & 3) + 8 * (r >> 2) + 4 * hi; const float uu = bf2f(ul[tok * UP + c]);
                    const float rr = sigmoid_f(A[tm][r] + brv), ii = sigmoid_f(X[tm][r] + biv);
                    const float a = __builtin_amdgcn_exp2f(-rr * spv); A[tm][r] = a; X[tm][r] = __builtin_amdgcn_sqrtf(1.0f - a * a) * (ii * uu);
                    if ((r & 3) == 3) asm volatile("" ::: "memory"); }
#pragma unroll
            for (int tm = 0; tm < 2; ++tm)
#pragma unroll
                for (int rg = 0; rg < 4; ++rg) { const int r0 = 4 * rg;
                    if (d == 0) {
#pragma unroll
                        for (int e2 = 1; e2 < 4; ++e2) { X[tm][r0 + e2] = A[tm][r0 + e2] * X[tm][r0 + e2 - 1] + X[tm][r0 + e2]; A[tm][r0 + e2] = A[tm][r0 + e2] * A[tm][r0 + e2 - 1]; } }
                    else {
#pragma unroll
                        for (int e2 = 2; e2 >= 0; --e2) { X[tm][r0 + e2] = A[tm][r0 + e2] * X[tm][r0 + e2 + 1] + X[tm][r0 + e2]; A[tm][r0 + e2] = A[tm][r0 + e2] * A[tm][r0 + e2 + 1]; } } }
            float enH[8], enP[8]; float EH = 0.f, EP = 1.f;
            if (d == 0) {
#pragma unroll
                for (int q = 0; q < 8; ++q) { const int tm = q >> 2, re = 4 * (q & 3) + 3; const float ce = A[tm][re], he = X[tm][re];
                    const float aH = swap_lo(ce * EH + he), aP = swap_lo(EP * ce);
                    const float E1H = hi ? aH : EH, E1P = hi ? aP : EP;
                    enH[q] = E1H; enP[q] = E1P;
                    EH = swap_hi(ce * E1H + he); EP = swap_hi(E1P * ce); }
            } else {
#pragma unroll
                for (int q = 7; q >= 0; --q) { const int tm = q >> 2, re = 4 * (q & 3); const float ce = A[tm][re], he = X[tm][re];
                    const float aH = swap_hi(ce * EH + he), aP = swap_hi(EP * ce);
                    const float E1H = hi ? EH : aH, E1P = hi ? EP : aP;
                    enH[q] = E1H; enP[q] = E1P;
                    EH = swap_lo(ce * E1H + he); EP = swap_lo(E1P * ce); }
            }
            { const unsigned ob = (unsigned)((((s0row + t0 + 4 * hi) * 2 + d) * 256 + c) * 2);
#pragma unroll
              for (int tm = 0; tm < 2; ++tm)
#pragma unroll
                for (int rg = 0; rg < 4; ++rg) { const int q = 4 * tm + rg;
#pragma unroll
                    for (int e2 = 0; e2 < 4; ++e2) { const int r = 4 * rg + e2; const unsigned o = ob + (unsigned)(32 * tm + 8 * rg + e2) * 1024u;
                        *(unsigned short*)((char*)HL + o) = (unsigned short)f2bf(X[tm][r] + A[tm][r] * enH[q]); *(unsigned short*)((char*)CP + o) = (unsigned short)f2bf(A[tm][r] * enP[q]); }
                    asm volatile("" ::: "memory"); } }
            if (hi == 0) SUM[((size_t)(b * NCHUNK + ci) * 2 + d) * 256 + c] = (f32x2v){EP, EH};
        }
        __syncthreads();
    }
}
constexpr size_t WS_CARRY = 255 * MiB;
__device__ __forceinline__ void ph_lru_carry(Frame& F) {
    if (F.vcu < 4) {
        const int g = F.vcu * NTHREADS + F.tid, b = g >> 9, d = (g >> 8) & 1, c = g & 255;
        const f32x2v* sb = (const f32x2v*)(F.ws + WS_SUM) + ((size_t)b * NCHUNK * 2 + d) * 256 + c;
        float* cr = (float*)(F.ws + WS_CARRY) + ((size_t)b * NCHUNK * 2 + d) * 256 + c;
        float h = 0.f;
#pragma unroll 1
        for (int p0 = 0; p0 < NCHUNK; p0 += 17) {
            f32x2v s[17];
#pragma unroll
            for (int i = 0; i < 17; ++i) { const int p = p0 + i, j = (d == 0) ? p : (p < 4 ? 3 - p : NCHUNK + 3 - p); s[i] = sb[(size_t)j * 512]; }
#pragma unroll
            for (int i = 0; i < 17; ++i) { const int p = p0 + i, j = (d == 0) ? p : (p < 4 ? 3 - p : NCHUNK + 3 - p); cr[(size_t)j * 512] = h; h = s[i].x * h + s[i].y; }
        }
    }
}
__device__ __forceinline__ void ph_lru2(Frame& F, int l) {
    const unsigned short* HL = (const unsigned short*)(F.ws + WS_HL); const unsigned short* CP = (const unsigned short*)(F.ws + WS_CP);
    const float* CARRY = (const float*)(F.ws + WS_CARRY); unsigned short* Y = (unsigned short*)(F.ws + WS_G);
    const int tid = F.tid, cg = tid & 31, tq = tid >> 5; const bool last = (l == NLAYER - 1);
    for (int unit = F.vcu; unit < NB * NCHUNK; unit += F.G) {
        const int b = unit / NCHUNK, ci = unit % NCHUNK;
        if (last && ci < 4) continue;
        const float* cp0 = CARRY + ((size_t)(b * NCHUNK + ci) * 2) * 256 + cg * 8;
        const f32x4 cfa = *(const f32x4*)cp0, cfb = *(const f32x4*)(cp0 + 4), cba = *(const f32x4*)(cp0 + 256), cbb = *(const f32x4*)(cp0 + 260);
        const float cf[8] = {cfa.x, cfa.y, cfa.z, cfa.w, cfb.x, cfb.y, cfb.z, cfb.w}, cbk[8] = {cba.x, cba.y, cba.z, cba.w, cbb.x, cbb.y, cbb.z, cbb.w};
        v4u hf[4], pf[4], hb[4], pb[4], gg[4];
#pragma unroll
        for (int i = 0; i < 4; ++i) { const size_t row = (size_t)b * TPB + ci * 64 + tq + 16 * i; const size_t o = (row * 2) * 256 + cg * 8;
            hf[i] = *(const v4u*)(HL + o); pf[i] = *(const v4u*)(CP + o); hb[i] = *(const v4u*)(HL + o + 256); pb[i] = *(const v4u*)(CP + o + 256); gg[i] = *(const v4u*)(Y + row * 1024 + 768 + cg * 8); }
#pragma unroll
        for (int i = 0; i < 4; ++i) { const size_t row = (size_t)b * TPB + ci * 64 + tq + 16 * i;
            unsigned w[4];
#pragma unroll
            for (int e = 0; e < 4; ++e) { const unsigned a = hf[i][e], p = pf[i][e], a2 = hb[i][e], p2 = pb[i][e], g = gg[i][e];
                const float v0 = (bflo(a) + bflo(p) * cf[2 * e] + bflo(a2) + bflo(p2) * cbk[2 * e]) * bflo(g);
                const float v1 = (bfhi(a) + bfhi(p) * cf[2 * e + 1] + bfhi(a2) + bfhi(p2) * cbk[2 * e + 1]) * bfhi(g);
                w[e] = pk2(v0, v1); }
            *(v4u*)(Y + row * 1024 + 768 + cg * 8) = (v4u){w[0], w[1], w[2], w[3]}; }
    }
}
namespace pgx {
typedef short bf16x8 __attribute__((ext_vector_type(8)));
typedef float f32x4 __attribute__((ext_vector_type(4)));
typedef unsigned u32x4 __attribute__((ext_vector_type(4)));
typedef unsigned u32x2 __attribute__((ext_vector_type(2)));
constexpr int OPB = 16384;
template <int VAR> __device__ __forceinline__ void pgx_unit(LAS unsigned char* lds, const unsigned short* Y, const unsigned short* Wb, const unsigned short* S, unsigned short* MIX, int row0, int n0, int tid) {
    const int lane = tid & 63, wid = __builtin_amdgcn_readfirstlane(tid >> 6), wm = wid & 3, wn = wid >> 2, fr = lane & 15, fq = lane >> 4;
    const int sr0 = tid >> 3, sk = (tid & 7) * 8;
    const unsigned short* ysrc = Y + (size_t)(row0 + sr0) * 1024 + sk;
    const unsigned short* wsrc = Wb + (size_t)(n0 + sr0) * 256 + sk;
    const int ldst = (tid & 7) * 2048 + (sr0 & ~15) * 16 + (((sr0 & 15) ^ (tid & 7)) << 4);
    const int wrow = (sr0 & ~63) | (((sr0 >> 2) & 3) << 4) | (((sr0 >> 4) & 3) << 2) | (sr0 & 3);
    const int ldstw = (tid & 7) * 2048 + (wrow & ~15) * 16 + (((wrow & 15) ^ (tid & 7)) << 4);
    f32x4 acc[2][4], mix[2][4];
#pragma unroll
    for (int a = 0; a < 2; ++a)
#pragma unroll
        for (int b = 0; b < 4; ++b) { acc[a][b] = (f32x4){0.f, 0.f, 0.f, 0.f}; mix[a][b] = (f32x4){0.f, 0.f, 0.f, 0.f}; }
    u32x4 st[4][4];
    const unsigned short* yA = ysrc; const unsigned short* yB = ysrc + 64 * 1024;
    const unsigned short* wA = wsrc; const unsigned short* wB = wsrc + 64 * 256;
    const unsigned short* sp0 = S + (size_t)(row0 + 32 * wm + fr) * 4096 + n0 + 64 * wn + 16 * fq; const unsigned short* sp1 = sp0 + (size_t)16 * 4096;
#define PGX_LOADQ(set_, yo_, wp0_, wp1_, wo_) do { if (VAR == 2) { st[set_][0] = *(const u32x4*)(ysrc); st[set_][1] = *(const u32x4*)(ysrc + 64 * 1024); st[set_][2] = *(const u32x4*)(wsrc); st[set_][3] = *(const u32x4*)(wsrc + 64 * 256); } else if (VAR == 4) { st[set_][0] = st[set_][1] = st[set_][2] = st[set_][3] = (u32x4){1u,2u,3u,4u}; asm volatile("" : "+v"(st[set_][0]), "+v"(st[set_][1]), "+v"(st[set_][2]), "+v"(st[set_][3])); } else { st[set_][0] = *(const u32x4*)(yA + (yo_)); st[set_][1] = *(const u32x4*)(yB + (yo_)); st[set_][2] = *(const u32x4*)((wp0_) + (wo_)); st[set_][3] = *(const u32x4*)((wp1_) + (wo_)); } } while (0)
#define PGX_STORE(buf_, set_) do { LAS unsigned char* b_ = lds + (buf_) * 2 * OPB + ldst; \
        *(LAS u32x4*)b_ = st[set_][0]; *(LAS u32x4*)(b_ + 1024) = st[set_][1]; *(LAS u32x4*)(b_ - ldst + OPB + ldstw) = st[set_][2]; *(LAS u32x4*)(b_ - ldst + OPB + ldstw + 1024) = st[set_][3]; } while (0)
    u32x4 sga[2][2], sgb[2][2];
#define PGX_SLOAD(dst_, off_) do { if (VAR == 1 || VAR == 4) { dst_[0][0] = dst_[0][1] = dst_[1][0] = dst_[1][1] = (u32x4){0x3f803f80u, 0x3f803f80u, 0x3f803f80u, 0x3f803f80u}; } \
        else { dst_[0][0] = *(const u32x4*)(sp0 + (off_)); dst_[0][1] = *(const u32x4*)(sp0 + (off_) + 8); dst_[1][0] = *(const u32x4*)(sp1 + (off_)); dst_[1][1] = *(const u32x4*)(sp1 + (off_) + 8); } } while (0)
    PGX_SLOAD(sga, 0);
    PGX_LOADQ(0, 0, wA, wB, 0); PGX_LOADQ(1, 64, wA, wB, 64); PGX_LOADQ(2, 128, wA, wB, 128);
    PGX_STORE(0, 0);
    __syncthreads();
#define PGX_COMPUTE(h_) do { const LAS unsigned char* yb = lds + ((h_) & 1) * 2 * OPB + 32 * wm * 16; const LAS unsigned char* wb = lds + ((h_) & 1) * 2 * OPB + OPB + 64 * wn * 16; \
          _Pragma("unroll") for (int ks = 0; ks < 2; ++ks) { const int fo_ = (4 * ks + fq) * 2048 + ((fr ^ (4 * ks + fq)) << 4); \
              bf16x8 yf[2], wf[4]; \
              _Pragma("unroll") for (int tt = 0; tt < 2; ++tt) yf[tt] = *(const LAS bf16x8*)(yb + fo_ + tt * 256); \
              _Pragma("unroll") for (int nt = 0; nt < 4; ++nt) wf[nt] = *(const LAS bf16x8*)(wb + fo_ + nt * 256); \
              _Pragma("unroll") for (int tt = 0; tt < 2; ++tt) \
                  _Pragma("unroll") for (int nt = 0; nt < 4; ++nt) acc[tt][nt] = __builtin_amdgcn_mfma_f32_16x16x32_bf16(wf[nt], yf[tt], acc[tt][nt], 0, 0, 0); } } while (0)
#pragma unroll 1
    for (int kk = 0; kk < 4; ++kk) {
        const bool more = kk < 3;
        const unsigned short* wnA = more ? wA + (size_t)1024 * 256 : wsrc; const unsigned short* wnB = more ? wB + (size_t)1024 * 256 : wsrc + 64 * 256;
        const int yo = more ? 256 : -768;
        PGX_SLOAD(sgb, more ? 1024 : 0);
        PGX_LOADQ(3, 192, wA, wB, 192); PGX_COMPUTE(0); PGX_STORE(1, 1); __syncthreads();
        PGX_LOADQ(0, yo, wnA, wnB, 0); PGX_COMPUTE(1); PGX_STORE(0, 2); __syncthreads();
        PGX_LOADQ(1, yo + 64, wnA, wnB, 64); PGX_COMPUTE(2); PGX_STORE(1, 3); __syncthreads();
        PGX_LOADQ(2, yo + 128, wnA, wnB, 128); PGX_COMPUTE(3);
#pragma unroll
        for (int tt = 0; tt < 2; ++tt)
#pragma unroll
            for (int nt = 0; nt < 4; ++nt) { const u32x4 gv = sga[tt][nt >> 1]; const unsigned g0 = (nt & 1) ? gv.z : gv.x, g1 = (nt & 1) ? gv.w : gv.y; const f32x4 a = acc[tt][nt];
                mix[tt][nt] += (f32x4){a[0] * bflo(g0), a[1] * bfhi(g0), a[2] * bflo(g1), a[3] * bfhi(g1)}; acc[tt][nt] = (f32x4){0.f, 0.f, 0.f, 0.f}; }
#pragma unroll
        for (int tt = 0; tt < 2; ++tt) { sga[tt][0] = sgb[tt][0]; sga[tt][1] = sgb[tt][1]; }
        if (more) PGX_STORE(0, 0);
        __syncthreads();
        yA += 256; yB += 256; wA = wnA; wB = wnB; sp0 += 1024; sp1 += 1024;
    }
#pragma unroll
    for (int tt = 0; tt < 2; ++tt) { unsigned short* mp = MIX + (size_t)(row0 + 32 * wm + 16 * tt + fr) * 1024 + n0 + 64 * wn + 16 * fq;
        u32x4 w0, w1; w0.x = pk2(mix[tt][0][0], mix[tt][0][1]); w0.y = pk2(mix[tt][0][2], mix[tt][0][3]); w0.z = pk2(mix[tt][1][0], mix[tt][1][1]); w0.w = pk2(mix[tt][1][2], mix[tt][1][3]);
        w1.x = pk2(mix[tt][2][0], mix[tt][2][1]); w1.y = pk2(mix[tt][2][2], mix[tt][2][3]); w1.z = pk2(mix[tt][3][0], mix[tt][3][1]); w1.w = pk2(mix[tt][3][2], mix[tt][3][3]);
        *(u32x4*)mp = w0; *(u32x4*)(mp + 8) = w1; }
#undef PGX_LOADQ
#undef PGX_SLOAD
#undef PGX_STORE
#undef PGX_COMPUTE
}
}
template <int VAR> __device__ __forceinline__ void ph_pgx(Frame& F, int l, int r_lo = 0, int r_hi = 1 << 20, bool signal = false) {
    const unsigned short* Y = (const unsigned short*)(F.ws + WS_G); const unsigned short* S = (const unsigned short*)(F.ws + WS_S); unsigned short* MIX = (VAR == 0) ? (unsigned short*)(F.ws + WS_H) : (unsigned short*)F.out;
    const unsigned short* Wb = (const unsigned short*)(F.ws + WS_W + (size_t)l * W_LAYER + WO_WB);
    const bool last = (l == NLAYER - 1);
    const int nrt = last ? 128 : NROWS / 128;
    for (int r = r_lo; r <= r_hi; ++r) {
        const int u = F.vcu + r * F.G; if (u >= nrt * 8) break;
        int rt = u >> 3; const int ct = u & 7;
        if (last) rt = rt + 2 * (rt / 32) + 2;
        pgx::pgx_unit<VAR>(F.lds + RING_OFF, Y, Wb, S, MIX, rt * 128, ct * 128, F.tid);
        if (signal) {
            asm volatile("s_waitcnt vmcnt(0)" ::: "memory"); __syncthreads();
            if (F.tid == 0) { __builtin_amdgcn_fence(__ATOMIC_RELEASE, "agent"); asm volatile("s_waitcnt vmcnt(0)" ::: "memory");
                (void)xb_add((unsigned*)((gu32*)(F.ws + WS_CTL) + CW_FLG) + (u >> 4), 1u); }
        }
    }
}
constexpr int NPL = 10;
enum { PH_H = 0, PH_G1, PH_POST1, PH_G2, PH_POST2, PH_ATT, PH_SG, PH_PG, PH_MIX, PH_OG };
constexpr int NPHASES = 1 + NLAYER * NPL;
#ifndef NAIVE_ATT
#define NAIVE_ATT 0
#endif
#ifndef PROBE_MASK
#define PROBE_MASK 0
#endif
#ifndef PROBE_LAYERS
#define PROBE_LAYERS 3
#endif
#ifndef MERGE_PGOG
#define MERGE_PGOG 0
#endif
#ifndef PHMASK
#define PHMASK 16383
#endif
#ifndef MK_ONE_LAUNCH
#define MK_ONE_LAUNCH 1
#endif

__global__ void __launch_bounds__(NTHREADS, 2) fwd_kernel(Args args) {
    extern __shared__ __attribute__((aligned(16))) unsigned char lds_raw[];
    { LAS unsigned char* l0 = (LAS unsigned char*)lds_raw;
      for (int u = threadIdx.x; u < (LDS_BYTES - LDSCTL_OFF) / 4; u += NTHREADS) ((LAS unsigned*)(l0 + LDSCTL_OFF))[u] = 0u;
      __syncthreads();
      if (args.ph_hi - args.ph_lo > 1) (void)xcd_barrier_post((unsigned*)((gu32*)(args.ws + WS_CTL) + CW_BAR), (volatile LAS unsigned*)(l0 + MISC_OFF) + 8); }

    unsigned long long tacc = 0ull;
    for (int ph = args.ph_lo; ph < args.ph_hi; ++ph) {
        unsigned long long tph0 = 0ull; bool probed = false;
        if (PROBE_MASK) { const int pl = (ph == 0) ? 0 : (ph - 1) / NPL, pp = (ph == 0) ? 10 : (ph - 1) % NPL; probed = ((PROBE_MASK >> pp) & 1) && ((PROBE_LAYERS >> pl) & 1); if (probed) tph0 = __builtin_amdgcn_s_memrealtime(); }
        int z; asm volatile("s_mov_b32 %0, 0" : "=s"(z));
        Frame F;
        F.lds = (LAS unsigned char*)lds_raw + z; F.kin = (const float* const __attribute__((address_space(4)))*)((const __attribute__((address_space(4))) char*)__builtin_amdgcn_kernarg_segment_ptr() + z); F.ws = args.ws + z; F.out = args.out + z; F.z = z;
        F.tid = threadIdx.x + z; F.lane = F.tid & 63; F.wave = __builtin_amdgcn_readfirstlane(F.tid >> 6);
        F.G = gridDim.x + z; { const int bx = blockIdx.x + z; F.vcu = (F.G % 8 == 0) ? (bx % 8) * (F.G / 8) + bx / 8 : bx; }
        F.gw = F.vcu * NWAVES + F.wave; F.NGW = F.G * NWAVES;
        bool is_gemm = false;
        pg8::Gemm g{nullptr, nullptr, NROWS, 256, 1024, 1024, 31, 0};
        pg8::Order S; S.init(1, 1, F.G, (int)blockIdx.x + z, 0);
        pg8::EpiU E{pg8::EM_PLAIN, 0, F.ws, nullptr, nullptr, nullptr, 0, 0, 0, 0, 1 << 20};
        if (ph == 0) { if (PHMASK & 8192) p0_prologue(F); }
        else {
            const int l = (ph - 1) / NPL, p = (ph - 1) % NPL;
            unsigned char* wl = F.ws + WS_W + (size_t)l * W_LAYER;
            const bool last = (l == NLAYER - 1);
            const int nMc = last ? 64 : NROWS / 256, lat = last ? 1 : 0;
            const bool merged = last && F.G == 256 && MERGE_PGOG;
            E.l = l;
            if (p == PH_H && (PHMASK & 1)) { ph_hnorm(F, l); }
            else if (p == PH_G1 && (PHMASK & 2)) {
                is_gemm = true; g.A = (const bf16*)(F.ws + WS_H); g.Bt = (const bf16*)(wl + WO_W1); g.N = N1; g.K = 1024; g.lda = 1024;
                S.init(NROWS / 256, N1 / 256, F.G, (int)blockIdx.x + z, 0);
                E.mode = pg8::EM_SILU2; E.oA = WS_ZS; E.ldc = ZS_P; E.oB = WS_G; E.ldc2 = 1024; E.split_tile = 7;
            }
            else if (p == PH_POST1 && (PHMASK & 4)) { ph_lru1(F, l); ph_post1(F, l); }
            else if (p == PH_G2 && (PHMASK & 8)) {
                is_gemm = true; g.A = (const bf16*)(F.ws + WS_ZS); g.Bt = (const bf16*)(wl + WO_UQ); g.N = 1024; g.K = 256; g.lda = ZS_P; g.a_shift = 1; g.a_step = 512;
                S.init(NROWS / 256, 4, F.G, (int)blockIdx.x + z, 0);
                E.mode = pg8::EM_PLAIN; E.oA = WS_MQ; E.ldc = 512; E.oB = WS_MKV; E.ldc2 = 512; E.split_tile = 2;
            }
            else if (p == PH_POST2 && (PHMASK & 16)) { ph_lru_carry(F); ph_post2(F, l); }
            else if (p == PH_ATT && (PHMASK & 32)) {
#if NAIVE_ATT
                ph_attn_naive(F, l);
#else
                ph_attn(F, l);
#endif
                ph_lru2(F, l); }
            else if (p == PH_SG && (PHMASK & 512)) {
                is_gemm = true; g.A = (const bf16*)(F.ws + WS_H); g.Bt = (const bf16*)(wl + WO_W1) + (size_t)N1 * 1024; g.N = 4096; g.K = 1024; g.lda = 1024;
                S.init(nMc, 16, F.G, (int)blockIdx.x + z, lat);
                E.mode = pg8::EM_SIG; E.oA = WS_S; E.ldc = 4096;
            }
            else if (p == PH_PG && (PHMASK & 1024)) {
                int r_hi = 1 << 20;
                if (merged) { pg8::Unit u0; pg8::Order S0; S0.init(64, 4, F.G, (int)blockIdx.x + z, 1); (void)S0.next(0, u0); r_hi = u0.pm / 17; }
                ph_pgx<0>(F, l, 0, r_hi, merged);
#ifdef PGX_PROBE
                if (l == 0) { __syncthreads(); ph_pgx<PGX_PROBE>(F, l); }
#endif
            }
            else if (p == PH_MIX) {
                if (!last && (PHMASK & 2048)) {
                    is_gemm = true; g.A = (const bf16*)(F.ws + WS_H); g.Bt = (const bf16*)(F.ws + WS_WOS); g.N = 4096; g.K = 256; g.lda = 1024; g.a_shift = 2; g.a_step = 512;
                    S.init(4, 16, F.G, (int)blockIdx.x + z, 2);
                    E.mode = pg8::EM_PLAIN; E.oA = WS_S; E.ldc = 4096; }
            }
            else if (p == PH_OG && (PHMASK & 4096)) {
                is_gemm = true; g.A = (const bf16*)(F.ws + WS_H); g.Bt = (const bf16*)(wl + WO_WO); g.N = 1024; g.K = 1024; g.lda = 1024;
                S.init(64, 4, F.G, (int)blockIdx.x + z, 1);
                E.mode = pg8::EM_RES; E.xin = (l == 0) ? F.in(I_X) : (const float*)F.out; E.xout = F.out; E.cin0 = F.in(I_CTX); E.oA = WS_MOD; E.oB = WS_CTX1;
                if (merged) {
                    pg8::Unit u0; (void)S.next(0, u0); const int q = (u0.pm / 17) * 16 + u0.pm % 17 - 1;
                    if (F.tid == 0) { unsigned* bar = (unsigned*)((gu32*)(F.ws + WS_CTL) + CW_BAR); unsigned* flg = (unsigned*)((gu32*)(F.ws + WS_CTL) + CW_FLG) + q;
                        XB_SPIN(xb_ld(flg) < 16u, bar); __builtin_amdgcn_fence(__ATOMIC_ACQUIRE, "agent"); asm volatile("s_waitcnt vmcnt(0)" ::: "memory"); }
                    __syncthreads(); }
            }
        }
        if (is_gemm) pg8::gemm_phase<pg8::EpiU, pg8::Order, true, true>(F.lds + RING_OFF, g, S, E, F.tid);
        if (NLAYER == 2 && ph >= 1 && ph <= 1 + PH_OG) {
            const int p = ph - 1;
            if (p == PH_G1 || p == PH_G2 || p == PH_SG || p == PH_PG || p == PH_OG) {
                int z4; asm volatile("s_mov_b32 %0, 0" : "=s"(z4));
                Frame C;
                C.lds = (LAS unsigned char*)lds_raw + z4; C.kin = (const float* const __attribute__((address_space(4)))*)((const __attribute__((address_space(4))) char*)__builtin_amdgcn_kernarg_segment_ptr() + z4); C.ws = args.ws + z4; C.out = args.out + z4; C.z = z4;
                C.tid = threadIdx.x + z4; C.lane = C.tid & 63; C.wave = __builtin_amdgcn_readfirstlane(C.tid >> 6);
                C.G = gridDim.x + z4; const int bx = blockIdx.x + z4; C.vcu = (C.G % 8 == 0) ? (bx % 8) * (C.G / 8) + bx / 8 : bx;
                C.gw = C.vcu * NWAVES + C.wave; C.NGW = C.G * NWAVES;
                int cidx = -1, cn = 1, loA = 0, nA = 0, loB = 0, nB = 0;
                if (p == PH_G1) { const int nb = ((NROWS / 256) * (N1 / 256)) % C.G; cidx = bx - nb; cn = C.G - nb; loA = I_EARLY; nA = IC_G1; }
                else if (p == PH_G2) { const int nb = ((NROWS / 256) * 4) % C.G; cidx = bx - nb; cn = C.G - nb; loA = I_EARLY + IC_G1; nA = I_INL - IC_G1; }
                else if (p == PH_SG) { const int nb = ((NROWS / 256) * 16) % C.G; cidx = bx - nb; cn = C.G - nb; loA = I_EARLY + I_INL; nA = I_BR; loB = 0; nB = 1536; }
                else if (p == PH_PG) { const int nb = ((NROWS / 128) * 8) % C.G; cidx = C.vcu - nb; cn = C.G - nb; loA = I_EARLY + I_INL + I_BR; nA = I_OUT + I_SPLIT; loB = 1536; nB = 1536; }
                else { const int nb = (64 < C.G) ? 64 : 0; cidx = bx - nb; cn = C.G - nb; loB = 3072; nB = I_LAYER - 3072; }
                if (cidx >= 0) { __syncthreads();
                    if (p == PH_G1) p0_tables(C, cidx * NTHREADS + C.tid, cn * NTHREADS);
                    weight_copies(C, cidx * NWAVES + C.wave, cn * NWAVES, loA, nA, loB, nB); }
            }
        }
        if (MERGE_PGOG && ph == 1 + (NLAYER - 1) * NPL + PH_OG && gridDim.x == 256) {
            int z5; asm volatile("s_mov_b32 %0, 0" : "=s"(z5));
            Frame C;
            C.lds = (LAS unsigned char*)lds_raw + z5; C.kin = (const float* const __attribute__((address_space(4)))*)((const __attribute__((address_space(4))) char*)__builtin_amdgcn_kernarg_segment_ptr() + z5); C.ws = args.ws + z5; C.out = args.out + z5; C.z = z5;
            C.tid = threadIdx.x + z5; C.lane = C.tid & 63; C.wave = __builtin_amdgcn_readfirstlane(C.tid >> 6);
            C.G = gridDim.x + z5; const int bx = blockIdx.x + z5; C.vcu = (C.G % 8 == 0) ? (bx % 8) * (C.G / 8) + bx / 8 : bx;
            C.gw = C.vcu * NWAVES + C.wave; C.NGW = C.G * NWAVES;
            pg8::Unit u0; pg8::Order S0; S0.init(64, 4, C.G, bx, 1); (void)S0.next(0, u0);
            __syncthreads(); ph_pgx<0>(C, NLAYER - 1, u0.pm / 17 + 1, 1 << 20, true);
        }
        const bool empty_phase = (ph > 0) && (((ph - 1) % NPL == PH_MIX) || (MERGE_PGOG && ph == 1 + (NLAYER - 1) * NPL + PH_PG && gridDim.x == 256));
        if (empty_phase) __syncthreads();
        if (ph + 1 < args.ph_hi && !empty_phase) {
            int z2; asm volatile("s_mov_b32 %0, 0" : "=s"(z2));
            XcdBarrier bar; bar.bar = (unsigned*)((gu32*)(args.ws + z2 + WS_CTL) + CW_BAR); bar.x = xb_xcc_id(); bar.st = (volatile LAS unsigned*)((LAS unsigned char*)lds_raw + z2 + MISC_OFF) + 8;
            xcd_barrier(bar);
        }
        if (PROBE_MASK) { if (probed) tacc += __builtin_amdgcn_s_memrealtime() - tph0; }
    }
#ifdef EXTRA_BARRIERS
    for (int xb = 0; xb < EXTRA_BARRIERS; ++xb) { int z3; asm volatile("s_mov_b32 %0, 0" : "=s"(z3));
        XcdBarrier bar; bar.bar = (unsigned*)((gu32*)(args.ws + z3 + WS_CTL) + CW_BAR); bar.x = xb_xcc_id(); bar.st = (volatile LAS unsigned*)((LAS unsigned char*)lds_raw + z3 + MISC_OFF) + 8;
        xcd_barrier(bar); }
#endif
    if (PROBE_MASK) { const unsigned long long t0 = __builtin_amdgcn_s_memrealtime(); while (__builtin_amdgcn_s_memrealtime() - t0 < tacc) __builtin_amdgcn_s_sleep(8); }
}

extern "C" void kernel_launch(void* const* d_in, const int* in_sizes, int n_in, void* d_out, int out_size, void* d_ws, size_t ws_size, hipStream_t stream) {
    static int grid = 0;
    if (grid == 0) {
        if (n_in != 28 || out_size != NB * SEQ * DM || ws_size < WS_END) { fprintf(stderr, "kernel_launch: unexpected shapes (n_in %d out %d ws %zu); nothing launched\n", n_in, out_size, ws_size); grid = -1; return; }
        int dev = 0, cus = 0, per_cu = 0;
        if (hipGetDevice(&dev) != hipSuccess || hipDeviceGetAttribute(&cus, hipDeviceAttributeMultiprocessorCount, dev) != hipSuccess) { grid = -1; return; }
        if (hipFuncSetAttribute((const void*)fwd_kernel, hipFuncAttributeMaxDynamicSharedMemorySize, LDS_BYTES) != hipSuccess) { fprintf(stderr, "kernel_launch: hipFuncSetAttribute failed\n"); grid = -1; return; }
        if (hipOccupancyMaxActiveBlocksPerMultiprocessor(&per_cu, (const void*)fwd_kernel, NTHREADS, LDS_BYTES) != hipSuccess || per_cu < 1) { fprintf(stderr, "kernel_launch: occupancy query says %d\n", per_cu); (void)hipGetLastError(); grid = -1; return; }
        grid = cus;
    }
    if (grid < 0) return;
    (void)hipMemsetAsync((char*)d_ws + WS_CTL, 0, CTL_ZERO_BYTES, stream);
    Args a{};
    for (int i = 0; i < 28; ++i) a.in[i] = (const float*)d_in[i];
    a.out = (float*)d_out; a.ws = (unsigned char*)d_ws;
#if MK_ONE_LAUNCH
    a.ph_lo = 0; a.ph_hi = NPHASES;
    hipLaunchKernelGGL(fwd_kernel, dim3(grid), dim3(NTHREADS), LDS_BYTES, stream, a);
#else
    for (int ph = 0; ph < NPHASES; ++ph) { a.ph_lo = ph; a.ph_hi = ph + 1; hipLaunchKernelGGL(fwd_kernel, dim3(grid), dim3(NTHREADS), LDS_BYTES, stream, a); }
#endif
}
```

```cpp
#include <hip/hip_runtime.h>
#include <cstdio>
#include <cstdint>
#include <cmath>
__device__ __forceinline__ float bflo(unsigned w) { return __uint_as_float(w << 16); }
__device__ __forceinline__ float bfhi(unsigned w) { return __uint_as_float(w & 0xffff0000u); }
__device__ __forceinline__ float sigmoid_f(float v) { return __builtin_amdgcn_rcpf(1.0f + __builtin_amdgcn_exp2f(-1.4426950408889634f * v)); }
namespace pg8 {
#define PG8_LAS __attribute__((address_space(3)))
typedef unsigned short bf16_t;
typedef short bf16x8 __attribute__((ext_vector_type(8)));
typedef float f32x4 __attribute__((ext_vector_type(4)));
typedef unsigned u32x4 __attribute__((ext_vector_type(4)));
constexpr int BM = 256, BK = 64, HALF = 128, HTB = HALF * BK * 2  , STAGE_BYTES = 8 * HTB, NXCD = 8, WGM = 8;

__host__ __device__ __forceinline__ int lds_byte(int r, int c) { const int st = (r >> 4) * 2 + (c >> 5), rr = r & 15, cc = c & 31, ob = rr * 64 + cc * 2; return st * 1024 + (ob ^ (((ob >> 9) & 1) << 5)); }
__host__ __device__ __forceinline__ void stage_rc(int b, int& R, int& C) { const int st = b / 1024, sb = b % 1024, swz = sb ^ (((sb >> 9) & 1) << 5); R = (st >> 1) * 16 + swz / 64; C = (st & 1) * 32 + (swz % 64) / 2; }
__host__ __device__ __forceinline__ int perm32(int rho) { const int n = rho >> 4, i = rho & 15; return 8 * (i >> 2) + 4 * n + (i & 3); }

struct Unit { int pm, pn; };
struct Gemm { const bf16_t* A; const bf16_t* Bt; int M, N, K, lda; int a_shift, a_step; };

struct StaticOrder {
    int nM, nN, nwg, G, c;
    __host__ __device__ void init(int M, int N, int G_, int c_) { nM = M / BM; nN = N / BM; nwg = nM * nN; G = G_; c = c_; }
    __host__ __device__ bool next(int i, Unit& u) const {
        const long L = (long)i * G + c; if (L >= nwg) return false;
        int wgid = (int)L; { const int q = nwg / NXCD, r = nwg % NXCD, xcd = wgid % NXCD, off = wgid / NXCD; wgid = (xcd < r ? xcd * (q + 1) : r * (q + 1) + (xcd - r) * q) + off; }
        const int nig = WGM * nN, gid = wgid / nig, fm = gid * WGM, gsz = (nM - fm) < WGM ? (nM - fm) : WGM;
        u.pm = fm + ((wgid % nig) % gsz); u.pn = (wgid % nig) / gsz; return true;
    }
    __device__ __forceinline__ void a_ready(const Unit&) const {}
    __device__ __forceinline__ void done(const Unit&) const {}
};

__device__ __forceinline__ unsigned cvt_pk_bf16(float lo, float hi) { unsigned r; asm volatile("v_cvt_pk_bf16_f32 %0, %1, %2" : "=v"(r) : "v"(lo), "v"(hi)); return r; }
enum { EM_PLAIN = 0, EM_SILU2 = 1, EM_SIG = 2, EM_MUL = 3, EM_RES = 4 };
struct EpiU {
    static constexpr bool PERM = true, AFTER_DRAIN = false;
    int mode; int l; unsigned char* ws; const float* xin; float* xout; const float* cin0;
    size_t oA, oB; int ldc, ldc2, split_tile;
    __device__ __forceinline__ void operator()(const f32x4 (&acc)[2][2][4][2], const Unit& u, int wr, int wc, int fr, int fq) const {
        if (mode == EM_RES) {
            const int b = u.pm / 17, t0 = u.pm % 17;
            const float* src; float* dst; const float* gate; const float* modl = (const float*)(ws + oA) + (size_t)l * 5 * 3072;
            if (t0 == 0) { float* c1 = (float*)(ws + oB); src = ((l == 0) ? cin0 : (const float*)c1) + (size_t)b * 256 * 1024; dst = c1 + (size_t)b * 256 * 1024; gate = modl + 4 * 3072 + 2048; }
            else { const size_t o = ((size_t)b * 4096 + (size_t)(t0 - 1) * 256) * 1024; src = xin + o; dst = xout + o; gate = modl + b * 3072 + 2048; }
            const int col0 = u.pn * BM + wc * 32 + 8 * fq;
            const char* srcb = (const char*)src; char* dstb = (char*)dst; const char* gb = (const char*)(gate + col0);
            const unsigned off0 = (unsigned)((wr * 64 + fr) * 1024 + col0) * 4u;
#pragma unroll
            for (int ai = 0; ai < 2; ++ai) {
                f32x4 xo[4][2][2];
#pragma unroll
                for (int m = 0; m < 4; ++m) { const unsigned off = off0 + (unsigned)(ai * HALF + m * 16) * 4096u;
#pragma unroll
                    for (int bj = 0; bj < 2; ++bj)
#pragma unroll
                        for (int n = 0; n < 2; ++n) xo[m][bj][n] = *(const f32x4*)(srcb + (off + (unsigned)(bj * HALF + n * 4) * 4u)); }
#pragma unroll
                for (int m = 0; m < 4; ++m) { const unsigned off = off0 + (unsigned)(ai * HALF + m * 16) * 4096u;
#pragma unroll
                    for (int bj = 0; bj < 2; ++bj)
#pragma unroll
                        for (int n = 0; n < 2; ++n) { const unsigned cb = (unsigned)(bj * HALF + n * 4) * 4u; const f32x4 g = *(const f32x4*)(gb + cb);
                            *(f32x4*)(dstb + (off + cb)) = xo[m][bj][n] + g * acc[ai][bj][m][n]; } }
                asm volatile("" ::: "memory"); }
            return;
        }
        const int row0 = u.pm * BM + wr * 64 + fr; int colt = u.pn * BM; bf16_t* base = (bf16_t*)(ws + oA); int ld = ldc; bool second = false;
        if (u.pn >= split_tile) { base = (bf16_t*)(ws + oB); ld = ldc2; colt -= split_tile * BM; second = true; }
        const bool do_silu = (mode == EM_SILU2) && second;
        const int col0 = colt + wc * 32 + 8 * fq;
#pragma unroll
        for (int ai = 0; ai < 2; ++ai)
#pragma unroll
            for (int m = 0; m < 4; ++m) { bf16_t* rowp = base + (size_t)(row0 + ai * HALF + m * 16) * ld + col0;
#pragma unroll
                for (int bj = 0; bj < 2; ++bj) { f32x4 v0 = acc[ai][bj][m][0], v1 = acc[ai][bj][m][1];
                    if (mode == EM_SIG) {
#pragma unroll
                        for (int e = 0; e < 4; ++e) { v0[e] = sigmoid_f(v0[e]); v1[e] = sigmoid_f(v1[e]); } }
                    if (do_silu) {
#pragma unroll
                        for (int e = 0; e < 4; ++e) { v0[e] = v0[e] * sigmoid_f(v0[e]); v1[e] = v1[e] * sigmoid_f(v1[e]); } }
                    u32x4 w; w.x = cvt_pk_bf16(v0[0], v0[1]); w.y = cvt_pk_bf16(v0[2], v0[3]); w.z = cvt_pk_bf16(v1[0], v1[1]); w.w = cvt_pk_bf16(v1[2], v1[3]);
                    *(u32x4*)(rowp + bj * HALF) = w; } }
    }
};
struct Order {
    int nM, nN, nwg, G, c, latent_only, grouped, vc, nctx;
    __device__ void init(int nM_, int nN_, int G_, int c_, int lat) { nM = nM_; nN = nN_; nwg = nM * nN; G = G_; c = c_; latent_only = lat; grouped = 0; vc = 0; nctx = 0; }
    __device__ void init_grouped(int G_, int vc_, int with_ctx) { init(64, 4, G_, vc_, 1); grouped = 1; vc = vc_; nctx = with_ctx ? 64 : 0; }
    __device__ bool next(int i, Unit& u) const {
        if (grouped) {
            const int gi = i >> 2, grp = vc + gi * G;
            if (grp < 256) { const int pm = grp >> 2; u.pm = pm + pm / 16 + 1; u.pn = 4 * (i & 3) + (grp & 3); return true; }
            const int done = ((256 - vc + G - 1) / G) * 4;
            const int x = vc + (i - done) * G;
            if (i >= done && x < nctx) { const int g = x >> 2, k = x & 3; u.pm = (g >> 2) * 17; u.pn = 4 * k + (g & 3); return true; }
            return false;
        }
        const long L = (long)i * G + c; if (L >= nwg) return false;
        int wgid = (int)L; { const int q = nwg / NXCD, r = nwg % NXCD, xcd = wgid % NXCD, off = wgid / NXCD; wgid = (xcd < r ? xcd * (q + 1) : r * (q + 1) + (xcd - r) * q) + off; }
        const int nig = WGM * nN, gid = wgid / nig, fm = gid * WGM, gsz = (nM - fm) < WGM ? (nM - fm) : WGM;
        int pm = fm + ((wgid % nig) % gsz); u.pn = (wgid % nig) / gsz; if (latent_only == 1) pm = pm + pm / 16 + 1; else if (latent_only == 2) pm = pm * 17; u.pm = pm; return true;
    }
    __device__ __forceinline__ void a_ready(const Unit&) const {}
    __device__ __forceinline__ void done(const Unit&) const {}
};
template <class Epi, class Sched, bool ALIGN_EPI = false, bool SP2 = false>
__device__ __forceinline__ void gemm_phase(PG8_LAS unsigned char* lds, const Gemm g, const Sched& S, const Epi& E, const int tid  ) {
    const int wid = __builtin_amdgcn_readfirstlane(tid >> 6), lane = tid & 63, wr = wid >> 2, wc = wid & 3, fr = lane & 15, fq = lane >> 4;
    const int K = g.K, nt = K / BK;
    unsigned voffA[2], voffB[2];
#pragma unroll
    for (int i = 0; i < 2; ++i) { int R, C; stage_rc(tid * 16 + i * 8192, R, C); const int Rb = Epi::PERM ? ((R & ~31) + perm32(R & 31)) : R;
        voffA[i] = (unsigned)(R * g.lda + C) * 2u; voffB[i] = (unsigned)(Rb * K + C) * 2u; }
    const size_t kstep = (size_t)(BK * 2);
    const size_t hstepA = (size_t)HALF * g.lda * 2, hstepB = (size_t)HALF * K * 2;
    const size_t tstepA = 2 * hstepA, tstepB = 2 * hstepB;
    const unsigned ldsw = (unsigned)wid * 1024u;
    const int aoff = lds_byte(wr * 64 + fr, fq * 8), boff = lds_byte(wc * 32 + fr, fq * 8);
#define PG8_SA(b, h) (((b) * 2 + (h)) * HTB)
#define PG8_SB(b, h) ((4 + (b) * 2 + (h)) * HTB)
#define PG8_STAGE(bufoff, gbase, voff) do { _Pragma("unroll") for (int _i = 0; _i < 2; ++_i) \
        __builtin_amdgcn_global_load_lds((const unsigned*)((const char*)(gbase) + (voff)[_i]), (PG8_LAS unsigned*)(lds + (bufoff) + ldsw + _i * 8192), 16, 0, 0); } while (0)
#define PG8_LDA(dst, b, h) do { _Pragma("unroll") for (int m = 0; m < 4; ++m) _Pragma("unroll") for (int k = 0; k < 2; ++k) dst[m][k] = *(const PG8_LAS bf16x8*)(lds + PG8_SA(b, h) + aoff + m * 2048 + k * 1024); } while (0)
#define PG8_LDB(dst, b, h) do { _Pragma("unroll") for (int n = 0; n < 2; ++n) _Pragma("unroll") for (int k = 0; k < 2; ++k) dst[n][k] = *(const PG8_LAS bf16x8*)(lds + PG8_SB(b, h) + boff + n * 2048 + k * 1024); } while (0)
#define PG8_MMA(ai, bj, At, Bt) do { __builtin_amdgcn_s_setprio(1); _Pragma("unroll") for (int m = 0; m < 4; ++m) _Pragma("unroll") for (int n = 0; n < 2; ++n) _Pragma("unroll") for (int k = 0; k < 2; ++k) \
        acc[ai][bj][m][n] = __builtin_amdgcn_mfma_f32_16x16x32_bf16(Bt[n][k], At[m][k], acc[ai][bj][m][n], 0, 0, 0); __builtin_amdgcn_s_setprio(0); } while (0)
#define PG8_WAIT_V(n) asm volatile("s_waitcnt vmcnt(" #n ")" ::: "memory")
#define PG8_WAIT_L(n) asm volatile("s_waitcnt lgkmcnt(" #n ")" ::: "memory")
#define PG8_BAR __builtin_amdgcn_s_barrier()
#define PG8_SCHED __builtin_amdgcn_sched_barrier(0)
    Unit cur, nxt; int ui = 0;
    if (!S.next(0, cur)) return;
    f32x4 acc[2][2][4][2];
#pragma unroll
    for (int a = 0; a < 2; ++a)
#pragma unroll
        for (int b = 0; b < 2; ++b)
#pragma unroll
            for (int m = 0; m < 4; ++m)
#pragma unroll
                for (int n = 0; n < 2; ++n) acc[a][b][m][n] = (f32x4){0.f, 0.f, 0.f, 0.f};
    bf16x8 At[4][2], B0[2][2], B1[2][2];
    const char* cA = (const char*)g.A + (size_t)cur.pm * tstepA + (size_t)(cur.pn >> g.a_shift) * (size_t)g.a_step; const char* cB = (const char*)g.Bt + (size_t)cur.pn * tstepB;
    S.a_ready(cur);
    if constexpr (SP2) {
        PG8_STAGE(PG8_SB(0, 0), cB, voffB); PG8_STAGE(PG8_SB(0, 1), cB + hstepB, voffB); PG8_STAGE(PG8_SA(0, 0), cA, voffA); PG8_STAGE(PG8_SA(0, 1), cA + hstepA, voffA);
        if (wr == 1) PG8_BAR;
        PG8_WAIT_V(2); PG8_BAR;
        PG8_STAGE(PG8_SB(1, 0), cB + kstep, voffB); PG8_STAGE(PG8_SA(1, 0), cA + kstep, voffA); PG8_STAGE(PG8_SB(1, 1), cB + hstepB + kstep, voffB);
        PG8_WAIT_V(6); PG8_BAR;
    } else {
        PG8_STAGE(PG8_SB(0, 0), cB, voffB); PG8_STAGE(PG8_SA(0, 0), cA, voffA); PG8_STAGE(PG8_SB(0, 1), cB + hstepB, voffB); PG8_STAGE(PG8_SA(0, 1), cA + hstepA, voffA);
        if (wr == 1) PG8_BAR;
        PG8_WAIT_V(4); PG8_BAR;
        PG8_STAGE(PG8_SB(1, 0), cB + kstep, voffB); PG8_STAGE(PG8_SA(1, 0), cA + kstep, voffA); PG8_STAGE(PG8_SB(1, 1), cB + hstepB + kstep, voffB);
        PG8_WAIT_V(6); PG8_BAR;
    }
    for (;;) {
        const bool has_next = S.next(ui + 1, nxt);
        const char* nA = has_next ? (const char*)g.A + (size_t)nxt.pm * tstepA + (size_t)(nxt.pn >> g.a_shift) * (size_t)g.a_step : cA; const char* nB = has_next ? (const char*)g.Bt + (size_t)nxt.pn * tstepB : cB;
        for (int t = 0; t < nt; t += 2) {
            const bool last = (t == nt - 2);
            const char* a1 = cA + (size_t)(t + 1) * kstep;
            const char* a2 = last ? nA : cA + (size_t)(t + 2) * kstep; const char* b2 = last ? nB : cB + (size_t)(t + 2) * kstep;
            const char* a3 = a2 + kstep; const char* b3 = b2 + kstep;
            if (last && has_next) S.a_ready(nxt);
            if constexpr (SP2) {
            PG8_LDB(B0, 0, 0); PG8_LDB(B1, 0, 1); PG8_SCHED; PG8_LDA(At, 0, 0); PG8_STAGE(PG8_SA(1, 1), a1 + hstepA, voffA);
            PG8_WAIT_V(8); PG8_WAIT_L(0); PG8_BAR; PG8_MMA(0, 0, At, B0); PG8_MMA(0, 1, At, B1); PG8_BAR; PG8_SCHED;
            PG8_LDA(At, 0, 1); PG8_STAGE(PG8_SB(0, 0), b2, voffB); PG8_STAGE(PG8_SB(0, 1), b2 + hstepB, voffB); PG8_STAGE(PG8_SA(0, 0), a2, voffA);
            PG8_WAIT_V(8); PG8_WAIT_L(0); PG8_BAR; PG8_MMA(1, 0, At, B0); PG8_MMA(1, 1, At, B1); PG8_BAR; PG8_SCHED;
            PG8_LDB(B0, 1, 0); PG8_LDB(B1, 1, 1); PG8_SCHED; PG8_LDA(At, 1, 0); PG8_STAGE(PG8_SA(0, 1), a2 + hstepA, voffA);
            PG8_WAIT_V(8); PG8_WAIT_L(0); PG8_BAR; PG8_MMA(0, 0, At, B0); PG8_MMA(0, 1, At, B1); PG8_BAR; PG8_SCHED;
            PG8_LDA(At, 1, 1); PG8_STAGE(PG8_SB(1, 0), b3, voffB); PG8_STAGE(PG8_SB(1, 1), b3 + hstepB, voffB); PG8_STAGE(PG8_SA(1, 0), a3, voffA);
            PG8_WAIT_V(8); PG8_WAIT_L(0); PG8_BAR; PG8_MMA(1, 0, At, B0); PG8_MMA(1, 1, At, B1); PG8_BAR; PG8_SCHED;
            } else {
            PG8_LDB(B0, 0, 0); PG8_SCHED; PG8_LDA(At, 0, 0); PG8_STAGE(PG8_SA(1, 1), a1 + hstepA, voffA);
            PG8_WAIT_L(8); PG8_BAR; PG8_WAIT_L(0); PG8_MMA(0, 0, At, B0); PG8_BAR; PG8_SCHED;
            PG8_LDB(B1, 0, 1); PG8_STAGE(PG8_SB(0, 0), b2, voffB);
            PG8_BAR; PG8_WAIT_L(0); PG8_MMA(0, 1, At, B1); PG8_BAR;
            PG8_LDA(At, 0, 1); PG8_STAGE(PG8_SA(0, 0), a2, voffA);
            PG8_BAR; PG8_WAIT_L(0); PG8_MMA(1, 0, At, B0); PG8_BAR; PG8_SCHED;
            PG8_STAGE(PG8_SB(0, 1), b2 + hstepB, voffB);
            PG8_WAIT_V(6); PG8_BAR; PG8_MMA(1, 1, At, B1); PG8_BAR;
            PG8_LDB(B0, 1, 0); PG8_SCHED; PG8_LDA(At, 1, 0); PG8_STAGE(PG8_SA(0, 1), a2 + hstepA, voffA);
            PG8_WAIT_L(8); PG8_BAR; PG8_WAIT_L(0); PG8_MMA(0, 0, At, B0); PG8_BAR; PG8_SCHED;
            PG8_LDB(B1, 1, 1); PG8_STAGE(PG8_SB(1, 0), b3, voffB);
            PG8_BAR; PG8_WAIT_L(0); PG8_MMA(0, 1, At, B1); PG8_BAR;
            PG8_LDA(At, 1, 1); PG8_STAGE(PG8_SA(1, 0), a3, voffA);
            PG8_BAR; PG8_WAIT_L(0); PG8_MMA(1, 0, At, B0); PG8_BAR; PG8_SCHED;
            PG8_STAGE(PG8_SB(1, 1), b3 + hstepB, voffB);
            PG8_WAIT_V(6); PG8_BAR; PG8_MMA(1, 1, At, B1); PG8_BAR;
            }
        }
        if constexpr (ALIGN_EPI) { if (wr == 0) PG8_BAR; }
        if constexpr (!Epi::AFTER_DRAIN) { E(acc, cur, wr, wc, fr, fq); S.done(cur); }
        if (!has_next) break;
#pragma unroll
        for (int a = 0; a < 2; ++a)
#pragma unroll
            for (int b = 0; b < 2; ++b)
#pragma unroll
                for (int m = 0; m < 4; ++m)
#pragma unroll
                    for (int n = 0; n < 2; ++n) acc[a][b][m][n] = (f32x4){0.f, 0.f, 0.f, 0.f};
        cur = nxt; cA = nA; cB = nB; ++ui;
        if constexpr (ALIGN_EPI) { if (wr == 1) PG8_BAR; }
    }
    PG8_WAIT_V(0);
    if constexpr (!ALIGN_EPI) { if (wr == 0) PG8_BAR; }
    PG8_BAR;
    if constexpr (Epi::AFTER_DRAIN) { E.fused(acc, cur, wr, wc, fr, fq, lds, wid, lane); S.done(cur); }
#undef PG8_SA
#undef PG8_SB
#undef PG8_STAGE
#undef PG8_LDA
#undef PG8_LDB
#undef PG8_MMA
#undef PG8_WAIT_V
#undef PG8_WAIT_L
#undef PG8_BAR
#undef PG8_SCHED
}
}
#define PG8_SP2 true
#define PG8_ALIGN true
#define GAS __attribute__((address_space(1)))
#define LAS __attribute__((address_space(3)))
typedef unsigned short bf16;
typedef unsigned v4u __attribute__((ext_vector_type(4)));
typedef float f32x4 __attribute__((ext_vector_type(4)));
typedef short bf16x8 __attribute__((ext_vector_type(8)));
typedef GAS unsigned gu32;
typedef GAS unsigned long long gu64;
#define RLX_AGENT __ATOMIC_RELAXED, __HIP_MEMORY_SCOPE_AGENT
#define LDS_WAIT() asm volatile("s_waitcnt lgkmcnt(0)" ::: "memory")
#define VM_WAIT() asm volatile("s_waitcnt vmcnt(0)" ::: "memory")
__device__ __forceinline__ unsigned long long rt() { return __builtin_amdgcn_s_memrealtime(); }
__device__ __forceinline__ unsigned f2bf(float f) { unsigned u = __builtin_bit_cast(unsigned, f); return (u + 0x7fffu + ((u >> 16) & 1u)) >> 16; }
__device__ __forceinline__ unsigned pk2(float lo, float hi) { return f2bf(lo) | (f2bf(hi) << 16); }
#define XB_TMO      128
#define XB_XCNT(j)  (256  + 64 * (j))
#define XB_XSUB(j)  (1280 + 64 * (j))
#define XB_XGEN(j)  (2304 + 64 * (j))
#define XB_TOP      3328
#define XB_TOPGEN   3392
#define XCD_BAR_WORDS 3456
#define XB_SPIN_CAP (1u << 18)

__device__ __forceinline__ unsigned xb_ld(unsigned* p)              { return __hip_atomic_load(p, __ATOMIC_RELAXED, __HIP_MEMORY_SCOPE_AGENT); }
__device__ __forceinline__ unsigned xb_add(unsigned* p, unsigned v) { return __hip_atomic_fetch_add(p, v, __ATOMIC_RELAXED, __HIP_MEMORY_SCOPE_AGENT); }
__device__ __forceinline__ unsigned xb_xcc_id() { return (unsigned)__builtin_amdgcn_s_getreg((3 << 11) | 20) & 0xFu; }
#define XB_SPIN(cond, bar) do { unsigned _sp = 0; while (cond) { __builtin_amdgcn_s_sleep(1); \
    if ((++_sp & 255u) == 0u) { if (xb_ld(&(bar)[XB_TMO])) break; if (_sp > XB_SPIN_CAP) { atomicAdd(&(bar)[XB_TMO], 1u); break; } } } } while (0)

struct XcdBarrier {
    unsigned* bar; unsigned x;
    volatile LAS unsigned* st;
};

__device__ __forceinline__ XcdBarrier xcd_barrier_post(unsigned* bar, volatile LAS unsigned* st) {
    XcdBarrier b; b.bar = bar; b.x = xb_xcc_id(); b.st = st;
    if (threadIdx.x == 0) (void)xb_add(&bar[XB_XCNT(b.x)], 1u);
    return b;
}
__device__ __forceinline__ void xcd_barrier_complete(unsigned* bar, unsigned x, unsigned& nloc, unsigned& nx) {
    const unsigned G = gridDim.x * gridDim.y * gridDim.z;
    unsigned sum, cnt, mine, sp = 0u;
    for (;;) {
        sum = 0u; cnt = 0u; mine = 0u;
#pragma unroll
        for (unsigned j = 0; j < 16; ++j) { const unsigned c = xb_ld(&bar[XB_XCNT(j)]); sum += c; cnt += (c > 0u) ? 1u : 0u; mine = (j == x) ? c : mine; }
        if (sum == G) break;
        __builtin_amdgcn_s_sleep(1);
        if ((++sp & 255u) == 0u) { if (xb_ld(&bar[XB_TMO])) break; if (sp > XB_SPIN_CAP) { atomicAdd(&bar[XB_TMO], 1u); break; } }
    }
    nloc = mine > 0u ? mine : 1u; nx = cnt > 0u ? cnt : 1u;
}

__device__ __forceinline__ void xcd_barrier(const XcdBarrier& b) {
    asm volatile("s_waitcnt vmcnt(0)" ::: "memory");
    __syncthreads();
    if (threadIdx.x == 0) {
        unsigned* bar = b.bar;
        __builtin_amdgcn_s_waitcnt(0);
        unsigned nloc = b.st[0], nx = b.st[1];
        if (nloc == 0u) { xcd_barrier_complete(bar, b.x, nloc, nx); b.st[0] = nloc; b.st[1] = nx; }
        const unsigned old = xb_add(&bar[XB_XSUB(b.x)], 1u);
        const unsigned gen = old / nloc;
        if (old + 1u == (gen + 1u) * nloc) {
            __builtin_amdgcn_fence(__ATOMIC_RELEASE, "agent");
            asm volatile("s_waitcnt vmcnt(0)" ::: "memory");
            const unsigned og = xb_add(&bar[XB_TOP], 1u);
            const unsigned tg = og / nx;
            if (og + 1u == (tg + 1u) * nx) xb_add(&bar[XB_TOPGEN], 1u);
            else XB_SPIN(xb_ld(&bar[XB_TOPGEN]) == tg, bar);
            __builtin_amdgcn_fence(__ATOMIC_ACQUIRE, "agent");
            xb_add(&bar[XB_XGEN(b.x)], 1u);
            asm volatile("s_waitcnt vmcnt(0)" ::: "memory");
        } else {
            XB_SPIN(xb_ld(&bar[XB_XGEN(b.x)]) == gen, bar);
            __builtin_amdgcn_fence(__ATOMIC_ACQUIRE, "agent");
            asm volatile("s_waitcnt vmcnt(0)" ::: "memory");
        }
    }
    __syncthreads();
}
constexpr int NB = 4, SEQ = 4096, CTXL = 256, TPB = SEQ + CTXL, NROWS = NB * TPB, DM = 1024, NLAYER = 2, IN_COLS = 6816;
constexpr int NWAVES = 8, NTHREADS = NWAVES * 64;
constexpr float RMS_EPS = 1e-6f;
constexpr float LOG2E = 1.4426950408889634f;
constexpr float QSCALE64 = 0.125f * LOG2E;
constexpr float QSCALE96 = 0.10206207261596575f * LOG2E;
constexpr int ZS_P = 1792, ZC_CQ = 0, ZC_CKV = 256, ZC_KR = 384, ZC_SQ = 512, ZC_SK = 768, ZC_SV = 896, ZC_AQ = 1024, ZC_AK = 1280, ZC_AV = 1408, ZC_LRU = 1536;
constexpr int N1 = 2816;
constexpr int W1ROWS = N1 + 4096;
constexpr size_t MiB = 1u << 20;
constexpr size_t WS_CTL = 0, CTL_ZERO_BYTES = 64 * 1024;
constexpr size_t WS_MOD = 1 * MiB;
constexpr size_t WS_RHC = 1 * MiB + 256 * 1024, WS_RHS = WS_RHC + 512 * 1024;
constexpr size_t WS_RMC = WS_RHS + 512 * 1024, WS_RMS = WS_RMC + 256 * 1024;
constexpr size_t WS_CTX1 = 3 * MiB;
constexpr size_t WS_WOS = 3 * MiB;
constexpr size_t WS_W = 8 * MiB, W_LAYER = 18 * MiB;
constexpr size_t WO_W1 = 0, WO_WB = 13 * MiB + 512 * 1024, WO_WO = WO_WB + 2 * MiB, WO_UQ = WO_WO + 2 * MiB, WO_UKV = WO_UQ + 256 * 1024;
constexpr size_t WS_H = 44 * MiB;
constexpr size_t WS_G = 78 * MiB;
constexpr size_t WS_S = 112 * MiB;
constexpr size_t WS_ZS = 112 * MiB;
constexpr size_t WS_MQ = 172 * MiB;
constexpr size_t WS_MKV = 189 * MiB;
constexpr size_t WS_MK = 206 * MiB;
constexpr size_t WS_U = 219 * MiB;
constexpr size_t WS_HF = 236 * MiB;
constexpr size_t WS_SP = 2 * MiB + 768 * 1024;
constexpr size_t WS_LWT = 254 * MiB + 512 * 1024;
constexpr size_t WS_END = 256 * MiB;
static_assert(WS_H + (size_t)NROWS * 1024 * 2 <= WS_G && WS_G + (size_t)NROWS * 1024 * 2 <= WS_S && WS_S + (size_t)NROWS * 4096 * 2 <= 248 * MiB, "ws map");
static_assert(WS_ZS + (size_t)NROWS * ZS_P * 2 <= WS_MQ && WS_MK + (size_t)NROWS * 384 * 2 <= WS_U, "ws map 2");
static_assert(WO_UKV + 512 * 256 * 2 <= W_LAYER, "weights");
constexpr int CW_BAR = 1024;
constexpr int CW_FLG = 8192;

constexpr int RING_OFF = 0, RING_BYTES = 131072, LDSCTL_OFF = RING_BYTES, MISC_OFF = LDSCTL_OFF + 320, LDS_BYTES = 147456;

typedef unsigned short bf16;
typedef unsigned u32x2 __attribute__((ext_vector_type(2)));
typedef float f32x2v __attribute__((ext_vector_type(2)));
__device__ __forceinline__ float bf2f(bf16 v) { return __uint_as_float((unsigned)v << 16); }
template <int O> __device__ __forceinline__ float xor_swz(float v) { return __int_as_float(__builtin_amdgcn_ds_swizzle(__float_as_int(v), (O << 10) | 0x1F)); }
__device__ __forceinline__ float wave_sum(float v) {
    v += xor_swz<1>(v); v += xor_swz<2>(v); v += xor_swz<4>(v); v += xor_swz<8>(v); v += xor_swz<16>(v);
    auto rr = __builtin_amdgcn_permlane32_swap(__float_as_uint(v), __float_as_uint(v), false, false); return __uint_as_float(rr[0]) + __uint_as_float(rr[1]); }
__device__ __forceinline__ float wave_max(float v) {
    v = fmaxf(v, xor_swz<1>(v)); v = fmaxf(v, xor_swz<2>(v)); v = fmaxf(v, xor_swz<4>(v)); v = fmaxf(v, xor_swz<8>(v)); v = fmaxf(v, xor_swz<16>(v));
    auto rr = __builtin_amdgcn_permlane32_swap(__float_as_uint(v), __float_as_uint(v), false, false); return fmaxf(__uint_as_float(rr[0]), __uint_as_float(rr[1])); }
__device__ __forceinline__ float grp16_sum(float v) {
    v += xor_swz<1>(v); v += xor_swz<2>(v); v += xor_swz<4>(v); v += xor_swz<8>(v); return v; }

struct Args { const float* in[28]; float* out; unsigned char* ws; int ph_lo, ph_hi; };
enum { I_X = 0, I_C, I_CTX, I_CCTX, I_WMOD, I_BMOD, I_NORMW, I_WIN, I_CQN, I_CKVN, I_WUQ, I_WUKV, I_MQN, I_MKN, I_SQN, I_SKN, I_SINK, I_AQN, I_AKN,
       I_CONVW, I_CONVB, I_LWR, I_LBR, I_LWI, I_LBI, I_LAM, I_WBR, I_WOUT };

struct Frame {
    LAS unsigned char* lds; const float* const __attribute__((address_space(4)))* kin; unsigned char* ws; float* out;
    int tid, lane, wave, G, vcu, gw, NGW, z;
    __device__ __forceinline__ const float* in(int i) const { return kin[i]; }
};

__device__ __forceinline__ void xpose_item(const float* W, int ldn, int k0, int n0, bf16* WT, int pd, int drow, LAS float* scr, int lane) {
    float v[32]; const float* wp = W + (size_t)(k0 + (lane >> 5)) * ldn + n0 + (lane & 31);
#pragma unroll
    for (int i = 0; i < 32; ++i) v[i] = wp[(size_t)(2 * i) * ldn];
#pragma unroll
    for (int i = 0; i < 32; ++i) scr[(2 * i + (lane >> 5)) * 33 + (lane & 31)] = v[i];
    LDS_WAIT(); asm volatile("" ::: "memory");
    const int c = lane & 7;
#pragma unroll
    for (int j = 0; j < 4; ++j) { const int n = (lane >> 3) + 8 * j; const LAS float* s = scr + (8 * c) * 33 + n;
        v4u o; o.x = pk2(s[0 * 33], s[1 * 33]); o.y = pk2(s[2 * 33], s[3 * 33]); o.z = pk2(s[4 * 33], s[5 * 33]); o.w = pk2(s[6 * 33], s[7 * 33]);
        *(GAS v4u*)(WT + (size_t)(drow + n0 + n) * pd + k0 + 8 * c) = o; }
    LDS_WAIT(); asm volatile("" ::: "memory");
}
__device__ __forceinline__ void zero16(bf16* p, size_t n16, int gt, int ngt) {
    for (size_t i = gt; i < n16; i += ngt) ((GAS v4u*)p)[i] = (v4u){0u, 0u, 0u, 0u};
}
constexpr int N1T = 2816 / 32;
constexpr int I_EARLY = 16 * N1T + 4 * 12 + 2 * 16, I_INL = 16 * (213 - N1T), I_BR = 4 * 4 * 32, I_OUT = 16 * 32, I_LAYER = I_EARLY + I_INL + I_BR + I_OUT, I_SPLIT = 16 * 32;
__device__ __forceinline__ void copy_item(Frame& F, int l, int r, LAS float* scr) {
    unsigned char* wl = F.ws + WS_W + (size_t)l * W_LAYER;
    if (r < 16 * N1T) { const int kb = r / N1T, nb = r % N1T, n0 = nb * 32;
        xpose_item(F.in(I_WIN) + (size_t)l * 1024 * IN_COLS, IN_COLS, kb * 64, n0, (bf16*)(wl + WO_W1), 1024, n0 >= 416 ? 96 : 0, scr, F.lane); return; } r -= 16 * N1T;
    if (r < 4 * 12) { const int kb = r / 12, nb = r % 12;
        xpose_item(F.in(I_WUQ) + (size_t)l * 256 * 384, 384, kb * 64, nb * 32, (bf16*)(wl + WO_UQ), 256, 0, scr, F.lane); return; } r -= 4 * 12;
    if (r < 2 * 16) { const int kb = r / 16, nb = r % 16;
        xpose_item(F.in(I_WUKV) + (size_t)l * 128 * 512, 512, kb * 64, nb * 32, (bf16*)(wl + WO_UKV), 256, 0, scr, F.lane); return; } r -= 2 * 16;
    if (r < I_INL) { const int kb = r / (213 - N1T), nb = N1T + r % (213 - N1T), n0 = nb * 32;
        xpose_item(F.in(I_WIN) + (size_t)l * 1024 * IN_COLS, IN_COLS, kb * 64, n0, (bf16*)(wl + WO_W1), 1024, 96, scr, F.lane); return; } r -= I_INL;
    if (r < I_BR) { const int k = r / 128, rr = r % 128, kb = rr / 32, nb = rr % 32;
        xpose_item(F.in(I_WBR) + ((size_t)l * 4 + k) * 256 * 1024, 1024, kb * 64, nb * 32, (bf16*)(wl + WO_WB) + (size_t)k * 1024 * 256, 256, 0, scr, F.lane); return; } r -= I_BR;
    if (r < I_OUT) { const int kb = r / 32, nb = r % 32;
        xpose_item(F.in(I_WOUT) + (size_t)l * 1024 * 1024, 1024, kb * 64, nb * 32, (bf16*)(wl + WO_WO), 1024, 0, scr, F.lane); return; } r -= I_OUT;
    if (r < I_SPLIT) { const int kb = r / 32, nb = r % 32, kq = kb >> 2;
        xpose_item(F.in(I_WOUT), 1024, kb * 64, nb * 32, (bf16*)(F.ws + WS_WOS) + (size_t)kq * (1024 * 256 - 256), 256, 0, scr, F.lane); }
}
__device__ __forceinline__ void weight_copies(Frame& F, int first, int stride, int loA, int nA, int loB, int nB) {
    LAS float* scr = (LAS float*)(F.lds + RING_OFF + F.wave * 16384);
#pragma unroll 1
    for (int v = first; v < nA + nB; v += stride) { const bool a = v < nA; copy_item(F, a ? 0 : NLAYER - 1, a ? loA + v : loB + v - nA, scr); }
}
constexpr int IC_G1 = 320;
__device__ __forceinline__ void p0_tables(Frame& F, int gt, int ngt) {
    { float* rhc = (float*)(F.ws + WS_RHC); float* rhs = (float*)(F.ws + WS_RHS); float* rmc = (float*)(F.ws + WS_RMC); float* rms = (float*)(F.ws + WS_RMS);
      constexpr float L2_10000 = 13.287712379549449f, INV_2PI = 0.15915494309189535f;
      for (int i = gt; i < 4096 * 32; i += ngt) { const int t = i >> 5, p = i & 31; const float fr = __builtin_amdgcn_exp2f(-(float)(p & 15) * (L2_10000 / 16.0f));
          const float pos = (float)((p < 16) ? (t >> 6) : (t & 63)); const float rev = pos * fr * INV_2PI; rhc[i] = __builtin_amdgcn_cosf(rev); rhs[i] = __builtin_amdgcn_sinf(rev); }
      for (int i = gt; i < 4096 * 16; i += ngt) { const int t = i >> 4, p = i & 15; const float fr = __builtin_amdgcn_exp2f(-(float)(p & 7) * (L2_10000 / 8.0f));
          const float pos = (float)((p < 8) ? (t >> 6) : (t & 63)); const float rev = pos * fr * INV_2PI; rmc[i] = __builtin_amdgcn_cosf(rev); rms[i] = __builtin_amdgcn_sinf(rev); } }
    { float* sp = (float*)(F.ws + WS_SP); for (int i = gt; i < NLAYER * 2 * 256; i += ngt) sp[i] = 8.0f * LOG2E * log1pf(expf(-F.in(I_LAM)[i])); }
    { float* lwt = (float*)(F.ws + WS_LWT);
      for (int o = gt; o < NLAYER * 2 * 2 * 256 * 64; o += ngt) { const int i = o & 63, c = (o >> 6) & 255, gate = (o >> 14) & 1, ld = o >> 15, k = c >> 6, j = c & 63;
          lwt[o] = (gate == 0 ? F.in(I_LWR) : F.in(I_LWI))[(((size_t)ld * 4 + k) * 64 + i) * 64 + j]; } }
}
__device__ __forceinline__ void p0_prologue(Frame& F) {
    weight_copies(F, F.gw, F.NGW, 0, I_EARLY, 0, 0);
    const int gt = F.vcu * NTHREADS + F.tid, ngt = F.G * NTHREADS;
    for (int l = 0; l < NLAYER; ++l) {
        unsigned char* wl = F.ws + WS_W + (size_t)l * W_LAYER;
        zero16((bf16*)(wl + WO_W1) + (size_t)416 * 1024, 96 * 1024 * 2 / 16, gt, ngt);
        zero16((bf16*)(wl + WO_UQ) + (size_t)384 * 256, 128 * 256 * 2 / 16, gt, ngt);
        for (int i = gt; i < 512 * 16; i += ngt) { const int n = i >> 4, c = i & 15; ((GAS v4u*)((bf16*)(wl + WO_UKV) + (size_t)n * 256 + 128))[c] = (v4u){0u, 0u, 0u, 0u}; }
    }
    { LAS float* sc = (LAS float*)(F.lds + RING_OFF);
      LAS float* red = sc + 5 * 1024;
      __syncthreads();
      for (int i = F.tid; i < 5 * 1024; i += NTHREADS) { const float v = (i < 4096) ? F.in(I_C)[i] : F.in(I_CCTX)[i - 4096]; sc[i] = v / (1.0f + expf(-v)); }
      __syncthreads();
      float* modv = (float*)(F.ws + WS_MOD);
      for (int it = F.vcu; it < NLAYER * 96; it += F.G) {
          const int l = it / 96, n0 = (it % 96) * 32, nn = F.tid & 31, kc = F.tid >> 5;
          const float* w = F.in(I_WMOD) + (size_t)l * 1024 * 3072 + n0 + nn;
          float acc[5] = {0.f, 0.f, 0.f, 0.f, 0.f};
#pragma unroll 1
          for (int k0 = kc * 64; k0 < kc * 64 + 64; k0 += 32) { float wv[32];
#pragma unroll
              for (int i = 0; i < 32; ++i) wv[i] = w[(size_t)(k0 + i) * 3072];
#pragma unroll
              for (int i = 0; i < 32; ++i)
#pragma unroll
                  for (int r = 0; r < 5; ++r) acc[r] += sc[r * 1024 + k0 + i] * wv[i]; }
#pragma unroll
          for (int r = 0; r < 5; ++r) red[(kc * 5 + r) * 32 + nn] = acc[r];
          __syncthreads();
          if (F.tid < 160) { const int r = F.tid >> 5; float s = 0.f;
              for (int q = 0; q < 16; ++q) s += red[(q * 5 + r) * 32 + nn];
              modv[((size_t)l * 5 + r) * 3072 + n0 + nn] = s + F.in(I_BMOD)[l * 3072 + n0 + nn]; }
          __syncthreads();
      } }
}

__device__ __forceinline__ void ph_hnorm(Frame& F, int l) {
    const float* xs = (l == 0) ? F.in(I_X) : F.out; const float* cs = (l == 0) ? F.in(I_CTX) : (const float*)(F.ws + WS_CTX1);
    const float* nw = F.in(I_NORMW) + l * 1024; const float* modl = (const float*)(F.ws + WS_MOD) + (size_t)l * 5 * 3072;
    bf16* H = (bf16*)(F.ws + WS_H);
    for (int row = F.gw; row < NROWS; row += F.NGW) {
        const int b = row / TPB, j = row % TPB; const float* src; int mr;
        if (j < CTXL) { src = cs + ((size_t)b * CTXL + j) * 1024; mr = 4; } else { src = xs + ((size_t)b * SEQ + (j - CTXL)) * 1024; mr = b; }
        const GAS f32x4* xr = (const GAS f32x4*)src + F.lane;
        f32x4 v[4]; float ss = 0.f;
        if (l > 0 && j < CTXL) {
            const unsigned short* P = (const unsigned short*)(F.ws + WS_S) + (size_t)row * 4096 + 4 * F.lane;
            const float* gt = (const float*)(F.ws + WS_MOD) + 4 * 3072 + 2048 + 4 * F.lane;
            const GAS f32x4* c0 = (const GAS f32x4*)(F.in(I_CTX) + ((size_t)b * CTXL + j) * 1024) + F.lane;
#pragma unroll
            for (int q = 0; q < 4; ++q) { f32x4 a = {0.f, 0.f, 0.f, 0.f};
#pragma unroll
                for (int kq = 0; kq < 4; ++kq) { const u32x2 w = *(const u32x2*)(P + kq * 1024 + 256 * q); a.x += bflo(w.x); a.y += bfhi(w.x); a.z += bflo(w.y); a.w += bfhi(w.y); }
                v[q] = c0[64 * q] + *(const f32x4*)(gt + 256 * q) * a; }
        } else {
#pragma unroll
            for (int q = 0; q < 4; ++q) v[q] = xr[64 * q];
        }
#pragma unroll
        for (int q = 0; q < 4; ++q) ss += (v[q].x * v[q].x + v[q].y * v[q].y) + (v[q].z * v[q].z + v[q].w * v[q].w);
        const float rstd = 1.0f / sqrtf(wave_sum(ss) * (1.0f / 1024.0f) + RMS_EPS);
        const float* mrow = modl + mr * 3072;
        GAS unsigned long long* o8 = (GAS unsigned long long*)(H + (size_t)row * 1024) + F.lane;
#pragma unroll
        for (int q = 0; q < 4; ++q) { const int c = 4 * F.lane + 256 * q;
            const f32x4 g = *(const f32x4*)(nw + c), sh = *(const f32x4*)(mrow + c), sc = *(const f32x4*)(mrow + 1024 + c);
            const f32x4 h = v[q] * rstd * g * (sc + 1.0f) + sh;
            o8[64 * q] = (unsigned long long)pk2(h.x, h.y) | ((unsigned long long)pk2(h.z, h.w) << 32); }
    }
}

struct P1Regs { u32x2 cq; unsigned ckv, h[3][2]; float rc[2], rs[2]; };
__device__ __forceinline__ void post1_load(const bf16* z, const float* rc, const float* rs, bool lat, int lane, P1Regs& R) {
    const int hg = lane >> 4, p0 = (lane & 15) * 2;
    R.cq = *(const u32x2*)(z + ZC_CQ + 4 * lane); R.ckv = *(const unsigned*)(z + ZC_CKV + 2 * lane);
    const bf16* h0 = z + ZC_SQ + hg * 64 + p0; const bf16* h1 = z + ZC_AQ + hg * 64 + p0; const bf16* h2 = z + ((hg < 2) ? (ZC_SK + hg * 64) : (ZC_AK + (hg - 2) * 64)) + p0;
    R.h[0][0] = *(const unsigned*)h0; R.h[0][1] = *(const unsigned*)(h0 + 32); R.h[1][0] = *(const unsigned*)h1; R.h[1][1] = *(const unsigned*)(h1 + 32); R.h[2][0] = *(const unsigned*)h2; R.h[2][1] = *(const unsigned*)(h2 + 32);
    if (lat) { R.rc[0] = rc[p0]; R.rc[1] = rc[p0 + 1]; R.rs[0] = rs[p0]; R.rs[1] = rs[p0 + 1]; } else { R.rc[0] = 1.f; R.rc[1] = 1.f; R.rs[0] = 0.f; R.rs[1] = 0.f; }
}
__device__ __forceinline__ void post1_finish(bf16* z, int lane, const P1Regs& R, const float (&gcq)[4], const float (&gckv)[2], const float (&gh)[3][4]) {
    const int hg = lane >> 4, p0 = (lane & 15) * 2;
    { float v0 = bflo(R.cq.x), v1 = bfhi(R.cq.x), v2 = bflo(R.cq.y), v3 = bfhi(R.cq.y);
      const float rstd = 1.0f / sqrtf(wave_sum(v0 * v0 + v1 * v1 + v2 * v2 + v3 * v3) * (1.0f / 256.0f) + RMS_EPS);
      u32x2 w; w.x = pk2(v0 * rstd * gcq[0], v1 * rstd * gcq[1]); w.y = pk2(v2 * rstd * gcq[2], v3 * rstd * gcq[3]); *(u32x2*)(z + ZC_CQ + 4 * lane) = w; }
    { float v0 = bflo(R.ckv), v1 = bfhi(R.ckv);
      const float rstd = 1.0f / sqrtf(wave_sum(v0 * v0 + v1 * v1) * (1.0f / 128.0f) + RMS_EPS);
      *(unsigned*)(z + ZC_CKV + 2 * lane) = pk2(v0 * rstd * gckv[0], v1 * rstd * gckv[1]); }
#pragma unroll
    for (int q = 0; q < 3; ++q) {
        bf16* hp = z + ((q == 0) ? (ZC_SQ + hg * 64) : (q == 1) ? (ZC_AQ + hg * 64) : ((hg < 2) ? (ZC_SK + hg * 64) : (ZC_AK + (hg - 2) * 64))) + p0;
        float a0 = bflo(R.h[q][0]), a1 = bfhi(R.h[q][0]), b0 = bflo(R.h[q][1]), b1 = bfhi(R.h[q][1]);
        const float rstd = 1.0f / sqrtf(grp16_sum(a0 * a0 + a1 * a1 + b0 * b0 + b1 * b1) * (1.0f / 64.0f) + RMS_EPS);
        a0 *= rstd * gh[q][0]; a1 *= rstd * gh[q][1]; b0 *= rstd * gh[q][2]; b1 *= rstd * gh[q][3];
        const float x0 = a0 * R.rc[0] - b0 * R.rs[0], y0 = b0 * R.rc[0] + a0 * R.rs[0], x1 = a1 * R.rc[1] - b1 * R.rs[1], y1 = b1 * R.rc[1] + a1 * R.rs[1];
        const float sc = (q < 2) ? QSCALE64 : 1.0f;
        *(unsigned*)hp = pk2(x0 * sc, x1 * sc); *(unsigned*)(hp + 32) = pk2(y0 * sc, y1 * sc);
    }
}
__device__ __forceinline__ void ph_post1(Frame& F, int l) {
    bf16* ZS = (bf16*)(F.ws + WS_ZS);
    const float* rhc = (const float*)(F.ws + WS_RHC); const float* rhs = (const float*)(F.ws + WS_RHS);
    const int lane = F.lane, hg = lane >> 4, p0 = (lane & 15) * 2;
    float gcq[4], gckv[2], gh[3][4];
#pragma unroll
    for (int i = 0; i < 4; ++i) gcq[i] = F.in(I_CQN)[l * 256 + 4 * lane + i];
    gckv[0] = F.in(I_CKVN)[l * 128 + 2 * lane]; gckv[1] = F.in(I_CKVN)[l * 128 + 2 * lane + 1];
    { const float* g0 = F.in(I_SQN) + l * 64; const float* g1 = F.in(I_AQN) + l * 64; const float* g2 = ((hg < 2) ? F.in(I_SKN) : F.in(I_AKN)) + l * 64;
      gh[0][0] = g0[p0]; gh[0][1] = g0[p0 + 1]; gh[0][2] = g0[32 + p0]; gh[0][3] = g0[33 + p0];
      gh[1][0] = g1[p0]; gh[1][1] = g1[p0 + 1]; gh[1][2] = g1[32 + p0]; gh[1][3] = g1[33 + p0];
      gh[2][0] = g2[p0]; gh[2][1] = g2[p0 + 1]; gh[2][2] = g2[32 + p0]; gh[2][3] = g2[33 + p0]; }
    for (int row = F.gw; row < NROWS; row += 2 * F.NGW) {
        const int row2 = row + F.NGW; const bool has2 = row2 < NROWS;
        const int j = row % TPB; const bool lat = j >= CTXL; const int pos = lat ? j - CTXL : 0;
        const int j2 = has2 ? row2 % TPB : 0; const bool lat2 = j2 >= CTXL; const int pos2 = lat2 ? j2 - CTXL : 0;
        bf16* z = ZS + (size_t)row * ZS_P; bf16* z2 = ZS + (size_t)(has2 ? row2 : row) * ZS_P;
        P1Regs A, B;
        post1_load(z, rhc + pos * 32, rhs + pos * 32, lat, lane, A);
        if (has2) post1_load(z2, rhc + pos2 * 32, rhs + pos2 * 32, lat2, lane, B);
        post1_finish(z, lane, A, gcq, gckv, gh);
        if (has2) post1_finish(z2, lane, B, gcq, gckv, gh);
    }
}
struct P2Regs { u32x2 qn, kn; bf16 q1, q2, k1, k2; float c, s; };
__device__ __forceinline__ void post2_load(const bf16* zrow, const bf16* mq, const bf16* mkv, const float* rc, const float* rs, bool lat, int lane, P2Regs& R) {
    const int h = lane >> 4, j = lane & 15;
    R.qn = *(const u32x2*)(mq + h * 96 + 4 * j); R.q1 = mq[h * 96 + 64 + j]; R.q2 = mq[h * 96 + 80 + j];
    R.kn = *(const u32x2*)(mkv + h * 128 + 4 * j); R.k1 = zrow[ZC_KR + j]; R.k2 = zrow[ZC_KR + 16 + j];
    if (lat) { R.c = rc[j]; R.s = rs[j]; } else { R.c = 1.f; R.s = 0.f; }
}
__device__ __forceinline__ void post2_finish(bf16* mq, bf16* mk, int lane, const P2Regs& R, const float (&gq)[6], const float (&gk)[6]) {
    const int h = lane >> 4, j = lane & 15;
#pragma unroll
    for (int qk = 0; qk < 2; ++qk) {
        const u32x2 n = qk == 0 ? R.qn : R.kn; float v0 = bflo(n.x), v1 = bfhi(n.x), v2 = bflo(n.y), v3 = bfhi(n.y), r1 = bf2f(qk == 0 ? R.q1 : R.k1), r2 = bf2f(qk == 0 ? R.q2 : R.k2);
        const float rstd = 1.0f / sqrtf(grp16_sum(v0 * v0 + v1 * v1 + v2 * v2 + v3 * v3 + r1 * r1 + r2 * r2) * (1.0f / 96.0f) + RMS_EPS);
        const float (&g)[6] = qk == 0 ? gq : gk; const float sc = qk == 0 ? QSCALE96 : 1.0f;
        const float y1 = r1 * rstd * g[4], y2 = r2 * rstd * g[5];
        const float t1 = (y1 * R.c - y2 * R.s) * sc, t2 = (y2 * R.c + y1 * R.s) * sc;
        bf16* o = (qk == 0 ? mq : mk) + h * 96;
        u32x2 w; w.x = pk2(v0 * rstd * g[0] * sc, v1 * rstd * g[1] * sc); w.y = pk2(v2 * rstd * g[2] * sc, v3 * rstd * g[3] * sc);
        *(u32x2*)(o + 4 * j) = w; o[64 + j] = (bf16)f2bf(t1); o[80 + j] = (bf16)f2bf(t2);
    }
}
__device__ __forceinline__ void ph_post2(Frame& F, int l) {
    const bf16* ZS = (const bf16*)(F.ws + WS_ZS); bf16* MQ = (bf16*)(F.ws + WS_MQ); const bf16* MKV = (const bf16*)(F.ws + WS_MKV); bf16* MK = (bf16*)(F.ws + WS_MK);
    const float* rmc = (const float*)(F.ws + WS_RMC); const float* rms = (const float*)(F.ws + WS_RMS);
    const int lane = F.lane, jj = lane & 15;
    float gq[6], gk[6];
    { const float* a = F.in(I_MQN) + l * 96; const float* b = F.in(I_MKN) + l * 96;
#pragma unroll
      for (int i = 0; i < 4; ++i) { gq[i] = a[4 * jj + i]; gk[i] = b[4 * jj + i]; }
      gq[4] = a[64 + jj]; gq[5] = a[80 + jj]; gk[4] = b[64 + jj]; gk[5] = b[80 + jj]; }
    for (int row = F.gw; row < NROWS; row += 2 * F.NGW) {
        const int row2 = row + F.NGW; const bool has2 = row2 < NROWS; const size_t rb = has2 ? row2 : row;
        const int j = row % TPB; const bool lat = j >= CTXL; const int pos = lat ? j - CTXL : 0;
        const int j2 = (int)(rb % TPB); const bool lat2 = j2 >= CTXL; const int pos2 = lat2 ? j2 - CTXL : 0;
        P2Regs A, B;
        post2_load(ZS + (size_t)row * ZS_P, MQ + (size_t)row * 512, MKV + (size_t)row * 512, rmc + pos * 16, rms + pos * 16, lat, lane, A);
        if (has2) post2_load(ZS + rb * ZS_P, MQ + rb * 512, MKV + rb * 512, rmc + pos2 * 16, rms + pos2 * 16, lat2, lane, B);
        post2_finish(MQ + (size_t)row * 512, MK + (size_t)row * 384, lane, A, gq, gk);
        if (has2) post2_finish(MQ + rb * 512, MK + rb * 384, lane, B, gq, gk);
    }
}

template <int DQK>
__device__ __forceinline__ void attn_row_naive(const bf16* q, const bf16* Kb, int kp, const bf16* Vb, int vp, int n1, int lo2, int hi2, bool has_sink, float sink2, bf16* y, int lane) {
    float qf[DQK];
#pragma unroll
    for (int c = 0; c < DQK / 8; ++c) { const v4u w = *(const v4u*)(q + 8 * c);
        qf[8 * c + 0] = bflo(w.x); qf[8 * c + 1] = bfhi(w.x); qf[8 * c + 2] = bflo(w.y); qf[8 * c + 3] = bfhi(w.y); qf[8 * c + 4] = bflo(w.z); qf[8 * c + 5] = bfhi(w.z); qf[8 * c + 6] = bflo(w.w); qf[8 * c + 7] = bfhi(w.w); }
    float m = -INFINITY, l = 0.f; float acc[64];
#pragma unroll
    for (int d = 0; d < 64; ++d) acc[d] = 0.f;
    for (int seg = 0; seg < 2; ++seg) {
        const int k0 = seg == 0 ? 0 : lo2, k1 = seg == 0 ? n1 : hi2;
        for (int key = k0 + lane; key < k1; key += 64) {
            const bf16* kr = Kb + (size_t)key * kp; float s = 0.f;
#pragma unroll
            for (int c = 0; c < DQK / 8; ++c) { const v4u w = *(const v4u*)(kr + 8 * c);
                s += qf[8 * c + 0] * bflo(w.x) + qf[8 * c + 1] * bfhi(w.x) + qf[8 * c + 2] * bflo(w.y) + qf[8 * c + 3] * bfhi(w.y) + qf[8 * c + 4] * bflo(w.z) + qf[8 * c + 5] * bfhi(w.z) + qf[8 * c + 6] * bflo(w.w) + qf[8 * c + 7] * bfhi(w.w); }
            if (s > m) { const float f = exp2f(m - s); l *= f;
#pragma unroll
                for (int d = 0; d < 64; ++d) acc[d] *= f;
                m = s; }
            const float p = exp2f(s - m); l += p;
            const bf16* vr = Vb + (size_t)key * vp;
#pragma unroll
            for (int c = 0; c < 8; ++c) { const v4u w = *(const v4u*)(vr + 8 * c);
                acc[8 * c + 0] += p * bflo(w.x); acc[8 * c + 1] += p * bfhi(w.x); acc[8 * c + 2] += p * bflo(w.y); acc[8 * c + 3] += p * bfhi(w.y); acc[8 * c + 4] += p * bflo(w.z); acc[8 * c + 5] += p * bfhi(w.z); acc[8 * c + 6] += p * bflo(w.w); acc[8 * c + 7] += p * bfhi(w.w); }
        }
    }
    float M = wave_max(m); if (has_sink) M = fmaxf(M, sink2);
    const float f = (m == -INFINITY) ? 0.f : exp2f(m - M);
    float L = wave_sum(l * f); if (has_sink) L += exp2f(sink2 - M);
    float mine = 0.f;
#pragma unroll
    for (int d = 0; d < 64; ++d) { const float t = wave_sum(acc[d] * f); if (lane == d) mine = t; }
    y[lane] = (bf16)f2bf(mine / L * bf2f(y[lane]));
}
__device__ __forceinline__ void ph_attn_naive(Frame& F, int l) {
    const bf16* ZS = (const bf16*)(F.ws + WS_ZS); const bf16* MQ = (const bf16*)(F.ws + WS_MQ); const bf16* MKV = (const bf16*)(F.ws + WS_MKV); const bf16* MK = (const bf16*)(F.ws + WS_MK);
    bf16* Y = (bf16*)(F.ws + WS_G);
    const long nitems = (long)NROWS * 12;
    for (long it = F.gw; it < nitems; it += F.NGW) {
        const int hb = (int)(it % 12); const int row = (int)(it / 12);
        const int b = row / TPB, j = row % TPB; const bool lat = j >= CTXL;
        if (!lat && l == NLAYER - 1) continue;
        const size_t r0 = (size_t)b * TPB;
        const int br = hb >> 2, h = hb & 3;
        bf16* y = Y + (size_t)row * 1024 + br * 256 + h * 64;
        if (br == 0) {
            attn_row_naive<96>(MQ + (size_t)row * 512 + h * 96, MK + r0 * 384 + h * 96, 384, MKV + r0 * 512 + h * 128 + 64, 512, CTXL, CTXL, lat ? TPB : CTXL, false, 0.f, y, F.lane);
        } else if (br == 1) {
            const int t = j - CTXL; int lo = CTXL, hi = CTXL;
            if (lat) { lo = CTXL + (t - 128 < 0 ? 0 : t - 128); hi = CTXL + (t + 128 > SEQ - 1 ? SEQ - 1 : t + 128) + 1; }
            attn_row_naive<64>(ZS + (size_t)row * ZS_P + ZC_SQ + h * 64, ZS + r0 * ZS_P + ZC_SK + (h >> 1) * 64, ZS_P, ZS + r0 * ZS_P + ZC_SV + (h >> 1) * 64, ZS_P, CTXL, lo, hi, true, F.in(I_SINK)[l * 4 + h] * LOG2E, y, F.lane);
        } else {
            attn_row_naive<64>(ZS + (size_t)row * ZS_P + ZC_AQ + h * 64, ZS + r0 * ZS_P + ZC_AK + (h >> 1) * 64, ZS_P, ZS + r0 * ZS_P + ZC_AV + (h >> 1) * 64, ZS_P, CTXL, CTXL, lat ? TPB : CTXL, false, 0.f, y, F.lane);
        }
    }
}

__device__ __forceinline__ void ph_lru_conv(Frame& F, int l) {
    const bf16* ZS = (const bf16*)(F.ws + WS_ZS); float* U = (float*)(F.ws + WS_U);
    const float* cw = F.in(I_CONVW) + l * 4 * 256; const float* cb = F.in(I_CONVB) + l * 256;
    const int gt = F.vcu * NTHREADS + F.tid, ngt = F.G * NTHREADS;
    for (int idx = gt; idx < NROWS * 256; idx += ngt) {
        const int row = idx >> 8, c = idx & 255, b = row / TPB, j = row % TPB;
        int s0, len, jj; if (j < CTXL) { s0 = b * TPB; len = CTXL; jj = j; } else { s0 = b * TPB + CTXL; len = SEQ; jj = j - CTXL; }
        float acc = cb[c];
#pragma unroll
        for (int i = 0; i < 4; ++i) { const int t = jj + i - 2; if (t >= 0 && t < len) acc += cw[i * 256 + c] * bf2f(ZS[(size_t)(s0 + t) * ZS_P + ZC_LRU + c]); }
        U[idx] = acc;
    }
}
__device__ __forceinline__ void ph_lru_scan(Frame& F, int l, int dir) {
    const float* U = (const float*)(F.ws + WS_U); float* HF = (float*)(F.ws + WS_HF); bf16* Y = (bf16*)(F.ws + WS_G);
    const int g = blockIdx.x * NTHREADS + F.tid;
    if (g < NB * 256) {
    const int b = g >> 8, c = g & 255, k = c >> 6, jc = c & 63;
    const float* wr = F.in(I_LWR) + ((((size_t)l * 2 + dir) * 4 + k) * 64) * 64 + jc;
    const float* wi = F.in(I_LWI) + ((((size_t)l * 2 + dir) * 4 + k) * 64) * 64 + jc;
    float wrr[64], wii[64];
#pragma unroll
    for (int i = 0; i < 64; ++i) { wrr[i] = wr[i * 64]; wii[i] = wi[i * 64]; }
    const float br = F.in(I_LBR)[(l * 2 + dir) * 256 + c], bi = F.in(I_LBI)[(l * 2 + dir) * 256 + c];
    const float lam = F.in(I_LAM)[(l * 2 + dir) * 256 + c];
    const float sp = log1pf(expf(-lam));
    float h = 0.f;
    for (int s = 0; s < TPB; ++s) {
        const int j = dir == 0 ? s : (s < CTXL ? CTXL - 1 - s : TPB + CTXL - 1 - s);
        const size_t row = (size_t)b * TPB + j;
        const float* ub = U + row * 256 + k * 64;
        float rp = br, ip = bi;
#pragma unroll
        for (int i = 0; i < 64; ++i) { const float uv = ub[i]; rp += uv * wrr[i]; ip += uv * wii[i]; }
        const float r = 1.0f / (1.0f + expf(-rp)), ig = 1.0f / (1.0f + expf(-ip));
        const float la = -8.0f * r * sp; const float a = expf(la);
        const float bx = sqrtf(-expm1f(2.0f * la)) * (ig * ub[jc]);
        h = a * h + bx;
        if (dir == 0) HF[row * 256 + c] = h;
        else { bf16* y = Y + row * 1024 + 768 + c; *y = (bf16)f2bf((HF[row * 256 + c] + h) * bf2f(*y)); }
    }
    }
}
__device__ __forceinline__ void ph_mixsum_ctx(Frame& F) {
    const bf16* S = (const bf16*)(F.ws + WS_S); bf16* MIX = (bf16*)(F.ws + WS_H);
    const int gt = F.vcu * NTHREADS + F.tid, ngt = F.G * NTHREADS;
    for (int idx = gt; idx < NB * CTXL * 128; idx += ngt) {
        const int r = idx >> 7, c8 = (idx & 127) * 8; const size_t row = (size_t)(r >> 8) * TPB + (r & 255); float s[8] = {0.f, 0.f, 0.f, 0.f, 0.f, 0.f, 0.f, 0.f};
#pragma unroll
        for (int k = 0; k < 4; ++k) { const v4u w = *(const GAS v4u*)(S + row * 4096 + k * 1024 + c8);
            s[0] += bflo(w.x); s[1] += bfhi(w.x); s[2] += bflo(w.y); s[3] += bfhi(w.y); s[4] += bflo(w.z); s[5] += bfhi(w.z); s[6] += bflo(w.w); s[7] += bfhi(w.w); }
        v4u o; o.x = pk2(s[0], s[1]); o.y = pk2(s[2], s[3]); o.z = pk2(s[4], s[5]); o.w = pk2(s[6], s[7]);
        *(GAS v4u*)(MIX + row * 1024 + c8) = o;
    }
}
namespace att {
typedef short bf16x8 __attribute__((ext_vector_type(8)));
typedef short s16x4 __attribute__((ext_vector_type(4)));
typedef short v4i16_t __attribute__((ext_vector_type(4)));
typedef float f32x16 __attribute__((ext_vector_type(16)));
typedef unsigned u32x4 __attribute__((ext_vector_type(4)));
typedef __attribute__((address_space(3))) const char* lds_cptr;
typedef float f32x2_t __attribute__((ext_vector_type(2))); typedef __bf16 bf16x2_t __attribute__((ext_vector_type(2)));
__device__ __forceinline__ int crow(int r, int hi) { return (r & 3) + 8 * (r >> 2) + 4 * hi; }
__device__ __forceinline__ void glds16(const void* gsrc, unsigned lds_dst) { unsigned keep;
    asm volatile("s_mov_b32 %0, m0\n\ts_mov_b32 m0, %2\n\ts_nop 0\n\tglobal_load_lds_dwordx4 %1, off\n\ts_mov_b32 m0, %0" : "=&s"(keep) : "v"(gsrc), "s"(lds_dst) : "memory"); }
__device__ __forceinline__ unsigned cvtpk(float lo, float hi) { f32x2_t v = {lo, hi}; bf16x2_t b = __builtin_convertvector(v, bf16x2_t); return __builtin_bit_cast(unsigned, b); }
__device__ __forceinline__ s16x4 vtr(lds_cptr p) { return __builtin_bit_cast(s16x4, __builtin_amdgcn_ds_read_tr16_b64_v4i16((__attribute__((address_space(3))) v4i16_t*)p)); }
__device__ __forceinline__ float halfswap_max(float m) { auto rr = __builtin_amdgcn_permlane32_swap(__float_as_uint(m), __float_as_uint(m), false, false); return fmaxf(__uint_as_float(rr[0]), __uint_as_float(rr[1])); }
__device__ __forceinline__ float halfswap_sum(float m) { auto rr = __builtin_amdgcn_permlane32_swap(__float_as_uint(m), __float_as_uint(m), false, false); return __uint_as_float(rr[0]) + __uint_as_float(rr[1]); }

template <int DQK> struct Cfg {
    static constexpr int KCH = DQK / 8, KSLOT = KCH * 1024, NKI = (KCH + 7) / 8, NI = NKI + 1;
    static constexpr int LDS_K = 0, LDS_V = 3 * KSLOT, LDS_WS = LDS_V + 3 * 8192, LDS_OST = LDS_WS + 8 * 256, BYTES = LDS_OST + 8 * 4096;
};
#define ATT_WAIT_BAR(N) asm volatile("s_waitcnt vmcnt(" #N ") lgkmcnt(0)\n\ts_barrier" ::: "memory")

struct UnitDesc {
    const unsigned short* Q; int qp;
    const unsigned short* K; int kp;
    const unsigned short* V; int vp;
    unsigned short* Y;
    int NT;
    int lat_row0;
    int qpos0, spos0;
    int has_sink; float sink2;
};

template <int DQK, bool SWA>
__device__ __forceinline__ void attn_unit(LAS unsigned char* ldsb, const UnitDesc& U, const int tid) {
    using C = Cfg<DQK>;
    const int lane = tid & 63, r32 = lane & 31, hi = lane >> 5; const int wid = __builtin_amdgcn_readfirstlane(tid >> 6);
    const unsigned lds0 = (unsigned)(uintptr_t)ldsb;
    LAS float* wsf = (LAS float*)(ldsb + C::LDS_WS) + wid * 64;
    const int kp = U.kp, vp = U.vp;
    const int kc1 = (C::NKI == 2 && wid < 4) ? wid + 8 : wid;
    const unsigned short* ksrc0 = U.K + (size_t)lane * kp + wid * 8;
    const unsigned short* ksrc1 = U.K + (size_t)lane * kp + kc1 * 8;
    const unsigned short* vsrc = U.V + (size_t)(16 * (wid & 3) + (lane >> 2)) * vp + (wid >> 2) * 32 + (lane & 3) * 8;
    const unsigned kdst0 = lds0 + C::LDS_K + wid * 1024, kdst1 = lds0 + C::LDS_K + kc1 * 1024, vdst = lds0 + C::LDS_V + wid * 1024;
    const int NT = U.NT;
#define ATT_KROW(t) (SWA ? ((t) < 4 ? 64 * (t) : U.lat_row0 + 64 * ((t) - 4)) : 64 * (t))
#define ATT_DMA_K(t, slot) do { const size_t ro_ = (size_t)ATT_KROW(t); \
        glds16(ksrc0 + ro_ * kp, (unsigned)__builtin_amdgcn_readfirstlane(kdst0 + (slot) * C::KSLOT)); \
        if (C::NKI == 2) glds16(ksrc1 + ro_ * kp, (unsigned)__builtin_amdgcn_readfirstlane(kdst1 + (slot) * C::KSLOT)); } while (0)
#define ATT_DMA_V(t, slot) do { const size_t ro_ = (size_t)ATT_KROW(t); glds16(vsrc + ro_ * vp, (unsigned)__builtin_amdgcn_readfirstlane(vdst + (slot) * 8192)); } while (0)
#define ATT_KLOAD(kslot) do { if (!SWA) { const lds_cptr kb_ = (lds_cptr)(ldsb + C::LDS_K) + (kslot) * C::KSLOT + hi * 1024 + r32 * 16; \
        _Pragma("unroll") for (int d0 = 0; d0 < DQK / 16; ++d0) { kf[2 * d0] = *(const __attribute__((address_space(3))) bf16x8*)(kb_ + d0 * 2048); kf[2 * d0 + 1] = *(const __attribute__((address_space(3))) bf16x8*)(kb_ + d0 * 2048 + 512); } } } while (0)
#define ATT_QKM(P0, P1, CINIT, kslot) do { P0 = f32x16{}; P1 = f32x16{}; \
        const lds_cptr kq_ = (lds_cptr)(ldsb + C::LDS_K) + (kslot) * C::KSLOT + hi * 1024 + r32 * 16; \
        _Pragma("unroll") for (int d0 = 0; d0 < DQK / 16; ++d0) { \
            const bf16x8 b0_ = SWA ? *(const __attribute__((address_space(3))) bf16x8*)(kq_ + d0 * 2048) : kf[2 * d0]; const bf16x8 b1_ = SWA ? *(const __attribute__((address_space(3))) bf16x8*)(kq_ + d0 * 2048 + 512) : kf[2 * d0 + 1]; \
            P0 = __builtin_amdgcn_mfma_f32_32x32x16_bf16(b0_, qr[d0], P0, 0, 0, 0); P1 = __builtin_amdgcn_mfma_f32_32x32x16_bf16(b1_, qr[d0], P1, 0, 0, 0); } } while (0)
#define ATT_VLOAD(vslot) do { if (!SWA) { const lds_cptr vb_ = (lds_cptr)(ldsb + C::LDS_V) + (vslot) * 8192 + ((lane >> 4) & 1) * 32 + (lane & 3) * 8 + (4 * hi + ((lane & 15) >> 2)) * 64; \
        _Pragma("unroll") for (int i = 0; i < 8; ++i) { vl[i] = vtr(vb_ + (i >> 2) * 4096 + (i & 3) * 1024); vh[i] = vtr(vb_ + (i >> 2) * 4096 + (i & 3) * 1024 + 512); } } } while (0)
#define ATT_MX3(a, b, c) __builtin_fmaxf(__builtin_fmaxf((a), (b)), (c))
#define ATT_NEEDMASK(j) ((j) >= 4 && U.qpos0 >= 0 && !((U.spos0 + 64 * ((j) - 4) + 63 - (U.qpos0 + 32 * wid) <= 128) && ((U.qpos0 + 32 * wid + 31) - (U.spos0 + 64 * ((j) - 4)) <= 128)))
#define ATT_SMPV(P0, P1, N0, N1, HASNEXT, t, vslot) do { \
        if (SWA && ATT_NEEDMASK(t)) { const bool mk_ = true; const int sb_ = U.spos0 + 64 * ((t) - 4) + 4 * hi;        \
            _Pragma("unroll") for (int r = 0; r < 16; ++r) { const int dd_ = qpos - (sb_ + (r & 3) + 8 * (r >> 2)); \
                P0[r] = (mk_ && (dd_ > 128 || dd_ < -128)) ? -INFINITY : P0[r]; P1[r] = (mk_ && (dd_ - 32 > 128 || dd_ - 32 < -128)) ? -INFINITY : P1[r]; } } \
        float ls_ = 0.f; \
        _Pragma("unroll") for (int r = 0; r < 16; ++r) { P0[r] = __builtin_amdgcn_exp2f(P0[r]); P1[r] = __builtin_amdgcn_exp2f(P1[r]); ls_ += P0[r] + P1[r]; } \
        l += ls_; \
        if (!SWA && DQK != 64) { __builtin_amdgcn_sched_barrier(0); ATT_VLOAD(vslot); } \
        u32x4 pw_[4]; \
        pw_[0] = (u32x4){cvtpk(P0[0], P0[1]), cvtpk(P0[2], P0[3]), cvtpk(P0[4], P0[5]), cvtpk(P0[6], P0[7])}; \
        pw_[1] = (u32x4){cvtpk(P0[8], P0[9]), cvtpk(P0[10], P0[11]), cvtpk(P0[12], P0[13]), cvtpk(P0[14], P0[15])}; \
        pw_[2] = (u32x4){cvtpk(P1[0], P1[1]), cvtpk(P1[2], P1[3]), cvtpk(P1[4], P1[5]), cvtpk(P1[6], P1[7])}; \
        pw_[3] = (u32x4){cvtpk(P1[8], P1[9]), cvtpk(P1[10], P1[11]), cvtpk(P1[12], P1[13]), cvtpk(P1[14], P1[15])}; \
        const lds_cptr vq_ = (lds_cptr)(ldsb + C::LDS_V) + (vslot) * 8192 + ((lane >> 4) & 1) * 32 + (lane & 3) * 8 + (4 * hi + ((lane & 15) >> 2)) * 64; \
        _Pragma("unroll") for (int d0 = 0; d0 < 2; ++d0) \
            _Pragma("unroll") for (int ks = 0; ks < 4; ++ks) { \
                const s16x4 lo_ = SWA ? vtr(vq_ + d0 * 4096 + ks * 1024) : vl[4 * d0 + ks], hh_ = SWA ? vtr(vq_ + d0 * 4096 + ks * 1024 + 512) : vh[4 * d0 + ks]; \
                const bf16x8 vf_ = (bf16x8){lo_[0], lo_[1], lo_[2], lo_[3], hh_[0], hh_[1], hh_[2], hh_[3]}; \
                o[d0] = __builtin_amdgcn_mfma_f32_32x32x16_bf16(__builtin_bit_cast(bf16x8, pw_[ks]), vf_, o[d0], 0, 0, 0); } } while (0)
#define ATT_SKIP(j) (SWA && (j) >= 4 && U.qpos0 >= 0 && ((U.spos0 + 64 * ((j) - 4) > U.qpos0 + 32 * wid + 31 + 128) || (U.spos0 + 64 * ((j) - 4) + 63 < U.qpos0 + 32 * wid - 128)))
#define ATT_STEP(C0, C1, N0, N1, t) do { \
        const int k3_ = (ks1 == 0) ? 2 : ks1 - 1, v2_ = (vs0 == 0) ? 2 : vs0 - 1; \
        if ((t) + 3 < NT) ATT_DMA_K((t) + 3, k3_); \
        if ((t) + 2 < NT) ATT_DMA_V((t) + 2, v2_); \
        ATT_KLOAD(ks1); \
        if (!SWA) __builtin_amdgcn_sched_barrier(0);        \
        if (!SWA || !ATT_SKIP((t) + 1)) ATT_QKM(N0, N1, -m, ks1); \
        if (DQK == 64) ATT_VLOAD(vs0);        \
        if (!SWA) __builtin_amdgcn_sched_barrier(0); \
        if (!SWA || !ATT_SKIP(t)) ATT_SMPV(C0, C1, N0, N1, true, t, vs0); \
        if ((t) + 3 < NT) { if (C::NI == 2) ATT_WAIT_BAR(2); else ATT_WAIT_BAR(3); } else ATT_WAIT_BAR(0); \
        ks1 = (ks1 == 2) ? 0 : ks1 + 1; vs0 = (vs0 == 2) ? 0 : vs0 + 1; } while (0)
    ATT_DMA_K(0, 0);
    ATT_DMA_K(1, 1); ATT_DMA_V(0, 0);
    ATT_DMA_K(2, 2); ATT_DMA_V(1, 1);
    bf16x8 qr[DQK / 16];
    { const unsigned short* qw = U.Q + (size_t)(wid * 32 + r32) * U.qp + hi * 8;
#pragma unroll
      for (int d0 = 0; d0 < DQK / 16; ++d0) qr[d0] = *(const bf16x8*)(qw + d0 * 16); }
    const float m = 0.f; float l = 0.f;
    f32x16 o[2]; o[0] = f32x16{}; o[1] = f32x16{};
    const int qpos = U.qpos0 + wid * 32 + r32;
    f32x16 pa0, pa1, pb0, pb1;
    bf16x8 kf[DQK / 8]; s16x4 vl[8], vh[8];
    if (C::NI == 2) ATT_WAIT_BAR(4); else ATT_WAIT_BAR(6);
    ATT_KLOAD(0); ATT_QKM(pa0, pa1, 0.f, 0);
    if (C::NI == 2) ATT_WAIT_BAR(2); else ATT_WAIT_BAR(3);
    int ks1 = 1, vs0 = 0;
    int t = 0;
    if (SWA) { for (; t + 1 < NT; ++t) { ATT_STEP(pa0, pa1, pb0, pb1, t); pa0 = pb0; pa1 = pb1; } if (!ATT_SKIP(NT - 1)) ATT_SMPV(pa0, pa1, pa0, pa1, false, NT - 1, vs0); }
    else {
    for (; t + 2 < NT; t += 2) { ATT_STEP(pa0, pa1, pb0, pb1, t); ATT_STEP(pb0, pb1, pa0, pa1, t + 1); }
    if (t + 1 < NT) { ATT_STEP(pa0, pa1, pb0, pb1, t); if (DQK == 64) ATT_VLOAD(vs0); ATT_SMPV(pb0, pb1, pb0, pb1, false, NT - 1, vs0); }
    else { if (DQK == 64) ATT_VLOAD(vs0); ATT_SMPV(pa0, pa1, pa0, pa1, false, NT - 1, vs0); }
    }
    l = halfswap_sum(l);
    if (U.has_sink) l += __builtin_amdgcn_exp2f(U.sink2 - m);
    if (hi == 0) wsf[32 + r32] = l;
    asm volatile("s_waitcnt lgkmcnt(0)" ::: "memory");
    { LAS unsigned short* stg = (LAS unsigned short*)(ldsb + C::LDS_OST) + wid * 2048;
#pragma unroll
      for (int r = 0; r < 16; ++r) { const int orow = crow(r, hi); const float rl = __builtin_amdgcn_rcpf(wsf[32 + orow]);
          stg[orow * 64 + r32] = (unsigned short)f2bf(o[0][r] * rl); stg[orow * 64 + 32 + r32] = (unsigned short)f2bf(o[1][r] * rl); }
      asm volatile("s_waitcnt lgkmcnt(0)" ::: "memory");
      unsigned short* yw = U.Y + (size_t)(wid * 32) * 1024;
#pragma unroll
      for (int i = 0; i < 4; ++i) { const int row = i * 8 + (lane >> 3), ch = lane & 7;
          const u32x4 ov = *(const LAS u32x4*)(stg + row * 64 + ch * 8);
          u32x4* gp = (u32x4*)(yw + (size_t)row * 1024 + ch * 8); const u32x4 g = *gp;
          u32x4 w; w.x = pk2(bflo(ov.x) * bflo(g.x), bfhi(ov.x) * bfhi(g.x)); w.y = pk2(bflo(ov.y) * bflo(g.y), bfhi(ov.y) * bfhi(g.y));
          w.z = pk2(bflo(ov.z) * bflo(g.z), bfhi(ov.z) * bfhi(g.z)); w.w = pk2(bflo(ov.w) * bflo(g.w), bfhi(ov.w) * bfhi(g.w));
          *gp = w; } }
    asm volatile("s_waitcnt vmcnt(0) lgkmcnt(0)\n\ts_barrier" ::: "memory");
#undef ATT_KROW
#undef ATT_DMA_K
#undef ATT_DMA_V
#undef ATT_KLOAD
#undef ATT_QKM
#undef ATT_VLOAD
#undef ATT_STEP
#undef ATT_SKIP
#undef ATT_SMPV
#undef ATT_MX3
#undef ATT_NEEDMASK
}

template <int DQK>
__device__ __forceinline__ void attn_unit_d(LAS unsigned char* ldsb, const UnitDesc& U, const int tid) {
    using C = Cfg<DQK>;
    constexpr int KP = (DQK == 64) ? 128 : 256, KSL = 64 * KP, SPR = KP / 16, RPP = 1024 / KP, NKI = KSL / 8192;
    static_assert(NKI == C::NKI, "K DMA count");
    constexpr int LDS_WS = 0, LDS_K = 2048, LDS_V = LDS_K + 3 * KSL, LDS_END = LDS_V + 3 * 8192, LDS_X = 2048, LDS_STG = LDS_X + 65536;
    static_assert(LDS_END <= RING_BYTES && LDS_STG + 8 * 4096 <= RING_BYTES, "attention LDS");
    const int lane = tid & 63, r32 = lane & 31, hi = lane >> 5; const int wid = __builtin_amdgcn_readfirstlane(tid >> 6); const int rg = wid & 3, kh = wid >> 2;
    const unsigned lds0 = (unsigned)(uintptr_t)ldsb;
    const int kp = U.kp, vp = U.vp;
    const unsigned short* ksrc0; const unsigned short* ksrc1;
    { const int ra = wid * RPP + lane / SPR, sa = lane % SPR, fa = (KP == 128) ? ((ra >> 1) & 7) : (ra & 15); int ca = sa ^ fa; if (ca >= DQK / 8) ca = 0;
      ksrc0 = U.K + (size_t)ra * kp + ca * 8;
      const int rb = (wid + 8) * RPP + lane / SPR, fb = (KP == 128) ? ((rb >> 1) & 7) : (rb & 15); int cb = sa ^ fb; if (cb >= DQK / 8) cb = 0;
      ksrc1 = U.K + (size_t)(NKI == 2 ? rb : ra) * kp + (NKI == 2 ? cb : ca) * 8; }
    const unsigned short* vsrc = U.V + (size_t)(16 * (wid & 3) + (lane >> 2)) * vp + (wid >> 2) * 32 + (lane & 3) * 8;
    const unsigned kdst0 = lds0 + LDS_K + wid * 1024, kdst1 = lds0 + LDS_K + (wid + 8) * 1024, vdst = lds0 + LDS_V + wid * 1024;
    const int NT = U.NT;
#define ATD_DMA(t, slot) do { const size_t ro_ = (size_t)64 * (t); \
        glds16(ksrc0 + ro_ * kp, (unsigned)__builtin_amdgcn_readfirstlane(kdst0 + (slot) * KSL)); \
        if (NKI == 2) glds16(ksrc1 + ro_ * kp, (unsigned)__builtin_amdgcn_readfirstlane(kdst1 + (slot) * KSL)); \
        glds16(vsrc + ro_ * vp, (unsigned)__builtin_amdgcn_readfirstlane(vdst + (slot) * 8192)); } while (0)
    ATD_DMA(0, 0); ATD_DMA(1, 1);
    bf16x8 qr[2][DQK / 16];
    { const unsigned short* qw = U.Q + (size_t)(rg * 64 + r32) * U.qp + hi * 8;
#pragma unroll
      for (int qb = 0; qb < 2; ++qb)
#pragma unroll
          for (int d0 = 0; d0 < DQK / 16; ++d0) qr[qb][d0] = *(const bf16x8*)(qw + (size_t)(qb * 32) * U.qp + d0 * 16); }
    f32x16 o[2][2]; o[0][0] = f32x16{}; o[0][1] = f32x16{}; o[1][0] = f32x16{}; o[1][1] = f32x16{};
    float l0 = 0.f, l1 = 0.f, l0b = 0.f, l1b = 0.f; u32x4 pp[4]; pp[0] = pp[1] = pp[2] = pp[3] = (u32x4){0u, 0u, 0u, 0u};
    if (C::NI == 2) ATT_WAIT_BAR(2); else ATT_WAIT_BAR(3);
#pragma unroll
    for (int qb = 0; qb < 2; ++qb)
#pragma unroll
        for (int d0 = 0; d0 < DQK / 16; ++d0) asm volatile("" : "+v"(qr[qb][d0]));
    const int krow = 32 * kh + r32, kfx = ((KP == 128) ? ((krow >> 1) & 7) : (krow & 15)) ^ hi;
    const unsigned kb0 = (unsigned)(uintptr_t)(ldsb + LDS_K) + krow * KP + kfx * 16;
    const lds_cptr vbase = (lds_cptr)(ldsb + LDS_V) + kh * 2048 + ((lane >> 4) & 1) * 32 + (lane & 3) * 8 + (4 * hi + ((lane & 15) >> 2)) * 64;
#define ATD_DOT(acc, w) acc = __builtin_amdgcn_fdot2_f32_bf16(__builtin_bit_cast(bf16x2_t, (w)), __builtin_bit_cast(bf16x2_t, 0x3f803f80u), acc, false)
#define ATD_SUM4(LA, LB, W) do { ATD_DOT(LA, W.x); ATD_DOT(LB, W.y); ATD_DOT(LA, W.z); ATD_DOT(LB, W.w); } while (0)
#define ATD_SMPV(S, PW0, PW1, OA, OB) do { \
        _Pragma("unroll") for (int r = 0; r < 16; ++r) S[r] = __builtin_amdgcn_exp2f(S[r]); \
        PW0 = (u32x4){cvtpk(S[0], S[1]), cvtpk(S[2], S[3]), cvtpk(S[4], S[5]), cvtpk(S[6], S[7])}; \
        PW1 = (u32x4){cvtpk(S[8], S[9]), cvtpk(S[10], S[11]), cvtpk(S[12], S[13]), cvtpk(S[14], S[15])}; \
        OA = __builtin_amdgcn_mfma_f32_32x32x16_bf16(__builtin_bit_cast(bf16x8, PW0), vf[0][0], OA, 0, 0, 0); OB = __builtin_amdgcn_mfma_f32_32x32x16_bf16(__builtin_bit_cast(bf16x8, PW0), vf[1][0], OB, 0, 0, 0); \
        OA = __builtin_amdgcn_mfma_f32_32x32x16_bf16(__builtin_bit_cast(bf16x8, PW1), vf[0][1], OA, 0, 0, 0); OB = __builtin_amdgcn_mfma_f32_32x32x16_bf16(__builtin_bit_cast(bf16x8, PW1), vf[1][1], OB, 0, 0, 0); } while (0)
    int s = 0;
#pragma unroll 1
    for (int t = 0; t < NT; ++t) {
        const int s2 = (s == 0) ? 2 : s - 1;
        if (t + 2 < NT) ATD_DMA(t + 2, s2);
        bf16x8 kf[DQK / 16], vf[2][2];
        {
#pragma unroll
          for (int d0 = 0; d0 < DQK / 16; ++d0) kf[d0] = *(const __attribute__((address_space(3))) bf16x8*)(uintptr_t)((kb0 ^ (unsigned)(32 * d0)) + (unsigned)(s * KSL)); }
        { const lds_cptr vb_ = vbase + s * 8192;
#pragma unroll
          for (int d0 = 0; d0 < 2; ++d0)
#pragma unroll
              for (int ks = 0; ks < 2; ++ks) { const s16x4 lo_ = vtr(vb_ + d0 * 4096 + ks * 1024), hh_ = vtr(vb_ + d0 * 4096 + ks * 1024 + 512);
                  vf[d0][ks] = (bf16x8){lo_[0], lo_[1], lo_[2], lo_[3], hh_[0], hh_[1], hh_[2], hh_[3]}; } }
        f32x16 S0 = f32x16{}, S1 = f32x16{};
#pragma unroll
        for (int d0 = 0; d0 < DQK / 16; ++d0) S0 = __builtin_amdgcn_mfma_f32_32x32x16_bf16(kf[d0], qr[0][d0], S0, 0, 0, 0);
#pragma unroll
        for (int d0 = 0; d0 < DQK / 16; ++d0) S1 = __builtin_amdgcn_mfma_f32_32x32x16_bf16(kf[d0], qr[1][d0], S1, 0, 0, 0);
        ATD_SUM4(l0, l0b, pp[0]); ATD_SUM4(l0, l0b, pp[1]); ATD_SUM4(l1, l1b, pp[2]); ATD_SUM4(l1, l1b, pp[3]);
        __builtin_amdgcn_sched_barrier(0);
        ATD_SMPV(S0, pp[0], pp[1], o[0][0], o[0][1]);
        ATD_SMPV(S1, pp[2], pp[3], o[1][0], o[1][1]);
        if (t + 2 < NT) { if (C::NI == 2) ATT_WAIT_BAR(2); else ATT_WAIT_BAR(3); } else ATT_WAIT_BAR(0);
        s = (s == 2) ? 0 : s + 1;
    }
    LAS float* wl = (LAS float*)(ldsb + LDS_WS);
    LAS float* X = (LAS float*)(ldsb + LDS_X);
    ATD_SUM4(l0, l0b, pp[0]); ATD_SUM4(l0, l0b, pp[1]); ATD_SUM4(l1, l1b, pp[2]); ATD_SUM4(l1, l1b, pp[3]); l0 += l0b; l1 += l1b;
    const float lkeep = halfswap_sum(kh ? l1 : l0), lsend = halfswap_sum(kh ? l0 : l1);
    f32x16 ok0 = kh ? o[1][0] : o[0][0], ok1 = kh ? o[1][1] : o[0][1]; const f32x16 os0 = kh ? o[0][0] : o[1][0], os1 = kh ? o[0][1] : o[1][1];
    { LAS float* xs = X + wid * 2048 + lane;
#pragma unroll
      for (int r = 0; r < 16; ++r) { xs[r * 64] = os0[r]; xs[(16 + r) * 64] = os1[r]; }
      if (hi == 0) wl[wid * 64 + r32] = lsend; }
    asm volatile("s_waitcnt lgkmcnt(0)\n\ts_barrier" ::: "memory");
    { const LAS float* xr = X + (wid ^ 4) * 2048 + lane;
#pragma unroll
      for (int r = 0; r < 16; ++r) { ok0[r] += xr[r * 64]; ok1[r] += xr[(16 + r) * 64]; }
      const float lt = lkeep + wl[(wid ^ 4) * 64 + r32];
      if (hi == 0) wl[wid * 64 + 32 + r32] = lt; }
    asm volatile("s_waitcnt lgkmcnt(0)" ::: "memory");
    { LAS unsigned short* stg = (LAS unsigned short*)(ldsb + LDS_STG) + wid * 2048;
      const LAS float* lt = wl + wid * 64 + 32;
#pragma unroll
      for (int r = 0; r < 16; ++r) { const int orow = crow(r, hi); const float rl = __builtin_amdgcn_rcpf(lt[orow]);
          stg[orow * 64 + r32] = (unsigned short)f2bf(ok0[r] * rl); stg[orow * 64 + 32 + r32] = (unsigned short)f2bf(ok1[r] * rl); }
      asm volatile("s_waitcnt lgkmcnt(0)" ::: "memory");
      unsigned short* yw = U.Y + (size_t)(rg * 64 + kh * 32) * 1024;
#pragma unroll
      for (int i = 0; i < 4; ++i) { const int row = i * 8 + (lane >> 3), ch = lane & 7;
          const u32x4 ov = *(const LAS u32x4*)(stg + row * 64 + ch * 8);
          u32x4* gp = (u32x4*)(yw + (size_t)row * 1024 + ch * 8); const u32x4 g = *gp;
          u32x4 w; w.x = pk2(bflo(ov.x) * bflo(g.x), bfhi(ov.x) * bfhi(g.x)); w.y = pk2(bflo(ov.y) * bflo(g.y), bfhi(ov.y) * bfhi(g.y));
          w.z = pk2(bflo(ov.z) * bflo(g.z), bfhi(ov.z) * bfhi(g.z)); w.w = pk2(bflo(ov.w) * bflo(g.w), bfhi(ov.w) * bfhi(g.w));
          *gp = w; } }
    asm volatile("s_waitcnt vmcnt(0) lgkmcnt(0)\n\ts_barrier" ::: "memory");
#undef ATD_DMA
#undef ATD_SMPV
#undef ATD_DOT
#undef ATD_SUM4
}
}

__device__ __forceinline__ void ph_attn(Frame& F, int l) {
    unsigned short* ZS = (unsigned short*)(F.ws + WS_ZS); unsigned short* MQ = (unsigned short*)(F.ws + WS_MQ); unsigned short* MKV = (unsigned short*)(F.ws + WS_MKV); unsigned short* MK = (unsigned short*)(F.ws + WS_MK);
    unsigned short* Y = (unsigned short*)(F.ws + WS_G);
    LAS unsigned char* lds = F.lds + RING_OFF;
    const int u = F.vcu;
    const bool ctxq = (l == 0);
    for (int uu = u; uu < 256; uu += F.G) { const int bh = uu >> 4, qb = uu & 15, b = bh >> 2, h = bh & 3; const size_t r0 = (size_t)b * TPB, rq = r0 + CTXL + qb * 256;
        att::UnitDesc U{MQ + rq * 512 + h * 96, 512, MK + r0 * 384 + h * 96, 384, MKV + r0 * 512 + h * 128 + 64, 512, Y + rq * 1024 + h * 64, TPB / 64, 0, -1, 0, 0, 0.f};
        { int tu_ = F.tid; asm volatile("" : "+v"(tu_)); att::attn_unit_d<96>(lds, U, tu_); } }
    for (int uu = u; uu < 256; uu += F.G) { const int qb = uu & 15, g = (uu >> 4) & 1, kvh = (uu >> 5) & 1, b = uu >> 6, qh = kvh * 2 + g; const size_t r0 = (size_t)b * TPB, rq = r0 + CTXL + qb * 256;
        att::UnitDesc U{ZS + rq * ZS_P + ZC_AQ + qh * 64, ZS_P, ZS + r0 * ZS_P + ZC_AK + kvh * 64, ZS_P, ZS + r0 * ZS_P + ZC_AV + kvh * 64, ZS_P, Y + rq * 1024 + 512 + qh * 64, TPB / 64, 0, -1, 0, 0, 0.f};
        { int tu_ = F.tid; asm volatile("" : "+v"(tu_)); att::attn_unit_d<64>(lds, U, tu_); } }
    for (int uu = u; uu < 256; uu += F.G) { const int qb = uu & 15, g = (uu >> 4) & 1, kvh = (uu >> 5) & 1, b = uu >> 6, qh = kvh * 2 + g; const size_t r0 = (size_t)b * TPB, rq = r0 + CTXL + qb * 256;
        const int q0 = qb * 256, s0 = (q0 - 128 < 0) ? 0 : q0 - 128, s1 = (q0 + 384 > SEQ) ? SEQ : q0 + 384;
        att::UnitDesc U{ZS + rq * ZS_P + ZC_SQ + qh * 64, ZS_P, ZS + r0 * ZS_P + ZC_SK + kvh * 64, ZS_P, ZS + r0 * ZS_P + ZC_SV + kvh * 64, ZS_P, Y + rq * 1024 + 256 + qh * 64, 4 + (s1 - s0) / 64, CTXL + s0, q0, s0, 1, F.in(I_SINK)[l * 4 + qh] * LOG2E};
        att::attn_unit<64, true>(lds, U, F.tid); }
    if (ctxq) for (int uu = u; uu < 48; uu += F.G) { const int br = uu >> 4, b = (uu >> 2) & 3, h = uu & 3; const size_t r0 = (size_t)b * TPB;
        if (br == 0) { att::UnitDesc U{MQ + r0 * 512 + h * 96, 512, MK + r0 * 384 + h * 96, 384, MKV + r0 * 512 + h * 128 + 64, 512, Y + r0 * 1024 + h * 64, 4, 0, -1, 0, 0, 0.f};
            { int tu_ = F.tid; asm volatile("" : "+v"(tu_)); att::attn_unit_d<96>(lds, U, tu_); } }
        else if (br == 1) { att::UnitDesc U{ZS + r0 * ZS_P + ZC_SQ + h * 64, ZS_P, ZS + r0 * ZS_P + ZC_SK + (h >> 1) * 64, ZS_P, ZS + r0 * ZS_P + ZC_SV + (h >> 1) * 64, ZS_P, Y + r0 * 1024 + 256 + h * 64, 4, CTXL, -1, 0, 1, F.in(I_SINK)[l * 4 + h] * LOG2E};
            att::attn_unit<64, true>(lds, U, F.tid); }
        else { att::UnitDesc U{ZS + r0 * ZS_P + ZC_AQ + h * 64, ZS_P, ZS + r0 * ZS_P + ZC_AK + (h >> 1) * 64, ZS_P, ZS + r0 * ZS_P + ZC_AV + (h >> 1) * 64, ZS_P, Y + r0 * 1024 + 512 + h * 64, 4, 0, -1, 0, 0, 0.f};
            { int tu_ = F.tid; asm volatile("" : "+v"(tu_)); att::attn_unit_d<64>(lds, U, tu_); } } }
}
constexpr size_t WS_SUM = 253 * MiB;
constexpr size_t WS_HL = WS_U, WS_CP = WS_HF;
constexpr int NCHUNK = TPB / 64;
__device__ __forceinline__ float swap_lo(float x) { auto rr = __builtin_amdgcn_permlane32_swap(__float_as_uint(x), __float_as_uint(x), false, false); return __uint_as_float(rr[0]); }
__device__ __forceinline__ float swap_hi(float x) { auto rr = __builtin_amdgcn_permlane32_swap(__float_as_uint(x), __float_as_uint(x), false, false); return __uint_as_float(rr[1]); }
__device__ __forceinline__ void ph_lru1(Frame& F, int l) {
    typedef short bf16x8 __attribute__((ext_vector_type(8))); typedef float f32x16 __attribute__((ext_vector_type(16)));
    const unsigned short* ZS = (const unsigned short*)(F.ws + WS_ZS); unsigned short* HL = (unsigned short*)(F.ws + WS_HL); unsigned short* CP = (unsigned short*)(F.ws + WS_CP);
    f32x2v* SUM = (f32x2v*)(F.ws + WS_SUM);
    constexpr int UP = 264;
    LAS unsigned short* ul = (LAS unsigned short*)(F.lds + RING_OFF);
    const float* cw = F.in(I_CONVW) + l * 4 * 256; const float* cb = F.in(I_CONVB) + l * 256;
    const int tid = F.tid, lane = tid & 63, r32 = lane & 31, hi = lane >> 5, k = F.wave & 3, d = F.wave >> 2;
    const int nfull = (NB * NCHUNK < F.G) ? NB * NCHUNK : F.G, nhalf = 2 * (NB * NCHUNK - nfull);
    for (int wi = F.vcu; wi < nfull + nhalf; wi += F.G) {
        const int unit = (wi < nfull) ? wi : nfull + ((wi - nfull) >> 1);
        const int tn_lo = (wi < nfull) ? 0 : ((wi - nfull) & 1), tn_hi = (wi < nfull) ? 2 : tn_lo + 1;
        const int b = unit / NCHUNK, ci = unit % NCHUNK;
        int s0row, len, t0; if (ci < 4) { s0row = b * TPB; len = CTXL; t0 = ci * 64; } else { s0row = b * TPB + CTXL; len = SEQ; t0 = (ci - 4) * 64; }
        { const int cc = tid & 255, hh = tid >> 8; float zv[35];
#pragma unroll
          for (int i = 0; i < 35; ++i) { const int tt = t0 + hh * 32 + i - 2; const int tc = tt < 0 ? 0 : (tt >= len ? len - 1 : tt);
              const float v = bf2f(ZS[(size_t)(s0row + tc) * ZS_P + ZC_LRU + cc]); zv[i] = (tt >= 0 && tt < len) ? v : 0.f; }
          const float w0 = cw[cc], w1 = cw[256 + cc], w2 = cw[512 + cc], w3 = cw[768 + cc], bb = cb[cc];
#pragma unroll
          for (int t = 0; t < 32; ++t) ul[(hh * 32 + t) * UP + cc] = (unsigned short)f2bf(bb + w0 * zv[t] + w1 * zv[t + 1] + w2 * zv[t + 2] + w3 * zv[t + 3]); }
        __syncthreads();
#pragma unroll 1
        for (int tn = tn_lo; tn < tn_hi; ++tn) {
            const int c = k * 64 + 32 * tn + r32;
            bf16x8 wf[2][4];
            const float brv = F.in(I_LBR)[(l * 2 + d) * 256 + c], biv = F.in(I_LBI)[(l * 2 + d) * 256 + c], spv = ((const float*)(F.ws + WS_SP))[(l * 2 + d) * 256 + c];
#pragma unroll
            for (int gate = 0; gate < 2; ++gate)
#pragma unroll
                for (int ks = 0; ks < 4; ++ks) { const float* src = (const float*)(F.ws + WS_LWT) + ((((size_t)l * 2 + d) * 2 + gate) * 256 + c) * 64 + 16 * ks + 8 * hi;
                    const f32x4 a = *(const f32x4*)src, b2 = *(const f32x4*)(src + 4);
                    v4u w; w.x = pk2(a.x, a.y); w.y = pk2(a.z, a.w); w.z = pk2(b2.x, b2.y); w.w = pk2(b2.z, b2.w); wf[gate][ks] = __builtin_bit_cast(bf16x8, w); }
            f32x16 A[2], X[2];
            A[0] = f32x16{}; A[1] = f32x16{}; X[0] = f32x16{}; X[1] = f32x16{};
#pragma unroll
            for (int tm = 0; tm < 2; ++tm)
#pragma unroll
                for (int ks = 0; ks < 4; ++ks) { const bf16x8 af = *(const LAS bf16x8*)(ul + (32 * tm + r32) * UP + k * 64 + 16 * ks + 8 * hi);
                    A[tm] = __builtin_amdgcn_mfma_f32_32x32x16_bf16(af, wf[0][ks], A[tm], 0, 0, 0); X[tm] = __builtin_amdgcn_mfma_f32_32x32x16_bf16(af, wf[1][ks], X[tm], 0, 0, 0); }
#pragma unroll
            for (int tm = 0; tm < 2; ++tm)
#pragma unroll
                for (int r = 0; r < 16; ++r) { const int tok = 32 * tm + (r & 3) + 8 * (r >> 2) + 4 * hi; const float uu = bf2f(ul[tok * UP + c]);
                    const float rr = sigmoid_f(A[tm][r] + brv), ii = sigmoid_f(X[tm][r] + biv);
                    const float a = __builtin_amdgcn_exp2f(-rr * spv); A[tm][r] = a; X[tm][r] = __builtin_amdgcn_sqrtf(1.0f - a * a) * (ii * uu);
                    if ((r & 3) == 3) asm volatile("" ::: "memory"); }
#pragma unroll
            for (int tm = 0; tm < 2; ++tm)
#pragma unroll
                for (int rg = 0; rg < 4; ++rg) { const int r0 = 4 * rg;
                    if (d == 0) {
#pragma unroll
                        for (int e2 = 1; e2 < 4; ++e2) { X[tm][r0 + e2] = A[tm][r0 + e2] * X[tm][r0 + e2 - 1] + X[tm][r0 + e2]; A[tm][r0 + e2] = A[tm][r0 + e2] * A[tm][r0 + e2 - 1]; } }
                    else {
#pragma unroll
                        for (int e2 = 2; e2 >= 0; --e2) { X[tm][r0 + e2] = A[tm][r0 + e2] * X[tm][r0 + e2 + 1] + X[tm][r0 + e2]; A[tm][r0 + e2] = A[tm][r0 + e2] * A[tm][r0 + e2 + 1]; } } }
            float enH[8], enP[8]; float EH = 0.f, EP = 1.f;
            if (d == 0) {
#pragma unroll
                for (int q = 0; q < 8; ++q) { const int tm = q >> 2, re = 4 * (q & 3) + 3; const float ce = A[tm][re], he = X[tm][re];
                    const float aH = swap_lo(ce * EH + he), aP = swap_lo(EP * ce);
                    const float E1H = hi ? aH : EH, E1P = hi ? aP : EP;
                    enH[q] = E1H; enP[q] = E1P;
                    EH = swap_hi(ce * E1H + he); EP = swap_hi(E1P * ce); }
            } else {
#pragma unroll
                for (int q = 7; q >= 0; --q) { const int tm = q >> 2, re = 4 * (q & 3); const float ce = A[tm][re], he = X[tm][re];
                    const float aH = swap_hi(ce * EH + he), aP = swap_hi(EP * ce);
                    const float E1H = hi ? EH : aH, E1P = hi ? EP : aP;
                    enH[q] = E1H; enP[q] = E1P;
                    EH = swap_lo(ce * E1H + he); EP = swap_lo(E1P * ce); }
            }
            { const unsigned ob = (unsigned)((((s0row + t0 + 4 * hi) * 2 + d) * 256 + c) * 2);
#pragma unroll
              for (int tm = 0; tm < 2; ++tm)
#pragma unroll
                for (int rg = 0; rg < 4; ++rg) { const int q = 4 * tm + rg;
#pragma unroll
                    for (int e2 = 0; e2 < 4; ++e2) { const int r = 4 * rg + e2; const unsigned o = ob + (unsigned)(32 * tm + 8 * rg + e2) * 1024u;
                        *(unsigned short*)((char*)HL + o) = (unsigned short)f2bf(X[tm][r] + A[tm][r] * enH[q]); *(unsigned short*)((char*)CP + o) = (unsigned short)f2bf(A[tm][r] * enP[q]); }
                    asm volatile("" ::: "memory"); } }
            if (hi == 0) SUM[((size_t)(b * NCHUNK + ci) * 2 + d) * 256 + c] = (f32x2v){EP, EH};
        }
        __syncthreads();
    }
}
constexpr size_t WS_CARRY = 255 * MiB;
__device__ __forceinline__ void ph_lru_carry(Frame& F) {
    if (F.vcu < 4) {
        const int g = F.vcu * NTHREADS + F.tid, b = g >> 9, d = (g >> 8) & 1, c = g & 255;
        const f32x2v* sb = (const f32x2v*)(F.ws + WS_SUM) + ((size_t)b * NCHUNK * 2 + d) * 256 + c;
        float* cr = (float*)(F.ws + WS_CARRY) + ((size_t)b * NCHUNK * 2 + d) * 256 + c;
        float h = 0.f;
#pragma unroll 1
        for (int p0 = 0; p0 < NCHUNK; p0 += 17) {
            f32x2v s[17];
#pragma unroll
            for (int i = 0; i < 17; ++i) { const int p = p0 + i, j = (d == 0) ? p : (p < 4 ? 3 - p : NCHUNK + 3 - p); s[i] = sb[(size_t)j * 512]; }
#pragma unroll
            for (int i = 0; i < 17; ++i) { const int p = p0 + i, j = (d == 0) ? p : (p < 4 ? 3 - p : NCHUNK + 3 - p); cr[(size_t)j * 512] = h; h = s[i].x * h + s[i].y; }
        }
    }
}
__device__ __forceinline__ void ph_lru2(Frame& F, int l) {
    const unsigned short* HL = (const unsigned short*)(F.ws + WS_HL); const unsigned short* CP = (const unsigned short*)(F.ws + WS_CP);
    const float* CARRY = (const float*)(F.ws + WS_CARRY); unsigned short* Y = (unsigned short*)(F.ws + WS_G);
    const int tid = F.tid, cg = tid & 31, tq = tid >> 5; const bool last = (l == NLAYER - 1);
    for (int unit = F.vcu; unit < NB * NCHUNK; unit += F.G) {
        const int b = unit / NCHUNK, ci = unit % NCHUNK;
        if (last && ci < 4) continue;
        const float* cp0 = CARRY + ((size_t)(b * NCHUNK + ci) * 2) * 256 + cg * 8;
        const f32x4 cfa = *(const f32x4*)cp0, cfb = *(const f32x4*)(cp0 + 4), cba = *(const f32x4*)(cp0 + 256), cbb = *(const f32x4*)(cp0 + 260);
        const float cf[8] = {cfa.x, cfa.y, cfa.z, cfa.w, cfb.x, cfb.y, cfb.z, cfb.w}, cbk[8] = {cba.x, cba.y, cba.z, cba.w, cbb.x, cbb.y, cbb.z, cbb.w};
        v4u hf[4], pf[4], hb[4], pb[4], gg[4];
#pragma unroll
        for (int i = 0; i < 4; ++i) { const size_t row = (size_t)b * TPB + ci * 64 + tq + 16 * i; const size_t o = (row * 2) * 256 + cg * 8;
            hf[i] = *(const v4u*)(HL + o); pf[i] = *(const v4u*)(CP + o); hb[i] = *(const v4u*)(HL + o + 256); pb[i] = *(const v4u*)(CP + o + 256); gg[i] = *(const v4u*)(Y + row * 1024 + 768 + cg * 8); }
#pragma unroll
        for (int i = 0; i < 4; ++i) { const size_t row = (size_t)b * TPB + ci * 64 + tq + 16 * i;
            unsigned w[4];
#pragma unroll
            for (int e = 0; e < 4; ++e) { const unsigned a = hf[i][e], p = pf[i][e], a2 = hb[i][e], p2 = pb[i][e], g = gg[i][e];
                const float v0 = (bflo(a) + bflo(p) * cf[2 * e] + bflo(a2) + bflo(p2) * cbk[2 * e]) * bflo(g);
                const float v1 = (bfhi(a) + bfhi(p) * cf[2 * e + 1] + bfhi(a2) + bfhi(p2) * cbk[2 * e + 1]) * bfhi(g);
                w[e] = pk2(v0, v1); }
            *(v4u*)(Y + row * 1024 + 768 + cg * 8) = (v4u){w[0], w[1], w[2], w[3]}; }
    }
}
namespace pgx {
typedef short bf16x8 __attribute__((ext_vector_type(8)));
typedef float f32x4 __attribute__((ext_vector_type(4)));
typedef unsigned u32x4 __attribute__((ext_vector_type(4)));
typedef unsigned u32x2 __attribute__((ext_vector_type(2)));
constexpr int OPB = 16384;
template <int VAR> __device__ __forceinline__ void pgx_unit(LAS unsigned char* lds, const unsigned short* Y, const unsigned short* Wb, const unsigned short* S, unsigned short* MIX, int row0, int n0, int tid) {
    const int lane = tid & 63, wid = __builtin_amdgcn_readfirstlane(tid >> 6), wm = wid & 3, wn = wid >> 2, fr = lane & 15, fq = lane >> 4;
    const int sr0 = tid >> 3, sk = (tid & 7) * 8;
    const unsigned short* ysrc = Y + (size_t)(row0 + sr0) * 1024 + sk;
    const unsigned short* wsrc = Wb + (size_t)(n0 + sr0) * 256 + sk;
    const int ldst = (tid & 7) * 2048 + (sr0 & ~15) * 16 + (((sr0 & 15) ^ (tid & 7)) << 4);
    const int wrow = (sr0 & ~63) | (((sr0 >> 2) & 3) << 4) | (((sr0 >> 4) & 3) << 2) | (sr0 & 3);
    const int ldstw = (tid & 7) * 2048 + (wrow & ~15) * 16 + (((wrow & 15) ^ (tid & 7)) << 4);
    f32x4 acc[2][4], mix[2][4];
#pragma unroll
    for (int a = 0; a < 2; ++a)
#pragma unroll
        for (int b = 0; b < 4; ++b) { acc[a][b] = (f32x4){0.f, 0.f, 0.f, 0.f}; mix[a][b] = (f32x4){0.f, 0.f, 0.f, 0.f}; }
    u32x4 st[4][4];
    const unsigned short* yA = ysrc; const unsigned short* yB = ysrc + 64 * 1024;
    const unsigned short* wA = wsrc; const unsigned short* wB = wsrc + 64 * 256;
    const unsigned short* sp0 = S + (size_t)(row0 + 32 * wm + fr) * 4096 + n0 + 64 * wn + 16 * fq; const unsigned short* sp1 = sp0 + (size_t)16 * 4096;
#define PGX_LOADQ(set_, yo_, wp0_, wp1_, wo_) do { if (VAR == 2) { st[set_][0] = *(const u32x4*)(ysrc); st[set_][1] = *(const u32x4*)(ysrc + 64 * 1024); st[set_][2] = *(const u32x4*)(wsrc); st[set_][3] = *(const u32x4*)(wsrc + 64 * 256); } else if (VAR == 4) { st[set_][0] = st[set_][1] = st[set_][2] = st[set_][3] = (u32x4){1u,2u,3u,4u}; asm volatile("" : "+v"(st[set_][0]), "+v"(st[set_][1]), "+v"(st[set_][2]), "+v"(st[set_][3])); } else { st[set_][0] = *(const u32x4*)(yA + (yo_)); st[set_][1] = *(const u32x4*)(yB + (yo_)); st[set_][2] = *(const u32x4*)((wp0_) + (wo_)); st[set_][3] = *(const u32x4*)((wp1_) + (wo_)); } } while (0)
#define PGX_STORE(buf_, set_) do { LAS unsigned char* b_ = lds + (buf_) * 2 * OPB + ldst; \
        *(LAS u32x4*)b_ = st[set_][0]; *(LAS u32x4*)(b_ + 1024) = st[set_][1]; *(LAS u32x4*)(b_ - ldst + OPB + ldstw) = st[set_][2]; *(LAS u32x4*)(b_ - ldst + OPB + ldstw + 1024) = st[set_][3]; } while (0)
    u32x4 sga[2][2], sgb[2][2];
#define PGX_SLOAD(dst_, off_) do { if (VAR == 1 || VAR == 4) { dst_[0][0] = dst_[0][1] = dst_[1][0] = dst_[1][1] = (u32x4){0x3f803f80u, 0x3f803f80u, 0x3f803f80u, 0x3f803f80u}; } \
        else { dst_[0][0] = *(const u32x4*)(sp0 + (off_)); dst_[0][1] = *(const u32x4*)(sp0 + (off_) + 8); dst_[1][0] = *(const u32x4*)(sp1 + (off_)); dst_[1][1] = *(const u32x4*)(sp1 + (off_) + 8); } } while (0)
    PGX_SLOAD(sga, 0);
    PGX_LOADQ(0, 0, wA, wB, 0); PGX_LOADQ(1, 64, wA, wB, 64); PGX_LOADQ(2, 128, wA, wB, 128);
    PGX_STORE(0, 0);
    __syncthreads();
#define PGX_COMPUTE(h_) do { const LAS unsigned char* yb = lds + ((h_) & 1) * 2 * OPB + 32 * wm * 16; const LAS unsigned char* wb = lds + ((h_) & 1) * 2 * OPB + OPB + 64 * wn * 16; \
          _Pragma("unroll") for (int ks = 0; ks < 2; ++ks) { const int fo_ = (4 * ks + fq) * 2048 + ((fr ^ (4 * ks + fq)) << 4); \
              bf16x8 yf[2], wf[4]; \
              _Pragma("unroll") for (int tt = 0; tt < 2; ++tt) yf[tt] = *(const LAS bf16x8*)(yb + fo_ + tt * 256); \
              _Pragma("unroll") for (int nt = 0; nt < 4; ++nt) wf[nt] = *(const LAS bf16x8*)(wb + fo_ + nt * 256); \
              _Pragma("unroll") for (int tt = 0; tt < 2; ++tt) \
                  _Pragma("unroll") for (int nt = 0; nt < 4; ++nt) acc[tt][nt] = __builtin_amdgcn_mfma_f32_16x16x32_bf16(wf[nt], yf[tt], acc[tt][nt], 0, 0, 0); } } while (0)
#pragma unroll 1
    for (int kk = 0; kk < 4; ++kk) {
        const bool more = kk < 3;
        const unsigned short* wnA = more ? wA + (size_t)1024 * 256 : wsrc; const unsigned short* wnB = more ? wB + (size_t)1024 * 256 : wsrc + 64 * 256;
        const int yo = more ? 256 : -768;
        PGX_SLOAD(sgb, more ? 1024 : 0);
        PGX_LOADQ(3, 192, wA, wB, 192); PGX_COMPUTE(0); PGX_STORE(1, 1); __syncthreads();
        PGX_LOADQ(0, yo, wnA, wnB, 0); PGX_COMPUTE(1); PGX_STORE(0, 2); __syncthreads();
        PGX_LOADQ(1, yo + 64, wnA, wnB, 64); PGX_COMPUTE(2); PGX_STORE(1, 3); __syncthreads();
        PGX_LOADQ(2, yo + 128, wnA, wnB, 128); PGX_COMPUTE(3);
#pragma unroll
        for (int tt = 0; tt < 2; ++tt)
#pragma unroll
            for (int nt = 0; nt < 4; ++nt) { const u32x4 gv = sga[tt][nt >> 1]; const unsigned g0 = (nt & 1) ? gv.z : gv.x, g1 = (nt & 1) ? gv.w : gv.y; const f32x4 a = acc[tt][nt];
                mix[tt][nt] += (f32x4){a[0] * bflo(g0), a[1] * bfhi(g0), a[2] * bflo(g1), a[3] * bfhi(g1)}; acc[tt][nt] = (f32x4){0.f, 0.f, 0.f, 0.f}; }
#pragma unroll
        for (int tt = 0; tt < 2; ++tt) { sga[tt][0] = sgb[tt][0]; sga[tt][1] = sgb[tt][1]; }
        if (more) PGX_STORE(0, 0);
        __syncthreads();
        yA += 256; yB += 256; wA = wnA; wB = wnB; sp0 += 1024; sp1 += 1024;
    }
#pragma unroll
    for (int tt = 0; tt < 2; ++tt) { unsigned short* mp = MIX + (size_t)(row0 + 32 * wm + 16 * tt + fr) * 1024 + n0 + 64 * wn + 16 * fq;
        u32x4 w0, w1; w0.x = pk2(mix[tt][0][0], mix[tt][0][1]); w0.y = pk2(mix[tt][0][2], mix[tt][0][3]); w0.z = pk2(mix[tt][1][0], mix[tt][1][1]); w0.w = pk2(mix[tt][1][2], mix[tt][1][3]);
        w1.x = pk2(mix[tt][2][0], mix[tt][2][1]); w1.y = pk2(mix[tt][2][2], mix[tt][2][3]); w1.z = pk2(mix[tt][3][0], mix[tt][3][1]); w1.w = pk2(mix[tt][3][2], mix[tt][3][3]);
        *(u32x4*)mp = w0; *(u32x4*)(mp + 8) = w1; }
#undef PGX_LOADQ
#undef PGX_SLOAD
#undef PGX_STORE
#undef PGX_COMPUTE
}
}
template <int VAR> __device__ __forceinline__ void ph_pgx(Frame& F, int l, int r_lo = 0, int r_hi = 1 << 20, bool signal = false) {
    const unsigned short* Y = (const unsigned short*)(F.ws + WS_G); const unsigned short* S = (const unsigned short*)(F.ws + WS_S); unsigned short* MIX = (VAR == 0) ? (unsigned short*)(F.ws + WS_H) : (unsigned short*)F.out;
    const unsigned short* Wb = (const unsigned short*)(F.ws + WS_W + (size_t)l * W_LAYER + WO_WB);
    const bool last = (l == NLAYER - 1);
    const int nrt = last ? 128 : NROWS / 128;
    for (int r = r_lo; r <= r_hi; ++r) {
        const int u = F.vcu + r * F.G; if (u >= nrt * 8) break;
        int rt = u >> 3; const int ct = u & 7;
        if (last) rt = rt + 2 * (rt / 32) + 2;
        pgx::pgx_unit<VAR>(F.lds + RING_OFF, Y, Wb, S, MIX, rt * 128, ct * 128, F.tid);
        if (signal) {
            asm volatile("s_waitcnt vmcnt(0)" ::: "memory"); __syncthreads();
            if (F.tid == 0) { __builtin_amdgcn_fence(__ATOMIC_RELEASE, "agent"); asm volatile("s_waitcnt vmcnt(0)" ::: "memory");
                (void)xb_add((unsigned*)((gu32*)(F.ws + WS_CTL) + CW_FLG) + (u >> 4), 1u); }
        }
    }
}
constexpr int NPL = 10;
enum { PH_H = 0, PH_G1, PH_POST1, PH_G2, PH_POST2, PH_ATT, PH_SG, PH_PG, PH_MIX, PH_OG };
constexpr int NPHASES = 1 + NLAYER * NPL;
#ifndef NAIVE_ATT
#define NAIVE_ATT 0
#endif
#ifndef PROBE_MASK
#define PROBE_MASK 0
#endif
#ifndef PROBE_LAYERS
#define PROBE_LAYERS 3
#endif
#ifndef MERGE_PGOG
#define MERGE_PGOG 0
#endif
#ifndef PHMASK
#define PHMASK 16383
#endif
#ifndef MK_ONE_LAUNCH
#define MK_ONE_LAUNCH 1
#endif

__global__ void __launch_bounds__(NTHREADS, 2) fwd_kernel(Args args) {
    extern __shared__ __attribute__((aligned(16))) unsigned char lds_raw[];
    { LAS unsigned char* l0 = (LAS unsigned char*)lds_raw;
      for (int u = threadIdx.x; u < (LDS_BYTES - LDSCTL_OFF) / 4; u += NTHREADS) ((LAS unsigned*)(l0 + LDSCTL_OFF))[u] = 0u;
      __syncthreads();
      if (args.ph_hi - args.ph_lo > 1) (void)xcd_barrier_post((unsigned*)((gu32*)(args.ws + WS_CTL) + CW_BAR), (volatile LAS unsigned*)(l0 + MISC_OFF) + 8); }

    unsigned long long tacc = 0ull;
    for (int ph = args.ph_lo; ph < args.ph_hi; ++ph) {
        unsigned long long tph0 = 0ull; bool probed = false;
        if (PROBE_MASK) { const int pl = (ph == 0) ? 0 : (ph - 1) / NPL, pp = (ph == 0) ? 10 : (ph - 1) % NPL; probed = ((PROBE_MASK >> pp) & 1) && ((PROBE_LAYERS >> pl) & 1); if (probed) tph0 = __builtin_amdgcn_s_memrealtime(); }
        int z; asm volatile("s_mov_b32 %0, 0" : "=s"(z));
        Frame F;
        F.lds = (LAS unsigned char*)lds_raw + z; F.kin = (const float* const __attribute__((address_space(4)))*)((const __attribute__((address_space(4))) char*)__builtin_amdgcn_kernarg_segment_ptr() + z); F.ws = args.ws + z; F.out = args.out + z; F.z = z;
        F.tid = threadIdx.x + z; F.lane = F.tid & 63; F.wave = __builtin_amdgcn_readfirstlane(F.tid >> 6);
        F.G = gridDim.x + z; { const int bx = blockIdx.x + z; F.vcu = (F.G % 8 == 0) ? (bx % 8) * (F.G / 8) + bx / 8 : bx; }
        F.gw = F.vcu * NWAVES + F.wave; F.NGW = F.G * NWAVES;
        bool is_gemm = false;
        pg8::Gemm g{nullptr, nullptr, NROWS, 256, 1024, 1024, 31, 0};
        pg8::Order S; S.init(1, 1, F.G, (int)blockIdx.x + z, 0);
        pg8::EpiU E{pg8::EM_PLAIN, 0, F.ws, nullptr, nullptr, nullptr, 0, 0, 0, 0, 1 << 20};
        if (ph == 0) { if (PHMASK & 8192) p0_prologue(F); }
        else {
            const int l = (ph - 1) / NPL, p = (ph - 1) % NPL;
            unsigned char* wl = F.ws + WS_W + (size_t)l * W_LAYER;
            const bool last = (l == NLAYER - 1);
            const int nMc = last ? 64 : NROWS / 256, lat = last ? 1 : 0;
            const bool merged = last && F.G == 256 && MERGE_PGOG;
            E.l = l;
            if (p == PH_H && (PHMASK & 1)) { ph_hnorm(F, l); }
            else if (p == PH_G1 && (PHMASK & 2)) {
                is_gemm = true; g.A = (const bf16*)(F.ws + WS_H); g.Bt = (const bf16*)(wl + WO_W1); g.N = N1; g.K = 1024; g.lda = 1024;
                S.init(NROWS / 256, N1 / 256, F.G, (int)blockIdx.x + z, 0);
                E.mode = pg8::EM_SILU2; E.oA = WS_ZS; E.ldc = ZS_P; E.oB = WS_G; E.ldc2 = 1024; E.split_tile = 7;
            }
            else if (p == PH_POST1 && (PHMASK & 4)) { ph_lru1(F, l); ph_post1(F, l); }
            else if (p == PH_G2 && (PHMASK & 8)) {
                is_gemm = true; g.A = (const bf16*)(F.ws + WS_ZS); g.Bt = (const bf16*)(wl + WO_UQ); g.N = 1024; g.K = 256; g.lda = ZS_P; g.a_shift = 1; g.a_step = 512;
                S.init(NROWS / 256, 4, F.G, (int)blockIdx.x + z, 0);
                E.mode = pg8::EM_PLAIN; E.oA = WS_MQ; E.ldc = 512; E.oB = WS_MKV; E.ldc2 = 512; E.split_tile = 2;
            }
            else if (p == PH_POST2 && (PHMASK & 16)) { ph_lru_carry(F); ph_post2(F, l); }
            else if (p == PH_ATT && (PHMASK & 32)) {
#if NAIVE_ATT
                ph_attn_naive(F, l);
#else
                ph_attn(F, l);
#endif
                ph_lru2(F, l); }
            else if (p == PH_SG && (PHMASK & 512)) {
                is_gemm = true; g.A = (const bf16*)(F.ws + WS_H); g.Bt = (const bf16*)(wl + WO_W1) + (size_t)N1 * 1024; g.N = 4096; g.K = 1024; g.lda = 1024;
                S.init(nMc, 16, F.G, (int)blockIdx.x + z, lat);
                E.mode = pg8::EM_SIG; E.oA = WS_S; E.ldc = 4096;
            }
            else if (p == PH_PG && (PHMASK & 1024)) {
                int r_hi = 1 << 20;
                if (merged) { pg8::Unit u0; pg8::Order S0; S0.init(64, 4, F.G, (int)blockIdx.x + z, 1); (void)S0.next(0, u0); r_hi = u0.pm / 17; }
                ph_pgx<0>(F, l, 0, r_hi, merged);
#ifdef PGX_PROBE
                if (l == 0) { __syncthreads(); ph_pgx<PGX_PROBE>(F, l); }
#endif
            }
            else if (p == PH_MIX) {
                if (!last && (PHMASK & 2048)) {
                    is_gemm = true; g.A = (const bf16*)(F.ws + WS_H); g.Bt = (const bf16*)(F.ws + WS_WOS); g.N = 4096; g.K = 256; g.lda = 1024; g.a_shift = 2; g.a_step = 512;
                    S.init(4, 16, F.G, (int)blockIdx.x + z, 2);
                    E.mode = pg8::EM_PLAIN; E.oA = WS_S; E.ldc = 4096; }
            }
            else if (p == PH_OG && (PHMASK & 4096)) {
                is_gemm = true; g.A = (const bf16*)(F.ws + WS_H); g.Bt = (const bf16*)(wl + WO_WO); g.N = 1024; g.K = 1024; g.lda = 1024;
                S.init(64, 4, F.G, (int)blockIdx.x + z, 1);
                E.mode = pg8::EM_RES; E.xin = (l == 0) ? F.in(I_X) : (const float*)F.out; E.xout = F.out; E.cin0 = F.in(I_CTX); E.oA = WS_MOD; E.oB = WS_CTX1;
                if (merged) {
                    pg8::Unit u0; (void)S.next(0, u0); const int q = (u0.pm / 17) * 16 + u0.pm % 17 - 1;
                    if (F.tid == 0) { unsigned* bar = (unsigned*)((gu32*)(F.ws + WS_CTL) + CW_BAR); unsigned* flg = (unsigned*)((gu32*)(F.ws + WS_CTL) + CW_FLG) + q;
                        XB_SPIN(xb_ld(flg) < 16u, bar); __builtin_amdgcn_fence(__ATOMIC_ACQUIRE, "agent"); asm volatile("s_waitcnt vmcnt(0)" ::: "memory"); }
                    __syncthreads(); }
            }
        }
        if (is_gemm) pg8::gemm_phase<pg8::EpiU, pg8::Order, true, true>(F.lds + RING_OFF, g, S, E, F.tid);
        if (NLAYER == 2 && ph >= 1 && ph <= 1 + PH_OG) {
            const int p = ph - 1;
            if (p == PH_G1 || p == PH_G2 || p == PH_SG || p == PH_PG || p == PH_OG) {
                int z4; asm volatile("s_mov_b32 %0, 0" : "=s"(z4));
                Frame C;
                C.lds = (LAS unsigned char*)lds_raw + z4; C.kin = (const float* const __attribute__((address_space(4)))*)((const __attribute__((address_space(4))) char*)__builtin_amdgcn_kernarg_segment_ptr() + z4); C.ws = args.ws + z4; C.out = args.out + z4; C.z = z4;
                C.tid = threadIdx.x + z4; C.lane = C.tid & 63; C.wave = __builtin_amdgcn_readfirstlane(C.tid >> 6);
                C.G = gridDim.x + z4; const int bx = blockIdx.x + z4; C.vcu = (C.G % 8 == 0) ? (bx % 8) * (C.G / 8) + bx / 8 : bx;
                C.gw = C.vcu * NWAVES + C.wave; C.NGW = C.G * NWAVES;
                int cidx = -1, cn = 1, loA = 0, nA = 0, loB = 0, nB = 0;
                if (p == PH_G1) { const int nb = ((NROWS / 256) * (N1 / 256)) % C.G; cidx = bx - nb; cn = C.G - nb; loA = I_EARLY; nA = IC_G1; }
                else if (p == PH_G2) { const int nb = ((NROWS / 256) * 4) % C.G; cidx = bx - nb; cn = C.G - nb; loA = I_EARLY + IC_G1; nA = I_INL - IC_G1; }
                else if (p == PH_SG) { const int nb = ((NROWS / 256) * 16) % C.G; cidx = bx - nb; cn = C.G - nb; loA = I_EARLY + I_INL; nA = I_BR; loB = 0; nB = 1536; }
                else if (p == PH_PG) { const int nb = ((NROWS / 128) * 8) % C.G; cidx = C.vcu - nb; cn = C.G - nb; loA = I_EARLY + I_INL + I_BR; nA = I_OUT + I_SPLIT; loB = 1536; nB = 1536; }
                else { const int nb = (64 < C.G) ? 64 : 0; cidx = bx - nb; cn = C.G - nb; loB = 3072; nB = I_LAYER - 3072; }
                if (cidx >= 0) { __syncthreads();
                    if (p == PH_G1) p0_tables(C, cidx * NTHREADS + C.tid, cn * NTHREADS);
                    weight_copies(C, cidx * NWAVES + C.wave, cn * NWAVES, loA, nA, loB, nB); }
            }
        }
        if (MERGE_PGOG && ph == 1 + (NLAYER - 1) * NPL + PH_OG && gridDim.x == 256) {
            int z5; asm volatile("s_mov_b32 %0, 0" : "=s"(z5));
            Frame C;
            C.lds = (LAS unsigned char*)lds_raw + z5; C.kin = (const float* const __attribute__((address_space(4)))*)((const __attribute__((address_space(4))) char*)__builtin_amdgcn_kernarg_segment_ptr() + z5); C.ws = args.ws + z5; C.out = args.out + z5; C.z = z5;
            C.tid = threadIdx.x + z5; C.lane = C.tid & 63; C.wave = __builtin_amdgcn_readfirstlane(C.tid >> 6);
            C.G = gridDim.x + z5; const int bx = blockIdx.x + z5; C.vcu = (C.G % 8 == 0) ? (bx % 8) * (C.G / 8) + bx / 8 : bx;
            C.gw = C.vcu * NWAVES + C.wave; C.NGW = C.G * NWAVES;
            pg8::Unit u0; pg8::Order S0; S0.init(64, 4, C.G, bx, 1); (void)S0.next(0, u0);
            __syncthreads(); ph_pgx<0>(C, NLAYER - 1, u0.pm / 17 + 1, 1 << 20, true);
        }
        const bool empty_phase = (ph > 0) && (((ph - 1) % NPL == PH_MIX) || (MERGE_PGOG && ph == 1 + (NLAYER - 1) * NPL + PH_PG && gridDim.x == 256));
        if (empty_phase) __syncthreads();
        if (ph + 1 < args.ph_hi && !empty_phase) {
            int z2; asm volatile("s_mov_b32 %0, 0" : "=s"(z2));
            XcdBarrier bar; bar.bar = (unsigned*)((gu32*)(args.ws + z2 + WS_CTL) + CW_BAR); bar.x = xb_xcc_id(); bar.st = (volatile LAS unsigned*)((LAS unsigned char*)lds_raw + z2 + MISC_OFF) + 8;
            xcd_barrier(bar);
        }
        if (PROBE_MASK) { if (probed) tacc += __builtin_amdgcn_s_memrealtime() - tph0; }
    }
#ifdef EXTRA_BARRIERS
    for (int xb = 0; xb < EXTRA_BARRIERS; ++xb) { int z3; asm volatile("s_mov_b32 %0, 0" : "=s"(z3));
        XcdBarrier bar; bar.bar = (unsigned*)((gu32*)(args.ws + z3 + WS_CTL) + CW_BAR); bar.x = xb_xcc_id(); bar.st = (volatile LAS unsigned*)((LAS unsigned char*)lds_raw + z3 + MISC_OFF) + 8;
        xcd_barrier(bar); }
#endif
    if (PROBE_MASK) { const unsigned long long t0 = __builtin_amdgcn_s_memrealtime(); while (__builtin_amdgcn_s_memrealtime() - t0 < tacc) __builtin_amdgcn_s_sleep(8); }
}

extern "C" void kernel_launch(void* const* d_in, const int* in_sizes, int n_in, void* d_out, int out_size, void* d_ws, size_t ws_size, hipStream_t stream) {
    static int grid = 0;
    if (grid == 0) {
        if (n_in != 28 || out_size != NB * SEQ * DM || ws_size < WS_END) { fprintf(stderr, "kernel_launch: unexpected shapes (n_in %d out %d ws %zu); nothing launched\n", n_in, out_size, ws_size); grid = -1; return; }
        int dev = 0, cus = 0, per_cu = 0;
        if (hipGetDevice(&dev) != hipSuccess || hipDeviceGetAttribute(&cus, hipDeviceAttributeMultiprocessorCount, dev) != hipSuccess) { grid = -1; return; }
        if (hipFuncSetAttribute((const void*)fwd_kernel, hipFuncAttributeMaxDynamicSharedMemorySize, LDS_BYTES) != hipSuccess) { fprintf(stderr, "kernel_launch: hipFuncSetAttribute failed\n"); grid = -1; return; }
        if (hipOccupancyMaxActiveBlocksPerMultiprocessor(&per_cu, (const void*)fwd_kernel, NTHREADS, LDS_BYTES) != hipSuccess || per_cu < 1) { fprintf(stderr, "kernel_launch: occupancy query says %d\n", per_cu); (void)hipGetLastError(); grid = -1; return; }
        grid = cus;
    }
    if (grid < 0) return;
    (void)hipMemsetAsync((char*)d_ws + WS_CTL, 0, CTL_ZERO_BYTES, stream);
    Args a{};
    for (int i = 0; i < 28; ++i) a.in[i] = (const float*)d_in[i];
    a.out = (float*)d_out; a.ws = (unsigned char*)d_ws;
#if MK_ONE_LAUNCH
    a.ph_lo = 0; a.ph_hi = NPHASES;
    hipLaunchKernelGGL(fwd_kernel, dim3(grid), dim3(NTHREADS), LDS_BYTES, stream, a);
#else
    for (int ph = 0; ph < NPHASES; ++ph) { a.ph_lo = ph; a.ph_hi = ph + 1; hipLaunchKernelGGL(fwd_kernel, dim3(grid), dim3(NTHREADS), LDS_BYTES, stream, a); }
#endif
}
```

```cpp
#include <hip/hip_runtime.h>
#include <cstdio>
#include <cstdint>
#include <cmath>
__device__ __forceinline__ float bflo(unsigned w) { return __uint_as_float(w << 16); }
__device__ __forceinline__ float bfhi(unsigned w) { return __uint_as_float(w & 0xffff0000u); }
__device__ __forceinline__ float sigmoid_f(float v) { return __builtin_amdgcn_rcpf(1.0f + __builtin_amdgcn_exp2f(-1.4426950408889634f * v)); }
namespace pg8 {
#define PG8_LAS __attribute__((address_space(3)))
typedef unsigned short bf16_t;
typedef short bf16x8 __attribute__((ext_vector_type(8)));
typedef float f32x4 __attribute__((ext_vector_type(4)));
typedef unsigned u32x4 __attribute__((ext_vector_type(4)));
constexpr int BM = 256, BK = 64, HALF = 128, HTB = HALF * BK * 2  , STAGE_BYTES = 8 * HTB, NXCD = 8, WGM = 8;

__host__ __device__ __forceinline__ int lds_byte(int r, int c) { const int st = (r >> 4) * 2 + (c >> 5), rr = r & 15, cc = c & 31, ob = rr * 64 + cc * 2; return st * 1024 + (ob ^ (((ob >> 9) & 1) << 5)); }
__host__ __device__ __forceinline__ void stage_rc(int b, int& R, int& C) { const int st = b / 1024, sb = b % 1024, swz = sb ^ (((sb >> 9) & 1) << 5); R = (st >> 1) * 16 + swz / 64; C = (st & 1) * 32 + (swz % 64) / 2; }
__host__ __device__ __forceinline__ int perm32(int rho) { const int n = rho >> 4, i = rho & 15; return 8 * (i >> 2) + 4 * n + (i & 3); }

struct Unit { int pm, pn; };
struct Gemm { const bf16_t* A; const bf16_t* Bt; int M, N, K, lda; int a_shift, a_step; };

struct StaticOrder {
    int nM, nN, nwg, G, c;
    __host__ __device__ void init(int M, int N, int G_, int c_) { nM = M / BM; nN = N / BM; nwg = nM * nN; G = G_; c = c_; }
    __host__ __device__ bool next(int i, Unit& u) const {
        const long L = (long)i * G + c; if (L >= nwg) return false;
        int wgid = (int)L; { const int q = nwg / NXCD, r = nwg % NXCD, xcd = wgid % NXCD, off = wgid / NXCD; wgid = (xcd < r ? xcd * (q + 1) : r * (q + 1) + (xcd - r) * q) + off; }
        const int nig = WGM * nN, gid = wgid / nig, fm = gid * WGM, gsz = (nM - fm) < WGM ? (nM - fm) : WGM;
        u.pm = fm + ((wgid % nig) % gsz); u.pn = (wgid % nig) / gsz; return true;
    }
    __device__ __forceinline__ void a_ready(const Unit&) const {}
    __device__ __forceinline__ void done(const Unit&) const {}
};

__device__ __forceinline__ unsigned cvt_pk_bf16(float lo, float hi) { unsigned r; asm volatile("v_cvt_pk_bf16_f32 %0, %1, %2" : "=v"(r) : "v"(lo), "v"(hi)); return r; }
enum { EM_PLAIN = 0, EM_SILU2 = 1, EM_SIG = 2, EM_MUL = 3, EM_RES = 4 };
struct EpiU {
    static constexpr bool PERM = true, AFTER_DRAIN = false;
    int mode; int l; unsigned char* ws; const float* xin; float* xout; const float* cin0;
    size_t oA, oB; int ldc, ldc2, split_tile;
    __device__ __forceinline__ void operator()(const f32x4 (&acc)[2][2][4][2], const Unit& u, int wr, int wc, int fr, int fq) const {
        if (mode == EM_RES) {
            const int b = u.pm / 17, t0 = u.pm % 17;
            const float* src; float* dst; const float* gate; const float* modl = (const float*)(ws + oA) + (size_t)l * 5 * 3072;
            if (t0 == 0) { float* c1 = (float*)(ws + oB); src = ((l == 0) ? cin0 : (const float*)c1) + (size_t)b * 256 * 1024; dst = c1 + (size_t)b * 256 * 1024; gate = modl + 4 * 3072 + 2048; }
            else { const size_t o = ((size_t)b * 4096 + (size_t)(t0 - 1) * 256) * 1024; src = xin + o; dst = xout + o; gate = modl + b * 3072 + 2048; }
            const int col0 = u.pn * BM + wc * 32 + 8 * fq;
            const char* srcb = (const char*)src; char* dstb = (char*)dst; const char* gb = (const char*)(gate + col0);
            const unsigned off0 = (unsigned)((wr * 64 + fr) * 1024 + col0) * 4u;
#pragma unroll
            for (int ai = 0; ai < 2; ++ai) {
                f32x4 xo[4][2][2];
#pragma unroll
                for (int m = 0; m < 4; ++m) { const unsigned off = off0 + (unsigned)(ai * HALF + m * 16) * 4096u;
#pragma unroll
                    for (int bj = 0; bj < 2; ++bj)
#pragma unroll
                        for (int n = 0; n < 2; ++n) xo[m][bj][n] = *(const f32x4*)(srcb + (off + (unsigned)(bj * HALF + n * 4) * 4u)); }
#pragma unroll
                for (int m = 0; m < 4; ++m) { const unsigned off = off0 + (unsigned)(ai * HALF + m * 16) * 4096u;
#pragma unroll
                    for (int bj = 0; bj < 2; ++bj)
#pragma unroll
                        for (int n = 0; n < 2; ++n) { const unsigned cb = (unsigned)(bj * HALF + n * 4) * 4u; const f32x4 g = *(const f32x4*)(gb + cb);
                            *(f32x4*)(dstb + (off + cb)) = xo[m][bj][n] + g * acc[ai][bj][m][n]; } }
                asm volatile("" ::: "memory"); }
            return;
        }
        const int row0 = u.pm * BM + wr * 64 + fr; int colt = u.pn * BM; bf16_t* base = (bf16_t*)(ws + oA); int ld = ldc; bool second = false;
        if (u.pn >= split_tile) { base = (bf16_t*)(ws + oB); ld = ldc2; colt -= split_tile * BM; second = true; }
        const bool do_silu = (mode == EM_SILU2) && second;
        const int col0 = colt + wc * 32 + 8 * fq;
#pragma unroll
        for (int ai = 0; ai < 2; ++ai)
#pragma unroll
            for (int m = 0; m < 4; ++m) { bf16_t* rowp = base + (size_t)(row0 + ai * HALF + m * 16) * ld + col0;
#pragma unroll
                for (int bj = 0; bj < 2; ++bj) { f32x4 v0 = acc[ai][bj][m][0], v1 = acc[ai][bj][m][1];
                    if (mode == EM_SIG) {
#pragma unroll
                        for (int e = 0; e < 4; ++e) { v0[e] = sigmoid_f(v0[e]); v1[e] = sigmoid_f(v1[e]); } }
                    if (do_silu) {
#pragma unroll
                        for (int e = 0; e < 4; ++e) { v0[e] = v0[e] * sigmoid_f(v0[e]); v1[e] = v1[e] * sigmoid_f(v1[e]); } }
                    u32x4 w; w.x = cvt_pk_bf16(v0[0], v0[1]); w.y = cvt_pk_bf16(v0[2], v0[3]); w.z = cvt_pk_bf16(v1[0], v1[1]); w.w = cvt_pk_bf16(v1[2], v1[3]);
                    *(u32x4*)(rowp + bj * HALF) = w; } }
    }
};
struct Order {
    int nM, nN, nwg, G, c, latent_only, grouped, vc, nctx;
    __device__ void init(int nM_, int nN_, int G_, int c_, int lat) { nM = nM_; nN = nN_; nwg = nM * nN; G = G_; c = c_; latent_only = lat; grouped = 0; vc = 0; nctx = 0; }
    __device__ void init_grouped(int G_, int vc_, int with_ctx) { init(64, 4, G_, vc_, 1); grouped = 1; vc = vc_; nctx = with_ctx ? 64 : 0; }
    __device__ bool next(int i, Unit& u) const {
        if (grouped) {
            const int gi = i >> 2, grp = vc + gi * G;
            if (grp < 256) { const int pm = grp >> 2; u.pm = pm + pm / 16 + 1; u.pn = 4 * (i & 3) + (grp & 3); return true; }
            const int done = ((256 - vc + G - 1) / G) * 4;
            const int x = vc + (i - done) * G;
            if (i >= done && x < nctx) { const int g = x >> 2, k = x & 3; u.pm = (g >> 2) * 17; u.pn = 4 * k + (g & 3); return true; }
            return false;
        }
        const long L = (long)i * G + c; if (L >= nwg) return false;
        int wgid = (int)L; { const int q = nwg / NXCD, r = nwg % NXCD, xcd = wgid % NXCD, off = wgid / NXCD; wgid = (xcd < r ? xcd * (q + 1) : r * (q + 1) + (xcd - r) * q) + off; }
        const int nig = WGM * nN, gid = wgid / nig, fm = gid * WGM, gsz = (nM - fm) < WGM ? (nM - fm) : WGM;
        int pm = fm + ((wgid % nig) % gsz); u.pn = (wgid % nig) / gsz; if (latent_only == 1) pm = pm + pm / 16 + 1; else if (latent_only == 2) pm = pm * 17; u.pm = pm; return true;
    }
    __device__ __forceinline__ void a_ready(const Unit&) const {}
    __device__ __forceinline__ void done(const Unit&) const {}
};
template <class Epi, class Sched, bool ALIGN_EPI = false, bool SP2 = false>
__device__ __forceinline__ void gemm_phase(PG8_LAS unsigned char* lds, const Gemm g, const Sched& S, const Epi& E, const int tid  ) {
    const int wid = __builtin_amdgcn_readfirstlane(tid >> 6), lane = tid & 63, wr = wid >> 2, wc = wid & 3, fr = lane & 15, fq = lane >> 4;
    const int K = g.K, nt = K / BK;
    unsigned voffA[2], voffB[2];
#pragma unroll
    for (int i = 0; i < 2; ++i) { int R, C; stage_rc(tid * 16 + i * 8192, R, C); const int Rb = Epi::PERM ? ((R & ~31) + perm32(R & 31)) : R;
        voffA[i] = (unsigned)(R * g.lda + C) * 2u; voffB[i] = (unsigned)(Rb * K + C) * 2u; }
    const size_t kstep = (size_t)(BK * 2);
    const size_t hstepA = (size_t)HALF * g.lda * 2, hstepB = (size_t)HALF * K * 2;
    const size_t tstepA = 2 * hstepA, tstepB = 2 * hstepB;
    const unsigned ldsw = (unsigned)wid * 1024u;
    const int aoff = lds_byte(wr * 64 + fr, fq * 8), boff = lds_byte(wc * 32 + fr, fq * 8);
#define PG8_SA(b, h) (((b) * 2 + (h)) * HTB)
#define PG8_SB(b, h) ((4 + (b) * 2 + (h)) * HTB)
#define PG8_STAGE(bufoff, gbase, voff) do { _Pragma("unroll") for (int _i = 0; _i < 2; ++_i) \
        __builtin_amdgcn_global_load_lds((const unsigned*)((const char*)(gbase) + (voff)[_i]), (PG8_LAS unsigned*)(lds + (bufoff) + ldsw + _i * 8192), 16, 0, 0); } while (0)
#define PG8_LDA(dst, b, h) do { _Pragma("unroll") for (int m = 0; m < 4; ++m) _Pragma("unroll") for (int k = 0; k < 2; ++k) dst[m][k] = *(const PG8_LAS bf16x8*)(lds + PG8_SA(b, h) + aoff + m * 2048 + k * 1024); } while (0)
#define PG8_LDB(dst, b, h) do { _Pragma("unroll") for (int n = 0; n < 2; ++n) _Pragma("unroll") for (int k = 0; k < 2; ++k) dst[n][k] = *(const PG8_LAS bf16x8*)(lds + PG8_SB(b, h) + boff + n * 2048 + k * 1024); } while (0)
#define PG8_MMA(ai, bj, At, Bt) do { __builtin_amdgcn_s_setprio(1); _Pragma("unroll") for (int m = 0; m < 4; ++m) _Pragma("unroll") for (int n = 0; n < 2; ++n) _Pragma("unroll") for (int k = 0; k < 2; ++k) \
        acc[ai][bj][m][n] = __builtin_amdgcn_mfma_f32_16x16x32_bf16(Bt[n][k], At[m][k], acc[ai][bj][m][n], 0, 0, 0); __builtin_amdgcn_s_setprio(0); } while (0)
#define PG8_WAIT_V(n) asm volatile("s_waitcnt vmcnt(" #n ")" ::: "memory")
#define PG8_WAIT_L(n) asm volatile("s_waitcnt lgkmcnt(" #n ")" ::: "memory")
#define PG8_BAR __builtin_amdgcn_s_barrier()
#define PG8_SCHED __builtin_amdgcn_sched_barrier(0)
    Unit cur, nxt; int ui = 0;
    if (!S.next(0, cur)) return;
    f32x4 acc[2][2][4][2];
#pragma unroll
    for (int a = 0; a < 2; ++a)
#pragma unroll
        for (int b = 0; b < 2; ++b)
#pragma unroll
            for (int m = 0; m < 4; ++m)
#pragma unroll
                for (int n = 0; n < 2; ++n) acc[a][b][m][n] = (f32x4){0.f, 0.f, 0.f, 0.f};
    bf16x8 At[4][2], B0[2][2], B1[2][2];
    const char* cA = (const char*)g.A + (size_t)cur.pm * tstepA + (size_t)(cur.pn >> g.a_shift) * (size_t)g.a_step; const char* cB = (const char*)g.Bt + (size_t)cur.pn * tstepB;
    S.a_ready(cur);
    if constexpr (SP2) {
        PG8_STAGE(PG8_SB(0, 0), cB, voffB); PG8_STAGE(PG8_SB(0, 1), cB + hstepB, voffB); PG8_STAGE(PG8_SA(0, 0), cA, voffA); PG8_STAGE(PG8_SA(0, 1), cA + hstepA, voffA);
        if (wr == 1) PG8_BAR;
        PG8_WAIT_V(2); PG8_BAR;
        PG8_STAGE(PG8_SB(1, 0), cB + kstep, voffB); PG8_STAGE(PG8_SA(1, 0), cA + kstep, voffA); PG8_STAGE(PG8_SB(1, 1), cB + hstepB + kstep, voffB);
        PG8_WAIT_V(6); PG8_BAR;
    } else {
        PG8_STAGE(PG8_SB(0, 0), cB, voffB); PG8_STAGE(PG8_SA(0, 0), cA, voffA); PG8_STAGE(PG8_SB(0, 1), cB + hstepB, voffB); PG8_STAGE(PG8_SA(0, 1), cA + hstepA, voffA);
        if (wr == 1) PG8_BAR;
        PG8_WAIT_V(4); PG8_BAR;
        PG8_STAGE(PG8_SB(1, 0), cB + kstep, voffB); PG8_STAGE(PG8_SA(1, 0), cA + kstep, voffA); PG8_STAGE(PG8_SB(1, 1), cB + hstepB + kstep, voffB);
        PG8_WAIT_V(6); PG8_BAR;
    }
    for (;;) {
        const bool has_next = S.next(ui + 1, nxt);
        const char* nA = has_next ? (const char*)g.A + (size_t)nxt.pm * tstepA + (size_t)(nxt.pn >> g.a_shift) * (size_t)g.a_step : cA; const char* nB = has_next ? (const char*)g.Bt + (size_t)nxt.pn * tstepB : cB;
        for (int t = 0; t < nt; t += 2) {
            const bool last = (t == nt - 2);
            const char* a1 = cA + (size_t)(t + 1) * kstep;
            const char* a2 = last ? nA : cA + (size_t)(t + 2) * kstep; const char* b2 = last ? nB : cB + (size_t)(t + 2) * kstep;
            const char* a3 = a2 + kstep; const char* b3 = b2 + kstep;
            if (last && has_next) S.a_ready(nxt);
            if constexpr (SP2) {
            PG8_LDB(B0, 0, 0); PG8_LDB(B1, 0, 1); PG8_SCHED; PG8_LDA(At, 0, 0); PG8_STAGE(PG8_SA(1, 1), a1 + hstepA, voffA);
            PG8_WAIT_V(8); PG8_WAIT_L(0); PG8_BAR; PG8_MMA(0, 0, At, B0); PG8_MMA(0, 1, At, B1); PG8_BAR; PG8_SCHED;
            PG8_LDA(At, 0, 1); PG8_STAGE(PG8_SB(0, 0), b2, voffB); PG8_STAGE(PG8_SB(0, 1), b2 + hstepB, voffB); PG8_STAGE(PG8_SA(0, 0), a2, voffA);
            PG8_WAIT_V(8); PG8_WAIT_L(0); PG8_BAR; PG8_MMA(1, 0, At, B0); PG8_MMA(1, 1, At, B1); PG8_BAR; PG8_SCHED;
            PG8_LDB(B0, 1, 0); PG8_LDB(B1, 1, 1); PG8_SCHED; PG8_LDA(At, 1, 0); PG8_STAGE(PG8_SA(0, 1), a2 + hstepA, voffA);
            PG8_WAIT_V(8); PG8_WAIT_L(0); PG8_BAR; PG8_MMA(0, 0, At, B0); PG8_MMA(0, 1, At, B1); PG8_BAR; PG8_SCHED;
            PG8_LDA(At, 1, 1); PG8_STAGE(PG8_SB(1, 0), b3, voffB); PG8_STAGE(PG8_SB(1, 1), b3 + hstepB, voffB); PG8_STAGE(PG8_SA(1, 0), a3, voffA);
            PG8_WAIT_V(8); PG8_WAIT_L(0); PG8_BAR; PG8_MMA(1, 0, At, B0); PG8_MMA(1, 1, At, B1); PG8_BAR; PG8_SCHED;
            } else {
            PG8_LDB(B0, 0, 0); PG8_SCHED; PG8_LDA(At, 0, 0); PG8_STAGE(PG8_SA(1, 1), a1 + hstepA, voffA);
            PG8_WAIT_L(8); PG8_BAR; PG8_WAIT_L(0); PG8_MMA(0, 0, At, B0); PG8_BAR; PG8_SCHED;
            PG8_LDB(B1, 0, 1); PG8_STAGE(PG8_SB(0, 0), b2, voffB);
            PG8_BAR; PG8_WAIT_L(0); PG8_MMA(0, 1, At, B1); PG8_BAR;
            PG8_LDA(At, 0, 1); PG8_STAGE(PG8_SA(0, 0), a2, voffA);
            PG8_BAR; PG8_WAIT_L(0); PG8_MMA(1, 0, At, B0); PG8_BAR; PG8_SCHED;
            PG8_STAGE(PG8_SB(0, 1), b2 + hstepB, voffB);
            PG8_WAIT_V(6); PG8_BAR; PG8_MMA(1, 1, At, B1); PG8_BAR;
            PG8_LDB(B0, 1, 0); PG8_SCHED; PG8_LDA(At, 1, 0); PG8_STAGE(PG8_SA(0, 1), a2 + hstepA, voffA);
            PG8_WAIT_L(8); PG8_BAR; PG8_WAIT_L(0); PG8_MMA(0, 0, At, B0); PG8_BAR; PG8_SCHED;
            PG8_LDB(B1, 1, 1); PG8_STAGE(PG8_SB(1, 0), b3, voffB);
            PG8_BAR; PG8_WAIT_L(0); PG8_MMA(0, 1, At, B1); PG8_BAR;
            PG8_LDA(At, 1, 1); PG8_STAGE(PG8_SA(1, 0), a3, voffA);
            PG8_BAR; PG8_WAIT_L(0); PG8_MMA(1, 0, At, B0); PG8_BAR; PG8_SCHED;
            PG8_STAGE(PG8_SB(1, 1), b3 + hstepB, voffB);
            PG8_WAIT_V(6); PG8_BAR; PG8_MMA(1, 1, At, B1); PG8_BAR;
            }
        }
        if constexpr (ALIGN_EPI) { if (wr == 0) PG8_BAR; }
        if constexpr (!Epi::AFTER_DRAIN) { E(acc, cur, wr, wc, fr, fq); S.done(cur); }
        if (!has_next) break;
#pragma unroll
        for (int a = 0; a < 2; ++a)
#pragma unroll
            for (int b = 0; b < 2; ++b)
#pragma unroll
                for (int m = 0; m < 4; ++m)
#pragma unroll
                    for (int n = 0; n < 2; ++n) acc[a][b][m][n] = (f32x4){0.f, 0.f, 0.f, 0.f};
        cur = nxt; cA = nA; cB = nB; ++ui;
        if constexpr (ALIGN_EPI) { if (wr == 1) PG8_BAR; }
    }
    PG8_WAIT_V(0);
    if constexpr (!ALIGN_EPI) { if (wr == 0) PG8_BAR; }
    PG8_BAR;
    if constexpr (Epi::AFTER_DRAIN) { E.fused(acc, cur, wr, wc, fr, fq, lds, wid, lane); S.done(cur); }
#undef PG8_SA
#undef PG8_SB
#undef PG8_STAGE
#undef PG8_LDA
#undef PG8_LDB
#undef PG8_MMA
#undef PG8_WAIT_V
#undef PG8_WAIT_L
#undef PG8_BAR
#undef PG8_SCHED
}
}
#define PG8_SP2 true
#define PG8_ALIGN true
#define GAS __attribute__((address_space(1)))
#define LAS __attribute__((address_space(3)))
typedef unsigned short bf16;
typedef unsigned v4u __attribute__((ext_vector_type(4)));
typedef float f32x4 __attribute__((ext_vector_type(4)));
typedef short bf16x8 __attribute__((ext_vector_type(8)));
typedef GAS unsigned gu32;
typedef GAS unsigned long long gu64;
#define RLX_AGENT __ATOMIC_RELAXED, __HIP_MEMORY_SCOPE_AGENT
#define LDS_WAIT() asm volatile("s_waitcnt lgkmcnt(0)" ::: "memory")
#define VM_WAIT() asm volatile("s_waitcnt vmcnt(0)" ::: "memory")
__device__ __forceinline__ unsigned long long rt() { return __builtin_amdgcn_s_memrealtime(); }
__device__ __forceinline__ unsigned f2bf(float f) { unsigned u = __builtin_bit_cast(unsigned, f); return (u + 0x7fffu + ((u >> 16) & 1u)) >> 16; }
__device__ __forceinline__ unsigned pk2(float lo, float hi) { return f2bf(lo) | (f2bf(hi) << 16); }
#define XB_TMO      128
#define XB_XCNT(j)  (256  + 64 * (j))
#define XB_XSUB(j)  (1280 + 64 * (j))
#define XB_XGEN(j)  (2304 + 64 * (j))
#define XB_TOP      3328
#define XB_TOPGEN   3392
#define XCD_BAR_WORDS 3456
#define XB_SPIN_CAP (1u << 18)

__device__ __forceinline__ unsigned xb_ld(unsigned* p)              { return __hip_atomic_load(p, __ATOMIC_RELAXED, __HIP_MEMORY_SCOPE_AGENT); }
__device__ __forceinline__ unsigned xb_add(unsigned* p, unsigned v) { return __hip_atomic_fetch_add(p, v, __ATOMIC_RELAXED, __HIP_MEMORY_SCOPE_AGENT); }
__device__ __forceinline__ unsigned xb_xcc_id() { return (unsigned)__builtin_amdgcn_s_getreg((3 << 11) | 20) & 0xFu; }
#define XB_SPIN(cond, bar) do { unsigned _sp = 0; while (cond) { __builtin_amdgcn_s_sleep(1); \
    if ((++_sp & 255u) == 0u) { if (xb_ld(&(bar)[XB_TMO])) break; if (_sp > XB_SPIN_CAP) { atomicAdd(&(bar)[XB_TMO], 1u); break; } } } } while (0)

struct XcdBarrier {
    unsigned* bar; unsigned x;
    volatile LAS unsigned* st;
};

__device__ __forceinline__ XcdBarrier xcd_barrier_post(unsigned* bar, volatile LAS unsigned* st) {
    XcdBarrier b; b.bar = bar; b.x = xb_xcc_id(); b.st = st;
    if (threadIdx.x == 0) (void)xb_add(&bar[XB_XCNT(b.x)], 1u);
    return b;
}
__device__ __forceinline__ void xcd_barrier_complete(unsigned* bar, unsigned x, unsigned& nloc, unsigned& nx) {
    const unsigned G = gridDim.x * gridDim.y * gridDim.z;
    unsigned sum, cnt, mine, sp = 0u;
    for (;;) {
        sum = 0u; cnt = 0u; mine = 0u;
#pragma unroll
        for (unsigned j = 0; j < 16; ++j) { const unsigned c = xb_ld(&bar[XB_XCNT(j)]); sum += c; cnt += (c > 0u) ? 1u : 0u; mine = (j == x) ? c : mine; }
        if (sum == G) break;
        __builtin_amdgcn_s_sleep(1);
        if ((++sp & 255u) == 0u) { if (xb_ld(&bar[XB_TMO])) break; if (sp > XB_SPIN_CAP) { atomicAdd(&bar[XB_TMO], 1u); break; } }
    }
    nloc = mine > 0u ? mine : 1u; nx = cnt > 0u ? cnt : 1u;
}

__device__ __forceinline__ void xcd_barrier(const XcdBarrier& b) {
    asm volatile("s_waitcnt vmcnt(0)" ::: "memory");
    __syncthreads();
    if (threadIdx.x == 0) {
        unsigned* bar = b.bar;
        __builtin_amdgcn_s_waitcnt(0);
        unsigned nloc = b.st[0], nx = b.st[1];
        if (nloc == 0u) { xcd_barrier_complete(bar, b.x, nloc, nx); b.st[0] = nloc; b.st[1] = nx; }
        const unsigned old = xb_add(&bar[XB_XSUB(b.x)], 1u);
        const unsigned gen = old / nloc;
        if (old + 1u == (gen + 1u) * nloc) {
            __builtin_amdgcn_fence(__ATOMIC_RELEASE, "agent");
            asm volatile("s_waitcnt vmcnt(0)" ::: "memory");
            const unsigned og = xb_add(&bar[XB_TOP], 1u);
            const unsigned tg = og / nx;
            if (og + 1u == (tg + 1u) * nx) xb_add(&bar[XB_TOPGEN], 1u);
            else XB_SPIN(xb_ld(&bar[XB_TOPGEN]) == tg, bar);
            __builtin_amdgcn_fence(__ATOMIC_ACQUIRE, "agent");
            xb_add(&bar[XB_XGEN(b.x)], 1u);
            asm volatile("s_waitcnt vmcnt(0)" ::: "memory");
        } else {
            XB_SPIN(xb_ld(&bar[XB_XGEN(b.x)]) == gen, bar);
            __builtin_amdgcn_fence(__ATOMIC_ACQUIRE, "agent");
            asm volatile("s_waitcnt vmcnt(0)" ::: "memory");
        }
    }
    __syncthreads();
}
constexpr int NB = 4, SEQ = 4096, CTXL = 256, TPB = SEQ + CTXL, NROWS = NB * TPB, DM = 1024, NLAYER = 2, IN_COLS = 6816;
constexpr int NWAVES = 8, NTHREADS = NWAVES * 64;
constexpr float RMS_EPS = 1e-6f;
constexpr float LOG2E = 1.4426950408889634f;
constexpr float QSCALE64 = 0.125f * LOG2E;
constexpr float QSCALE96 = 0.10206207261596575f * LOG2E;
constexpr int ZS_P = 1792, ZC_CQ = 0, ZC_CKV = 256, ZC_KR = 384, ZC_SQ = 512, ZC_SK = 768, ZC_SV = 896, ZC_AQ = 1024, ZC_AK = 1280, ZC_AV = 1408, ZC_LRU = 1536;
constexpr int N1 = 2816;
constexpr int W1ROWS = N1 + 4096;
constexpr size_t MiB = 1u << 20;
constexpr size_t WS_CTL = 0, CTL_ZERO_BYTES = 64 * 1024;
constexpr size_t WS_MOD = 1 * MiB;
constexpr size_t WS_RHC = 1 * MiB + 256 * 1024, WS_RHS = WS_RHC + 512 * 1024;
constexpr size_t WS_RMC = WS_RHS + 512 * 1024, WS_RMS = WS_RMC + 256 * 1024;
constexpr size_t WS_CTX1 = 3 * MiB;
constexpr size_t WS_WOS = 3 * MiB;
constexpr size_t WS_W = 8 * MiB, W_LAYER = 18 * MiB;
constexpr size_t WO_W1 = 0, WO_WB = 13 * MiB + 512 * 1024, WO_WO = WO_WB + 2 * MiB, WO_UQ = WO_WO + 2 * MiB, WO_UKV = WO_UQ + 256 * 1024;
constexpr size_t WS_H = 44 * MiB;
constexpr size_t WS_G = 78 * MiB;
constexpr size_t WS_S = 112 * MiB;
constexpr size_t WS_ZS = 112 * MiB;
constexpr size_t WS_MQ = 172 * MiB;
constexpr size_t WS_MKV = 189 * MiB;
constexpr size_t WS_MK = 206 * MiB;
constexpr size_t WS_U = 219 * MiB;
constexpr size_t WS_HF = 236 * MiB;
constexpr size_t WS_SP = 2 * MiB + 768 * 1024;
constexpr size_t WS_LWT = 254 * MiB + 512 * 1024;
constexpr size_t WS_END = 256 * MiB;
static_assert(WS_H + (size_t)NROWS * 1024 * 2 <= WS_G && WS_G + (size_t)NROWS * 1024 * 2 <= WS_S && WS_S + (size_t)NROWS * 4096 * 2 <= 248 * MiB, "ws map");
static_assert(WS_ZS + (size_t)NROWS * ZS_P * 2 <= WS_MQ && WS_MK + (size_t)NROWS * 384 * 2 <= WS_U, "ws map 2");
static_assert(WO_UKV + 512 * 256 * 2 <= W_LAYER, "weights");
constexpr int CW_BAR = 1024;
constexpr int CW_FLG = 8192;

constexpr int RING_OFF = 0, RING_BYTES = 131072, LDSCTL_OFF = RING_BYTES, MISC_OFF = LDSCTL_OFF + 320, LDS_BYTES = 147456;

typedef unsigned short bf16;
typedef unsigned u32x2 __attribute__((ext_vector_type(2)));
typedef float f32x2v __attribute__((ext_vector_type(2)));
__device__ __forceinline__ float bf2f(bf16 v) { return __uint_as_float((unsigned)v << 16); }
template <int O> __device__ __forceinline__ float xor_swz(float v) { return __int_as_float(__builtin_amdgcn_ds_swizzle(__float_as_int(v), (O << 10) | 0x1F)); }
__device__ __forceinline__ float wave_sum(float v) {
    v += xor_swz<1>(v); v += xor_swz<2>(v); v += xor_swz<4>(v); v += xor_swz<8>(v); v += xor_swz<16>(v);
    auto rr = __builtin_amdgcn_permlane32_swap(__float_as_uint(v), __float_as_uint(v), false, false); return __uint_as_float(rr[0]) + __uint_as_float(rr[1]); }
__device__ __forceinline__ float wave_max(float v) {
    v = fmaxf(v, xor_swz<1>(v)); v = fmaxf(v, xor_swz<2>(v)); v = fmaxf(v, xor_swz<4>(v)); v = fmaxf(v, xor_swz<8>(v)); v = fmaxf(v, xor_swz<16>(v));
    auto rr = __builtin_amdgcn_permlane32_swap(__float_as_uint(v), __float_as_uint(v), false, false); return fmaxf(__uint_as_float(rr[0]), __uint_as_float(rr[1])); }
__device__ __forceinline__ float grp16_sum(float v) {
    v += xor_swz<1>(v); v += xor_swz<2>(v); v += xor_swz<4>(v); v += xor_swz<8>(v); return v; }

struct Args { const float* in[28]; float* out; unsigned char* ws; int ph_lo, ph_hi; };
enum { I_X = 0, I_C, I_CTX, I_CCTX, I_WMOD, I_BMOD, I_NORMW, I_WIN, I_CQN, I_CKVN, I_WUQ, I_WUKV, I_MQN, I_MKN, I_SQN, I_SKN, I_SINK, I_AQN, I_AKN,
       I_CONVW, I_CONVB, I_LWR, I_LBR, I_LWI, I_LBI, I_LAM, I_WBR, I_WOUT };

struct Frame {
    LAS unsigned char* lds; const float* const __attribute__((address_space(4)))* kin; unsigned char* ws; float* out;
    int tid, lane, wave, G, vcu, gw, NGW, z;
    __device__ __forceinline__ const float* in(int i) const { return kin[i]; }
};

__device__ __forceinline__ void xpose_item(const float* W, int ldn, int k0, int n0, bf16* WT, int pd, int drow, LAS float* scr, int lane) {
    float v[32]; const float* wp = W + (size_t)(k0 + (lane >> 5)) * ldn + n0 + (lane & 31);
#pragma unroll
    for (int i = 0; i < 32; ++i) v[i] = wp[(size_t)(2 * i) * ldn];
#pragma unroll
    for (int i = 0; i < 32; ++i) scr[(2 * i + (lane >> 5)) * 33 + (lane & 31)] = v[i];
    LDS_WAIT(); asm volatile("" ::: "memory");
    const int c = lane & 7;
#pragma unroll
    for (int j = 0; j < 4; ++j) { const int n = (lane >> 3) + 8 * j; const LAS float* s = scr + (8 * c) * 33 + n;
        v4u o; o.x = pk2(s[0 * 33], s[1 * 33]); o.y = pk2(s[2 * 33], s[3 * 33]); o.z = pk2(s[4 * 33], s[5 * 33]); o.w = pk2(s[6 * 33], s[7 * 33]);
        *(GAS v4u*)(WT + (size_t)(drow + n0 + n) * pd + k0 + 8 * c) = o; }
    LDS_WAIT(); asm volatile("" ::: "memory");
}
__device__ __forceinline__ void zero16(bf16* p, size_t n16, int gt, int ngt) {
    for (size_t i = gt; i < n16; i += ngt) ((GAS v4u*)p)[i] = (v4u){0u, 0u, 0u, 0u};
}
constexpr int N1T = 2816 / 32;
constexpr int I_EARLY = 16 * N1T + 4 * 12 + 2 * 16, I_INL = 16 * (213 - N1T), I_BR = 4 * 4 * 32, I_OUT = 16 * 32, I_LAYER = I_EARLY + I_INL + I_BR + I_OUT, I_SPLIT = 16 * 32;
__device__ __forceinline__ void copy_item(Frame& F, int l, int r, LAS float* scr) {
    unsigned char* wl = F.ws + WS_W + (size_t)l * W_LAYER;
    if (r < 16 * N1T) { const int kb = r / N1T, nb = r % N1T, n0 = nb * 32;
        xpose_item(F.in(I_WIN) + (size_t)l * 1024 * IN_COLS, IN_COLS, kb * 64, n0, (bf16*)(wl + WO_W1), 1024, n0 >= 416 ? 96 : 0, scr, F.lane); return; } r -= 16 * N1T;
    if (r < 4 * 12) { const int kb = r / 12, nb = r % 12;
        xpose_item(F.in(I_WUQ) + (size_t)l * 256 * 384, 384, kb * 64, nb * 32, (bf16*)(wl + WO_UQ), 256, 0, scr, F.lane); return; } r -= 4 * 12;
    if (r < 2 * 16) { const int kb = r / 16, nb = r % 16;
        xpose_item(F.in(I_WUKV) + (size_t)l * 128 * 512, 512, kb * 64, nb * 32, (bf16*)(wl + WO_UKV), 256, 0, scr, F.lane); return; } r -= 2 * 16;
    if (r < I_INL) { const int kb = r / (213 - N1T), nb = N1T + r % (213 - N1T), n0 = nb * 32;
        xpose_item(F.in(I_WIN) + (size_t)l * 1024 * IN_COLS, IN_COLS, kb * 64, n0, (bf16*)(wl + WO_W1), 1024, 96, scr, F.lane); return; } r -= I_INL;
    if (r < I_BR) { const int k = r / 128, rr = r % 128, kb = rr / 32, nb = rr % 32;
        xpose_item(F.in(I_WBR) + ((size_t)l * 4 + k) * 256 * 1024, 1024, kb * 64, nb * 32, (bf16*)(wl + WO_WB) + (size_t)k * 1024 * 256, 256, 0, scr, F.lane); return; } r -= I_BR;
    if (r < I_OUT) { const int kb = r / 32, nb = r % 32;
        xpose_item(F.in(I_WOUT) + (size_t)l * 1024 * 1024, 1024, kb * 64, nb * 32, (bf16*)(wl + WO_WO), 1024, 0, scr, F.lane); return; } r -= I_OUT;
    if (r < I_SPLIT) { const int kb = r / 32, nb = r % 32, kq = kb >> 2;
        xpose_item(F.in(I_WOUT), 1024, kb * 64, nb * 32, (bf16*)(F.ws + WS_WOS) + (size_t)kq * (1024 * 256 - 256), 256, 0, scr, F.lane); }
}
__device__ __forceinline__ void weight_copies(Frame& F, int first, int stride, int loA, int nA, int loB, int nB) {
    LAS float* scr = (LAS float*)(F.lds + RING_OFF + F.wave * 16384);
#pragma unroll 1
    for (int v = first; v < nA + nB; v += stride) { const bool a = v < nA; copy_item(F, a ? 0 : NLAYER - 1, a ? loA + v : loB + v - nA, scr); }
}
constexpr int IC_G1 = 320;
__device__ __forceinline__ void p0_tables(Frame& F, int gt, int ngt) {
    { float* rhc = (float*)(F.ws + WS_RHC); float* rhs = (float*)(F.ws + WS_RHS); float* rmc = (float*)(F.ws + WS_RMC); float* rms = (float*)(F.ws + WS_RMS);
      constexpr float L2_10000 = 13.287712379549449f, INV_2PI = 0.15915494309189535f;
      for (int i = gt; i < 4096 * 32; i += ngt) { const int t = i >> 5, p = i & 31; const float fr = __builtin_amdgcn_exp2f(-(float)(p & 15) * (L2_10000 / 16.0f));
          const float pos = (float)((p < 16) ? (t >> 6) : (t & 63)); const float rev = pos * fr * INV_2PI; rhc[i] = __builtin_amdgcn_cosf(rev); rhs[i] = __builtin_amdgcn_sinf(rev); }
      for (int i = gt; i < 4096 * 16; i += ngt) { const int t = i >> 4, p = i & 15; const float fr = __builtin_amdgcn_exp2f(-(float)(p & 7) * (L2_10000 / 8.0f));
          const float pos = (float)((p < 8) ? (t >> 6) : (t & 63)); const float rev = pos * fr * INV_2PI; rmc[i] = __builtin_amdgcn_cosf(rev); rms[i] = __builtin_amdgcn_sinf(rev); } }
    { float* sp = (float*)(F.ws + WS_SP); for (int i = gt; i < NLAYER * 2 * 256; i += ngt) sp[i] = 8.0f * LOG2E * log1pf(expf(-F.in(I_LAM)[i])); }
    { float* lwt = (float*)(F.ws + WS_LWT);
      for (int o = gt; o < NLAYER * 2 * 2 * 256 * 64; o += ngt) { const int i = o & 63, c = (o >> 6) & 255, gate = (o >> 14) & 1, ld = o >> 15, k = c >> 6, j = c & 63;
          lwt[o] = (gate == 0 ? F.in(I_LWR) : F.in(I_LWI))[(((size_t)ld * 4 + k) * 64 + i) * 64 + j]; } }
}
__device__ __forceinline__ void p0_prologue(Frame& F) {
    weight_copies(F, F.gw, F.NGW, 0, I_EARLY, 0, 0);
    const int gt = F.vcu * NTHREADS + F.tid, ngt = F.G * NTHREADS;
    for (int l = 0; l < NLAYER; ++l) {
        unsigned char* wl = F.ws + WS_W + (size_t)l * W_LAYER;
        zero16((bf16*)(wl + WO_W1) + (size_t)416 * 1024, 96 * 1024 * 2 / 16, gt, ngt);
        zero16((bf16*)(wl + WO_UQ) + (size_t)384 * 256, 128 * 256 * 2 / 16, gt, ngt);
        for (int i = gt; i < 512 * 16; i += ngt) { const int n = i >> 4, c = i & 15; ((GAS v4u*)((bf16*)(wl + WO_UKV) + (size_t)n * 256 + 128))[c] = (v4u){0u, 0u, 0u, 0u}; }
    }
    { LAS float* sc = (LAS float*)(F.lds + RING_OFF);
      LAS float* red = sc + 5 * 1024;
      __syncthreads();
      for (int i = F.tid; i < 5 * 1024; i += NTHREADS) { const float v = (i < 4096) ? F.in(I_C)[i] : F.in(I_CCTX)[i - 4096]; sc[i] = v / (1.0f + expf(-v)); }
      __syncthreads();
      float* modv = (float*)(F.ws + WS_MOD);
      for (int it = F.vcu; it < NLAYER * 96; it += F.G) {
          const int l = it / 96, n0 = (it % 96) * 32, nn = F.tid & 31, kc = F.tid >> 5;
          const float* w = F.in(I_WMOD) + (size_t)l * 1024 * 3072 + n0 + nn;
          float acc[5] = {0.f, 0.f, 0.f, 0.f, 0.f};
#pragma unroll 1
          for (int k0 = kc * 64; k0 < kc * 64 + 64; k0 += 32) { float wv[32];
#pragma unroll
              for (int i = 0; i < 32; ++i) wv[i] = w[(size_t)(k0 + i) * 3072];
#pragma unroll
              for (int i = 0; i < 32; ++i)
#pragma unroll
                  for (int r = 0; r < 5; ++r) acc[r] += sc[r * 1024 + k0 + i] * wv[i]; }
#pragma unroll
          for (int r = 0; r < 5; ++r) red[(kc * 5 + r) * 32 + nn] = acc[r];
          __syncthreads();
          if (F.tid < 160) { const int r = F.tid >> 5; float s = 0.f;
              for (int q = 0; q < 16; ++q) s += red[(q * 5 + r) * 32 + nn];
              modv[((size_t)l * 5 + r) * 3072 + n0 + nn] = s + F.in(I_BMOD)[l * 3072 + n0 + nn]; }
          __syncthreads();
      } }
}

__device__ __forceinline__ void ph_hnorm(Frame& F, int l) {
    const float* xs = (l == 0) ? F.in(I_X) : F.out; const float* cs = (l == 0) ? F.in(I_CTX) : (const float*)(F.ws + WS_CTX1);
    const float* nw = F.in(I_NORMW) + l * 1024; const float* modl = (const float*)(F.ws + WS_MOD) + (size_t)l * 5 * 3072;
    bf16* H = (bf16*)(F.ws + WS_H);
    for (int row = F.gw; row < NROWS; row += F.NGW) {
        const int b = row / TPB, j = row % TPB; const float* src; int mr;
        if (j < CTXL) { src = cs + ((size_t)b * CTXL + j) * 1024; mr = 4; } else { src = xs + ((size_t)b * SEQ + (j - CTXL)) * 1024; mr = b; }
        const GAS f32x4* xr = (const GAS f32x4*)src + F.lane;
        f32x4 v[4]; float ss = 0.f;
        if (l > 0 && j < CTXL) {
            const unsigned short* P = (const unsigned short*)(F.ws + WS_S) + (size_t)row * 4096 + 4 * F.lane;
            const float* gt = (const float*)(F.ws + WS_MOD) + 4 * 3072 + 2048 + 4 * F.lane;
            const GAS f32x4* c0 = (const GAS f32x4*)(F.in(I_CTX) + ((size_t)b * CTXL + j) * 1024) + F.lane;
#pragma unroll
            for (int q = 0; q < 4; ++q) { f32x4 a = {0.f, 0.f, 0.f, 0.f};
#pragma unroll
                for (int kq = 0; kq < 4; ++kq) { const u32x2 w = *(const u32x2*)(P + kq * 1024 + 256 * q); a.x += bflo(w.x); a.y += bfhi(w.x); a.z += bflo(w.y); a.w += bfhi(w.y); }
                v[q] = c0[64 * q] + *(const f32x4*)(gt + 256 * q) * a; }
        } else {
#pragma unroll
            for (int q = 0; q < 4; ++q) v[q] = xr[64 * q];
        }
#pragma unroll
        for (int q = 0; q < 4; ++q) ss += (v[q].x * v[q].x + v[q].y * v[q].y) + (v[q].z * v[q].z + v[q].w * v[q].w);
        const float rstd = 1.0f / sqrtf(wave_sum(ss) * (1.0f / 1024.0f) + RMS_EPS);
        const float* mrow = modl + mr * 3072;
        GAS unsigned long long* o8 = (GAS unsigned long long*)(H + (size_t)row * 1024) + F.lane;
#pragma unroll
        for (int q = 0; q < 4; ++q) { const int c = 4 * F.lane + 256 * q;
            const f32x4 g = *(const f32x4*)(nw + c), sh = *(const f32x4*)(mrow + c), sc = *(const f32x4*)(mrow + 1024 + c);
            const f32x4 h = v[q] * rstd * g * (sc + 1.0f) + sh;
            o8[64 * q] = (unsigned long long)pk2(h.x, h.y) | ((unsigned long long)pk2(h.z, h.w) << 32); }
    }
}

struct P1Regs { u32x2 cq; unsigned ckv, h[3][2]; float rc[2], rs[2]; };
__device__ __forceinline__ void post1_load(const bf16* z, const float* rc, const float* rs, bool lat, int lane, P1Regs& R) {
    const int hg = lane >> 4, p0 = (lane & 15) * 2;
    R.cq = *(const u32x2*)(z + ZC_CQ + 4 * lane); R.ckv = *(const unsigned*)(z + ZC_CKV + 2 * lane);
    const bf16* h0 = z + ZC_SQ + hg * 64 + p0; const bf16* h1 = z + ZC_AQ + hg * 64 + p0; const bf16* h2 = z + ((hg < 2) ? (ZC_SK + hg * 64) : (ZC_AK + (hg - 2) * 64)) + p0;
    R.h[0][0] = *(const unsigned*)h0; R.h[0][1] = *(const unsigned*)(h0 + 32); R.h[1][0] = *(const unsigned*)h1; R.h[1][1] = *(const unsigned*)(h1 + 32); R.h[2][0] = *(const unsigned*)h2; R.h[2][1] = *(const unsigned*)(h2 + 32);
    if (lat) { R.rc[0] = rc[p0]; R.rc[1] = rc[p0 + 1]; R.rs[0] = rs[p0]; R.rs[1] = rs[p0 + 1]; } else { R.rc[0] = 1.f; R.rc[1] = 1.f; R.rs[0] = 0.f; R.rs[1] = 0.f; }
}
__device__ __forceinline__ void post1_finish(bf16* z, int lane, const P1Regs& R, const float (&gcq)[4], const float (&gckv)[2], const float (&gh)[3][4]) {
    const int hg = lane >> 4, p0 = (lane & 15) * 2;
    { float v0 = bflo(R.cq.x), v1 = bfhi(R.cq.x), v2 = bflo(R.cq.y), v3 = bfhi(R.cq.y);
      const float rstd = 1.0f / sqrtf(wave_sum(v0 * v0 + v1 * v1 + v2 * v2 + v3 * v3) * (1.0f / 256.0f) + RMS_EPS);
      u32x2 w; w.x = pk2(v0 * rstd * gcq[0], v1 * rstd * gcq[1]); w.y = pk2(v2 * rstd * gcq[2], v3 * rstd * gcq[3]); *(u32x2*)(z + ZC_CQ + 4 * lane) = w; }
    { float v0 = bflo(R.ckv), v1 = bfhi(R.ckv);
      const float rstd = 1.0f / sqrtf(wave_sum(v0 * v0 + v1 * v1) * (1.0f / 128.0f) + RMS_EPS);
      *(unsigned*)(z + ZC_CKV + 2 * lane) = pk2(v0 * rstd * gckv[0], v1 * rstd * gckv[1]); }
#pragma unroll
    for (int q = 0; q < 3; ++q) {
        bf16* hp = z + ((q == 0) ? (ZC_SQ + hg * 64) : (q == 1) ? (ZC_AQ + hg * 64) : ((hg < 2) ? (ZC_SK + hg * 64) : (ZC_AK + (hg - 2) * 64))) + p0;
        float a0 = bflo(R.h[q][0]), a1 = bfhi(R.h[q][0]), b0 = bflo(R.h[q][1]), b1 = bfhi(R.h[q][1]);
        const float rstd = 1.0f / sqrtf(grp16_sum(a0 * a0 + a1 * a1 + b0 * b0 + b1 * b1) * (1.0f / 64.0f) + RMS_EPS);
        a0 *= rstd * gh[q][0]; a1 *= rstd * gh[q][1]; b0 *= rstd * gh[q][2]; b1 *= rstd * gh[q][3];
        const float x0 = a0 * R.rc[0] - b0 * R.rs[0], y0 = b0 * R.rc[0] + a0 * R.rs[0], x1 = a1 * R.rc[1] - b1 * R.rs[1], y1 = b1 * R.rc[1] + a1 * R.rs[1];
        const float sc = (q < 2) ? QSCALE64 : 1.0f;
        *(unsigned*)hp = pk2(x0 * sc, x1 * sc); *(unsigned*)(hp + 32) = pk2(y0 * sc, y1 * sc);
    }
}
__device__ __forceinline__ void ph_post1(Frame& F, int l) {
    bf16* ZS = (bf16*)(F.ws + WS_ZS);
    const float* rhc = (const float*)(F.ws + WS_RHC); const float* rhs = (const float*)(F.ws + WS_RHS);
    const int lane = F.lane, hg = lane >> 4, p0 = (lane & 15) * 2;
    float gcq[4], gckv[2], gh[3][4];
#pragma unroll
    for (int i = 0; i < 4; ++i) gcq[i] = F.in(I_CQN)[l * 256 + 4 * lane + i];
    gckv[0] = F.in(I_CKVN)[l * 128 + 2 * lane]; gckv[1] = F.in(I_CKVN)[l * 128 + 2 * lane + 1];
    { const float* g0 = F.in(I_SQN) + l * 64; const float* g1 = F.in(I_AQN) + l * 64; const float* g2 = ((hg < 2) ? F.in(I_SKN) : F.in(I_AKN)) + l * 64;
      gh[0][0] = g0[p0]; gh[0][1] = g0[p0 + 1]; gh[0][2] = g0[32 + p0]; gh[0][3] = g0[33 + p0];
      gh[1][0] = g1[p0]; gh[1][1] = g1[p0 + 1]; gh[1][2] = g1[32 + p0]; gh[1][3] = g1[33 + p0];
      gh[2][0] = g2[p0]; gh[2][1] = g2[p0 + 1]; gh[2][2] = g2[32 + p0]; gh[2][3] = g2[33 + p0]; }
    for (int row = F.gw; row < NROWS; row += 2 * F.NGW) {
        const int row2 = row + F.NGW; const bool has2 = row2 < NROWS;
        const int j = row % TPB; const bool lat = j >= CTXL; const int pos = lat ? j - CTXL : 0;
        const int j2 = has2 ? row2 % TPB : 0; const bool lat2 = j2 >= CTXL; const int pos2 = lat2 ? j2 - CTXL : 0;
        bf16* z = ZS + (size_t)row * ZS_P; bf16* z2 = ZS + (size_t)(has2 ? row2 : row) * ZS_P;
        P1Regs A, B;
        post1_load(z, rhc + pos * 32, rhs + pos * 32, lat, lane, A);
        if (has2) post1_load(z2, rhc + pos2 * 32, rhs + pos2 * 32, lat2, lane, B);
        post1_finish(z, lane, A, gcq, gckv, gh);
        if (has2) post1_finish(z2, lane, B, gcq, gckv, gh);
    }
}
struct P2Regs { u32x2 qn, kn; bf16 q1, q2, k1, k2; float c, s; };
__device__ __forceinline__ void post2_load(const bf16* zrow, const bf16* mq, const bf16* mkv, const float* rc, const float* rs, bool lat, int lane, P2Regs& R) {
    const int h = lane >> 4, j = lane & 15;
    R.qn = *(const u32x2*)(mq + h * 96 + 4 * j); R.q1 = mq[h * 96 + 64 + j]; R.q2 = mq[h * 96 + 80 + j];
    R.kn = *(const u32x2*)(mkv + h * 128 + 4 * j); R.k1 = zrow[ZC_KR + j]; R.k2 = zrow[ZC_KR + 16 + j];
    if (lat) { R.c = rc[j]; R.s = rs[j]; } else { R.c = 1.f; R.s = 0.f; }
}
__device__ __forceinline__ void post2_finish(bf16* mq, bf16* mk, int lane, const P2Regs& R, const float (&gq)[6], const float (&gk)[6]) {
    const int h = lane >> 4, j = lane & 15;
#pragma unroll
    for (int qk = 0; qk < 2; ++qk) {
        const u32x2 n = qk == 0 ? R.qn : R.kn; float v0 = bflo(n.x), v1 = bfhi(n.x), v2 = bflo(n.y), v3 = bfhi(n.y), r1 = bf2f(qk == 0 ? R.q1 : R.k1), r2 = bf2f(qk == 0 ? R.q2 : R.k2);
        const float rstd = 1.0f / sqrtf(grp16_sum(v0 * v0 + v1 * v1 + v2 * v2 + v3 * v3 + r1 * r1 + r2 * r2) * (1.0f / 96.0f) + RMS_EPS);
        const float (&g)[6] = qk == 0 ? gq : gk; const float sc = qk == 0 ? QSCALE96 : 1.0f;
        const float y1 = r1 * rstd * g[4], y2 = r2 * rstd * g[5];
        const float t1 = (y1 * R.c - y2 * R.s) * sc, t2 = (y2 * R.c + y1 * R.s) * sc;
        bf16* o = (qk == 0 ? mq : mk) + h * 96;
        u32x2 w; w.x = pk2(v0 * rstd * g[0] * sc, v1 * rstd * g[1] * sc); w.y = pk2(v2 * rstd * g[2] * sc, v3 * rstd * g[3] * sc);
        *(u32x2*)(o + 4 * j) = w; o[64 + j] = (bf16)f2bf(t1); o[80 + j] = (bf16)f2bf(t2);
    }
}
__device__ __forceinline__ void ph_post2(Frame& F, int l) {
    const bf16* ZS = (const bf16*)(F.ws + WS_ZS); bf16* MQ = (bf16*)(F.ws + WS_MQ); const bf16* MKV = (const bf16*)(F.ws + WS_MKV); bf16* MK = (bf16*)(F.ws + WS_MK);
    const float* rmc = (const float*)(F.ws + WS_RMC); const float* rms = (const float*)(F.ws + WS_RMS);
    const int lane = F.lane, jj = lane & 15;
    float gq[6], gk[6];
    { const float* a = F.in(I_MQN) + l * 96; const float* b = F.in(I_MKN) + l * 96;
#pragma unroll
      for (int i = 0; i < 4; ++i) { gq[i] = a[4 * jj + i]; gk[i] = b[4 * jj + i]; }
      gq[4] = a[64 + jj]; gq[5] = a[80 + jj]; gk[4] = b[64 + jj]; gk[5] = b[80 + jj]; }
    for (int row = F.gw; row < NROWS; row += 2 * F.NGW) {
        const int row2 = row + F.NGW; const bool has2 = row2 < NROWS; const size_t rb = has2 ? row2 : row;
        const int j = row % TPB; const bool lat = j >= CTXL; const int pos = lat ? j - CTXL : 0;
        const int j2 = (int)(rb % TPB); const bool lat2 = j2 >= CTXL; const int pos2 = lat2 ? j2 - CTXL : 0;
        P2Regs A, B;
        post2_load(ZS + (size_t)row * ZS_P, MQ + (size_t)row * 512, MKV + (size_t)row * 512, rmc + pos * 16, rms + pos * 16, lat, lane, A);
        if (has2) post2_load(ZS + rb * ZS_P, MQ + rb * 512, MKV + rb * 512, rmc + pos2 * 16, rms + pos2 * 16, lat2, lane, B);
        post2_finish(MQ + (size_t)row * 512, MK + (size_t)row * 384, lane, A, gq, gk);
        if (has2) post2_finish(MQ + rb * 512, MK + rb * 384, lane, B, gq, gk);
    }
}

template <int DQK>
__device__ __forceinline__ void attn_row_naive(const bf16* q, const bf16* Kb, int kp, const bf16* Vb, int vp, int n1, int lo2, int hi2, bool has_sink, float sink2, bf16* y, int lane) {
    float qf[DQK];
#pragma unroll
    for (int c = 0; c < DQK / 8; ++c) { const v4u w = *(const v4u*)(q + 8 * c);
        qf[8 * c + 0] = bflo(w.x); qf[8 * c + 1] = bfhi(w.x); qf[8 * c + 2] = bflo(w.y); qf[8 * c + 3] = bfhi(w.y); qf[8 * c + 4] = bflo(w.z); qf[8 * c + 5] = bfhi(w.z); qf[8 * c + 6] = bflo(w.w); qf[8 * c + 7] = bfhi(w.w); }
    float m = -INFINITY, l = 0.f; float acc[64];
#pragma unroll
    for (int d = 0; d < 64; ++d) acc[d] = 0.f;
    for (int seg = 0; seg < 2; ++seg) {
        const int k0 = seg == 0 ? 0 : lo2, k1 = seg == 0 ? n1 : hi2;
        for (int key = k0 + lane; key < k1; key += 64) {
            const bf16* kr = Kb + (size_t)key * kp; float s = 0.f;
#pragma unroll
            for (int c = 0; c < DQK / 8; ++c) { const v4u w = *(const v4u*)(kr + 8 * c);
                s += qf[8 * c + 0] * bflo(w.x) + qf[8 * c + 1] * bfhi(w.x) + qf[8 * c + 2] * bflo(w.y) + qf[8 * c + 3] * bfhi(w.y) + qf[8 * c + 4] * bflo(w.z) + qf[8 * c + 5] * bfhi(w.z) + qf[8 * c + 6] * bflo(w.w) + qf[8 * c + 7] * bfhi(w.w); }
            if (s > m) { const float f = exp2f(m - s); l *= f;
#pragma unroll
                for (int d = 0; d < 64; ++d) acc[d] *= f;
                m = s; }
            const float p = exp2f(s - m); l += p;
            const bf16* vr = Vb + (size_t)key * vp;
#pragma unroll
            for (int c = 0; c < 8; ++c) { const v4u w = *(const v4u*)(vr + 8 * c);
                acc[8 * c + 0] += p * bflo(w.x); acc[8 * c + 1] += p * bfhi(w.x); acc[8 * c + 2] += p * bflo(w.y); acc[8 * c + 3] += p * bfhi(w.y); acc[8 * c + 4] += p * bflo(w.z); acc[8 * c + 5] += p * bfhi(w.z); acc[8 * c + 6] += p * bflo(w.w); acc[8 * c + 7] += p * bfhi(w.w); }
        }
    }
    float M = wave_max(m); if (has_sink) M = fmaxf(M, sink2);
    const float f = (m == -INFINITY) ? 0.f : exp2f(m - M);
    float L = wave_sum(l * f); if (has_sink) L += exp2f(sink2 - M);
    float mine = 0.f;
#pragma unroll
    for (int d = 0; d < 64; ++d) { const float t = wave_sum(acc[d] * f); if (lane == d) mine = t; }
    y[lane] = (bf16)f2bf(mine / L * bf2f(y[lane]));
}
__device__ __forceinline__ void ph_attn_naive(Frame& F, int l) {
    const bf16* ZS = (const bf16*)(F.ws + WS_ZS); const bf16* MQ = (const bf16*)(F.ws + WS_MQ); const bf16* MKV = (const bf16*)(F.ws + WS_MKV); const bf16* MK = (const bf16*)(F.ws + WS_MK);
    bf16* Y = (bf16*)(F.ws + WS_G);
    const long nitems = (long)NROWS * 12;
    for (long it = F.gw; it < nitems; it += F.NGW) {
        const int hb = (int)(it % 12); const int row = (int)(it / 12);
        const int b = row / TPB, j = row % TPB; const bool lat = j >= CTXL;
        if (!lat && l == NLAYER - 1) continue;
        const size_t r0 = (size_t)b * TPB;
        const int br = hb >> 2, h = hb & 3;
        bf16* y = Y + (size_t)row * 1024 + br * 256 + h * 64;
        if (br == 0) {
            attn_row_naive<96>(MQ + (size_t)row * 512 + h * 96, MK + r0 * 384 + h * 96, 384, MKV + r0 * 512 + h * 128 + 64, 512, CTXL, CTXL, lat ? TPB : CTXL, false, 0.f, y, F.lane);
        } else if (br == 1) {
            const int t = j - CTXL; int lo = CTXL, hi = CTXL;
            if (lat) { lo = CTXL + (t - 128 < 0 ? 0 : t - 128); hi = CTXL + (t + 128 > SEQ - 1 ? SEQ - 1 : t + 128) + 1; }
            attn_row_naive<64>(ZS + (size_t)row * ZS_P + ZC_SQ + h * 64, ZS + r0 * ZS_P + ZC_SK + (h >> 1) * 64, ZS_P, ZS + r0 * ZS_P + ZC_SV + (h >> 1) * 64, ZS_P, CTXL, lo, hi, true, F.in(I_SINK)[l * 4 + h] * LOG2E, y, F.lane);
        } else {
            attn_row_naive<64>(ZS + (size_t)row * ZS_P + ZC_AQ + h * 64, ZS + r0 * ZS_P + ZC_AK + (h >> 1) * 64, ZS_P, ZS + r0 * ZS_P + ZC_AV + (h >> 1) * 64, ZS_P, CTXL, CTXL, lat ? TPB : CTXL, false, 0.f, y, F.lane);
        }
    }
}

__device__ __forceinline__ void ph_lru_conv(Frame& F, int l) {
    const bf16* ZS = (const bf16*)(F.ws + WS_ZS); float* U = (float*)(F.ws + WS_U);
    const float* cw = F.in(I_CONVW) + l * 4 * 256; const float* cb = F.in(I_CONVB) + l * 256;
    const int gt = F.vcu * NTHREADS + F.tid, ngt = F.G * NTHREADS;
    for (int idx = gt; idx < NROWS * 256; idx += ngt) {
        const int row = idx >> 8, c = idx & 255, b = row / TPB, j = row % TPB;
        int s0, len, jj; if (j < CTXL) { s0 = b * TPB; len = CTXL; jj = j; } else { s0 = b * TPB + CTXL; len = SEQ; jj = j - CTXL; }
        float acc = cb[c];
#pragma unroll
        for (int i = 0; i < 4; ++i) { const int t = jj + i - 2; if (t >= 0 && t < len) acc += cw[i * 256 + c] * bf2f(ZS[(size_t)(s0 + t) * ZS_P + ZC_LRU + c]); }
        U[idx] = acc;
    }
}
__device__ __forceinline__ void ph_lru_scan(Frame& F, int l, int dir) {
    const float* U = (const float*)(F.ws + WS_U); float* HF = (float*)(F.ws + WS_HF); bf16* Y = (bf16*)(F.ws + WS_G);
    const int g = blockIdx.x * NTHREADS + F.tid;
    if (g < NB * 256) {
    const int b = g >> 8, c = g & 255, k = c >> 6, jc = c & 63;
    const float* wr = F.in(I_LWR) + ((((size_t)l * 2 + dir) * 4 + k) * 64) * 64 + jc;
    const float* wi = F.in(I_LWI) + ((((size_t)l * 2 + dir) * 4 + k) * 64) * 64 + jc;
    float wrr[64], wii[64];
#pragma unroll
    for (int i = 0; i < 64; ++i) { wrr[i] = wr[i * 64]; wii[i] = wi[i * 64]; }
    const float br = F.in(I_LBR)[(l * 2 + dir) * 256 + c], bi = F.in(I_LBI)[(l * 2 + dir) * 256 + c];
    const float lam = F.in(I_LAM)[(l * 2 + dir) * 256 + c];
    const float sp = log1pf(expf(-lam));
    float h = 0.f;
    for (int s = 0; s < TPB; ++s) {
        const int j = dir == 0 ? s : (s < CTXL ? CTXL - 1 - s : TPB + CTXL - 1 - s);
        const size_t row = (size_t)b * TPB + j;
        const float* ub = U + row * 256 + k * 64;
        float rp = br, ip = bi;
#pragma unroll
        for (int i = 0; i < 64; ++i) { const float uv = ub[i]; rp += uv * wrr[i]; ip += uv * wii[i]; }
        const float r = 1.0f / (1.0f + expf(-rp)), ig = 1.0f / (1.0f + expf(-ip));
        const float la = -8.0f * r * sp; const float a = expf(la);
        const float bx = sqrtf(-expm1f(2.0f * la)) * (ig * ub[jc]);
        h = a * h + bx;
        if (dir == 0) HF[row * 256 + c] = h;
        else { bf16* y = Y + row * 1024 + 768 + c; *y = (bf16)f2bf((HF[row * 256 + c] + h) * bf2f(*y)); }
    }
    }
}
__device__ __forceinline__ void ph_mixsum_ctx(Frame& F) {
    const bf16* S = (const bf16*)(F.ws + WS_S); bf16* MIX = (bf16*)(F.ws + WS_H);
    const int gt = F.vcu * NTHREADS + F.tid, ngt = F.G * NTHREADS;
    for (int idx = gt; idx < NB * CTXL * 128; idx += ngt) {
        const int r = idx >> 7, c8 = (idx & 127) * 8; const size_t row = (size_t)(r >> 8) * TPB + (r & 255); float s[8] = {0.f, 0.f, 0.f, 0.f, 0.f, 0.f, 0.f, 0.f};
#pragma unroll
        for (int k = 0; k < 4; ++k) { const v4u w = *(const GAS v4u*)(S + row * 4096 + k * 1024 + c8);
            s[0] += bflo(w.x); s[1] += bfhi(w.x); s[2] += bflo(w.y); s[3] += bfhi(w.y); s[4] += bflo(w.z); s[5] += bfhi(w.z); s[6] += bflo(w.w); s[7] += bfhi(w.w); }
        v4u o; o.x = pk2(s[0], s[1]); o.y = pk2(s[2], s[3]); o.z = pk2(s[4], s[5]); o.w = pk2(s[6], s[7]);
        *(GAS v4u*)(MIX + row * 1024 + c8) = o;
    }
}
namespace att {
typedef short bf16x8 __attribute__((ext_vector_type(8)));
typedef short s16x4 __attribute__((ext_vector_type(4)));
typedef short v4i16_t __attribute__((ext_vector_type(4)));
typedef float f32x16 __attribute__((ext_vector_type(16)));
typedef unsigned u32x4 __attribute__((ext_vector_type(4)));
typedef __attribute__((address_space(3))) const char* lds_cptr;
typedef float f32x2_t __attribute__((ext_vector_type(2))); typedef __bf16 bf16x2_t __attribute__((ext_vector_type(2)));
__device__ __forceinline__ int crow(int r, int hi) { return (r & 3) + 8 * (r >> 2) + 4 * hi; }
__device__ __forceinline__ void glds16(const void* gsrc, unsigned lds_dst) { unsigned keep;
    asm volatile("s_mov_b32 %0, m0\n\ts_mov_b32 m0, %2\n\ts_nop 0\n\tglobal_load_lds_dwordx4 %1, off\n\ts_mov_b32 m0, %0" : "=&s"(keep) : "v"(gsrc), "s"(lds_dst) : "memory"); }
__device__ __forceinline__ unsigned cvtpk(float lo, float hi) { f32x2_t v = {lo, hi}; bf16x2_t b = __builtin_convertvector(v, bf16x2_t); return __builtin_bit_cast(unsigned, b); }
__device__ __forceinline__ s16x4 vtr(lds_cptr p) { return __builtin_bit_cast(s16x4, __builtin_amdgcn_ds_read_tr16_b64_v4i16((__attribute__((address_space(3))) v4i16_t*)p)); }
__device__ __forceinline__ float halfswap_max(float m) { auto rr = __builtin_amdgcn_permlane32_swap(__float_as_uint(m), __float_as_uint(m), false, false); return fmaxf(__uint_as_float(rr[0]), __uint_as_float(rr[1])); }
__device__ __forceinline__ float halfswap_sum(float m) { auto rr = __builtin_amdgcn_permlane32_swap(__float_as_uint(m), __float_as_uint(m), false, false); return __uint_as_float(rr[0]) + __uint_as_float(rr[1]); }

template <int DQK> struct Cfg {
    static constexpr int KCH = DQK / 8, KSLOT = KCH * 1024, NKI = (KCH + 7) / 8, NI = NKI + 1;
    static constexpr int LDS_K = 0, LDS_V = 3 * KSLOT, LDS_WS = LDS_V + 3 * 8192, LDS_OST = LDS_WS + 8 * 256, BYTES = LDS_OST + 8 * 4096;
};
#define ATT_WAIT_BAR(N) asm volatile("s_waitcnt vmcnt(" #N ") lgkmcnt(0)\n\ts_barrier" ::: "memory")

struct UnitDesc {
    const unsigned short* Q; int qp;
    const unsigned short* K; int kp;
    const unsigned short* V; int vp;
    unsigned short* Y;
    int NT;
    int lat_row0;
    int qpos0, spos0;
    int has_sink; float sink2;
};

template <int DQK, bool SWA>
__device__ __forceinline__ void attn_unit(LAS unsigned char* ldsb, const UnitDesc& U, const int tid) {
    using C = Cfg<DQK>;
    const int lane = tid & 63, r32 = lane & 31, hi = lane >> 5; const int wid = __builtin_amdgcn_readfirstlane(tid >> 6);
    const unsigned lds0 = (unsigned)(uintptr_t)ldsb;
    LAS float* wsf = (LAS float*)(ldsb + C::LDS_WS) + wid * 64;
    const int kp = U.kp, vp = U.vp;
    const int kc1 = (C::NKI == 2 && wid < 4) ? wid + 8 : wid;
    const unsigned short* ksrc0 = U.K + (size_t)lane * kp + wid * 8;
    const unsigned short* ksrc1 = U.K + (size_t)lane * kp + kc1 * 8;
    const unsigned short* vsrc = U.V + (size_t)(16 * (wid & 3) + (lane >> 2)) * vp + (wid >> 2) * 32 + (lane & 3) * 8;
    const unsigned kdst0 = lds0 + C::LDS_K + wid * 1024, kdst1 = lds0 + C::LDS_K + kc1 * 1024, vdst = lds0 + C::LDS_V + wid * 1024;
    const int NT = U.NT;
#define ATT_KROW(t) (SWA ? ((t) < 4 ? 64 * (t) : U.lat_row0 + 64 * ((t) - 4)) : 64 * (t))
#define ATT_DMA_K(t, slot) do { const size_t ro_ = (size_t)ATT_KROW(t); \
        glds16(ksrc0 + ro_ * kp, (unsigned)__builtin_amdgcn_readfirstlane(kdst0 + (slot) * C::KSLOT)); \
        if (C::NKI == 2) glds16(ksrc1 + ro_ * kp, (unsigned)__builtin_amdgcn_readfirstlane(kdst1 + (slot) * C::KSLOT)); } while (0)
#define ATT_DMA_V(t, slot) do { const size_t ro_ = (size_t)ATT_KROW(t); glds16(vsrc + ro_ * vp, (unsigned)__builtin_amdgcn_readfirstlane(vdst + (slot) * 8192)); } while (0)
#define ATT_KLOAD(kslot) do { if (!SWA) { const lds_cptr kb_ = (lds_cptr)(ldsb + C::LDS_K) + (kslot) * C::KSLOT + hi * 1024 + r32 * 16; \
        _Pragma("unroll") for (int d0 = 0; d0 < DQK / 16; ++d0) { kf[2 * d0] = *(const __attribute__((address_space(3))) bf16x8*)(kb_ + d0 * 2048); kf[2 * d0 + 1] = *(const __attribute__((address_space(3))) bf16x8*)(kb_ + d0 * 2048 + 512); } } } while (0)
#define ATT_QKM(P0, P1, CINIT, kslot) do { P0 = f32x16{}; P1 = f32x16{}; \
        const lds_cptr kq_ = (lds_cptr)(ldsb + C::LDS_K) + (kslot) * C::KSLOT + hi * 1024 + r32 * 16; \
        _Pragma("unroll") for (int d0 = 0; d0 < DQK / 16; ++d0) { \
            const bf16x8 b0_ = SWA ? *(const __attribute__((address_space(3))) bf16x8*)(kq_ + d0 * 2048) : kf[2 * d0]; const bf16x8 b1_ = SWA ? *(const __attribute__((address_space(3))) bf16x8*)(kq_ + d0 * 2048 + 512) : kf[2 * d0 + 1]; \
            P0 = __builtin_amdgcn_mfma_f32_32x32x16_bf16(b0_, qr[d0], P0, 0, 0, 0); P1 = __builtin_amdgcn_mfma_f32_32x32x16_bf16(b1_, qr[d0], P1, 0, 0, 0); } } while (0)
#define ATT_VLOAD(vslot) do { if (!SWA) { const lds_cptr vb_ = (lds_cptr)(ldsb + C::LDS_V) + (vslot) * 8192 + ((lane >> 4) & 1) * 32 + (lane & 3) * 8 + (4 * hi + ((lane & 15) >> 2)) * 64; \
        _Pragma("unroll") for (int i = 0; i < 8; ++i) { vl[i] = vtr(vb_ + (i >> 2) * 4096 + (i & 3) * 1024); vh[i] = vtr(vb_ + (i >> 2) * 4096 + (i & 3) * 1024 + 512); } } } while (0)
#define ATT_MX3(a, b, c) __builtin_fmaxf(__builtin_fmaxf((a), (b)), (c))
#define ATT_NEEDMASK(j) ((j) >= 4 && U.qpos0 >= 0 && !((U.spos0 + 64 * ((j) - 4) + 63 - (U.qpos0 + 32 * wid) <= 128) && ((U.qpos0 + 32 * wid + 31) - (U.spos0 + 64 * ((j) - 4)) <= 128)))
#define ATT_SMPV(P0, P1, N0, N1, HASNEXT, t, vslot) do { \
        if (SWA && ATT_NEEDMASK(t)) { const bool mk_ = true; const int sb_ = U.spos0 + 64 * ((t) - 4) + 4 * hi;        \
            _Pragma("unroll") for (int r = 0; r < 16; ++r) { const int dd_ = qpos - (sb_ + (r & 3) + 8 * (r >> 2)); \
                P0[r] = (mk_ && (dd_ > 128 || dd_ < -128)) ? -INFINITY : P0[r]; P1[r] = (mk_ && (dd_ - 32 > 128 || dd_ - 32 < -128)) ? -INFINITY : P1[r]; } } \
        float ls_ = 0.f; \
        _Pragma("unroll") for (int r = 0; r < 16; ++r) { P0[r] = __builtin_amdgcn_exp2f(P0[r]); P1[r] = __builtin_amdgcn_exp2f(P1[r]); ls_ += P0[r] + P1[r]; } \
        l += ls_; \
        if (!SWA && DQK != 64) { __builtin_amdgcn_sched_barrier(0); ATT_VLOAD(vslot); } \
        u32x4 pw_[4]; \
        pw_[0] = (u32x4){cvtpk(P0[0], P0[1]), cvtpk(P0[2], P0[3]), cvtpk(P0[4], P0[5]), cvtpk(P0[6], P0[7])}; \
        pw_[1] = (u32x4){cvtpk(P0[8], P0[9]), cvtpk(P0[10], P0[11]), cvtpk(P0[12], P0[13]), cvtpk(P0[14], P0[15])}; \
        pw_[2] = (u32x4){cvtpk(P1[0], P1[1]), cvtpk(P1[2], P1[3]), cvtpk(P1[4], P1[5]), cvtpk(P1[6], P1[7])}; \
        pw_[3] = (u32x4){cvtpk(P1[8], P1[9]), cvtpk(P1[10], P1[11]), cvtpk(P1[12], P1[13]), cvtpk(P1[14], P1[15])}; \
        const lds_cptr vq_ = (lds_cptr)(ldsb + C::LDS_V) + (vslot) * 8192 + ((lane >> 4) & 1) * 32 + (lane & 3) * 8 + (4 * hi + ((lane & 15) >> 2)) * 64; \
        _Pragma("unroll") for (int d0 = 0; d0 < 2; ++d0) \
            _Pragma("unroll") for (int ks = 0; ks < 4; ++ks) { \
                const s16x4 lo_ = SWA ? vtr(vq_ + d0 * 4096 + ks * 1024) : vl[4 * d0 + ks], hh_ = SWA ? vtr(vq_ + d0 * 4096 + ks * 1024 + 512) : vh[4 * d0 + ks]; \
                const bf16x8 vf_ = (bf16x8){lo_[0], lo_[1], lo_[2], lo_[3], hh_[0], hh_[1], hh_[2], hh_[3]}; \
                o[d0] = __builtin_amdgcn_mfma_f32_32x32x16_bf16(__builtin_bit_cast(bf16x8, pw_[ks]), vf_, o[d0], 0, 0, 0); } } while (0)
#define ATT_SKIP(j) (SWA && (j) >= 4 && U.qpos0 >= 0 && ((U.spos0 + 64 * ((j) - 4) > U.qpos0 + 32 * wid + 31 + 128) || (U.spos0 + 64 * ((j) - 4) + 63 < U.qpos0 + 32 * wid - 128)))
#define ATT_STEP(C0, C1, N0, N1, t) do { \
        const int k3_ = (ks1 == 0) ? 2 : ks1 - 1, v2_ = (vs0 == 0) ? 2 : vs0 - 1; \
        if ((t) + 3 < NT) ATT_DMA_K((t) + 3, k3_); \
        if ((t) + 2 < NT) ATT_DMA_V((t) + 2, v2_); \
        ATT_KLOAD(ks1); \
        if (!SWA) __builtin_amdgcn_sched_barrier(0);        \
        if (!SWA || !ATT_SKIP((t) + 1)) ATT_QKM(N0, N1, -m, ks1); \
        if (DQK == 64) ATT_VLOAD(vs0);        \
        if (!SWA) __builtin_amdgcn_sched_barrier(0); \
        if (!SWA || !ATT_SKIP(t)) ATT_SMPV(C0, C1, N0, N1, true, t, vs0); \
        if ((t) + 3 < NT) { if (C::NI == 2) ATT_WAIT_BAR(2); else ATT_WAIT_BAR(3); } else ATT_WAIT_BAR(0); \
        ks1 = (ks1 == 2) ? 0 : ks1 + 1; vs0 = (vs0 == 2) ? 0 : vs0 + 1; } while (0)
    ATT_DMA_K(0, 0);
    ATT_DMA_K(1, 1); ATT_DMA_V(0, 0);
    ATT_DMA_K(2, 2); ATT_DMA_V(1, 1);
    bf16x8 qr[DQK / 16];
    { const unsigned short* qw = U.Q + (size_t)(wid * 32 + r32) * U.qp + hi * 8;
#pragma unroll
      for (int d0 = 0; d0 < DQK / 16; ++d0) qr[d0] = *(const bf16x8*)(qw + d0 * 16); }
    const float m = 0.f; float l = 0.f;
    f32x16 o[2]; o[0] = f32x16{}; o[1] = f32x16{};
    const int qpos = U.qpos0 + wid * 32 + r32;
    f32x16 pa0, pa1, pb0, pb1;
    bf16x8 kf[DQK / 8]; s16x4 vl[8], vh[8];
    if (C::NI == 2) ATT_WAIT_BAR(4); else ATT_WAIT_BAR(6);
    ATT_KLOAD(0); ATT_QKM(pa0, pa1, 0.f, 0);
    if (C::NI == 2) ATT_WAIT_BAR(2); else ATT_WAIT_BAR(3);
    int ks1 = 1, vs0 = 0;
    int t = 0;
    if (SWA) { for (; t + 1 < NT; ++t) { ATT_STEP(pa0, pa1, pb0, pb1, t); pa0 = pb0; pa1 = pb1; } if (!ATT_SKIP(NT - 1)) ATT_SMPV(pa0, pa1, pa0, pa1, false, NT - 1, vs0); }
    else {
    for (; t + 2 < NT; t += 2) { ATT_STEP(pa0, pa1, pb0, pb1, t); ATT_STEP(pb0, pb1, pa0, pa1, t + 1); }
    if (t + 1 < NT) { ATT_STEP(pa0, pa1, pb0, pb1, t); if (DQK == 64) ATT_VLOAD(vs0); ATT_SMPV(pb0, pb1, pb0, pb1, false, NT - 1, vs0); }
    else { if (DQK == 64) ATT_VLOAD(vs0); ATT_SMPV(pa0, pa1, pa0, pa1, false, NT - 1, vs0); }
    }
    l = halfswap_sum(l);
    if (U.has_sink) l += __builtin_amdgcn_exp2f(U.sink2 - m);
    if (hi == 0) wsf[32 + r32] = l;
    asm volatile("s_waitcnt lgkmcnt(0)" ::: "memory");
    { LAS unsigned short* stg = (LAS unsigned short*)(ldsb + C::LDS_OST) + wid * 2048;
#pragma unroll
      for (int r = 0; r < 16; ++r) { const int orow = crow(r, hi); const float rl = __builtin_amdgcn_rcpf(wsf[32 + orow]);
          stg[orow * 64 + r32] = (unsigned short)f2bf(o[0][r] * rl); stg[orow * 64 + 32 + r32] = (unsigned short)f2bf(o[1][r] * rl); }
      asm volatile("s_waitcnt lgkmcnt(0)" ::: "memory");
      unsigned short* yw = U.Y + (size_t)(wid * 32) * 1024;
#pragma unroll
      for (int i = 0; i < 4; ++i) { const int row = i * 8 + (lane >> 3), ch = lane & 7;
          const u32x4 ov = *(const LAS u32x4*)(stg + row * 64 + ch * 8);
          u32x4* gp = (u32x4*)(yw + (size_t)row * 1024 + ch * 8); const u32x4 g = *gp;
          u32x4 w; w.x = pk2(bflo(ov.x) * bflo(g.x), bfhi(ov.x) * bfhi(g.x)); w.y = pk2(bflo(ov.y) * bflo(g.y), bfhi(ov.y) * bfhi(g.y));
          w.z = pk2(bflo(ov.z) * bflo(g.z), bfhi(ov.z) * bfhi(g.z)); w.w = pk2(bflo(ov.w) * bflo(g.w), bfhi(ov.w) * bfhi(g.w));
          *gp = w; } }
    asm volatile("s_waitcnt vmcnt(0) lgkmcnt(0)\n\ts_barrier" ::: "memory");
#undef ATT_KROW
#undef ATT_DMA_K
#undef ATT_DMA_V
#undef ATT_KLOAD
#undef ATT_QKM
#undef ATT_VLOAD
#undef ATT_STEP
#undef ATT_SKIP
#undef ATT_SMPV
#undef ATT_MX3
#undef ATT_NEEDMASK
}

template <int DQK>
__device__ __forceinline__ void attn_unit_d(LAS unsigned char* ldsb, const UnitDesc& U, const int tid) {
    using C = Cfg<DQK>;
    constexpr int KP = (DQK == 64) ? 128 : 256, KSL = 64 * KP, SPR = KP / 16, RPP = 1024 / KP, NKI = KSL / 8192;
    static_assert(NKI == C::NKI, "K DMA count");
    constexpr int LDS_WS = 0, LDS_K = 2048, LDS_V = LDS_K + 3 * KSL, LDS_END = LDS_V + 3 * 8192, LDS_X = 2048, LDS_STG = LDS_X + 65536;
    static_assert(LDS_END <= RING_BYTES && LDS_STG + 8 * 4096 <= RING_BYTES, "attention LDS");
    const int lane = tid & 63, r32 = lane & 31, hi = lane >> 5; const int wid = __builtin_amdgcn_readfirstlane(tid >> 6); const int rg = wid & 3, kh = wid >> 2;
    const unsigned lds0 = (unsigned)(uintptr_t)ldsb;
    const int kp = U.kp, vp = U.vp;
    const unsigned short* ksrc0; const unsigned short* ksrc1;
    { const int ra = wid * RPP + lane / SPR, sa = lane % SPR, fa = (KP == 128) ? ((ra >> 1) & 7) : (ra & 15); int ca = sa ^ fa; if (ca >= DQK / 8) ca = 0;
      ksrc0 = U.K + (size_t)ra * kp + ca * 8;
      const int rb = (wid + 8) * RPP + lane / SPR, fb = (KP == 128) ? ((rb >> 1) & 7) : (rb & 15); int cb = sa ^ fb; if (cb >= DQK / 8) cb = 0;
      ksrc1 = U.K + (size_t)(NKI == 2 ? rb : ra) * kp + (NKI == 2 ? cb : ca) * 8; }
    const unsigned short* vsrc = U.V + (size_t)(16 * (wid & 3) + (lane >> 2)) * vp + (wid >> 2) * 32 + (lane & 3) * 8;
    const unsigned kdst0 = lds0 + LDS_K + wid * 1024, kdst1 = lds0 + LDS_K + (wid + 8) * 1024, vdst = lds0 + LDS_V + wid * 1024;
    const int NT = U.NT;
#define ATD_DMA(t, slot) do { const size_t ro_ = (size_t)64 * (t); \
        glds16(ksrc0 + ro_ * kp, (unsigned)__builtin_amdgcn_readfirstlane(kdst0 + (slot) * KSL)); \
        if (NKI == 2) glds16(ksrc1 + ro_ * kp, (unsigned)__builtin_amdgcn_readfirstlane(kdst1 + (slot) * KSL)); \
        glds16(vsrc + ro_ * vp, (unsigned)__builtin_amdgcn_readfirstlane(vdst + (slot) * 8192)); } while (0)
    ATD_DMA(0, 0); ATD_DMA(1, 1);
    bf16x8 qr[2][DQK / 16];
    { const unsigned short* qw = U.Q + (size_t)(rg * 64 + r32) * U.qp + hi * 8;
#pragma unroll
      for (int qb = 0; qb < 2; ++qb)
#pragma unroll
          for (int d0 = 0; d0 < DQK / 16; ++d0) qr[qb][d0] = *(const bf16x8*)(qw + (size_t)(qb * 32) * U.qp + d0 * 16); }
    f32x16 o[2][2]; o[0][0] = f32x16{}; o[0][1] = f32x16{}; o[1][0] = f32x16{}; o[1][1] = f32x16{};
    float l0 = 0.f, l1 = 0.f, l0b = 0.f, l1b = 0.f; u32x4 pp[4]; pp[0] = pp[1] = pp[2] = pp[3] = (u32x4){0u, 0u, 0u, 0u};
    if (C::NI == 2) ATT_WAIT_BAR(2); else ATT_WAIT_BAR(3);
#pragma unroll
    for (int qb = 0; qb < 2; ++qb)
#pragma unroll
        for (int d0 = 0; d0 < DQK / 16; ++d0) asm volatile("" : "+v"(qr[qb][d0]));
    const int krow = 32 * kh + r32, kfx = ((KP == 128) ? ((krow >> 1) & 7) : (krow & 15)) ^ hi;
    const unsigned kb0 = (unsigned)(uintptr_t)(ldsb + LDS_K) + krow * KP + kfx * 16;
    const lds_cptr vbase = (lds_cptr)(ldsb + LDS_V) + kh * 2048 + ((lane >> 4) & 1) * 32 + (lane & 3) * 8 + (4 * hi + ((lane & 15) >> 2)) * 64;
#define ATD_DOT(acc, w) acc = __builtin_amdgcn_fdot2_f32_bf16(__builtin_bit_cast(bf16x2_t, (w)), __builtin_bit_cast(bf16x2_t, 0x3f803f80u), acc, false)
#define ATD_SUM4(LA, LB, W) do { ATD_DOT(LA, W.x); ATD_DOT(LB, W.y); ATD_DOT(LA, W.z); ATD_DOT(LB, W.w); } while (0)
#define ATD_SMPV(S, PW0, PW1, OA, OB) do { \
        _Pragma("unroll") for (int r = 0; r < 16; ++r) S[r] = __builtin_amdgcn_exp2f(S[r]); \
        PW0 = (u32x4){cvtpk(S[0], S[1]), cvtpk(S[2], S[3]), cvtpk(S[4], S[5]), cvtpk(S[6], S[7])}; \
        PW1 = (u32x4){cvtpk(S[8], S[9]), cvtpk(S[10], S[11]), cvtpk(S[12], S[13]), cvtpk(S[14], S[15])}; \
        OA = __builtin_amdgcn_mfma_f32_32x32x16_bf16(__builtin_bit_cast(bf16x8, PW0), vf[0][0], OA, 0, 0, 0); OB = __builtin_amdgcn_mfma_f32_32x32x16_bf16(__builtin_bit_cast(bf16x8, PW0), vf[1][0], OB, 0, 0, 0); \
        OA = __builtin_amdgcn_mfma_f32_32x32x16_bf16(__builtin_bit_cast(bf16x8, PW1), vf[0][1], OA, 0, 0, 0); OB = __builtin_amdgcn_mfma_f32_32x32x16_bf16(__builtin_bit_cast(bf16x8, PW1), vf[1][1], OB, 0, 0, 0); } while (0)
    int s = 0;
#pragma unroll 1
    for (int t = 0; t < NT; ++t) {
        const int s2 = (s == 0) ? 2 : s - 1;
        if (t + 2 < NT) ATD_DMA(t + 2, s2);
        bf16x8 kf[DQK / 16], vf[2][2];
        {
#pragma unroll
          for (int d0 = 0; d0 < DQK / 16; ++d0) kf[d0] = *(const __attribute__((address_space(3))) bf16x8*)(uintptr_t)((kb0 ^ (unsigned)(32 * d0)) + (unsigned)(s * KSL)); }
        { const lds_cptr vb_ = vbase + s * 8192;
#pragma unroll
          for (int d0 = 0; d0 < 2; ++d0)
#pragma unroll
              for (int ks = 0; ks < 2; ++ks) { const s16x4 lo_ = vtr(vb_ + d0 * 4096 + ks * 1024), hh_ = vtr(vb_ + d0 * 4096 + ks * 1024 + 512);
                  vf[d0][ks] = (bf16x8){lo_[0], lo_[1], lo_[2], lo_[3], hh_[0], hh_[1], hh_[2], hh_[3]}; } }
        f32x16 S0 = f32x16{}, S1 = f32x16{};
#pragma unroll
        for (int d0 = 0; d0 < DQK / 16; ++d0) S0 = __builtin_amdgcn_mfma_f32_32x32x16_bf16(kf[d0], qr[0][d0], S0, 0, 0, 0);
#pragma unroll
        for (int d0 = 0; d0 < DQK / 16; ++d0) S1 = __builtin_amdgcn_mfma_f32_32x32x16_bf16(kf[d0], qr[1][d0], S1, 0, 0, 0);
        ATD_SUM4(l0, l0b, pp[0]); ATD_SUM4(l0, l0b, pp[1]); ATD_SUM4(l1, l1b, pp[2]); ATD_SUM4(l1, l1b, pp[3]);
        __builtin_amdgcn_sched_barrier(0);
        ATD_SMPV(S0, pp[0], pp[1], o[0][0], o[0][1]);
        ATD_SMPV(S1, pp[2], pp[3], o[1][0], o[1][1]);
        if (t + 2 < NT) { if (C::NI == 2) ATT_WAIT_BAR(2); else ATT_WAIT_BAR(3); } else ATT_WAIT_BAR(0);
        s = (s == 2) ? 0 : s + 1;
    }
    LAS float* wl = (LAS float*)(ldsb + LDS_WS);
    LAS float* X = (LAS float*)(ldsb + LDS_X);
    ATD_SUM4(l0, l0b, pp[0]); ATD_SUM4(l0, l0b, pp[1]); ATD_SUM4(l1, l1b, pp[2]); ATD_SUM4(l1, l1b, pp[3]); l0 += l0b; l1 += l1b;
    const float lkeep = halfswap_sum(kh ? l1 : l0), lsend = halfswap_sum(kh ? l0 : l1);
    f32x16 ok0 = kh ? o[1][0] : o[0][0], ok1 = kh ? o[1][1] : o[0][1]; const f32x16 os0 = kh ? o[0][0] : o[1][0], os1 = kh ? o[0][1] : o[1][1];
    { LAS float* xs = X + wid * 2048 + lane;
#pragma unroll
      for (int r = 0; r < 16; ++r) { xs[r * 64] = os0[r]; xs[(16 + r) * 64] = os1[r]; }
      if (hi == 0) wl[wid * 64 + r32] = lsend; }
    asm volatile("s_waitcnt lgkmcnt(0)\n\ts_barrier" ::: "memory");
    { const LAS float* xr = X + (wid ^ 4) * 2048 + lane;
#pragma unroll
      for (int r = 0; r < 16; ++r) { ok0[r] += xr[r * 64]; ok1[r] += xr[(16 + r) * 64]; }
      const float lt = lkeep + wl[(wid ^ 4) * 64 + r32];
      if (hi == 0) wl[wid * 64 + 32 + r32] = lt; }
    asm volatile("s_waitcnt lgkmcnt(0)" ::: "memory");
    { LAS unsigned short* stg = (LAS unsigned short*)(ldsb + LDS_STG) + wid * 2048;
      const LAS float* lt = wl + wid * 64 + 32;
#pragma unroll
      for (int r = 0; r < 16; ++r) { const int orow = crow(r, hi); const float rl = __builtin_amdgcn_rcpf(lt[orow]);
          stg[orow * 64 + r32] = (unsigned short)f2bf(ok0[r] * rl); stg[orow * 64 + 32 + r32] = (unsigned short)f2bf(ok1[r] * rl); }
      asm volatile("s_waitcnt lgkmcnt(0)" ::: "memory");
      unsigned short* yw = U.Y + (size_t)(rg * 64 + kh * 32) * 1024;
#pragma unroll
      for (int i = 0; i < 4; ++i) { const int row = i * 8 + (lane >> 3), ch = lane & 7;
          const u32x4 ov = *(const LAS u32x4*)(stg + row * 64 + ch * 8);
          u32x4* gp = (u32x4*)(yw + (size_t)row * 1024 + ch * 8); const u32x4 g = *gp;
          u32x4 w; w.x = pk2(bflo(ov.x) * bflo(g.x), bfhi(ov.x) * bfhi(g.x)); w.y = pk2(bflo(ov.y) * bflo(g.y), bfhi(ov.y) * bfhi(g.y));
          w.z = pk2(bflo(ov.z) * bflo(g.z), bfhi(ov.z) * bfhi(g.z)); w.w = pk2(bflo(ov.w) * bflo(g.w), bfhi(ov.w) * bfhi(g.w));
          *gp = w; } }
    asm volatile("s_waitcnt vmcnt(0) lgkmcnt(0)\n\ts_barrier" ::: "memory");
#undef ATD_DMA
#undef ATD_SMPV
#undef ATD_DOT
#undef ATD_SUM4
}
}

__device__ __forceinline__ void ph_attn(Frame& F, int l) {
    unsigned short* ZS = (unsigned short*)(F.ws + WS_ZS); unsigned short* MQ = (unsigned short*)(F.ws + WS_MQ); unsigned short* MKV = (unsigned short*)(F.ws + WS_MKV); unsigned short* MK = (unsigned short*)(F.ws + WS_MK);
    unsigned short* Y = (unsigned short*)(F.ws + WS_G);
    LAS unsigned char* lds = F.lds + RING_OFF;
    const int u = F.vcu;
    const bool ctxq = (l == 0);
    for (int uu = u; uu < 256; uu += F.G) { const int bh = uu >> 4, qb = uu & 15, b = bh >> 2, h = bh & 3; const size_t r0 = (size_t)b * TPB, rq = r0 + CTXL + qb * 256;
        att::UnitDesc U{MQ + rq * 512 + h * 96, 512, MK + r0 * 384 + h * 96, 384, MKV + r0 * 512 + h * 128 + 64, 512, Y + rq * 1024 + h * 64, TPB / 64, 0, -1, 0, 0, 0.f};
        { int tu_ = F.tid; asm volatile("" : "+v"(tu_)); att::attn_unit_d<96>(lds, U, tu_); } }
    for (int uu = u; uu < 256; uu += F.G) { const int qb = uu & 15, g = (uu >> 4) & 1, kvh = (uu >> 5) & 1, b = uu >> 6, qh = kvh * 2 + g; const size_t r0 = (size_t)b * TPB, rq = r0 + CTXL + qb * 256;
        att::UnitDesc U{ZS + rq * ZS_P + ZC_AQ + qh * 64, ZS_P, ZS + r0 * ZS_P + ZC_AK + kvh * 64, ZS_P, ZS + r0 * ZS_P + ZC_AV + kvh * 64, ZS_P, Y + rq * 1024 + 512 + qh * 64, TPB / 64, 0, -1, 0, 0, 0.f};
        { int tu_ = F.tid; asm volatile("" : "+v"(tu_)); att::attn_unit_d<64>(lds, U, tu_); } }
    for (int uu = u; uu < 256; uu += F.G) { const int qb = uu & 15, g = (uu >> 4) & 1, kvh = (uu >> 5) & 1, b = uu >> 6, qh = kvh * 2 + g; const size_t r0 = (size_t)b * TPB, rq = r0 + CTXL + qb * 256;
        const int q0 = qb * 256, s0 = (q0 - 128 < 0) ? 0 : q0 - 128, s1 = (q0 + 384 > SEQ) ? SEQ : q0 + 384;
        att::UnitDesc U{ZS + rq * ZS_P + ZC_SQ + qh * 64, ZS_P, ZS + r0 * ZS_P + ZC_SK + kvh * 64, ZS_P, ZS + r0 * ZS_P + ZC_SV + kvh * 64, ZS_P, Y + rq * 1024 + 256 + qh * 64, 4 + (s1 - s0) / 64, CTXL + s0, q0, s0, 1, F.in(I_SINK)[l * 4 + qh] * LOG2E};
        att::attn_unit<64, true>(lds, U, F.tid); }
    if (ctxq) for (int uu = u; uu < 48; uu += F.G) { const int br = uu >> 4, b = (uu >> 2) & 3, h = uu & 3; const size_t r0 = (size_t)b * TPB;
        if (br == 0) { att::UnitDesc U{MQ + r0 * 512 + h * 96, 512, MK + r0 * 384 + h * 96, 384, MKV + r0 * 512 + h * 128 + 64, 512, Y + r0 * 1024 + h * 64, 4, 0, -1, 0, 0, 0.f};
            { int tu_ = F.tid; asm volatile("" : "+v"(tu_)); att::attn_unit_d<96>(lds, U, tu_); } }
        else if (br == 1) { att::UnitDesc U{ZS + r0 * ZS_P + ZC_SQ + h * 64, ZS_P, ZS + r0 * ZS_P + ZC_SK + (h >> 1) * 64, ZS_P, ZS + r0 * ZS_P + ZC_SV + (h >> 1) * 64, ZS_P, Y + r0 * 1024 + 256 + h * 64, 4, CTXL, -1, 0, 1, F.in(I_SINK)[l * 4 + h] * LOG2E};
            att::attn_unit<64, true>(lds, U, F.tid); }
        else { att::UnitDesc U{ZS + r0 * ZS_P + ZC_AQ + h * 64, ZS_P, ZS + r0 * ZS_P + ZC_AK + (h >> 1) * 64, ZS_P, ZS + r0 * ZS_P + ZC_AV + (h >> 1) * 64, ZS_P, Y + r0 * 1024 + 512 + h * 64, 4, 0, -1, 0, 0, 0.f};
            { int tu_ = F.tid; asm volatile("" : "+v"(tu_)); att::attn_unit_d<64>(lds, U, tu_); } } }
}
constexpr size_t WS_SUM = 253 * MiB;
constexpr size_t WS_HL = WS_U, WS_CP = WS_HF;
constexpr int NCHUNK = TPB / 64;
__device__ __forceinline__ float swap_lo(float x) { auto rr = __builtin_amdgcn_permlane32_swap(__float_as_uint(x), __float_as_uint(x), false, false); return __uint_as_float(rr[0]); }
__device__ __forceinline__ float swap_hi(float x) { auto rr = __builtin_amdgcn_permlane32_swap(__float_as_uint(x), __float_as_uint(x), false, false); return __uint_as_float(rr[1]); }
__device__ __forceinline__ void ph_lru1(Frame& F, int l) {
    typedef short bf16x8 __attribute__((ext_vector_type(8))); typedef float f32x16 __attribute__((ext_vector_type(16)));
    const unsigned short* ZS = (const unsigned short*)(F.ws + WS_ZS); unsigned short* HL = (unsigned short*)(F.ws + WS_HL); unsigned short* CP = (unsigned short*)(F.ws + WS_CP);
    f32x2v* SUM = (f32x2v*)(F.ws + WS_SUM);
    constexpr int UP = 264;
    LAS unsigned short* ul = (LAS unsigned short*)(F.lds + RING_OFF);
    const float* cw = F.in(I_CONVW) + l * 4 * 256; const float* cb = F.in(I_CONVB) + l * 256;
    const int tid = F.tid, lane = tid & 63, r32 = lane & 31, hi = lane >> 5, k = F.wave & 3, d = F.wave >> 2;
    const int nfull = (NB * NCHUNK < F.G) ? NB * NCHUNK : F.G, nhalf = 2 * (NB * NCHUNK - nfull);
    for (int wi = F.vcu; wi < nfull + nhalf; wi += F.G) {
        const int unit = (wi < nfull) ? wi : nfull + ((wi - nfull) >> 1);
        const int tn_lo = (wi < nfull) ? 0 : ((wi - nfull) & 1), tn_hi = (wi < nfull) ? 2 : tn_lo + 1;
        const int b = unit / NCHUNK, ci = unit % NCHUNK;
        int s0row, len, t0; if (ci < 4) { s0row = b * TPB; len = CTXL; t0 = ci * 64; } else { s0row = b * TPB + CTXL; len = SEQ; t0 = (ci - 4) * 64; }
        { const int cc = tid & 255, hh = tid >> 8; float zv[35];
#pragma unroll
          for (int i = 0; i < 35; ++i) { const int tt = t0 + hh * 32 + i - 2; const int tc = tt < 0 ? 0 : (tt >= len ? len - 1 : tt);
              const float v = bf2f(ZS[(size_t)(s0row + tc) * ZS_P + ZC_LRU + cc]); zv[i] = (tt >= 0 && tt < len) ? v : 0.f; }
          const float w0 = cw[cc], w1 = cw[256 + cc], w2 = cw[512 + cc], w3 = cw[768 + cc], bb = cb[cc];
#pragma unroll
          for (int t = 0; t < 32; ++t) ul[(hh * 32 + t) * UP + cc] = (unsigned short)f2bf(bb + w0 * zv[t] + w1 * zv[t + 1] + w2 * zv[t + 2] + w3 * zv[t + 3]); }
        __syncthreads();
#pragma unroll 1
        for (int tn = tn_lo; tn < tn_hi; ++tn) {
            const int c = k * 64 + 32 * tn + r32;
            bf16x8 wf[2][4];
            const float brv = F.in(I_LBR)[(l * 2 + d) * 256 + c], biv = F.in(I_LBI)[(l * 2 + d) * 256 + c], spv = ((const float*)(F.ws + WS_SP))[(l * 2 + d) * 256 + c];
#pragma unroll
            for (int gate = 0; gate < 2; ++gate)
#pragma unroll
                for (int ks = 0; ks < 4; ++ks) { const float* src = (const float*)(F.ws + WS_LWT) + ((((size_t)l * 2 + d) * 2 + gate) * 256 + c) * 64 + 16 * ks + 8 * hi;
                    const f32x4 a = *(const f32x4*)src, b2 = *(const f32x4*)(src + 4);
                    v4u w; w.x = pk2(a.x, a.y); w.y = pk2(a.z, a.w); w.z = pk2(b2.x, b2.y); w.w = pk2(b2.z, b2.w); wf[gate][ks] = __builtin_bit_cast(bf16x8, w); }
            f32x16 A[2], X[2];
            A[0] = f32x16{}; A[1] = f32x16{}; X[0] = f32x16{}; X[1] = f32x16{};
#pragma unroll
            for (int tm = 0; tm < 2; ++tm)
#pragma unroll
                for (int ks = 0; ks < 4; ++ks) { const bf16x8 af = *(const LAS bf16x8*)(ul + (32 * tm + r32) * UP + k * 64 + 16 * ks + 8 * hi);
                    A[tm] = __builtin_amdgcn_mfma_f32_32x32x16_bf16(af, wf[0][ks], A[tm], 0, 0, 0); X[tm] = __builtin_amdgcn_mfma_f32_32x32x16_bf16(af, wf[1][ks], X[tm], 0, 0, 0); }
#pragma unroll
            for (int tm = 0; tm < 2; ++tm)
#pragma unroll
                for (int r = 0; r < 16; ++r) { const int tok = 32 * tm + (r & 3) + 8 * (r >> 2) + 4 * hi; const float uu = bf2f(ul[tok * UP + c]);
                    const float rr = sigmoid_f(A[tm][r] + brv), ii = sigmoid_f(X[tm][r] + biv);
                    const float a = __builtin_amdgcn_exp2f(-rr * spv); A[tm][r] = a; X[tm][r] = __builtin_amdgcn_sqrtf(1.0f - a * a) * (ii * uu);
                    if ((r & 3) == 3) asm volatile("" ::: "memory"); }
#pragma unroll
            for (int tm = 0; tm < 2; ++tm)
#pragma unroll
                for (int rg = 0; rg < 4; ++rg) { const int r0 = 4 * rg;
                    if (d == 0) {
#pragma unroll
                        for (int e2 = 1; e2 < 4; ++e2) { X[tm][r0 + e2] = A[tm][r0 + e2] * X[tm][r0 + e2 - 1] + X[tm][r0 + e2]; A[tm][r0 + e2] = A[tm][r0 + e2] * A[tm][r0 + e2 - 1]; } }
                    else {
#pragma unroll
                        for (int e2 = 2; e2 >= 0; --e2) { X[tm][r0 + e2] = A[tm][r0 + e2] * X[tm][r0 + e2 + 1] + X[tm][r0 + e2]; A[tm][r0 + e2] = A[tm][r0 + e2] * A[tm][r0 + e2 + 1]; } } }
            float enH[8], enP[8]; float EH = 0.f, EP = 1.f;
            if (d == 0) {
#pragma unroll
                for (int q = 0; q < 8; ++q) { const int tm = q >> 2, re = 4 * (q & 3) + 3; const float ce = A[tm][re], he = X[tm][re];
                    const float aH = swap_lo(ce * EH + he), aP = swap_lo(EP * ce);
                    const float E1H = hi ? aH : EH, E1P = hi ? aP : EP;
                    enH[q] = E1H; enP[q] = E1P;
                    EH = swap_hi(ce * E1H + he); EP = swap_hi(E1P * ce); }
            } else {
#pragma unroll
                for (int q = 7; q >= 0; --q) { const int tm = q >> 2, re = 4 * (q & 3); const float ce = A[tm][re], he = X[tm][re];
                    const float aH = swap_hi(ce * EH + he), aP = swap_hi(EP * ce);
                    const float E1H = hi ? EH : aH, E1P = hi ? EP : aP;
                    enH[q] = E1H; enP[q] = E1P;
                    EH = swap_lo(ce * E1H + he); EP = swap_lo(E1P * ce); }
            }
            { const unsigned ob = (unsigned)((((s0row + t0 + 4 * hi) * 2 + d) * 256 + c) * 2);
#pragma unroll
              for (int tm = 0; tm < 2; ++tm)
#pragma unroll
                for (int rg = 0; rg < 4; ++rg) { const int q = 4 * tm + rg;
#pragma unroll
                    for (int e2 = 0; e2 < 4; ++e2) { const int r = 4 * rg + e2; const unsigned o = ob + (unsigned)(32 * tm + 8 * rg + e2) * 1024u;
                        *(unsigned short*)((char*)HL + o) = (unsigned short)f2bf(X[tm][r] + A[tm][r] * enH[q]); *(unsigned short*)((char*)CP + o) = (unsigned short)f2bf(A[tm][r] * enP[q]); }
                    asm volatile("" ::: "memory"); } }
            if (hi == 0) SUM[((size_t)(b * NCHUNK + ci) * 2 + d) * 256 + c] = (f32x2v){EP, EH};
        }
        __syncthreads();
    }
}
constexpr size_t WS_CARRY = 255 * MiB;
__device__ __forceinline__ void ph_lru_carry(Frame& F) {
    if (F.vcu < 4) {
        const int g = F.vcu * NTHREADS + F.tid, b = g >> 9, d = (g >> 8) & 1, c = g & 255;
        const f32x2v* sb = (const f32x2v*)(F.ws + WS_SUM) + ((size_t)b * NCHUNK * 2 + d) * 256 + c;
        float* cr = (float*)(F.ws + WS_CARRY) + ((size_t)b * NCHUNK * 2 + d) * 256 + c;
        float h = 0.f;
#pragma unroll 1
        for (int p0 = 0; p0 < NCHUNK; p0 += 17) {
            f32x2v s[17];
#pragma unroll
            for (int i = 0; i < 17; ++i) { const int p = p0 + i, j = (d == 0) ? p : (p < 4 ? 3 - p : NCHUNK + 3 - p); s[i] = sb[(size_t)j * 512]; }
#pragma unroll
            for (int i = 0; i < 17; ++i) { const int p = p0 + i, j = (d == 0) ? p : (p < 4 ? 3 - p : NCHUNK + 3 - p); cr[(size_t)j * 512] = h; h = s[i].x * h + s[i].y; }
        }
    }
}
__device__ __forceinline__ void ph_lru2(Frame& F, int l) {
    const unsigned short* HL = (const unsigned short*)(F.ws + WS_HL); const unsigned short* CP = (const unsigned short*)(F.ws + WS_CP);
    const float* CARRY = (const float*)(F.ws + WS_CARRY); unsigned short* Y = (unsigned short*)(F.ws + WS_G);
    const int tid = F.tid, cg = tid & 31, tq = tid >> 5; const bool last = (l == NLAYER - 1);
    for (int unit = F.vcu; unit < NB * NCHUNK; unit += F.G) {
        const int b = unit / NCHUNK, ci = unit % NCHUNK;
        if (last && ci < 4) continue;
        const float* cp0 = CARRY + ((size_t)(b * NCHUNK + ci) * 2) * 256 + cg * 8;
        const f32x4 cfa = *(const f32x4*)cp0, cfb = *(const f32x4*)(cp0 + 4), cba = *(const f32x4*)(cp0 + 256), cbb = *(const f32x4*)(cp0 + 260);
        const float cf[8] = {cfa.x, cfa.y, cfa.z, cfa.w, cfb.x, cfb.y, cfb.z, cfb.w}, cbk[8] = {cba.x, cba.y, cba.z, cba.w, cbb.x, cbb.y, cbb.z, cbb.w};
        v4u hf[4], pf[4], hb[4], pb[4], gg[4];
#pragma unroll
        for (int i = 0; i < 4; ++i) { const size_t row = (size_t)b * TPB + ci * 64 + tq + 16 * i; const size_t o = (row * 2) * 256 + cg * 8;
            hf[i] = *(const v4u*)(HL + o); pf[i] = *(const v4u*)(CP + o); hb[i] = *(const v4u*)(HL + o + 256); pb[i] = *(const v4u*)(CP + o + 256); gg[i] = *(const v4u*)(Y + row * 1024 + 768 + cg * 8); }
#pragma unroll
        for (int i = 0; i < 4; ++i) { const size_t row = (size_t)b * TPB + ci * 64 + tq + 16 * i;
            unsigned w[4];
#pragma unroll
            for (int e = 0; e < 4; ++e) { const unsigned a = hf[i][e], p = pf[i][e], a2 = hb[i][e], p2 = pb[i][e], g = gg[i][e];
                const float v0 = (bflo(a) + bflo(p) * cf[2 * e] + bflo(a2) + bflo(p2) * cbk[2 * e]) * bflo(g);
                const float v1 = (bfhi(a) + bfhi(p) * cf[2 * e + 1] + bfhi(a2) + bfhi(p2) * cbk[2 * e + 1]) * bfhi(g);
                w[e] = pk2(v0, v1); }
            *(v4u*)(Y + row * 1024 + 768 + cg * 8) = (v4u){w[0], w[1], w[2], w[3]}; }
    }
}
#ifndef PGX_DMA
#define PGX_DMA 1
#endif
namespace pgx {
typedef short bf16x8 __attribute__((ext_vector_type(8)));
typedef float f32x4 __attribute__((ext_vector_type(4)));
typedef unsigned u32x4 __attribute__((ext_vector_type(4)));
typedef unsigned u32x2 __attribute__((ext_vector_type(2)));
constexpr int OPB = 16384;
template <int VAR> __device__ __forceinline__ void pgx_unit(LAS unsigned char* lds, const unsigned short* Y, const unsigned short* Wb, const unsigned short* S, unsigned short* MIX, int row0, int n0, int tid) {
    const int lane = tid & 63, wid = __builtin_amdgcn_readfirstlane(tid >> 6), wm = wid & 3, wn = wid >> 2, fr = lane & 15, fq = lane >> 4;
    const int sr0 = tid >> 3, sk = (tid & 7) * 8;
    const unsigned short* ysrc = Y + (size_t)(row0 + sr0) * 1024 + sk;
    const unsigned short* wsrc = Wb + (size_t)(n0 + sr0) * 256 + sk;
    const int ldst = (tid & 7) * 2048 + (sr0 & ~15) * 16 + (((sr0 & 15) ^ (tid & 7)) << 4);
    const int wrow = (sr0 & ~63) | (((sr0 >> 2) & 3) << 4) | (((sr0 >> 4) & 3) << 2) | (sr0 & 3);
    const int ldstw = (tid & 7) * 2048 + (wrow & ~15) * 16 + (((wrow & 15) ^ (tid & 7)) << 4);
    f32x4 acc[2][4], mix[2][4];
#pragma unroll
    for (int a = 0; a < 2; ++a)
#pragma unroll
        for (int b = 0; b < 4; ++b) { acc[a][b] = (f32x4){0.f, 0.f, 0.f, 0.f}; mix[a][b] = (f32x4){0.f, 0.f, 0.f, 0.f}; }
    u32x4 st[4][4];
    const unsigned short* yA = ysrc; const unsigned short* yB = ysrc + 64 * 1024;
    const unsigned short* wA = wsrc; const unsigned short* wB = wsrc + 64 * 256;
    const unsigned short* sp0 = S + (size_t)(row0 + 32 * wm + fr) * 4096 + n0 + 64 * wn + 16 * fq; const unsigned short* sp1 = sp0 + (size_t)16 * 4096;
#define PGX_LOADQ(set_, yo_, wp0_, wp1_, wo_) do { if (VAR == 2) { st[set_][0] = *(const u32x4*)(ysrc); st[set_][1] = *(const u32x4*)(ysrc + 64 * 1024); st[set_][2] = *(const u32x4*)(wsrc); st[set_][3] = *(const u32x4*)(wsrc + 64 * 256); } else if (VAR == 4) { st[set_][0] = st[set_][1] = st[set_][2] = st[set_][3] = (u32x4){1u,2u,3u,4u}; asm volatile("" : "+v"(st[set_][0]), "+v"(st[set_][1]), "+v"(st[set_][2]), "+v"(st[set_][3])); } else { st[set_][0] = *(const u32x4*)(yA + (yo_)); st[set_][1] = *(const u32x4*)(yB + (yo_)); st[set_][2] = *(const u32x4*)((wp0_) + (wo_)); st[set_][3] = *(const u32x4*)((wp1_) + (wo_)); } } while (0)
#define PGX_STORE(buf_, set_) do { LAS unsigned char* b_ = lds + (buf_) * 2 * OPB + ldst; \
        *(LAS u32x4*)b_ = st[set_][0]; *(LAS u32x4*)(b_ + 1024) = st[set_][1]; *(LAS u32x4*)(b_ - ldst + OPB + ldstw) = st[set_][2]; *(LAS u32x4*)(b_ - ldst + OPB + ldstw + 1024) = st[set_][3]; } while (0)
    u32x4 sga[2][2], sgb[2][2];
#define PGX_SLOAD(dst_, off_) do { if (VAR == 1 || VAR == 4) { dst_[0][0] = dst_[0][1] = dst_[1][0] = dst_[1][1] = (u32x4){0x3f803f80u, 0x3f803f80u, 0x3f803f80u, 0x3f803f80u}; } \
        else { dst_[0][0] = *(const u32x4*)(sp0 + (off_)); dst_[0][1] = *(const u32x4*)(sp0 + (off_) + 8); dst_[1][0] = *(const u32x4*)(sp1 + (off_)); dst_[1][1] = *(const u32x4*)(sp1 + (off_) + 8); } } while (0)
    PGX_SLOAD(sga, 0);
    PGX_LOADQ(0, 0, wA, wB, 0); PGX_LOADQ(1, 64, wA, wB, 64); PGX_LOADQ(2, 128, wA, wB, 128);
    PGX_STORE(0, 0);
    __syncthreads();
#define PGX_COMPUTE(h_) do { const LAS unsigned char* yb = lds + ((h_) & 1) * 2 * OPB + 32 * wm * 16; const LAS unsigned char* wb = lds + ((h_) & 1) * 2 * OPB + OPB + 64 * wn * 16; \
          _Pragma("unroll") for (int ks = 0; ks < 2; ++ks) { const int fo_ = (4 * ks + fq) * 2048 + ((fr ^ (4 * ks + fq)) << 4); \
              bf16x8 yf[2], wf[4]; \
              _Pragma("unroll") for (int tt = 0; tt < 2; ++tt) yf[tt] = *(const LAS bf16x8*)(yb + fo_ + tt * 256); \
              _Pragma("unroll") for (int nt = 0; nt < 4; ++nt) wf[nt] = *(const LAS bf16x8*)(wb + fo_ + nt * 256); \
              _Pragma("unroll") for (int tt = 0; tt < 2; ++tt) \
                  _Pragma("unroll") for (int nt = 0; nt < 4; ++nt) acc[tt][nt] = __builtin_amdgcn_mfma_f32_16x16x32_bf16(wf[nt], yf[tt], acc[tt][nt], 0, 0, 0); } } while (0)
#pragma unroll 1
    for (int kk = 0; kk < 4; ++kk) {
        const bool more = kk < 3;
        const unsigned short* wnA = more ? wA + (size_t)1024 * 256 : wsrc; const unsigned short* wnB = more ? wB + (size_t)1024 * 256 : wsrc + 64 * 256;
        const int yo = more ? 256 : -768;
        PGX_SLOAD(sgb, more ? 1024 : 0);
        PGX_LOADQ(3, 192, wA, wB, 192); PGX_COMPUTE(0); PGX_STORE(1, 1); __syncthreads();
        PGX_LOADQ(0, yo, wnA, wnB, 0); PGX_COMPUTE(1); PGX_STORE(0, 2); __syncthreads();
        PGX_LOADQ(1, yo + 64, wnA, wnB, 64); PGX_COMPUTE(2); PGX_STORE(1, 3); __syncthreads();
        PGX_LOADQ(2, yo + 128, wnA, wnB, 128); PGX_COMPUTE(3);
#pragma unroll
        for (int tt = 0; tt < 2; ++tt)
#pragma unroll
            for (int nt = 0; nt < 4; ++nt) { const u32x4 gv = sga[tt][nt >> 1]; const unsigned g0 = (nt & 1) ? gv.z : gv.x, g1 = (nt & 1) ? gv.w : gv.y; const f32x4 a = acc[tt][nt];
                mix[tt][nt] += (f32x4){a[0] * bflo(g0), a[1] * bfhi(g0), a[2] * bflo(g1), a[3] * bfhi(g1)}; acc[tt][nt] = (f32x4){0.f, 0.f, 0.f, 0.f}; }
#pragma unroll
        for (int tt = 0; tt < 2; ++tt) { sga[tt][0] = sgb[tt][0]; sga[tt][1] = sgb[tt][1]; }
        if (more) PGX_STORE(0, 0);
        __syncthreads();
        yA += 256; yB += 256; wA = wnA; wB = wnB; sp0 += 1024; sp1 += 1024;
    }
#pragma unroll
    for (int tt = 0; tt < 2; ++tt) { unsigned short* mp = MIX + (size_t)(row0 + 32 * wm + 16 * tt + fr) * 1024 + n0 + 64 * wn + 16 * fq;
        u32x4 w0, w1; w0.x = pk2(mix[tt][0][0], mix[tt][0][1]); w0.y = pk2(mix[tt][0][2], mix[tt][0][3]); w0.z = pk2(mix[tt][1][0], mix[tt][1][1]); w0.w = pk2(mix[tt][1][2], mix[tt][1][3]);
        w1.x = pk2(mix[tt][2][0], mix[tt][2][1]); w1.y = pk2(mix[tt][2][2], mix[tt][2][3]); w1.z = pk2(mix[tt][3][0], mix[tt][3][1]); w1.w = pk2(mix[tt][3][2], mix[tt][3][3]);
        *(u32x4*)mp = w0; *(u32x4*)(mp + 8) = w1; }
#undef PGX_LOADQ
#undef PGX_SLOAD
#undef PGX_STORE
#undef PGX_COMPUTE
}

__device__ __forceinline__ void pgx_unit_dma(LAS unsigned char* lds, const unsigned short* Y, const unsigned short* Wb, const unsigned short* S, unsigned short* MIX, int row0, int n0, int tid) {
    const int lane = tid & 63, wid = __builtin_amdgcn_readfirstlane(tid >> 6), wm = wid & 3, wn = wid >> 2, fr = lane & 15, fq = lane >> 4;
    const int dr = 8 * wid + (lane >> 3), dc = (lane & 7) ^ ((dr >> 1) & 7);
    const int wr = (dr & ~63) | (((dr >> 2) & 3) << 4) | (((dr >> 4) & 3) << 2) | (dr & 3);
    const unsigned short* yg = Y + (size_t)(row0 + dr) * 1024 + dc * 8;
    const unsigned short* wg = Wb + (size_t)(n0 + wr) * 256 + dc * 8;
    const unsigned ldsw = (unsigned)(uintptr_t)lds + wid * 1024;
#define PGD_DMA(s_) do { const int s__ = (s_); const unsigned b__ = ldsw + (unsigned)(s__ & 3) * 2 * OPB; const unsigned short* y__ = yg + s__ * 64; const unsigned short* w__ = wg + (size_t)(s__ >> 2) * 1024 * 256 + (s__ & 3) * 64; \
        att::glds16(y__, (unsigned)__builtin_amdgcn_readfirstlane(b__)); att::glds16(y__ + 64 * 1024, (unsigned)__builtin_amdgcn_readfirstlane(b__ + 8192)); \
        att::glds16(w__, (unsigned)__builtin_amdgcn_readfirstlane(b__ + OPB)); att::glds16(w__ + 64 * 256, (unsigned)__builtin_amdgcn_readfirstlane(b__ + OPB + 8192)); } while (0)
    f32x4 acc[2][4], mix[2][4];
#pragma unroll
    for (int a = 0; a < 2; ++a)
#pragma unroll
        for (int b = 0; b < 4; ++b) { acc[a][b] = (f32x4){0.f, 0.f, 0.f, 0.f}; mix[a][b] = (f32x4){0.f, 0.f, 0.f, 0.f}; }
    const unsigned short* sp0 = S + (size_t)(row0 + 32 * wm + fr) * 4096 + n0 + 64 * wn + 16 * fq; const unsigned short* sp1 = sp0 + (size_t)16 * 4096;
    u32x4 sga[2][2], sgb[2][2];
#define PGD_SLOAD(dst_, off_) do { dst_[0][0] = *(const u32x4*)(sp0 + (off_)); dst_[0][1] = *(const u32x4*)(sp0 + (off_) + 8); dst_[1][0] = *(const u32x4*)(sp1 + (off_)); dst_[1][1] = *(const u32x4*)(sp1 + (off_) + 8); } while (0)
    PGD_DMA(0); PGD_DMA(1); PGD_DMA(2);
    PGD_SLOAD(sga, 0);
    asm volatile("s_waitcnt vmcnt(12) lgkmcnt(0)\n\ts_barrier" ::: "memory");
    const unsigned fo0 = (unsigned)(uintptr_t)lds + fr * 128 + ((fq ^ ((fr >> 1) & 7)) << 4);
#define PGD_COMPUTE(h_) do { const unsigned yb = (h_) * 2 * OPB + 32 * wm * 128, wb = (h_) * 2 * OPB + OPB + 64 * wn * 128; \
          _Pragma("unroll") for (int ks = 0; ks < 2; ++ks) { const unsigned fo_ = fo0 ^ (unsigned)(64 * ks); \
              bf16x8 yf[2], wf[4]; \
              _Pragma("unroll") for (int tt = 0; tt < 2; ++tt) yf[tt] = *(const LAS bf16x8*)(uintptr_t)(fo_ + yb + tt * 2048); \
              _Pragma("unroll") for (int nt = 0; nt < 4; ++nt) wf[nt] = *(const LAS bf16x8*)(uintptr_t)(fo_ + wb + nt * 2048); \
              _Pragma("unroll") for (int tt = 0; tt < 2; ++tt) \
                  _Pragma("unroll") for (int nt = 0; nt < 4; ++nt) acc[tt][nt] = __builtin_amdgcn_mfma_f32_16x16x32_bf16(wf[nt], yf[tt], acc[tt][nt], 0, 0, 0); } } while (0)
#define PGD_END(N) asm volatile("s_waitcnt vmcnt(" #N ") lgkmcnt(0)\n\ts_barrier" ::: "memory")
#define PGD_MIX() do { \
        _Pragma("unroll") for (int tt = 0; tt < 2; ++tt) \
            _Pragma("unroll") for (int nt = 0; nt < 4; ++nt) { const u32x4 gv = sga[tt][nt >> 1]; const unsigned g0 = (nt & 1) ? gv.z : gv.x, g1 = (nt & 1) ? gv.w : gv.y; const f32x4 a = acc[tt][nt];        \
                mix[tt][nt] += (f32x4){a[0] * bflo(g0), a[1] * bfhi(g0), a[2] * bflo(g1), a[3] * bfhi(g1)}; acc[tt][nt] = (f32x4){0.f, 0.f, 0.f, 0.f}; } } while (0)
#pragma unroll 1
    for (int kk = 0; kk < 3; ++kk) {
        const int s0 = 4 * kk;
        PGD_SLOAD(sgb, 1024);
        PGD_DMA(s0 + 3); PGD_COMPUTE(0); PGD_END(12);
        PGD_DMA(s0 + 4); PGD_COMPUTE(1); PGD_END(12);
        PGD_DMA(s0 + 5); PGD_COMPUTE(2); PGD_END(8);
        PGD_DMA(s0 + 6); PGD_COMPUTE(3);
        PGD_MIX();
#pragma unroll
        for (int tt = 0; tt < 2; ++tt) { sga[tt][0] = sgb[tt][0]; sga[tt][1] = sgb[tt][1]; }
        PGD_END(8);
        sp0 += 1024; sp1 += 1024;
    }
    PGD_DMA(15); PGD_COMPUTE(0); PGD_END(8);
    PGD_COMPUTE(1); PGD_END(4);
    PGD_COMPUTE(2); PGD_END(0);
    PGD_COMPUTE(3);
    PGD_MIX();
    PGD_END(0);
#pragma unroll
    for (int tt = 0; tt < 2; ++tt) { unsigned short* mp = MIX + (size_t)(row0 + 32 * wm + 16 * tt + fr) * 1024 + n0 + 64 * wn + 16 * fq;
        u32x4 w0, w1; w0.x = pk2(mix[tt][0][0], mix[tt][0][1]); w0.y = pk2(mix[tt][0][2], mix[tt][0][3]); w0.z = pk2(mix[tt][1][0], mix[tt][1][1]); w0.w = pk2(mix[tt][1][2], mix[tt][1][3]);
        w1.x = pk2(mix[tt][2][0], mix[tt][2][1]); w1.y = pk2(mix[tt][2][2], mix[tt][2][3]); w1.z = pk2(mix[tt][3][0], mix[tt][3][1]); w1.w = pk2(mix[tt][3][2], mix[tt][3][3]);
        *(u32x4*)mp = w0; *(u32x4*)(mp + 8) = w1; }
#undef PGD_DMA
#undef PGD_SLOAD
#undef PGD_COMPUTE
#undef PGD_END
#undef PGD_MIX
}
}
template <int VAR> __device__ __forceinline__ void ph_pgx(Frame& F, int l, int r_lo = 0, int r_hi = 1 << 20, bool signal = false) {
    const unsigned short* Y = (const unsigned short*)(F.ws + WS_G); const unsigned short* S = (const unsigned short*)(F.ws + WS_S); unsigned short* MIX = (VAR == 0) ? (unsigned short*)(F.ws + WS_H) : (unsigned short*)F.out;
    const unsigned short* Wb = (const unsigned short*)(F.ws + WS_W + (size_t)l * W_LAYER + WO_WB);
    const bool last = (l == NLAYER - 1);
    const int nrt = last ? 128 : NROWS / 128;
    for (int r = r_lo; r <= r_hi; ++r) {
        const int u = F.vcu + r * F.G; if (u >= nrt * 8) break;
        int rt = u >> 3; const int ct = u & 7;
        if (last) rt = rt + 2 * (rt / 32) + 2;
        if (VAR == 0 && PGX_DMA) pgx::pgx_unit_dma(F.lds + RING_OFF, Y, Wb, S, MIX, rt * 128, ct * 128, F.tid); else pgx::pgx_unit<VAR>(F.lds + RING_OFF, Y, Wb, S, MIX, rt * 128, ct * 128, F.tid);
        if (signal) {
            asm volatile("s_waitcnt vmcnt(0)" ::: "memory"); __syncthreads();
            if (F.tid == 0) { __builtin_amdgcn_fence(__ATOMIC_RELEASE, "agent"); asm volatile("s_waitcnt vmcnt(0)" ::: "memory");
                (void)xb_add((unsigned*)((gu32*)(F.ws + WS_CTL) + CW_FLG) + (u >> 4), 1u); }
        }
    }
}
constexpr int NPL = 10;
enum { PH_H = 0, PH_G1, PH_POST1, PH_G2, PH_POST2, PH_ATT, PH_SG, PH_PG, PH_MIX, PH_OG };
constexpr int NPHASES = 1 + NLAYER * NPL;
#ifndef NAIVE_ATT
#define NAIVE_ATT 0
#endif
#ifndef PROBE_MASK
#define PROBE_MASK 0
#endif
#ifndef PROBE_LAYERS
#define PROBE_LAYERS 3
#endif
#ifndef MERGE_PGOG
#define MERGE_PGOG 0
#endif
#ifndef PHMASK
#define PHMASK 16383
#endif
#ifndef MK_ONE_LAUNCH
#define MK_ONE_LAUNCH 1
#endif

__global__ void __launch_bounds__(NTHREADS, 2) fwd_kernel(Args args) {
    extern __shared__ __attribute__((aligned(16))) unsigned char lds_raw[];
    { LAS unsigned char* l0 = (LAS unsigned char*)lds_raw;
      for (int u = threadIdx.x; u < (LDS_BYTES - LDSCTL_OFF) / 4; u += NTHREADS) ((LAS unsigned*)(l0 + LDSCTL_OFF))[u] = 0u;
      __syncthreads();
      if (args.ph_hi - args.ph_lo > 1) (void)xcd_barrier_post((unsigned*)((gu32*)(args.ws + WS_CTL) + CW_BAR), (volatile LAS unsigned*)(l0 + MISC_OFF) + 8); }

    unsigned long long tacc = 0ull;
    for (int ph = args.ph_lo; ph < args.ph_hi; ++ph) {
        unsigned long long tph0 = 0ull; bool probed = false;
        if (PROBE_MASK) { const int pl = (ph == 0) ? 0 : (ph - 1) / NPL, pp = (ph == 0) ? 10 : (ph - 1) % NPL; probed = ((PROBE_MASK >> pp) & 1) && ((PROBE_LAYERS >> pl) & 1); if (probed) tph0 = __builtin_amdgcn_s_memrealtime(); }
        int z; asm volatile("s_mov_b32 %0, 0" : "=s"(z));
        Frame F;
        F.lds = (LAS unsigned char*)lds_raw + z; F.kin = (const float* const __attribute__((address_space(4)))*)((const __attribute__((address_space(4))) char*)__builtin_amdgcn_kernarg_segment_ptr() + z); F.ws = args.ws + z; F.out = args.out + z; F.z = z;
        F.tid = threadIdx.x + z; F.lane = F.tid & 63; F.wave = __builtin_amdgcn_readfirstlane(F.tid >> 6);
        F.G = gridDim.x + z; { const int bx = blockIdx.x + z; F.vcu = (F.G % 8 == 0) ? (bx % 8) * (F.G / 8) + bx / 8 : bx; }
        F.gw = F.vcu * NWAVES + F.wave; F.NGW = F.G * NWAVES;
        bool is_gemm = false;
        pg8::Gemm g{nullptr, nullptr, NROWS, 256, 1024, 1024, 31, 0};
        pg8::Order S; S.init(1, 1, F.G, (int)blockIdx.x + z, 0);
        pg8::EpiU E{pg8::EM_PLAIN, 0, F.ws, nullptr, nullptr, nullptr, 0, 0, 0, 0, 1 << 20};
        if (ph == 0) { if (PHMASK & 8192) p0_prologue(F); }
        else {
            const int l = (ph - 1) / NPL, p = (ph - 1) % NPL;
            unsigned char* wl = F.ws + WS_W + (size_t)l * W_LAYER;
            const bool last = (l == NLAYER - 1);
            const int nMc = last ? 64 : NROWS / 256, lat = last ? 1 : 0;
            const bool merged = last && F.G == 256 && MERGE_PGOG;
            E.l = l;
            if (p == PH_H && (PHMASK & 1)) { ph_hnorm(F, l); }
            else if (p == PH_G1 && (PHMASK & 2)) {
                is_gemm = true; g.A = (const bf16*)(F.ws + WS_H); g.Bt = (const bf16*)(wl + WO_W1); g.N = N1; g.K = 1024; g.lda = 1024;
                S.init(NROWS / 256, N1 / 256, F.G, (int)blockIdx.x + z, 0);
                E.mode = pg8::EM_SILU2; E.oA = WS_ZS; E.ldc = ZS_P; E.oB = WS_G; E.ldc2 = 1024; E.split_tile = 7;
            }
            else if (p == PH_POST1 && (PHMASK & 4)) { ph_lru1(F, l); ph_post1(F, l); }
            else if (p == PH_G2 && (PHMASK & 8)) {
                is_gemm = true; g.A = (const bf16*)(F.ws + WS_ZS); g.Bt = (const bf16*)(wl + WO_UQ); g.N = 1024; g.K = 256; g.lda = ZS_P; g.a_shift = 1; g.a_step = 512;
                S.init(NROWS / 256, 4, F.G, (int)blockIdx.x + z, 0);
                E.mode = pg8::EM_PLAIN; E.oA = WS_MQ; E.ldc = 512; E.oB = WS_MKV; E.ldc2 = 512; E.split_tile = 2;
            }
            else if (p == PH_POST2 && (PHMASK & 16)) { ph_lru_carry(F); ph_post2(F, l); }
            else if (p == PH_ATT && (PHMASK & 32)) {
#if NAIVE_ATT
                ph_attn_naive(F, l);
#else
                ph_attn(F, l);
#endif
                ph_lru2(F, l); }
            else if (p == PH_SG && (PHMASK & 512)) {
                is_gemm = true; g.A = (const bf16*)(F.ws + WS_H); g.Bt = (const bf16*)(wl + WO_W1) + (size_t)N1 * 1024; g.N = 4096; g.K = 1024; g.lda = 1024;
                S.init(nMc, 16, F.G, (int)blockIdx.x + z, lat);
                E.mode = pg8::EM_SIG; E.oA = WS_S; E.ldc = 4096;
            }
            else if (p == PH_PG && (PHMASK & 1024)) {
                int r_hi = 1 << 20;
                if (merged) { pg8::Unit u0; pg8::Order S0; S0.init(64, 4, F.G, (int)blockIdx.x + z, 1); (void)S0.next(0, u0); r_hi = u0.pm / 17; }
                ph_pgx<0>(F, l, 0, r_hi, merged);
#ifdef PGX_PROBE
                if (l == 0) { __syncthreads(); ph_pgx<PGX_PROBE>(F, l); }
#endif
            }
            else if (p == PH_MIX) {
                if (!last && (PHMASK & 2048)) {
                    is_gemm = true; g.A = (const bf16*)(F.ws + WS_H); g.Bt = (const bf16*)(F.ws + WS_WOS); g.N = 4096; g.K = 256; g.lda = 1024; g.a_shift = 2; g.a_step = 512;
                    S.init(4, 16, F.G, (int)blockIdx.x + z, 2);
                    E.mode = pg8::EM_PLAIN; E.oA = WS_S; E.ldc = 4096; }
            }
            else if (p == PH_OG && (PHMASK & 4096)) {
                is_gemm = true; g.A = (const bf16*)(F.ws + WS_H); g.Bt = (const bf16*)(wl + WO_WO); g.N = 1024; g.K = 1024; g.lda = 1024;
                S.init(64, 4, F.G, (int)blockIdx.x + z, 1);
                E.mode = pg8::EM_RES; E.xin = (l == 0) ? F.in(I_X) : (const float*)F.out; E.xout = F.out; E.cin0 = F.in(I_CTX); E.oA = WS_MOD; E.oB = WS_CTX1;
                if (merged) {
                    pg8::Unit u0; (void)S.next(0, u0); const int q = (u0.pm / 17) * 16 + u0.pm % 17 - 1;
                    if (F.tid == 0) { unsigned* bar = (unsigned*)((gu32*)(F.ws + WS_CTL) + CW_BAR); unsigned* flg = (unsigned*)((gu32*)(F.ws + WS_CTL) + CW_FLG) + q;
                        XB_SPIN(xb_ld(flg) < 16u, bar); __builtin_amdgcn_fence(__ATOMIC_ACQUIRE, "agent"); asm volatile("s_waitcnt vmcnt(0)" ::: "memory"); }
                    __syncthreads(); }
            }
        }
        if (is_gemm) pg8::gemm_phase<pg8::EpiU, pg8::Order, true, true>(F.lds + RING_OFF, g, S, E, F.tid);
        if (NLAYER == 2 && ph >= 1 && ph <= 1 + PH_OG) {
            const int p = ph - 1;
            if (p == PH_G1 || p == PH_G2 || p == PH_SG || p == PH_PG || p == PH_OG) {
                int z4; asm volatile("s_mov_b32 %0, 0" : "=s"(z4));
                Frame C;
                C.lds = (LAS unsigned char*)lds_raw + z4; C.kin = (const float* const __attribute__((address_space(4)))*)((const __attribute__((address_space(4))) char*)__builtin_amdgcn_kernarg_segment_ptr() + z4); C.ws = args.ws + z4; C.out = args.out + z4; C.z = z4;
                C.tid = threadIdx.x + z4; C.lane = C.tid & 63; C.wave = __builtin_amdgcn_readfirstlane(C.tid >> 6);
                C.G = gridDim.x + z4; const int bx = blockIdx.x + z4; C.vcu = (C.G % 8 == 0) ? (bx % 8) * (C.G / 8) + bx / 8 : bx;
                C.gw = C.vcu * NWAVES + C.wave; C.NGW = C.G * NWAVES;
                int cidx = -1, cn = 1, loA = 0, nA = 0, loB = 0, nB = 0;
                if (p == PH_G1) { const int nb = ((NROWS / 256) * (N1 / 256)) % C.G; cidx = bx - nb; cn = C.G - nb; loA = I_EARLY; nA = IC_G1; }
                else if (p == PH_G2) { const int nb = ((NROWS / 256) * 4) % C.G; cidx = bx - nb; cn = C.G - nb; loA = I_EARLY + IC_G1; nA = I_INL - IC_G1; }
                else if (p == PH_SG) { const int nb = ((NROWS / 256) * 16) % C.G; cidx = bx - nb; cn = C.G - nb; loA = I_EARLY + I_INL; nA = I_BR; loB = 0; nB = 1536; }
                else if (p == PH_PG) { const int nb = ((NROWS / 128) * 8) % C.G; cidx = C.vcu - nb; cn = C.G - nb; loA = I_EARLY + I_INL + I_BR; nA = I_OUT + I_SPLIT; loB = 1536; nB = 1536; }
                else { const int nb = (64 < C.G) ? 64 : 0; cidx = bx - nb; cn = C.G - nb; loB = 3072; nB = I_LAYER - 3072; }
                if (cidx >= 0) { __syncthreads();
                    if (p == PH_G1) p0_tables(C, cidx * NTHREADS + C.tid, cn * NTHREADS);
                    weight_copies(C, cidx * NWAVES + C.wave, cn * NWAVES, loA, nA, loB, nB); }
            }
        }
        if (MERGE_PGOG && ph == 1 + (NLAYER - 1) * NPL + PH_OG && gridDim.x == 256) {
            int z5; asm volatile("s_mov_b32 %0, 0" : "=s"(z5));
            Frame C;
            C.lds = (LAS unsigned char*)lds_raw + z5; C.kin = (const float* const __attribute__((address_space(4)))*)((const __attribute__((address_space(4))) char*)__builtin_amdgcn_kernarg_segment_ptr() + z5); C.ws = args.ws + z5; C.out = args.out + z5; C.z = z5;
            C.tid = threadIdx.x + z5; C.lane = C.tid & 63; C.wave = __builtin_amdgcn_readfirstlane(C.tid >> 6);
            C.G = gridDim.x + z5; const int bx = blockIdx.x + z5; C.vcu = (C.G % 8 == 0) ? (bx % 8) * (C.G / 8) + bx / 8 : bx;
            C.gw = C.vcu * NWAVES + C.wave; C.NGW = C.G * NWAVES;
            pg8::Unit u0; pg8::Order S0; S0.init(64, 4, C.G, bx, 1); (void)S0.next(0, u0);
            __syncthreads(); ph_pgx<0>(C, NLAYER - 1, u0.pm / 17 + 1, 1 << 20, true);
        }
        const bool empty_phase = (ph > 0) && (((ph - 1) % NPL == PH_MIX) || (MERGE_PGOG && ph == 1 + (NLAYER - 1) * NPL + PH_PG && gridDim.x == 256));
        if (empty_phase) __syncthreads();
        if (ph + 1 < args.ph_hi && !empty_phase) {
            int z2; asm volatile("s_mov_b32 %0, 0" : "=s"(z2));
            XcdBarrier bar; bar.bar = (unsigned*)((gu32*)(args.ws + z2 + WS_CTL) + CW_BAR); bar.x = xb_xcc_id(); bar.st = (volatile LAS unsigned*)((LAS unsigned char*)lds_raw + z2 + MISC_OFF) + 8;
            xcd_barrier(bar);
        }
        if (PROBE_MASK) { if (probed) tacc += __builtin_amdgcn_s_memrealtime() - tph0; }
    }
#ifdef EXTRA_BARRIERS
    for (int xb = 0; xb < EXTRA_BARRIERS; ++xb) { int z3; asm volatile("s_mov_b32 %0, 0" : "=s"(z3));
        XcdBarrier bar; bar.bar = (unsigned*)((gu32*)(args.ws + z3 + WS_CTL) + CW_BAR); bar.x = xb_xcc_id(); bar.st = (volatile LAS unsigned*)((LAS unsigned char*)lds_raw + z3 + MISC_OFF) + 8;
        xcd_barrier(bar); }
#endif
    if (PROBE_MASK) { const unsigned long long t0 = __builtin_amdgcn_s_memrealtime(); while (__builtin_amdgcn_s_memrealtime() - t0 < tacc) __builtin_amdgcn_s_sleep(8); }
}

extern "C" void kernel_launch(void* const* d_in, const int* in_sizes, int n_in, void* d_out, int out_size, void* d_ws, size_t ws_size, hipStream_t stream) {
    static int grid = 0;
    if (grid == 0) {
        if (n_in != 28 || out_size != NB * SEQ * DM || ws_size < WS_END) { fprintf(stderr, "kernel_launch: unexpected shapes (n_in %d out %d ws %zu); nothing launched\n", n_in, out_size, ws_size); grid = -1; return; }
        int dev = 0, cus = 0, per_cu = 0;
        if (hipGetDevice(&dev) != hipSuccess || hipDeviceGetAttribute(&cus, hipDeviceAttributeMultiprocessorCount, dev) != hipSuccess) { grid = -1; return; }
        if (hipFuncSetAttribute((const void*)fwd_kernel, hipFuncAttributeMaxDynamicSharedMemorySize, LDS_BYTES) != hipSuccess) { fprintf(stderr, "kernel_launch: hipFuncSetAttribute failed\n"); grid = -1; return; }
        if (hipOccupancyMaxActiveBlocksPerMultiprocessor(&per_cu, (const void*)fwd_kernel, NTHREADS, LDS_BYTES) != hipSuccess || per_cu < 1) { fprintf(stderr, "kernel_launch: occupancy query says %d\n", per_cu); (void)hipGetLastError(); grid = -1; return; }
        grid = cus;
    }
    if (grid < 0) return;
    (void)hipMemsetAsync((char*)d_ws + WS_CTL, 0, CTL_ZERO_BYTES, stream);
    Args a{};
    for (int i = 0; i < 28; ++i) a.in[i] = (const float*)d_in[i];
    a.out = (float*)d_out; a.ws = (unsigned char*)d_ws;
#if MK_ONE_LAUNCH
    a.ph_lo = 0; a.ph_hi = NPHASES;
    hipLaunchKernelGGL(fwd_kernel, dim3(grid), dim3(NTHREADS), LDS_BYTES, stream, a);
#else
    for (int ph = 0; ph < NPHASES; ++ph) { a.ph_lo = ph; a.ph_hi = ph + 1; hipLaunchKernelGGL(fwd_kernel, dim3(grid), dim3(NTHREADS), LDS_BYTES, stream, a); }
#endif
}
```

```cpp
#include <hip/hip_runtime.h>
#include <cstdio>
#include <cstdint>
#include <cmath>
__device__ __forceinline__ float bflo(unsigned w) { return __uint_as_float(w << 16); }
__device__ __forceinline__ float bfhi(unsigned w) { return __uint_as_float(w & 0xffff0000u); }
__device__ __forceinline__ float sigmoid_f(float v) { return __builtin_amdgcn_rcpf(1.0f + __builtin_amdgcn_exp2f(-1.4426950408889634f * v)); }
namespace pg8 {
#define PG8_LAS __attribute__((address_space(3)))
typedef unsigned short bf16_t;
typedef short bf16x8 __attribute__((ext_vector_type(8)));
typedef float f32x4 __attribute__((ext_vector_type(4)));
typedef unsigned u32x4 __attribute__((ext_vector_type(4)));
constexpr int BM = 256, BK = 64, HALF = 128, HTB = HALF * BK * 2  , STAGE_BYTES = 8 * HTB, NXCD = 8, WGM = 8;

__host__ __device__ __forceinline__ int lds_byte(int r, int c) { const int st = (r >> 4) * 2 + (c >> 5), rr = r & 15, cc = c & 31, ob = rr * 64 + cc * 2; return st * 1024 + (ob ^ (((ob >> 9) & 1) << 5)); }
__host__ __device__ __forceinline__ void stage_rc(int b, int& R, int& C) { const int st = b / 1024, sb = b % 1024, swz = sb ^ (((sb >> 9) & 1) << 5); R = (st >> 1) * 16 + swz / 64; C = (st & 1) * 32 + (swz % 64) / 2; }
__host__ __device__ __forceinline__ int perm32(int rho) { const int n = rho >> 4, i = rho & 15; return 8 * (i >> 2) + 4 * n + (i & 3); }

struct Unit { int pm, pn; };
struct Gemm { const bf16_t* A; const bf16_t* Bt; int M, N, K, lda; int a_shift, a_step; };

struct StaticOrder {
    int nM, nN, nwg, G, c;
    __host__ __device__ void init(int M, int N, int G_, int c_) { nM = M / BM; nN = N / BM; nwg = nM * nN; G = G_; c = c_; }
    __host__ __device__ bool next(int i, Unit& u) const {
        const long L = (long)i * G + c; if (L >= nwg) return false;
        int wgid = (int)L; { const int q = nwg / NXCD, r = nwg % NXCD, xcd = wgid % NXCD, off = wgid / NXCD; wgid = (xcd < r ? xcd * (q + 1) : r * (q + 1) + (xcd - r) * q) + off; }
        const int nig = WGM * nN, gid = wgid / nig, fm = gid * WGM, gsz = (nM - fm) < WGM ? (nM - fm) : WGM;
        u.pm = fm + ((wgid % nig) % gsz); u.pn = (wgid % nig) / gsz; return true;
    }
    __device__ __forceinline__ void a_ready(const Unit&) const {}
    __device__ __forceinline__ void done(const Unit&) const {}
};

__device__ __forceinline__ unsigned cvt_pk_bf16(float lo, float hi) { unsigned r; asm volatile("v_cvt_pk_bf16_f32 %0, %1, %2" : "=v"(r) : "v"(lo), "v"(hi)); return r; }
enum { EM_PLAIN = 0, EM_SILU2 = 1, EM_SIG = 2, EM_MUL = 3, EM_RES = 4 };
struct EpiU {
    static constexpr bool PERM = true, AFTER_DRAIN = false;
    int mode; int l; unsigned char* ws; const float* xin; float* xout; const float* cin0;
    size_t oA, oB; int ldc, ldc2, split_tile;
    __device__ __forceinline__ void operator()(const f32x4 (&acc)[2][2][4][2], const Unit& u, int wr, int wc, int fr, int fq) const {
        if (mode == EM_RES) {
            const int b = u.pm / 17, t0 = u.pm % 17;
            const float* src; float* dst; const float* gate; const float* modl = (const float*)(ws + oA) + (size_t)l * 5 * 3072;
            if (t0 == 0) { float* c1 = (float*)(ws + oB); src = ((l == 0) ? cin0 : (const float*)c1) + (size_t)b * 256 * 1024; dst = c1 + (size_t)b * 256 * 1024; gate = modl + 4 * 3072 + 2048; }
            else { const size_t o = ((size_t)b * 4096 + (size_t)(t0 - 1) * 256) * 1024; src = xin + o; dst = xout + o; gate = modl + b * 3072 + 2048; }
            const int col0 = u.pn * BM + wc * 32 + 8 * fq;
            const char* srcb = (const char*)src; char* dstb = (char*)dst; const char* gb = (const char*)(gate + col0);
            const unsigned off0 = (unsigned)((wr * 64 + fr) * 1024 + col0) * 4u;
#pragma unroll
            for (int ai = 0; ai < 2; ++ai) {
                f32x4 xo[4][2][2];
#pragma unroll
                for (int m = 0; m < 4; ++m) { const unsigned off = off0 + (unsigned)(ai * HALF + m * 16) * 4096u;
#pragma unroll
                    for (int bj = 0; bj < 2; ++bj)
#pragma unroll
                        for (int n = 0; n < 2; ++n) xo[m][bj][n] = *(const f32x4*)(srcb + (off + (unsigned)(bj * HALF + n * 4) * 4u)); }
#pragma unroll
                for (int m = 0; m < 4; ++m) { const unsigned off = off0 + (unsigned)(ai * HALF + m * 16) * 4096u;
#pragma unroll
                    for (int bj = 0; bj < 2; ++bj)
#pragma unroll
                        for (int n = 0; n < 2; ++n) { const unsigned cb = (unsigned)(bj * HALF + n * 4) * 4u; const f32x4 g = *(const f32x4*)(gb + cb);
                            *(f32x4*)(dstb + (off + cb)) = xo[m][bj][n] + g * acc[ai][bj][m][n]; } }
                asm volatile("" ::: "memory"); }
            return;
        }
        const int row0 = u.pm * BM + wr * 64 + fr; int colt = u.pn * BM; bf16_t* base = (bf16_t*)(ws + oA); int ld = ldc; bool second = false;
        if (u.pn >= split_tile) { base = (bf16_t*)(ws + oB); ld = ldc2; colt -= split_tile * BM; second = true; }
        const bool do_silu = (mode == EM_SILU2) && second;
        const int col0 = colt + wc * 32 + 8 * fq;
#pragma unroll
        for (int ai = 0; ai < 2; ++ai)
#pragma unroll
            for (int m = 0; m < 4; ++m) { bf16_t* rowp = base + (size_t)(row0 + ai * HALF + m * 16) * ld + col0;
#pragma unroll
                for (int bj = 0; bj < 2; ++bj) { f32x4 v0 = acc[ai][bj][m][0], v1 = acc[ai][bj][m][1];
                    if (mode == EM_SIG) {
#pragma unroll
                        for (int e = 0; e < 4; ++e) { v0[e] = sigmoid_f(v0[e]); v1[e] = sigmoid_f(v1[e]); } }
                    if (do_silu) {
#pragma unroll
                        for (int e = 0; e < 4; ++e) { v0[e] = v0[e] * sigmoid_f(v0[e]); v1[e] = v1[e] * sigmoid_f(v1[e]); } }
                    u32x4 w; w.x = cvt_pk_bf16(v0[0], v0[1]); w.y = cvt_pk_bf16(v0[2], v0[3]); w.z = cvt_pk_bf16(v1[0], v1[1]); w.w = cvt_pk_bf16(v1[2], v1[3]);
                    *(u32x4*)(rowp + bj * HALF) = w; } }
    }
};
struct Order {
    int nM, nN, nwg, G, c, latent_only, grouped, vc, nctx;
    __device__ void init(int nM_, int nN_, int G_, int c_, int lat) { nM = nM_; nN = nN_; nwg = nM * nN; G = G_; c = c_; latent_only = lat; grouped = 0; vc = 0; nctx = 0; }
    __device__ void init_grouped(int G_, int vc_, int with_ctx) { init(64, 4, G_, vc_, 1); grouped = 1; vc = vc_; nctx = with_ctx ? 64 : 0; }
    __device__ bool next(int i, Unit& u) const {
        if (grouped) {
            const int gi = i >> 2, grp = vc + gi * G;
            if (grp < 256) { const int pm = grp >> 2; u.pm = pm + pm / 16 + 1; u.pn = 4 * (i & 3) + (grp & 3); return true; }
            const int done = ((256 - vc + G - 1) / G) * 4;
            const int x = vc + (i - done) * G;
            if (i >= done && x < nctx) { const int g = x >> 2, k = x & 3; u.pm = (g >> 2) * 17; u.pn = 4 * k + (g & 3); return true; }
            return false;
        }
        const long L = (long)i * G + c; if (L >= nwg) return false;
        int wgid = (int)L; { const int q = nwg / NXCD, r = nwg % NXCD, xcd = wgid % NXCD, off = wgid / NXCD; wgid = (xcd < r ? xcd * (q + 1) : r * (q + 1) + (xcd - r) * q) + off; }
        const int nig = WGM * nN, gid = wgid / nig, fm = gid * WGM, gsz = (nM - fm) < WGM ? (nM - fm) : WGM;
        int pm = fm + ((wgid % nig) % gsz); u.pn = (wgid % nig) / gsz; if (latent_only == 1) pm = pm + pm / 16 + 1; else if (latent_only == 2) pm = pm * 17; u.pm = pm; return true;
    }
    __device__ __forceinline__ void a_ready(const Unit&) const {}
    __device__ __forceinline__ void done(const Unit&) const {}
};
template <class Epi, class Sched, bool ALIGN_EPI = false, bool SP2 = false>
__device__ __forceinline__ void gemm_phase(PG8_LAS unsigned char* lds, const Gemm g, const Sched& S, const Epi& E, const int tid  ) {
    const int wid = __builtin_amdgcn_readfirstlane(tid >> 6), lane = tid & 63, wr = wid >> 2, wc = wid & 3, fr = lane & 15, fq = lane >> 4;
    const int K = g.K, nt = K / BK;
    unsigned voffA[2], voffB[2];
#pragma unroll
    for (int i = 0; i < 2; ++i) { int R, C; stage_rc(tid * 16 + i * 8192, R, C); const int Rb = Epi::PERM ? ((R & ~31) + perm32(R & 31)) : R;
        voffA[i] = (unsigned)(R * g.lda + C) * 2u; voffB[i] = (unsigned)(Rb * K + C) * 2u; }
    const size_t kstep = (size_t)(BK * 2);
    const size_t hstepA = (size_t)HALF * g.lda * 2, hstepB = (size_t)HALF * K * 2;
    const size_t tstepA = 2 * hstepA, tstepB = 2 * hstepB;
    const unsigned ldsw = (unsigned)wid * 1024u;
    const int aoff = lds_byte(wr * 64 + fr, fq * 8), boff = lds_byte(wc * 32 + fr, fq * 8);
#define PG8_SA(b, h) (((b) * 2 + (h)) * HTB)
#define PG8_SB(b, h) ((4 + (b) * 2 + (h)) * HTB)
#define PG8_STAGE(bufoff, gbase, voff) do { _Pragma("unroll") for (int _i = 0; _i < 2; ++_i) \
        __builtin_amdgcn_global_load_lds((const unsigned*)((const char*)(gbase) + (voff)[_i]), (PG8_LAS unsigned*)(lds + (bufoff) + ldsw + _i * 8192), 16, 0, 0); } while (0)
#define PG8_LDA(dst, b, h) do { _Pragma("unroll") for (int m = 0; m < 4; ++m) _Pragma("unroll") for (int k = 0; k < 2; ++k) dst[m][k] = *(const PG8_LAS bf16x8*)(lds + PG8_SA(b, h) + aoff + m * 2048 + k * 1024); } while (0)
#define PG8_LDB(dst, b, h) do { _Pragma("unroll") for (int n = 0; n < 2; ++n) _Pragma("unroll") for (int k = 0; k < 2; ++k) dst[n][k] = *(const PG8_LAS bf16x8*)(lds + PG8_SB(b, h) + boff + n * 2048 + k * 1024); } while (0)
#define PG8_MMA(ai, bj, At, Bt) do { __builtin_amdgcn_s_setprio(1); _Pragma("unroll") for (int m = 0; m < 4; ++m) _Pragma("unroll") for (int n = 0; n < 2; ++n) _Pragma("unroll") for (int k = 0; k < 2; ++k) \
        acc[ai][bj][m][n] = __builtin_amdgcn_mfma_f32_16x16x32_bf16(Bt[n][k], At[m][k], acc[ai][bj][m][n], 0, 0, 0); __builtin_amdgcn_s_setprio(0); } while (0)
#define PG8_WAIT_V(n) asm volatile("s_waitcnt vmcnt(" #n ")" ::: "memory")
#define PG8_WAIT_L(n) asm volatile("s_waitcnt lgkmcnt(" #n ")" ::: "memory")
#define PG8_BAR __builtin_amdgcn_s_barrier()
#define PG8_SCHED __builtin_amdgcn_sched_barrier(0)
    Unit cur, nxt; int ui = 0;
    if (!S.next(0, cur)) return;
    f32x4 acc[2][2][4][2];
#pragma unroll
    for (int a = 0; a < 2; ++a)
#pragma unroll
        for (int b = 0; b < 2; ++b)
#pragma unroll
            for (int m = 0; m < 4; ++m)
#pragma unroll
                for (int n = 0; n < 2; ++n) acc[a][b][m][n] = (f32x4){0.f, 0.f, 0.f, 0.f};
    bf16x8 At[4][2], B0[2][2], B1[2][2];
    const char* cA = (const char*)g.A + (size_t)cur.pm * tstepA + (size_t)(cur.pn >> g.a_shift) * (size_t)g.a_step; const char* cB = (const char*)g.Bt + (size_t)cur.pn * tstepB;
    S.a_ready(cur);
    if constexpr (SP2) {
        PG8_STAGE(PG8_SB(0, 0), cB, voffB); PG8_STAGE(PG8_SB(0, 1), cB + hstepB, voffB); PG8_STAGE(PG8_SA(0, 0), cA, voffA); PG8_STAGE(PG8_SA(0, 1), cA + hstepA, voffA);
        if (wr == 1) PG8_BAR;
        PG8_WAIT_V(2); PG8_BAR;
        PG8_STAGE(PG8_SB(1, 0), cB + kstep, voffB); PG8_STAGE(PG8_SA(1, 0), cA + kstep, voffA); PG8_STAGE(PG8_SB(1, 1), cB + hstepB + kstep, voffB);
        PG8_WAIT_V(6); PG8_BAR;
    } else {
        PG8_STAGE(PG8_SB(0, 0), cB, voffB); PG8_STAGE(PG8_SA(0, 0), cA, voffA); PG8_STAGE(PG8_SB(0, 1), cB + hstepB, voffB); PG8_STAGE(PG8_SA(0, 1), cA + hstepA, voffA);
        if (wr == 1) PG8_BAR;
        PG8_WAIT_V(4); PG8_BAR;
        PG8_STAGE(PG8_SB(1, 0), cB + kstep, voffB); PG8_STAGE(PG8_SA(1, 0), cA + kstep, voffA); PG8_STAGE(PG8_SB(1, 1), cB + hstepB + kstep, voffB);
        PG8_WAIT_V(6); PG8_BAR;
    }
    for (;;) {
        const bool has_next = S.next(ui + 1, nxt);
        const char* nA = has_next ? (const char*)g.A + (size_t)nxt.pm * tstepA + (size_t)(nxt.pn >> g.a_shift) * (size_t)g.a_step : cA; const char* nB = has_next ? (const char*)g.Bt + (size_t)nxt.pn * tstepB : cB;
        for (int t = 0; t < nt; t += 2) {
            const bool last = (t == nt - 2);
            const char* a1 = cA + (size_t)(t + 1) * kstep;
            const char* a2 = last ? nA : cA + (size_t)(t + 2) * kstep; const char* b2 = last ? nB : cB + (size_t)(t + 2) * kstep;
            const char* a3 = a2 + kstep; const char* b3 = b2 + kstep;
            if (last && has_next) S.a_ready(nxt);
            if constexpr (SP2) {
            PG8_LDB(B0, 0, 0); PG8_LDB(B1, 0, 1); PG8_SCHED; PG8_LDA(At, 0, 0); PG8_STAGE(PG8_SA(1, 1), a1 + hstepA, voffA);
            PG8_WAIT_V(8); PG8_WAIT_L(0); PG8_BAR; PG8_MMA(0, 0, At, B0); PG8_MMA(0, 1, At, B1); PG8_BAR; PG8_SCHED;
            PG8_LDA(At, 0, 1); PG8_STAGE(PG8_SB(0, 0), b2, voffB); PG8_STAGE(PG8_SB(0, 1), b2 + hstepB, voffB); PG8_STAGE(PG8_SA(0, 0), a2, voffA);
            PG8_WAIT_V(8); PG8_WAIT_L(0); PG8_BAR; PG8_MMA(1, 0, At, B0); PG8_MMA(1, 1, At, B1); PG8_BAR; PG8_SCHED;
            PG8_LDB(B0, 1, 0); PG8_LDB(B1, 1, 1); PG8_SCHED; PG8_LDA(At, 1, 0); PG8_STAGE(PG8_SA(0, 1), a2 + hstepA, voffA);
            PG8_WAIT_V(8); PG8_WAIT_L(0); PG8_BAR; PG8_MMA(0, 0, At, B0); PG8_MMA(0, 1, At, B1); PG8_BAR; PG8_SCHED;
            PG8_LDA(At, 1, 1); PG8_STAGE(PG8_SB(1, 0), b3, voffB); PG8_STAGE(PG8_SB(1, 1), b3 + hstepB, voffB); PG8_STAGE(PG8_SA(1, 0), a3, voffA);
            PG8_WAIT_V(8); PG8_WAIT_L(0); PG8_BAR; PG8_MMA(1, 0, At, B0); PG8_MMA(1, 1, At, B1); PG8_BAR; PG8_SCHED;
            } else {
            PG8_LDB(B0, 0, 0); PG8_SCHED; PG8_LDA(At, 0, 0); PG8_STAGE(PG8_SA(1, 1), a1 + hstepA, voffA);
            PG8_WAIT_L(8); PG8_BAR; PG8_WAIT_L(0); PG8_MMA(0, 0, At, B0); PG8_BAR; PG8_SCHED;
            PG8_LDB(B1, 0, 1); PG8_STAGE(PG8_SB(0, 0), b2, voffB);
            PG8_BAR; PG8_WAIT_L(0); PG8_MMA(0, 1, At, B1); PG8_BAR;
            PG8_LDA(At, 0, 1); PG8_STAGE(PG8_SA(0, 0), a2, voffA);
            PG8_BAR; PG8_WAIT_L(0); PG8_MMA(1, 0, At, B0); PG8_BAR; PG8_SCHED;
            PG8_STAGE(PG8_SB(0, 1), b2 + hstepB, voffB);
            PG8_WAIT_V(6); PG8_BAR; PG8_MMA(1, 1, At, B1); PG8_BAR;
            PG8_LDB(B0, 1, 0); PG8_SCHED; PG8_LDA(At, 1, 0); PG8_STAGE(PG8_SA(0, 1), a2 + hstepA, voffA);
            PG8_WAIT_L(8); PG8_BAR; PG8_WAIT_L(0); PG8_MMA(0, 0, At, B0); PG8_BAR; PG8_SCHED;
            PG8_LDB(B1, 1, 1); PG8_STAGE(PG8_SB(1, 0), b3, voffB);
            PG8_BAR; PG8_WAIT_L(0); PG8_MMA(0, 1, At, B1); PG8_BAR;
            PG8_LDA(At, 1, 1); PG8_STAGE(PG8_SA(1, 0), a3, voffA);
            PG8_BAR; PG8_WAIT_L(0); PG8_MMA(1, 0, At, B0); PG8_BAR; PG8_SCHED;
            PG8_STAGE(PG8_SB(1, 1), b3 + hstepB, voffB);
            PG8_WAIT_V(6); PG8_BAR; PG8_MMA(1, 1, At, B1); PG8_BAR;
            }
        }
        if constexpr (ALIGN_EPI) { if (wr == 0) PG8_BAR; }
        if constexpr (!Epi::AFTER_DRAIN) { E(acc, cur, wr, wc, fr, fq); S.done(cur); }
        if (!has_next) break;
#pragma unroll
        for (int a = 0; a < 2; ++a)
#pragma unroll
            for (int b = 0; b < 2; ++b)
#pragma unroll
                for (int m = 0; m < 4; ++m)
#pragma unroll
                    for (int n = 0; n < 2; ++n) acc[a][b][m][n] = (f32x4){0.f, 0.f, 0.f, 0.f};
        cur = nxt; cA = nA; cB = nB; ++ui;
        if constexpr (ALIGN_EPI) { if (wr == 1) PG8_BAR; }
    }
    PG8_WAIT_V(0);
    if constexpr (!ALIGN_EPI) { if (wr == 0) PG8_BAR; }
    PG8_BAR;
    if constexpr (Epi::AFTER_DRAIN) { E.fused(acc, cur, wr, wc, fr, fq, lds, wid, lane); S.done(cur); }
#undef PG8_SA
#undef PG8_SB
#undef PG8_STAGE
#undef PG8_LDA
#undef PG8_LDB
#undef PG8_MMA
#undef PG8_WAIT_V
#undef PG8_WAIT_L
#undef PG8_BAR
#undef PG8_SCHED
}
}
#define PG8_SP2 true
#define PG8_ALIGN true
#define GAS __attribute__((address_space(1)))
#define LAS __attribute__((address_space(3)))
typedef unsigned short bf16;
typedef unsigned v4u __attribute__((ext_vector_type(4)));
typedef float f32x4 __attribute__((ext_vector_type(4)));
typedef short bf16x8 __attribute__((ext_vector_type(8)));
typedef GAS unsigned gu32;
typedef GAS unsigned long long gu64;
#define RLX_AGENT __ATOMIC_RELAXED, __HIP_MEMORY_SCOPE_AGENT
#define LDS_WAIT() asm volatile("s_waitcnt lgkmcnt(0)" ::: "memory")
#define VM_WAIT() asm volatile("s_waitcnt vmcnt(0)" ::: "memory")
__device__ __forceinline__ unsigned long long rt() { return __builtin_amdgcn_s_memrealtime(); }
__device__ __forceinline__ unsigned f2bf(float f) { unsigned u = __builtin_bit_cast(unsigned, f); return (u + 0x7fffu + ((u >> 16) & 1u)) >> 16; }
__device__ __forceinline__ unsigned pk2(float lo, float hi) { return f2bf(lo) | (f2bf(hi) << 16); }
#define XB_TMO      128
#define XB_XCNT(j)  (256  + 64 * (j))
#define XB_XSUB(j)  (1280 + 64 * (j))
#define XB_XGEN(j)  (2304 + 64 * (j))
#define XB_TOP      3328
#define XB_TOPGEN   3392
#define XCD_BAR_WORDS 3456
#define XB_SPIN_CAP (1u << 18)

__device__ __forceinline__ unsigned xb_ld(unsigned* p)              { return __hip_atomic_load(p, __ATOMIC_RELAXED, __HIP_MEMORY_SCOPE_AGENT); }
__device__ __forceinline__ unsigned xb_add(unsigned* p, unsigned v) { return __hip_atomic_fetch_add(p, v, __ATOMIC_RELAXED, __HIP_MEMORY_SCOPE_AGENT); }
__device__ __forceinline__ unsigned xb_xcc_id() { return (unsigned)__builtin_amdgcn_s_getreg((3 << 11) | 20) & 0xFu; }
#define XB_SPIN(cond, bar) do { unsigned _sp = 0; while (cond) { __builtin_amdgcn_s_sleep(1); \
    if ((++_sp & 255u) == 0u) { if (xb_ld(&(bar)[XB_TMO])) break; if (_sp > XB_SPIN_CAP) { atomicAdd(&(bar)[XB_TMO], 1u); break; } } } } while (0)

struct XcdBarrier {
    unsigned* bar; unsigned x;
    volatile LAS unsigned* st;
};

__device__ __forceinline__ XcdBarrier xcd_barrier_post(unsigned* bar, volatile LAS unsigned* st) {
    XcdBarrier b; b.bar = bar; b.x = xb_xcc_id(); b.st = st;
    if (threadIdx.x == 0) (void)xb_add(&bar[XB_XCNT(b.x)], 1u);
    return b;
}
__device__ __forceinline__ void xcd_barrier_complete(unsigned* bar, unsigned x, unsigned& nloc, unsigned& nx) {
    const unsigned G = gridDim.x * gridDim.y * gridDim.z;
    unsigned sum, cnt, mine, sp = 0u;
    for (;;) {
        sum = 0u; cnt = 0u; mine = 0u;
#pragma unroll
        for (unsigned j = 0; j < 16; ++j) { const unsigned c = xb_ld(&bar[XB_XCNT(j)]); sum += c; cnt += (c > 0u) ? 1u : 0u; mine = (j == x) ? c : mine; }
        if (sum == G) break;
        __builtin_amdgcn_s_sleep(1);
        if ((++sp & 255u) == 0u) { if (xb_ld(&bar[XB_TMO])) break; if (sp > XB_SPIN_CAP) { atomicAdd(&bar[XB_TMO], 1u); break; } }
    }
    nloc = mine > 0u ? mine : 1u; nx = cnt > 0u ? cnt : 1u;
}

__device__ __forceinline__ void xcd_barrier(const XcdBarrier& b) {
    asm volatile("s_waitcnt vmcnt(0)" ::: "memory");
    __syncthreads();
    if (threadIdx.x == 0) {
        unsigned* bar = b.bar;
        __builtin_amdgcn_s_waitcnt(0);
        unsigned nloc = b.st[0], nx = b.st[1];
        if (nloc == 0u) { xcd_barrier_complete(bar, b.x, nloc, nx); b.st[0] = nloc; b.st[1] = nx; }
        const unsigned old = xb_add(&bar[XB_XSUB(b.x)], 1u);
        const unsigned gen = old / nloc;
        if (old + 1u == (gen + 1u) * nloc) {
            __builtin_amdgcn_fence(__ATOMIC_RELEASE, "agent");
            asm volatile("s_waitcnt vmcnt(0)" ::: "memory");
            const unsigned og = xb_add(&bar[XB_TOP], 1u);
            const unsigned tg = og / nx;
            if (og + 1u == (tg + 1u) * nx) xb_add(&bar[XB_TOPGEN], 1u);
            else XB_SPIN(xb_ld(&bar[XB_TOPGEN]) == tg, bar);
            __builtin_amdgcn_fence(__ATOMIC_ACQUIRE, "agent");
            xb_add(&bar[XB_XGEN(b.x)], 1u);
            asm volatile("s_waitcnt vmcnt(0)" ::: "memory");
        } else {
            XB_SPIN(xb_ld(&bar[XB_XGEN(b.x)]) == gen, bar);
            __builtin_amdgcn_fence(__ATOMIC_ACQUIRE, "agent");
            asm volatile("s_waitcnt vmcnt(0)" ::: "memory");
        }
    }
    __syncthreads();
}
constexpr int NB = 4, SEQ = 4096, CTXL = 256, TPB = SEQ + CTXL, NROWS = NB * TPB, DM = 1024, NLAYER = 2, IN_COLS = 6816;
constexpr int NWAVES = 8, NTHREADS = NWAVES * 64;
constexpr float RMS_EPS = 1e-6f;
constexpr float LOG2E = 1.4426950408889634f;
constexpr float QSCALE64 = 0.125f * LOG2E;
constexpr float QSCALE96 = 0.10206207261596575f * LOG2E;
constexpr int ZS_P = 1792, ZC_CQ = 0, ZC_CKV = 256, ZC_KR = 384, ZC_SQ = 512, ZC_SK = 768, ZC_SV = 896, ZC_AQ = 1024, ZC_AK = 1280, ZC_AV = 1408, ZC_LRU = 1536;
constexpr int N1 = 2816;
constexpr int W1ROWS = N1 + 4096;
constexpr size_t MiB = 1u << 20;
constexpr size_t WS_CTL = 0, CTL_ZERO_BYTES = 64 * 1024;
constexpr size_t WS_MOD = 1 * MiB;
constexpr size_t WS_RHC = 1 * MiB + 256 * 1024, WS_RHS = WS_RHC + 512 * 1024;
constexpr size_t WS_RMC = WS_RHS + 512 * 1024, WS_RMS = WS_RMC + 256 * 1024;
constexpr size_t WS_CTX1 = 3 * MiB;
constexpr size_t WS_WOS = 3 * MiB;
constexpr size_t WS_W = 8 * MiB, W_LAYER = 18 * MiB;
constexpr size_t WO_W1 = 0, WO_WB = 13 * MiB + 512 * 1024, WO_WO = WO_WB + 2 * MiB, WO_UQ = WO_WO + 2 * MiB, WO_UKV = WO_UQ + 256 * 1024;
constexpr size_t WS_H = 44 * MiB;
constexpr size_t WS_G = 78 * MiB;
constexpr size_t WS_S = 112 * MiB;
constexpr size_t WS_ZS = 112 * MiB;
constexpr size_t WS_MQ = 172 * MiB;
constexpr size_t WS_MKV = 189 * MiB;
constexpr size_t WS_MK = 206 * MiB;
constexpr size_t WS_U = 219 * MiB;
constexpr size_t WS_HF = 236 * MiB;
constexpr size_t WS_SP = 2 * MiB + 768 * 1024;
constexpr size_t WS_LWT = 254 * MiB + 512 * 1024;
constexpr size_t WS_END = 256 * MiB;
static_assert(WS_H + (size_t)NROWS * 1024 * 2 <= WS_G && WS_G + (size_t)NROWS * 1024 * 2 <= WS_S && WS_S + (size_t)NROWS * 4096 * 2 <= 248 * MiB, "ws map");
static_assert(WS_ZS + (size_t)NROWS * ZS_P * 2 <= WS_MQ && WS_MK + (size_t)NROWS * 384 * 2 <= WS_U, "ws map 2");
static_assert(WO_UKV + 512 * 256 * 2 <= W_LAYER, "weights");
constexpr int CW_BAR = 1024;
constexpr int CW_FLG = 8192;

constexpr int RING_OFF = 0, RING_BYTES = 131072, LDSCTL_OFF = RING_BYTES, MISC_OFF = LDSCTL_OFF + 320, LDS_BYTES = 147456;

typedef unsigned short bf16;
typedef unsigned u32x2 __attribute__((ext_vector_type(2)));
typedef float f32x2v __attribute__((ext_vector_type(2)));
__device__ __forceinline__ float bf2f(bf16 v) { return __uint_as_float((unsigned)v << 16); }
template <int O> __device__ __forceinline__ float xor_swz(float v) { return __int_as_float(__builtin_amdgcn_ds_swizzle(__float_as_int(v), (O << 10) | 0x1F)); }
__device__ __forceinline__ float wave_sum(float v) {
    v += xor_swz<1>(v); v += xor_swz<2>(v); v += xor_swz<4>(v); v += xor_swz<8>(v); v += xor_swz<16>(v);
    auto rr = __builtin_amdgcn_permlane32_swap(__float_as_uint(v), __float_as_uint(v), false, false); return __uint_as_float(rr[0]) + __uint_as_float(rr[1]); }
__device__ __forceinline__ float wave_max(float v) {
    v = fmaxf(v, xor_swz<1>(v)); v = fmaxf(v, xor_swz<2>(v)); v = fmaxf(v, xor_swz<4>(v)); v = fmaxf(v, xor_swz<8>(v)); v = fmaxf(v, xor_swz<16>(v));
    auto rr = __builtin_amdgcn_permlane32_swap(__float_as_uint(v), __float_as_uint(v), false, false); return fmaxf(__uint_as_float(rr[0]), __uint_as_float(rr[1])); }
__device__ __forceinline__ float grp16_sum(float v) {
    v += xor_swz<1>(v); v += xor_swz<2>(v); v += xor_swz<4>(v); v += xor_swz<8>(v); return v; }

struct Args { const float* in[28]; float* out; unsigned char* ws; int ph_lo, ph_hi; };
enum { I_X = 0, I_C, I_CTX, I_CCTX, I_WMOD, I_BMOD, I_NORMW, I_WIN, I_CQN, I_CKVN, I_WUQ, I_WUKV, I_MQN, I_MKN, I_SQN, I_SKN, I_SINK, I_AQN, I_AKN,
       I_CONVW, I_CONVB, I_LWR, I_LBR, I_LWI, I_LBI, I_LAM, I_WBR, I_WOUT };

struct Frame {
    LAS unsigned char* lds; const float* const __attribute__((address_space(4)))* kin; unsigned char* ws; float* out;
    int tid, lane, wave, G, vcu, gw, NGW, z;
    __device__ __forceinline__ const float* in(int i) const { return kin[i]; }
};

__device__ __forceinline__ void xpose_item(const float* W, int ldn, int k0, int n0, bf16* WT, int pd, int drow, LAS float* scr, int lane) {
    float v[32]; const float* wp = W + (size_t)(k0 + (lane >> 5)) * ldn + n0 + (lane & 31);
#pragma unroll
    for (int i = 0; i < 32; ++i) v[i] = wp[(size_t)(2 * i) * ldn];
#pragma unroll
    for (int i = 0; i < 32; ++i) scr[(2 * i + (lane >> 5)) * 33 + (lane & 31)] = v[i];
    LDS_WAIT(); asm volatile("" ::: "memory");
    const int c = lane & 7;
#pragma unroll
    for (int j = 0; j < 4; ++j) { const int n = (lane >> 3) + 8 * j; const LAS float* s = scr + (8 * c) * 33 + n;
        v4u o; o.x = pk2(s[0 * 33], s[1 * 33]); o.y = pk2(s[2 * 33], s[3 * 33]); o.z = pk2(s[4 * 33], s[5 * 33]); o.w = pk2(s[6 * 33], s[7 * 33]);
        *(GAS v4u*)(WT + (size_t)(drow + n0 + n) * pd + k0 + 8 * c) = o; }
    LDS_WAIT(); asm volatile("" ::: "memory");
}
__device__ __forceinline__ void zero16(bf16* p, size_t n16, int gt, int ngt) {
    for (size_t i = gt; i < n16; i += ngt) ((GAS v4u*)p)[i] = (v4u){0u, 0u, 0u, 0u};
}
constexpr int N1T = 2816 / 32;
constexpr int I_EARLY = 16 * N1T + 4 * 12 + 2 * 16, I_INL = 16 * (213 - N1T), I_BR = 4 * 4 * 32, I_OUT = 16 * 32, I_LAYER = I_EARLY + I_INL + I_BR + I_OUT, I_SPLIT = 16 * 32;
__device__ __forceinline__ void copy_item(Frame& F, int l, int r, LAS float* scr) {
    unsigned char* wl = F.ws + WS_W + (size_t)l * W_LAYER;
    if (r < 16 * N1T) { const int kb = r / N1T, nb = r % N1T, n0 = nb * 32;
        xpose_item(F.in(I_WIN) + (size_t)l * 1024 * IN_COLS, IN_COLS, kb * 64, n0, (bf16*)(wl + WO_W1), 1024, n0 >= 416 ? 96 : 0, scr, F.lane); return; } r -= 16 * N1T;
    if (r < 4 * 12) { const int kb = r / 12, nb = r % 12;
        xpose_item(F.in(I_WUQ) + (size_t)l * 256 * 384, 384, kb * 64, nb * 32, (bf16*)(wl + WO_UQ), 256, 0, scr, F.lane); return; } r -= 4 * 12;
    if (r < 2 * 16) { const int kb = r / 16, nb = r % 16;
        xpose_item(F.in(I_WUKV) + (size_t)l * 128 * 512, 512, kb * 64, nb * 32, (bf16*)(wl + WO_UKV), 256, 0, scr, F.lane); return; } r -= 2 * 16;
    if (r < I_INL) { const int kb = r / (213 - N1T), nb = N1T + r % (213 - N1T), n0 = nb * 32;
        xpose_item(F.in(I_WIN) + (size_t)l * 1024 * IN_COLS, IN_COLS, kb * 64, n0, (bf16*)(wl + WO_W1), 1024, 96, scr, F.lane); return; } r -= I_INL;
    if (r < I_BR) { const int k = r / 128, rr = r % 128, kb = rr / 32, nb = rr % 32;
        xpose_item(F.in(I_WBR) + ((size_t)l * 4 + k) * 256 * 1024, 1024, kb * 64, nb * 32, (bf16*)(wl + WO_WB) + (size_t)k * 1024 * 256, 256, 0, scr, F.lane); return; } r -= I_BR;
    if (r < I_OUT) { const int kb = r / 32, nb = r % 32;
        xpose_item(F.in(I_WOUT) + (size_t)l * 1024 * 1024, 1024, kb * 64, nb * 32, (bf16*)(wl + WO_WO), 1024, 0, scr, F.lane); return; } r -= I_OUT;
    if (r < I_SPLIT) { const int kb = r / 32, nb = r % 32, kq = kb >> 2;
        xpose_item(F.in(I_WOUT), 1024, kb * 64, nb * 32, (bf16*)(F.ws + WS_WOS) + (size_t)kq * (1024 * 256 - 256), 256, 0, scr, F.lane); }
}
__device__ __forceinline__ void weight_copies(Frame& F, int first, int stride, int loA, int nA, int loB, int nB) {
    LAS float* scr = (LAS float*)(F.lds + RING_OFF + F.wave * 16384);
#pragma unroll 1
    for (int v = first; v < nA + nB; v += stride) { const bool a = v < nA; copy_item(F, a ? 0 : NLAYER - 1, a ? loA + v : loB + v - nA, scr); }
}
constexpr int IC_G1 = 320;
__device__ __forceinline__ void p0_tables(Frame& F, int gt, int ngt) {
    { float* rhc = (float*)(F.ws + WS_RHC); float* rhs = (float*)(F.ws + WS_RHS); float* rmc = (float*)(F.ws + WS_RMC); float* rms = (float*)(F.ws + WS_RMS);
      constexpr float L2_10000 = 13.287712379549449f, INV_2PI = 0.15915494309189535f;
      for (int i = gt; i < 4096 * 32; i += ngt) { const int t = i >> 5, p = i & 31; const float fr = __builtin_amdgcn_exp2f(-(float)(p & 15) * (L2_10000 / 16.0f));
          const float pos = (float)((p < 16) ? (t >> 6) : (t & 63)); const float rev = pos * fr * INV_2PI; rhc[i] = __builtin_amdgcn_cosf(rev); rhs[i] = __builtin_amdgcn_sinf(rev); }
      for (int i = gt; i < 4096 * 16; i += ngt) { const int t = i >> 4, p = i & 15; const float fr = __builtin_amdgcn_exp2f(-(float)(p & 7) * (L2_10000 / 8.0f));
          const float pos = (float)((p < 8) ? (t >> 6) : (t & 63)); const float rev = pos * fr * INV_2PI; rmc[i] = __builtin_amdgcn_cosf(rev); rms[i] = __builtin_amdgcn_sinf(rev); } }
    { float* sp = (float*)(F.ws + WS_SP); for (int i = gt; i < NLAYER * 2 * 256; i += ngt) sp[i] = 8.0f * LOG2E * log1pf(expf(-F.in(I_LAM)[i])); }
    { float* lwt = (float*)(F.ws + WS_LWT);
      for (int o = gt; o < NLAYER * 2 * 2 * 256 * 64; o += ngt) { const int i = o & 63, c = (o >> 6) & 255, gate = (o >> 14) & 1, ld = o >> 15, k = c >> 6, j = c & 63;
          lwt[o] = (gate == 0 ? F.in(I_LWR) : F.in(I_LWI))[(((size_t)ld * 4 + k) * 64 + i) * 64 + j]; } }
}
__device__ __forceinline__ void p0_prologue(Frame& F) {
    weight_copies(F, F.gw, F.NGW, 0, I_EARLY, 0, 0);
    const int gt = F.vcu * NTHREADS + F.tid, ngt = F.G * NTHREADS;
    for (int l = 0; l < NLAYER; ++l) {
        unsigned char* wl = F.ws + WS_W + (size_t)l * W_LAYER;
        zero16((bf16*)(wl + WO_W1) + (size_t)416 * 1024, 96 * 1024 * 2 / 16, gt, ngt);
        zero16((bf16*)(wl + WO_UQ) + (size_t)384 * 256, 128 * 256 * 2 / 16, gt, ngt);
        for (int i = gt; i < 512 * 16; i += ngt) { const int n = i >> 4, c = i & 15; ((GAS v4u*)((bf16*)(wl + WO_UKV) + (size_t)n * 256 + 128))[c] = (v4u){0u, 0u, 0u, 0u}; }
    }
    { LAS float* sc = (LAS float*)(F.lds + RING_OFF);
      LAS float* red = sc + 5 * 1024;
      __syncthreads();
      for (int i = F.tid; i < 5 * 1024; i += NTHREADS) { const float v = (i < 4096) ? F.in(I_C)[i] : F.in(I_CCTX)[i - 4096]; sc[i] = v / (1.0f + expf(-v)); }
      __syncthreads();
      float* modv = (float*)(F.ws + WS_MOD);
      for (int it = F.vcu; it < NLAYER * 96; it += F.G) {
          const int l = it / 96, n0 = (it % 96) * 32, nn = F.tid & 31, kc = F.tid >> 5;
          const float* w = F.in(I_WMOD) + (size_t)l * 1024 * 3072 + n0 + nn;
          float acc[5] = {0.f, 0.f, 0.f, 0.f, 0.f};
#pragma unroll 1
          for (int k0 = kc * 64; k0 < kc * 64 + 64; k0 += 32) { float wv[32];
#pragma unroll
              for (int i = 0; i < 32; ++i) wv[i] = w[(size_t)(k0 + i) * 3072];
#pragma unroll
              for (int i = 0; i < 32; ++i)
#pragma unroll
                  for (int r = 0; r < 5; ++r) acc[r] += sc[r * 1024 + k0 + i] * wv[i]; }
#pragma unroll
          for (int r = 0; r < 5; ++r) red[(kc * 5 + r) * 32 + nn] = acc[r];
          __syncthreads();
          if (F.tid < 160) { const int r = F.tid >> 5; float s = 0.f;
              for (int q = 0; q < 16; ++q) s += red[(q * 5 + r) * 32 + nn];
              modv[((size_t)l * 5 + r) * 3072 + n0 + nn] = s + F.in(I_BMOD)[l * 3072 + n0 + nn]; }
          __syncthreads();
      } }
}

struct HRow { f32x4 v[4], sh[4], sc[4]; int row; };
__device__ __forceinline__ void hnorm_load(Frame& F, int l, int row, const float* xs, const float* cs, const float* modl, HRow& R) {
    const int b = row / TPB, j = row % TPB; const float* src; int mr;
    if (j < CTXL) { src = cs + ((size_t)b * CTXL + j) * 1024; mr = 4; } else { src = xs + ((size_t)b * SEQ + (j - CTXL)) * 1024; mr = b; }
    const GAS f32x4* xr = (const GAS f32x4*)src + F.lane; const float* mrow = modl + mr * 3072 + 4 * F.lane;
#pragma unroll
    for (int q = 0; q < 4; ++q) { R.v[q] = xr[64 * q]; R.sh[q] = *(const f32x4*)(mrow + 256 * q); R.sc[q] = *(const f32x4*)(mrow + 1024 + 256 * q); }
    R.row = row;
}
__device__ __forceinline__ void hnorm_finish(Frame& F, const HRow& R, const f32x4 (&g)[4], bf16* H) {
    float ss = 0.f;
#pragma unroll
    for (int q = 0; q < 4; ++q) ss += (R.v[q].x * R.v[q].x + R.v[q].y * R.v[q].y) + (R.v[q].z * R.v[q].z + R.v[q].w * R.v[q].w);
    const float rstd = 1.0f / sqrtf(wave_sum(ss) * (1.0f / 1024.0f) + RMS_EPS);
    GAS unsigned long long* o8 = (GAS unsigned long long*)(H + (size_t)R.row * 1024) + F.lane;
#pragma unroll
    for (int q = 0; q < 4; ++q) { const f32x4 h = R.v[q] * rstd * g[q] * (R.sc[q] + 1.0f) + R.sh[q];
        o8[64 * q] = (unsigned long long)pk2(h.x, h.y) | ((unsigned long long)pk2(h.z, h.w) << 32); }
}
__device__ __forceinline__ void ph_hnorm(Frame& F, int l) {
    const float* xs = (l == 0) ? F.in(I_X) : F.out; const float* cs = F.in(I_CTX);
    const float* nw = F.in(I_NORMW) + l * 1024; const float* modl = (const float*)(F.ws + WS_MOD) + (size_t)l * 5 * 3072;
    bf16* H = (bf16*)(F.ws + WS_H);
    f32x4 g[4];
#pragma unroll
    for (int q = 0; q < 4; ++q) g[q] = *(const f32x4*)(nw + 4 * F.lane + 256 * q);
    if (l > 0) {
        for (int cr = F.gw; cr < NB * CTXL; cr += F.NGW) { const int b = cr / CTXL, j = cr % CTXL, row = b * TPB + j;
            const unsigned short* P = (const unsigned short*)(F.ws + WS_S) + (size_t)row * 4096 + 4 * F.lane;
            const float* gt = (const float*)(F.ws + WS_MOD) + 4 * 3072 + 2048 + 4 * F.lane;
            const GAS f32x4* c0 = (const GAS f32x4*)(cs + ((size_t)b * CTXL + j) * 1024) + F.lane;
            const float* mrow = modl + 4 * 3072 + 4 * F.lane;
            HRow R; R.row = row;
#pragma unroll
            for (int q = 0; q < 4; ++q) { f32x4 a = {0.f, 0.f, 0.f, 0.f};
#pragma unroll
                for (int kq = 0; kq < 4; ++kq) { const u32x2 w = *(const u32x2*)(P + kq * 1024 + 256 * q); a.x += bflo(w.x); a.y += bfhi(w.x); a.z += bflo(w.y); a.w += bfhi(w.y); }
                R.v[q] = c0[64 * q] + *(const f32x4*)(gt + 256 * q) * a; R.sh[q] = *(const f32x4*)(mrow + 256 * q); R.sc[q] = *(const f32x4*)(mrow + 1024 + 256 * q); }
            hnorm_finish(F, R, g, H); }
    }
    const int n = (l == 0) ? NROWS : NB * SEQ;
#define HN_ROW(i_) ((l == 0) ? (i_) : ((i_) / SEQ) * TPB + CTXL + (i_) % SEQ)
    HRow A, B; int i = F.gw;
    if (i < n) hnorm_load(F, l, HN_ROW(i), xs, cs, modl, A);
    for (; i < n; i += 2 * F.NGW) {
        const int i1 = i + F.NGW, i2 = i + 2 * F.NGW;
        if (i1 < n) hnorm_load(F, l, HN_ROW(i1), xs, cs, modl, B);
        hnorm_finish(F, A, g, H);
        if (i2 < n) hnorm_load(F, l, HN_ROW(i2), xs, cs, modl, A);
        if (i1 < n) hnorm_finish(F, B, g, H);
    }
#undef HN_ROW
}

struct P1Regs { u32x2 cq; unsigned ckv, h[3][2]; float rc[2], rs[2]; };
__device__ __forceinline__ void post1_load(const bf16* z, const float* rc, const float* rs, bool lat, int lane, P1Regs& R) {
    const int hg = lane >> 4, p0 = (lane & 15) * 2;
    R.cq = *(const u32x2*)(z + ZC_CQ + 4 * lane); R.ckv = *(const unsigned*)(z + ZC_CKV + 2 * lane);
    const bf16* h0 = z + ZC_SQ + hg * 64 + p0; const bf16* h1 = z + ZC_AQ + hg * 64 + p0; const bf16* h2 = z + ((hg < 2) ? (ZC_SK + hg * 64) : (ZC_AK + (hg - 2) * 64)) + p0;
    R.h[0][0] = *(const unsigned*)h0; R.h[0][1] = *(const unsigned*)(h0 + 32); R.h[1][0] = *(const unsigned*)h1; R.h[1][1] = *(const unsigned*)(h1 + 32); R.h[2][0] = *(const unsigned*)h2; R.h[2][1] = *(const unsigned*)(h2 + 32);
    if (lat) { R.rc[0] = rc[p0]; R.rc[1] = rc[p0 + 1]; R.rs[0] = rs[p0]; R.rs[1] = rs[p0 + 1]; } else { R.rc[0] = 1.f; R.rc[1] = 1.f; R.rs[0] = 0.f; R.rs[1] = 0.f; }
}
__device__ __forceinline__ void post1_finish(bf16* z, int lane, const P1Regs& R, const float (&gcq)[4], const float (&gckv)[2], const float (&gh)[3][4]) {
    const int hg = lane >> 4, p0 = (lane & 15) * 2;
    { float v0 = bflo(R.cq.x), v1 = bfhi(R.cq.x), v2 = bflo(R.cq.y), v3 = bfhi(R.cq.y);
      const float rstd = 1.0f / sqrtf(wave_sum(v0 * v0 + v1 * v1 + v2 * v2 + v3 * v3) * (1.0f / 256.0f) + RMS_EPS);
      u32x2 w; w.x = pk2(v0 * rstd * gcq[0], v1 * rstd * gcq[1]); w.y = pk2(v2 * rstd * gcq[2], v3 * rstd * gcq[3]); *(u32x2*)(z + ZC_CQ + 4 * lane) = w; }
    { float v0 = bflo(R.ckv), v1 = bfhi(R.ckv);
      const float rstd = 1.0f / sqrtf(wave_sum(v0 * v0 + v1 * v1) * (1.0f / 128.0f) + RMS_EPS);
      *(unsigned*)(z + ZC_CKV + 2 * lane) = pk2(v0 * rstd * gckv[0], v1 * rstd * gckv[1]); }
#pragma unroll
    for (int q = 0; q < 3; ++q) {
        bf16* hp = z + ((q == 0) ? (ZC_SQ + hg * 64) : (q == 1) ? (ZC_AQ + hg * 64) : ((hg < 2) ? (ZC_SK + hg * 64) : (ZC_AK + (hg - 2) * 64))) + p0;
        float a0 = bflo(R.h[q][0]), a1 = bfhi(R.h[q][0]), b0 = bflo(R.h[q][1]), b1 = bfhi(R.h[q][1]);
        const float rstd = 1.0f / sqrtf(grp16_sum(a0 * a0 + a1 * a1 + b0 * b0 + b1 * b1) * (1.0f / 64.0f) + RMS_EPS);
        a0 *= rstd * gh[q][0]; a1 *= rstd * gh[q][1]; b0 *= rstd * gh[q][2]; b1 *= rstd * gh[q][3];
        const float x0 = a0 * R.rc[0] - b0 * R.rs[0], y0 = b0 * R.rc[0] + a0 * R.rs[0], x1 = a1 * R.rc[1] - b1 * R.rs[1], y1 = b1 * R.rc[1] + a1 * R.rs[1];
        const float sc = (q < 2) ? QSCALE64 : 1.0f;
        *(unsigned*)hp = pk2(x0 * sc, x1 * sc); *(unsigned*)(hp + 32) = pk2(y0 * sc, y1 * sc);
    }
}
__device__ __forceinline__ void ph_post1(Frame& F, int l) {
    bf16* ZS = (bf16*)(F.ws + WS_ZS);
    const float* rhc = (const float*)(F.ws + WS_RHC); const float* rhs = (const float*)(F.ws + WS_RHS);
    const int lane = F.lane, hg = lane >> 4, p0 = (lane & 15) * 2;
    float gcq[4], gckv[2], gh[3][4];
#pragma unroll
    for (int i = 0; i < 4; ++i) gcq[i] = F.in(I_CQN)[l * 256 + 4 * lane + i];
    gckv[0] = F.in(I_CKVN)[l * 128 + 2 * lane]; gckv[1] = F.in(I_CKVN)[l * 128 + 2 * lane + 1];
    { const float* g0 = F.in(I_SQN) + l * 64; const float* g1 = F.in(I_AQN) + l * 64; const float* g2 = ((hg < 2) ? F.in(I_SKN) : F.in(I_AKN)) + l * 64;
      gh[0][0] = g0[p0]; gh[0][1] = g0[p0 + 1]; gh[0][2] = g0[32 + p0]; gh[0][3] = g0[33 + p0];
      gh[1][0] = g1[p0]; gh[1][1] = g1[p0 + 1]; gh[1][2] = g1[32 + p0]; gh[1][3] = g1[33 + p0];
      gh[2][0] = g2[p0]; gh[2][1] = g2[p0 + 1]; gh[2][2] = g2[32 + p0]; gh[2][3] = g2[33 + p0]; }
    for (int row = F.gw; row < NROWS; row += 2 * F.NGW) {
        const int row2 = row + F.NGW; const bool has2 = row2 < NROWS;
        const int j = row % TPB; const bool lat = j >= CTXL; const int pos = lat ? j - CTXL : 0;
        const int j2 = has2 ? row2 % TPB : 0; const bool lat2 = j2 >= CTXL; const int pos2 = lat2 ? j2 - CTXL : 0;
        bf16* z = ZS + (size_t)row * ZS_P; bf16* z2 = ZS + (size_t)(has2 ? row2 : row) * ZS_P;
        P1Regs A, B;
        post1_load(z, rhc + pos * 32, rhs + pos * 32, lat, lane, A);
        if (has2) post1_load(z2, rhc + pos2 * 32, rhs + pos2 * 32, lat2, lane, B);
        post1_finish(z, lane, A, gcq, gckv, gh);
        if (has2) post1_finish(z2, lane, B, gcq, gckv, gh);
    }
}
struct P2Regs { u32x2 qn, kn; bf16 q1, q2, k1, k2; float c, s; };
__device__ __forceinline__ void post2_load(const bf16* zrow, const bf16* mq, const bf16* mkv, const float* rc, const float* rs, bool lat, int lane, P2Regs& R) {
    const int h = lane >> 4, j = lane & 15;
    R.qn = *(const u32x2*)(mq + h * 96 + 4 * j); R.q1 = mq[h * 96 + 64 + j]; R.q2 = mq[h * 96 + 80 + j];
    R.kn = *(const u32x2*)(mkv + h * 128 + 4 * j); R.k1 = zrow[ZC_KR + j]; R.k2 = zrow[ZC_KR + 16 + j];
    if (lat) { R.c = rc[j]; R.s = rs[j]; } else { R.c = 1.f; R.s = 0.f; }
}
__device__ __forceinline__ void post2_finish(bf16* mq, bf16* mk, int lane, const P2Regs& R, const float (&gq)[6], const float (&gk)[6]) {
    const int h = lane >> 4, j = lane & 15;
#pragma unroll
    for (int qk = 0; qk < 2; ++qk) {
        const u32x2 n = qk == 0 ? R.qn : R.kn; float v0 = bflo(n.x), v1 = bfhi(n.x), v2 = bflo(n.y), v3 = bfhi(n.y), r1 = bf2f(qk == 0 ? R.q1 : R.k1), r2 = bf2f(qk == 0 ? R.q2 : R.k2);
        const float rstd = 1.0f / sqrtf(grp16_sum(v0 * v0 + v1 * v1 + v2 * v2 + v3 * v3 + r1 * r1 + r2 * r2) * (1.0f / 96.0f) + RMS_EPS);
        const float (&g)[6] = qk == 0 ? gq : gk; const float sc = qk == 0 ? QSCALE96 : 1.0f;
        const float y1 = r1 * rstd * g[4], y2 = r2 * rstd * g[5];
        const float t1 = (y1 * R.c - y2 * R.s) * sc, t2 = (y2 * R.c + y1 * R.s) * sc;
        bf16* o = (qk == 0 ? mq : mk) + h * 96;
        u32x2 w; w.x = pk2(v0 * rstd * g[0] * sc, v1 * rstd * g[1] * sc); w.y = pk2(v2 * rstd * g[2] * sc, v3 * rstd * g[3] * sc);
        *(u32x2*)(o + 4 * j) = w; o[64 + j] = (bf16)f2bf(t1); o[80 + j] = (bf16)f2bf(t2);
    }
}
__device__ __forceinline__ void ph_post2(Frame& F, int l) {
    const bf16* ZS = (const bf16*)(F.ws + WS_ZS); bf16* MQ = (bf16*)(F.ws + WS_MQ); const bf16* MKV = (const bf16*)(F.ws + WS_MKV); bf16* MK = (bf16*)(F.ws + WS_MK);
    const float* rmc = (const float*)(F.ws + WS_RMC); const float* rms = (const float*)(F.ws + WS_RMS);
    const int lane = F.lane, jj = lane & 15;
    float gq[6], gk[6];
    { const float* a = F.in(I_MQN) + l * 96; const float* b = F.in(I_MKN) + l * 96;
#pragma unroll
      for (int i = 0; i < 4; ++i) { gq[i] = a[4 * jj + i]; gk[i] = b[4 * jj + i]; }
      gq[4] = a[64 + jj]; gq[5] = a[80 + jj]; gk[4] = b[64 + jj]; gk[5] = b[80 + jj]; }
    for (int row = F.gw; row < NROWS; row += 2 * F.NGW) {
        const int row2 = row + F.NGW; const bool has2 = row2 < NROWS; const size_t rb = has2 ? row2 : row;
        const int j = row % TPB; const bool lat = j >= CTXL; const int pos = lat ? j - CTXL : 0;
        const int j2 = (int)(rb % TPB); const bool lat2 = j2 >= CTXL; const int pos2 = lat2 ? j2 - CTXL : 0;
        P2Regs A, B;
        post2_load(ZS + (size_t)row * ZS_P, MQ + (size_t)row * 512, MKV + (size_t)row * 512, rmc + pos * 16, rms + pos * 16, lat, lane, A);
        if (has2) post2_load(ZS + rb * ZS_P, MQ + rb * 512, MKV + rb * 512, rmc + pos2 * 16, rms + pos2 * 16, lat2, lane, B);
        post2_finish(MQ + (size_t)row * 512, MK + (size_t)row * 384, lane, A, gq, gk);
        if (has2) post2_finish(MQ + rb * 512, MK + rb * 384, lane, B, gq, gk);
    }
}

template <int DQK>
__device__ __forceinline__ void attn_row_naive(const bf16* q, const bf16* Kb, int kp, const bf16* Vb, int vp, int n1, int lo2, int hi2, bool has_sink, float sink2, bf16* y, int lane) {
    float qf[DQK];
#pragma unroll
    for (int c = 0; c < DQK / 8; ++c) { const v4u w = *(const v4u*)(q + 8 * c);
        qf[8 * c + 0] = bflo(w.x); qf[8 * c + 1] = bfhi(w.x); qf[8 * c + 2] = bflo(w.y); qf[8 * c + 3] = bfhi(w.y); qf[8 * c + 4] = bflo(w.z); qf[8 * c + 5] = bfhi(w.z); qf[8 * c + 6] = bflo(w.w); qf[8 * c + 7] = bfhi(w.w); }
    float m = -INFINITY, l = 0.f; float acc[64];
#pragma unroll
    for (int d = 0; d < 64; ++d) acc[d] = 0.f;
    for (int seg = 0; seg < 2; ++seg) {
        const int k0 = seg == 0 ? 0 : lo2, k1 = seg == 0 ? n1 : hi2;
        for (int key = k0 + lane; key < k1; key += 64) {
            const bf16* kr = Kb + (size_t)key * kp; float s = 0.f;
#pragma unroll
            for (int c = 0; c < DQK / 8; ++c) { const v4u w = *(const v4u*)(kr + 8 * c);
                s += qf[8 * c + 0] * bflo(w.x) + qf[8 * c + 1] * bfhi(w.x) + qf[8 * c + 2] * bflo(w.y) + qf[8 * c + 3] * bfhi(w.y) + qf[8 * c + 4] * bflo(w.z) + qf[8 * c + 5] * bfhi(w.z) + qf[8 * c + 6] * bflo(w.w) + qf[8 * c + 7] * bfhi(w.w); }
            if (s > m) { const float f = exp2f(m - s); l *= f;
#pragma unroll
                for (int d = 0; d < 64; ++d) acc[d] *= f;
                m = s; }
            const float p = exp2f(s - m); l += p;
            const bf16* vr = Vb + (size_t)key * vp;
#pragma unroll
            for (int c = 0; c < 8; ++c) { const v4u w = *(const v4u*)(vr + 8 * c);
                acc[8 * c + 0] += p * bflo(w.x); acc[8 * c + 1] += p * bfhi(w.x); acc[8 * c + 2] += p * bflo(w.y); acc[8 * c + 3] += p * bfhi(w.y); acc[8 * c + 4] += p * bflo(w.z); acc[8 * c + 5] += p * bfhi(w.z); acc[8 * c + 6] += p * bflo(w.w); acc[8 * c + 7] += p * bfhi(w.w); }
        }
    }
    float M = wave_max(m); if (has_sink) M = fmaxf(M, sink2);
    const float f = (m == -INFINITY) ? 0.f : exp2f(m - M);
    float L = wave_sum(l * f); if (has_sink) L += exp2f(sink2 - M);
    float mine = 0.f;
#pragma unroll
    for (int d = 0; d < 64; ++d) { const float t = wave_sum(acc[d] * f); if (lane == d) mine = t; }
    y[lane] = (bf16)f2bf(mine / L * bf2f(y[lane]));
}
__device__ __forceinline__ void ph_attn_naive(Frame& F, int l) {
    const bf16* ZS = (const bf16*)(F.ws + WS_ZS); const bf16* MQ = (const bf16*)(F.ws + WS_MQ); const bf16* MKV = (const bf16*)(F.ws + WS_MKV); const bf16* MK = (const bf16*)(F.ws + WS_MK);
    bf16* Y = (bf16*)(F.ws + WS_G);
    const long nitems = (long)NROWS * 12;
    for (long it = F.gw; it < nitems; it += F.NGW) {
        const int hb = (int)(it % 12); const int row = (int)(it / 12);
        const int b = row / TPB, j = row % TPB; const bool lat = j >= CTXL;
        if (!lat && l == NLAYER - 1) continue;
        const size_t r0 = (size_t)b * TPB;
        const int br = hb >> 2, h = hb & 3;
        bf16* y = Y + (size_t)row * 1024 + br * 256 + h * 64;
        if (br == 0) {
            attn_row_naive<96>(MQ + (size_t)row * 512 + h * 96, MK + r0 * 384 + h * 96, 384, MKV + r0 * 512 + h * 128 + 64, 512, CTXL, CTXL, lat ? TPB : CTXL, false, 0.f, y, F.lane);
        } else if (br == 1) {
            const int t = j - CTXL; int lo = CTXL, hi = CTXL;
            if (lat) { lo = CTXL + (t - 128 < 0 ? 0 : t - 128); hi = CTXL + (t + 128 > SEQ - 1 ? SEQ - 1 : t + 128) + 1; }
            attn_row_naive<64>(ZS + (size_t)row * ZS_P + ZC_SQ + h * 64, ZS + r0 * ZS_P + ZC_SK + (h >> 1) * 64, ZS_P, ZS + r0 * ZS_P + ZC_SV + (h >> 1) * 64, ZS_P, CTXL, lo, hi, true, F.in(I_SINK)[l * 4 + h] * LOG2E, y, F.lane);
        } else {
            attn_row_naive<64>(ZS + (size_t)row * ZS_P + ZC_AQ + h * 64, ZS + r0 * ZS_P + ZC_AK + (h >> 1) * 64, ZS_P, ZS + r0 * ZS_P + ZC_AV + (h >> 1) * 64, ZS_P, CTXL, CTXL, lat ? TPB : CTXL, false, 0.f, y, F.lane);
        }
    }
}

__device__ __forceinline__ void ph_lru_conv(Frame& F, int l) {
    const bf16* ZS = (const bf16*)(F.ws + WS_ZS); float* U = (float*)(F.ws + WS_U);
    const float* cw = F.in(I_CONVW) + l * 4 * 256; const float* cb = F.in(I_CONVB) + l * 256;
    const int gt = F.vcu * NTHREADS + F.tid, ngt = F.G * NTHREADS;
    for (int idx = gt; idx < NROWS * 256; idx += ngt) {
        const int row = idx >> 8, c = idx & 255, b = row / TPB, j = row % TPB;
        int s0, len, jj; if (j < CTXL) { s0 = b * TPB; len = CTXL; jj = j; } else { s0 = b * TPB + CTXL; len = SEQ; jj = j - CTXL; }
        float acc = cb[c];
#pragma unroll
        for (int i = 0; i < 4; ++i) { const int t = jj + i - 2; if (t >= 0 && t < len) acc += cw[i * 256 + c] * bf2f(ZS[(size_t)(s0 + t) * ZS_P + ZC_LRU + c]); }
        U[idx] = acc;
    }
}
__device__ __forceinline__ void ph_lru_scan(Frame& F, int l, int dir) {
    const float* U = (const float*)(F.ws + WS_U); float* HF = (float*)(F.ws + WS_HF); bf16* Y = (bf16*)(F.ws + WS_G);
    const int g = blockIdx.x * NTHREADS + F.tid;
    if (g < NB * 256) {
    const int b = g >> 8, c = g & 255, k = c >> 6, jc = c & 63;
    const float* wr = F.in(I_LWR) + ((((size_t)l * 2 + dir) * 4 + k) * 64) * 64 + jc;
    const float* wi = F.in(I_LWI) + ((((size_t)l * 2 + dir) * 4 + k) * 64) * 64 + jc;
    float wrr[64], wii[64];
#pragma unroll
    for (int i = 0; i < 64; ++i) { wrr[i] = wr[i * 64]; wii[i] = wi[i * 64]; }
    const float br = F.in(I_LBR)[(l * 2 + dir) * 256 + c], bi = F.in(I_LBI)[(l * 2 + dir) * 256 + c];
    const float lam = F.in(I_LAM)[(l * 2 + dir) * 256 + c];
    const float sp = log1pf(expf(-lam));
    float h = 0.f;
    for (int s = 0; s < TPB; ++s) {
        const int j = dir == 0 ? s : (s < CTXL ? CTXL - 1 - s : TPB + CTXL - 1 - s);
        const size_t row = (size_t)b * TPB + j;
        const float* ub = U + row * 256 + k * 64;
        float rp = br, ip = bi;
#pragma unroll
        for (int i = 0; i < 64; ++i) { const float uv = ub[i]; rp += uv * wrr[i]; ip += uv * wii[i]; }
        const float r = 1.0f / (1.0f + expf(-rp)), ig = 1.0f / (1.0f + expf(-ip));
        const float la = -8.0f * r * sp; const float a = expf(la);
        const float bx = sqrtf(-expm1f(2.0f * la)) * (ig * ub[jc]);
        h = a * h + bx;
        if (dir == 0) HF[row * 256 + c] = h;
        else { bf16* y = Y + row * 1024 + 768 + c; *y = (bf16)f2bf((HF[row * 256 + c] + h) * bf2f(*y)); }
    }
    }
}
__device__ __forceinline__ void ph_mixsum_ctx(Frame& F) {
    const bf16* S = (const bf16*)(F.ws + WS_S); bf16* MIX = (bf16*)(F.ws + WS_H);
    const int gt = F.vcu * NTHREADS + F.tid, ngt = F.G * NTHREADS;
    for (int idx = gt; idx < NB * CTXL * 128; idx += ngt) {
        const int r = idx >> 7, c8 = (idx & 127) * 8; const size_t row = (size_t)(r >> 8) * TPB + (r & 255); float s[8] = {0.f, 0.f, 0.f, 0.f, 0.f, 0.f, 0.f, 0.f};
#pragma unroll
        for (int k = 0; k < 4; ++k) { const v4u w = *(const GAS v4u*)(S + row * 4096 + k * 1024 + c8);
            s[0] += bflo(w.x); s[1] += bfhi(w.x); s[2] += bflo(w.y); s[3] += bfhi(w.y); s[4] += bflo(w.z); s[5] += bfhi(w.z); s[6] += bflo(w.w); s[7] += bfhi(w.w); }
        v4u o; o.x = pk2(s[0], s[1]); o.y = pk2(s[2], s[3]); o.z = pk2(s[4], s[5]); o.w = pk2(s[6], s[7]);
        *(GAS v4u*)(MIX + row * 1024 + c8) = o;
    }
}
namespace att {
typedef short bf16x8 __attribute__((ext_vector_type(8)));
typedef short s16x4 __attribute__((ext_vector_type(4)));
typedef short v4i16_t __attribute__((ext_vector_type(4)));
typedef float f32x16 __attribute__((ext_vector_type(16)));
typedef unsigned u32x4 __attribute__((ext_vector_type(4)));
typedef __attribute__((address_space(3))) const char* lds_cptr;
typedef float f32x2_t __attribute__((ext_vector_type(2))); typedef __bf16 bf16x2_t __attribute__((ext_vector_type(2)));
__device__ __forceinline__ int crow(int r, int hi) { return (r & 3) + 8 * (r >> 2) + 4 * hi; }
__device__ __forceinline__ void glds16(const void* gsrc, unsigned lds_dst) { unsigned keep;
    asm volatile("s_mov_b32 %0, m0\n\ts_mov_b32 m0, %2\n\ts_nop 0\n\tglobal_load_lds_dwordx4 %1, off\n\ts_mov_b32 m0, %0" : "=&s"(keep) : "v"(gsrc), "s"(lds_dst) : "memory"); }
__device__ __forceinline__ unsigned cvtpk(float lo, float hi) { f32x2_t v = {lo, hi}; bf16x2_t b = __builtin_convertvector(v, bf16x2_t); return __builtin_bit_cast(unsigned, b); }
__device__ __forceinline__ s16x4 vtr(lds_cptr p) { return __builtin_bit_cast(s16x4, __builtin_amdgcn_ds_read_tr16_b64_v4i16((__attribute__((address_space(3))) v4i16_t*)p)); }
__device__ __forceinline__ float halfswap_max(float m) { auto rr = __builtin_amdgcn_permlane32_swap(__float_as_uint(m), __float_as_uint(m), false, false); return fmaxf(__uint_as_float(rr[0]), __uint_as_float(rr[1])); }
__device__ __forceinline__ float halfswap_sum(float m) { auto rr = __builtin_amdgcn_permlane32_swap(__float_as_uint(m), __float_as_uint(m), false, false); return __uint_as_float(rr[0]) + __uint_as_float(rr[1]); }

template <int DQK> struct Cfg {
    static constexpr int KCH = DQK / 8, KSLOT = KCH * 1024, NKI = (KCH + 7) / 8, NI = NKI + 1;
    static constexpr int LDS_K = 0, LDS_V = 3 * KSLOT, LDS_WS = LDS_V + 3 * 8192, LDS_OST = LDS_WS + 8 * 256, BYTES = LDS_OST + 8 * 4096;
};
#define ATT_WAIT_BAR(N) asm volatile("s_waitcnt vmcnt(" #N ") lgkmcnt(0)\n\ts_barrier" ::: "memory")

struct UnitDesc {
    const unsigned short* Q; int qp;
    const unsigned short* K; int kp;
    const unsigned short* V; int vp;
    unsigned short* Y;
    int NT;
    int lat_row0;
    int qpos0, spos0;
    int has_sink; float sink2;
};

template <int DQK, bool SWA>
__device__ __forceinline__ void attn_unit(LAS unsigned char* ldsb, const UnitDesc& U, const int tid) {
    using C = Cfg<DQK>;
    const int lane = tid & 63, r32 = lane & 31, hi = lane >> 5; const int wid = __builtin_amdgcn_readfirstlane(tid >> 6);
    const unsigned lds0 = (unsigned)(uintptr_t)ldsb;
    LAS float* wsf = (LAS float*)(ldsb + C::LDS_WS) + wid * 64;
    const int kp = U.kp, vp = U.vp;
    const int kc1 = (C::NKI == 2 && wid < 4) ? wid + 8 : wid;
    const unsigned short* ksrc0 = U.K + (size_t)lane * kp + wid * 8;
    const unsigned short* ksrc1 = U.K + (size_t)lane * kp + kc1 * 8;
    const unsigned short* vsrc = U.V + (size_t)(16 * (wid & 3) + (lane >> 2)) * vp + (wid >> 2) * 32 + (lane & 3) * 8;
    const unsigned kdst0 = lds0 + C::LDS_K + wid * 1024, kdst1 = lds0 + C::LDS_K + kc1 * 1024, vdst = lds0 + C::LDS_V + wid * 1024;
    const int NT = U.NT;
#define ATT_KROW(t) (SWA ? ((t) < 4 ? 64 * (t) : U.lat_row0 + 64 * ((t) - 4)) : 64 * (t))
#define ATT_DMA_K(t, slot) do { const size_t ro_ = (size_t)ATT_KROW(t); \
        glds16(ksrc0 + ro_ * kp, (unsigned)__builtin_amdgcn_readfirstlane(kdst0 + (slot) * C::KSLOT)); \
        if (C::NKI == 2) glds16(ksrc1 + ro_ * kp, (unsigned)__builtin_amdgcn_readfirstlane(kdst1 + (slot) * C::KSLOT)); } while (0)
#define ATT_DMA_V(t, slot) do { const size_t ro_ = (size_t)ATT_KROW(t); glds16(vsrc + ro_ * vp, (unsigned)__builtin_amdgcn_readfirstlane(vdst + (slot) * 8192)); } while (0)
#define ATT_KLOAD(kslot) do { if (!SWA) { const lds_cptr kb_ = (lds_cptr)(ldsb + C::LDS_K) + (kslot) * C::KSLOT + hi * 1024 + r32 * 16; \
        _Pragma("unroll") for (int d0 = 0; d0 < DQK / 16; ++d0) { kf[2 * d0] = *(const __attribute__((address_space(3))) bf16x8*)(kb_ + d0 * 2048); kf[2 * d0 + 1] = *(const __attribute__((address_space(3))) bf16x8*)(kb_ + d0 * 2048 + 512); } } } while (0)
#define ATT_QKM(P0, P1, CINIT, kslot) do { P0 = f32x16{}; P1 = f32x16{}; \
        const lds_cptr kq_ = (lds_cptr)(ldsb + C::LDS_K) + (kslot) * C::KSLOT + hi * 1024 + r32 * 16; \
        _Pragma("unroll") for (int d0 = 0; d0 < DQK / 16; ++d0) { \
            const bf16x8 b0_ = SWA ? *(const __attribute__((address_space(3))) bf16x8*)(kq_ + d0 * 2048) : kf[2 * d0]; const bf16x8 b1_ = SWA ? *(const __attribute__((address_space(3))) bf16x8*)(kq_ + d0 * 2048 + 512) : kf[2 * d0 + 1]; \
            P0 = __builtin_amdgcn_mfma_f32_32x32x16_bf16(b0_, qr[d0], P0, 0, 0, 0); P1 = __builtin_amdgcn_mfma_f32_32x32x16_bf16(b1_, qr[d0], P1, 0, 0, 0); } } while (0)
#define ATT_VLOAD(vslot) do { if (!SWA) { const lds_cptr vb_ = (lds_cptr)(ldsb + C::LDS_V) + (vslot) * 8192 + ((lane >> 4) & 1) * 32 + (lane & 3) * 8 + (4 * hi + ((lane & 15) >> 2)) * 64; \
        _Pragma("unroll") for (int i = 0; i < 8; ++i) { vl[i] = vtr(vb_ + (i >> 2) * 4096 + (i & 3) * 1024); vh[i] = vtr(vb_ + (i >> 2) * 4096 + (i & 3) * 1024 + 512); } } } while (0)
#define ATT_MX3(a, b, c) __builtin_fmaxf(__builtin_fmaxf((a), (b)), (c))
#define ATT_NEEDMASK(j) ((j) >= 4 && U.qpos0 >= 0 && !((U.spos0 + 64 * ((j) - 4) + 63 - (U.qpos0 + 32 * wid) <= 128) && ((U.qpos0 + 32 * wid + 31) - (U.spos0 + 64 * ((j) - 4)) <= 128)))
#define ATT_SMPV(P0, P1, N0, N1, HASNEXT, t, vslot) do { \
        if (SWA && ATT_NEEDMASK(t)) { const bool mk_ = true; const int sb_ = U.spos0 + 64 * ((t) - 4) + 4 * hi;        \
            _Pragma("unroll") for (int r = 0; r < 16; ++r) { const int dd_ = qpos - (sb_ + (r & 3) + 8 * (r >> 2)); \
                P0[r] = (mk_ && (dd_ > 128 || dd_ < -128)) ? -INFINITY : P0[r]; P1[r] = (mk_ && (dd_ - 32 > 128 || dd_ - 32 < -128)) ? -INFINITY : P1[r]; } } \
        float ls_ = 0.f; \
        _Pragma("unroll") for (int r = 0; r < 16; ++r) { P0[r] = __builtin_amdgcn_exp2f(P0[r]); P1[r] = __builtin_amdgcn_exp2f(P1[r]); ls_ += P0[r] + P1[r]; } \
        l += ls_; \
        if (!SWA && DQK != 64) { __builtin_amdgcn_sched_barrier(0); ATT_VLOAD(vslot); } \
        u32x4 pw_[4]; \
        pw_[0] = (u32x4){cvtpk(P0[0], P0[1]), cvtpk(P0[2], P0[3]), cvtpk(P0[4], P0[5]), cvtpk(P0[6], P0[7])}; \
        pw_[1] = (u32x4){cvtpk(P0[8], P0[9]), cvtpk(P0[10], P0[11]), cvtpk(P0[12], P0[13]), cvtpk(P0[14], P0[15])}; \
        pw_[2] = (u32x4){cvtpk(P1[0], P1[1]), cvtpk(P1[2], P1[3]), cvtpk(P1[4], P1[5]), cvtpk(P1[6], P1[7])}; \
        pw_[3] = (u32x4){cvtpk(P1[8], P1[9]), cvtpk(P1[10], P1[11]), cvtpk(P1[12], P1[13]), cvtpk(P1[14], P1[15])}; \
        const lds_cptr vq_ = (lds_cptr)(ldsb + C::LDS_V) + (vslot) * 8192 + ((lane >> 4) & 1) * 32 + (lane & 3) * 8 + (4 * hi + ((lane & 15) >> 2)) * 64; \
        _Pragma("unroll") for (int d0 = 0; d0 < 2; ++d0) \
            _Pragma("unroll") for (int ks = 0; ks < 4; ++ks) { \
                const s16x4 lo_ = SWA ? vtr(vq_ + d0 * 4096 + ks * 1024) : vl[4 * d0 + ks], hh_ = SWA ? vtr(vq_ + d0 * 4096 + ks * 1024 + 512) : vh[4 * d0 + ks]; \
                const bf16x8 vf_ = (bf16x8){lo_[0], lo_[1], lo_[2], lo_[3], hh_[0], hh_[1], hh_[2], hh_[3]}; \
                o[d0] = __builtin_amdgcn_mfma_f32_32x32x16_bf16(__builtin_bit_cast(bf16x8, pw_[ks]), vf_, o[d0], 0, 0, 0); } } while (0)
#define ATT_SKIP(j) (SWA && (j) >= 4 && U.qpos0 >= 0 && ((U.spos0 + 64 * ((j) - 4) > U.qpos0 + 32 * wid + 31 + 128) || (U.spos0 + 64 * ((j) - 4) + 63 < U.qpos0 + 32 * wid - 128)))
#define ATT_STEP(C0, C1, N0, N1, t) do { \
        const int k3_ = (ks1 == 0) ? 2 : ks1 - 1, v2_ = (vs0 == 0) ? 2 : vs0 - 1; \
        if ((t) + 3 < NT) ATT_DMA_K((t) + 3, k3_); \
        if ((t) + 2 < NT) ATT_DMA_V((t) + 2, v2_); \
        ATT_KLOAD(ks1); \
        if (!SWA) __builtin_amdgcn_sched_barrier(0);        \
        if (!SWA || !ATT_SKIP((t) + 1)) ATT_QKM(N0, N1, -m, ks1); \
        if (DQK == 64) ATT_VLOAD(vs0);        \
        if (!SWA) __builtin_amdgcn_sched_barrier(0); \
        if (!SWA || !ATT_SKIP(t)) ATT_SMPV(C0, C1, N0, N1, true, t, vs0); \
        if ((t) + 3 < NT) { if (C::NI == 2) ATT_WAIT_BAR(2); else ATT_WAIT_BAR(3); } else ATT_WAIT_BAR(0); \
        ks1 = (ks1 == 2) ? 0 : ks1 + 1; vs0 = (vs0 == 2) ? 0 : vs0 + 1; } while (0)
    ATT_DMA_K(0, 0);
    ATT_DMA_K(1, 1); ATT_DMA_V(0, 0);
    ATT_DMA_K(2, 2); ATT_DMA_V(1, 1);
    bf16x8 qr[DQK / 16];
    { const unsigned short* qw = U.Q + (size_t)(wid * 32 + r32) * U.qp + hi * 8;
#pragma unroll
      for (int d0 = 0; d0 < DQK / 16; ++d0) qr[d0] = *(const bf16x8*)(qw + d0 * 16); }
    const float m = 0.f; float l = 0.f;
    f32x16 o[2]; o[0] = f32x16{}; o[1] = f32x16{};
    const int qpos = U.qpos0 + wid * 32 + r32;
    f32x16 pa0, pa1, pb0, pb1;
    bf16x8 kf[DQK / 8]; s16x4 vl[8], vh[8];
    if (C::NI == 2) ATT_WAIT_BAR(4); else ATT_WAIT_BAR(6);
    ATT_KLOAD(0); ATT_QKM(pa0, pa1, 0.f, 0);
    if (C::NI == 2) ATT_WAIT_BAR(2); else ATT_WAIT_BAR(3);
    int ks1 = 1, vs0 = 0;
    int t = 0;
    if (SWA) { for (; t + 1 < NT; ++t) { ATT_STEP(pa0, pa1, pb0, pb1, t); pa0 = pb0; pa1 = pb1; } if (!ATT_SKIP(NT - 1)) ATT_SMPV(pa0, pa1, pa0, pa1, false, NT - 1, vs0); }
    else {
    for (; t + 2 < NT; t += 2) { ATT_STEP(pa0, pa1, pb0, pb1, t); ATT_STEP(pb0, pb1, pa0, pa1, t + 1); }
    if (t + 1 < NT) { ATT_STEP(pa0, pa1, pb0, pb1, t); if (DQK == 64) ATT_VLOAD(vs0); ATT_SMPV(pb0, pb1, pb0, pb1, false, NT - 1, vs0); }
    else { if (DQK == 64) ATT_VLOAD(vs0); ATT_SMPV(pa0, pa1, pa0, pa1, false, NT - 1, vs0); }
    }
    l = halfswap_sum(l);
    if (U.has_sink) l += __builtin_amdgcn_exp2f(U.sink2 - m);
    if (hi == 0) wsf[32 + r32] = l;
    asm volatile("s_waitcnt lgkmcnt(0)" ::: "memory");
    { LAS unsigned short* stg = (LAS unsigned short*)(ldsb + C::LDS_OST) + wid * 2048;
#pragma unroll
      for (int r = 0; r < 16; ++r) { const int orow = crow(r, hi); const float rl = __builtin_amdgcn_rcpf(wsf[32 + orow]);
          stg[orow * 64 + r32] = (unsigned short)f2bf(o[0][r] * rl); stg[orow * 64 + 32 + r32] = (unsigned short)f2bf(o[1][r] * rl); }
      asm volatile("s_waitcnt lgkmcnt(0)" ::: "memory");
      unsigned short* yw = U.Y + (size_t)(wid * 32) * 1024;
#pragma unroll
      for (int i = 0; i < 4; ++i) { const int row = i * 8 + (lane >> 3), ch = lane & 7;
          const u32x4 ov = *(const LAS u32x4*)(stg + row * 64 + ch * 8);
          u32x4* gp = (u32x4*)(yw + (size_t)row * 1024 + ch * 8); const u32x4 g = *gp;
          u32x4 w; w.x = pk2(bflo(ov.x) * bflo(g.x), bfhi(ov.x) * bfhi(g.x)); w.y = pk2(bflo(ov.y) * bflo(g.y), bfhi(ov.y) * bfhi(g.y));
          w.z = pk2(bflo(ov.z) * bflo(g.z), bfhi(ov.z) * bfhi(g.z)); w.w = pk2(bflo(ov.w) * bflo(g.w), bfhi(ov.w) * bfhi(g.w));
          *gp = w; } }
    asm volatile("s_waitcnt vmcnt(0) lgkmcnt(0)\n\ts_barrier" ::: "memory");
#undef ATT_KROW
#undef ATT_DMA_K
#undef ATT_DMA_V
#undef ATT_KLOAD
#undef ATT_QKM
#undef ATT_VLOAD
#undef ATT_STEP
#undef ATT_SKIP
#undef ATT_SMPV
#undef ATT_MX3
#undef ATT_NEEDMASK
}

template <int DQK>
__device__ __forceinline__ void attn_unit_d(LAS unsigned char* ldsb, const UnitDesc& U, const int tid) {
    using C = Cfg<DQK>;
    constexpr int KP = (DQK == 64) ? 128 : 256, KSL = 64 * KP, SPR = KP / 16, RPP = 1024 / KP, NKI = KSL / 8192;
    static_assert(NKI == C::NKI, "K DMA count");
    constexpr int LDS_WS = 0, LDS_K = 2048, LDS_V = LDS_K + 3 * KSL, LDS_END = LDS_V + 3 * 8192, LDS_X = 2048, LDS_STG = LDS_X + 65536;
    static_assert(LDS_END <= RING_BYTES && LDS_STG + 8 * 4096 <= RING_BYTES, "attention LDS");
    const int lane = tid & 63, r32 = lane & 31, hi = lane >> 5; const int wid = __builtin_amdgcn_readfirstlane(tid >> 6); const int rg = wid & 3, kh = wid >> 2;
    const unsigned lds0 = (unsigned)(uintptr_t)ldsb;
    const int kp = U.kp, vp = U.vp;
    const unsigned short* ksrc0; const unsigned short* ksrc1;
    { const int ra = wid * RPP + lane / SPR, sa = lane % SPR, fa = (KP == 128) ? ((ra >> 1) & 7) : (ra & 15); int ca = sa ^ fa; if (ca >= DQK / 8) ca = 0;
      ksrc0 = U.K + (size_t)ra * kp + ca * 8;
      const int rb = (wid + 8) * RPP + lane / SPR, fb = (KP == 128) ? ((rb >> 1) & 7) : (rb & 15); int cb = sa ^ fb; if (cb >= DQK / 8) cb = 0;
      ksrc1 = U.K + (size_t)(NKI == 2 ? rb : ra) * kp + (NKI == 2 ? cb : ca) * 8; }
    const unsigned short* vsrc = U.V + (size_t)(16 * (wid & 3) + (lane >> 2)) * vp + (wid >> 2) * 32 + (lane & 3) * 8;
    const unsigned kdst0 = lds0 + LDS_K + wid * 1024, kdst1 = lds0 + LDS_K + (wid + 8) * 1024, vdst = lds0 + LDS_V + wid * 1024;
    const int NT = U.NT;
#define ATD_DMA(t, slot) do { const size_t ro_ = (size_t)64 * (t); \
        glds16(ksrc0 + ro_ * kp, (unsigned)__builtin_amdgcn_readfirstlane(kdst0 + (slot) * KSL)); \
        if (NKI == 2) glds16(ksrc1 + ro_ * kp, (unsigned)__builtin_amdgcn_readfirstlane(kdst1 + (slot) * KSL)); \
        glds16(vsrc + ro_ * vp, (unsigned)__builtin_amdgcn_readfirstlane(vdst + (slot) * 8192)); } while (0)
    ATD_DMA(0, 0); ATD_DMA(1, 1);
    bf16x8 qr[2][DQK / 16];
    { const unsigned short* qw = U.Q + (size_t)(rg * 64 + r32) * U.qp + hi * 8;
#pragma unroll
      for (int qb = 0; qb < 2; ++qb)
#pragma unroll
          for (int d0 = 0; d0 < DQK / 16; ++d0) qr[qb][d0] = *(const bf16x8*)(qw + (size_t)(qb * 32) * U.qp + d0 * 16); }
    f32x16 o[2][2]; o[0][0] = f32x16{}; o[0][1] = f32x16{}; o[1][0] = f32x16{}; o[1][1] = f32x16{};
    float l0 = 0.f, l1 = 0.f, l0b = 0.f, l1b = 0.f; u32x4 pp[4]; pp[0] = pp[1] = pp[2] = pp[3] = (u32x4){0u, 0u, 0u, 0u};
    if (C::NI == 2) ATT_WAIT_BAR(2); else ATT_WAIT_BAR(3);
#pragma unroll
    for (int qb = 0; qb < 2; ++qb)
#pragma unroll
        for (int d0 = 0; d0 < DQK / 16; ++d0) asm volatile("" : "+v"(qr[qb][d0]));
    const int krow = 32 * kh + r32, kfx = ((KP == 128) ? ((krow >> 1) & 7) : (krow & 15)) ^ hi;
    const unsigned kb0 = (unsigned)(uintptr_t)(ldsb + LDS_K) + krow * KP + kfx * 16;
    const lds_cptr vbase = (lds_cptr)(ldsb + LDS_V) + kh * 2048 + ((lane >> 4) & 1) * 32 + (lane & 3) * 8 + (4 * hi + ((lane & 15) >> 2)) * 64;
#define ATD_DOT(acc, w) acc = __builtin_amdgcn_fdot2_f32_bf16(__builtin_bit_cast(bf16x2_t, (w)), __builtin_bit_cast(bf16x2_t, 0x3f803f80u), acc, false)
#define ATD_SUM4(LA, LB, W) do { ATD_DOT(LA, W.x); ATD_DOT(LB, W.y); ATD_DOT(LA, W.z); ATD_DOT(LB, W.w); } while (0)
#define ATD_SMPV(S, PW0, PW1, OA, OB) do { \
        _Pragma("unroll") for (int r = 0; r < 16; ++r) S[r] = __builtin_amdgcn_exp2f(S[r]); \
        PW0 = (u32x4){cvtpk(S[0], S[1]), cvtpk(S[2], S[3]), cvtpk(S[4], S[5]), cvtpk(S[6], S[7])}; \
        PW1 = (u32x4){cvtpk(S[8], S[9]), cvtpk(S[10], S[11]), cvtpk(S[12], S[13]), cvtpk(S[14], S[15])}; \
        OA = __builtin_amdgcn_mfma_f32_32x32x16_bf16(__builtin_bit_cast(bf16x8, PW0), vf[0][0], OA, 0, 0, 0); OB = __builtin_amdgcn_mfma_f32_32x32x16_bf16(__builtin_bit_cast(bf16x8, PW0), vf[1][0], OB, 0, 0, 0); \
        OA = __builtin_amdgcn_mfma_f32_32x32x16_bf16(__builtin_bit_cast(bf16x8, PW1), vf[0][1], OA, 0, 0, 0); OB = __builtin_amdgcn_mfma_f32_32x32x16_bf16(__builtin_bit_cast(bf16x8, PW1), vf[1][1], OB, 0, 0, 0); } while (0)
    int s = 0;
#pragma unroll 1
    for (int t = 0; t < NT; ++t) {
        const int s2 = (s == 0) ? 2 : s - 1;
        if (t + 2 < NT) ATD_DMA(t + 2, s2);
        bf16x8 kf[DQK / 16], vf[2][2];
        {
#pragma unroll
          for (int d0 = 0; d0 < DQK / 16; ++d0) kf[d0] = *(const __attribute__((address_space(3))) bf16x8*)(uintptr_t)((kb0 ^ (unsigned)(32 * d0)) + (unsigned)(s * KSL)); }
        { const lds_cptr vb_ = vbase + s * 8192;
#pragma unroll
          for (int d0 = 0; d0 < 2; ++d0)
#pragma unroll
              for (int ks = 0; ks < 2; ++ks) { const s16x4 lo_ = vtr(vb_ + d0 * 4096 + ks * 1024), hh_ = vtr(vb_ + d0 * 4096 + ks * 1024 + 512);
                  vf[d0][ks] = (bf16x8){lo_[0], lo_[1], lo_[2], lo_[3], hh_[0], hh_[1], hh_[2], hh_[3]}; } }
        f32x16 S0 = f32x16{}, S1 = f32x16{};
#pragma unroll
        for (int d0 = 0; d0 < DQK / 16; ++d0) S0 = __builtin_amdgcn_mfma_f32_32x32x16_bf16(kf[d0], qr[0][d0], S0, 0, 0, 0);
#pragma unroll
        for (int d0 = 0; d0 < DQK / 16; ++d0) S1 = __builtin_amdgcn_mfma_f32_32x32x16_bf16(kf[d0], qr[1][d0], S1, 0, 0, 0);
        ATD_SUM4(l0, l0b, pp[0]); ATD_SUM4(l0, l0b, pp[1]); ATD_SUM4(l1, l1b, pp[2]); ATD_SUM4(l1, l1b, pp[3]);
        __builtin_amdgcn_sched_barrier(0);
        ATD_SMPV(S0, pp[0], pp[1], o[0][0], o[0][1]);
        ATD_SMPV(S1, pp[2], pp[3], o[1][0], o[1][1]);
        if (t + 2 < NT) { if (C::NI == 2) ATT_WAIT_BAR(2); else ATT_WAIT_BAR(3); } else ATT_WAIT_BAR(0);
        s = (s == 2) ? 0 : s + 1;
    }
    LAS float* wl = (LAS float*)(ldsb + LDS_WS);
    LAS float* X = (LAS float*)(ldsb + LDS_X);
    ATD_SUM4(l0, l0b, pp[0]); ATD_SUM4(l0, l0b, pp[1]); ATD_SUM4(l1, l1b, pp[2]); ATD_SUM4(l1, l1b, pp[3]); l0 += l0b; l1 += l1b;
    const float lkeep = halfswap_sum(kh ? l1 : l0), lsend = halfswap_sum(kh ? l0 : l1);
    f32x16 ok0 = kh ? o[1][0] : o[0][0], ok1 = kh ? o[1][1] : o[0][1]; const f32x16 os0 = kh ? o[0][0] : o[1][0], os1 = kh ? o[0][1] : o[1][1];
    { LAS float* xs = X + wid * 2048 + lane;
#pragma unroll
      for (int r = 0; r < 16; ++r) { xs[r * 64] = os0[r]; xs[(16 + r) * 64] = os1[r]; }
      if (hi == 0) wl[wid * 64 + r32] = lsend; }
    asm volatile("s_waitcnt lgkmcnt(0)\n\ts_barrier" ::: "memory");
    { const LAS float* xr = X + (wid ^ 4) * 2048 + lane;
#pragma unroll
      for (int r = 0; r < 16; ++r) { ok0[r] += xr[r * 64]; ok1[r] += xr[(16 + r) * 64]; }
      const float lt = lkeep + wl[(wid ^ 4) * 64 + r32];
      if (hi == 0) wl[wid * 64 + 32 + r32] = lt; }
    asm volatile("s_waitcnt lgkmcnt(0)" ::: "memory");
    { LAS unsigned short* stg = (LAS unsigned short*)(ldsb + LDS_STG) + wid * 2048;
      const LAS float* lt = wl + wid * 64 + 32;
#pragma unroll
      for (int r = 0; r < 16; ++r) { const int orow = crow(r, hi); const float rl = __builtin_amdgcn_rcpf(lt[orow]);
          stg[orow * 64 + r32] = (unsigned short)f2bf(ok0[r] * rl); stg[orow * 64 + 32 + r32] = (unsigned short)f2bf(ok1[r] * rl); }
      asm volatile("s_waitcnt lgkmcnt(0)" ::: "memory");
      unsigned short* yw = U.Y + (size_t)(rg * 64 + kh * 32) * 1024;
#pragma unroll
      for (int i = 0; i < 4; ++i) { const int row = i * 8 + (lane >> 3), ch = lane & 7;
          const u32x4 ov = *(const LAS u32x4*)(stg + row * 64 + ch * 8);
          u32x4* gp = (u32x4*)(yw + (size_t)row * 1024 + ch * 8); const u32x4 g = *gp;
          u32x4 w; w.x = pk2(bflo(ov.x) * bflo(g.x), bfhi(ov.x) * bfhi(g.x)); w.y = pk2(bflo(ov.y) * bflo(g.y), bfhi(ov.y) * bfhi(g.y));
          w.z = pk2(bflo(ov.z) * bflo(g.z), bfhi(ov.z) * bfhi(g.z)); w.w = pk2(bflo(ov.w) * bflo(g.w), bfhi(ov.w) * bfhi(g.w));
          *gp = w; } }
    asm volatile("s_waitcnt vmcnt(0) lgkmcnt(0)\n\ts_barrier" ::: "memory");
#undef ATD_DMA
#undef ATD_SMPV
#undef ATD_DOT
#undef ATD_SUM4
}
}

__device__ __forceinline__ void ph_attn(Frame& F, int l) {
    unsigned short* ZS = (unsigned short*)(F.ws + WS_ZS); unsigned short* MQ = (unsigned short*)(F.ws + WS_MQ); unsigned short* MKV = (unsigned short*)(F.ws + WS_MKV); unsigned short* MK = (unsigned short*)(F.ws + WS_MK);
    unsigned short* Y = (unsigned short*)(F.ws + WS_G);
    LAS unsigned char* lds = F.lds + RING_OFF;
    const int u = F.vcu;
    const bool ctxq = (l == 0);
    for (int uu = u; uu < 256; uu += F.G) { const int bh = uu >> 4, qb = uu & 15, b = bh >> 2, h = bh & 3; const size_t r0 = (size_t)b * TPB, rq = r0 + CTXL + qb * 256;
        att::UnitDesc U{MQ + rq * 512 + h * 96, 512, MK + r0 * 384 + h * 96, 384, MKV + r0 * 512 + h * 128 + 64, 512, Y + rq * 1024 + h * 64, TPB / 64, 0, -1, 0, 0, 0.f};
        { int tu_ = F.tid; asm volatile("" : "+v"(tu_)); att::attn_unit_d<96>(lds, U, tu_); } }
    for (int uu = u; uu < 256; uu += F.G) { const int qb = uu & 15, g = (uu >> 4) & 1, kvh = (uu >> 5) & 1, b = uu >> 6, qh = kvh * 2 + g; const size_t r0 = (size_t)b * TPB, rq = r0 + CTXL + qb * 256;
        att::UnitDesc U{ZS + rq * ZS_P + ZC_AQ + qh * 64, ZS_P, ZS + r0 * ZS_P + ZC_AK + kvh * 64, ZS_P, ZS + r0 * ZS_P + ZC_AV + kvh * 64, ZS_P, Y + rq * 1024 + 512 + qh * 64, TPB / 64, 0, -1, 0, 0, 0.f};
        { int tu_ = F.tid; asm volatile("" : "+v"(tu_)); att::attn_unit_d<64>(lds, U, tu_); } }
    for (int uu = u; uu < 256; uu += F.G) { const int qb = uu & 15, g = (uu >> 4) & 1, kvh = (uu >> 5) & 1, b = uu >> 6, qh = kvh * 2 + g; const size_t r0 = (size_t)b * TPB, rq = r0 + CTXL + qb * 256;
        const int q0 = qb * 256, s0 = (q0 - 128 < 0) ? 0 : q0 - 128, s1 = (q0 + 384 > SEQ) ? SEQ : q0 + 384;
        att::UnitDesc U{ZS + rq * ZS_P + ZC_SQ + qh * 64, ZS_P, ZS + r0 * ZS_P + ZC_SK + kvh * 64, ZS_P, ZS + r0 * ZS_P + ZC_SV + kvh * 64, ZS_P, Y + rq * 1024 + 256 + qh * 64, 4 + (s1 - s0) / 64, CTXL + s0, q0, s0, 1, F.in(I_SINK)[l * 4 + qh] * LOG2E};
        att::attn_unit<64, true>(lds, U, F.tid); }
    if (ctxq) for (int uu = u; uu < 48; uu += F.G) { const int br = uu >> 4, b = (uu >> 2) & 3, h = uu & 3; const size_t r0 = (size_t)b * TPB;
        if (br == 0) { att::UnitDesc U{MQ + r0 * 512 + h * 96, 512, MK + r0 * 384 + h * 96, 384, MKV + r0 * 512 + h * 128 + 64, 512, Y + r0 * 1024 + h * 64, 4, 0, -1, 0, 0, 0.f};
            { int tu_ = F.tid; asm volatile("" : "+v"(tu_)); att::attn_unit_d<96>(lds, U, tu_); } }
        else if (br == 1) { att::UnitDesc U{ZS + r0 * ZS_P + ZC_SQ + h * 64, ZS_P, ZS + r0 * ZS_P + ZC_SK + (h >> 1) * 64, ZS_P, ZS + r0 * ZS_P + ZC_SV + (h >> 1) * 64, ZS_P, Y + r0 * 1024 + 256 + h * 64, 4, CTXL, -1, 0, 1, F.in(I_SINK)[l * 4 + h] * LOG2E};
            att::attn_unit<64, true>(lds, U, F.tid); }
        else { att::UnitDesc U{ZS + r0 * ZS_P + ZC_AQ + h * 64, ZS_P, ZS + r0 * ZS_P + ZC_AK + (h >> 1) * 64, ZS_P, ZS + r0 * ZS_P + ZC_AV + (h >> 1) * 64, ZS_P, Y + r0 * 1024 + 512 + h * 64, 4, 0, -1, 0, 0, 0.f};
            { int tu_ = F.tid; asm volatile("" : "+v"(tu_)); att::attn_unit_d<64>(lds, U, tu_); } } }
}
constexpr size_t WS_SUM = 253 * MiB;
constexpr size_t WS_HL = WS_U, WS_CP = WS_HF;
constexpr int NCHUNK = TPB / 64;
__device__ __forceinline__ float swap_lo(float x) { auto rr = __builtin_amdgcn_permlane32_swap(__float_as_uint(x), __float_as_uint(x), false, false); return __uint_as_float(rr[0]); }
__device__ __forceinline__ float swap_hi(float x) { auto rr = __builtin_amdgcn_permlane32_swap(__float_as_uint(x), __float_as_uint(x), false, false); return __uint_as_float(rr[1]); }
__device__ __forceinline__ void ph_lru1(Frame& F, int l) {
    typedef short bf16x8 __attribute__((ext_vector_type(8))); typedef float f32x16 __attribute__((ext_vector_type(16)));
    const unsigned short* ZS = (const unsigned short*)(F.ws + WS_ZS); unsigned short* HL = (unsigned short*)(F.ws + WS_HL); unsigned short* CP = (unsigned short*)(F.ws + WS_CP);
    f32x2v* SUM = (f32x2v*)(F.ws + WS_SUM);
    constexpr int UP = 264;
    LAS unsigned short* ul = (LAS unsigned short*)(F.lds + RING_OFF);
    const float* cw = F.in(I_CONVW) + l * 4 * 256; const float* cb = F.in(I_CONVB) + l * 256;
    const int tid = F.tid, lane = tid & 63, r32 = lane & 31, hi = lane >> 5, k = F.wave & 3, d = F.wave >> 2;
    const int nfull = (NB * NCHUNK < F.G) ? NB * NCHUNK : F.G, nhalf = 2 * (NB * NCHUNK - nfull);
    for (int wi = F.vcu; wi < nfull + nhalf; wi += F.G) {
        const int unit = (wi < nfull) ? wi : nfull + ((wi - nfull) >> 1);
        const int tn_lo = (wi < nfull) ? 0 : ((wi - nfull) & 1), tn_hi = (wi < nfull) ? 2 : tn_lo + 1;
        const int b = unit / NCHUNK, ci = unit % NCHUNK;
        int s0row, len, t0; if (ci < 4) { s0row = b * TPB; len = CTXL; t0 = ci * 64; } else { s0row = b * TPB + CTXL; len = SEQ; t0 = (ci - 4) * 64; }
        { const int cc = tid & 255, hh = tid >> 8; float zv[35];
#pragma unroll
          for (int i = 0; i < 35; ++i) { const int tt = t0 + hh * 32 + i - 2; const int tc = tt < 0 ? 0 : (tt >= len ? len - 1 : tt);
              const float v = bf2f(ZS[(size_t)(s0row + tc) * ZS_P + ZC_LRU + cc]); zv[i] = (tt >= 0 && tt < len) ? v : 0.f; }
          const float w0 = cw[cc], w1 = cw[256 + cc], w2 = cw[512 + cc], w3 = cw[768 + cc], bb = cb[cc];
#pragma unroll
          for (int t = 0; t < 32; ++t) ul[(hh * 32 + t) * UP + cc] = (unsigned short)f2bf(bb + w0 * zv[t] + w1 * zv[t + 1] + w2 * zv[t + 2] + w3 * zv[t + 3]); }
        __syncthreads();
#pragma unroll 1
        for (int tn = tn_lo; tn < tn_hi; ++tn) {
            const int c = k * 64 + 32 * tn + r32;
            bf16x8 wf[2][4];
            const float brv = F.in(I_LBR)[(l * 2 + d) * 256 + c], biv = F.in(I_LBI)[(l * 2 + d) * 256 + c], spv = ((const float*)(F.ws + WS_SP))[(l * 2 + d) * 256 + c];
#pragma unroll
            for (int gate = 0; gate < 2; ++gate)
#pragma unroll
                for (int ks = 0; ks < 4; ++ks) { const float* src = (const float*)(F.ws + WS_LWT) + ((((size_t)l * 2 + d) * 2 + gate) * 256 + c) * 64 + 16 * ks + 8 * hi;
                    const f32x4 a = *(const f32x4*)src, b2 = *(const f32x4*)(src + 4);
                    v4u w; w.x = pk2(a.x, a.y); w.y = pk2(a.z, a.w); w.z = pk2(b2.x, b2.y); w.w = pk2(b2.z, b2.w); wf[gate][ks] = __builtin_bit_cast(bf16x8, w); }
            f32x16 A[2], X[2];
            A[0] = f32x16{}; A[1] = f32x16{}; X[0] = f32x16{}; X[1] = f32x16{};
#pragma unroll
            for (int tm = 0; tm < 2; ++tm)
#pragma unroll
                for (int ks = 0; ks < 4; ++ks) { const bf16x8 af = *(const LAS bf16x8*)(ul + (32 * tm + r32) * UP + k * 64 + 16 * ks + 8 * hi);
                    A[tm] = __builtin_amdgcn_mfma_f32_32x32x16_bf16(af, wf[0][ks], A[tm], 0, 0, 0); X[tm] = __builtin_amdgcn_mfma_f32_32x32x16_bf16(af, wf[1][ks], X[tm], 0, 0, 0); }
#pragma unroll
            for (int tm = 0; tm < 2; ++tm)
#pragma unroll
                for (int r = 0; r < 16; ++r) { const int tok = 32 * tm + (r & 3) + 8 * (r >> 2) + 4 * hi; const float uu = bf2f(ul[tok * UP + c]);
                    const float rr = sigmoid_f(A[tm][r] + brv), ii = sigmoid_f(X[tm][r] + biv);
                    const float a = __builtin_amdgcn_exp2f(-rr * spv); A[tm][r] = a; X[tm][r] = __builtin_amdgcn_sqrtf(1.0f - a * a) * (ii * uu);
                    if ((r & 3) == 3) asm volatile("" ::: "memory"); }
#pragma unroll
            for (int tm = 0; tm < 2; ++tm)
#pragma unroll
                for (int rg = 0; rg < 4; ++rg) { const int r0 = 4 * rg;
                    if (d == 0) {
#pragma unroll
                        for (int e2 = 1; e2 < 4; ++e2) { X[tm][r0 + e2] = A[tm][r0 + e2] * X[tm][r0 + e2 - 1] + X[tm][r0 + e2]; A[tm][r0 + e2] = A[tm][r0 + e2] * A[tm][r0 + e2 - 1]; } }
                    else {
#pragma unroll
                        for (int e2 = 2; e2 >= 0; --e2) { X[tm][r0 + e2] = A[tm][r0 + e2] * X[tm][r0 + e2 + 1] + X[tm][r0 + e2]; A[tm][r0 + e2] = A[tm][r0 + e2] * A[tm][r0 + e2 + 1]; } } }
            float enH[8], enP[8]; float EH = 0.f, EP = 1.f;
            if (d == 0) {
#pragma unroll
                for (int q = 0; q < 8; ++q) { const int tm = q >> 2, re = 4 * (q & 3) + 3; const float ce = A[tm][re], he = X[tm][re];
                    const float aH = swap_lo(ce * EH + he), aP = swap_lo(EP * ce);
                    const float E1H = hi ? aH : EH, E1P = hi ? aP : EP;
                    enH[q] = E1H; enP[q] = E1P;
                    EH = swap_hi(ce * E1H + he); EP = swap_hi(E1P * ce); }
            } else {
#pragma unroll
                for (int q = 7; q >= 0; --q) { const int tm = q >> 2, re = 4 * (q & 3); const float ce = A[tm][re], he = X[tm][re];
                    const float aH = swap_hi(ce * EH + he), aP = swap_hi(EP * ce);
                    const float E1H = hi ? EH : aH, E1P = hi ? EP : aP;
                    enH[q] = E1H; enP[q] = E1P;
                    EH = swap_lo(ce * E1H + he); EP = swap_lo(E1P * ce); }
            }
            { const unsigned ob = (unsigned)((((s0row + t0 + 4 * hi) * 2 + d) * 256 + c) * 2);
#pragma unroll
              for (int tm = 0; tm < 2; ++tm)
#pragma unroll
                for (int rg = 0; rg < 4; ++rg) { const int q = 4 * tm + rg;
#pragma unroll
                    for (int e2 = 0; e2 < 4; ++e2) { const int r = 4 * rg + e2; const unsigned o = ob + (unsigned)(32 * tm + 8 * rg + e2) * 1024u;
                        *(unsigned short*)((char*)HL + o) = (unsigned short)f2bf(X[tm][r] + A[tm][r] * enH[q]); *(unsigned short*)((char*)CP + o) = (unsigned short)f2bf(A[tm][r] * enP[q]); }
                    asm volatile("" ::: "memory"); } }
            if (hi == 0) SUM[((size_t)(b * NCHUNK + ci) * 2 + d) * 256 + c] = (f32x2v){EP, EH};
        }
        __syncthreads();
    }
}
constexpr size_t WS_CARRY = 255 * MiB;
__device__ __forceinline__ void ph_lru_carry(Frame& F) {
    if (F.vcu < 4) {
        const int g = F.vcu * NTHREADS + F.tid, b = g >> 9, d = (g >> 8) & 1, c = g & 255;
        const f32x2v* sb = (const f32x2v*)(F.ws + WS_SUM) + ((size_t)b * NCHUNK * 2 + d) * 256 + c;
        float* cr = (float*)(F.ws + WS_CARRY) + ((size_t)b * NCHUNK * 2 + d) * 256 + c;
        float h = 0.f;
#pragma unroll 1
        for (int p0 = 0; p0 < NCHUNK; p0 += 17) {
            f32x2v s[17];
#pragma unroll
            for (int i = 0; i < 17; ++i) { const int p = p0 + i, j = (d == 0) ? p : (p < 4 ? 3 - p : NCHUNK + 3 - p); s[i] = sb[(size_t)j * 512]; }
#pragma unroll
            for (int i = 0; i < 17; ++i) { const int p = p0 + i, j = (d == 0) ? p : (p < 4 ? 3 - p : NCHUNK + 3 - p); cr[(size_t)j * 512] = h; h = s[i].x * h + s[i].y; }
        }
    }
}
__device__ __forceinline__ void ph_lru2(Frame& F, int l) {
    const unsigned short* HL = (const unsigned short*)(F.ws + WS_HL); const unsigned short* CP = (const unsigned short*)(F.ws + WS_CP);
    const float* CARRY = (const float*)(F.ws + WS_CARRY); unsigned short* Y = (unsigned short*)(F.ws + WS_G);
    const int tid = F.tid, cg = tid & 31, tq = tid >> 5; const bool last = (l == NLAYER - 1);
    for (int unit = F.vcu; unit < NB * NCHUNK; unit += F.G) {
        const int b = unit / NCHUNK, ci = unit % NCHUNK;
        if (last && ci < 4) continue;
        const float* cp0 = CARRY + ((size_t)(b * NCHUNK + ci) * 2) * 256 + cg * 8;
        const f32x4 cfa = *(const f32x4*)cp0, cfb = *(const f32x4*)(cp0 + 4), cba = *(const f32x4*)(cp0 + 256), cbb = *(const f32x4*)(cp0 + 260);
        const float cf[8] = {cfa.x, cfa.y, cfa.z, cfa.w, cfb.x, cfb.y, cfb.z, cfb.w}, cbk[8] = {cba.x, cba.y, cba.z, cba.w, cbb.x, cbb.y, cbb.z, cbb.w};
        v4u hf[4], pf[4], hb[4], pb[4], gg[4];
#pragma unroll
        for (int i = 0; i < 4; ++i) { const size_t row = (size_t)b * TPB + ci * 64 + tq + 16 * i; const size_t o = (row * 2) * 256 + cg * 8;
            hf[i] = *(const v4u*)(HL + o); pf[i] = *(const v4u*)(CP + o); hb[i] = *(const v4u*)(HL + o + 256); pb[i] = *(const v4u*)(CP + o + 256); gg[i] = *(const v4u*)(Y + row * 1024 + 768 + cg * 8); }
#pragma unroll
        for (int i = 0; i < 4; ++i) { const size_t row = (size_t)b * TPB + ci * 64 + tq + 16 * i;
            unsigned w[4];
#pragma unroll
            for (int e = 0; e < 4; ++e) { const unsigned a = hf[i][e], p = pf[i][e], a2 = hb[i][e], p2 = pb[i][e], g = gg[i][e];
                const float v0 = (bflo(a) + bflo(p) * cf[2 * e] + bflo(a2) + bflo(p2) * cbk[2 * e]) * bflo(g);
                const float v1 = (bfhi(a) + bfhi(p) * cf[2 * e + 1] + bfhi(a2) + bfhi(p2) * cbk[2 * e + 1]) * bfhi(g);
                w[e] = pk2(v0, v1); }
            *(v4u*)(Y + row * 1024 + 768 + cg * 8) = (v4u){w[0], w[1], w[2], w[3]}; }
    }
}
#ifndef PGX_DMA
#define PGX_DMA 1
#endif
namespace pgx {
typedef short bf16x8 __attribute__((ext_vector_type(8)));
typedef float f32x4 __attribute__((ext_vector_type(4)));
typedef unsigned u32x4 __attribute__((ext_vector_type(4)));
typedef unsigned u32x2 __attribute__((ext_vector_type(2)));
constexpr int OPB = 16384;
template <int VAR> __device__ __forceinline__ void pgx_unit(LAS unsigned char* lds, const unsigned short* Y, const unsigned short* Wb, const unsigned short* S, unsigned short* MIX, int row0, int n0, int tid) {
    const int lane = tid & 63, wid = __builtin_amdgcn_readfirstlane(tid >> 6), wm = wid & 3, wn = wid >> 2, fr = lane & 15, fq = lane >> 4;
    const int sr0 = tid >> 3, sk = (tid & 7) * 8;
    const unsigned short* ysrc = Y + (size_t)(row0 + sr0) * 1024 + sk;
    const unsigned short* wsrc = Wb + (size_t)(n0 + sr0) * 256 + sk;
    const int ldst = (tid & 7) * 2048 + (sr0 & ~15) * 16 + (((sr0 & 15) ^ (tid & 7)) << 4);
    const int wrow = (sr0 & ~63) | (((sr0 >> 2) & 3) << 4) | (((sr0 >> 4) & 3) << 2) | (sr0 & 3);
    const int ldstw = (tid & 7) * 2048 + (wrow & ~15) * 16 + (((wrow & 15) ^ (tid & 7)) << 4);
    f32x4 acc[2][4], mix[2][4];
#pragma unroll
    for (int a = 0; a < 2; ++a)
#pragma unroll
        for (int b = 0; b < 4; ++b) { acc[a][b] = (f32x4){0.f, 0.f, 0.f, 0.f}; mix[a][b] = (f32x4){0.f, 0.f, 0.f, 0.f}; }
    u32x4 st[4][4];
    const unsigned short* yA = ysrc; const unsigned short* yB = ysrc + 64 * 1024;
    const unsigned short* wA = wsrc; const unsigned short* wB = wsrc + 64 * 256;
    const unsigned short* sp0 = S + (size_t)(row0 + 32 * wm + fr) * 4096 + n0 + 64 * wn + 16 * fq; const unsigned short* sp1 = sp0 + (size_t)16 * 4096;
#define PGX_LOADQ(set_, yo_, wp0_, wp1_, wo_) do { if (VAR == 2) { st[set_][0] = *(const u32x4*)(ysrc); st[set_][1] = *(const u32x4*)(ysrc + 64 * 1024); st[set_][2] = *(const u32x4*)(wsrc); st[set_][3] = *(const u32x4*)(wsrc + 64 * 256); } else if (VAR == 4) { st[set_][0] = st[set_][1] = st[set_][2] = st[set_][3] = (u32x4){1u,2u,3u,4u}; asm volatile("" : "+v"(st[set_][0]), "+v"(st[set_][1]), "+v"(st[set_][2]), "+v"(st[set_][3])); } else { st[set_][0] = *(const u32x4*)(yA + (yo_)); st[set_][1] = *(const u32x4*)(yB + (yo_)); st[set_][2] = *(const u32x4*)((wp0_) + (wo_)); st[set_][3] = *(const u32x4*)((wp1_) + (wo_)); } } while (0)
#define PGX_STORE(buf_, set_) do { LAS unsigned char* b_ = lds + (buf_) * 2 * OPB + ldst; \
        *(LAS u32x4*)b_ = st[set_][0]; *(LAS u32x4*)(b_ + 1024) = st[set_][1]; *(LAS u32x4*)(b_ - ldst + OPB + ldstw) = st[set_][2]; *(LAS u32x4*)(b_ - ldst + OPB + ldstw + 1024) = st[set_][3]; } while (0)
    u32x4 sga[2][2], sgb[2][2];
#define PGX_SLOAD(dst_, off_) do { if (VAR == 1 || VAR == 4) { dst_[0][0] = dst_[0][1] = dst_[1][0] = dst_[1][1] = (u32x4){0x3f803f80u, 0x3f803f80u, 0x3f803f80u, 0x3f803f80u}; } \
        else { dst_[0][0] = *(const u32x4*)(sp0 + (off_)); dst_[0][1] = *(const u32x4*)(sp0 + (off_) + 8); dst_[1][0] = *(const u32x4*)(sp1 + (off_)); dst_[1][1] = *(const u32x4*)(sp1 + (off_) + 8); } } while (0)
    PGX_SLOAD(sga, 0);
    PGX_LOADQ(0, 0, wA, wB, 0); PGX_LOADQ(1, 64, wA, wB, 64); PGX_LOADQ(2, 128, wA, wB, 128);
    PGX_STORE(0, 0);
    __syncthreads();
#define PGX_COMPUTE(h_) do { const LAS unsigned char* yb = lds + ((h_) & 1) * 2 * OPB + 32 * wm * 16; const LAS unsigned char* wb = lds + ((h_) & 1) * 2 * OPB + OPB + 64 * wn * 16; \
          _Pragma("unroll") for (int ks = 0; ks < 2; ++ks) { const int fo_ = (4 * ks + fq) * 2048 + ((fr ^ (4 * ks + fq)) << 4); \
              bf16x8 yf[2], wf[4]; \
              _Pragma("unroll") for (int tt = 0; tt < 2; ++tt) yf[tt] = *(const LAS bf16x8*)(yb + fo_ + tt * 256); \
              _Pragma("unroll") for (int nt = 0; nt < 4; ++nt) wf[nt] = *(const LAS bf16x8*)(wb + fo_ + nt * 256); \
              _Pragma("unroll") for (int tt = 0; tt < 2; ++tt) \
                  _Pragma("unroll") for (int nt = 0; nt < 4; ++nt) acc[tt][nt] = __builtin_amdgcn_mfma_f32_16x16x32_bf16(wf[nt], yf[tt], acc[tt][nt], 0, 0, 0); } } while (0)
#pragma unroll 1
    for (int kk = 0; kk < 4; ++kk) {
        const bool more = kk < 3;
        const unsigned short* wnA = more ? wA + (size_t)1024 * 256 : wsrc; const unsigned short* wnB = more ? wB + (size_t)1024 * 256 : wsrc + 64 * 256;
        const int yo = more ? 256 : -768;
        PGX_SLOAD(sgb, more ? 1024 : 0);
        PGX_LOADQ(3, 192, wA, wB, 192); PGX_COMPUTE(0); PGX_STORE(1, 1); __syncthreads();
        PGX_LOADQ(0, yo, wnA, wnB, 0); PGX_COMPUTE(1); PGX_STORE(0, 2); __syncthreads();
        PGX_LOADQ(1, yo + 64, wnA, wnB, 64); PGX_COMPUTE(2); PGX_STORE(1, 3); __syncthreads();
        PGX_LOADQ(2, yo + 128, wnA, wnB, 128); PGX_COMPUTE(3);
#pragma unroll
        for (int tt = 0; tt < 2; ++tt)
#pragma unroll
            for (int nt = 0; nt < 4; ++nt) { const u32x4 gv = sga[tt][nt >> 1]; const unsigned g0 = (nt & 1) ? gv.z : gv.x, g1 = (nt & 1) ? gv.w : gv.y; const f32x4 a = acc[tt][nt];
                mix[tt][nt] += (f32x4){a[0] * bflo(g0), a[1] * bfhi(g0), a[2] * bflo(g1), a[3] * bfhi(g1)}; acc[tt][nt] = (f32x4){0.f, 0.f, 0.f, 0.f}; }
#pragma unroll
        for (int tt = 0; tt < 2; ++tt) { sga[tt][0] = sgb[tt][0]; sga[tt][1] = sgb[tt][1]; }
        if (more) PGX_STORE(0, 0);
        __syncthreads();
        yA += 256; yB += 256; wA = wnA; wB = wnB; sp0 += 1024; sp1 += 1024;
    }
#pragma unroll
    for (int tt = 0; tt < 2; ++tt) { unsigned short* mp = MIX + (size_t)(row0 + 32 * wm + 16 * tt + fr) * 1024 + n0 + 64 * wn + 16 * fq;
        u32x4 w0, w1; w0.x = pk2(mix[tt][0][0], mix[tt][0][1]); w0.y = pk2(mix[tt][0][2], mix[tt][0][3]); w0.z = pk2(mix[tt][1][0], mix[tt][1][1]); w0.w = pk2(mix[tt][1][2], mix[tt][1][3]);
        w1.x = pk2(mix[tt][2][0], mix[tt][2][1]); w1.y = pk2(mix[tt][2][2], mix[tt][2][3]); w1.z = pk2(mix[tt][3][0], mix[tt][3][1]); w1.w = pk2(mix[tt][3][2], mix[tt][3][3]);
        *(u32x4*)mp = w0; *(u32x4*)(mp + 8) = w1; }
#undef PGX_LOADQ
#undef PGX_SLOAD
#undef PGX_STORE
#undef PGX_COMPUTE
}

__device__ __forceinline__ void pgx_unit_dma(LAS unsigned char* lds, const unsigned short* Y, const unsigned short* Wb, const unsigned short* S, unsigned short* MIX, int row0, int n0, int tid) {
    const int lane = tid & 63, wid = __builtin_amdgcn_readfirstlane(tid >> 6), wm = wid & 3, wn = wid >> 2, fr = lane & 15, fq = lane >> 4;
    const int dr = 8 * wid + (lane >> 3), dc = (lane & 7) ^ ((dr >> 1) & 7);
    const int wr = (dr & ~63) | (((dr >> 2) & 3) << 4) | (((dr >> 4) & 3) << 2) | (dr & 3);
    const unsigned short* yg = Y + (size_t)(row0 + dr) * 1024 + dc * 8;
    const unsigned short* wg = Wb + (size_t)(n0 + wr) * 256 + dc * 8;
    const unsigned ldsw = (unsigned)(uintptr_t)lds + wid * 1024;
#define PGD_DMA(s_) do { const int s__ = (s_); const unsigned b__ = ldsw + (unsigned)(s__ & 3) * 2 * OPB; const unsigned short* y__ = yg + s__ * 64; const unsigned short* w__ = wg + (size_t)(s__ >> 2) * 1024 * 256 + (s__ & 3) * 64; \
        att::glds16(y__, (unsigned)__builtin_amdgcn_readfirstlane(b__)); att::glds16(y__ + 64 * 1024, (unsigned)__builtin_amdgcn_readfirstlane(b__ + 8192)); \
        att::glds16(w__, (unsigned)__builtin_amdgcn_readfirstlane(b__ + OPB)); att::glds16(w__ + 64 * 256, (unsigned)__builtin_amdgcn_readfirstlane(b__ + OPB + 8192)); } while (0)
    f32x4 acc[2][4], mix[2][4];
#pragma unroll
    for (int a = 0; a < 2; ++a)
#pragma unroll
        for (int b = 0; b < 4; ++b) { acc[a][b] = (f32x4){0.f, 0.f, 0.f, 0.f}; mix[a][b] = (f32x4){0.f, 0.f, 0.f, 0.f}; }
    const unsigned short* sp0 = S + (size_t)(row0 + 32 * wm + fr) * 4096 + n0 + 64 * wn + 16 * fq; const unsigned short* sp1 = sp0 + (size_t)16 * 4096;
    u32x4 sga[2][2], sgb[2][2];
#define PGD_SLOAD(dst_, off_) do { dst_[0][0] = *(const u32x4*)(sp0 + (off_)); dst_[0][1] = *(const u32x4*)(sp0 + (off_) + 8); dst_[1][0] = *(const u32x4*)(sp1 + (off_)); dst_[1][1] = *(const u32x4*)(sp1 + (off_) + 8); } while (0)
    PGD_DMA(0); PGD_DMA(1); PGD_DMA(2);
    PGD_SLOAD(sga, 0);
    asm volatile("s_waitcnt vmcnt(12) lgkmcnt(0)\n\ts_barrier" ::: "memory");
    const unsigned fo0 = (unsigned)(uintptr_t)lds + fr * 128 + ((fq ^ ((fr >> 1) & 7)) << 4);
#define PGD_COMPUTE(h_) do { const unsigned yb = (h_) * 2 * OPB + 32 * wm * 128, wb = (h_) * 2 * OPB + OPB + 64 * wn * 128; \
          _Pragma("unroll") for (int ks = 0; ks < 2; ++ks) { const unsigned fo_ = fo0 ^ (unsigned)(64 * ks); \
              bf16x8 yf[2], wf[4]; \
              _Pragma("unroll") for (int tt = 0; tt < 2; ++tt) yf[tt] = *(const LAS bf16x8*)(uintptr_t)(fo_ + yb + tt * 2048); \
              _Pragma("unroll") for (int nt = 0; nt < 4; ++nt) wf[nt] = *(const LAS bf16x8*)(uintptr_t)(fo_ + wb + nt * 2048); \
              _Pragma("unroll") for (int tt = 0; tt < 2; ++tt) \
                  _Pragma("unroll") for (int nt = 0; nt < 4; ++nt) acc[tt][nt] = __builtin_amdgcn_mfma_f32_16x16x32_bf16(wf[nt], yf[tt], acc[tt][nt], 0, 0, 0); } } while (0)
#define PGD_END(N) asm volatile("s_waitcnt vmcnt(" #N ") lgkmcnt(0)\n\ts_barrier" ::: "memory")
#define PGD_MIX() do { \
        _Pragma("unroll") for (int tt = 0; tt < 2; ++tt) \
            _Pragma("unroll") for (int nt = 0; nt < 4; ++nt) { const u32x4 gv = sga[tt][nt >> 1]; const unsigned g0 = (nt & 1) ? gv.z : gv.x, g1 = (nt & 1) ? gv.w : gv.y; const f32x4 a = acc[tt][nt];        \
                mix[tt][nt] += (f32x4){a[0] * bflo(g0), a[1] * bfhi(g0), a[2] * bflo(g1), a[3] * bfhi(g1)}; acc[tt][nt] = (f32x4){0.f, 0.f, 0.f, 0.f}; } } while (0)
#pragma unroll 1
    for (int kk = 0; kk < 3; ++kk) {
        const int s0 = 4 * kk;
        PGD_SLOAD(sgb, 1024);
        PGD_DMA(s0 + 3); PGD_COMPUTE(0); PGD_END(12);
        PGD_DMA(s0 + 4); PGD_COMPUTE(1); PGD_END(12);
        PGD_DMA(s0 + 5); PGD_COMPUTE(2); PGD_END(8);
        PGD_DMA(s0 + 6); PGD_COMPUTE(3);
        PGD_MIX();
#pragma unroll
        for (int tt = 0; tt < 2; ++tt) { sga[tt][0] = sgb[tt][0]; sga[tt][1] = sgb[tt][1]; }
        PGD_END(8);
        sp0 += 1024; sp1 += 1024;
    }
    PGD_DMA(15); PGD_COMPUTE(0); PGD_END(8);
    PGD_COMPUTE(1); PGD_END(4);
    PGD_COMPUTE(2); PGD_END(0);
    PGD_COMPUTE(3);
    PGD_MIX();
    PGD_END(0);
#pragma unroll
    for (int tt = 0; tt < 2; ++tt) { unsigned short* mp = MIX + (size_t)(row0 + 32 * wm + 16 * tt + fr) * 1024 + n0 + 64 * wn + 16 * fq;
        u32x4 w0, w1; w0.x = pk2(mix[tt][0][0], mix[tt][0][1]); w0.y = pk2(mix[tt][0][2], mix[tt][0][3]); w0.z = pk2(mix[tt][1][0], mix[tt][1][1]); w0.w = pk2(mix[tt][1][2], mix[tt][1][3]);
        w1.x = pk2(mix[tt][2][0], mix[tt][2][1]); w1.y = pk2(mix[tt][2][2], mix[tt][2][3]); w1.z = pk2(mix[tt][3][0], mix[tt][3][1]); w1.w = pk2(mix[tt][3][2], mix[tt][3][3]);
        *(u32x4*)mp = w0; *(u32x4*)(mp + 8) = w1; }
#undef PGD_DMA
#undef PGD_SLOAD
#undef PGD_COMPUTE
#undef PGD_END
#undef PGD_MIX
}
}
template <int VAR> __device__ __forceinline__ void ph_pgx(Frame& F, int l, int r_lo = 0, int r_hi = 1 << 20, bool signal = false) {
    const unsigned short* Y = (const unsigned short*)(F.ws + WS_G); const unsigned short* S = (const unsigned short*)(F.ws + WS_S); unsigned short* MIX = (VAR == 0) ? (unsigned short*)(F.ws + WS_H) : (unsigned short*)F.out;
    const unsigned short* Wb = (const unsigned short*)(F.ws + WS_W + (size_t)l * W_LAYER + WO_WB);
    const bool last = (l == NLAYER - 1);
    const int nrt = last ? 128 : NROWS / 128;
    for (int r = r_lo; r <= r_hi; ++r) {
        const int u = F.vcu + r * F.G; if (u >= nrt * 8) break;
        int rt = u >> 3; const int ct = u & 7;
        if (last) rt = rt + 2 * (rt / 32) + 2;
        if (VAR == 0 && PGX_DMA) pgx::pgx_unit_dma(F.lds + RING_OFF, Y, Wb, S, MIX, rt * 128, ct * 128, F.tid); else pgx::pgx_unit<VAR>(F.lds + RING_OFF, Y, Wb, S, MIX, rt * 128, ct * 128, F.tid);
        if (signal) {
            asm volatile("s_waitcnt vmcnt(0)" ::: "memory"); __syncthreads();
            if (F.tid == 0) { __builtin_amdgcn_fence(__ATOMIC_RELEASE, "agent"); asm volatile("s_waitcnt vmcnt(0)" ::: "memory");
                (void)xb_add((unsigned*)((gu32*)(F.ws + WS_CTL) + CW_FLG) + (u >> 4), 1u); }
        }
    }
}
constexpr int NPL = 10;
enum { PH_H = 0, PH_G1, PH_POST1, PH_G2, PH_POST2, PH_ATT, PH_SG, PH_PG, PH_MIX, PH_OG };
constexpr int NPHASES = 1 + NLAYER * NPL;
#ifndef NAIVE_ATT
#define NAIVE_ATT 0
#endif
#ifndef PROBE_MASK
#define PROBE_MASK 0
#endif
#ifndef PROBE_LAYERS
#define PROBE_LAYERS 3
#endif
#ifndef MERGE_PGOG
#define MERGE_PGOG 0
#endif
#ifndef PHMASK
#define PHMASK 16383
#endif
#ifndef MK_ONE_LAUNCH
#define MK_ONE_LAUNCH 1
#endif

__global__ void __launch_bounds__(NTHREADS, 2) fwd_kernel(Args args) {
    extern __shared__ __attribute__((aligned(16))) unsigned char lds_raw[];
    { LAS unsigned char* l0 = (LAS unsigned char*)lds_raw;
      for (int u = threadIdx.x; u < (LDS_BYTES - LDSCTL_OFF) / 4; u += NTHREADS) ((LAS unsigned*)(l0 + LDSCTL_OFF))[u] = 0u;
      __syncthreads();
      if (args.ph_hi - args.ph_lo > 1) (void)xcd_barrier_post((unsigned*)((gu32*)(args.ws + WS_CTL) + CW_BAR), (volatile LAS unsigned*)(l0 + MISC_OFF) + 8); }

    unsigned long long tacc = 0ull;
    for (int ph = args.ph_lo; ph < args.ph_hi; ++ph) {
        unsigned long long tph0 = 0ull; bool probed = false;
        if (PROBE_MASK) { const int pl = (ph == 0) ? 0 : (ph - 1) / NPL, pp = (ph == 0) ? 10 : (ph - 1) % NPL; probed = ((PROBE_MASK >> pp) & 1) && ((PROBE_LAYERS >> pl) & 1); if (probed) tph0 = __builtin_amdgcn_s_memrealtime(); }
        int z; asm volatile("s_mov_b32 %0, 0" : "=s"(z));
        Frame F;
        F.lds = (LAS unsigned char*)lds_raw + z; F.kin = (const float* const __attribute__((address_space(4)))*)((const __attribute__((address_space(4))) char*)__builtin_amdgcn_kernarg_segment_ptr() + z); F.ws = args.ws + z; F.out = args.out + z; F.z = z;
        F.tid = threadIdx.x + z; F.lane = F.tid & 63; F.wave = __builtin_amdgcn_readfirstlane(F.tid >> 6);
        F.G = gridDim.x + z; { const int bx = blockIdx.x + z; F.vcu = (F.G % 8 == 0) ? (bx % 8) * (F.G / 8) + bx / 8 : bx; }
        F.gw = F.vcu * NWAVES + F.wave; F.NGW = F.G * NWAVES;
        bool is_gemm = false;
        pg8::Gemm g{nullptr, nullptr, NROWS, 256, 1024, 1024, 31, 0};
        pg8::Order S; S.init(1, 1, F.G, (int)blockIdx.x + z, 0);
        pg8::EpiU E{pg8::EM_PLAIN, 0, F.ws, nullptr, nullptr, nullptr, 0, 0, 0, 0, 1 << 20};
        if (ph == 0) { if (PHMASK & 8192) p0_prologue(F); }
        else {
            const int l = (ph - 1) / NPL, p = (ph - 1) % NPL;
            unsigned char* wl = F.ws + WS_W + (size_t)l * W_LAYER;
            const bool last = (l == NLAYER - 1);
            const int nMc = last ? 64 : NROWS / 256, lat = last ? 1 : 0;
            const bool merged = last && F.G == 256 && MERGE_PGOG;
            E.l = l;
            if (p == PH_H && (PHMASK & 1)) { ph_hnorm(F, l); }
            else if (p == PH_G1 && (PHMASK & 2)) {
                is_gemm = true; g.A = (const bf16*)(F.ws + WS_H); g.Bt = (const bf16*)(wl + WO_W1); g.N = N1; g.K = 1024; g.lda = 1024;
                S.init(NROWS / 256, N1 / 256, F.G, (int)blockIdx.x + z, 0);
                E.mode = pg8::EM_SILU2; E.oA = WS_ZS; E.ldc = ZS_P; E.oB = WS_G; E.ldc2 = 1024; E.split_tile = 7;
            }
            else if (p == PH_POST1 && (PHMASK & 4)) { ph_lru1(F, l); ph_post1(F, l); }
            else if (p == PH_G2 && (PHMASK & 8)) {
                is_gemm = true; g.A = (const bf16*)(F.ws + WS_ZS); g.Bt = (const bf16*)(wl + WO_UQ); g.N = 1024; g.K = 256; g.lda = ZS_P; g.a_shift = 1; g.a_step = 512;
                S.init(NROWS / 256, 4, F.G, (int)blockIdx.x + z, 0);
                E.mode = pg8::EM_PLAIN; E.oA = WS_MQ; E.ldc = 512; E.oB = WS_MKV; E.ldc2 = 512; E.split_tile = 2;
            }
            else if (p == PH_POST2 && (PHMASK & 16)) { ph_lru_carry(F); ph_post2(F, l); }
            else if (p == PH_ATT && (PHMASK & 32)) {
#if NAIVE_ATT
                ph_attn_naive(F, l);
#else
                ph_attn(F, l);
#endif
                ph_lru2(F, l); }
            else if (p == PH_SG && (PHMASK & 512)) {
                is_gemm = true; g.A = (const bf16*)(F.ws + WS_H); g.Bt = (const bf16*)(wl + WO_W1) + (size_t)N1 * 1024; g.N = 4096; g.K = 1024; g.lda = 1024;
                S.init(nMc, 16, F.G, (int)blockIdx.x + z, lat);
                E.mode = pg8::EM_SIG; E.oA = WS_S; E.ldc = 4096;
            }
            else if (p == PH_PG && (PHMASK & 1024)) {
                int r_hi = 1 << 20;
                if (merged) { pg8::Unit u0; pg8::Order S0; S0.init(64, 4, F.G, (int)blockIdx.x + z, 1); (void)S0.next(0, u0); r_hi = u0.pm / 17; }
                ph_pgx<0>(F, l, 0, r_hi, merged);
#ifdef PGX_PROBE
                if (l == 0) { __syncthreads(); ph_pgx<PGX_PROBE>(F, l); }
#endif
            }
            else if (p == PH_MIX) {
                if (!last && (PHMASK & 2048)) {
                    is_gemm = true; g.A = (const bf16*)(F.ws + WS_H); g.Bt = (const bf16*)(F.ws + WS_WOS); g.N = 4096; g.K = 256; g.lda = 1024; g.a_shift = 2; g.a_step = 512;
                    S.init(4, 16, F.G, (int)blockIdx.x + z, 2);
                    E.mode = pg8::EM_PLAIN; E.oA = WS_S; E.ldc = 4096; }
            }
            else if (p == PH_OG && (PHMASK & 4096)) {
                is_gemm = true; g.A = (const bf16*)(F.ws + WS_H); g.Bt = (const bf16*)(wl + WO_WO); g.N = 1024; g.K = 1024; g.lda = 1024;
                S.init(64, 4, F.G, (int)blockIdx.x + z, 1);
                E.mode = pg8::EM_RES; E.xin = (l == 0) ? F.in(I_X) : (const float*)F.out; E.xout = F.out; E.cin0 = F.in(I_CTX); E.oA = WS_MOD; E.oB = WS_CTX1;
                if (merged) {
                    pg8::Unit u0; (void)S.next(0, u0); const int q = (u0.pm / 17) * 16 + u0.pm % 17 - 1;
                    if (F.tid == 0) { unsigned* bar = (unsigned*)((gu32*)(F.ws + WS_CTL) + CW_BAR); unsigned* flg = (unsigned*)((gu32*)(F.ws + WS_CTL) + CW_FLG) + q;
                        XB_SPIN(xb_ld(flg) < 16u, bar); __builtin_amdgcn_fence(__ATOMIC_ACQUIRE, "agent"); asm volatile("s_waitcnt vmcnt(0)" ::: "memory"); }
                    __syncthreads(); }
            }
        }
        if (is_gemm) pg8::gemm_phase<pg8::EpiU, pg8::Order, true, true>(F.lds + RING_OFF, g, S, E, F.tid);
        if (NLAYER == 2 && ph >= 1 && ph <= 1 + PH_OG) {
            const int p = ph - 1;
            if (p == PH_G1 || p == PH_G2 || p == PH_SG || p == PH_PG || p == PH_OG) {
                int z4; asm volatile("s_mov_b32 %0, 0" : "=s"(z4));
                Frame C;
                C.lds = (LAS unsigned char*)lds_raw + z4; C.kin = (const float* const __attribute__((address_space(4)))*)((const __attribute__((address_space(4))) char*)__builtin_amdgcn_kernarg_segment_ptr() + z4); C.ws = args.ws + z4; C.out = args.out + z4; C.z = z4;
                C.tid = threadIdx.x + z4; C.lane = C.tid & 63; C.wave = __builtin_amdgcn_readfirstlane(C.tid >> 6);
                C.G = gridDim.x + z4; const int bx = blockIdx.x + z4; C.vcu = (C.G % 8 == 0) ? (bx % 8) * (C.G / 8) + bx / 8 : bx;
                C.gw = C.vcu * NWAVES + C.wave; C.NGW = C.G * NWAVES;
                int cidx = -1, cn = 1, loA = 0, nA = 0, loB = 0, nB = 0;
                if (p == PH_G1) { const int nb = ((NROWS / 256) * (N1 / 256)) % C.G; cidx = bx - nb; cn = C.G - nb; loA = I_EARLY; nA = IC_G1; }
                else if (p == PH_G2) { const int nb = ((NROWS / 256) * 4) % C.G; cidx = bx - nb; cn = C.G - nb; loA = I_EARLY + IC_G1; nA = I_INL - IC_G1; }
                else if (p == PH_SG) { const int nb = ((NROWS / 256) * 16) % C.G; cidx = bx - nb; cn = C.G - nb; loA = I_EARLY + I_INL; nA = I_BR; loB = 0; nB = 1536; }
                else if (p == PH_PG) { const int nb = ((NROWS / 128) * 8) % C.G; cidx = C.vcu - nb; cn = C.G - nb; loA = I_EARLY + I_INL + I_BR; nA = I_OUT + I_SPLIT; loB = 1536; nB = 1536; }
                else { const int nb = (64 < C.G) ? 64 : 0; cidx = bx - nb; cn = C.G - nb; loB = 3072; nB = I_LAYER - 3072; }
                if (cidx >= 0) { __syncthreads();
                    if (p == PH_G1) p0_tables(C, cidx * NTHREADS + C.tid, cn * NTHREADS);
                    weight_copies(C, cidx * NWAVES + C.wave, cn * NWAVES, loA, nA, loB, nB); }
            }
        }
        if (MERGE_PGOG && ph == 1 + (NLAYER - 1) * NPL + PH_OG && gridDim.x == 256) {
            int z5; asm volatile("s_mov_b32 %0, 0" : "=s"(z5));
            Frame C;
            C.lds = (LAS unsigned char*)lds_raw + z5; C.kin = (const float* const __attribute__((address_space(4)))*)((const __attribute__((address_space(4))) char*)__builtin_amdgcn_kernarg_segment_ptr() + z5); C.ws = args.ws + z5; C.out = args.out + z5; C.z = z5;
            C.tid = threadIdx.x + z5; C.lane = C.tid & 63; C.wave = __builtin_amdgcn_readfirstlane(C.tid >> 6);
            C.G = gridDim.x + z5; const int bx = blockIdx.x + z5; C.vcu = (C.G % 8 == 0) ? (bx % 8) * (C.G / 8) + bx / 8 : bx;
            C.gw = C.vcu * NWAVES + C.wave; C.NGW = C.G * NWAVES;
            pg8::Unit u0; pg8::Order S0; S0.init(64, 4, C.G, bx, 1); (void)S0.next(0, u0);
            __syncthreads(); ph_pgx<0>(C, NLAYER - 1, u0.pm / 17 + 1, 1 << 20, true);
        }
        const bool empty_phase = (ph > 0) && (((ph - 1) % NPL == PH_MIX) || (MERGE_PGOG && ph == 1 + (NLAYER - 1) * NPL + PH_PG && gridDim.x == 256));
        if (empty_phase) __syncthreads();
        if (ph + 1 < args.ph_hi && !empty_phase) {
            int z2; asm volatile("s_mov_b32 %0, 0" : "=s"(z2));
            XcdBarrier bar; bar.bar = (unsigned*)((gu32*)(args.ws + z2 + WS_CTL) + CW_BAR); bar.x = xb_xcc_id(); bar.st = (volatile LAS unsigned*)((LAS unsigned char*)lds_raw + z2 + MISC_OFF) + 8;
            xcd_barrier(bar);
        }
        if (PROBE_MASK) { if (probed) tacc += __builtin_amdgcn_s_memrealtime() - tph0; }
    }
#ifdef EXTRA_BARRIERS
    for (int xb = 0; xb < EXTRA_BARRIERS; ++xb) { int z3; asm volatile("s_mov_b32 %0, 0" : "=s"(z3));
        XcdBarrier bar; bar.bar = (unsigned*)((gu32*)(args.ws + z3 + WS_CTL) + CW_BAR); bar.x = xb_xcc_id(); bar.st = (volatile LAS unsigned*)((LAS unsigned char*)lds_raw + z3 + MISC_OFF) + 8;
        xcd_barrier(bar); }
#endif
    if (PROBE_MASK) { const unsigned long long t0 = __builtin_amdgcn_s_memrealtime(); while (__builtin_amdgcn_s_memrealtime() - t0 < tacc) __builtin_amdgcn_s_sleep(8); }
}

extern "C" void kernel_launch(void* const* d_in, const int* in_sizes, int n_in, void* d_out, int out_size, void* d_ws, size_t ws_size, hipStream_t stream) {
    static int grid = 0;
    if (grid == 0) {
        if (n_in != 28 || out_size != NB * SEQ * DM || ws_size < WS_END) { fprintf(stderr, "kernel_launch: unexpected shapes (n_in %d out %d ws %zu); nothing launched\n", n_in, out_size, ws_size); grid = -1; return; }
        int dev = 0, cus = 0, per_cu = 0;
        if (hipGetDevice(&dev) != hipSuccess || hipDeviceGetAttribute(&cus, hipDeviceAttributeMultiprocessorCount, dev) != hipSuccess) { grid = -1; return; }
        if (hipFuncSetAttribute((const void*)fwd_kernel, hipFuncAttributeMaxDynamicSharedMemorySize, LDS_BYTES) != hipSuccess) { fprintf(stderr, "kernel_launch: hipFuncSetAttribute failed\n"); grid = -1; return; }
        if (hipOccupancyMaxActiveBlocksPerMultiprocessor(&per_cu, (const void*)fwd_kernel, NTHREADS, LDS_BYTES) != hipSuccess || per_cu < 1) { fprintf(stderr, "kernel_launch: occupancy query says %d\n", per_cu); (void)hipGetLastError(); grid = -1; return; }
        grid = cus;
    }
    if (grid < 0) return;
    (void)hipMemsetAsync((char*)d_ws + WS_CTL, 0, CTL_ZERO_BYTES, stream);
    Args a{};
    for (int i = 0; i < 28; ++i) a.in[i] = (const float*)d_in[i];
    a.out = (float*)d_out; a.ws = (unsigned char*)d_ws;
#if MK_ONE_LAUNCH
    a.ph_lo = 0; a.ph_hi = NPHASES;
    hipLaunchKernelGGL(fwd_kernel, dim3(grid), dim3(NTHREADS), LDS_BYTES, stream, a);
#else
    for (int ph = 0; ph < NPHASES; ++ph) { a.ph_lo = ph; a.ph_hi = ph + 1; hipLaunchKernelGGL(fwd_kernel, dim3(grid), dim3(NTHREADS), LDS_BYTES, stream, a); }
#endif
}
```

```cpp
#include <hip/hip_runtime.h>
#include <cstdio>
#include <cstdint>
#include <cmath>
__device__ __forceinline__ float bflo(unsigned w) { return __uint_as_float(w << 16); }
__device__ __forceinline__ float bfhi(unsigned w) { return __uint_as_float(w & 0xffff0000u); }
__device__ __forceinline__ float sigmoid_f(float v) { return __builtin_amdgcn_rcpf(1.0f + __builtin_amdgcn_exp2f(-1.4426950408889634f * v)); }
namespace pg8 {
#define PG8_LAS __attribute__((address_space(3)))
typedef unsigned short bf16_t;
typedef short bf16x8 __attribute__((ext_vector_type(8)));
typedef float f32x4 __attribute__((ext_vector_type(4)));
typedef unsigned u32x4 __attribute__((ext_vector_type(4)));
constexpr int BM = 256, BK = 64, HALF = 128, HTB = HALF * BK * 2  , STAGE_BYTES = 8 * HTB, NXCD = 8, WGM = 8;

__host__ __device__ __forceinline__ int lds_byte(int r, int c) { const int st = (r >> 4) * 2 + (c >> 5), rr = r & 15, cc = c & 31, ob = rr * 64 + cc * 2; return st * 1024 + (ob ^ (((ob >> 9) & 1) << 5)); }
__host__ __device__ __forceinline__ void stage_rc(int b, int& R, int& C) { const int st = b / 1024, sb = b % 1024, swz = sb ^ (((sb >> 9) & 1) << 5); R = (st >> 1) * 16 + swz / 64; C = (st & 1) * 32 + (swz % 64) / 2; }
__host__ __device__ __forceinline__ int perm32(int rho) { const int n = rho >> 4, i = rho & 15; return 8 * (i >> 2) + 4 * n + (i & 3); }

struct Unit { int pm, pn; };
struct Gemm { const bf16_t* A; const bf16_t* Bt; int M, N, K, lda; int a_shift, a_step; };

struct StaticOrder {
    int nM, nN, nwg, G, c;
    __host__ __device__ void init(int M, int N, int G_, int c_) { nM = M / BM; nN = N / BM; nwg = nM * nN; G = G_; c = c_; }
    __host__ __device__ bool next(int i, Unit& u) const {
        const long L = (long)i * G + c; if (L >= nwg) return false;
        int wgid = (int)L; { const int q = nwg / NXCD, r = nwg % NXCD, xcd = wgid % NXCD, off = wgid / NXCD; wgid = (xcd < r ? xcd * (q + 1) : r * (q + 1) + (xcd - r) * q) + off; }
        const int nig = WGM * nN, gid = wgid / nig, fm = gid * WGM, gsz = (nM - fm) < WGM ? (nM - fm) : WGM;
        u.pm = fm + ((wgid % nig) % gsz); u.pn = (wgid % nig) / gsz; return true;
    }
    __device__ __forceinline__ void a_ready(const Unit&) const {}
    __device__ __forceinline__ void done(const Unit&) const {}
};

__device__ __forceinline__ unsigned cvt_pk_bf16(float lo, float hi) { unsigned r; asm volatile("v_cvt_pk_bf16_f32 %0, %1, %2" : "=v"(r) : "v"(lo), "v"(hi)); return r; }
enum { EM_PLAIN = 0, EM_SILU2 = 1, EM_SIG = 2, EM_MUL = 3, EM_RES = 4 };
struct EpiU {
    static constexpr bool PERM = true, AFTER_DRAIN = false;
    int mode; int l; unsigned char* ws; const float* xin; float* xout; const float* cin0;
    size_t oA, oB; int ldc, ldc2, split_tile;
    __device__ __forceinline__ void operator()(const f32x4 (&acc)[2][2][4][2], const Unit& u, int wr, int wc, int fr, int fq) const {
        if (mode == EM_RES) {
            const int b = u.pm / 17, t0 = u.pm % 17;
            const float* src; float* dst; const float* gate; const float* modl = (const float*)(ws + oA) + (size_t)l * 5 * 3072;
            if (t0 == 0) { float* c1 = (float*)(ws + oB); src = ((l == 0) ? cin0 : (const float*)c1) + (size_t)b * 256 * 1024; dst = c1 + (size_t)b * 256 * 1024; gate = modl + 4 * 3072 + 2048; }
            else { const size_t o = ((size_t)b * 4096 + (size_t)(t0 - 1) * 256) * 1024; src = xin + o; dst = xout + o; gate = modl + b * 3072 + 2048; }
            const int col0 = u.pn * BM + wc * 32 + 8 * fq;
            const char* srcb = (const char*)src; char* dstb = (char*)dst; const char* gb = (const char*)(gate + col0);
            const unsigned off0 = (unsigned)((wr * 64 + fr) * 1024 + col0) * 4u;
#pragma unroll
            for (int ai = 0; ai < 2; ++ai) {
                f32x4 xo[4][2][2];
#pragma unroll
                for (int m = 0; m < 4; ++m) { const unsigned off = off0 + (unsigned)(ai * HALF + m * 16) * 4096u;
#pragma unroll
                    for (int bj = 0; bj < 2; ++bj)
#pragma unroll
                        for (int n = 0; n < 2; ++n) xo[m][bj][n] = *(const f32x4*)(srcb + (off + (unsigned)(bj * HALF + n * 4) * 4u)); }
#pragma unroll
                for (int m = 0; m < 4; ++m) { const unsigned off = off0 + (unsigned)(ai * HALF + m * 16) * 4096u;
#pragma unroll
                    for (int bj = 0; bj < 2; ++bj)
#pragma unroll
                        for (int n = 0; n < 2; ++n) { const unsigned cb = (unsigned)(bj * HALF + n * 4) * 4u; const f32x4 g = *(const f32x4*)(gb + cb);
                            *(f32x4*)(dstb + (off + cb)) = xo[m][bj][n] + g * acc[ai][bj][m][n]; } }
                asm volatile("" ::: "memory"); }
            return;
        }
        const int row0 = u.pm * BM + wr * 64 + fr; int colt = u.pn * BM; bf16_t* base = (bf16_t*)(ws + oA); int ld = ldc; bool second = false;
        if (u.pn >= split_tile) { base = (bf16_t*)(ws + oB); ld = ldc2; colt -= split_tile * BM; second = true; }
        const bool do_silu = (mode == EM_SILU2) && second;
        const int col0 = colt + wc * 32 + 8 * fq;
#pragma unroll
        for (int ai = 0; ai < 2; ++ai)
#pragma unroll
            for (int m = 0; m < 4; ++m) { bf16_t* rowp = base + (size_t)(row0 + ai * HALF + m * 16) * ld + col0;
#pragma unroll
                for (int bj = 0; bj < 2; ++bj) { f32x4 v0 = acc[ai][bj][m][0], v1 = acc[ai][bj][m][1];
                    if (mode == EM_SIG) {
#pragma unroll
                        for (int e = 0; e < 4; ++e) { v0[e] = __builtin_amdgcn_rcpf(1.0f + __builtin_amdgcn_exp2f(-v0[e])); v1[e] = __builtin_amdgcn_rcpf(1.0f + __builtin_amdgcn_exp2f(-v1[e])); } }
                    if (do_silu) {
#pragma unroll
                        for (int e = 0; e < 4; ++e) { v0[e] = v0[e] * sigmoid_f(v0[e]); v1[e] = v1[e] * sigmoid_f(v1[e]); } }
                    u32x4 w; w.x = cvt_pk_bf16(v0[0], v0[1]); w.y = cvt_pk_bf16(v0[2], v0[3]); w.z = cvt_pk_bf16(v1[0], v1[1]); w.w = cvt_pk_bf16(v1[2], v1[3]);
                    *(u32x4*)(rowp + bj * HALF) = w; } }
    }
};
struct Order {
    int nM, nN, nwg, G, c, latent_only, grouped, vc, nctx;
    __device__ void init(int nM_, int nN_, int G_, int c_, int lat) { nM = nM_; nN = nN_; nwg = nM * nN; G = G_; c = c_; latent_only = lat; grouped = 0; vc = 0; nctx = 0; }
    __device__ void init_grouped(int G_, int vc_, int with_ctx) { init(64, 4, G_, vc_, 1); grouped = 1; vc = vc_; nctx = with_ctx ? 64 : 0; }
    __device__ bool next(int i, Unit& u) const {
        if (grouped) {
            const int gi = i >> 2, grp = vc + gi * G;
            if (grp < 256) { const int pm = grp >> 2; u.pm = pm + pm / 16 + 1; u.pn = 4 * (i & 3) + (grp & 3); return true; }
            const int done = ((256 - vc + G - 1) / G) * 4;
            const int x = vc + (i - done) * G;
            if (i >= done && x < nctx) { const int g = x >> 2, k = x & 3; u.pm = (g >> 2) * 17; u.pn = 4 * k + (g & 3); return true; }
            return false;
        }
        const long L = (long)i * G + c; if (L >= nwg) return false;
        int wgid = (int)L; { const int q = nwg / NXCD, r = nwg % NXCD, xcd = wgid % NXCD, off = wgid / NXCD; wgid = (xcd < r ? xcd * (q + 1) : r * (q + 1) + (xcd - r) * q) + off; }
        const int nig = WGM * nN, gid = wgid / nig, fm = gid * WGM, gsz = (nM - fm) < WGM ? (nM - fm) : WGM;
        int pm = fm + ((wgid % nig) % gsz); u.pn = (wgid % nig) / gsz; if (latent_only == 1) pm = pm + pm / 16 + 1; else if (latent_only == 2) pm = pm * 17; u.pm = pm; return true;
    }
    __device__ __forceinline__ void a_ready(const Unit&) const {}
    __device__ __forceinline__ void done(const Unit&) const {}
};
template <class Epi, class Sched, bool ALIGN_EPI = false, bool SP2 = false>
__device__ __forceinline__ void gemm_phase(PG8_LAS unsigned char* lds, const Gemm g, const Sched& S, const Epi& E, const int tid  ) {
    const int wid = __builtin_amdgcn_readfirstlane(tid >> 6), lane = tid & 63, wr = wid >> 2, wc = wid & 3, fr = lane & 15, fq = lane >> 4;
    const int K = g.K, nt = K / BK;
    unsigned voffA[2], voffB[2];
#pragma unroll
    for (int i = 0; i < 2; ++i) { int R, C; stage_rc(tid * 16 + i * 8192, R, C); const int Rb = Epi::PERM ? ((R & ~31) + perm32(R & 31)) : R;
        voffA[i] = (unsigned)(R * g.lda + C) * 2u; voffB[i] = (unsigned)(Rb * K + C) * 2u; }
    const size_t kstep = (size_t)(BK * 2);
    const size_t hstepA = (size_t)HALF * g.lda * 2, hstepB = (size_t)HALF * K * 2;
    const size_t tstepA = 2 * hstepA, tstepB = 2 * hstepB;
    const unsigned ldsw = (unsigned)wid * 1024u;
    const int aoff = lds_byte(wr * 64 + fr, fq * 8), boff = lds_byte(wc * 32 + fr, fq * 8);
#define PG8_SA(b, h) (((b) * 2 + (h)) * HTB)
#define PG8_SB(b, h) ((4 + (b) * 2 + (h)) * HTB)
#define PG8_STAGE(bufoff, gbase, voff) do { _Pragma("unroll") for (int _i = 0; _i < 2; ++_i) \
        __builtin_amdgcn_global_load_lds((const unsigned*)((const char*)(gbase) + (voff)[_i]), (PG8_LAS unsigned*)(lds + (bufoff) + ldsw + _i * 8192), 16, 0, 0); } while (0)
#define PG8_LDA(dst, b, h) do { _Pragma("unroll") for (int m = 0; m < 4; ++m) _Pragma("unroll") for (int k = 0; k < 2; ++k) dst[m][k] = *(const PG8_LAS bf16x8*)(lds + PG8_SA(b, h) + aoff + m * 2048 + k * 1024); } while (0)
#define PG8_LDB(dst, b, h) do { _Pragma("unroll") for (int n = 0; n < 2; ++n) _Pragma("unroll") for (int k = 0; k < 2; ++k) dst[n][k] = *(const PG8_LAS bf16x8*)(lds + PG8_SB(b, h) + boff + n * 2048 + k * 1024); } while (0)
#define PG8_MMA(ai, bj, At, Bt) do { __builtin_amdgcn_s_setprio(1); _Pragma("unroll") for (int m = 0; m < 4; ++m) _Pragma("unroll") for (int n = 0; n < 2; ++n) _Pragma("unroll") for (int k = 0; k < 2; ++k) \
        acc[ai][bj][m][n] = __builtin_amdgcn_mfma_f32_16x16x32_bf16(Bt[n][k], At[m][k], acc[ai][bj][m][n], 0, 0, 0); __builtin_amdgcn_s_setprio(0); } while (0)
#define PG8_WAIT_V(n) asm volatile("s_waitcnt vmcnt(" #n ")" ::: "memory")
#define PG8_WAIT_L(n) asm volatile("s_waitcnt lgkmcnt(" #n ")" ::: "memory")
#define PG8_BAR __builtin_amdgcn_s_barrier()
#define PG8_SCHED __builtin_amdgcn_sched_barrier(0)
    Unit cur, nxt; int ui = 0;
    if (!S.next(0, cur)) return;
    f32x4 acc[2][2][4][2];
#pragma unroll
    for (int a = 0; a < 2; ++a)
#pragma unroll
        for (int b = 0; b < 2; ++b)
#pragma unroll
            for (int m = 0; m < 4; ++m)
#pragma unroll
                for (int n = 0; n < 2; ++n) acc[a][b][m][n] = (f32x4){0.f, 0.f, 0.f, 0.f};
    bf16x8 At[4][2], B0[2][2], B1[2][2];
    const char* cA = (const char*)g.A + (size_t)cur.pm * tstepA + (size_t)(cur.pn >> g.a_shift) * (size_t)g.a_step; const char* cB = (const char*)g.Bt + (size_t)cur.pn * tstepB;
    S.a_ready(cur);
    if constexpr (SP2) {
        PG8_STAGE(PG8_SB(0, 0), cB, voffB); PG8_STAGE(PG8_SB(0, 1), cB + hstepB, voffB); PG8_STAGE(PG8_SA(0, 0), cA, voffA); PG8_STAGE(PG8_SA(0, 1), cA + hstepA, voffA);
        if (wr == 1) PG8_BAR;
        PG8_WAIT_V(2); PG8_BAR;
        PG8_STAGE(PG8_SB(1, 0), cB + kstep, voffB); PG8_STAGE(PG8_SA(1, 0), cA + kstep, voffA); PG8_STAGE(PG8_SB(1, 1), cB + hstepB + kstep, voffB);
        PG8_WAIT_V(6); PG8_BAR;
    } else {
        PG8_STAGE(PG8_SB(0, 0), cB, voffB); PG8_STAGE(PG8_SA(0, 0), cA, voffA); PG8_STAGE(PG8_SB(0, 1), cB + hstepB, voffB); PG8_STAGE(PG8_SA(0, 1), cA + hstepA, voffA);
        if (wr == 1) PG8_BAR;
        PG8_WAIT_V(4); PG8_BAR;
        PG8_STAGE(PG8_SB(1, 0), cB + kstep, voffB); PG8_STAGE(PG8_SA(1, 0), cA + kstep, voffA); PG8_STAGE(PG8_SB(1, 1), cB + hstepB + kstep, voffB);
        PG8_WAIT_V(6); PG8_BAR;
    }
    for (;;) {
        const bool has_next = S.next(ui + 1, nxt);
        const char* nA = has_next ? (const char*)g.A + (size_t)nxt.pm * tstepA + (size_t)(nxt.pn >> g.a_shift) * (size_t)g.a_step : cA; const char* nB = has_next ? (const char*)g.Bt + (size_t)nxt.pn * tstepB : cB;
        for (int t = 0; t < nt; t += 2) {
            const bool last = (t == nt - 2);
            const char* a1 = cA + (size_t)(t + 1) * kstep;
            const char* a2 = last ? nA : cA + (size_t)(t + 2) * kstep; const char* b2 = last ? nB : cB + (size_t)(t + 2) * kstep;
            const char* a3 = a2 + kstep; const char* b3 = b2 + kstep;
            if (last && has_next) S.a_ready(nxt);
            if constexpr (SP2) {
            PG8_LDB(B0, 0, 0); PG8_LDB(B1, 0, 1); PG8_SCHED; PG8_LDA(At, 0, 0); PG8_STAGE(PG8_SA(1, 1), a1 + hstepA, voffA);
            PG8_WAIT_V(8); PG8_WAIT_L(0); PG8_BAR; PG8_MMA(0, 0, At, B0); PG8_MMA(0, 1, At, B1); PG8_BAR; PG8_SCHED;
            PG8_LDA(At, 0, 1); PG8_STAGE(PG8_SB(0, 0), b2, voffB); PG8_STAGE(PG8_SB(0, 1), b2 + hstepB, voffB); PG8_STAGE(PG8_SA(0, 0), a2, voffA);
            PG8_WAIT_V(8); PG8_WAIT_L(0); PG8_BAR; PG8_MMA(1, 0, At, B0); PG8_MMA(1, 1, At, B1); PG8_BAR; PG8_SCHED;
            PG8_LDB(B0, 1, 0); PG8_LDB(B1, 1, 1); PG8_SCHED; PG8_LDA(At, 1, 0); PG8_STAGE(PG8_SA(0, 1), a2 + hstepA, voffA);
            PG8_WAIT_V(8); PG8_WAIT_L(0); PG8_BAR; PG8_MMA(0, 0, At, B0); PG8_MMA(0, 1, At, B1); PG8_BAR; PG8_SCHED;
            PG8_LDA(At, 1, 1); PG8_STAGE(PG8_SB(1, 0), b3, voffB); PG8_STAGE(PG8_SB(1, 1), b3 + hstepB, voffB); PG8_STAGE(PG8_SA(1, 0), a3, voffA);
            PG8_WAIT_V(8); PG8_WAIT_L(0); PG8_BAR; PG8_MMA(1, 0, At, B0); PG8_MMA(1, 1, At, B1); PG8_BAR; PG8_SCHED;
            } else {
            PG8_LDB(B0, 0, 0); PG8_SCHED; PG8_LDA(At, 0, 0); PG8_STAGE(PG8_SA(1, 1), a1 + hstepA, voffA);
            PG8_WAIT_L(8); PG8_BAR; PG8_WAIT_L(0); PG8_MMA(0, 0, At, B0); PG8_BAR; PG8_SCHED;
            PG8_LDB(B1, 0, 1); PG8_STAGE(PG8_SB(0, 0), b2, voffB);
            PG8_BAR; PG8_WAIT_L(0); PG8_MMA(0, 1, At, B1); PG8_BAR;
            PG8_LDA(At, 0, 1); PG8_STAGE(PG8_SA(0, 0), a2, voffA);
            PG8_BAR; PG8_WAIT_L(0); PG8_MMA(1, 0, At, B0); PG8_BAR; PG8_SCHED;
            PG8_STAGE(PG8_SB(0, 1), b2 + hstepB, voffB);
            PG8_WAIT_V(6); PG8_BAR; PG8_MMA(1, 1, At, B1); PG8_BAR;
            PG8_LDB(B0, 1, 0); PG8_SCHED; PG8_LDA(At, 1, 0); PG8_STAGE(PG8_SA(0, 1), a2 + hstepA, voffA);
            PG8_WAIT_L(8); PG8_BAR; PG8_WAIT_L(0); PG8_MMA(0, 0, At, B0); PG8_BAR; PG8_SCHED;
            PG8_LDB(B1, 1, 1); PG8_STAGE(PG8_SB(1, 0), b3, voffB);
            PG8_BAR; PG8_WAIT_L(0); PG8_MMA(0, 1, At, B1); PG8_BAR;
            PG8_LDA(At, 1, 1); PG8_STAGE(PG8_SA(1, 0), a3, voffA);
            PG8_BAR; PG8_WAIT_L(0); PG8_MMA(1, 0, At, B0); PG8_BAR; PG8_SCHED;
            PG8_STAGE(PG8_SB(1, 1), b3 + hstepB, voffB);
            PG8_WAIT_V(6); PG8_BAR; PG8_MMA(1, 1, At, B1); PG8_BAR;
            }
        }
        if constexpr (ALIGN_EPI) { if (wr == 0) PG8_BAR; }
        if constexpr (!Epi::AFTER_DRAIN) { E(acc, cur, wr, wc, fr, fq); S.done(cur); }
        if (!has_next) break;
#pragma unroll
        for (int a = 0; a < 2; ++a)
#pragma unroll
            for (int b = 0; b < 2; ++b)
#pragma unroll
                for (int m = 0; m < 4; ++m)
#pragma unroll
                    for (int n = 0; n < 2; ++n) acc[a][b][m][n] = (f32x4){0.f, 0.f, 0.f, 0.f};
        cur = nxt; cA = nA; cB = nB; ++ui;
        if constexpr (ALIGN_EPI) { if (wr == 1) PG8_BAR; }
    }
    PG8_WAIT_V(0);
    if constexpr (!ALIGN_EPI) { if (wr == 0) PG8_BAR; }
    PG8_BAR;
    if constexpr (Epi::AFTER_DRAIN) { E.fused(acc, cur, wr, wc, fr, fq, lds, wid, lane); S.done(cur); }
#undef PG8_SA
#undef PG8_SB
#undef PG8_STAGE
#undef PG8_LDA
#undef PG8_LDB
#undef PG8_MMA
#undef PG8_WAIT_V
#undef PG8_WAIT_L
#undef PG8_BAR
#undef PG8_SCHED
}
}
#define PG8_SP2 true
#define PG8_ALIGN true
#define GAS __attribute__((address_space(1)))
#define LAS __attribute__((address_space(3)))
typedef unsigned short bf16;
typedef unsigned v4u __attribute__((ext_vector_type(4)));
typedef float f32x4 __attribute__((ext_vector_type(4)));
typedef short bf16x8 __attribute__((ext_vector_type(8)));
typedef GAS unsigned gu32;
typedef GAS unsigned long long gu64;
#define RLX_AGENT __ATOMIC_RELAXED, __HIP_MEMORY_SCOPE_AGENT
#define LDS_WAIT() asm volatile("s_waitcnt lgkmcnt(0)" ::: "memory")
#define VM_WAIT() asm volatile("s_waitcnt vmcnt(0)" ::: "memory")
__device__ __forceinline__ unsigned long long rt() { return __builtin_amdgcn_s_memrealtime(); }
__device__ __forceinline__ unsigned f2bf(float f) { unsigned u = __builtin_bit_cast(unsigned, f); return (u + 0x7fffu + ((u >> 16) & 1u)) >> 16; }
__device__ __forceinline__ unsigned pk2(float lo, float hi) { return f2bf(lo) | (f2bf(hi) << 16); }
#define XB_TMO      128
#define XB_XCNT(j)  (256  + 64 * (j))
#define XB_XSUB(j)  (1280 + 64 * (j))
#define XB_XGEN(j)  (2304 + 64 * (j))
#define XB_TOP      3328
#define XB_TOPGEN   3392
#define XCD_BAR_WORDS 3456
#define XB_SPIN_CAP (1u << 18)

__device__ __forceinline__ unsigned xb_ld(unsigned* p)              { return __hip_atomic_load(p, __ATOMIC_RELAXED, __HIP_MEMORY_SCOPE_AGENT); }
__device__ __forceinline__ unsigned xb_add(unsigned* p, unsigned v) { return __hip_atomic_fetch_add(p, v, __ATOMIC_RELAXED, __HIP_MEMORY_SCOPE_AGENT); }
__device__ __forceinline__ unsigned xb_xcc_id() { return (unsigned)__builtin_amdgcn_s_getreg((3 << 11) | 20) & 0xFu; }
#define XB_SPIN(cond, bar) do { unsigned _sp = 0; while (cond) { __builtin_amdgcn_s_sleep(1); \
    if ((++_sp & 255u) == 0u) { if (xb_ld(&(bar)[XB_TMO])) break; if (_sp > XB_SPIN_CAP) { atomicAdd(&(bar)[XB_TMO], 1u); break; } } } } while (0)

struct XcdBarrier {
    unsigned* bar; unsigned x;
    volatile LAS unsigned* st;
};

__device__ __forceinline__ XcdBarrier xcd_barrier_post(unsigned* bar, volatile LAS unsigned* st) {
    XcdBarrier b; b.bar = bar; b.x = xb_xcc_id(); b.st = st;
    if (threadIdx.x == 0) (void)xb_add(&bar[XB_XCNT(b.x)], 1u);
    return b;
}
__device__ __forceinline__ void xcd_barrier_complete(unsigned* bar, unsigned x, unsigned& nloc, unsigned& nx) {
    const unsigned G = gridDim.x * gridDim.y * gridDim.z;
    unsigned sum, cnt, mine, sp = 0u;
    for (;;) {
        sum = 0u; cnt = 0u; mine = 0u;
#pragma unroll
        for (unsigned j = 0; j < 16; ++j) { const unsigned c = xb_ld(&bar[XB_XCNT(j)]); sum += c; cnt += (c > 0u) ? 1u : 0u; mine = (j == x) ? c : mine; }
        if (sum == G) break;
        __builtin_amdgcn_s_sleep(1);
        if ((++sp & 255u) == 0u) { if (xb_ld(&bar[XB_TMO])) break; if (sp > XB_SPIN_CAP) { atomicAdd(&bar[XB_TMO], 1u); break; } }
    }
    nloc = mine > 0u ? mine : 1u; nx = cnt > 0u ? cnt : 1u;
}

__device__ __forceinline__ void xcd_barrier(const XcdBarrier& b) {
    asm volatile("s_waitcnt vmcnt(0)" ::: "memory");
    __syncthreads();
    if (threadIdx.x == 0) {
        unsigned* bar = b.bar;
        __builtin_amdgcn_s_waitcnt(0);
        unsigned nloc = b.st[0], nx = b.st[1];
        if (nloc == 0u) { xcd_barrier_complete(bar, b.x, nloc, nx); b.st[0] = nloc; b.st[1] = nx; }
        const unsigned old = xb_add(&bar[XB_XSUB(b.x)], 1u);
        const unsigned gen = old / nloc;
        if (old + 1u == (gen + 1u) * nloc) {
            __builtin_amdgcn_fence(__ATOMIC_RELEASE, "agent");
            asm volatile("s_waitcnt vmcnt(0)" ::: "memory");
            const unsigned og = xb_add(&bar[XB_TOP], 1u);
            const unsigned tg = og / nx;
            if (og + 1u == (tg + 1u) * nx) xb_add(&bar[XB_TOPGEN], 1u);
            else XB_SPIN(xb_ld(&bar[XB_TOPGEN]) == tg, bar);
            __builtin_amdgcn_fence(__ATOMIC_ACQUIRE, "agent");
            xb_add(&bar[XB_XGEN(b.x)], 1u);
            asm volatile("s_waitcnt vmcnt(0)" ::: "memory");
        } else {
            XB_SPIN(xb_ld(&bar[XB_XGEN(b.x)]) == gen, bar);
            __builtin_amdgcn_fence(__ATOMIC_ACQUIRE, "agent");
            asm volatile("s_waitcnt vmcnt(0)" ::: "memory");
        }
    }
    __syncthreads();
}
constexpr int NB = 4, SEQ = 4096, CTXL = 256, TPB = SEQ + CTXL, NROWS = NB * TPB, DM = 1024, NLAYER = 2, IN_COLS = 6816;
constexpr int NWAVES = 8, NTHREADS = NWAVES * 64;
constexpr float RMS_EPS = 1e-6f;
constexpr float LOG2E = 1.4426950408889634f;
constexpr float QSCALE64 = 0.125f * LOG2E;
constexpr float QSCALE96 = 0.10206207261596575f * LOG2E;
constexpr int ZS_P = 1792, ZC_CQ = 0, ZC_CKV = 256, ZC_KR = 384, ZC_SQ = 512, ZC_SK = 768, ZC_SV = 896, ZC_AQ = 1024, ZC_AK = 1280, ZC_AV = 1408, ZC_LRU = 1536;
constexpr int N1 = 2816;
constexpr int W1ROWS = N1 + 4096;
constexpr size_t MiB = 1u << 20;
constexpr size_t WS_CTL = 0, CTL_ZERO_BYTES = 64 * 1024;
constexpr size_t WS_MOD = 1 * MiB;
constexpr size_t WS_RHC = 1 * MiB + 256 * 1024, WS_RHS = WS_RHC + 512 * 1024;
constexpr size_t WS_RMC = WS_RHS + 512 * 1024, WS_RMS = WS_RMC + 256 * 1024;
constexpr size_t WS_CTX1 = 3 * MiB;
constexpr size_t WS_WOS = 3 * MiB;
constexpr size_t WS_W = 8 * MiB, W_LAYER = 18 * MiB;
constexpr size_t WO_W1 = 0, WO_WB = 13 * MiB + 512 * 1024, WO_WO = WO_WB + 2 * MiB, WO_UQ = WO_WO + 2 * MiB, WO_UKV = WO_UQ + 256 * 1024;
constexpr size_t WS_H = 44 * MiB;
constexpr size_t WS_G = 78 * MiB;
constexpr size_t WS_S = 112 * MiB;
constexpr size_t WS_ZS = 112 * MiB;
constexpr size_t WS_MQ = 172 * MiB;
constexpr size_t WS_MKV = 189 * MiB;
constexpr size_t WS_MK = 206 * MiB;
constexpr size_t WS_U = 219 * MiB;
constexpr size_t WS_HF = 236 * MiB;
constexpr size_t WS_SP = 2 * MiB + 768 * 1024;
constexpr size_t WS_LWT = 254 * MiB + 512 * 1024;
constexpr size_t WS_END = 256 * MiB;
static_assert(WS_H + (size_t)NROWS * 1024 * 2 <= WS_G && WS_G + (size_t)NROWS * 1024 * 2 <= WS_S && WS_S + (size_t)NROWS * 4096 * 2 <= 248 * MiB, "ws map");
static_assert(WS_ZS + (size_t)NROWS * ZS_P * 2 <= WS_MQ && WS_MK + (size_t)NROWS * 384 * 2 <= WS_U, "ws map 2");
static_assert(WO_UKV + 512 * 256 * 2 <= W_LAYER, "weights");
constexpr int CW_BAR = 1024;
constexpr int CW_FLG = 8192;

constexpr int RING_OFF = 0, RING_BYTES = 131072, LDSCTL_OFF = RING_BYTES, MISC_OFF = LDSCTL_OFF + 320, LDS_BYTES = 147456;

typedef unsigned short bf16;
typedef unsigned u32x2 __attribute__((ext_vector_type(2)));
typedef float f32x2v __attribute__((ext_vector_type(2)));
__device__ __forceinline__ float bf2f(bf16 v) { return __uint_as_float((unsigned)v << 16); }
template <int O> __device__ __forceinline__ float xor_swz(float v) { return __int_as_float(__builtin_amdgcn_ds_swizzle(__float_as_int(v), (O << 10) | 0x1F)); }
__device__ __forceinline__ float wave_sum(float v) {
    v += xor_swz<1>(v); v += xor_swz<2>(v); v += xor_swz<4>(v); v += xor_swz<8>(v); v += xor_swz<16>(v);
    auto rr = __builtin_amdgcn_permlane32_swap(__float_as_uint(v), __float_as_uint(v), false, false); return __uint_as_float(rr[0]) + __uint_as_float(rr[1]); }
__device__ __forceinline__ float wave_max(float v) {
    v = fmaxf(v, xor_swz<1>(v)); v = fmaxf(v, xor_swz<2>(v)); v = fmaxf(v, xor_swz<4>(v)); v = fmaxf(v, xor_swz<8>(v)); v = fmaxf(v, xor_swz<16>(v));
    auto rr = __builtin_amdgcn_permlane32_swap(__float_as_uint(v), __float_as_uint(v), false, false); return fmaxf(__uint_as_float(rr[0]), __uint_as_float(rr[1])); }
__device__ __forceinline__ float grp16_sum(float v) {
    v += xor_swz<1>(v); v += xor_swz<2>(v); v += xor_swz<4>(v); v += xor_swz<8>(v); return v; }

struct Args { const float* in[28]; float* out; unsigned char* ws; int ph_lo, ph_hi; };
enum { I_X = 0, I_C, I_CTX, I_CCTX, I_WMOD, I_BMOD, I_NORMW, I_WIN, I_CQN, I_CKVN, I_WUQ, I_WUKV, I_MQN, I_MKN, I_SQN, I_SKN, I_SINK, I_AQN, I_AKN,
       I_CONVW, I_CONVB, I_LWR, I_LBR, I_LWI, I_LBI, I_LAM, I_WBR, I_WOUT };

struct Frame {
    LAS unsigned char* lds; const float* const __attribute__((address_space(4)))* kin; unsigned char* ws; float* out;
    int tid, lane, wave, G, vcu, gw, NGW, z;
    __device__ __forceinline__ const float* in(int i) const { return kin[i]; }
};

__device__ __forceinline__ void xpose_item(const float* W, int ldn, int k0, int n0, bf16* WT, int pd, int drow, LAS float* scr, int lane, float scale = 1.0f) {
    float v[32]; const float* wp = W + (size_t)(k0 + (lane >> 5)) * ldn + n0 + (lane & 31);
#pragma unroll
    for (int i = 0; i < 32; ++i) v[i] = wp[(size_t)(2 * i) * ldn];
#pragma unroll
    for (int i = 0; i < 32; ++i) scr[(2 * i + (lane >> 5)) * 33 + (lane & 31)] = v[i];
    LDS_WAIT(); asm volatile("" ::: "memory");
    const int c = lane & 7;
#pragma unroll
    for (int j = 0; j < 4; ++j) { const int n = (lane >> 3) + 8 * j; const LAS float* s = scr + (8 * c) * 33 + n;
        v4u o; o.x = pk2(s[0 * 33] * scale, s[1 * 33] * scale); o.y = pk2(s[2 * 33] * scale, s[3 * 33] * scale); o.z = pk2(s[4 * 33] * scale, s[5 * 33] * scale); o.w = pk2(s[6 * 33] * scale, s[7 * 33] * scale);
        *(GAS v4u*)(WT + (size_t)(drow + n0 + n) * pd + k0 + 8 * c) = o; }
    LDS_WAIT(); asm volatile("" ::: "memory");
}
__device__ __forceinline__ void zero16(bf16* p, size_t n16, int gt, int ngt) {
    for (size_t i = gt; i < n16; i += ngt) ((GAS v4u*)p)[i] = (v4u){0u, 0u, 0u, 0u};
}
constexpr int N1T = 2816 / 32;
constexpr int I_EARLY = 16 * N1T + 4 * 12 + 2 * 16, I_INL = 16 * (213 - N1T), I_BR = 4 * 4 * 32, I_OUT = 16 * 32, I_LAYER = I_EARLY + I_INL + I_BR + I_OUT, I_SPLIT = 16 * 32;
__device__ __forceinline__ void copy_item(Frame& F, int l, int r, LAS float* scr) {
    unsigned char* wl = F.ws + WS_W + (size_t)l * W_LAYER;
    if (r < 16 * N1T) { const int kb = r / N1T, nb = r % N1T, n0 = nb * 32;
        xpose_item(F.in(I_WIN) + (size_t)l * 1024 * IN_COLS, IN_COLS, kb * 64, n0, (bf16*)(wl + WO_W1), 1024, n0 >= 416 ? 96 : 0, scr, F.lane, n0 >= N1 - 96 ? LOG2E : 1.0f); return; } r -= 16 * N1T;
    if (r < 4 * 12) { const int kb = r / 12, nb = r % 12;
        xpose_item(F.in(I_WUQ) + (size_t)l * 256 * 384, 384, kb * 64, nb * 32, (bf16*)(wl + WO_UQ), 256, 0, scr, F.lane); return; } r -= 4 * 12;
    if (r < 2 * 16) { const int kb = r / 16, nb = r % 16;
        xpose_item(F.in(I_WUKV) + (size_t)l * 128 * 512, 512, kb * 64, nb * 32, (bf16*)(wl + WO_UKV), 256, 0, scr, F.lane); return; } r -= 2 * 16;
    if (r < I_INL) { const int kb = r / (213 - N1T), nb = N1T + r % (213 - N1T), n0 = nb * 32;
        xpose_item(F.in(I_WIN) + (size_t)l * 1024 * IN_COLS, IN_COLS, kb * 64, n0, (bf16*)(wl + WO_W1), 1024, 96, scr, F.lane, LOG2E); return; } r -= I_INL;
    if (r < I_BR) { const int k = r / 128, rr = r % 128, kb = rr / 32, nb = rr % 32;
        xpose_item(F.in(I_WBR) + ((size_t)l * 4 + k) * 256 * 1024, 1024, kb * 64, nb * 32, (bf16*)(wl + WO_WB) + (size_t)k * 1024 * 256, 256, 0, scr, F.lane); return; } r -= I_BR;
    if (r < I_OUT) { const int kb = r / 32, nb = r % 32;
        xpose_item(F.in(I_WOUT) + (size_t)l * 1024 * 1024, 1024, kb * 64, nb * 32, (bf16*)(wl + WO_WO), 1024, 0, scr, F.lane); return; } r -= I_OUT;
    if (r < I_SPLIT) { const int kb = r / 32, nb = r % 32, kq = kb >> 2;
        xpose_item(F.in(I_WOUT), 1024, kb * 64, nb * 32, (bf16*)(F.ws + WS_WOS) + (size_t)kq * (1024 * 256 - 256), 256, 0, scr, F.lane); }
}
__device__ __forceinline__ void weight_copies(Frame& F, int first, int stride, int loA, int nA, int loB, int nB) {
    LAS float* scr = (LAS float*)(F.lds + RING_OFF + F.wave * 16384);
#pragma unroll 1
    for (int v = first; v < nA + nB; v += stride) { const bool a = v < nA; copy_item(F, a ? 0 : NLAYER - 1, a ? loA + v : loB + v - nA, scr); }
}
constexpr int IC_G1 = 320;
__device__ __forceinline__ void p0_tables(Frame& F, int gt, int ngt) {
    { float* rhc = (float*)(F.ws + WS_RHC); float* rhs = (float*)(F.ws + WS_RHS); float* rmc = (float*)(F.ws + WS_RMC); float* rms = (float*)(F.ws + WS_RMS);
      constexpr float L2_10000 = 13.287712379549449f, INV_2PI = 0.15915494309189535f;
      for (int i = gt; i < 4096 * 32; i += ngt) { const int t = i >> 5, p = i & 31; const float fr = __builtin_amdgcn_exp2f(-(float)(p & 15) * (L2_10000 / 16.0f));
          const float pos = (float)((p < 16) ? (t >> 6) : (t & 63)); const float rev = pos * fr * INV_2PI; rhc[i] = __builtin_amdgcn_cosf(rev); rhs[i] = __builtin_amdgcn_sinf(rev); }
      for (int i = gt; i < 4096 * 16; i += ngt) { const int t = i >> 4, p = i & 15; const float fr = __builtin_amdgcn_exp2f(-(float)(p & 7) * (L2_10000 / 8.0f));
          const float pos = (float)((p < 8) ? (t >> 6) : (t & 63)); const float rev = pos * fr * INV_2PI; rmc[i] = __builtin_amdgcn_cosf(rev); rms[i] = __builtin_amdgcn_sinf(rev); } }
    { float* sp = (float*)(F.ws + WS_SP); for (int i = gt; i < NLAYER * 2 * 256; i += ngt) sp[i] = 8.0f * LOG2E * log1pf(expf(-F.in(I_LAM)[i])); }
    { float* lwt = (float*)(F.ws + WS_LWT);
      for (int o = gt; o < NLAYER * 2 * 2 * 256 * 64; o += ngt) { const int i = o & 63, c = (o >> 6) & 255, gate = (o >> 14) & 1, ld = o >> 15, k = c >> 6, j = c & 63;
          lwt[o] = (gate == 0 ? F.in(I_LWR) : F.in(I_LWI))[(((size_t)ld * 4 + k) * 64 + i) * 64 + j]; } }
}
__device__ __forceinline__ void p0_prologue(Frame& F) {
    weight_copies(F, F.gw, F.NGW, 0, I_EARLY, 0, 0);
    const int gt = F.vcu * NTHREADS + F.tid, ngt = F.G * NTHREADS;
    for (int l = 0; l < NLAYER; ++l) {
        unsigned char* wl = F.ws + WS_W + (size_t)l * W_LAYER;
        zero16((bf16*)(wl + WO_W1) + (size_t)416 * 1024, 96 * 1024 * 2 / 16, gt, ngt);
        zero16((bf16*)(wl + WO_UQ) + (size_t)384 * 256, 128 * 256 * 2 / 16, gt, ngt);
        for (int i = gt; i < 512 * 16; i += ngt) { const int n = i >> 4, c = i & 15; ((GAS v4u*)((bf16*)(wl + WO_UKV) + (size_t)n * 256 + 128))[c] = (v4u){0u, 0u, 0u, 0u}; }
    }
    { LAS float* sc = (LAS float*)(F.lds + RING_OFF);
      LAS float* red = sc + 5 * 1024;
      __syncthreads();
      for (int i = F.tid; i < 5 * 1024; i += NTHREADS) { const float v = (i < 4096) ? F.in(I_C)[i] : F.in(I_CCTX)[i - 4096]; sc[i] = v / (1.0f + expf(-v)); }
      __syncthreads();
      float* modv = (float*)(F.ws + WS_MOD);
      for (int it = F.vcu; it < NLAYER * 96; it += F.G) {
          const int l = it / 96, n0 = (it % 96) * 32, nn = F.tid & 31, kc = F.tid >> 5;
          const float* w = F.in(I_WMOD) + (size_t)l * 1024 * 3072 + n0 + nn;
          float acc[5] = {0.f, 0.f, 0.f, 0.f, 0.f};
#pragma unroll 1
          for (int k0 = kc * 64; k0 < kc * 64 + 64; k0 += 32) { float wv[32];
#pragma unroll
              for (int i = 0; i < 32; ++i) wv[i] = w[(size_t)(k0 + i) * 3072];
#pragma unroll
              for (int i = 0; i < 32; ++i)
#pragma unroll
                  for (int r = 0; r < 5; ++r) acc[r] += sc[r * 1024 + k0 + i] * wv[i]; }
#pragma unroll
          for (int r = 0; r < 5; ++r) red[(kc * 5 + r) * 32 + nn] = acc[r];
          __syncthreads();
          if (F.tid < 160) { const int r = F.tid >> 5; float s = 0.f;
              for (int q = 0; q < 16; ++q) s += red[(q * 5 + r) * 32 + nn];
              modv[((size_t)l * 5 + r) * 3072 + n0 + nn] = s + F.in(I_BMOD)[l * 3072 + n0 + nn]; }
          __syncthreads();
      } }
}

struct HRow { f32x4 v[4], sh[4], sc[4]; int row; };
__device__ __forceinline__ void hnorm_load(Frame& F, int l, int row, const float* xs, const float* cs, const float* modl, HRow& R) {
    const int b = row / TPB, j = row % TPB; const float* src; int mr;
    if (j < CTXL) { src = cs + ((size_t)b * CTXL + j) * 1024; mr = 4; } else { src = xs + ((size_t)b * SEQ + (j - CTXL)) * 1024; mr = b; }
    const GAS f32x4* xr = (const GAS f32x4*)src + F.lane; const float* mrow = modl + mr * 3072 + 4 * F.lane;
#pragma unroll
    for (int q = 0; q < 4; ++q) { R.v[q] = xr[64 * q]; R.sh[q] = *(const f32x4*)(mrow + 256 * q); R.sc[q] = *(const f32x4*)(mrow + 1024 + 256 * q); }
    R.row = row;
}
__device__ __forceinline__ void hnorm_finish(Frame& F, const HRow& R, const f32x4 (&g)[4], bf16* H) {
    float ss = 0.f;
#pragma unroll
    for (int q = 0; q < 4; ++q) ss += (R.v[q].x * R.v[q].x + R.v[q].y * R.v[q].y) + (R.v[q].z * R.v[q].z + R.v[q].w * R.v[q].w);
    const float rstd = 1.0f / sqrtf(wave_sum(ss) * (1.0f / 1024.0f) + RMS_EPS);
    GAS unsigned long long* o8 = (GAS unsigned long long*)(H + (size_t)R.row * 1024) + F.lane;
#pragma unroll
    for (int q = 0; q < 4; ++q) { const f32x4 h = R.v[q] * rstd * g[q] * (R.sc[q] + 1.0f) + R.sh[q];
        o8[64 * q] = (unsigned long long)pk2(h.x, h.y) | ((unsigned long long)pk2(h.z, h.w) << 32); }
}
__device__ __forceinline__ void ph_hnorm(Frame& F, int l) {
    const float* xs = (l == 0) ? F.in(I_X) : F.out; const float* cs = F.in(I_CTX);
    const float* nw = F.in(I_NORMW) + l * 1024; const float* modl = (const float*)(F.ws + WS_MOD) + (size_t)l * 5 * 3072;
    bf16* H = (bf16*)(F.ws + WS_H);
    f32x4 g[4];
#pragma unroll
    for (int q = 0; q < 4; ++q) g[q] = *(const f32x4*)(nw + 4 * F.lane + 256 * q);
    if (l > 0) {
        for (int cr = F.gw; cr < NB * CTXL; cr += F.NGW) { const int b = cr / CTXL, j = cr % CTXL, row = b * TPB + j;
            const unsigned short* P = (const unsigned short*)(F.ws + WS_S) + (size_t)row * 4096 + 4 * F.lane;
            const float* gt = (const float*)(F.ws + WS_MOD) + 4 * 3072 + 2048 + 4 * F.lane;
            const GAS f32x4* c0 = (const GAS f32x4*)(cs + ((size_t)b * CTXL + j) * 1024) + F.lane;
            const float* mrow = modl + 4 * 3072 + 4 * F.lane;
            HRow R; R.row = row;
#pragma unroll
            for (int q = 0; q < 4; ++q) { f32x4 a = {0.f, 0.f, 0.f, 0.f};
#pragma unroll
                for (int kq = 0; kq < 4; ++kq) { const u32x2 w = *(const u32x2*)(P + kq * 1024 + 256 * q); a.x += bflo(w.x); a.y += bfhi(w.x); a.z += bflo(w.y); a.w += bfhi(w.y); }
                R.v[q] = c0[64 * q] + *(const f32x4*)(gt + 256 * q) * a; R.sh[q] = *(const f32x4*)(mrow + 256 * q); R.sc[q] = *(const f32x4*)(mrow + 1024 + 256 * q); }
            hnorm_finish(F, R, g, H); }
    }
    const int n = (l == 0) ? NROWS : NB * SEQ;
#define HN_ROW(i_) ((l == 0) ? (i_) : ((i_) / SEQ) * TPB + CTXL + (i_) % SEQ)
    HRow A, B; int i = F.gw;
    if (i < n) hnorm_load(F, l, HN_ROW(i), xs, cs, modl, A);
    for (; i < n; i += 2 * F.NGW) {
        const int i1 = i + F.NGW, i2 = i + 2 * F.NGW;
        if (i1 < n) hnorm_load(F, l, HN_ROW(i1), xs, cs, modl, B);
        hnorm_finish(F, A, g, H);
        if (i2 < n) hnorm_load(F, l, HN_ROW(i2), xs, cs, modl, A);
        if (i1 < n) hnorm_finish(F, B, g, H);
    }
#undef HN_ROW
}

struct P1Regs { u32x2 cq; unsigned ckv, h[3][2]; float rc[2], rs[2]; };
__device__ __forceinline__ void post1_load(const bf16* z, const float* rc, const float* rs, bool lat, int lane, P1Regs& R) {
    const int hg = lane >> 4, p0 = (lane & 15) * 2;
    R.cq = *(const u32x2*)(z + ZC_CQ + 4 * lane); R.ckv = *(const unsigned*)(z + ZC_CKV + 2 * lane);
    const bf16* h0 = z + ZC_SQ + hg * 64 + p0; const bf16* h1 = z + ZC_AQ + hg * 64 + p0; const bf16* h2 = z + ((hg < 2) ? (ZC_SK + hg * 64) : (ZC_AK + (hg - 2) * 64)) + p0;
    R.h[0][0] = *(const unsigned*)h0; R.h[0][1] = *(const unsigned*)(h0 + 32); R.h[1][0] = *(const unsigned*)h1; R.h[1][1] = *(const unsigned*)(h1 + 32); R.h[2][0] = *(const unsigned*)h2; R.h[2][1] = *(const unsigned*)(h2 + 32);
    if (lat) { R.rc[0] = rc[p0]; R.rc[1] = rc[p0 + 1]; R.rs[0] = rs[p0]; R.rs[1] = rs[p0 + 1]; } else { R.rc[0] = 1.f; R.rc[1] = 1.f; R.rs[0] = 0.f; R.rs[1] = 0.f; }
}
__device__ __forceinline__ void post1_finish(bf16* z, int lane, const P1Regs& R, const float (&gcq)[4], const float (&gckv)[2], const float (&gh)[3][4]) {
    const int hg = lane >> 4, p0 = (lane & 15) * 2;
    { float v0 = bflo(R.cq.x), v1 = bfhi(R.cq.x), v2 = bflo(R.cq.y), v3 = bfhi(R.cq.y);
      const float rstd = 1.0f / sqrtf(wave_sum(v0 * v0 + v1 * v1 + v2 * v2 + v3 * v3) * (1.0f / 256.0f) + RMS_EPS);
      u32x2 w; w.x = pk2(v0 * rstd * gcq[0], v1 * rstd * gcq[1]); w.y = pk2(v2 * rstd * gcq[2], v3 * rstd * gcq[3]); *(u32x2*)(z + ZC_CQ + 4 * lane) = w; }
    { float v0 = bflo(R.ckv), v1 = bfhi(R.ckv);
      const float rstd = 1.0f / sqrtf(wave_sum(v0 * v0 + v1 * v1) * (1.0f / 128.0f) + RMS_EPS);
      *(unsigned*)(z + ZC_CKV + 2 * lane) = pk2(v0 * rstd * gckv[0], v1 * rstd * gckv[1]); }
#pragma unroll
    for (int q = 0; q < 3; ++q) {
        bf16* hp = z + ((q == 0) ? (ZC_SQ + hg * 64) : (q == 1) ? (ZC_AQ + hg * 64) : ((hg < 2) ? (ZC_SK + hg * 64) : (ZC_AK + (hg - 2) * 64))) + p0;
        float a0 = bflo(R.h[q][0]), a1 = bfhi(R.h[q][0]), b0 = bflo(R.h[q][1]), b1 = bfhi(R.h[q][1]);
        const float rstd = 1.0f / sqrtf(grp16_sum(a0 * a0 + a1 * a1 + b0 * b0 + b1 * b1) * (1.0f / 64.0f) + RMS_EPS);
        a0 *= rstd * gh[q][0]; a1 *= rstd * gh[q][1]; b0 *= rstd * gh[q][2]; b1 *= rstd * gh[q][3];
        const float x0 = a0 * R.rc[0] - b0 * R.rs[0], y0 = b0 * R.rc[0] + a0 * R.rs[0], x1 = a1 * R.rc[1] - b1 * R.rs[1], y1 = b1 * R.rc[1] + a1 * R.rs[1];
        const float sc = (q < 2) ? QSCALE64 : 1.0f;
        *(unsigned*)hp = pk2(x0 * sc, x1 * sc); *(unsigned*)(hp + 32) = pk2(y0 * sc, y1 * sc);
    }
}
__device__ __forceinline__ void ph_post1(Frame& F, int l) {
    bf16* ZS = (bf16*)(F.ws + WS_ZS);
    const float* rhc = (const float*)(F.ws + WS_RHC); const float* rhs = (const float*)(F.ws + WS_RHS);
    const int lane = F.lane, hg = lane >> 4, p0 = (lane & 15) * 2;
    float gcq[4], gckv[2], gh[3][4];
#pragma unroll
    for (int i = 0; i < 4; ++i) gcq[i] = F.in(I_CQN)[l * 256 + 4 * lane + i];
    gckv[0] = F.in(I_CKVN)[l * 128 + 2 * lane]; gckv[1] = F.in(I_CKVN)[l * 128 + 2 * lane + 1];
    { const float* g0 = F.in(I_SQN) + l * 64; const float* g1 = F.in(I_AQN) + l * 64; const float* g2 = ((hg < 2) ? F.in(I_SKN) : F.in(I_AKN)) + l * 64;
      gh[0][0] = g0[p0]; gh[0][1] = g0[p0 + 1]; gh[0][2] = g0[32 + p0]; gh[0][3] = g0[33 + p0];
      gh[1][0] = g1[p0]; gh[1][1] = g1[p0 + 1]; gh[1][2] = g1[32 + p0]; gh[1][3] = g1[33 + p0];
      gh[2][0] = g2[p0]; gh[2][1] = g2[p0 + 1]; gh[2][2] = g2[32 + p0]; gh[2][3] = g2[33 + p0]; }
#define P1_LOAD(R_, row_) do { const int j_ = (row_) % TPB; const bool lat_ = j_ >= CTXL; const int pos_ = lat_ ? j_ - CTXL : 0; post1_load(ZS + (size_t)(row_) * ZS_P, rhc + pos_ * 32, rhs + pos_ * 32, lat_, lane, R_); } while (0)
    P1Regs A, B; int row = F.gw;
    if (row < NROWS) P1_LOAD(A, row);
    for (; row < NROWS; row += 2 * F.NGW) {
        const int row1 = row + F.NGW, row2 = row + 2 * F.NGW;
        if (row1 < NROWS) P1_LOAD(B, row1);
        post1_finish(ZS + (size_t)row * ZS_P, lane, A, gcq, gckv, gh);
        if (row2 < NROWS) P1_LOAD(A, row2);
        if (row1 < NROWS) post1_finish(ZS + (size_t)row1 * ZS_P, lane, B, gcq, gckv, gh);
    }
#undef P1_LOAD
}
struct P2Regs { u32x2 qn, kn; bf16 q1, q2, k1, k2; float c, s; };
__device__ __forceinline__ void post2_load(const bf16* zrow, const bf16* mq, const bf16* mkv, const float* rc, const float* rs, bool lat, int lane, P2Regs& R) {
    const int h = lane >> 4, j = lane & 15;
    R.qn = *(const u32x2*)(mq + h * 96 + 4 * j); R.q1 = mq[h * 96 + 64 + j]; R.q2 = mq[h * 96 + 80 + j];
    R.kn = *(const u32x2*)(mkv + h * 128 + 4 * j); R.k1 = zrow[ZC_KR + j]; R.k2 = zrow[ZC_KR + 16 + j];
    if (lat) { R.c = rc[j]; R.s = rs[j]; } else { R.c = 1.f; R.s = 0.f; }
}
__device__ __forceinline__ void post2_finish(bf16* mq, bf16* mk, int lane, const P2Regs& R, const float (&gq)[6], const float (&gk)[6]) {
    const int h = lane >> 4, j = lane & 15;
#pragma unroll
    for (int qk = 0; qk < 2; ++qk) {
        const u32x2 n = qk == 0 ? R.qn : R.kn; float v0 = bflo(n.x), v1 = bfhi(n.x), v2 = bflo(n.y), v3 = bfhi(n.y), r1 = bf2f(qk == 0 ? R.q1 : R.k1), r2 = bf2f(qk == 0 ? R.q2 : R.k2);
        const float rstd = 1.0f / sqrtf(grp16_sum(v0 * v0 + v1 * v1 + v2 * v2 + v3 * v3 + r1 * r1 + r2 * r2) * (1.0f / 96.0f) + RMS_EPS);
        const float (&g)[6] = qk == 0 ? gq : gk; const float sc = qk == 0 ? QSCALE96 : 1.0f;
        const float y1 = r1 * rstd * g[4], y2 = r2 * rstd * g[5];
        const float t1 = (y1 * R.c - y2 * R.s) * sc, t2 = (y2 * R.c + y1 * R.s) * sc;
        bf16* o = (qk == 0 ? mq : mk) + h * 96;
        u32x2 w; w.x = pk2(v0 * rstd * g[0] * sc, v1 * rstd * g[1] * sc); w.y = pk2(v2 * rstd * g[2] * sc, v3 * rstd * g[3] * sc);
        *(u32x2*)(o + 4 * j) = w; o[64 + j] = (bf16)f2bf(t1); o[80 + j] = (bf16)f2bf(t2);
    }
}
__device__ __forceinline__ void ph_post2(Frame& F, int l) {
    const bf16* ZS = (const bf16*)(F.ws + WS_ZS); bf16* MQ = (bf16*)(F.ws + WS_MQ); const bf16* MKV = (const bf16*)(F.ws + WS_MKV); bf16* MK = (bf16*)(F.ws + WS_MK);
    const float* rmc = (const float*)(F.ws + WS_RMC); const float* rms = (const float*)(F.ws + WS_RMS);
    const int lane = F.lane, jj = lane & 15;
    float gq[6], gk[6];
    { const float* a = F.in(I_MQN) + l * 96; const float* b = F.in(I_MKN) + l * 96;
#pragma unroll
      for (int i = 0; i < 4; ++i) { gq[i] = a[4 * jj + i]; gk[i] = b[4 * jj + i]; }
      gq[4] = a[64 + jj]; gq[5] = a[80 + jj]; gk[4] = b[64 + jj]; gk[5] = b[80 + jj]; }
    for (int row = F.gw; row < NROWS; row += 2 * F.NGW) {
        const int row2 = row + F.NGW; const bool has2 = row2 < NROWS; const size_t rb = has2 ? row2 : row;
        const int j = row % TPB; const bool lat = j >= CTXL; const int pos = lat ? j - CTXL : 0;
        const int j2 = (int)(rb % TPB); const bool lat2 = j2 >= CTXL; const int pos2 = lat2 ? j2 - CTXL : 0;
        P2Regs A, B;
        post2_load(ZS + (size_t)row * ZS_P, MQ + (size_t)row * 512, MKV + (size_t)row * 512, rmc + pos * 16, rms + pos * 16, lat, lane, A);
        if (has2) post2_load(ZS + rb * ZS_P, MQ + rb * 512, MKV + rb * 512, rmc + pos2 * 16, rms + pos2 * 16, lat2, lane, B);
        post2_finish(MQ + (size_t)row * 512, MK + (size_t)row * 384, lane, A, gq, gk);
        if (has2) post2_finish(MQ + rb * 512, MK + rb * 384, lane, B, gq, gk);
    }
}

template <int DQK>
__device__ __forceinline__ void attn_row_naive(const bf16* q, const bf16* Kb, int kp, const bf16* Vb, int vp, int n1, int lo2, int hi2, bool has_sink, float sink2, bf16* y, int lane) {
    float qf[DQK];
#pragma unroll
    for (int c = 0; c < DQK / 8; ++c) { const v4u w = *(const v4u*)(q + 8 * c);
        qf[8 * c + 0] = bflo(w.x); qf[8 * c + 1] = bfhi(w.x); qf[8 * c + 2] = bflo(w.y); qf[8 * c + 3] = bfhi(w.y); qf[8 * c + 4] = bflo(w.z); qf[8 * c + 5] = bfhi(w.z); qf[8 * c + 6] = bflo(w.w); qf[8 * c + 7] = bfhi(w.w); }
    float m = -INFINITY, l = 0.f; float acc[64];
#pragma unroll
    for (int d = 0; d < 64; ++d) acc[d] = 0.f;
    for (int seg = 0; seg < 2; ++seg) {
        const int k0 = seg == 0 ? 0 : lo2, k1 = seg == 0 ? n1 : hi2;
        for (int key = k0 + lane; key < k1; key += 64) {
            const bf16* kr = Kb + (size_t)key * kp; float s = 0.f;
#pragma unroll
            for (int c = 0; c < DQK / 8; ++c) { const v4u w = *(const v4u*)(kr + 8 * c);
                s += qf[8 * c + 0] * bflo(w.x) + qf[8 * c + 1] * bfhi(w.x) + qf[8 * c + 2] * bflo(w.y) + qf[8 * c + 3] * bfhi(w.y) + qf[8 * c + 4] * bflo(w.z) + qf[8 * c + 5] * bfhi(w.z) + qf[8 * c + 6] * bflo(w.w) + qf[8 * c + 7] * bfhi(w.w); }
            if (s > m) { const float f = exp2f(m - s); l *= f;
#pragma unroll
                for (int d = 0; d < 64; ++d) acc[d] *= f;
                m = s; }
            const float p = exp2f(s - m); l += p;
            const bf16* vr = Vb + (size_t)key * vp;
#pragma unroll
            for (int c = 0; c < 8; ++c) { const v4u w = *(const v4u*)(vr + 8 * c);
                acc[8 * c + 0] += p * bflo(w.x); acc[8 * c + 1] += p * bfhi(w.x); acc[8 * c + 2] += p * bflo(w.y); acc[8 * c + 3] += p * bfhi(w.y); acc[8 * c + 4] += p * bflo(w.z); acc[8 * c + 5] += p * bfhi(w.z); acc[8 * c + 6] += p * bflo(w.w); acc[8 * c + 7] += p * bfhi(w.w); }
        }
    }
    float M = wave_max(m); if (has_sink) M = fmaxf(M, sink2);
    const float f = (m == -INFINITY) ? 0.f : exp2f(m - M);
    float L = wave_sum(l * f); if (has_sink) L += exp2f(sink2 - M);
    float mine = 0.f;
#pragma unroll
    for (int d = 0; d < 64; ++d) { const float t = wave_sum(acc[d] * f); if (lane == d) mine = t; }
    y[lane] = (bf16)f2bf(mine / L * bf2f(y[lane]));
}
__device__ __forceinline__ void ph_attn_naive(Frame& F, int l) {
    const bf16* ZS = (const bf16*)(F.ws + WS_ZS); const bf16* MQ = (const bf16*)(F.ws + WS_MQ); const bf16* MKV = (const bf16*)(F.ws + WS_MKV); const bf16* MK = (const bf16*)(F.ws + WS_MK);
    bf16* Y = (bf16*)(F.ws + WS_G);
    const long nitems = (long)NROWS * 12;
    for (long it = F.gw; it < nitems; it += F.NGW) {
        const int hb = (int)(it % 12); const int row = (int)(it / 12);
        const int b = row / TPB, j = row % TPB; const bool lat = j >= CTXL;
        if (!lat && l == NLAYER - 1) continue;
        const size_t r0 = (size_t)b * TPB;
        const int br = hb >> 2, h = hb & 3;
        bf16* y = Y + (size_t)row * 1024 + br * 256 + h * 64;
        if (br == 0) {
            attn_row_naive<96>(MQ + (size_t)row * 512 + h * 96, MK + r0 * 384 + h * 96, 384, MKV + r0 * 512 + h * 128 + 64, 512, CTXL, CTXL, lat ? TPB : CTXL, false, 0.f, y, F.lane);
        } else if (br == 1) {
            const int t = j - CTXL; int lo = CTXL, hi = CTXL;
            if (lat) { lo = CTXL + (t - 128 < 0 ? 0 : t - 128); hi = CTXL + (t + 128 > SEQ - 1 ? SEQ - 1 : t + 128) + 1; }
            attn_row_naive<64>(ZS + (size_t)row * ZS_P + ZC_SQ + h * 64, ZS + r0 * ZS_P + ZC_SK + (h >> 1) * 64, ZS_P, ZS + r0 * ZS_P + ZC_SV + (h >> 1) * 64, ZS_P, CTXL, lo, hi, true, F.in(I_SINK)[l * 4 + h] * LOG2E, y, F.lane);
        } else {
            attn_row_naive<64>(ZS + (size_t)row * ZS_P + ZC_AQ + h * 64, ZS + r0 * ZS_P + ZC_AK + (h >> 1) * 64, ZS_P, ZS + r0 * ZS_P + ZC_AV + (h >> 1) * 64, ZS_P, CTXL, CTXL, lat ? TPB : CTXL, false, 0.f, y, F.lane);
        }
    }
}

__device__ __forceinline__ void ph_lru_conv(Frame& F, int l) {
    const bf16* ZS = (const bf16*)(F.ws + WS_ZS); float* U = (float*)(F.ws + WS_U);
    const float* cw = F.in(I_CONVW) + l * 4 * 256; const float* cb = F.in(I_CONVB) + l * 256;
    const int gt = F.vcu * NTHREADS + F.tid, ngt = F.G * NTHREADS;
    for (int idx = gt; idx < NROWS * 256; idx += ngt) {
        const int row = idx >> 8, c = idx & 255, b = row / TPB, j = row % TPB;
        int s0, len, jj; if (j < CTXL) { s0 = b * TPB; len = CTXL; jj = j; } else { s0 = b * TPB + CTXL; len = SEQ; jj = j - CTXL; }
        float acc = cb[c];
#pragma unroll
        for (int i = 0; i < 4; ++i) { const int t = jj + i - 2; if (t >= 0 && t < len) acc += cw[i * 256 + c] * bf2f(ZS[(size_t)(s0 + t) * ZS_P + ZC_LRU + c]); }
        U[idx] = acc;
    }
}
__device__ __forceinline__ void ph_lru_scan(Frame& F, int l, int dir) {
    const float* U = (const float*)(F.ws + WS_U); float* HF = (float*)(F.ws + WS_HF); bf16* Y = (bf16*)(F.ws + WS_G);
    const int g = blockIdx.x * NTHREADS + F.tid;
    if (g < NB * 256) {
    const int b = g >> 8, c = g & 255, k = c >> 6, jc = c & 63;
    const float* wr = F.in(I_LWR) + ((((size_t)l * 2 + dir) * 4 + k) * 64) * 64 + jc;
    const float* wi = F.in(I_LWI) + ((((size_t)l * 2 + dir) * 4 + k) * 64) * 64 + jc;
    float wrr[64], wii[64];
#pragma unroll
    for (int i = 0; i < 64; ++i) { wrr[i] = wr[i * 64]; wii[i] = wi[i * 64]; }
    const float br = F.in(I_LBR)[(l * 2 + dir) * 256 + c], bi = F.in(I_LBI)[(l * 2 + dir) * 256 + c];
    const float lam = F.in(I_LAM)[(l * 2 + dir) * 256 + c];
    const float sp = log1pf(expf(-lam));
    float h = 0.f;
    for (int s = 0; s < TPB; ++s) {
        const int j = dir == 0 ? s : (s < CTXL ? CTXL - 1 - s : TPB + CTXL - 1 - s);
        const size_t row = (size_t)b * TPB + j;
        const float* ub = U + row * 256 + k * 64;
        float rp = br, ip = bi;
#pragma unroll
        for (int i = 0; i < 64; ++i) { const float uv = ub[i]; rp += uv * wrr[i]; ip += uv * wii[i]; }
        const float r = 1.0f / (1.0f + expf(-rp)), ig = 1.0f / (1.0f + expf(-ip));
        const float la = -8.0f * r * sp; const float a = expf(la);
        const float bx = sqrtf(-expm1f(2.0f * la)) * (ig * ub[jc]);
        h = a * h + bx;
        if (dir == 0) HF[row * 256 + c] = h;
        else { bf16* y = Y + row * 1024 + 768 + c; *y = (bf16)f2bf((HF[row * 256 + c] + h) * bf2f(*y)); }
    }
    }
}
__device__ __forceinline__ void ph_mixsum_ctx(Frame& F) {
    const bf16* S = (const bf16*)(F.ws + WS_S); bf16* MIX = (bf16*)(F.ws + WS_H);
    const int gt = F.vcu * NTHREADS + F.tid, ngt = F.G * NTHREADS;
    for (int idx = gt; idx < NB * CTXL * 128; idx += ngt) {
        const int r = idx >> 7, c8 = (idx & 127) * 8; const size_t row = (size_t)(r >> 8) * TPB + (r & 255); float s[8] = {0.f, 0.f, 0.f, 0.f, 0.f, 0.f, 0.f, 0.f};
#pragma unroll
        for (int k = 0; k < 4; ++k) { const v4u w = *(const GAS v4u*)(S + row * 4096 + k * 1024 + c8);
            s[0] += bflo(w.x); s[1] += bfhi(w.x); s[2] += bflo(w.y); s[3] += bfhi(w.y); s[4] += bflo(w.z); s[5] += bfhi(w.z); s[6] += bflo(w.w); s[7] += bfhi(w.w); }
        v4u o; o.x = pk2(s[0], s[1]); o.y = pk2(s[2], s[3]); o.z = pk2(s[4], s[5]); o.w = pk2(s[6], s[7]);
        *(GAS v4u*)(MIX + row * 1024 + c8) = o;
    }
}
namespace att {
typedef short bf16x8 __attribute__((ext_vector_type(8)));
typedef short s16x4 __attribute__((ext_vector_type(4)));
typedef short v4i16_t __attribute__((ext_vector_type(4)));
typedef float f32x16 __attribute__((ext_vector_type(16)));
typedef unsigned u32x4 __attribute__((ext_vector_type(4)));
typedef __attribute__((address_space(3))) const char* lds_cptr;
typedef float f32x2_t __attribute__((ext_vector_type(2))); typedef __bf16 bf16x2_t __attribute__((ext_vector_type(2)));
__device__ __forceinline__ int crow(int r, int hi) { return (r & 3) + 8 * (r >> 2) + 4 * hi; }
__device__ __forceinline__ void glds16(const void* gsrc, unsigned lds_dst) { unsigned keep;
    asm volatile("s_mov_b32 %0, m0\n\ts_mov_b32 m0, %2\n\ts_nop 0\n\tglobal_load_lds_dwordx4 %1, off\n\ts_mov_b32 m0, %0" : "=&s"(keep) : "v"(gsrc), "s"(lds_dst) : "memory"); }
__device__ __forceinline__ unsigned cvtpk(float lo, float hi) { f32x2_t v = {lo, hi}; bf16x2_t b = __builtin_convertvector(v, bf16x2_t); return __builtin_bit_cast(unsigned, b); }
__device__ __forceinline__ s16x4 vtr(lds_cptr p) { return __builtin_bit_cast(s16x4, __builtin_amdgcn_ds_read_tr16_b64_v4i16((__attribute__((address_space(3))) v4i16_t*)p)); }
__device__ __forceinline__ float halfswap_max(float m) { auto rr = __builtin_amdgcn_permlane32_swap(__float_as_uint(m), __float_as_uint(m), false, false); return fmaxf(__uint_as_float(rr[0]), __uint_as_float(rr[1])); }
__device__ __forceinline__ float halfswap_sum(float m) { auto rr = __builtin_amdgcn_permlane32_swap(__float_as_uint(m), __float_as_uint(m), false, false); return __uint_as_float(rr[0]) + __uint_as_float(rr[1]); }

template <int DQK> struct Cfg {
    static constexpr int KCH = DQK / 8, KSLOT = KCH * 1024, NKI = (KCH + 7) / 8, NI = NKI + 1;
    static constexpr int LDS_K = 0, LDS_V = 3 * KSLOT, LDS_WS = LDS_V + 3 * 8192, LDS_OST = LDS_WS + 8 * 256, BYTES = LDS_OST + 8 * 4096;
};
#define ATT_WAIT_BAR(N) asm volatile("s_waitcnt vmcnt(" #N ") lgkmcnt(0)\n\ts_barrier" ::: "memory")

struct UnitDesc {
    const unsigned short* Q; int qp;
    const unsigned short* K; int kp;
    const unsigned short* V; int vp;
    unsigned short* Y;
    int NT;
    int lat_row0;
    int qpos0, spos0;
    int has_sink; float sink2;
};

template <int DQK, bool SWA>
__device__ __forceinline__ void attn_unit(LAS unsigned char* ldsb, const UnitDesc& U, const int tid) {
    using C = Cfg<DQK>;
    const int lane = tid & 63, r32 = lane & 31, hi = lane >> 5; const int wid = __builtin_amdgcn_readfirstlane(tid >> 6);
    const unsigned lds0 = (unsigned)(uintptr_t)ldsb;
    LAS float* wsf = (LAS float*)(ldsb + C::LDS_WS) + wid * 64;
    const int kp = U.kp, vp = U.vp;
    const int kc1 = (C::NKI == 2 && wid < 4) ? wid + 8 : wid;
    const unsigned short* ksrc0 = U.K + (size_t)lane * kp + wid * 8;
    const unsigned short* ksrc1 = U.K + (size_t)lane * kp + kc1 * 8;
    const unsigned short* vsrc = U.V + (size_t)(16 * (wid & 3) + (lane >> 2)) * vp + (wid >> 2) * 32 + (lane & 3) * 8;
    const unsigned kdst0 = lds0 + C::LDS_K + wid * 1024, kdst1 = lds0 + C::LDS_K + kc1 * 1024, vdst = lds0 + C::LDS_V + wid * 1024;
    const int NT = U.NT;
#define ATT_KROW(t) (SWA ? ((t) < 4 ? 64 * (t) : U.lat_row0 + 64 * ((t) - 4)) : 64 * (t))
#define ATT_DMA_K(t, slot) do { const size_t ro_ = (size_t)ATT_KROW(t); \
        glds16(ksrc0 + ro_ * kp, (unsigned)__builtin_amdgcn_readfirstlane(kdst0 + (slot) * C::KSLOT)); \
        if (C::NKI == 2) glds16(ksrc1 + ro_ * kp, (unsigned)__builtin_amdgcn_readfirstlane(kdst1 + (slot) * C::KSLOT)); } while (0)
#define ATT_DMA_V(t, slot) do { const size_t ro_ = (size_t)ATT_KROW(t); glds16(vsrc + ro_ * vp, (unsigned)__builtin_amdgcn_readfirstlane(vdst + (slot) * 8192)); } while (0)
#define ATT_KLOAD(kslot) do { if (!SWA) { const lds_cptr kb_ = (lds_cptr)(ldsb + C::LDS_K) + (kslot) * C::KSLOT + hi * 1024 + r32 * 16; \
        _Pragma("unroll") for (int d0 = 0; d0 < DQK / 16; ++d0) { kf[2 * d0] = *(const __attribute__((address_space(3))) bf16x8*)(kb_ + d0 * 2048); kf[2 * d0 + 1] = *(const __attribute__((address_space(3))) bf16x8*)(kb_ + d0 * 2048 + 512); } } } while (0)
#define ATT_QKM(P0, P1, CINIT, kslot) do { P0 = f32x16{}; P1 = f32x16{}; \
        const lds_cptr kq_ = (lds_cptr)(ldsb + C::LDS_K) + (kslot) * C::KSLOT + hi * 1024 + r32 * 16; \
        _Pragma("unroll") for (int d0 = 0; d0 < DQK / 16; ++d0) { \
            const bf16x8 b0_ = SWA ? *(const __attribute__((address_space(3))) bf16x8*)(kq_ + d0 * 2048) : kf[2 * d0]; const bf16x8 b1_ = SWA ? *(const __attribute__((address_space(3))) bf16x8*)(kq_ + d0 * 2048 + 512) : kf[2 * d0 + 1]; \
            P0 = __builtin_amdgcn_mfma_f32_32x32x16_bf16(b0_, qr[d0], P0, 0, 0, 0); P1 = __builtin_amdgcn_mfma_f32_32x32x16_bf16(b1_, qr[d0], P1, 0, 0, 0); } } while (0)
#define ATT_VLOAD(vslot) do { if (!SWA) { const lds_cptr vb_ = (lds_cptr)(ldsb + C::LDS_V) + (vslot) * 8192 + ((lane >> 4) & 1) * 32 + (lane & 3) * 8 + (4 * hi + ((lane & 15) >> 2)) * 64; \
        _Pragma("unroll") for (int i = 0; i < 8; ++i) { vl[i] = vtr(vb_ + (i >> 2) * 4096 + (i & 3) * 1024); vh[i] = vtr(vb_ + (i >> 2) * 4096 + (i & 3) * 1024 + 512); } } } while (0)
#define ATT_MX3(a, b, c) __builtin_fmaxf(__builtin_fmaxf((a), (b)), (c))
#define ATT_NEEDMASK(j) ((j) >= 4 && U.qpos0 >= 0 && !((U.spos0 + 64 * ((j) - 4) + 63 - (U.qpos0 + 32 * wid) <= 128) && ((U.qpos0 + 32 * wid + 31) - (U.spos0 + 64 * ((j) - 4)) <= 128)))
#define ATT_SMPV(P0, P1, N0, N1, HASNEXT, t, vslot) do { \
        if (SWA && ATT_NEEDMASK(t)) { const bool mk_ = true; const int sb_ = U.spos0 + 64 * ((t) - 4) + 4 * hi;        \
            _Pragma("unroll") for (int r = 0; r < 16; ++r) { const int dd_ = qpos - (sb_ + (r & 3) + 8 * (r >> 2)); \
                P0[r] = (mk_ && (dd_ > 128 || dd_ < -128)) ? -INFINITY : P0[r]; P1[r] = (mk_ && (dd_ - 32 > 128 || dd_ - 32 < -128)) ? -INFINITY : P1[r]; } } \
        float ls_ = 0.f; \
        _Pragma("unroll") for (int r = 0; r < 16; ++r) { P0[r] = __builtin_amdgcn_exp2f(P0[r]); P1[r] = __builtin_amdgcn_exp2f(P1[r]); ls_ += P0[r] + P1[r]; } \
        l += ls_; \
        if (!SWA && DQK != 64) { __builtin_amdgcn_sched_barrier(0); ATT_VLOAD(vslot); } \
        u32x4 pw_[4]; \
        pw_[0] = (u32x4){cvtpk(P0[0], P0[1]), cvtpk(P0[2], P0[3]), cvtpk(P0[4], P0[5]), cvtpk(P0[6], P0[7])}; \
        pw_[1] = (u32x4){cvtpk(P0[8], P0[9]), cvtpk(P0[10], P0[11]), cvtpk(P0[12], P0[13]), cvtpk(P0[14], P0[15])}; \
        pw_[2] = (u32x4){cvtpk(P1[0], P1[1]), cvtpk(P1[2], P1[3]), cvtpk(P1[4], P1[5]), cvtpk(P1[6], P1[7])}; \
        pw_[3] = (u32x4){cvtpk(P1[8], P1[9]), cvtpk(P1[10], P1[11]), cvtpk(P1[12], P1[13]), cvtpk(P1[14], P1[15])}; \
        const lds_cptr vq_ = (lds_cptr)(ldsb + C::LDS_V) + (vslot) * 8192 + ((lane >> 4) & 1) * 32 + (lane & 3) * 8 + (4 * hi + ((lane & 15) >> 2)) * 64; \
        _Pragma("unroll") for (int d0 = 0; d0 < 2; ++d0) \
            _Pragma("unroll") for (int ks = 0; ks < 4; ++ks) { \
                const s16x4 lo_ = SWA ? vtr(vq_ + d0 * 4096 + ks * 1024) : vl[4 * d0 + ks], hh_ = SWA ? vtr(vq_ + d0 * 4096 + ks * 1024 + 512) : vh[4 * d0 + ks]; \
                const bf16x8 vf_ = (bf16x8){lo_[0], lo_[1], lo_[2], lo_[3], hh_[0], hh_[1], hh_[2], hh_[3]}; \
                o[d0] = __builtin_amdgcn_mfma_f32_32x32x16_bf16(__builtin_bit_cast(bf16x8, pw_[ks]), vf_, o[d0], 0, 0, 0); } } while (0)
#define ATT_SKIP(j) (SWA && (j) >= 4 && U.qpos0 >= 0 && ((U.spos0 + 64 * ((j) - 4) > U.qpos0 + 32 * wid + 31 + 128) || (U.spos0 + 64 * ((j) - 4) + 63 < U.qpos0 + 32 * wid - 128)))
#define ATT_STEP(C0, C1, N0, N1, t) do { \
        const int k3_ = (ks1 == 0) ? 2 : ks1 - 1, v2_ = (vs0 == 0) ? 2 : vs0 - 1; \
        if ((t) + 3 < NT) ATT_DMA_K((t) + 3, k3_); \
        if ((t) + 2 < NT) ATT_DMA_V((t) + 2, v2_); \
        ATT_KLOAD(ks1); \
        if (!SWA) __builtin_amdgcn_sched_barrier(0);        \
        if (!SWA || !ATT_SKIP((t) + 1)) ATT_QKM(N0, N1, -m, ks1); \
        if (DQK == 64) ATT_VLOAD(vs0);        \
        if (!SWA) __builtin_amdgcn_sched_barrier(0); \
        if (!SWA || !ATT_SKIP(t)) ATT_SMPV(C0, C1, N0, N1, true, t, vs0); \
        if ((t) + 3 < NT) { if (C::NI == 2) ATT_WAIT_BAR(2); else ATT_WAIT_BAR(3); } else ATT_WAIT_BAR(0); \
        ks1 = (ks1 == 2) ? 0 : ks1 + 1; vs0 = (vs0 == 2) ? 0 : vs0 + 1; } while (0)
    ATT_DMA_K(0, 0);
    ATT_DMA_K(1, 1); ATT_DMA_V(0, 0);
    ATT_DMA_K(2, 2); ATT_DMA_V(1, 1);
    bf16x8 qr[DQK / 16];
    { const unsigned short* qw = U.Q + (size_t)(wid * 32 + r32) * U.qp + hi * 8;
#pragma unroll
      for (int d0 = 0; d0 < DQK / 16; ++d0) qr[d0] = *(const bf16x8*)(qw + d0 * 16); }
    const float m = 0.f; float l = 0.f;
    f32x16 o[2]; o[0] = f32x16{}; o[1] = f32x16{};
    const int qpos = U.qpos0 + wid * 32 + r32;
    f32x16 pa0, pa1, pb0, pb1;
    bf16x8 kf[DQK / 8]; s16x4 vl[8], vh[8];
    if (C::NI == 2) ATT_WAIT_BAR(4); else ATT_WAIT_BAR(6);
    ATT_KLOAD(0); ATT_QKM(pa0, pa1, 0.f, 0);
    if (C::NI == 2) ATT_WAIT_BAR(2); else ATT_WAIT_BAR(3);
    int ks1 = 1, vs0 = 0;
    int t = 0;
    if (SWA) { for (; t + 1 < NT; ++t) { ATT_STEP(pa0, pa1, pb0, pb1, t); pa0 = pb0; pa1 = pb1; } if (!ATT_SKIP(NT - 1)) ATT_SMPV(pa0, pa1, pa0, pa1, false, NT - 1, vs0); }
    else {
    for (; t + 2 < NT; t += 2) { ATT_STEP(pa0, pa1, pb0, pb1, t); ATT_STEP(pb0, pb1, pa0, pa1, t + 1); }
    if (t + 1 < NT) { ATT_STEP(pa0, pa1, pb0, pb1, t); if (DQK == 64) ATT_VLOAD(vs0); ATT_SMPV(pb0, pb1, pb0, pb1, false, NT - 1, vs0); }
    else { if (DQK == 64) ATT_VLOAD(vs0); ATT_SMPV(pa0, pa1, pa0, pa1, false, NT - 1, vs0); }
    }
    l = halfswap_sum(l);
    if (U.has_sink) l += __builtin_amdgcn_exp2f(U.sink2 - m);
    if (hi == 0) wsf[32 + r32] = l;
    asm volatile("s_waitcnt lgkmcnt(0)" ::: "memory");
    { LAS unsigned short* stg = (LAS unsigned short*)(ldsb + C::LDS_OST) + wid * 2048;
#pragma unroll
      for (int r = 0; r < 16; ++r) { const int orow = crow(r, hi); const float rl = __builtin_amdgcn_rcpf(wsf[32 + orow]);
          stg[orow * 64 + r32] = (unsigned short)f2bf(o[0][r] * rl); stg[orow * 64 + 32 + r32] = (unsigned short)f2bf(o[1][r] * rl); }
      asm volatile("s_waitcnt lgkmcnt(0)" ::: "memory");
      unsigned short* yw = U.Y + (size_t)(wid * 32) * 1024;
#pragma unroll
      for (int i = 0; i < 4; ++i) { const int row = i * 8 + (lane >> 3), ch = lane & 7;
          const u32x4 ov = *(const LAS u32x4*)(stg + row * 64 + ch * 8);
          u32x4* gp = (u32x4*)(yw + (size_t)row * 1024 + ch * 8); const u32x4 g = *gp;
          u32x4 w; w.x = pk2(bflo(ov.x) * bflo(g.x), bfhi(ov.x) * bfhi(g.x)); w.y = pk2(bflo(ov.y) * bflo(g.y), bfhi(ov.y) * bfhi(g.y));
          w.z = pk2(bflo(ov.z) * bflo(g.z), bfhi(ov.z) * bfhi(g.z)); w.w = pk2(bflo(ov.w) * bflo(g.w), bfhi(ov.w) * bfhi(g.w));
          *gp = w; } }
    asm volatile("s_waitcnt vmcnt(0) lgkmcnt(0)\n\ts_barrier" ::: "memory");
#undef ATT_KROW
#undef ATT_DMA_K
#undef ATT_DMA_V
#undef ATT_KLOAD
#undef ATT_QKM
#undef ATT_VLOAD
#undef ATT_STEP
#undef ATT_SKIP
#undef ATT_SMPV
#undef ATT_MX3
#undef ATT_NEEDMASK
}

template <int DQK>
__device__ __forceinline__ void attn_unit_d(LAS unsigned char* ldsb, const UnitDesc& U, const int tid) {
    using C = Cfg<DQK>;
    constexpr int KP = (DQK == 64) ? 128 : 256, KSL = 64 * KP, SPR = KP / 16, RPP = 1024 / KP, NKI = KSL / 8192;
    static_assert(NKI == C::NKI, "K DMA count");
    constexpr int LDS_WS = 0, LDS_K = 2048, LDS_V = LDS_K + 3 * KSL, LDS_END = LDS_V + 3 * 8192, LDS_X = 2048, LDS_STG = LDS_X + 65536;
    static_assert(LDS_END <= RING_BYTES && LDS_STG + 8 * 4096 <= RING_BYTES, "attention LDS");
    const int lane = tid & 63, r32 = lane & 31, hi = lane >> 5; const int wid = __builtin_amdgcn_readfirstlane(tid >> 6); const int rg = wid & 3, kh = wid >> 2;
    const unsigned lds0 = (unsigned)(uintptr_t)ldsb;
    const int kp = U.kp, vp = U.vp;
    const unsigned short* ksrc0; const unsigned short* ksrc1;
    { const int ra = wid * RPP + lane / SPR, sa = lane % SPR, fa = (KP == 128) ? ((ra >> 1) & 7) : (ra & 15); int ca = sa ^ fa; if (ca >= DQK / 8) ca = 0;
      ksrc0 = U.K + (size_t)ra * kp + ca * 8;
      const int rb = (wid + 8) * RPP + lane / SPR, fb = (KP == 128) ? ((rb >> 1) & 7) : (rb & 15); int cb = sa ^ fb; if (cb >= DQK / 8) cb = 0;
      ksrc1 = U.K + (size_t)(NKI == 2 ? rb : ra) * kp + (NKI == 2 ? cb : ca) * 8; }
    const unsigned short* vsrc = U.V + (size_t)(16 * (wid & 3) + (lane >> 2)) * vp + (wid >> 2) * 32 + (lane & 3) * 8;
    const unsigned kdst0 = lds0 + LDS_K + wid * 1024, kdst1 = lds0 + LDS_K + (wid + 8) * 1024, vdst = lds0 + LDS_V + wid * 1024;
    const int NT = U.NT;
#define ATD_DMA(t, slot) do { const size_t ro_ = (size_t)64 * (t); \
        glds16(ksrc0 + ro_ * kp, (unsigned)__builtin_amdgcn_readfirstlane(kdst0 + (slot) * KSL)); \
        if (NKI == 2) glds16(ksrc1 + ro_ * kp, (unsigned)__builtin_amdgcn_readfirstlane(kdst1 + (slot) * KSL)); \
        glds16(vsrc + ro_ * vp, (unsigned)__builtin_amdgcn_readfirstlane(vdst + (slot) * 8192)); } while (0)
    ATD_DMA(0, 0); ATD_DMA(1, 1);
    bf16x8 qr[2][DQK / 16];
    { const unsigned short* qw = U.Q + (size_t)(rg * 64 + r32) * U.qp + hi * 8;
#pragma unroll
      for (int qb = 0; qb < 2; ++qb)
#pragma unroll
          for (int d0 = 0; d0 < DQK / 16; ++d0) qr[qb][d0] = *(const bf16x8*)(qw + (size_t)(qb * 32) * U.qp + d0 * 16); }
    f32x16 o[2][2]; o[0][0] = f32x16{}; o[0][1] = f32x16{}; o[1][0] = f32x16{}; o[1][1] = f32x16{};
    float l0 = 0.f, l1 = 0.f, l0b = 0.f, l1b = 0.f; u32x4 pp[4]; pp[0] = pp[1] = pp[2] = pp[3] = (u32x4){0u, 0u, 0u, 0u};
    if (C::NI == 2) ATT_WAIT_BAR(2); else ATT_WAIT_BAR(3);
#pragma unroll
    for (int qb = 0; qb < 2; ++qb)
#pragma unroll
        for (int d0 = 0; d0 < DQK / 16; ++d0) asm volatile("" : "+v"(qr[qb][d0]));
    const int krow = 32 * kh + r32, kfx = ((KP == 128) ? ((krow >> 1) & 7) : (krow & 15)) ^ hi;
    const unsigned kb0 = (unsigned)(uintptr_t)(ldsb + LDS_K) + krow * KP + kfx * 16;
    const lds_cptr vbase = (lds_cptr)(ldsb + LDS_V) + kh * 2048 + ((lane >> 4) & 1) * 32 + (lane & 3) * 8 + (4 * hi + ((lane & 15) >> 2)) * 64;
#define ATD_DOT(acc, w) acc = __builtin_amdgcn_fdot2_f32_bf16(__builtin_bit_cast(bf16x2_t, (w)), __builtin_bit_cast(bf16x2_t, 0x3f803f80u), acc, false)
#define ATD_SUM4(LA, LB, W) do { ATD_DOT(LA, W.x); ATD_DOT(LB, W.y); ATD_DOT(LA, W.z); ATD_DOT(LB, W.w); } while (0)
#define ATD_SMPV(S, PW0, PW1, OA, OB) do { \
        _Pragma("unroll") for (int r = 0; r < 16; ++r) S[r] = __builtin_amdgcn_exp2f(S[r]); \
        PW0 = (u32x4){cvtpk(S[0], S[1]), cvtpk(S[2], S[3]), cvtpk(S[4], S[5]), cvtpk(S[6], S[7])}; \
        PW1 = (u32x4){cvtpk(S[8], S[9]), cvtpk(S[10], S[11]), cvtpk(S[12], S[13]), cvtpk(S[14], S[15])}; \
        OA = __builtin_amdgcn_mfma_f32_32x32x16_bf16(__builtin_bit_cast(bf16x8, PW0), vf[0][0], OA, 0, 0, 0); OB = __builtin_amdgcn_mfma_f32_32x32x16_bf16(__builtin_bit_cast(bf16x8, PW0), vf[1][0], OB, 0, 0, 0); \
        OA = __builtin_amdgcn_mfma_f32_32x32x16_bf16(__builtin_bit_cast(bf16x8, PW1), vf[0][1], OA, 0, 0, 0); OB = __builtin_amdgcn_mfma_f32_32x32x16_bf16(__builtin_bit_cast(bf16x8, PW1), vf[1][1], OB, 0, 0, 0); } while (0)
    int s = 0;
#pragma unroll 1
    for (int t = 0; t < NT; ++t) {
        const int s2 = (s == 0) ? 2 : s - 1;
        if (t + 2 < NT) ATD_DMA(t + 2, s2);
        bf16x8 kf[DQK / 16], vf[2][2];
        {
#pragma unroll
          for (int d0 = 0; d0 < DQK / 16; ++d0) kf[d0] = *(const __attribute__((address_space(3))) bf16x8*)(uintptr_t)((kb0 ^ (unsigned)(32 * d0)) + (unsigned)(s * KSL)); }
        { const lds_cptr vb_ = vbase + s * 8192;
#pragma unroll
          for (int d0 = 0; d0 < 2; ++d0)
#pragma unroll
              for (int ks = 0; ks < 2; ++ks) { const s16x4 lo_ = vtr(vb_ + d0 * 4096 + ks * 1024), hh_ = vtr(vb_ + d0 * 4096 + ks * 1024 + 512);
                  vf[d0][ks] = (bf16x8){lo_[0], lo_[1], lo_[2], lo_[3], hh_[0], hh_[1], hh_[2], hh_[3]}; } }
        f32x16 S0 = f32x16{}, S1 = f32x16{};
#pragma unroll
        for (int d0 = 0; d0 < DQK / 16; ++d0) S0 = __builtin_amdgcn_mfma_f32_32x32x16_bf16(kf[d0], qr[0][d0], S0, 0, 0, 0);
#pragma unroll
        for (int d0 = 0; d0 < DQK / 16; ++d0) S1 = __builtin_amdgcn_mfma_f32_32x32x16_bf16(kf[d0], qr[1][d0], S1, 0, 0, 0);
        ATD_SUM4(l0, l0b, pp[0]); ATD_SUM4(l0, l0b, pp[1]); ATD_SUM4(l1, l1b, pp[2]); ATD_SUM4(l1, l1b, pp[3]);
        __builtin_amdgcn_sched_barrier(0);
        ATD_SMPV(S0, pp[0], pp[1], o[0][0], o[0][1]);
        ATD_SMPV(S1, pp[2], pp[3], o[1][0], o[1][1]);
        if (t + 2 < NT) { if (C::NI == 2) ATT_WAIT_BAR(2); else ATT_WAIT_BAR(3); } else ATT_WAIT_BAR(0);
        s = (s == 2) ? 0 : s + 1;
    }
    LAS float* wl = (LAS float*)(ldsb + LDS_WS);
    LAS float* X = (LAS float*)(ldsb + LDS_X);
    ATD_SUM4(l0, l0b, pp[0]); ATD_SUM4(l0, l0b, pp[1]); ATD_SUM4(l1, l1b, pp[2]); ATD_SUM4(l1, l1b, pp[3]); l0 += l0b; l1 += l1b;
    const float lkeep = halfswap_sum(kh ? l1 : l0), lsend = halfswap_sum(kh ? l0 : l1);
    f32x16 ok0 = kh ? o[1][0] : o[0][0], ok1 = kh ? o[1][1] : o[0][1]; const f32x16 os0 = kh ? o[0][0] : o[1][0], os1 = kh ? o[0][1] : o[1][1];
    { LAS float* xs = X + wid * 2048 + lane;
#pragma unroll
      for (int r = 0; r < 16; ++r) { xs[r * 64] = os0[r]; xs[(16 + r) * 64] = os1[r]; }
      if (hi == 0) wl[wid * 64 + r32] = lsend; }
    asm volatile("s_waitcnt lgkmcnt(0)\n\ts_barrier" ::: "memory");
    { const LAS float* xr = X + (wid ^ 4) * 2048 + lane;
#pragma unroll
      for (int r = 0; r < 16; ++r) { ok0[r] += xr[r * 64]; ok1[r] += xr[(16 + r) * 64]; }
      const float lt = lkeep + wl[(wid ^ 4) * 64 + r32];
      if (hi == 0) wl[wid * 64 + 32 + r32] = lt; }
    asm volatile("s_waitcnt lgkmcnt(0)" ::: "memory");
    { LAS unsigned short* stg = (LAS unsigned short*)(ldsb + LDS_STG) + wid * 2048;
      const LAS float* lt = wl + wid * 64 + 32;
#pragma unroll
      for (int r = 0; r < 16; ++r) { const int orow = crow(r, hi); const float rl = __builtin_amdgcn_rcpf(lt[orow]);
          stg[orow * 64 + r32] = (unsigned short)f2bf(ok0[r] * rl); stg[orow * 64 + 32 + r32] = (unsigned short)f2bf(ok1[r] * rl); }
      asm volatile("s_waitcnt lgkmcnt(0)" ::: "memory");
      unsigned short* yw = U.Y + (size_t)(rg * 64 + kh * 32) * 1024;
#pragma unroll
      for (int i = 0; i < 4; ++i) { const int row = i * 8 + (lane >> 3), ch = lane & 7;
          const u32x4 ov = *(const LAS u32x4*)(stg + row * 64 + ch * 8);
          u32x4* gp = (u32x4*)(yw + (size_t)row * 1024 + ch * 8); const u32x4 g = *gp;
          u32x4 w; w.x = pk2(bflo(ov.x) * bflo(g.x), bfhi(ov.x) * bfhi(g.x)); w.y = pk2(bflo(ov.y) * bflo(g.y), bfhi(ov.y) * bfhi(g.y));
          w.z = pk2(bflo(ov.z) * bflo(g.z), bfhi(ov.z) * bfhi(g.z)); w.w = pk2(bflo(ov.w) * bflo(g.w), bfhi(ov.w) * bfhi(g.w));
          *gp = w; } }
    asm volatile("s_waitcnt vmcnt(0) lgkmcnt(0)\n\ts_barrier" ::: "memory");
#undef ATD_DMA
#undef ATD_SMPV
#undef ATD_DOT
#undef ATD_SUM4
}
}

__device__ __forceinline__ void ph_attn(Frame& F, int l) {
    unsigned short* ZS = (unsigned short*)(F.ws + WS_ZS); unsigned short* MQ = (unsigned short*)(F.ws + WS_MQ); unsigned short* MKV = (unsigned short*)(F.ws + WS_MKV); unsigned short* MK = (unsigned short*)(F.ws + WS_MK);
    unsigned short* Y = (unsigned short*)(F.ws + WS_G);
    LAS unsigned char* lds = F.lds + RING_OFF;
    const int u = F.vcu;
    const bool ctxq = (l == 0);
    for (int uu = u; uu < 256; uu += F.G) { const int bh = uu >> 4, qb = uu & 15, b = bh >> 2, h = bh & 3; const size_t r0 = (size_t)b * TPB, rq = r0 + CTXL + qb * 256;
        att::UnitDesc U{MQ + rq * 512 + h * 96, 512, MK + r0 * 384 + h * 96, 384, MKV + r0 * 512 + h * 128 + 64, 512, Y + rq * 1024 + h * 64, TPB / 64, 0, -1, 0, 0, 0.f};
        { int tu_ = F.tid; asm volatile("" : "+v"(tu_)); att::attn_unit_d<96>(lds, U, tu_); } }
    for (int uu = u; uu < 256; uu += F.G) { const int qb = uu & 15, g = (uu >> 4) & 1, kvh = (uu >> 5) & 1, b = uu >> 6, qh = kvh * 2 + g; const size_t r0 = (size_t)b * TPB, rq = r0 + CTXL + qb * 256;
        att::UnitDesc U{ZS + rq * ZS_P + ZC_AQ + qh * 64, ZS_P, ZS + r0 * ZS_P + ZC_AK + kvh * 64, ZS_P, ZS + r0 * ZS_P + ZC_AV + kvh * 64, ZS_P, Y + rq * 1024 + 512 + qh * 64, TPB / 64, 0, -1, 0, 0, 0.f};
        { int tu_ = F.tid; asm volatile("" : "+v"(tu_)); att::attn_unit_d<64>(lds, U, tu_); } }
    for (int uu = u; uu < 256; uu += F.G) { const int qb = uu & 15, g = (uu >> 4) & 1, kvh = (uu >> 5) & 1, b = uu >> 6, qh = kvh * 2 + g; const size_t r0 = (size_t)b * TPB, rq = r0 + CTXL + qb * 256;
        const int q0 = qb * 256, s0 = (q0 - 128 < 0) ? 0 : q0 - 128, s1 = (q0 + 384 > SEQ) ? SEQ : q0 + 384;
        att::UnitDesc U{ZS + rq * ZS_P + ZC_SQ + qh * 64, ZS_P, ZS + r0 * ZS_P + ZC_SK + kvh * 64, ZS_P, ZS + r0 * ZS_P + ZC_SV + kvh * 64, ZS_P, Y + rq * 1024 + 256 + qh * 64, 4 + (s1 - s0) / 64, CTXL + s0, q0, s0, 1, F.in(I_SINK)[l * 4 + qh] * LOG2E};
        att::attn_unit<64, true>(lds, U, F.tid); }
    if (ctxq) for (int uu = u; uu < 48; uu += F.G) { const int br = uu >> 4, b = (uu >> 2) & 3, h = uu & 3; const size_t r0 = (size_t)b * TPB;
        if (br == 0) { att::UnitDesc U{MQ + r0 * 512 + h * 96, 512, MK + r0 * 384 + h * 96, 384, MKV + r0 * 512 + h * 128 + 64, 512, Y + r0 * 1024 + h * 64, 4, 0, -1, 0, 0, 0.f};
            { int tu_ = F.tid; asm volatile("" : "+v"(tu_)); att::attn_unit_d<96>(lds, U, tu_); } }
        else if (br == 1) { att::UnitDesc U{ZS + r0 * ZS_P + ZC_SQ + h * 64, ZS_P, ZS + r0 * ZS_P + ZC_SK + (h >> 1) * 64, ZS_P, ZS + r0 * ZS_P + ZC_SV + (h >> 1) * 64, ZS_P, Y + r0 * 1024 + 256 + h * 64, 4, CTXL, -1, 0, 1, F.in(I_SINK)[l * 4 + h] * LOG2E};
            att::attn_unit<64, true>(lds, U, F.tid); }
        else { att::UnitDesc U{ZS + r0 * ZS_P + ZC_AQ + h * 64, ZS_P, ZS + r0 * ZS_P + ZC_AK + (h >> 1) * 64, ZS_P, ZS + r0 * ZS_P + ZC_AV + (h >> 1) * 64, ZS_P, Y + r0 * 1024 + 512 + h * 64, 4, 0, -1, 0, 0, 0.f};
            { int tu_ = F.tid; asm volatile("" : "+v"(tu_)); att::attn_unit_d<64>(lds, U, tu_); } } }
}
constexpr size_t WS_SUM = 253 * MiB;
constexpr size_t WS_HL = WS_U, WS_CP = WS_HF;
constexpr int NCHUNK = TPB / 64;
__device__ __forceinline__ float swap_lo(float x) { auto rr = __builtin_amdgcn_permlane32_swap(__float_as_uint(x), __float_as_uint(x), false, false); return __uint_as_float(rr[0]); }
__device__ __forceinline__ float swap_hi(float x) { auto rr = __builtin_amdgcn_permlane32_swap(__float_as_uint(x), __float_as_uint(x), false, false); return __uint_as_float(rr[1]); }
__device__ __forceinline__ void ph_lru1(Frame& F, int l) {
    typedef short bf16x8 __attribute__((ext_vector_type(8))); typedef float f32x16 __attribute__((ext_vector_type(16)));
    const unsigned short* ZS = (const unsigned short*)(F.ws + WS_ZS); unsigned short* HL = (unsigned short*)(F.ws + WS_HL); unsigned short* CP = (unsigned short*)(F.ws + WS_CP);
    f32x2v* SUM = (f32x2v*)(F.ws + WS_SUM);
    constexpr int UP = 264;
    LAS unsigned short* ul = (LAS unsigned short*)(F.lds + RING_OFF);
    const float* cw = F.in(I_CONVW) + l * 4 * 256; const float* cb = F.in(I_CONVB) + l * 256;
    const int tid = F.tid, lane = tid & 63, r32 = lane & 31, hi = lane >> 5, k = F.wave & 3, d = F.wave >> 2;
    const int nfull = (NB * NCHUNK < F.G) ? NB * NCHUNK : F.G, nhalf = 2 * (NB * NCHUNK - nfull);
    for (int wi = F.vcu; wi < nfull + nhalf; wi += F.G) {
        const int unit = (wi < nfull) ? wi : nfull + ((wi - nfull) >> 1);
        const int tn_lo = (wi < nfull) ? 0 : ((wi - nfull) & 1), tn_hi = (wi < nfull) ? 2 : tn_lo + 1;
        const int b = unit / NCHUNK, ci = unit % NCHUNK;
        int s0row, len, t0; if (ci < 4) { s0row = b * TPB; len = CTXL; t0 = ci * 64; } else { s0row = b * TPB + CTXL; len = SEQ; t0 = (ci - 4) * 64; }
        { const int cc = tid & 255, hh = tid >> 8; float zv[35];
#pragma unroll
          for (int i = 0; i < 35; ++i) { const int tt = t0 + hh * 32 + i - 2; const int tc = tt < 0 ? 0 : (tt >= len ? len - 1 : tt);
              const float v = bf2f(ZS[(size_t)(s0row + tc) * ZS_P + ZC_LRU + cc]); zv[i] = (tt >= 0 && tt < len) ? v : 0.f; }
          const float w0 = cw[cc], w1 = cw[256 + cc], w2 = cw[512 + cc], w3 = cw[768 + cc], bb = cb[cc];
#pragma unroll
          for (int t = 0; t < 32; ++t) ul[(hh * 32 + t) * UP + cc] = (unsigned short)f2bf(bb + w0 * zv[t] + w1 * zv[t + 1] + w2 * zv[t + 2] + w3 * zv[t + 3]); }
        __syncthreads();
#pragma unroll 1
        for (int tn = tn_lo; tn < tn_hi; ++tn) {
            const int c = k * 64 + 32 * tn + r32;
            bf16x8 wf[2][4];
            const float brv = F.in(I_LBR)[(l * 2 + d) * 256 + c], biv = F.in(I_LBI)[(l * 2 + d) * 256 + c], spv = ((const float*)(F.ws + WS_SP))[(l * 2 + d) * 256 + c];
#pragma unroll
            for (int gate = 0; gate < 2; ++gate)
#pragma unroll
                for (int ks = 0; ks < 4; ++ks) { const float* src = (const float*)(F.ws + WS_LWT) + ((((size_t)l * 2 + d) * 2 + gate) * 256 + c) * 64 + 16 * ks + 8 * hi;
                    const f32x4 a = *(const f32x4*)src, b2 = *(const f32x4*)(src + 4);
                    v4u w; w.x = pk2(a.x, a.y); w.y = pk2(a.z, a.w); w.z = pk2(b2.x, b2.y); w.w = pk2(b2.z, b2.w); wf[gate][ks] = __builtin_bit_cast(bf16x8, w); }
            f32x16 A[2], X[2];
            A[0] = f32x16{}; A[1] = f32x16{}; X[0] = f32x16{}; X[1] = f32x16{};
#pragma unroll
            for (int tm = 0; tm < 2; ++tm)
#pragma unroll
                for (int ks = 0; ks < 4; ++ks) { const bf16x8 af = *(const LAS bf16x8*)(ul + (32 * tm + r32) * UP + k * 64 + 16 * ks + 8 * hi);
                    A[tm] = __builtin_amdgcn_mfma_f32_32x32x16_bf16(af, wf[0][ks], A[tm], 0, 0, 0); X[tm] = __builtin_amdgcn_mfma_f32_32x32x16_bf16(af, wf[1][ks], X[tm], 0, 0, 0); }
#pragma unroll
            for (int tm = 0; tm < 2; ++tm)
#pragma unroll
                for (int r = 0; r < 16; ++r) { const int tok = 32 * tm + (r & 3) + 8 * (r >> 2) + 4 * hi; const float uu = bf2f(ul[tok * UP + c]);
                    const float rr = sigmoid_f(A[tm][r] + brv), ii = sigmoid_f(X[tm][r] + biv);
                    const float a = __builtin_amdgcn_exp2f(-rr * spv); A[tm][r] = a; X[tm][r] = __builtin_amdgcn_sqrtf(1.0f - a * a) * (ii * uu);
                    if ((r & 3) == 3) asm volatile("" ::: "memory"); }
#pragma unroll
            for (int tm = 0; tm < 2; ++tm)
#pragma unroll
                for (int rg = 0; rg < 4; ++rg) { const int r0 = 4 * rg;
                    if (d == 0) {
#pragma unroll
                        for (int e2 = 1; e2 < 4; ++e2) { X[tm][r0 + e2] = A[tm][r0 + e2] * X[tm][r0 + e2 - 1] + X[tm][r0 + e2]; A[tm][r0 + e2] = A[tm][r0 + e2] * A[tm][r0 + e2 - 1]; } }
                    else {
#pragma unroll
                        for (int e2 = 2; e2 >= 0; --e2) { X[tm][r0 + e2] = A[tm][r0 + e2] * X[tm][r0 + e2 + 1] + X[tm][r0 + e2]; A[tm][r0 + e2] = A[tm][r0 + e2] * A[tm][r0 + e2 + 1]; } } }
            float enH[8], enP[8]; float EH = 0.f, EP = 1.f;
            if (d == 0) {
#pragma unroll
                for (int q = 0; q < 8; ++q) { const int tm = q >> 2, re = 4 * (q & 3) + 3; const float ce = A[tm][re], he = X[tm][re];
                    const float aH = swap_lo(ce * EH + he), aP = swap_lo(EP * ce);
                    const float E1H = hi ? aH : EH, E1P = hi ? aP : EP;
                    enH[q] = E1H; enP[q] = E1P;
                    EH = swap_hi(ce * E1H + he); EP = swap_hi(E1P * ce); }
            } else {
#pragma unroll
                for (int q = 7; q >= 0; --q) { const int tm = q >> 2, re = 4 * (q & 3); const float ce = A[tm][re], he = X[tm][re];
                    const float aH = swap_hi(ce * EH + he), aP = swap_hi(EP * ce);
                    const float E1H = hi ? EH : aH, E1P = hi ? EP : aP;
                    enH[q] = E1H; enP[q] = E1P;
                    EH = swap_lo(ce * E1H + he); EP = swap_lo(E1P * ce); }
            }
            { const unsigned ob = (unsigned)((((s0row + t0 + 4 * hi) * 2 + d) * 256 + c) * 2);
#pragma unroll
              for (int tm = 0; tm < 2; ++tm)
#pragma unroll
                for (int rg = 0; rg < 4; ++rg) { const int q = 4 * tm + rg;
#pragma unroll
                    for (int e2 = 0; e2 < 4; ++e2) { const int r = 4 * rg + e2; const unsigned o = ob + (unsigned)(32 * tm + 8 * rg + e2) * 1024u;
                        *(unsigned short*)((char*)HL + o) = (unsigned short)f2bf(X[tm][r] + A[tm][r] * enH[q]); *(unsigned short*)((char*)CP + o) = (unsigned short)f2bf(A[tm][r] * enP[q]); }
                    asm volatile("" ::: "memory"); } }
            if (hi == 0) SUM[((size_t)(b * NCHUNK + ci) * 2 + d) * 256 + c] = (f32x2v){EP, EH};
        }
        __syncthreads();
    }
}
constexpr size_t WS_CARRY = 255 * MiB;
__device__ __forceinline__ void ph_lru_carry(Frame& F) {
    if (F.vcu < 4) {
        const int g = F.vcu * NTHREADS + F.tid, b = g >> 9, d = (g >> 8) & 1, c = g & 255;
        const f32x2v* sb = (const f32x2v*)(F.ws + WS_SUM) + ((size_t)b * NCHUNK * 2 + d) * 256 + c;
        float* cr = (float*)(F.ws + WS_CARRY) + ((size_t)b * NCHUNK * 2 + d) * 256 + c;
        float h = 0.f;
#pragma unroll 1
        for (int p0 = 0; p0 < NCHUNK; p0 += 17) {
            f32x2v s[17];
#pragma unroll
            for (int i = 0; i < 17; ++i) { const int p = p0 + i, j = (d == 0) ? p : (p < 4 ? 3 - p : NCHUNK + 3 - p); s[i] = sb[(size_t)j * 512]; }
#pragma unroll
            for (int i = 0; i < 17; ++i) { const int p = p0 + i, j = (d == 0) ? p : (p < 4 ? 3 - p : NCHUNK + 3 - p); cr[(size_t)j * 512] = h; h = s[i].x * h + s[i].y; }
        }
    }
}
__device__ __forceinline__ void ph_lru2(Frame& F, int l) {
    const unsigned short* HL = (const unsigned short*)(F.ws + WS_HL); const unsigned short* CP = (const unsigned short*)(F.ws + WS_CP);
    const float* CARRY = (const float*)(F.ws + WS_CARRY); unsigned short* Y = (unsigned short*)(F.ws + WS_G);
    const int tid = F.tid, cg = tid & 31, tq = tid >> 5; const bool last = (l == NLAYER - 1);
    for (int unit = F.vcu; unit < NB * NCHUNK; unit += F.G) {
        const int b = unit / NCHUNK, ci = unit % NCHUNK;
        if (last && ci < 4) continue;
        const float* cp0 = CARRY + ((size_t)(b * NCHUNK + ci) * 2) * 256 + cg * 8;
        const f32x4 cfa = *(const f32x4*)cp0, cfb = *(const f32x4*)(cp0 + 4), cba = *(const f32x4*)(cp0 + 256), cbb = *(const f32x4*)(cp0 + 260);
        const float cf[8] = {cfa.x, cfa.y, cfa.z, cfa.w, cfb.x, cfb.y, cfb.z, cfb.w}, cbk[8] = {cba.x, cba.y, cba.z, cba.w, cbb.x, cbb.y, cbb.z, cbb.w};
        v4u hf[4], pf[4], hb[4], pb[4], gg[4];
#pragma unroll
        for (int i = 0; i < 4; ++i) { const size_t row = (size_t)b * TPB + ci * 64 + tq + 16 * i; const size_t o = (row * 2) * 256 + cg * 8;
            hf[i] = *(const v4u*)(HL + o); pf[i] = *(const v4u*)(CP + o); hb[i] = *(const v4u*)(HL + o + 256); pb[i] = *(const v4u*)(CP + o + 256); gg[i] = *(const v4u*)(Y + row * 1024 + 768 + cg * 8); }
#pragma unroll
        for (int i = 0; i < 4; ++i) { const size_t row = (size_t)b * TPB + ci * 64 + tq + 16 * i;
            unsigned w[4];
#pragma unroll
            for (int e = 0; e < 4; ++e) { const unsigned a = hf[i][e], p = pf[i][e], a2 = hb[i][e], p2 = pb[i][e], g = gg[i][e];
                const float v0 = (bflo(a) + bflo(p) * cf[2 * e] + bflo(a2) + bflo(p2) * cbk[2 * e]) * bflo(g);
                const float v1 = (bfhi(a) + bfhi(p) * cf[2 * e + 1] + bfhi(a2) + bfhi(p2) * cbk[2 * e + 1]) * bfhi(g);
                w[e] = pk2(v0, v1); }
            *(v4u*)(Y + row * 1024 + 768 + cg * 8) = (v4u){w[0], w[1], w[2], w[3]}; }
    }
}
#ifndef PGX_DMA
#define PGX_DMA 1
#endif
namespace pgx {
typedef short bf16x8 __attribute__((ext_vector_type(8)));
typedef float f32x4 __attribute__((ext_vector_type(4)));
typedef unsigned u32x4 __attribute__((ext_vector_type(4)));
typedef unsigned u32x2 __attribute__((ext_vector_type(2)));
constexpr int OPB = 16384;
template <int VAR> __device__ __forceinline__ void pgx_unit(LAS unsigned char* lds, const unsigned short* Y, const unsigned short* Wb, const unsigned short* S, unsigned short* MIX, int row0, int n0, int tid) {
    const int lane = tid & 63, wid = __builtin_amdgcn_readfirstlane(tid >> 6), wm = wid & 3, wn = wid >> 2, fr = lane & 15, fq = lane >> 4;
    const int sr0 = tid >> 3, sk = (tid & 7) * 8;
    const unsigned short* ysrc = Y + (size_t)(row0 + sr0) * 1024 + sk;
    const unsigned short* wsrc = Wb + (size_t)(n0 + sr0) * 256 + sk;
    const int ldst = (tid & 7) * 2048 + (sr0 & ~15) * 16 + (((sr0 & 15) ^ (tid & 7)) << 4);
    const int wrow = (sr0 & ~63) | (((sr0 >> 2) & 3) << 4) | (((sr0 >> 4) & 3) << 2) | (sr0 & 3);
    const int ldstw = (tid & 7) * 2048 + (wrow & ~15) * 16 + (((wrow & 15) ^ (tid & 7)) << 4);
    f32x4 acc[2][4], mix[2][4];
#pragma unroll
    for (int a = 0; a < 2; ++a)
#pragma unroll
        for (int b = 0; b < 4; ++b) { acc[a][b] = (f32x4){0.f, 0.f, 0.f, 0.f}; mix[a][b] = (f32x4){0.f, 0.f, 0.f, 0.f}; }
    u32x4 st[4][4];
    const unsigned short* yA = ysrc; const unsigned short* yB = ysrc + 64 * 1024;
    const unsigned short* wA = wsrc; const unsigned short* wB = wsrc + 64 * 256;
    const unsigned short* sp0 = S + (size_t)(row0 + 32 * wm + fr) * 4096 + n0 + 64 * wn + 16 * fq; const unsigned short* sp1 = sp0 + (size_t)16 * 4096;
#define PGX_LOADQ(set_, yo_, wp0_, wp1_, wo_) do { if (VAR == 2) { st[set_][0] = *(const u32x4*)(ysrc); st[set_][1] = *(const u32x4*)(ysrc + 64 * 1024); st[set_][2] = *(const u32x4*)(wsrc); st[set_][3] = *(const u32x4*)(wsrc + 64 * 256); } else if (VAR == 4) { st[set_][0] = st[set_][1] = st[set_][2] = st[set_][3] = (u32x4){1u,2u,3u,4u}; asm volatile("" : "+v"(st[set_][0]), "+v"(st[set_][1]), "+v"(st[set_][2]), "+v"(st[set_][3])); } else { st[set_][0] = *(const u32x4*)(yA + (yo_)); st[set_][1] = *(const u32x4*)(yB + (yo_)); st[set_][2] = *(const u32x4*)((wp0_) + (wo_)); st[set_][3] = *(const u32x4*)((wp1_) + (wo_)); } } while (0)
#define PGX_STORE(buf_, set_) do { LAS unsigned char* b_ = lds + (buf_) * 2 * OPB + ldst; \
        *(LAS u32x4*)b_ = st[set_][0]; *(LAS u32x4*)(b_ + 1024) = st[set_][1]; *(LAS u32x4*)(b_ - ldst + OPB + ldstw) = st[set_][2]; *(LAS u32x4*)(b_ - ldst + OPB + ldstw + 1024) = st[set_][3]; } while (0)
    u32x4 sga[2][2], sgb[2][2];
#define PGX_SLOAD(dst_, off_) do { if (VAR == 1 || VAR == 4) { dst_[0][0] = dst_[0][1] = dst_[1][0] = dst_[1][1] = (u32x4){0x3f803f80u, 0x3f803f80u, 0x3f803f80u, 0x3f803f80u}; } \
        else { dst_[0][0] = *(const u32x4*)(sp0 + (off_)); dst_[0][1] = *(const u32x4*)(sp0 + (off_) + 8); dst_[1][0] = *(const u32x4*)(sp1 + (off_)); dst_[1][1] = *(const u32x4*)(sp1 + (off_) + 8); } } while (0)
    PGX_SLOAD(sga, 0);
    PGX_LOADQ(0, 0, wA, wB, 0); PGX_LOADQ(1, 64, wA, wB, 64); PGX_LOADQ(2, 128, wA, wB, 128);
    PGX_STORE(0, 0);
    __syncthreads();
#define PGX_COMPUTE(h_) do { const LAS unsigned char* yb = lds + ((h_) & 1) * 2 * OPB + 32 * wm * 16; const LAS unsigned char* wb = lds + ((h_) & 1) * 2 * OPB + OPB + 64 * wn * 16; \
          _Pragma("unroll") for (int ks = 0; ks < 2; ++ks) { const int fo_ = (4 * ks + fq) * 2048 + ((fr ^ (4 * ks + fq)) << 4); \
              bf16x8 yf[2], wf[4]; \
              _Pragma("unroll") for (int tt = 0; tt < 2; ++tt) yf[tt] = *(const LAS bf16x8*)(yb + fo_ + tt * 256); \
              _Pragma("unroll") for (int nt = 0; nt < 4; ++nt) wf[nt] = *(const LAS bf16x8*)(wb + fo_ + nt * 256); \
              _Pragma("unroll") for (int tt = 0; tt < 2; ++tt) \
                  _Pragma("unroll") for (int nt = 0; nt < 4; ++nt) acc[tt][nt] = __builtin_amdgcn_mfma_f32_16x16x32_bf16(wf[nt], yf[tt], acc[tt][nt], 0, 0, 0); } } while (0)
#pragma unroll 1
    for (int kk = 0; kk < 4; ++kk) {
        const bool more = kk < 3;
        const unsigned short* wnA = more ? wA + (size_t)1024 * 256 : wsrc; const unsigned short* wnB = more ? wB + (size_t)1024 * 256 : wsrc + 64 * 256;
        const int yo = more ? 256 : -768;
        PGX_SLOAD(sgb, more ? 1024 : 0);
        PGX_LOADQ(3, 192, wA, wB, 192); PGX_COMPUTE(0); PGX_STORE(1, 1); __syncthreads();
        PGX_LOADQ(0, yo, wnA, wnB, 0); PGX_COMPUTE(1); PGX_STORE(0, 2); __syncthreads();
        PGX_LOADQ(1, yo + 64, wnA, wnB, 64); PGX_COMPUTE(2); PGX_STORE(1, 3); __syncthreads();
        PGX_LOADQ(2, yo + 128, wnA, wnB, 128); PGX_COMPUTE(3);
#pragma unroll
        for (int tt = 0; tt < 2; ++tt)
#pragma unroll
            for (int nt = 0; nt < 4; ++nt) { const u32x4 gv = sga[tt][nt >> 1]; const unsigned g0 = (nt & 1) ? gv.z : gv.x, g1 = (nt & 1) ? gv.w : gv.y; const f32x4 a = acc[tt][nt];
                mix[tt][nt] += (f32x4){a[0] * bflo(g0), a[1] * bfhi(g0), a[2] * bflo(g1), a[3] * bfhi(g1)}; acc[tt][nt] = (f32x4){0.f, 0.f, 0.f, 0.f}; }
#pragma unroll
        for (int tt = 0; tt < 2; ++tt) { sga[tt][0] = sgb[tt][0]; sga[tt][1] = sgb[tt][1]; }
        if (more) PGX_STORE(0, 0);
        __syncthreads();
        yA += 256; yB += 256; wA = wnA; wB = wnB; sp0 += 1024; sp1 += 1024;
    }
#pragma unroll
    for (int tt = 0; tt < 2; ++tt) { unsigned short* mp = MIX + (size_t)(row0 + 32 * wm + 16 * tt + fr) * 1024 + n0 + 64 * wn + 16 * fq;
        u32x4 w0, w1; w0.x = pk2(mix[tt][0][0], mix[tt][0][1]); w0.y = pk2(mix[tt][0][2], mix[tt][0][3]); w0.z = pk2(mix[tt][1][0], mix[tt][1][1]); w0.w = pk2(mix[tt][1][2], mix[tt][1][3]);
        w1.x = pk2(mix[tt][2][0], mix[tt][2][1]); w1.y = pk2(mix[tt][2][2], mix[tt][2][3]); w1.z = pk2(mix[tt][3][0], mix[tt][3][1]); w1.w = pk2(mix[tt][3][2], mix[tt][3][3]);
        *(u32x4*)mp = w0; *(u32x4*)(mp + 8) = w1; }
#undef PGX_LOADQ
#undef PGX_SLOAD
#undef PGX_STORE
#undef PGX_COMPUTE
}

__device__ __forceinline__ void pgx_unit_dma(LAS unsigned char* lds, const unsigned short* Y, const unsigned short* Wb, const unsigned short* S, unsigned short* MIX, int row0, int n0, int tid, bool first, bool has_next, int row0n, int n0n, u32x4 (&sga)[2][2]) {
    const int lane = tid & 63, wid = __builtin_amdgcn_readfirstlane(tid >> 6), wm = wid & 3, wn = wid >> 2, fr = lane & 15, fq = lane >> 4;
    const int dr = 8 * wid + (lane >> 3), dc = (lane & 7) ^ ((dr >> 1) & 7);
    const int wr = (dr & ~63) | (((dr >> 2) & 3) << 4) | (((dr >> 4) & 3) << 2) | (dr & 3);
    const unsigned short* yg = Y + (size_t)(row0 + dr) * 1024 + dc * 8;
    const unsigned short* wg = Wb + (size_t)(n0 + wr) * 256 + dc * 8;
    const unsigned ldsw = (unsigned)(uintptr_t)lds + wid * 1024;
#define PGD_DMA(s_) do { const int s__ = (s_); const unsigned b__ = ldsw + (unsigned)(s__ & 3) * 2 * OPB; const unsigned short* y__ = yg + s__ * 64; const unsigned short* w__ = wg + (size_t)(s__ >> 2) * 1024 * 256 + (s__ & 3) * 64; \
        att::glds16(y__, (unsigned)__builtin_amdgcn_readfirstlane(b__)); att::glds16(y__ + 64 * 1024, (unsigned)__builtin_amdgcn_readfirstlane(b__ + 8192)); \
        att::glds16(w__, (unsigned)__builtin_amdgcn_readfirstlane(b__ + OPB)); att::glds16(w__ + 64 * 256, (unsigned)__builtin_amdgcn_readfirstlane(b__ + OPB + 8192)); } while (0)
    f32x4 acc[2][4], mix[2][4];
#pragma unroll
    for (int a = 0; a < 2; ++a)
#pragma unroll
        for (int b = 0; b < 4; ++b) { acc[a][b] = (f32x4){0.f, 0.f, 0.f, 0.f}; mix[a][b] = (f32x4){0.f, 0.f, 0.f, 0.f}; }
    const unsigned short* sp0 = S + (size_t)(row0 + 32 * wm + fr) * 4096 + n0 + 64 * wn + 16 * fq; const unsigned short* sp1 = sp0 + (size_t)16 * 4096;
    u32x4 sgb[2][2];
#define PGD_LD16(dst_, ptr_) asm volatile("global_load_dwordx4 %0, %1, off" : "=v"(dst_) : "v"(ptr_) : "memory")
#define PGD_SLOAD(dst_, off_) do { PGD_LD16(dst_[0][0], sp0 + (off_)); PGD_LD16(dst_[0][1], sp0 + (off_) + 8); PGD_LD16(dst_[1][0], sp1 + (off_)); PGD_LD16(dst_[1][1], sp1 + (off_) + 8); } while (0)
#define PGD_PIN(r_) asm volatile("" : "+v"(r_[0][0]), "+v"(r_[0][1]), "+v"(r_[1][0]), "+v"(r_[1][1]))
    const unsigned short* ygn = Y + (size_t)(row0n + dr) * 1024 + dc * 8; const unsigned short* wgn = Wb + (size_t)(n0n + wr) * 256 + dc * 8;
#define PGD_DMA_NEXT(s_) do { const unsigned b__ = ldsw + (unsigned)(s_) * 2 * OPB; const unsigned short* y__ = ygn + (s_) * 64; const unsigned short* w__ = wgn + (s_) * 64; \
        att::glds16(y__, (unsigned)__builtin_amdgcn_readfirstlane(b__)); att::glds16(y__ + 64 * 1024, (unsigned)__builtin_amdgcn_readfirstlane(b__ + 8192)); \
        att::glds16(w__, (unsigned)__builtin_amdgcn_readfirstlane(b__ + OPB)); att::glds16(w__ + 64 * 256, (unsigned)__builtin_amdgcn_readfirstlane(b__ + OPB + 8192)); } while (0)
    if (first) { PGD_DMA(0); PGD_DMA(1); PGD_DMA(2); PGD_SLOAD(sga, 0);
        asm volatile("s_waitcnt vmcnt(12) lgkmcnt(0)\n\ts_barrier" ::: "memory"); }
    else asm volatile("s_waitcnt vmcnt(8) lgkmcnt(0)\n\ts_barrier" ::: "memory");
    const unsigned fo0 = (unsigned)(uintptr_t)lds + fr * 128 + ((fq ^ ((fr >> 1) & 7)) << 4);
#define PGD_COMPUTE(h_) do { const unsigned yb = (h_) * 2 * OPB + 32 * wm * 128, wb = (h_) * 2 * OPB + OPB + 64 * wn * 128; \
          _Pragma("unroll") for (int ks = 0; ks < 2; ++ks) { const unsigned fo_ = fo0 ^ (unsigned)(64 * ks); \
              bf16x8 yf[2], wf[4]; \
              _Pragma("unroll") for (int tt = 0; tt < 2; ++tt) yf[tt] = *(const LAS bf16x8*)(uintptr_t)(fo_ + yb + tt * 2048); \
              _Pragma("unroll") for (int nt = 0; nt < 4; ++nt) wf[nt] = *(const LAS bf16x8*)(uintptr_t)(fo_ + wb + nt * 2048); \
              _Pragma("unroll") for (int tt = 0; tt < 2; ++tt) \
                  _Pragma("unroll") for (int nt = 0; nt < 4; ++nt) acc[tt][nt] = __builtin_amdgcn_mfma_f32_16x16x32_bf16(wf[nt], yf[tt], acc[tt][nt], 0, 0, 0); } } while (0)
#define PGD_END(N) asm volatile("s_waitcnt vmcnt(" #N ") lgkmcnt(0)\n\ts_barrier" ::: "memory")
#define PGD_MIX() do { \
        _Pragma("unroll") for (int tt = 0; tt < 2; ++tt) \
            _Pragma("unroll") for (int nt = 0; nt < 4; ++nt) { const u32x4 gv = sga[tt][nt >> 1]; const unsigned g0 = (nt & 1) ? gv.z : gv.x, g1 = (nt & 1) ? gv.w : gv.y; const f32x4 a = acc[tt][nt];        \
                mix[tt][nt] += (f32x4){a[0] * bflo(g0), a[1] * bfhi(g0), a[2] * bflo(g1), a[3] * bfhi(g1)}; acc[tt][nt] = (f32x4){0.f, 0.f, 0.f, 0.f}; } } while (0)
#pragma unroll 1
    for (int kk = 0; kk < 3; ++kk) {
        const int s0 = 4 * kk;
        PGD_SLOAD(sgb, 1024);
        PGD_DMA(s0 + 3); PGD_COMPUTE(0); PGD_END(12);
        PGD_DMA(s0 + 4); PGD_COMPUTE(1); PGD_END(12);
        PGD_DMA(s0 + 5); PGD_COMPUTE(2); PGD_END(8); PGD_PIN(sga); PGD_PIN(sgb);
        PGD_DMA(s0 + 6); PGD_COMPUTE(3);
        PGD_MIX();
#pragma unroll
        for (int tt = 0; tt < 2; ++tt) { sga[tt][0] = sgb[tt][0]; sga[tt][1] = sgb[tt][1]; }
        PGD_END(8);
        sp0 += 1024; sp1 += 1024;
    }
    if (has_next) {
        { const unsigned short* sn0 = S + (size_t)(row0n + 32 * wm + fr) * 4096 + n0n + 64 * wn + 16 * fq; const unsigned short* sn1 = sn0 + (size_t)16 * 4096;
          PGD_LD16(sgb[0][0], sn0); PGD_LD16(sgb[0][1], sn0 + 8); PGD_LD16(sgb[1][0], sn1); PGD_LD16(sgb[1][1], sn1 + 8); }
        PGD_DMA(15); PGD_COMPUTE(0); PGD_END(12);
        PGD_DMA_NEXT(0); PGD_COMPUTE(1); PGD_END(12);
        PGD_DMA_NEXT(1); PGD_COMPUTE(2); PGD_END(8); PGD_PIN(sgb);
        PGD_DMA_NEXT(2); PGD_COMPUTE(3);
        PGD_MIX();
#pragma unroll
        for (int tt = 0; tt < 2; ++tt) { sga[tt][0] = sgb[tt][0]; sga[tt][1] = sgb[tt][1]; }
        PGD_END(12);
    } else {
        PGD_DMA(15); PGD_COMPUTE(0); PGD_END(8);
        PGD_COMPUTE(1); PGD_END(4);
        PGD_COMPUTE(2); PGD_END(0);
        PGD_COMPUTE(3);
        PGD_MIX();
        PGD_END(0);
    }
#pragma unroll
    for (int tt = 0; tt < 2; ++tt) { unsigned short* mp = MIX + (size_t)(row0 + 32 * wm + 16 * tt + fr) * 1024 + n0 + 64 * wn + 16 * fq;
        u32x4 w0, w1; w0.x = pk2(mix[tt][0][0], mix[tt][0][1]); w0.y = pk2(mix[tt][0][2], mix[tt][0][3]); w0.z = pk2(mix[tt][1][0], mix[tt][1][1]); w0.w = pk2(mix[tt][1][2], mix[tt][1][3]);
        w1.x = pk2(mix[tt][2][0], mix[tt][2][1]); w1.y = pk2(mix[tt][2][2], mix[tt][2][3]); w1.z = pk2(mix[tt][3][0], mix[tt][3][1]); w1.w = pk2(mix[tt][3][2], mix[tt][3][3]);
        *(u32x4*)mp = w0; *(u32x4*)(mp + 8) = w1; }
#undef PGD_DMA
#undef PGD_DMA_NEXT
#undef PGD_SLOAD
#undef PGD_LD16
#undef PGD_PIN
#undef PGD_COMPUTE
#undef PGD_END
#undef PGD_MIX
}
}
template <int VAR> __device__ __forceinline__ void ph_pgx(Frame& F, int l, int r_lo = 0, int r_hi = 1 << 20, bool signal = false) {
    const unsigned short* Y = (const unsigned short*)(F.ws + WS_G); const unsigned short* S = (const unsigned short*)(F.ws + WS_S); unsigned short* MIX = (VAR == 0) ? (unsigned short*)(F.ws + WS_H) : (unsigned short*)F.out;
    const unsigned short* Wb = (const unsigned short*)(F.ws + WS_W + (size_t)l * W_LAYER + WO_WB);
    const bool last = (l == NLAYER - 1);
    const int nrt = last ? 128 : NROWS / 128;
    bool first = true; pgx::u32x4 sga[2][2];
    for (int r = r_lo; r <= r_hi; ++r) {
        const int u = F.vcu + r * F.G; if (u >= nrt * 8) break;
        int rt = u >> 3; const int ct = u & 7;
        if (last) rt = rt + 2 * (rt / 32) + 2;
        const int u2 = u + F.G; const bool has_next = (r < r_hi) && (u2 < nrt * 8) && !signal;
        int rt2 = u2 >> 3; const int ct2 = u2 & 7; if (last) rt2 = rt2 + 2 * (rt2 / 32) + 2; if (!has_next) rt2 = rt;
        if (VAR == 0 && PGX_DMA) { pgx::pgx_unit_dma(F.lds + RING_OFF, Y, Wb, S, MIX, rt * 128, ct * 128, F.tid, first, has_next, rt2 * 128, ct2 * 128, sga); first = !has_next; }
        else pgx::pgx_unit<VAR>(F.lds + RING_OFF, Y, Wb, S, MIX, rt * 128, ct * 128, F.tid);
        if (signal) {
            asm volatile("s_waitcnt vmcnt(0)" ::: "memory"); __syncthreads();
            if (F.tid == 0) { __builtin_amdgcn_fence(__ATOMIC_RELEASE, "agent"); asm volatile("s_waitcnt vmcnt(0)" ::: "memory");
                (void)xb_add((unsigned*)((gu32*)(F.ws + WS_CTL) + CW_FLG) + (u >> 4), 1u); }
        }
    }
}
constexpr int NPL = 10;
enum { PH_H = 0, PH_G1, PH_POST1, PH_G2, PH_POST2, PH_ATT, PH_SG, PH_PG, PH_MIX, PH_OG };
constexpr int NPHASES = 1 + NLAYER * NPL;
#ifndef NAIVE_ATT
#define NAIVE_ATT 0
#endif
#ifndef PROBE_MASK
#define PROBE_MASK 0
#endif
#ifndef PROBE_LAYERS
#define PROBE_LAYERS 3
#endif
#ifndef MERGE_PGOG
#define MERGE_PGOG 0
#endif
#ifndef PHMASK
#define PHMASK 16383
#endif
#ifndef MK_ONE_LAUNCH
#define MK_ONE_LAUNCH 1
#endif

__global__ void __launch_bounds__(NTHREADS, 2) fwd_kernel(Args args) {
    extern __shared__ __attribute__((aligned(16))) unsigned char lds_raw[];
    { LAS unsigned char* l0 = (LAS unsigned char*)lds_raw;
      for (int u = threadIdx.x; u < (LDS_BYTES - LDSCTL_OFF) / 4; u += NTHREADS) ((LAS unsigned*)(l0 + LDSCTL_OFF))[u] = 0u;
      __syncthreads();
      if (args.ph_hi - args.ph_lo > 1) (void)xcd_barrier_post((unsigned*)((gu32*)(args.ws + WS_CTL) + CW_BAR), (volatile LAS unsigned*)(l0 + MISC_OFF) + 8); }

    unsigned long long tacc = 0ull;
    for (int ph = args.ph_lo; ph < args.ph_hi; ++ph) {
        unsigned long long tph0 = 0ull; bool probed = false;
        if (PROBE_MASK) { const int pl = (ph == 0) ? 0 : (ph - 1) / NPL, pp = (ph == 0) ? 10 : (ph - 1) % NPL; probed = ((PROBE_MASK >> pp) & 1) && ((PROBE_LAYERS >> pl) & 1); if (probed) tph0 = __builtin_amdgcn_s_memrealtime(); }
        int z; asm volatile("s_mov_b32 %0, 0" : "=s"(z));
        Frame F;
        F.lds = (LAS unsigned char*)lds_raw + z; F.kin = (const float* const __attribute__((address_space(4)))*)((const __attribute__((address_space(4))) char*)__builtin_amdgcn_kernarg_segment_ptr() + z); F.ws = args.ws + z; F.out = args.out + z; F.z = z;
        F.tid = threadIdx.x + z; F.lane = F.tid & 63; F.wave = __builtin_amdgcn_readfirstlane(F.tid >> 6);
        F.G = gridDim.x + z; { const int bx = blockIdx.x + z; F.vcu = (F.G % 8 == 0) ? (bx % 8) * (F.G / 8) + bx / 8 : bx; }
        F.gw = F.vcu * NWAVES + F.wave; F.NGW = F.G * NWAVES;
        bool is_gemm = false;
        pg8::Gemm g{nullptr, nullptr, NROWS, 256, 1024, 1024, 31, 0};
        pg8::Order S; S.init(1, 1, F.G, (int)blockIdx.x + z, 0);
        pg8::EpiU E{pg8::EM_PLAIN, 0, F.ws, nullptr, nullptr, nullptr, 0, 0, 0, 0, 1 << 20};
        if (ph == 0) { if (PHMASK & 8192) p0_prologue(F); }
        else {
            const int l = (ph - 1) / NPL, p = (ph - 1) % NPL;
            unsigned char* wl = F.ws + WS_W + (size_t)l * W_LAYER;
            const bool last = (l == NLAYER - 1);
            const int nMc = last ? 64 : NROWS / 256, lat = last ? 1 : 0;
            const bool merged = last && F.G == 256 && MERGE_PGOG;
            E.l = l;
            if (p == PH_H && (PHMASK & 1)) { ph_hnorm(F, l); }
            else if (p == PH_G1 && (PHMASK & 2)) {
                is_gemm = true; g.A = (const bf16*)(F.ws + WS_H); g.Bt = (const bf16*)(wl + WO_W1); g.N = N1; g.K = 1024; g.lda = 1024;
                S.init(NROWS / 256, N1 / 256, F.G, (int)blockIdx.x + z, 0);
                E.mode = pg8::EM_SILU2; E.oA = WS_ZS; E.ldc = ZS_P; E.oB = WS_G; E.ldc2 = 1024; E.split_tile = 7;
            }
            else if (p == PH_POST1 && (PHMASK & 4)) { ph_lru1(F, l); ph_post1(F, l); }
            else if (p == PH_G2 && (PHMASK & 8)) {
                is_gemm = true; g.A = (const bf16*)(F.ws + WS_ZS); g.Bt = (const bf16*)(wl + WO_UQ); g.N = 1024; g.K = 256; g.lda = ZS_P; g.a_shift = 1; g.a_step = 512;
                S.init(NROWS / 256, 4, F.G, (int)blockIdx.x + z, 0);
                E.mode = pg8::EM_PLAIN; E.oA = WS_MQ; E.ldc = 512; E.oB = WS_MKV; E.ldc2 = 512; E.split_tile = 2;
            }
            else if (p == PH_POST2 && (PHMASK & 16)) { ph_lru_carry(F); ph_post2(F, l); }
            else if (p == PH_ATT && (PHMASK & 32)) {
#if NAIVE_ATT
                ph_attn_naive(F, l);
#else
                ph_attn(F, l);
#endif
                ph_lru2(F, l); }
            else if (p == PH_SG && (PHMASK & 512)) {
                is_gemm = true; g.A = (const bf16*)(F.ws + WS_H); g.Bt = (const bf16*)(wl + WO_W1) + (size_t)N1 * 1024; g.N = 4096; g.K = 1024; g.lda = 1024;
                S.init(nMc, 16, F.G, (int)blockIdx.x + z, lat);
                E.mode = pg8::EM_SIG; E.oA = WS_S; E.ldc = 4096;
            }
            else if (p == PH_PG && (PHMASK & 1024)) {
                int r_hi = 1 << 20;
                if (merged) { pg8::Unit u0; pg8::Order S0; S0.init(64, 4, F.G, (int)blockIdx.x + z, 1); (void)S0.next(0, u0); r_hi = u0.pm / 17; }
                ph_pgx<0>(F, l, 0, r_hi, merged);
#ifdef PGX_PROBE
                if (l == 0) { __syncthreads(); ph_pgx<PGX_PROBE>(F, l); }
#endif
            }
            else if (p == PH_MIX) {
                if (!last && (PHMASK & 2048)) {
                    is_gemm = true; g.A = (const bf16*)(F.ws + WS_H); g.Bt = (const bf16*)(F.ws + WS_WOS); g.N = 4096; g.K = 256; g.lda = 1024; g.a_shift = 2; g.a_step = 512;
                    S.init(4, 16, F.G, (int)blockIdx.x + z, 2);
                    E.mode = pg8::EM_PLAIN; E.oA = WS_S; E.ldc = 4096; }
            }
            else if (p == PH_OG && (PHMASK & 4096)) {
                is_gemm = true; g.A = (const bf16*)(F.ws + WS_H); g.Bt = (const bf16*)(wl + WO_WO); g.N = 1024; g.K = 1024; g.lda = 1024;
                S.init(64, 4, F.G, (int)blockIdx.x + z, 1);
                E.mode = pg8::EM_RES; E.xin = (l == 0) ? F.in(I_X) : (const float*)F.out; E.xout = F.out; E.cin0 = F.in(I_CTX); E.oA = WS_MOD; E.oB = WS_CTX1;
                if (merged) {
                    pg8::Unit u0; (void)S.next(0, u0); const int q = (u0.pm / 17) * 16 + u0.pm % 17 - 1;
                    if (F.tid == 0) { unsigned* bar = (unsigned*)((gu32*)(F.ws + WS_CTL) + CW_BAR); unsigned* flg = (unsigned*)((gu32*)(F.ws + WS_CTL) + CW_FLG) + q;
                        XB_SPIN(xb_ld(flg) < 16u, bar); __builtin_amdgcn_fence(__ATOMIC_ACQUIRE, "agent"); asm volatile("s_waitcnt vmcnt(0)" ::: "memory"); }
                    __syncthreads(); }
            }
        }
        if (is_gemm) pg8::gemm_phase<pg8::EpiU, pg8::Order, true, true>(F.lds + RING_OFF, g, S, E, F.tid);
        if (NLAYER == 2 && ph >= 1 && ph <= 1 + PH_OG) {
            const int p = ph - 1;
            if (p == PH_G1 || p == PH_G2 || p == PH_SG || p == PH_PG || p == PH_OG) {
                int z4; asm volatile("s_mov_b32 %0, 0" : "=s"(z4));
                Frame C;
                C.lds = (LAS unsigned char*)lds_raw + z4; C.kin = (const float* const __attribute__((address_space(4)))*)((const __attribute__((address_space(4))) char*)__builtin_amdgcn_kernarg_segment_ptr() + z4); C.ws = args.ws + z4; C.out = args.out + z4; C.z = z4;
                C.tid = threadIdx.x + z4; C.lane = C.tid & 63; C.wave = __builtin_amdgcn_readfirstlane(C.tid >> 6);
                C.G = gridDim.x + z4; const int bx = blockIdx.x + z4; C.vcu = (C.G % 8 == 0) ? (bx % 8) * (C.G / 8) + bx / 8 : bx;
                C.gw = C.vcu * NWAVES + C.wave; C.NGW = C.G * NWAVES;
                int cidx = -1, cn = 1, loA = 0, nA = 0, loB = 0, nB = 0;
                if (p == PH_G1) { const int nb = ((NROWS / 256) * (N1 / 256)) % C.G; cidx = bx - nb; cn = C.G - nb; loA = I_EARLY; nA = IC_G1; }
                else if (p == PH_G2) { const int nb = ((NROWS / 256) * 4) % C.G; cidx = bx - nb; cn = C.G - nb; loA = I_EARLY + IC_G1; nA = I_INL - IC_G1; }
                else if (p == PH_SG) { const int nb = ((NROWS / 256) * 16) % C.G; cidx = bx - nb; cn = C.G - nb; loA = I_EARLY + I_INL; nA = I_BR; loB = 0; nB = 1536; }
                else if (p == PH_PG) { const int nb = ((NROWS / 128) * 8) % C.G; cidx = C.vcu - nb; cn = C.G - nb; loA = I_EARLY + I_INL + I_BR; nA = I_OUT + I_SPLIT; loB = 1536; nB = 1536; }
                else { const int nb = (64 < C.G) ? 64 : 0; cidx = bx - nb; cn = C.G - nb; loB = 3072; nB = I_LAYER - 3072; }
                if (cidx >= 0) { __syncthreads();
                    if (p == PH_G1) p0_tables(C, cidx * NTHREADS + C.tid, cn * NTHREADS);
                    weight_copies(C, cidx * NWAVES + C.wave, cn * NWAVES, loA, nA, loB, nB); }
            }
        }
        if (MERGE_PGOG && ph == 1 + (NLAYER - 1) * NPL + PH_OG && gridDim.x == 256) {
            int z5; asm volatile("s_mov_b32 %0, 0" : "=s"(z5));
            Frame C;
            C.lds = (LAS unsigned char*)lds_raw + z5; C.kin = (const float* const __attribute__((address_space(4)))*)((const __attribute__((address_space(4))) char*)__builtin_amdgcn_kernarg_segment_ptr() + z5); C.ws = args.ws + z5; C.out = args.out + z5; C.z = z5;
            C.tid = threadIdx.x + z5; C.lane = C.tid & 63; C.wave = __builtin_amdgcn_readfirstlane(C.tid >> 6);
            C.G = gridDim.x + z5; const int bx = blockIdx.x + z5; C.vcu = (C.G % 8 == 0) ? (bx % 8) * (C.G / 8) + bx / 8 : bx;
            C.gw = C.vcu * NWAVES + C.wave; C.NGW = C.G * NWAVES;
            pg8::Unit u0; pg8::Order S0; S0.init(64, 4, C.G, bx, 1); (void)S0.next(0, u0);
            __syncthreads(); ph_pgx<0>(C, NLAYER - 1, u0.pm / 17 + 1, 1 << 20, true);
        }
        const bool empty_phase = (ph > 0) && (((ph - 1) % NPL == PH_MIX) || (MERGE_PGOG && ph == 1 + (NLAYER - 1) * NPL + PH_PG && gridDim.x == 256));
        if (empty_phase) __syncthreads();
        if (ph + 1 < args.ph_hi && !empty_phase) {
            int z2; asm volatile("s_mov_b32 %0, 0" : "=s"(z2));
            XcdBarrier bar; bar.bar = (unsigned*)((gu32*)(args.ws + z2 + WS_CTL) + CW_BAR); bar.x = xb_xcc_id(); bar.st = (volatile LAS unsigned*)((LAS unsigned char*)lds_raw + z2 + MISC_OFF) + 8;
            xcd_barrier(bar);
        }
        if (PROBE_MASK) { if (probed) tacc += __builtin_amdgcn_s_memrealtime() - tph0; }
    }
#ifdef EXTRA_BARRIERS
    for (int xb = 0; xb < EXTRA_BARRIERS; ++xb) { int z3; asm volatile("s_mov_b32 %0, 0" : "=s"(z3));
        XcdBarrier bar; bar.bar = (unsigned*)((gu32*)(args.ws + z3 + WS_CTL) + CW_BAR); bar.x = xb_xcc_id(); bar.st = (volatile LAS unsigned*)((LAS unsigned char*)lds_raw + z3 + MISC_OFF) + 8;
        xcd_barrier(bar); }
#endif
    if (PROBE_MASK) { const unsigned long long t0 = __builtin_amdgcn_s_memrealtime(); while (__builtin_amdgcn_s_memrealtime() - t0 < tacc) __builtin_amdgcn_s_sleep(8); }
}

extern "C" void kernel_launch(void* const* d_in, const int* in_sizes, int n_in, void* d_out, int out_size, void* d_ws, size_t ws_size, hipStream_t stream) {
    static int grid = 0;
    if (grid == 0) {
        if (n_in != 28 || out_size != NB * SEQ * DM || ws_size < WS_END) { fprintf(stderr, "kernel_launch: unexpected shapes (n_in %d out %d ws %zu); nothing launched\n", n_in, out_size, ws_size); grid = -1; return; }
        int dev = 0, cus = 0, per_cu = 0;
        if (hipGetDevice(&dev) != hipSuccess || hipDeviceGetAttribute(&cus, hipDeviceAttributeMultiprocessorCount, dev) != hipSuccess) { grid = -1; return; }
        if (hipFuncSetAttribute((const void*)fwd_kernel, hipFuncAttributeMaxDynamicSharedMemorySize, LDS_BYTES) != hipSuccess) { fprintf(stderr, "kernel_launch: hipFuncSetAttribute failed\n"); grid = -1; return; }
        if (hipOccupancyMaxActiveBlocksPerMultiprocessor(&per_cu, (const void*)fwd_kernel, NTHREADS, LDS_BYTES) != hipSuccess || per_cu < 1) { fprintf(stderr, "kernel_launch: occupancy query says %d\n", per_cu); (void)hipGetLastError(); grid = -1; return; }
        grid = cus;
    }
    if (grid < 0) return;
    (void)hipMemsetAsync((char*)d_ws + WS_CTL, 0, CTL_ZERO_BYTES, stream);
    Args a{};
    for (int i = 0; i < 28; ++i) a.in[i] = (const float*)d_in[i];
    a.out = (float*)d_out; a.ws = (unsigned char*)d_ws;
#if MK_ONE_LAUNCH
    a.ph_lo = 0; a.ph_hi = NPHASES;
    hipLaunchKernelGGL(fwd_kernel, dim3(grid), dim3(NTHREADS), LDS_BYTES, stream, a);
#else
    for (int ph = 0; ph < NPHASES; ++ph) { a.ph_lo = ph; a.ph_hi = ph + 1; hipLaunchKernelGGL(fwd_kernel, dim3(grid), dim3(NTHREADS), LDS_BYTES, stream, a); }
#endif
}
```
